# Optimizing an MI355X kernel written in HIP

```python
import math
import jax, jax.numpy as jnp
from jax import lax
import numpy as np

D_MODEL = 1024
BATCH = 2
SEQ = 8192
DEPTH = 1

HEAD_DIM = 64
MIX_WIDTH = D_MODEL
NSA_HEADS = (MIX_WIDTH // 2) // HEAD_DIM
NSA_KV_GROUPS = 2
NSA_GROUP_SIZE = NSA_HEADS // NSA_KV_GROUPS
NSA_WIDTH = NSA_HEADS * HEAD_DIM
NSA_KV_WIDTH = NSA_KV_GROUPS * HEAD_DIM
CMP_BLOCK = 32
CMP_STRIDE = 16
CMP_HIDDEN = 256
SEL_BLOCK = 64
SEL_TOPK = 16
SEL_FORCE = 1e4
WINDOW = 512
Q_BLOCK = 128
RWKV_HEADS = (MIX_WIDTH - NSA_WIDTH) // HEAD_DIM
RWKV_WIDTH = RWKV_HEADS * HEAD_DIM
DECAY_LORA = 64
AAA_LORA = 64
GATE_LORA = 128
RWKV_GN_EPS = 64e-5
D_FF = 2816
MEM_TOKENS = 256
MEM_HEADS = 4
MEM_HEAD_DIM = D_MODEL // MEM_HEADS
ROPE_THETA = 10000.0
NORM_EPS = 1e-6
NEG_INF = -1e30

NSA_SPLITS = (NSA_WIDTH,) + (NSA_KV_WIDTH,) * 6 + (3 * NSA_HEADS,)
RWKV_SPLITS = (RWKV_WIDTH,) * 3 + (DECAY_LORA, AAA_LORA, GATE_LORA)
NSA_COLS = sum(NSA_SPLITS)
RWKV_COLS = sum(RWKV_SPLITS)
IN_COLS = NSA_COLS + RWKV_COLS

kernel_name = 'hybrid_nsa_rwkv7_macaron_block'


def rms_norm(x, g):
    xf = x.astype(jnp.float32)
    y = xf * lax.rsqrt(jnp.mean(xf * xf, -1, keepdims=True) + NORM_EPS)
    return (y * g.astype(jnp.float32)).astype(x.dtype)


def swiglu(x, w_gate, w_up, w_down):
    return (jax.nn.silu(x @ w_gate) * (x @ w_up)) @ w_down


def rope(x, pos):
    half = x.shape[-1] // 2
    inv = ROPE_THETA ** (-jnp.arange(half, dtype=jnp.float32) / half)
    ang = pos.astype(jnp.float32)[:, None] * inv[None, :]
    cos, sin = jnp.cos(ang).astype(x.dtype), jnp.sin(ang).astype(x.dtype)
    x1, x2 = x[..., :half], x[..., half:]
    return jnp.concatenate([x1 * cos - x2 * sin, x1 * sin + x2 * cos], -1)


def masked_softmax(s, mask):
    s = jnp.where(mask, s.astype(jnp.float32), NEG_INF)
    m = jnp.max(s, -1, keepdims=True)
    e = jnp.where(mask, jnp.exp(s - m), 0.0)
    return e / jnp.maximum(jnp.sum(e, -1, keepdims=True), 1e-30)


def split_cols(z, sizes):
    return jnp.split(z, np.cumsum(sizes)[:-1].tolist(), axis=-1)


def compress_blocks(kv, pe, w1, w2):
    T = kv.shape[2]
    n_cmp = (T - CMP_BLOCK) // CMP_STRIDE + 1
    idx = np.arange(n_cmp)[:, None] * CMP_STRIDE + np.arange(CMP_BLOCK)[None, :]
    blocks = kv[:, :, idx, :] + pe
    flat = blocks.reshape(blocks.shape[:3] + (CMP_BLOCK * HEAD_DIM,))
    return jax.nn.silu(flat @ w1) @ w2


def nsa_mixer(q, k_cmp, v_cmp, k_slc, v_slc, k_win, v_win, gate_logits,
              pe_k, w1_k, w2_k, pe_v, w1_v, w2_v):
    B, T, _ = q.shape
    G, R, dh = NSA_KV_GROUPS, NSA_GROUP_SIZE, HEAD_DIM
    pos = jnp.arange(T)
    qh = rope(q.reshape(B, T, G, R, dh).transpose(0, 2, 3, 1, 4), pos)

    def kv_heads(z):
        return z.reshape(B, T, G, dh).transpose(0, 2, 1, 3)

    n_cmp = (T - CMP_BLOCK) // CMP_STRIDE + 1
    cmp_start = np.arange(n_cmp) * CMP_STRIDE
    cmp_end = jnp.asarray(cmp_start + CMP_BLOCK - 1)
    kc = rope(compress_blocks(kv_heads(k_cmp), pe_k, w1_k, w2_k), cmp_end)
    vc = compress_blocks(kv_heads(v_cmp), pe_v, w1_v, w2_v)

    n_sel = T // SEL_BLOCK
    n_top = min(SEL_TOPK, n_sel)
    sel_start = np.arange(n_sel) * SEL_BLOCK
    overlap = jnp.asarray(((cmp_start[:, None] < sel_start[None, :] + SEL_BLOCK)
                           & (cmp_start[:, None] + CMP_BLOCK > sel_start[None, :])).astype(np.float32))
    ks_blocks = rope(kv_heads(k_slc), pos).reshape(B, G, n_sel, SEL_BLOCK, dh)
    vs_blocks = kv_heads(v_slc).reshape(B, G, n_sel, SEL_BLOCK, dh)
    pad = ((0, 0), (0, 0), (WINDOW, 0), (0, 0))
    kw_pad = jnp.pad(rope(kv_heads(k_win), pos), pad)
    vw_pad = jnp.pad(kv_heads(v_win), pad)
    gates = jax.nn.sigmoid(gate_logits).reshape(B, T, G, R, 3).transpose(0, 2, 3, 1, 4)
    scale = HEAD_DIM ** -0.5
    gather_blocks = jax.vmap(jax.vmap(lambda blocks, ids: blocks[ids]))
    sel_ids = jnp.arange(n_sel)

    def query_block(i):
        q0 = i * Q_BLOCK
        t = q0 + jnp.arange(Q_BLOCK)
        qb = lax.dynamic_slice_in_dim(qh, q0, Q_BLOCK, axis=3)
        gb = lax.dynamic_slice_in_dim(gates, q0, Q_BLOCK, axis=3)
        s_c = jnp.einsum('bgrqd,bgcd->bgrqc', qb, kc) * scale
        p_c = masked_softmax(s_c, cmp_end[None, :] <= t[:, None])
        o_c = jnp.einsum('bgrqc,bgcd->bgrqd', p_c.astype(vc.dtype), vc)
        imp = jnp.einsum('bgrqc,cs->bgqs', p_c, overlap)
        cur = (t // SEL_BLOCK)[:, None]
        forced = (sel_ids == 0) | (sel_ids == cur) | (sel_ids == cur - 1)
        score = jnp.where(forced, SEL_FORCE, jnp.where(sel_ids <= cur, imp, -SEL_FORCE))
        _, top = lax.top_k(score, n_top)
        ks = gather_blocks(ks_blocks, top).reshape(B, G, Q_BLOCK, n_top * SEL_BLOCK, dh)
        vs = gather_blocks(vs_blocks, top).reshape(B, G, Q_BLOCK, n_top * SEL_BLOCK, dh)
        pos_s = (top[..., None] * SEL_BLOCK + jnp.arange(SEL_BLOCK)).reshape(B, G, 1, Q_BLOCK, n_top * SEL_BLOCK)
        s_s = jnp.einsum('bgrqd,bgqkd->bgrqk', qb, ks) * scale
        p_s = masked_softmax(s_s, pos_s <= t[:, None])
        o_s = jnp.einsum('bgrqk,bgqkd->bgrqd', p_s.astype(vs.dtype), vs)
        kw = lax.dynamic_slice_in_dim(kw_pad, q0, Q_BLOCK + WINDOW, axis=2)
        vw = lax.dynamic_slice_in_dim(vw_pad, q0, Q_BLOCK + WINDOW, axis=2)
        pos_w = q0 - WINDOW + jnp.arange(Q_BLOCK + WINDOW)
        rel = t[:, None] - pos_w[None, :]
        s_w = jnp.einsum('bgrqd,bgkd->bgrqk', qb, kw) * scale
        p_w = masked_softmax(s_w, (pos_w[None, :] >= 0) & (rel >= 0) & (rel < WINDOW))
        o_w = jnp.einsum('bgrqk,bgkd->bgrqd', p_w.astype(vw.dtype), vw)
        return gb[..., 0:1] * o_c + gb[..., 1:2] * o_s + gb[..., 2:3] * o_w

    out = lax.map(query_block, jnp.arange(T // Q_BLOCK))
    return out.transpose(1, 0, 4, 2, 3, 5).reshape(B, T, NSA_WIDTH)


def rwkv7_mixer(r, k, v, w_lo, a_lo, g_lo, w0, w2, a0, a2, g2, k_k, k_a, r_k, gn_g, gn_b):
    B, T, C = r.shape
    H, N = RWKV_HEADS, HEAD_DIM
    f32 = jnp.float32
    w = -jax.nn.softplus(-(w0 + jnp.tanh(w_lo) @ w2)) - 0.5
    decay = jnp.exp(-jnp.exp(w.astype(f32)))
    a = jax.nn.sigmoid(a0 + a_lo @ a2)
    g = jax.nn.sigmoid(g_lo) @ g2
    kk = (k * k_k).astype(f32).reshape(B, T, H, N)
    kk = kk / jnp.maximum(jnp.sqrt(jnp.sum(kk * kk, -1, keepdims=True)), 1e-12)
    k = k * (1 + (a - 1) * k_a)

    def heads(z):
        return z.astype(f32).reshape(B, T, H, N).transpose(1, 0, 2, 3)

    def step(state, inp):
        r_t, w_t, k_t, v_t, kk_t, a_t = inp
        sa = jnp.einsum('bhvk,bhk->bhv', state, -kk_t)
        state = (state * w_t[:, :, None, :] + sa[..., None] * (kk_t * a_t)[:, :, None, :]
                 + v_t[..., None] * k_t[:, :, None, :])
        return state, jnp.einsum('bhvk,bhk->bhv', state, r_t)

    state0 = jnp.zeros((B, H, N, N), f32)
    _, y = lax.scan(step, state0, (heads(r), heads(decay), heads(k), heads(v),
                                   kk.transpose(1, 0, 2, 3), heads(a)))
    y = y.transpose(1, 0, 2, 3)
    mu = jnp.mean(y, -1, keepdims=True)
    var = jnp.mean(jnp.square(y - mu), -1, keepdims=True)
    y = ((y - mu) * lax.rsqrt(var + RWKV_GN_EPS)).reshape(B, T, C)
    y = y * gn_g.astype(f32) + gn_b.astype(f32)
    bonus = (jnp.sum((r * k * r_k).astype(f32).reshape(B, T, H, N), -1, keepdims=True)
             * v.astype(f32).reshape(B, T, H, N)).reshape(B, T, C)
    return (y + bonus).astype(r.dtype) * g


def memory_cross_attention(h, m, wq, wk, wv, wo):
    B, T, _ = h.shape
    M = m.shape[1]
    q = (h @ wq).reshape(B, T, MEM_HEADS, MEM_HEAD_DIM)
    k = (m @ wk).reshape(B, M, MEM_HEADS, MEM_HEAD_DIM)
    v = (m @ wv).reshape(B, M, MEM_HEADS, MEM_HEAD_DIM)
    s = jnp.einsum('bqhd,bkhd->bhqk', q, k) * (MEM_HEAD_DIM ** -0.5)
    p = jax.nn.softmax(s.astype(jnp.float32), axis=-1).astype(v.dtype)
    o = jnp.einsum('bhqk,bkhd->bqhd', p, v).reshape(B, T, D_MODEL)
    return o @ wo


def setup_inputs(seed: int = 0) -> dict:
    key = jax.random.key(seed)
    L = DEPTH
    specs = [
        ('x', (BATCH, SEQ, D_MODEL), 'normal', 1.0),
        ('mem', (BATCH, MEM_TOKENS, D_MODEL), 'normal', 1.0),
        ('ffn1_pre_g', (L, D_MODEL), 'gain', 0.02),
        ('ffn1_w_gate', (L, D_MODEL, D_FF), 'normal', D_MODEL ** -0.5),
        ('ffn1_w_up', (L, D_MODEL, D_FF), 'normal', D_MODEL ** -0.5),
        ('ffn1_w_down', (L, D_FF, D_MODEL), 'normal', D_FF ** -0.5),
        ('ffn1_post_g', (L, D_MODEL), 'gain', 0.02),
        ('mix_pre_g', (L, D_MODEL), 'gain', 0.02),
        ('w_in', (L, D_MODEL, IN_COLS), 'normal', D_MODEL ** -0.5),
        ('cmp_pe_k', (L, CMP_BLOCK, HEAD_DIM), 'normal', 0.1),
        ('cmp_w1_k', (L, CMP_BLOCK * HEAD_DIM, CMP_HIDDEN), 'normal', (CMP_BLOCK * HEAD_DIM) ** -0.5),
        ('cmp_w2_k', (L, CMP_HIDDEN, HEAD_DIM), 'normal', CMP_HIDDEN ** -0.5),
        ('cmp_pe_v', (L, CMP_BLOCK, HEAD_DIM), 'normal', 0.1),
        ('cmp_w1_v', (L, CMP_BLOCK * HEAD_DIM, CMP_HIDDEN), 'normal', (CMP_BLOCK * HEAD_DIM) ** -0.5),
        ('cmp_w2_v', (L, CMP_HIDDEN, HEAD_DIM), 'normal', CMP_HIDDEN ** -0.5),
        ('nsa_out_g', (L, NSA_WIDTH), 'gain', 0.02),
        ('rwkv_mu', (L, RWKV_COLS), 'uniform', (0.0, 1.0)),
        ('rwkv_w0', (L, RWKV_WIDTH), 'uniform', (-5.0, 1.0)),
        ('rwkv_w2', (L, DECAY_LORA, RWKV_WIDTH), 'normal', DECAY_LORA ** -0.5),
        ('rwkv_a0', (L, RWKV_WIDTH), 'normal', 0.1),
        ('rwkv_a2', (L, AAA_LORA, RWKV_WIDTH), 'normal', AAA_LORA ** -0.5),
        ('rwkv_g2', (L, GATE_LORA, RWKV_WIDTH), 'normal', GATE_LORA ** -0.5),
        ('rwkv_k_k', (L, RWKV_WIDTH), 'uniform', (0.7, 1.0)),
        ('rwkv_k_a', (L, RWKV_WIDTH), 'uniform', (0.8, 1.2)),
        ('rwkv_r_k', (L, RWKV_WIDTH), 'normal', 0.1),
        ('rwkv_gn_g', (L, RWKV_WIDTH), 'gain', 0.02),
        ('rwkv_gn_b', (L, RWKV_WIDTH), 'normal', 0.02),
        ('w_out', (L, MIX_WIDTH, D_MODEL), 'normal', MIX_WIDTH ** -0.5),
        ('mix_post_g', (L, D_MODEL), 'gain', 0.02),
        ('mem_pre_g', (L, D_MODEL), 'gain', 0.02),
        ('mem_kv_g', (L, D_MODEL), 'gain', 0.02),
        ('mem_wq', (L, D_MODEL, D_MODEL), 'normal', D_MODEL ** -0.5),
        ('mem_wk', (L, D_MODEL, D_MODEL), 'normal', D_MODEL ** -0.5),
        ('mem_wv', (L, D_MODEL, D_MODEL), 'normal', D_MODEL ** -0.5),
        ('mem_wo', (L, D_MODEL, D_MODEL), 'normal', D_MODEL ** -0.5),
        ('mem_post_g', (L, D_MODEL), 'gain', 0.02),
        ('ffn2_pre_g', (L, D_MODEL), 'gain', 0.02),
        ('ffn2_w_gate', (L, D_MODEL, D_FF), 'normal', D_MODEL ** -0.5),
        ('ffn2_w_up', (L, D_MODEL, D_FF), 'normal', D_MODEL ** -0.5),
        ('ffn2_w_down', (L, D_FF, D_MODEL), 'normal', D_FF ** -0.5),
        ('ffn2_post_g', (L, D_MODEL), 'gain', 0.02),
    ]
    keys = jax.random.split(key, len(specs))
    out = {}
    for kk, (name, shape, kind, p) in zip(keys, specs):
        if kind == 'normal':
            out[name] = p * jax.random.normal(kk, shape, jnp.float32)
        elif kind == 'gain':
            out[name] = 1.0 + p * jax.random.normal(kk, shape, jnp.float32)
        else:
            out[name] = jax.random.uniform(kk, shape, jnp.float32, p[0], p[1])
    return out


def reference(x, mem,
              ffn1_pre_g, ffn1_w_gate, ffn1_w_up, ffn1_w_down, ffn1_post_g,
              mix_pre_g, w_in, cmp_pe_k, cmp_w1_k, cmp_w2_k, cmp_pe_v, cmp_w1_v, cmp_w2_v, nsa_out_g,
              rwkv_mu, rwkv_w0, rwkv_w2, rwkv_a0, rwkv_a2, rwkv_g2, rwkv_k_k, rwkv_k_a, rwkv_r_k,
              rwkv_gn_g, rwkv_gn_b, w_out, mix_post_g,
              mem_pre_g, mem_kv_g, mem_wq, mem_wk, mem_wv, mem_wo, mem_post_g,
              ffn2_pre_g, ffn2_w_gate, ffn2_w_up, ffn2_w_down, ffn2_post_g):
    for l in range(DEPTH):
        h = rms_norm(x, ffn1_pre_g[l])
        x = x + 0.5 * rms_norm(swiglu(h, ffn1_w_gate[l], ffn1_w_up[l], ffn1_w_down[l]), ffn1_post_g[l])
        h = rms_norm(x, mix_pre_g[l])
        proj = h @ w_in[l]
        nsa_cols, rwkv_cols = proj[..., :NSA_COLS], proj[..., NSA_COLS:]
        prev = jnp.pad(rwkv_cols, ((0, 0), (1, 0), (0, 0)))[:, :-1]
        rwkv_cols = rwkv_cols + (prev - rwkv_cols) * rwkv_mu[l]
        q, k_c, v_c, k_s, v_s, k_w, v_w, gate_logits = split_cols(nsa_cols, NSA_SPLITS)
        r, k, v, w_lo, a_lo, g_lo = split_cols(rwkv_cols, RWKV_SPLITS)
        o_nsa = nsa_mixer(q, k_c, v_c, k_s, v_s, k_w, v_w, gate_logits,
                          cmp_pe_k[l], cmp_w1_k[l], cmp_w2_k[l], cmp_pe_v[l], cmp_w1_v[l], cmp_w2_v[l])
        o_rwkv = rwkv7_mixer(r, k, v, w_lo, a_lo, g_lo, rwkv_w0[l], rwkv_w2[l], rwkv_a0[l], rwkv_a2[l],
                             rwkv_g2[l], rwkv_k_k[l], rwkv_k_a[l], rwkv_r_k[l], rwkv_gn_g[l], rwkv_gn_b[l])
        mixed = jnp.concatenate([rms_norm(o_nsa, nsa_out_g[l]), o_rwkv], -1) @ w_out[l]
        x = x + rms_norm(mixed, mix_post_g[l])
        h = rms_norm(x, mem_pre_g[l])
        m = rms_norm(mem, mem_kv_g[l])
        x = x + rms_norm(memory_cross_attention(h, m, mem_wq[l], mem_wk[l], mem_wv[l], mem_wo[l]), mem_post_g[l])
        h = rms_norm(x, ffn2_pre_g[l])
        x = x + 0.5 * rms_norm(swiglu(h, ffn2_w_gate[l], ffn2_w_up[l], ffn2_w_down[l]), ffn2_post_g[l])
    return x
```

```cpp
#include <hip/hip_runtime.h>
#include <cstdint>
#include <cstdio>

constexpr int NB = 2, T_ = 8192, DM = 1024, M_ = NB * T_;
constexpr int FF = 2816, NGU = 2 * FF;
constexpr int IN_COLS = 3096, NWIN = 3328;
constexpr int NRW = 1792;
constexpr int NCP = 512;
constexpr int NLORA = 1536, KLORA = 256;
constexpr float NORM_EPS = 1e-6f;
constexpr float QSCALE = 0.125f * 1.4426950408889634f;
constexpr float MSCALE = 0.0625f * 1.4426950408889634f;

typedef unsigned short bf16;
typedef short bf16x8 __attribute__((ext_vector_type(8)));
typedef float f32x4 __attribute__((ext_vector_type(4)));
typedef unsigned u32x2 __attribute__((ext_vector_type(2)));
typedef unsigned u32x4 __attribute__((ext_vector_type(4)));

__device__ __forceinline__ unsigned f2bf(float f) { unsigned u = __builtin_bit_cast(unsigned, f); return (u + 0x7fffu + ((u >> 16) & 1u)) >> 16; }
__device__ __forceinline__ float bf2f(bf16 h) { return __builtin_bit_cast(float, (unsigned)h << 16); }
__device__ __forceinline__ unsigned pk2(float lo, float hi) { return f2bf(lo) | (f2bf(hi) << 16); }
__device__ __forceinline__ void st_bf4(bf16* p, f32x4 v) { u32x2 w; w.x = pk2(v[0], v[1]); w.y = pk2(v[2], v[3]); *(u32x2*)p = w; }
__device__ __forceinline__ float wave_sum(float v) {
#pragma unroll
    for (int o = 1; o < 64; o <<= 1) v += __shfl_xor(v, o);
    return v;
}
__device__ __forceinline__ float wave_max(float v) {
#pragma unroll
    for (int o = 1; o < 64; o <<= 1) v = fmaxf(v, __shfl_xor(v, o));
    return v;
}
__device__ __forceinline__ float sigmoidf_(float x) { return 1.f / (1.f + __expf(-x)); }

constexpr size_t MiB = 1u << 20, KiB64 = 65536;
constexpr size_t WS_CTL = 0;
constexpr size_t WS_KC = 256 * 1024;
constexpr size_t WS_VCT = 512 * 1024;
constexpr size_t WS_W1GU = 1 * MiB;
constexpr size_t WS_W1D = 12 * MiB;
constexpr size_t WS_W2GU = WS_W1D + 88 * KiB64;
constexpr size_t WS_W2D = WS_W2GU + 11 * MiB;
constexpr size_t WS_WIN = WS_W2D + 88 * KiB64;
constexpr size_t WS_WOUT = WS_WIN + 104 * KiB64;
constexpr size_t WS_WQ = WS_WOUT + 2 * MiB, WS_WK = WS_WQ + 2 * MiB, WS_WV = WS_WK + 2 * MiB, WS_WO = WS_WV + 2 * MiB;
constexpr size_t WS_CW1K = WS_WO + 2 * MiB, WS_CW1V = WS_CW1K + 1 * MiB;
constexpr size_t WS_WLORA = WS_CW1V + 1 * MiB;
constexpr size_t WS_ROPE = WS_WLORA + 12 * KiB64;
constexpr size_t WS_CBIAS = WS_ROPE + 2 * MiB;
constexpr size_t WS_MEMN = WS_CBIAS + KiB64;
constexpr size_t WS_HIDK = WS_MEMN + 1 * MiB;
constexpr size_t WS_HIDV = WS_HIDK + 1 * MiB;
constexpr size_t WS_GATES = WS_HIDV + 1 * MiB;
constexpr size_t WS_XN = 60 * MiB;
constexpr size_t WS_YB = 92 * MiB;
constexpr size_t WS_D = 124 * MiB;
constexpr size_t WS_HB = WS_D;
constexpr size_t WS_QB = WS_D;
constexpr size_t WS_KS = WS_D + 16 * MiB;
constexpr size_t WS_KW = WS_D + 20 * MiB;
constexpr size_t WS_KCR = WS_D + 24 * MiB;
constexpr size_t WS_VCR = WS_D + 29 * MiB;
constexpr size_t WS_VST = WS_D + 34 * MiB;
constexpr size_t WS_VWT = WS_D + 38 * MiB;
constexpr size_t WS_PR = WS_D + 42 * MiB;
constexpr size_t WS_AGA = WS_D + 98 * MiB;
constexpr size_t WS_AGG = WS_D + 114 * MiB;
constexpr size_t WS_END = 256 * MiB;
constexpr size_t WS_QM = WS_D;
constexpr size_t WS_OM = WS_D + 32 * MiB;
constexpr size_t WS_MK = WS_D + 64 * MiB;
constexpr size_t WS_MVT = WS_D + 65 * MiB;
static_assert(WS_GATES + (size_t)M_ * 24 * 4 <= WS_XN, "ws map");
static_assert(WS_AGG + 16 * MiB <= WS_END, "ws map");

struct Params {
    const float* in[41];
    float* out;
    unsigned char* ws;
};
enum { I_X = 0, I_MEM, I_F1_PRE, I_F1_WG, I_F1_WU, I_F1_WD, I_F1_POST, I_MIX_PRE, I_WIN, I_PE_K, I_W1_K, I_W2_K, I_PE_V, I_W1_V, I_W2_V,
       I_NSA_G, I_MU, I_W0, I_W2, I_A0, I_A2, I_G2, I_KK, I_KA, I_RK, I_GNG, I_GNB, I_WOUT, I_MIX_POST, I_MEM_PRE, I_MEM_KVG, I_WQ, I_WK, I_WV,
       I_WO, I_MEM_POST, I_F2_PRE, I_F2_WG, I_F2_WU, I_F2_WD, I_F2_POST };

struct MapPlain { const float* W; int N; int pad; __device__ const float* col(int p) const { return W + p; } };
struct MapGU {
    const float* Wg; const float* Wu; int N; int pad;
    __device__ const float* col(int p) const {
        const int pn = p >> 8, q = p & 255, n = (q >> 4) & 1;
        const int hid = 128 * pn + 64 * (q >> 7) + 16 * ((q >> 5) & 3) + (q & 15);
        return (n ? Wu : Wg) + hid;
    }
};
__host__ __device__ inline int rope_perm(int x) { return 16 * ((x >> 5) & 1) + (x & 15) + 32 * ((x >> 4) & 1); }
struct MapWin {
    const float* W; int N; int pad;
    __device__ const float* col(int p) const {
        int l;
        if (p < 512) l = (p & ~63) + rope_perm(p & 63);
        else if (p < 640) l = 768 + ((p - 512) & ~63) + rope_perm(p & 63);
        else if (p < 768) l = 1024 + ((p - 640) & ~63) + rope_perm(p & 63);
        else if (p < 896) l = 512 + (p - 768);
        else if (p < 1024) l = 640 + (p - 896);
        else if (p < 1152) l = 896 + (p - 1024);
        else if (p < 1280) l = 1152 + (p - 1152);
        else if (p < 3072) l = 1304 + (p - 1280);
        else if (p < 3096) l = 1280 + (p - 3072);
        else return nullptr;
        return W + l;
    }
};
template <class Map> __global__ void __launch_bounds__(256) k_convert(bf16* WT, int K, Map map) {
    const int p = blockIdx.x * 64 + (threadIdx.x & 63);
    const int k0 = blockIdx.y * 64 + (threadIdx.x >> 6) * 16;
    const float* src = map.col(p);
    float v[16];
#pragma unroll
    for (int i = 0; i < 16; ++i) v[i] = src ? src[(size_t)(k0 + i) * map.N] : 0.f;
    u32x4 a, b;
    a.x = pk2(v[0], v[1]); a.y = pk2(v[2], v[3]); a.z = pk2(v[4], v[5]); a.w = pk2(v[6], v[7]);
    b.x = pk2(v[8], v[9]); b.y = pk2(v[10], v[11]); b.z = pk2(v[12], v[13]); b.w = pk2(v[14], v[15]);
    u32x4* dst = (u32x4*)(WT + (size_t)p * K + k0);
    dst[0] = a; dst[1] = b;
}
__global__ void __launch_bounds__(256) k_convert_lora(bf16* WT, const float* w2, const float* a2, const float* g2) {
    const int idx = blockIdx.x * 256 + threadIdx.x;
    const int p = idx >> 8, k = idx & 255;
    float v = 0.f;
    if (p < 512) { if (k < 64) v = w2[k * 512 + p]; }
    else if (p < 1024) { if (k >= 64 && k < 128) v = a2[(k - 64) * 512 + (p - 512)]; }
    else { if (k >= 128) v = g2[(k - 128) * 512 + (p - 1024)]; }
    WT[idx] = (bf16)f2bf(v);
}
__global__ void __launch_bounds__(256) k_rope_table(float* tab) {
    const int idx = blockIdx.x * 256 + threadIdx.x;
    const int pos = idx >> 5, i = idx & 31;
    const float inv = (float)pow(10000.0, -(double)i / 32.0);
    const float ang = (float)pos * inv;
    tab[2 * idx] = (float)cos((double)ang); tab[2 * idx + 1] = (float)sin((double)ang);
}
__global__ void __launch_bounds__(512) k_cmp_bias(const float* pe_k, const float* w1_k, const float* pe_v, const float* w1_v, float* bias) {
    __shared__ float red[8][64];
    const float* pe = blockIdx.y ? pe_v : pe_k; const float* w1 = blockIdx.y ? w1_v : w1_k;
    const int lane = threadIdx.x & 63, w = threadIdx.x >> 6, n = blockIdx.x * 64 + lane;
    float s = 0.f;
    for (int j = w * 256; j < w * 256 + 256; ++j) s += pe[j] * w1[(size_t)j * 256 + n];
    red[w][lane] = s; __syncthreads();
    if (w == 0) { float t = 0.f; for (int i = 0; i < 8; ++i) t += red[i][lane]; bias[blockIdx.y * 256 + n] = t; }
}

__global__ void __launch_bounds__(256) k_rownorm(const float* x, const float* g, bf16* xn, int rows) {
    const int row = blockIdx.x * 4 + (threadIdx.x >> 6), lane = threadIdx.x & 63; if (row >= rows) return;
    const f32x4* xr = (const f32x4*)(x + (size_t)row * DM) + lane; f32x4 v[4]; float s = 0.f;
#pragma unroll
    for (int j = 0; j < 4; ++j) { v[j] = xr[64 * j]; s += v[j][0] * v[j][0] + v[j][1] * v[j][1] + v[j][2] * v[j][2] + v[j][3] * v[j][3]; }
    const float rstd = rsqrtf(wave_sum(s) * (1.f / DM) + NORM_EPS);
#pragma unroll
    for (int j = 0; j < 4; ++j) { const f32x4 gg = ((const f32x4*)g)[lane + 64 * j]; st_bf4(xn + (size_t)row * DM + 4 * (lane + 64 * j), v[j] * rstd * gg); }
}
__global__ void __launch_bounds__(256) k_rowpass(const float* xin, const bf16* y, const float* gpost, float coef, const float* gpre, float* xout, bf16* xn) {
    const int row = blockIdx.x * 4 + (threadIdx.x >> 6), lane = threadIdx.x & 63;
    f32x4 yv[4], xv[4]; float s = 0.f;
#pragma unroll
    for (int j = 0; j < 4; ++j) {
        const u32x2 w = *(const u32x2*)(y + (size_t)row * DM + 4 * (lane + 64 * j));
        yv[j][0] = __builtin_bit_cast(float, w.x << 16); yv[j][1] = __builtin_bit_cast(float, w.x & 0xffff0000u);
        yv[j][2] = __builtin_bit_cast(float, w.y << 16); yv[j][3] = __builtin_bit_cast(float, w.y & 0xffff0000u);
        s += yv[j][0] * yv[j][0] + yv[j][1] * yv[j][1] + yv[j][2] * yv[j][2] + yv[j][3] * yv[j][3];
        xv[j] = ((const f32x4*)(xin + (size_t)row * DM))[lane + 64 * j];
    }
    const float rstd = rsqrtf(wave_sum(s) * (1.f / DM) + NORM_EPS) * coef; float s2 = 0.f;
#pragma unroll
    for (int j = 0; j < 4; ++j) { const f32x4 gg = ((const f32x4*)gpost)[lane + 64 * j]; xv[j] = xv[j] + yv[j] * rstd * gg;
        s2 += xv[j][0] * xv[j][0] + xv[j][1] * xv[j][1] + xv[j][2] * xv[j][2] + xv[j][3] * xv[j][3];
        ((f32x4*)(xout + (size_t)row * DM))[lane + 64 * j] = xv[j]; }
    if (gpre) {
        const float r2 = rsqrtf(wave_sum(s2) * (1.f / DM) + NORM_EPS);
#pragma unroll
        for (int j = 0; j < 4; ++j) { const f32x4 gg = ((const f32x4*)gpre)[lane + 64 * j]; st_bf4(xn + (size_t)row * DM + 4 * (lane + 64 * j), xv[j] * r2 * gg); }
    }
}
__global__ void __launch_bounds__(256) k_nsa_outnorm(bf16* amix, const float* g) {
    const int row = blockIdx.x * 4 + (threadIdx.x >> 6), lane = threadIdx.x & 63;
    bf16* p = amix + (size_t)row * DM + 8 * lane;
    const u32x4 w = *(const u32x4*)p; float v[8]; float s = 0.f;
    v[0] = __builtin_bit_cast(float, w.x << 16); v[1] = __builtin_bit_cast(float, w.x & 0xffff0000u);
    v[2] = __builtin_bit_cast(float, w.y << 16); v[3] = __builtin_bit_cast(float, w.y & 0xffff0000u);
    v[4] = __builtin_bit_cast(float, w.z << 16); v[5] = __builtin_bit_cast(float, w.z & 0xffff0000u);
    v[6] = __builtin_bit_cast(float, w.w << 16); v[7] = __builtin_bit_cast(float, w.w & 0xffff0000u);
#pragma unroll
    for (int i = 0; i < 8; ++i) s += v[i] * v[i];
    const float rstd = rsqrtf(wave_sum(s) * (1.f / 512.f) + NORM_EPS);
    u32x4 o; const float* gg = g + 8 * lane;
    o.x = pk2(v[0] * rstd * gg[0], v[1] * rstd * gg[1]); o.y = pk2(v[2] * rstd * gg[2], v[3] * rstd * gg[3]);
    o.z = pk2(v[4] * rstd * gg[4], v[5] * rstd * gg[5]); o.w = pk2(v[6] * rstd * gg[6], v[7] * rstd * gg[7]);
    *(u32x4*)p = o;
}

struct EpiStore { bf16* O; int ldc; float scale;
    __device__ __forceinline__ void operator()(int row, int p, f32x4 v0, f32x4 v1) const { bf16* o = O + (size_t)row * ldc + p; st_bf4(o, v0 * scale); st_bf4(o + 16, v1 * scale); } };
struct EpiSwiGLU { bf16* H;
    __device__ __forceinline__ void operator()(int row, int p, f32x4 g, f32x4 u) const {
        const int q = p & 255, hid = 128 * (p >> 8) + 64 * (q >> 7) + 16 * ((q >> 5) & 3) + (q & 15);
        f32x4 h;
#pragma unroll
        for (int e = 0; e < 4; ++e) h[e] = g[e] / (1.f + __expf(-g[e])) * u[e];
        st_bf4(H + (size_t)row * FF + hid, h); } };
struct EpiBiasSilu { bf16* O; const float* bias;
    __device__ __forceinline__ void operator()(int row, int p, f32x4 v0, f32x4 v1) const {
        f32x4 a, b;
#pragma unroll
        for (int e = 0; e < 4; ++e) { const float x0 = v0[e] + bias[p + e], x1 = v1[e] + bias[p + 16 + e]; a[e] = x0 / (1.f + __expf(-x0)); b[e] = x1 / (1.f + __expf(-x1)); }
        bf16* o = O + (size_t)row * 256 + p; st_bf4(o, a); st_bf4(o + 16, b); } };
struct EpiLora { float* wdec; bf16* aga; bf16* agg; const float* w0; const float* a0;
    __device__ __forceinline__ void one(int row, int p, f32x4 v) const {
        if (p < 512) { f32x4 o;
#pragma unroll
            for (int e = 0; e < 4; ++e) { const float z = -(w0[p + e] + v[e]); const float sp = fmaxf(z, 0.f) + log1pf(__expf(-fabsf(z))); o[e] = __expf(-__expf(-sp - 0.5f)); }
            *(f32x4*)(wdec + (size_t)row * 512 + p) = o;
        } else if (p < 1024) { f32x4 o;
#pragma unroll
            for (int e = 0; e < 4; ++e) o[e] = sigmoidf_(a0[p - 512 + e] + v[e]);
            st_bf4(aga + (size_t)row * 512 + (p - 512), o);
        } else st_bf4(agg + (size_t)row * 512 + (p - 1024), v);
    }
    __device__ __forceinline__ void operator()(int row, int p, f32x4 v0, f32x4 v1) const { one(row, p, v0); one(row, p + 16, v1); } };
struct EpiWin {
    bf16 *qb, *ks, *kw, *kcr, *vcr, *vst, *vwt, *pr; float* gates; const float* rope;
    __device__ __forceinline__ void operator()(int row, int p, f32x4 v0, f32x4 v1) const {
        const int b = row / T_, t = row % T_;
        if (p < 768) {
            const int x = p & 63, d = 16 * ((x >> 5) & 1) + (x & 15);
            const float* rp = rope + ((size_t)t * 32 + d) * 2; f32x4 lo, hi;
#pragma unroll
            for (int e = 0; e < 4; ++e) { const float c = rp[2 * e], s = rp[2 * e + 1]; lo[e] = v0[e] * c - v1[e] * s; hi[e] = v0[e] * s + v1[e] * c; }
            if (p < 512) { bf16* o = qb + (size_t)row * 512 + (p & ~63) + d; st_bf4(o, lo * QSCALE); st_bf4(o + 32, hi * QSCALE); }
            else { const int g = ((p - 512) >> 6) & 1; bf16* base = (p < 640) ? ks : kw; bf16* o = base + ((size_t)(b * 2 + g) * T_ + t) * 64 + d; st_bf4(o, lo); st_bf4(o + 32, hi); }
        } else if (p < 1024) {
            const int c = (p - 768) & 127, g = c >> 6, d = c & 63; bf16* base = (p < 896) ? kcr : vcr;
            bf16* o = base + ((size_t)(b * 2 + g) * T_ + t) * 64 + d; st_bf4(o, v0); st_bf4(o + 16, v1);
        } else if (p < 1280) {
            const int c = (p - 1024) & 127, g = c >> 6, d = c & 63; bf16* base = (p < 1152) ? vst : vwt;
            bf16* o = base + ((size_t)(b * 2 + g) * 64 + d) * T_ + t;
#pragma unroll
            for (int e = 0; e < 4; ++e) { o[(size_t)e * T_] = (bf16)f2bf(v0[e]); o[(size_t)(16 + e) * T_] = (bf16)f2bf(v1[e]); }
        } else if (p < 3072) {
            bf16* o = pr + (size_t)row * NRW + (p - 1280); st_bf4(o, v0); st_bf4(o + 16, v1);
        } else {
            const int c = p - 3072; float* o = gates + (size_t)row * 24 + c;
            if (c < 24) { f32x4 s = {sigmoidf_(v0[0]), sigmoidf_(v0[1]), sigmoidf_(v0[2]), sigmoidf_(v0[3])}; *(f32x4*)o = s; }
            if (c + 16 < 24) { f32x4 s = {sigmoidf_(v1[0]), sigmoidf_(v1[1]), sigmoidf_(v1[2]), sigmoidf_(v1[3])}; *(f32x4*)(o + 16) = s; }
        }
    }
};

template <class Epi> __global__ void __launch_bounds__(256) k_gemm_simple(const bf16* A, int lda, const bf16* Bt, int ldb, int M, int N, int K, Epi epi) {
    const int wave = blockIdx.x * 4 + (threadIdx.x >> 6), lane = threadIdx.x & 63, fr = lane & 15, fq = lane >> 4;
    const int ntn = N / 32, tm = wave / ntn, tn = wave % ntn;
    if (tm >= M / 16) return;
    const bf16* ap = A + (size_t)(tm * 16 + fr) * lda + fq * 8;
    const bf16* b0 = Bt + (size_t)(tn * 32 + fr) * ldb + fq * 8;
    const bf16* b1 = b0 + (size_t)16 * ldb;
    f32x4 c0 = {0.f, 0.f, 0.f, 0.f}, c1 = {0.f, 0.f, 0.f, 0.f};
    for (int k0 = 0; k0 < K; k0 += 32) {
        const bf16x8 a = *(const bf16x8*)(ap + k0), w0 = *(const bf16x8*)(b0 + k0), w1 = *(const bf16x8*)(b1 + k0);
        c0 = __builtin_amdgcn_mfma_f32_16x16x32_bf16(w0, a, c0, 0, 0, 0);
        c1 = __builtin_amdgcn_mfma_f32_16x16x32_bf16(w1, a, c1, 0, 0, 0);
    }
    epi(tm * 16 + fr, tn * 32 + 4 * fq, c0, c1);
}

__global__ void __launch_bounds__(256) k_cmp2(const bf16* hidk, const bf16* hidv, const float* w2k, const float* w2v, const float* rope, bf16* kc, bf16* vct) {
    const int idx = blockIdx.x * 256 + threadIdx.x; const int R = idx >> 5, i = idx & 31; const int bg = R >> 9, c = R & 511;
    float k0 = 0.f, k1 = 0.f, v0 = 0.f, v1 = 0.f;
    for (int n = 0; n < 256; ++n) { const float hk = bf2f(hidk[(size_t)R * 256 + n]), hv = bf2f(hidv[(size_t)R * 256 + n]);
        k0 += hk * w2k[n * 64 + i]; k1 += hk * w2k[n * 64 + i + 32]; v0 += hv * w2v[n * 64 + i]; v1 += hv * w2v[n * 64 + i + 32]; }
    const int pos = (16 * c + 31) & (T_ - 1);
    const float cs = rope[((size_t)pos * 32 + i) * 2], sn = rope[((size_t)pos * 32 + i) * 2 + 1];
    kc[(size_t)R * 64 + i] = (bf16)f2bf(k0 * cs - k1 * sn); kc[(size_t)R * 64 + i + 32] = (bf16)f2bf(k0 * sn + k1 * cs);
    vct[((size_t)bg * 64 + i) * NCP + c] = (bf16)f2bf(v0); vct[((size_t)bg * 64 + i + 32) * NCP + c] = (bf16)f2bf(v1);
}

struct NsaArgs { const bf16 *qb, *kc, *vct, *ks, *vst, *kw, *vwt; const float* gates; bf16* amix; };
__device__ __forceinline__ float dot64(const float* q, const bf16* k) {
    float s = 0.f;
#pragma unroll
    for (int i = 0; i < 8; ++i) { const u32x4 w = ((const u32x4*)k)[i];
        s += q[8 * i + 0] * __builtin_bit_cast(float, w.x << 16) + q[8 * i + 1] * __builtin_bit_cast(float, w.x & 0xffff0000u)
           + q[8 * i + 2] * __builtin_bit_cast(float, w.y << 16) + q[8 * i + 3] * __builtin_bit_cast(float, w.y & 0xffff0000u)
           + q[8 * i + 4] * __builtin_bit_cast(float, w.z << 16) + q[8 * i + 5] * __builtin_bit_cast(float, w.z & 0xffff0000u)
           + q[8 * i + 6] * __builtin_bit_cast(float, w.w << 16) + q[8 * i + 7] * __builtin_bit_cast(float, w.w & 0xffff0000u); }
    return s;
}
__device__ __forceinline__ void softmax_row(float* s, int n, int lane) {
    float m = -INFINITY; for (int i = lane; i < n; i += 64) m = fmaxf(m, s[i]);
    m = wave_max(m); if (m == -INFINITY) m = 0.f;
    float l = 0.f; for (int i = lane; i < n; i += 64) { const float e = exp2f(s[i] - m); s[i] = e; l += e; }
    l = wave_sum(l); const float inv = 1.f / fmaxf(l, 1e-30f);
    for (int i = lane; i < n; i += 64) s[i] *= inv;
}
__global__ void __launch_bounds__(256) k_nsa_simple(NsaArgs a) {
    __shared__ float qs[4][64]; __shared__ float sc[4][1024]; __shared__ float imp[128]; __shared__ float score[128]; __shared__ int list[16]; __shared__ int nlist;
    const int bg = blockIdx.x / T_, t = blockIdx.x % T_, b = bg >> 1, g = bg & 1;
    const int tid = threadIdx.x, r = tid >> 6, d = tid & 63, lane = d;
    const size_t row = (size_t)b * T_ + t;
    qs[r][d] = bf2f(a.qb[row * 512 + g * 256 + r * 64 + d]);
    if (tid == 0) nlist = 0;
    __syncthreads();
    const int nv = t < 31 ? 0 : (t - 31) / 16 + 1;
    for (int c = tid; c < nv; c += 256) { const bf16* k = a.kc + ((size_t)bg * NCP + c) * 64;
        sc[0][c] = dot64(qs[0], k); sc[1][c] = dot64(qs[1], k); sc[2][c] = dot64(qs[2], k); sc[3][c] = dot64(qs[3], k); }
    __syncthreads();
    softmax_row(sc[r], nv, lane);
    __syncthreads();
    float oc = 0.f; { const bf16* v = a.vct + ((size_t)bg * 64 + d) * NCP; for (int c = 0; c < nv; ++c) oc += sc[r][c] * bf2f(v[c]); }
    if (tid < 128) { const int s = tid; float acc = 0.f;
        for (int c = 4 * s - 1; c <= 4 * s + 3; ++c) if (c >= 0 && c < nv) acc += sc[0][c] + sc[1][c] + sc[2][c] + sc[3][c];
        imp[s] = acc; }
    __syncthreads();
    const int cur = t >> 6;
    if (tid < 128) { const int s = tid; const bool forced = (s == 0) || (s == cur) || (s == cur - 1);
        score[s] = forced ? 1e4f : (s <= cur ? imp[s] : -1e4f); }
    __syncthreads();
    if (tid < 128) { const int s = tid; const float my = score[s]; int rank = 0;
        for (int j = 0; j < 128; ++j) { const float o = score[j]; rank += (o > my || (o == my && j < s)) ? 1 : 0; }
        if (rank < 16 && s <= cur) { const int slot = atomicAdd(&nlist, 1); list[slot] = s; } }
    __syncthreads();
    const int ns = nlist * 64;
    for (int i = tid; i < ns; i += 256) { const int pos = list[i >> 6] * 64 + (i & 63);
        if (pos <= t) { const bf16* k = a.ks + ((size_t)bg * T_ + pos) * 64; sc[0][i] = dot64(qs[0], k); sc[1][i] = dot64(qs[1], k); sc[2][i] = dot64(qs[2], k); sc[3][i] = dot64(qs[3], k); }
        else { sc[0][i] = -INFINITY; sc[1][i] = -INFINITY; sc[2][i] = -INFINITY; sc[3][i] = -INFINITY; } }
    __syncthreads();
    softmax_row(sc[r], ns, lane);
    __syncthreads();
    float os = 0.f; { const bf16* v = a.vst + ((size_t)bg * 64 + d) * T_;
        for (int i = 0; i < ns; ++i) { const int pos = list[i >> 6] * 64 + (i & 63); if (pos <= t) os += sc[r][i] * bf2f(v[pos]); } }
    __syncthreads();
    const int lo = t - 511 > 0 ? t - 511 : 0, nw = t - lo + 1;
    for (int i = tid; i < nw; i += 256) { const bf16* k = a.kw + ((size_t)bg * T_ + lo + i) * 64;
        sc[0][i] = dot64(qs[0], k); sc[1][i] = dot64(qs[1], k); sc[2][i] = dot64(qs[2], k); sc[3][i] = dot64(qs[3], k); }
    __syncthreads();
    softmax_row(sc[r], nw, lane);
    __syncthreads();
    float ow = 0.f; { const bf16* v = a.vwt + ((size_t)bg * 64 + d) * T_ + lo; for (int i = 0; i < nw; ++i) ow += sc[r][i] * bf2f(v[i]); }
    const float* gt = a.gates + row * 24 + g * 12 + r * 3;
    a.amix[row * DM + g * 256 + r * 64 + d] = (bf16)f2bf(gt[0] * oc + gt[1] * os + gt[2] * ow);
}

__global__ void __launch_bounds__(256) k_lora_prep(const bf16* pr, const float* mu, bf16* la) {
    const int row = blockIdx.x, c = threadIdx.x, t = row % T_;
    const float cur = bf2f(pr[(size_t)row * NRW + 1536 + c]), prev = t ? bf2f(pr[(size_t)(row - 1) * NRW + 1536 + c]) : 0.f;
    const float x = cur + (prev - cur) * mu[1536 + c];
    const float v = c < 64 ? tanhf(x) : (c < 128 ? x : sigmoidf_(x));
    la[(size_t)row * KLORA + c] = (bf16)f2bf(v);
}
struct RwkvArgs { const bf16* pr; const float* wdec; const bf16 *aga, *agg; const float *mu, *kk, *ka, *rk, *gng, *gnb; bf16* amix; };
constexpr int TC = 16;
__global__ void __launch_bounds__(512) k_rwkv_scan(RwkvArgs a) {
    __shared__ float vec[TC][6][64]; __shared__ float scal[TC][4]; __shared__ float ybuf[TC][64]; __shared__ float gbuf[TC][64];
    const int b = blockIdx.x >> 3, h = blockIdx.x & 7, tid = threadIdx.x, w = tid >> 6, lane = tid & 63;
    const int v = tid >> 3, sub = tid & 7, col = h * 64 + lane;
    const float mur = a.mu[col], muk = a.mu[512 + col], muv = a.mu[1024 + col], kkc = a.kk[col], kac = a.ka[col], rkc = a.rk[col], gng = a.gng[col], gnb = a.gnb[col];
    float S0 = 0.f, S1 = 0.f, S2 = 0.f, S3 = 0.f, S4 = 0.f, S5 = 0.f, S6 = 0.f, S7 = 0.f;
    for (int c0 = 0; c0 < T_; c0 += TC) {
#pragma unroll
        for (int i = 0; i < TC / 8; ++i) { const int tl = w + 8 * i, t = c0 + tl; const size_t row = (size_t)b * T_ + t;
            const bf16* p = a.pr + row * NRW; const bool hp = t > 0;
            const float r0 = bf2f(p[col]), k0 = bf2f(p[512 + col]), v0 = bf2f(p[1024 + col]);
            const float r1 = hp ? bf2f(p[col - NRW]) : 0.f, k1 = hp ? bf2f(p[512 + col - NRW]) : 0.f, v1 = hp ? bf2f(p[1024 + col - NRW]) : 0.f;
            const float r = r0 + (r1 - r0) * mur, k = k0 + (k1 - k0) * muk, vv = v0 + (v1 - v0) * muv;
            const float wd = a.wdec[row * 512 + col], al = bf2f(a.aga[row * 512 + col]), gg = bf2f(a.agg[row * 512 + col]);
            const float kkv = k * kkc, nrm = sqrtf(wave_sum(kkv * kkv)), kkn = kkv / fmaxf(nrm, 1e-12f);
            const float bb = kkn * al, kt = k * (1.f + (al - 1.f) * kac);
            const float br = wave_sum(bb * r), kr = wave_sum(kt * r), rk = wave_sum(r * kt * rkc);
            vec[tl][0][lane] = -kkn; vec[tl][1][lane] = wd; vec[tl][2][lane] = bb; vec[tl][3][lane] = kt; vec[tl][4][lane] = wd * r; vec[tl][5][lane] = vv;
            gbuf[tl][lane] = gg; if (lane == 0) { scal[tl][0] = br; scal[tl][1] = kr; scal[tl][2] = rk; } }
        __syncthreads();
        for (int tl = 0; tl < TC; ++tl) {
            const f32x4 n0 = *(const f32x4*)&vec[tl][0][8 * sub], n1 = *(const f32x4*)&vec[tl][0][8 * sub + 4];
            const f32x4 w0 = *(const f32x4*)&vec[tl][1][8 * sub], w1 = *(const f32x4*)&vec[tl][1][8 * sub + 4];
            const f32x4 b0 = *(const f32x4*)&vec[tl][2][8 * sub], b1 = *(const f32x4*)&vec[tl][2][8 * sub + 4];
            const f32x4 k0 = *(const f32x4*)&vec[tl][3][8 * sub], k1 = *(const f32x4*)&vec[tl][3][8 * sub + 4];
            const f32x4 q0 = *(const f32x4*)&vec[tl][4][8 * sub], q1 = *(const f32x4*)&vec[tl][4][8 * sub + 4];
            const float vv = vec[tl][5][v], br = scal[tl][0], kr = scal[tl][1];
            float d1 = S0 * n0[0] + S1 * n0[1] + S2 * n0[2] + S3 * n0[3] + S4 * n1[0] + S5 * n1[1] + S6 * n1[2] + S7 * n1[3];
            float d2 = S0 * q0[0] + S1 * q0[1] + S2 * q0[2] + S3 * q0[3] + S4 * q1[0] + S5 * q1[1] + S6 * q1[2] + S7 * q1[3];
            d1 += __shfl_xor(d1, 1); d2 += __shfl_xor(d2, 1); d1 += __shfl_xor(d1, 2); d2 += __shfl_xor(d2, 2); d1 += __shfl_xor(d1, 4); d2 += __shfl_xor(d2, 4);
            S0 = S0 * w0[0] + d1 * b0[0] + vv * k0[0]; S1 = S1 * w0[1] + d1 * b0[1] + vv * k0[1]; S2 = S2 * w0[2] + d1 * b0[2] + vv * k0[2]; S3 = S3 * w0[3] + d1 * b0[3] + vv * k0[3];
            S4 = S4 * w1[0] + d1 * b1[0] + vv * k1[0]; S5 = S5 * w1[1] + d1 * b1[1] + vv * k1[1]; S6 = S6 * w1[2] + d1 * b1[2] + vv * k1[2]; S7 = S7 * w1[3] + d1 * b1[3] + vv * k1[3];
            if (sub == 0) ybuf[tl][v] = d2 + d1 * br + vv * kr;
        }
        __syncthreads();
#pragma unroll
        for (int i = 0; i < TC / 8; ++i) { const int tl = w + 8 * i, t = c0 + tl; const size_t row = (size_t)b * T_ + t;
            const float y = ybuf[tl][lane], mean = wave_sum(y) * (1.f / 64.f), dy = y - mean, var = wave_sum(dy * dy) * (1.f / 64.f);
            const float yn = dy * rsqrtf(var + 64e-5f) * gng + gnb;
            a.amix[row * DM + 512 + col] = (bf16)f2bf((yn + scal[tl][2] * vec[tl][5][lane]) * gbuf[tl][lane]); }
        __syncthreads();
    }
}

__global__ void __launch_bounds__(256) k_memattn_simple(const bf16* qm, const bf16* mk, const bf16* mvt, bf16* om) {
    __shared__ float qs[4][256]; __shared__ float sc[4][256];
    const int row = blockIdx.x, b = row / T_, tid = threadIdx.x, h = tid >> 6, lane = tid & 63;
    for (int i = lane; i < 256; i += 64) qs[h][i] = bf2f(qm[(size_t)row * DM + h * 256 + i]);
    __syncthreads();
    for (int key = lane; key < 256; key += 64) { const bf16* k = mk + ((size_t)b * 256 + key) * DM + h * 256;
        sc[h][key] = dot64(qs[h], k) + dot64(qs[h] + 64, k + 64) + dot64(qs[h] + 128, k + 128) + dot64(qs[h] + 192, k + 192); }
    __syncthreads();
    softmax_row(sc[h], 256, lane);
    __syncthreads();
    for (int dv = lane; dv < 256; dv += 64) { const bf16* v = mvt + ((size_t)h * 256 + dv) * 512 + b * 256; float o = 0.f;
        for (int key = 0; key < 256; ++key) o += sc[h][key] * bf2f(v[key]);
        om[(size_t)row * DM + h * 256 + dv] = (bf16)f2bf(o); }
}

template <class Epi> static void gemm_simple(hipStream_t s, const bf16* A, int lda, const bf16* Bt, int ldb, int M, int N, int K, Epi e) {
    const int waves = (M / 16) * (N / 32);
    hipLaunchKernelGGL(k_gemm_simple<Epi>, dim3((waves + 3) / 4), dim3(256), 0, s, A, lda, Bt, ldb, M, N, K, e);
}
extern "C" void kernel_launch(void* const* d_in, const int* in_sizes, int n_in, void* d_out, int out_size, void* d_ws, size_t ws_size, hipStream_t stream) {
    if (n_in != 41 || ws_size < WS_END) { fprintf(stderr, "kernel_launch: unexpected n_in %d / ws %zu\n", n_in, ws_size); return; }
    const float* in[41]; for (int i = 0; i < 41; ++i) in[i] = (const float*)d_in[i];
    unsigned char* ws = (unsigned char*)d_ws; float* out = (float*)d_out;
#define WSB(off) ((bf16*)(ws + (off)))
#define WSF(off) ((float*)(ws + (off)))
    hipLaunchKernelGGL(k_convert<MapGU>, dim3(NGU / 64, DM / 64), dim3(256), 0, stream, WSB(WS_W1GU), DM, MapGU{in[I_F1_WG], in[I_F1_WU], FF});
    hipLaunchKernelGGL(k_convert<MapPlain>, dim3(DM / 64, FF / 64), dim3(256), 0, stream, WSB(WS_W1D), FF, MapPlain{in[I_F1_WD], DM});
    hipLaunchKernelGGL(k_convert<MapGU>, dim3(NGU / 64, DM / 64), dim3(256), 0, stream, WSB(WS_W2GU), DM, MapGU{in[I_F2_WG], in[I_F2_WU], FF});
    hipLaunchKernelGGL(k_convert<MapPlain>, dim3(DM / 64, FF / 64), dim3(256), 0, stream, WSB(WS_W2D), FF, MapPlain{in[I_F2_WD], DM});
    hipLaunchKernelGGL(k_convert<MapWin>, dim3(NWIN / 64, DM / 64), dim3(256), 0, stream, WSB(WS_WIN), DM, MapWin{in[I_WIN], IN_COLS});
    hipLaunchKernelGGL(k_convert<MapPlain>, dim3(DM / 64, DM / 64), dim3(256), 0, stream, WSB(WS_WOUT), DM, MapPlain{in[I_WOUT], DM});
    hipLaunchKernelGGL(k_convert<MapPlain>, dim3(DM / 64, DM / 64), dim3(256), 0, stream, WSB(WS_WQ), DM, MapPlain{in[I_WQ], DM});
    hipLaunchKernelGGL(k_convert<MapPlain>, dim3(DM / 64, DM / 64), dim3(256), 0, stream, WSB(WS_WK), DM, MapPlain{in[I_WK], DM});
    hipLaunchKernelGGL(k_convert<MapPlain>, dim3(DM / 64, DM / 64), dim3(256), 0, stream, WSB(WS_WV), DM, MapPlain{in[I_WV], DM});
    hipLaunchKernelGGL(k_convert<MapPlain>, dim3(DM / 64, DM / 64), dim3(256), 0, stream, WSB(WS_WO), DM, MapPlain{in[I_WO], DM});
    hipLaunchKernelGGL(k_convert<MapPlain>, dim3(256 / 64, 2048 / 64), dim3(256), 0, stream, WSB(WS_CW1K), 2048, MapPlain{in[I_W1_K], 256});
    hipLaunchKernelGGL(k_convert<MapPlain>, dim3(256 / 64, 2048 / 64), dim3(256), 0, stream, WSB(WS_CW1V), 2048, MapPlain{in[I_W1_V], 256});
    hipLaunchKernelGGL(k_convert_lora, dim3(NLORA * KLORA / 256), dim3(256), 0, stream, WSB(WS_WLORA), in[I_W2], in[I_A2], in[I_G2]);
    hipLaunchKernelGGL(k_rope_table, dim3(T_ * 32 / 256), dim3(256), 0, stream, WSF(WS_ROPE));
    hipLaunchKernelGGL(k_cmp_bias, dim3(4, 2), dim3(512), 0, stream, in[I_PE_K], in[I_W1_K], in[I_PE_V], in[I_W1_V], WSF(WS_CBIAS));
    hipLaunchKernelGGL(k_rownorm, dim3(M_ / 4), dim3(256), 0, stream, in[I_X], in[I_F1_PRE], WSB(WS_XN), M_);
    hipLaunchKernelGGL(k_rownorm, dim3(512 / 4), dim3(256), 0, stream, in[I_MEM], in[I_MEM_KVG], WSB(WS_MEMN), 512);
    gemm_simple(stream, WSB(WS_XN), DM, WSB(WS_W1GU), DM, M_, NGU, DM, EpiSwiGLU{WSB(WS_HB)});
    gemm_simple(stream, WSB(WS_HB), FF, WSB(WS_W1D), FF, M_, DM, FF, EpiStore{WSB(WS_YB), DM, 1.f});
    hipLaunchKernelGGL(k_rowpass, dim3(M_ / 4), dim3(256), 0, stream, in[I_X], WSB(WS_YB), in[I_F1_POST], 0.5f, in[I_MIX_PRE], out, WSB(WS_XN));
    gemm_simple(stream, WSB(WS_XN), DM, WSB(WS_WIN), DM, M_, NWIN, DM,
                EpiWin{WSB(WS_QB), WSB(WS_KS), WSB(WS_KW), WSB(WS_KCR), WSB(WS_VCR), WSB(WS_VST), WSB(WS_VWT), WSB(WS_PR), WSF(WS_GATES), WSF(WS_ROPE)});
    gemm_simple(stream, WSB(WS_KCR), 1024, WSB(WS_CW1K), 2048, 2048, 256, 2048, EpiBiasSilu{WSB(WS_HIDK), WSF(WS_CBIAS)});
    gemm_simple(stream, WSB(WS_VCR), 1024, WSB(WS_CW1V), 2048, 2048, 256, 2048, EpiBiasSilu{WSB(WS_HIDV), WSF(WS_CBIAS) + 256});
    hipLaunchKernelGGL(k_cmp2, dim3(2048 * 32 / 256), dim3(256), 0, stream, WSB(WS_HIDK), WSB(WS_HIDV), in[I_W2_K], in[I_W2_V], WSF(WS_ROPE), WSB(WS_KC), WSB(WS_VCT));
    hipLaunchKernelGGL(k_lora_prep, dim3(M_), dim3(256), 0, stream, WSB(WS_PR), in[I_MU], WSB(WS_XN));
    gemm_simple(stream, WSB(WS_XN), KLORA, WSB(WS_WLORA), KLORA, M_, NLORA, KLORA, EpiLora{WSF(WS_YB), WSB(WS_AGA), WSB(WS_AGG), in[I_W0], in[I_A0]});
    hipLaunchKernelGGL(k_rwkv_scan, dim3(16), dim3(512), 0, stream,
                       RwkvArgs{WSB(WS_PR), WSF(WS_YB), WSB(WS_AGA), WSB(WS_AGG), in[I_MU], in[I_KK], in[I_KA], in[I_RK], in[I_GNG], in[I_GNB], WSB(WS_XN)});
    hipLaunchKernelGGL(k_nsa_simple, dim3(4 * T_), dim3(256), 0, stream,
                       NsaArgs{WSB(WS_QB), WSB(WS_KC), WSB(WS_VCT), WSB(WS_KS), WSB(WS_VST), WSB(WS_KW), WSB(WS_VWT), WSF(WS_GATES), WSB(WS_XN)});
    hipLaunchKernelGGL(k_nsa_outnorm, dim3(M_ / 4), dim3(256), 0, stream, WSB(WS_XN), in[I_NSA_G]);
    gemm_simple(stream, WSB(WS_XN), DM, WSB(WS_WOUT), DM, M_, DM, DM, EpiStore{WSB(WS_YB), DM, 1.f});
    hipLaunchKernelGGL(k_rowpass, dim3(M_ / 4), dim3(256), 0, stream, out, WSB(WS_YB), in[I_MIX_POST], 1.0f, in[I_MEM_PRE], out, WSB(WS_XN));
    gemm_simple(stream, WSB(WS_XN), DM, WSB(WS_WQ), DM, M_, DM, DM, EpiStore{WSB(WS_QM), DM, MSCALE});
    gemm_simple(stream, WSB(WS_MEMN), DM, WSB(WS_WK), DM, 512, DM, DM, EpiStore{WSB(WS_MK), DM, 1.f});
    gemm_simple(stream, WSB(WS_WV), DM, WSB(WS_MEMN), DM, DM, 512, DM, EpiStore{WSB(WS_MVT), 512, 1.f});
    hipLaunchKernelGGL(k_memattn_simple, dim3(M_), dim3(256), 0, stream, WSB(WS_QM), WSB(WS_MK), WSB(WS_MVT), WSB(WS_OM));
    gemm_simple(stream, WSB(WS_OM), DM, WSB(WS_WO), DM, M_, DM, DM, EpiStore{WSB(WS_YB), DM, 1.f});
    hipLaunchKernelGGL(k_rowpass, dim3(M_ / 4), dim3(256), 0, stream, out, WSB(WS_YB), in[I_MEM_POST], 1.0f, in[I_F2_PRE], out, WSB(WS_XN));
    gemm_simple(stream, WSB(WS_XN), DM, WSB(WS_W2GU), DM, M_, NGU, DM, EpiSwiGLU{WSB(WS_HB)});
    gemm_simple(stream, WSB(WS_HB), FF, WSB(WS_W2D), FF, M_, DM, FF, EpiStore{WSB(WS_YB), DM, 1.f});
    hipLaunchKernelGGL(k_rowpass, dim3(M_ / 4), dim3(256), 0, stream, out, WSB(WS_YB), in[I_F2_POST], 0.5f, (const float*)nullptr, out, (bf16*)nullptr);
}
```

```cpp
#include <hip/hip_runtime.h>
#include <hip/hip_cooperative_groups.h>
#include <cstdint>
#include <cstdio>

constexpr int NB = 2, T_ = 8192, DM = 1024, M_ = NB * T_;
constexpr int FF = 2816, NGU = 2 * FF;
constexpr int IN_COLS = 3096, NWIN = 3328;
constexpr int NRW = 1792;
constexpr int NCP = 512;
constexpr int NLORA = 1536, KLORA = 256;
constexpr float NORM_EPS = 1e-6f;
constexpr float QSCALE = 0.125f * 1.4426950408889634f;
constexpr float MSCALE = 0.0625f * 1.4426950408889634f;

typedef unsigned short bf16;
typedef short bf16x8 __attribute__((ext_vector_type(8)));
typedef float f32x4 __attribute__((ext_vector_type(4)));
typedef unsigned u32x2 __attribute__((ext_vector_type(2)));
typedef unsigned u32x4 __attribute__((ext_vector_type(4)));

__device__ __forceinline__ unsigned f2bf(float f) { unsigned u = __builtin_bit_cast(unsigned, f); return (u + 0x7fffu + ((u >> 16) & 1u)) >> 16; }
__device__ __forceinline__ float bf2f(bf16 h) { return __builtin_bit_cast(float, (unsigned)h << 16); }
__device__ __forceinline__ unsigned pk2(float lo, float hi) { return f2bf(lo) | (f2bf(hi) << 16); }
__device__ __forceinline__ void st_bf4(bf16* p, f32x4 v) { u32x2 w; w.x = pk2(v[0], v[1]); w.y = pk2(v[2], v[3]); *(u32x2*)p = w; }
__device__ __forceinline__ float wave_sum(float v) {
#pragma unroll
    for (int o = 1; o < 64; o <<= 1) v += __shfl_xor(v, o);
    return v;
}
__device__ __forceinline__ float wave_max(float v) {
#pragma unroll
    for (int o = 1; o < 64; o <<= 1) v = fmaxf(v, __shfl_xor(v, o));
    return v;
}
__device__ __forceinline__ float sigmoidf_(float x) { return 1.f / (1.f + __expf(-x)); }
__device__ __forceinline__ int tidx() { int t = threadIdx.x; asm volatile("" : "+v"(t)); return t; }

constexpr size_t MiB = 1u << 20, KiB64 = 65536;
constexpr size_t WS_CTL = 0;
constexpr size_t WS_KC = 256 * 1024;
constexpr size_t WS_VCT = 512 * 1024;
constexpr size_t WS_W1GU = 1 * MiB;
constexpr size_t WS_W1D = 12 * MiB;
constexpr size_t WS_W2GU = WS_W1D + 88 * KiB64;
constexpr size_t WS_W2D = WS_W2GU + 11 * MiB;
constexpr size_t WS_WIN = WS_W2D + 88 * KiB64;
constexpr size_t WS_WOUT = WS_WIN + 104 * KiB64;
constexpr size_t WS_WQ = WS_WOUT + 2 * MiB, WS_WK = WS_WQ + 2 * MiB, WS_WV = WS_WK + 2 * MiB, WS_WO = WS_WV + 2 * MiB;
constexpr size_t WS_CW1K = WS_WO + 2 * MiB, WS_CW1V = WS_CW1K + 1 * MiB;
constexpr size_t WS_WLORA = WS_CW1V + 1 * MiB;
constexpr size_t WS_ROPE = WS_WLORA + 12 * KiB64;
constexpr size_t WS_CBIAS = WS_ROPE + 2 * MiB;
constexpr size_t WS_MEMN = WS_CBIAS + KiB64;
constexpr size_t WS_HIDK = WS_MEMN + 1 * MiB;
constexpr size_t WS_HIDV = WS_HIDK + 1 * MiB;
constexpr size_t WS_GATES = WS_HIDV + 1 * MiB;
constexpr size_t WS_XN = 60 * MiB;
constexpr size_t WS_YB = 92 * MiB;
constexpr size_t WS_D = 124 * MiB;
constexpr size_t WS_HB = WS_D;
constexpr size_t WS_QB = WS_D;
constexpr size_t WS_KS = WS_D + 16 * MiB;
constexpr size_t WS_KW = WS_D + 20 * MiB;
constexpr size_t WS_KCR = WS_D + 24 * MiB;
constexpr size_t WS_VCR = WS_D + 29 * MiB;
constexpr size_t WS_VST = WS_D + 34 * MiB;
constexpr size_t WS_VWT = WS_D + 38 * MiB;
constexpr size_t WS_PR = WS_D + 42 * MiB;
constexpr size_t WS_AGA = WS_D + 98 * MiB;
constexpr size_t WS_AGG = WS_D + 114 * MiB;
constexpr size_t WS_END = 256 * MiB;
constexpr size_t WS_QM = WS_D;
constexpr size_t WS_OM = WS_D + 32 * MiB;
constexpr size_t WS_MK = WS_D + 64 * MiB;
constexpr size_t WS_MVT = WS_D + 65 * MiB;
static_assert(WS_GATES + (size_t)M_ * 24 * 4 <= WS_XN, "ws map");
static_assert(WS_AGG + 16 * MiB <= WS_END, "ws map");

struct Params {
    const float* in[41];
    float* out;
    unsigned char* ws;
};
enum { I_X = 0, I_MEM, I_F1_PRE, I_F1_WG, I_F1_WU, I_F1_WD, I_F1_POST, I_MIX_PRE, I_WIN, I_PE_K, I_W1_K, I_W2_K, I_PE_V, I_W1_V, I_W2_V,
       I_NSA_G, I_MU, I_W0, I_W2, I_A0, I_A2, I_G2, I_KK, I_KA, I_RK, I_GNG, I_GNB, I_WOUT, I_MIX_POST, I_MEM_PRE, I_MEM_KVG, I_WQ, I_WK, I_WV,
       I_WO, I_MEM_POST, I_F2_PRE, I_F2_WG, I_F2_WU, I_F2_WD, I_F2_POST };

struct MapPlain { const float* W; int N; int pad; __device__ const float* col(int p) const { return W + p; } };
struct MapGU {
    const float* Wg; const float* Wu; int N; int pad;
    __device__ const float* col(int p) const {
        const int pn = p >> 8, q = p & 255, n = (q >> 4) & 1;
        const int hid = 128 * pn + 64 * (q >> 7) + 16 * ((q >> 5) & 3) + (q & 15);
        return Wg + (size_t)n * (size_t)(Wu - Wg) + hid;
    }
};
__host__ __device__ inline int rope_perm(int x) { return 16 * ((x >> 5) & 1) + (x & 15) + 32 * ((x >> 4) & 1); }
struct MapWin {
    const float* W; int N; int pad;
    __device__ const float* col(int p) const {
        int l;
        if (p < 512) l = (p & ~63) + rope_perm(p & 63);
        else if (p < 640) l = 768 + ((p - 512) & ~63) + rope_perm(p & 63);
        else if (p < 768) l = 1024 + ((p - 640) & ~63) + rope_perm(p & 63);
        else if (p < 896) l = 512 + (p - 768);
        else if (p < 1024) l = 640 + (p - 896);
        else if (p < 1152) l = 896 + (p - 1024);
        else if (p < 1280) l = 1152 + (p - 1152);
        else if (p < 3072) l = 1304 + (p - 1280);
        else if (p < 3096) l = 1280 + (p - 3072);
        else return nullptr;
        return W + l;
    }
};

#define FOR_VB(vb, n) for (int vb = (int)blockIdx.x * 2 + (T512 >> 8); vb < (n); vb += (int)gridDim.x * 2)

template <class Map> __device__ __forceinline__ void d_convert(bf16* WT, int Np, int K, Map map) {
    const int T512 = tidx(), tid = T512 & 255, nbx = Np / 64, nb = nbx * (K / 64);
    FOR_VB(vb, nb) {
        const int p = (vb % nbx) * 64 + (tid & 63), k0 = (vb / nbx) * 64 + (tid >> 6) * 16;
        const float* src = map.col(p);
        float v[16];
#pragma unroll
        for (int i = 0; i < 16; ++i) v[i] = src ? src[(size_t)(k0 + i) * map.N] : 0.f;
        u32x4 a, b;
        a.x = pk2(v[0], v[1]); a.y = pk2(v[2], v[3]); a.z = pk2(v[4], v[5]); a.w = pk2(v[6], v[7]);
        b.x = pk2(v[8], v[9]); b.y = pk2(v[10], v[11]); b.z = pk2(v[12], v[13]); b.w = pk2(v[14], v[15]);
        u32x4* dst = (u32x4*)(WT + (size_t)p * K + k0);
        dst[0] = a; dst[1] = b;
    }
}
__device__ __forceinline__ void d_convert_lora(bf16* WT, const float* w2, const float* a2, const float* g2) {
    const int T512 = tidx(), tid = T512 & 255;
    FOR_VB(vb, NLORA * KLORA / 256) {
        const int idx = vb * 256 + tid, p = idx >> 8, k = idx & 255;
        float v = 0.f;
        if (p < 512) { if (k < 64) v = w2[k * 512 + p]; }
        else if (p < 1024) { if (k >= 64 && k < 128) v = a2[(k - 64) * 512 + (p - 512)]; }
        else { if (k >= 128) v = g2[(k - 128) * 512 + (p - 1024)]; }
        WT[idx] = (bf16)f2bf(v);
    }
}
__device__ __forceinline__ void d_rope_table(float* tab) {
    const int T512 = tidx(), tid = T512 & 255;
    FOR_VB(vb, T_ * 32 / 256) {
        const int idx = vb * 256 + tid, pos = idx >> 5, i = idx & 31;
        const float inv = (float)pow(10000.0, -(double)i / 32.0);
        const float ang = (float)pos * inv;
        tab[2 * idx] = (float)cos((double)ang); tab[2 * idx + 1] = (float)sin((double)ang);
    }
}
__device__ __forceinline__ void d_cmp_bias(const float* pe_k, const float* w1_k, const float* pe_v, const float* w1_v, float* bias, float* red  ) {
    for (int job = blockIdx.x; job < 8; job += gridDim.x) {
        const int kv = job >> 2; const float* pe = kv ? pe_v : pe_k; const float* w1 = kv ? w1_v : w1_k;
        const int T512 = tidx(), lane = T512 & 63, w = T512 >> 6, n = (job & 3) * 64 + lane;
        float s = 0.f;
        for (int j = w * 256; j < w * 256 + 256; ++j) s += pe[j] * w1[(size_t)j * 256 + n];
        red[w * 64 + lane] = s; __syncthreads();
        if (w == 0) { float t = 0.f; for (int i = 0; i < 8; ++i) t += red[i * 64 + lane]; bias[kv * 256 + n] = t; }
        __syncthreads();
    }
}
__device__ __forceinline__ void d_rownorm(const float* x, const float* g, bf16* xn, int rows) {
    const int T512 = tidx(), tid = T512 & 255, lane = tid & 63;
    FOR_VB(vb, rows / 4) {
        const int row = vb * 4 + (tid >> 6);
        const f32x4* xr = (const f32x4*)(x + (size_t)row * DM) + lane; f32x4 v[4]; float s = 0.f;
#pragma unroll
        for (int j = 0; j < 4; ++j) { v[j] = xr[64 * j]; s += v[j][0] * v[j][0] + v[j][1] * v[j][1] + v[j][2] * v[j][2] + v[j][3] * v[j][3]; }
        const float rstd = rsqrtf(wave_sum(s) * (1.f / DM) + NORM_EPS);
#pragma unroll
        for (int j = 0; j < 4; ++j) { const f32x4 gg = ((const f32x4*)g)[lane + 64 * j]; st_bf4(xn + (size_t)row * DM + 4 * (lane + 64 * j), v[j] * rstd * gg); }
    }
}
__device__ __forceinline__ void d_rowpass(const float* xin, const bf16* y, const float* gpost, float coef, const float* gpre, float* xout, bf16* xn) {
    const int T512 = tidx(), tid = T512 & 255, lane = tid & 63;
    FOR_VB(vb, M_ / 4) {
        const int row = vb * 4 + (tid >> 6);
        f32x4 yv[4], xv[4]; float s = 0.f;
#pragma unroll
        for (int j = 0; j < 4; ++j) {
            const u32x2 w = *(const u32x2*)(y + (size_t)row * DM + 4 * (lane + 64 * j));
            yv[j][0] = __builtin_bit_cast(float, w.x << 16); yv[j][1] = __builtin_bit_cast(float, w.x & 0xffff0000u);
            yv[j][2] = __builtin_bit_cast(float, w.y << 16); yv[j][3] = __builtin_bit_cast(float, w.y & 0xffff0000u);
            s += yv[j][0] * yv[j][0] + yv[j][1] * yv[j][1] + yv[j][2] * yv[j][2] + yv[j][3] * yv[j][3];
            xv[j] = ((const f32x4*)(xin + (size_t)row * DM))[lane + 64 * j];
        }
        const float rstd = rsqrtf(wave_sum(s) * (1.f / DM) + NORM_EPS) * coef; float s2 = 0.f;
#pragma unroll
        for (int j = 0; j < 4; ++j) { const f32x4 gg = ((const f32x4*)gpost)[lane + 64 * j]; xv[j] = xv[j] + yv[j] * rstd * gg;
            s2 += xv[j][0] * xv[j][0] + xv[j][1] * xv[j][1] + xv[j][2] * xv[j][2] + xv[j][3] * xv[j][3];
            ((f32x4*)(xout + (size_t)row * DM))[lane + 64 * j] = xv[j]; }
        if (gpre) {
            const float r2 = rsqrtf(wave_sum(s2) * (1.f / DM) + NORM_EPS);
#pragma unroll
            for (int j = 0; j < 4; ++j) { const f32x4 gg = ((const f32x4*)gpre)[lane + 64 * j]; st_bf4(xn + (size_t)row * DM + 4 * (lane + 64 * j), xv[j] * r2 * gg); }
        }
    }
}
__device__ __forceinline__ void d_nsa_outnorm(bf16* amix, const float* g) {
    const int T512 = tidx(), tid = T512 & 255, lane = tid & 63;
    FOR_VB(vb, M_ / 4) {
        const int row = vb * 4 + (tid >> 6);
        bf16* p = amix + (size_t)row * DM + 8 * lane;
        const u32x4 w = *(const u32x4*)p; float v[8]; float s = 0.f;
        v[0] = __builtin_bit_cast(float, w.x << 16); v[1] = __builtin_bit_cast(float, w.x & 0xffff0000u);
        v[2] = __builtin_bit_cast(float, w.y << 16); v[3] = __builtin_bit_cast(float, w.y & 0xffff0000u);
        v[4] = __builtin_bit_cast(float, w.z << 16); v[5] = __builtin_bit_cast(float, w.z & 0xffff0000u);
        v[6] = __builtin_bit_cast(float, w.w << 16); v[7] = __builtin_bit_cast(float, w.w & 0xffff0000u);
#pragma unroll
        for (int i = 0; i < 8; ++i) s += v[i] * v[i];
        const float rstd = rsqrtf(wave_sum(s) * (1.f / 512.f) + NORM_EPS);
        u32x4 o; const float* gg = g + 8 * lane;
        o.x = pk2(v[0] * rstd * gg[0], v[1] * rstd * gg[1]); o.y = pk2(v[2] * rstd * gg[2], v[3] * rstd * gg[3]);
        o.z = pk2(v[4] * rstd * gg[4], v[5] * rstd * gg[5]); o.w = pk2(v[6] * rstd * gg[6], v[7] * rstd * gg[7]);
        *(u32x4*)p = o;
    }
}

struct EpiStore { bf16* O; int ldc; float scale;
    static constexpr int NCAT = 1;
    __device__ __forceinline__ int cat(int) const { return 0; }
    template <int C> __device__ __forceinline__ void apply(int row, int p, f32x4 v0, f32x4 v1) const { bf16* o = O + (size_t)row * ldc + p; st_bf4(o, v0 * scale); st_bf4(o + 16, v1 * scale); } };
struct EpiSwiGLU { bf16* H;
    static constexpr int NCAT = 1;
    __device__ __forceinline__ int cat(int) const { return 0; }
    template <int C> __device__ __forceinline__ void apply(int row, int p, f32x4 g, f32x4 u) const {
        const int q = p & 255, hid = 128 * (p >> 8) + 64 * (q >> 7) + 16 * ((q >> 5) & 3) + (q & 15);
        f32x4 h;
#pragma unroll
        for (int e = 0; e < 4; ++e) h[e] = g[e] / (1.f + __expf(-g[e])) * u[e];
        st_bf4(H + (size_t)row * FF + hid, h); } };
struct EpiBiasSilu { bf16* O; const float* bias;
    static constexpr int NCAT = 1;
    __device__ __forceinline__ int cat(int) const { return 0; }
    template <int C> __device__ __forceinline__ void apply(int row, int p, f32x4 v0, f32x4 v1) const {
        f32x4 a, b; const f32x4 b0 = *(const f32x4*)(bias + p), b1 = *(const f32x4*)(bias + p + 16);
#pragma unroll
        for (int e = 0; e < 4; ++e) { const float x0 = v0[e] + b0[e], x1 = v1[e] + b1[e]; a[e] = x0 / (1.f + __expf(-x0)); b[e] = x1 / (1.f + __expf(-x1)); }
        bf16* o = O + (size_t)row * 256 + p; st_bf4(o, a); st_bf4(o + 16, b); } };
struct EpiLora { float* wdec; bf16* aga; bf16* agg; const float* w0; const float* a0;
    static constexpr int NCAT = 3;
    __device__ __forceinline__ int cat(int p0) const { return p0 < 512 ? 0 : (p0 < 1024 ? 1 : 2); }
    template <int C> __device__ __forceinline__ void one(int row, int p, f32x4 v) const {
        if (C == 0) { f32x4 o; const f32x4 ww = *(const f32x4*)(w0 + p);
#pragma unroll
            for (int e = 0; e < 4; ++e) o[e] = __expf(-0.6065306597126334f * sigmoidf_(ww[e] + v[e]));
            *(f32x4*)(wdec + (size_t)row * 512 + p) = o;
        } else if (C == 1) { f32x4 o; const f32x4 aa = *(const f32x4*)(a0 + p - 512);
#pragma unroll
            for (int e = 0; e < 4; ++e) o[e] = sigmoidf_(aa[e] + v[e]);
            st_bf4(aga + (size_t)row * 512 + (p - 512), o);
        } else st_bf4(agg + (size_t)row * 512 + (p - 1024), v);
    }
    template <int C> __device__ __forceinline__ void apply(int row, int p, f32x4 v0, f32x4 v1) const { one<C>(row, p, v0); one<C>(row, p + 16, v1); } };
struct EpiWin {
    bf16 *qb, *ks, *kw, *kcr, *vcr, *vst, *vwt, *pr; float* gates; const float* rope;
    static constexpr int NCAT = 6;
    __device__ __forceinline__ int cat(int p0) const { return p0 < 512 ? 0 : (p0 < 768 ? 1 : (p0 < 1024 ? 2 : (p0 < 1280 ? 3 : (p0 < 3072 ? 4 : 5)))); }
    template <int C> __device__ __forceinline__ void apply(int row, int p, f32x4 v0, f32x4 v1) const {
        const int b = row / T_, t = row % T_;
        if (C == 0 || C == 1) {
            const int x = p & 63, d = 16 * ((x >> 5) & 1) + (x & 15);
            const f32x4* rp = (const f32x4*)(rope + ((size_t)t * 32 + d) * 2); const f32x4 r0 = rp[0], r1 = rp[1];
            const f32x4 cs = {r0[0], r0[2], r1[0], r1[2]}, sn = {r0[1], r0[3], r1[1], r1[3]};
            const f32x4 lo = v0 * cs - v1 * sn, hi = v0 * sn + v1 * cs;
            if (C == 0) { bf16* o = qb + (size_t)row * 512 + (p & ~63) + d; st_bf4(o, lo * QSCALE); st_bf4(o + 32, hi * QSCALE); }
            else { const int g = ((p - 512) >> 6) & 1; bf16* base = (p < 640) ? ks : kw; bf16* o = base + ((size_t)(b * 2 + g) * T_ + t) * 64 + d; st_bf4(o, lo); st_bf4(o + 32, hi); }
        } else if (C == 2) {
            const int c = (p - 768) & 127, g = c >> 6, d = c & 63; bf16* base = (p < 896) ? kcr : vcr;
            bf16* o = base + ((size_t)(b * 2 + g) * T_ + t) * 64 + d; st_bf4(o, v0); st_bf4(o + 16, v1);
        } else if (C == 3) {
            const int c = (p - 1024) & 127, g = c >> 6, d = c & 63; bf16* base = (p < 1152) ? vst : vwt;
            bf16* o = base + ((size_t)(b * 2 + g) * 64 + d) * T_ + t;
#pragma unroll
            for (int e = 0; e < 4; ++e) { o[(size_t)e * T_] = (bf16)f2bf(v0[e]); o[(size_t)(16 + e) * T_] = (bf16)f2bf(v1[e]); }
        } else if (C == 4) {
            bf16* o = pr + (size_t)row * NRW + (p - 1280); st_bf4(o, v0); st_bf4(o + 16, v1);
        } else {
            const int c = p - 3072; float* o = gates + (size_t)row * 24 + c;
            if (c < 24) { f32x4 s = {sigmoidf_(v0[0]), sigmoidf_(v0[1]), sigmoidf_(v0[2]), sigmoidf_(v0[3])}; *(f32x4*)o = s; }
            if (c + 16 < 24) { f32x4 s = {sigmoidf_(v1[0]), sigmoidf_(v1[1]), sigmoidf_(v1[2]), sigmoidf_(v1[3])}; *(f32x4*)(o + 16) = s; }
        }
    }
};

namespace pg8 {
#define PG8_LAS __attribute__((address_space(3)))
typedef unsigned short bf16_t;
typedef short bf16x8 __attribute__((ext_vector_type(8)));
typedef float f32x4 __attribute__((ext_vector_type(4)));
typedef unsigned u32x4 __attribute__((ext_vector_type(4)));
constexpr int BM = 256, BK = 64, HALF = 128, HTB = HALF * BK * 2  , STAGE_BYTES = 8 * HTB, NXCD = 8, WGM = 8;

__host__ __device__ __forceinline__ int lds_byte(int r, int c) { const int st = (r >> 4) * 2 + (c >> 5), rr = r & 15, cc = c & 31, ob = rr * 64 + cc * 2; return st * 1024 + (ob ^ (((ob >> 9) & 1) << 5)); }
__host__ __device__ __forceinline__ void stage_rc(int b, int& R, int& C) { const int st = b / 1024, sb = b % 1024, swz = sb ^ (((sb >> 9) & 1) << 5); R = (st >> 1) * 16 + swz / 64; C = (st & 1) * 32 + (swz % 64) / 2; }
__host__ __device__ __forceinline__ int perm32(int rho) { const int n = rho >> 4, i = rho & 15; return 8 * (i >> 2) + 4 * n + (i & 3); }

struct Unit { int pm, pn; };
struct Gemm { const bf16_t* A; const bf16_t* Bt; int M, N, K, lda, ldb; };

struct StaticOrder {
    int nM, nN, nwg, G, c;
    __host__ __device__ void init(int M, int N, int G_, int c_) { nM = M / BM; nN = N / BM; nwg = nM * nN; G = G_; c = c_; }
    __host__ __device__ bool next(int i, Unit& u) const {
        const long L = (long)i * G + c; if (L >= nwg) return false;
        int wgid = (int)L; { const int q = nwg / NXCD, r = nwg % NXCD, xcd = wgid % NXCD, off = wgid / NXCD; wgid = (xcd < r ? xcd * (q + 1) : r * (q + 1) + (xcd - r) * q) + off; }
        const int nig = WGM * nN, gid = wgid / nig, fm = gid * WGM, gsz = (nM - fm) < WGM ? (nM - fm) : WGM;
        u.pm = fm + ((wgid % nig) % gsz); u.pn = (wgid % nig) / gsz; return true;
    }
    __device__ __forceinline__ void a_ready(const Unit&) const {}
    __device__ __forceinline__ void done(const Unit&) const {}
};

template <class Epi, class Sched, bool ALIGN_EPI = false, bool SP2 = false>
__device__ __forceinline__ void gemm_phase(PG8_LAS unsigned char* lds, const Gemm g, const Sched& S, const Epi& E) {
    const int tid = tidx(), wid = __builtin_amdgcn_readfirstlane(tid >> 6), lane = tid & 63, wr = wid >> 2, wc = wid & 3, fr = lane & 15, fq = lane >> 4;
    const int K = g.K, nt = K / BK;
    unsigned voffA[2], voffB[2];
#pragma unroll
    for (int i = 0; i < 2; ++i) { int R, C; stage_rc(tid * 16 + i * 8192, R, C); const int Rb = Epi::PERM ? ((R & ~31) + perm32(R & 31)) : R;
        voffA[i] = (unsigned)(R * g.lda + C) * 2u; voffB[i] = (unsigned)(Rb * g.ldb + C) * 2u; }
    const size_t kstep = (size_t)(BK * 2);
    const size_t hstepA = (size_t)HALF * g.lda * 2, hstepB = (size_t)HALF * g.ldb * 2;
    const size_t tstepA = 2 * hstepA, tstepB = 2 * hstepB;
    const unsigned ldsw = (unsigned)wid * 1024u;
    const int aoff = lds_byte(wr * 64 + fr, fq * 8), boff = lds_byte(wc * 32 + fr, fq * 8);
#define PG8_SA(b, h) (((b) * 2 + (h)) * HTB)
#define PG8_SB(b, h) ((4 + (b) * 2 + (h)) * HTB)
#define PG8_STAGE(bufoff, gbase, voff) do { _Pragma("unroll") for (int _i = 0; _i < 2; ++_i) \
        __builtin_amdgcn_global_load_lds((const unsigned*)((const char*)(gbase) + (voff)[_i]), (PG8_LAS unsigned*)(lds + (bufoff) + ldsw + _i * 8192), 16, 0, 0); } while (0)
#define PG8_LDA(dst, b, h) do { _Pragma("unroll") for (int m = 0; m < 4; ++m) _Pragma("unroll") for (int k = 0; k < 2; ++k) dst[m][k] = *(const PG8_LAS bf16x8*)(lds + PG8_SA(b, h) + aoff + m * 2048 + k * 1024); } while (0)
#define PG8_LDB(dst, b, h) do { _Pragma("unroll") for (int n = 0; n < 2; ++n) _Pragma("unroll") for (int k = 0; k < 2; ++k) dst[n][k] = *(const PG8_LAS bf16x8*)(lds + PG8_SB(b, h) + boff + n * 2048 + k * 1024); } while (0)
#define PG8_MMA(ai, bj, At, Bt) do { __builtin_amdgcn_s_setprio(1); _Pragma("unroll") for (int m = 0; m < 4; ++m) _Pragma("unroll") for (int n = 0; n < 2; ++n) _Pragma("unroll") for (int k = 0; k < 2; ++k) \
        acc[ai][bj][m][n] = __builtin_amdgcn_mfma_f32_16x16x32_bf16(Bt[n][k], At[m][k], acc[ai][bj][m][n], 0, 0, 0); __builtin_amdgcn_s_setprio(0); } while (0)
#define PG8_WAIT_V(n) asm volatile("s_waitcnt vmcnt(" #n ")" ::: "memory")
#define PG8_WAIT_L(n) asm volatile("s_waitcnt lgkmcnt(" #n ")" ::: "memory")
#define PG8_BAR __builtin_amdgcn_s_barrier()
#define PG8_SCHED __builtin_amdgcn_sched_barrier(0)
    Unit cur, nxt; int ui = 0;
    if (!S.next(0, cur)) return;
    f32x4 acc[2][2][4][2];
#pragma unroll
    for (int a = 0; a < 2; ++a)
#pragma unroll
        for (int b = 0; b < 2; ++b)
#pragma unroll
            for (int m = 0; m < 4; ++m)
#pragma unroll
                for (int n = 0; n < 2; ++n) acc[a][b][m][n] = (f32x4){0.f, 0.f, 0.f, 0.f};
    bf16x8 At[4][2], B0[2][2], B1[2][2];
    const char* cA = (const char*)g.A + (size_t)cur.pm * tstepA; const char* cB = (const char*)g.Bt + (size_t)cur.pn * tstepB;
    S.a_ready(cur);
    if constexpr (SP2) {
        PG8_STAGE(PG8_SB(0, 0), cB, voffB); PG8_STAGE(PG8_SB(0, 1), cB + hstepB, voffB); PG8_STAGE(PG8_SA(0, 0), cA, voffA); PG8_STAGE(PG8_SA(0, 1), cA + hstepA, voffA);
        if (wr == 1) PG8_BAR;
        PG8_WAIT_V(2); PG8_BAR;
        PG8_STAGE(PG8_SB(1, 0), cB + kstep, voffB); PG8_STAGE(PG8_SA(1, 0), cA + kstep, voffA); PG8_STAGE(PG8_SB(1, 1), cB + hstepB + kstep, voffB);
        PG8_WAIT_V(6); PG8_BAR;
    } else {
        PG8_STAGE(PG8_SB(0, 0), cB, voffB); PG8_STAGE(PG8_SA(0, 0), cA, voffA); PG8_STAGE(PG8_SB(0, 1), cB + hstepB, voffB); PG8_STAGE(PG8_SA(0, 1), cA + hstepA, voffA);
        if (wr == 1) PG8_BAR;
        PG8_WAIT_V(4); PG8_BAR;
        PG8_STAGE(PG8_SB(1, 0), cB + kstep, voffB); PG8_STAGE(PG8_SA(1, 0), cA + kstep, voffA); PG8_STAGE(PG8_SB(1, 1), cB + hstepB + kstep, voffB);
        PG8_WAIT_V(6); PG8_BAR;
    }
    for (;;) {
        const bool has_next = S.next(ui + 1, nxt);
        const char* nA = has_next ? (const char*)g.A + (size_t)nxt.pm * tstepA : cA; const char* nB = has_next ? (const char*)g.Bt + (size_t)nxt.pn * tstepB : cB;
        for (int t = 0; t < nt; t += 2) {
            const bool last = (t == nt - 2);
            const char* a1 = cA + (size_t)(t + 1) * kstep;
            const char* a2 = last ? nA : cA + (size_t)(t + 2) * kstep; const char* b2 = last ? nB : cB + (size_t)(t + 2) * kstep;
            const char* a3 = a2 + kstep; const char* b3 = b2 + kstep;
            if (last && has_next) S.a_ready(nxt);
            if constexpr (SP2) {
            PG8_LDB(B0, 0, 0); PG8_LDB(B1, 0, 1); PG8_SCHED; PG8_LDA(At, 0, 0); PG8_STAGE(PG8_SA(1, 1), a1 + hstepA, voffA);
            PG8_WAIT_V(8); PG8_WAIT_L(0); PG8_BAR; PG8_MMA(0, 0, At, B0); PG8_MMA(0, 1, At, B1); PG8_BAR; PG8_SCHED;
            PG8_LDA(At, 0, 1); PG8_STAGE(PG8_SB(0, 0), b2, voffB); PG8_STAGE(PG8_SB(0, 1), b2 + hstepB, voffB); PG8_STAGE(PG8_SA(0, 0), a2, voffA);
            PG8_WAIT_V(8); PG8_WAIT_L(0); PG8_BAR; PG8_MMA(1, 0, At, B0); PG8_MMA(1, 1, At, B1); PG8_BAR; PG8_SCHED;
            PG8_LDB(B0, 1, 0); PG8_LDB(B1, 1, 1); PG8_SCHED; PG8_LDA(At, 1, 0); PG8_STAGE(PG8_SA(0, 1), a2 + hstepA, voffA);
            PG8_WAIT_V(8); PG8_WAIT_L(0); PG8_BAR; PG8_MMA(0, 0, At, B0); PG8_MMA(0, 1, At, B1); PG8_BAR; PG8_SCHED;
            PG8_LDA(At, 1, 1); PG8_STAGE(PG8_SB(1, 0), b3, voffB); PG8_STAGE(PG8_SB(1, 1), b3 + hstepB, voffB); PG8_STAGE(PG8_SA(1, 0), a3, voffA);
            PG8_WAIT_V(8); PG8_WAIT_L(0); PG8_BAR; PG8_MMA(1, 0, At, B0); PG8_MMA(1, 1, At, B1); PG8_BAR; PG8_SCHED;
            } else {
            PG8_LDB(B0, 0, 0); PG8_SCHED; PG8_LDA(At, 0, 0); PG8_STAGE(PG8_SA(1, 1), a1 + hstepA, voffA);
            PG8_WAIT_L(8); PG8_BAR; PG8_WAIT_L(0); PG8_MMA(0, 0, At, B0); PG8_BAR; PG8_SCHED;
            PG8_LDB(B1, 0, 1); PG8_STAGE(PG8_SB(0, 0), b2, voffB);
            PG8_BAR; PG8_WAIT_L(0); PG8_MMA(0, 1, At, B1); PG8_BAR;
            PG8_LDA(At, 0, 1); PG8_STAGE(PG8_SA(0, 0), a2, voffA);
            PG8_BAR; PG8_WAIT_L(0); PG8_MMA(1, 0, At, B0); PG8_BAR; PG8_SCHED;
            PG8_STAGE(PG8_SB(0, 1), b2 + hstepB, voffB);
            PG8_WAIT_V(6); PG8_BAR; PG8_MMA(1, 1, At, B1); PG8_BAR;
            PG8_LDB(B0, 1, 0); PG8_SCHED; PG8_LDA(At, 1, 0); PG8_STAGE(PG8_SA(0, 1), a2 + hstepA, voffA);
            PG8_WAIT_L(8); PG8_BAR; PG8_WAIT_L(0); PG8_MMA(0, 0, At, B0); PG8_BAR; PG8_SCHED;
            PG8_LDB(B1, 1, 1); PG8_STAGE(PG8_SB(1, 0), b3, voffB);
            PG8_BAR; PG8_WAIT_L(0); PG8_MMA(0, 1, At, B1); PG8_BAR;
            PG8_LDA(At, 1, 1); PG8_STAGE(PG8_SA(1, 0), a3, voffA);
            PG8_BAR; PG8_WAIT_L(0); PG8_MMA(1, 0, At, B0); PG8_BAR; PG8_SCHED;
            PG8_STAGE(PG8_SB(1, 1), b3 + hstepB, voffB);
            PG8_WAIT_V(6); PG8_BAR; PG8_MMA(1, 1, At, B1); PG8_BAR;
            }
        }
        if constexpr (ALIGN_EPI) { if (wr == 0) PG8_BAR; }
        if constexpr (!Epi::AFTER_DRAIN) { E(acc, cur, wr, wc, fr, fq); S.done(cur); }
        if (!has_next) break;
#pragma unroll
        for (int a = 0; a < 2; ++a)
#pragma unroll
            for (int b = 0; b < 2; ++b)
#pragma unroll
                for (int m = 0; m < 4; ++m)
#pragma unroll
                    for (int n = 0; n < 2; ++n) acc[a][b][m][n] = (f32x4){0.f, 0.f, 0.f, 0.f};
        cur = nxt; cA = nA; cB = nB; ++ui;
        if constexpr (ALIGN_EPI) { if (wr == 1) PG8_BAR; }
    }
    PG8_WAIT_V(0);
    if constexpr (!ALIGN_EPI) { if (wr == 0) PG8_BAR; }
    PG8_BAR;
    if constexpr (Epi::AFTER_DRAIN) { E.fused(acc, cur, wr, wc, fr, fq, lds, wid, lane); S.done(cur); }
#undef PG8_SA
#undef PG8_SB
#undef PG8_STAGE
#undef PG8_LDA
#undef PG8_LDB
#undef PG8_MMA
#undef PG8_WAIT_V
#undef PG8_WAIT_L
#undef PG8_BAR
#undef PG8_SCHED
}
}

template <class F> struct EpiQuad {
    static constexpr bool PERM = false, AFTER_DRAIN = false;
    F f;
    template <int C, int BJ> __device__ __forceinline__ void half(const pg8::f32x4 (&acc)[2][2][4][2], int row0, int p) const {
#pragma unroll
        for (int ai = 0; ai < 2; ++ai)
#pragma unroll
            for (int m = 0; m < 4; ++m) { f.template apply<C>(row0 + ai * 128 + m * 16, p, acc[ai][BJ][m][0], acc[ai][BJ][m][1]); asm volatile("" ::: "memory"); }
    }
    template <int BJ> __device__ __forceinline__ void disp(const pg8::f32x4 (&acc)[2][2][4][2], int row0, int p0, int p) const {
        const int c = f.cat(p0);
        if (F::NCAT == 1 || c == 0) half<0, BJ>(acc, row0, p);
        else if (F::NCAT > 1 && c == 1) half<(F::NCAT > 1 ? 1 : 0), BJ>(acc, row0, p);
        else if (F::NCAT > 2 && c == 2) half<(F::NCAT > 2 ? 2 : 0), BJ>(acc, row0, p);
        else if (F::NCAT > 3 && c == 3) half<(F::NCAT > 3 ? 3 : 0), BJ>(acc, row0, p);
        else if (F::NCAT > 4 && c == 4) half<(F::NCAT > 4 ? 4 : 0), BJ>(acc, row0, p);
        else if (F::NCAT > 5) half<(F::NCAT > 5 ? 5 : 0), BJ>(acc, row0, p);
    }
    __device__ __forceinline__ void operator()(const pg8::f32x4 (&acc)[2][2][4][2], const pg8::Unit& u, int wr, int wc, int fr, int fq) const {
        const int row0 = u.pm * 256 + wr * 64 + fr, p0 = u.pn * 256;
        disp<0>(acc, row0, p0, p0 + wc * 32 + 4 * fq);
        disp<1>(acc, row0, p0 + 128, p0 + 128 + wc * 32 + 4 * fq);
    }
};
template <class F> __device__ __forceinline__ void gemm_pg8(unsigned char* lds, const bf16* A, int lda, const bf16* Bt, int ldb, int M, int N, int K, const F& f) {
    pg8::Gemm g{A, Bt, M, N, K, lda, ldb}; pg8::StaticOrder S; S.init(M, N, (int)gridDim.x, (int)blockIdx.x);
    EpiQuad<F> E{f};
    pg8::gemm_phase<EpiQuad<F>, pg8::StaticOrder, true, true>((PG8_LAS unsigned char*)lds, g, S, E);
}

__device__ __forceinline__ void d_cmp2(const bf16* hidk, const bf16* hidv, const float* w2k, const float* w2v, const float* rope, bf16* kc, bf16* vct) {
    const int T512 = tidx(), tid = T512 & 255;
    FOR_VB(vb, 2048 * 32 / 256) {
        const int idx = vb * 256 + tid; const int R = idx >> 5, i = idx & 31; const int bg = R >> 9, c = R & 511;
        float k0 = 0.f, k1 = 0.f, v0 = 0.f, v1 = 0.f;
        for (int n = 0; n < 256; ++n) { const float hk = bf2f(hidk[(size_t)R * 256 + n]), hv = bf2f(hidv[(size_t)R * 256 + n]);
            k0 += hk * w2k[n * 64 + i]; k1 += hk * w2k[n * 64 + i + 32]; v0 += hv * w2v[n * 64 + i]; v1 += hv * w2v[n * 64 + i + 32]; }
        const int pos = (16 * c + 31) & (T_ - 1);
        const float cs = rope[((size_t)pos * 32 + i) * 2], sn = rope[((size_t)pos * 32 + i) * 2 + 1];
        kc[(size_t)R * 64 + i] = (bf16)f2bf(k0 * cs - k1 * sn); kc[(size_t)R * 64 + i + 32] = (bf16)f2bf(k0 * sn + k1 * cs);
        vct[((size_t)bg * 64 + i) * NCP + c] = (bf16)f2bf(v0); vct[((size_t)bg * 64 + i + 32) * NCP + c] = (bf16)f2bf(v1);
    }
}

struct NsaArgs { const bf16 *qb, *kc, *vct, *ks, *vst, *kw, *vwt; const float* gates; bf16* amix; };
__device__ __forceinline__ float dot64(const float* q, const bf16* k) {
    float s = 0.f;
#pragma unroll
    for (int i = 0; i < 8; ++i) { const u32x4 w = ((const u32x4*)k)[i];
        s += q[8 * i + 0] * __builtin_bit_cast(float, w.x << 16) + q[8 * i + 1] * __builtin_bit_cast(float, w.x & 0xffff0000u)
           + q[8 * i + 2] * __builtin_bit_cast(float, w.y << 16) + q[8 * i + 3] * __builtin_bit_cast(float, w.y & 0xffff0000u)
           + q[8 * i + 4] * __builtin_bit_cast(float, w.z << 16) + q[8 * i + 5] * __builtin_bit_cast(float, w.z & 0xffff0000u)
           + q[8 * i + 6] * __builtin_bit_cast(float, w.w << 16) + q[8 * i + 7] * __builtin_bit_cast(float, w.w & 0xffff0000u); }
    return s;
}
__device__ __forceinline__ void softmax_row(float* s, int n, int lane) {
    float m = -INFINITY; for (int i = lane; i < n; i += 64) m = fmaxf(m, s[i]);
    m = wave_max(m); if (m == -INFINITY) m = 0.f;
    float l = 0.f; for (int i = lane; i < n; i += 64) { const float e = exp2f(s[i] - m); s[i] = e; l += e; }
    l = wave_sum(l); const float inv = 1.f / fmaxf(l, 1e-30f);
    for (int i = lane; i < n; i += 64) s[i] *= inv;
}
__device__ __forceinline__ void d_nsa_simple(const NsaArgs& a, int vb, int tid, unsigned char* smem) {
    float (*qs)[64] = (float (*)[64])smem; float (*sc)[1024] = (float (*)[1024])(smem + 1024); float* imp = (float*)(smem + 17408); float* score = imp + 128;
    int* list = (int*)(score + 128); int* nlist = list + 16;
    const int bg = vb / T_, t = vb % T_, b = bg >> 1, g = bg & 1;
    const int r = tid >> 6, d = tid & 63, lane = d;
    const size_t row = (size_t)b * T_ + t;
    qs[r][d] = bf2f(a.qb[row * 512 + g * 256 + r * 64 + d]);
    if (tid == 0) *nlist = 0;
    __syncthreads();
    const int nv = t < 31 ? 0 : (t - 31) / 16 + 1;
    for (int c = tid; c < nv; c += 256) { const bf16* k = a.kc + ((size_t)bg * NCP + c) * 64;
        _Pragma("unroll 1") for (int rr = 0; rr < 4; ++rr) sc[rr][c] = dot64(qs[rr], k); }
    __syncthreads();
    softmax_row(sc[r], nv, lane);
    __syncthreads();
    float oc = 0.f; { const bf16* v = a.vct + ((size_t)bg * 64 + d) * NCP; for (int c = 0; c < nv; ++c) oc += sc[r][c] * bf2f(v[c]); }
    if (tid < 128) { const int s = tid; float acc = 0.f;
        for (int c = 4 * s - 1; c <= 4 * s + 3; ++c) if (c >= 0 && c < nv) acc += sc[0][c] + sc[1][c] + sc[2][c] + sc[3][c];
        imp[s] = acc; }
    __syncthreads();
    const int cur = t >> 6;
    if (tid < 128) { const int s = tid; const bool forced = (s == 0) || (s == cur) || (s == cur - 1);
        score[s] = forced ? 1e4f : (s <= cur ? imp[s] : -1e4f); }
    __syncthreads();
    if (tid < 128) { const int s = tid; const float my = score[s]; int rank = 0;
        for (int j = 0; j < 128; ++j) { const float o = score[j]; rank += (o > my || (o == my && j < s)) ? 1 : 0; }
        if (rank < 16 && s <= cur) { const int slot = atomicAdd(nlist, 1); list[slot] = s; } }
    __syncthreads();
    const int ns = *nlist * 64;
    for (int i = tid; i < ns; i += 256) { const int pos = list[i >> 6] * 64 + (i & 63);
        if (pos <= t) { const bf16* k = a.ks + ((size_t)bg * T_ + pos) * 64; _Pragma("unroll 1") for (int rr = 0; rr < 4; ++rr) sc[rr][i] = dot64(qs[rr], k); }
        else { sc[0][i] = -INFINITY; sc[1][i] = -INFINITY; sc[2][i] = -INFINITY; sc[3][i] = -INFINITY; } }
    __syncthreads();
    softmax_row(sc[r], ns, lane);
    __syncthreads();
    float os = 0.f; { const bf16* v = a.vst + ((size_t)bg * 64 + d) * T_;
        for (int i = 0; i < ns; ++i) { const int pos = list[i >> 6] * 64 + (i & 63); if (pos <= t) os += sc[r][i] * bf2f(v[pos]); } }
    __syncthreads();
    const int lo = t - 511 > 0 ? t - 511 : 0, nw = t - lo + 1;
    for (int i = tid; i < nw; i += 256) { const bf16* k = a.kw + ((size_t)bg * T_ + lo + i) * 64;
        _Pragma("unroll 1") for (int rr = 0; rr < 4; ++rr) sc[rr][i] = dot64(qs[rr], k); }
    __syncthreads();
    softmax_row(sc[r], nw, lane);
    __syncthreads();
    float ow = 0.f; { const bf16* v = a.vwt + ((size_t)bg * 64 + d) * T_ + lo; for (int i = 0; i < nw; ++i) ow += sc[r][i] * bf2f(v[i]); }
    const float* gt = a.gates + row * 24 + g * 12 + r * 3;
    a.amix[row * DM + g * 256 + r * 64 + d] = (bf16)f2bf(gt[0] * oc + gt[1] * os + gt[2] * ow);
    __syncthreads();
}

__device__ __forceinline__ void d_lora_prep(const bf16* pr, const float* mu, bf16* la) {
    const int T512 = tidx(), c = T512 & 255;
    FOR_VB(row, M_) {
        const int t = row % T_;
        const float cur = bf2f(pr[(size_t)row * NRW + 1536 + c]), prev = t ? bf2f(pr[(size_t)(row - 1) * NRW + 1536 + c]) : 0.f;
        const float x = cur + (prev - cur) * mu[1536 + c];
        const float v = c < 64 ? tanhf(x) : (c < 128 ? x : sigmoidf_(x));
        la[(size_t)row * KLORA + c] = (bf16)f2bf(v);
    }
}
struct RwkvArgs { const bf16* pr; const float* wdec; const bf16 *aga, *agg; const float *mu, *kk, *ka, *rk, *gng, *gnb; bf16* amix; };
constexpr int TC = 16;
__device__ __forceinline__ void d_rwkv_scan(const RwkvArgs& a, int bh, unsigned char* smem) {
    float (*vec)[6][64] = (float (*)[6][64])smem; float (*scal)[4] = (float (*)[4])(smem + TC * 6 * 64 * 4);
    float (*ybuf)[64] = (float (*)[64])(smem + TC * 6 * 64 * 4 + TC * 16); float (*gbuf)[64] = (float (*)[64])(smem + TC * 6 * 64 * 4 + TC * 16 + TC * 256);
    const int b = bh >> 3, h = bh & 7, tid = tidx(), w = tid >> 6, lane = tid & 63;
    const int v = tid >> 3, sub = tid & 7, col = h * 64 + lane;
    const float mur = a.mu[col], muk = a.mu[512 + col], muv = a.mu[1024 + col], kkc = a.kk[col], kac = a.ka[col], rkc = a.rk[col], gng = a.gng[col], gnb = a.gnb[col];
    float S0 = 0.f, S1 = 0.f, S2 = 0.f, S3 = 0.f, S4 = 0.f, S5 = 0.f, S6 = 0.f, S7 = 0.f;
    for (int c0 = 0; c0 < T_; c0 += TC) {
#pragma unroll
        for (int i = 0; i < TC / 8; ++i) { const int tl = w + 8 * i, t = c0 + tl; const size_t row = (size_t)b * T_ + t;
            const bf16* p = a.pr + row * NRW; const bool hp = t > 0;
            const float r0 = bf2f(p[col]), k0 = bf2f(p[512 + col]), v0 = bf2f(p[1024 + col]);
            const float r1 = hp ? bf2f(p[col - NRW]) : 0.f, k1 = hp ? bf2f(p[512 + col - NRW]) : 0.f, v1 = hp ? bf2f(p[1024 + col - NRW]) : 0.f;
            const float r = r0 + (r1 - r0) * mur, k = k0 + (k1 - k0) * muk, vv = v0 + (v1 - v0) * muv;
            const float wd = a.wdec[row * 512 + col], al = bf2f(a.aga[row * 512 + col]), gg = bf2f(a.agg[row * 512 + col]);
            const float kkv = k * kkc, nrm = sqrtf(wave_sum(kkv * kkv)), kkn = kkv / fmaxf(nrm, 1e-12f);
            const float bb = kkn * al, kt = k * (1.f + (al - 1.f) * kac);
            const float br = wave_sum(bb * r), kr = wave_sum(kt * r), rk = wave_sum(r * kt * rkc);
            vec[tl][0][lane] = -kkn; vec[tl][1][lane] = wd; vec[tl][2][lane] = bb; vec[tl][3][lane] = kt; vec[tl][4][lane] = wd * r; vec[tl][5][lane] = vv;
            gbuf[tl][lane] = gg; if (lane == 0) { scal[tl][0] = br; scal[tl][1] = kr; scal[tl][2] = rk; } }
        __syncthreads();
        for (int tl = 0; tl < TC; ++tl) {
            const f32x4 n0 = *(const f32x4*)&vec[tl][0][8 * sub], n1 = *(const f32x4*)&vec[tl][0][8 * sub + 4];
            const f32x4 w0 = *(const f32x4*)&vec[tl][1][8 * sub], w1 = *(const f32x4*)&vec[tl][1][8 * sub + 4];
            const f32x4 b0 = *(const f32x4*)&vec[tl][2][8 * sub], b1 = *(const f32x4*)&vec[tl][2][8 * sub + 4];
            const f32x4 k0 = *(const f32x4*)&vec[tl][3][8 * sub], k1 = *(const f32x4*)&vec[tl][3][8 * sub + 4];
            const f32x4 q0 = *(const f32x4*)&vec[tl][4][8 * sub], q1 = *(const f32x4*)&vec[tl][4][8 * sub + 4];
            const float vv = vec[tl][5][v], br = scal[tl][0], kr = scal[tl][1];
            float d1 = S0 * n0[0] + S1 * n0[1] + S2 * n0[2] + S3 * n0[3] + S4 * n1[0] + S5 * n1[1] + S6 * n1[2] + S7 * n1[3];
            float d2 = S0 * q0[0] + S1 * q0[1] + S2 * q0[2] + S3 * q0[3] + S4 * q1[0] + S5 * q1[1] + S6 * q1[2] + S7 * q1[3];
            d1 += __shfl_xor(d1, 1); d2 += __shfl_xor(d2, 1); d1 += __shfl_xor(d1, 2); d2 += __shfl_xor(d2, 2); d1 += __shfl_xor(d1, 4); d2 += __shfl_xor(d2, 4);
            S0 = S0 * w0[0] + d1 * b0[0] + vv * k0[0]; S1 = S1 * w0[1] + d1 * b0[1] + vv * k0[1]; S2 = S2 * w0[2] + d1 * b0[2] + vv * k0[2]; S3 = S3 * w0[3] + d1 * b0[3] + vv * k0[3];
            S4 = S4 * w1[0] + d1 * b1[0] + vv * k1[0]; S5 = S5 * w1[1] + d1 * b1[1] + vv * k1[1]; S6 = S6 * w1[2] + d1 * b1[2] + vv * k1[2]; S7 = S7 * w1[3] + d1 * b1[3] + vv * k1[3];
            if (sub == 0) ybuf[tl][v] = d2 + d1 * br + vv * kr;
        }
        __syncthreads();
#pragma unroll
        for (int i = 0; i < TC / 8; ++i) { const int tl = w + 8 * i, t = c0 + tl; const size_t row = (size_t)b * T_ + t;
            const float y = ybuf[tl][lane], mean = wave_sum(y) * (1.f / 64.f), dy = y - mean, var = wave_sum(dy * dy) * (1.f / 64.f);
            const float yn = dy * rsqrtf(var + 64e-5f) * gng + gnb;
            a.amix[row * DM + 512 + col] = (bf16)f2bf((yn + scal[tl][2] * vec[tl][5][lane]) * gbuf[tl][lane]); }
        __syncthreads();
    }
}

__device__ __forceinline__ void d_memattn_simple(const bf16* qm, const bf16* mk, const bf16* mvt, bf16* om, int row, int tid, unsigned char* smem) {
    float (*qs)[256] = (float (*)[256])smem; float (*sc)[256] = (float (*)[256])(smem + 4096);
    const int b = row / T_, h = tid >> 6, lane = tid & 63;
    for (int i = lane; i < 256; i += 64) qs[h][i] = bf2f(qm[(size_t)row * DM + h * 256 + i]);
    __syncthreads();
    for (int key = lane; key < 256; key += 64) { const bf16* k = mk + ((size_t)b * 256 + key) * DM + h * 256;
        sc[h][key] = dot64(qs[h], k) + dot64(qs[h] + 64, k + 64) + dot64(qs[h] + 128, k + 128) + dot64(qs[h] + 192, k + 192); }
    __syncthreads();
    softmax_row(sc[h], 256, lane);
    __syncthreads();
    for (int dv = lane; dv < 256; dv += 64) { const bf16* v = mvt + ((size_t)h * 256 + dv) * 512 + b * 256; float o = 0.f;
        for (int key = 0; key < 256; ++key) o += sc[h][key] * bf2f(v[key]);
        om[(size_t)row * DM + h * 256 + dv] = (bf16)f2bf(o); }
    __syncthreads();
}

namespace cg = cooperative_groups;
constexpr int NTHREADS = 512, LDS_BYTES = 147456;
struct MegaArgs { const float* in[41]; float* out; unsigned char* ws; };
#define WSB(off) ((bf16*)(ws + (off)))
#define WSF(off) ((float*)(ws + (off)))

__global__ void __launch_bounds__(NTHREADS) mega_fwd(MegaArgs A) {
    extern __shared__ __attribute__((aligned(16))) unsigned char lds[];
    cg::grid_group grid = cg::this_grid();
    const float* const* in = A.in; unsigned char* ws = A.ws; float* out = A.out;

    d_convert(WSB(WS_W1GU), NGU, DM, MapGU{in[I_F1_WG], in[I_F1_WU], FF});
    d_convert(WSB(WS_W1D), DM, FF, MapPlain{in[I_F1_WD], DM});
    d_convert(WSB(WS_W2GU), NGU, DM, MapGU{in[I_F2_WG], in[I_F2_WU], FF});
    d_convert(WSB(WS_W2D), DM, FF, MapPlain{in[I_F2_WD], DM});
    d_convert(WSB(WS_WIN), NWIN, DM, MapWin{in[I_WIN], IN_COLS});
    d_convert(WSB(WS_WOUT), DM, DM, MapPlain{in[I_WOUT], DM});
    d_convert(WSB(WS_WQ), DM, DM, MapPlain{in[I_WQ], DM});
    d_convert(WSB(WS_WK), DM, DM, MapPlain{in[I_WK], DM});
    d_convert(WSB(WS_WV), DM, DM, MapPlain{in[I_WV], DM});
    d_convert(WSB(WS_WO), DM, DM, MapPlain{in[I_WO], DM});
    d_convert(WSB(WS_CW1K), 256, 2048, MapPlain{in[I_W1_K], 256});
    d_convert(WSB(WS_CW1V), 256, 2048, MapPlain{in[I_W1_V], 256});
    d_convert_lora(WSB(WS_WLORA), in[I_W2], in[I_A2], in[I_G2]);
    d_rope_table(WSF(WS_ROPE));
    d_cmp_bias(in[I_PE_K], in[I_W1_K], in[I_PE_V], in[I_W1_V], WSF(WS_CBIAS), (float*)lds);
    d_rownorm(in[I_X], in[I_F1_PRE], WSB(WS_XN), M_);
    d_rownorm(in[I_MEM], in[I_MEM_KVG], WSB(WS_MEMN), 512);
    grid.sync();
    gemm_pg8(lds, WSB(WS_XN), DM, WSB(WS_W1GU), DM, M_, NGU, DM, EpiSwiGLU{WSB(WS_HB)});
    grid.sync();
    gemm_pg8(lds, WSB(WS_HB), FF, WSB(WS_W1D), FF, M_, DM, FF, EpiStore{WSB(WS_YB), DM, 1.f});
    grid.sync();
    d_rowpass(in[I_X], WSB(WS_YB), in[I_F1_POST], 0.5f, in[I_MIX_PRE], out, WSB(WS_XN));
    grid.sync();
    gemm_pg8(lds, WSB(WS_XN), DM, WSB(WS_WIN), DM, M_, NWIN, DM,
             EpiWin{WSB(WS_QB), WSB(WS_KS), WSB(WS_KW), WSB(WS_KCR), WSB(WS_VCR), WSB(WS_VST), WSB(WS_VWT), WSB(WS_PR), WSF(WS_GATES), WSF(WS_ROPE)});
    grid.sync();
    gemm_pg8(lds, WSB(WS_KCR), 1024, WSB(WS_CW1K), 2048, 2048, 256, 2048, EpiBiasSilu{WSB(WS_HIDK), WSF(WS_CBIAS)});
    gemm_pg8(lds, WSB(WS_VCR), 1024, WSB(WS_CW1V), 2048, 2048, 256, 2048, EpiBiasSilu{WSB(WS_HIDV), WSF(WS_CBIAS) + 256});
    d_lora_prep(WSB(WS_PR), in[I_MU], WSB(WS_XN));
    grid.sync();
    d_cmp2(WSB(WS_HIDK), WSB(WS_HIDV), in[I_W2_K], in[I_W2_V], WSF(WS_ROPE), WSB(WS_KC), WSB(WS_VCT));
    gemm_pg8(lds, WSB(WS_XN), KLORA, WSB(WS_WLORA), KLORA, M_, NLORA, KLORA, EpiLora{WSF(WS_YB), WSB(WS_AGA), WSB(WS_AGG), in[I_W0], in[I_A0]});
    grid.sync();
    if (blockIdx.x < 16) {
        const RwkvArgs ra{WSB(WS_PR), WSF(WS_YB), WSB(WS_AGA), WSB(WS_AGG), in[I_MU], in[I_KK], in[I_KA], in[I_RK], in[I_GNG], in[I_GNB], WSB(WS_XN)};
        d_rwkv_scan(ra, blockIdx.x, lds);
    }
    {
        const NsaArgs na{WSB(WS_QB), WSB(WS_KC), WSB(WS_VCT), WSB(WS_KS), WSB(WS_VST), WSB(WS_KW), WSB(WS_VWT), WSF(WS_GATES), WSB(WS_XN)};
        const int t5 = tidx(), half = t5 >> 8;
        for (int vb = blockIdx.x * 2 + half; vb < 4 * T_; vb += gridDim.x * 2) d_nsa_simple(na, vb, t5 & 255, lds + half * 20480);
    }
    grid.sync();
    d_nsa_outnorm(WSB(WS_XN), in[I_NSA_G]);
    grid.sync();
    gemm_pg8(lds, WSB(WS_XN), DM, WSB(WS_WOUT), DM, M_, DM, DM, EpiStore{WSB(WS_YB), DM, 1.f});
    grid.sync();
    d_rowpass(out, WSB(WS_YB), in[I_MIX_POST], 1.0f, in[I_MEM_PRE], out, WSB(WS_XN));
    grid.sync();
    gemm_pg8(lds, WSB(WS_XN), DM, WSB(WS_WQ), DM, M_, DM, DM, EpiStore{WSB(WS_QM), DM, MSCALE});
    gemm_pg8(lds, WSB(WS_MEMN), DM, WSB(WS_WK), DM, 512, DM, DM, EpiStore{WSB(WS_MK), DM, 1.f});
    gemm_pg8(lds, WSB(WS_WV), DM, WSB(WS_MEMN), DM, DM, 512, DM, EpiStore{WSB(WS_MVT), 512, 1.f});
    grid.sync();
    { const int t5 = tidx(), half = t5 >> 8;
      for (int row = blockIdx.x * 2 + half; row < M_; row += gridDim.x * 2) d_memattn_simple(WSB(WS_QM), WSB(WS_MK), WSB(WS_MVT), WSB(WS_OM), row, t5 & 255, lds + half * 8192); }
    grid.sync();
    gemm_pg8(lds, WSB(WS_OM), DM, WSB(WS_WO), DM, M_, DM, DM, EpiStore{WSB(WS_YB), DM, 1.f});
    grid.sync();
    d_rowpass(out, WSB(WS_YB), in[I_MEM_POST], 1.0f, in[I_F2_PRE], out, WSB(WS_XN));
    grid.sync();
    gemm_pg8(lds, WSB(WS_XN), DM, WSB(WS_W2GU), DM, M_, NGU, DM, EpiSwiGLU{WSB(WS_HB)});
    grid.sync();
    gemm_pg8(lds, WSB(WS_HB), FF, WSB(WS_W2D), FF, M_, DM, FF, EpiStore{WSB(WS_YB), DM, 1.f});
    grid.sync();
    d_rowpass(out, WSB(WS_YB), in[I_F2_POST], 0.5f, (const float*)nullptr, out, (bf16*)nullptr);
}

extern "C" void kernel_launch(void* const* d_in, const int* in_sizes, int n_in, void* d_out, int out_size, void* d_ws, size_t ws_size, hipStream_t stream) {
    static int grid = 0;
    if (grid == 0) {
        if (n_in != 41 || ws_size < WS_END) { fprintf(stderr, "kernel_launch: unexpected n_in %d / ws %zu\n", n_in, ws_size); grid = -1; return; }
        int dev = 0, cus = 0, per_cu = 0;
        hipGetDevice(&dev); hipDeviceGetAttribute(&cus, hipDeviceAttributeMultiprocessorCount, dev);
        if (hipFuncSetAttribute((const void*)mega_fwd, hipFuncAttributeMaxDynamicSharedMemorySize, LDS_BYTES) != hipSuccess) { fprintf(stderr, "kernel_launch: hipFuncSetAttribute failed\n"); grid = -1; return; }
        if (hipOccupancyMaxActiveBlocksPerMultiprocessor(&per_cu, (const void*)mega_fwd, NTHREADS, LDS_BYTES) != hipSuccess || per_cu < 1) { fprintf(stderr, "kernel_launch: occupancy query says %d\n", per_cu); grid = -1; (void)hipGetLastError(); return; }
        grid = cus;
    }
    if (grid < 0) return;
    MegaArgs a{};
    for (int i = 0; i < 41; ++i) a.in[i] = (const float*)d_in[i];
    a.out = (float*)d_out; a.ws = (unsigned char*)d_ws;
    void* args[] = {&a};
    hipError_t e = hipLaunchCooperativeKernel((const void*)mega_fwd, dim3(grid), dim3(NTHREADS), args, LDS_BYTES, stream);
    if (e != hipSuccess) fprintf(stderr, "kernel_launch: cooperative launch failed: %s (grid %d)\n", hipGetErrorString(e), grid);
}
```

```cpp
#include <hip/hip_runtime.h>
#include <hip/hip_cooperative_groups.h>
#include <cstdint>
#include <cstdio>

constexpr int NB = 2, T_ = 8192, DM = 1024, M_ = NB * T_;
constexpr int FF = 2816, NGU = 2 * FF;
constexpr int IN_COLS = 3096, NWIN = 3328;
constexpr int NRW = 1792;
constexpr int NCP = 512;
constexpr int NLORA = 1536, KLORA = 256;
constexpr float NORM_EPS = 1e-6f;
constexpr float QSCALE = 0.125f * 1.4426950408889634f;
constexpr float MSCALE = 0.0625f * 1.4426950408889634f;

typedef unsigned short bf16;
typedef short bf16x8 __attribute__((ext_vector_type(8)));
typedef float f32x4 __attribute__((ext_vector_type(4)));
typedef unsigned u32x2 __attribute__((ext_vector_type(2)));
typedef unsigned u32x4 __attribute__((ext_vector_type(4)));

__device__ __forceinline__ unsigned f2bf(float f) { unsigned u = __builtin_bit_cast(unsigned, f); return (u + 0x7fffu + ((u >> 16) & 1u)) >> 16; }
__device__ __forceinline__ float bf2f(bf16 h) { return __builtin_bit_cast(float, (unsigned)h << 16); }
__device__ __forceinline__ unsigned pk2(float lo, float hi) { return f2bf(lo) | (f2bf(hi) << 16); }
__device__ __forceinline__ void st_bf4(bf16* p, f32x4 v) { u32x2 w; w.x = pk2(v[0], v[1]); w.y = pk2(v[2], v[3]); *(u32x2*)p = w; }
__device__ __forceinline__ float wave_sum(float v) {
#pragma unroll
    for (int o = 1; o < 64; o <<= 1) v += __shfl_xor(v, o);
    return v;
}
__device__ __forceinline__ float wave_max(float v) {
#pragma unroll
    for (int o = 1; o < 64; o <<= 1) v = fmaxf(v, __shfl_xor(v, o));
    return v;
}
__device__ __forceinline__ float sigmoidf_(float x) { return 1.f / (1.f + __expf(-x)); }
__device__ __forceinline__ int tidx() { int t = threadIdx.x; asm volatile("" : "+v"(t)); return t; }

constexpr size_t MiB = 1u << 20, KiB64 = 65536;
constexpr size_t WS_CTL = 0;
constexpr size_t WS_KC = 256 * 1024;
constexpr size_t WS_VCT = 512 * 1024;
constexpr size_t WS_W1GU = 1 * MiB;
constexpr size_t WS_W1D = 12 * MiB;
constexpr size_t WS_W2GU = WS_W1D + 88 * KiB64;
constexpr size_t WS_W2D = WS_W2GU + 11 * MiB;
constexpr size_t WS_WIN = WS_W2D + 88 * KiB64;
constexpr size_t WS_WOUT = WS_WIN + 104 * KiB64;
constexpr size_t WS_WQ = WS_WOUT + 2 * MiB, WS_WK = WS_WQ + 2 * MiB, WS_WV = WS_WK + 2 * MiB, WS_WO = WS_WV + 2 * MiB;
constexpr size_t WS_CW1K = WS_WO + 2 * MiB, WS_CW1V = WS_CW1K + 1 * MiB;
constexpr size_t WS_WLORA = WS_CW1V + 1 * MiB;
constexpr size_t WS_ROPE = WS_WLORA + 12 * KiB64;
constexpr size_t WS_CBIAS = WS_ROPE + 2 * MiB;
constexpr size_t WS_MEMN = WS_CBIAS + KiB64;
constexpr size_t WS_HIDK = WS_MEMN + 1 * MiB;
constexpr size_t WS_HIDV = WS_HIDK + 1 * MiB;
constexpr size_t WS_GATES = WS_HIDV + 1 * MiB;
constexpr size_t WS_XN = 60 * MiB;
constexpr size_t WS_YB = 92 * MiB;
constexpr size_t WS_D = 124 * MiB;
constexpr size_t WS_HB = WS_D;
constexpr size_t WS_QB = WS_D;
constexpr size_t WS_KS = WS_D + 16 * MiB;
constexpr size_t WS_KW = WS_D + 20 * MiB;
constexpr size_t WS_KCR = WS_D + 24 * MiB;
constexpr size_t WS_VCR = WS_D + 29 * MiB;
constexpr size_t WS_VST = WS_D + 34 * MiB;
constexpr size_t WS_VWT = WS_D + 38 * MiB;
constexpr size_t WS_PR = WS_D + 42 * MiB;
constexpr size_t WS_AGA = WS_D + 98 * MiB;
constexpr size_t WS_AGG = WS_D + 114 * MiB;
constexpr size_t WS_END = 256 * MiB;
constexpr size_t WS_QM = WS_D;
constexpr size_t WS_OM = WS_D + 32 * MiB;
constexpr size_t WS_MK = WS_D + 64 * MiB;
constexpr size_t WS_MVT = WS_D + 65 * MiB;
static_assert(WS_GATES + (size_t)M_ * 24 * 4 <= WS_XN, "ws map");
static_assert(WS_AGG + 16 * MiB <= WS_END, "ws map");

struct Params {
    const float* in[41];
    float* out;
    unsigned char* ws;
};
enum { I_X = 0, I_MEM, I_F1_PRE, I_F1_WG, I_F1_WU, I_F1_WD, I_F1_POST, I_MIX_PRE, I_WIN, I_PE_K, I_W1_K, I_W2_K, I_PE_V, I_W1_V, I_W2_V,
       I_NSA_G, I_MU, I_W0, I_W2, I_A0, I_A2, I_G2, I_KK, I_KA, I_RK, I_GNG, I_GNB, I_WOUT, I_MIX_POST, I_MEM_PRE, I_MEM_KVG, I_WQ, I_WK, I_WV,
       I_WO, I_MEM_POST, I_F2_PRE, I_F2_WG, I_F2_WU, I_F2_WD, I_F2_POST };

struct MapPlain { const float* W; int N; int pad; __device__ const float* col(int p) const { return W + p; } };
struct MapGU {
    const float* Wg; const float* Wu; int N; int pad;
    __device__ const float* col(int p) const {
        const int pn = p >> 8, q = p & 255, n = (q >> 4) & 1;
        const int hid = 128 * pn + 64 * (q >> 7) + 16 * ((q >> 5) & 3) + (q & 15);
        return Wg + (size_t)n * (size_t)(Wu - Wg) + hid;
    }
};
__host__ __device__ inline int rope_perm(int x) { return 16 * ((x >> 5) & 1) + (x & 15) + 32 * ((x >> 4) & 1); }
struct MapWin {
    const float* W; int N; int pad;
    __device__ const float* col(int p) const {
        int l;
        if (p < 512) l = (p & ~63) + rope_perm(p & 63);
        else if (p < 640) l = 768 + ((p - 512) & ~63) + rope_perm(p & 63);
        else if (p < 768) l = 1024 + ((p - 640) & ~63) + rope_perm(p & 63);
        else if (p < 896) l = 512 + (p - 768);
        else if (p < 1024) l = 640 + (p - 896);
        else if (p < 1152) l = 896 + (p - 1024);
        else if (p < 1280) l = 1152 + (p - 1152);
        else if (p < 3072) l = 1304 + (p - 1280);
        else if (p < 3096) l = 1280 + (p - 3072);
        else return nullptr;
        return W + l;
    }
};

#define FOR_VB(vb, n) for (int vb = (int)blockIdx.x * 2 + (T512 >> 8); vb < (n); vb += (int)gridDim.x * 2)

template <class Map> __device__ __forceinline__ void d_convert(bf16* WT, int Np, int K, Map map) {
    const int T512 = tidx(), tid = T512 & 255, nbx = Np / 64, nb = nbx * (K / 64);
    FOR_VB(vb, nb) {
        const int p = (vb % nbx) * 64 + (tid & 63), k0 = (vb / nbx) * 64 + (tid >> 6) * 16;
        const float* src = map.col(p);
        float v[16];
#pragma unroll
        for (int i = 0; i < 16; ++i) v[i] = src ? src[(size_t)(k0 + i) * map.N] : 0.f;
        u32x4 a, b;
        a.x = pk2(v[0], v[1]); a.y = pk2(v[2], v[3]); a.z = pk2(v[4], v[5]); a.w = pk2(v[6], v[7]);
        b.x = pk2(v[8], v[9]); b.y = pk2(v[10], v[11]); b.z = pk2(v[12], v[13]); b.w = pk2(v[14], v[15]);
        u32x4* dst = (u32x4*)(WT + (size_t)p * K + k0);
        dst[0] = a; dst[1] = b;
    }
}
__device__ __forceinline__ void d_convert_lora(bf16* WT, const float* w2, const float* a2, const float* g2) {
    const int T512 = tidx(), tid = T512 & 255;
    FOR_VB(vb, NLORA * KLORA / 256) {
        const int idx = vb * 256 + tid, p = idx >> 8, k = idx & 255;
        float v = 0.f;
        if (p < 512) { if (k < 64) v = w2[k * 512 + p]; }
        else if (p < 1024) { if (k >= 64 && k < 128) v = a2[(k - 64) * 512 + (p - 512)]; }
        else { if (k >= 128) v = g2[(k - 128) * 512 + (p - 1024)]; }
        WT[idx] = (bf16)f2bf(v);
    }
}
__device__ __forceinline__ void d_rope_table(float* tab) {
    const int T512 = tidx(), tid = T512 & 255;
    FOR_VB(vb, T_ * 32 / 256) {
        const int idx = vb * 256 + tid, pos = idx >> 5, i = idx & 31;
        const float inv = (float)pow(10000.0, -(double)i / 32.0);
        const float ang = (float)pos * inv;
        tab[2 * idx] = (float)cos((double)ang); tab[2 * idx + 1] = (float)sin((double)ang);
    }
}
__device__ __forceinline__ void d_cmp_bias(const float* pe_k, const float* w1_k, const float* pe_v, const float* w1_v, float* bias, float* red  ) {
    for (int job = blockIdx.x; job < 8; job += gridDim.x) {
        const int kv = job >> 2; const float* pe = kv ? pe_v : pe_k; const float* w1 = kv ? w1_v : w1_k;
        const int T512 = tidx(), lane = T512 & 63, w = T512 >> 6, n = (job & 3) * 64 + lane;
        float s = 0.f;
        for (int j = w * 256; j < w * 256 + 256; ++j) s += pe[j] * w1[(size_t)j * 256 + n];
        red[w * 64 + lane] = s; __syncthreads();
        if (w == 0) { float t = 0.f; for (int i = 0; i < 8; ++i) t += red[i * 64 + lane]; bias[kv * 256 + n] = t; }
        __syncthreads();
    }
}
__device__ __forceinline__ void d_rownorm(const float* x, const float* g, bf16* xn, int rows) {
    const int T512 = tidx(), tid = T512 & 255, lane = tid & 63;
    FOR_VB(vb, rows / 4) {
        const int row = vb * 4 + (tid >> 6);
        const f32x4* xr = (const f32x4*)(x + (size_t)row * DM) + lane; f32x4 v[4]; float s = 0.f;
#pragma unroll
        for (int j = 0; j < 4; ++j) { v[j] = xr[64 * j]; s += v[j][0] * v[j][0] + v[j][1] * v[j][1] + v[j][2] * v[j][2] + v[j][3] * v[j][3]; }
        const float rstd = rsqrtf(wave_sum(s) * (1.f / DM) + NORM_EPS);
#pragma unroll
        for (int j = 0; j < 4; ++j) { const f32x4 gg = ((const f32x4*)g)[lane + 64 * j]; st_bf4(xn + (size_t)row * DM + 4 * (lane + 64 * j), v[j] * rstd * gg); }
    }
}
__device__ __forceinline__ void d_rowpass(const float* xin, const bf16* y, const float* gpost, float coef, const float* gpre, float* xout, bf16* xn) {
    const int T512 = tidx(), tid = T512 & 255, lane = tid & 63;
    FOR_VB(vb, M_ / 4) {
        const int row = vb * 4 + (tid >> 6);
        f32x4 yv[4], xv[4]; float s = 0.f;
#pragma unroll
        for (int j = 0; j < 4; ++j) {
            const u32x2 w = *(const u32x2*)(y + (size_t)row * DM + 4 * (lane + 64 * j));
            yv[j][0] = __builtin_bit_cast(float, w.x << 16); yv[j][1] = __builtin_bit_cast(float, w.x & 0xffff0000u);
            yv[j][2] = __builtin_bit_cast(float, w.y << 16); yv[j][3] = __builtin_bit_cast(float, w.y & 0xffff0000u);
            s += yv[j][0] * yv[j][0] + yv[j][1] * yv[j][1] + yv[j][2] * yv[j][2] + yv[j][3] * yv[j][3];
            xv[j] = ((const f32x4*)(xin + (size_t)row * DM))[lane + 64 * j];
        }
        const float rstd = rsqrtf(wave_sum(s) * (1.f / DM) + NORM_EPS) * coef; float s2 = 0.f;
#pragma unroll
        for (int j = 0; j < 4; ++j) { const f32x4 gg = ((const f32x4*)gpost)[lane + 64 * j]; xv[j] = xv[j] + yv[j] * rstd * gg;
            s2 += xv[j][0] * xv[j][0] + xv[j][1] * xv[j][1] + xv[j][2] * xv[j][2] + xv[j][3] * xv[j][3];
            ((f32x4*)(xout + (size_t)row * DM))[lane + 64 * j] = xv[j]; }
        if (gpre) {
            const float r2 = rsqrtf(wave_sum(s2) * (1.f / DM) + NORM_EPS);
#pragma unroll
            for (int j = 0; j < 4; ++j) { const f32x4 gg = ((const f32x4*)gpre)[lane + 64 * j]; st_bf4(xn + (size_t)row * DM + 4 * (lane + 64 * j), xv[j] * r2 * gg); }
        }
    }
}
__device__ __forceinline__ void d_nsa_outnorm(bf16* amix, const float* g) {
    const int T512 = tidx(), tid = T512 & 255, lane = tid & 63;
    FOR_VB(vb, M_ / 4) {
        const int row = vb * 4 + (tid >> 6);
        bf16* p = amix + (size_t)row * DM + 8 * lane;
        const u32x4 w = *(const u32x4*)p; float v[8]; float s = 0.f;
        v[0] = __builtin_bit_cast(float, w.x << 16); v[1] = __builtin_bit_cast(float, w.x & 0xffff0000u);
        v[2] = __builtin_bit_cast(float, w.y << 16); v[3] = __builtin_bit_cast(float, w.y & 0xffff0000u);
        v[4] = __builtin_bit_cast(float, w.z << 16); v[5] = __builtin_bit_cast(float, w.z & 0xffff0000u);
        v[6] = __builtin_bit_cast(float, w.w << 16); v[7] = __builtin_bit_cast(float, w.w & 0xffff0000u);
#pragma unroll
        for (int i = 0; i < 8; ++i) s += v[i] * v[i];
        const float rstd = rsqrtf(wave_sum(s) * (1.f / 512.f) + NORM_EPS);
        u32x4 o; const float* gg = g + 8 * lane;
        o.x = pk2(v[0] * rstd * gg[0], v[1] * rstd * gg[1]); o.y = pk2(v[2] * rstd * gg[2], v[3] * rstd * gg[3]);
        o.z = pk2(v[4] * rstd * gg[4], v[5] * rstd * gg[5]); o.w = pk2(v[6] * rstd * gg[6], v[7] * rstd * gg[7]);
        *(u32x4*)p = o;
    }
}

struct EpiStore { bf16* O; int ldc; float scale;
    static constexpr int NCAT = 1;
    __device__ __forceinline__ int cat(int) const { return 0; }
    template <int C> __device__ __forceinline__ void apply(int row, int p, f32x4 v0, f32x4 v1) const { bf16* o = O + (size_t)row * ldc + p; st_bf4(o, v0 * scale); st_bf4(o + 16, v1 * scale); } };
struct EpiSwiGLU { bf16* H;
    static constexpr int NCAT = 1;
    __device__ __forceinline__ int cat(int) const { return 0; }
    template <int C> __device__ __forceinline__ void apply(int row, int p, f32x4 g, f32x4 u) const {
        const int q = p & 255, hid = 128 * (p >> 8) + 64 * (q >> 7) + 16 * ((q >> 5) & 3) + (q & 15);
        f32x4 h;
#pragma unroll
        for (int e = 0; e < 4; ++e) h[e] = g[e] / (1.f + __expf(-g[e])) * u[e];
        st_bf4(H + (size_t)row * FF + hid, h); } };
struct EpiBiasSilu { bf16* O; const float* bias;
    static constexpr int NCAT = 1;
    __device__ __forceinline__ int cat(int) const { return 0; }
    template <int C> __device__ __forceinline__ void apply(int row, int p, f32x4 v0, f32x4 v1) const {
        f32x4 a, b; const f32x4 b0 = *(const f32x4*)(bias + p), b1 = *(const f32x4*)(bias + p + 16);
#pragma unroll
        for (int e = 0; e < 4; ++e) { const float x0 = v0[e] + b0[e], x1 = v1[e] + b1[e]; a[e] = x0 / (1.f + __expf(-x0)); b[e] = x1 / (1.f + __expf(-x1)); }
        bf16* o = O + (size_t)row * 256 + p; st_bf4(o, a); st_bf4(o + 16, b); } };
struct EpiLora { float* wdec; bf16* aga; bf16* agg; const float* w0; const float* a0;
    static constexpr int NCAT = 3;
    __device__ __forceinline__ int cat(int p0) const { return p0 < 512 ? 0 : (p0 < 1024 ? 1 : 2); }
    template <int C> __device__ __forceinline__ void one(int row, int p, f32x4 v) const {
        if (C == 0) { f32x4 o; const f32x4 ww = *(const f32x4*)(w0 + p);
#pragma unroll
            for (int e = 0; e < 4; ++e) o[e] = __expf(-0.6065306597126334f * sigmoidf_(ww[e] + v[e]));
            *(f32x4*)(wdec + (size_t)row * 512 + p) = o;
        } else if (C == 1) { f32x4 o; const f32x4 aa = *(const f32x4*)(a0 + p - 512);
#pragma unroll
            for (int e = 0; e < 4; ++e) o[e] = sigmoidf_(aa[e] + v[e]);
            st_bf4(aga + (size_t)row * 512 + (p - 512), o);
        } else st_bf4(agg + (size_t)row * 512 + (p - 1024), v);
    }
    template <int C> __device__ __forceinline__ void apply(int row, int p, f32x4 v0, f32x4 v1) const { one<C>(row, p, v0); one<C>(row, p + 16, v1); } };
struct EpiWin {
    bf16 *qb, *ks, *kw, *kcr, *vcr, *vst, *vwt, *pr; float* gates; const float* rope;
    static constexpr int NCAT = 6;
    __device__ __forceinline__ int cat(int p0) const { return p0 < 512 ? 0 : (p0 < 768 ? 1 : (p0 < 1024 ? 2 : (p0 < 1280 ? 3 : (p0 < 3072 ? 4 : 5)))); }
    template <int C> __device__ __forceinline__ void apply(int row, int p, f32x4 v0, f32x4 v1) const {
        const int b = row / T_, t = row % T_;
        if (C == 0 || C == 1) {
            const int x = p & 63, d = 16 * ((x >> 5) & 1) + (x & 15);
            const f32x4* rp = (const f32x4*)(rope + ((size_t)t * 32 + d) * 2); const f32x4 r0 = rp[0], r1 = rp[1];
            const f32x4 cs = {r0[0], r0[2], r1[0], r1[2]}, sn = {r0[1], r0[3], r1[1], r1[3]};
            const f32x4 lo = v0 * cs - v1 * sn, hi = v0 * sn + v1 * cs;
            if (C == 0) { bf16* o = qb + (size_t)row * 512 + (p & ~63) + d; st_bf4(o, lo * QSCALE); st_bf4(o + 32, hi * QSCALE); }
            else { const int g = ((p - 512) >> 6) & 1; bf16* base = (p < 640) ? ks : kw; bf16* o = base + ((size_t)(b * 2 + g) * T_ + t) * 64 + d; st_bf4(o, lo); st_bf4(o + 32, hi); }
        } else if (C == 2) {
            const int c = (p - 768) & 127, g = c >> 6, d = c & 63; bf16* base = (p < 896) ? kcr : vcr;
            bf16* o = base + ((size_t)(b * 2 + g) * T_ + t) * 64 + d; st_bf4(o, v0); st_bf4(o + 16, v1);
        } else if (C == 3) {
            const int c = (p - 1024) & 127, g = c >> 6, d = c & 63; bf16* base = (p < 1152) ? vst : vwt;
            bf16* o = base + ((size_t)(b * 2 + g) * 64 + d) * T_ + t;
#pragma unroll
            for (int e = 0; e < 4; ++e) { o[(size_t)e * T_] = (bf16)f2bf(v0[e]); o[(size_t)(16 + e) * T_] = (bf16)f2bf(v1[e]); }
        } else if (C == 4) {
            bf16* o = pr + (size_t)row * NRW + (p - 1280); st_bf4(o, v0); st_bf4(o + 16, v1);
        } else {
            const int c = p - 3072; float* o = gates + (size_t)row * 24 + c;
            if (c < 24) { f32x4 s = {sigmoidf_(v0[0]), sigmoidf_(v0[1]), sigmoidf_(v0[2]), sigmoidf_(v0[3])}; *(f32x4*)o = s; }
            if (c + 16 < 24) { f32x4 s = {sigmoidf_(v1[0]), sigmoidf_(v1[1]), sigmoidf_(v1[2]), sigmoidf_(v1[3])}; *(f32x4*)(o + 16) = s; }
        }
    }
};

namespace pg8 {
#define PG8_LAS __attribute__((address_space(3)))
typedef unsigned short bf16_t;
typedef short bf16x8 __attribute__((ext_vector_type(8)));
typedef float f32x4 __attribute__((ext_vector_type(4)));
typedef unsigned u32x4 __attribute__((ext_vector_type(4)));
constexpr int BM = 256, BK = 64, HALF = 128, HTB = HALF * BK * 2  , STAGE_BYTES = 8 * HTB, NXCD = 8, WGM = 8;

__host__ __device__ __forceinline__ int lds_byte(int r, int c) { const int st = (r >> 4) * 2 + (c >> 5), rr = r & 15, cc = c & 31, ob = rr * 64 + cc * 2; return st * 1024 + (ob ^ (((ob >> 9) & 1) << 5)); }
__host__ __device__ __forceinline__ void stage_rc(int b, int& R, int& C) { const int st = b / 1024, sb = b % 1024, swz = sb ^ (((sb >> 9) & 1) << 5); R = (st >> 1) * 16 + swz / 64; C = (st & 1) * 32 + (swz % 64) / 2; }
__host__ __device__ __forceinline__ int perm32(int rho) { const int n = rho >> 4, i = rho & 15; return 8 * (i >> 2) + 4 * n + (i & 3); }

struct Unit { int pm, pn; };
struct Gemm { const bf16_t* A; const bf16_t* Bt; int M, N, K, lda, ldb; };

struct StaticOrder {
    int nM, nN, nwg, G, c;
    __host__ __device__ void init(int M, int N, int G_, int c_) { nM = M / BM; nN = N / BM; nwg = nM * nN; G = G_; c = c_; }
    __host__ __device__ bool next(int i, Unit& u) const {
        const long L = (long)i * G + c; if (L >= nwg) return false;
        int wgid = (int)L; { const int q = nwg / NXCD, r = nwg % NXCD, xcd = wgid % NXCD, off = wgid / NXCD; wgid = (xcd < r ? xcd * (q + 1) : r * (q + 1) + (xcd - r) * q) + off; }
        const int nig = WGM * nN, gid = wgid / nig, fm = gid * WGM, gsz = (nM - fm) < WGM ? (nM - fm) : WGM;
        u.pm = fm + ((wgid % nig) % gsz); u.pn = (wgid % nig) / gsz; return true;
    }
    __device__ __forceinline__ void a_ready(const Unit&) const {}
    __device__ __forceinline__ void done(const Unit&) const {}
};

template <class Epi, class Sched, bool ALIGN_EPI = false, bool SP2 = false>
__device__ __forceinline__ void gemm_phase(PG8_LAS unsigned char* lds, const Gemm g, const Sched& S, const Epi& E) {
    const int tid = tidx(), wid = __builtin_amdgcn_readfirstlane(tid >> 6), lane = tid & 63, wr = wid >> 2, wc = wid & 3, fr = lane & 15, fq = lane >> 4;
    const int K = g.K, nt = K / BK;
    unsigned voffA[2], voffB[2];
#pragma unroll
    for (int i = 0; i < 2; ++i) { int R, C; stage_rc(tid * 16 + i * 8192, R, C); const int Rb = Epi::PERM ? ((R & ~31) + perm32(R & 31)) : R;
        voffA[i] = (unsigned)(R * g.lda + C) * 2u; voffB[i] = (unsigned)(Rb * g.ldb + C) * 2u; }
    const size_t kstep = (size_t)(BK * 2);
    const size_t hstepA = (size_t)HALF * g.lda * 2, hstepB = (size_t)HALF * g.ldb * 2;
    const size_t tstepA = 2 * hstepA, tstepB = 2 * hstepB;
    const unsigned ldsw = (unsigned)wid * 1024u;
    const int aoff = lds_byte(wr * 64 + fr, fq * 8), boff = lds_byte(wc * 32 + fr, fq * 8);
#define PG8_SA(b, h) (((b) * 2 + (h)) * HTB)
#define PG8_SB(b, h) ((4 + (b) * 2 + (h)) * HTB)
#define PG8_STAGE(bufoff, gbase, voff) do { _Pragma("unroll") for (int _i = 0; _i < 2; ++_i) \
        __builtin_amdgcn_global_load_lds((const unsigned*)((const char*)(gbase) + (voff)[_i]), (PG8_LAS unsigned*)(lds + (bufoff) + ldsw + _i * 8192), 16, 0, 0); } while (0)
#define PG8_LDA(dst, b, h) do { _Pragma("unroll") for (int m = 0; m < 4; ++m) _Pragma("unroll") for (int k = 0; k < 2; ++k) dst[m][k] = *(const PG8_LAS bf16x8*)(lds + PG8_SA(b, h) + aoff + m * 2048 + k * 1024); } while (0)
#define PG8_LDB(dst, b, h) do { _Pragma("unroll") for (int n = 0; n < 2; ++n) _Pragma("unroll") for (int k = 0; k < 2; ++k) dst[n][k] = *(const PG8_LAS bf16x8*)(lds + PG8_SB(b, h) + boff + n * 2048 + k * 1024); } while (0)
#define PG8_MMA(ai, bj, At, Bt) do { __builtin_amdgcn_s_setprio(1); _Pragma("unroll") for (int m = 0; m < 4; ++m) _Pragma("unroll") for (int n = 0; n < 2; ++n) _Pragma("unroll") for (int k = 0; k < 2; ++k) \
        acc[ai][bj][m][n] = __builtin_amdgcn_mfma_f32_16x16x32_bf16(Bt[n][k], At[m][k], acc[ai][bj][m][n], 0, 0, 0); __builtin_amdgcn_s_setprio(0); } while (0)
#define PG8_WAIT_V(n) asm volatile("s_waitcnt vmcnt(" #n ")" ::: "memory")
#define PG8_WAIT_L(n) asm volatile("s_waitcnt lgkmcnt(" #n ")" ::: "memory")
#define PG8_BAR __builtin_amdgcn_s_barrier()
#define PG8_SCHED __builtin_amdgcn_sched_barrier(0)
    Unit cur, nxt; int ui = 0;
    if (!S.next(0, cur)) return;
    f32x4 acc[2][2][4][2];
#pragma unroll
    for (int a = 0; a < 2; ++a)
#pragma unroll
        for (int b = 0; b < 2; ++b)
#pragma unroll
            for (int m = 0; m < 4; ++m)
#pragma unroll
                for (int n = 0; n < 2; ++n) acc[a][b][m][n] = (f32x4){0.f, 0.f, 0.f, 0.f};
    bf16x8 At[4][2], B0[2][2], B1[2][2];
    const char* cA = (const char*)g.A + (size_t)cur.pm * tstepA; const char* cB = (const char*)g.Bt + (size_t)cur.pn * tstepB;
    S.a_ready(cur);
    if constexpr (SP2) {
        PG8_STAGE(PG8_SB(0, 0), cB, voffB); PG8_STAGE(PG8_SB(0, 1), cB + hstepB, voffB); PG8_STAGE(PG8_SA(0, 0), cA, voffA); PG8_STAGE(PG8_SA(0, 1), cA + hstepA, voffA);
        if (wr == 1) PG8_BAR;
        PG8_WAIT_V(2); PG8_BAR;
        PG8_STAGE(PG8_SB(1, 0), cB + kstep, voffB); PG8_STAGE(PG8_SA(1, 0), cA + kstep, voffA); PG8_STAGE(PG8_SB(1, 1), cB + hstepB + kstep, voffB);
        PG8_WAIT_V(6); PG8_BAR;
    } else {
        PG8_STAGE(PG8_SB(0, 0), cB, voffB); PG8_STAGE(PG8_SA(0, 0), cA, voffA); PG8_STAGE(PG8_SB(0, 1), cB + hstepB, voffB); PG8_STAGE(PG8_SA(0, 1), cA + hstepA, voffA);
        if (wr == 1) PG8_BAR;
        PG8_WAIT_V(4); PG8_BAR;
        PG8_STAGE(PG8_SB(1, 0), cB + kstep, voffB); PG8_STAGE(PG8_SA(1, 0), cA + kstep, voffA); PG8_STAGE(PG8_SB(1, 1), cB + hstepB + kstep, voffB);
        PG8_WAIT_V(6); PG8_BAR;
    }
    for (;;) {
        const bool has_next = S.next(ui + 1, nxt);
        const char* nA = has_next ? (const char*)g.A + (size_t)nxt.pm * tstepA : cA; const char* nB = has_next ? (const char*)g.Bt + (size_t)nxt.pn * tstepB : cB;
        for (int t = 0; t < nt; t += 2) {
            const bool last = (t == nt - 2);
            const char* a1 = cA + (size_t)(t + 1) * kstep;
            const char* a2 = last ? nA : cA + (size_t)(t + 2) * kstep; const char* b2 = last ? nB : cB + (size_t)(t + 2) * kstep;
            const char* a3 = a2 + kstep; const char* b3 = b2 + kstep;
            if (last && has_next) S.a_ready(nxt);
            if constexpr (SP2) {
            PG8_LDB(B0, 0, 0); PG8_LDB(B1, 0, 1); PG8_SCHED; PG8_LDA(At, 0, 0); PG8_STAGE(PG8_SA(1, 1), a1 + hstepA, voffA);
            PG8_WAIT_V(8); PG8_WAIT_L(0); PG8_BAR; PG8_MMA(0, 0, At, B0); PG8_MMA(0, 1, At, B1); PG8_BAR; PG8_SCHED;
            PG8_LDA(At, 0, 1); PG8_STAGE(PG8_SB(0, 0), b2, voffB); PG8_STAGE(PG8_SB(0, 1), b2 + hstepB, voffB); PG8_STAGE(PG8_SA(0, 0), a2, voffA);
            PG8_WAIT_V(8); PG8_WAIT_L(0); PG8_BAR; PG8_MMA(1, 0, At, B0); PG8_MMA(1, 1, At, B1); PG8_BAR; PG8_SCHED;
            PG8_LDB(B0, 1, 0); PG8_LDB(B1, 1, 1); PG8_SCHED; PG8_LDA(At, 1, 0); PG8_STAGE(PG8_SA(0, 1), a2 + hstepA, voffA);
            PG8_WAIT_V(8); PG8_WAIT_L(0); PG8_BAR; PG8_MMA(0, 0, At, B0); PG8_MMA(0, 1, At, B1); PG8_BAR; PG8_SCHED;
            PG8_LDA(At, 1, 1); PG8_STAGE(PG8_SB(1, 0), b3, voffB); PG8_STAGE(PG8_SB(1, 1), b3 + hstepB, voffB); PG8_STAGE(PG8_SA(1, 0), a3, voffA);
            PG8_WAIT_V(8); PG8_WAIT_L(0); PG8_BAR; PG8_MMA(1, 0, At, B0); PG8_MMA(1, 1, At, B1); PG8_BAR; PG8_SCHED;
            } else {
            PG8_LDB(B0, 0, 0); PG8_SCHED; PG8_LDA(At, 0, 0); PG8_STAGE(PG8_SA(1, 1), a1 + hstepA, voffA);
            PG8_WAIT_L(8); PG8_BAR; PG8_WAIT_L(0); PG8_MMA(0, 0, At, B0); PG8_BAR; PG8_SCHED;
            PG8_LDB(B1, 0, 1); PG8_STAGE(PG8_SB(0, 0), b2, voffB);
            PG8_BAR; PG8_WAIT_L(0); PG8_MMA(0, 1, At, B1); PG8_BAR;
            PG8_LDA(At, 0, 1); PG8_STAGE(PG8_SA(0, 0), a2, voffA);
            PG8_BAR; PG8_WAIT_L(0); PG8_MMA(1, 0, At, B0); PG8_BAR; PG8_SCHED;
            PG8_STAGE(PG8_SB(0, 1), b2 + hstepB, voffB);
            PG8_WAIT_V(6); PG8_BAR; PG8_MMA(1, 1, At, B1); PG8_BAR;
            PG8_LDB(B0, 1, 0); PG8_SCHED; PG8_LDA(At, 1, 0); PG8_STAGE(PG8_SA(0, 1), a2 + hstepA, voffA);
            PG8_WAIT_L(8); PG8_BAR; PG8_WAIT_L(0); PG8_MMA(0, 0, At, B0); PG8_BAR; PG8_SCHED;
            PG8_LDB(B1, 1, 1); PG8_STAGE(PG8_SB(1, 0), b3, voffB);
            PG8_BAR; PG8_WAIT_L(0); PG8_MMA(0, 1, At, B1); PG8_BAR;
            PG8_LDA(At, 1, 1); PG8_STAGE(PG8_SA(1, 0), a3, voffA);
            PG8_BAR; PG8_WAIT_L(0); PG8_MMA(1, 0, At, B0); PG8_BAR; PG8_SCHED;
            PG8_STAGE(PG8_SB(1, 1), b3 + hstepB, voffB);
            PG8_WAIT_V(6); PG8_BAR; PG8_MMA(1, 1, At, B1); PG8_BAR;
            }
        }
        if constexpr (ALIGN_EPI) { if (wr == 0) PG8_BAR; }
        if constexpr (!Epi::AFTER_DRAIN) { E(acc, cur, wr, wc, fr, fq); S.done(cur); }
        if (!has_next) break;
#pragma unroll
        for (int a = 0; a < 2; ++a)
#pragma unroll
            for (int b = 0; b < 2; ++b)
#pragma unroll
                for (int m = 0; m < 4; ++m)
#pragma unroll
                    for (int n = 0; n < 2; ++n) acc[a][b][m][n] = (f32x4){0.f, 0.f, 0.f, 0.f};
        cur = nxt; cA = nA; cB = nB; ++ui;
        if constexpr (ALIGN_EPI) { if (wr == 1) PG8_BAR; }
    }
    PG8_WAIT_V(0);
    if constexpr (!ALIGN_EPI) { if (wr == 0) PG8_BAR; }
    PG8_BAR;
    if constexpr (Epi::AFTER_DRAIN) { E.fused(acc, cur, wr, wc, fr, fq, lds, wid, lane); S.done(cur); }
#undef PG8_SA
#undef PG8_SB
#undef PG8_STAGE
#undef PG8_LDA
#undef PG8_LDB
#undef PG8_MMA
#undef PG8_WAIT_V
#undef PG8_WAIT_L
#undef PG8_BAR
#undef PG8_SCHED
}
}

template <class F> struct EpiQuad {
    static constexpr bool PERM = false, AFTER_DRAIN = false;
    F f;
    template <int C, int BJ> __device__ __forceinline__ void half(const pg8::f32x4 (&acc)[2][2][4][2], int row0, int p) const {
#pragma unroll
        for (int ai = 0; ai < 2; ++ai)
#pragma unroll
            for (int m = 0; m < 4; ++m) { f.template apply<C>(row0 + ai * 128 + m * 16, p, acc[ai][BJ][m][0], acc[ai][BJ][m][1]); asm volatile("" ::: "memory"); }
    }
    template <int BJ> __device__ __forceinline__ void disp(const pg8::f32x4 (&acc)[2][2][4][2], int row0, int p0, int p) const {
        const int c = f.cat(p0);
        if (F::NCAT == 1 || c == 0) half<0, BJ>(acc, row0, p);
        else if (F::NCAT > 1 && c == 1) half<(F::NCAT > 1 ? 1 : 0), BJ>(acc, row0, p);
        else if (F::NCAT > 2 && c == 2) half<(F::NCAT > 2 ? 2 : 0), BJ>(acc, row0, p);
        else if (F::NCAT > 3 && c == 3) half<(F::NCAT > 3 ? 3 : 0), BJ>(acc, row0, p);
        else if (F::NCAT > 4 && c == 4) half<(F::NCAT > 4 ? 4 : 0), BJ>(acc, row0, p);
        else if (F::NCAT > 5) half<(F::NCAT > 5 ? 5 : 0), BJ>(acc, row0, p);
    }
    __device__ __forceinline__ void operator()(const pg8::f32x4 (&acc)[2][2][4][2], const pg8::Unit& u, int wr, int wc, int fr, int fq) const {
        const int row0 = u.pm * 256 + wr * 64 + fr, p0 = u.pn * 256;
        disp<0>(acc, row0, p0, p0 + wc * 32 + 4 * fq);
        disp<1>(acc, row0, p0 + 128, p0 + 128 + wc * 32 + 4 * fq);
    }
};
template <class F> __device__ __forceinline__ void gemm_pg8(unsigned char* lds, const bf16* A, int lda, const bf16* Bt, int ldb, int M, int N, int K, const F& f) {
    pg8::Gemm g{A, Bt, M, N, K, lda, ldb}; pg8::StaticOrder S; S.init(M, N, (int)gridDim.x, (int)blockIdx.x);
    EpiQuad<F> E{f};
    pg8::gemm_phase<EpiQuad<F>, pg8::StaticOrder, true, true>((PG8_LAS unsigned char*)lds, g, S, E);
}

__device__ __forceinline__ void d_cmp2(const bf16* hidk, const bf16* hidv, const float* w2k, const float* w2v, const float* rope, bf16* kc, bf16* vct) {
    const int T512 = tidx(), tid = T512 & 255;
    FOR_VB(vb, 2048 * 32 / 256) {
        const int idx = vb * 256 + tid; const int R = idx >> 5, i = idx & 31; const int bg = R >> 9, c = R & 511;
        float k0 = 0.f, k1 = 0.f, v0 = 0.f, v1 = 0.f;
        for (int n = 0; n < 256; ++n) { const float hk = bf2f(hidk[(size_t)R * 256 + n]), hv = bf2f(hidv[(size_t)R * 256 + n]);
            k0 += hk * w2k[n * 64 + i]; k1 += hk * w2k[n * 64 + i + 32]; v0 += hv * w2v[n * 64 + i]; v1 += hv * w2v[n * 64 + i + 32]; }
        const int pos = (16 * c + 31) & (T_ - 1);
        const float cs = rope[((size_t)pos * 32 + i) * 2], sn = rope[((size_t)pos * 32 + i) * 2 + 1];
        kc[(size_t)R * 64 + i] = (bf16)f2bf(k0 * cs - k1 * sn); kc[(size_t)R * 64 + i + 32] = (bf16)f2bf(k0 * sn + k1 * cs);
        vct[((size_t)bg * 64 + i) * NCP + c] = (bf16)f2bf(v0); vct[((size_t)bg * 64 + i + 32) * NCP + c] = (bf16)f2bf(v1);
    }
}

struct NsaArgs { const bf16 *qb, *kc, *vct, *ks, *vst, *kw, *vwt; const float* gates; bf16* amix; };
__device__ __forceinline__ float dot64(const float* q, const bf16* k) {
    float s = 0.f;
#pragma unroll
    for (int i = 0; i < 8; ++i) { const u32x4 w = ((const u32x4*)k)[i];
        s += q[8 * i + 0] * __builtin_bit_cast(float, w.x << 16) + q[8 * i + 1] * __builtin_bit_cast(float, w.x & 0xffff0000u)
           + q[8 * i + 2] * __builtin_bit_cast(float, w.y << 16) + q[8 * i + 3] * __builtin_bit_cast(float, w.y & 0xffff0000u)
           + q[8 * i + 4] * __builtin_bit_cast(float, w.z << 16) + q[8 * i + 5] * __builtin_bit_cast(float, w.z & 0xffff0000u)
           + q[8 * i + 6] * __builtin_bit_cast(float, w.w << 16) + q[8 * i + 7] * __builtin_bit_cast(float, w.w & 0xffff0000u); }
    return s;
}
__device__ __forceinline__ void softmax_row(float* s, int n, int lane) {
    float m = -INFINITY; for (int i = lane; i < n; i += 64) m = fmaxf(m, s[i]);
    m = wave_max(m); if (m == -INFINITY) m = 0.f;
    float l = 0.f; for (int i = lane; i < n; i += 64) { const float e = exp2f(s[i] - m); s[i] = e; l += e; }
    l = wave_sum(l); const float inv = 1.f / fmaxf(l, 1e-30f);
    for (int i = lane; i < n; i += 64) s[i] *= inv;
}
__device__ __forceinline__ void d_nsa_simple(const NsaArgs& a, int vb, int tid, unsigned char* smem) {
    float (*qs)[64] = (float (*)[64])smem; float (*sc)[1024] = (float (*)[1024])(smem + 1024); float* imp = (float*)(smem + 17408); float* score = imp + 128;
    int* list = (int*)(score + 128); int* nlist = list + 16;
    const int bg = vb / T_, t = vb % T_, b = bg >> 1, g = bg & 1;
    const int r = tid >> 6, d = tid & 63, lane = d;
    const size_t row = (size_t)b * T_ + t;
    qs[r][d] = bf2f(a.qb[row * 512 + g * 256 + r * 64 + d]);
    if (tid == 0) *nlist = 0;
    __syncthreads();
    const int nv = t < 31 ? 0 : (t - 31) / 16 + 1;
    for (int c = tid; c < nv; c += 256) { const bf16* k = a.kc + ((size_t)bg * NCP + c) * 64;
        _Pragma("unroll 1") for (int rr = 0; rr < 4; ++rr) sc[rr][c] = dot64(qs[rr], k); }
    __syncthreads();
    softmax_row(sc[r], nv, lane);
    __syncthreads();
    float oc = 0.f; { const bf16* v = a.vct + ((size_t)bg * 64 + d) * NCP; for (int c = 0; c < nv; ++c) oc += sc[r][c] * bf2f(v[c]); }
    if (tid < 128) { const int s = tid; float acc = 0.f;
        for (int c = 4 * s - 1; c <= 4 * s + 3; ++c) if (c >= 0 && c < nv) acc += sc[0][c] + sc[1][c] + sc[2][c] + sc[3][c];
        imp[s] = acc; }
    __syncthreads();
    const int cur = t >> 6;
    if (tid < 128) { const int s = tid; const bool forced = (s == 0) || (s == cur) || (s == cur - 1);
        score[s] = forced ? 1e4f : (s <= cur ? imp[s] : -1e4f); }
    __syncthreads();
    if (tid < 128) { const int s = tid; const float my = score[s]; int rank = 0;
        for (int j = 0; j < 128; ++j) { const float o = score[j]; rank += (o > my || (o == my && j < s)) ? 1 : 0; }
        if (rank < 16 && s <= cur) { const int slot = atomicAdd(nlist, 1); list[slot] = s; } }
    __syncthreads();
    const int ns = *nlist * 64;
    for (int i = tid; i < ns; i += 256) { const int pos = list[i >> 6] * 64 + (i & 63);
        if (pos <= t) { const bf16* k = a.ks + ((size_t)bg * T_ + pos) * 64; _Pragma("unroll 1") for (int rr = 0; rr < 4; ++rr) sc[rr][i] = dot64(qs[rr], k); }
        else { sc[0][i] = -INFINITY; sc[1][i] = -INFINITY; sc[2][i] = -INFINITY; sc[3][i] = -INFINITY; } }
    __syncthreads();
    softmax_row(sc[r], ns, lane);
    __syncthreads();
    float os = 0.f; { const bf16* v = a.vst + ((size_t)bg * 64 + d) * T_;
        for (int i = 0; i < ns; ++i) { const int pos = list[i >> 6] * 64 + (i & 63); if (pos <= t) os += sc[r][i] * bf2f(v[pos]); } }
    __syncthreads();
    const int lo = t - 511 > 0 ? t - 511 : 0, nw = t - lo + 1;
    for (int i = tid; i < nw; i += 256) { const bf16* k = a.kw + ((size_t)bg * T_ + lo + i) * 64;
        _Pragma("unroll 1") for (int rr = 0; rr < 4; ++rr) sc[rr][i] = dot64(qs[rr], k); }
    __syncthreads();
    softmax_row(sc[r], nw, lane);
    __syncthreads();
    float ow = 0.f; { const bf16* v = a.vwt + ((size_t)bg * 64 + d) * T_ + lo; for (int i = 0; i < nw; ++i) ow += sc[r][i] * bf2f(v[i]); }
    const float* gt = a.gates + row * 24 + g * 12 + r * 3;
    a.amix[row * DM + g * 256 + r * 64 + d] = (bf16)f2bf(gt[0] * oc + gt[1] * os + gt[2] * ow);
    __syncthreads();
}


namespace nsa {
typedef float f32x16 __attribute__((ext_vector_type(16)));
constexpr int KROW = 144, VROW = 136, KBUF = 64 * KROW, VBUF = 64 * VROW;
constexpr int OFF_K = 0, OFF_V = 2 * KBUF, OFF_IMP = OFF_V + 2 * VBUF, IMPW = 130, OFF_SEL = OFF_IMP + 64 * IMPW * 4, OFF_UM = OFF_SEL + 1024, OFF_WS = OFF_UM + 16, OFF_UNIT = OFF_WS + 1024, LDS_NEED = OFF_UNIT + 16;
static_assert(OFF_IMP % 16 == 0 && OFF_SEL % 16 == 0 && OFF_WS % 16 == 0, "nsa lds map");
__device__ __forceinline__ int crow(int r, int hi) { return (r & 3) + 8 * (r >> 2) + 4 * hi; }
__device__ __forceinline__ int next_bit(unsigned m0, unsigned m1, unsigned m2, unsigned m3, int from) {
#pragma unroll
    for (int wd = 0; wd < 4; ++wd) {
        unsigned x = wd == 0 ? m0 : (wd == 1 ? m1 : (wd == 2 ? m2 : m3)); const int base = wd * 32;
        if (from < base + 32) { if (from > base) x &= (~0u) << (from - base); if (x) return base + __builtin_ctz(x); }
    }
    return 128;
}
__device__ __forceinline__ bf16x8 pack8(const f32x16& p, int b0) {
    u32x4 w; w.x = pk2(p[b0 + 0], p[b0 + 1]); w.y = pk2(p[b0 + 2], p[b0 + 3]); w.z = pk2(p[b0 + 4], p[b0 + 5]); w.w = pk2(p[b0 + 6], p[b0 + 7]);
    return __builtin_bit_cast(bf16x8, w);
}
struct Branch { const bf16* k; const bf16* vt; int ldv; };

template <int MODE, bool SEL>
__device__ __forceinline__ void run_branch(unsigned char* sm, const Branch br, unsigned m0, unsigned m1, unsigned m2, unsigned m3,
                                           const bf16x8 (&qf)[4], int lo, int hi_b, int lo_max, int hi_min, unsigned s0, unsigned s1, unsigned s2, unsigned s3,
                                           float& m, float& l, float invl, f32x16 (&o)[2], float* imp_row, float* wsc, int tid, int lane) {
    const int i = lane & 31, hi = lane >> 5;
    int j = next_bit(m0, m1, m2, m3, 0);
    u32x4 kr, vr;
    if (j < 128) {
        kr = *(const u32x4*)(br.k + (size_t)j * 4096 + tid * 8);
        if (MODE != 0) vr = *(const u32x4*)(br.vt + (size_t)(tid >> 3) * br.ldv + j * 64 + (tid & 7) * 8);
        *(u32x4*)(sm + OFF_K + (tid >> 3) * KROW + (tid & 7) * 16) = kr;
        if (MODE != 0) { unsigned char* vp = sm + OFF_V + (tid >> 3) * VROW + (tid & 7) * 16; *(u32x2*)vp = (u32x2){vr.x, vr.y}; *(u32x2*)(vp + 8) = (u32x2){vr.z, vr.w}; }
    }
    __syncthreads();
    int cb = 0;
    while (j < 128) {
        const int jn = next_bit(m0, m1, m2, m3, j + 1);
        if (jn < 128) {
            kr = *(const u32x4*)(br.k + (size_t)jn * 4096 + tid * 8);
            if (MODE != 0) vr = *(const u32x4*)(br.vt + (size_t)(tid >> 3) * br.ldv + jn * 64 + (tid & 7) * 8);
        }
        const unsigned char* kb = sm + OFF_K + cb * KBUF; const unsigned char* vb = sm + OFF_V + cb * VBUF;
        const int key0 = 64 * j;
        bool rowsel = true;
        if (SEL) { const unsigned wsel = j < 32 ? s0 : (j < 64 ? s1 : (j < 96 ? s2 : s3)); rowsel = (wsel >> (j & 31)) & 1u; }
        if (!SEL || __any(rowsel)) {
            const float cinit = rowsel ? 0.f : -INFINITY;
            f32x16 p0, p1;
#pragma unroll
            for (int r = 0; r < 16; ++r) { p0[r] = cinit; p1[r] = cinit; }
#pragma unroll
            for (int d0 = 0; d0 < 4; ++d0) {
                const bf16x8 a0 = *(const bf16x8*)(kb + i * KROW + (16 * d0 + 8 * hi) * 2);
                const bf16x8 a1 = *(const bf16x8*)(kb + (32 + i) * KROW + (16 * d0 + 8 * hi) * 2);
                p0 = __builtin_amdgcn_mfma_f32_32x32x16_bf16(a0, qf[d0], p0, 0, 0, 0);
                p1 = __builtin_amdgcn_mfma_f32_32x32x16_bf16(a1, qf[d0], p1, 0, 0, 0);
            }
            if (!(key0 >= lo_max && key0 + 63 <= hi_min)) {
#pragma unroll
                for (int r = 0; r < 16; ++r) { const int key = key0 + crow(r, hi);
                    if (key < lo || key > hi_b) p0[r] = -INFINITY;
                    if (key + 32 < lo || key + 32 > hi_b) p1[r] = -INFINITY; }
            }
            if (MODE == 1) {
#pragma unroll
                for (int r = 0; r < 16; ++r) { p0[r] = __builtin_amdgcn_exp2f(p0[r] - m) * invl; p1[r] = __builtin_amdgcn_exp2f(p1[r] - m) * invl; }
#pragma unroll
                for (int gq = 0; gq < 4; ++gq) {
                    float G0 = (p0[4 * gq] + p0[4 * gq + 1]) + (p0[4 * gq + 2] + p0[4 * gq + 3]), L0 = p0[4 * gq + 3];
                    float G1 = (p1[4 * gq] + p1[4 * gq + 1]) + (p1[4 * gq + 2] + p1[4 * gq + 3]), L1 = p1[4 * gq + 3];
                    G0 += __shfl_xor(G0, 1); L0 += __shfl_xor(L0, 1); G1 += __shfl_xor(G1, 1); L1 += __shfl_xor(L1, 1);
                    G0 += __shfl_xor(G0, 2); L0 += __shfl_xor(L0, 2); G1 += __shfl_xor(G1, 2); L1 += __shfl_xor(L1, 2);
                    if ((i & 3) == 0) { const int s = 16 * j + 2 * gq + hi;
                        atomicAdd(imp_row + s, G0); atomicAdd(imp_row + s + 1, L0); atomicAdd(imp_row + s + 8, G1); atomicAdd(imp_row + s + 9, L1); }
                }
            } else {
                float tm = fmaxf(p0[0], p1[0]);
#pragma unroll
                for (int r = 1; r < 16; ++r) tm = fmaxf(tm, fmaxf(p0[r], p1[r]));
                tm = fmaxf(tm, __shfl_xor(tm, 32));
                const float mn = fmaxf(m, tm), alpha = __builtin_amdgcn_exp2f(m - mn);
                m = mn; float rs = 0.f;
#pragma unroll
                for (int r = 0; r < 16; ++r) { p0[r] = __builtin_amdgcn_exp2f(p0[r] - mn); p1[r] = __builtin_amdgcn_exp2f(p1[r] - mn); rs += p0[r] + p1[r]; }
                l = l * alpha + rs;
                if (MODE == 2) {
                    if (hi == 0) wsc[i] = alpha;
                    asm volatile("" ::: "memory");
#pragma unroll
                    for (int rg = 0; rg < 4; ++rg) { const f32x4 a4 = *(const f32x4*)(wsc + 8 * rg + 4 * hi);
#pragma unroll
                        for (int e = 0; e < 4; ++e) { o[0][4 * rg + e] *= a4[e]; o[1][4 * rg + e] *= a4[e]; } }
                    asm volatile("" ::: "memory");
                }
            }
            if (MODE != 0) {
                const bf16x8 pf0 = pack8(p0, 0), pf1 = pack8(p0, 8), pf2 = pack8(p1, 0), pf3 = pack8(p1, 8);
#pragma unroll
                for (int dt = 0; dt < 2; ++dt) {
                    const unsigned char* vp = vb + (32 * dt + i) * VROW + 8 * hi;
#pragma unroll
                    for (int ks = 0; ks < 4; ++ks) {
                        const u32x2 v_lo = *(const u32x2*)(vp + 32 * ks), v_hi = *(const u32x2*)(vp + 32 * ks + 16);
                        const bf16x8 vf = __builtin_bit_cast(bf16x8, (u32x4){v_lo.x, v_lo.y, v_hi.x, v_hi.y});
                        o[dt] = __builtin_amdgcn_mfma_f32_32x32x16_bf16(ks == 0 ? pf0 : (ks == 1 ? pf1 : (ks == 2 ? pf2 : pf3)), vf, o[dt], 0, 0, 0);
                    }
                }
            }
        }
        if (jn < 128) {
            *(u32x4*)(sm + OFF_K + (cb ^ 1) * KBUF + (tid >> 3) * KROW + (tid & 7) * 16) = kr;
            if (MODE != 0) { unsigned char* vp = sm + OFF_V + (cb ^ 1) * VBUF + (tid >> 3) * VROW + (tid & 7) * 16; *(u32x2*)vp = (u32x2){vr.x, vr.y}; *(u32x2*)(vp + 8) = (u32x2){vr.z, vr.w}; }
        }
        __syncthreads();
        j = jn; cb ^= 1;
    }
}
__device__ __forceinline__ void add_scaled(f32x16 (&acc)[2], const f32x16 (&o)[2], float f, float* wsc, int i, int hi) {
    if (hi == 0) wsc[i] = f;
    asm volatile("" ::: "memory");
#pragma unroll
    for (int rg = 0; rg < 4; ++rg) { const f32x4 a4 = *(const f32x4*)(wsc + 8 * rg + 4 * hi);
#pragma unroll
        for (int e = 0; e < 4; ++e) { acc[0][4 * rg + e] += a4[e] * o[0][4 * rg + e]; acc[1][4 * rg + e] += a4[e] * o[1][4 * rg + e]; } }
    asm volatile("" ::: "memory");
}
__device__ __forceinline__ void unit(const NsaArgs& a, int u, unsigned char* sm) {
    const int tid = tidx(), lane = tid & 63, w = __builtin_amdgcn_readfirstlane(tid >> 6), i = lane & 31, hi = lane >> 5;
    const int cur = 127 - (u >> 2), bg = u & 3, b = bg >> 1, g = bg & 1, q0 = cur * 64;
    const int ql = 8 * w + (i >> 2), hd = i & 3, t = q0 + ql;
    const size_t grow = (size_t)b * T_ + t;
    bf16x8 qf[4];
    { const bf16* qp = a.qb + grow * 512 + g * 256 + hd * 64 + 8 * hi;
#pragma unroll
      for (int d0 = 0; d0 < 4; ++d0) qf[d0] = *(const bf16x8*)(qp + 16 * d0); }
    float* wsc = (float*)(sm + OFF_WS) + w * 32;
    float* imp = (float*)(sm + OFF_IMP);
    unsigned* selw = (unsigned*)(sm + OFF_SEL);
    unsigned* um = (unsigned*)(sm + OFF_UM);
    for (int k = tid; k < 64 * IMPW; k += 512) imp[k] = 0.f;
    if (tid < 4) um[tid] = 0u;
    const float* gt = a.gates + grow * 24 + g * 12 + hd * 3;
    const float gc = gt[0], gs = gt[1], gw = gt[2];
    f32x16 acc[2], o[2];
#pragma unroll
    for (int r = 0; r < 16; ++r) { acc[0][r] = 0.f; acc[1][r] = 0.f; }
    const int tw0 = q0 + 8 * w, tw1 = tw0 + 7;
    {
        const int nv = t < 31 ? 0 : (t - 31) / 16 + 1;
        const int nvw = tw0 < 31 ? 0 : (tw0 - 31) / 16 + 1;
        const int nvmax = (q0 + 63 - 31) / 16 + 1, ntc = (nvmax + 63) / 64;
        const unsigned cm0 = ntc >= 32 ? ~0u : ((1u << ntc) - 1u);
        const Branch br{a.kc + (size_t)bg * NCP * 64, a.vct + (size_t)bg * 64 * NCP, NCP};
        float m = -1e30f, l = 0.f;
        run_branch<0, false>(sm, br, cm0, 0u, 0u, 0u, qf, 0, nv - 1, 0, nvw - 1, 0u, 0u, 0u, 0u, m, l, 0.f, o, nullptr, wsc, tid, lane);
        l += __shfl_xor(l, 32);
        const float invl = 1.f / fmaxf(l, 1e-30f);
#pragma unroll
        for (int r = 0; r < 16; ++r) { o[0][r] = 0.f; o[1][r] = 0.f; }
        run_branch<1, false>(sm, br, cm0, 0u, 0u, 0u, qf, 0, nv - 1, 0, nvw - 1, 0u, 0u, 0u, 0u, m, l, invl, o, imp + ql * IMPW, wsc, tid, lane);
        add_scaled(acc, o, gc, wsc, i, hi);
    }
    {
        unsigned u0 = 0u, u1 = 0u, u2 = 0u, u3 = 0u;
        const int ncand = cur - 2;
        for (int qq = 0; qq < 8; ++qq) {
            unsigned k0 = 0u, k1 = 0u, k2 = 0u, k3 = 0u;
            if (ncand <= 13) {
#pragma unroll
                for (int wd = 0; wd < 4; ++wd) { const int nb = cur + 1 - 32 * wd; const unsigned x = nb >= 32 ? ~0u : (nb <= 0 ? 0u : ((1u << nb) - 1u));
                    if (wd == 0) k0 = x; else if (wd == 1) k1 = x; else if (wd == 2) k2 = x; else k3 = x; }
            } else {
                const float* ir = imp + (8 * w + qq) * IMPW;
                float v0 = (lane >= 1 && lane <= cur - 2) ? ir[lane] : -1.f;
                float v1 = (lane + 64 <= cur - 2) ? ir[lane + 64] : -1.f;
                for (int it = 0; it < 13; ++it) {
                    float bv = v0; int bs = lane;
                    if (v1 > v0) { bv = v1; bs = lane + 64; }
#pragma unroll
                    for (int off = 1; off < 64; off <<= 1) { const float ov = __shfl_xor(bv, off); const int os = __shfl_xor(bs, off);
                        if (ov > bv || (ov == bv && os < bs)) { bv = ov; bs = os; } }
                    bs = __builtin_amdgcn_readfirstlane(bs);
                    if (bs == lane) v0 = -1.f; if (bs == lane + 64) v1 = -1.f;
                    const unsigned bit = 1u << (bs & 31);
                    if (bs < 32) k0 |= bit; else if (bs < 64) k1 |= bit; else if (bs < 96) k2 |= bit; else k3 |= bit;
                }
                k0 |= 1u;
                { const int c1 = cur - 1; const unsigned bit = 1u << (c1 & 31); if (c1 < 32) k0 |= bit; else if (c1 < 64) k1 |= bit; else if (c1 < 96) k2 |= bit; else k3 |= bit; }
                { const unsigned bit = 1u << (cur & 31); if (cur < 32) k0 |= bit; else if (cur < 64) k1 |= bit; else if (cur < 96) k2 |= bit; else k3 |= bit; }
            }
            if (lane == 0) { unsigned* sp = selw + (8 * w + qq) * 4; sp[0] = k0; sp[1] = k1; sp[2] = k2; sp[3] = k3; }
            u0 |= k0; u1 |= k1; u2 |= k2; u3 |= k3;
        }
        if (lane == 0) { atomicOr(um + 0, u0); atomicOr(um + 1, u1); atomicOr(um + 2, u2); atomicOr(um + 3, u3); }
    }
    __syncthreads();
    {
        const unsigned U0 = um[0], U1 = um[1], U2 = um[2], U3 = um[3];
        const unsigned* sp = selw + ql * 4; const unsigned s0 = sp[0], s1 = sp[1], s2 = sp[2], s3 = sp[3];
        const Branch br{a.ks + (size_t)bg * T_ * 64, a.vst + (size_t)bg * 64 * T_, T_};
        float m = -1e30f, l = 0.f;
#pragma unroll
        for (int r = 0; r < 16; ++r) { o[0][r] = 0.f; o[1][r] = 0.f; }
        run_branch<2, true>(sm, br, __builtin_amdgcn_readfirstlane(U0), __builtin_amdgcn_readfirstlane(U1), __builtin_amdgcn_readfirstlane(U2), __builtin_amdgcn_readfirstlane(U3),
                            qf, 0, t, 0, tw0, s0, s1, s2, s3, m, l, 0.f, o, nullptr, wsc, tid, lane);
        l += __shfl_xor(l, 32);
        add_scaled(acc, o, gs / fmaxf(l, 1e-30f), wsc, i, hi);
    }
    {
        const int j0 = cur - 8 > 0 ? cur - 8 : 0;
        unsigned wm0 = 0u, wm1 = 0u, wm2 = 0u, wm3 = 0u;
#pragma unroll
        for (int wd = 0; wd < 4; ++wd) { const int a0 = j0 - 32 * wd, a1 = cur + 1 - 32 * wd;
            const unsigned hi_m = a1 >= 32 ? ~0u : (a1 <= 0 ? 0u : ((1u << a1) - 1u)), lo_m = a0 >= 32 ? ~0u : (a0 <= 0 ? 0u : ((1u << a0) - 1u));
            const unsigned x = hi_m & ~lo_m; if (wd == 0) wm0 = x; else if (wd == 1) wm1 = x; else if (wd == 2) wm2 = x; else wm3 = x; }
        const Branch br{a.kw + (size_t)bg * T_ * 64, a.vwt + (size_t)bg * 64 * T_, T_};
        float m = -1e30f, l = 0.f;
#pragma unroll
        for (int r = 0; r < 16; ++r) { o[0][r] = 0.f; o[1][r] = 0.f; }
        run_branch<2, false>(sm, br, wm0, wm1, wm2, wm3, qf, t - 511, t, tw1 - 511, tw0, 0u, 0u, 0u, 0u, m, l, 0.f, o, nullptr, wsc, tid, lane);
        l += __shfl_xor(l, 32);
        add_scaled(acc, o, gw / fmaxf(l, 1e-30f), wsc, i, hi);
    }
#pragma unroll
    for (int r = 0; r < 16; ++r) { const int rw = crow(r, hi), qq = 8 * w + (rw >> 2), hh = rw & 3;
        bf16* op = a.amix + ((size_t)b * T_ + q0 + qq) * DM + g * 256 + hh * 64 + i;
        op[0] = (bf16)f2bf(acc[0][r]); op[32] = (bf16)f2bf(acc[1][r]); }
}
__device__ __forceinline__ void phase(const NsaArgs& a, unsigned* ctr, unsigned char* sm) {
    int* slot = (int*)(sm + OFF_UNIT);
    for (;;) {
        if (tidx() == 0) *slot = (int)atomicAdd(ctr, 1u);
        __syncthreads();
        const int u = *slot;
        __syncthreads();
        if (u >= 512) break;
        unit(a, u, sm);
    }
}
}

__device__ __forceinline__ void d_lora_prep(const bf16* pr, const float* mu, bf16* la) {
    const int T512 = tidx(), c = T512 & 255;
    FOR_VB(row, M_) {
        const int t = row % T_;
        const float cur = bf2f(pr[(size_t)row * NRW + 1536 + c]), prev = t ? bf2f(pr[(size_t)(row - 1) * NRW + 1536 + c]) : 0.f;
        const float x = cur + (prev - cur) * mu[1536 + c];
        const float v = c < 64 ? tanhf(x) : (c < 128 ? x : sigmoidf_(x));
        la[(size_t)row * KLORA + c] = (bf16)f2bf(v);
    }
}
struct RwkvArgs { const bf16* pr; const float* wdec; const bf16 *aga, *agg; const float *mu, *kk, *ka, *rk, *gng, *gnb; bf16* amix; };
constexpr int TC = 16;
__device__ __forceinline__ void d_rwkv_scan(const RwkvArgs& a, int bh, unsigned char* smem) {
    float (*vec)[6][64] = (float (*)[6][64])smem; float (*scal)[4] = (float (*)[4])(smem + TC * 6 * 64 * 4);
    float (*ybuf)[64] = (float (*)[64])(smem + TC * 6 * 64 * 4 + TC * 16); float (*gbuf)[64] = (float (*)[64])(smem + TC * 6 * 64 * 4 + TC * 16 + TC * 256);
    const int b = bh >> 3, h = bh & 7, tid = tidx(), w = tid >> 6, lane = tid & 63;
    const int v = tid >> 3, sub = tid & 7, col = h * 64 + lane;
    const float mur = a.mu[col], muk = a.mu[512 + col], muv = a.mu[1024 + col], kkc = a.kk[col], kac = a.ka[col], rkc = a.rk[col], gng = a.gng[col], gnb = a.gnb[col];
    float S0 = 0.f, S1 = 0.f, S2 = 0.f, S3 = 0.f, S4 = 0.f, S5 = 0.f, S6 = 0.f, S7 = 0.f;
    for (int c0 = 0; c0 < T_; c0 += TC) {
#pragma unroll
        for (int i = 0; i < TC / 8; ++i) { const int tl = w + 8 * i, t = c0 + tl; const size_t row = (size_t)b * T_ + t;
            const bf16* p = a.pr + row * NRW; const bool hp = t > 0;
            const float r0 = bf2f(p[col]), k0 = bf2f(p[512 + col]), v0 = bf2f(p[1024 + col]);
            const float r1 = hp ? bf2f(p[col - NRW]) : 0.f, k1 = hp ? bf2f(p[512 + col - NRW]) : 0.f, v1 = hp ? bf2f(p[1024 + col - NRW]) : 0.f;
            const float r = r0 + (r1 - r0) * mur, k = k0 + (k1 - k0) * muk, vv = v0 + (v1 - v0) * muv;
            const float wd = a.wdec[row * 512 + col], al = bf2f(a.aga[row * 512 + col]), gg = bf2f(a.agg[row * 512 + col]);
            const float kkv = k * kkc, nrm = sqrtf(wave_sum(kkv * kkv)), kkn = kkv / fmaxf(nrm, 1e-12f);
            const float bb = kkn * al, kt = k * (1.f + (al - 1.f) * kac);
            const float br = wave_sum(bb * r), kr = wave_sum(kt * r), rk = wave_sum(r * kt * rkc);
            vec[tl][0][lane] = -kkn; vec[tl][1][lane] = wd; vec[tl][2][lane] = bb; vec[tl][3][lane] = kt; vec[tl][4][lane] = wd * r; vec[tl][5][lane] = vv;
            gbuf[tl][lane] = gg; if (lane == 0) { scal[tl][0] = br; scal[tl][1] = kr; scal[tl][2] = rk; } }
        __syncthreads();
        for (int tl = 0; tl < TC; ++tl) {
            const f32x4 n0 = *(const f32x4*)&vec[tl][0][8 * sub], n1 = *(const f32x4*)&vec[tl][0][8 * sub + 4];
            const f32x4 w0 = *(const f32x4*)&vec[tl][1][8 * sub], w1 = *(const f32x4*)&vec[tl][1][8 * sub + 4];
            const f32x4 b0 = *(const f32x4*)&vec[tl][2][8 * sub], b1 = *(const f32x4*)&vec[tl][2][8 * sub + 4];
            const f32x4 k0 = *(const f32x4*)&vec[tl][3][8 * sub], k1 = *(const f32x4*)&vec[tl][3][8 * sub + 4];
            const f32x4 q0 = *(const f32x4*)&vec[tl][4][8 * sub], q1 = *(const f32x4*)&vec[tl][4][8 * sub + 4];
            const float vv = vec[tl][5][v], br = scal[tl][0], kr = scal[tl][1];
            float d1 = S0 * n0[0] + S1 * n0[1] + S2 * n0[2] + S3 * n0[3] + S4 * n1[0] + S5 * n1[1] + S6 * n1[2] + S7 * n1[3];
            float d2 = S0 * q0[0] + S1 * q0[1] + S2 * q0[2] + S3 * q0[3] + S4 * q1[0] + S5 * q1[1] + S6 * q1[2] + S7 * q1[3];
            d1 += __shfl_xor(d1, 1); d2 += __shfl_xor(d2, 1); d1 += __shfl_xor(d1, 2); d2 += __shfl_xor(d2, 2); d1 += __shfl_xor(d1, 4); d2 += __shfl_xor(d2, 4);
            S0 = S0 * w0[0] + d1 * b0[0] + vv * k0[0]; S1 = S1 * w0[1] + d1 * b0[1] + vv * k0[1]; S2 = S2 * w0[2] + d1 * b0[2] + vv * k0[2]; S3 = S3 * w0[3] + d1 * b0[3] + vv * k0[3];
            S4 = S4 * w1[0] + d1 * b1[0] + vv * k1[0]; S5 = S5 * w1[1] + d1 * b1[1] + vv * k1[1]; S6 = S6 * w1[2] + d1 * b1[2] + vv * k1[2]; S7 = S7 * w1[3] + d1 * b1[3] + vv * k1[3];
            if (sub == 0) ybuf[tl][v] = d2 + d1 * br + vv * kr;
        }
        __syncthreads();
#pragma unroll
        for (int i = 0; i < TC / 8; ++i) { const int tl = w + 8 * i, t = c0 + tl; const size_t row = (size_t)b * T_ + t;
            const float y = ybuf[tl][lane], mean = wave_sum(y) * (1.f / 64.f), dy = y - mean, var = wave_sum(dy * dy) * (1.f / 64.f);
            const float yn = dy * rsqrtf(var + 64e-5f) * gng + gnb;
            a.amix[row * DM + 512 + col] = (bf16)f2bf((yn + scal[tl][2] * vec[tl][5][lane]) * gbuf[tl][lane]); }
        __syncthreads();
    }
}

__device__ __forceinline__ void d_memattn_simple(const bf16* qm, const bf16* mk, const bf16* mvt, bf16* om, int row, int tid, unsigned char* smem) {
    float (*qs)[256] = (float (*)[256])smem; float (*sc)[256] = (float (*)[256])(smem + 4096);
    const int b = row / T_, h = tid >> 6, lane = tid & 63;
    for (int i = lane; i < 256; i += 64) qs[h][i] = bf2f(qm[(size_t)row * DM + h * 256 + i]);
    __syncthreads();
    for (int key = lane; key < 256; key += 64) { const bf16* k = mk + ((size_t)b * 256 + key) * DM + h * 256;
        sc[h][key] = dot64(qs[h], k) + dot64(qs[h] + 64, k + 64) + dot64(qs[h] + 128, k + 128) + dot64(qs[h] + 192, k + 192); }
    __syncthreads();
    softmax_row(sc[h], 256, lane);
    __syncthreads();
    for (int dv = lane; dv < 256; dv += 64) { const bf16* v = mvt + ((size_t)h * 256 + dv) * 512 + b * 256; float o = 0.f;
        for (int key = 0; key < 256; ++key) o += sc[h][key] * bf2f(v[key]);
        om[(size_t)row * DM + h * 256 + dv] = (bf16)f2bf(o); }
    __syncthreads();
}

namespace cg = cooperative_groups;
constexpr int NTHREADS = 512, LDS_BYTES = 147456;
struct MegaArgs { const float* in[41]; float* out; unsigned char* ws; };
#define WSB(off) ((bf16*)(ws + (off)))
#define WSF(off) ((float*)(ws + (off)))

__global__ void __launch_bounds__(NTHREADS) mega_fwd(MegaArgs A) {
    extern __shared__ __attribute__((aligned(16))) unsigned char lds[];
    cg::grid_group grid = cg::this_grid();
    const float* const* in = A.in; unsigned char* ws = A.ws; float* out = A.out;

    d_convert(WSB(WS_W1GU), NGU, DM, MapGU{in[I_F1_WG], in[I_F1_WU], FF});
    d_convert(WSB(WS_W1D), DM, FF, MapPlain{in[I_F1_WD], DM});
    d_convert(WSB(WS_W2GU), NGU, DM, MapGU{in[I_F2_WG], in[I_F2_WU], FF});
    d_convert(WSB(WS_W2D), DM, FF, MapPlain{in[I_F2_WD], DM});
    d_convert(WSB(WS_WIN), NWIN, DM, MapWin{in[I_WIN], IN_COLS});
    d_convert(WSB(WS_WOUT), DM, DM, MapPlain{in[I_WOUT], DM});
    d_convert(WSB(WS_WQ), DM, DM, MapPlain{in[I_WQ], DM});
    d_convert(WSB(WS_WK), DM, DM, MapPlain{in[I_WK], DM});
    d_convert(WSB(WS_WV), DM, DM, MapPlain{in[I_WV], DM});
    d_convert(WSB(WS_WO), DM, DM, MapPlain{in[I_WO], DM});
    d_convert(WSB(WS_CW1K), 256, 2048, MapPlain{in[I_W1_K], 256});
    d_convert(WSB(WS_CW1V), 256, 2048, MapPlain{in[I_W1_V], 256});
    d_convert_lora(WSB(WS_WLORA), in[I_W2], in[I_A2], in[I_G2]);
    d_rope_table(WSF(WS_ROPE));
    d_cmp_bias(in[I_PE_K], in[I_W1_K], in[I_PE_V], in[I_W1_V], WSF(WS_CBIAS), (float*)lds);
    d_rownorm(in[I_X], in[I_F1_PRE], WSB(WS_XN), M_);
    d_rownorm(in[I_MEM], in[I_MEM_KVG], WSB(WS_MEMN), 512);
    grid.sync();
    gemm_pg8(lds, WSB(WS_XN), DM, WSB(WS_W1GU), DM, M_, NGU, DM, EpiSwiGLU{WSB(WS_HB)});
    grid.sync();
    gemm_pg8(lds, WSB(WS_HB), FF, WSB(WS_W1D), FF, M_, DM, FF, EpiStore{WSB(WS_YB), DM, 1.f});
    grid.sync();
    d_rowpass(in[I_X], WSB(WS_YB), in[I_F1_POST], 0.5f, in[I_MIX_PRE], out, WSB(WS_XN));
    grid.sync();
    gemm_pg8(lds, WSB(WS_XN), DM, WSB(WS_WIN), DM, M_, NWIN, DM,
             EpiWin{WSB(WS_QB), WSB(WS_KS), WSB(WS_KW), WSB(WS_KCR), WSB(WS_VCR), WSB(WS_VST), WSB(WS_VWT), WSB(WS_PR), WSF(WS_GATES), WSF(WS_ROPE)});
    grid.sync();
    gemm_pg8(lds, WSB(WS_KCR), 1024, WSB(WS_CW1K), 2048, 2048, 256, 2048, EpiBiasSilu{WSB(WS_HIDK), WSF(WS_CBIAS)});
    gemm_pg8(lds, WSB(WS_VCR), 1024, WSB(WS_CW1V), 2048, 2048, 256, 2048, EpiBiasSilu{WSB(WS_HIDV), WSF(WS_CBIAS) + 256});
    d_lora_prep(WSB(WS_PR), in[I_MU], WSB(WS_XN));
    grid.sync();
    d_cmp2(WSB(WS_HIDK), WSB(WS_HIDV), in[I_W2_K], in[I_W2_V], WSF(WS_ROPE), WSB(WS_KC), WSB(WS_VCT));
    gemm_pg8(lds, WSB(WS_XN), KLORA, WSB(WS_WLORA), KLORA, M_, NLORA, KLORA, EpiLora{WSF(WS_YB), WSB(WS_AGA), WSB(WS_AGG), in[I_W0], in[I_A0]});
    grid.sync();
    if (blockIdx.x < 16) {
        const RwkvArgs ra{WSB(WS_PR), WSF(WS_YB), WSB(WS_AGA), WSB(WS_AGG), in[I_MU], in[I_KK], in[I_KA], in[I_RK], in[I_GNG], in[I_GNB], WSB(WS_XN)};
        d_rwkv_scan(ra, blockIdx.x, lds);
    }
    {
        const NsaArgs na{WSB(WS_QB), WSB(WS_KC), WSB(WS_VCT), WSB(WS_KS), WSB(WS_VST), WSB(WS_KW), WSB(WS_VWT), WSF(WS_GATES), WSB(WS_XN)};
        nsa::phase(na, (unsigned*)(ws + WS_CTL), lds);
    }
    grid.sync();
    d_nsa_outnorm(WSB(WS_XN), in[I_NSA_G]);
    grid.sync();
    gemm_pg8(lds, WSB(WS_XN), DM, WSB(WS_WOUT), DM, M_, DM, DM, EpiStore{WSB(WS_YB), DM, 1.f});
    grid.sync();
    d_rowpass(out, WSB(WS_YB), in[I_MIX_POST], 1.0f, in[I_MEM_PRE], out, WSB(WS_XN));
    grid.sync();
    gemm_pg8(lds, WSB(WS_XN), DM, WSB(WS_WQ), DM, M_, DM, DM, EpiStore{WSB(WS_QM), DM, MSCALE});
    gemm_pg8(lds, WSB(WS_MEMN), DM, WSB(WS_WK), DM, 512, DM, DM, EpiStore{WSB(WS_MK), DM, 1.f});
    gemm_pg8(lds, WSB(WS_WV), DM, WSB(WS_MEMN), DM, DM, 512, DM, EpiStore{WSB(WS_MVT), 512, 1.f});
    grid.sync();
    { const int t5 = tidx(), half = t5 >> 8;
      for (int row = blockIdx.x * 2 + half; row < M_; row += gridDim.x * 2) d_memattn_simple(WSB(WS_QM), WSB(WS_MK), WSB(WS_MVT), WSB(WS_OM), row, t5 & 255, lds + half * 8192); }
    grid.sync();
    gemm_pg8(lds, WSB(WS_OM), DM, WSB(WS_WO), DM, M_, DM, DM, EpiStore{WSB(WS_YB), DM, 1.f});
    grid.sync();
    d_rowpass(out, WSB(WS_YB), in[I_MEM_POST], 1.0f, in[I_F2_PRE], out, WSB(WS_XN));
    grid.sync();
    gemm_pg8(lds, WSB(WS_XN), DM, WSB(WS_W2GU), DM, M_, NGU, DM, EpiSwiGLU{WSB(WS_HB)});
    grid.sync();
    gemm_pg8(lds, WSB(WS_HB), FF, WSB(WS_W2D), FF, M_, DM, FF, EpiStore{WSB(WS_YB), DM, 1.f});
    grid.sync();
    d_rowpass(out, WSB(WS_YB), in[I_F2_POST], 0.5f, (const float*)nullptr, out, (bf16*)nullptr);
}

extern "C" void kernel_launch(void* const* d_in, const int* in_sizes, int n_in, void* d_out, int out_size, void* d_ws, size_t ws_size, hipStream_t stream) {
    static int grid = 0;
    if (grid == 0) {
        if (n_in != 41 || ws_size < WS_END) { fprintf(stderr, "kernel_launch: unexpected n_in %d / ws %zu\n", n_in, ws_size); grid = -1; return; }
        int dev = 0, cus = 0, per_cu = 0;
        hipGetDevice(&dev); hipDeviceGetAttribute(&cus, hipDeviceAttributeMultiprocessorCount, dev);
        if (hipFuncSetAttribute((const void*)mega_fwd, hipFuncAttributeMaxDynamicSharedMemorySize, LDS_BYTES) != hipSuccess) { fprintf(stderr, "kernel_launch: hipFuncSetAttribute failed\n"); grid = -1; return; }
        if (hipOccupancyMaxActiveBlocksPerMultiprocessor(&per_cu, (const void*)mega_fwd, NTHREADS, LDS_BYTES) != hipSuccess || per_cu < 1) { fprintf(stderr, "kernel_launch: occupancy query says %d\n", per_cu); grid = -1; (void)hipGetLastError(); return; }
        grid = cus;
    }
    if (grid < 0) return;
    MegaArgs a{};
    for (int i = 0; i < 41; ++i) a.in[i] = (const float*)d_in[i];
    a.out = (float*)d_out; a.ws = (unsigned char*)d_ws;
    hipMemsetAsync(d_ws, 0, 4096, stream);
    void* args[] = {&a};
    hipError_t e = hipLaunchCooperativeKernel((const void*)mega_fwd, dim3(grid), dim3(NTHREADS), args, LDS_BYTES, stream);
    if (e != hipSuccess) fprintf(stderr, "kernel_launch: cooperative launch failed: %s (grid %d)\n", hipGetErrorString(e), grid);
}
```

```cpp
#include <hip/hip_runtime.h>
#include <hip/hip_cooperative_groups.h>
#include <cstdint>
#include <cstdio>

constexpr int NB = 2, T_ = 8192, DM = 1024, M_ = NB * T_;
constexpr int FF = 2816, NGU = 2 * FF;
constexpr int IN_COLS = 3096, NWIN = 3328;
constexpr int NRW = 1792;
constexpr int NCP = 512;
constexpr int NLORA = 1536, KLORA = 256;
constexpr float NORM_EPS = 1e-6f;
constexpr float QSCALE = 0.125f * 1.4426950408889634f;
constexpr float MSCALE = 0.0625f * 1.4426950408889634f;

typedef unsigned short bf16;
typedef short bf16x8 __attribute__((ext_vector_type(8)));
typedef float f32x4 __attribute__((ext_vector_type(4)));
typedef unsigned u32x2 __attribute__((ext_vector_type(2)));
typedef unsigned u32x4 __attribute__((ext_vector_type(4)));

__device__ __forceinline__ unsigned f2bf(float f) { unsigned u = __builtin_bit_cast(unsigned, f); return (u + 0x7fffu + ((u >> 16) & 1u)) >> 16; }
__device__ __forceinline__ float bf2f(bf16 h) { return __builtin_bit_cast(float, (unsigned)h << 16); }
typedef float f32x2_t __attribute__((ext_vector_type(2))); typedef __bf16 bf16x2_t __attribute__((ext_vector_type(2)));
__device__ __forceinline__ unsigned pk2(float lo, float hi) { const f32x2_t v = {lo, hi}; return __builtin_bit_cast(unsigned, __builtin_convertvector(v, bf16x2_t)); }
__device__ __forceinline__ void st_bf4(bf16* p, f32x4 v) { u32x2 w; w.x = pk2(v[0], v[1]); w.y = pk2(v[2], v[3]); *(u32x2*)p = w; }
__device__ __forceinline__ float wave_sum(float v) {
#pragma unroll
    for (int o = 1; o < 64; o <<= 1) v += __shfl_xor(v, o);
    return v;
}
__device__ __forceinline__ float wave_max(float v) {
#pragma unroll
    for (int o = 1; o < 64; o <<= 1) v = fmaxf(v, __shfl_xor(v, o));
    return v;
}
__device__ __forceinline__ float sigmoidf_(float x) { return 1.f / (1.f + __expf(-x)); }
__device__ __forceinline__ int tidx() { int t = threadIdx.x; asm volatile("" : "+v"(t)); return t; }

constexpr size_t MiB = 1u << 20, KiB64 = 65536;
constexpr size_t WS_CTL = 0;
constexpr size_t WS_KC = 256 * 1024;
constexpr size_t WS_VCT = 512 * 1024;
constexpr size_t WS_W1GU = 1 * MiB;
constexpr size_t WS_W1D = 12 * MiB;
constexpr size_t WS_W2GU = WS_W1D + 88 * KiB64;
constexpr size_t WS_W2D = WS_W2GU + 11 * MiB;
constexpr size_t WS_WIN = WS_W2D + 88 * KiB64;
constexpr size_t WS_WOUT = WS_WIN + 104 * KiB64;
constexpr size_t WS_WQ = WS_WOUT + 2 * MiB, WS_WK = WS_WQ + 2 * MiB, WS_WV = WS_WK + 2 * MiB, WS_WO = WS_WV + 2 * MiB;
constexpr size_t WS_CW1K = WS_WO + 2 * MiB, WS_CW1V = WS_CW1K + 1 * MiB;
constexpr size_t WS_WLORA = WS_CW1V + 1 * MiB;
constexpr size_t WS_ROPE = WS_WLORA + 12 * KiB64;
constexpr size_t WS_CBIAS = WS_ROPE + 2 * MiB;
constexpr size_t WS_MEMN = WS_CBIAS + KiB64;
constexpr size_t WS_HIDK = WS_MEMN + 1 * MiB;
constexpr size_t WS_HIDV = WS_HIDK + 1 * MiB;
constexpr size_t WS_GATES = WS_HIDV + 1 * MiB;
constexpr size_t WS_XN = 60 * MiB;
constexpr size_t WS_YB = 92 * MiB;
constexpr size_t WS_D = 124 * MiB;
constexpr size_t WS_HB = WS_D;
constexpr size_t WS_QB = WS_D;
constexpr size_t WS_KS = WS_D + 16 * MiB;
constexpr size_t WS_KW = WS_D + 20 * MiB;
constexpr size_t WS_KCR = WS_D + 24 * MiB;
constexpr size_t WS_VCR = WS_D + 29 * MiB;
constexpr size_t WS_VST = WS_D + 34 * MiB;
constexpr size_t WS_VWT = WS_D + 38 * MiB;
constexpr size_t WS_RKVA = WS_D + 42 * MiB;
constexpr size_t WS_PRL = WS_D + 106 * MiB;
constexpr size_t WS_AGG = WS_D + 114 * MiB;
constexpr size_t WS_BONUS = WS_KCR;
constexpr size_t WS_END = 256 * MiB;
constexpr size_t WS_QM = WS_D;
constexpr size_t WS_OM = WS_D + 32 * MiB;
constexpr size_t WS_MK = WS_D + 64 * MiB;
constexpr size_t WS_MVT = WS_D + 65 * MiB;
static_assert(WS_GATES + (size_t)M_ * 24 * 4 <= WS_XN, "ws map");
static_assert(WS_AGG + 16 * MiB <= WS_END, "ws map");

struct Params {
    const float* in[41];
    float* out;
    unsigned char* ws;
};
enum { I_X = 0, I_MEM, I_F1_PRE, I_F1_WG, I_F1_WU, I_F1_WD, I_F1_POST, I_MIX_PRE, I_WIN, I_PE_K, I_W1_K, I_W2_K, I_PE_V, I_W1_V, I_W2_V,
       I_NSA_G, I_MU, I_W0, I_W2, I_A0, I_A2, I_G2, I_KK, I_KA, I_RK, I_GNG, I_GNB, I_WOUT, I_MIX_POST, I_MEM_PRE, I_MEM_KVG, I_WQ, I_WK, I_WV,
       I_WO, I_MEM_POST, I_F2_PRE, I_F2_WG, I_F2_WU, I_F2_WD, I_F2_POST };

struct MapPlain { const float* W; int N; int pad; __device__ const float* col(int p) const { return W + p; } };
struct MapGU {
    const float* Wg; const float* Wu; int N; int pad;
    __device__ const float* col(int p) const {
        const int pn = p >> 8, q = p & 255, n = (q >> 4) & 1;
        const int hid = 128 * pn + 64 * (q >> 7) + 16 * ((q >> 5) & 3) + (q & 15);
        return Wg + (size_t)n * (size_t)(Wu - Wg) + hid;
    }
};
__host__ __device__ inline int rope_perm(int x) { return 16 * ((x >> 5) & 1) + (x & 15) + 32 * ((x >> 4) & 1); }
struct MapWin {
    const float* W; int N; int pad;
    __device__ const float* col(int p) const {
        int l;
        if (p < 512) l = (p & ~63) + rope_perm(p & 63);
        else if (p < 640) l = 768 + ((p - 512) & ~63) + rope_perm(p & 63);
        else if (p < 768) l = 1024 + ((p - 640) & ~63) + rope_perm(p & 63);
        else if (p < 896) l = 512 + (p - 768);
        else if (p < 1024) l = 640 + (p - 896);
        else if (p < 1152) l = 896 + (p - 1024);
        else if (p < 1280) l = 1152 + (p - 1152);
        else if (p < 2304) { const int q = p - 1280; l = 1304 + (((q >> 4) & 1) ? 512 : 0) + 16 * (q >> 5) + (q & 15); }
        else if (p < 3072) l = 1304 + (p - 1280);
        else if (p < 3096) l = 1280 + (p - 3072);
        else return nullptr;
        return W + l;
    }
};

#define FOR_VB(vb, n) for (int vb = (int)blockIdx.x * 2 + (T512 >> 8); vb < (n); vb += (int)gridDim.x * 2)

template <class Map> __device__ __forceinline__ void d_convert(bf16* WT, int Np, int K, Map map) {
    const int T512 = tidx(), tid = T512 & 255, nbx = Np / 64, nb = nbx * (K / 64);
    FOR_VB(vb, nb) {
        const int p = (vb % nbx) * 64 + (tid & 63), k0 = (vb / nbx) * 64 + (tid >> 6) * 16;
        const float* src = map.col(p);
        float v[16];
#pragma unroll
        for (int i = 0; i < 16; ++i) v[i] = src ? src[(size_t)(k0 + i) * map.N] : 0.f;
        u32x4 a, b;
        a.x = pk2(v[0], v[1]); a.y = pk2(v[2], v[3]); a.z = pk2(v[4], v[5]); a.w = pk2(v[6], v[7]);
        b.x = pk2(v[8], v[9]); b.y = pk2(v[10], v[11]); b.z = pk2(v[12], v[13]); b.w = pk2(v[14], v[15]);
        u32x4* dst = (u32x4*)(WT + (size_t)p * K + k0);
        dst[0] = a; dst[1] = b;
    }
}
__device__ __forceinline__ void d_convert_lora(bf16* WT, const float* w2, const float* a2, const float* g2) {
    const int T512 = tidx(), tid = T512 & 255;
    FOR_VB(vb, NLORA * KLORA / 256) {
        const int idx = vb * 256 + tid, p = idx >> 8, k = idx & 255;
        float v = 0.f;
        if (p < 512) { if (k < 64) v = w2[k * 512 + p]; }
        else if (p < 1024) { if (k >= 64 && k < 128) v = a2[(k - 64) * 512 + (p - 512)]; }
        else { if (k >= 128) v = g2[(k - 128) * 512 + (p - 1024)]; }
        WT[idx] = (bf16)f2bf(v);
    }
}
__device__ __forceinline__ void d_rope_table(float* tab) {
    const int T512 = tidx(), tid = T512 & 255;
    FOR_VB(vb, T_ * 32 / 256) {
        const int idx = vb * 256 + tid, pos = idx >> 5, i = idx & 31;
        const float inv = (float)pow(10000.0, -(double)i / 32.0);
        const float ang = (float)pos * inv;
        tab[2 * idx] = (float)cos((double)ang); tab[2 * idx + 1] = (float)sin((double)ang);
    }
}
__device__ __forceinline__ void d_cmp_bias(const float* pe_k, const float* w1_k, const float* pe_v, const float* w1_v, float* bias, float* red  ) {
    for (int job = blockIdx.x; job < 8; job += gridDim.x) {
        const int kv = job >> 2; const float* pe = kv ? pe_v : pe_k; const float* w1 = kv ? w1_v : w1_k;
        const int T512 = tidx(), lane = T512 & 63, w = T512 >> 6, n = (job & 3) * 64 + lane;
        float s = 0.f;
        for (int j = w * 256; j < w * 256 + 256; ++j) s += pe[j] * w1[(size_t)j * 256 + n];
        red[w * 64 + lane] = s; __syncthreads();
        if (w == 0) { float t = 0.f; for (int i = 0; i < 8; ++i) t += red[i * 64 + lane]; bias[kv * 256 + n] = t; }
        __syncthreads();
    }
}
__device__ __forceinline__ void d_rownorm(const float* x, const float* g, bf16* xn, int rows) {
    const int T512 = tidx(), tid = T512 & 255, lane = tid & 63;
    FOR_VB(vb, rows / 4) {
        const int row = vb * 4 + (tid >> 6);
        const f32x4* xr = (const f32x4*)(x + (size_t)row * DM) + lane; f32x4 v[4]; float s = 0.f;
#pragma unroll
        for (int j = 0; j < 4; ++j) { v[j] = xr[64 * j]; s += v[j][0] * v[j][0] + v[j][1] * v[j][1] + v[j][2] * v[j][2] + v[j][3] * v[j][3]; }
        const float rstd = rsqrtf(wave_sum(s) * (1.f / DM) + NORM_EPS);
#pragma unroll
        for (int j = 0; j < 4; ++j) { const f32x4 gg = ((const f32x4*)g)[lane + 64 * j]; st_bf4(xn + (size_t)row * DM + 4 * (lane + 64 * j), v[j] * rstd * gg); }
    }
}
__device__ __forceinline__ void d_rowpass(const float* xin, const bf16* y, const float* gpost, float coef, const float* gpre, float* xout, bf16* xn) {
    const int T512 = tidx(), tid = T512 & 255, lane = tid & 63;
    FOR_VB(vb, M_ / 4) {
        const int row = vb * 4 + (tid >> 6);
        f32x4 yv[4], xv[4]; float s = 0.f;
#pragma unroll
        for (int j = 0; j < 4; ++j) {
            const u32x2 w = *(const u32x2*)(y + (size_t)row * DM + 4 * (lane + 64 * j));
            yv[j][0] = __builtin_bit_cast(float, w.x << 16); yv[j][1] = __builtin_bit_cast(float, w.x & 0xffff0000u);
            yv[j][2] = __builtin_bit_cast(float, w.y << 16); yv[j][3] = __builtin_bit_cast(float, w.y & 0xffff0000u);
            s += yv[j][0] * yv[j][0] + yv[j][1] * yv[j][1] + yv[j][2] * yv[j][2] + yv[j][3] * yv[j][3];
            xv[j] = ((const f32x4*)(xin + (size_t)row * DM))[lane + 64 * j];
        }
        const float rstd = rsqrtf(wave_sum(s) * (1.f / DM) + NORM_EPS) * coef; float s2 = 0.f;
#pragma unroll
        for (int j = 0; j < 4; ++j) { const f32x4 gg = ((const f32x4*)gpost)[lane + 64 * j]; xv[j] = xv[j] + yv[j] * rstd * gg;
            s2 += xv[j][0] * xv[j][0] + xv[j][1] * xv[j][1] + xv[j][2] * xv[j][2] + xv[j][3] * xv[j][3];
            ((f32x4*)(xout + (size_t)row * DM))[lane + 64 * j] = xv[j]; }
        if (gpre) {
            const float r2 = rsqrtf(wave_sum(s2) * (1.f / DM) + NORM_EPS);
#pragma unroll
            for (int j = 0; j < 4; ++j) { const f32x4 gg = ((const f32x4*)gpre)[lane + 64 * j]; st_bf4(xn + (size_t)row * DM + 4 * (lane + 64 * j), xv[j] * r2 * gg); }
        }
    }
}
__device__ __forceinline__ void d_nsa_outnorm(bf16* amix, const float* g) {
    const int T512 = tidx(), tid = T512 & 255, lane = tid & 63;
    FOR_VB(vb, M_ / 4) {
        const int row = vb * 4 + (tid >> 6);
        bf16* p = amix + (size_t)row * DM + 8 * lane;
        const u32x4 w = *(const u32x4*)p; float v[8]; float s = 0.f;
        v[0] = __builtin_bit_cast(float, w.x << 16); v[1] = __builtin_bit_cast(float, w.x & 0xffff0000u);
        v[2] = __builtin_bit_cast(float, w.y << 16); v[3] = __builtin_bit_cast(float, w.y & 0xffff0000u);
        v[4] = __builtin_bit_cast(float, w.z << 16); v[5] = __builtin_bit_cast(float, w.z & 0xffff0000u);
        v[6] = __builtin_bit_cast(float, w.w << 16); v[7] = __builtin_bit_cast(float, w.w & 0xffff0000u);
#pragma unroll
        for (int i = 0; i < 8; ++i) s += v[i] * v[i];
        const float rstd = rsqrtf(wave_sum(s) * (1.f / 512.f) + NORM_EPS);
        u32x4 o; const float* gg = g + 8 * lane;
        o.x = pk2(v[0] * rstd * gg[0], v[1] * rstd * gg[1]); o.y = pk2(v[2] * rstd * gg[2], v[3] * rstd * gg[3]);
        o.z = pk2(v[4] * rstd * gg[4], v[5] * rstd * gg[5]); o.w = pk2(v[6] * rstd * gg[6], v[7] * rstd * gg[7]);
        *(u32x4*)p = o;
    }
}

struct EpiStore { bf16* O; int ldc; float scale;
    static constexpr int NCAT = 1;
    __device__ __forceinline__ int cat(int) const { return 0; }
    template <int C> __device__ __forceinline__ void apply(int row, int p, f32x4 v0, f32x4 v1) const { bf16* o = O + (size_t)row * ldc + p; st_bf4(o, v0 * scale); st_bf4(o + 16, v1 * scale); } };
struct EpiSwiGLU { bf16* H;
    static constexpr int NCAT = 1;
    __device__ __forceinline__ int cat(int) const { return 0; }
    template <int C> __device__ __forceinline__ void apply(int row, int p, f32x4 g, f32x4 u) const {
        const int q = p & 255, hid = 128 * (p >> 8) + 64 * (q >> 7) + 16 * ((q >> 5) & 3) + (q & 15);
        f32x4 h;
#pragma unroll
        for (int e = 0; e < 4; ++e) h[e] = g[e] / (1.f + __expf(-g[e])) * u[e];
        st_bf4(H + (size_t)row * FF + hid, h); } };
struct EpiBiasSilu { bf16* O; const float* bias;
    static constexpr int NCAT = 1;
    __device__ __forceinline__ int cat(int) const { return 0; }
    template <int C> __device__ __forceinline__ void apply(int row, int p, f32x4 v0, f32x4 v1) const {
        f32x4 a, b; const f32x4 b0 = *(const f32x4*)(bias + p), b1 = *(const f32x4*)(bias + p + 16);
#pragma unroll
        for (int e = 0; e < 4; ++e) { const float x0 = v0[e] + b0[e], x1 = v1[e] + b1[e]; a[e] = x0 / (1.f + __expf(-x0)); b[e] = x1 / (1.f + __expf(-x1)); }
        bf16* o = O + (size_t)row * 256 + p; st_bf4(o, a); st_bf4(o + 16, b); } };
struct EpiLora { float* wdec; bf16* aga; bf16* agg; const float* w0; const float* a0;
    static constexpr int NCAT = 3;
    __device__ __forceinline__ int cat(int p0) const { return p0 < 512 ? 0 : (p0 < 1024 ? 1 : 2); }
    template <int C> __device__ __forceinline__ void one(int row, int p, f32x4 v) const {
        if (C == 0) { f32x4 o; const f32x4 ww = *(const f32x4*)(w0 + p);
#pragma unroll
            for (int e = 0; e < 4; ++e) o[e] = __expf(-0.6065306597126334f * sigmoidf_(ww[e] + v[e]));
            *(f32x4*)(wdec + (size_t)row * 512 + p) = o;
        } else if (C == 1) { f32x4 o; const f32x4 aa = *(const f32x4*)(a0 + p - 512);
#pragma unroll
            for (int e = 0; e < 4; ++e) o[e] = sigmoidf_(aa[e] + v[e]);
            st_bf4(aga + (size_t)row * 512 + (p - 512), o);
        } else st_bf4(agg + (size_t)row * 512 + (p - 1024), v);
    }
    template <int C> __device__ __forceinline__ void apply(int row, int p, f32x4 v0, f32x4 v1) const { one<C>(row, p, v0); one<C>(row, p + 16, v1); } };
struct EpiWin {
    bf16 *qb, *ks, *kw, *kcr, *vcr, *vst, *vwt; unsigned* rk; bf16 *vv, *prl; float* gates; const float* rope;
    static constexpr int NCAT = 8;
    __device__ __forceinline__ int cat(int p0) const { return p0 < 512 ? 0 : (p0 < 768 ? 1 : (p0 < 1024 ? 2 : (p0 < 1280 ? 3 : (p0 < 2304 ? 4 : (p0 < 2816 ? 7 : (p0 < 3072 ? 6 : 5)))))); }
    template <int C> __device__ __forceinline__ void apply(int row, int p, f32x4 v0, f32x4 v1) const {
        const int b = row / T_, t = row % T_;
        if (C == 0 || C == 1) {
            const int x = p & 63, d = 16 * ((x >> 5) & 1) + (x & 15);
            const f32x4* rp = (const f32x4*)(rope + ((size_t)t * 32 + d) * 2); const f32x4 r0 = rp[0], r1 = rp[1];
            const f32x4 cs = {r0[0], r0[2], r1[0], r1[2]}, sn = {r0[1], r0[3], r1[1], r1[3]};
            const f32x4 lo = v0 * cs - v1 * sn, hi = v0 * sn + v1 * cs;
            if (C == 0) { bf16* o = qb + (size_t)row * 512 + (p & ~63) + d; st_bf4(o, lo * QSCALE); st_bf4(o + 32, hi * QSCALE); }
            else { const int g = ((p - 512) >> 6) & 1; bf16* base = (p < 640) ? ks : kw; bf16* o = base + ((size_t)(b * 2 + g) * T_ + t) * 64 + d; st_bf4(o, lo); st_bf4(o + 32, hi); }
        } else if (C == 2) {
            const int c = (p - 768) & 127, g = c >> 6, d = c & 63; bf16* base = (p < 896) ? kcr : vcr;
            bf16* o = base + ((size_t)(b * 2 + g) * T_ + t) * 64 + d; st_bf4(o, v0); st_bf4(o + 16, v1);
        } else if (C == 3) {
            const int c = (p - 1024) & 127, g = c >> 6, d = c & 63; bf16* base = (p < 1152) ? vst : vwt;
            bf16* o = base + ((size_t)(b * 2 + g) * 64 + d) * T_ + t;
#pragma unroll
            for (int e = 0; e < 4; ++e) { o[(size_t)e * T_] = (bf16)f2bf(v0[e]); o[(size_t)(16 + e) * T_] = (bf16)f2bf(v1[e]); }
        } else if (C == 4) {
            const int q = p - 1280, ch = 16 * (q >> 5) + (q & 15);
            u32x4 w; w.x = pk2(v0[0], v1[0]); w.y = pk2(v0[1], v1[1]); w.z = pk2(v0[2], v1[2]); w.w = pk2(v0[3], v1[3]);
            *(u32x4*)(rk + (size_t)row * 512 + ch) = w;
        } else if (C == 7) {
            bf16* o = vv + (size_t)row * 512 + (p - 2304); st_bf4(o, v0); st_bf4(o + 16, v1);
        } else if (C == 6) {
            bf16* o = prl + (size_t)row * 256 + (p - 2816); st_bf4(o, v0); st_bf4(o + 16, v1);
        } else {
            const int c = p - 3072; float* o = gates + (size_t)row * 24 + c;
            if (c < 24) { f32x4 s = {sigmoidf_(v0[0]), sigmoidf_(v0[1]), sigmoidf_(v0[2]), sigmoidf_(v0[3])}; *(f32x4*)o = s; }
            if (c + 16 < 24) { f32x4 s = {sigmoidf_(v1[0]), sigmoidf_(v1[1]), sigmoidf_(v1[2]), sigmoidf_(v1[3])}; *(f32x4*)(o + 16) = s; }
        }
    }
};

namespace pg8 {
#define PG8_LAS __attribute__((address_space(3)))
typedef unsigned short bf16_t;
typedef short bf16x8 __attribute__((ext_vector_type(8)));
typedef float f32x4 __attribute__((ext_vector_type(4)));
typedef unsigned u32x4 __attribute__((ext_vector_type(4)));
constexpr int BM = 256, BK = 64, HALF = 128, HTB = HALF * BK * 2  , STAGE_BYTES = 8 * HTB, NXCD = 8, WGM = 8;

__host__ __device__ __forceinline__ int lds_byte(int r, int c) { const int st = (r >> 4) * 2 + (c >> 5), rr = r & 15, cc = c & 31, ob = rr * 64 + cc * 2; return st * 1024 + (ob ^ (((ob >> 9) & 1) << 5)); }
__host__ __device__ __forceinline__ void stage_rc(int b, int& R, int& C) { const int st = b / 1024, sb = b % 1024, swz = sb ^ (((sb >> 9) & 1) << 5); R = (st >> 1) * 16 + swz / 64; C = (st & 1) * 32 + (swz % 64) / 2; }
__host__ __device__ __forceinline__ int perm32(int rho) { const int n = rho >> 4, i = rho & 15; return 8 * (i >> 2) + 4 * n + (i & 3); }

struct Unit { int pm, pn; };
struct Gemm { const bf16_t* A; const bf16_t* Bt; int M, N, K, lda, ldb; };

struct StaticOrder {
    int nM, nN, nwg, G, c;
    __host__ __device__ void init(int M, int N, int G_, int c_) { nM = M / BM; nN = N / BM; nwg = nM * nN; G = G_; c = c_; }
    __host__ __device__ bool next(int i, Unit& u) const {
        const long L = (long)i * G + c; if (L >= nwg) return false;
        int wgid = (int)L; { const int q = nwg / NXCD, r = nwg % NXCD, xcd = wgid % NXCD, off = wgid / NXCD; wgid = (xcd < r ? xcd * (q + 1) : r * (q + 1) + (xcd - r) * q) + off; }
        const int nig = WGM * nN, gid = wgid / nig, fm = gid * WGM, gsz = (nM - fm) < WGM ? (nM - fm) : WGM;
        u.pm = fm + ((wgid % nig) % gsz); u.pn = (wgid % nig) / gsz; return true;
    }
    __device__ __forceinline__ void a_ready(const Unit&) const {}
    __device__ __forceinline__ void done(const Unit&) const {}
};

template <class Epi, class Sched, bool ALIGN_EPI = false, bool SP2 = false>
__device__ __forceinline__ void gemm_phase(PG8_LAS unsigned char* lds, const Gemm g, const Sched& S, const Epi& E) {
    const int tid = tidx(), wid = __builtin_amdgcn_readfirstlane(tid >> 6), lane = tid & 63, wr = wid >> 2, wc = wid & 3, fr = lane & 15, fq = lane >> 4;
    const int K = g.K, nt = K / BK;
    unsigned voffA[2], voffB[2];
#pragma unroll
    for (int i = 0; i < 2; ++i) { int R, C; stage_rc(tid * 16 + i * 8192, R, C); const int Rb = Epi::PERM ? ((R & ~31) + perm32(R & 31)) : R;
        voffA[i] = (unsigned)(R * g.lda + C) * 2u; voffB[i] = (unsigned)(Rb * g.ldb + C) * 2u; }
    const size_t kstep = (size_t)(BK * 2);
    const size_t hstepA = (size_t)HALF * g.lda * 2, hstepB = (size_t)HALF * g.ldb * 2;
    const size_t tstepA = 2 * hstepA, tstepB = 2 * hstepB;
    const unsigned ldsw = (unsigned)wid * 1024u;
    const int aoff = lds_byte(wr * 64 + fr, fq * 8), boff = lds_byte(wc * 32 + fr, fq * 8);
#define PG8_SA(b, h) (((b) * 2 + (h)) * HTB)
#define PG8_SB(b, h) ((4 + (b) * 2 + (h)) * HTB)
#define PG8_STAGE(bufoff, gbase, voff) do { _Pragma("unroll") for (int _i = 0; _i < 2; ++_i) \
        __builtin_amdgcn_global_load_lds((const unsigned*)((const char*)(gbase) + (voff)[_i]), (PG8_LAS unsigned*)(lds + (bufoff) + ldsw + _i * 8192), 16, 0, 0); } while (0)
#define PG8_LDA(dst, b, h) do { _Pragma("unroll") for (int m = 0; m < 4; ++m) _Pragma("unroll") for (int k = 0; k < 2; ++k) dst[m][k] = *(const PG8_LAS bf16x8*)(lds + PG8_SA(b, h) + aoff + m * 2048 + k * 1024); } while (0)
#define PG8_LDB(dst, b, h) do { _Pragma("unroll") for (int n = 0; n < 2; ++n) _Pragma("unroll") for (int k = 0; k < 2; ++k) dst[n][k] = *(const PG8_LAS bf16x8*)(lds + PG8_SB(b, h) + boff + n * 2048 + k * 1024); } while (0)
#define PG8_MMA(ai, bj, At, Bt) do { __builtin_amdgcn_s_setprio(1); _Pragma("unroll") for (int m = 0; m < 4; ++m) _Pragma("unroll") for (int n = 0; n < 2; ++n) _Pragma("unroll") for (int k = 0; k < 2; ++k) \
        acc[ai][bj][m][n] = __builtin_amdgcn_mfma_f32_16x16x32_bf16(Bt[n][k], At[m][k], acc[ai][bj][m][n], 0, 0, 0); __builtin_amdgcn_s_setprio(0); } while (0)
#define PG8_WAIT_V(n) asm volatile("s_waitcnt vmcnt(" #n ")" ::: "memory")
#define PG8_WAIT_L(n) asm volatile("s_waitcnt lgkmcnt(" #n ")" ::: "memory")
#define PG8_BAR __builtin_amdgcn_s_barrier()
#define PG8_SCHED __builtin_amdgcn_sched_barrier(0)
    Unit cur, nxt; int ui = 0;
    if (!S.next(0, cur)) return;
    f32x4 acc[2][2][4][2];
#pragma unroll
    for (int a = 0; a < 2; ++a)
#pragma unroll
        for (int b = 0; b < 2; ++b)
#pragma unroll
            for (int m = 0; m < 4; ++m)
#pragma unroll
                for (int n = 0; n < 2; ++n) acc[a][b][m][n] = (f32x4){0.f, 0.f, 0.f, 0.f};
    bf16x8 At[4][2], B0[2][2], B1[2][2];
    const char* cA = (const char*)g.A + (size_t)cur.pm * tstepA; const char* cB = (const char*)g.Bt + (size_t)cur.pn * tstepB;
    S.a_ready(cur);
    if constexpr (SP2) {
        PG8_STAGE(PG8_SB(0, 0), cB, voffB); PG8_STAGE(PG8_SB(0, 1), cB + hstepB, voffB); PG8_STAGE(PG8_SA(0, 0), cA, voffA); PG8_STAGE(PG8_SA(0, 1), cA + hstepA, voffA);
        if (wr == 1) PG8_BAR;
        PG8_WAIT_V(2); PG8_BAR;
        PG8_STAGE(PG8_SB(1, 0), cB + kstep, voffB); PG8_STAGE(PG8_SA(1, 0), cA + kstep, voffA); PG8_STAGE(PG8_SB(1, 1), cB + hstepB + kstep, voffB);
        PG8_WAIT_V(6); PG8_BAR;
    } else {
        PG8_STAGE(PG8_SB(0, 0), cB, voffB); PG8_STAGE(PG8_SA(0, 0), cA, voffA); PG8_STAGE(PG8_SB(0, 1), cB + hstepB, voffB); PG8_STAGE(PG8_SA(0, 1), cA + hstepA, voffA);
        if (wr == 1) PG8_BAR;
        PG8_WAIT_V(4); PG8_BAR;
        PG8_STAGE(PG8_SB(1, 0), cB + kstep, voffB); PG8_STAGE(PG8_SA(1, 0), cA + kstep, voffA); PG8_STAGE(PG8_SB(1, 1), cB + hstepB + kstep, voffB);
        PG8_WAIT_V(6); PG8_BAR;
    }
    for (;;) {
        const bool has_next = S.next(ui + 1, nxt);
        const char* nA = has_next ? (const char*)g.A + (size_t)nxt.pm * tstepA : cA; const char* nB = has_next ? (const char*)g.Bt + (size_t)nxt.pn * tstepB : cB;
        for (int t = 0; t < nt; t += 2) {
            const bool last = (t == nt - 2);
            const char* a1 = cA + (size_t)(t + 1) * kstep;
            const char* a2 = last ? nA : cA + (size_t)(t + 2) * kstep; const char* b2 = last ? nB : cB + (size_t)(t + 2) * kstep;
            const char* a3 = a2 + kstep; const char* b3 = b2 + kstep;
            if (last && has_next) S.a_ready(nxt);
            if constexpr (SP2) {
            PG8_LDB(B0, 0, 0); PG8_LDB(B1, 0, 1); PG8_SCHED; PG8_LDA(At, 0, 0); PG8_STAGE(PG8_SA(1, 1), a1 + hstepA, voffA);
            PG8_WAIT_V(8); PG8_WAIT_L(0); PG8_BAR; PG8_MMA(0, 0, At, B0); PG8_MMA(0, 1, At, B1); PG8_BAR; PG8_SCHED;
            PG8_LDA(At, 0, 1); PG8_STAGE(PG8_SB(0, 0), b2, voffB); PG8_STAGE(PG8_SB(0, 1), b2 + hstepB, voffB); PG8_STAGE(PG8_SA(0, 0), a2, voffA);
            PG8_WAIT_V(8); PG8_WAIT_L(0); PG8_BAR; PG8_MMA(1, 0, At, B0); PG8_MMA(1, 1, At, B1); PG8_BAR; PG8_SCHED;
            PG8_LDB(B0, 1, 0); PG8_LDB(B1, 1, 1); PG8_SCHED; PG8_LDA(At, 1, 0); PG8_STAGE(PG8_SA(0, 1), a2 + hstepA, voffA);
            PG8_WAIT_V(8); PG8_WAIT_L(0); PG8_BAR; PG8_MMA(0, 0, At, B0); PG8_MMA(0, 1, At, B1); PG8_BAR; PG8_SCHED;
            PG8_LDA(At, 1, 1); PG8_STAGE(PG8_SB(1, 0), b3, voffB); PG8_STAGE(PG8_SB(1, 1), b3 + hstepB, voffB); PG8_STAGE(PG8_SA(1, 0), a3, voffA);
            PG8_WAIT_V(8); PG8_WAIT_L(0); PG8_BAR; PG8_MMA(1, 0, At, B0); PG8_MMA(1, 1, At, B1); PG8_BAR; PG8_SCHED;
            } else {
            PG8_LDB(B0, 0, 0); PG8_SCHED; PG8_LDA(At, 0, 0); PG8_STAGE(PG8_SA(1, 1), a1 + hstepA, voffA);
            PG8_WAIT_L(8); PG8_BAR; PG8_WAIT_L(0); PG8_MMA(0, 0, At, B0); PG8_BAR; PG8_SCHED;
            PG8_LDB(B1, 0, 1); PG8_STAGE(PG8_SB(0, 0), b2, voffB);
            PG8_BAR; PG8_WAIT_L(0); PG8_MMA(0, 1, At, B1); PG8_BAR;
            PG8_LDA(At, 0, 1); PG8_STAGE(PG8_SA(0, 0), a2, voffA);
            PG8_BAR; PG8_WAIT_L(0); PG8_MMA(1, 0, At, B0); PG8_BAR; PG8_SCHED;
            PG8_STAGE(PG8_SB(0, 1), b2 + hstepB, voffB);
            PG8_WAIT_V(6); PG8_BAR; PG8_MMA(1, 1, At, B1); PG8_BAR;
            PG8_LDB(B0, 1, 0); PG8_SCHED; PG8_LDA(At, 1, 0); PG8_STAGE(PG8_SA(0, 1), a2 + hstepA, voffA);
            PG8_WAIT_L(8); PG8_BAR; PG8_WAIT_L(0); PG8_MMA(0, 0, At, B0); PG8_BAR; PG8_SCHED;
            PG8_LDB(B1, 1, 1); PG8_STAGE(PG8_SB(1, 0), b3, voffB);
            PG8_BAR; PG8_WAIT_L(0); PG8_MMA(0, 1, At, B1); PG8_BAR;
            PG8_LDA(At, 1, 1); PG8_STAGE(PG8_SA(1, 0), a3, voffA);
            PG8_BAR; PG8_WAIT_L(0); PG8_MMA(1, 0, At, B0); PG8_BAR; PG8_SCHED;
            PG8_STAGE(PG8_SB(1, 1), b3 + hstepB, voffB);
            PG8_WAIT_V(6); PG8_BAR; PG8_MMA(1, 1, At, B1); PG8_BAR;
            }
        }
        if constexpr (ALIGN_EPI) { if (wr == 0) PG8_BAR; }
        if constexpr (!Epi::AFTER_DRAIN) { E(acc, cur, wr, wc, fr, fq); S.done(cur); }
        if (!has_next) break;
#pragma unroll
        for (int a = 0; a < 2; ++a)
#pragma unroll
            for (int b = 0; b < 2; ++b)
#pragma unroll
                for (int m = 0; m < 4; ++m)
#pragma unroll
                    for (int n = 0; n < 2; ++n) acc[a][b][m][n] = (f32x4){0.f, 0.f, 0.f, 0.f};
        cur = nxt; cA = nA; cB = nB; ++ui;
        if constexpr (ALIGN_EPI) { if (wr == 1) PG8_BAR; }
    }
    PG8_WAIT_V(0);
    if constexpr (!ALIGN_EPI) { if (wr == 0) PG8_BAR; }
    PG8_BAR;
    if constexpr (Epi::AFTER_DRAIN) { E.fused(acc, cur, wr, wc, fr, fq, lds, wid, lane); S.done(cur); }
#undef PG8_SA
#undef PG8_SB
#undef PG8_STAGE
#undef PG8_LDA
#undef PG8_LDB
#undef PG8_MMA
#undef PG8_WAIT_V
#undef PG8_WAIT_L
#undef PG8_BAR
#undef PG8_SCHED
}
}

template <class F> struct EpiQuad {
    static constexpr bool PERM = false, AFTER_DRAIN = false;
    F f;
    template <int C, int BJ> __device__ __forceinline__ void half(const pg8::f32x4 (&acc)[2][2][4][2], int row0, int p) const {
#pragma unroll
        for (int ai = 0; ai < 2; ++ai)
#pragma unroll
            for (int m = 0; m < 4; ++m) { f.template apply<C>(row0 + ai * 128 + m * 16, p, acc[ai][BJ][m][0], acc[ai][BJ][m][1]); asm volatile("" ::: "memory"); }
    }
    template <int BJ> __device__ __forceinline__ void disp(const pg8::f32x4 (&acc)[2][2][4][2], int row0, int p0, int p) const {
        const int c = f.cat(p0);
        if (F::NCAT == 1 || c == 0) half<0, BJ>(acc, row0, p);
        else if (F::NCAT > 1 && c == 1) half<(F::NCAT > 1 ? 1 : 0), BJ>(acc, row0, p);
        else if (F::NCAT > 2 && c == 2) half<(F::NCAT > 2 ? 2 : 0), BJ>(acc, row0, p);
        else if (F::NCAT > 3 && c == 3) half<(F::NCAT > 3 ? 3 : 0), BJ>(acc, row0, p);
        else if (F::NCAT > 4 && c == 4) half<(F::NCAT > 4 ? 4 : 0), BJ>(acc, row0, p);
        else if (F::NCAT > 5 && c == 5) half<(F::NCAT > 5 ? 5 : 0), BJ>(acc, row0, p);
        else if (F::NCAT > 6 && c == 6) half<(F::NCAT > 6 ? 6 : 0), BJ>(acc, row0, p);
        else if (F::NCAT > 7) half<(F::NCAT > 7 ? 7 : 0), BJ>(acc, row0, p);
    }
    __device__ __forceinline__ void operator()(const pg8::f32x4 (&acc)[2][2][4][2], const pg8::Unit& u, int wr, int wc, int fr, int fq) const {
        const int row0 = u.pm * 256 + wr * 64 + fr, p0 = u.pn * 256;
        disp<0>(acc, row0, p0, p0 + wc * 32 + 4 * fq);
        disp<1>(acc, row0, p0 + 128, p0 + 128 + wc * 32 + 4 * fq);
    }
};
template <class F> __device__ __forceinline__ void gemm_pg8(unsigned char* lds, const bf16* A, int lda, const bf16* Bt, int ldb, int M, int N, int K, const F& f) {
    pg8::Gemm g{A, Bt, M, N, K, lda, ldb}; pg8::StaticOrder S; S.init(M, N, (int)gridDim.x, (int)blockIdx.x);
    EpiQuad<F> E{f};
    pg8::gemm_phase<EpiQuad<F>, pg8::StaticOrder, true, true>((PG8_LAS unsigned char*)lds, g, S, E);
}

__device__ __forceinline__ void d_cmp2(const bf16* hidk, const bf16* hidv, const float* w2k, const float* w2v, const float* rope, bf16* kc, bf16* vct) {
    const int T512 = tidx(), tid = T512 & 255;
    FOR_VB(vb, 2048 * 32 / 256) {
        const int idx = vb * 256 + tid; const int R = idx >> 5, i = idx & 31; const int bg = R >> 9, c = R & 511;
        float k0 = 0.f, k1 = 0.f, v0 = 0.f, v1 = 0.f;
        for (int n = 0; n < 256; ++n) { const float hk = bf2f(hidk[(size_t)R * 256 + n]), hv = bf2f(hidv[(size_t)R * 256 + n]);
            k0 += hk * w2k[n * 64 + i]; k1 += hk * w2k[n * 64 + i + 32]; v0 += hv * w2v[n * 64 + i]; v1 += hv * w2v[n * 64 + i + 32]; }
        const int pos = (16 * c + 31) & (T_ - 1);
        const float cs = rope[((size_t)pos * 32 + i) * 2], sn = rope[((size_t)pos * 32 + i) * 2 + 1];
        kc[(size_t)R * 64 + i] = (bf16)f2bf(k0 * cs - k1 * sn); kc[(size_t)R * 64 + i + 32] = (bf16)f2bf(k0 * sn + k1 * cs);
        vct[((size_t)bg * 64 + i) * NCP + c] = (bf16)f2bf(v0); vct[((size_t)bg * 64 + i + 32) * NCP + c] = (bf16)f2bf(v1);
    }
}

struct NsaArgs { const bf16 *qb, *kc, *vct, *ks, *vst, *kw, *vwt; const float* gates; bf16* amix; };
__device__ __forceinline__ float dot64(const float* q, const bf16* k) {
    float s = 0.f;
#pragma unroll
    for (int i = 0; i < 8; ++i) { const u32x4 w = ((const u32x4*)k)[i];
        s += q[8 * i + 0] * __builtin_bit_cast(float, w.x << 16) + q[8 * i + 1] * __builtin_bit_cast(float, w.x & 0xffff0000u)
           + q[8 * i + 2] * __builtin_bit_cast(float, w.y << 16) + q[8 * i + 3] * __builtin_bit_cast(float, w.y & 0xffff0000u)
           + q[8 * i + 4] * __builtin_bit_cast(float, w.z << 16) + q[8 * i + 5] * __builtin_bit_cast(float, w.z & 0xffff0000u)
           + q[8 * i + 6] * __builtin_bit_cast(float, w.w << 16) + q[8 * i + 7] * __builtin_bit_cast(float, w.w & 0xffff0000u); }
    return s;
}
__device__ __forceinline__ void softmax_row(float* s, int n, int lane) {
    float m = -INFINITY; for (int i = lane; i < n; i += 64) m = fmaxf(m, s[i]);
    m = wave_max(m); if (m == -INFINITY) m = 0.f;
    float l = 0.f; for (int i = lane; i < n; i += 64) { const float e = exp2f(s[i] - m); s[i] = e; l += e; }
    l = wave_sum(l); const float inv = 1.f / fmaxf(l, 1e-30f);
    for (int i = lane; i < n; i += 64) s[i] *= inv;
}
__device__ __forceinline__ void d_nsa_simple(const NsaArgs& a, int vb, int tid, unsigned char* smem) {
    float (*qs)[64] = (float (*)[64])smem; float (*sc)[1024] = (float (*)[1024])(smem + 1024); float* imp = (float*)(smem + 17408); float* score = imp + 128;
    int* list = (int*)(score + 128); int* nlist = list + 16;
    const int bg = vb / T_, t = vb % T_, b = bg >> 1, g = bg & 1;
    const int r = tid >> 6, d = tid & 63, lane = d;
    const size_t row = (size_t)b * T_ + t;
    qs[r][d] = bf2f(a.qb[row * 512 + g * 256 + r * 64 + d]);
    if (tid == 0) *nlist = 0;
    __syncthreads();
    const int nv = t < 31 ? 0 : (t - 31) / 16 + 1;
    for (int c = tid; c < nv; c += 256) { const bf16* k = a.kc + ((size_t)bg * NCP + c) * 64;
        _Pragma("unroll 1") for (int rr = 0; rr < 4; ++rr) sc[rr][c] = dot64(qs[rr], k); }
    __syncthreads();
    softmax_row(sc[r], nv, lane);
    __syncthreads();
    float oc = 0.f; { const bf16* v = a.vct + ((size_t)bg * 64 + d) * NCP; for (int c = 0; c < nv; ++c) oc += sc[r][c] * bf2f(v[c]); }
    if (tid < 128) { const int s = tid; float acc = 0.f;
        for (int c = 4 * s - 1; c <= 4 * s + 3; ++c) if (c >= 0 && c < nv) acc += sc[0][c] + sc[1][c] + sc[2][c] + sc[3][c];
        imp[s] = acc; }
    __syncthreads();
    const int cur = t >> 6;
    if (tid < 128) { const int s = tid; const bool forced = (s == 0) || (s == cur) || (s == cur - 1);
        score[s] = forced ? 1e4f : (s <= cur ? imp[s] : -1e4f); }
    __syncthreads();
    if (tid < 128) { const int s = tid; const float my = score[s]; int rank = 0;
        for (int j = 0; j < 128; ++j) { const float o = score[j]; rank += (o > my || (o == my && j < s)) ? 1 : 0; }
        if (rank < 16 && s <= cur) { const int slot = atomicAdd(nlist, 1); list[slot] = s; } }
    __syncthreads();
    const int ns = *nlist * 64;
    for (int i = tid; i < ns; i += 256) { const int pos = list[i >> 6] * 64 + (i & 63);
        if (pos <= t) { const bf16* k = a.ks + ((size_t)bg * T_ + pos) * 64; _Pragma("unroll 1") for (int rr = 0; rr < 4; ++rr) sc[rr][i] = dot64(qs[rr], k); }
        else { sc[0][i] = -INFINITY; sc[1][i] = -INFINITY; sc[2][i] = -INFINITY; sc[3][i] = -INFINITY; } }
    __syncthreads();
    softmax_row(sc[r], ns, lane);
    __syncthreads();
    float os = 0.f; { const bf16* v = a.vst + ((size_t)bg * 64 + d) * T_;
        for (int i = 0; i < ns; ++i) { const int pos = list[i >> 6] * 64 + (i & 63); if (pos <= t) os += sc[r][i] * bf2f(v[pos]); } }
    __syncthreads();
    const int lo = t - 511 > 0 ? t - 511 : 0, nw = t - lo + 1;
    for (int i = tid; i < nw; i += 256) { const bf16* k = a.kw + ((size_t)bg * T_ + lo + i) * 64;
        _Pragma("unroll 1") for (int rr = 0; rr < 4; ++rr) sc[rr][i] = dot64(qs[rr], k); }
    __syncthreads();
    softmax_row(sc[r], nw, lane);
    __syncthreads();
    float ow = 0.f; { const bf16* v = a.vwt + ((size_t)bg * 64 + d) * T_ + lo; for (int i = 0; i < nw; ++i) ow += sc[r][i] * bf2f(v[i]); }
    const float* gt = a.gates + row * 24 + g * 12 + r * 3;
    a.amix[row * DM + g * 256 + r * 64 + d] = (bf16)f2bf(gt[0] * oc + gt[1] * os + gt[2] * ow);
    __syncthreads();
}


namespace nsa {
typedef float f32x16 __attribute__((ext_vector_type(16)));
constexpr int KROW = 144, VROW = 136, KBUF = 64 * KROW, VBUF = 64 * VROW;
constexpr int OFF_K = 0, OFF_V = 2 * KBUF, OFF_IMP = OFF_V + 2 * VBUF, IMPW = 130, OFF_SEL = OFF_IMP + 64 * IMPW * 4, OFF_UM = OFF_SEL + 1024, OFF_WS = OFF_UM + 16, OFF_UNIT = OFF_WS + 1024, LDS_NEED = OFF_UNIT + 16;
static_assert(OFF_IMP % 16 == 0 && OFF_SEL % 16 == 0 && OFF_WS % 16 == 0, "nsa lds map");
__device__ __forceinline__ int crow(int r, int hi) { return (r & 3) + 8 * (r >> 2) + 4 * hi; }
__device__ __forceinline__ int next_bit(unsigned m0, unsigned m1, unsigned m2, unsigned m3, int from) {
#pragma unroll
    for (int wd = 0; wd < 4; ++wd) {
        unsigned x = wd == 0 ? m0 : (wd == 1 ? m1 : (wd == 2 ? m2 : m3)); const int base = wd * 32;
        if (from < base + 32) { if (from > base) x &= (~0u) << (from - base); if (x) return base + __builtin_ctz(x); }
    }
    return 128;
}
__device__ __forceinline__ bf16x8 pack8(const f32x16& p, int b0) {
    u32x4 w; w.x = pk2(p[b0 + 0], p[b0 + 1]); w.y = pk2(p[b0 + 2], p[b0 + 3]); w.z = pk2(p[b0 + 4], p[b0 + 5]); w.w = pk2(p[b0 + 6], p[b0 + 7]);
    return __builtin_bit_cast(bf16x8, w);
}
struct Branch { const bf16* k; const bf16* vt; int ldv; };

template <int MODE, bool SEL>
__device__ __forceinline__ void run_branch(unsigned char* sm, const Branch br, unsigned m0, unsigned m1, unsigned m2, unsigned m3,
                                           const bf16x8 (&qf)[4], int lo, int hi_b, int lo_max, int hi_min, unsigned s0, unsigned s1, unsigned s2, unsigned s3,
                                           float& m, float& l, float invl, f32x16 (&o)[2], float* imp_row, float* wsc, int tid, int lane) {
    const int i = lane & 31, hi = lane >> 5;
    int j = next_bit(m0, m1, m2, m3, 0);
    u32x4 kr, vr;
    if (j < 128) {
        kr = *(const u32x4*)(br.k + (size_t)j * 4096 + tid * 8);
        if (MODE != 0) vr = *(const u32x4*)(br.vt + (size_t)(tid >> 3) * br.ldv + j * 64 + (tid & 7) * 8);
        *(u32x4*)(sm + OFF_K + (tid >> 3) * KROW + (tid & 7) * 16) = kr;
        if (MODE != 0) { unsigned char* vp = sm + OFF_V + (tid >> 3) * VROW + (tid & 7) * 16; *(u32x2*)vp = (u32x2){vr.x, vr.y}; *(u32x2*)(vp + 8) = (u32x2){vr.z, vr.w}; }
    }
    __syncthreads();
    int cb = 0;
    while (j < 128) {
        const int jn = next_bit(m0, m1, m2, m3, j + 1);
        if (jn < 128) {
            kr = *(const u32x4*)(br.k + (size_t)jn * 4096 + tid * 8);
            if (MODE != 0) vr = *(const u32x4*)(br.vt + (size_t)(tid >> 3) * br.ldv + jn * 64 + (tid & 7) * 8);
        }
        const unsigned char* kb = sm + OFF_K + cb * KBUF; const unsigned char* vb = sm + OFF_V + cb * VBUF;
        const int key0 = 64 * j;
        bool rowsel = true;
        if (SEL) { const unsigned wsel = j < 32 ? s0 : (j < 64 ? s1 : (j < 96 ? s2 : s3)); rowsel = (wsel >> (j & 31)) & 1u; }
        if (!SEL || __any(rowsel)) {
            const float cinit = rowsel ? 0.f : -INFINITY;
            f32x16 p0, p1;
#pragma unroll
            for (int r = 0; r < 16; ++r) { p0[r] = cinit; p1[r] = cinit; }
#pragma unroll
            for (int d0 = 0; d0 < 4; ++d0) {
                const bf16x8 a0 = *(const bf16x8*)(kb + i * KROW + (16 * d0 + 8 * hi) * 2);
                const bf16x8 a1 = *(const bf16x8*)(kb + (32 + i) * KROW + (16 * d0 + 8 * hi) * 2);
                p0 = __builtin_amdgcn_mfma_f32_32x32x16_bf16(a0, qf[d0], p0, 0, 0, 0);
                p1 = __builtin_amdgcn_mfma_f32_32x32x16_bf16(a1, qf[d0], p1, 0, 0, 0);
            }
            if (!(key0 >= lo_max && key0 + 63 <= hi_min)) {
#pragma unroll
                for (int r = 0; r < 16; ++r) { const int key = key0 + crow(r, hi);
                    if (key < lo || key > hi_b) p0[r] = -INFINITY;
                    if (key + 32 < lo || key + 32 > hi_b) p1[r] = -INFINITY; }
            }
            if (MODE == 1) {
#pragma unroll
                for (int r = 0; r < 16; ++r) { p0[r] = __builtin_amdgcn_exp2f(p0[r] - m) * invl; p1[r] = __builtin_amdgcn_exp2f(p1[r] - m) * invl; }
#pragma unroll
                for (int gq = 0; gq < 4; ++gq) {
                    float G0 = (p0[4 * gq] + p0[4 * gq + 1]) + (p0[4 * gq + 2] + p0[4 * gq + 3]), L0 = p0[4 * gq + 3];
                    float G1 = (p1[4 * gq] + p1[4 * gq + 1]) + (p1[4 * gq + 2] + p1[4 * gq + 3]), L1 = p1[4 * gq + 3];
                    G0 += __shfl_xor(G0, 1); L0 += __shfl_xor(L0, 1); G1 += __shfl_xor(G1, 1); L1 += __shfl_xor(L1, 1);
                    G0 += __shfl_xor(G0, 2); L0 += __shfl_xor(L0, 2); G1 += __shfl_xor(G1, 2); L1 += __shfl_xor(L1, 2);
                    if ((i & 3) == 0) { const int s = 16 * j + 2 * gq + hi;
                        atomicAdd(imp_row + s, G0); atomicAdd(imp_row + s + 1, L0); atomicAdd(imp_row + s + 8, G1); atomicAdd(imp_row + s + 9, L1); }
                }
            } else {
                float tm = fmaxf(p0[0], p1[0]);
#pragma unroll
                for (int r = 1; r < 16; ++r) tm = fmaxf(tm, fmaxf(p0[r], p1[r]));
                tm = fmaxf(tm, __shfl_xor(tm, 32));
                const float mn = fmaxf(m, tm), alpha = __builtin_amdgcn_exp2f(m - mn);
                m = mn; float rs = 0.f;
#pragma unroll
                for (int r = 0; r < 16; ++r) { p0[r] = __builtin_amdgcn_exp2f(p0[r] - mn); p1[r] = __builtin_amdgcn_exp2f(p1[r] - mn); rs += p0[r] + p1[r]; }
                l = l * alpha + rs;
                if (MODE == 2) {
                    if (hi == 0) wsc[i] = alpha;
                    asm volatile("" ::: "memory");
#pragma unroll
                    for (int rg = 0; rg < 4; ++rg) { const f32x4 a4 = *(const f32x4*)(wsc + 8 * rg + 4 * hi);
#pragma unroll
                        for (int e = 0; e < 4; ++e) { o[0][4 * rg + e] *= a4[e]; o[1][4 * rg + e] *= a4[e]; } }
                    asm volatile("" ::: "memory");
                }
            }
            if (MODE != 0) {
                const bf16x8 pf0 = pack8(p0, 0), pf1 = pack8(p0, 8), pf2 = pack8(p1, 0), pf3 = pack8(p1, 8);
#pragma unroll
                for (int dt = 0; dt < 2; ++dt) {
                    const unsigned char* vp = vb + (32 * dt + i) * VROW + 8 * hi;
#pragma unroll
                    for (int ks = 0; ks < 4; ++ks) {
                        const u32x2 v_lo = *(const u32x2*)(vp + 32 * ks), v_hi = *(const u32x2*)(vp + 32 * ks + 16);
                        const bf16x8 vf = __builtin_bit_cast(bf16x8, (u32x4){v_lo.x, v_lo.y, v_hi.x, v_hi.y});
                        o[dt] = __builtin_amdgcn_mfma_f32_32x32x16_bf16(ks == 0 ? pf0 : (ks == 1 ? pf1 : (ks == 2 ? pf2 : pf3)), vf, o[dt], 0, 0, 0);
                    }
                }
            }
        }
        if (jn < 128) {
            *(u32x4*)(sm + OFF_K + (cb ^ 1) * KBUF + (tid >> 3) * KROW + (tid & 7) * 16) = kr;
            if (MODE != 0) { unsigned char* vp = sm + OFF_V + (cb ^ 1) * VBUF + (tid >> 3) * VROW + (tid & 7) * 16; *(u32x2*)vp = (u32x2){vr.x, vr.y}; *(u32x2*)(vp + 8) = (u32x2){vr.z, vr.w}; }
        }
        __syncthreads();
        j = jn; cb ^= 1;
    }
}
__device__ __forceinline__ void add_scaled(f32x16 (&acc)[2], const f32x16 (&o)[2], float f, float* wsc, int i, int hi) {
    if (hi == 0) wsc[i] = f;
    asm volatile("" ::: "memory");
#pragma unroll
    for (int rg = 0; rg < 4; ++rg) { const f32x4 a4 = *(const f32x4*)(wsc + 8 * rg + 4 * hi);
#pragma unroll
        for (int e = 0; e < 4; ++e) { acc[0][4 * rg + e] += a4[e] * o[0][4 * rg + e]; acc[1][4 * rg + e] += a4[e] * o[1][4 * rg + e]; } }
    asm volatile("" ::: "memory");
}
__device__ __forceinline__ void unit(const NsaArgs& a, int u, unsigned char* sm) {
    const int tid = tidx(), lane = tid & 63, w = __builtin_amdgcn_readfirstlane(tid >> 6), i = lane & 31, hi = lane >> 5;
    const int cur = 127 - (u >> 2), bg = u & 3, b = bg >> 1, g = bg & 1, q0 = cur * 64;
    const int ql = 8 * w + (i >> 2), hd = i & 3, t = q0 + ql;
    const size_t grow = (size_t)b * T_ + t;
    bf16x8 qf[4];
    { const bf16* qp = a.qb + grow * 512 + g * 256 + hd * 64 + 8 * hi;
#pragma unroll
      for (int d0 = 0; d0 < 4; ++d0) qf[d0] = *(const bf16x8*)(qp + 16 * d0); }
    float* wsc = (float*)(sm + OFF_WS) + w * 32;
    float* imp = (float*)(sm + OFF_IMP);
    unsigned* selw = (unsigned*)(sm + OFF_SEL);
    unsigned* um = (unsigned*)(sm + OFF_UM);
    for (int k = tid; k < 64 * IMPW; k += 512) imp[k] = 0.f;
    if (tid < 4) um[tid] = 0u;
    const float* gt = a.gates + grow * 24 + g * 12 + hd * 3;
    const float gc = gt[0], gs = gt[1], gw = gt[2];
    f32x16 acc[2], o[2];
#pragma unroll
    for (int r = 0; r < 16; ++r) { acc[0][r] = 0.f; acc[1][r] = 0.f; }
    const int tw0 = q0 + 8 * w, tw1 = tw0 + 7;
    {
        const int nv = t < 31 ? 0 : (t - 31) / 16 + 1;
        const int nvw = tw0 < 31 ? 0 : (tw0 - 31) / 16 + 1;
        const int nvmax = (q0 + 63 - 31) / 16 + 1, ntc = (nvmax + 63) / 64;
        const unsigned cm0 = ntc >= 32 ? ~0u : ((1u << ntc) - 1u);
        const Branch br{a.kc + (size_t)bg * NCP * 64, a.vct + (size_t)bg * 64 * NCP, NCP};
        float m = -1e30f, l = 0.f;
        run_branch<0, false>(sm, br, cm0, 0u, 0u, 0u, qf, 0, nv - 1, 0, nvw - 1, 0u, 0u, 0u, 0u, m, l, 0.f, o, nullptr, wsc, tid, lane);
        l += __shfl_xor(l, 32);
        const float invl = 1.f / fmaxf(l, 1e-30f);
#pragma unroll
        for (int r = 0; r < 16; ++r) { o[0][r] = 0.f; o[1][r] = 0.f; }
        run_branch<1, false>(sm, br, cm0, 0u, 0u, 0u, qf, 0, nv - 1, 0, nvw - 1, 0u, 0u, 0u, 0u, m, l, invl, o, imp + ql * IMPW, wsc, tid, lane);
        add_scaled(acc, o, gc, wsc, i, hi);
    }
    {
        unsigned u0 = 0u, u1 = 0u, u2 = 0u, u3 = 0u;
        const int ncand = cur - 2;
        for (int qq = 0; qq < 8; ++qq) {
            unsigned k0 = 0u, k1 = 0u, k2 = 0u, k3 = 0u;
            if (ncand <= 13) {
#pragma unroll
                for (int wd = 0; wd < 4; ++wd) { const int nb = cur + 1 - 32 * wd; const unsigned x = nb >= 32 ? ~0u : (nb <= 0 ? 0u : ((1u << nb) - 1u));
                    if (wd == 0) k0 = x; else if (wd == 1) k1 = x; else if (wd == 2) k2 = x; else k3 = x; }
            } else {
                const float* ir = imp + (8 * w + qq) * IMPW;
                float v0 = (lane >= 1 && lane <= cur - 2) ? ir[lane] : -1.f;
                float v1 = (lane + 64 <= cur - 2) ? ir[lane + 64] : -1.f;
                for (int it = 0; it < 13; ++it) {
                    float bv = v0; int bs = lane;
                    if (v1 > v0) { bv = v1; bs = lane + 64; }
#pragma unroll
                    for (int off = 1; off < 64; off <<= 1) { const float ov = __shfl_xor(bv, off); const int os = __shfl_xor(bs, off);
                        if (ov > bv || (ov == bv && os < bs)) { bv = ov; bs = os; } }
                    bs = __builtin_amdgcn_readfirstlane(bs);
                    if (bs == lane) v0 = -1.f; if (bs == lane + 64) v1 = -1.f;
                    const unsigned bit = 1u << (bs & 31);
                    if (bs < 32) k0 |= bit; else if (bs < 64) k1 |= bit; else if (bs < 96) k2 |= bit; else k3 |= bit;
                }
                k0 |= 1u;
                { const int c1 = cur - 1; const unsigned bit = 1u << (c1 & 31); if (c1 < 32) k0 |= bit; else if (c1 < 64) k1 |= bit; else if (c1 < 96) k2 |= bit; else k3 |= bit; }
                { const unsigned bit = 1u << (cur & 31); if (cur < 32) k0 |= bit; else if (cur < 64) k1 |= bit; else if (cur < 96) k2 |= bit; else k3 |= bit; }
            }
            if (lane == 0) { unsigned* sp = selw + (8 * w + qq) * 4; sp[0] = k0; sp[1] = k1; sp[2] = k2; sp[3] = k3; }
            u0 |= k0; u1 |= k1; u2 |= k2; u3 |= k3;
        }
        if (lane == 0) { atomicOr(um + 0, u0); atomicOr(um + 1, u1); atomicOr(um + 2, u2); atomicOr(um + 3, u3); }
    }
    __syncthreads();
    {
        const unsigned U0 = um[0], U1 = um[1], U2 = um[2], U3 = um[3];
        const unsigned* sp = selw + ql * 4; const unsigned s0 = sp[0], s1 = sp[1], s2 = sp[2], s3 = sp[3];
        const Branch br{a.ks + (size_t)bg * T_ * 64, a.vst + (size_t)bg * 64 * T_, T_};
        float m = -1e30f, l = 0.f;
#pragma unroll
        for (int r = 0; r < 16; ++r) { o[0][r] = 0.f; o[1][r] = 0.f; }
        run_branch<2, true>(sm, br, __builtin_amdgcn_readfirstlane(U0), __builtin_amdgcn_readfirstlane(U1), __builtin_amdgcn_readfirstlane(U2), __builtin_amdgcn_readfirstlane(U3),
                            qf, 0, t, 0, tw0, s0, s1, s2, s3, m, l, 0.f, o, nullptr, wsc, tid, lane);
        l += __shfl_xor(l, 32);
        add_scaled(acc, o, gs / fmaxf(l, 1e-30f), wsc, i, hi);
    }
    {
        const int j0 = cur - 8 > 0 ? cur - 8 : 0;
        unsigned wm0 = 0u, wm1 = 0u, wm2 = 0u, wm3 = 0u;
#pragma unroll
        for (int wd = 0; wd < 4; ++wd) { const int a0 = j0 - 32 * wd, a1 = cur + 1 - 32 * wd;
            const unsigned hi_m = a1 >= 32 ? ~0u : (a1 <= 0 ? 0u : ((1u << a1) - 1u)), lo_m = a0 >= 32 ? ~0u : (a0 <= 0 ? 0u : ((1u << a0) - 1u));
            const unsigned x = hi_m & ~lo_m; if (wd == 0) wm0 = x; else if (wd == 1) wm1 = x; else if (wd == 2) wm2 = x; else wm3 = x; }
        const Branch br{a.kw + (size_t)bg * T_ * 64, a.vwt + (size_t)bg * 64 * T_, T_};
        float m = -1e30f, l = 0.f;
#pragma unroll
        for (int r = 0; r < 16; ++r) { o[0][r] = 0.f; o[1][r] = 0.f; }
        run_branch<2, false>(sm, br, wm0, wm1, wm2, wm3, qf, t - 511, t, tw1 - 511, tw0, 0u, 0u, 0u, 0u, m, l, 0.f, o, nullptr, wsc, tid, lane);
        l += __shfl_xor(l, 32);
        add_scaled(acc, o, gw / fmaxf(l, 1e-30f), wsc, i, hi);
    }
#pragma unroll
    for (int r = 0; r < 16; ++r) { const int rw = crow(r, hi), qq = 8 * w + (rw >> 2), hh = rw & 3;
        bf16* op = a.amix + ((size_t)b * T_ + q0 + qq) * DM + g * 256 + hh * 64 + i;
        op[0] = (bf16)f2bf(acc[0][r]); op[32] = (bf16)f2bf(acc[1][r]); }
}
__device__ __forceinline__ void phase(const NsaArgs& a, unsigned* ctr, unsigned char* sm) {
    int* slot = (int*)(sm + OFF_UNIT);
    for (;;) {
        if (tidx() == 0) *slot = (int)atomicAdd(ctr, 1u);
        __syncthreads();
        const int u = *slot;
        __syncthreads();
        if (u >= 512) break;
        unit(a, u, sm);
    }
}
}

__device__ __forceinline__ void d_lora_prep(const bf16* pr, const float* mu, bf16* la) {
    const int T512 = tidx(), c = T512 & 255;
    FOR_VB(row, M_) {
        const int t = row % T_;
        const float cur = bf2f(pr[(size_t)row * 256 + c]), prev = t ? bf2f(pr[(size_t)(row - 1) * 256 + c]) : 0.f;
        const float x = cur + (prev - cur) * mu[1536 + c];
        const float v = c < 64 ? tanhf(x) : (c < 128 ? x : sigmoidf_(x));
        la[(size_t)row * KLORA + c] = (bf16)f2bf(v);
    }
}
namespace rw7 {
using nsa::f32x16; using nsa::crow; using nsa::pack8;
constexpr int NSLOT = 4, S_AT = 0, S_RT = 2048, S_BT = 4096, S_KT = 6144, S_SM = 8192, S_VT = 10240, S_GC = 12288, SLOT = 12544;
constexpr int OFF_SCR = 2 * NSLOT * SLOT, SCR = 4096, LDS_NEED = OFF_SCR + NSLOT * SCR;
struct Args { const unsigned* rkw; const bf16* vv; const bf16* aga; const float* wdec; const float *mu, *kk, *ka, *rk; float* yraw; float* bonus; };
struct Raw { u32x2 q[16]; float w[16]; };
__device__ __forceinline__ void fetch(const Args& a, int b, int h, int c, int lane, Raw& q) {
    const size_t base = ((size_t)b * T_ + (size_t)c * 16) * 512 + h * 64 + lane;
#pragma unroll
    for (int t = 0; t < 16; ++t) { q.q[t].x = a.rkw[base + (size_t)t * 512]; q.q[t].y = (unsigned)a.vv[base + (size_t)t * 512] | ((unsigned)a.aga[base + (size_t)t * 512] << 16); q.w[t] = a.wdec[base + (size_t)t * 512]; }
}
__device__ __forceinline__ void produce(const Args& a, int b, int h, int c, const Raw& q, unsigned char* slot, unsigned char* scr, int lane) {
    const int col = h * 64 + lane, i = lane & 31, hi = lane >> 5;
    const float mur = a.mu[col], muk = a.mu[512 + col], muv = a.mu[1024 + col], kkc = a.kk[col], kac = a.ka[col], rkc = a.rk[col];
    const size_t row0 = (size_t)b * T_ + (size_t)c * 16;
    float pr_r = 0.f, pr_k = 0.f, pr_v = 0.f;
    if (c > 0) { u32x2 pq; pq.x = a.rkw[(row0 - 1) * 512 + col]; pq.y = (unsigned)a.vv[(row0 - 1) * 512 + col];
        pr_r = __builtin_bit_cast(float, pq.x << 16); pr_k = __builtin_bit_cast(float, pq.x & 0xffff0000u); pr_v = __builtin_bit_cast(float, pq.y << 16); }
    float gam = 1.f, myrk = 0.f;
    unsigned btp[8], ktp[8], vtp[8];
    bf16* AT = (bf16*)(slot + S_AT); bf16* RT = (bf16*)(slot + S_RT); bf16* BK = (bf16*)scr;
#pragma unroll
    for (int t = 0; t < 16; ++t) {
        const float r0 = __builtin_bit_cast(float, q.q[t].x << 16), k0 = __builtin_bit_cast(float, q.q[t].x & 0xffff0000u);
        const float v0 = __builtin_bit_cast(float, q.q[t].y << 16), al = __builtin_bit_cast(float, q.q[t].y & 0xffff0000u);
        const float r = r0 + (pr_r - r0) * mur, k = k0 + (pr_k - k0) * muk, v = v0 + (pr_v - v0) * muv;
        pr_r = r0; pr_k = k0; pr_v = v0;
        const float wd = q.w[t];
        const float kkv = k * kkc, nrm = sqrtf(wave_sum(kkv * kkv)), kkn = kkv / fmaxf(nrm, 1e-12f);
        const float bb = kkn * al, ktv = k * (1.f + (al - 1.f) * kac);
        const float rkv = wave_sum(r * ktv * rkc);
        myrk = (lane == t) ? rkv : myrk;
        const float gp = gam; gam *= wd; const float ig = 1.f / gam;
        const unsigned hb = f2bf(bb * ig), hk = f2bf(ktv * ig), hv = f2bf(v);
        AT[t * 64 + lane] = (bf16)f2bf(-kkn * gp); RT[t * 64 + lane] = (bf16)f2bf(r * gam);
        BK[t * 64 + lane] = (bf16)hb; BK[(16 + t) * 64 + lane] = (bf16)hk;
        if (t & 1) { btp[t >> 1] |= hb << 16; ktp[t >> 1] |= hk << 16; vtp[t >> 1] |= hv << 16; }
        else { btp[t >> 1] = hb; ktp[t >> 1] = hk; vtp[t >> 1] = hv; }
    }
    if (lane < 16) a.bonus[(row0 + lane) * 8 + h] = myrk;
    *(u32x4*)(slot + S_BT + lane * 32) = (u32x4){btp[0], btp[1], btp[2], btp[3]}; *(u32x4*)(slot + S_BT + lane * 32 + 16) = (u32x4){btp[4], btp[5], btp[6], btp[7]};
    *(u32x4*)(slot + S_KT + lane * 32) = (u32x4){ktp[0], ktp[1], ktp[2], ktp[3]}; *(u32x4*)(slot + S_KT + lane * 32 + 16) = (u32x4){ktp[4], ktp[5], ktp[6], ktp[7]};
    *(u32x4*)(slot + S_VT + lane * 32) = (u32x4){vtp[0], vtp[1], vtp[2], vtp[3]}; *(u32x4*)(slot + S_VT + lane * 32 + 16) = (u32x4){vtp[4], vtp[5], vtp[6], vtp[7]};
    ((float*)(slot + S_GC))[lane] = gam;
    asm volatile("s_waitcnt lgkmcnt(0)" ::: "memory");
    f32x16 C;
#pragma unroll
    for (int r = 0; r < 16; ++r) C[r] = 0.f;
#pragma unroll
    for (int ks = 0; ks < 4; ++ks) {
        const bf16x8 af = *(const bf16x8*)(slot + S_AT + i * 128 + (16 * ks + 8 * hi) * 2);
        const bf16x8 bf = *(const bf16x8*)(scr + i * 128 + (16 * ks + 8 * hi) * 2);
        C = __builtin_amdgcn_mfma_f32_32x32x16_bf16(af, bf, C, 0, 0, 0);
    }
    asm volatile("s_waitcnt lgkmcnt(0)" ::: "memory");
    float* AAB = (float*)scr;
    bf16* SM = (bf16*)(slot + S_SM);
#pragma unroll
    for (int r = 0; r < 16; ++r) {
        const int rho = crow(r, hi); const float val = C[r];
        if (r < 8) {
            if (i < 16) AAB[rho * 16 + i] = (i < rho) ? val : 0.f;
            else SM[256 + rho * 16 + (i - 16)] = (bf16)f2bf((i - 16 < rho) ? val : 0.f);
        } else {
            const int tt = rho - 16;
            if (i < 16) SM[512 + tt * 16 + i] = (bf16)f2bf((i <= tt) ? val : 0.f);
            else SM[768 + tt * 16 + (i - 16)] = (bf16)f2bf((i - 16 <= tt) ? val : 0.f);
        }
    }
    asm volatile("s_waitcnt lgkmcnt(0)" ::: "memory");
    { const int j = lane & 15; float Tr[16];
#pragma unroll
      for (int t = 0; t < 16; ++t) { float acc = (t == j) ? 1.f : 0.f;
#pragma unroll
          for (int s = 0; s < t; ++s) acc += AAB[t * 16 + s] * Tr[s];
          Tr[t] = acc;
          if (lane < 16) SM[t * 16 + j] = (bf16)f2bf(acc); } }
}

__device__ __forceinline__ bf16x8 rd_perm(const unsigned char* p, int hi) {
    const u32x2 a = *(const u32x2*)(p + 8 * hi), b = *(const u32x2*)(p + 16 + 8 * hi);
    return __builtin_bit_cast(bf16x8, (u32x4){a.x, a.y, b.x, b.y});
}
__device__ __forceinline__ void consume(const unsigned char* slot, f32x16 (&z)[2], float* yout, int vt, int lane) {
    const int i = lane & 31, hi = lane >> 5, i16 = i & 15; const bool lo16 = i < 16;
    const bf16x8 zero = {0, 0, 0, 0, 0, 0, 0, 0};
    const bf16x8 zb0 = pack8(z[0], 0), zb1 = pack8(z[0], 8), zb2 = pack8(z[1], 0), zb3 = pack8(z[1], 8);
    const unsigned char* at = slot + S_AT + i16 * 128; const unsigned char* rt = slot + S_RT + i16 * 128; const unsigned char* sm16 = slot + S_SM + i16 * 32;
    const bf16x8 vtf = *(const bf16x8*)(slot + S_VT + (32 * vt + i) * 32 + 16 * hi);
    f32x16 X, U, Y;
#pragma unroll
    for (int r = 0; r < 16; ++r) { X[r] = 0.f; U[r] = 0.f; Y[r] = 0.f; }
    X = __builtin_amdgcn_mfma_f32_32x32x16_bf16(lo16 ? rd_perm(at, hi) : zero, zb0, X, 0, 0, 0);
    X = __builtin_amdgcn_mfma_f32_32x32x16_bf16(lo16 ? rd_perm(at + 32, hi) : zero, zb1, X, 0, 0, 0);
    X = __builtin_amdgcn_mfma_f32_32x32x16_bf16(lo16 ? rd_perm(at + 64, hi) : zero, zb2, X, 0, 0, 0);
    X = __builtin_amdgcn_mfma_f32_32x32x16_bf16(lo16 ? rd_perm(at + 96, hi) : zero, zb3, X, 0, 0, 0);
    X = __builtin_amdgcn_mfma_f32_32x32x16_bf16(lo16 ? *(const bf16x8*)(sm16 + 512 + 16 * hi) : zero, vtf, X, 0, 0, 0);
    const bf16x8 xb = pack8(X, 0);
    U = __builtin_amdgcn_mfma_f32_32x32x16_bf16(lo16 ? rd_perm(sm16, hi) : zero, xb, U, 0, 0, 0);
    const bf16x8 ub = pack8(U, 0);
    Y = __builtin_amdgcn_mfma_f32_32x32x16_bf16(lo16 ? rd_perm(rt, hi) : zero, zb0, Y, 0, 0, 0);
    Y = __builtin_amdgcn_mfma_f32_32x32x16_bf16(lo16 ? rd_perm(rt + 32, hi) : zero, zb1, Y, 0, 0, 0);
    Y = __builtin_amdgcn_mfma_f32_32x32x16_bf16(lo16 ? rd_perm(rt + 64, hi) : zero, zb2, Y, 0, 0, 0);
    Y = __builtin_amdgcn_mfma_f32_32x32x16_bf16(lo16 ? rd_perm(rt + 96, hi) : zero, zb3, Y, 0, 0, 0);
    Y = __builtin_amdgcn_mfma_f32_32x32x16_bf16(lo16 ? rd_perm(sm16 + 1024, hi) : zero, ub, Y, 0, 0, 0);
    Y = __builtin_amdgcn_mfma_f32_32x32x16_bf16(lo16 ? *(const bf16x8*)(sm16 + 1536 + 16 * hi) : zero, vtf, Y, 0, 0, 0);
#pragma unroll
    for (int kt = 0; kt < 2; ++kt) {
        z[kt] = __builtin_amdgcn_mfma_f32_32x32x16_bf16(*(const bf16x8*)(slot + S_KT + (32 * kt + i) * 32 + 16 * hi), vtf, z[kt], 0, 0, 0);
        z[kt] = __builtin_amdgcn_mfma_f32_32x32x16_bf16(rd_perm(slot + S_BT + (32 * kt + i) * 32, hi), ub, z[kt], 0, 0, 0);
#pragma unroll
        for (int rg = 0; rg < 4; ++rg) { const f32x4 g4 = *(const f32x4*)(slot + S_GC + (32 * kt + 8 * rg + 4 * hi) * 4);
#pragma unroll
            for (int e = 0; e < 4; ++e) z[kt][4 * rg + e] *= g4[e]; }
    }
#pragma unroll
    for (int r = 0; r < 8; ++r) yout[(size_t)crow(r, hi) * 512] = Y[r];
}

__device__ __forceinline__ void head(const Args& a, int bh, unsigned char* sm) {
    const int tid = tidx(), lane = tid & 63, w = __builtin_amdgcn_readfirstlane(tid >> 6);
    const int b = bh >> 3, h = bh & 7;
    constexpr int NSTEP = T_ / 16 / NSLOT;
    if (w < 2) {
        f32x16 z[2];
#pragma unroll
        for (int r = 0; r < 16; ++r) { z[0][r] = 0.f; z[1][r] = 0.f; }
        __syncthreads();
        for (int g = 0; g < NSTEP; ++g) {
            for (int p = 0; p < NSLOT; ++p) {
                const int c = NSLOT * g + p;
                consume(sm + (size_t)((g & 1) * NSLOT + p) * SLOT, z, a.yraw + ((size_t)b * T_ + (size_t)c * 16) * 512 + h * 64 + 32 * w + (lane & 31), w, lane);
            }
            __syncthreads();
        }
    } else if ((w & 2) != 0) {
        const int pw = (w & 1) | ((w >> 2) << 1);
        unsigned char* scr = sm + OFF_SCR + pw * SCR;
        Raw q; fetch(a, b, h, pw, lane, q);
        { Raw nq; fetch(a, b, h, pw + NSLOT, lane, nq); produce(a, b, h, pw, q, sm + (size_t)pw * SLOT, scr, lane); q = nq; }
        __syncthreads();
        for (int g = 0; g < NSTEP; ++g) {
            const int c = NSLOT * (g + 1) + pw;
            if (c < T_ / 16) { Raw nq; if (c + NSLOT < T_ / 16) fetch(a, b, h, c + NSLOT, lane, nq);
                produce(a, b, h, c, q, sm + (size_t)(((g + 1) & 1) * NSLOT + pw) * SLOT, scr, lane); q = nq; }
            __syncthreads();
        }
    } else {
        __syncthreads();
        for (int g = 0; g < NSTEP; ++g) __syncthreads();
    }
}
__device__ __forceinline__ void finish(const float* yraw, const float* bonus, const bf16* vv, const bf16* agg, const float* mu, const float* gng, const float* gnb, bf16* amix) {
    const int T512 = tidx(), lane = T512 & 63;
    for (int it = blockIdx.x * 8 + (T512 >> 6); it < M_ * 8; it += gridDim.x * 8) {
        const int row = it >> 3, h = it & 7, col = h * 64 + lane, t = row % T_;
        const float y = yraw[(size_t)row * 512 + col], mean = wave_sum(y) * (1.f / 64.f), dy = y - mean, var = wave_sum(dy * dy) * (1.f / 64.f);
        const float yn = dy * rsqrtf(var + 64e-5f) * gng[col] + gnb[col];
        const float v0 = bf2f(vv[(size_t)row * 512 + col]), v1 = t ? bf2f(vv[(size_t)(row - 1) * 512 + col]) : 0.f;
        const float v = v0 + (v1 - v0) * mu[1024 + col];
        amix[(size_t)row * DM + 512 + col] = (bf16)f2bf((yn + bonus[(size_t)row * 8 + h] * v) * bf2f(agg[(size_t)row * 512 + col]));
    }
}
}

namespace mema {
using nsa::f32x16; using nsa::KROW; using nsa::VROW; using nsa::KBUF; using nsa::VBUF; using nsa::OFF_K; using nsa::OFF_V; using nsa::OFF_WS; using nsa::crow; using nsa::pack8;
__device__ __forceinline__ void unit(const bf16* qm, const bf16* mk, const bf16* mvt, bf16* om, int u, unsigned char* sm) {
    const int tid = tidx(), lane = tid & 63, w = __builtin_amdgcn_readfirstlane(tid >> 6), i = lane & 31, hi = lane >> 5;
    const int b = u >> 7, h = (u >> 5) & 3, rb = u & 31;
    const int row0 = b * T_ + rb * 256 + 32 * w;
    const bf16* qrow = qm + (size_t)(row0 + i) * DM + h * 256 + 8 * hi;
    const bf16* kbase = mk + (size_t)(b * 256 + (tid >> 3)) * DM + h * 256 + (tid & 7) * 8;
    const bf16* vbase = mvt + (size_t)(h * 256 + (tid >> 3)) * 512 + b * 256 + (tid & 7) * 8;
    unsigned char* kst = sm + OFF_K + (tid >> 3) * KROW + (tid & 7) * 16;
    unsigned char* vst = sm + OFF_V + (tid >> 3) * VROW + (tid & 7) * 16;
    float* wsc = (float*)(sm + OFF_WS) + w * 32;
    f32x16 p[4][2];
#pragma unroll
    for (int kt = 0; kt < 4; ++kt)
#pragma unroll
        for (int r = 0; r < 16; ++r) { p[kt][0][r] = 0.f; p[kt][1][r] = 0.f; }
    u32x4 tr = *(const u32x4*)kbase;
    *(u32x4*)kst = tr;
    __syncthreads();
    bf16x8 qf[4];
#pragma unroll
    for (int n = 0; n < 16; ++n) {
        const int dc = n >> 2, kt = n & 3, cb = n & 1;
        if (n + 1 < 16) tr = *(const u32x4*)(kbase + (size_t)(64 * ((n + 1) & 3)) * DM + 64 * ((n + 1) >> 2));
        else tr = *(const u32x4*)vbase;
        if (kt == 0) {
#pragma unroll
            for (int d0 = 0; d0 < 4; ++d0) qf[d0] = *(const bf16x8*)(qrow + 64 * dc + 16 * d0);
        }
        const unsigned char* kb = sm + OFF_K + cb * KBUF;
#pragma unroll
        for (int d0 = 0; d0 < 4; ++d0) {
            const bf16x8 a0 = *(const bf16x8*)(kb + i * KROW + (16 * d0 + 8 * hi) * 2);
            const bf16x8 a1 = *(const bf16x8*)(kb + (32 + i) * KROW + (16 * d0 + 8 * hi) * 2);
            p[kt][0] = __builtin_amdgcn_mfma_f32_32x32x16_bf16(a0, qf[d0], p[kt][0], 0, 0, 0);
            p[kt][1] = __builtin_amdgcn_mfma_f32_32x32x16_bf16(a1, qf[d0], p[kt][1], 0, 0, 0);
        }
        if (n + 1 < 16) *(u32x4*)(kst + (cb ^ 1) * KBUF) = tr;
        else { *(u32x2*)vst = (u32x2){tr.x, tr.y}; *(u32x2*)(vst + 8) = (u32x2){tr.z, tr.w}; }
        __syncthreads();
    }
    float mx = p[0][0][0];
#pragma unroll
    for (int kt = 0; kt < 4; ++kt)
#pragma unroll
        for (int r = 0; r < 16; ++r) mx = fmaxf(mx, fmaxf(p[kt][0][r], p[kt][1][r]));
    mx = fmaxf(mx, __shfl_xor(mx, 32));
    float l = 0.f;
#pragma unroll
    for (int kt = 0; kt < 4; ++kt)
#pragma unroll
        for (int r = 0; r < 16; ++r) { p[kt][0][r] = __builtin_amdgcn_exp2f(p[kt][0][r] - mx); p[kt][1][r] = __builtin_amdgcn_exp2f(p[kt][1][r] - mx); l += p[kt][0][r] + p[kt][1][r]; }
    l += __shfl_xor(l, 32);
    bf16x8 pf[4][4];
#pragma unroll
    for (int kt = 0; kt < 4; ++kt) { pf[kt][0] = pack8(p[kt][0], 0); pf[kt][1] = pack8(p[kt][0], 8); pf[kt][2] = pack8(p[kt][1], 0); pf[kt][3] = pack8(p[kt][1], 8); }
    if (hi == 0) wsc[i] = 1.f / l;
    asm volatile("" ::: "memory");
    f32x4 il[4];
#pragma unroll
    for (int rg = 0; rg < 4; ++rg) il[rg] = *(const f32x4*)(wsc + 8 * rg + 4 * hi);
    f32x16 o[2];
#pragma unroll
    for (int n = 0; n < 16; ++n) {
        const int dvt = n >> 2, kt = n & 3, cb = n & 1;
        if (n + 1 < 16) tr = *(const u32x4*)(vbase + (size_t)(64 * ((n + 1) >> 2)) * 512 + 64 * ((n + 1) & 3));
        if (kt == 0) {
#pragma unroll
            for (int r = 0; r < 16; ++r) { o[0][r] = 0.f; o[1][r] = 0.f; }
        }
        const unsigned char* vb = sm + OFF_V + cb * VBUF;
#pragma unroll
        for (int dt = 0; dt < 2; ++dt) {
            const unsigned char* vp = vb + (32 * dt + i) * VROW + 8 * hi;
#pragma unroll
            for (int ks = 0; ks < 4; ++ks) {
                const u32x2 v_lo = *(const u32x2*)(vp + 32 * ks), v_hi = *(const u32x2*)(vp + 32 * ks + 16);
                const bf16x8 vf = __builtin_bit_cast(bf16x8, (u32x4){v_lo.x, v_lo.y, v_hi.x, v_hi.y});
                o[dt] = __builtin_amdgcn_mfma_f32_32x32x16_bf16(pf[kt][ks], vf, o[dt], 0, 0, 0);
            }
        }
        if (kt == 3) {
#pragma unroll
            for (int r = 0; r < 16; ++r) { bf16* op = om + (size_t)(row0 + crow(r, hi)) * DM + h * 256 + 64 * dvt + i;
                op[0] = (bf16)f2bf(o[0][r] * il[r >> 2][r & 3]); op[32] = (bf16)f2bf(o[1][r] * il[r >> 2][r & 3]); }
        }
        if (n + 1 < 16) { unsigned char* vp2 = vst + (cb ^ 1) * VBUF; *(u32x2*)vp2 = (u32x2){tr.x, tr.y}; *(u32x2*)(vp2 + 8) = (u32x2){tr.z, tr.w}; }
        __syncthreads();
    }
}
}

namespace cg = cooperative_groups;
constexpr int NTHREADS = 512, LDS_BYTES = 147456;
struct MegaArgs { const float* in[41]; float* out; unsigned char* ws; };
#define WSB(off) ((bf16*)(ws + (off)))
#define WSF(off) ((float*)(ws + (off)))

__global__ void __launch_bounds__(NTHREADS) mega_fwd(MegaArgs A) {
    extern __shared__ __attribute__((aligned(16))) unsigned char lds[];
    cg::grid_group grid = cg::this_grid();
    const float* const* in = A.in; unsigned char* ws = A.ws; float* out = A.out;

    d_convert(WSB(WS_W1GU), NGU, DM, MapGU{in[I_F1_WG], in[I_F1_WU], FF});
    d_convert(WSB(WS_W1D), DM, FF, MapPlain{in[I_F1_WD], DM});
    d_convert(WSB(WS_W2GU), NGU, DM, MapGU{in[I_F2_WG], in[I_F2_WU], FF});
    d_convert(WSB(WS_W2D), DM, FF, MapPlain{in[I_F2_WD], DM});
    d_convert(WSB(WS_WIN), NWIN, DM, MapWin{in[I_WIN], IN_COLS});
    d_convert(WSB(WS_WOUT), DM, DM, MapPlain{in[I_WOUT], DM});
    d_convert(WSB(WS_WQ), DM, DM, MapPlain{in[I_WQ], DM});
    d_convert(WSB(WS_WK), DM, DM, MapPlain{in[I_WK], DM});
    d_convert(WSB(WS_WV), DM, DM, MapPlain{in[I_WV], DM});
    d_convert(WSB(WS_WO), DM, DM, MapPlain{in[I_WO], DM});
    d_convert(WSB(WS_CW1K), 256, 2048, MapPlain{in[I_W1_K], 256});
    d_convert(WSB(WS_CW1V), 256, 2048, MapPlain{in[I_W1_V], 256});
    d_convert_lora(WSB(WS_WLORA), in[I_W2], in[I_A2], in[I_G2]);
    d_rope_table(WSF(WS_ROPE));
    d_cmp_bias(in[I_PE_K], in[I_W1_K], in[I_PE_V], in[I_W1_V], WSF(WS_CBIAS), (float*)lds);
    d_rownorm(in[I_X], in[I_F1_PRE], WSB(WS_XN), M_);
    d_rownorm(in[I_MEM], in[I_MEM_KVG], WSB(WS_MEMN), 512);
    grid.sync();
    gemm_pg8(lds, WSB(WS_XN), DM, WSB(WS_W1GU), DM, M_, NGU, DM, EpiSwiGLU{WSB(WS_HB)});
    grid.sync();
    gemm_pg8(lds, WSB(WS_HB), FF, WSB(WS_W1D), FF, M_, DM, FF, EpiStore{WSB(WS_YB), DM, 1.f});
    grid.sync();
    d_rowpass(in[I_X], WSB(WS_YB), in[I_F1_POST], 0.5f, in[I_MIX_PRE], out, WSB(WS_XN));
    grid.sync();
    gemm_pg8(lds, WSB(WS_XN), DM, WSB(WS_WIN), DM, M_, NWIN, DM,
             EpiWin{WSB(WS_QB), WSB(WS_KS), WSB(WS_KW), WSB(WS_KCR), WSB(WS_VCR), WSB(WS_VST), WSB(WS_VWT), (unsigned*)(ws + WS_RKVA), WSB(WS_RKVA + 32 * MiB), WSB(WS_PRL), WSF(WS_GATES), WSF(WS_ROPE)});
    grid.sync();
    gemm_pg8(lds, WSB(WS_KCR), 1024, WSB(WS_CW1K), 2048, 2048, 256, 2048, EpiBiasSilu{WSB(WS_HIDK), WSF(WS_CBIAS)});
    gemm_pg8(lds, WSB(WS_VCR), 1024, WSB(WS_CW1V), 2048, 2048, 256, 2048, EpiBiasSilu{WSB(WS_HIDV), WSF(WS_CBIAS) + 256});
    d_lora_prep(WSB(WS_PRL), in[I_MU], WSB(WS_XN));
    grid.sync();
    d_cmp2(WSB(WS_HIDK), WSB(WS_HIDV), in[I_W2_K], in[I_W2_V], WSF(WS_ROPE), WSB(WS_KC), WSB(WS_VCT));
    gemm_pg8(lds, WSB(WS_XN), KLORA, WSB(WS_WLORA), KLORA, M_, NLORA, KLORA, EpiLora{WSF(WS_YB), WSB(WS_RKVA + 48 * MiB), WSB(WS_AGG), in[I_W0], in[I_A0]});
    grid.sync();
    if (blockIdx.x < 16) {
        const rw7::Args ra{(const unsigned*)(ws + WS_RKVA), WSB(WS_RKVA + 32 * MiB), WSB(WS_RKVA + 48 * MiB), WSF(WS_YB), in[I_MU], in[I_KK], in[I_KA], in[I_RK], WSF(WS_YB), WSF(WS_BONUS)};
        rw7::head(ra, blockIdx.x, lds);
    }
    {
        const NsaArgs na{WSB(WS_QB), WSB(WS_KC), WSB(WS_VCT), WSB(WS_KS), WSB(WS_VST), WSB(WS_KW), WSB(WS_VWT), WSF(WS_GATES), WSB(WS_XN)};
        nsa::phase(na, (unsigned*)(ws + WS_CTL), lds);
    }
    grid.sync();
    d_nsa_outnorm(WSB(WS_XN), in[I_NSA_G]);
    rw7::finish(WSF(WS_YB), WSF(WS_BONUS), WSB(WS_RKVA + 32 * MiB), WSB(WS_AGG), in[I_MU], in[I_GNG], in[I_GNB], WSB(WS_XN));
    grid.sync();
    gemm_pg8(lds, WSB(WS_XN), DM, WSB(WS_WOUT), DM, M_, DM, DM, EpiStore{WSB(WS_YB), DM, 1.f});
    grid.sync();
    d_rowpass(out, WSB(WS_YB), in[I_MIX_POST], 1.0f, in[I_MEM_PRE], out, WSB(WS_XN));
    grid.sync();
    gemm_pg8(lds, WSB(WS_XN), DM, WSB(WS_WQ), DM, M_, DM, DM, EpiStore{WSB(WS_QM), DM, MSCALE});
    gemm_pg8(lds, WSB(WS_MEMN), DM, WSB(WS_WK), DM, 512, DM, DM, EpiStore{WSB(WS_MK), DM, 1.f});
    gemm_pg8(lds, WSB(WS_WV), DM, WSB(WS_MEMN), DM, DM, 512, DM, EpiStore{WSB(WS_MVT), 512, 1.f});
    grid.sync();
    for (int u = blockIdx.x; u < 256; u += gridDim.x) mema::unit(WSB(WS_QM), WSB(WS_MK), WSB(WS_MVT), WSB(WS_OM), u, lds);
    grid.sync();
    gemm_pg8(lds, WSB(WS_OM), DM, WSB(WS_WO), DM, M_, DM, DM, EpiStore{WSB(WS_YB), DM, 1.f});
    grid.sync();
    d_rowpass(out, WSB(WS_YB), in[I_MEM_POST], 1.0f, in[I_F2_PRE], out, WSB(WS_XN));
    grid.sync();
    gemm_pg8(lds, WSB(WS_XN), DM, WSB(WS_W2GU), DM, M_, NGU, DM, EpiSwiGLU{WSB(WS_HB)});
    grid.sync();
    gemm_pg8(lds, WSB(WS_HB), FF, WSB(WS_W2D), FF, M_, DM, FF, EpiStore{WSB(WS_YB), DM, 1.f});
    grid.sync();
    d_rowpass(out, WSB(WS_YB), in[I_F2_POST], 0.5f, (const float*)nullptr, out, (bf16*)nullptr);
}

extern "C" void kernel_launch(void* const* d_in, const int* in_sizes, int n_in, void* d_out, int out_size, void* d_ws, size_t ws_size, hipStream_t stream) {
    static int grid = 0;
    if (grid == 0) {
        if (n_in != 41 || ws_size < WS_END) { fprintf(stderr, "kernel_launch: unexpected n_in %d / ws %zu\n", n_in, ws_size); grid = -1; return; }
        int dev = 0, cus = 0, per_cu = 0;
        hipGetDevice(&dev); hipDeviceGetAttribute(&cus, hipDeviceAttributeMultiprocessorCount, dev);
        if (hipFuncSetAttribute((const void*)mega_fwd, hipFuncAttributeMaxDynamicSharedMemorySize, LDS_BYTES) != hipSuccess) { fprintf(stderr, "kernel_launch: hipFuncSetAttribute failed\n"); grid = -1; return; }
        if (hipOccupancyMaxActiveBlocksPerMultiprocessor(&per_cu, (const void*)mega_fwd, NTHREADS, LDS_BYTES) != hipSuccess || per_cu < 1) { fprintf(stderr, "kernel_launch: occupancy query says %d\n", per_cu); grid = -1; (void)hipGetLastError(); return; }
        grid = cus;
    }
    if (grid < 0) return;
    MegaArgs a{};
    for (int i = 0; i < 41; ++i) a.in[i] = (const float*)d_in[i];
    a.out = (float*)d_out; a.ws = (unsigned char*)d_ws;
    hipMemsetAsync(d_ws, 0, 4096, stream);
    void* args[] = {&a};
    hipError_t e = hipLaunchCooperativeKernel((const void*)mega_fwd, dim3(grid), dim3(NTHREADS), args, LDS_BYTES, stream);
    if (e != hipSuccess) fprintf(stderr, "kernel_launch: cooperative launch failed: %s (grid %d)\n", hipGetErrorString(e), grid);
}
```

```cpp
#include <hip/hip_runtime.h>
#include <hip/hip_cooperative_groups.h>
#include <cstdint>
#include <cstdio>

constexpr int NB = 2, T_ = 8192, DM = 1024, M_ = NB * T_;
constexpr int FF = 2816, NGU = 2 * FF;
constexpr int IN_COLS = 3096, NWIN = 3328;
constexpr int NRW = 1792;
constexpr int NCP = 512;
constexpr int NLORA = 1536, KLORA = 256;
constexpr float NORM_EPS = 1e-6f;
constexpr float QSCALE = 0.125f * 1.4426950408889634f;
constexpr float MSCALE = 0.0625f * 1.4426950408889634f;

typedef unsigned short bf16;
typedef short bf16x8 __attribute__((ext_vector_type(8)));
typedef float f32x4 __attribute__((ext_vector_type(4)));
typedef unsigned u32x2 __attribute__((ext_vector_type(2)));
typedef unsigned u32x4 __attribute__((ext_vector_type(4)));

__device__ __forceinline__ unsigned f2bf(float f) { unsigned u = __builtin_bit_cast(unsigned, f); return (u + 0x7fffu + ((u >> 16) & 1u)) >> 16; }
__device__ __forceinline__ float bf2f(bf16 h) { return __builtin_bit_cast(float, (unsigned)h << 16); }
typedef float f32x2_t __attribute__((ext_vector_type(2))); typedef __bf16 bf16x2_t __attribute__((ext_vector_type(2)));
__device__ __forceinline__ unsigned pk2(float lo, float hi) { const f32x2_t v = {lo, hi}; return __builtin_bit_cast(unsigned, __builtin_convertvector(v, bf16x2_t)); }
__device__ __forceinline__ void st_bf4(bf16* p, f32x4 v) { u32x2 w; w.x = pk2(v[0], v[1]); w.y = pk2(v[2], v[3]); *(u32x2*)p = w; }
__device__ __forceinline__ float wave_sum(float v) {
#pragma unroll
    for (int o = 1; o < 64; o <<= 1) v += __shfl_xor(v, o);
    return v;
}
__device__ __forceinline__ float wave_max(float v) {
#pragma unroll
    for (int o = 1; o < 64; o <<= 1) v = fmaxf(v, __shfl_xor(v, o));
    return v;
}
__device__ __forceinline__ float sigmoidf_(float x) { return 1.f / (1.f + __expf(-x)); }
__device__ __forceinline__ int tidx() { int t = threadIdx.x; asm volatile("" : "+v"(t)); return t; }

constexpr size_t MiB = 1u << 20, KiB64 = 65536;
constexpr size_t WS_CTL = 0;
constexpr size_t WS_KC = 256 * 1024;
constexpr size_t WS_VCT = 512 * 1024;
constexpr size_t WS_W1GU = 1 * MiB;
constexpr size_t WS_W1D = 12 * MiB;
constexpr size_t WS_W2GU = WS_W1D + 88 * KiB64;
constexpr size_t WS_W2D = WS_W2GU + 11 * MiB;
constexpr size_t WS_WIN = WS_W2D + 88 * KiB64;
constexpr size_t WS_WOUT = WS_WIN + 104 * KiB64;
constexpr size_t WS_WQ = WS_WOUT + 2 * MiB, WS_WK = WS_WQ + 2 * MiB, WS_WV = WS_WK + 2 * MiB, WS_WO = WS_WV + 2 * MiB;
constexpr size_t WS_CW1K = WS_WO + 2 * MiB, WS_CW1V = WS_CW1K + 1 * MiB;
constexpr size_t WS_WLORA = WS_CW1V + 1 * MiB;
constexpr size_t WS_ROPE = WS_WLORA + 12 * KiB64;
constexpr size_t WS_CBIAS = WS_ROPE + 2 * MiB;
constexpr size_t WS_MEMN = WS_CBIAS + KiB64;
constexpr size_t WS_HIDK = WS_MEMN + 1 * MiB;
constexpr size_t WS_HIDV = WS_HIDK + 1 * MiB;
constexpr size_t WS_GATES = WS_HIDV + 1 * MiB;
constexpr size_t WS_XN = 60 * MiB;
constexpr size_t WS_YB = 92 * MiB;
constexpr size_t WS_D = 124 * MiB;
constexpr size_t WS_HB = WS_D;
constexpr size_t WS_QB = WS_D;
constexpr size_t WS_KS = WS_D + 16 * MiB;
constexpr size_t WS_KW = WS_D + 20 * MiB;
constexpr size_t WS_KCR = WS_D + 24 * MiB;
constexpr size_t WS_VCR = WS_D + 29 * MiB;
constexpr size_t WS_VST = WS_D + 34 * MiB;
constexpr size_t WS_VWT = WS_D + 38 * MiB;
constexpr size_t WS_RKVA = WS_D + 42 * MiB;
constexpr size_t WS_PRL = WS_D + 106 * MiB;
constexpr size_t WS_AGG = WS_D + 114 * MiB;
constexpr size_t WS_BONUS = WS_KCR;
constexpr size_t WS_END = 256 * MiB;
constexpr size_t WS_QM = WS_D;
constexpr size_t WS_OM = WS_D + 32 * MiB;
constexpr size_t WS_MK = WS_D + 64 * MiB;
constexpr size_t WS_MVT = WS_D + 65 * MiB;
static_assert(WS_GATES + (size_t)M_ * 24 * 4 <= WS_XN, "ws map");
static_assert(WS_AGG + 16 * MiB <= WS_END, "ws map");

struct Params {
    const float* in[41];
    float* out;
    unsigned char* ws;
};
enum { I_X = 0, I_MEM, I_F1_PRE, I_F1_WG, I_F1_WU, I_F1_WD, I_F1_POST, I_MIX_PRE, I_WIN, I_PE_K, I_W1_K, I_W2_K, I_PE_V, I_W1_V, I_W2_V,
       I_NSA_G, I_MU, I_W0, I_W2, I_A0, I_A2, I_G2, I_KK, I_KA, I_RK, I_GNG, I_GNB, I_WOUT, I_MIX_POST, I_MEM_PRE, I_MEM_KVG, I_WQ, I_WK, I_WV,
       I_WO, I_MEM_POST, I_F2_PRE, I_F2_WG, I_F2_WU, I_F2_WD, I_F2_POST };

struct MapPlain { const float* W; int N; int pad; __device__ const float* col(int p) const { return W + p; } };
struct MapGU {
    const float* Wg; const float* Wu; int N; int pad;
    __device__ const float* col(int p) const {
        const int pn = p >> 8, q = p & 255, n = (q >> 4) & 1;
        const int hid = 128 * pn + 64 * (q >> 7) + 16 * ((q >> 5) & 3) + (q & 15);
        return Wg + (size_t)n * (size_t)(Wu - Wg) + hid;
    }
};
__host__ __device__ inline int rope_perm(int x) { return 16 * ((x >> 5) & 1) + (x & 15) + 32 * ((x >> 4) & 1); }
struct MapWin {
    const float* W; int N; int pad;
    __device__ const float* col(int p) const {
        int l;
        if (p < 512) l = (p & ~63) + rope_perm(p & 63);
        else if (p < 640) l = 768 + ((p - 512) & ~63) + rope_perm(p & 63);
        else if (p < 768) l = 1024 + ((p - 640) & ~63) + rope_perm(p & 63);
        else if (p < 896) l = 512 + (p - 768);
        else if (p < 1024) l = 640 + (p - 896);
        else if (p < 1152) l = 896 + (p - 1024);
        else if (p < 1280) l = 1152 + (p - 1152);
        else if (p < 2304) { const int q = p - 1280; l = 1304 + (((q >> 4) & 1) ? 512 : 0) + 16 * (q >> 5) + (q & 15); }
        else if (p < 3072) l = 1304 + (p - 1280);
        else if (p < 3096) l = 1280 + (p - 3072);
        else return nullptr;
        return W + l;
    }
};

#define FOR_VB(vb, n) for (int vb = (int)blockIdx.x * 2 + (T512 >> 8); vb < (n); vb += (int)gridDim.x * 2)

template <class Map> __device__ __forceinline__ void d_convert(bf16* WT, int Np, int K, Map map) {
    const int T512 = tidx(), tid = T512 & 255, nbx = Np / 64, nb = nbx * (K / 64);
    FOR_VB(vb, nb) {
        const int p = (vb % nbx) * 64 + (tid & 63), k0 = (vb / nbx) * 64 + (tid >> 6) * 16;
        const float* src = map.col(p);
        float v[16];
#pragma unroll
        for (int i = 0; i < 16; ++i) v[i] = src ? src[(size_t)(k0 + i) * map.N] : 0.f;
        u32x4 a, b;
        a.x = pk2(v[0], v[1]); a.y = pk2(v[2], v[3]); a.z = pk2(v[4], v[5]); a.w = pk2(v[6], v[7]);
        b.x = pk2(v[8], v[9]); b.y = pk2(v[10], v[11]); b.z = pk2(v[12], v[13]); b.w = pk2(v[14], v[15]);
        u32x4* dst = (u32x4*)(WT + (size_t)p * K + k0);
        dst[0] = a; dst[1] = b;
    }
}
__device__ __forceinline__ void d_convert_lora(bf16* WT, const float* w2, const float* a2, const float* g2) {
    const int T512 = tidx(), tid = T512 & 255;
    FOR_VB(vb, NLORA * KLORA / 256) {
        const int idx = vb * 256 + tid, p = idx >> 8, k = idx & 255;
        float v = 0.f;
        if (p < 512) { if (k < 64) v = w2[k * 512 + p]; }
        else if (p < 1024) { if (k >= 64 && k < 128) v = a2[(k - 64) * 512 + (p - 512)]; }
        else { if (k >= 128) v = g2[(k - 128) * 512 + (p - 1024)]; }
        WT[idx] = (bf16)f2bf(v);
    }
}
__device__ __forceinline__ void d_rope_table(float* tab) {
    const int T512 = tidx(), tid = T512 & 255;
    FOR_VB(vb, T_ * 32 / 256) {
        const int idx = vb * 256 + tid, pos = idx >> 5, i = idx & 31;
        const float inv = (float)pow(10000.0, -(double)i / 32.0);
        const float ang = (float)pos * inv;
        tab[2 * idx] = (float)cos((double)ang); tab[2 * idx + 1] = (float)sin((double)ang);
    }
}
__device__ __forceinline__ void d_cmp_bias(const float* pe_k, const float* w1_k, const float* pe_v, const float* w1_v, float* bias, float* red  ) {
    for (int job = blockIdx.x; job < 8; job += gridDim.x) {
        const int kv = job >> 2; const float* pe = kv ? pe_v : pe_k; const float* w1 = kv ? w1_v : w1_k;
        const int T512 = tidx(), lane = T512 & 63, w = T512 >> 6, n = (job & 3) * 64 + lane;
        float s = 0.f;
        for (int j = w * 256; j < w * 256 + 256; ++j) s += pe[j] * w1[(size_t)j * 256 + n];
        red[w * 64 + lane] = s; __syncthreads();
        if (w == 0) { float t = 0.f; for (int i = 0; i < 8; ++i) t += red[i * 64 + lane]; bias[kv * 256 + n] = t; }
        __syncthreads();
    }
}
__device__ __forceinline__ void d_rownorm(const float* x, const float* g, bf16* xn, int rows) {
    const int T512 = tidx(), tid = T512 & 255, lane = tid & 63;
    FOR_VB(vb, rows / 4) {
        const int row = vb * 4 + (tid >> 6);
        const f32x4* xr = (const f32x4*)(x + (size_t)row * DM) + lane; f32x4 v[4]; float s = 0.f;
#pragma unroll
        for (int j = 0; j < 4; ++j) { v[j] = xr[64 * j]; s += v[j][0] * v[j][0] + v[j][1] * v[j][1] + v[j][2] * v[j][2] + v[j][3] * v[j][3]; }
        const float rstd = rsqrtf(wave_sum(s) * (1.f / DM) + NORM_EPS);
#pragma unroll
        for (int j = 0; j < 4; ++j) { const f32x4 gg = ((const f32x4*)g)[lane + 64 * j]; st_bf4(xn + (size_t)row * DM + 4 * (lane + 64 * j), v[j] * rstd * gg); }
    }
}
__device__ __forceinline__ void d_rowpass(const float* xin, const bf16* y, const float* gpost, float coef, const float* gpre, float* xout, bf16* xn) {
    const int T512 = tidx(), tid = T512 & 255, lane = tid & 63;
    FOR_VB(vb, M_ / 4) {
        const int row = vb * 4 + (tid >> 6);
        f32x4 yv[4], xv[4]; float s = 0.f;
#pragma unroll
        for (int j = 0; j < 4; ++j) {
            const u32x2 w = *(const u32x2*)(y + (size_t)row * DM + 4 * (lane + 64 * j));
            yv[j][0] = __builtin_bit_cast(float, w.x << 16); yv[j][1] = __builtin_bit_cast(float, w.x & 0xffff0000u);
            yv[j][2] = __builtin_bit_cast(float, w.y << 16); yv[j][3] = __builtin_bit_cast(float, w.y & 0xffff0000u);
            s += yv[j][0] * yv[j][0] + yv[j][1] * yv[j][1] + yv[j][2] * yv[j][2] + yv[j][3] * yv[j][3];
            xv[j] = ((const f32x4*)(xin + (size_t)row * DM))[lane + 64 * j];
        }
        const float rstd = rsqrtf(wave_sum(s) * (1.f / DM) + NORM_EPS) * coef; float s2 = 0.f;
#pragma unroll
        for (int j = 0; j < 4; ++j) { const f32x4 gg = ((const f32x4*)gpost)[lane + 64 * j]; xv[j] = xv[j] + yv[j] * rstd * gg;
            s2 += xv[j][0] * xv[j][0] + xv[j][1] * xv[j][1] + xv[j][2] * xv[j][2] + xv[j][3] * xv[j][3];
            ((f32x4*)(xout + (size_t)row * DM))[lane + 64 * j] = xv[j]; }
        if (gpre) {
            const float r2 = rsqrtf(wave_sum(s2) * (1.f / DM) + NORM_EPS);
#pragma unroll
            for (int j = 0; j < 4; ++j) { const f32x4 gg = ((const f32x4*)gpre)[lane + 64 * j]; st_bf4(xn + (size_t)row * DM + 4 * (lane + 64 * j), xv[j] * r2 * gg); }
        }
    }
}
__device__ __forceinline__ void d_nsa_outnorm(bf16* amix, const float* g) {
    const int T512 = tidx(), tid = T512 & 255, lane = tid & 63;
    FOR_VB(vb, M_ / 4) {
        const int row = vb * 4 + (tid >> 6);
        bf16* p = amix + (size_t)row * DM + 8 * lane;
        const u32x4 w = *(const u32x4*)p; float v[8]; float s = 0.f;
        v[0] = __builtin_bit_cast(float, w.x << 16); v[1] = __builtin_bit_cast(float, w.x & 0xffff0000u);
        v[2] = __builtin_bit_cast(float, w.y << 16); v[3] = __builtin_bit_cast(float, w.y & 0xffff0000u);
        v[4] = __builtin_bit_cast(float, w.z << 16); v[5] = __builtin_bit_cast(float, w.z & 0xffff0000u);
        v[6] = __builtin_bit_cast(float, w.w << 16); v[7] = __builtin_bit_cast(float, w.w & 0xffff0000u);
#pragma unroll
        for (int i = 0; i < 8; ++i) s += v[i] * v[i];
        const float rstd = rsqrtf(wave_sum(s) * (1.f / 512.f) + NORM_EPS);
        u32x4 o; const float* gg = g + 8 * lane;
        o.x = pk2(v[0] * rstd * gg[0], v[1] * rstd * gg[1]); o.y = pk2(v[2] * rstd * gg[2], v[3] * rstd * gg[3]);
        o.z = pk2(v[4] * rstd * gg[4], v[5] * rstd * gg[5]); o.w = pk2(v[6] * rstd * gg[6], v[7] * rstd * gg[7]);
        *(u32x4*)p = o;
    }
}

struct EpiStore { bf16* O; int ldc; float scale;
    static constexpr int NCAT = 1;
    __device__ __forceinline__ int cat(int) const { return 0; }
    template <int C> __device__ __forceinline__ void apply(int row, int p, f32x4 v0, f32x4 v1) const { bf16* o = O + (size_t)row * ldc + p; st_bf4(o, v0 * scale); st_bf4(o + 16, v1 * scale); } };
struct EpiSwiGLU { bf16* H;
    static constexpr int NCAT = 1;
    __device__ __forceinline__ int cat(int) const { return 0; }
    template <int C> __device__ __forceinline__ void apply(int row, int p, f32x4 g, f32x4 u) const {
        const int q = p & 255, hid = 128 * (p >> 8) + 64 * (q >> 7) + 16 * ((q >> 5) & 3) + (q & 15);
        f32x4 h;
#pragma unroll
        for (int e = 0; e < 4; ++e) h[e] = g[e] / (1.f + __expf(-g[e])) * u[e];
        st_bf4(H + (size_t)row * FF + hid, h); } };
struct EpiBiasSilu { bf16* O; const float* bias;
    static constexpr int NCAT = 1;
    __device__ __forceinline__ int cat(int) const { return 0; }
    template <int C> __device__ __forceinline__ void apply(int row, int p, f32x4 v0, f32x4 v1) const {
        f32x4 a, b; const f32x4 b0 = *(const f32x4*)(bias + p), b1 = *(const f32x4*)(bias + p + 16);
#pragma unroll
        for (int e = 0; e < 4; ++e) { const float x0 = v0[e] + b0[e], x1 = v1[e] + b1[e]; a[e] = x0 / (1.f + __expf(-x0)); b[e] = x1 / (1.f + __expf(-x1)); }
        bf16* o = O + (size_t)row * 256 + p; st_bf4(o, a); st_bf4(o + 16, b); } };
struct EpiLora { float* wdec; bf16* aga; bf16* agg; const float* w0; const float* a0;
    static constexpr int NCAT = 3;
    __device__ __forceinline__ int cat(int p0) const { return p0 < 512 ? 0 : (p0 < 1024 ? 1 : 2); }
    template <int C> __device__ __forceinline__ void one(int row, int p, f32x4 v) const {
        if (C == 0) { f32x4 o; const f32x4 ww = *(const f32x4*)(w0 + p);
#pragma unroll
            for (int e = 0; e < 4; ++e) o[e] = __expf(-0.6065306597126334f * sigmoidf_(ww[e] + v[e]));
            *(f32x4*)(wdec + (size_t)row * 512 + p) = o;
        } else if (C == 1) { f32x4 o; const f32x4 aa = *(const f32x4*)(a0 + p - 512);
#pragma unroll
            for (int e = 0; e < 4; ++e) o[e] = sigmoidf_(aa[e] + v[e]);
            st_bf4(aga + (size_t)row * 512 + (p - 512), o);
        } else st_bf4(agg + (size_t)row * 512 + (p - 1024), v);
    }
    template <int C> __device__ __forceinline__ void apply(int row, int p, f32x4 v0, f32x4 v1) const { one<C>(row, p, v0); one<C>(row, p + 16, v1); } };
struct EpiWin {
    bf16 *qb, *ks, *kw, *kcr, *vcr, *vst, *vwt; unsigned* rk; bf16 *vv, *prl; float* gates; const float* rope;
    static constexpr int NCAT = 8;
    __device__ __forceinline__ int cat(int p0) const { return p0 < 512 ? 0 : (p0 < 768 ? 1 : (p0 < 1024 ? 2 : (p0 < 1280 ? 3 : (p0 < 2304 ? 4 : (p0 < 2816 ? 7 : (p0 < 3072 ? 6 : 5)))))); }
    template <int C> __device__ __forceinline__ void apply(int row, int p, f32x4 v0, f32x4 v1) const {
        const int b = row / T_, t = row % T_;
        if (C == 0 || C == 1) {
            const int x = p & 63, d = 16 * ((x >> 5) & 1) + (x & 15);
            const f32x4* rp = (const f32x4*)(rope + ((size_t)t * 32 + d) * 2); const f32x4 r0 = rp[0], r1 = rp[1];
            const f32x4 cs = {r0[0], r0[2], r1[0], r1[2]}, sn = {r0[1], r0[3], r1[1], r1[3]};
            const f32x4 lo = v0 * cs - v1 * sn, hi = v0 * sn + v1 * cs;
            if (C == 0) { bf16* o = qb + (size_t)row * 512 + (p & ~63) + d; st_bf4(o, lo * QSCALE); st_bf4(o + 32, hi * QSCALE); }
            else { const int g = ((p - 512) >> 6) & 1; bf16* base = (p < 640) ? ks : kw; bf16* o = base + ((size_t)(b * 2 + g) * T_ + t) * 64 + d; st_bf4(o, lo); st_bf4(o + 32, hi); }
        } else if (C == 2) {
            const int c = (p - 768) & 127, g = c >> 6, d = c & 63; bf16* base = (p < 896) ? kcr : vcr;
            bf16* o = base + ((size_t)(b * 2 + g) * T_ + t) * 64 + d; st_bf4(o, v0); st_bf4(o + 16, v1);
        } else if (C == 3) {
            const int c = (p - 1024) & 127, g = c >> 6, d = c & 63; bf16* base = (p < 1152) ? vst : vwt;
            bf16* o = base + ((size_t)(b * 2 + g) * 64 + d) * T_ + t;
#pragma unroll
            for (int e = 0; e < 4; ++e) { o[(size_t)e * T_] = (bf16)f2bf(v0[e]); o[(size_t)(16 + e) * T_] = (bf16)f2bf(v1[e]); }
        } else if (C == 4) {
            const int q = p - 1280, ch = 16 * (q >> 5) + (q & 15);
            u32x4 w; w.x = pk2(v0[0], v1[0]); w.y = pk2(v0[1], v1[1]); w.z = pk2(v0[2], v1[2]); w.w = pk2(v0[3], v1[3]);
            *(u32x4*)(rk + (size_t)row * 512 + ch) = w;
        } else if (C == 7) {
            bf16* o = vv + (size_t)row * 512 + (p - 2304); st_bf4(o, v0); st_bf4(o + 16, v1);
        } else if (C == 6) {
            bf16* o = prl + (size_t)row * 256 + (p - 2816); st_bf4(o, v0); st_bf4(o + 16, v1);
        } else {
            const int c = p - 3072; float* o = gates + (size_t)row * 24 + c;
            if (c < 24) { f32x4 s = {sigmoidf_(v0[0]), sigmoidf_(v0[1]), sigmoidf_(v0[2]), sigmoidf_(v0[3])}; *(f32x4*)o = s; }
            if (c + 16 < 24) { f32x4 s = {sigmoidf_(v1[0]), sigmoidf_(v1[1]), sigmoidf_(v1[2]), sigmoidf_(v1[3])}; *(f32x4*)(o + 16) = s; }
        }
    }
};

namespace pg8 {
#define PG8_LAS __attribute__((address_space(3)))
typedef unsigned short bf16_t;
typedef short bf16x8 __attribute__((ext_vector_type(8)));
typedef float f32x4 __attribute__((ext_vector_type(4)));
typedef unsigned u32x4 __attribute__((ext_vector_type(4)));
constexpr int BM = 256, BK = 64, HALF = 128, HTB = HALF * BK * 2  , STAGE_BYTES = 8 * HTB, NXCD = 8, WGM = 8;

__host__ __device__ __forceinline__ int lds_byte(int r, int c) { const int st = (r >> 4) * 2 + (c >> 5), rr = r & 15, cc = c & 31, ob = rr * 64 + cc * 2; return st * 1024 + (ob ^ (((ob >> 9) & 1) << 5)); }
__host__ __device__ __forceinline__ void stage_rc(int b, int& R, int& C) { const int st = b / 1024, sb = b % 1024, swz = sb ^ (((sb >> 9) & 1) << 5); R = (st >> 1) * 16 + swz / 64; C = (st & 1) * 32 + (swz % 64) / 2; }
__host__ __device__ __forceinline__ int perm32(int rho) { const int n = rho >> 4, i = rho & 15; return 8 * (i >> 2) + 4 * n + (i & 3); }

struct Unit { int pm, pn; };
struct Gemm { const bf16_t* A; const bf16_t* Bt; int M, N, K, lda, ldb; };

struct StaticOrder {
    int nM, nN, nwg, G, c;
    __host__ __device__ void init(int M, int N, int G_, int c_) { nM = M / BM; nN = N / BM; nwg = nM * nN; G = G_; c = c_; }
    __host__ __device__ bool next(int i, Unit& u) const {
        const long L = (long)i * G + c; if (L >= nwg) return false;
        int wgid = (int)L; { const int q = nwg / NXCD, r = nwg % NXCD, xcd = wgid % NXCD, off = wgid / NXCD; wgid = (xcd < r ? xcd * (q + 1) : r * (q + 1) + (xcd - r) * q) + off; }
        const int nig = WGM * nN, gid = wgid / nig, fm = gid * WGM, gsz = (nM - fm) < WGM ? (nM - fm) : WGM;
        u.pm = fm + ((wgid % nig) % gsz); u.pn = (wgid % nig) / gsz; return true;
    }
    __device__ __forceinline__ void a_ready(const Unit&) const {}
    __device__ __forceinline__ void done(const Unit&) const {}
};

template <class Epi, class Sched, bool ALIGN_EPI = false, bool SP2 = false>
__device__ __forceinline__ void gemm_phase(PG8_LAS unsigned char* lds, const Gemm g, const Sched& S, const Epi& E) {
    const int tid = tidx(), wid = __builtin_amdgcn_readfirstlane(tid >> 6), lane = tid & 63, wr = wid >> 2, wc = wid & 3, fr = lane & 15, fq = lane >> 4;
    const int K = g.K, nt = K / BK;
    unsigned voffA[2], voffB[2];
#pragma unroll
    for (int i = 0; i < 2; ++i) { int R, C; stage_rc(tid * 16 + i * 8192, R, C); const int Rb = Epi::PERM ? ((R & ~31) + perm32(R & 31)) : R;
        voffA[i] = (unsigned)(R * g.lda + C) * 2u; voffB[i] = (unsigned)(Rb * g.ldb + C) * 2u; }
    const size_t kstep = (size_t)(BK * 2);
    const size_t hstepA = (size_t)HALF * g.lda * 2, hstepB = (size_t)HALF * g.ldb * 2;
    const size_t tstepA = 2 * hstepA, tstepB = 2 * hstepB;
    const unsigned ldsw = (unsigned)wid * 1024u;
    const int aoff = lds_byte(wr * 64 + fr, fq * 8), boff = lds_byte(wc * 32 + fr, fq * 8);
#define PG8_SA(b, h) (((b) * 2 + (h)) * HTB)
#define PG8_SB(b, h) ((4 + (b) * 2 + (h)) * HTB)
#define PG8_STAGE(bufoff, gbase, voff) do { _Pragma("unroll") for (int _i = 0; _i < 2; ++_i) \
        __builtin_amdgcn_global_load_lds((const unsigned*)((const char*)(gbase) + (voff)[_i]), (PG8_LAS unsigned*)(lds + (bufoff) + ldsw + _i * 8192), 16, 0, 0); } while (0)
#define PG8_LDA(dst, b, h) do { _Pragma("unroll") for (int m = 0; m < 4; ++m) _Pragma("unroll") for (int k = 0; k < 2; ++k) dst[m][k] = *(const PG8_LAS bf16x8*)(lds + PG8_SA(b, h) + aoff + m * 2048 + k * 1024); } while (0)
#define PG8_LDB(dst, b, h) do { _Pragma("unroll") for (int n = 0; n < 2; ++n) _Pragma("unroll") for (int k = 0; k < 2; ++k) dst[n][k] = *(const PG8_LAS bf16x8*)(lds + PG8_SB(b, h) + boff + n * 2048 + k * 1024); } while (0)
#define PG8_MMA(ai, bj, At, Bt) do { __builtin_amdgcn_s_setprio(1); _Pragma("unroll") for (int m = 0; m < 4; ++m) _Pragma("unroll") for (int n = 0; n < 2; ++n) _Pragma("unroll") for (int k = 0; k < 2; ++k) \
        acc[ai][bj][m][n] = __builtin_amdgcn_mfma_f32_16x16x32_bf16(Bt[n][k], At[m][k], acc[ai][bj][m][n], 0, 0, 0); __builtin_amdgcn_s_setprio(0); } while (0)
#define PG8_WAIT_V(n) asm volatile("s_waitcnt vmcnt(" #n ")" ::: "memory")
#define PG8_WAIT_L(n) asm volatile("s_waitcnt lgkmcnt(" #n ")" ::: "memory")
#define PG8_BAR __builtin_amdgcn_s_barrier()
#define PG8_SCHED __builtin_amdgcn_sched_barrier(0)
    Unit cur, nxt; int ui = 0;
    if (!S.next(0, cur)) return;
    f32x4 acc[2][2][4][2];
#pragma unroll
    for (int a = 0; a < 2; ++a)
#pragma unroll
        for (int b = 0; b < 2; ++b)
#pragma unroll
            for (int m = 0; m < 4; ++m)
#pragma unroll
                for (int n = 0; n < 2; ++n) acc[a][b][m][n] = (f32x4){0.f, 0.f, 0.f, 0.f};
    bf16x8 At[4][2], B0[2][2], B1[2][2];
    const char* cA = (const char*)g.A + (size_t)cur.pm * tstepA; const char* cB = (const char*)g.Bt + (size_t)cur.pn * tstepB;
    S.a_ready(cur);
    if constexpr (SP2) {
        PG8_STAGE(PG8_SB(0, 0), cB, voffB); PG8_STAGE(PG8_SB(0, 1), cB + hstepB, voffB); PG8_STAGE(PG8_SA(0, 0), cA, voffA); PG8_STAGE(PG8_SA(0, 1), cA + hstepA, voffA);
        if (wr == 1) PG8_BAR;
        PG8_WAIT_V(2); PG8_BAR;
        PG8_STAGE(PG8_SB(1, 0), cB + kstep, voffB); PG8_STAGE(PG8_SA(1, 0), cA + kstep, voffA); PG8_STAGE(PG8_SB(1, 1), cB + hstepB + kstep, voffB);
        PG8_WAIT_V(6); PG8_BAR;
    } else {
        PG8_STAGE(PG8_SB(0, 0), cB, voffB); PG8_STAGE(PG8_SA(0, 0), cA, voffA); PG8_STAGE(PG8_SB(0, 1), cB + hstepB, voffB); PG8_STAGE(PG8_SA(0, 1), cA + hstepA, voffA);
        if (wr == 1) PG8_BAR;
        PG8_WAIT_V(4); PG8_BAR;
        PG8_STAGE(PG8_SB(1, 0), cB + kstep, voffB); PG8_STAGE(PG8_SA(1, 0), cA + kstep, voffA); PG8_STAGE(PG8_SB(1, 1), cB + hstepB + kstep, voffB);
        PG8_WAIT_V(6); PG8_BAR;
    }
    for (;;) {
        const bool has_next = S.next(ui + 1, nxt);
        const char* nA = has_next ? (const char*)g.A + (size_t)nxt.pm * tstepA : cA; const char* nB = has_next ? (const char*)g.Bt + (size_t)nxt.pn * tstepB : cB;
        for (int t = 0; t < nt; t += 2) {
            const bool last = (t == nt - 2);
            const char* a1 = cA + (size_t)(t + 1) * kstep;
            const char* a2 = last ? nA : cA + (size_t)(t + 2) * kstep; const char* b2 = last ? nB : cB + (size_t)(t + 2) * kstep;
            const char* a3 = a2 + kstep; const char* b3 = b2 + kstep;
            if (last && has_next) S.a_ready(nxt);
            if constexpr (SP2) {
            PG8_LDB(B0, 0, 0); PG8_LDB(B1, 0, 1); PG8_SCHED; PG8_LDA(At, 0, 0); PG8_STAGE(PG8_SA(1, 1), a1 + hstepA, voffA);
            PG8_WAIT_V(8); PG8_WAIT_L(0); PG8_BAR; PG8_MMA(0, 0, At, B0); PG8_MMA(0, 1, At, B1); PG8_BAR; PG8_SCHED;
            PG8_LDA(At, 0, 1); PG8_STAGE(PG8_SB(0, 0), b2, voffB); PG8_STAGE(PG8_SB(0, 1), b2 + hstepB, voffB); PG8_STAGE(PG8_SA(0, 0), a2, voffA);
            PG8_WAIT_V(8); PG8_WAIT_L(0); PG8_BAR; PG8_MMA(1, 0, At, B0); PG8_MMA(1, 1, At, B1); PG8_BAR; PG8_SCHED;
            PG8_LDB(B0, 1, 0); PG8_LDB(B1, 1, 1); PG8_SCHED; PG8_LDA(At, 1, 0); PG8_STAGE(PG8_SA(0, 1), a2 + hstepA, voffA);
            PG8_WAIT_V(8); PG8_WAIT_L(0); PG8_BAR; PG8_MMA(0, 0, At, B0); PG8_MMA(0, 1, At, B1); PG8_BAR; PG8_SCHED;
            PG8_LDA(At, 1, 1); PG8_STAGE(PG8_SB(1, 0), b3, voffB); PG8_STAGE(PG8_SB(1, 1), b3 + hstepB, voffB); PG8_STAGE(PG8_SA(1, 0), a3, voffA);
            PG8_WAIT_V(8); PG8_WAIT_L(0); PG8_BAR; PG8_MMA(1, 0, At, B0); PG8_MMA(1, 1, At, B1); PG8_BAR; PG8_SCHED;
            } else {
            PG8_LDB(B0, 0, 0); PG8_SCHED; PG8_LDA(At, 0, 0); PG8_STAGE(PG8_SA(1, 1), a1 + hstepA, voffA);
            PG8_WAIT_L(8); PG8_BAR; PG8_WAIT_L(0); PG8_MMA(0, 0, At, B0); PG8_BAR; PG8_SCHED;
            PG8_LDB(B1, 0, 1); PG8_STAGE(PG8_SB(0, 0), b2, voffB);
            PG8_BAR; PG8_WAIT_L(0); PG8_MMA(0, 1, At, B1); PG8_BAR;
            PG8_LDA(At, 0, 1); PG8_STAGE(PG8_SA(0, 0), a2, voffA);
            PG8_BAR; PG8_WAIT_L(0); PG8_MMA(1, 0, At, B0); PG8_BAR; PG8_SCHED;
            PG8_STAGE(PG8_SB(0, 1), b2 + hstepB, voffB);
            PG8_WAIT_V(6); PG8_BAR; PG8_MMA(1, 1, At, B1); PG8_BAR;
            PG8_LDB(B0, 1, 0); PG8_SCHED; PG8_LDA(At, 1, 0); PG8_STAGE(PG8_SA(0, 1), a2 + hstepA, voffA);
            PG8_WAIT_L(8); PG8_BAR; PG8_WAIT_L(0); PG8_MMA(0, 0, At, B0); PG8_BAR; PG8_SCHED;
            PG8_LDB(B1, 1, 1); PG8_STAGE(PG8_SB(1, 0), b3, voffB);
            PG8_BAR; PG8_WAIT_L(0); PG8_MMA(0, 1, At, B1); PG8_BAR;
            PG8_LDA(At, 1, 1); PG8_STAGE(PG8_SA(1, 0), a3, voffA);
            PG8_BAR; PG8_WAIT_L(0); PG8_MMA(1, 0, At, B0); PG8_BAR; PG8_SCHED;
            PG8_STAGE(PG8_SB(1, 1), b3 + hstepB, voffB);
            PG8_WAIT_V(6); PG8_BAR; PG8_MMA(1, 1, At, B1); PG8_BAR;
            }
        }
        if constexpr (ALIGN_EPI) { if (wr == 0) PG8_BAR; }
        if constexpr (!Epi::AFTER_DRAIN) { E(acc, cur, wr, wc, fr, fq); S.done(cur); }
        if (!has_next) break;
#pragma unroll
        for (int a = 0; a < 2; ++a)
#pragma unroll
            for (int b = 0; b < 2; ++b)
#pragma unroll
                for (int m = 0; m < 4; ++m)
#pragma unroll
                    for (int n = 0; n < 2; ++n) acc[a][b][m][n] = (f32x4){0.f, 0.f, 0.f, 0.f};
        cur = nxt; cA = nA; cB = nB; ++ui;
        if constexpr (ALIGN_EPI) { if (wr == 1) PG8_BAR; }
    }
    PG8_WAIT_V(0);
    if constexpr (!ALIGN_EPI) { if (wr == 0) PG8_BAR; }
    PG8_BAR;
    if constexpr (Epi::AFTER_DRAIN) { E.fused(acc, cur, wr, wc, fr, fq, lds, wid, lane); S.done(cur); }
#undef PG8_SA
#undef PG8_SB
#undef PG8_STAGE
#undef PG8_LDA
#undef PG8_LDB
#undef PG8_MMA
#undef PG8_WAIT_V
#undef PG8_WAIT_L
#undef PG8_BAR
#undef PG8_SCHED
}
}

template <class F> struct EpiQuad {
    static constexpr bool PERM = false, AFTER_DRAIN = false;
    F f;
    template <int C, int BJ> __device__ __forceinline__ void half(const pg8::f32x4 (&acc)[2][2][4][2], int row0, int p) const {
#pragma unroll
        for (int ai = 0; ai < 2; ++ai)
#pragma unroll
            for (int m = 0; m < 4; ++m) { f.template apply<C>(row0 + ai * 128 + m * 16, p, acc[ai][BJ][m][0], acc[ai][BJ][m][1]); asm volatile("" ::: "memory"); }
    }
    template <int BJ> __device__ __forceinline__ void disp(const pg8::f32x4 (&acc)[2][2][4][2], int row0, int p0, int p) const {
        const int c = f.cat(p0);
        if (F::NCAT == 1 || c == 0) half<0, BJ>(acc, row0, p);
        else if (F::NCAT > 1 && c == 1) half<(F::NCAT > 1 ? 1 : 0), BJ>(acc, row0, p);
        else if (F::NCAT > 2 && c == 2) half<(F::NCAT > 2 ? 2 : 0), BJ>(acc, row0, p);
        else if (F::NCAT > 3 && c == 3) half<(F::NCAT > 3 ? 3 : 0), BJ>(acc, row0, p);
        else if (F::NCAT > 4 && c == 4) half<(F::NCAT > 4 ? 4 : 0), BJ>(acc, row0, p);
        else if (F::NCAT > 5 && c == 5) half<(F::NCAT > 5 ? 5 : 0), BJ>(acc, row0, p);
        else if (F::NCAT > 6 && c == 6) half<(F::NCAT > 6 ? 6 : 0), BJ>(acc, row0, p);
        else if (F::NCAT > 7) half<(F::NCAT > 7 ? 7 : 0), BJ>(acc, row0, p);
    }
    __device__ __forceinline__ void operator()(const pg8::f32x4 (&acc)[2][2][4][2], const pg8::Unit& u, int wr, int wc, int fr, int fq) const {
        const int row0 = u.pm * 256 + wr * 64 + fr, p0 = u.pn * 256;
        disp<0>(acc, row0, p0, p0 + wc * 32 + 4 * fq);
        disp<1>(acc, row0, p0 + 128, p0 + 128 + wc * 32 + 4 * fq);
    }
};
template <class F> __device__ __forceinline__ void gemm_pg8(unsigned char* lds, const bf16* A, int lda, const bf16* Bt, int ldb, int M, int N, int K, const F& f) {
    pg8::Gemm g{A, Bt, M, N, K, lda, ldb}; pg8::StaticOrder S; S.init(M, N, (int)gridDim.x, (int)blockIdx.x);
    EpiQuad<F> E{f};
    pg8::gemm_phase<EpiQuad<F>, pg8::StaticOrder, true, true>((PG8_LAS unsigned char*)lds, g, S, E);
}

__device__ __forceinline__ void d_cmp2(const bf16* hidk, const bf16* hidv, const float* w2k, const float* w2v, const float* rope, bf16* kc, bf16* vct) {
    const int T512 = tidx(), tid = T512 & 255;
    FOR_VB(vb, 2048 * 32 / 256) {
        const int idx = vb * 256 + tid; const int R = idx >> 5, i = idx & 31; const int bg = R >> 9, c = R & 511;
        float k0 = 0.f, k1 = 0.f, v0 = 0.f, v1 = 0.f;
        for (int n = 0; n < 256; ++n) { const float hk = bf2f(hidk[(size_t)R * 256 + n]), hv = bf2f(hidv[(size_t)R * 256 + n]);
            k0 += hk * w2k[n * 64 + i]; k1 += hk * w2k[n * 64 + i + 32]; v0 += hv * w2v[n * 64 + i]; v1 += hv * w2v[n * 64 + i + 32]; }
        const int pos = (16 * c + 31) & (T_ - 1);
        const float cs = rope[((size_t)pos * 32 + i) * 2], sn = rope[((size_t)pos * 32 + i) * 2 + 1];
        kc[(size_t)R * 64 + i] = (bf16)f2bf(k0 * cs - k1 * sn); kc[(size_t)R * 64 + i + 32] = (bf16)f2bf(k0 * sn + k1 * cs);
        vct[((size_t)bg * 64 + i) * NCP + c] = (bf16)f2bf(v0); vct[((size_t)bg * 64 + i + 32) * NCP + c] = (bf16)f2bf(v1);
    }
}

struct NsaArgs { const bf16 *qb, *kc, *vct, *ks, *vst, *kw, *vwt; const float* gates; bf16* amix; };
__device__ __forceinline__ float dot64(const float* q, const bf16* k) {
    float s = 0.f;
#pragma unroll
    for (int i = 0; i < 8; ++i) { const u32x4 w = ((const u32x4*)k)[i];
        s += q[8 * i + 0] * __builtin_bit_cast(float, w.x << 16) + q[8 * i + 1] * __builtin_bit_cast(float, w.x & 0xffff0000u)
           + q[8 * i + 2] * __builtin_bit_cast(float, w.y << 16) + q[8 * i + 3] * __builtin_bit_cast(float, w.y & 0xffff0000u)
           + q[8 * i + 4] * __builtin_bit_cast(float, w.z << 16) + q[8 * i + 5] * __builtin_bit_cast(float, w.z & 0xffff0000u)
           + q[8 * i + 6] * __builtin_bit_cast(float, w.w << 16) + q[8 * i + 7] * __builtin_bit_cast(float, w.w & 0xffff0000u); }
    return s;
}
__device__ __forceinline__ void softmax_row(float* s, int n, int lane) {
    float m = -INFINITY; for (int i = lane; i < n; i += 64) m = fmaxf(m, s[i]);
    m = wave_max(m); if (m == -INFINITY) m = 0.f;
    float l = 0.f; for (int i = lane; i < n; i += 64) { const float e = exp2f(s[i] - m); s[i] = e; l += e; }
    l = wave_sum(l); const float inv = 1.f / fmaxf(l, 1e-30f);
    for (int i = lane; i < n; i += 64) s[i] *= inv;
}
__device__ __forceinline__ void d_nsa_simple(const NsaArgs& a, int vb, int tid, unsigned char* smem) {
    float (*qs)[64] = (float (*)[64])smem; float (*sc)[1024] = (float (*)[1024])(smem + 1024); float* imp = (float*)(smem + 17408); float* score = imp + 128;
    int* list = (int*)(score + 128); int* nlist = list + 16;
    const int bg = vb / T_, t = vb % T_, b = bg >> 1, g = bg & 1;
    const int r = tid >> 6, d = tid & 63, lane = d;
    const size_t row = (size_t)b * T_ + t;
    qs[r][d] = bf2f(a.qb[row * 512 + g * 256 + r * 64 + d]);
    if (tid == 0) *nlist = 0;
    __syncthreads();
    const int nv = t < 31 ? 0 : (t - 31) / 16 + 1;
    for (int c = tid; c < nv; c += 256) { const bf16* k = a.kc + ((size_t)bg * NCP + c) * 64;
        _Pragma("unroll 1") for (int rr = 0; rr < 4; ++rr) sc[rr][c] = dot64(qs[rr], k); }
    __syncthreads();
    softmax_row(sc[r], nv, lane);
    __syncthreads();
    float oc = 0.f; { const bf16* v = a.vct + ((size_t)bg * 64 + d) * NCP; for (int c = 0; c < nv; ++c) oc += sc[r][c] * bf2f(v[c]); }
    if (tid < 128) { const int s = tid; float acc = 0.f;
        for (int c = 4 * s - 1; c <= 4 * s + 3; ++c) if (c >= 0 && c < nv) acc += sc[0][c] + sc[1][c] + sc[2][c] + sc[3][c];
        imp[s] = acc; }
    __syncthreads();
    const int cur = t >> 6;
    if (tid < 128) { const int s = tid; const bool forced = (s == 0) || (s == cur) || (s == cur - 1);
        score[s] = forced ? 1e4f : (s <= cur ? imp[s] : -1e4f); }
    __syncthreads();
    if (tid < 128) { const int s = tid; const float my = score[s]; int rank = 0;
        for (int j = 0; j < 128; ++j) { const float o = score[j]; rank += (o > my || (o == my && j < s)) ? 1 : 0; }
        if (rank < 16 && s <= cur) { const int slot = atomicAdd(nlist, 1); list[slot] = s; } }
    __syncthreads();
    const int ns = *nlist * 64;
    for (int i = tid; i < ns; i += 256) { const int pos = list[i >> 6] * 64 + (i & 63);
        if (pos <= t) { const bf16* k = a.ks + ((size_t)bg * T_ + pos) * 64; _Pragma("unroll 1") for (int rr = 0; rr < 4; ++rr) sc[rr][i] = dot64(qs[rr], k); }
        else { sc[0][i] = -INFINITY; sc[1][i] = -INFINITY; sc[2][i] = -INFINITY; sc[3][i] = -INFINITY; } }
    __syncthreads();
    softmax_row(sc[r], ns, lane);
    __syncthreads();
    float os = 0.f; { const bf16* v = a.vst + ((size_t)bg * 64 + d) * T_;
        for (int i = 0; i < ns; ++i) { const int pos = list[i >> 6] * 64 + (i & 63); if (pos <= t) os += sc[r][i] * bf2f(v[pos]); } }
    __syncthreads();
    const int lo = t - 511 > 0 ? t - 511 : 0, nw = t - lo + 1;
    for (int i = tid; i < nw; i += 256) { const bf16* k = a.kw + ((size_t)bg * T_ + lo + i) * 64;
        _Pragma("unroll 1") for (int rr = 0; rr < 4; ++rr) sc[rr][i] = dot64(qs[rr], k); }
    __syncthreads();
    softmax_row(sc[r], nw, lane);
    __syncthreads();
    float ow = 0.f; { const bf16* v = a.vwt + ((size_t)bg * 64 + d) * T_ + lo; for (int i = 0; i < nw; ++i) ow += sc[r][i] * bf2f(v[i]); }
    const float* gt = a.gates + row * 24 + g * 12 + r * 3;
    a.amix[row * DM + g * 256 + r * 64 + d] = (bf16)f2bf(gt[0] * oc + gt[1] * os + gt[2] * ow);
    __syncthreads();
}


namespace nsa {
typedef float f32x16 __attribute__((ext_vector_type(16)));
constexpr int KROW = 144, VROW = 136, KBUF = 64 * KROW, VBUF = 64 * VROW;
constexpr int OFF_K = 0, OFF_V = 2 * KBUF, OFF_IMP = OFF_V + 2 * VBUF, IMPW = 130, OFF_SEL = OFF_IMP + 64 * IMPW * 4, OFF_UM = OFF_SEL + 1024, OFF_WS = OFF_UM + 16, OFF_UNIT = OFF_WS + 1024, LDS_NEED = OFF_UNIT + 16;
static_assert(OFF_IMP % 16 == 0 && OFF_SEL % 16 == 0 && OFF_WS % 16 == 0, "nsa lds map");
__device__ __forceinline__ int crow(int r, int hi) { return (r & 3) + 8 * (r >> 2) + 4 * hi; }
__device__ __forceinline__ int next_bit(unsigned m0, unsigned m1, unsigned m2, unsigned m3, int from) {
#pragma unroll
    for (int wd = 0; wd < 4; ++wd) {
        unsigned x = wd == 0 ? m0 : (wd == 1 ? m1 : (wd == 2 ? m2 : m3)); const int base = wd * 32;
        if (from < base + 32) { if (from > base) x &= (~0u) << (from - base); if (x) return base + __builtin_ctz(x); }
    }
    return 128;
}
__device__ __forceinline__ bf16x8 pack8(const f32x16& p, int b0) {
    u32x4 w; w.x = pk2(p[b0 + 0], p[b0 + 1]); w.y = pk2(p[b0 + 2], p[b0 + 3]); w.z = pk2(p[b0 + 4], p[b0 + 5]); w.w = pk2(p[b0 + 6], p[b0 + 7]);
    return __builtin_bit_cast(bf16x8, w);
}
struct Branch { const bf16* k; const bf16* vt; int ldv; };

template <int MODE, bool SEL>
__device__ __forceinline__ void run_branch(unsigned char* sm, const Branch br, unsigned m0, unsigned m1, unsigned m2, unsigned m3,
                                           const bf16x8 (&qf)[4], int lo, int hi_b, int lo_max, int hi_min, unsigned s0, unsigned s1, unsigned s2, unsigned s3,
                                           float& m, float& l, float invl, f32x16 (&o)[2], float* imp_row, float* wsc, int tid, int lane) {
    const int i = lane & 31, hi = lane >> 5;
    int j = next_bit(m0, m1, m2, m3, 0);
    u32x4 kr, vr;
    if (j < 128) {
        kr = *(const u32x4*)(br.k + (size_t)j * 4096 + tid * 8);
        if (MODE != 0) vr = *(const u32x4*)(br.vt + (size_t)(tid >> 3) * br.ldv + j * 64 + (tid & 7) * 8);
        *(u32x4*)(sm + OFF_K + (tid >> 3) * KROW + (tid & 7) * 16) = kr;
        if (MODE != 0) { unsigned char* vp = sm + OFF_V + (tid >> 3) * VROW + (tid & 7) * 16; *(u32x2*)vp = (u32x2){vr.x, vr.y}; *(u32x2*)(vp + 8) = (u32x2){vr.z, vr.w}; }
    }
    __syncthreads();
    int cb = 0;
    while (j < 128) {
        const int jn = next_bit(m0, m1, m2, m3, j + 1);
        if (jn < 128) {
            kr = *(const u32x4*)(br.k + (size_t)jn * 4096 + tid * 8);
            if (MODE != 0) vr = *(const u32x4*)(br.vt + (size_t)(tid >> 3) * br.ldv + jn * 64 + (tid & 7) * 8);
        }
        const unsigned char* kb = sm + OFF_K + cb * KBUF; const unsigned char* vb = sm + OFF_V + cb * VBUF;
        const int key0 = 64 * j;
        bool rowsel = true;
        if (SEL) { const unsigned wsel = j < 32 ? s0 : (j < 64 ? s1 : (j < 96 ? s2 : s3)); rowsel = (wsel >> (j & 31)) & 1u; }
        if (!SEL || __any(rowsel)) {
            const float cinit = rowsel ? 0.f : -INFINITY;
            f32x16 p0, p1;
#pragma unroll
            for (int r = 0; r < 16; ++r) { p0[r] = cinit; p1[r] = cinit; }
#pragma unroll
            for (int d0 = 0; d0 < 4; ++d0) {
                const bf16x8 a0 = *(const bf16x8*)(kb + i * KROW + (16 * d0 + 8 * hi) * 2);
                const bf16x8 a1 = *(const bf16x8*)(kb + (32 + i) * KROW + (16 * d0 + 8 * hi) * 2);
                p0 = __builtin_amdgcn_mfma_f32_32x32x16_bf16(a0, qf[d0], p0, 0, 0, 0);
                p1 = __builtin_amdgcn_mfma_f32_32x32x16_bf16(a1, qf[d0], p1, 0, 0, 0);
            }
            if (!(key0 >= lo_max && key0 + 63 <= hi_min)) {
#pragma unroll
                for (int r = 0; r < 16; ++r) { const int key = key0 + crow(r, hi);
                    if (key < lo || key > hi_b) p0[r] = -INFINITY;
                    if (key + 32 < lo || key + 32 > hi_b) p1[r] = -INFINITY; }
            }
            if (MODE == 1) {
#pragma unroll
                for (int r = 0; r < 16; ++r) { p0[r] = __builtin_amdgcn_exp2f(p0[r] - m) * invl; p1[r] = __builtin_amdgcn_exp2f(p1[r] - m) * invl; }
#pragma unroll
                for (int gq = 0; gq < 4; ++gq) {
                    float G0 = (p0[4 * gq] + p0[4 * gq + 1]) + (p0[4 * gq + 2] + p0[4 * gq + 3]), L0 = p0[4 * gq + 3];
                    float G1 = (p1[4 * gq] + p1[4 * gq + 1]) + (p1[4 * gq + 2] + p1[4 * gq + 3]), L1 = p1[4 * gq + 3];
                    G0 += __shfl_xor(G0, 1); L0 += __shfl_xor(L0, 1); G1 += __shfl_xor(G1, 1); L1 += __shfl_xor(L1, 1);
                    G0 += __shfl_xor(G0, 2); L0 += __shfl_xor(L0, 2); G1 += __shfl_xor(G1, 2); L1 += __shfl_xor(L1, 2);
                    if ((i & 3) == 0) { const int s = 16 * j + 2 * gq + hi;
                        atomicAdd(imp_row + s, G0); atomicAdd(imp_row + s + 1, L0); atomicAdd(imp_row + s + 8, G1); atomicAdd(imp_row + s + 9, L1); }
                }
            } else {
                float tm = fmaxf(p0[0], p1[0]);
#pragma unroll
                for (int r = 1; r < 16; ++r) tm = fmaxf(tm, fmaxf(p0[r], p1[r]));
                tm = fmaxf(tm, __shfl_xor(tm, 32));
                const float mn = fmaxf(m, tm), alpha = __builtin_amdgcn_exp2f(m - mn);
                m = mn; float rs = 0.f;
#pragma unroll
                for (int r = 0; r < 16; ++r) { p0[r] = __builtin_amdgcn_exp2f(p0[r] - mn); p1[r] = __builtin_amdgcn_exp2f(p1[r] - mn); rs += p0[r] + p1[r]; }
                l = l * alpha + rs;
                if (MODE == 2) {
                    if (hi == 0) wsc[i] = alpha;
                    asm volatile("" ::: "memory");
#pragma unroll
                    for (int rg = 0; rg < 4; ++rg) { const f32x4 a4 = *(const f32x4*)(wsc + 8 * rg + 4 * hi);
#pragma unroll
                        for (int e = 0; e < 4; ++e) { o[0][4 * rg + e] *= a4[e]; o[1][4 * rg + e] *= a4[e]; } }
                    asm volatile("" ::: "memory");
                }
            }
            if (MODE != 0) {
                const bf16x8 pf0 = pack8(p0, 0), pf1 = pack8(p0, 8), pf2 = pack8(p1, 0), pf3 = pack8(p1, 8);
#pragma unroll
                for (int dt = 0; dt < 2; ++dt) {
                    const unsigned char* vp = vb + (32 * dt + i) * VROW + 8 * hi;
#pragma unroll
                    for (int ks = 0; ks < 4; ++ks) {
                        const u32x2 v_lo = *(const u32x2*)(vp + 32 * ks), v_hi = *(const u32x2*)(vp + 32 * ks + 16);
                        const bf16x8 vf = __builtin_bit_cast(bf16x8, (u32x4){v_lo.x, v_lo.y, v_hi.x, v_hi.y});
                        o[dt] = __builtin_amdgcn_mfma_f32_32x32x16_bf16(ks == 0 ? pf0 : (ks == 1 ? pf1 : (ks == 2 ? pf2 : pf3)), vf, o[dt], 0, 0, 0);
                    }
                }
            }
        }
        if (jn < 128) {
            *(u32x4*)(sm + OFF_K + (cb ^ 1) * KBUF + (tid >> 3) * KROW + (tid & 7) * 16) = kr;
            if (MODE != 0) { unsigned char* vp = sm + OFF_V + (cb ^ 1) * VBUF + (tid >> 3) * VROW + (tid & 7) * 16; *(u32x2*)vp = (u32x2){vr.x, vr.y}; *(u32x2*)(vp + 8) = (u32x2){vr.z, vr.w}; }
        }
        __syncthreads();
        j = jn; cb ^= 1;
    }
}
__device__ __forceinline__ void add_scaled(f32x16 (&acc)[2], const f32x16 (&o)[2], float f, float* wsc, int i, int hi) {
    if (hi == 0) wsc[i] = f;
    asm volatile("" ::: "memory");
#pragma unroll
    for (int rg = 0; rg < 4; ++rg) { const f32x4 a4 = *(const f32x4*)(wsc + 8 * rg + 4 * hi);
#pragma unroll
        for (int e = 0; e < 4; ++e) { acc[0][4 * rg + e] += a4[e] * o[0][4 * rg + e]; acc[1][4 * rg + e] += a4[e] * o[1][4 * rg + e]; } }
    asm volatile("" ::: "memory");
}
__device__ __forceinline__ void unit(const NsaArgs& a, int u, unsigned char* sm) {
    const int tid = tidx(), lane = tid & 63, w = __builtin_amdgcn_readfirstlane(tid >> 6), i = lane & 31, hi = lane >> 5;
    const int cur = 127 - (u >> 2), bg = u & 3, b = bg >> 1, g = bg & 1, q0 = cur * 64;
    const int ql = 8 * w + (i >> 2), hd = i & 3, t = q0 + ql;
    const size_t grow = (size_t)b * T_ + t;
    bf16x8 qf[4];
    { const bf16* qp = a.qb + grow * 512 + g * 256 + hd * 64 + 8 * hi;
#pragma unroll
      for (int d0 = 0; d0 < 4; ++d0) qf[d0] = *(const bf16x8*)(qp + 16 * d0); }
    float* wsc = (float*)(sm + OFF_WS) + w * 32;
    float* imp = (float*)(sm + OFF_IMP);
    unsigned* selw = (unsigned*)(sm + OFF_SEL);
    unsigned* um = (unsigned*)(sm + OFF_UM);
    for (int k = tid; k < 64 * IMPW; k += 512) imp[k] = 0.f;
    if (tid < 4) um[tid] = 0u;
    const float* gt = a.gates + grow * 24 + g * 12 + hd * 3;
    const float gc = gt[0], gs = gt[1], gw = gt[2];
    f32x16 acc[2], o[2];
#pragma unroll
    for (int r = 0; r < 16; ++r) { acc[0][r] = 0.f; acc[1][r] = 0.f; }
    const int tw0 = q0 + 8 * w, tw1 = tw0 + 7;
    {
        const int nv = t < 31 ? 0 : (t - 31) / 16 + 1;
        const int nvw = tw0 < 31 ? 0 : (tw0 - 31) / 16 + 1;
        const int nvmax = (q0 + 63 - 31) / 16 + 1, ntc = (nvmax + 63) / 64;
        const unsigned cm0 = ntc >= 32 ? ~0u : ((1u << ntc) - 1u);
        const Branch br{a.kc + (size_t)bg * NCP * 64, a.vct + (size_t)bg * 64 * NCP, NCP};
        float m = -1e30f, l = 0.f;
        run_branch<0, false>(sm, br, cm0, 0u, 0u, 0u, qf, 0, nv - 1, 0, nvw - 1, 0u, 0u, 0u, 0u, m, l, 0.f, o, nullptr, wsc, tid, lane);
        l += __shfl_xor(l, 32);
        const float invl = 1.f / fmaxf(l, 1e-30f);
#pragma unroll
        for (int r = 0; r < 16; ++r) { o[0][r] = 0.f; o[1][r] = 0.f; }
        run_branch<1, false>(sm, br, cm0, 0u, 0u, 0u, qf, 0, nv - 1, 0, nvw - 1, 0u, 0u, 0u, 0u, m, l, invl, o, imp + ql * IMPW, wsc, tid, lane);
        add_scaled(acc, o, gc, wsc, i, hi);
    }
    {
        unsigned u0 = 0u, u1 = 0u, u2 = 0u, u3 = 0u;
        const int ncand = cur - 2;
        for (int qq = 0; qq < 8; ++qq) {
            unsigned k0 = 0u, k1 = 0u, k2 = 0u, k3 = 0u;
            if (ncand <= 13) {
#pragma unroll
                for (int wd = 0; wd < 4; ++wd) { const int nb = cur + 1 - 32 * wd; const unsigned x = nb >= 32 ? ~0u : (nb <= 0 ? 0u : ((1u << nb) - 1u));
                    if (wd == 0) k0 = x; else if (wd == 1) k1 = x; else if (wd == 2) k2 = x; else k3 = x; }
            } else {
                const float* ir = imp + (8 * w + qq) * IMPW;
                float v0 = (lane >= 1 && lane <= cur - 2) ? ir[lane] : -1.f;
                float v1 = (lane + 64 <= cur - 2) ? ir[lane + 64] : -1.f;
                for (int it = 0; it < 13; ++it) {
                    float bv = v0; int bs = lane;
                    if (v1 > v0) { bv = v1; bs = lane + 64; }
#pragma unroll
                    for (int off = 1; off < 64; off <<= 1) { const float ov = __shfl_xor(bv, off); const int os = __shfl_xor(bs, off);
                        if (ov > bv || (ov == bv && os < bs)) { bv = ov; bs = os; } }
                    bs = __builtin_amdgcn_readfirstlane(bs);
                    if (bs == lane) v0 = -1.f; if (bs == lane + 64) v1 = -1.f;
                    const unsigned bit = 1u << (bs & 31);
                    if (bs < 32) k0 |= bit; else if (bs < 64) k1 |= bit; else if (bs < 96) k2 |= bit; else k3 |= bit;
                }
                k0 |= 1u;
                { const int c1 = cur - 1; const unsigned bit = 1u << (c1 & 31); if (c1 < 32) k0 |= bit; else if (c1 < 64) k1 |= bit; else if (c1 < 96) k2 |= bit; else k3 |= bit; }
                { const unsigned bit = 1u << (cur & 31); if (cur < 32) k0 |= bit; else if (cur < 64) k1 |= bit; else if (cur < 96) k2 |= bit; else k3 |= bit; }
            }
            if (lane == 0) { unsigned* sp = selw + (8 * w + qq) * 4; sp[0] = k0; sp[1] = k1; sp[2] = k2; sp[3] = k3; }
            u0 |= k0; u1 |= k1; u2 |= k2; u3 |= k3;
        }
        if (lane == 0) { atomicOr(um + 0, u0); atomicOr(um + 1, u1); atomicOr(um + 2, u2); atomicOr(um + 3, u3); }
    }
    __syncthreads();
    {
        const unsigned U0 = um[0], U1 = um[1], U2 = um[2], U3 = um[3];
        const unsigned* sp = selw + ql * 4; const unsigned s0 = sp[0], s1 = sp[1], s2 = sp[2], s3 = sp[3];
        const Branch br{a.ks + (size_t)bg * T_ * 64, a.vst + (size_t)bg * 64 * T_, T_};
        float m = -1e30f, l = 0.f;
#pragma unroll
        for (int r = 0; r < 16; ++r) { o[0][r] = 0.f; o[1][r] = 0.f; }
        run_branch<2, true>(sm, br, __builtin_amdgcn_readfirstlane(U0), __builtin_amdgcn_readfirstlane(U1), __builtin_amdgcn_readfirstlane(U2), __builtin_amdgcn_readfirstlane(U3),
                            qf, 0, t, 0, tw0, s0, s1, s2, s3, m, l, 0.f, o, nullptr, wsc, tid, lane);
        l += __shfl_xor(l, 32);
        add_scaled(acc, o, gs / fmaxf(l, 1e-30f), wsc, i, hi);
    }
    {
        const int j0 = cur - 8 > 0 ? cur - 8 : 0;
        unsigned wm0 = 0u, wm1 = 0u, wm2 = 0u, wm3 = 0u;
#pragma unroll
        for (int wd = 0; wd < 4; ++wd) { const int a0 = j0 - 32 * wd, a1 = cur + 1 - 32 * wd;
            const unsigned hi_m = a1 >= 32 ? ~0u : (a1 <= 0 ? 0u : ((1u << a1) - 1u)), lo_m = a0 >= 32 ? ~0u : (a0 <= 0 ? 0u : ((1u << a0) - 1u));
            const unsigned x = hi_m & ~lo_m; if (wd == 0) wm0 = x; else if (wd == 1) wm1 = x; else if (wd == 2) wm2 = x; else wm3 = x; }
        const Branch br{a.kw + (size_t)bg * T_ * 64, a.vwt + (size_t)bg * 64 * T_, T_};
        float m = -1e30f, l = 0.f;
#pragma unroll
        for (int r = 0; r < 16; ++r) { o[0][r] = 0.f; o[1][r] = 0.f; }
        run_branch<2, false>(sm, br, wm0, wm1, wm2, wm3, qf, t - 511, t, tw1 - 511, tw0, 0u, 0u, 0u, 0u, m, l, 0.f, o, nullptr, wsc, tid, lane);
        l += __shfl_xor(l, 32);
        add_scaled(acc, o, gw / fmaxf(l, 1e-30f), wsc, i, hi);
    }
#pragma unroll
    for (int r = 0; r < 16; ++r) { const int rw = crow(r, hi), qq = 8 * w + (rw >> 2), hh = rw & 3;
        bf16* op = a.amix + ((size_t)b * T_ + q0 + qq) * DM + g * 256 + hh * 64 + i;
        op[0] = (bf16)f2bf(acc[0][r]); op[32] = (bf16)f2bf(acc[1][r]); }
}
__device__ __forceinline__ void phase(const NsaArgs& a, unsigned* ctr, unsigned char* sm) {
    int* slot = (int*)(sm + OFF_UNIT);
    for (;;) {
        if (tidx() == 0) *slot = (int)atomicAdd(ctr, 1u);
        __syncthreads();
        const int u = *slot;
        __syncthreads();
        if (u >= 512) break;
        unit(a, u, sm);
    }
}
}

__device__ __forceinline__ void d_lora_prep(const bf16* pr, const float* mu, bf16* la) {
    const int T512 = tidx(), c = T512 & 255;
    FOR_VB(row, M_) {
        const int t = row % T_;
        const float cur = bf2f(pr[(size_t)row * 256 + c]), prev = t ? bf2f(pr[(size_t)(row - 1) * 256 + c]) : 0.f;
        const float x = cur + (prev - cur) * mu[1536 + c];
        const float v = c < 64 ? tanhf(x) : (c < 128 ? x : sigmoidf_(x));
        la[(size_t)row * KLORA + c] = (bf16)f2bf(v);
    }
}
namespace rw7 {
using nsa::f32x16; using nsa::crow; using nsa::pack8;
constexpr int NSLOT = 4, RA = 144, RB = 40, S_AT = 0, S_RT = 16 * RA, S_BT = 32 * RA, S_KT = S_BT + 64 * RB, S_VT = S_KT + 64 * RB, S_SM = S_VT + 64 * RB, SMM = 16 * RB, S_GC = S_SM + 4 * SMM, SLOT = S_GC + 256;
constexpr int OFF_SCR = 2 * NSLOT * SLOT, SCR = 32 * RA, LDS_NEED = OFF_SCR + NSLOT * SCR;
static_assert(LDS_NEED <= 147456 && SLOT % 16 == 0 && S_BT % 16 == 0 && 128 * RB >= 4096 && SCR >= 4096, "rw7 lds map");
struct Args { const unsigned* rkw; const bf16* vv; const bf16* aga; const float* wdec; const float *mu, *kk, *ka, *rk; float* yraw; float* bonus; };
struct Chan { float mur, muk, muv, kkc, kac, rkc; };
struct Raw { unsigned rk[16]; unsigned short v[16], al[16]; float w[16]; unsigned prk; unsigned short pv; };
__device__ __forceinline__ void fetch(const Args& a, int b, int h, int c, int lane, Raw& q) {
    const size_t base = ((size_t)b * T_ + (size_t)c * 16) * 512 + h * 64 + lane;
#pragma unroll
    for (int t = 0; t < 16; ++t) { q.rk[t] = a.rkw[base + (size_t)t * 512]; q.v[t] = a.vv[base + (size_t)t * 512]; q.al[t] = a.aga[base + (size_t)t * 512]; q.w[t] = a.wdec[base + (size_t)t * 512]; }
    q.prk = 0u; q.pv = 0;
    if (c > 0) { q.prk = a.rkw[base - 512]; q.pv = a.vv[base - 512]; }
}
__device__ __forceinline__ void st_row40(unsigned char* p, const unsigned (&w)[8]) {
    *(u32x2*)p = (u32x2){w[0], w[1]}; *(u32x2*)(p + 8) = (u32x2){w[2], w[3]}; *(u32x2*)(p + 16) = (u32x2){w[4], w[5]}; *(u32x2*)(p + 24) = (u32x2){w[6], w[7]};
}
__device__ __forceinline__ void produce(const Args& a, const Chan& ch, int b, int h, int c, const Raw& q, unsigned char* slot, unsigned char* scr, int lane) {
    const int i = lane & 31, hi = lane >> 5;
    const size_t row0 = (size_t)b * T_ + (size_t)c * 16;
    float pr_r = __builtin_bit_cast(float, q.prk << 16), pr_k = __builtin_bit_cast(float, q.prk & 0xffff0000u), pr_v = bf2f(q.pv);
    float rr[16], kq[16], kt[16];
    float* RED1 = (float*)scr;
    float* RED2 = (float*)(slot + S_BT);
#pragma unroll
    for (int t4 = 0; t4 < 4; ++t4) { f32x4 e1, e2;
#pragma unroll
        for (int e = 0; e < 4; ++e) { const int t = 4 * t4 + e;
            const float r0 = __builtin_bit_cast(float, q.rk[t] << 16), k0 = __builtin_bit_cast(float, q.rk[t] & 0xffff0000u), al = bf2f(q.al[t]);
            const float r = r0 + (pr_r - r0) * ch.mur, k = k0 + (pr_k - k0) * ch.muk;
            pr_r = r0; pr_k = k0;
            rr[t] = r; kq[t] = k * ch.kkc; kt[t] = k * (1.f + (al - 1.f) * ch.kac);
            e1[e] = kq[t] * kq[t]; e2[e] = r * kt[t] * ch.rkc; }
        *(f32x4*)(RED1 + lane * 16 + 4 * t4) = e1; *(f32x4*)(RED2 + lane * 16 + 4 * t4) = e2; }
    asm volatile("s_waitcnt lgkmcnt(0)" ::: "memory");
    { const int t = lane & 15, part = lane >> 4; float s1 = 0.f, s2 = 0.f;
#pragma unroll
      for (int j = 0; j < 16; ++j) { s1 += RED1[(part * 16 + j) * 16 + t]; s2 += RED2[(part * 16 + j) * 16 + t]; }
      s1 += __shfl_xor(s1, 16); s2 += __shfl_xor(s2, 16); s1 += __shfl_xor(s1, 32); s2 += __shfl_xor(s2, 32);
      asm volatile("s_waitcnt lgkmcnt(0)" ::: "memory");
      if (lane < 16) { ((float*)(slot + S_GC))[lane] = s1; a.bonus[(row0 + lane) * 8 + h] = s2; } }
    asm volatile("s_waitcnt lgkmcnt(0)" ::: "memory");
    f32x4 n2[4];
#pragma unroll
    for (int t4 = 0; t4 < 4; ++t4) n2[t4] = *(const f32x4*)(slot + S_GC + 16 * t4);
    asm volatile("s_waitcnt lgkmcnt(0)" ::: "memory");
    float gam = 1.f;
    unsigned btp[8], ktp[8], vtp[8];
    float b_ev = 0.f, k_ev = 0.f, v_ev = 0.f;
#pragma unroll
    for (int t = 0; t < 16; ++t) {
        const float v0 = bf2f(q.v[t]), al = bf2f(q.al[t]);
        const float v = v0 + (pr_v - v0) * ch.muv; pr_v = v0;
        const float kkn = kq[t] * __builtin_amdgcn_rsqf(fmaxf(n2[t >> 2][t & 3], 1e-24f));
        const float gp = gam; gam *= q.w[t]; const float ig = __builtin_amdgcn_rcpf(gam);
        const float bt_ = kkn * al * ig, kt_ = kt[t] * ig;
        const unsigned ar = pk2(-kkn * gp, rr[t] * gam), bk = pk2(bt_, kt_);
        *(bf16*)(slot + S_AT + t * RA + lane * 2) = (bf16)(ar & 0xffffu); *(bf16*)(slot + S_RT + t * RA + lane * 2) = (bf16)(ar >> 16);
        *(bf16*)(scr + t * RA + lane * 2) = (bf16)(bk & 0xffffu); *(bf16*)(scr + (16 + t) * RA + lane * 2) = (bf16)(bk >> 16);
        if (t & 1) { btp[t >> 1] = pk2(b_ev, bt_); ktp[t >> 1] = pk2(k_ev, kt_); vtp[t >> 1] = pk2(v_ev, v); }
        else { b_ev = bt_; k_ev = kt_; v_ev = v; }
    }
    st_row40(slot + S_BT + lane * RB, btp); st_row40(slot + S_KT + lane * RB, ktp); st_row40(slot + S_VT + lane * RB, vtp);
    ((float*)(slot + S_GC))[lane] = gam;
    asm volatile("s_waitcnt lgkmcnt(0)" ::: "memory");
    f32x16 C;
#pragma unroll
    for (int r = 0; r < 16; ++r) C[r] = 0.f;
#pragma unroll
    for (int ks = 0; ks < 4; ++ks) {
        const bf16x8 af = *(const bf16x8*)(slot + S_AT + i * RA + (16 * ks + 8 * hi) * 2);
        const bf16x8 bf = *(const bf16x8*)(scr + i * RA + (16 * ks + 8 * hi) * 2);
        C = __builtin_amdgcn_mfma_f32_32x32x16_bf16(af, bf, C, 0, 0, 0);
    }
    asm volatile("s_waitcnt lgkmcnt(0)" ::: "memory");
    float* AAB = (float*)scr;
    unsigned char* SM = slot + S_SM;
#pragma unroll
    for (int r = 0; r < 16; ++r) {
        const int rho = crow(r, hi); const float val = C[r];
        if (r < 8) {
            if (i < 16) AAB[rho * 16 + i] = (i < rho) ? val : 0.f;
            else *(bf16*)(SM + SMM + rho * RB + (i - 16) * 2) = (bf16)f2bf((i - 16 < rho) ? val : 0.f);
        } else {
            const int tt = rho - 16;
            if (i < 16) *(bf16*)(SM + 2 * SMM + tt * RB + i * 2) = (bf16)f2bf((i <= tt) ? val : 0.f);
            else *(bf16*)(SM + 3 * SMM + tt * RB + (i - 16) * 2) = (bf16)f2bf((i - 16 <= tt) ? val : 0.f);
        }
    }
    asm volatile("s_waitcnt lgkmcnt(0)" ::: "memory");
    { const int j = lane & 15; float Tr[16];
#pragma unroll
      for (int t = 0; t < 16; ++t) { float acc = (t == j) ? 1.f : 0.f;
#pragma unroll
          for (int s4 = 0; s4 < (t + 3) / 4; ++s4) { const f32x4 ar = *(const f32x4*)(AAB + t * 16 + 4 * s4);
#pragma unroll
              for (int e = 0; e < 4; ++e) if (4 * s4 + e < t) acc += ar[e] * Tr[4 * s4 + e]; }
          Tr[t] = acc;
          if (lane < 16) *(bf16*)(SM + t * RB + j * 2) = (bf16)f2bf(acc); } }
}

__device__ __forceinline__ bf16x8 rd_perm(const unsigned char* p, int hi) {
    const u32x2 a = *(const u32x2*)(p + 8 * hi), b = *(const u32x2*)(p + 16 + 8 * hi);
    return __builtin_bit_cast(bf16x8, (u32x4){a.x, a.y, b.x, b.y});
}
__device__ __forceinline__ bf16x8 rd_nat(const unsigned char* p, int hi) {
    const u32x2 a = *(const u32x2*)(p + 16 * hi), b = *(const u32x2*)(p + 16 * hi + 8);
    return __builtin_bit_cast(bf16x8, (u32x4){a.x, a.y, b.x, b.y});
}
__device__ __forceinline__ void consume(const unsigned char* slot, f32x16 (&z)[2], float* yout, int vt, int lane) {
    const int i = lane & 31, hi = lane >> 5, i16 = i & 15; const bool lo16 = i < 16;
    const bf16x8 zero = {0, 0, 0, 0, 0, 0, 0, 0};
    const bf16x8 zb0 = pack8(z[0], 0), zb1 = pack8(z[0], 8), zb2 = pack8(z[1], 0), zb3 = pack8(z[1], 8);
    const unsigned char* at = slot + S_AT + i16 * RA; const unsigned char* rt = slot + S_RT + i16 * RA; const unsigned char* sm16 = slot + S_SM + i16 * RB;
    const bf16x8 vtf = rd_nat(slot + S_VT + (32 * vt + i) * RB, hi);
    f32x16 X, U, Y;
#pragma unroll
    for (int r = 0; r < 16; ++r) { X[r] = 0.f; U[r] = 0.f; Y[r] = 0.f; }
    X = __builtin_amdgcn_mfma_f32_32x32x16_bf16(lo16 ? rd_perm(at, hi) : zero, zb0, X, 0, 0, 0);
    X = __builtin_amdgcn_mfma_f32_32x32x16_bf16(lo16 ? rd_perm(at + 32, hi) : zero, zb1, X, 0, 0, 0);
    X = __builtin_amdgcn_mfma_f32_32x32x16_bf16(lo16 ? rd_perm(at + 64, hi) : zero, zb2, X, 0, 0, 0);
    X = __builtin_amdgcn_mfma_f32_32x32x16_bf16(lo16 ? rd_perm(at + 96, hi) : zero, zb3, X, 0, 0, 0);
    X = __builtin_amdgcn_mfma_f32_32x32x16_bf16(lo16 ? rd_nat(sm16 + SMM, hi) : zero, vtf, X, 0, 0, 0);
    const bf16x8 xb = pack8(X, 0);
    U = __builtin_amdgcn_mfma_f32_32x32x16_bf16(lo16 ? rd_perm(sm16, hi) : zero, xb, U, 0, 0, 0);
    const bf16x8 ub = pack8(U, 0);
    Y = __builtin_amdgcn_mfma_f32_32x32x16_bf16(lo16 ? rd_perm(rt, hi) : zero, zb0, Y, 0, 0, 0);
    Y = __builtin_amdgcn_mfma_f32_32x32x16_bf16(lo16 ? rd_perm(rt + 32, hi) : zero, zb1, Y, 0, 0, 0);
    Y = __builtin_amdgcn_mfma_f32_32x32x16_bf16(lo16 ? rd_perm(rt + 64, hi) : zero, zb2, Y, 0, 0, 0);
    Y = __builtin_amdgcn_mfma_f32_32x32x16_bf16(lo16 ? rd_perm(rt + 96, hi) : zero, zb3, Y, 0, 0, 0);
    Y = __builtin_amdgcn_mfma_f32_32x32x16_bf16(lo16 ? rd_perm(sm16 + 2 * SMM, hi) : zero, ub, Y, 0, 0, 0);
    Y = __builtin_amdgcn_mfma_f32_32x32x16_bf16(lo16 ? rd_nat(sm16 + 3 * SMM, hi) : zero, vtf, Y, 0, 0, 0);
#pragma unroll
    for (int kt = 0; kt < 2; ++kt) {
        z[kt] = __builtin_amdgcn_mfma_f32_32x32x16_bf16(rd_nat(slot + S_KT + (32 * kt + i) * RB, hi), vtf, z[kt], 0, 0, 0);
        z[kt] = __builtin_amdgcn_mfma_f32_32x32x16_bf16(rd_perm(slot + S_BT + (32 * kt + i) * RB, hi), ub, z[kt], 0, 0, 0);
#pragma unroll
        for (int rg = 0; rg < 4; ++rg) { const f32x4 g4 = *(const f32x4*)(slot + S_GC + (32 * kt + 8 * rg + 4 * hi) * 4);
#pragma unroll
            for (int e = 0; e < 4; ++e) z[kt][4 * rg + e] *= g4[e]; }
    }
#pragma unroll
    for (int r = 0; r < 8; ++r) yout[(size_t)crow(r, hi) * 512] = Y[r];
}

__device__ __forceinline__ void head(const Args& a, int bh, unsigned char* sm) {
    const int tid = tidx(), lane = tid & 63, w = __builtin_amdgcn_readfirstlane(tid >> 6);
    const int b = bh >> 3, h = bh & 7;
    constexpr int NSTEP = T_ / 16 / NSLOT;
    if (w < 2) {
        f32x16 z[2];
#pragma unroll
        for (int r = 0; r < 16; ++r) { z[0][r] = 0.f; z[1][r] = 0.f; }
        __syncthreads();
        for (int g = 0; g < NSTEP; ++g) {
#pragma unroll
            for (int p = 0; p < NSLOT; ++p) {
                const int c = NSLOT * g + p;
                consume(sm + (size_t)((g & 1) * NSLOT + p) * SLOT, z, a.yraw + ((size_t)b * T_ + (size_t)c * 16) * 512 + h * 64 + 32 * w + (lane & 31), w, lane);
            }
            __syncthreads();
        }
    } else if ((w & 2) != 0) {
        const int pw = (w & 1) | ((w >> 2) << 1), col = h * 64 + lane;
        const Chan ch{a.mu[col], a.mu[512 + col], a.mu[1024 + col], a.kk[col], a.ka[col], a.rk[col]};
        unsigned char* scr = sm + OFF_SCR + pw * SCR;
        Raw q; fetch(a, b, h, pw, lane, q);
        { Raw nq; fetch(a, b, h, pw + NSLOT, lane, nq); produce(a, ch, b, h, pw, q, sm + (size_t)pw * SLOT, scr, lane); q = nq; }
        __syncthreads();
        for (int g = 0; g < NSTEP; ++g) {
            const int c = NSLOT * (g + 1) + pw;
            if (c < T_ / 16) { Raw nq; if (c + NSLOT < T_ / 16) fetch(a, b, h, c + NSLOT, lane, nq);
                produce(a, ch, b, h, c, q, sm + (size_t)(((g + 1) & 1) * NSLOT + pw) * SLOT, scr, lane); q = nq; }
            __syncthreads();
        }
    } else {
        __syncthreads();
        for (int g = 0; g < NSTEP; ++g) __syncthreads();
    }
}
__device__ __forceinline__ void finish(const float* yraw, const float* bonus, const bf16* vv, const bf16* agg, const float* mu, const float* gng, const float* gnb, bf16* amix) {
    const int T512 = tidx(), lane = T512 & 63;
    for (int it = blockIdx.x * 8 + (T512 >> 6); it < M_ * 8; it += gridDim.x * 8) {
        const int row = it >> 3, h = it & 7, col = h * 64 + lane, t = row % T_;
        const float y = yraw[(size_t)row * 512 + col], mean = wave_sum(y) * (1.f / 64.f), dy = y - mean, var = wave_sum(dy * dy) * (1.f / 64.f);
        const float yn = dy * rsqrtf(var + 64e-5f) * gng[col] + gnb[col];
        const float v0 = bf2f(vv[(size_t)row * 512 + col]), v1 = t ? bf2f(vv[(size_t)(row - 1) * 512 + col]) : 0.f;
        const float v = v0 + (v1 - v0) * mu[1024 + col];
        amix[(size_t)row * DM + 512 + col] = (bf16)f2bf((yn + bonus[(size_t)row * 8 + h] * v) * bf2f(agg[(size_t)row * 512 + col]));
    }
}
}

namespace mema {
using nsa::f32x16; using nsa::KROW; using nsa::VROW; using nsa::KBUF; using nsa::VBUF; using nsa::OFF_K; using nsa::OFF_V; using nsa::OFF_WS; using nsa::crow; using nsa::pack8;
__device__ __forceinline__ void unit(const bf16* qm, const bf16* mk, const bf16* mvt, bf16* om, int u, unsigned char* sm) {
    const int tid = tidx(), lane = tid & 63, w = __builtin_amdgcn_readfirstlane(tid >> 6), i = lane & 31, hi = lane >> 5;
    const int b = u >> 7, h = (u >> 5) & 3, rb = u & 31;
    const int row0 = b * T_ + rb * 256 + 32 * w;
    const bf16* qrow = qm + (size_t)(row0 + i) * DM + h * 256 + 8 * hi;
    const bf16* kbase = mk + (size_t)(b * 256 + (tid >> 3)) * DM + h * 256 + (tid & 7) * 8;
    const bf16* vbase = mvt + (size_t)(h * 256 + (tid >> 3)) * 512 + b * 256 + (tid & 7) * 8;
    unsigned char* kst = sm + OFF_K + (tid >> 3) * KROW + (tid & 7) * 16;
    unsigned char* vst = sm + OFF_V + (tid >> 3) * VROW + (tid & 7) * 16;
    float* wsc = (float*)(sm + OFF_WS) + w * 32;
    f32x16 p[4][2];
#pragma unroll
    for (int kt = 0; kt < 4; ++kt)
#pragma unroll
        for (int r = 0; r < 16; ++r) { p[kt][0][r] = 0.f; p[kt][1][r] = 0.f; }
    u32x4 tr = *(const u32x4*)kbase;
    *(u32x4*)kst = tr;
    __syncthreads();
    bf16x8 qf[4];
#pragma unroll
    for (int n = 0; n < 16; ++n) {
        const int dc = n >> 2, kt = n & 3, cb = n & 1;
        if (n + 1 < 16) tr = *(const u32x4*)(kbase + (size_t)(64 * ((n + 1) & 3)) * DM + 64 * ((n + 1) >> 2));
        else tr = *(const u32x4*)vbase;
        if (kt == 0) {
#pragma unroll
            for (int d0 = 0; d0 < 4; ++d0) qf[d0] = *(const bf16x8*)(qrow + 64 * dc + 16 * d0);
        }
        const unsigned char* kb = sm + OFF_K + cb * KBUF;
#pragma unroll
        for (int d0 = 0; d0 < 4; ++d0) {
            const bf16x8 a0 = *(const bf16x8*)(kb + i * KROW + (16 * d0 + 8 * hi) * 2);
            const bf16x8 a1 = *(const bf16x8*)(kb + (32 + i) * KROW + (16 * d0 + 8 * hi) * 2);
            p[kt][0] = __builtin_amdgcn_mfma_f32_32x32x16_bf16(a0, qf[d0], p[kt][0], 0, 0, 0);
            p[kt][1] = __builtin_amdgcn_mfma_f32_32x32x16_bf16(a1, qf[d0], p[kt][1], 0, 0, 0);
        }
        if (n + 1 < 16) *(u32x4*)(kst + (cb ^ 1) * KBUF) = tr;
        else { *(u32x2*)vst = (u32x2){tr.x, tr.y}; *(u32x2*)(vst + 8) = (u32x2){tr.z, tr.w}; }
        __syncthreads();
    }
    float mx = p[0][0][0];
#pragma unroll
    for (int kt = 0; kt < 4; ++kt)
#pragma unroll
        for (int r = 0; r < 16; ++r) mx = fmaxf(mx, fmaxf(p[kt][0][r], p[kt][1][r]));
    mx = fmaxf(mx, __shfl_xor(mx, 32));
    float l = 0.f;
#pragma unroll
    for (int kt = 0; kt < 4; ++kt)
#pragma unroll
        for (int r = 0; r < 16; ++r) { p[kt][0][r] = __builtin_amdgcn_exp2f(p[kt][0][r] - mx); p[kt][1][r] = __builtin_amdgcn_exp2f(p[kt][1][r] - mx); l += p[kt][0][r] + p[kt][1][r]; }
    l += __shfl_xor(l, 32);
    bf16x8 pf[4][4];
#pragma unroll
    for (int kt = 0; kt < 4; ++kt) { pf[kt][0] = pack8(p[kt][0], 0); pf[kt][1] = pack8(p[kt][0], 8); pf[kt][2] = pack8(p[kt][1], 0); pf[kt][3] = pack8(p[kt][1], 8); }
    if (hi == 0) wsc[i] = 1.f / l;
    asm volatile("" ::: "memory");
    f32x4 il[4];
#pragma unroll
    for (int rg = 0; rg < 4; ++rg) il[rg] = *(const f32x4*)(wsc + 8 * rg + 4 * hi);
    f32x16 o[2];
#pragma unroll
    for (int n = 0; n < 16; ++n) {
        const int dvt = n >> 2, kt = n & 3, cb = n & 1;
        if (n + 1 < 16) tr = *(const u32x4*)(vbase + (size_t)(64 * ((n + 1) >> 2)) * 512 + 64 * ((n + 1) & 3));
        if (kt == 0) {
#pragma unroll
            for (int r = 0; r < 16; ++r) { o[0][r] = 0.f; o[1][r] = 0.f; }
        }
        const unsigned char* vb = sm + OFF_V + cb * VBUF;
#pragma unroll
        for (int dt = 0; dt < 2; ++dt) {
            const unsigned char* vp = vb + (32 * dt + i) * VROW + 8 * hi;
#pragma unroll
            for (int ks = 0; ks < 4; ++ks) {
                const u32x2 v_lo = *(const u32x2*)(vp + 32 * ks), v_hi = *(const u32x2*)(vp + 32 * ks + 16);
                const bf16x8 vf = __builtin_bit_cast(bf16x8, (u32x4){v_lo.x, v_lo.y, v_hi.x, v_hi.y});
                o[dt] = __builtin_amdgcn_mfma_f32_32x32x16_bf16(pf[kt][ks], vf, o[dt], 0, 0, 0);
            }
        }
        if (kt == 3) {
#pragma unroll
            for (int r = 0; r < 16; ++r) { bf16* op = om + (size_t)(row0 + crow(r, hi)) * DM + h * 256 + 64 * dvt + i;
                op[0] = (bf16)f2bf(o[0][r] * il[r >> 2][r & 3]); op[32] = (bf16)f2bf(o[1][r] * il[r >> 2][r & 3]); }
        }
        if (n + 1 < 16) { unsigned char* vp2 = vst + (cb ^ 1) * VBUF; *(u32x2*)vp2 = (u32x2){tr.x, tr.y}; *(u32x2*)(vp2 + 8) = (u32x2){tr.z, tr.w}; }
        __syncthreads();
    }
}
}

namespace cg = cooperative_groups;
constexpr int NTHREADS = 512, LDS_BYTES = 147456;
struct MegaArgs { const float* in[41]; float* out; unsigned char* ws; };
#define WSB(off) ((bf16*)(ws + (off)))
#define WSF(off) ((float*)(ws + (off)))

__global__ void __launch_bounds__(NTHREADS) mega_fwd(MegaArgs A) {
    extern __shared__ __attribute__((aligned(16))) unsigned char lds[];
    cg::grid_group grid = cg::this_grid();
    const float* const* in = A.in; unsigned char* ws = A.ws; float* out = A.out;

    d_convert(WSB(WS_W1GU), NGU, DM, MapGU{in[I_F1_WG], in[I_F1_WU], FF});
    d_convert(WSB(WS_W1D), DM, FF, MapPlain{in[I_F1_WD], DM});
    d_convert(WSB(WS_W2GU), NGU, DM, MapGU{in[I_F2_WG], in[I_F2_WU], FF});
    d_convert(WSB(WS_W2D), DM, FF, MapPlain{in[I_F2_WD], DM});
    d_convert(WSB(WS_WIN), NWIN, DM, MapWin{in[I_WIN], IN_COLS});
    d_convert(WSB(WS_WOUT), DM, DM, MapPlain{in[I_WOUT], DM});
    d_convert(WSB(WS_WQ), DM, DM, MapPlain{in[I_WQ], DM});
    d_convert(WSB(WS_WK), DM, DM, MapPlain{in[I_WK], DM});
    d_convert(WSB(WS_WV), DM, DM, MapPlain{in[I_WV], DM});
    d_convert(WSB(WS_WO), DM, DM, MapPlain{in[I_WO], DM});
    d_convert(WSB(WS_CW1K), 256, 2048, MapPlain{in[I_W1_K], 256});
    d_convert(WSB(WS_CW1V), 256, 2048, MapPlain{in[I_W1_V], 256});
    d_convert_lora(WSB(WS_WLORA), in[I_W2], in[I_A2], in[I_G2]);
    d_rope_table(WSF(WS_ROPE));
    d_cmp_bias(in[I_PE_K], in[I_W1_K], in[I_PE_V], in[I_W1_V], WSF(WS_CBIAS), (float*)lds);
    d_rownorm(in[I_X], in[I_F1_PRE], WSB(WS_XN), M_);
    d_rownorm(in[I_MEM], in[I_MEM_KVG], WSB(WS_MEMN), 512);
    grid.sync();
    gemm_pg8(lds, WSB(WS_XN), DM, WSB(WS_W1GU), DM, M_, NGU, DM, EpiSwiGLU{WSB(WS_HB)});
    grid.sync();
    gemm_pg8(lds, WSB(WS_HB), FF, WSB(WS_W1D), FF, M_, DM, FF, EpiStore{WSB(WS_YB), DM, 1.f});
    grid.sync();
    d_rowpass(in[I_X], WSB(WS_YB), in[I_F1_POST], 0.5f, in[I_MIX_PRE], out, WSB(WS_XN));
    grid.sync();
    gemm_pg8(lds, WSB(WS_XN), DM, WSB(WS_WIN), DM, M_, NWIN, DM,
             EpiWin{WSB(WS_QB), WSB(WS_KS), WSB(WS_KW), WSB(WS_KCR), WSB(WS_VCR), WSB(WS_VST), WSB(WS_VWT), (unsigned*)(ws + WS_RKVA), WSB(WS_RKVA + 32 * MiB), WSB(WS_PRL), WSF(WS_GATES), WSF(WS_ROPE)});
    grid.sync();
    gemm_pg8(lds, WSB(WS_KCR), 1024, WSB(WS_CW1K), 2048, 2048, 256, 2048, EpiBiasSilu{WSB(WS_HIDK), WSF(WS_CBIAS)});
    gemm_pg8(lds, WSB(WS_VCR), 1024, WSB(WS_CW1V), 2048, 2048, 256, 2048, EpiBiasSilu{WSB(WS_HIDV), WSF(WS_CBIAS) + 256});
    d_lora_prep(WSB(WS_PRL), in[I_MU], WSB(WS_XN));
    grid.sync();
    d_cmp2(WSB(WS_HIDK), WSB(WS_HIDV), in[I_W2_K], in[I_W2_V], WSF(WS_ROPE), WSB(WS_KC), WSB(WS_VCT));
    gemm_pg8(lds, WSB(WS_XN), KLORA, WSB(WS_WLORA), KLORA, M_, NLORA, KLORA, EpiLora{WSF(WS_YB), WSB(WS_RKVA + 48 * MiB), WSB(WS_AGG), in[I_W0], in[I_A0]});
    grid.sync();
    if (blockIdx.x < 16) {
        const rw7::Args ra{(const unsigned*)(ws + WS_RKVA), WSB(WS_RKVA + 32 * MiB), WSB(WS_RKVA + 48 * MiB), WSF(WS_YB), in[I_MU], in[I_KK], in[I_KA], in[I_RK], WSF(WS_YB), WSF(WS_BONUS)};
        rw7::head(ra, blockIdx.x, lds);
    }
    {
        const NsaArgs na{WSB(WS_QB), WSB(WS_KC), WSB(WS_VCT), WSB(WS_KS), WSB(WS_VST), WSB(WS_KW), WSB(WS_VWT), WSF(WS_GATES), WSB(WS_XN)};
        nsa::phase(na, (unsigned*)(ws + WS_CTL), lds);
    }
    grid.sync();
    d_nsa_outnorm(WSB(WS_XN), in[I_NSA_G]);
    rw7::finish(WSF(WS_YB), WSF(WS_BONUS), WSB(WS_RKVA + 32 * MiB), WSB(WS_AGG), in[I_MU], in[I_GNG], in[I_GNB], WSB(WS_XN));
    grid.sync();
    gemm_pg8(lds, WSB(WS_XN), DM, WSB(WS_WOUT), DM, M_, DM, DM, EpiStore{WSB(WS_YB), DM, 1.f});
    grid.sync();
    d_rowpass(out, WSB(WS_YB), in[I_MIX_POST], 1.0f, in[I_MEM_PRE], out, WSB(WS_XN));
    grid.sync();
    gemm_pg8(lds, WSB(WS_XN), DM, WSB(WS_WQ), DM, M_, DM, DM, EpiStore{WSB(WS_QM), DM, MSCALE});
    gemm_pg8(lds, WSB(WS_MEMN), DM, WSB(WS_WK), DM, 512, DM, DM, EpiStore{WSB(WS_MK), DM, 1.f});
    gemm_pg8(lds, WSB(WS_WV), DM, WSB(WS_MEMN), DM, DM, 512, DM, EpiStore{WSB(WS_MVT), 512, 1.f});
    grid.sync();
    for (int u = blockIdx.x; u < 256; u += gridDim.x) mema::unit(WSB(WS_QM), WSB(WS_MK), WSB(WS_MVT), WSB(WS_OM), u, lds);
    grid.sync();
    gemm_pg8(lds, WSB(WS_OM), DM, WSB(WS_WO), DM, M_, DM, DM, EpiStore{WSB(WS_YB), DM, 1.f});
    grid.sync();
    d_rowpass(out, WSB(WS_YB), in[I_MEM_POST], 1.0f, in[I_F2_PRE], out, WSB(WS_XN));
    grid.sync();
    gemm_pg8(lds, WSB(WS_XN), DM, WSB(WS_W2GU), DM, M_, NGU, DM, EpiSwiGLU{WSB(WS_HB)});
    grid.sync();
    gemm_pg8(lds, WSB(WS_HB), FF, WSB(WS_W2D), FF, M_, DM, FF, EpiStore{WSB(WS_YB), DM, 1.f});
    grid.sync();
    d_rowpass(out, WSB(WS_YB), in[I_F2_POST], 0.5f, (const float*)nullptr, out, (bf16*)nullptr);
}

extern "C" void kernel_launch(void* const* d_in, const int* in_sizes, int n_in, void* d_out, int out_size, void* d_ws, size_t ws_size, hipStream_t stream) {
    static int grid = 0;
    if (grid == 0) {
        if (n_in != 41 || ws_size < WS_END) { fprintf(stderr, "kernel_launch: unexpected n_in %d / ws %zu\n", n_in, ws_size); grid = -1; return; }
        int dev = 0, cus = 0, per_cu = 0;
        hipGetDevice(&dev); hipDeviceGetAttribute(&cus, hipDeviceAttributeMultiprocessorCount, dev);
        if (hipFuncSetAttribute((const void*)mega_fwd, hipFuncAttributeMaxDynamicSharedMemorySize, LDS_BYTES) != hipSuccess) { fprintf(stderr, "kernel_launch: hipFuncSetAttribute failed\n"); grid = -1; return; }
        if (hipOccupancyMaxActiveBlocksPerMultiprocessor(&per_cu, (const void*)mega_fwd, NTHREADS, LDS_BYTES) != hipSuccess || per_cu < 1) { fprintf(stderr, "kernel_launch: occupancy query says %d\n", per_cu); grid = -1; (void)hipGetLastError(); return; }
        grid = cus;
    }
    if (grid < 0) return;
    MegaArgs a{};
    for (int i = 0; i < 41; ++i) a.in[i] = (const float*)d_in[i];
    a.out = (float*)d_out; a.ws = (unsigned char*)d_ws;
    hipMemsetAsync(d_ws, 0, 4096, stream);
    void* args[] = {&a};
    hipError_t e = hipLaunchCooperativeKernel((const void*)mega_fwd, dim3(grid), dim3(NTHREADS), args, LDS_BYTES, stream);
    if (e != hipSuccess) fprintf(stderr, "kernel_launch: cooperative launch failed: %s (grid %d)\n", hipGetErrorString(e), grid);
}
```

```cpp
#include <hip/hip_runtime.h>
#include <hip/hip_cooperative_groups.h>
#include <cstdint>
#include <cstdio>

constexpr int NB = 2, T_ = 8192, DM = 1024, M_ = NB * T_;
constexpr int FF = 2816, NGU = 2 * FF;
constexpr int IN_COLS = 3096, NWIN = 3328;
constexpr int NRW = 1792;
constexpr int NCP = 512;
constexpr int NLORA = 1536, KLORA = 256;
constexpr float NORM_EPS = 1e-6f;
constexpr float QSCALE = 0.125f * 1.4426950408889634f;
constexpr float MSCALE = 0.0625f * 1.4426950408889634f;

typedef unsigned short bf16;
typedef short bf16x8 __attribute__((ext_vector_type(8)));
typedef float f32x4 __attribute__((ext_vector_type(4)));
typedef unsigned u32x2 __attribute__((ext_vector_type(2)));
typedef unsigned u32x4 __attribute__((ext_vector_type(4)));

__device__ __forceinline__ unsigned f2bf(float f) { unsigned u = __builtin_bit_cast(unsigned, f); return (u + 0x7fffu + ((u >> 16) & 1u)) >> 16; }
__device__ __forceinline__ float bf2f(bf16 h) { return __builtin_bit_cast(float, (unsigned)h << 16); }
typedef float f32x2_t __attribute__((ext_vector_type(2))); typedef __bf16 bf16x2_t __attribute__((ext_vector_type(2)));
__device__ __forceinline__ unsigned pk2(float lo, float hi) { const f32x2_t v = {lo, hi}; return __builtin_bit_cast(unsigned, __builtin_convertvector(v, bf16x2_t)); }
__device__ __forceinline__ void st_bf4(bf16* p, f32x4 v) { u32x2 w; w.x = pk2(v[0], v[1]); w.y = pk2(v[2], v[3]); *(u32x2*)p = w; }
__device__ __forceinline__ float wave_sum(float v) {
#pragma unroll
    for (int o = 1; o < 64; o <<= 1) v += __shfl_xor(v, o);
    return v;
}
__device__ __forceinline__ float wave_max(float v) {
#pragma unroll
    for (int o = 1; o < 64; o <<= 1) v = fmaxf(v, __shfl_xor(v, o));
    return v;
}
__device__ __forceinline__ float sigmoidf_(float x) { return 1.f / (1.f + __expf(-x)); }
__device__ __forceinline__ int tidx() { int t = threadIdx.x; asm volatile("" : "+v"(t)); return t; }

constexpr size_t MiB = 1u << 20, KiB64 = 65536;
constexpr size_t WS_CTL = 0;
constexpr size_t WS_KC = 256 * 1024;
constexpr size_t WS_VCT = 512 * 1024;
constexpr size_t WS_W1GU = 1 * MiB;
constexpr size_t WS_W1D = 12 * MiB;
constexpr size_t WS_W2GU = WS_W1D + 88 * KiB64;
constexpr size_t WS_W2D = WS_W2GU + 11 * MiB;
constexpr size_t WS_WIN = WS_W2D + 88 * KiB64;
constexpr size_t WS_WOUT = WS_WIN + 104 * KiB64;
constexpr size_t WS_WQ = WS_WOUT + 2 * MiB, WS_WK = WS_WQ + 2 * MiB, WS_WV = WS_WK + 2 * MiB, WS_WO = WS_WV + 2 * MiB;
constexpr size_t WS_CW1K = WS_WO + 2 * MiB, WS_CW1V = WS_CW1K + 1 * MiB;
constexpr size_t WS_WLORA = WS_CW1V + 1 * MiB;
constexpr size_t WS_ROPE = WS_WLORA + 12 * KiB64;
constexpr size_t WS_CBIAS = WS_ROPE + 2 * MiB;
constexpr size_t WS_MEMN = WS_CBIAS + KiB64;
constexpr size_t WS_HIDK = WS_MEMN + 1 * MiB;
constexpr size_t WS_HIDV = WS_HIDK + 1 * MiB;
constexpr size_t WS_GATES = WS_HIDV + 1 * MiB;
constexpr size_t WS_XN = 60 * MiB;
constexpr size_t WS_YB = 92 * MiB;
constexpr size_t WS_D = 124 * MiB;
constexpr size_t WS_HB = WS_D;
constexpr size_t WS_QB = WS_D;
constexpr size_t WS_KS = WS_D + 16 * MiB;
constexpr size_t WS_KW = WS_D + 20 * MiB;
constexpr size_t WS_KCR = WS_D + 24 * MiB;
constexpr size_t WS_VCR = WS_D + 29 * MiB;
constexpr size_t WS_VST = WS_D + 34 * MiB;
constexpr size_t WS_VWT = WS_D + 38 * MiB;
constexpr size_t WS_RKVA = WS_D + 42 * MiB;
constexpr size_t WS_PRL = WS_D + 106 * MiB;
constexpr size_t WS_AGG = WS_D + 114 * MiB;
constexpr size_t WS_BONUS = WS_KCR;
constexpr size_t WS_END = 256 * MiB;
constexpr size_t WS_QM = WS_D;
constexpr size_t WS_OM = WS_D + 32 * MiB;
constexpr size_t WS_MK = WS_D + 64 * MiB;
constexpr size_t WS_MVT = WS_D + 65 * MiB;
static_assert(WS_GATES + (size_t)M_ * 24 * 4 <= WS_XN, "ws map");
static_assert(WS_AGG + 16 * MiB <= WS_END, "ws map");

struct Params {
    const float* in[41];
    float* out;
    unsigned char* ws;
};
enum { I_X = 0, I_MEM, I_F1_PRE, I_F1_WG, I_F1_WU, I_F1_WD, I_F1_POST, I_MIX_PRE, I_WIN, I_PE_K, I_W1_K, I_W2_K, I_PE_V, I_W1_V, I_W2_V,
       I_NSA_G, I_MU, I_W0, I_W2, I_A0, I_A2, I_G2, I_KK, I_KA, I_RK, I_GNG, I_GNB, I_WOUT, I_MIX_POST, I_MEM_PRE, I_MEM_KVG, I_WQ, I_WK, I_WV,
       I_WO, I_MEM_POST, I_F2_PRE, I_F2_WG, I_F2_WU, I_F2_WD, I_F2_POST };

struct MapPlain { const float* W; int N; int pad; __device__ const float* col(int p) const { return W + p; } };
struct MapGU {
    const float* Wg; const float* Wu; int N; int pad;
    __device__ const float* col(int p) const {
        const int pn = p >> 8, q = p & 255, n = (q >> 4) & 1;
        const int hid = 128 * pn + 64 * (q >> 7) + 16 * ((q >> 5) & 3) + (q & 15);
        return Wg + (size_t)n * (size_t)(Wu - Wg) + hid;
    }
};
__host__ __device__ inline int rope_perm(int x) { return 16 * ((x >> 5) & 1) + (x & 15) + 32 * ((x >> 4) & 1); }
struct MapWin {
    const float* W; int N; int pad;
    __device__ const float* col(int p) const {
        int l;
        if (p < 512) l = (p & ~63) + rope_perm(p & 63);
        else if (p < 640) l = 768 + ((p - 512) & ~63) + rope_perm(p & 63);
        else if (p < 768) l = 1024 + ((p - 640) & ~63) + rope_perm(p & 63);
        else if (p < 896) l = 512 + (p - 768);
        else if (p < 1024) l = 640 + (p - 896);
        else if (p < 1152) l = 896 + (p - 1024);
        else if (p < 1280) l = 1152 + (p - 1152);
        else if (p < 2304) { const int q = p - 1280; l = 1304 + (((q >> 4) & 1) ? 512 : 0) + 16 * (q >> 5) + (q & 15); }
        else if (p < 3072) l = 1304 + (p - 1280);
        else if (p < 3096) l = 1280 + (p - 3072);
        else return nullptr;
        return W + l;
    }
};

#define FOR_VB(vb, n) for (int vb = (int)blockIdx.x * 2 + (T512 >> 8); vb < (n); vb += (int)gridDim.x * 2)

template <class Map> __device__ __forceinline__ void d_convert(bf16* WT, int Np, int K, Map map) {
    const int T512 = tidx(), tid = T512 & 255, nbx = Np / 64, nb = nbx * (K / 64);
    FOR_VB(vb, nb) {
        const int p = (vb % nbx) * 64 + (tid & 63), k0 = (vb / nbx) * 64 + (tid >> 6) * 16;
        const float* src = map.col(p);
        float v[16];
#pragma unroll
        for (int i = 0; i < 16; ++i) v[i] = src ? src[(size_t)(k0 + i) * map.N] : 0.f;
        u32x4 a, b;
        a.x = pk2(v[0], v[1]); a.y = pk2(v[2], v[3]); a.z = pk2(v[4], v[5]); a.w = pk2(v[6], v[7]);
        b.x = pk2(v[8], v[9]); b.y = pk2(v[10], v[11]); b.z = pk2(v[12], v[13]); b.w = pk2(v[14], v[15]);
        u32x4* dst = (u32x4*)(WT + (size_t)p * K + k0);
        dst[0] = a; dst[1] = b;
    }
}
__device__ __forceinline__ void d_convert_lora(bf16* WT, const float* w2, const float* a2, const float* g2) {
    const int T512 = tidx(), tid = T512 & 255;
    FOR_VB(vb, NLORA * KLORA / 256) {
        const int idx = vb * 256 + tid, p = idx >> 8, k = idx & 255;
        float v = 0.f;
        if (p < 512) { if (k < 64) v = w2[k * 512 + p]; }
        else if (p < 1024) { if (k >= 64 && k < 128) v = a2[(k - 64) * 512 + (p - 512)]; }
        else { if (k >= 128) v = g2[(k - 128) * 512 + (p - 1024)]; }
        WT[idx] = (bf16)f2bf(v);
    }
}
__device__ __forceinline__ void d_rope_table(float* tab) {
    const int T512 = tidx(), tid = T512 & 255;
    FOR_VB(vb, T_ * 32 / 256) {
        const int idx = vb * 256 + tid, pos = idx >> 5, i = idx & 31;
        const float inv = (float)pow(10000.0, -(double)i / 32.0);
        const float ang = (float)pos * inv;
        tab[2 * idx] = (float)cos((double)ang); tab[2 * idx + 1] = (float)sin((double)ang);
    }
}
__device__ __forceinline__ void d_cmp_bias(const float* pe_k, const float* w1_k, const float* pe_v, const float* w1_v, float* bias, float* red  ) {
    for (int job = blockIdx.x; job < 8; job += gridDim.x) {
        const int kv = job >> 2; const float* pe = kv ? pe_v : pe_k; const float* w1 = kv ? w1_v : w1_k;
        const int T512 = tidx(), lane = T512 & 63, w = T512 >> 6, n = (job & 3) * 64 + lane;
        float s = 0.f;
        for (int j = w * 256; j < w * 256 + 256; ++j) s += pe[j] * w1[(size_t)j * 256 + n];
        red[w * 64 + lane] = s; __syncthreads();
        if (w == 0) { float t = 0.f; for (int i = 0; i < 8; ++i) t += red[i * 64 + lane]; bias[kv * 256 + n] = t; }
        __syncthreads();
    }
}
__device__ __forceinline__ void d_rownorm(const float* x, const float* g, bf16* xn, int rows) {
    const int T512 = tidx(), tid = T512 & 255, lane = tid & 63;
    FOR_VB(vb, rows / 4) {
        const int row = vb * 4 + (tid >> 6);
        const f32x4* xr = (const f32x4*)(x + (size_t)row * DM) + lane; f32x4 v[4]; float s = 0.f;
#pragma unroll
        for (int j = 0; j < 4; ++j) { v[j] = xr[64 * j]; s += v[j][0] * v[j][0] + v[j][1] * v[j][1] + v[j][2] * v[j][2] + v[j][3] * v[j][3]; }
        const float rstd = rsqrtf(wave_sum(s) * (1.f / DM) + NORM_EPS);
#pragma unroll
        for (int j = 0; j < 4; ++j) { const f32x4 gg = ((const f32x4*)g)[lane + 64 * j]; st_bf4(xn + (size_t)row * DM + 4 * (lane + 64 * j), v[j] * rstd * gg); }
    }
}
__device__ __forceinline__ void d_rowpass(const float* xin, const bf16* y, const float* gpost, float coef, const float* gpre, float* xout, bf16* xn) {
    const int T512 = tidx(), tid = T512 & 255, lane = tid & 63;
    FOR_VB(vb, M_ / 4) {
        const int row = vb * 4 + (tid >> 6);
        f32x4 yv[4], xv[4]; float s = 0.f;
#pragma unroll
        for (int j = 0; j < 4; ++j) {
            const u32x2 w = *(const u32x2*)(y + (size_t)row * DM + 4 * (lane + 64 * j));
            yv[j][0] = __builtin_bit_cast(float, w.x << 16); yv[j][1] = __builtin_bit_cast(float, w.x & 0xffff0000u);
            yv[j][2] = __builtin_bit_cast(float, w.y << 16); yv[j][3] = __builtin_bit_cast(float, w.y & 0xffff0000u);
            s += yv[j][0] * yv[j][0] + yv[j][1] * yv[j][1] + yv[j][2] * yv[j][2] + yv[j][3] * yv[j][3];
            xv[j] = ((const f32x4*)(xin + (size_t)row * DM))[lane + 64 * j];
        }
        const float rstd = rsqrtf(wave_sum(s) * (1.f / DM) + NORM_EPS) * coef; float s2 = 0.f;
#pragma unroll
        for (int j = 0; j < 4; ++j) { const f32x4 gg = ((const f32x4*)gpost)[lane + 64 * j]; xv[j] = xv[j] + yv[j] * rstd * gg;
            s2 += xv[j][0] * xv[j][0] + xv[j][1] * xv[j][1] + xv[j][2] * xv[j][2] + xv[j][3] * xv[j][3];
            ((f32x4*)(xout + (size_t)row * DM))[lane + 64 * j] = xv[j]; }
        if (gpre) {
            const float r2 = rsqrtf(wave_sum(s2) * (1.f / DM) + NORM_EPS);
#pragma unroll
            for (int j = 0; j < 4; ++j) { const f32x4 gg = ((const f32x4*)gpre)[lane + 64 * j]; st_bf4(xn + (size_t)row * DM + 4 * (lane + 64 * j), xv[j] * r2 * gg); }
        }
    }
}
__device__ __forceinline__ void d_nsa_outnorm(bf16* amix, const float* g) {
    const int T512 = tidx(), tid = T512 & 255, lane = tid & 63;
    FOR_VB(vb, M_ / 4) {
        const int row = vb * 4 + (tid >> 6);
        bf16* p = amix + (size_t)row * DM + 8 * lane;
        const u32x4 w = *(const u32x4*)p; float v[8]; float s = 0.f;
        v[0] = __builtin_bit_cast(float, w.x << 16); v[1] = __builtin_bit_cast(float, w.x & 0xffff0000u);
        v[2] = __builtin_bit_cast(float, w.y << 16); v[3] = __builtin_bit_cast(float, w.y & 0xffff0000u);
        v[4] = __builtin_bit_cast(float, w.z << 16); v[5] = __builtin_bit_cast(float, w.z & 0xffff0000u);
        v[6] = __builtin_bit_cast(float, w.w << 16); v[7] = __builtin_bit_cast(float, w.w & 0xffff0000u);
#pragma unroll
        for (int i = 0; i < 8; ++i) s += v[i] * v[i];
        const float rstd = rsqrtf(wave_sum(s) * (1.f / 512.f) + NORM_EPS);
        u32x4 o; const float* gg = g + 8 * lane;
        o.x = pk2(v[0] * rstd * gg[0], v[1] * rstd * gg[1]); o.y = pk2(v[2] * rstd * gg[2], v[3] * rstd * gg[3]);
        o.z = pk2(v[4] * rstd * gg[4], v[5] * rstd * gg[5]); o.w = pk2(v[6] * rstd * gg[6], v[7] * rstd * gg[7]);
        *(u32x4*)p = o;
    }
}

struct EpiStore { bf16* O; int ldc; float scale;
    static constexpr int NCAT = 1;
    __device__ __forceinline__ int cat(int) const { return 0; }
    template <int C> __device__ __forceinline__ void apply(int row, int p, f32x4 v0, f32x4 v1) const { bf16* o = O + (size_t)row * ldc + p; st_bf4(o, v0 * scale); st_bf4(o + 16, v1 * scale); } };
struct EpiSwiGLU { bf16* H;
    static constexpr int NCAT = 1;
    __device__ __forceinline__ int cat(int) const { return 0; }
    template <int C> __device__ __forceinline__ void apply(int row, int p, f32x4 g, f32x4 u) const {
        const int q = p & 255, hid = 128 * (p >> 8) + 64 * (q >> 7) + 16 * ((q >> 5) & 3) + (q & 15);
        f32x4 h;
#pragma unroll
        for (int e = 0; e < 4; ++e) h[e] = g[e] / (1.f + __expf(-g[e])) * u[e];
        st_bf4(H + (size_t)row * FF + hid, h); } };
struct EpiBiasSilu { bf16* O; const float* bias;
    static constexpr int NCAT = 1;
    __device__ __forceinline__ int cat(int) const { return 0; }
    template <int C> __device__ __forceinline__ void apply(int row, int p, f32x4 v0, f32x4 v1) const {
        f32x4 a, b; const f32x4 b0 = *(const f32x4*)(bias + p), b1 = *(const f32x4*)(bias + p + 16);
#pragma unroll
        for (int e = 0; e < 4; ++e) { const float x0 = v0[e] + b0[e], x1 = v1[e] + b1[e]; a[e] = x0 / (1.f + __expf(-x0)); b[e] = x1 / (1.f + __expf(-x1)); }
        bf16* o = O + (size_t)row * 256 + p; st_bf4(o, a); st_bf4(o + 16, b); } };
struct EpiLora { float* wdec; bf16* aga; bf16* agg; const float* w0; const float* a0;
    static constexpr int NCAT = 3;
    __device__ __forceinline__ int cat(int p0) const { return p0 < 512 ? 0 : (p0 < 1024 ? 1 : 2); }
    template <int C> __device__ __forceinline__ void one(int row, int p, f32x4 v) const {
        if (C == 0) { f32x4 o; const f32x4 ww = *(const f32x4*)(w0 + p);
#pragma unroll
            for (int e = 0; e < 4; ++e) o[e] = __expf(-0.6065306597126334f * sigmoidf_(ww[e] + v[e]));
            *(f32x4*)(wdec + (size_t)row * 512 + p) = o;
        } else if (C == 1) { f32x4 o; const f32x4 aa = *(const f32x4*)(a0 + p - 512);
#pragma unroll
            for (int e = 0; e < 4; ++e) o[e] = sigmoidf_(aa[e] + v[e]);
            st_bf4(aga + (size_t)row * 512 + (p - 512), o);
        } else st_bf4(agg + (size_t)row * 512 + (p - 1024), v);
    }
    template <int C> __device__ __forceinline__ void apply(int row, int p, f32x4 v0, f32x4 v1) const { one<C>(row, p, v0); one<C>(row, p + 16, v1); } };
struct EpiWin {
    bf16 *qb, *ks, *kw, *kcr, *vcr, *vst, *vwt; unsigned* rk; bf16 *vv, *prl; float* gates; const float* rope;
    static constexpr int NCAT = 8;
    __device__ __forceinline__ int cat(int p0) const { return p0 < 512 ? 0 : (p0 < 768 ? 1 : (p0 < 1024 ? 2 : (p0 < 1280 ? 3 : (p0 < 2304 ? 4 : (p0 < 2816 ? 7 : (p0 < 3072 ? 6 : 5)))))); }
    template <int C> __device__ __forceinline__ void apply(int row, int p, f32x4 v0, f32x4 v1) const {
        const int b = row / T_, t = row % T_;
        if (C == 0 || C == 1) {
            const int x = p & 63, d = 16 * ((x >> 5) & 1) + (x & 15);
            const f32x4* rp = (const f32x4*)(rope + ((size_t)t * 32 + d) * 2); const f32x4 r0 = rp[0], r1 = rp[1];
            const f32x4 cs = {r0[0], r0[2], r1[0], r1[2]}, sn = {r0[1], r0[3], r1[1], r1[3]};
            const f32x4 lo = v0 * cs - v1 * sn, hi = v0 * sn + v1 * cs;
            if (C == 0) { bf16* o = qb + (size_t)row * 512 + (p & ~63) + d; st_bf4(o, lo * QSCALE); st_bf4(o + 32, hi * QSCALE); }
            else { const int g = ((p - 512) >> 6) & 1; bf16* base = (p < 640) ? ks : kw; bf16* o = base + ((size_t)(b * 2 + g) * T_ + t) * 64 + d; st_bf4(o, lo); st_bf4(o + 32, hi); }
        } else if (C == 2) {
            const int c = (p - 768) & 127, g = c >> 6, d = c & 63; bf16* base = (p < 896) ? kcr : vcr;
            bf16* o = base + ((size_t)(b * 2 + g) * T_ + t) * 64 + d; st_bf4(o, v0); st_bf4(o + 16, v1);
        } else if (C == 3) {
            const int c = (p - 1024) & 127, g = c >> 6, d = c & 63; bf16* base = (p < 1152) ? vst : vwt;
            bf16* o = base + ((size_t)(b * 2 + g) * 64 + d) * T_ + t;
#pragma unroll
            for (int e = 0; e < 4; ++e) { o[(size_t)e * T_] = (bf16)f2bf(v0[e]); o[(size_t)(16 + e) * T_] = (bf16)f2bf(v1[e]); }
        } else if (C == 4) {
            const int q = p - 1280, ch = 16 * (q >> 5) + (q & 15);
            u32x4 w; w.x = pk2(v0[0], v1[0]); w.y = pk2(v0[1], v1[1]); w.z = pk2(v0[2], v1[2]); w.w = pk2(v0[3], v1[3]);
            *(u32x4*)(rk + (size_t)row * 512 + ch) = w;
        } else if (C == 7) {
            bf16* o = vv + (size_t)row * 512 + (p - 2304); st_bf4(o, v0); st_bf4(o + 16, v1);
        } else if (C == 6) {
            bf16* o = prl + (size_t)row * 256 + (p - 2816); st_bf4(o, v0); st_bf4(o + 16, v1);
        } else {
            const int c = p - 3072; float* o = gates + (size_t)row * 24 + c;
            if (c < 24) { f32x4 s = {sigmoidf_(v0[0]), sigmoidf_(v0[1]), sigmoidf_(v0[2]), sigmoidf_(v0[3])}; *(f32x4*)o = s; }
            if (c + 16 < 24) { f32x4 s = {sigmoidf_(v1[0]), sigmoidf_(v1[1]), sigmoidf_(v1[2]), sigmoidf_(v1[3])}; *(f32x4*)(o + 16) = s; }
        }
    }
};

namespace pg8 {
#define PG8_LAS __attribute__((address_space(3)))
typedef unsigned short bf16_t;
typedef short bf16x8 __attribute__((ext_vector_type(8)));
typedef float f32x4 __attribute__((ext_vector_type(4)));
typedef unsigned u32x4 __attribute__((ext_vector_type(4)));
constexpr int BM = 256, BK = 64, HALF = 128, HTB = HALF * BK * 2  , STAGE_BYTES = 8 * HTB, NXCD = 8, WGM = 8;

__host__ __device__ __forceinline__ int lds_byte(int r, int c) { const int st = (r >> 4) * 2 + (c >> 5), rr = r & 15, cc = c & 31, ob = rr * 64 + cc * 2; return st * 1024 + (ob ^ (((ob >> 9) & 1) << 5)); }
__host__ __device__ __forceinline__ void stage_rc(int b, int& R, int& C) { const int st = b / 1024, sb = b % 1024, swz = sb ^ (((sb >> 9) & 1) << 5); R = (st >> 1) * 16 + swz / 64; C = (st & 1) * 32 + (swz % 64) / 2; }
__host__ __device__ __forceinline__ int perm32(int rho) { const int n = rho >> 4, i = rho & 15; return 8 * (i >> 2) + 4 * n + (i & 3); }

struct Unit { int pm, pn; };
struct Gemm { const bf16_t* A; const bf16_t* Bt; int M, N, K, lda, ldb; };

struct StaticOrder {
    int nM, nN, nwg, G, c;
    __host__ __device__ void init(int M, int N, int G_, int c_) { nM = M / BM; nN = N / BM; nwg = nM * nN; G = G_; c = c_; }
    __host__ __device__ bool next(int i, Unit& u) const {
        const long L = (long)i * G + c; if (L >= nwg) return false;
        int wgid = (int)L; { const int q = nwg / NXCD, r = nwg % NXCD, xcd = wgid % NXCD, off = wgid / NXCD; wgid = (xcd < r ? xcd * (q + 1) : r * (q + 1) + (xcd - r) * q) + off; }
        const int nig = WGM * nN, gid = wgid / nig, fm = gid * WGM, gsz = (nM - fm) < WGM ? (nM - fm) : WGM;
        u.pm = fm + ((wgid % nig) % gsz); u.pn = (wgid % nig) / gsz; return true;
    }
    __device__ __forceinline__ void a_ready(const Unit&) const {}
    __device__ __forceinline__ void done(const Unit&) const {}
};

template <class Epi, class Sched, bool ALIGN_EPI = false, bool SP2 = false>
__device__ __forceinline__ void gemm_phase(PG8_LAS unsigned char* lds, const Gemm g, const Sched& S, const Epi& E) {
    const int tid = tidx(), wid = __builtin_amdgcn_readfirstlane(tid >> 6), lane = tid & 63, wr = wid >> 2, wc = wid & 3, fr = lane & 15, fq = lane >> 4;
    const int K = g.K, nt = K / BK;
    unsigned voffA[2], voffB[2];
#pragma unroll
    for (int i = 0; i < 2; ++i) { int R, C; stage_rc(tid * 16 + i * 8192, R, C); const int Rb = Epi::PERM ? ((R & ~31) + perm32(R & 31)) : R;
        voffA[i] = (unsigned)(R * g.lda + C) * 2u; voffB[i] = (unsigned)(Rb * g.ldb + C) * 2u; }
    const size_t kstep = (size_t)(BK * 2);
    const size_t hstepA = (size_t)HALF * g.lda * 2, hstepB = (size_t)HALF * g.ldb * 2;
    const size_t tstepA = 2 * hstepA, tstepB = 2 * hstepB;
    const unsigned ldsw = (unsigned)wid * 1024u;
    const int aoff = lds_byte(wr * 64 + fr, fq * 8), boff = lds_byte(wc * 32 + fr, fq * 8);
#define PG8_SA(b, h) (((b) * 2 + (h)) * HTB)
#define PG8_SB(b, h) ((4 + (b) * 2 + (h)) * HTB)
#define PG8_STAGE(bufoff, gbase, voff) do { _Pragma("unroll") for (int _i = 0; _i < 2; ++_i) \
        __builtin_amdgcn_global_load_lds((const unsigned*)((const char*)(gbase) + (voff)[_i]), (PG8_LAS unsigned*)(lds + (bufoff) + ldsw + _i * 8192), 16, 0, 0); } while (0)
#define PG8_LDA(dst, b, h) do { _Pragma("unroll") for (int m = 0; m < 4; ++m) _Pragma("unroll") for (int k = 0; k < 2; ++k) dst[m][k] = *(const PG8_LAS bf16x8*)(lds + PG8_SA(b, h) + aoff + m * 2048 + k * 1024); } while (0)
#define PG8_LDB(dst, b, h) do { _Pragma("unroll") for (int n = 0; n < 2; ++n) _Pragma("unroll") for (int k = 0; k < 2; ++k) dst[n][k] = *(const PG8_LAS bf16x8*)(lds + PG8_SB(b, h) + boff + n * 2048 + k * 1024); } while (0)
#define PG8_MMA(ai, bj, At, Bt) do { __builtin_amdgcn_s_setprio(1); _Pragma("unroll") for (int m = 0; m < 4; ++m) _Pragma("unroll") for (int n = 0; n < 2; ++n) _Pragma("unroll") for (int k = 0; k < 2; ++k) \
        acc[ai][bj][m][n] = __builtin_amdgcn_mfma_f32_16x16x32_bf16(Bt[n][k], At[m][k], acc[ai][bj][m][n], 0, 0, 0); __builtin_amdgcn_s_setprio(0); } while (0)
#define PG8_WAIT_V(n) asm volatile("s_waitcnt vmcnt(" #n ")" ::: "memory")
#define PG8_WAIT_L(n) asm volatile("s_waitcnt lgkmcnt(" #n ")" ::: "memory")
#define PG8_BAR __builtin_amdgcn_s_barrier()
#define PG8_SCHED __builtin_amdgcn_sched_barrier(0)
    Unit cur, nxt; int ui = 0;
    if (!S.next(0, cur)) return;
    f32x4 acc[2][2][4][2];
#pragma unroll
    for (int a = 0; a < 2; ++a)
#pragma unroll
        for (int b = 0; b < 2; ++b)
#pragma unroll
            for (int m = 0; m < 4; ++m)
#pragma unroll
                for (int n = 0; n < 2; ++n) acc[a][b][m][n] = (f32x4){0.f, 0.f, 0.f, 0.f};
    bf16x8 At[4][2], B0[2][2], B1[2][2];
    const char* cA = (const char*)g.A + (size_t)cur.pm * tstepA; const char* cB = (const char*)g.Bt + (size_t)cur.pn * tstepB;
    S.a_ready(cur);
    if constexpr (SP2) {
        PG8_STAGE(PG8_SB(0, 0), cB, voffB); PG8_STAGE(PG8_SB(0, 1), cB + hstepB, voffB); PG8_STAGE(PG8_SA(0, 0), cA, voffA); PG8_STAGE(PG8_SA(0, 1), cA + hstepA, voffA);
        if (wr == 1) PG8_BAR;
        PG8_WAIT_V(2); PG8_BAR;
        PG8_STAGE(PG8_SB(1, 0), cB + kstep, voffB); PG8_STAGE(PG8_SA(1, 0), cA + kstep, voffA); PG8_STAGE(PG8_SB(1, 1), cB + hstepB + kstep, voffB);
        PG8_WAIT_V(6); PG8_BAR;
    } else {
        PG8_STAGE(PG8_SB(0, 0), cB, voffB); PG8_STAGE(PG8_SA(0, 0), cA, voffA); PG8_STAGE(PG8_SB(0, 1), cB + hstepB, voffB); PG8_STAGE(PG8_SA(0, 1), cA + hstepA, voffA);
        if (wr == 1) PG8_BAR;
        PG8_WAIT_V(4); PG8_BAR;
        PG8_STAGE(PG8_SB(1, 0), cB + kstep, voffB); PG8_STAGE(PG8_SA(1, 0), cA + kstep, voffA); PG8_STAGE(PG8_SB(1, 1), cB + hstepB + kstep, voffB);
        PG8_WAIT_V(6); PG8_BAR;
    }
    for (;;) {
        const bool has_next = S.next(ui + 1, nxt);
        const char* nA = has_next ? (const char*)g.A + (size_t)nxt.pm * tstepA : cA; const char* nB = has_next ? (const char*)g.Bt + (size_t)nxt.pn * tstepB : cB;
        for (int t = 0; t < nt; t += 2) {
            const bool last = (t == nt - 2);
            const char* a1 = cA + (size_t)(t + 1) * kstep;
            const char* a2 = last ? nA : cA + (size_t)(t + 2) * kstep; const char* b2 = last ? nB : cB + (size_t)(t + 2) * kstep;
            const char* a3 = a2 + kstep; const char* b3 = b2 + kstep;
            if (last && has_next) S.a_ready(nxt);
            if constexpr (SP2) {
            PG8_LDB(B0, 0, 0); PG8_LDB(B1, 0, 1); PG8_SCHED; PG8_LDA(At, 0, 0); PG8_STAGE(PG8_SA(1, 1), a1 + hstepA, voffA);
            PG8_WAIT_V(8); PG8_WAIT_L(0); PG8_BAR; PG8_MMA(0, 0, At, B0); PG8_MMA(0, 1, At, B1); PG8_BAR; PG8_SCHED;
            PG8_LDA(At, 0, 1); PG8_STAGE(PG8_SB(0, 0), b2, voffB); PG8_STAGE(PG8_SB(0, 1), b2 + hstepB, voffB); PG8_STAGE(PG8_SA(0, 0), a2, voffA);
            PG8_WAIT_V(8); PG8_WAIT_L(0); PG8_BAR; PG8_MMA(1, 0, At, B0); PG8_MMA(1, 1, At, B1); PG8_BAR; PG8_SCHED;
            PG8_LDB(B0, 1, 0); PG8_LDB(B1, 1, 1); PG8_SCHED; PG8_LDA(At, 1, 0); PG8_STAGE(PG8_SA(0, 1), a2 + hstepA, voffA);
            PG8_WAIT_V(8); PG8_WAIT_L(0); PG8_BAR; PG8_MMA(0, 0, At, B0); PG8_MMA(0, 1, At, B1); PG8_BAR; PG8_SCHED;
            PG8_LDA(At, 1, 1); PG8_STAGE(PG8_SB(1, 0), b3, voffB); PG8_STAGE(PG8_SB(1, 1), b3 + hstepB, voffB); PG8_STAGE(PG8_SA(1, 0), a3, voffA);
            PG8_WAIT_V(8); PG8_WAIT_L(0); PG8_BAR; PG8_MMA(1, 0, At, B0); PG8_MMA(1, 1, At, B1); PG8_BAR; PG8_SCHED;
            } else {
            PG8_LDB(B0, 0, 0); PG8_SCHED; PG8_LDA(At, 0, 0); PG8_STAGE(PG8_SA(1, 1), a1 + hstepA, voffA);
            PG8_WAIT_L(8); PG8_BAR; PG8_WAIT_L(0); PG8_MMA(0, 0, At, B0); PG8_BAR; PG8_SCHED;
            PG8_LDB(B1, 0, 1); PG8_STAGE(PG8_SB(0, 0), b2, voffB);
            PG8_BAR; PG8_WAIT_L(0); PG8_MMA(0, 1, At, B1); PG8_BAR;
            PG8_LDA(At, 0, 1); PG8_STAGE(PG8_SA(0, 0), a2, voffA);
            PG8_BAR; PG8_WAIT_L(0); PG8_MMA(1, 0, At, B0); PG8_BAR; PG8_SCHED;
            PG8_STAGE(PG8_SB(0, 1), b2 + hstepB, voffB);
            PG8_WAIT_V(6); PG8_BAR; PG8_MMA(1, 1, At, B1); PG8_BAR;
            PG8_LDB(B0, 1, 0); PG8_SCHED; PG8_LDA(At, 1, 0); PG8_STAGE(PG8_SA(0, 1), a2 + hstepA, voffA);
            PG8_WAIT_L(8); PG8_BAR; PG8_WAIT_L(0); PG8_MMA(0, 0, At, B0); PG8_BAR; PG8_SCHED;
            PG8_LDB(B1, 1, 1); PG8_STAGE(PG8_SB(1, 0), b3, voffB);
            PG8_BAR; PG8_WAIT_L(0); PG8_MMA(0, 1, At, B1); PG8_BAR;
            PG8_LDA(At, 1, 1); PG8_STAGE(PG8_SA(1, 0), a3, voffA);
            PG8_BAR; PG8_WAIT_L(0); PG8_MMA(1, 0, At, B0); PG8_BAR; PG8_SCHED;
            PG8_STAGE(PG8_SB(1, 1), b3 + hstepB, voffB);
            PG8_WAIT_V(6); PG8_BAR; PG8_MMA(1, 1, At, B1); PG8_BAR;
            }
        }
        if constexpr (ALIGN_EPI) { if (wr == 0) PG8_BAR; }
        if constexpr (!Epi::AFTER_DRAIN) { E(acc, cur, wr, wc, fr, fq); S.done(cur); }
        if (!has_next) break;
#pragma unroll
        for (int a = 0; a < 2; ++a)
#pragma unroll
            for (int b = 0; b < 2; ++b)
#pragma unroll
                for (int m = 0; m < 4; ++m)
#pragma unroll
                    for (int n = 0; n < 2; ++n) acc[a][b][m][n] = (f32x4){0.f, 0.f, 0.f, 0.f};
        cur = nxt; cA = nA; cB = nB; ++ui;
        if constexpr (ALIGN_EPI) { if (wr == 1) PG8_BAR; }
    }
    PG8_WAIT_V(0);
    if constexpr (!ALIGN_EPI) { if (wr == 0) PG8_BAR; }
    PG8_BAR;
    if constexpr (Epi::AFTER_DRAIN) { E.fused(acc, cur, wr, wc, fr, fq, lds, wid, lane); S.done(cur); }
#undef PG8_SA
#undef PG8_SB
#undef PG8_STAGE
#undef PG8_LDA
#undef PG8_LDB
#undef PG8_MMA
#undef PG8_WAIT_V
#undef PG8_WAIT_L
#undef PG8_BAR
#undef PG8_SCHED
}
}

template <class F> struct EpiQuad {
    static constexpr bool PERM = false, AFTER_DRAIN = false;
    F f;
    template <int C, int BJ> __device__ __forceinline__ void half(const pg8::f32x4 (&acc)[2][2][4][2], int row0, int p) const {
#pragma unroll
        for (int ai = 0; ai < 2; ++ai)
#pragma unroll
            for (int m = 0; m < 4; ++m) { f.template apply<C>(row0 + ai * 128 + m * 16, p, acc[ai][BJ][m][0], acc[ai][BJ][m][1]); asm volatile("" ::: "memory"); }
    }
    template <int BJ> __device__ __forceinline__ void disp(const pg8::f32x4 (&acc)[2][2][4][2], int row0, int p0, int p) const {
        const int c = f.cat(p0);
        if (F::NCAT == 1 || c == 0) half<0, BJ>(acc, row0, p);
        else if (F::NCAT > 1 && c == 1) half<(F::NCAT > 1 ? 1 : 0), BJ>(acc, row0, p);
        else if (F::NCAT > 2 && c == 2) half<(F::NCAT > 2 ? 2 : 0), BJ>(acc, row0, p);
        else if (F::NCAT > 3 && c == 3) half<(F::NCAT > 3 ? 3 : 0), BJ>(acc, row0, p);
        else if (F::NCAT > 4 && c == 4) half<(F::NCAT > 4 ? 4 : 0), BJ>(acc, row0, p);
        else if (F::NCAT > 5 && c == 5) half<(F::NCAT > 5 ? 5 : 0), BJ>(acc, row0, p);
        else if (F::NCAT > 6 && c == 6) half<(F::NCAT > 6 ? 6 : 0), BJ>(acc, row0, p);
        else if (F::NCAT > 7) half<(F::NCAT > 7 ? 7 : 0), BJ>(acc, row0, p);
    }
    __device__ __forceinline__ void operator()(const pg8::f32x4 (&acc)[2][2][4][2], const pg8::Unit& u, int wr, int wc, int fr, int fq) const {
        const int row0 = u.pm * 256 + wr * 64 + fr, p0 = u.pn * 256;
        disp<0>(acc, row0, p0, p0 + wc * 32 + 4 * fq);
        disp<1>(acc, row0, p0 + 128, p0 + 128 + wc * 32 + 4 * fq);
    }
};
template <class F> __device__ __forceinline__ void gemm_pg8(unsigned char* lds, const bf16* A, int lda, const bf16* Bt, int ldb, int M, int N, int K, const F& f) {
    pg8::Gemm g{A, Bt, M, N, K, lda, ldb}; pg8::StaticOrder S; S.init(M, N, (int)gridDim.x, (int)blockIdx.x);
    EpiQuad<F> E{f};
    pg8::gemm_phase<EpiQuad<F>, pg8::StaticOrder, true, true>((PG8_LAS unsigned char*)lds, g, S, E);
}

namespace cg = cooperative_groups;
struct EpiNormRes {
    static constexpr bool PERM = false, AFTER_DRAIN = true;
    const float* xin; float* xout; bf16* xn; const float* gpost; const float* gpre; float coef; unsigned* part; unsigned* cnt;
    __device__ __forceinline__ void operator()(const pg8::f32x4 (&)[2][2][4][2], const pg8::Unit&, int, int, int, int) const {}
    __device__ __forceinline__ void rowstat(const pg8::f32x4 (&acc)[2][2][4][2], float* P, int wr, int wc, int fr, int fq) const {
#pragma unroll
        for (int ai = 0; ai < 2; ++ai)
#pragma unroll
            for (int m = 0; m < 4; ++m) { float sq = 0.f;
#pragma unroll
                for (int bj = 0; bj < 2; ++bj)
#pragma unroll
                    for (int n = 0; n < 2; ++n) { const pg8::f32x4 v = acc[ai][bj][m][n]; sq += (v[0] * v[0] + v[1] * v[1]) + (v[2] * v[2] + v[3] * v[3]); }
                sq += __shfl_xor(sq, 16); sq += __shfl_xor(sq, 32);
                if (fq == 0) P[(ai * 128 + wr * 64 + m * 16 + fr) * 4 + wc] = sq; }
    }
    __device__ __forceinline__ void exchange(float* P, float* S, unsigned* bank, unsigned* cnt, const pg8::Unit& u, int tid, float scale) const {
        __syncthreads();
        if (tid < 256) { const f32x4 p = *(const f32x4*)(P + tid * 4);
            __hip_atomic_store(bank + (size_t)(u.pm * 256 + tid) * 4 + u.pn, __builtin_bit_cast(unsigned, (p[0] + p[1]) + (p[2] + p[3])), __ATOMIC_RELAXED, __HIP_MEMORY_SCOPE_AGENT); }
        asm volatile("s_waitcnt vmcnt(0)" ::: "memory");
        __syncthreads();
        if (tid == 0) { unsigned* c = cnt + u.pm * 16; __hip_atomic_fetch_add(c, 1u, __ATOMIC_RELAXED, __HIP_MEMORY_SCOPE_AGENT);
            while (__hip_atomic_load(c, __ATOMIC_RELAXED, __HIP_MEMORY_SCOPE_AGENT) < 4u) __builtin_amdgcn_s_sleep(1); }
        __syncthreads();
        if (tid < 256) { const unsigned* b = bank + (size_t)(u.pm * 256 + tid) * 4; float q = 0.f;
#pragma unroll
            for (int j = 0; j < 4; ++j) q += __builtin_bit_cast(float, __hip_atomic_load(b + j, __ATOMIC_RELAXED, __HIP_MEMORY_SCOPE_AGENT));
            S[tid] = rsqrtf(q * (1.f / DM) + NORM_EPS) * scale; }
        __syncthreads();
    }
    __device__ __forceinline__ void fused(pg8::f32x4 (&acc)[2][2][4][2], const pg8::Unit& u, int wr, int wc, int fr, int fq, PG8_LAS unsigned char* lds, int wid, int lane) const {
        float* P = (float*)lds; float* S = P + 1024; const int tid = wid * 64 + lane;
        rowstat(acc, P, wr, wc, fr, fq);
        exchange(P, S, part, cnt, u, tid, coef);
        const int col0 = u.pn * 256 + wc * 32 + 4 * fq;
#pragma unroll
        for (int ai = 0; ai < 2; ++ai)
#pragma unroll
            for (int m = 0; m < 4; ++m) { const int r = ai * 128 + wr * 64 + m * 16 + fr; const float sr = S[r]; const size_t off = (size_t)(u.pm * 256 + r) * DM + col0;
#pragma unroll
                for (int bj = 0; bj < 2; ++bj)
#pragma unroll
                    for (int n = 0; n < 2; ++n) { const int o = bj * 128 + n * 16; const f32x4 g4 = *(const f32x4*)(gpost + col0 + o), x4 = *(const f32x4*)(xin + off + o);
                        const f32x4 y = x4 + acc[ai][bj][m][n] * sr * g4; acc[ai][bj][m][n] = y; *(f32x4*)(xout + off + o) = y; }
                asm volatile("" ::: "memory"); }
        if (!gpre) return;
        rowstat(acc, P, wr, wc, fr, fq);
        exchange(P, S, part + (size_t)M_ * 4, cnt + 64 * 16, u, tid, 1.f);
#pragma unroll
        for (int ai = 0; ai < 2; ++ai)
#pragma unroll
            for (int m = 0; m < 4; ++m) { const int r = ai * 128 + wr * 64 + m * 16 + fr; const float sr = S[r]; const size_t off = (size_t)(u.pm * 256 + r) * DM + col0;
#pragma unroll
                for (int bj = 0; bj < 2; ++bj)
#pragma unroll
                    for (int n = 0; n < 2; ++n) { const int o = bj * 128 + n * 16; const f32x4 g4 = *(const f32x4*)(gpre + col0 + o); st_bf4(xn + off + o, acc[ai][bj][m][n] * sr * g4); }
                asm volatile("" ::: "memory"); }
    }
};
__device__ __forceinline__ void gemm_norm_res(unsigned char* lds, const bf16* A, int lda, const bf16* Bt, int K, const float* xin, float* xout, bf16* xn, const float* gpost, const float* gpre,
                                              float coef, bf16* ybuf, unsigned* part, unsigned* cnt) {
    pg8::Gemm g{A, Bt, M_, DM, K, lda, K}; pg8::StaticOrder S; S.init(M_, DM, 256, (int)blockIdx.x);
    const EpiNormRes E{xin, xout, xn, gpost, gpre, coef, part, cnt};
    pg8::gemm_phase<EpiNormRes, pg8::StaticOrder, false, true>((PG8_LAS unsigned char*)lds, g, S, E);
}

__device__ __forceinline__ void d_cmp2(const bf16* hidk, const bf16* hidv, const float* w2k, const float* w2v, const float* rope, bf16* kc, bf16* vct) {
    const int T512 = tidx(), tid = T512 & 255;
    FOR_VB(vb, 2048 * 32 / 256) {
        const int idx = vb * 256 + tid; const int R = idx >> 5, i = idx & 31; const int bg = R >> 9, c = R & 511;
        float k0 = 0.f, k1 = 0.f, v0 = 0.f, v1 = 0.f;
        for (int n = 0; n < 256; ++n) { const float hk = bf2f(hidk[(size_t)R * 256 + n]), hv = bf2f(hidv[(size_t)R * 256 + n]);
            k0 += hk * w2k[n * 64 + i]; k1 += hk * w2k[n * 64 + i + 32]; v0 += hv * w2v[n * 64 + i]; v1 += hv * w2v[n * 64 + i + 32]; }
        const int pos = (16 * c + 31) & (T_ - 1);
        const float cs = rope[((size_t)pos * 32 + i) * 2], sn = rope[((size_t)pos * 32 + i) * 2 + 1];
        kc[(size_t)R * 64 + i] = (bf16)f2bf(k0 * cs - k1 * sn); kc[(size_t)R * 64 + i + 32] = (bf16)f2bf(k0 * sn + k1 * cs);
        vct[((size_t)bg * 64 + i) * NCP + c] = (bf16)f2bf(v0); vct[((size_t)bg * 64 + i + 32) * NCP + c] = (bf16)f2bf(v1);
    }
}

struct NsaArgs { const bf16 *qb, *kc, *vct, *ks, *vst, *kw, *vwt; const float* gates; bf16* amix; };
__device__ __forceinline__ float dot64(const float* q, const bf16* k) {
    float s = 0.f;
#pragma unroll
    for (int i = 0; i < 8; ++i) { const u32x4 w = ((const u32x4*)k)[i];
        s += q[8 * i + 0] * __builtin_bit_cast(float, w.x << 16) + q[8 * i + 1] * __builtin_bit_cast(float, w.x & 0xffff0000u)
           + q[8 * i + 2] * __builtin_bit_cast(float, w.y << 16) + q[8 * i + 3] * __builtin_bit_cast(float, w.y & 0xffff0000u)
           + q[8 * i + 4] * __builtin_bit_cast(float, w.z << 16) + q[8 * i + 5] * __builtin_bit_cast(float, w.z & 0xffff0000u)
           + q[8 * i + 6] * __builtin_bit_cast(float, w.w << 16) + q[8 * i + 7] * __builtin_bit_cast(float, w.w & 0xffff0000u); }
    return s;
}
__device__ __forceinline__ void softmax_row(float* s, int n, int lane) {
    float m = -INFINITY; for (int i = lane; i < n; i += 64) m = fmaxf(m, s[i]);
    m = wave_max(m); if (m == -INFINITY) m = 0.f;
    float l = 0.f; for (int i = lane; i < n; i += 64) { const float e = exp2f(s[i] - m); s[i] = e; l += e; }
    l = wave_sum(l); const float inv = 1.f / fmaxf(l, 1e-30f);
    for (int i = lane; i < n; i += 64) s[i] *= inv;
}
__device__ __forceinline__ void d_nsa_simple(const NsaArgs& a, int vb, int tid, unsigned char* smem) {
    float (*qs)[64] = (float (*)[64])smem; float (*sc)[1024] = (float (*)[1024])(smem + 1024); float* imp = (float*)(smem + 17408); float* score = imp + 128;
    int* list = (int*)(score + 128); int* nlist = list + 16;
    const int bg = vb / T_, t = vb % T_, b = bg >> 1, g = bg & 1;
    const int r = tid >> 6, d = tid & 63, lane = d;
    const size_t row = (size_t)b * T_ + t;
    qs[r][d] = bf2f(a.qb[row * 512 + g * 256 + r * 64 + d]);
    if (tid == 0) *nlist = 0;
    __syncthreads();
    const int nv = t < 31 ? 0 : (t - 31) / 16 + 1;
    for (int c = tid; c < nv; c += 256) { const bf16* k = a.kc + ((size_t)bg * NCP + c) * 64;
        _Pragma("unroll 1") for (int rr = 0; rr < 4; ++rr) sc[rr][c] = dot64(qs[rr], k); }
    __syncthreads();
    softmax_row(sc[r], nv, lane);
    __syncthreads();
    float oc = 0.f; { const bf16* v = a.vct + ((size_t)bg * 64 + d) * NCP; for (int c = 0; c < nv; ++c) oc += sc[r][c] * bf2f(v[c]); }
    if (tid < 128) { const int s = tid; float acc = 0.f;
        for (int c = 4 * s - 1; c <= 4 * s + 3; ++c) if (c >= 0 && c < nv) acc += sc[0][c] + sc[1][c] + sc[2][c] + sc[3][c];
        imp[s] = acc; }
    __syncthreads();
    const int cur = t >> 6;
    if (tid < 128) { const int s = tid; const bool forced = (s == 0) || (s == cur) || (s == cur - 1);
        score[s] = forced ? 1e4f : (s <= cur ? imp[s] : -1e4f); }
    __syncthreads();
    if (tid < 128) { const int s = tid; const float my = score[s]; int rank = 0;
        for (int j = 0; j < 128; ++j) { const float o = score[j]; rank += (o > my || (o == my && j < s)) ? 1 : 0; }
        if (rank < 16 && s <= cur) { const int slot = atomicAdd(nlist, 1); list[slot] = s; } }
    __syncthreads();
    const int ns = *nlist * 64;
    for (int i = tid; i < ns; i += 256) { const int pos = list[i >> 6] * 64 + (i & 63);
        if (pos <= t) { const bf16* k = a.ks + ((size_t)bg * T_ + pos) * 64; _Pragma("unroll 1") for (int rr = 0; rr < 4; ++rr) sc[rr][i] = dot64(qs[rr], k); }
        else { sc[0][i] = -INFINITY; sc[1][i] = -INFINITY; sc[2][i] = -INFINITY; sc[3][i] = -INFINITY; } }
    __syncthreads();
    softmax_row(sc[r], ns, lane);
    __syncthreads();
    float os = 0.f; { const bf16* v = a.vst + ((size_t)bg * 64 + d) * T_;
        for (int i = 0; i < ns; ++i) { const int pos = list[i >> 6] * 64 + (i & 63); if (pos <= t) os += sc[r][i] * bf2f(v[pos]); } }
    __syncthreads();
    const int lo = t - 511 > 0 ? t - 511 : 0, nw = t - lo + 1;
    for (int i = tid; i < nw; i += 256) { const bf16* k = a.kw + ((size_t)bg * T_ + lo + i) * 64;
        _Pragma("unroll 1") for (int rr = 0; rr < 4; ++rr) sc[rr][i] = dot64(qs[rr], k); }
    __syncthreads();
    softmax_row(sc[r], nw, lane);
    __syncthreads();
    float ow = 0.f; { const bf16* v = a.vwt + ((size_t)bg * 64 + d) * T_ + lo; for (int i = 0; i < nw; ++i) ow += sc[r][i] * bf2f(v[i]); }
    const float* gt = a.gates + row * 24 + g * 12 + r * 3;
    a.amix[row * DM + g * 256 + r * 64 + d] = (bf16)f2bf(gt[0] * oc + gt[1] * os + gt[2] * ow);
    __syncthreads();
}


namespace nsa {
typedef float f32x16 __attribute__((ext_vector_type(16)));
constexpr int KROW = 144, VROW = 136, KBUF = 64 * KROW, VBUF = 64 * VROW;
constexpr int OFF_K = 0, OFF_V = 2 * KBUF, OFF_IMP = OFF_V + 2 * VBUF, IMPW = 130, OFF_SEL = OFF_IMP + 64 * IMPW * 4, OFF_UM = OFF_SEL + 1024, OFF_WS = OFF_UM + 16, OFF_UNIT = OFF_WS + 1024, LDS_NEED = OFF_UNIT + 16;
static_assert(OFF_IMP % 16 == 0 && OFF_SEL % 16 == 0 && OFF_WS % 16 == 0, "nsa lds map");
__device__ __forceinline__ int crow(int r, int hi) { return (r & 3) + 8 * (r >> 2) + 4 * hi; }
__device__ __forceinline__ int next_bit(unsigned m0, unsigned m1, unsigned m2, unsigned m3, int from) {
#pragma unroll
    for (int wd = 0; wd < 4; ++wd) {
        unsigned x = wd == 0 ? m0 : (wd == 1 ? m1 : (wd == 2 ? m2 : m3)); const int base = wd * 32;
        if (from < base + 32) { if (from > base) x &= (~0u) << (from - base); if (x) return base + __builtin_ctz(x); }
    }
    return 128;
}
__device__ __forceinline__ bf16x8 pack8(const f32x16& p, int b0) {
    u32x4 w; w.x = pk2(p[b0 + 0], p[b0 + 1]); w.y = pk2(p[b0 + 2], p[b0 + 3]); w.z = pk2(p[b0 + 4], p[b0 + 5]); w.w = pk2(p[b0 + 6], p[b0 + 7]);
    return __builtin_bit_cast(bf16x8, w);
}
struct Branch { const bf16* k; const bf16* vt; int ldv; };

template <int MODE, bool SEL>
__device__ __forceinline__ void run_branch(unsigned char* sm, const Branch br, unsigned m0, unsigned m1, unsigned m2, unsigned m3,
                                           const bf16x8 (&qf)[4], int lo, int hi_b, int lo_max, int hi_min, unsigned s0, unsigned s1, unsigned s2, unsigned s3,
                                           float& m, float& l, float invl, f32x16 (&o)[2], float* imp_row, float* wsc, int tid, int lane) {
    const int i = lane & 31, hi = lane >> 5;
    int j = next_bit(m0, m1, m2, m3, 0);
    u32x4 kr, vr;
    if (j < 128) {
        kr = *(const u32x4*)(br.k + (size_t)j * 4096 + tid * 8);
        if (MODE != 0) vr = *(const u32x4*)(br.vt + (size_t)(tid >> 3) * br.ldv + j * 64 + (tid & 7) * 8);
        *(u32x4*)(sm + OFF_K + (tid >> 3) * KROW + (tid & 7) * 16) = kr;
        if (MODE != 0) { unsigned char* vp = sm + OFF_V + (tid >> 3) * VROW + (tid & 7) * 16; *(u32x2*)vp = (u32x2){vr.x, vr.y}; *(u32x2*)(vp + 8) = (u32x2){vr.z, vr.w}; }
    }
    __syncthreads();
    int cb = 0;
    while (j < 128) {
        const int jn = next_bit(m0, m1, m2, m3, j + 1);
        if (jn < 128) {
            kr = *(const u32x4*)(br.k + (size_t)jn * 4096 + tid * 8);
            if (MODE != 0) vr = *(const u32x4*)(br.vt + (size_t)(tid >> 3) * br.ldv + jn * 64 + (tid & 7) * 8);
        }
        const unsigned char* kb = sm + OFF_K + cb * KBUF; const unsigned char* vb = sm + OFF_V + cb * VBUF;
        const int key0 = 64 * j;
        bool rowsel = true;
        if (SEL) { const unsigned wsel = j < 32 ? s0 : (j < 64 ? s1 : (j < 96 ? s2 : s3)); rowsel = (wsel >> (j & 31)) & 1u; }
        if (!SEL || __any(rowsel)) {
            const float cinit = rowsel ? 0.f : -INFINITY;
            f32x16 p0, p1;
#pragma unroll
            for (int r = 0; r < 16; ++r) { p0[r] = cinit; p1[r] = cinit; }
#pragma unroll
            for (int d0 = 0; d0 < 4; ++d0) {
                const bf16x8 a0 = *(const bf16x8*)(kb + i * KROW + (16 * d0 + 8 * hi) * 2);
                const bf16x8 a1 = *(const bf16x8*)(kb + (32 + i) * KROW + (16 * d0 + 8 * hi) * 2);
                p0 = __builtin_amdgcn_mfma_f32_32x32x16_bf16(a0, qf[d0], p0, 0, 0, 0);
                p1 = __builtin_amdgcn_mfma_f32_32x32x16_bf16(a1, qf[d0], p1, 0, 0, 0);
            }
            if (!(key0 >= lo_max && key0 + 63 <= hi_min)) {
#pragma unroll
                for (int r = 0; r < 16; ++r) { const int key = key0 + crow(r, hi);
                    if (key < lo || key > hi_b) p0[r] = -INFINITY;
                    if (key + 32 < lo || key + 32 > hi_b) p1[r] = -INFINITY; }
            }
            if (MODE == 1) {
#pragma unroll
                for (int r = 0; r < 16; ++r) { p0[r] = __builtin_amdgcn_exp2f(p0[r] - m) * invl; p1[r] = __builtin_amdgcn_exp2f(p1[r] - m) * invl; }
#pragma unroll
                for (int gq = 0; gq < 4; ++gq) {
                    float G0 = (p0[4 * gq] + p0[4 * gq + 1]) + (p0[4 * gq + 2] + p0[4 * gq + 3]), L0 = p0[4 * gq + 3];
                    float G1 = (p1[4 * gq] + p1[4 * gq + 1]) + (p1[4 * gq + 2] + p1[4 * gq + 3]), L1 = p1[4 * gq + 3];
                    G0 += __shfl_xor(G0, 1); L0 += __shfl_xor(L0, 1); G1 += __shfl_xor(G1, 1); L1 += __shfl_xor(L1, 1);
                    G0 += __shfl_xor(G0, 2); L0 += __shfl_xor(L0, 2); G1 += __shfl_xor(G1, 2); L1 += __shfl_xor(L1, 2);
                    if ((i & 3) == 0) { const int s = 16 * j + 2 * gq + hi;
                        atomicAdd(imp_row + s, G0); atomicAdd(imp_row + s + 1, L0); atomicAdd(imp_row + s + 8, G1); atomicAdd(imp_row + s + 9, L1); }
                }
            } else {
                float tm = fmaxf(p0[0], p1[0]);
#pragma unroll
                for (int r = 1; r < 16; ++r) tm = fmaxf(tm, fmaxf(p0[r], p1[r]));
                tm = fmaxf(tm, __shfl_xor(tm, 32));
                const float mn = fmaxf(m, tm), alpha = __builtin_amdgcn_exp2f(m - mn);
                m = mn; float rs = 0.f;
#pragma unroll
                for (int r = 0; r < 16; ++r) { p0[r] = __builtin_amdgcn_exp2f(p0[r] - mn); p1[r] = __builtin_amdgcn_exp2f(p1[r] - mn); rs += p0[r] + p1[r]; }
                l = l * alpha + rs;
                if (MODE == 2) {
                    if (hi == 0) wsc[i] = alpha;
                    asm volatile("" ::: "memory");
#pragma unroll
                    for (int rg = 0; rg < 4; ++rg) { const f32x4 a4 = *(const f32x4*)(wsc + 8 * rg + 4 * hi);
#pragma unroll
                        for (int e = 0; e < 4; ++e) { o[0][4 * rg + e] *= a4[e]; o[1][4 * rg + e] *= a4[e]; } }
                    asm volatile("" ::: "memory");
                }
            }
            if (MODE != 0) {
                const bf16x8 pf0 = pack8(p0, 0), pf1 = pack8(p0, 8), pf2 = pack8(p1, 0), pf3 = pack8(p1, 8);
#pragma unroll
                for (int dt = 0; dt < 2; ++dt) {
                    const unsigned char* vp = vb + (32 * dt + i) * VROW + 8 * hi;
#pragma unroll
                    for (int ks = 0; ks < 4; ++ks) {
                        const u32x2 v_lo = *(const u32x2*)(vp + 32 * ks), v_hi = *(const u32x2*)(vp + 32 * ks + 16);
                        const bf16x8 vf = __builtin_bit_cast(bf16x8, (u32x4){v_lo.x, v_lo.y, v_hi.x, v_hi.y});
                        o[dt] = __builtin_amdgcn_mfma_f32_32x32x16_bf16(ks == 0 ? pf0 : (ks == 1 ? pf1 : (ks == 2 ? pf2 : pf3)), vf, o[dt], 0, 0, 0);
                    }
                }
            }
        }
        if (jn < 128) {
            *(u32x4*)(sm + OFF_K + (cb ^ 1) * KBUF + (tid >> 3) * KROW + (tid & 7) * 16) = kr;
            if (MODE != 0) { unsigned char* vp = sm + OFF_V + (cb ^ 1) * VBUF + (tid >> 3) * VROW + (tid & 7) * 16; *(u32x2*)vp = (u32x2){vr.x, vr.y}; *(u32x2*)(vp + 8) = (u32x2){vr.z, vr.w}; }
        }
        __syncthreads();
        j = jn; cb ^= 1;
    }
}
__device__ __forceinline__ void add_scaled(f32x16 (&acc)[2], const f32x16 (&o)[2], float f, float* wsc, int i, int hi) {
    if (hi == 0) wsc[i] = f;
    asm volatile("" ::: "memory");
#pragma unroll
    for (int rg = 0; rg < 4; ++rg) { const f32x4 a4 = *(const f32x4*)(wsc + 8 * rg + 4 * hi);
#pragma unroll
        for (int e = 0; e < 4; ++e) { acc[0][4 * rg + e] += a4[e] * o[0][4 * rg + e]; acc[1][4 * rg + e] += a4[e] * o[1][4 * rg + e]; } }
    asm volatile("" ::: "memory");
}
__device__ __forceinline__ void unit(const NsaArgs& a, int u, unsigned char* sm) {
    const int tid = tidx(), lane = tid & 63, w = __builtin_amdgcn_readfirstlane(tid >> 6), i = lane & 31, hi = lane >> 5;
    const int cur = 127 - (u >> 2), bg = u & 3, b = bg >> 1, g = bg & 1, q0 = cur * 64;
    const int ql = 8 * w + (i >> 2), hd = i & 3, t = q0 + ql;
    const size_t grow = (size_t)b * T_ + t;
    bf16x8 qf[4];
    { const bf16* qp = a.qb + grow * 512 + g * 256 + hd * 64 + 8 * hi;
#pragma unroll
      for (int d0 = 0; d0 < 4; ++d0) qf[d0] = *(const bf16x8*)(qp + 16 * d0); }
    float* wsc = (float*)(sm + OFF_WS) + w * 32;
    float* imp = (float*)(sm + OFF_IMP);
    unsigned* selw = (unsigned*)(sm + OFF_SEL);
    unsigned* um = (unsigned*)(sm + OFF_UM);
    for (int k = tid; k < 64 * IMPW; k += 512) imp[k] = 0.f;
    if (tid < 4) um[tid] = 0u;
    const float* gt = a.gates + grow * 24 + g * 12 + hd * 3;
    const float gc = gt[0], gs = gt[1], gw = gt[2];
    f32x16 acc[2], o[2];
#pragma unroll
    for (int r = 0; r < 16; ++r) { acc[0][r] = 0.f; acc[1][r] = 0.f; }
    const int tw0 = q0 + 8 * w, tw1 = tw0 + 7;
    {
        const int nv = t < 31 ? 0 : (t - 31) / 16 + 1;
        const int nvw = tw0 < 31 ? 0 : (tw0 - 31) / 16 + 1;
        const int nvmax = (q0 + 63 - 31) / 16 + 1, ntc = (nvmax + 63) / 64;
        const unsigned cm0 = ntc >= 32 ? ~0u : ((1u << ntc) - 1u);
        const Branch br{a.kc + (size_t)bg * NCP * 64, a.vct + (size_t)bg * 64 * NCP, NCP};
        float m = -1e30f, l = 0.f;
        run_branch<0, false>(sm, br, cm0, 0u, 0u, 0u, qf, 0, nv - 1, 0, nvw - 1, 0u, 0u, 0u, 0u, m, l, 0.f, o, nullptr, wsc, tid, lane);
        l += __shfl_xor(l, 32);
        const float invl = 1.f / fmaxf(l, 1e-30f);
#pragma unroll
        for (int r = 0; r < 16; ++r) { o[0][r] = 0.f; o[1][r] = 0.f; }
        run_branch<1, false>(sm, br, cm0, 0u, 0u, 0u, qf, 0, nv - 1, 0, nvw - 1, 0u, 0u, 0u, 0u, m, l, invl, o, imp + ql * IMPW, wsc, tid, lane);
        add_scaled(acc, o, gc, wsc, i, hi);
    }
    {
        unsigned u0 = 0u, u1 = 0u, u2 = 0u, u3 = 0u;
        const int ncand = cur - 2;
        for (int qq = 0; qq < 8; ++qq) {
            unsigned k0 = 0u, k1 = 0u, k2 = 0u, k3 = 0u;
            if (ncand <= 13) {
#pragma unroll
                for (int wd = 0; wd < 4; ++wd) { const int nb = cur + 1 - 32 * wd; const unsigned x = nb >= 32 ? ~0u : (nb <= 0 ? 0u : ((1u << nb) - 1u));
                    if (wd == 0) k0 = x; else if (wd == 1) k1 = x; else if (wd == 2) k2 = x; else k3 = x; }
            } else {
                const float* ir = imp + (8 * w + qq) * IMPW;
                float v0 = (lane >= 1 && lane <= cur - 2) ? ir[lane] : -1.f;
                float v1 = (lane + 64 <= cur - 2) ? ir[lane + 64] : -1.f;
                for (int it = 0; it < 13; ++it) {
                    float bv = v0; int bs = lane;
                    if (v1 > v0) { bv = v1; bs = lane + 64; }
#pragma unroll
                    for (int off = 1; off < 64; off <<= 1) { const float ov = __shfl_xor(bv, off); const int os = __shfl_xor(bs, off);
                        if (ov > bv || (ov == bv && os < bs)) { bv = ov; bs = os; } }
                    bs = __builtin_amdgcn_readfirstlane(bs);
                    if (bs == lane) v0 = -1.f; if (bs == lane + 64) v1 = -1.f;
                    const unsigned bit = 1u << (bs & 31);
                    if (bs < 32) k0 |= bit; else if (bs < 64) k1 |= bit; else if (bs < 96) k2 |= bit; else k3 |= bit;
                }
                k0 |= 1u;
                { const int c1 = cur - 1; const unsigned bit = 1u << (c1 & 31); if (c1 < 32) k0 |= bit; else if (c1 < 64) k1 |= bit; else if (c1 < 96) k2 |= bit; else k3 |= bit; }
                { const unsigned bit = 1u << (cur & 31); if (cur < 32) k0 |= bit; else if (cur < 64) k1 |= bit; else if (cur < 96) k2 |= bit; else k3 |= bit; }
            }
            if (lane == 0) { unsigned* sp = selw + (8 * w + qq) * 4; sp[0] = k0; sp[1] = k1; sp[2] = k2; sp[3] = k3; }
            u0 |= k0; u1 |= k1; u2 |= k2; u3 |= k3;
        }
        if (lane == 0) { atomicOr(um + 0, u0); atomicOr(um + 1, u1); atomicOr(um + 2, u2); atomicOr(um + 3, u3); }
    }
    __syncthreads();
    {
        const unsigned U0 = um[0], U1 = um[1], U2 = um[2], U3 = um[3];
        const unsigned* sp = selw + ql * 4; const unsigned s0 = sp[0], s1 = sp[1], s2 = sp[2], s3 = sp[3];
        const Branch br{a.ks + (size_t)bg * T_ * 64, a.vst + (size_t)bg * 64 * T_, T_};
        float m = -1e30f, l = 0.f;
#pragma unroll
        for (int r = 0; r < 16; ++r) { o[0][r] = 0.f; o[1][r] = 0.f; }
        run_branch<2, true>(sm, br, __builtin_amdgcn_readfirstlane(U0), __builtin_amdgcn_readfirstlane(U1), __builtin_amdgcn_readfirstlane(U2), __builtin_amdgcn_readfirstlane(U3),
                            qf, 0, t, 0, tw0, s0, s1, s2, s3, m, l, 0.f, o, nullptr, wsc, tid, lane);
        l += __shfl_xor(l, 32);
        add_scaled(acc, o, gs / fmaxf(l, 1e-30f), wsc, i, hi);
    }
    {
        const int j0 = cur - 8 > 0 ? cur - 8 : 0;
        unsigned wm0 = 0u, wm1 = 0u, wm2 = 0u, wm3 = 0u;
#pragma unroll
        for (int wd = 0; wd < 4; ++wd) { const int a0 = j0 - 32 * wd, a1 = cur + 1 - 32 * wd;
            const unsigned hi_m = a1 >= 32 ? ~0u : (a1 <= 0 ? 0u : ((1u << a1) - 1u)), lo_m = a0 >= 32 ? ~0u : (a0 <= 0 ? 0u : ((1u << a0) - 1u));
            const unsigned x = hi_m & ~lo_m; if (wd == 0) wm0 = x; else if (wd == 1) wm1 = x; else if (wd == 2) wm2 = x; else wm3 = x; }
        const Branch br{a.kw + (size_t)bg * T_ * 64, a.vwt + (size_t)bg * 64 * T_, T_};
        float m = -1e30f, l = 0.f;
#pragma unroll
        for (int r = 0; r < 16; ++r) { o[0][r] = 0.f; o[1][r] = 0.f; }
        run_branch<2, false>(sm, br, wm0, wm1, wm2, wm3, qf, t - 511, t, tw1 - 511, tw0, 0u, 0u, 0u, 0u, m, l, 0.f, o, nullptr, wsc, tid, lane);
        l += __shfl_xor(l, 32);
        add_scaled(acc, o, gw / fmaxf(l, 1e-30f), wsc, i, hi);
    }
#pragma unroll
    for (int r = 0; r < 16; ++r) { const int rw = crow(r, hi), qq = 8 * w + (rw >> 2), hh = rw & 3;
        bf16* op = a.amix + ((size_t)b * T_ + q0 + qq) * DM + g * 256 + hh * 64 + i;
        op[0] = (bf16)f2bf(acc[0][r]); op[32] = (bf16)f2bf(acc[1][r]); }
}
__device__ __forceinline__ void phase(const NsaArgs& a, unsigned* ctr, unsigned char* sm) {
    int* slot = (int*)(sm + OFF_UNIT);
    for (;;) {
        if (tidx() == 0) *slot = (int)atomicAdd(ctr, 1u);
        __syncthreads();
        const int u = *slot;
        __syncthreads();
        if (u >= 512) break;
        unit(a, u, sm);
    }
}
}

__device__ __forceinline__ void d_lora_prep(const bf16* pr, const float* mu, bf16* la) {
    const int T512 = tidx(), c = T512 & 255;
    const float m = mu[1536 + c];
    FOR_VB(vb, M_ / 4) {
        const int row0 = vb * 4;
        float x[5];
        x[0] = (row0 % T_) ? bf2f(pr[(size_t)(row0 - 1) * 256 + c]) : 0.f;
#pragma unroll
        for (int j = 0; j < 4; ++j) x[j + 1] = bf2f(pr[(size_t)(row0 + j) * 256 + c]);
#pragma unroll
        for (int j = 0; j < 4; ++j) { const float xs = x[j + 1] + (x[j] - x[j + 1]) * m;
            const float v = c < 64 ? tanhf(xs) : (c < 128 ? xs : sigmoidf_(xs));
            la[(size_t)(row0 + j) * KLORA + c] = (bf16)f2bf(v); }
    }
}

namespace rw7 {
using nsa::f32x16; using nsa::crow; using nsa::pack8;
constexpr int NSLOT = 4, RA = 144, RB = 40, S_AT = 0, S_RT = 16 * RA, S_BT = 32 * RA, S_KT = S_BT + 64 * RB, S_VT = S_KT + 64 * RB, S_SM = S_VT + 64 * RB, SMM = 16 * RB, S_GC = S_SM + 4 * SMM, SLOT = S_GC + 256;
constexpr int OFF_SCR = 2 * NSLOT * SLOT, SCR = 32 * RA, LDS_NEED = OFF_SCR + NSLOT * SCR;
static_assert(LDS_NEED <= 147456 && SLOT % 16 == 0 && S_BT % 16 == 0 && 128 * RB >= 4096 && SCR >= 4096, "rw7 lds map");
struct Args { const unsigned* rkw; const bf16* vv; const bf16* aga; const float* wdec; const float *mu, *kk, *ka, *rk; float* yraw; float* bonus; };
struct Chan { float mur, muk, muv, kkc, kac, rkc; };
struct Raw { unsigned rk[16]; unsigned short v[16], al[16]; float w[16]; unsigned prk; unsigned short pv; };
__device__ __forceinline__ void fetch(const Args& a, int b, int h, int c, int lane, Raw& q) {
    const size_t base = ((size_t)b * T_ + (size_t)c * 16) * 512 + h * 64 + lane;
#pragma unroll
    for (int t = 0; t < 16; ++t) { q.rk[t] = a.rkw[base + (size_t)t * 512]; q.v[t] = a.vv[base + (size_t)t * 512]; q.al[t] = a.aga[base + (size_t)t * 512]; q.w[t] = a.wdec[base + (size_t)t * 512]; }
    q.prk = 0u; q.pv = 0;
    if (c > 0) { q.prk = a.rkw[base - 512]; q.pv = a.vv[base - 512]; }
}
__device__ __forceinline__ void st_row40(unsigned char* p, const unsigned (&w)[8]) {
    *(u32x2*)p = (u32x2){w[0], w[1]}; *(u32x2*)(p + 8) = (u32x2){w[2], w[3]}; *(u32x2*)(p + 16) = (u32x2){w[4], w[5]}; *(u32x2*)(p + 24) = (u32x2){w[6], w[7]};
}
__device__ __forceinline__ void produce(const Args& a, const Chan& ch, int b, int h, int c, const Raw& q, unsigned char* slot, unsigned char* scr, int lane) {
    const int i = lane & 31, hi = lane >> 5;
    const size_t row0 = (size_t)b * T_ + (size_t)c * 16;
    float pr_r = __builtin_bit_cast(float, q.prk << 16), pr_k = __builtin_bit_cast(float, q.prk & 0xffff0000u), pr_v = bf2f(q.pv);
    float rr[16], kq[16], kt[16];
    float* RED1 = (float*)scr;
    float* RED2 = (float*)(slot + S_BT);
#pragma unroll
    for (int t4 = 0; t4 < 4; ++t4) { f32x4 e1, e2;
#pragma unroll
        for (int e = 0; e < 4; ++e) { const int t = 4 * t4 + e;
            const float r0 = __builtin_bit_cast(float, q.rk[t] << 16), k0 = __builtin_bit_cast(float, q.rk[t] & 0xffff0000u), al = bf2f(q.al[t]);
            const float r = r0 + (pr_r - r0) * ch.mur, k = k0 + (pr_k - k0) * ch.muk;
            pr_r = r0; pr_k = k0;
            rr[t] = r; kq[t] = k * ch.kkc; kt[t] = k * (1.f + (al - 1.f) * ch.kac);
            e1[e] = kq[t] * kq[t]; e2[e] = r * kt[t] * ch.rkc; }
        *(f32x4*)(RED1 + lane * 16 + 4 * t4) = e1; *(f32x4*)(RED2 + lane * 16 + 4 * t4) = e2; }
    asm volatile("s_waitcnt lgkmcnt(0)" ::: "memory");
    { const int t = lane & 15, part = lane >> 4; float s1 = 0.f, s2 = 0.f;
#pragma unroll
      for (int j = 0; j < 16; ++j) { s1 += RED1[(part * 16 + j) * 16 + t]; s2 += RED2[(part * 16 + j) * 16 + t]; }
      s1 += __shfl_xor(s1, 16); s2 += __shfl_xor(s2, 16); s1 += __shfl_xor(s1, 32); s2 += __shfl_xor(s2, 32);
      asm volatile("s_waitcnt lgkmcnt(0)" ::: "memory");
      if (lane < 16) { ((float*)(slot + S_GC))[lane] = s1; a.bonus[(row0 + lane) * 8 + h] = s2; } }
    asm volatile("s_waitcnt lgkmcnt(0)" ::: "memory");
    f32x4 n2[4];
#pragma unroll
    for (int t4 = 0; t4 < 4; ++t4) n2[t4] = *(const f32x4*)(slot + S_GC + 16 * t4);
    asm volatile("s_waitcnt lgkmcnt(0)" ::: "memory");
    float gam = 1.f;
    unsigned btp[8], ktp[8], vtp[8];
    float b_ev = 0.f, k_ev = 0.f, v_ev = 0.f;
#pragma unroll
    for (int t = 0; t < 16; ++t) {
        const float v0 = bf2f(q.v[t]), al = bf2f(q.al[t]);
        const float v = v0 + (pr_v - v0) * ch.muv; pr_v = v0;
        const float kkn = kq[t] * __builtin_amdgcn_rsqf(fmaxf(n2[t >> 2][t & 3], 1e-24f));
        const float gp = gam; gam *= q.w[t]; const float ig = __builtin_amdgcn_rcpf(gam);
        const float bt_ = kkn * al * ig, kt_ = kt[t] * ig;
        const unsigned ar = pk2(-kkn * gp, rr[t] * gam), bk = pk2(bt_, kt_);
        *(bf16*)(slot + S_AT + t * RA + lane * 2) = (bf16)(ar & 0xffffu); *(bf16*)(slot + S_RT + t * RA + lane * 2) = (bf16)(ar >> 16);
        *(bf16*)(scr + t * RA + lane * 2) = (bf16)(bk & 0xffffu); *(bf16*)(scr + (16 + t) * RA + lane * 2) = (bf16)(bk >> 16);
        if (t & 1) { btp[t >> 1] = pk2(b_ev, bt_); ktp[t >> 1] = pk2(k_ev, kt_); vtp[t >> 1] = pk2(v_ev, v); }
        else { b_ev = bt_; k_ev = kt_; v_ev = v; }
    }
    st_row40(slot + S_BT + lane * RB, btp); st_row40(slot + S_KT + lane * RB, ktp); st_row40(slot + S_VT + lane * RB, vtp);
    ((float*)(slot + S_GC))[lane] = gam;
    asm volatile("s_waitcnt lgkmcnt(0)" ::: "memory");
    f32x16 C;
#pragma unroll
    for (int r = 0; r < 16; ++r) C[r] = 0.f;
#pragma unroll
    for (int ks = 0; ks < 4; ++ks) {
        const bf16x8 af = *(const bf16x8*)(slot + S_AT + i * RA + (16 * ks + 8 * hi) * 2);
        const bf16x8 bf = *(const bf16x8*)(scr + i * RA + (16 * ks + 8 * hi) * 2);
        C = __builtin_amdgcn_mfma_f32_32x32x16_bf16(af, bf, C, 0, 0, 0);
    }
    asm volatile("s_waitcnt lgkmcnt(0)" ::: "memory");
    float* AAB = (float*)scr;
    unsigned char* SM = slot + S_SM;
#pragma unroll
    for (int r = 0; r < 16; ++r) {
        const int rho = crow(r, hi); const float val = C[r];
        if (r < 8) {
            if (i < 16) AAB[rho * 16 + i] = (i < rho) ? val : 0.f;
            else *(bf16*)(SM + SMM + rho * RB + (i - 16) * 2) = (bf16)f2bf((i - 16 < rho) ? val : 0.f);
        } else {
            const int tt = rho - 16;
            if (i < 16) *(bf16*)(SM + 2 * SMM + tt * RB + i * 2) = (bf16)f2bf((i <= tt) ? val : 0.f);
            else *(bf16*)(SM + 3 * SMM + tt * RB + (i - 16) * 2) = (bf16)f2bf((i - 16 <= tt) ? val : 0.f);
        }
    }
    asm volatile("s_waitcnt lgkmcnt(0)" ::: "memory");
    { const int j = lane & 15; float Tr[16];
#pragma unroll
      for (int t = 0; t < 16; ++t) { float acc = (t == j) ? 1.f : 0.f;
#pragma unroll
          for (int s4 = 0; s4 < (t + 3) / 4; ++s4) { const f32x4 ar = *(const f32x4*)(AAB + t * 16 + 4 * s4);
#pragma unroll
              for (int e = 0; e < 4; ++e) if (4 * s4 + e < t) acc += ar[e] * Tr[4 * s4 + e]; }
          Tr[t] = acc;
          if (lane < 16) *(bf16*)(SM + t * RB + j * 2) = (bf16)f2bf(acc); } }
}

__device__ __forceinline__ bf16x8 rd_perm(const unsigned char* p, int hi) {
    const u32x2 a = *(const u32x2*)(p + 8 * hi), b = *(const u32x2*)(p + 16 + 8 * hi);
    return __builtin_bit_cast(bf16x8, (u32x4){a.x, a.y, b.x, b.y});
}
__device__ __forceinline__ bf16x8 rd_nat(const unsigned char* p, int hi) {
    const u32x2 a = *(const u32x2*)(p + 16 * hi), b = *(const u32x2*)(p + 16 * hi + 8);
    return __builtin_bit_cast(bf16x8, (u32x4){a.x, a.y, b.x, b.y});
}
__device__ __forceinline__ void consume(const unsigned char* slot, f32x16 (&z)[2], float* yout, int vt, int lane) {
    const int i = lane & 31, hi = lane >> 5, i16 = i & 15; const bool lo16 = i < 16;
    const bf16x8 zero = {0, 0, 0, 0, 0, 0, 0, 0};
    const bf16x8 zb0 = pack8(z[0], 0), zb1 = pack8(z[0], 8), zb2 = pack8(z[1], 0), zb3 = pack8(z[1], 8);
    const unsigned char* at = slot + S_AT + i16 * RA; const unsigned char* rt = slot + S_RT + i16 * RA; const unsigned char* sm16 = slot + S_SM + i16 * RB;
    const bf16x8 vtf = rd_nat(slot + S_VT + (32 * vt + i) * RB, hi);
    f32x16 X, U, Y;
#pragma unroll
    for (int r = 0; r < 16; ++r) { X[r] = 0.f; U[r] = 0.f; Y[r] = 0.f; }
    X = __builtin_amdgcn_mfma_f32_32x32x16_bf16(lo16 ? rd_perm(at, hi) : zero, zb0, X, 0, 0, 0);
    X = __builtin_amdgcn_mfma_f32_32x32x16_bf16(lo16 ? rd_perm(at + 32, hi) : zero, zb1, X, 0, 0, 0);
    X = __builtin_amdgcn_mfma_f32_32x32x16_bf16(lo16 ? rd_perm(at + 64, hi) : zero, zb2, X, 0, 0, 0);
    X = __builtin_amdgcn_mfma_f32_32x32x16_bf16(lo16 ? rd_perm(at + 96, hi) : zero, zb3, X, 0, 0, 0);
    X = __builtin_amdgcn_mfma_f32_32x32x16_bf16(lo16 ? rd_nat(sm16 + SMM, hi) : zero, vtf, X, 0, 0, 0);
    const bf16x8 xb = pack8(X, 0);
    U = __builtin_amdgcn_mfma_f32_32x32x16_bf16(lo16 ? rd_perm(sm16, hi) : zero, xb, U, 0, 0, 0);
    const bf16x8 ub = pack8(U, 0);
    Y = __builtin_amdgcn_mfma_f32_32x32x16_bf16(lo16 ? rd_perm(rt, hi) : zero, zb0, Y, 0, 0, 0);
    Y = __builtin_amdgcn_mfma_f32_32x32x16_bf16(lo16 ? rd_perm(rt + 32, hi) : zero, zb1, Y, 0, 0, 0);
    Y = __builtin_amdgcn_mfma_f32_32x32x16_bf16(lo16 ? rd_perm(rt + 64, hi) : zero, zb2, Y, 0, 0, 0);
    Y = __builtin_amdgcn_mfma_f32_32x32x16_bf16(lo16 ? rd_perm(rt + 96, hi) : zero, zb3, Y, 0, 0, 0);
    Y = __builtin_amdgcn_mfma_f32_32x32x16_bf16(lo16 ? rd_perm(sm16 + 2 * SMM, hi) : zero, ub, Y, 0, 0, 0);
    Y = __builtin_amdgcn_mfma_f32_32x32x16_bf16(lo16 ? rd_nat(sm16 + 3 * SMM, hi) : zero, vtf, Y, 0, 0, 0);
#pragma unroll
    for (int kt = 0; kt < 2; ++kt) {
        z[kt] = __builtin_amdgcn_mfma_f32_32x32x16_bf16(rd_nat(slot + S_KT + (32 * kt + i) * RB, hi), vtf, z[kt], 0, 0, 0);
        z[kt] = __builtin_amdgcn_mfma_f32_32x32x16_bf16(rd_perm(slot + S_BT + (32 * kt + i) * RB, hi), ub, z[kt], 0, 0, 0);
#pragma unroll
        for (int rg = 0; rg < 4; ++rg) { const f32x4 g4 = *(const f32x4*)(slot + S_GC + (32 * kt + 8 * rg + 4 * hi) * 4);
#pragma unroll
            for (int e = 0; e < 4; ++e) z[kt][4 * rg + e] *= g4[e]; }
    }
#pragma unroll
    for (int r = 0; r < 8; ++r) yout[(size_t)crow(r, hi) * 512] = Y[r];
}

__device__ __forceinline__ void head(const Args& a, int bh, unsigned char* sm) {
    const int tid = tidx(), lane = tid & 63, w = __builtin_amdgcn_readfirstlane(tid >> 6);
    const int b = bh >> 3, h = bh & 7;
    constexpr int NSTEP = T_ / 16 / NSLOT;
    if (w < 2) {
        f32x16 z[2];
#pragma unroll
        for (int r = 0; r < 16; ++r) { z[0][r] = 0.f; z[1][r] = 0.f; }
        __syncthreads();
        for (int g = 0; g < NSTEP; ++g) {
#pragma unroll
            for (int p = 0; p < NSLOT; ++p) {
                const int c = NSLOT * g + p;
                consume(sm + (size_t)((g & 1) * NSLOT + p) * SLOT, z, a.yraw + ((size_t)b * T_ + (size_t)c * 16) * 512 + h * 64 + 32 * w + (lane & 31), w, lane);
            }
            __syncthreads();
        }
    } else if ((w & 2) != 0) {
        const int pw = (w & 1) | ((w >> 2) << 1), col = h * 64 + lane;
        const Chan ch{a.mu[col], a.mu[512 + col], a.mu[1024 + col], a.kk[col], a.ka[col], a.rk[col]};
        unsigned char* scr = sm + OFF_SCR + pw * SCR;
        Raw q; fetch(a, b, h, pw, lane, q);
        { Raw nq; fetch(a, b, h, pw + NSLOT, lane, nq); produce(a, ch, b, h, pw, q, sm + (size_t)pw * SLOT, scr, lane); q = nq; }
        __syncthreads();
        for (int g = 0; g < NSTEP; ++g) {
            const int c = NSLOT * (g + 1) + pw;
            if (c < T_ / 16) { Raw nq; if (c + NSLOT < T_ / 16) fetch(a, b, h, c + NSLOT, lane, nq);
                produce(a, ch, b, h, c, q, sm + (size_t)(((g + 1) & 1) * NSLOT + pw) * SLOT, scr, lane); q = nq; }
            __syncthreads();
        }
    } else {
        __syncthreads();
        for (int g = 0; g < NSTEP; ++g) __syncthreads();
    }
}
__device__ __forceinline__ void finish(const float* yraw, const float* bonus, const bf16* vv, const bf16* agg, const float* mu, const float* gng, const float* gnb, bf16* amix) {
    const int T512 = tidx(), lane = T512 & 63;
    for (int it0 = (blockIdx.x * 8 + (T512 >> 6)) * 4; it0 < M_ * 8; it0 += gridDim.x * 8 * 4) {
        const int row = it0 >> 3, h0 = it0 & 7, t = row % T_;
        float y[4], v0[4], v1[4], gg[4], bo[4];
#pragma unroll
        for (int j = 0; j < 4; ++j) { const int col = (h0 + j) * 64 + lane;
            y[j] = yraw[(size_t)row * 512 + col]; v0[j] = bf2f(vv[(size_t)row * 512 + col]); v1[j] = t ? bf2f(vv[(size_t)(row - 1) * 512 + col]) : 0.f;
            gg[j] = bf2f(agg[(size_t)row * 512 + col]); bo[j] = bonus[(size_t)row * 8 + h0 + j]; }
        float mean[4], var[4];
#pragma unroll
        for (int j = 0; j < 4; ++j) mean[j] = y[j];
#pragma unroll
        for (int o = 1; o < 64; o <<= 1) {
#pragma unroll
            for (int j = 0; j < 4; ++j) mean[j] += __shfl_xor(mean[j], o); }
#pragma unroll
        for (int j = 0; j < 4; ++j) { mean[j] *= (1.f / 64.f); y[j] -= mean[j]; var[j] = y[j] * y[j]; }
#pragma unroll
        for (int o = 1; o < 64; o <<= 1) {
#pragma unroll
            for (int j = 0; j < 4; ++j) var[j] += __shfl_xor(var[j], o); }
#pragma unroll
        for (int j = 0; j < 4; ++j) { const int col = (h0 + j) * 64 + lane;
            const float yn = y[j] * rsqrtf(var[j] * (1.f / 64.f) + 64e-5f) * gng[col] + gnb[col];
            const float v = v0[j] + (v1[j] - v0[j]) * mu[1024 + col];
            amix[(size_t)row * DM + 512 + col] = (bf16)f2bf((yn + bo[j] * v) * gg[j]); }
    }
}
}

namespace mema {
using nsa::f32x16; using nsa::KROW; using nsa::VROW; using nsa::KBUF; using nsa::VBUF; using nsa::OFF_K; using nsa::OFF_V; using nsa::OFF_WS; using nsa::crow; using nsa::pack8;
__device__ __forceinline__ void unit(const bf16* qm, const bf16* mk, const bf16* mvt, bf16* om, int u, unsigned char* sm) {
    const int tid = tidx(), lane = tid & 63, w = __builtin_amdgcn_readfirstlane(tid >> 6), i = lane & 31, hi = lane >> 5;
    const int b = u >> 7, h = (u >> 5) & 3, rb = u & 31;
    const int row0 = b * T_ + rb * 256 + 32 * w;
    const bf16* qrow = qm + (size_t)(row0 + i) * DM + h * 256 + 8 * hi;
    const bf16* kbase = mk + (size_t)(b * 256 + (tid >> 3)) * DM + h * 256 + (tid & 7) * 8;
    const bf16* vbase = mvt + (size_t)(h * 256 + (tid >> 3)) * 512 + b * 256 + (tid & 7) * 8;
    unsigned char* kst = sm + OFF_K + (tid >> 3) * KROW + (tid & 7) * 16;
    unsigned char* vst = sm + OFF_V + (tid >> 3) * VROW + (tid & 7) * 16;
    float* wsc = (float*)(sm + OFF_WS) + w * 32;
    f32x16 p[4][2];
#pragma unroll
    for (int kt = 0; kt < 4; ++kt)
#pragma unroll
        for (int r = 0; r < 16; ++r) { p[kt][0][r] = 0.f; p[kt][1][r] = 0.f; }
    u32x4 tr = *(const u32x4*)kbase;
    *(u32x4*)kst = tr;
    __syncthreads();
    bf16x8 qf[4];
#pragma unroll
    for (int n = 0; n < 16; ++n) {
        const int dc = n >> 2, kt = n & 3, cb = n & 1;
        if (n + 1 < 16) tr = *(const u32x4*)(kbase + (size_t)(64 * ((n + 1) & 3)) * DM + 64 * ((n + 1) >> 2));
        else tr = *(const u32x4*)vbase;
        if (kt == 0) {
#pragma unroll
            for (int d0 = 0; d0 < 4; ++d0) qf[d0] = *(const bf16x8*)(qrow + 64 * dc + 16 * d0);
        }
        const unsigned char* kb = sm + OFF_K + cb * KBUF;
#pragma unroll
        for (int d0 = 0; d0 < 4; ++d0) {
            const bf16x8 a0 = *(const bf16x8*)(kb + i * KROW + (16 * d0 + 8 * hi) * 2);
            const bf16x8 a1 = *(const bf16x8*)(kb + (32 + i) * KROW + (16 * d0 + 8 * hi) * 2);
            p[kt][0] = __builtin_amdgcn_mfma_f32_32x32x16_bf16(a0, qf[d0], p[kt][0], 0, 0, 0);
            p[kt][1] = __builtin_amdgcn_mfma_f32_32x32x16_bf16(a1, qf[d0], p[kt][1], 0, 0, 0);
        }
        if (n + 1 < 16) *(u32x4*)(kst + (cb ^ 1) * KBUF) = tr;
        else { *(u32x2*)vst = (u32x2){tr.x, tr.y}; *(u32x2*)(vst + 8) = (u32x2){tr.z, tr.w}; }
        __syncthreads();
    }
    float mx = p[0][0][0];
#pragma unroll
    for (int kt = 0; kt < 4; ++kt)
#pragma unroll
        for (int r = 0; r < 16; ++r) mx = fmaxf(mx, fmaxf(p[kt][0][r], p[kt][1][r]));
    mx = fmaxf(mx, __shfl_xor(mx, 32));
    float l = 0.f;
#pragma unroll
    for (int kt = 0; kt < 4; ++kt)
#pragma unroll
        for (int r = 0; r < 16; ++r) { p[kt][0][r] = __builtin_amdgcn_exp2f(p[kt][0][r] - mx); p[kt][1][r] = __builtin_amdgcn_exp2f(p[kt][1][r] - mx); l += p[kt][0][r] + p[kt][1][r]; }
    l += __shfl_xor(l, 32);
    bf16x8 pf[4][4];
#pragma unroll
    for (int kt = 0; kt < 4; ++kt) { pf[kt][0] = pack8(p[kt][0], 0); pf[kt][1] = pack8(p[kt][0], 8); pf[kt][2] = pack8(p[kt][1], 0); pf[kt][3] = pack8(p[kt][1], 8); }
    if (hi == 0) wsc[i] = 1.f / l;
    asm volatile("" ::: "memory");
    f32x4 il[4];
#pragma unroll
    for (int rg = 0; rg < 4; ++rg) il[rg] = *(const f32x4*)(wsc + 8 * rg + 4 * hi);
    f32x16 o[2];
#pragma unroll
    for (int n = 0; n < 16; ++n) {
        const int dvt = n >> 2, kt = n & 3, cb = n & 1;
        if (n + 1 < 16) tr = *(const u32x4*)(vbase + (size_t)(64 * ((n + 1) >> 2)) * 512 + 64 * ((n + 1) & 3));
        if (kt == 0) {
#pragma unroll
            for (int r = 0; r < 16; ++r) { o[0][r] = 0.f; o[1][r] = 0.f; }
        }
        const unsigned char* vb = sm + OFF_V + cb * VBUF;
#pragma unroll
        for (int dt = 0; dt < 2; ++dt) {
            const unsigned char* vp = vb + (32 * dt + i) * VROW + 8 * hi;
#pragma unroll
            for (int ks = 0; ks < 4; ++ks) {
                const u32x2 v_lo = *(const u32x2*)(vp + 32 * ks), v_hi = *(const u32x2*)(vp + 32 * ks + 16);
                const bf16x8 vf = __builtin_bit_cast(bf16x8, (u32x4){v_lo.x, v_lo.y, v_hi.x, v_hi.y});
                o[dt] = __builtin_amdgcn_mfma_f32_32x32x16_bf16(pf[kt][ks], vf, o[dt], 0, 0, 0);
            }
        }
        if (kt == 3) {
#pragma unroll
            for (int r = 0; r < 16; ++r) { bf16* op = om + (size_t)(row0 + crow(r, hi)) * DM + h * 256 + 64 * dvt + i;
                op[0] = (bf16)f2bf(o[0][r] * il[r >> 2][r & 3]); op[32] = (bf16)f2bf(o[1][r] * il[r >> 2][r & 3]); }
        }
        if (n + 1 < 16) { unsigned char* vp2 = vst + (cb ^ 1) * VBUF; *(u32x2*)vp2 = (u32x2){tr.x, tr.y}; *(u32x2*)(vp2 + 8) = (u32x2){tr.z, tr.w}; }
        __syncthreads();
    }
}
}

constexpr int NTHREADS = 512, LDS_BYTES = 147456;
struct MegaArgs { const float* in[41]; float* out; unsigned char* ws; };
#define WSB(off) ((bf16*)(ws + (off)))
#define WSF(off) ((float*)(ws + (off)))

__global__ void __launch_bounds__(NTHREADS) mega_fwd(MegaArgs A) {
    extern __shared__ __attribute__((aligned(16))) unsigned char lds[];
    cg::grid_group grid = cg::this_grid();
    const float* const* in = A.in; unsigned char* ws = A.ws; float* out = A.out;

    d_convert(WSB(WS_W1GU), NGU, DM, MapGU{in[I_F1_WG], in[I_F1_WU], FF});
    d_convert(WSB(WS_W1D), DM, FF, MapPlain{in[I_F1_WD], DM});
    d_convert(WSB(WS_W2GU), NGU, DM, MapGU{in[I_F2_WG], in[I_F2_WU], FF});
    d_convert(WSB(WS_W2D), DM, FF, MapPlain{in[I_F2_WD], DM});
    d_convert(WSB(WS_WIN), NWIN, DM, MapWin{in[I_WIN], IN_COLS});
    d_convert(WSB(WS_WOUT), DM, DM, MapPlain{in[I_WOUT], DM});
    d_convert(WSB(WS_WQ), DM, DM, MapPlain{in[I_WQ], DM});
    d_convert(WSB(WS_WK), DM, DM, MapPlain{in[I_WK], DM});
    d_convert(WSB(WS_WV), DM, DM, MapPlain{in[I_WV], DM});
    d_convert(WSB(WS_WO), DM, DM, MapPlain{in[I_WO], DM});
    d_convert(WSB(WS_CW1K), 256, 2048, MapPlain{in[I_W1_K], 256});
    d_convert(WSB(WS_CW1V), 256, 2048, MapPlain{in[I_W1_V], 256});
    d_convert_lora(WSB(WS_WLORA), in[I_W2], in[I_A2], in[I_G2]);
    d_rope_table(WSF(WS_ROPE));
    d_cmp_bias(in[I_PE_K], in[I_W1_K], in[I_PE_V], in[I_W1_V], WSF(WS_CBIAS), (float*)lds);
    d_rownorm(in[I_X], in[I_F1_PRE], WSB(WS_XN), M_);
    d_rownorm(in[I_MEM], in[I_MEM_KVG], WSB(WS_MEMN), 512);
    grid.sync();
    gemm_pg8(lds, WSB(WS_XN), DM, WSB(WS_W1GU), DM, M_, NGU, DM, EpiSwiGLU{WSB(WS_HB)});
    grid.sync();
    gemm_norm_res(lds, WSB(WS_HB), FF, WSB(WS_W1D), FF, in[I_X], out, WSB(WS_XN), in[I_F1_POST], in[I_MIX_PRE], 0.5f, WSB(WS_YB), (unsigned*)(ws + WS_GATES), (unsigned*)(ws + WS_CTL) + 1024 + 0 * 2048);
    grid.sync();
    gemm_pg8(lds, WSB(WS_XN), DM, WSB(WS_WIN), DM, M_, NWIN, DM,
             EpiWin{WSB(WS_QB), WSB(WS_KS), WSB(WS_KW), WSB(WS_KCR), WSB(WS_VCR), WSB(WS_VST), WSB(WS_VWT), (unsigned*)(ws + WS_RKVA), WSB(WS_RKVA + 32 * MiB), WSB(WS_PRL), WSF(WS_GATES), WSF(WS_ROPE)});
    grid.sync();
    gemm_pg8(lds, WSB(WS_KCR), 1024, WSB(WS_CW1K), 2048, 2048, 256, 2048, EpiBiasSilu{WSB(WS_HIDK), WSF(WS_CBIAS)});
    gemm_pg8(lds, WSB(WS_VCR), 1024, WSB(WS_CW1V), 2048, 2048, 256, 2048, EpiBiasSilu{WSB(WS_HIDV), WSF(WS_CBIAS) + 256});
    d_lora_prep(WSB(WS_PRL), in[I_MU], WSB(WS_XN));
    grid.sync();
    d_cmp2(WSB(WS_HIDK), WSB(WS_HIDV), in[I_W2_K], in[I_W2_V], WSF(WS_ROPE), WSB(WS_KC), WSB(WS_VCT));
    gemm_pg8(lds, WSB(WS_XN), KLORA, WSB(WS_WLORA), KLORA, M_, NLORA, KLORA, EpiLora{WSF(WS_YB), WSB(WS_RKVA + 48 * MiB), WSB(WS_AGG), in[I_W0], in[I_A0]});
    grid.sync();
    if (blockIdx.x < 16) {
        const rw7::Args ra{(const unsigned*)(ws + WS_RKVA), WSB(WS_RKVA + 32 * MiB), WSB(WS_RKVA + 48 * MiB), WSF(WS_YB), in[I_MU], in[I_KK], in[I_KA], in[I_RK], WSF(WS_YB), WSF(WS_BONUS)};
        rw7::head(ra, blockIdx.x, lds);
    }
    {
        const NsaArgs na{WSB(WS_QB), WSB(WS_KC), WSB(WS_VCT), WSB(WS_KS), WSB(WS_VST), WSB(WS_KW), WSB(WS_VWT), WSF(WS_GATES), WSB(WS_XN)};
        nsa::phase(na, (unsigned*)(ws + WS_CTL), lds);
    }
    grid.sync();
    d_nsa_outnorm(WSB(WS_XN), in[I_NSA_G]);
    rw7::finish(WSF(WS_YB), WSF(WS_BONUS), WSB(WS_RKVA + 32 * MiB), WSB(WS_AGG), in[I_MU], in[I_GNG], in[I_GNB], WSB(WS_XN));
    grid.sync();
    gemm_norm_res(lds, WSB(WS_XN), DM, WSB(WS_WOUT), DM, out, out, WSB(WS_XN), in[I_MIX_POST], in[I_MEM_PRE], 1.0f, WSB(WS_YB), (unsigned*)(ws + WS_GATES), (unsigned*)(ws + WS_CTL) + 1024 + 1 * 2048);
    grid.sync();
    gemm_pg8(lds, WSB(WS_XN), DM, WSB(WS_WQ), DM, M_, DM, DM, EpiStore{WSB(WS_QM), DM, MSCALE});
    gemm_pg8(lds, WSB(WS_MEMN), DM, WSB(WS_WK), DM, 512, DM, DM, EpiStore{WSB(WS_MK), DM, 1.f});
    gemm_pg8(lds, WSB(WS_WV), DM, WSB(WS_MEMN), DM, DM, 512, DM, EpiStore{WSB(WS_MVT), 512, 1.f});
    grid.sync();
    for (int u = blockIdx.x; u < 256; u += gridDim.x) mema::unit(WSB(WS_QM), WSB(WS_MK), WSB(WS_MVT), WSB(WS_OM), u, lds);
    grid.sync();
    gemm_norm_res(lds, WSB(WS_OM), DM, WSB(WS_WO), DM, out, out, WSB(WS_XN), in[I_MEM_POST], in[I_F2_PRE], 1.0f, WSB(WS_YB), (unsigned*)(ws + WS_GATES), (unsigned*)(ws + WS_CTL) + 1024 + 2 * 2048);
    grid.sync();
    gemm_pg8(lds, WSB(WS_XN), DM, WSB(WS_W2GU), DM, M_, NGU, DM, EpiSwiGLU{WSB(WS_HB)});
    grid.sync();
    gemm_norm_res(lds, WSB(WS_HB), FF, WSB(WS_W2D), FF, out, out, (bf16*)nullptr, in[I_F2_POST], (const float*)nullptr, 0.5f, WSB(WS_YB), (unsigned*)(ws + WS_GATES), (unsigned*)(ws + WS_CTL) + 1024 + 3 * 2048);
}

extern "C" void kernel_launch(void* const* d_in, const int* in_sizes, int n_in, void* d_out, int out_size, void* d_ws, size_t ws_size, hipStream_t stream) {
    static int grid = 0;
    if (grid == 0) {
        if (n_in != 41 || ws_size < WS_END) { fprintf(stderr, "kernel_launch: unexpected n_in %d / ws %zu\n", n_in, ws_size); grid = -1; return; }
        int dev = 0, cus = 0, per_cu = 0;
        hipGetDevice(&dev); hipDeviceGetAttribute(&cus, hipDeviceAttributeMultiprocessorCount, dev);
        if (hipFuncSetAttribute((const void*)mega_fwd, hipFuncAttributeMaxDynamicSharedMemorySize, LDS_BYTES) != hipSuccess) { fprintf(stderr, "kernel_launch: hipFuncSetAttribute failed\n"); grid = -1; return; }
        if (hipOccupancyMaxActiveBlocksPerMultiprocessor(&per_cu, (const void*)mega_fwd, NTHREADS, LDS_BYTES) != hipSuccess || per_cu < 1) { fprintf(stderr, "kernel_launch: occupancy query says %d\n", per_cu); grid = -1; (void)hipGetLastError(); return; }
        grid = cus;
        if (grid != 256) { fprintf(stderr, "kernel_launch: built for 256 CUs (one 256x256 tile per workgroup in the fused norm epilogues), found %d\n", cus); grid = -1; return; }
    }
    if (grid < 0) return;
    MegaArgs a{};
    for (int i = 0; i < 41; ++i) a.in[i] = (const float*)d_in[i];
    a.out = (float*)d_out; a.ws = (unsigned char*)d_ws;
    hipMemsetAsync(d_ws, 0, 65536, stream);
    void* args[] = {&a};
    hipError_t e = hipLaunchCooperativeKernel((const void*)mega_fwd, dim3(grid), dim3(NTHREADS), args, LDS_BYTES, stream);
    if (e != hipSuccess) fprintf(stderr, "kernel_launch: cooperative launch failed: %s (grid %d)\n", hipGetErrorString(e), grid);
}
```

```cpp
#include <hip/hip_runtime.h>
#include <hip/hip_cooperative_groups.h>
#include <cstdint>
#include <cstdio>

constexpr int NB = 2, T_ = 8192, DM = 1024, M_ = NB * T_;
constexpr int FF = 2816, NGU = 2 * FF;
constexpr int IN_COLS = 3096, NWIN = 3328;
constexpr int NRW = 1792;
constexpr int NCP = 512;
constexpr int NLORA = 1536, KLORA = 256;
constexpr float NORM_EPS = 1e-6f;
constexpr float QSCALE = 0.125f * 1.4426950408889634f;
constexpr float MSCALE = 0.0625f * 1.4426950408889634f;

typedef unsigned short bf16;
typedef short bf16x8 __attribute__((ext_vector_type(8)));
typedef float f32x4 __attribute__((ext_vector_type(4)));
typedef unsigned u32x2 __attribute__((ext_vector_type(2)));
typedef unsigned u32x4 __attribute__((ext_vector_type(4)));

__device__ __forceinline__ unsigned f2bf(float f) { unsigned u = __builtin_bit_cast(unsigned, f); return (u + 0x7fffu + ((u >> 16) & 1u)) >> 16; }
__device__ __forceinline__ float bf2f(bf16 h) { return __builtin_bit_cast(float, (unsigned)h << 16); }
typedef float f32x2_t __attribute__((ext_vector_type(2))); typedef __bf16 bf16x2_t __attribute__((ext_vector_type(2)));
__device__ __forceinline__ unsigned pk2(float lo, float hi) { const f32x2_t v = {lo, hi}; return __builtin_bit_cast(unsigned, __builtin_convertvector(v, bf16x2_t)); }
__device__ __forceinline__ void st_bf4(bf16* p, f32x4 v) { u32x2 w; w.x = pk2(v[0], v[1]); w.y = pk2(v[2], v[3]); *(u32x2*)p = w; }
__device__ __forceinline__ float wave_sum(float v) {
#pragma unroll
    for (int o = 1; o < 64; o <<= 1) v += __shfl_xor(v, o);
    return v;
}
__device__ __forceinline__ float wave_max(float v) {
#pragma unroll
    for (int o = 1; o < 64; o <<= 1) v = fmaxf(v, __shfl_xor(v, o));
    return v;
}
__device__ __forceinline__ float sigmoidf_(float x) { return 1.f / (1.f + __expf(-x)); }
__device__ __forceinline__ int tidx() { int t = threadIdx.x; asm volatile("" : "+v"(t)); return t; }

constexpr size_t MiB = 1u << 20, KiB64 = 65536;
constexpr size_t WS_CTL = 0;
constexpr size_t WS_KC = 256 * 1024;
constexpr size_t WS_VCT = 512 * 1024;
constexpr size_t WS_W1GU = 1 * MiB;
constexpr size_t WS_W1D = 12 * MiB;
constexpr size_t WS_W2GU = WS_W1D + 88 * KiB64;
constexpr size_t WS_W2D = WS_W2GU + 11 * MiB;
constexpr size_t WS_WIN = WS_W2D + 88 * KiB64;
constexpr size_t WS_WOUT = WS_WIN + 104 * KiB64;
constexpr size_t WS_WQ = WS_WOUT + 2 * MiB, WS_WK = WS_WQ + 2 * MiB, WS_WV = WS_WK + 2 * MiB, WS_WO = WS_WV + 2 * MiB;
constexpr size_t WS_CW1K = WS_WO + 2 * MiB, WS_CW1V = WS_CW1K + 1 * MiB;
constexpr size_t WS_WLORA = WS_CW1V + 1 * MiB;
constexpr size_t WS_ROPE = WS_WLORA + 12 * KiB64;
constexpr size_t WS_CBIAS = WS_ROPE + 2 * MiB;
constexpr size_t WS_MEMN = WS_CBIAS + KiB64;
constexpr size_t WS_HIDK = WS_MEMN + 1 * MiB;
constexpr size_t WS_HIDV = WS_HIDK + 1 * MiB;
constexpr size_t WS_GATES = WS_HIDV + 1 * MiB;
constexpr size_t WS_XN = 60 * MiB;
constexpr size_t WS_YB = 92 * MiB;
constexpr size_t WS_D = 124 * MiB;
constexpr size_t WS_HB = WS_D;
constexpr size_t WS_QB = WS_D;
constexpr size_t WS_KS = WS_D + 16 * MiB;
constexpr size_t WS_KW = WS_D + 20 * MiB;
constexpr size_t WS_KCR = WS_D + 24 * MiB;
constexpr size_t WS_VCR = WS_D + 29 * MiB;
constexpr size_t WS_VST = WS_D + 34 * MiB;
constexpr size_t WS_VWT = WS_D + 38 * MiB;
constexpr size_t WS_RKVA = WS_D + 42 * MiB;
constexpr size_t WS_PRL = WS_D + 106 * MiB;
constexpr size_t WS_AGG = WS_D + 114 * MiB;
constexpr size_t WS_BONUS = WS_KCR;
constexpr size_t WS_END = 256 * MiB;
constexpr size_t WS_QM = WS_D;
constexpr size_t WS_OM = WS_D + 32 * MiB;
constexpr size_t WS_MK = WS_D + 64 * MiB;
constexpr size_t WS_MVT = WS_D + 65 * MiB;
static_assert(WS_GATES + (size_t)M_ * 24 * 4 <= WS_XN, "ws map");
static_assert(WS_AGG + 16 * MiB <= WS_END, "ws map");

struct Params {
    const float* in[41];
    float* out;
    unsigned char* ws;
};
enum { I_X = 0, I_MEM, I_F1_PRE, I_F1_WG, I_F1_WU, I_F1_WD, I_F1_POST, I_MIX_PRE, I_WIN, I_PE_K, I_W1_K, I_W2_K, I_PE_V, I_W1_V, I_W2_V,
       I_NSA_G, I_MU, I_W0, I_W2, I_A0, I_A2, I_G2, I_KK, I_KA, I_RK, I_GNG, I_GNB, I_WOUT, I_MIX_POST, I_MEM_PRE, I_MEM_KVG, I_WQ, I_WK, I_WV,
       I_WO, I_MEM_POST, I_F2_PRE, I_F2_WG, I_F2_WU, I_F2_WD, I_F2_POST };

struct MapPlain { const float* W; int N; int pad; __device__ const float* col(int p) const { return W + p; } };
struct MapGU {
    const float* Wg; const float* Wu; int N; int pad;
    __device__ const float* col(int p) const {
        const int pn = p >> 8, q = p & 255, n = (q >> 4) & 1;
        const int hid = 128 * pn + 64 * (q >> 7) + 16 * ((q >> 5) & 3) + (q & 15);
        return Wg + (size_t)n * (size_t)(Wu - Wg) + hid;
    }
};
__host__ __device__ inline int rope_perm(int x) { return 16 * ((x >> 5) & 1) + (x & 15) + 32 * ((x >> 4) & 1); }
struct MapWin {
    const float* W; int N; int pad;
    __device__ const float* col(int p) const {
        int l;
        if (p < 512) l = (p & ~63) + rope_perm(p & 63);
        else if (p < 640) l = 768 + ((p - 512) & ~63) + rope_perm(p & 63);
        else if (p < 768) l = 1024 + ((p - 640) & ~63) + rope_perm(p & 63);
        else if (p < 896) l = 512 + (p - 768);
        else if (p < 1024) l = 640 + (p - 896);
        else if (p < 1152) l = 896 + (p - 1024);
        else if (p < 1280) l = 1152 + (p - 1152);
        else if (p < 2304) { const int q = p - 1280; l = 1304 + (((q >> 4) & 1) ? 512 : 0) + 16 * (q >> 5) + (q & 15); }
        else if (p < 3072) l = 1304 + (p - 1280);
        else if (p < 3096) l = 1280 + (p - 3072);
        else return nullptr;
        return W + l;
    }
};

#define FOR_VB(vb, n) for (int vb = (int)blockIdx.x * 2 + (T512 >> 8); vb < (n); vb += (int)gridDim.x * 2)

template <class Map> __device__ __forceinline__ void d_convert(bf16* WT, int Np, int K, Map map) {
    const int T512 = tidx(), tid = T512 & 255, nbx = Np / 64, nb = nbx * (K / 64);
    FOR_VB(vb, nb) {
        const int p = (vb % nbx) * 64 + (tid & 63), k0 = (vb / nbx) * 64 + (tid >> 6) * 16;
        const float* src = map.col(p);
        float v[16];
#pragma unroll
        for (int i = 0; i < 16; ++i) v[i] = src ? src[(size_t)(k0 + i) * map.N] : 0.f;
        u32x4 a, b;
        a.x = pk2(v[0], v[1]); a.y = pk2(v[2], v[3]); a.z = pk2(v[4], v[5]); a.w = pk2(v[6], v[7]);
        b.x = pk2(v[8], v[9]); b.y = pk2(v[10], v[11]); b.z = pk2(v[12], v[13]); b.w = pk2(v[14], v[15]);
        u32x4* dst = (u32x4*)(WT + (size_t)p * K + k0);
        dst[0] = a; dst[1] = b;
    }
}
__device__ __forceinline__ void d_convert_lora(bf16* WT, const float* w2, const float* a2, const float* g2) {
    const int T512 = tidx(), tid = T512 & 255;
    FOR_VB(vb, NLORA * KLORA / 256) {
        const int idx = vb * 256 + tid, p = idx >> 8, k = idx & 255;
        float v = 0.f;
        if (p < 512) { if (k < 64) v = w2[k * 512 + p]; }
        else if (p < 1024) { if (k >= 64 && k < 128) v = a2[(k - 64) * 512 + (p - 512)]; }
        else { if (k >= 128) v = g2[(k - 128) * 512 + (p - 1024)]; }
        WT[idx] = (bf16)f2bf(v);
    }
}
__device__ __forceinline__ void d_rope_table(float* tab) {
    const int T512 = tidx(), tid = T512 & 255;
    FOR_VB(vb, T_ * 32 / 256) {
        const int idx = vb * 256 + tid, pos = idx >> 5, i = idx & 31;
        const float inv = (float)pow(10000.0, -(double)i / 32.0);
        const float ang = (float)pos * inv;
        tab[2 * idx] = (float)cos((double)ang); tab[2 * idx + 1] = (float)sin((double)ang);
    }
}
__device__ __forceinline__ void d_cmp_bias(const float* pe_k, const float* w1_k, const float* pe_v, const float* w1_v, float* bias, float* red  ) {
    for (int job = blockIdx.x; job < 8; job += gridDim.x) {
        const int kv = job >> 2; const float* pe = kv ? pe_v : pe_k; const float* w1 = kv ? w1_v : w1_k;
        const int T512 = tidx(), lane = T512 & 63, w = T512 >> 6, n = (job & 3) * 64 + lane;
        float s = 0.f;
        for (int j = w * 256; j < w * 256 + 256; ++j) s += pe[j] * w1[(size_t)j * 256 + n];
        red[w * 64 + lane] = s; __syncthreads();
        if (w == 0) { float t = 0.f; for (int i = 0; i < 8; ++i) t += red[i * 64 + lane]; bias[kv * 256 + n] = t; }
        __syncthreads();
    }
}
__device__ __forceinline__ void d_rownorm(const float* x, const float* g, bf16* xn, int rows) {
    const int T512 = tidx(), tid = T512 & 255, lane = tid & 63;
    FOR_VB(vb, rows / 4) {
        const int row = vb * 4 + (tid >> 6);
        const f32x4* xr = (const f32x4*)(x + (size_t)row * DM) + lane; f32x4 v[4]; float s = 0.f;
#pragma unroll
        for (int j = 0; j < 4; ++j) { v[j] = xr[64 * j]; s += v[j][0] * v[j][0] + v[j][1] * v[j][1] + v[j][2] * v[j][2] + v[j][3] * v[j][3]; }
        const float rstd = rsqrtf(wave_sum(s) * (1.f / DM) + NORM_EPS);
#pragma unroll
        for (int j = 0; j < 4; ++j) { const f32x4 gg = ((const f32x4*)g)[lane + 64 * j]; st_bf4(xn + (size_t)row * DM + 4 * (lane + 64 * j), v[j] * rstd * gg); }
    }
}
__device__ __forceinline__ void d_rowpass(const float* xin, const bf16* y, const float* gpost, float coef, const float* gpre, float* xout, bf16* xn) {
    const int T512 = tidx(), tid = T512 & 255, lane = tid & 63;
    FOR_VB(vb, M_ / 4) {
        const int row = vb * 4 + (tid >> 6);
        f32x4 yv[4], xv[4]; float s = 0.f;
#pragma unroll
        for (int j = 0; j < 4; ++j) {
            const u32x2 w = *(const u32x2*)(y + (size_t)row * DM + 4 * (lane + 64 * j));
            yv[j][0] = __builtin_bit_cast(float, w.x << 16); yv[j][1] = __builtin_bit_cast(float, w.x & 0xffff0000u);
            yv[j][2] = __builtin_bit_cast(float, w.y << 16); yv[j][3] = __builtin_bit_cast(float, w.y & 0xffff0000u);
            s += yv[j][0] * yv[j][0] + yv[j][1] * yv[j][1] + yv[j][2] * yv[j][2] + yv[j][3] * yv[j][3];
            xv[j] = ((const f32x4*)(xin + (size_t)row * DM))[lane + 64 * j];
        }
        const float rstd = rsqrtf(wave_sum(s) * (1.f / DM) + NORM_EPS) * coef; float s2 = 0.f;
#pragma unroll
        for (int j = 0; j < 4; ++j) { const f32x4 gg = ((const f32x4*)gpost)[lane + 64 * j]; xv[j] = xv[j] + yv[j] * rstd * gg;
            s2 += xv[j][0] * xv[j][0] + xv[j][1] * xv[j][1] + xv[j][2] * xv[j][2] + xv[j][3] * xv[j][3];
            ((f32x4*)(xout + (size_t)row * DM))[lane + 64 * j] = xv[j]; }
        if (gpre) {
            const float r2 = rsqrtf(wave_sum(s2) * (1.f / DM) + NORM_EPS);
#pragma unroll
            for (int j = 0; j < 4; ++j) { const f32x4 gg = ((const f32x4*)gpre)[lane + 64 * j]; st_bf4(xn + (size_t)row * DM + 4 * (lane + 64 * j), xv[j] * r2 * gg); }
        }
    }
}
__device__ __forceinline__ void d_nsa_outnorm(bf16* amix, const float* g) {
    const int T512 = tidx(), tid = T512 & 255, lane = tid & 63;
    FOR_VB(vb, M_ / 4) {
        const int row = vb * 4 + (tid >> 6);
        bf16* p = amix + (size_t)row * DM + 8 * lane;
        const u32x4 w = *(const u32x4*)p; float v[8]; float s = 0.f;
        v[0] = __builtin_bit_cast(float, w.x << 16); v[1] = __builtin_bit_cast(float, w.x & 0xffff0000u);
        v[2] = __builtin_bit_cast(float, w.y << 16); v[3] = __builtin_bit_cast(float, w.y & 0xffff0000u);
        v[4] = __builtin_bit_cast(float, w.z << 16); v[5] = __builtin_bit_cast(float, w.z & 0xffff0000u);
        v[6] = __builtin_bit_cast(float, w.w << 16); v[7] = __builtin_bit_cast(float, w.w & 0xffff0000u);
#pragma unroll
        for (int i = 0; i < 8; ++i) s += v[i] * v[i];
        const float rstd = rsqrtf(wave_sum(s) * (1.f / 512.f) + NORM_EPS);
        u32x4 o; const float* gg = g + 8 * lane;
        o.x = pk2(v[0] * rstd * gg[0], v[1] * rstd * gg[1]); o.y = pk2(v[2] * rstd * gg[2], v[3] * rstd * gg[3]);
        o.z = pk2(v[4] * rstd * gg[4], v[5] * rstd * gg[5]); o.w = pk2(v[6] * rstd * gg[6], v[7] * rstd * gg[7]);
        *(u32x4*)p = o;
    }
}

struct EpiStore { bf16* O; int ldc; float scale;
    static constexpr int NCAT = 1;
    __device__ __forceinline__ int cat(int) const { return 0; }
    template <int C> __device__ __forceinline__ void apply(int row, int p, f32x4 v0, f32x4 v1) const { bf16* o = O + (size_t)row * ldc + p; st_bf4(o, v0 * scale); st_bf4(o + 16, v1 * scale); } };
struct EpiSwiGLU { bf16* H;
    static constexpr int NCAT = 1;
    __device__ __forceinline__ int cat(int) const { return 0; }
    template <int C> __device__ __forceinline__ void apply(int row, int p, f32x4 g, f32x4 u) const {
        const int q = p & 255, hid = 128 * (p >> 8) + 64 * (q >> 7) + 16 * ((q >> 5) & 3) + (q & 15);
        f32x4 h;
#pragma unroll
        for (int e = 0; e < 4; ++e) h[e] = g[e] / (1.f + __expf(-g[e])) * u[e];
        st_bf4(H + (size_t)row * FF + hid, h); } };
struct EpiBiasSilu { bf16* O; const float* bias;
    static constexpr int NCAT = 1;
    __device__ __forceinline__ int cat(int) const { return 0; }
    template <int C> __device__ __forceinline__ void apply(int row, int p, f32x4 v0, f32x4 v1) const {
        f32x4 a, b; const f32x4 b0 = *(const f32x4*)(bias + p), b1 = *(const f32x4*)(bias + p + 16);
#pragma unroll
        for (int e = 0; e < 4; ++e) { const float x0 = v0[e] + b0[e], x1 = v1[e] + b1[e]; a[e] = x0 / (1.f + __expf(-x0)); b[e] = x1 / (1.f + __expf(-x1)); }
        bf16* o = O + (size_t)row * 256 + p; st_bf4(o, a); st_bf4(o + 16, b); } };
struct EpiLora { float* wdec; bf16* aga; bf16* agg; const float* w0; const float* a0;
    static constexpr int NCAT = 3;
    __device__ __forceinline__ int cat(int p0) const { return p0 < 512 ? 0 : (p0 < 1024 ? 1 : 2); }
    template <int C> __device__ __forceinline__ void one(int row, int p, f32x4 v) const {
        if (C == 0) { f32x4 o; const f32x4 ww = *(const f32x4*)(w0 + p);
#pragma unroll
            for (int e = 0; e < 4; ++e) o[e] = __expf(-0.6065306597126334f * sigmoidf_(ww[e] + v[e]));
            *(f32x4*)(wdec + (size_t)row * 512 + p) = o;
        } else if (C == 1) { f32x4 o; const f32x4 aa = *(const f32x4*)(a0 + p - 512);
#pragma unroll
            for (int e = 0; e < 4; ++e) o[e] = sigmoidf_(aa[e] + v[e]);
            st_bf4(aga + (size_t)row * 512 + (p - 512), o);
        } else st_bf4(agg + (size_t)row * 512 + (p - 1024), v);
    }
    template <int C> __device__ __forceinline__ void apply(int row, int p, f32x4 v0, f32x4 v1) const { one<C>(row, p, v0); one<C>(row, p + 16, v1); } };
struct EpiWin {
    bf16 *qb, *ks, *kw, *kcr, *vcr, *vst, *vwt; unsigned* rk; bf16 *vv, *prl; float* gates; const float* rope;
    static constexpr int NCAT = 8;
    __device__ __forceinline__ int cat(int p0) const { return p0 < 512 ? 0 : (p0 < 768 ? 1 : (p0 < 1024 ? 2 : (p0 < 1280 ? 3 : (p0 < 2304 ? 4 : (p0 < 2816 ? 7 : (p0 < 3072 ? 6 : 5)))))); }
    template <int C> __device__ __forceinline__ void apply(int row, int p, f32x4 v0, f32x4 v1) const {
        const int b = row / T_, t = row % T_;
        if (C == 0 || C == 1) {
            const int x = p & 63, d = 16 * ((x >> 5) & 1) + (x & 15);
            const f32x4* rp = (const f32x4*)(rope + ((size_t)t * 32 + d) * 2); const f32x4 r0 = rp[0], r1 = rp[1];
            const f32x4 cs = {r0[0], r0[2], r1[0], r1[2]}, sn = {r0[1], r0[3], r1[1], r1[3]};
            const f32x4 lo = v0 * cs - v1 * sn, hi = v0 * sn + v1 * cs;
            if (C == 0) { bf16* o = qb + (size_t)row * 512 + (p & ~63) + d; st_bf4(o, lo * QSCALE); st_bf4(o + 32, hi * QSCALE); }
            else { const int g = ((p - 512) >> 6) & 1; bf16* base = (p < 640) ? ks : kw; bf16* o = base + ((size_t)(b * 2 + g) * T_ + t) * 64 + d; st_bf4(o, lo); st_bf4(o + 32, hi); }
        } else if (C == 2) {
            const int c = (p - 768) & 127, g = c >> 6, d = c & 63; bf16* base = (p < 896) ? kcr : vcr;
            bf16* o = base + ((size_t)(b * 2 + g) * T_ + t) * 64 + d; st_bf4(o, v0); st_bf4(o + 16, v1);
        } else if (C == 3) {
            const int c = (p - 1024) & 127, g = c >> 6, d = c & 63; bf16* base = (p < 1152) ? vst : vwt;
            bf16* o = base + ((size_t)(b * 2 + g) * 64 + d) * T_ + t;
#pragma unroll
            for (int e = 0; e < 4; ++e) { o[(size_t)e * T_] = (bf16)f2bf(v0[e]); o[(size_t)(16 + e) * T_] = (bf16)f2bf(v1[e]); }
        } else if (C == 4) {
            const int q = p - 1280, ch = 16 * (q >> 5) + (q & 15);
            u32x4 w; w.x = pk2(v0[0], v1[0]); w.y = pk2(v0[1], v1[1]); w.z = pk2(v0[2], v1[2]); w.w = pk2(v0[3], v1[3]);
            *(u32x4*)(rk + (size_t)row * 512 + ch) = w;
        } else if (C == 7) {
            bf16* o = vv + (size_t)row * 512 + (p - 2304); st_bf4(o, v0); st_bf4(o + 16, v1);
        } else if (C == 6) {
            bf16* o = prl + (size_t)row * 256 + (p - 2816); st_bf4(o, v0); st_bf4(o + 16, v1);
        } else {
            const int c = p - 3072; float* o = gates + (size_t)row * 24 + c;
            if (c < 24) { f32x4 s = {sigmoidf_(v0[0]), sigmoidf_(v0[1]), sigmoidf_(v0[2]), sigmoidf_(v0[3])}; *(f32x4*)o = s; }
            if (c + 16 < 24) { f32x4 s = {sigmoidf_(v1[0]), sigmoidf_(v1[1]), sigmoidf_(v1[2]), sigmoidf_(v1[3])}; *(f32x4*)(o + 16) = s; }
        }
    }
};

namespace pg8 {
#define PG8_LAS __attribute__((address_space(3)))
typedef unsigned short bf16_t;
typedef short bf16x8 __attribute__((ext_vector_type(8)));
typedef float f32x4 __attribute__((ext_vector_type(4)));
typedef unsigned u32x4 __attribute__((ext_vector_type(4)));
constexpr int BM = 256, BK = 64, HALF = 128, HTB = HALF * BK * 2  , STAGE_BYTES = 8 * HTB, NXCD = 8, WGM = 8;

__host__ __device__ __forceinline__ int lds_byte(int r, int c) { const int st = (r >> 4) * 2 + (c >> 5), rr = r & 15, cc = c & 31, ob = rr * 64 + cc * 2; return st * 1024 + (ob ^ (((ob >> 9) & 1) << 5)); }
__host__ __device__ __forceinline__ void stage_rc(int b, int& R, int& C) { const int st = b / 1024, sb = b % 1024, swz = sb ^ (((sb >> 9) & 1) << 5); R = (st >> 1) * 16 + swz / 64; C = (st & 1) * 32 + (swz % 64) / 2; }
__host__ __device__ __forceinline__ int perm32(int rho) { const int n = rho >> 4, i = rho & 15; return 8 * (i >> 2) + 4 * n + (i & 3); }

struct Unit { int pm, pn; };
struct Gemm { const bf16_t* A; const bf16_t* Bt; int M, N, K, lda, ldb; };

struct StaticOrder {
    int nM, nN, nwg, G, c;
    __host__ __device__ void init(int M, int N, int G_, int c_) { nM = M / BM; nN = N / BM; nwg = nM * nN; G = G_; c = c_; }
    __host__ __device__ bool next(int i, Unit& u) const {
        const long L = (long)i * G + c; if (L >= nwg) return false;
        int wgid = (int)L; { const int q = nwg / NXCD, r = nwg % NXCD, xcd = wgid % NXCD, off = wgid / NXCD; wgid = (xcd < r ? xcd * (q + 1) : r * (q + 1) + (xcd - r) * q) + off; }
        const int nig = WGM * nN, gid = wgid / nig, fm = gid * WGM, gsz = (nM - fm) < WGM ? (nM - fm) : WGM;
        u.pm = fm + ((wgid % nig) % gsz); u.pn = (wgid % nig) / gsz; return true;
    }
    __device__ __forceinline__ void a_ready(const Unit&) const {}
    __device__ __forceinline__ void done(const Unit&) const {}
};

template <class Epi, class Sched, bool ALIGN_EPI = false, bool SP2 = false>
__device__ __forceinline__ void gemm_phase(PG8_LAS unsigned char* lds, const Gemm g, const Sched& S, const Epi& E) {
    const int tid = tidx(), wid = __builtin_amdgcn_readfirstlane(tid >> 6), lane = tid & 63, wr = wid >> 2, wc = wid & 3, fr = lane & 15, fq = lane >> 4;
    const int K = g.K, nt = K / BK;
    unsigned voffA[2], voffB[2];
#pragma unroll
    for (int i = 0; i < 2; ++i) { int R, C; stage_rc(tid * 16 + i * 8192, R, C); const int Rb = Epi::PERM ? ((R & ~31) + perm32(R & 31)) : R;
        voffA[i] = (unsigned)(R * g.lda + C) * 2u; voffB[i] = (unsigned)(Rb * g.ldb + C) * 2u; }
    const size_t kstep = (size_t)(BK * 2);
    const size_t hstepA = (size_t)HALF * g.lda * 2, hstepB = (size_t)HALF * g.ldb * 2;
    const size_t tstepA = 2 * hstepA, tstepB = 2 * hstepB;
    const unsigned ldsw = (unsigned)wid * 1024u;
    const int aoff = lds_byte(wr * 64 + fr, fq * 8), boff = lds_byte(wc * 32 + fr, fq * 8);
#define PG8_SA(b, h) (((b) * 2 + (h)) * HTB)
#define PG8_SB(b, h) ((4 + (b) * 2 + (h)) * HTB)
#define PG8_STAGE(bufoff, gbase, voff) do { _Pragma("unroll") for (int _i = 0; _i < 2; ++_i) \
        __builtin_amdgcn_global_load_lds((const unsigned*)((const char*)(gbase) + (voff)[_i]), (PG8_LAS unsigned*)(lds + (bufoff) + ldsw + _i * 8192), 16, 0, 0); } while (0)
#define PG8_LDA(dst, b, h) do { _Pragma("unroll") for (int m = 0; m < 4; ++m) _Pragma("unroll") for (int k = 0; k < 2; ++k) dst[m][k] = *(const PG8_LAS bf16x8*)(lds + PG8_SA(b, h) + aoff + m * 2048 + k * 1024); } while (0)
#define PG8_LDB(dst, b, h) do { _Pragma("unroll") for (int n = 0; n < 2; ++n) _Pragma("unroll") for (int k = 0; k < 2; ++k) dst[n][k] = *(const PG8_LAS bf16x8*)(lds + PG8_SB(b, h) + boff + n * 2048 + k * 1024); } while (0)
#define PG8_MMA(ai, bj, At, Bt) do { __builtin_amdgcn_s_setprio(1); _Pragma("unroll") for (int m = 0; m < 4; ++m) _Pragma("unroll") for (int n = 0; n < 2; ++n) _Pragma("unroll") for (int k = 0; k < 2; ++k) \
        acc[ai][bj][m][n] = __builtin_amdgcn_mfma_f32_16x16x32_bf16(Bt[n][k], At[m][k], acc[ai][bj][m][n], 0, 0, 0); __builtin_amdgcn_s_setprio(0); } while (0)
#define PG8_WAIT_V(n) asm volatile("s_waitcnt vmcnt(" #n ")" ::: "memory")
#define PG8_WAIT_L(n) asm volatile("s_waitcnt lgkmcnt(" #n ")" ::: "memory")
#define PG8_BAR __builtin_amdgcn_s_barrier()
#define PG8_SCHED __builtin_amdgcn_sched_barrier(0)
    Unit cur, nxt; int ui = 0;
    if (!S.next(0, cur)) return;
    f32x4 acc[2][2][4][2];
#pragma unroll
    for (int a = 0; a < 2; ++a)
#pragma unroll
        for (int b = 0; b < 2; ++b)
#pragma unroll
            for (int m = 0; m < 4; ++m)
#pragma unroll
                for (int n = 0; n < 2; ++n) acc[a][b][m][n] = (f32x4){0.f, 0.f, 0.f, 0.f};
    bf16x8 At[4][2], B0[2][2], B1[2][2];
    const char* cA = (const char*)g.A + (size_t)cur.pm * tstepA; const char* cB = (const char*)g.Bt + (size_t)cur.pn * tstepB;
    S.a_ready(cur);
    if constexpr (SP2) {
        PG8_STAGE(PG8_SB(0, 0), cB, voffB); PG8_STAGE(PG8_SB(0, 1), cB + hstepB, voffB); PG8_STAGE(PG8_SA(0, 0), cA, voffA); PG8_STAGE(PG8_SA(0, 1), cA + hstepA, voffA);
        if (wr == 1) PG8_BAR;
        PG8_WAIT_V(2); PG8_BAR;
        PG8_STAGE(PG8_SB(1, 0), cB + kstep, voffB); PG8_STAGE(PG8_SA(1, 0), cA + kstep, voffA); PG8_STAGE(PG8_SB(1, 1), cB + hstepB + kstep, voffB);
        PG8_WAIT_V(6); PG8_BAR;
    } else {
        PG8_STAGE(PG8_SB(0, 0), cB, voffB); PG8_STAGE(PG8_SA(0, 0), cA, voffA); PG8_STAGE(PG8_SB(0, 1), cB + hstepB, voffB); PG8_STAGE(PG8_SA(0, 1), cA + hstepA, voffA);
        if (wr == 1) PG8_BAR;
        PG8_WAIT_V(4); PG8_BAR;
        PG8_STAGE(PG8_SB(1, 0), cB + kstep, voffB); PG8_STAGE(PG8_SA(1, 0), cA + kstep, voffA); PG8_STAGE(PG8_SB(1, 1), cB + hstepB + kstep, voffB);
        PG8_WAIT_V(6); PG8_BAR;
    }
    for (;;) {
        const bool has_next = S.next(ui + 1, nxt);
        const char* nA = has_next ? (const char*)g.A + (size_t)nxt.pm * tstepA : cA; const char* nB = has_next ? (const char*)g.Bt + (size_t)nxt.pn * tstepB : cB;
        for (int t = 0; t < nt; t += 2) {
            const bool last = (t == nt - 2);
            const char* a1 = cA + (size_t)(t + 1) * kstep;
            const char* a2 = last ? nA : cA + (size_t)(t + 2) * kstep; const char* b2 = last ? nB : cB + (size_t)(t + 2) * kstep;
            const char* a3 = a2 + kstep; const char* b3 = b2 + kstep;
            if (last && has_next) S.a_ready(nxt);
            if constexpr (SP2) {
            PG8_LDB(B0, 0, 0); PG8_LDB(B1, 0, 1); PG8_SCHED; PG8_LDA(At, 0, 0); PG8_STAGE(PG8_SA(1, 1), a1 + hstepA, voffA);
            PG8_WAIT_V(8); PG8_WAIT_L(0); PG8_BAR; PG8_MMA(0, 0, At, B0); PG8_MMA(0, 1, At, B1); PG8_BAR; PG8_SCHED;
            PG8_LDA(At, 0, 1); PG8_STAGE(PG8_SB(0, 0), b2, voffB); PG8_STAGE(PG8_SB(0, 1), b2 + hstepB, voffB); PG8_STAGE(PG8_SA(0, 0), a2, voffA);
            PG8_WAIT_V(8); PG8_WAIT_L(0); PG8_BAR; PG8_MMA(1, 0, At, B0); PG8_MMA(1, 1, At, B1); PG8_BAR; PG8_SCHED;
            PG8_LDB(B0, 1, 0); PG8_LDB(B1, 1, 1); PG8_SCHED; PG8_LDA(At, 1, 0); PG8_STAGE(PG8_SA(0, 1), a2 + hstepA, voffA);
            PG8_WAIT_V(8); PG8_WAIT_L(0); PG8_BAR; PG8_MMA(0, 0, At, B0); PG8_MMA(0, 1, At, B1); PG8_BAR; PG8_SCHED;
            PG8_LDA(At, 1, 1); PG8_STAGE(PG8_SB(1, 0), b3, voffB); PG8_STAGE(PG8_SB(1, 1), b3 + hstepB, voffB); PG8_STAGE(PG8_SA(1, 0), a3, voffA);
            PG8_WAIT_V(8); PG8_WAIT_L(0); PG8_BAR; PG8_MMA(1, 0, At, B0); PG8_MMA(1, 1, At, B1); PG8_BAR; PG8_SCHED;
            } else {
            PG8_LDB(B0, 0, 0); PG8_SCHED; PG8_LDA(At, 0, 0); PG8_STAGE(PG8_SA(1, 1), a1 + hstepA, voffA);
            PG8_WAIT_L(8); PG8_BAR; PG8_WAIT_L(0); PG8_MMA(0, 0, At, B0); PG8_BAR; PG8_SCHED;
            PG8_LDB(B1, 0, 1); PG8_STAGE(PG8_SB(0, 0), b2, voffB);
            PG8_BAR; PG8_WAIT_L(0); PG8_MMA(0, 1, At, B1); PG8_BAR;
            PG8_LDA(At, 0, 1); PG8_STAGE(PG8_SA(0, 0), a2, voffA);
            PG8_BAR; PG8_WAIT_L(0); PG8_MMA(1, 0, At, B0); PG8_BAR; PG8_SCHED;
            PG8_STAGE(PG8_SB(0, 1), b2 + hstepB, voffB);
            PG8_WAIT_V(6); PG8_BAR; PG8_MMA(1, 1, At, B1); PG8_BAR;
            PG8_LDB(B0, 1, 0); PG8_SCHED; PG8_LDA(At, 1, 0); PG8_STAGE(PG8_SA(0, 1), a2 + hstepA, voffA);
            PG8_WAIT_L(8); PG8_BAR; PG8_WAIT_L(0); PG8_MMA(0, 0, At, B0); PG8_BAR; PG8_SCHED;
            PG8_LDB(B1, 1, 1); PG8_STAGE(PG8_SB(1, 0), b3, voffB);
            PG8_BAR; PG8_WAIT_L(0); PG8_MMA(0, 1, At, B1); PG8_BAR;
            PG8_LDA(At, 1, 1); PG8_STAGE(PG8_SA(1, 0), a3, voffA);
            PG8_BAR; PG8_WAIT_L(0); PG8_MMA(1, 0, At, B0); PG8_BAR; PG8_SCHED;
            PG8_STAGE(PG8_SB(1, 1), b3 + hstepB, voffB);
            PG8_WAIT_V(6); PG8_BAR; PG8_MMA(1, 1, At, B1); PG8_BAR;
            }
        }
        if constexpr (ALIGN_EPI) { if (wr == 0) PG8_BAR; }
        if constexpr (!Epi::AFTER_DRAIN) { E(acc, cur, wr, wc, fr, fq); S.done(cur); }
        if (!has_next) break;
#pragma unroll
        for (int a = 0; a < 2; ++a)
#pragma unroll
            for (int b = 0; b < 2; ++b)
#pragma unroll
                for (int m = 0; m < 4; ++m)
#pragma unroll
                    for (int n = 0; n < 2; ++n) acc[a][b][m][n] = (f32x4){0.f, 0.f, 0.f, 0.f};
        cur = nxt; cA = nA; cB = nB; ++ui;
        if constexpr (ALIGN_EPI) { if (wr == 1) PG8_BAR; }
    }
    PG8_WAIT_V(0);
    if constexpr (!ALIGN_EPI) { if (wr == 0) PG8_BAR; }
    PG8_BAR;
    if constexpr (Epi::AFTER_DRAIN) { E.fused(acc, cur, wr, wc, fr, fq, lds, wid, lane); S.done(cur); }
#undef PG8_SA
#undef PG8_SB
#undef PG8_STAGE
#undef PG8_LDA
#undef PG8_LDB
#undef PG8_MMA
#undef PG8_WAIT_V
#undef PG8_WAIT_L
#undef PG8_BAR
#undef PG8_SCHED
}
}

template <class F> struct EpiQuad {
    static constexpr bool PERM = false, AFTER_DRAIN = false;
    F f;
    template <int C, int BJ> __device__ __forceinline__ void half(const pg8::f32x4 (&acc)[2][2][4][2], int row0, int p) const {
#pragma unroll
        for (int ai = 0; ai < 2; ++ai)
#pragma unroll
            for (int m = 0; m < 4; ++m) { f.template apply<C>(row0 + ai * 128 + m * 16, p, acc[ai][BJ][m][0], acc[ai][BJ][m][1]); asm volatile("" ::: "memory"); }
    }
    template <int BJ> __device__ __forceinline__ void disp(const pg8::f32x4 (&acc)[2][2][4][2], int row0, int p0, int p) const {
        const int c = f.cat(p0);
        if (F::NCAT == 1 || c == 0) half<0, BJ>(acc, row0, p);
        else if (F::NCAT > 1 && c == 1) half<(F::NCAT > 1 ? 1 : 0), BJ>(acc, row0, p);
        else if (F::NCAT > 2 && c == 2) half<(F::NCAT > 2 ? 2 : 0), BJ>(acc, row0, p);
        else if (F::NCAT > 3 && c == 3) half<(F::NCAT > 3 ? 3 : 0), BJ>(acc, row0, p);
        else if (F::NCAT > 4 && c == 4) half<(F::NCAT > 4 ? 4 : 0), BJ>(acc, row0, p);
        else if (F::NCAT > 5 && c == 5) half<(F::NCAT > 5 ? 5 : 0), BJ>(acc, row0, p);
        else if (F::NCAT > 6 && c == 6) half<(F::NCAT > 6 ? 6 : 0), BJ>(acc, row0, p);
        else if (F::NCAT > 7) half<(F::NCAT > 7 ? 7 : 0), BJ>(acc, row0, p);
    }
    __device__ __forceinline__ void operator()(const pg8::f32x4 (&acc)[2][2][4][2], const pg8::Unit& u, int wr, int wc, int fr, int fq) const {
        const int row0 = u.pm * 256 + wr * 64 + fr, p0 = u.pn * 256;
        disp<0>(acc, row0, p0, p0 + wc * 32 + 4 * fq);
        disp<1>(acc, row0, p0 + 128, p0 + 128 + wc * 32 + 4 * fq);
    }
};
template <class F> __device__ __forceinline__ void gemm_pg8(unsigned char* lds, const bf16* A, int lda, const bf16* Bt, int ldb, int M, int N, int K, const F& f) {
    pg8::Gemm g{A, Bt, M, N, K, lda, ldb}; pg8::StaticOrder S; S.init(M, N, (int)gridDim.x, (int)blockIdx.x);
    EpiQuad<F> E{f};
    pg8::gemm_phase<EpiQuad<F>, pg8::StaticOrder, true, true>((PG8_LAS unsigned char*)lds, g, S, E);
}

namespace cg = cooperative_groups;
struct EpiNormRes {
    static constexpr bool PERM = false, AFTER_DRAIN = true;
    const float* xin; float* xout; bf16* xn; const float* gpost; const float* gpre; float coef; unsigned* part; unsigned* cnt;
    __device__ __forceinline__ void operator()(const pg8::f32x4 (&)[2][2][4][2], const pg8::Unit&, int, int, int, int) const {}
    __device__ __forceinline__ void rowstat(const pg8::f32x4 (&acc)[2][2][4][2], float* P, int wr, int wc, int fr, int fq) const {
#pragma unroll
        for (int ai = 0; ai < 2; ++ai)
#pragma unroll
            for (int m = 0; m < 4; ++m) { float sq = 0.f;
#pragma unroll
                for (int bj = 0; bj < 2; ++bj)
#pragma unroll
                    for (int n = 0; n < 2; ++n) { const pg8::f32x4 v = acc[ai][bj][m][n]; sq += (v[0] * v[0] + v[1] * v[1]) + (v[2] * v[2] + v[3] * v[3]); }
                sq += __shfl_xor(sq, 16); sq += __shfl_xor(sq, 32);
                if (fq == 0) P[(ai * 128 + wr * 64 + m * 16 + fr) * 4 + wc] = sq; }
    }
    __device__ __forceinline__ void exchange(float* P, float* S, unsigned* bank, unsigned* cnt, const pg8::Unit& u, int tid, float scale) const {
        __syncthreads();
        if (tid < 256) { const f32x4 p = *(const f32x4*)(P + tid * 4);
            __hip_atomic_store(bank + (size_t)(u.pm * 256 + tid) * 4 + u.pn, __builtin_bit_cast(unsigned, (p[0] + p[1]) + (p[2] + p[3])), __ATOMIC_RELAXED, __HIP_MEMORY_SCOPE_AGENT); }
        asm volatile("s_waitcnt vmcnt(0)" ::: "memory");
        __syncthreads();
        if (tid == 0) { unsigned* c = cnt + u.pm * 16; __hip_atomic_fetch_add(c, 1u, __ATOMIC_RELAXED, __HIP_MEMORY_SCOPE_AGENT);
            while (__hip_atomic_load(c, __ATOMIC_RELAXED, __HIP_MEMORY_SCOPE_AGENT) < 4u) __builtin_amdgcn_s_sleep(1); }
        __syncthreads();
        if (tid < 256) { const unsigned* b = bank + (size_t)(u.pm * 256 + tid) * 4; float q = 0.f;
#pragma unroll
            for (int j = 0; j < 4; ++j) q += __builtin_bit_cast(float, __hip_atomic_load(b + j, __ATOMIC_RELAXED, __HIP_MEMORY_SCOPE_AGENT));
            S[tid] = rsqrtf(q * (1.f / DM) + NORM_EPS) * scale; }
        __syncthreads();
    }
    __device__ __forceinline__ void fused(pg8::f32x4 (&acc)[2][2][4][2], const pg8::Unit& u, int wr, int wc, int fr, int fq, PG8_LAS unsigned char* lds, int wid, int lane) const {
        float* P = (float*)lds; float* S = P + 1024; const int tid = wid * 64 + lane;
        rowstat(acc, P, wr, wc, fr, fq);
        exchange(P, S, part, cnt, u, tid, coef);
        const int col0 = u.pn * 256 + wc * 32 + 4 * fq;
#pragma unroll
        for (int ai = 0; ai < 2; ++ai)
#pragma unroll
            for (int m = 0; m < 4; ++m) { const int r = ai * 128 + wr * 64 + m * 16 + fr; const float sr = S[r]; const size_t off = (size_t)(u.pm * 256 + r) * DM + col0;
#pragma unroll
                for (int bj = 0; bj < 2; ++bj)
#pragma unroll
                    for (int n = 0; n < 2; ++n) { const int o = bj * 128 + n * 16; const f32x4 g4 = *(const f32x4*)(gpost + col0 + o), x4 = *(const f32x4*)(xin + off + o);
                        const f32x4 y = x4 + acc[ai][bj][m][n] * sr * g4; acc[ai][bj][m][n] = y; *(f32x4*)(xout + off + o) = y; }
                asm volatile("" ::: "memory"); }
        if (!gpre) return;
        rowstat(acc, P, wr, wc, fr, fq);
        exchange(P, S, part + (size_t)M_ * 4, cnt + 64 * 16, u, tid, 1.f);
#pragma unroll
        for (int ai = 0; ai < 2; ++ai)
#pragma unroll
            for (int m = 0; m < 4; ++m) { const int r = ai * 128 + wr * 64 + m * 16 + fr; const float sr = S[r]; const size_t off = (size_t)(u.pm * 256 + r) * DM + col0;
#pragma unroll
                for (int bj = 0; bj < 2; ++bj)
#pragma unroll
                    for (int n = 0; n < 2; ++n) { const int o = bj * 128 + n * 16; const f32x4 g4 = *(const f32x4*)(gpre + col0 + o); st_bf4(xn + off + o, acc[ai][bj][m][n] * sr * g4); }
                asm volatile("" ::: "memory"); }
    }
};
__device__ __forceinline__ void gemm_norm_res(unsigned char* lds, const bf16* A, int lda, const bf16* Bt, int K, const float* xin, float* xout, bf16* xn, const float* gpost, const float* gpre,
                                              float coef, bf16* ybuf, unsigned* part, unsigned* cnt) {
    pg8::Gemm g{A, Bt, M_, DM, K, lda, K}; pg8::StaticOrder S; S.init(M_, DM, 256, (int)blockIdx.x);
    const EpiNormRes E{xin, xout, xn, gpost, gpre, coef, part, cnt};
    pg8::gemm_phase<EpiNormRes, pg8::StaticOrder, false, true>((PG8_LAS unsigned char*)lds, g, S, E);
}

__device__ __forceinline__ void d_cmp2(const bf16* hidk, const bf16* hidv, const float* w2k, const float* w2v, const float* rope, bf16* kc, bf16* vct) {
    const int T512 = tidx(), tid = T512 & 255;
    FOR_VB(vb, 2048 * 32 / 256) {
        const int idx = vb * 256 + tid; const int R = idx >> 5, i = idx & 31; const int bg = R >> 9, c = R & 511;
        float k0 = 0.f, k1 = 0.f, v0 = 0.f, v1 = 0.f;
        for (int n = 0; n < 256; ++n) { const float hk = bf2f(hidk[(size_t)R * 256 + n]), hv = bf2f(hidv[(size_t)R * 256 + n]);
            k0 += hk * w2k[n * 64 + i]; k1 += hk * w2k[n * 64 + i + 32]; v0 += hv * w2v[n * 64 + i]; v1 += hv * w2v[n * 64 + i + 32]; }
        const int pos = (16 * c + 31) & (T_ - 1);
        const float cs = rope[((size_t)pos * 32 + i) * 2], sn = rope[((size_t)pos * 32 + i) * 2 + 1];
        kc[(size_t)R * 64 + i] = (bf16)f2bf(k0 * cs - k1 * sn); kc[(size_t)R * 64 + i + 32] = (bf16)f2bf(k0 * sn + k1 * cs);
        vct[((size_t)bg * 64 + i) * NCP + c] = (bf16)f2bf(v0); vct[((size_t)bg * 64 + i + 32) * NCP + c] = (bf16)f2bf(v1);
    }
}

struct NsaArgs { const bf16 *qb, *kc, *vct, *ks, *vst, *kw, *vwt; const float* gates; bf16* amix; };
__device__ __forceinline__ float dot64(const float* q, const bf16* k) {
    float s = 0.f;
#pragma unroll
    for (int i = 0; i < 8; ++i) { const u32x4 w = ((const u32x4*)k)[i];
        s += q[8 * i + 0] * __builtin_bit_cast(float, w.x << 16) + q[8 * i + 1] * __builtin_bit_cast(float, w.x & 0xffff0000u)
           + q[8 * i + 2] * __builtin_bit_cast(float, w.y << 16) + q[8 * i + 3] * __builtin_bit_cast(float, w.y & 0xffff0000u)
           + q[8 * i + 4] * __builtin_bit_cast(float, w.z << 16) + q[8 * i + 5] * __builtin_bit_cast(float, w.z & 0xffff0000u)
           + q[8 * i + 6] * __builtin_bit_cast(float, w.w << 16) + q[8 * i + 7] * __builtin_bit_cast(float, w.w & 0xffff0000u); }
    return s;
}
__device__ __forceinline__ void softmax_row(float* s, int n, int lane) {
    float m = -INFINITY; for (int i = lane; i < n; i += 64) m = fmaxf(m, s[i]);
    m = wave_max(m); if (m == -INFINITY) m = 0.f;
    float l = 0.f; for (int i = lane; i < n; i += 64) { const float e = exp2f(s[i] - m); s[i] = e; l += e; }
    l = wave_sum(l); const float inv = 1.f / fmaxf(l, 1e-30f);
    for (int i = lane; i < n; i += 64) s[i] *= inv;
}
__device__ __forceinline__ void d_nsa_simple(const NsaArgs& a, int vb, int tid, unsigned char* smem) {
    float (*qs)[64] = (float (*)[64])smem; float (*sc)[1024] = (float (*)[1024])(smem + 1024); float* imp = (float*)(smem + 17408); float* score = imp + 128;
    int* list = (int*)(score + 128); int* nlist = list + 16;
    const int bg = vb / T_, t = vb % T_, b = bg >> 1, g = bg & 1;
    const int r = tid >> 6, d = tid & 63, lane = d;
    const size_t row = (size_t)b * T_ + t;
    qs[r][d] = bf2f(a.qb[row * 512 + g * 256 + r * 64 + d]);
    if (tid == 0) *nlist = 0;
    __syncthreads();
    const int nv = t < 31 ? 0 : (t - 31) / 16 + 1;
    for (int c = tid; c < nv; c += 256) { const bf16* k = a.kc + ((size_t)bg * NCP + c) * 64;
        _Pragma("unroll 1") for (int rr = 0; rr < 4; ++rr) sc[rr][c] = dot64(qs[rr], k); }
    __syncthreads();
    softmax_row(sc[r], nv, lane);
    __syncthreads();
    float oc = 0.f; { const bf16* v = a.vct + ((size_t)bg * 64 + d) * NCP; for (int c = 0; c < nv; ++c) oc += sc[r][c] * bf2f(v[c]); }
    if (tid < 128) { const int s = tid; float acc = 0.f;
        for (int c = 4 * s - 1; c <= 4 * s + 3; ++c) if (c >= 0 && c < nv) acc += sc[0][c] + sc[1][c] + sc[2][c] + sc[3][c];
        imp[s] = acc; }
    __syncthreads();
    const int cur = t >> 6;
    if (tid < 128) { const int s = tid; const bool forced = (s == 0) || (s == cur) || (s == cur - 1);
        score[s] = forced ? 1e4f : (s <= cur ? imp[s] : -1e4f); }
    __syncthreads();
    if (tid < 128) { const int s = tid; const float my = score[s]; int rank = 0;
        for (int j = 0; j < 128; ++j) { const float o = score[j]; rank += (o > my || (o == my && j < s)) ? 1 : 0; }
        if (rank < 16 && s <= cur) { const int slot = atomicAdd(nlist, 1); list[slot] = s; } }
    __syncthreads();
    const int ns = *nlist * 64;
    for (int i = tid; i < ns; i += 256) { const int pos = list[i >> 6] * 64 + (i & 63);
        if (pos <= t) { const bf16* k = a.ks + ((size_t)bg * T_ + pos) * 64; _Pragma("unroll 1") for (int rr = 0; rr < 4; ++rr) sc[rr][i] = dot64(qs[rr], k); }
        else { sc[0][i] = -INFINITY; sc[1][i] = -INFINITY; sc[2][i] = -INFINITY; sc[3][i] = -INFINITY; } }
    __syncthreads();
    softmax_row(sc[r], ns, lane);
    __syncthreads();
    float os = 0.f; { const bf16* v = a.vst + ((size_t)bg * 64 + d) * T_;
        for (int i = 0; i < ns; ++i) { const int pos = list[i >> 6] * 64 + (i & 63); if (pos <= t) os += sc[r][i] * bf2f(v[pos]); } }
    __syncthreads();
    const int lo = t - 511 > 0 ? t - 511 : 0, nw = t - lo + 1;
    for (int i = tid; i < nw; i += 256) { const bf16* k = a.kw + ((size_t)bg * T_ + lo + i) * 64;
        _Pragma("unroll 1") for (int rr = 0; rr < 4; ++rr) sc[rr][i] = dot64(qs[rr], k); }
    __syncthreads();
    softmax_row(sc[r], nw, lane);
    __syncthreads();
    float ow = 0.f; { const bf16* v = a.vwt + ((size_t)bg * 64 + d) * T_ + lo; for (int i = 0; i < nw; ++i) ow += sc[r][i] * bf2f(v[i]); }
    const float* gt = a.gates + row * 24 + g * 12 + r * 3;
    a.amix[row * DM + g * 256 + r * 64 + d] = (bf16)f2bf(gt[0] * oc + gt[1] * os + gt[2] * ow);
    __syncthreads();
}


namespace nsa {
typedef float f32x16 __attribute__((ext_vector_type(16)));
constexpr int KROW = 144, VROW = 136, KBUF = 64 * KROW, VBUF = 64 * VROW;
constexpr int OFF_K = 0, OFF_V = 2 * KBUF, OFF_IMP = OFF_V + 2 * VBUF, IMPW = 130, OFF_SEL = OFF_IMP + 64 * IMPW * 4, OFF_UM = OFF_SEL + 1024, OFF_WS = OFF_UM + 16, OFF_UNIT = OFF_WS + 1024, LDS_NEED = OFF_UNIT + 16;
static_assert(OFF_IMP % 16 == 0 && OFF_SEL % 16 == 0 && OFF_WS % 16 == 0, "nsa lds map");
__device__ __forceinline__ int crow(int r, int hi) { return (r & 3) + 8 * (r >> 2) + 4 * hi; }
__device__ __forceinline__ int next_bit(unsigned m0, unsigned m1, unsigned m2, unsigned m3, int from) {
#pragma unroll
    for (int wd = 0; wd < 4; ++wd) {
        unsigned x = wd == 0 ? m0 : (wd == 1 ? m1 : (wd == 2 ? m2 : m3)); const int base = wd * 32;
        if (from < base + 32) { if (from > base) x &= (~0u) << (from - base); if (x) return base + __builtin_ctz(x); }
    }
    return 128;
}
__device__ __forceinline__ bf16x8 pack8(const f32x16& p, int b0) {
    u32x4 w; w.x = pk2(p[b0 + 0], p[b0 + 1]); w.y = pk2(p[b0 + 2], p[b0 + 3]); w.z = pk2(p[b0 + 4], p[b0 + 5]); w.w = pk2(p[b0 + 6], p[b0 + 7]);
    return __builtin_bit_cast(bf16x8, w);
}
struct Branch { const bf16* k; const bf16* vt; int ldv; };

template <int MODE, bool SEL>
__device__ __forceinline__ void run_branch(unsigned char* sm, const Branch br, unsigned m0, unsigned m1, unsigned m2, unsigned m3,
                                           const bf16x8 (&qf)[4], int lo, int hi_b, int lo_max, int hi_min, unsigned s0, unsigned s1, unsigned s2, unsigned s3,
                                           float& m, float& l, float invl, f32x16 (&o)[2], float* imp_row, float* wsc, int tid, int lane) {
    const int i = lane & 31, hi = lane >> 5;
    int j = next_bit(m0, m1, m2, m3, 0);
    u32x4 kr, vr;
    if (j < 128) {
        kr = *(const u32x4*)(br.k + (size_t)j * 4096 + tid * 8);
        if (MODE != 0) vr = *(const u32x4*)(br.vt + (size_t)(tid >> 3) * br.ldv + j * 64 + (tid & 7) * 8);
        *(u32x4*)(sm + OFF_K + (tid >> 3) * KROW + (tid & 7) * 16) = kr;
        if (MODE != 0) { unsigned char* vp = sm + OFF_V + (tid >> 3) * VROW + (tid & 7) * 16; *(u32x2*)vp = (u32x2){vr.x, vr.y}; *(u32x2*)(vp + 8) = (u32x2){vr.z, vr.w}; }
    }
    __syncthreads();
    int cb = 0;
    while (j < 128) {
        const int jn = next_bit(m0, m1, m2, m3, j + 1);
        if (jn < 128) {
            kr = *(const u32x4*)(br.k + (size_t)jn * 4096 + tid * 8);
            if (MODE != 0) vr = *(const u32x4*)(br.vt + (size_t)(tid >> 3) * br.ldv + jn * 64 + (tid & 7) * 8);
        }
        const unsigned char* kb = sm + OFF_K + cb * KBUF; const unsigned char* vb = sm + OFF_V + cb * VBUF;
        const int key0 = 64 * j;
        bool rowsel = true;
        if (SEL) { const unsigned wsel = j < 32 ? s0 : (j < 64 ? s1 : (j < 96 ? s2 : s3)); rowsel = (wsel >> (j & 31)) & 1u; }
        if (!SEL || __any(rowsel)) {
            const float cinit = rowsel ? 0.f : -INFINITY;
            f32x16 p0, p1;
#pragma unroll
            for (int r = 0; r < 16; ++r) { p0[r] = cinit; p1[r] = cinit; }
#pragma unroll
            for (int d0 = 0; d0 < 4; ++d0) {
                const bf16x8 a0 = *(const bf16x8*)(kb + i * KROW + (16 * d0 + 8 * hi) * 2);
                const bf16x8 a1 = *(const bf16x8*)(kb + (32 + i) * KROW + (16 * d0 + 8 * hi) * 2);
                p0 = __builtin_amdgcn_mfma_f32_32x32x16_bf16(a0, qf[d0], p0, 0, 0, 0);
                p1 = __builtin_amdgcn_mfma_f32_32x32x16_bf16(a1, qf[d0], p1, 0, 0, 0);
            }
            if (!(key0 >= lo_max && key0 + 63 <= hi_min)) {
#pragma unroll
                for (int r = 0; r < 16; ++r) { const int key = key0 + crow(r, hi);
                    if (key < lo || key > hi_b) p0[r] = -INFINITY;
                    if (key + 32 < lo || key + 32 > hi_b) p1[r] = -INFINITY; }
            }
            if (MODE == 1) {
#pragma unroll
                for (int r = 0; r < 16; ++r) { p0[r] = __builtin_amdgcn_exp2f(p0[r] - m) * invl; p1[r] = __builtin_amdgcn_exp2f(p1[r] - m) * invl; }
#pragma unroll
                for (int gq = 0; gq < 4; ++gq) {
                    float G0 = (p0[4 * gq] + p0[4 * gq + 1]) + (p0[4 * gq + 2] + p0[4 * gq + 3]), L0 = p0[4 * gq + 3];
                    float G1 = (p1[4 * gq] + p1[4 * gq + 1]) + (p1[4 * gq + 2] + p1[4 * gq + 3]), L1 = p1[4 * gq + 3];
                    G0 += __shfl_xor(G0, 1); L0 += __shfl_xor(L0, 1); G1 += __shfl_xor(G1, 1); L1 += __shfl_xor(L1, 1);
                    G0 += __shfl_xor(G0, 2); L0 += __shfl_xor(L0, 2); G1 += __shfl_xor(G1, 2); L1 += __shfl_xor(L1, 2);
                    if ((i & 3) == 0) { const int s = 16 * j + 2 * gq + hi;
                        atomicAdd(imp_row + s, G0); atomicAdd(imp_row + s + 1, L0); atomicAdd(imp_row + s + 8, G1); atomicAdd(imp_row + s + 9, L1); }
                }
            } else {
                float tm = fmaxf(p0[0], p1[0]);
#pragma unroll
                for (int r = 1; r < 16; ++r) tm = fmaxf(tm, fmaxf(p0[r], p1[r]));
                tm = fmaxf(tm, __shfl_xor(tm, 32));
                const float mn = fmaxf(m, tm), alpha = __builtin_amdgcn_exp2f(m - mn);
                m = mn; float rs = 0.f;
#pragma unroll
                for (int r = 0; r < 16; ++r) { p0[r] = __builtin_amdgcn_exp2f(p0[r] - mn); p1[r] = __builtin_amdgcn_exp2f(p1[r] - mn); rs += p0[r] + p1[r]; }
                l = l * alpha + rs;
                if (MODE == 2) {
                    if (hi == 0) wsc[i] = alpha;
                    asm volatile("" ::: "memory");
#pragma unroll
                    for (int rg = 0; rg < 4; ++rg) { const f32x4 a4 = *(const f32x4*)(wsc + 8 * rg + 4 * hi);
#pragma unroll
                        for (int e = 0; e < 4; ++e) { o[0][4 * rg + e] *= a4[e]; o[1][4 * rg + e] *= a4[e]; } }
                    asm volatile("" ::: "memory");
                }
            }
            if (MODE != 0) {
                const bf16x8 pf0 = pack8(p0, 0), pf1 = pack8(p0, 8), pf2 = pack8(p1, 0), pf3 = pack8(p1, 8);
#pragma unroll
                for (int dt = 0; dt < 2; ++dt) {
                    const unsigned char* vp = vb + (32 * dt + i) * VROW + 8 * hi;
#pragma unroll
                    for (int ks = 0; ks < 4; ++ks) {
                        const u32x2 v_lo = *(const u32x2*)(vp + 32 * ks), v_hi = *(const u32x2*)(vp + 32 * ks + 16);
                        const bf16x8 vf = __builtin_bit_cast(bf16x8, (u32x4){v_lo.x, v_lo.y, v_hi.x, v_hi.y});
                        o[dt] = __builtin_amdgcn_mfma_f32_32x32x16_bf16(ks == 0 ? pf0 : (ks == 1 ? pf1 : (ks == 2 ? pf2 : pf3)), vf, o[dt], 0, 0, 0);
                    }
                }
            }
        }
        if (jn < 128) {
            *(u32x4*)(sm + OFF_K + (cb ^ 1) * KBUF + (tid >> 3) * KROW + (tid & 7) * 16) = kr;
            if (MODE != 0) { unsigned char* vp = sm + OFF_V + (cb ^ 1) * VBUF + (tid >> 3) * VROW + (tid & 7) * 16; *(u32x2*)vp = (u32x2){vr.x, vr.y}; *(u32x2*)(vp + 8) = (u32x2){vr.z, vr.w}; }
        }
        __syncthreads();
        j = jn; cb ^= 1;
    }
}
__device__ __forceinline__ void add_scaled(f32x16 (&acc)[2], const f32x16 (&o)[2], float f, float* wsc, int i, int hi) {
    if (hi == 0) wsc[i] = f;
    asm volatile("" ::: "memory");
#pragma unroll
    for (int rg = 0; rg < 4; ++rg) { const f32x4 a4 = *(const f32x4*)(wsc + 8 * rg + 4 * hi);
#pragma unroll
        for (int e = 0; e < 4; ++e) { acc[0][4 * rg + e] += a4[e] * o[0][4 * rg + e]; acc[1][4 * rg + e] += a4[e] * o[1][4 * rg + e]; } }
    asm volatile("" ::: "memory");
}
__device__ __forceinline__ void unit(const NsaArgs& a, int u, unsigned char* sm) {
    const int tid = tidx(), lane = tid & 63, w = __builtin_amdgcn_readfirstlane(tid >> 6), i = lane & 31, hi = lane >> 5;
    const int cur = 127 - (u >> 2), bg = u & 3, b = bg >> 1, g = bg & 1, q0 = cur * 64;
    const int ql = 8 * w + (i >> 2), hd = i & 3, t = q0 + ql;
    const size_t grow = (size_t)b * T_ + t;
    bf16x8 qf[4];
    { const bf16* qp = a.qb + grow * 512 + g * 256 + hd * 64 + 8 * hi;
#pragma unroll
      for (int d0 = 0; d0 < 4; ++d0) qf[d0] = *(const bf16x8*)(qp + 16 * d0); }
    float* wsc = (float*)(sm + OFF_WS) + w * 32;
    float* imp = (float*)(sm + OFF_IMP);
    unsigned* selw = (unsigned*)(sm + OFF_SEL);
    unsigned* um = (unsigned*)(sm + OFF_UM);
    for (int k = tid; k < 64 * IMPW; k += 512) imp[k] = 0.f;
    if (tid < 4) um[tid] = 0u;
    const float* gt = a.gates + grow * 24 + g * 12 + hd * 3;
    const float gc = gt[0], gs = gt[1], gw = gt[2];
    f32x16 acc[2], o[2];
#pragma unroll
    for (int r = 0; r < 16; ++r) { acc[0][r] = 0.f; acc[1][r] = 0.f; }
    const int tw0 = q0 + 8 * w, tw1 = tw0 + 7;
    {
        const int nv = t < 31 ? 0 : (t - 31) / 16 + 1;
        const int nvw = tw0 < 31 ? 0 : (tw0 - 31) / 16 + 1;
        const int nvmax = (q0 + 63 - 31) / 16 + 1, ntc = (nvmax + 63) / 64;
        const unsigned cm0 = ntc >= 32 ? ~0u : ((1u << ntc) - 1u);
        const Branch br{a.kc + (size_t)bg * NCP * 64, a.vct + (size_t)bg * 64 * NCP, NCP};
        float m = -1e30f, l = 0.f;
        run_branch<0, false>(sm, br, cm0, 0u, 0u, 0u, qf, 0, nv - 1, 0, nvw - 1, 0u, 0u, 0u, 0u, m, l, 0.f, o, nullptr, wsc, tid, lane);
        l += __shfl_xor(l, 32);
        const float invl = 1.f / fmaxf(l, 1e-30f);
#pragma unroll
        for (int r = 0; r < 16; ++r) { o[0][r] = 0.f; o[1][r] = 0.f; }
        run_branch<1, false>(sm, br, cm0, 0u, 0u, 0u, qf, 0, nv - 1, 0, nvw - 1, 0u, 0u, 0u, 0u, m, l, invl, o, imp + ql * IMPW, wsc, tid, lane);
        add_scaled(acc, o, gc, wsc, i, hi);
    }
    {
        unsigned u0 = 0u, u1 = 0u, u2 = 0u, u3 = 0u;
        const int ncand = cur - 2;
        for (int qq = 0; qq < 8; ++qq) {
            unsigned k0 = 0u, k1 = 0u, k2 = 0u, k3 = 0u;
            if (ncand <= 13) {
#pragma unroll
                for (int wd = 0; wd < 4; ++wd) { const int nb = cur + 1 - 32 * wd; const unsigned x = nb >= 32 ? ~0u : (nb <= 0 ? 0u : ((1u << nb) - 1u));
                    if (wd == 0) k0 = x; else if (wd == 1) k1 = x; else if (wd == 2) k2 = x; else k3 = x; }
            } else {
                const float* ir = imp + (8 * w + qq) * IMPW;
                float v0 = (lane >= 1 && lane <= cur - 2) ? ir[lane] : -1.f;
                float v1 = (lane + 64 <= cur - 2) ? ir[lane + 64] : -1.f;
                for (int it = 0; it < 13; ++it) {
                    float bv = v0; int bs = lane;
                    if (v1 > v0) { bv = v1; bs = lane + 64; }
#pragma unroll
                    for (int off = 1; off < 64; off <<= 1) { const float ov = __shfl_xor(bv, off); const int os = __shfl_xor(bs, off);
                        if (ov > bv || (ov == bv && os < bs)) { bv = ov; bs = os; } }
                    bs = __builtin_amdgcn_readfirstlane(bs);
                    if (bs == lane) v0 = -1.f; if (bs == lane + 64) v1 = -1.f;
                    const unsigned bit = 1u << (bs & 31);
                    if (bs < 32) k0 |= bit; else if (bs < 64) k1 |= bit; else if (bs < 96) k2 |= bit; else k3 |= bit;
                }
                k0 |= 1u;
                { const int c1 = cur - 1; const unsigned bit = 1u << (c1 & 31); if (c1 < 32) k0 |= bit; else if (c1 < 64) k1 |= bit; else if (c1 < 96) k2 |= bit; else k3 |= bit; }
                { const unsigned bit = 1u << (cur & 31); if (cur < 32) k0 |= bit; else if (cur < 64) k1 |= bit; else if (cur < 96) k2 |= bit; else k3 |= bit; }
            }
            if (lane == 0) { unsigned* sp = selw + (8 * w + qq) * 4; sp[0] = k0; sp[1] = k1; sp[2] = k2; sp[3] = k3; }
            u0 |= k0; u1 |= k1; u2 |= k2; u3 |= k3;
        }
        if (lane == 0) { atomicOr(um + 0, u0); atomicOr(um + 1, u1); atomicOr(um + 2, u2); atomicOr(um + 3, u3); }
    }
    __syncthreads();
    {
        const unsigned U0 = um[0], U1 = um[1], U2 = um[2], U3 = um[3];
        const unsigned* sp = selw + ql * 4; const unsigned s0 = sp[0], s1 = sp[1], s2 = sp[2], s3 = sp[3];
        const Branch br{a.ks + (size_t)bg * T_ * 64, a.vst + (size_t)bg * 64 * T_, T_};
        float m = -1e30f, l = 0.f;
#pragma unroll
        for (int r = 0; r < 16; ++r) { o[0][r] = 0.f; o[1][r] = 0.f; }
        run_branch<2, true>(sm, br, __builtin_amdgcn_readfirstlane(U0), __builtin_amdgcn_readfirstlane(U1), __builtin_amdgcn_readfirstlane(U2), __builtin_amdgcn_readfirstlane(U3),
                            qf, 0, t, 0, tw0, s0, s1, s2, s3, m, l, 0.f, o, nullptr, wsc, tid, lane);
        l += __shfl_xor(l, 32);
        add_scaled(acc, o, gs / fmaxf(l, 1e-30f), wsc, i, hi);
    }
    {
        const int j0 = cur - 8 > 0 ? cur - 8 : 0;
        unsigned wm0 = 0u, wm1 = 0u, wm2 = 0u, wm3 = 0u;
#pragma unroll
        for (int wd = 0; wd < 4; ++wd) { const int a0 = j0 - 32 * wd, a1 = cur + 1 - 32 * wd;
            const unsigned hi_m = a1 >= 32 ? ~0u : (a1 <= 0 ? 0u : ((1u << a1) - 1u)), lo_m = a0 >= 32 ? ~0u : (a0 <= 0 ? 0u : ((1u << a0) - 1u));
            const unsigned x = hi_m & ~lo_m; if (wd == 0) wm0 = x; else if (wd == 1) wm1 = x; else if (wd == 2) wm2 = x; else wm3 = x; }
        const Branch br{a.kw + (size_t)bg * T_ * 64, a.vwt + (size_t)bg * 64 * T_, T_};
        float m = -1e30f, l = 0.f;
#pragma unroll
        for (int r = 0; r < 16; ++r) { o[0][r] = 0.f; o[1][r] = 0.f; }
        run_branch<2, false>(sm, br, wm0, wm1, wm2, wm3, qf, t - 511, t, tw1 - 511, tw0, 0u, 0u, 0u, 0u, m, l, 0.f, o, nullptr, wsc, tid, lane);
        l += __shfl_xor(l, 32);
        add_scaled(acc, o, gw / fmaxf(l, 1e-30f), wsc, i, hi);
    }
#pragma unroll
    for (int r = 0; r < 16; ++r) { const int rw = crow(r, hi), qq = 8 * w + (rw >> 2), hh = rw & 3;
        bf16* op = a.amix + ((size_t)b * T_ + q0 + qq) * DM + g * 256 + hh * 64 + i;
        op[0] = (bf16)f2bf(acc[0][r]); op[32] = (bf16)f2bf(acc[1][r]); }
}
__device__ __forceinline__ void phase(const NsaArgs& a, unsigned* ctr, unsigned char* sm) {
    int* slot = (int*)(sm + OFF_UNIT);
    for (;;) {
        if (tidx() == 0) *slot = (int)atomicAdd(ctr, 1u);
        __syncthreads();
        const int u = *slot;
        __syncthreads();
        if (u >= 512) break;
        unit(a, u, sm);
    }
}
}

__device__ __forceinline__ void d_lora_prep(const bf16* pr, const float* mu, bf16* la) {
    const int T512 = tidx(), c = T512 & 255;
    const float m = mu[1536 + c];
    FOR_VB(vb, M_ / 4) {
        const int row0 = vb * 4;
        float x[5];
        x[0] = (row0 % T_) ? bf2f(pr[(size_t)(row0 - 1) * 256 + c]) : 0.f;
#pragma unroll
        for (int j = 0; j < 4; ++j) x[j + 1] = bf2f(pr[(size_t)(row0 + j) * 256 + c]);
#pragma unroll
        for (int j = 0; j < 4; ++j) { const float xs = x[j + 1] + (x[j] - x[j + 1]) * m;
            const float v = c < 64 ? tanhf(xs) : (c < 128 ? xs : sigmoidf_(xs));
            la[(size_t)(row0 + j) * KLORA + c] = (bf16)f2bf(v); }
    }
}

namespace rw7 {
using nsa::f32x16; using nsa::crow; using nsa::pack8;
constexpr int NSLOT = 4, RA = 144, RB = 40, S_AT = 0, S_RT = 16 * RA, S_BT = 32 * RA, S_KT = S_BT + 64 * RB, S_VT = S_KT + 64 * RB, S_SM = S_VT + 64 * RB, SMM = 16 * RB, S_GC = S_SM + 4 * SMM, SLOT = S_GC + 256;
constexpr int OFF_SCR = 2 * NSLOT * SLOT, SCR = 32 * RA, LDS_NEED = OFF_SCR + NSLOT * SCR;
static_assert(LDS_NEED <= 147456 && SLOT % 16 == 0 && S_BT % 16 == 0 && 128 * RB >= 4096 && SCR >= 4096, "rw7 lds map");
struct Args { const unsigned* rkw; const bf16* vv; const bf16* aga; const float* wdec; const float *mu, *kk, *ka, *rk; float* yraw; float* bonus; };
struct Chan { float mur, muk, muv, kkc, kac, rkc; };
struct Raw { unsigned rk[16]; unsigned short v[16], al[16]; float w[16]; unsigned prk; unsigned short pv; };
__device__ __forceinline__ void fetch(const Args& a, int b, int h, int c, int lane, Raw& q) {
    const size_t base = ((size_t)b * T_ + (size_t)c * 16) * 512 + h * 64 + lane;
#pragma unroll
    for (int t = 0; t < 16; ++t) { q.rk[t] = a.rkw[base + (size_t)t * 512]; q.v[t] = a.vv[base + (size_t)t * 512]; q.al[t] = a.aga[base + (size_t)t * 512]; q.w[t] = a.wdec[base + (size_t)t * 512]; }
    q.prk = 0u; q.pv = 0;
    if (c > 0) { q.prk = a.rkw[base - 512]; q.pv = a.vv[base - 512]; }
}
__device__ __forceinline__ void st_row40(unsigned char* p, const unsigned (&w)[8]) {
    *(u32x2*)p = (u32x2){w[0], w[1]}; *(u32x2*)(p + 8) = (u32x2){w[2], w[3]}; *(u32x2*)(p + 16) = (u32x2){w[4], w[5]}; *(u32x2*)(p + 24) = (u32x2){w[6], w[7]};
}
__device__ __forceinline__ void produce(const Args& a, const Chan& ch, int b, int h, int c, const Raw& q, unsigned char* slot, unsigned char* scr, int lane) {
    const int i = lane & 31, hi = lane >> 5;
    const size_t row0 = (size_t)b * T_ + (size_t)c * 16;
    float pr_r = __builtin_bit_cast(float, q.prk << 16), pr_k = __builtin_bit_cast(float, q.prk & 0xffff0000u), pr_v = bf2f(q.pv);
    float rr[16], kq[16], kt[16];
    float* RED1 = (float*)scr;
    float* RED2 = (float*)(slot + S_BT);
#pragma unroll
    for (int t4 = 0; t4 < 4; ++t4) { f32x4 e1, e2;
#pragma unroll
        for (int e = 0; e < 4; ++e) { const int t = 4 * t4 + e;
            const float r0 = __builtin_bit_cast(float, q.rk[t] << 16), k0 = __builtin_bit_cast(float, q.rk[t] & 0xffff0000u), al = bf2f(q.al[t]);
            const float r = r0 + (pr_r - r0) * ch.mur, k = k0 + (pr_k - k0) * ch.muk;
            pr_r = r0; pr_k = k0;
            rr[t] = r; kq[t] = k * ch.kkc; kt[t] = k * (1.f + (al - 1.f) * ch.kac);
            e1[e] = kq[t] * kq[t]; e2[e] = r * kt[t] * ch.rkc; }
        *(f32x4*)(RED1 + lane * 16 + 4 * t4) = e1; *(f32x4*)(RED2 + lane * 16 + 4 * t4) = e2; }
    asm volatile("s_waitcnt lgkmcnt(0)" ::: "memory");
    { const int t = lane & 15, part = lane >> 4; float s1 = 0.f, s2 = 0.f;
#pragma unroll
      for (int j = 0; j < 16; ++j) { s1 += RED1[(part * 16 + j) * 16 + t]; s2 += RED2[(part * 16 + j) * 16 + t]; }
      s1 += __shfl_xor(s1, 16); s2 += __shfl_xor(s2, 16); s1 += __shfl_xor(s1, 32); s2 += __shfl_xor(s2, 32);
      asm volatile("s_waitcnt lgkmcnt(0)" ::: "memory");
      if (lane < 16) { ((float*)(slot + S_GC))[lane] = s1; a.bonus[(row0 + lane) * 8 + h] = s2; } }
    asm volatile("s_waitcnt lgkmcnt(0)" ::: "memory");
    f32x4 n2[4];
#pragma unroll
    for (int t4 = 0; t4 < 4; ++t4) n2[t4] = *(const f32x4*)(slot + S_GC + 16 * t4);
    asm volatile("s_waitcnt lgkmcnt(0)" ::: "memory");
    float gam = 1.f;
    unsigned btp[8], ktp[8], vtp[8];
    float b_ev = 0.f, k_ev = 0.f, v_ev = 0.f;
#pragma unroll
    for (int t = 0; t < 16; ++t) {
        const float v0 = bf2f(q.v[t]), al = bf2f(q.al[t]);
        const float v = v0 + (pr_v - v0) * ch.muv; pr_v = v0;
        const float kkn = kq[t] * __builtin_amdgcn_rsqf(fmaxf(n2[t >> 2][t & 3], 1e-24f));
        const float gp = gam; gam *= q.w[t]; const float ig = __builtin_amdgcn_rcpf(gam);
        const float bt_ = kkn * al * ig, kt_ = kt[t] * ig;
        const unsigned ar = pk2(-kkn * gp, rr[t] * gam), bk = pk2(bt_, kt_);
        *(bf16*)(slot + S_AT + t * RA + lane * 2) = (bf16)(ar & 0xffffu); *(bf16*)(slot + S_RT + t * RA + lane * 2) = (bf16)(ar >> 16);
        *(bf16*)(scr + t * RA + lane * 2) = (bf16)(bk & 0xffffu); *(bf16*)(scr + (16 + t) * RA + lane * 2) = (bf16)(bk >> 16);
        if (t & 1) { btp[t >> 1] = pk2(b_ev, bt_); ktp[t >> 1] = pk2(k_ev, kt_); vtp[t >> 1] = pk2(v_ev, v); }
        else { b_ev = bt_; k_ev = kt_; v_ev = v; }
    }
    st_row40(slot + S_BT + lane * RB, btp); st_row40(slot + S_KT + lane * RB, ktp); st_row40(slot + S_VT + lane * RB, vtp);
    ((float*)(slot + S_GC))[lane] = gam;
    asm volatile("s_waitcnt lgkmcnt(0)" ::: "memory");
    f32x16 C;
#pragma unroll
    for (int r = 0; r < 16; ++r) C[r] = 0.f;
#pragma unroll
    for (int ks = 0; ks < 4; ++ks) {
        const bf16x8 af = *(const bf16x8*)(slot + S_AT + i * RA + (16 * ks + 8 * hi) * 2);
        const bf16x8 bf = *(const bf16x8*)(scr + i * RA + (16 * ks + 8 * hi) * 2);
        C = __builtin_amdgcn_mfma_f32_32x32x16_bf16(af, bf, C, 0, 0, 0);
    }
    asm volatile("s_waitcnt lgkmcnt(0)" ::: "memory");
    float* AAB = (float*)scr;
    unsigned char* SM = slot + S_SM;
#pragma unroll
    for (int r = 0; r < 16; ++r) {
        const int rho = crow(r, hi); const float val = C[r];
        if (r < 8) {
            if (i < 16) AAB[rho * 16 + i] = (i < rho) ? val : 0.f;
            else *(bf16*)(SM + SMM + rho * RB + (i - 16) * 2) = (bf16)f2bf((i - 16 < rho) ? val : 0.f);
        } else {
            const int tt = rho - 16;
            if (i < 16) *(bf16*)(SM + 2 * SMM + tt * RB + i * 2) = (bf16)f2bf((i <= tt) ? val : 0.f);
            else *(bf16*)(SM + 3 * SMM + tt * RB + (i - 16) * 2) = (bf16)f2bf((i - 16 <= tt) ? val : 0.f);
        }
    }
    asm volatile("s_waitcnt lgkmcnt(0)" ::: "memory");
    { const int j = lane & 15; float Tr[16];
#pragma unroll
      for (int t = 0; t < 16; ++t) { float acc = (t == j) ? 1.f : 0.f;
#pragma unroll
          for (int s4 = 0; s4 < (t + 3) / 4; ++s4) { const f32x4 ar = *(const f32x4*)(AAB + t * 16 + 4 * s4);
#pragma unroll
              for (int e = 0; e < 4; ++e) if (4 * s4 + e < t) acc += ar[e] * Tr[4 * s4 + e]; }
          Tr[t] = acc;
          if (lane < 16) *(bf16*)(SM + t * RB + j * 2) = (bf16)f2bf(acc); } }
}

__device__ __forceinline__ bf16x8 rd_perm(const unsigned char* p, int hi) {
    const u32x2 a = *(const u32x2*)(p + 8 * hi), b = *(const u32x2*)(p + 16 + 8 * hi);
    return __builtin_bit_cast(bf16x8, (u32x4){a.x, a.y, b.x, b.y});
}
__device__ __forceinline__ bf16x8 rd_nat(const unsigned char* p, int hi) {
    const u32x2 a = *(const u32x2*)(p + 16 * hi), b = *(const u32x2*)(p + 16 * hi + 8);
    return __builtin_bit_cast(bf16x8, (u32x4){a.x, a.y, b.x, b.y});
}
__device__ __forceinline__ void consume(const unsigned char* slot, f32x16 (&z)[2], float* yout, int vt, int lane) {
    const int i = lane & 31, hi = lane >> 5, i16 = i & 15; const bool lo16 = i < 16;
    const bf16x8 zero = {0, 0, 0, 0, 0, 0, 0, 0};
    const bf16x8 zb0 = pack8(z[0], 0), zb1 = pack8(z[0], 8), zb2 = pack8(z[1], 0), zb3 = pack8(z[1], 8);
    const unsigned char* at = slot + S_AT + i16 * RA; const unsigned char* rt = slot + S_RT + i16 * RA; const unsigned char* sm16 = slot + S_SM + i16 * RB;
    const bf16x8 vtf = rd_nat(slot + S_VT + (32 * vt + i) * RB, hi);
    f32x16 X, U, Y;
#pragma unroll
    for (int r = 0; r < 16; ++r) { X[r] = 0.f; U[r] = 0.f; Y[r] = 0.f; }
    X = __builtin_amdgcn_mfma_f32_32x32x16_bf16(lo16 ? rd_perm(at, hi) : zero, zb0, X, 0, 0, 0);
    X = __builtin_amdgcn_mfma_f32_32x32x16_bf16(lo16 ? rd_perm(at + 32, hi) : zero, zb1, X, 0, 0, 0);
    X = __builtin_amdgcn_mfma_f32_32x32x16_bf16(lo16 ? rd_perm(at + 64, hi) : zero, zb2, X, 0, 0, 0);
    X = __builtin_amdgcn_mfma_f32_32x32x16_bf16(lo16 ? rd_perm(at + 96, hi) : zero, zb3, X, 0, 0, 0);
    X = __builtin_amdgcn_mfma_f32_32x32x16_bf16(lo16 ? rd_nat(sm16 + SMM, hi) : zero, vtf, X, 0, 0, 0);
    const bf16x8 xb = pack8(X, 0);
    U = __builtin_amdgcn_mfma_f32_32x32x16_bf16(lo16 ? rd_perm(sm16, hi) : zero, xb, U, 0, 0, 0);
    const bf16x8 ub = pack8(U, 0);
    Y = __builtin_amdgcn_mfma_f32_32x32x16_bf16(lo16 ? rd_perm(rt, hi) : zero, zb0, Y, 0, 0, 0);
    Y = __builtin_amdgcn_mfma_f32_32x32x16_bf16(lo16 ? rd_perm(rt + 32, hi) : zero, zb1, Y, 0, 0, 0);
    Y = __builtin_amdgcn_mfma_f32_32x32x16_bf16(lo16 ? rd_perm(rt + 64, hi) : zero, zb2, Y, 0, 0, 0);
    Y = __builtin_amdgcn_mfma_f32_32x32x16_bf16(lo16 ? rd_perm(rt + 96, hi) : zero, zb3, Y, 0, 0, 0);
    Y = __builtin_amdgcn_mfma_f32_32x32x16_bf16(lo16 ? rd_perm(sm16 + 2 * SMM, hi) : zero, ub, Y, 0, 0, 0);
    Y = __builtin_amdgcn_mfma_f32_32x32x16_bf16(lo16 ? rd_nat(sm16 + 3 * SMM, hi) : zero, vtf, Y, 0, 0, 0);
#pragma unroll
    for (int kt = 0; kt < 2; ++kt) {
        z[kt] = __builtin_amdgcn_mfma_f32_32x32x16_bf16(rd_nat(slot + S_KT + (32 * kt + i) * RB, hi), vtf, z[kt], 0, 0, 0);
        z[kt] = __builtin_amdgcn_mfma_f32_32x32x16_bf16(rd_perm(slot + S_BT + (32 * kt + i) * RB, hi), ub, z[kt], 0, 0, 0);
#pragma unroll
        for (int rg = 0; rg < 4; ++rg) { const f32x4 g4 = *(const f32x4*)(slot + S_GC + (32 * kt + 8 * rg + 4 * hi) * 4);
#pragma unroll
            for (int e = 0; e < 4; ++e) z[kt][4 * rg + e] *= g4[e]; }
    }
#pragma unroll
    for (int r = 0; r < 8; ++r) yout[(size_t)crow(r, hi) * 512] = Y[r];
}

__device__ __forceinline__ void head(const Args& a, int bh, unsigned char* sm) {
    const int tid = tidx(), lane = tid & 63, w = __builtin_amdgcn_readfirstlane(tid >> 6);
    const int b = bh >> 3, h = bh & 7;
    constexpr int NSTEP = T_ / 16 / NSLOT;
    if (w < 2) {
        f32x16 z[2];
#pragma unroll
        for (int r = 0; r < 16; ++r) { z[0][r] = 0.f; z[1][r] = 0.f; }
        __syncthreads();
        for (int g = 0; g < NSTEP; ++g) {
#pragma unroll
            for (int p = 0; p < NSLOT; ++p) {
                const int c = NSLOT * g + p;
                consume(sm + (size_t)((g & 1) * NSLOT + p) * SLOT, z, a.yraw + ((size_t)b * T_ + (size_t)c * 16) * 512 + h * 64 + 32 * w + (lane & 31), w, lane);
            }
            __syncthreads();
        }
    } else if ((w & 2) != 0) {
        const int pw = (w & 1) | ((w >> 2) << 1), col = h * 64 + lane;
        const Chan ch{a.mu[col], a.mu[512 + col], a.mu[1024 + col], a.kk[col], a.ka[col], a.rk[col]};
        unsigned char* scr = sm + OFF_SCR + pw * SCR;
        Raw q; fetch(a, b, h, pw, lane, q);
        { Raw nq; fetch(a, b, h, pw + NSLOT, lane, nq); produce(a, ch, b, h, pw, q, sm + (size_t)pw * SLOT, scr, lane); q = nq; }
        __syncthreads();
        for (int g = 0; g < NSTEP; ++g) {
            const int c = NSLOT * (g + 1) + pw;
            if (c < T_ / 16) { Raw nq; if (c + NSLOT < T_ / 16) fetch(a, b, h, c + NSLOT, lane, nq);
                produce(a, ch, b, h, c, q, sm + (size_t)(((g + 1) & 1) * NSLOT + pw) * SLOT, scr, lane); q = nq; }
            __syncthreads();
        }
    } else {
        __syncthreads();
        for (int g = 0; g < NSTEP; ++g) __syncthreads();
    }
}
__device__ __forceinline__ void finish(const float* yraw, const float* bonus, const bf16* vv, const bf16* agg, const float* mu, const float* gng, const float* gnb, bf16* amix) {
    const int T512 = tidx(), lane = T512 & 63;
    for (int it0 = (blockIdx.x * 8 + (T512 >> 6)) * 4; it0 < M_ * 8; it0 += gridDim.x * 8 * 4) {
        const int row = it0 >> 3, h0 = it0 & 7, t = row % T_;
        float y[4], v0[4], v1[4], gg[4], bo[4];
#pragma unroll
        for (int j = 0; j < 4; ++j) { const int col = (h0 + j) * 64 + lane;
            y[j] = yraw[(size_t)row * 512 + col]; v0[j] = bf2f(vv[(size_t)row * 512 + col]); v1[j] = t ? bf2f(vv[(size_t)(row - 1) * 512 + col]) : 0.f;
            gg[j] = bf2f(agg[(size_t)row * 512 + col]); bo[j] = bonus[(size_t)row * 8 + h0 + j]; }
        float mean[4], var[4];
#pragma unroll
        for (int j = 0; j < 4; ++j) mean[j] = y[j];
#pragma unroll
        for (int o = 1; o < 64; o <<= 1) {
#pragma unroll
            for (int j = 0; j < 4; ++j) mean[j] += __shfl_xor(mean[j], o); }
#pragma unroll
        for (int j = 0; j < 4; ++j) { mean[j] *= (1.f / 64.f); y[j] -= mean[j]; var[j] = y[j] * y[j]; }
#pragma unroll
        for (int o = 1; o < 64; o <<= 1) {
#pragma unroll
            for (int j = 0; j < 4; ++j) var[j] += __shfl_xor(var[j], o); }
#pragma unroll
        for (int j = 0; j < 4; ++j) { const int col = (h0 + j) * 64 + lane;
            const float yn = y[j] * rsqrtf(var[j] * (1.f / 64.f) + 64e-5f) * gng[col] + gnb[col];
            const float v = v0[j] + (v1[j] - v0[j]) * mu[1024 + col];
            amix[(size_t)row * DM + 512 + col] = (bf16)f2bf((yn + bo[j] * v) * gg[j]); }
    }
}
}

namespace mema {
using nsa::f32x16; using nsa::KROW; using nsa::VROW; using nsa::KBUF; using nsa::VBUF; using nsa::OFF_K; using nsa::OFF_V; using nsa::OFF_WS; using nsa::crow; using nsa::pack8;
__device__ __forceinline__ void unit(const bf16* qm, const bf16* mk, const bf16* mvt, bf16* om, int u, unsigned char* sm) {
    const int tid = tidx(), lane = tid & 63, w = __builtin_amdgcn_readfirstlane(tid >> 6), i = lane & 31, hi = lane >> 5;
    const int b = u >> 7, h = (u >> 5) & 3, rb = u & 31;
    const int row0 = b * T_ + rb * 256 + 32 * w;
    const bf16* qrow = qm + (size_t)(row0 + i) * DM + h * 256 + 8 * hi;
    const bf16* kbase = mk + (size_t)(b * 256 + (tid >> 3)) * DM + h * 256 + (tid & 7) * 8;
    const bf16* vbase = mvt + (size_t)(h * 256 + (tid >> 3)) * 512 + b * 256 + (tid & 7) * 8;
    unsigned char* kst = sm + OFF_K + (tid >> 3) * KROW + (tid & 7) * 16;
    unsigned char* vst = sm + OFF_V + (tid >> 3) * VROW + (tid & 7) * 16;
    float* wsc = (float*)(sm + OFF_WS) + w * 32;
    f32x16 p[4][2];
#pragma unroll
    for (int kt = 0; kt < 4; ++kt)
#pragma unroll
        for (int r = 0; r < 16; ++r) { p[kt][0][r] = 0.f; p[kt][1][r] = 0.f; }
    u32x4 tr = *(const u32x4*)kbase;
    *(u32x4*)kst = tr;
    __syncthreads();
    bf16x8 qf[4];
#pragma unroll
    for (int n = 0; n < 16; ++n) {
        const int dc = n >> 2, kt = n & 3, cb = n & 1;
        if (n + 1 < 16) tr = *(const u32x4*)(kbase + (size_t)(64 * ((n + 1) & 3)) * DM + 64 * ((n + 1) >> 2));
        else tr = *(const u32x4*)vbase;
        if (kt == 0) {
#pragma unroll
            for (int d0 = 0; d0 < 4; ++d0) qf[d0] = *(const bf16x8*)(qrow + 64 * dc + 16 * d0);
        }
        const unsigned char* kb = sm + OFF_K + cb * KBUF;
#pragma unroll
        for (int d0 = 0; d0 < 4; ++d0) {
            const bf16x8 a0 = *(const bf16x8*)(kb + i * KROW + (16 * d0 + 8 * hi) * 2);
            const bf16x8 a1 = *(const bf16x8*)(kb + (32 + i) * KROW + (16 * d0 + 8 * hi) * 2);
            p[kt][0] = __builtin_amdgcn_mfma_f32_32x32x16_bf16(a0, qf[d0], p[kt][0], 0, 0, 0);
            p[kt][1] = __builtin_amdgcn_mfma_f32_32x32x16_bf16(a1, qf[d0], p[kt][1], 0, 0, 0);
        }
        if (n + 1 < 16) *(u32x4*)(kst + (cb ^ 1) * KBUF) = tr;
        else { *(u32x2*)vst = (u32x2){tr.x, tr.y}; *(u32x2*)(vst + 8) = (u32x2){tr.z, tr.w}; }
        __syncthreads();
    }
    float mx = p[0][0][0];
#pragma unroll
    for (int kt = 0; kt < 4; ++kt)
#pragma unroll
        for (int r = 0; r < 16; ++r) mx = fmaxf(mx, fmaxf(p[kt][0][r], p[kt][1][r]));
    mx = fmaxf(mx, __shfl_xor(mx, 32));
    float l = 0.f;
#pragma unroll
    for (int kt = 0; kt < 4; ++kt)
#pragma unroll
        for (int r = 0; r < 16; ++r) { p[kt][0][r] = __builtin_amdgcn_exp2f(p[kt][0][r] - mx); p[kt][1][r] = __builtin_amdgcn_exp2f(p[kt][1][r] - mx); l += p[kt][0][r] + p[kt][1][r]; }
    l += __shfl_xor(l, 32);
    bf16x8 pf[4][4];
#pragma unroll
    for (int kt = 0; kt < 4; ++kt) { pf[kt][0] = pack8(p[kt][0], 0); pf[kt][1] = pack8(p[kt][0], 8); pf[kt][2] = pack8(p[kt][1], 0); pf[kt][3] = pack8(p[kt][1], 8); }
    if (hi == 0) wsc[i] = 1.f / l;
    asm volatile("" ::: "memory");
    f32x4 il[4];
#pragma unroll
    for (int rg = 0; rg < 4; ++rg) il[rg] = *(const f32x4*)(wsc + 8 * rg + 4 * hi);
    f32x16 o[2];
#pragma unroll
    for (int n = 0; n < 16; ++n) {
        const int dvt = n >> 2, kt = n & 3, cb = n & 1;
        if (n + 1 < 16) tr = *(const u32x4*)(vbase + (size_t)(64 * ((n + 1) >> 2)) * 512 + 64 * ((n + 1) & 3));
        if (kt == 0) {
#pragma unroll
            for (int r = 0; r < 16; ++r) { o[0][r] = 0.f; o[1][r] = 0.f; }
        }
        const unsigned char* vb = sm + OFF_V + cb * VBUF;
#pragma unroll
        for (int dt = 0; dt < 2; ++dt) {
            const unsigned char* vp = vb + (32 * dt + i) * VROW + 8 * hi;
#pragma unroll
            for (int ks = 0; ks < 4; ++ks) {
                const u32x2 v_lo = *(const u32x2*)(vp + 32 * ks), v_hi = *(const u32x2*)(vp + 32 * ks + 16);
                const bf16x8 vf = __builtin_bit_cast(bf16x8, (u32x4){v_lo.x, v_lo.y, v_hi.x, v_hi.y});
                o[dt] = __builtin_amdgcn_mfma_f32_32x32x16_bf16(pf[kt][ks], vf, o[dt], 0, 0, 0);
            }
        }
        if (kt == 3) {
#pragma unroll
            for (int r = 0; r < 16; ++r) { bf16* op = om + (size_t)(row0 + crow(r, hi)) * DM + h * 256 + 64 * dvt + i;
                op[0] = (bf16)f2bf(o[0][r] * il[r >> 2][r & 3]); op[32] = (bf16)f2bf(o[1][r] * il[r >> 2][r & 3]); }
        }
        if (n + 1 < 16) { unsigned char* vp2 = vst + (cb ^ 1) * VBUF; *(u32x2*)vp2 = (u32x2){tr.x, tr.y}; *(u32x2*)(vp2 + 8) = (u32x2){tr.z, tr.w}; }
        __syncthreads();
    }
}
}

#define LAS __attribute__((address_space(3)))
#define XB_TMO      128
#define XB_XCNT(j)  (256  + 64 * (j))
#define XB_XSUB(j)  (1280 + 64 * (j))
#define XB_XGEN(j)  (2304 + 64 * (j))
#define XB_TOP      3328
#define XB_TOPGEN   3392
#define XCD_BAR_WORDS 3456
#define XB_SPIN_CAP (1u << 18)

__device__ __forceinline__ unsigned xb_ld(unsigned* p)              { return __hip_atomic_load(p, __ATOMIC_RELAXED, __HIP_MEMORY_SCOPE_AGENT); }
__device__ __forceinline__ unsigned xb_add(unsigned* p, unsigned v) { return __hip_atomic_fetch_add(p, v, __ATOMIC_RELAXED, __HIP_MEMORY_SCOPE_AGENT); }
__device__ __forceinline__ unsigned xb_xcc_id() { return (unsigned)__builtin_amdgcn_s_getreg((3 << 11) | 20) & 0xFu; }
#define XB_SPIN(cond, bar) do { unsigned _sp = 0; while (cond) { __builtin_amdgcn_s_sleep(1); \
    if ((++_sp & 255u) == 0u) { if (xb_ld(&(bar)[XB_TMO])) break; if (_sp > XB_SPIN_CAP) { atomicAdd(&(bar)[XB_TMO], 1u); break; } } } } while (0)

struct XcdBarrier {
    unsigned* bar; unsigned x;
    volatile LAS unsigned* st;
};

__device__ __forceinline__ XcdBarrier xcd_barrier_post(unsigned* bar, volatile LAS unsigned* st) {
    XcdBarrier b; b.bar = bar; b.x = xb_xcc_id(); b.st = st;
    if (tidx() == 0) (void)xb_add(&bar[XB_XCNT(b.x)], 1u);
    return b;
}
__device__ __forceinline__ void xcd_barrier_complete(unsigned* bar, unsigned x, unsigned& nloc, unsigned& nx) {
    const unsigned G = gridDim.x * gridDim.y * gridDim.z;
    unsigned sum, cnt, mine, sp = 0u;
    for (;;) {
        sum = 0u; cnt = 0u; mine = 0u;
#pragma unroll
        for (unsigned j = 0; j < 16; ++j) { const unsigned c = xb_ld(&bar[XB_XCNT(j)]); sum += c; cnt += (c > 0u) ? 1u : 0u; mine = (j == x) ? c : mine; }
        if (sum == G) break;
        __builtin_amdgcn_s_sleep(1);
        if ((++sp & 255u) == 0u) { if (xb_ld(&bar[XB_TMO])) break; if (sp > XB_SPIN_CAP) { atomicAdd(&bar[XB_TMO], 1u); break; } }
    }
    nloc = mine > 0u ? mine : 1u; nx = cnt > 0u ? cnt : 1u;
}

__device__ __forceinline__ void xcd_barrier(const XcdBarrier& b) {
    asm volatile("s_waitcnt vmcnt(0)" ::: "memory");
    __syncthreads();
    if (tidx() == 0) {
        unsigned* bar = b.bar;
        __builtin_amdgcn_s_waitcnt(0);
        unsigned nloc = b.st[0], nx = b.st[1];
        if (nloc == 0u) { xcd_barrier_complete(bar, b.x, nloc, nx); b.st[0] = nloc; b.st[1] = nx; }
        const unsigned old = xb_add(&bar[XB_XSUB(b.x)], 1u);
        const unsigned gen = old / nloc;
        if (old + 1u == (gen + 1u) * nloc) {
            __builtin_amdgcn_fence(__ATOMIC_RELEASE, "agent");
            asm volatile("s_waitcnt vmcnt(0)" ::: "memory");
            const unsigned og = xb_add(&bar[XB_TOP], 1u);
            const unsigned tg = og / nx;
            if (og + 1u == (tg + 1u) * nx) xb_add(&bar[XB_TOPGEN], 1u);
            else XB_SPIN(xb_ld(&bar[XB_TOPGEN]) == tg, bar);
            __builtin_amdgcn_fence(__ATOMIC_ACQUIRE, "agent");
            xb_add(&bar[XB_XGEN(b.x)], 1u);
            asm volatile("s_waitcnt vmcnt(0)" ::: "memory");
        } else {
            XB_SPIN(xb_ld(&bar[XB_XGEN(b.x)]) == gen, bar);
            __builtin_amdgcn_fence(__ATOMIC_ACQUIRE, "agent");
            asm volatile("s_waitcnt vmcnt(0)" ::: "memory");
        }
    }
    __syncthreads();
}

constexpr int NTHREADS = 512, LDS_BYTES = 147456;
struct MegaArgs { const float* in[41]; float* out; unsigned char* ws; };
#define WSB(off) ((bf16*)(ws + (off)))
#define WSF(off) ((float*)(ws + (off)))

__global__ void __launch_bounds__(NTHREADS) mega_fwd(MegaArgs A) {
    extern __shared__ __attribute__((aligned(16))) unsigned char lds[];
    cg::grid_group grid = cg::this_grid();
    const float* const* in = A.in; unsigned char* ws = A.ws; float* out = A.out;
    if (tidx() < 2) ((volatile LAS unsigned*)(lds + LDS_BYTES - 64))[tidx()] = 0u;
    __syncthreads();
    const XcdBarrier xbar = xcd_barrier_post((unsigned*)(ws + WS_CTL) + 16384, (volatile LAS unsigned*)(lds + LDS_BYTES - 64));

    d_convert(WSB(WS_W1GU), NGU, DM, MapGU{in[I_F1_WG], in[I_F1_WU], FF});
    d_convert(WSB(WS_W1D), DM, FF, MapPlain{in[I_F1_WD], DM});
    d_convert(WSB(WS_W2GU), NGU, DM, MapGU{in[I_F2_WG], in[I_F2_WU], FF});
    d_convert(WSB(WS_W2D), DM, FF, MapPlain{in[I_F2_WD], DM});
    d_convert(WSB(WS_WIN), NWIN, DM, MapWin{in[I_WIN], IN_COLS});
    d_convert(WSB(WS_WOUT), DM, DM, MapPlain{in[I_WOUT], DM});
    d_convert(WSB(WS_WQ), DM, DM, MapPlain{in[I_WQ], DM});
    d_convert(WSB(WS_WK), DM, DM, MapPlain{in[I_WK], DM});
    d_convert(WSB(WS_WV), DM, DM, MapPlain{in[I_WV], DM});
    d_convert(WSB(WS_WO), DM, DM, MapPlain{in[I_WO], DM});
    d_convert(WSB(WS_CW1K), 256, 2048, MapPlain{in[I_W1_K], 256});
    d_convert(WSB(WS_CW1V), 256, 2048, MapPlain{in[I_W1_V], 256});
    d_convert_lora(WSB(WS_WLORA), in[I_W2], in[I_A2], in[I_G2]);
    d_rope_table(WSF(WS_ROPE));
    d_cmp_bias(in[I_PE_K], in[I_W1_K], in[I_PE_V], in[I_W1_V], WSF(WS_CBIAS), (float*)lds);
    d_rownorm(in[I_X], in[I_F1_PRE], WSB(WS_XN), M_);
    d_rownorm(in[I_MEM], in[I_MEM_KVG], WSB(WS_MEMN), 512);
    grid.sync();
    gemm_pg8(lds, WSB(WS_XN), DM, WSB(WS_W1GU), DM, M_, NGU, DM, EpiSwiGLU{WSB(WS_HB)});
    xcd_barrier(xbar);
    gemm_norm_res(lds, WSB(WS_HB), FF, WSB(WS_W1D), FF, in[I_X], out, WSB(WS_XN), in[I_F1_POST], in[I_MIX_PRE], 0.5f, WSB(WS_YB), (unsigned*)(ws + WS_GATES), (unsigned*)(ws + WS_CTL) + 1024 + 0 * 2048);
    xcd_barrier(xbar);
    gemm_pg8(lds, WSB(WS_XN), DM, WSB(WS_WIN), DM, M_, NWIN, DM,
             EpiWin{WSB(WS_QB), WSB(WS_KS), WSB(WS_KW), WSB(WS_KCR), WSB(WS_VCR), WSB(WS_VST), WSB(WS_VWT), (unsigned*)(ws + WS_RKVA), WSB(WS_RKVA + 32 * MiB), WSB(WS_PRL), WSF(WS_GATES), WSF(WS_ROPE)});
    xcd_barrier(xbar);
    gemm_pg8(lds, WSB(WS_KCR), 1024, WSB(WS_CW1K), 2048, 2048, 256, 2048, EpiBiasSilu{WSB(WS_HIDK), WSF(WS_CBIAS)});
    gemm_pg8(lds, WSB(WS_VCR), 1024, WSB(WS_CW1V), 2048, 2048, 256, 2048, EpiBiasSilu{WSB(WS_HIDV), WSF(WS_CBIAS) + 256});
    d_lora_prep(WSB(WS_PRL), in[I_MU], WSB(WS_XN));
    xcd_barrier(xbar);
    d_cmp2(WSB(WS_HIDK), WSB(WS_HIDV), in[I_W2_K], in[I_W2_V], WSF(WS_ROPE), WSB(WS_KC), WSB(WS_VCT));
    gemm_pg8(lds, WSB(WS_XN), KLORA, WSB(WS_WLORA), KLORA, M_, NLORA, KLORA, EpiLora{WSF(WS_YB), WSB(WS_RKVA + 48 * MiB), WSB(WS_AGG), in[I_W0], in[I_A0]});
    xcd_barrier(xbar);
    if (blockIdx.x < 16) {
        const rw7::Args ra{(const unsigned*)(ws + WS_RKVA), WSB(WS_RKVA + 32 * MiB), WSB(WS_RKVA + 48 * MiB), WSF(WS_YB), in[I_MU], in[I_KK], in[I_KA], in[I_RK], WSF(WS_YB), WSF(WS_BONUS)};
        rw7::head(ra, blockIdx.x, lds);
    }
    {
        const NsaArgs na{WSB(WS_QB), WSB(WS_KC), WSB(WS_VCT), WSB(WS_KS), WSB(WS_VST), WSB(WS_KW), WSB(WS_VWT), WSF(WS_GATES), WSB(WS_XN)};
        nsa::phase(na, (unsigned*)(ws + WS_CTL), lds);
    }
    xcd_barrier(xbar);
    d_nsa_outnorm(WSB(WS_XN), in[I_NSA_G]);
    rw7::finish(WSF(WS_YB), WSF(WS_BONUS), WSB(WS_RKVA + 32 * MiB), WSB(WS_AGG), in[I_MU], in[I_GNG], in[I_GNB], WSB(WS_XN));
    xcd_barrier(xbar);
    gemm_norm_res(lds, WSB(WS_XN), DM, WSB(WS_WOUT), DM, out, out, WSB(WS_XN), in[I_MIX_POST], in[I_MEM_PRE], 1.0f, WSB(WS_YB), (unsigned*)(ws + WS_GATES), (unsigned*)(ws + WS_CTL) + 1024 + 1 * 2048);
    xcd_barrier(xbar);
    gemm_pg8(lds, WSB(WS_XN), DM, WSB(WS_WQ), DM, M_, DM, DM, EpiStore{WSB(WS_QM), DM, MSCALE});
    gemm_pg8(lds, WSB(WS_MEMN), DM, WSB(WS_WK), DM, 512, DM, DM, EpiStore{WSB(WS_MK), DM, 1.f});
    gemm_pg8(lds, WSB(WS_WV), DM, WSB(WS_MEMN), DM, DM, 512, DM, EpiStore{WSB(WS_MVT), 512, 1.f});
    xcd_barrier(xbar);
    for (int u = blockIdx.x; u < 256; u += gridDim.x) mema::unit(WSB(WS_QM), WSB(WS_MK), WSB(WS_MVT), WSB(WS_OM), u, lds);
    xcd_barrier(xbar);
    gemm_norm_res(lds, WSB(WS_OM), DM, WSB(WS_WO), DM, out, out, WSB(WS_XN), in[I_MEM_POST], in[I_F2_PRE], 1.0f, WSB(WS_YB), (unsigned*)(ws + WS_GATES), (unsigned*)(ws + WS_CTL) + 1024 + 2 * 2048);
    xcd_barrier(xbar);
    gemm_pg8(lds, WSB(WS_XN), DM, WSB(WS_W2GU), DM, M_, NGU, DM, EpiSwiGLU{WSB(WS_HB)});
    xcd_barrier(xbar);
    gemm_norm_res(lds, WSB(WS_HB), FF, WSB(WS_W2D), FF, out, out, (bf16*)nullptr, in[I_F2_POST], (const float*)nullptr, 0.5f, WSB(WS_YB), (unsigned*)(ws + WS_GATES), (unsigned*)(ws + WS_CTL) + 1024 + 3 * 2048);
}

extern "C" void kernel_launch(void* const* d_in, const int* in_sizes, int n_in, void* d_out, int out_size, void* d_ws, size_t ws_size, hipStream_t stream) {
    static int grid = 0;
    if (grid == 0) {
        if (n_in != 41 || ws_size < WS_END) { fprintf(stderr, "kernel_launch: unexpected n_in %d / ws %zu\n", n_in, ws_size); grid = -1; return; }
        int dev = 0, cus = 0, per_cu = 0;
        hipGetDevice(&dev); hipDeviceGetAttribute(&cus, hipDeviceAttributeMultiprocessorCount, dev);
        if (hipFuncSetAttribute((const void*)mega_fwd, hipFuncAttributeMaxDynamicSharedMemorySize, LDS_BYTES) != hipSuccess) { fprintf(stderr, "kernel_launch: hipFuncSetAttribute failed\n"); grid = -1; return; }
        if (hipOccupancyMaxActiveBlocksPerMultiprocessor(&per_cu, (const void*)mega_fwd, NTHREADS, LDS_BYTES) != hipSuccess || per_cu < 1) { fprintf(stderr, "kernel_launch: occupancy query says %d\n", per_cu); grid = -1; (void)hipGetLastError(); return; }
        grid = cus;
        if (grid != 256) { fprintf(stderr, "kernel_launch: built for 256 CUs (one 256x256 tile per workgroup in the fused norm epilogues), found %d\n", cus); grid = -1; return; }
    }
    if (grid < 0) return;
    MegaArgs a{};
    for (int i = 0; i < 41; ++i) a.in[i] = (const float*)d_in[i];
    a.out = (float*)d_out; a.ws = (unsigned char*)d_ws;
    hipMemsetAsync(d_ws, 0, 131072, stream);
    void* args[] = {&a};
    hipError_t e = hipLaunchCooperativeKernel((const void*)mega_fwd, dim3(grid), dim3(NTHREADS), args, LDS_BYTES, stream);
    if (e != hipSuccess) fprintf(stderr, "kernel_launch: cooperative launch failed: %s (grid %d)\n", hipGetErrorString(e), grid);
}
```

```cpp
#include <hip/hip_runtime.h>
#include <hip/hip_cooperative_groups.h>
#include <cstdint>
#include <cstdio>

constexpr int NB = 2, T_ = 8192, DM = 1024, M_ = NB * T_;
constexpr int FF = 2816, NGU = 2 * FF;
constexpr int IN_COLS = 3096, NWIN = 3328;
constexpr int NRW = 1792;
constexpr int NCP = 512;
constexpr int NLORA = 1536, KLORA = 256;
constexpr float NORM_EPS = 1e-6f;
constexpr float QSCALE = 0.125f * 1.4426950408889634f;
constexpr float MSCALE = 0.0625f * 1.4426950408889634f;

typedef unsigned short bf16;
typedef short bf16x8 __attribute__((ext_vector_type(8)));
typedef float f32x4 __attribute__((ext_vector_type(4)));
typedef unsigned u32x2 __attribute__((ext_vector_type(2)));
typedef unsigned u32x4 __attribute__((ext_vector_type(4)));

__device__ __forceinline__ unsigned f2bf(float f) { unsigned u = __builtin_bit_cast(unsigned, f); return (u + 0x7fffu + ((u >> 16) & 1u)) >> 16; }
__device__ __forceinline__ float bf2f(bf16 h) { return __builtin_bit_cast(float, (unsigned)h << 16); }
typedef float f32x2_t __attribute__((ext_vector_type(2))); typedef __bf16 bf16x2_t __attribute__((ext_vector_type(2)));
__device__ __forceinline__ unsigned pk2(float lo, float hi) { const f32x2_t v = {lo, hi}; return __builtin_bit_cast(unsigned, __builtin_convertvector(v, bf16x2_t)); }
__device__ __forceinline__ void st_bf4(bf16* p, f32x4 v) { u32x2 w; w.x = pk2(v[0], v[1]); w.y = pk2(v[2], v[3]); *(u32x2*)p = w; }
__device__ __forceinline__ float wave_sum(float v) {
#pragma unroll
    for (int o = 1; o < 64; o <<= 1) v += __shfl_xor(v, o);
    return v;
}
__device__ __forceinline__ float wave_max(float v) {
#pragma unroll
    for (int o = 1; o < 64; o <<= 1) v = fmaxf(v, __shfl_xor(v, o));
    return v;
}
__device__ __forceinline__ float sigmoidf_(float x) { return 1.f / (1.f + __expf(-x)); }
__device__ __forceinline__ int tidx() { int t = threadIdx.x; asm volatile("" : "+v"(t)); return t; }

constexpr size_t MiB = 1u << 20, KiB64 = 65536;
constexpr size_t WS_CTL = 0;
constexpr size_t WS_KC = 256 * 1024;
constexpr size_t WS_VCT = 512 * 1024;
constexpr size_t WS_W1GU = 1 * MiB;
constexpr size_t WS_W1D = 12 * MiB;
constexpr size_t WS_W2GU = WS_W1D + 88 * KiB64;
constexpr size_t WS_W2D = WS_W2GU + 11 * MiB;
constexpr size_t WS_WIN = WS_W2D + 88 * KiB64;
constexpr size_t WS_WOUT = WS_WIN + 104 * KiB64;
constexpr size_t WS_WQ = WS_WOUT + 2 * MiB, WS_WK = WS_WQ + 2 * MiB, WS_WV = WS_WK + 2 * MiB, WS_WO = WS_WV + 2 * MiB;
constexpr size_t WS_CW1K = WS_WO + 2 * MiB, WS_CW1V = WS_CW1K + 1 * MiB;
constexpr size_t WS_WLORA = WS_CW1V + 1 * MiB;
constexpr size_t WS_ROPE = WS_WLORA + 12 * KiB64;
constexpr size_t WS_CBIAS = WS_ROPE + 2 * MiB;
constexpr size_t WS_MEMN = WS_CBIAS + KiB64;
constexpr size_t WS_HIDK = WS_MEMN + 1 * MiB;
constexpr size_t WS_HIDV = WS_HIDK + 1 * MiB;
constexpr size_t WS_GATES = WS_HIDV + 1 * MiB;
constexpr size_t WS_XN = 60 * MiB;
constexpr size_t WS_YB = 92 * MiB;
constexpr size_t WS_D = 124 * MiB;
constexpr size_t WS_HB = WS_D;
constexpr size_t WS_QB = WS_D;
constexpr size_t WS_KS = WS_D + 16 * MiB;
constexpr size_t WS_KW = WS_D + 20 * MiB;
constexpr size_t WS_KCR = WS_D + 24 * MiB;
constexpr size_t WS_VCR = WS_D + 29 * MiB;
constexpr size_t WS_VST = WS_D + 34 * MiB;
constexpr size_t WS_VWT = WS_D + 38 * MiB;
constexpr size_t WS_RKVA = WS_D + 42 * MiB;
constexpr size_t WS_PRL = WS_D + 106 * MiB;
constexpr size_t WS_AGG = WS_D + 114 * MiB;
constexpr size_t WS_BONUS = WS_KCR;
constexpr size_t WS_END = 256 * MiB;
constexpr size_t WS_QM = WS_D;
constexpr size_t WS_OM = WS_D + 32 * MiB;
constexpr size_t WS_MK = WS_D + 64 * MiB;
constexpr size_t WS_MVT = WS_D + 65 * MiB;
static_assert(WS_GATES + (size_t)M_ * 24 * 4 <= WS_XN, "ws map");
static_assert(WS_AGG + 16 * MiB <= WS_END, "ws map");

struct Params {
    const float* in[41];
    float* out;
    unsigned char* ws;
};
enum { I_X = 0, I_MEM, I_F1_PRE, I_F1_WG, I_F1_WU, I_F1_WD, I_F1_POST, I_MIX_PRE, I_WIN, I_PE_K, I_W1_K, I_W2_K, I_PE_V, I_W1_V, I_W2_V,
       I_NSA_G, I_MU, I_W0, I_W2, I_A0, I_A2, I_G2, I_KK, I_KA, I_RK, I_GNG, I_GNB, I_WOUT, I_MIX_POST, I_MEM_PRE, I_MEM_KVG, I_WQ, I_WK, I_WV,
       I_WO, I_MEM_POST, I_F2_PRE, I_F2_WG, I_F2_WU, I_F2_WD, I_F2_POST };

struct MapPlain { const float* W; int N; int pad; __device__ const float* col(int p) const { return W + p; } };
struct MapGU {
    const float* Wg; const float* Wu; int N; int pad;
    __device__ const float* col(int p) const {
        const int pn = p >> 8, q = p & 255, n = (q >> 4) & 1;
        const int hid = 128 * pn + 64 * (q >> 7) + 16 * ((q >> 5) & 3) + (q & 15);
        return Wg + (size_t)n * (size_t)(Wu - Wg) + hid;
    }
};
__host__ __device__ inline int rope_perm(int x) { return 16 * ((x >> 5) & 1) + (x & 15) + 32 * ((x >> 4) & 1); }
struct MapWin {
    const float* W; int N; int pad;
    __device__ const float* col(int p) const {
        int l;
        if (p < 512) l = (p & ~63) + rope_perm(p & 63);
        else if (p < 640) l = 768 + ((p - 512) & ~63) + rope_perm(p & 63);
        else if (p < 768) l = 1024 + ((p - 640) & ~63) + rope_perm(p & 63);
        else if (p < 896) l = 512 + (p - 768);
        else if (p < 1024) l = 640 + (p - 896);
        else if (p < 1152) l = 896 + (p - 1024);
        else if (p < 1280) l = 1152 + (p - 1152);
        else if (p < 2304) { const int q = p - 1280; l = 1304 + (((q >> 4) & 1) ? 512 : 0) + 16 * (q >> 5) + (q & 15); }
        else if (p < 3072) l = 1304 + (p - 1280);
        else if (p < 3096) l = 1280 + (p - 3072);
        else return nullptr;
        return W + l;
    }
};

#define FOR_VB(vb, n) for (int vb = (int)blockIdx.x * 2 + (T512 >> 8); vb < (n); vb += (int)gridDim.x * 2)

template <class Map> __device__ __forceinline__ void d_convert(bf16* WT, int Np, int K, Map map) {
    const int T512 = tidx(), tid = T512 & 255, nbx = Np / 64, nb = nbx * (K / 64);
    FOR_VB(vb, nb) {
        const int p = (vb % nbx) * 64 + (tid & 63), k0 = (vb / nbx) * 64 + (tid >> 6) * 16;
        const float* src = map.col(p);
        float v[16];
#pragma unroll
        for (int i = 0; i < 16; ++i) v[i] = src ? src[(size_t)(k0 + i) * map.N] : 0.f;
        u32x4 a, b;
        a.x = pk2(v[0], v[1]); a.y = pk2(v[2], v[3]); a.z = pk2(v[4], v[5]); a.w = pk2(v[6], v[7]);
        b.x = pk2(v[8], v[9]); b.y = pk2(v[10], v[11]); b.z = pk2(v[12], v[13]); b.w = pk2(v[14], v[15]);
        u32x4* dst = (u32x4*)(WT + (size_t)p * K + k0);
        dst[0] = a; dst[1] = b;
    }
}
__device__ __forceinline__ void d_convert_lora(bf16* WT, const float* w2, const float* a2, const float* g2) {
    const int T512 = tidx(), tid = T512 & 255;
    FOR_VB(vb, NLORA * KLORA / 256) {
        const int idx = vb * 256 + tid, p = idx >> 8, k = idx & 255;
        float v = 0.f;
        if (p < 512) { if (k < 64) v = w2[k * 512 + p]; }
        else if (p < 1024) { if (k >= 64 && k < 128) v = a2[(k - 64) * 512 + (p - 512)]; }
        else { if (k >= 128) v = g2[(k - 128) * 512 + (p - 1024)]; }
        WT[idx] = (bf16)f2bf(v);
    }
}
__device__ __forceinline__ void d_rope_table(float* tab) {
    const int T512 = tidx(), tid = T512 & 255;
    FOR_VB(vb, T_ * 32 / 256) {
        const int idx = vb * 256 + tid, pos = idx >> 5, i = idx & 31;
        const float inv = (float)pow(10000.0, -(double)i / 32.0);
        const float ang = (float)pos * inv;
        tab[2 * idx] = (float)cos((double)ang); tab[2 * idx + 1] = (float)sin((double)ang);
    }
}
__device__ __forceinline__ void d_cmp_bias(const float* pe_k, const float* w1_k, const float* pe_v, const float* w1_v, float* bias, float* red  ) {
    for (int job = blockIdx.x; job < 8; job += gridDim.x) {
        const int kv = job >> 2; const float* pe = kv ? pe_v : pe_k; const float* w1 = kv ? w1_v : w1_k;
        const int T512 = tidx(), lane = T512 & 63, w = T512 >> 6, n = (job & 3) * 64 + lane;
        float s = 0.f;
        for (int j = w * 256; j < w * 256 + 256; ++j) s += pe[j] * w1[(size_t)j * 256 + n];
        red[w * 64 + lane] = s; __syncthreads();
        if (w == 0) { float t = 0.f; for (int i = 0; i < 8; ++i) t += red[i * 64 + lane]; bias[kv * 256 + n] = t; }
        __syncthreads();
    }
}
__device__ __forceinline__ void d_rownorm(const float* x, const float* g, bf16* xn, int rows) {
    const int T512 = tidx(), tid = T512 & 255, lane = tid & 63;
    FOR_VB(vb, rows / 4) {
        const int row = vb * 4 + (tid >> 6);
        const f32x4* xr = (const f32x4*)(x + (size_t)row * DM) + lane; f32x4 v[4]; float s = 0.f;
#pragma unroll
        for (int j = 0; j < 4; ++j) { v[j] = xr[64 * j]; s += v[j][0] * v[j][0] + v[j][1] * v[j][1] + v[j][2] * v[j][2] + v[j][3] * v[j][3]; }
        const float rstd = rsqrtf(wave_sum(s) * (1.f / DM) + NORM_EPS);
#pragma unroll
        for (int j = 0; j < 4; ++j) { const f32x4 gg = ((const f32x4*)g)[lane + 64 * j]; st_bf4(xn + (size_t)row * DM + 4 * (lane + 64 * j), v[j] * rstd * gg); }
    }
}
__device__ __forceinline__ void d_rowpass(const float* xin, const bf16* y, const float* gpost, float coef, const float* gpre, float* xout, bf16* xn) {
    const int T512 = tidx(), tid = T512 & 255, lane = tid & 63;
    FOR_VB(vb, M_ / 4) {
        const int row = vb * 4 + (tid >> 6);
        f32x4 yv[4], xv[4]; float s = 0.f;
#pragma unroll
        for (int j = 0; j < 4; ++j) {
            const u32x2 w = *(const u32x2*)(y + (size_t)row * DM + 4 * (lane + 64 * j));
            yv[j][0] = __builtin_bit_cast(float, w.x << 16); yv[j][1] = __builtin_bit_cast(float, w.x & 0xffff0000u);
            yv[j][2] = __builtin_bit_cast(float, w.y << 16); yv[j][3] = __builtin_bit_cast(float, w.y & 0xffff0000u);
            s += yv[j][0] * yv[j][0] + yv[j][1] * yv[j][1] + yv[j][2] * yv[j][2] + yv[j][3] * yv[j][3];
            xv[j] = ((const f32x4*)(xin + (size_t)row * DM))[lane + 64 * j];
        }
        const float rstd = rsqrtf(wave_sum(s) * (1.f / DM) + NORM_EPS) * coef; float s2 = 0.f;
#pragma unroll
        for (int j = 0; j < 4; ++j) { const f32x4 gg = ((const f32x4*)gpost)[lane + 64 * j]; xv[j] = xv[j] + yv[j] * rstd * gg;
            s2 += xv[j][0] * xv[j][0] + xv[j][1] * xv[j][1] + xv[j][2] * xv[j][2] + xv[j][3] * xv[j][3];
            ((f32x4*)(xout + (size_t)row * DM))[lane + 64 * j] = xv[j]; }
        if (gpre) {
            const float r2 = rsqrtf(wave_sum(s2) * (1.f / DM) + NORM_EPS);
#pragma unroll
            for (int j = 0; j < 4; ++j) { const f32x4 gg = ((const f32x4*)gpre)[lane + 64 * j]; st_bf4(xn + (size_t)row * DM + 4 * (lane + 64 * j), xv[j] * r2 * gg); }
        }
    }
}
__device__ __forceinline__ void d_nsa_outnorm(bf16* amix, const float* g) {
    const int T512 = tidx(), tid = T512 & 255, lane = tid & 63;
    FOR_VB(vb, M_ / 4) {
        const int row = vb * 4 + (tid >> 6);
        bf16* p = amix + (size_t)row * DM + 8 * lane;
        const u32x4 w = *(const u32x4*)p; float v[8]; float s = 0.f;
        v[0] = __builtin_bit_cast(float, w.x << 16); v[1] = __builtin_bit_cast(float, w.x & 0xffff0000u);
        v[2] = __builtin_bit_cast(float, w.y << 16); v[3] = __builtin_bit_cast(float, w.y & 0xffff0000u);
        v[4] = __builtin_bit_cast(float, w.z << 16); v[5] = __builtin_bit_cast(float, w.z & 0xffff0000u);
        v[6] = __builtin_bit_cast(float, w.w << 16); v[7] = __builtin_bit_cast(float, w.w & 0xffff0000u);
#pragma unroll
        for (int i = 0; i < 8; ++i) s += v[i] * v[i];
        const float rstd = rsqrtf(wave_sum(s) * (1.f / 512.f) + NORM_EPS);
        u32x4 o; const float* gg = g + 8 * lane;
        o.x = pk2(v[0] * rstd * gg[0], v[1] * rstd * gg[1]); o.y = pk2(v[2] * rstd * gg[2], v[3] * rstd * gg[3]);
        o.z = pk2(v[4] * rstd * gg[4], v[5] * rstd * gg[5]); o.w = pk2(v[6] * rstd * gg[6], v[7] * rstd * gg[7]);
        *(u32x4*)p = o;
    }
}

struct EpiStore { bf16* O; int ldc; float scale;
    static constexpr int NCAT = 1;
    __device__ __forceinline__ int cat(int) const { return 0; }
    template <int C> __device__ __forceinline__ void apply(int row, int p, f32x4 v0, f32x4 v1) const { bf16* o = O + (size_t)row * ldc + p; st_bf4(o, v0 * scale); st_bf4(o + 16, v1 * scale); } };
struct EpiSwiGLU { bf16* H;
    static constexpr int NCAT = 1;
    __device__ __forceinline__ int cat(int) const { return 0; }
    template <int C> __device__ __forceinline__ void apply(int row, int p, f32x4 g, f32x4 u) const {
        const int q = p & 255, hid = 128 * (p >> 8) + 64 * (q >> 7) + 16 * ((q >> 5) & 3) + (q & 15);
        f32x4 h;
#pragma unroll
        for (int e = 0; e < 4; ++e) h[e] = g[e] / (1.f + __expf(-g[e])) * u[e];
        st_bf4(H + (size_t)row * FF + hid, h); } };
struct EpiBiasSilu { bf16* O; const float* bias;
    static constexpr int NCAT = 1;
    __device__ __forceinline__ int cat(int) const { return 0; }
    template <int C> __device__ __forceinline__ void apply(int row, int p, f32x4 v0, f32x4 v1) const {
        f32x4 a, b; const f32x4 b0 = *(const f32x4*)(bias + p), b1 = *(const f32x4*)(bias + p + 16);
#pragma unroll
        for (int e = 0; e < 4; ++e) { const float x0 = v0[e] + b0[e], x1 = v1[e] + b1[e]; a[e] = x0 / (1.f + __expf(-x0)); b[e] = x1 / (1.f + __expf(-x1)); }
        bf16* o = O + (size_t)row * 256 + p; st_bf4(o, a); st_bf4(o + 16, b); } };
struct EpiLora { float* wdec; bf16* aga; bf16* agg; const float* w0; const float* a0;
    static constexpr int NCAT = 3;
    __device__ __forceinline__ int cat(int p0) const { return p0 < 512 ? 0 : (p0 < 1024 ? 1 : 2); }
    template <int C> __device__ __forceinline__ void one(int row, int p, f32x4 v) const {
        if (C == 0) { f32x4 o; const f32x4 ww = *(const f32x4*)(w0 + p);
#pragma unroll
            for (int e = 0; e < 4; ++e) o[e] = __expf(-0.6065306597126334f * sigmoidf_(ww[e] + v[e]));
            *(f32x4*)(wdec + (size_t)row * 512 + p) = o;
        } else if (C == 1) { f32x4 o; const f32x4 aa = *(const f32x4*)(a0 + p - 512);
#pragma unroll
            for (int e = 0; e < 4; ++e) o[e] = sigmoidf_(aa[e] + v[e]);
            st_bf4(aga + (size_t)row * 512 + (p - 512), o);
        } else st_bf4(agg + (size_t)row * 512 + (p - 1024), v);
    }
    template <int C> __device__ __forceinline__ void apply(int row, int p, f32x4 v0, f32x4 v1) const { one<C>(row, p, v0); one<C>(row, p + 16, v1); } };
struct EpiWin {
    bf16 *qb, *ks, *kw, *kcr, *vcr, *vst, *vwt; unsigned* rk; bf16 *vv, *prl; float* gates; const float* rope;
    static constexpr int NCAT = 8;
    __device__ __forceinline__ int cat(int p0) const { return p0 < 512 ? 0 : (p0 < 768 ? 1 : (p0 < 1024 ? 2 : (p0 < 1280 ? 3 : (p0 < 2304 ? 4 : (p0 < 2816 ? 7 : (p0 < 3072 ? 6 : 5)))))); }
    template <int C> __device__ __forceinline__ void apply(int row, int p, f32x4 v0, f32x4 v1) const {
        const int b = row / T_, t = row % T_;
        if (C == 0 || C == 1) {
            const int x = p & 63, d = 16 * ((x >> 5) & 1) + (x & 15);
            const f32x4* rp = (const f32x4*)(rope + ((size_t)t * 32 + d) * 2); const f32x4 r0 = rp[0], r1 = rp[1];
            const f32x4 cs = {r0[0], r0[2], r1[0], r1[2]}, sn = {r0[1], r0[3], r1[1], r1[3]};
            const f32x4 lo = v0 * cs - v1 * sn, hi = v0 * sn + v1 * cs;
            if (C == 0) { bf16* o = qb + (size_t)row * 512 + (p & ~63) + d; st_bf4(o, lo * QSCALE); st_bf4(o + 32, hi * QSCALE); }
            else { const int g = ((p - 512) >> 6) & 1; bf16* base = (p < 640) ? ks : kw; bf16* o = base + ((size_t)(b * 2 + g) * T_ + t) * 64 + d; st_bf4(o, lo); st_bf4(o + 32, hi); }
        } else if (C == 2) {
            const int c = (p - 768) & 127, g = c >> 6, d = c & 63; bf16* base = (p < 896) ? kcr : vcr;
            bf16* o = base + ((size_t)(b * 2 + g) * T_ + t) * 64 + d; st_bf4(o, v0); st_bf4(o + 16, v1);
        } else if (C == 3) {
            const int c = (p - 1024) & 127, g = c >> 6, d = c & 63; bf16* base = (p < 1152) ? vst : vwt;
            bf16* o = base + ((size_t)(b * 2 + g) * 64 + d) * T_ + t;
#pragma unroll
            for (int e = 0; e < 4; ++e) { o[(size_t)e * T_] = (bf16)f2bf(v0[e]); o[(size_t)(16 + e) * T_] = (bf16)f2bf(v1[e]); }
        } else if (C == 4) {
            const int q = p - 1280, ch = 16 * (q >> 5) + (q & 15);
            u32x4 w; w.x = pk2(v0[0], v1[0]); w.y = pk2(v0[1], v1[1]); w.z = pk2(v0[2], v1[2]); w.w = pk2(v0[3], v1[3]);
            *(u32x4*)(rk + (size_t)row * 512 + ch) = w;
        } else if (C == 7) {
            bf16* o = vv + (size_t)row * 512 + (p - 2304); st_bf4(o, v0); st_bf4(o + 16, v1);
        } else if (C == 6) {
            bf16* o = prl + (size_t)row * 256 + (p - 2816); st_bf4(o, v0); st_bf4(o + 16, v1);
        } else {
            const int c = p - 3072; float* o = gates + (size_t)row * 24 + c;
            if (c < 24) { f32x4 s = {sigmoidf_(v0[0]), sigmoidf_(v0[1]), sigmoidf_(v0[2]), sigmoidf_(v0[3])}; *(f32x4*)o = s; }
            if (c + 16 < 24) { f32x4 s = {sigmoidf_(v1[0]), sigmoidf_(v1[1]), sigmoidf_(v1[2]), sigmoidf_(v1[3])}; *(f32x4*)(o + 16) = s; }
        }
    }
};

namespace pg8 {
#define PG8_LAS __attribute__((address_space(3)))
typedef unsigned short bf16_t;
typedef short bf16x8 __attribute__((ext_vector_type(8)));
typedef float f32x4 __attribute__((ext_vector_type(4)));
typedef unsigned u32x4 __attribute__((ext_vector_type(4)));
constexpr int BM = 256, BK = 64, HALF = 128, HTB = HALF * BK * 2  , STAGE_BYTES = 8 * HTB, NXCD = 8, WGM = 8;

__host__ __device__ __forceinline__ int lds_byte(int r, int c) { const int st = (r >> 4) * 2 + (c >> 5), rr = r & 15, cc = c & 31, ob = rr * 64 + cc * 2; return st * 1024 + (ob ^ (((ob >> 9) & 1) << 5)); }
__host__ __device__ __forceinline__ void stage_rc(int b, int& R, int& C) { const int st = b / 1024, sb = b % 1024, swz = sb ^ (((sb >> 9) & 1) << 5); R = (st >> 1) * 16 + swz / 64; C = (st & 1) * 32 + (swz % 64) / 2; }
__host__ __device__ __forceinline__ int perm32(int rho) { const int n = rho >> 4, i = rho & 15; return 8 * (i >> 2) + 4 * n + (i & 3); }

struct Unit { int pm, pn; };
struct Gemm { const bf16_t* A; const bf16_t* Bt; int M, N, K, lda, ldb; };

struct StaticOrder {
    int nM, nN, nwg, G, c;
    __host__ __device__ void init(int M, int N, int G_, int c_) { nM = M / BM; nN = N / BM; nwg = nM * nN; G = G_; c = c_; }
    __host__ __device__ bool next(int i, Unit& u) const {
        const long L = (long)i * G + c; if (L >= nwg) return false;
        int wgid = (int)L; { const int q = nwg / NXCD, r = nwg % NXCD, xcd = wgid % NXCD, off = wgid / NXCD; wgid = (xcd < r ? xcd * (q + 1) : r * (q + 1) + (xcd - r) * q) + off; }
        const int nig = WGM * nN, gid = wgid / nig, fm = gid * WGM, gsz = (nM - fm) < WGM ? (nM - fm) : WGM;
        u.pm = fm + ((wgid % nig) % gsz); u.pn = (wgid % nig) / gsz; return true;
    }
    __device__ __forceinline__ void a_ready(const Unit&) const {}
    __device__ __forceinline__ void done(const Unit&) const {}
};

template <class Epi, class Sched, bool ALIGN_EPI = false, bool SP2 = false>
__device__ __forceinline__ void gemm_phase(PG8_LAS unsigned char* lds, const Gemm g, const Sched& S, const Epi& E) {
    const int tid = tidx(), wid = __builtin_amdgcn_readfirstlane(tid >> 6), lane = tid & 63, wr = wid >> 2, wc = wid & 3, fr = lane & 15, fq = lane >> 4;
    const int K = g.K, nt = K / BK;
    unsigned voffA[2], voffB[2];
#pragma unroll
    for (int i = 0; i < 2; ++i) { int R, C; stage_rc(tid * 16 + i * 8192, R, C); const int Rb = Epi::PERM ? ((R & ~31) + perm32(R & 31)) : R;
        voffA[i] = (unsigned)(R * g.lda + C) * 2u; voffB[i] = (unsigned)(Rb * g.ldb + C) * 2u; }
    const size_t kstep = (size_t)(BK * 2);
    const size_t hstepA = (size_t)HALF * g.lda * 2, hstepB = (size_t)HALF * g.ldb * 2;
    const size_t tstepA = 2 * hstepA, tstepB = 2 * hstepB;
    const unsigned ldsw = (unsigned)wid * 1024u;
    const int aoff = lds_byte(wr * 64 + fr, fq * 8), boff = lds_byte(wc * 32 + fr, fq * 8);
#define PG8_SA(b, h) (((b) * 2 + (h)) * HTB)
#define PG8_SB(b, h) ((4 + (b) * 2 + (h)) * HTB)
#define PG8_STAGE(bufoff, gbase, voff) do { _Pragma("unroll") for (int _i = 0; _i < 2; ++_i) \
        __builtin_amdgcn_global_load_lds((const unsigned*)((const char*)(gbase) + (voff)[_i]), (PG8_LAS unsigned*)(lds + (bufoff) + ldsw + _i * 8192), 16, 0, 0); } while (0)
#define PG8_LDA(dst, b, h) do { _Pragma("unroll") for (int m = 0; m < 4; ++m) _Pragma("unroll") for (int k = 0; k < 2; ++k) dst[m][k] = *(const PG8_LAS bf16x8*)(lds + PG8_SA(b, h) + aoff + m * 2048 + k * 1024); } while (0)
#define PG8_LDB(dst, b, h) do { _Pragma("unroll") for (int n = 0; n < 2; ++n) _Pragma("unroll") for (int k = 0; k < 2; ++k) dst[n][k] = *(const PG8_LAS bf16x8*)(lds + PG8_SB(b, h) + boff + n * 2048 + k * 1024); } while (0)
#define PG8_MMA(ai, bj, At, Bt) do { __builtin_amdgcn_s_setprio(1); _Pragma("unroll") for (int m = 0; m < 4; ++m) _Pragma("unroll") for (int n = 0; n < 2; ++n) _Pragma("unroll") for (int k = 0; k < 2; ++k) \
        acc[ai][bj][m][n] = __builtin_amdgcn_mfma_f32_16x16x32_bf16(Bt[n][k], At[m][k], acc[ai][bj][m][n], 0, 0, 0); __builtin_amdgcn_s_setprio(0); } while (0)
#define PG8_WAIT_V(n) asm volatile("s_waitcnt vmcnt(" #n ")" ::: "memory")
#define PG8_WAIT_L(n) asm volatile("s_waitcnt lgkmcnt(" #n ")" ::: "memory")
#define PG8_BAR __builtin_amdgcn_s_barrier()
#define PG8_SCHED __builtin_amdgcn_sched_barrier(0)
    Unit cur, nxt; int ui = 0;
    if (!S.next(0, cur)) return;
    f32x4 acc[2][2][4][2];
#pragma unroll
    for (int a = 0; a < 2; ++a)
#pragma unroll
        for (int b = 0; b < 2; ++b)
#pragma unroll
            for (int m = 0; m < 4; ++m)
#pragma unroll
                for (int n = 0; n < 2; ++n) acc[a][b][m][n] = (f32x4){0.f, 0.f, 0.f, 0.f};
    bf16x8 At[4][2], B0[2][2], B1[2][2];
    const char* cA = (const char*)g.A + (size_t)cur.pm * tstepA; const char* cB = (const char*)g.Bt + (size_t)cur.pn * tstepB;
    S.a_ready(cur);
    if constexpr (SP2) {
        PG8_STAGE(PG8_SB(0, 0), cB, voffB); PG8_STAGE(PG8_SB(0, 1), cB + hstepB, voffB); PG8_STAGE(PG8_SA(0, 0), cA, voffA); PG8_STAGE(PG8_SA(0, 1), cA + hstepA, voffA);
        if (wr == 1) PG8_BAR;
        PG8_WAIT_V(2); PG8_BAR;
        PG8_STAGE(PG8_SB(1, 0), cB + kstep, voffB); PG8_STAGE(PG8_SA(1, 0), cA + kstep, voffA); PG8_STAGE(PG8_SB(1, 1), cB + hstepB + kstep, voffB);
        PG8_WAIT_V(6); PG8_BAR;
    } else {
        PG8_STAGE(PG8_SB(0, 0), cB, voffB); PG8_STAGE(PG8_SA(0, 0), cA, voffA); PG8_STAGE(PG8_SB(0, 1), cB + hstepB, voffB); PG8_STAGE(PG8_SA(0, 1), cA + hstepA, voffA);
        if (wr == 1) PG8_BAR;
        PG8_WAIT_V(4); PG8_BAR;
        PG8_STAGE(PG8_SB(1, 0), cB + kstep, voffB); PG8_STAGE(PG8_SA(1, 0), cA + kstep, voffA); PG8_STAGE(PG8_SB(1, 1), cB + hstepB + kstep, voffB);
        PG8_WAIT_V(6); PG8_BAR;
    }
    for (;;) {
        const bool has_next = S.next(ui + 1, nxt);
        const char* nA = has_next ? (const char*)g.A + (size_t)nxt.pm * tstepA : cA; const char* nB = has_next ? (const char*)g.Bt + (size_t)nxt.pn * tstepB : cB;
        for (int t = 0; t < nt; t += 2) {
            const bool last = (t == nt - 2);
            const char* a1 = cA + (size_t)(t + 1) * kstep;
            const char* a2 = last ? nA : cA + (size_t)(t + 2) * kstep; const char* b2 = last ? nB : cB + (size_t)(t + 2) * kstep;
            const char* a3 = a2 + kstep; const char* b3 = b2 + kstep;
            if (last && has_next) S.a_ready(nxt);
            if constexpr (SP2) {
            PG8_LDB(B0, 0, 0); PG8_LDB(B1, 0, 1); PG8_SCHED; PG8_LDA(At, 0, 0); PG8_STAGE(PG8_SA(1, 1), a1 + hstepA, voffA);
            PG8_WAIT_V(8); PG8_WAIT_L(0); PG8_BAR; PG8_MMA(0, 0, At, B0); PG8_MMA(0, 1, At, B1); PG8_BAR; PG8_SCHED;
            PG8_LDA(At, 0, 1); PG8_STAGE(PG8_SB(0, 0), b2, voffB); PG8_STAGE(PG8_SB(0, 1), b2 + hstepB, voffB); PG8_STAGE(PG8_SA(0, 0), a2, voffA);
            PG8_WAIT_V(8); PG8_WAIT_L(0); PG8_BAR; PG8_MMA(1, 0, At, B0); PG8_MMA(1, 1, At, B1); PG8_BAR; PG8_SCHED;
            PG8_LDB(B0, 1, 0); PG8_LDB(B1, 1, 1); PG8_SCHED; PG8_LDA(At, 1, 0); PG8_STAGE(PG8_SA(0, 1), a2 + hstepA, voffA);
            PG8_WAIT_V(8); PG8_WAIT_L(0); PG8_BAR; PG8_MMA(0, 0, At, B0); PG8_MMA(0, 1, At, B1); PG8_BAR; PG8_SCHED;
            PG8_LDA(At, 1, 1); PG8_STAGE(PG8_SB(1, 0), b3, voffB); PG8_STAGE(PG8_SB(1, 1), b3 + hstepB, voffB); PG8_STAGE(PG8_SA(1, 0), a3, voffA);
            PG8_WAIT_V(8); PG8_WAIT_L(0); PG8_BAR; PG8_MMA(1, 0, At, B0); PG8_MMA(1, 1, At, B1); PG8_BAR; PG8_SCHED;
            } else {
            PG8_LDB(B0, 0, 0); PG8_SCHED; PG8_LDA(At, 0, 0); PG8_STAGE(PG8_SA(1, 1), a1 + hstepA, voffA);
            PG8_WAIT_L(8); PG8_BAR; PG8_WAIT_L(0); PG8_MMA(0, 0, At, B0); PG8_BAR; PG8_SCHED;
            PG8_LDB(B1, 0, 1); PG8_STAGE(PG8_SB(0, 0), b2, voffB);
            PG8_BAR; PG8_WAIT_L(0); PG8_MMA(0, 1, At, B1); PG8_BAR;
            PG8_LDA(At, 0, 1); PG8_STAGE(PG8_SA(0, 0), a2, voffA);
            PG8_BAR; PG8_WAIT_L(0); PG8_MMA(1, 0, At, B0); PG8_BAR; PG8_SCHED;
            PG8_STAGE(PG8_SB(0, 1), b2 + hstepB, voffB);
            PG8_WAIT_V(6); PG8_BAR; PG8_MMA(1, 1, At, B1); PG8_BAR;
            PG8_LDB(B0, 1, 0); PG8_SCHED; PG8_LDA(At, 1, 0); PG8_STAGE(PG8_SA(0, 1), a2 + hstepA, voffA);
            PG8_WAIT_L(8); PG8_BAR; PG8_WAIT_L(0); PG8_MMA(0, 0, At, B0); PG8_BAR; PG8_SCHED;
            PG8_LDB(B1, 1, 1); PG8_STAGE(PG8_SB(1, 0), b3, voffB);
            PG8_BAR; PG8_WAIT_L(0); PG8_MMA(0, 1, At, B1); PG8_BAR;
            PG8_LDA(At, 1, 1); PG8_STAGE(PG8_SA(1, 0), a3, voffA);
            PG8_BAR; PG8_WAIT_L(0); PG8_MMA(1, 0, At, B0); PG8_BAR; PG8_SCHED;
            PG8_STAGE(PG8_SB(1, 1), b3 + hstepB, voffB);
            PG8_WAIT_V(6); PG8_BAR; PG8_MMA(1, 1, At, B1); PG8_BAR;
            }
        }
        if constexpr (ALIGN_EPI) { if (wr == 0) PG8_BAR; }
        if constexpr (!Epi::AFTER_DRAIN) { E(acc, cur, wr, wc, fr, fq); S.done(cur); }
        if (!has_next) break;
#pragma unroll
        for (int a = 0; a < 2; ++a)
#pragma unroll
            for (int b = 0; b < 2; ++b)
#pragma unroll
                for (int m = 0; m < 4; ++m)
#pragma unroll
                    for (int n = 0; n < 2; ++n) acc[a][b][m][n] = (f32x4){0.f, 0.f, 0.f, 0.f};
        cur = nxt; cA = nA; cB = nB; ++ui;
        if constexpr (ALIGN_EPI) { if (wr == 1) PG8_BAR; }
    }
    PG8_WAIT_V(0);
    if constexpr (!ALIGN_EPI) { if (wr == 0) PG8_BAR; }
    PG8_BAR;
    if constexpr (Epi::AFTER_DRAIN) { E.fused(acc, cur, wr, wc, fr, fq, lds, wid, lane); S.done(cur); }
#undef PG8_SA
#undef PG8_SB
#undef PG8_STAGE
#undef PG8_LDA
#undef PG8_LDB
#undef PG8_MMA
#undef PG8_WAIT_V
#undef PG8_WAIT_L
#undef PG8_BAR
#undef PG8_SCHED
}
}

template <class F> struct EpiQuad {
    static constexpr bool PERM = false, AFTER_DRAIN = false;
    F f;
    template <int C, int BJ> __device__ __forceinline__ void half(const pg8::f32x4 (&acc)[2][2][4][2], int row0, int p) const {
#pragma unroll
        for (int ai = 0; ai < 2; ++ai)
#pragma unroll
            for (int m = 0; m < 4; ++m) { f.template apply<C>(row0 + ai * 128 + m * 16, p, acc[ai][BJ][m][0], acc[ai][BJ][m][1]); asm volatile("" ::: "memory"); }
    }
    template <int BJ> __device__ __forceinline__ void disp(const pg8::f32x4 (&acc)[2][2][4][2], int row0, int p0, int p) const {
        const int c = f.cat(p0);
        if (F::NCAT == 1 || c == 0) half<0, BJ>(acc, row0, p);
        else if (F::NCAT > 1 && c == 1) half<(F::NCAT > 1 ? 1 : 0), BJ>(acc, row0, p);
        else if (F::NCAT > 2 && c == 2) half<(F::NCAT > 2 ? 2 : 0), BJ>(acc, row0, p);
        else if (F::NCAT > 3 && c == 3) half<(F::NCAT > 3 ? 3 : 0), BJ>(acc, row0, p);
        else if (F::NCAT > 4 && c == 4) half<(F::NCAT > 4 ? 4 : 0), BJ>(acc, row0, p);
        else if (F::NCAT > 5 && c == 5) half<(F::NCAT > 5 ? 5 : 0), BJ>(acc, row0, p);
        else if (F::NCAT > 6 && c == 6) half<(F::NCAT > 6 ? 6 : 0), BJ>(acc, row0, p);
        else if (F::NCAT > 7) half<(F::NCAT > 7 ? 7 : 0), BJ>(acc, row0, p);
    }
    __device__ __forceinline__ void operator()(const pg8::f32x4 (&acc)[2][2][4][2], const pg8::Unit& u, int wr, int wc, int fr, int fq) const {
        const int row0 = u.pm * 256 + wr * 64 + fr, p0 = u.pn * 256;
        disp<0>(acc, row0, p0, p0 + wc * 32 + 4 * fq);
        disp<1>(acc, row0, p0 + 128, p0 + 128 + wc * 32 + 4 * fq);
    }
};
template <class F> __device__ __forceinline__ void gemm_pg8(unsigned char* lds, const bf16* A, int lda, const bf16* Bt, int ldb, int M, int N, int K, const F& f) {
    pg8::Gemm g{A, Bt, M, N, K, lda, ldb}; pg8::StaticOrder S; S.init(M, N, (int)gridDim.x, (int)blockIdx.x);
    EpiQuad<F> E{f};
    pg8::gemm_phase<EpiQuad<F>, pg8::StaticOrder, true, true>((PG8_LAS unsigned char*)lds, g, S, E);
}

namespace cg = cooperative_groups;
struct EpiNormRes {
    static constexpr bool PERM = false, AFTER_DRAIN = true;
    const float* xin; float* xout; bf16* xn; const float* gpost; const float* gpre; float coef; unsigned* part; unsigned* cnt;
    __device__ __forceinline__ void operator()(const pg8::f32x4 (&)[2][2][4][2], const pg8::Unit&, int, int, int, int) const {}
    __device__ __forceinline__ void rowstat(const pg8::f32x4 (&acc)[2][2][4][2], float* P, int wr, int wc, int fr, int fq) const {
#pragma unroll
        for (int ai = 0; ai < 2; ++ai)
#pragma unroll
            for (int m = 0; m < 4; ++m) { float sq = 0.f;
#pragma unroll
                for (int bj = 0; bj < 2; ++bj)
#pragma unroll
                    for (int n = 0; n < 2; ++n) { const pg8::f32x4 v = acc[ai][bj][m][n]; sq += (v[0] * v[0] + v[1] * v[1]) + (v[2] * v[2] + v[3] * v[3]); }
                sq += __shfl_xor(sq, 16); sq += __shfl_xor(sq, 32);
                if (fq == 0) P[(ai * 128 + wr * 64 + m * 16 + fr) * 4 + wc] = sq; }
    }
    __device__ __forceinline__ void exchange(float* P, float* S, unsigned* bank, unsigned* cnt, const pg8::Unit& u, int tid, float scale) const {
        __syncthreads();
        if (tid < 256) { const f32x4 p = *(const f32x4*)(P + tid * 4);
            __hip_atomic_store(bank + (size_t)(u.pm * 256 + tid) * 4 + u.pn, __builtin_bit_cast(unsigned, (p[0] + p[1]) + (p[2] + p[3])), __ATOMIC_RELAXED, __HIP_MEMORY_SCOPE_AGENT); }
        asm volatile("s_waitcnt vmcnt(0)" ::: "memory");
        __syncthreads();
        if (tid == 0) { unsigned* c = cnt + u.pm * 16; __hip_atomic_fetch_add(c, 1u, __ATOMIC_RELAXED, __HIP_MEMORY_SCOPE_AGENT);
            while (__hip_atomic_load(c, __ATOMIC_RELAXED, __HIP_MEMORY_SCOPE_AGENT) < 4u) __builtin_amdgcn_s_sleep(1); }
        __syncthreads();
        if (tid < 256) { const unsigned* b = bank + (size_t)(u.pm * 256 + tid) * 4; float q = 0.f;
#pragma unroll
            for (int j = 0; j < 4; ++j) q += __builtin_bit_cast(float, __hip_atomic_load(b + j, __ATOMIC_RELAXED, __HIP_MEMORY_SCOPE_AGENT));
            S[tid] = rsqrtf(q * (1.f / DM) + NORM_EPS) * scale; }
        __syncthreads();
    }
    __device__ __forceinline__ void fused(pg8::f32x4 (&acc)[2][2][4][2], const pg8::Unit& u, int wr, int wc, int fr, int fq, PG8_LAS unsigned char* lds, int wid, int lane) const {
        float* P = (float*)lds; float* S = P + 1024; const int tid = wid * 64 + lane;
        rowstat(acc, P, wr, wc, fr, fq);
        exchange(P, S, part, cnt, u, tid, coef);
        const int col0 = u.pn * 256 + wc * 32 + 4 * fq;
#pragma unroll
        for (int ai = 0; ai < 2; ++ai)
#pragma unroll
            for (int m = 0; m < 4; ++m) { const int r = ai * 128 + wr * 64 + m * 16 + fr; const float sr = S[r]; const size_t off = (size_t)(u.pm * 256 + r) * DM + col0;
#pragma unroll
                for (int bj = 0; bj < 2; ++bj)
#pragma unroll
                    for (int n = 0; n < 2; ++n) { const int o = bj * 128 + n * 16; const f32x4 g4 = *(const f32x4*)(gpost + col0 + o), x4 = *(const f32x4*)(xin + off + o);
                        const f32x4 y = x4 + acc[ai][bj][m][n] * sr * g4; acc[ai][bj][m][n] = y; *(f32x4*)(xout + off + o) = y; }
                asm volatile("" ::: "memory"); }
        if (!gpre) return;
        rowstat(acc, P, wr, wc, fr, fq);
        exchange(P, S, part + (size_t)M_ * 4, cnt + 64 * 16, u, tid, 1.f);
#pragma unroll
        for (int ai = 0; ai < 2; ++ai)
#pragma unroll
            for (int m = 0; m < 4; ++m) { const int r = ai * 128 + wr * 64 + m * 16 + fr; const float sr = S[r]; const size_t off = (size_t)(u.pm * 256 + r) * DM + col0;
#pragma unroll
                for (int bj = 0; bj < 2; ++bj)
#pragma unroll
                    for (int n = 0; n < 2; ++n) { const int o = bj * 128 + n * 16; const f32x4 g4 = *(const f32x4*)(gpre + col0 + o); st_bf4(xn + off + o, acc[ai][bj][m][n] * sr * g4); }
                asm volatile("" ::: "memory"); }
    }
};
__device__ __forceinline__ void gemm_norm_res(unsigned char* lds, const bf16* A, int lda, const bf16* Bt, int K, const float* xin, float* xout, bf16* xn, const float* gpost, const float* gpre,
                                              float coef, bf16* ybuf, unsigned* part, unsigned* cnt) {
    pg8::Gemm g{A, Bt, M_, DM, K, lda, K}; pg8::StaticOrder S; S.init(M_, DM, 256, (int)blockIdx.x);
    const EpiNormRes E{xin, xout, xn, gpost, gpre, coef, part, cnt};
    pg8::gemm_phase<EpiNormRes, pg8::StaticOrder, false, true>((PG8_LAS unsigned char*)lds, g, S, E);
}

__device__ __forceinline__ void d_cmp2(const bf16* hidk, const bf16* hidv, const float* w2k, const float* w2v, const float* rope, bf16* kc, bf16* vct) {
    const int T512 = tidx(), tid = T512 & 255;
    FOR_VB(vb, 2048 * 32 / 256) {
        const int idx = vb * 256 + tid; const int R = idx >> 5, i = idx & 31; const int bg = R >> 9, c = R & 511;
        float k0 = 0.f, k1 = 0.f, v0 = 0.f, v1 = 0.f;
        for (int n = 0; n < 256; ++n) { const float hk = bf2f(hidk[(size_t)R * 256 + n]), hv = bf2f(hidv[(size_t)R * 256 + n]);
            k0 += hk * w2k[n * 64 + i]; k1 += hk * w2k[n * 64 + i + 32]; v0 += hv * w2v[n * 64 + i]; v1 += hv * w2v[n * 64 + i + 32]; }
        const int pos = (16 * c + 31) & (T_ - 1);
        const float cs = rope[((size_t)pos * 32 + i) * 2], sn = rope[((size_t)pos * 32 + i) * 2 + 1];
        kc[(size_t)R * 64 + i] = (bf16)f2bf(k0 * cs - k1 * sn); kc[(size_t)R * 64 + i + 32] = (bf16)f2bf(k0 * sn + k1 * cs);
        vct[((size_t)bg * 64 + i) * NCP + c] = (bf16)f2bf(v0); vct[((size_t)bg * 64 + i + 32) * NCP + c] = (bf16)f2bf(v1);
    }
}

struct NsaArgs { const bf16 *qb, *kc, *vct, *ks, *vst, *kw, *vwt; const float* gates; bf16* amix; };
__device__ __forceinline__ float dot64(const float* q, const bf16* k) {
    float s = 0.f;
#pragma unroll
    for (int i = 0; i < 8; ++i) { const u32x4 w = ((const u32x4*)k)[i];
        s += q[8 * i + 0] * __builtin_bit_cast(float, w.x << 16) + q[8 * i + 1] * __builtin_bit_cast(float, w.x & 0xffff0000u)
           + q[8 * i + 2] * __builtin_bit_cast(float, w.y << 16) + q[8 * i + 3] * __builtin_bit_cast(float, w.y & 0xffff0000u)
           + q[8 * i + 4] * __builtin_bit_cast(float, w.z << 16) + q[8 * i + 5] * __builtin_bit_cast(float, w.z & 0xffff0000u)
           + q[8 * i + 6] * __builtin_bit_cast(float, w.w << 16) + q[8 * i + 7] * __builtin_bit_cast(float, w.w & 0xffff0000u); }
    return s;
}
__device__ __forceinline__ void softmax_row(float* s, int n, int lane) {
    float m = -INFINITY; for (int i = lane; i < n; i += 64) m = fmaxf(m, s[i]);
    m = wave_max(m); if (m == -INFINITY) m = 0.f;
    float l = 0.f; for (int i = lane; i < n; i += 64) { const float e = exp2f(s[i] - m); s[i] = e; l += e; }
    l = wave_sum(l); const float inv = 1.f / fmaxf(l, 1e-30f);
    for (int i = lane; i < n; i += 64) s[i] *= inv;
}
__device__ __forceinline__ void d_nsa_simple(const NsaArgs& a, int vb, int tid, unsigned char* smem) {
    float (*qs)[64] = (float (*)[64])smem; float (*sc)[1024] = (float (*)[1024])(smem + 1024); float* imp = (float*)(smem + 17408); float* score = imp + 128;
    int* list = (int*)(score + 128); int* nlist = list + 16;
    const int bg = vb / T_, t = vb % T_, b = bg >> 1, g = bg & 1;
    const int r = tid >> 6, d = tid & 63, lane = d;
    const size_t row = (size_t)b * T_ + t;
    qs[r][d] = bf2f(a.qb[row * 512 + g * 256 + r * 64 + d]);
    if (tid == 0) *nlist = 0;
    __syncthreads();
    const int nv = t < 31 ? 0 : (t - 31) / 16 + 1;
    for (int c = tid; c < nv; c += 256) { const bf16* k = a.kc + ((size_t)bg * NCP + c) * 64;
        _Pragma("unroll 1") for (int rr = 0; rr < 4; ++rr) sc[rr][c] = dot64(qs[rr], k); }
    __syncthreads();
    softmax_row(sc[r], nv, lane);
    __syncthreads();
    float oc = 0.f; { const bf16* v = a.vct + ((size_t)bg * 64 + d) * NCP; for (int c = 0; c < nv; ++c) oc += sc[r][c] * bf2f(v[c]); }
    if (tid < 128) { const int s = tid; float acc = 0.f;
        for (int c = 4 * s - 1; c <= 4 * s + 3; ++c) if (c >= 0 && c < nv) acc += sc[0][c] + sc[1][c] + sc[2][c] + sc[3][c];
        imp[s] = acc; }
    __syncthreads();
    const int cur = t >> 6;
    if (tid < 128) { const int s = tid; const bool forced = (s == 0) || (s == cur) || (s == cur - 1);
        score[s] = forced ? 1e4f : (s <= cur ? imp[s] : -1e4f); }
    __syncthreads();
    if (tid < 128) { const int s = tid; const float my = score[s]; int rank = 0;
        for (int j = 0; j < 128; ++j) { const float o = score[j]; rank += (o > my || (o == my && j < s)) ? 1 : 0; }
        if (rank < 16 && s <= cur) { const int slot = atomicAdd(nlist, 1); list[slot] = s; } }
    __syncthreads();
    const int ns = *nlist * 64;
    for (int i = tid; i < ns; i += 256) { const int pos = list[i >> 6] * 64 + (i & 63);
        if (pos <= t) { const bf16* k = a.ks + ((size_t)bg * T_ + pos) * 64; _Pragma("unroll 1") for (int rr = 0; rr < 4; ++rr) sc[rr][i] = dot64(qs[rr], k); }
        else { sc[0][i] = -INFINITY; sc[1][i] = -INFINITY; sc[2][i] = -INFINITY; sc[3][i] = -INFINITY; } }
    __syncthreads();
    softmax_row(sc[r], ns, lane);
    __syncthreads();
    float os = 0.f; { const bf16* v = a.vst + ((size_t)bg * 64 + d) * T_;
        for (int i = 0; i < ns; ++i) { const int pos = list[i >> 6] * 64 + (i & 63); if (pos <= t) os += sc[r][i] * bf2f(v[pos]); } }
    __syncthreads();
    const int lo = t - 511 > 0 ? t - 511 : 0, nw = t - lo + 1;
    for (int i = tid; i < nw; i += 256) { const bf16* k = a.kw + ((size_t)bg * T_ + lo + i) * 64;
        _Pragma("unroll 1") for (int rr = 0; rr < 4; ++rr) sc[rr][i] = dot64(qs[rr], k); }
    __syncthreads();
    softmax_row(sc[r], nw, lane);
    __syncthreads();
    float ow = 0.f; { const bf16* v = a.vwt + ((size_t)bg * 64 + d) * T_ + lo; for (int i = 0; i < nw; ++i) ow += sc[r][i] * bf2f(v[i]); }
    const float* gt = a.gates + row * 24 + g * 12 + r * 3;
    a.amix[row * DM + g * 256 + r * 64 + d] = (bf16)f2bf(gt[0] * oc + gt[1] * os + gt[2] * ow);
    __syncthreads();
}


namespace nsa {
typedef float f32x16 __attribute__((ext_vector_type(16)));
constexpr int KROW = 144, VROW = 136, KBUF = 64 * KROW, VBUF = 64 * VROW;
constexpr int OFF_K = 0, OFF_V = 2 * KBUF, OFF_IMP = OFF_V + 2 * VBUF, IMPW = 130, OFF_SEL = OFF_IMP + 64 * IMPW * 4, OFF_UM = OFF_SEL + 1024, OFF_WS = OFF_UM + 16, OFF_UNIT = OFF_WS + 1024, LDS_NEED = OFF_UNIT + 16;
static_assert(OFF_IMP % 16 == 0 && OFF_SEL % 16 == 0 && OFF_WS % 16 == 0, "nsa lds map");
__device__ __forceinline__ int crow(int r, int hi) { return (r & 3) + 8 * (r >> 2) + 4 * hi; }
__device__ __forceinline__ int next_bit(unsigned m0, unsigned m1, unsigned m2, unsigned m3, int from) {
#pragma unroll
    for (int wd = 0; wd < 4; ++wd) {
        unsigned x = wd == 0 ? m0 : (wd == 1 ? m1 : (wd == 2 ? m2 : m3)); const int base = wd * 32;
        if (from < base + 32) { if (from > base) x &= (~0u) << (from - base); if (x) return base + __builtin_ctz(x); }
    }
    return 128;
}
__device__ __forceinline__ bf16x8 pack8(const f32x16& p, int b0) {
    u32x4 w; w.x = pk2(p[b0 + 0], p[b0 + 1]); w.y = pk2(p[b0 + 2], p[b0 + 3]); w.z = pk2(p[b0 + 4], p[b0 + 5]); w.w = pk2(p[b0 + 6], p[b0 + 7]);
    return __builtin_bit_cast(bf16x8, w);
}
struct Branch { const bf16* k; const bf16* vt; int ldv; };

template <int MODE, bool SEL>
__device__ __forceinline__ void run_branch(unsigned char* sm, const Branch br, unsigned m0, unsigned m1, unsigned m2, unsigned m3,
                                           const bf16x8 (&qf)[4], int lo, int hi_b, int lo_max, int hi_min, unsigned s0, unsigned s1, unsigned s2, unsigned s3,
                                           float& m, float& l, float invl, f32x16 (&o)[2], float* imp_row, float* wsc, int tid, int lane) {
    const int i = lane & 31, hi = lane >> 5;
    int j = next_bit(m0, m1, m2, m3, 0);
    u32x4 kr, vr;
    if (j < 128) {
        kr = *(const u32x4*)(br.k + (size_t)j * 4096 + tid * 8);
        if (MODE != 0) vr = *(const u32x4*)(br.vt + (size_t)(tid >> 3) * br.ldv + j * 64 + (tid & 7) * 8);
        *(u32x4*)(sm + OFF_K + (tid >> 3) * KROW + (tid & 7) * 16) = kr;
        if (MODE != 0) { unsigned char* vp = sm + OFF_V + (tid >> 3) * VROW + (tid & 7) * 16; *(u32x2*)vp = (u32x2){vr.x, vr.y}; *(u32x2*)(vp + 8) = (u32x2){vr.z, vr.w}; }
    }
    __syncthreads();
    int cb = 0;
    while (j < 128) {
        const int jn = next_bit(m0, m1, m2, m3, j + 1);
        if (jn < 128) {
            kr = *(const u32x4*)(br.k + (size_t)jn * 4096 + tid * 8);
            if (MODE != 0) vr = *(const u32x4*)(br.vt + (size_t)(tid >> 3) * br.ldv + jn * 64 + (tid & 7) * 8);
        }
        const unsigned char* kb = sm + OFF_K + cb * KBUF; const unsigned char* vb = sm + OFF_V + cb * VBUF;
        const int key0 = 64 * j;
        bool rowsel = true;
        if (SEL) { const unsigned wsel = j < 32 ? s0 : (j < 64 ? s1 : (j < 96 ? s2 : s3)); rowsel = (wsel >> (j & 31)) & 1u; }
        if (!SEL || __any(rowsel)) {
            const float cinit = rowsel ? 0.f : -INFINITY;
            f32x16 p0, p1;
#pragma unroll
            for (int r = 0; r < 16; ++r) { p0[r] = cinit; p1[r] = cinit; }
#pragma unroll
            for (int d0 = 0; d0 < 4; ++d0) {
                const bf16x8 a0 = *(const bf16x8*)(kb + i * KROW + (16 * d0 + 8 * hi) * 2);
                const bf16x8 a1 = *(const bf16x8*)(kb + (32 + i) * KROW + (16 * d0 + 8 * hi) * 2);
                p0 = __builtin_amdgcn_mfma_f32_32x32x16_bf16(a0, qf[d0], p0, 0, 0, 0);
                p1 = __builtin_amdgcn_mfma_f32_32x32x16_bf16(a1, qf[d0], p1, 0, 0, 0);
            }
            if (!(key0 >= lo_max && key0 + 63 <= hi_min)) {
#pragma unroll
                for (int r = 0; r < 16; ++r) { const int key = key0 + crow(r, hi);
                    if (key < lo || key > hi_b) p0[r] = -INFINITY;
                    if (key + 32 < lo || key + 32 > hi_b) p1[r] = -INFINITY; }
            }
            if (MODE == 1) {
#pragma unroll
                for (int r = 0; r < 16; ++r) { p0[r] = __builtin_amdgcn_exp2f(p0[r] - m) * invl; p1[r] = __builtin_amdgcn_exp2f(p1[r] - m) * invl; }
#pragma unroll
                for (int gq = 0; gq < 4; ++gq) {
                    float G0 = (p0[4 * gq] + p0[4 * gq + 1]) + (p0[4 * gq + 2] + p0[4 * gq + 3]), L0 = p0[4 * gq + 3];
                    float G1 = (p1[4 * gq] + p1[4 * gq + 1]) + (p1[4 * gq + 2] + p1[4 * gq + 3]), L1 = p1[4 * gq + 3];
                    G0 += __shfl_xor(G0, 1); L0 += __shfl_xor(L0, 1); G1 += __shfl_xor(G1, 1); L1 += __shfl_xor(L1, 1);
                    G0 += __shfl_xor(G0, 2); L0 += __shfl_xor(L0, 2); G1 += __shfl_xor(G1, 2); L1 += __shfl_xor(L1, 2);
                    if ((i & 3) == 0) { const int s = 16 * j + 2 * gq + hi;
                        atomicAdd(imp_row + s, G0); atomicAdd(imp_row + s + 1, L0); atomicAdd(imp_row + s + 8, G1); atomicAdd(imp_row + s + 9, L1); }
                }
            } else {
                float tm = fmaxf(p0[0], p1[0]);
#pragma unroll
                for (int r = 1; r < 16; ++r) tm = fmaxf(tm, fmaxf(p0[r], p1[r]));
                tm = fmaxf(tm, __shfl_xor(tm, 32));
                const float mn = fmaxf(m, tm), alpha = __builtin_amdgcn_exp2f(m - mn);
                m = mn; float rs = 0.f;
#pragma unroll
                for (int r = 0; r < 16; ++r) { p0[r] = __builtin_amdgcn_exp2f(p0[r] - mn); p1[r] = __builtin_amdgcn_exp2f(p1[r] - mn); rs += p0[r] + p1[r]; }
                l = l * alpha + rs;
                if (MODE == 2) {
                    if (hi == 0) wsc[i] = alpha;
                    asm volatile("" ::: "memory");
#pragma unroll
                    for (int rg = 0; rg < 4; ++rg) { const f32x4 a4 = *(const f32x4*)(wsc + 8 * rg + 4 * hi);
#pragma unroll
                        for (int e = 0; e < 4; ++e) { o[0][4 * rg + e] *= a4[e]; o[1][4 * rg + e] *= a4[e]; } }
                    asm volatile("" ::: "memory");
                }
            }
            if (MODE != 0) {
                const bf16x8 pf0 = pack8(p0, 0), pf1 = pack8(p0, 8), pf2 = pack8(p1, 0), pf3 = pack8(p1, 8);
#pragma unroll
                for (int dt = 0; dt < 2; ++dt) {
                    const unsigned char* vp = vb + (32 * dt + i) * VROW + 8 * hi;
#pragma unroll
                    for (int ks = 0; ks < 4; ++ks) {
                        const u32x2 v_lo = *(const u32x2*)(vp + 32 * ks), v_hi = *(const u32x2*)(vp + 32 * ks + 16);
                        const bf16x8 vf = __builtin_bit_cast(bf16x8, (u32x4){v_lo.x, v_lo.y, v_hi.x, v_hi.y});
                        o[dt] = __builtin_amdgcn_mfma_f32_32x32x16_bf16(ks == 0 ? pf0 : (ks == 1 ? pf1 : (ks == 2 ? pf2 : pf3)), vf, o[dt], 0, 0, 0);
                    }
                }
            }
        }
        if (jn < 128) {
            *(u32x4*)(sm + OFF_K + (cb ^ 1) * KBUF + (tid >> 3) * KROW + (tid & 7) * 16) = kr;
            if (MODE != 0) { unsigned char* vp = sm + OFF_V + (cb ^ 1) * VBUF + (tid >> 3) * VROW + (tid & 7) * 16; *(u32x2*)vp = (u32x2){vr.x, vr.y}; *(u32x2*)(vp + 8) = (u32x2){vr.z, vr.w}; }
        }
        __syncthreads();
        j = jn; cb ^= 1;
    }
}
__device__ __forceinline__ void add_scaled(f32x16 (&acc)[2], const f32x16 (&o)[2], float f, float* wsc, int i, int hi) {
    if (hi == 0) wsc[i] = f;
    asm volatile("" ::: "memory");
#pragma unroll
    for (int rg = 0; rg < 4; ++rg) { const f32x4 a4 = *(const f32x4*)(wsc + 8 * rg + 4 * hi);
#pragma unroll
        for (int e = 0; e < 4; ++e) { acc[0][4 * rg + e] += a4[e] * o[0][4 * rg + e]; acc[1][4 * rg + e] += a4[e] * o[1][4 * rg + e]; } }
    asm volatile("" ::: "memory");
}
__device__ __forceinline__ void unit(const NsaArgs& a, int u, unsigned char* sm) {
    const int tid = tidx(), lane = tid & 63, w = __builtin_amdgcn_readfirstlane(tid >> 6), i = lane & 31, hi = lane >> 5;
    const int cur = 127 - (u >> 2), bg = u & 3, b = bg >> 1, g = bg & 1, q0 = cur * 64;
    const int ql = 8 * w + (i >> 2), hd = i & 3, t = q0 + ql;
    const size_t grow = (size_t)b * T_ + t;
    bf16x8 qf[4];
    { const bf16* qp = a.qb + grow * 512 + g * 256 + hd * 64 + 8 * hi;
#pragma unroll
      for (int d0 = 0; d0 < 4; ++d0) qf[d0] = *(const bf16x8*)(qp + 16 * d0); }
    float* wsc = (float*)(sm + OFF_WS) + w * 32;
    float* imp = (float*)(sm + OFF_IMP);
    unsigned* selw = (unsigned*)(sm + OFF_SEL);
    unsigned* um = (unsigned*)(sm + OFF_UM);
    for (int k = tid; k < 64 * IMPW; k += 512) imp[k] = 0.f;
    if (tid < 4) um[tid] = 0u;
    const float* gt = a.gates + grow * 24 + g * 12 + hd * 3;
    const float gc = gt[0], gs = gt[1], gw = gt[2];
    f32x16 acc[2], o[2];
#pragma unroll
    for (int r = 0; r < 16; ++r) { acc[0][r] = 0.f; acc[1][r] = 0.f; }
    const int tw0 = q0 + 8 * w, tw1 = tw0 + 7;
    {
        const int nv = t < 31 ? 0 : (t - 31) / 16 + 1;
        const int nvw = tw0 < 31 ? 0 : (tw0 - 31) / 16 + 1;
        const int nvmax = (q0 + 63 - 31) / 16 + 1, ntc = (nvmax + 63) / 64;
        const unsigned cm0 = ntc >= 32 ? ~0u : ((1u << ntc) - 1u);
        const Branch br{a.kc + (size_t)bg * NCP * 64, a.vct + (size_t)bg * 64 * NCP, NCP};
        float m = -1e30f, l = 0.f;
        run_branch<0, false>(sm, br, cm0, 0u, 0u, 0u, qf, 0, nv - 1, 0, nvw - 1, 0u, 0u, 0u, 0u, m, l, 0.f, o, nullptr, wsc, tid, lane);
        l += __shfl_xor(l, 32);
        const float invl = 1.f / fmaxf(l, 1e-30f);
#pragma unroll
        for (int r = 0; r < 16; ++r) { o[0][r] = 0.f; o[1][r] = 0.f; }
        run_branch<1, false>(sm, br, cm0, 0u, 0u, 0u, qf, 0, nv - 1, 0, nvw - 1, 0u, 0u, 0u, 0u, m, l, invl, o, imp + ql * IMPW, wsc, tid, lane);
        add_scaled(acc, o, gc, wsc, i, hi);
    }
    {
        unsigned u0 = 0u, u1 = 0u, u2 = 0u, u3 = 0u;
        const int ncand = cur - 2;
        for (int qq = 0; qq < 8; ++qq) {
            unsigned k0 = 0u, k1 = 0u, k2 = 0u, k3 = 0u;
            if (ncand <= 13) {
#pragma unroll
                for (int wd = 0; wd < 4; ++wd) { const int nb = cur + 1 - 32 * wd; const unsigned x = nb >= 32 ? ~0u : (nb <= 0 ? 0u : ((1u << nb) - 1u));
                    if (wd == 0) k0 = x; else if (wd == 1) k1 = x; else if (wd == 2) k2 = x; else k3 = x; }
            } else {
                const float* ir = imp + (8 * w + qq) * IMPW;
                float v0 = (lane >= 1 && lane <= cur - 2) ? ir[lane] : -1.f;
                float v1 = (lane + 64 <= cur - 2) ? ir[lane + 64] : -1.f;
                for (int it = 0; it < 13; ++it) {
                    float bv = v0; int bs = lane;
                    if (v1 > v0) { bv = v1; bs = lane + 64; }
#pragma unroll
                    for (int off = 1; off < 64; off <<= 1) { const float ov = __shfl_xor(bv, off); const int os = __shfl_xor(bs, off);
                        if (ov > bv || (ov == bv && os < bs)) { bv = ov; bs = os; } }
                    bs = __builtin_amdgcn_readfirstlane(bs);
                    if (bs == lane) v0 = -1.f; if (bs == lane + 64) v1 = -1.f;
                    const unsigned bit = 1u << (bs & 31);
                    if (bs < 32) k0 |= bit; else if (bs < 64) k1 |= bit; else if (bs < 96) k2 |= bit; else k3 |= bit;
                }
                k0 |= 1u;
                { const int c1 = cur - 1; const unsigned bit = 1u << (c1 & 31); if (c1 < 32) k0 |= bit; else if (c1 < 64) k1 |= bit; else if (c1 < 96) k2 |= bit; else k3 |= bit; }
                { const unsigned bit = 1u << (cur & 31); if (cur < 32) k0 |= bit; else if (cur < 64) k1 |= bit; else if (cur < 96) k2 |= bit; else k3 |= bit; }
            }
            if (lane == 0) { unsigned* sp = selw + (8 * w + qq) * 4; sp[0] = k0; sp[1] = k1; sp[2] = k2; sp[3] = k3; }
            u0 |= k0; u1 |= k1; u2 |= k2; u3 |= k3;
        }
        if (lane == 0) { atomicOr(um + 0, u0); atomicOr(um + 1, u1); atomicOr(um + 2, u2); atomicOr(um + 3, u3); }
    }
    __syncthreads();
    {
        const unsigned U0 = um[0], U1 = um[1], U2 = um[2], U3 = um[3];
        const unsigned* sp = selw + ql * 4; const unsigned s0 = sp[0], s1 = sp[1], s2 = sp[2], s3 = sp[3];
        const Branch br{a.ks + (size_t)bg * T_ * 64, a.vst + (size_t)bg * 64 * T_, T_};
        float m = -1e30f, l = 0.f;
#pragma unroll
        for (int r = 0; r < 16; ++r) { o[0][r] = 0.f; o[1][r] = 0.f; }
        run_branch<2, true>(sm, br, __builtin_amdgcn_readfirstlane(U0), __builtin_amdgcn_readfirstlane(U1), __builtin_amdgcn_readfirstlane(U2), __builtin_amdgcn_readfirstlane(U3),
                            qf, 0, t, 0, tw0, s0, s1, s2, s3, m, l, 0.f, o, nullptr, wsc, tid, lane);
        l += __shfl_xor(l, 32);
        add_scaled(acc, o, gs / fmaxf(l, 1e-30f), wsc, i, hi);
    }
    {
        const int j0 = cur - 8 > 0 ? cur - 8 : 0;
        unsigned wm0 = 0u, wm1 = 0u, wm2 = 0u, wm3 = 0u;
#pragma unroll
        for (int wd = 0; wd < 4; ++wd) { const int a0 = j0 - 32 * wd, a1 = cur + 1 - 32 * wd;
            const unsigned hi_m = a1 >= 32 ? ~0u : (a1 <= 0 ? 0u : ((1u << a1) - 1u)), lo_m = a0 >= 32 ? ~0u : (a0 <= 0 ? 0u : ((1u << a0) - 1u));
            const unsigned x = hi_m & ~lo_m; if (wd == 0) wm0 = x; else if (wd == 1) wm1 = x; else if (wd == 2) wm2 = x; else wm3 = x; }
        const Branch br{a.kw + (size_t)bg * T_ * 64, a.vwt + (size_t)bg * 64 * T_, T_};
        float m = -1e30f, l = 0.f;
#pragma unroll
        for (int r = 0; r < 16; ++r) { o[0][r] = 0.f; o[1][r] = 0.f; }
        run_branch<2, false>(sm, br, wm0, wm1, wm2, wm3, qf, t - 511, t, tw1 - 511, tw0, 0u, 0u, 0u, 0u, m, l, 0.f, o, nullptr, wsc, tid, lane);
        l += __shfl_xor(l, 32);
        add_scaled(acc, o, gw / fmaxf(l, 1e-30f), wsc, i, hi);
    }
#pragma unroll
    for (int r = 0; r < 16; ++r) { const int rw = crow(r, hi), qq = 8 * w + (rw >> 2), hh = rw & 3;
        bf16* op = a.amix + ((size_t)b * T_ + q0 + qq) * DM + g * 256 + hh * 64 + i;
        op[0] = (bf16)f2bf(acc[0][r]); op[32] = (bf16)f2bf(acc[1][r]); }
}
__device__ __forceinline__ void phase(const NsaArgs& a, unsigned* ctr, unsigned char* sm) {
    int* slot = (int*)(sm + OFF_UNIT);
    for (;;) {
        if (tidx() == 0) *slot = (int)atomicAdd(ctr, 1u);
        __syncthreads();
        const int u = *slot;
        __syncthreads();
        if (u >= 512) break;
        unit(a, u, sm);
    }
}
}

__device__ __forceinline__ void d_lora_prep(const bf16* pr, const float* mu, bf16* la) {
    const int T512 = tidx(), c = T512 & 255;
    const float m = mu[1536 + c];
    FOR_VB(vb, M_ / 4) {
        const int row0 = vb * 4;
        float x[5];
        x[0] = (row0 % T_) ? bf2f(pr[(size_t)(row0 - 1) * 256 + c]) : 0.f;
#pragma unroll
        for (int j = 0; j < 4; ++j) x[j + 1] = bf2f(pr[(size_t)(row0 + j) * 256 + c]);
#pragma unroll
        for (int j = 0; j < 4; ++j) { const float xs = x[j + 1] + (x[j] - x[j + 1]) * m;
            const float v = c < 64 ? tanhf(xs) : (c < 128 ? xs : sigmoidf_(xs));
            la[(size_t)(row0 + j) * KLORA + c] = (bf16)f2bf(v); }
    }
}

namespace rw7 {
using nsa::f32x16; using nsa::crow; using nsa::pack8;
constexpr int NHELP = 5, RG = 7;
constexpr int NPROD = 6, RING = 7, RA = 144, RB = 40, S_AT = 0, S_RT = 16 * RA, S_BT = 32 * RA, S_KT = S_BT + 64 * RB, S_VT = S_KT + 64 * RB, S_SM = S_VT + 64 * RB, SMM = 16 * RB, S_GC = S_SM + 4 * SMM, SLOT = S_GC + 256;
constexpr int OFF_SCR = RING * SLOT, SCR = 32 * RA, LDS_NEED = OFF_SCR + (NPROD / (NHELP + 1)) * SCR;
static_assert(NPROD % (NHELP + 1) == 0 && LDS_NEED <= 147456 - 64 && 6 * (SLOT + SCR) <= 147456 - 64 && (size_t)16 * NHELP * RG * SLOT <= (size_t)9 << 20 && SLOT % 16 == 0 && S_BT % 16 == 0 && 128 * RB >= 4096 && SCR >= 4096, "rw7 lds map");
struct Args { const unsigned* rkw; const bf16* vv; const bf16* aga; const float* wdec; const float *mu, *kk, *ka, *rk; float* yraw; float* bonus; unsigned char* ring; unsigned* flags; unsigned* cons; };
__device__ __forceinline__ void wg_bar() { asm volatile("s_waitcnt lgkmcnt(0)" ::: "memory"); __builtin_amdgcn_s_barrier(); asm volatile("" ::: "memory"); }
struct Chan { float mur, muk, muv, kkc, kac, rkc; };
struct Raw { unsigned rk[16]; unsigned short v[16], al[16]; float w[16]; unsigned prk; unsigned short pv; };
__device__ __forceinline__ void fetch(const Args& a, int b, int h, int c, int lane, Raw& q) {
    const size_t base = ((size_t)b * T_ + (size_t)c * 16) * 512 + h * 64 + lane;
#pragma unroll
    for (int t = 0; t < 16; ++t) { q.rk[t] = a.rkw[base + (size_t)t * 512]; q.v[t] = a.vv[base + (size_t)t * 512]; q.al[t] = a.aga[base + (size_t)t * 512]; q.w[t] = a.wdec[base + (size_t)t * 512]; }
    q.prk = 0u; q.pv = 0;
    if (c > 0) { q.prk = a.rkw[base - 512]; q.pv = a.vv[base - 512]; }
}
__device__ __forceinline__ void st_row40(unsigned char* p, const unsigned (&w)[8]) {
    *(u32x2*)p = (u32x2){w[0], w[1]}; *(u32x2*)(p + 8) = (u32x2){w[2], w[3]}; *(u32x2*)(p + 16) = (u32x2){w[4], w[5]}; *(u32x2*)(p + 24) = (u32x2){w[6], w[7]};
}
template <bool BAR> __device__ __forceinline__ void seg_end() { if (BAR) wg_bar(); else { asm volatile("s_waitcnt lgkmcnt(0)" ::: "memory"); __builtin_amdgcn_sched_barrier(0); } }
template <bool BAR> __device__ __forceinline__ void produce(const Args& a, const Chan& ch, int b, int h, int c, const Raw& q, unsigned char* slot, unsigned char* scr, int lane) {
    const int i = lane & 31, hi = lane >> 5;
    const size_t row0 = (size_t)b * T_ + (size_t)c * 16;
    float pr_r = __builtin_bit_cast(float, q.prk << 16), pr_k = __builtin_bit_cast(float, q.prk & 0xffff0000u), pr_v = bf2f(q.pv);
    float rr[16], kq[16], kt[16];
    float* RED1 = (float*)scr;
    float* RED2 = (float*)(slot + S_BT);
#pragma unroll
    for (int t4 = 0; t4 < 4; ++t4) { f32x4 e1, e2;
#pragma unroll
        for (int e = 0; e < 4; ++e) { const int t = 4 * t4 + e;
            const float r0 = __builtin_bit_cast(float, q.rk[t] << 16), k0 = __builtin_bit_cast(float, q.rk[t] & 0xffff0000u), al = bf2f(q.al[t]);
            const float r = r0 + (pr_r - r0) * ch.mur, k = k0 + (pr_k - k0) * ch.muk;
            pr_r = r0; pr_k = k0;
            rr[t] = r; kq[t] = k * ch.kkc; kt[t] = k * (1.f + (al - 1.f) * ch.kac);
            e1[e] = kq[t] * kq[t]; e2[e] = r * kt[t] * ch.rkc; }
        *(f32x4*)(RED1 + lane * 16 + 4 * t4) = e1; *(f32x4*)(RED2 + lane * 16 + 4 * t4) = e2; }
    seg_end<BAR>();
    { const int t = lane & 15, part = lane >> 4; float s1 = 0.f, s2 = 0.f;
#pragma unroll
      for (int j = 0; j < 16; ++j) { s1 += RED1[(part * 16 + j) * 16 + t]; s2 += RED2[(part * 16 + j) * 16 + t]; }
      s1 += __shfl_xor(s1, 16); s2 += __shfl_xor(s2, 16); s1 += __shfl_xor(s1, 32); s2 += __shfl_xor(s2, 32);
      asm volatile("s_waitcnt lgkmcnt(0)" ::: "memory");
      if (lane < 16) { ((float*)(slot + S_GC))[lane] = s1; a.bonus[(row0 + lane) * 8 + h] = s2; } }
    asm volatile("s_waitcnt lgkmcnt(0)" ::: "memory");
    f32x4 n2[4];
#pragma unroll
    for (int t4 = 0; t4 < 4; ++t4) n2[t4] = *(const f32x4*)(slot + S_GC + 16 * t4);
    asm volatile("s_waitcnt lgkmcnt(0)" ::: "memory");
    float gam = 1.f;
    unsigned btp[8], ktp[8], vtp[8];
    float b_ev = 0.f, k_ev = 0.f, v_ev = 0.f;
#pragma unroll
    for (int t = 0; t < 16; ++t) {
        if (t == 6) seg_end<BAR>();
        const float v0 = bf2f(q.v[t]), al = bf2f(q.al[t]);
        const float v = v0 + (pr_v - v0) * ch.muv; pr_v = v0;
        const float kkn = kq[t] * __builtin_amdgcn_rsqf(fmaxf(n2[t >> 2][t & 3], 1e-24f));
        const float gp = gam; gam *= q.w[t]; const float ig = __builtin_amdgcn_rcpf(gam);
        const float bt_ = kkn * al * ig, kt_ = kt[t] * ig;
        const unsigned ar = pk2(-kkn * gp, rr[t] * gam), bk = pk2(bt_, kt_);
        *(bf16*)(slot + S_AT + t * RA + lane * 2) = (bf16)(ar & 0xffffu); *(bf16*)(slot + S_RT + t * RA + lane * 2) = (bf16)(ar >> 16);
        *(bf16*)(scr + t * RA + lane * 2) = (bf16)(bk & 0xffffu); *(bf16*)(scr + (16 + t) * RA + lane * 2) = (bf16)(bk >> 16);
        if (t & 1) { btp[t >> 1] = pk2(b_ev, bt_); ktp[t >> 1] = pk2(k_ev, kt_); vtp[t >> 1] = pk2(v_ev, v); }
        else { b_ev = bt_; k_ev = kt_; v_ev = v; }
    }
    st_row40(slot + S_BT + lane * RB, btp); st_row40(slot + S_KT + lane * RB, ktp); st_row40(slot + S_VT + lane * RB, vtp);
    ((float*)(slot + S_GC))[lane] = gam;
    seg_end<BAR>();
    f32x16 C;
#pragma unroll
    for (int r = 0; r < 16; ++r) C[r] = 0.f;
#pragma unroll
    for (int ks = 0; ks < 4; ++ks) {
        const bf16x8 af = *(const bf16x8*)(slot + S_AT + i * RA + (16 * ks + 8 * hi) * 2);
        const bf16x8 bf = *(const bf16x8*)(scr + i * RA + (16 * ks + 8 * hi) * 2);
        C = __builtin_amdgcn_mfma_f32_32x32x16_bf16(af, bf, C, 0, 0, 0);
    }
    asm volatile("s_waitcnt lgkmcnt(0)" ::: "memory");
    float* AAB = (float*)scr;
    unsigned char* SM = slot + S_SM;
#pragma unroll
    for (int r = 0; r < 16; ++r) {
        const int rho = crow(r, hi); const float val = C[r];
        if (r < 8) {
            if (i < 16) AAB[rho * 16 + i] = (i < rho) ? val : 0.f;
            else *(bf16*)(SM + SMM + rho * RB + (i - 16) * 2) = (bf16)f2bf((i - 16 < rho) ? val : 0.f);
        } else {
            const int tt = rho - 16;
            if (i < 16) *(bf16*)(SM + 2 * SMM + tt * RB + i * 2) = (bf16)f2bf((i <= tt) ? val : 0.f);
            else *(bf16*)(SM + 3 * SMM + tt * RB + (i - 16) * 2) = (bf16)f2bf((i - 16 <= tt) ? val : 0.f);
        }
    }
    seg_end<BAR>();
    { const int j = lane & 15; float Tr[16];
#pragma unroll
      for (int t = 0; t < 16; ++t) { if (t == 11) seg_end<BAR>();
          float acc = (t == j) ? 1.f : 0.f;
#pragma unroll
          for (int s4 = 0; s4 < (t + 3) / 4; ++s4) { const f32x4 ar = *(const f32x4*)(AAB + t * 16 + 4 * s4);
#pragma unroll
              for (int e = 0; e < 4; ++e) if (4 * s4 + e < t) acc += ar[e] * Tr[4 * s4 + e]; }
          Tr[t] = acc;
          if (lane < 16) *(bf16*)(SM + t * RB + j * 2) = (bf16)f2bf(acc); } }
    seg_end<BAR>();
}

__device__ __forceinline__ bf16x8 rd_perm(const unsigned char* p, int hi) {
    const u32x2 a = *(const u32x2*)(p + 8 * hi), b = *(const u32x2*)(p + 16 + 8 * hi);
    return __builtin_bit_cast(bf16x8, (u32x4){a.x, a.y, b.x, b.y});
}
__device__ __forceinline__ bf16x8 rd_nat(const unsigned char* p, int hi) {
    const u32x2 a = *(const u32x2*)(p + 16 * hi), b = *(const u32x2*)(p + 16 * hi + 8);
    return __builtin_bit_cast(bf16x8, (u32x4){a.x, a.y, b.x, b.y});
}
__device__ __forceinline__ bf16x8 and8(bf16x8 f, unsigned m) { u32x4 w = __builtin_bit_cast(u32x4, f); w.x &= m; w.y &= m; w.z &= m; w.w &= m; return __builtin_bit_cast(bf16x8, w); }
__device__ __forceinline__ void consume(const unsigned char* slot, f32x16 (&z)[2], float* yout, int vt, int lane) {
    const int i = lane & 31, hi = lane >> 5, i16 = i & 15;
    const unsigned m16 = i < 16 ? 0xffffffffu : 0u;
    const unsigned char* at = slot + S_AT + i16 * RA; const unsigned char* rt = slot + S_RT + i16 * RA; const unsigned char* sm16 = slot + S_SM + i16 * RB;
    bf16x8 fa0 = rd_perm(at, hi), fa1 = rd_perm(at + 32, hi), fa2 = rd_perm(at + 64, hi), fa3 = rd_perm(at + 96, hi);
    bf16x8 fak = rd_nat(sm16 + SMM, hi), ft = rd_perm(sm16, hi);
    const bf16x8 vtf = rd_nat(slot + S_VT + (32 * vt + i) * RB, hi);
    bf16x8 fr0 = rd_perm(rt, hi), fr1 = rd_perm(rt + 32, hi), fr2 = rd_perm(rt + 64, hi), fr3 = rd_perm(rt + 96, hi);
    bf16x8 frb = rd_perm(sm16 + 2 * SMM, hi), frk = rd_nat(sm16 + 3 * SMM, hi);
    const bf16x8 fk0 = rd_nat(slot + S_KT + i * RB, hi), fk1 = rd_nat(slot + S_KT + (32 + i) * RB, hi);
    const bf16x8 fb0 = rd_perm(slot + S_BT + i * RB, hi), fb1 = rd_perm(slot + S_BT + (32 + i) * RB, hi);
    f32x4 g4[2][4];
#pragma unroll
    for (int kt = 0; kt < 2; ++kt)
#pragma unroll
        for (int rg = 0; rg < 4; ++rg) g4[kt][rg] = *(const f32x4*)(slot + S_GC + (32 * kt + 8 * rg + 4 * hi) * 4);
    const bf16x8 zb0 = pack8(z[0], 0), zb1 = pack8(z[0], 8), zb2 = pack8(z[1], 0), zb3 = pack8(z[1], 8);
    fa0 = and8(fa0, m16); fa1 = and8(fa1, m16); fa2 = and8(fa2, m16); fa3 = and8(fa3, m16); fak = and8(fak, m16); ft = and8(ft, m16);
    fr0 = and8(fr0, m16); fr1 = and8(fr1, m16); fr2 = and8(fr2, m16); fr3 = and8(fr3, m16); frb = and8(frb, m16); frk = and8(frk, m16);
    f32x16 X, U, Y;
#pragma unroll
    for (int r = 0; r < 16; ++r) { X[r] = 0.f; U[r] = 0.f; Y[r] = 0.f; }
    X = __builtin_amdgcn_mfma_f32_32x32x16_bf16(fa0, zb0, X, 0, 0, 0);
    X = __builtin_amdgcn_mfma_f32_32x32x16_bf16(fa1, zb1, X, 0, 0, 0);
    X = __builtin_amdgcn_mfma_f32_32x32x16_bf16(fa2, zb2, X, 0, 0, 0);
    X = __builtin_amdgcn_mfma_f32_32x32x16_bf16(fa3, zb3, X, 0, 0, 0);
    X = __builtin_amdgcn_mfma_f32_32x32x16_bf16(fak, vtf, X, 0, 0, 0);
    Y = __builtin_amdgcn_mfma_f32_32x32x16_bf16(fr0, zb0, Y, 0, 0, 0);
    Y = __builtin_amdgcn_mfma_f32_32x32x16_bf16(fr1, zb1, Y, 0, 0, 0);
    Y = __builtin_amdgcn_mfma_f32_32x32x16_bf16(fr2, zb2, Y, 0, 0, 0);
    Y = __builtin_amdgcn_mfma_f32_32x32x16_bf16(fr3, zb3, Y, 0, 0, 0);
    Y = __builtin_amdgcn_mfma_f32_32x32x16_bf16(frk, vtf, Y, 0, 0, 0);
    z[0] = __builtin_amdgcn_mfma_f32_32x32x16_bf16(fk0, vtf, z[0], 0, 0, 0);
    z[1] = __builtin_amdgcn_mfma_f32_32x32x16_bf16(fk1, vtf, z[1], 0, 0, 0);
    const bf16x8 xb = pack8(X, 0);
    U = __builtin_amdgcn_mfma_f32_32x32x16_bf16(ft, xb, U, 0, 0, 0);
    const bf16x8 ub = pack8(U, 0);
    z[0] = __builtin_amdgcn_mfma_f32_32x32x16_bf16(fb0, ub, z[0], 0, 0, 0);
    z[1] = __builtin_amdgcn_mfma_f32_32x32x16_bf16(fb1, ub, z[1], 0, 0, 0);
    Y = __builtin_amdgcn_mfma_f32_32x32x16_bf16(frb, ub, Y, 0, 0, 0);
#pragma unroll
    for (int kt = 0; kt < 2; ++kt)
#pragma unroll
        for (int rg = 0; rg < 4; ++rg)
#pragma unroll
            for (int e = 0; e < 4; ++e) z[kt][4 * rg + e] *= g4[kt][rg][e];
#pragma unroll
    for (int r = 0; r < 8; ++r) yout[(size_t)crow(r, hi) * 512] = Y[r];
}

__device__ __forceinline__ unsigned ld_relaxed(const unsigned* p) { return __hip_atomic_load(p, __ATOMIC_RELAXED, __HIP_MEMORY_SCOPE_AGENT); }
__device__ __forceinline__ void head(const Args& a, int bh, unsigned char* sm) {
    const int tid = tidx(), lane = tid & 63, w = __builtin_amdgcn_readfirstlane(tid >> 6);
    const int b = bh >> 3, h = bh & 7;
    constexpr int NCH = T_ / 16, NBAR = NCH + NPROD;
    if (w < 2) {
        f32x16 z[2];
#pragma unroll
        for (int r = 0; r < 16; ++r) { z[0][r] = 0.f; z[1][r] = 0.f; }
        for (int i = 0; i < NPROD; ++i) wg_bar();
        for (int c = 0; c < NCH; ++c) {
            consume(sm + (size_t)(c % RING) * SLOT, z, a.yraw + ((size_t)b * T_ + (size_t)c * 16) * 512 + h * 64 + 32 * w + (lane & 31), w, lane);
            if (w == 0 && (c & 7) == 7 && lane == 0) __hip_atomic_store(a.cons + bh * 64, (unsigned)(c + 1), __ATOMIC_RELAXED, __HIP_MEMORY_SCOPE_AGENT);
            wg_bar();
        }
    } else {
        const int pw = w - 2, col = h * 64 + lane;
        unsigned char* scr = sm + OFF_SCR + (pw / (NHELP + 1)) * SCR;
        int nb = pw;
        if (pw % (NHELP + 1) == 0) {
            const Chan ch{a.mu[col], a.mu[512 + col], a.mu[1024 + col], a.kk[col], a.ka[col], a.rk[col]};
            Raw q; fetch(a, b, h, pw, lane, q);
            for (int i = 0; i < pw; ++i) wg_bar();
            for (int c = pw; c < NCH; c += NPROD) {
                Raw nq; if (c + NPROD < NCH) fetch(a, b, h, c + NPROD, lane, nq);
                produce<true>(a, ch, b, h, c, q, sm + (size_t)(c % RING) * SLOT, scr, lane);
                q = nq; nb += NPROD;
            }
        } else {
            u32x4 v[15];
            auto pull = [&](int c) {
                const int hl = c % (NHELP + 1) - 1, n = c / (NHELP + 1);
                const unsigned char* g = a.ring + ((size_t)(bh * NHELP + hl) * RG + (n % RG)) * SLOT;
                while (__builtin_amdgcn_readfirstlane(ld_relaxed(a.flags + bh * NCH + c)) == 0u) __builtin_amdgcn_s_sleep(2);
                __builtin_amdgcn_fence(__ATOMIC_ACQUIRE, "agent");
                asm volatile("s_waitcnt vmcnt(0)" ::: "memory");
#pragma unroll
                for (int i = 0; i < 15; ++i) { const int off = (i * 64 + lane) * 16; if (off < SLOT) v[i] = *(const u32x4*)(g + off); }
            };
            pull(pw);
            for (int i = 0; i < pw; ++i) wg_bar();
            for (int c = pw; c < NCH; c += NPROD) {
                unsigned char* slot = sm + (size_t)(c % RING) * SLOT;
#pragma unroll
                for (int i = 0; i < 15; ++i) { const int off = (i * 64 + lane) * 16; if (off < SLOT) *(u32x4*)(slot + off) = v[i]; }
                if (c + NPROD < NCH) pull(c + NPROD);
                wg_bar(); wg_bar(); wg_bar(); wg_bar(); wg_bar(); wg_bar();
                nb += NPROD;
            }
        }
        for (; nb < NBAR; ++nb) wg_bar();
    }
}
__device__ __forceinline__ void helper(const Args& a, int bh, int hl, unsigned char* sm) {
    const int tid = tidx(), lane = tid & 63, w = __builtin_amdgcn_readfirstlane(tid >> 6);
    if (w >= 6) return;
    const int b = bh >> 3, h = bh & 7, col = h * 64 + lane;
    constexpr int NCH = T_ / 16;
    unsigned char* slot = sm + (size_t)w * SLOT; unsigned char* scr = sm + 6 * SLOT + w * SCR;
    const Chan ch{a.mu[col], a.mu[512 + col], a.mu[1024 + col], a.kk[col], a.ka[col], a.rk[col]};
    int n = w, c = (NHELP + 1) * n + hl + 1;
    if (c >= NCH) return;
    for (; c < NCH; n += 6, c += 6 * (NHELP + 1)) {
        Raw q; fetch(a, b, h, c, lane, q);
        if (n >= RG) { const unsigned need = (unsigned)(c - RG * (NHELP + 1) + 1);
            while (__builtin_amdgcn_readfirstlane(ld_relaxed(a.cons + bh * 64)) < need) __builtin_amdgcn_s_sleep(8); }
        produce<false>(a, ch, b, h, c, q, slot, scr, lane);
        asm volatile("s_waitcnt lgkmcnt(0)" ::: "memory");
        unsigned char* g = a.ring + ((size_t)(bh * NHELP + hl) * RG + (n % RG)) * SLOT;
#pragma unroll
        for (int i = 0; i < 15; ++i) { const int off = (i * 64 + lane) * 16;
            if (off < SLOT) { const u32x4 d = *(const u32x4*)(slot + off); unsigned char* gp = g + off; asm volatile("global_store_dwordx4 %0, %1, off sc1\n\ts_nop 1" :: "v"(gp), "v"(d) : "memory"); } }
        asm volatile("s_waitcnt vmcnt(0)" ::: "memory");
        if (lane == 0) __hip_atomic_store(a.flags + bh * NCH + c, 1u, __ATOMIC_RELAXED, __HIP_MEMORY_SCOPE_AGENT);
    }
}
__device__ __forceinline__ void finish(const float* yraw, const float* bonus, const bf16* vv, const bf16* agg, const float* mu, const float* gng, const float* gnb, bf16* amix) {
    const int T512 = tidx(), lane = T512 & 63;
    for (int it0 = (blockIdx.x * 8 + (T512 >> 6)) * 4; it0 < M_ * 8; it0 += gridDim.x * 8 * 4) {
        const int row = it0 >> 3, h0 = it0 & 7, t = row % T_;
        float y[4], v0[4], v1[4], gg[4], bo[4];
#pragma unroll
        for (int j = 0; j < 4; ++j) { const int col = (h0 + j) * 64 + lane;
            y[j] = yraw[(size_t)row * 512 + col]; v0[j] = bf2f(vv[(size_t)row * 512 + col]); v1[j] = t ? bf2f(vv[(size_t)(row - 1) * 512 + col]) : 0.f;
            gg[j] = bf2f(agg[(size_t)row * 512 + col]); bo[j] = bonus[(size_t)row * 8 + h0 + j]; }
        float mean[4], var[4];
#pragma unroll
        for (int j = 0; j < 4; ++j) mean[j] = y[j];
#pragma unroll
        for (int o = 1; o < 64; o <<= 1) {
#pragma unroll
            for (int j = 0; j < 4; ++j) mean[j] += __shfl_xor(mean[j], o); }
#pragma unroll
        for (int j = 0; j < 4; ++j) { mean[j] *= (1.f / 64.f); y[j] -= mean[j]; var[j] = y[j] * y[j]; }
#pragma unroll
        for (int o = 1; o < 64; o <<= 1) {
#pragma unroll
            for (int j = 0; j < 4; ++j) var[j] += __shfl_xor(var[j], o); }
#pragma unroll
        for (int j = 0; j < 4; ++j) { const int col = (h0 + j) * 64 + lane;
            const float yn = y[j] * rsqrtf(var[j] * (1.f / 64.f) + 64e-5f) * gng[col] + gnb[col];
            const float v = v0[j] + (v1[j] - v0[j]) * mu[1024 + col];
            amix[(size_t)row * DM + 512 + col] = (bf16)f2bf((yn + bo[j] * v) * gg[j]); }
    }
}
}

namespace mema {
using nsa::f32x16; using nsa::KROW; using nsa::VROW; using nsa::KBUF; using nsa::VBUF; using nsa::OFF_K; using nsa::OFF_V; using nsa::OFF_WS; using nsa::crow; using nsa::pack8;
__device__ __forceinline__ void unit(const bf16* qm, const bf16* mk, const bf16* mvt, bf16* om, int u, unsigned char* sm) {
    const int tid = tidx(), lane = tid & 63, w = __builtin_amdgcn_readfirstlane(tid >> 6), i = lane & 31, hi = lane >> 5;
    const int b = u >> 7, h = (u >> 5) & 3, rb = u & 31;
    const int row0 = b * T_ + rb * 256 + 32 * w;
    const bf16* qrow = qm + (size_t)(row0 + i) * DM + h * 256 + 8 * hi;
    const bf16* kbase = mk + (size_t)(b * 256 + (tid >> 3)) * DM + h * 256 + (tid & 7) * 8;
    const bf16* vbase = mvt + (size_t)(h * 256 + (tid >> 3)) * 512 + b * 256 + (tid & 7) * 8;
    unsigned char* kst = sm + OFF_K + (tid >> 3) * KROW + (tid & 7) * 16;
    unsigned char* vst = sm + OFF_V + (tid >> 3) * VROW + (tid & 7) * 16;
    float* wsc = (float*)(sm + OFF_WS) + w * 32;
    f32x16 p[4][2];
#pragma unroll
    for (int kt = 0; kt < 4; ++kt)
#pragma unroll
        for (int r = 0; r < 16; ++r) { p[kt][0][r] = 0.f; p[kt][1][r] = 0.f; }
    u32x4 tr = *(const u32x4*)kbase;
    *(u32x4*)kst = tr;
    __syncthreads();
    bf16x8 qf[4];
#pragma unroll
    for (int n = 0; n < 16; ++n) {
        const int dc = n >> 2, kt = n & 3, cb = n & 1;
        if (n + 1 < 16) tr = *(const u32x4*)(kbase + (size_t)(64 * ((n + 1) & 3)) * DM + 64 * ((n + 1) >> 2));
        else tr = *(const u32x4*)vbase;
        if (kt == 0) {
#pragma unroll
            for (int d0 = 0; d0 < 4; ++d0) qf[d0] = *(const bf16x8*)(qrow + 64 * dc + 16 * d0);
        }
        const unsigned char* kb = sm + OFF_K + cb * KBUF;
#pragma unroll
        for (int d0 = 0; d0 < 4; ++d0) {
            const bf16x8 a0 = *(const bf16x8*)(kb + i * KROW + (16 * d0 + 8 * hi) * 2);
            const bf16x8 a1 = *(const bf16x8*)(kb + (32 + i) * KROW + (16 * d0 + 8 * hi) * 2);
            p[kt][0] = __builtin_amdgcn_mfma_f32_32x32x16_bf16(a0, qf[d0], p[kt][0], 0, 0, 0);
            p[kt][1] = __builtin_amdgcn_mfma_f32_32x32x16_bf16(a1, qf[d0], p[kt][1], 0, 0, 0);
        }
        if (n + 1 < 16) *(u32x4*)(kst + (cb ^ 1) * KBUF) = tr;
        else { *(u32x2*)vst = (u32x2){tr.x, tr.y}; *(u32x2*)(vst + 8) = (u32x2){tr.z, tr.w}; }
        __syncthreads();
    }
    float mx = p[0][0][0];
#pragma unroll
    for (int kt = 0; kt < 4; ++kt)
#pragma unroll
        for (int r = 0; r < 16; ++r) mx = fmaxf(mx, fmaxf(p[kt][0][r], p[kt][1][r]));
    mx = fmaxf(mx, __shfl_xor(mx, 32));
    float l = 0.f;
#pragma unroll
    for (int kt = 0; kt < 4; ++kt)
#pragma unroll
        for (int r = 0; r < 16; ++r) { p[kt][0][r] = __builtin_amdgcn_exp2f(p[kt][0][r] - mx); p[kt][1][r] = __builtin_amdgcn_exp2f(p[kt][1][r] - mx); l += p[kt][0][r] + p[kt][1][r]; }
    l += __shfl_xor(l, 32);
    bf16x8 pf[4][4];
#pragma unroll
    for (int kt = 0; kt < 4; ++kt) { pf[kt][0] = pack8(p[kt][0], 0); pf[kt][1] = pack8(p[kt][0], 8); pf[kt][2] = pack8(p[kt][1], 0); pf[kt][3] = pack8(p[kt][1], 8); }
    if (hi == 0) wsc[i] = 1.f / l;
    asm volatile("" ::: "memory");
    f32x4 il[4];
#pragma unroll
    for (int rg = 0; rg < 4; ++rg) il[rg] = *(const f32x4*)(wsc + 8 * rg + 4 * hi);
    f32x16 o[2];
#pragma unroll
    for (int n = 0; n < 16; ++n) {
        const int dvt = n >> 2, kt = n & 3, cb = n & 1;
        if (n + 1 < 16) tr = *(const u32x4*)(vbase + (size_t)(64 * ((n + 1) >> 2)) * 512 + 64 * ((n + 1) & 3));
        if (kt == 0) {
#pragma unroll
            for (int r = 0; r < 16; ++r) { o[0][r] = 0.f; o[1][r] = 0.f; }
        }
        const unsigned char* vb = sm + OFF_V + cb * VBUF;
#pragma unroll
        for (int dt = 0; dt < 2; ++dt) {
            const unsigned char* vp = vb + (32 * dt + i) * VROW + 8 * hi;
#pragma unroll
            for (int ks = 0; ks < 4; ++ks) {
                const u32x2 v_lo = *(const u32x2*)(vp + 32 * ks), v_hi = *(const u32x2*)(vp + 32 * ks + 16);
                const bf16x8 vf = __builtin_bit_cast(bf16x8, (u32x4){v_lo.x, v_lo.y, v_hi.x, v_hi.y});
                o[dt] = __builtin_amdgcn_mfma_f32_32x32x16_bf16(pf[kt][ks], vf, o[dt], 0, 0, 0);
            }
        }
        if (kt == 3) {
#pragma unroll
            for (int r = 0; r < 16; ++r) { bf16* op = om + (size_t)(row0 + crow(r, hi)) * DM + h * 256 + 64 * dvt + i;
                op[0] = (bf16)f2bf(o[0][r] * il[r >> 2][r & 3]); op[32] = (bf16)f2bf(o[1][r] * il[r >> 2][r & 3]); }
        }
        if (n + 1 < 16) { unsigned char* vp2 = vst + (cb ^ 1) * VBUF; *(u32x2*)vp2 = (u32x2){tr.x, tr.y}; *(u32x2*)(vp2 + 8) = (u32x2){tr.z, tr.w}; }
        __syncthreads();
    }
}
}

#define LAS __attribute__((address_space(3)))
#define XB_TMO      128
#define XB_XCNT(j)  (256  + 64 * (j))
#define XB_XSUB(j)  (1280 + 64 * (j))
#define XB_XGEN(j)  (2304 + 64 * (j))
#define XB_TOP      3328
#define XB_TOPGEN   3392
#define XCD_BAR_WORDS 3456
#define XB_SPIN_CAP (1u << 18)

__device__ __forceinline__ unsigned xb_ld(unsigned* p)              { return __hip_atomic_load(p, __ATOMIC_RELAXED, __HIP_MEMORY_SCOPE_AGENT); }
__device__ __forceinline__ unsigned xb_add(unsigned* p, unsigned v) { return __hip_atomic_fetch_add(p, v, __ATOMIC_RELAXED, __HIP_MEMORY_SCOPE_AGENT); }
__device__ __forceinline__ unsigned xb_xcc_id() { return (unsigned)__builtin_amdgcn_s_getreg((3 << 11) | 20) & 0xFu; }
#define XB_SPIN(cond, bar) do { unsigned _sp = 0; while (cond) { __builtin_amdgcn_s_sleep(1); \
    if ((++_sp & 255u) == 0u) { if (xb_ld(&(bar)[XB_TMO])) break; if (_sp > XB_SPIN_CAP) { atomicAdd(&(bar)[XB_TMO], 1u); break; } } } } while (0)

struct XcdBarrier {
    unsigned* bar; unsigned x;
    volatile LAS unsigned* st;
};

__device__ __forceinline__ XcdBarrier xcd_barrier_post(unsigned* bar, volatile LAS unsigned* st) {
    XcdBarrier b; b.bar = bar; b.x = xb_xcc_id(); b.st = st;
    if (tidx() == 0) (void)xb_add(&bar[XB_XCNT(b.x)], 1u);
    return b;
}
__device__ __forceinline__ void xcd_barrier_complete(unsigned* bar, unsigned x, unsigned& nloc, unsigned& nx) {
    const unsigned G = gridDim.x * gridDim.y * gridDim.z;
    unsigned sum, cnt, mine, sp = 0u;
    for (;;) {
        sum = 0u; cnt = 0u; mine = 0u;
#pragma unroll
        for (unsigned j = 0; j < 16; ++j) { const unsigned c = xb_ld(&bar[XB_XCNT(j)]); sum += c; cnt += (c > 0u) ? 1u : 0u; mine = (j == x) ? c : mine; }
        if (sum == G) break;
        __builtin_amdgcn_s_sleep(1);
        if ((++sp & 255u) == 0u) { if (xb_ld(&bar[XB_TMO])) break; if (sp > XB_SPIN_CAP) { atomicAdd(&bar[XB_TMO], 1u); break; } }
    }
    nloc = mine > 0u ? mine : 1u; nx = cnt > 0u ? cnt : 1u;
}

__device__ __forceinline__ void xcd_barrier(const XcdBarrier& b) {
    asm volatile("s_waitcnt vmcnt(0)" ::: "memory");
    __syncthreads();
    if (tidx() == 0) {
        unsigned* bar = b.bar;
        __builtin_amdgcn_s_waitcnt(0);
        unsigned nloc = b.st[0], nx = b.st[1];
        if (nloc == 0u) { xcd_barrier_complete(bar, b.x, nloc, nx); b.st[0] = nloc; b.st[1] = nx; }
        const unsigned old = xb_add(&bar[XB_XSUB(b.x)], 1u);
        const unsigned gen = old / nloc;
        if (old + 1u == (gen + 1u) * nloc) {
            __builtin_amdgcn_fence(__ATOMIC_RELEASE, "agent");
            asm volatile("s_waitcnt vmcnt(0)" ::: "memory");
            const unsigned og = xb_add(&bar[XB_TOP], 1u);
            const unsigned tg = og / nx;
            if (og + 1u == (tg + 1u) * nx) xb_add(&bar[XB_TOPGEN], 1u);
            else XB_SPIN(xb_ld(&bar[XB_TOPGEN]) == tg, bar);
            __builtin_amdgcn_fence(__ATOMIC_ACQUIRE, "agent");
            xb_add(&bar[XB_XGEN(b.x)], 1u);
            asm volatile("s_waitcnt vmcnt(0)" ::: "memory");
        } else {
            XB_SPIN(xb_ld(&bar[XB_XGEN(b.x)]) == gen, bar);
            __builtin_amdgcn_fence(__ATOMIC_ACQUIRE, "agent");
            asm volatile("s_waitcnt vmcnt(0)" ::: "memory");
        }
    }
    __syncthreads();
}

constexpr int NTHREADS = 512, LDS_BYTES = 147456;
struct MegaArgs { const float* in[41]; float* out; unsigned char* ws; };
#define WSB(off) ((bf16*)(ws + (off)))
#define WSF(off) ((float*)(ws + (off)))

__global__ void __launch_bounds__(NTHREADS) mega_fwd(MegaArgs A) {
    extern __shared__ __attribute__((aligned(16))) unsigned char lds[];
    cg::grid_group grid = cg::this_grid();
    const float* const* in = A.in; unsigned char* ws = A.ws; float* out = A.out;
    if (tidx() < 2) ((volatile LAS unsigned*)(lds + LDS_BYTES - 64))[tidx()] = 0u;
    __syncthreads();
    const XcdBarrier xbar = xcd_barrier_post((unsigned*)(ws + WS_CTL) + 16384, (volatile LAS unsigned*)(lds + LDS_BYTES - 64));

    d_convert(WSB(WS_W1GU), NGU, DM, MapGU{in[I_F1_WG], in[I_F1_WU], FF});
    d_convert(WSB(WS_W1D), DM, FF, MapPlain{in[I_F1_WD], DM});
    d_convert(WSB(WS_W2GU), NGU, DM, MapGU{in[I_F2_WG], in[I_F2_WU], FF});
    d_convert(WSB(WS_W2D), DM, FF, MapPlain{in[I_F2_WD], DM});
    d_convert(WSB(WS_WIN), NWIN, DM, MapWin{in[I_WIN], IN_COLS});
    d_convert(WSB(WS_WOUT), DM, DM, MapPlain{in[I_WOUT], DM});
    d_convert(WSB(WS_WQ), DM, DM, MapPlain{in[I_WQ], DM});
    d_convert(WSB(WS_WK), DM, DM, MapPlain{in[I_WK], DM});
    d_convert(WSB(WS_WV), DM, DM, MapPlain{in[I_WV], DM});
    d_convert(WSB(WS_WO), DM, DM, MapPlain{in[I_WO], DM});
    d_convert(WSB(WS_CW1K), 256, 2048, MapPlain{in[I_W1_K], 256});
    d_convert(WSB(WS_CW1V), 256, 2048, MapPlain{in[I_W1_V], 256});
    d_convert_lora(WSB(WS_WLORA), in[I_W2], in[I_A2], in[I_G2]);
    d_rope_table(WSF(WS_ROPE));
    d_cmp_bias(in[I_PE_K], in[I_W1_K], in[I_PE_V], in[I_W1_V], WSF(WS_CBIAS), (float*)lds);
    d_rownorm(in[I_X], in[I_F1_PRE], WSB(WS_XN), M_);
    d_rownorm(in[I_MEM], in[I_MEM_KVG], WSB(WS_MEMN), 512);
    grid.sync();
    gemm_pg8(lds, WSB(WS_XN), DM, WSB(WS_W1GU), DM, M_, NGU, DM, EpiSwiGLU{WSB(WS_HB)});
    xcd_barrier(xbar);
    gemm_norm_res(lds, WSB(WS_HB), FF, WSB(WS_W1D), FF, in[I_X], out, WSB(WS_XN), in[I_F1_POST], in[I_MIX_PRE], 0.5f, WSB(WS_YB), (unsigned*)(ws + WS_GATES), (unsigned*)(ws + WS_CTL) + 1024 + 0 * 2048);
    xcd_barrier(xbar);
    gemm_pg8(lds, WSB(WS_XN), DM, WSB(WS_WIN), DM, M_, NWIN, DM,
             EpiWin{WSB(WS_QB), WSB(WS_KS), WSB(WS_KW), WSB(WS_KCR), WSB(WS_VCR), WSB(WS_VST), WSB(WS_VWT), (unsigned*)(ws + WS_RKVA), WSB(WS_RKVA + 32 * MiB), WSB(WS_PRL), WSF(WS_GATES), WSF(WS_ROPE)});
    xcd_barrier(xbar);
    gemm_pg8(lds, WSB(WS_KCR), 1024, WSB(WS_CW1K), 2048, 2048, 256, 2048, EpiBiasSilu{WSB(WS_HIDK), WSF(WS_CBIAS)});
    gemm_pg8(lds, WSB(WS_VCR), 1024, WSB(WS_CW1V), 2048, 2048, 256, 2048, EpiBiasSilu{WSB(WS_HIDV), WSF(WS_CBIAS) + 256});
    d_lora_prep(WSB(WS_PRL), in[I_MU], WSB(WS_XN));
    xcd_barrier(xbar);
    d_cmp2(WSB(WS_HIDK), WSB(WS_HIDV), in[I_W2_K], in[I_W2_V], WSF(WS_ROPE), WSB(WS_KC), WSB(WS_VCT));
    gemm_pg8(lds, WSB(WS_XN), KLORA, WSB(WS_WLORA), KLORA, M_, NLORA, KLORA, EpiLora{WSF(WS_YB), WSB(WS_RKVA + 48 * MiB), WSB(WS_AGG), in[I_W0], in[I_A0]});
    xcd_barrier(xbar);
    if (blockIdx.x < 16 * (1 + rw7::NHELP)) {
        const rw7::Args ra{(const unsigned*)(ws + WS_RKVA), WSB(WS_RKVA + 32 * MiB), WSB(WS_RKVA + 48 * MiB), WSF(WS_YB), in[I_MU], in[I_KK], in[I_KA], in[I_RK], WSF(WS_YB), WSF(WS_BONUS),
                           ws + WS_KCR + 1 * MiB, (unsigned*)(ws + WS_CTL) + 32768, (unsigned*)(ws + WS_CTL) + 24576};
        if (blockIdx.x < 16) rw7::head(ra, blockIdx.x, lds);
        else rw7::helper(ra, (blockIdx.x - 16) % 16, (blockIdx.x - 16) / 16, lds);
        __syncthreads();
    }
    {
        const NsaArgs na{WSB(WS_QB), WSB(WS_KC), WSB(WS_VCT), WSB(WS_KS), WSB(WS_VST), WSB(WS_KW), WSB(WS_VWT), WSF(WS_GATES), WSB(WS_XN)};
        nsa::phase(na, (unsigned*)(ws + WS_CTL), lds);
    }
    xcd_barrier(xbar);
    d_nsa_outnorm(WSB(WS_XN), in[I_NSA_G]);
    rw7::finish(WSF(WS_YB), WSF(WS_BONUS), WSB(WS_RKVA + 32 * MiB), WSB(WS_AGG), in[I_MU], in[I_GNG], in[I_GNB], WSB(WS_XN));
    xcd_barrier(xbar);
    gemm_norm_res(lds, WSB(WS_XN), DM, WSB(WS_WOUT), DM, out, out, WSB(WS_XN), in[I_MIX_POST], in[I_MEM_PRE], 1.0f, WSB(WS_YB), (unsigned*)(ws + WS_GATES), (unsigned*)(ws + WS_CTL) + 1024 + 1 * 2048);
    xcd_barrier(xbar);
    gemm_pg8(lds, WSB(WS_XN), DM, WSB(WS_WQ), DM, M_, DM, DM, EpiStore{WSB(WS_QM), DM, MSCALE});
    gemm_pg8(lds, WSB(WS_MEMN), DM, WSB(WS_WK), DM, 512, DM, DM, EpiStore{WSB(WS_MK), DM, 1.f});
    gemm_pg8(lds, WSB(WS_WV), DM, WSB(WS_MEMN), DM, DM, 512, DM, EpiStore{WSB(WS_MVT), 512, 1.f});
    xcd_barrier(xbar);
    for (int u = blockIdx.x; u < 256; u += gridDim.x) mema::unit(WSB(WS_QM), WSB(WS_MK), WSB(WS_MVT), WSB(WS_OM), u, lds);
    xcd_barrier(xbar);
    gemm_norm_res(lds, WSB(WS_OM), DM, WSB(WS_WO), DM, out, out, WSB(WS_XN), in[I_MEM_POST], in[I_F2_PRE], 1.0f, WSB(WS_YB), (unsigned*)(ws + WS_GATES), (unsigned*)(ws + WS_CTL) + 1024 + 2 * 2048);
    xcd_barrier(xbar);
    gemm_pg8(lds, WSB(WS_XN), DM, WSB(WS_W2GU), DM, M_, NGU, DM, EpiSwiGLU{WSB(WS_HB)});
    xcd_barrier(xbar);
    gemm_norm_res(lds, WSB(WS_HB), FF, WSB(WS_W2D), FF, out, out, (bf16*)nullptr, in[I_F2_POST], (const float*)nullptr, 0.5f, WSB(WS_YB), (unsigned*)(ws + WS_GATES), (unsigned*)(ws + WS_CTL) + 1024 + 3 * 2048);
}

extern "C" void kernel_launch(void* const* d_in, const int* in_sizes, int n_in, void* d_out, int out_size, void* d_ws, size_t ws_size, hipStream_t stream) {
    static int grid = 0;
    if (grid == 0) {
        if (n_in != 41 || ws_size < WS_END) { fprintf(stderr, "kernel_launch: unexpected n_in %d / ws %zu\n", n_in, ws_size); grid = -1; return; }
        int dev = 0, cus = 0, per_cu = 0;
        hipGetDevice(&dev); hipDeviceGetAttribute(&cus, hipDeviceAttributeMultiprocessorCount, dev);
        if (hipFuncSetAttribute((const void*)mega_fwd, hipFuncAttributeMaxDynamicSharedMemorySize, LDS_BYTES) != hipSuccess) { fprintf(stderr, "kernel_launch: hipFuncSetAttribute failed\n"); grid = -1; return; }
        if (hipOccupancyMaxActiveBlocksPerMultiprocessor(&per_cu, (const void*)mega_fwd, NTHREADS, LDS_BYTES) != hipSuccess || per_cu < 1) { fprintf(stderr, "kernel_launch: occupancy query says %d\n", per_cu); grid = -1; (void)hipGetLastError(); return; }
        grid = cus;
        if (grid != 256) { fprintf(stderr, "kernel_launch: built for 256 CUs (one 256x256 tile per workgroup in the fused norm epilogues), found %d\n", cus); grid = -1; return; }
    }
    if (grid < 0) return;
    MegaArgs a{};
    for (int i = 0; i < 41; ++i) a.in[i] = (const float*)d_in[i];
    a.out = (float*)d_out; a.ws = (unsigned char*)d_ws;
    hipMemsetAsync(d_ws, 0, 196608, stream);
    void* args[] = {&a};
    hipError_t e = hipLaunchCooperativeKernel((const void*)mega_fwd, dim3(grid), dim3(NTHREADS), args, LDS_BYTES, stream);
    if (e != hipSuccess) fprintf(stderr, "kernel_launch: cooperative launch failed: %s (grid %d)\n", hipGetErrorString(e), grid);
}
```

```cpp
#include <hip/hip_runtime.h>
#include <hip/hip_cooperative_groups.h>
#include <cstdint>
#include <cstdio>

constexpr int NB = 2, T_ = 8192, DM = 1024, M_ = NB * T_;
constexpr int FF = 2816, NGU = 2 * FF;
constexpr int IN_COLS = 3096, NWIN = 3328;
constexpr int NRW = 1792;
constexpr int NCP = 512;
constexpr int NLORA = 1536, KLORA = 256;
constexpr float NORM_EPS = 1e-6f;
constexpr float QSCALE = 0.125f * 1.4426950408889634f;
constexpr float MSCALE = 0.0625f * 1.4426950408889634f;

typedef unsigned short bf16;
typedef short bf16x8 __attribute__((ext_vector_type(8)));
typedef float f32x4 __attribute__((ext_vector_type(4)));
typedef unsigned u32x2 __attribute__((ext_vector_type(2)));
typedef unsigned u32x4 __attribute__((ext_vector_type(4)));

__device__ __forceinline__ unsigned f2bf(float f) { unsigned u = __builtin_bit_cast(unsigned, f); return (u + 0x7fffu + ((u >> 16) & 1u)) >> 16; }
__device__ __forceinline__ float bf2f(bf16 h) { return __builtin_bit_cast(float, (unsigned)h << 16); }
typedef float f32x2_t __attribute__((ext_vector_type(2))); typedef __bf16 bf16x2_t __attribute__((ext_vector_type(2)));
__device__ __forceinline__ unsigned pk2(float lo, float hi) { const f32x2_t v = {lo, hi}; return __builtin_bit_cast(unsigned, __builtin_convertvector(v, bf16x2_t)); }
__device__ __forceinline__ void st_bf4(bf16* p, f32x4 v) { u32x2 w; w.x = pk2(v[0], v[1]); w.y = pk2(v[2], v[3]); *(u32x2*)p = w; }
__device__ __forceinline__ float wave_sum(float v) {
#pragma unroll
    for (int o = 1; o < 64; o <<= 1) v += __shfl_xor(v, o);
    return v;
}
__device__ __forceinline__ float wave_max(float v) {
#pragma unroll
    for (int o = 1; o < 64; o <<= 1) v = fmaxf(v, __shfl_xor(v, o));
    return v;
}
__device__ __forceinline__ float sigmoidf_(float x) { return 1.f / (1.f + __expf(-x)); }
__device__ __forceinline__ int tidx() { int t = threadIdx.x; asm volatile("" : "+v"(t)); return t; }

constexpr size_t MiB = 1u << 20, KiB64 = 65536;
constexpr size_t WS_CTL = 0;
constexpr size_t WS_KC = 256 * 1024;
constexpr size_t WS_VCT = 512 * 1024;
constexpr size_t WS_W1GU = 1 * MiB;
constexpr size_t WS_W1D = 12 * MiB;
constexpr size_t WS_W2GU = WS_W1D + 88 * KiB64;
constexpr size_t WS_W2D = WS_W2GU + 11 * MiB;
constexpr size_t WS_WIN = WS_W2D + 88 * KiB64;
constexpr size_t WS_WOUT = WS_WIN + 104 * KiB64;
constexpr size_t WS_WQ = WS_WOUT + 2 * MiB, WS_WK = WS_WQ + 2 * MiB, WS_WV = WS_WK + 2 * MiB, WS_WO = WS_WV + 2 * MiB;
constexpr size_t WS_CW1K = WS_WO + 2 * MiB, WS_CW1V = WS_CW1K + 1 * MiB;
constexpr size_t WS_WLORA = WS_CW1V + 1 * MiB;
constexpr size_t WS_ROPE = WS_WLORA + 12 * KiB64;
constexpr size_t WS_CBIAS = WS_ROPE + 2 * MiB;
constexpr size_t WS_MEMN = WS_CBIAS + KiB64;
constexpr size_t WS_HIDK = WS_MEMN + 1 * MiB;
constexpr size_t WS_HIDV = WS_HIDK + 1 * MiB;
constexpr size_t WS_GATES = WS_HIDV + 1 * MiB;
constexpr size_t WS_XN = 60 * MiB;
constexpr size_t WS_YB = 92 * MiB;
constexpr size_t WS_D = 124 * MiB;
constexpr size_t WS_HB = WS_D;
constexpr size_t WS_QB = WS_D;
constexpr size_t WS_KS = WS_D + 16 * MiB;
constexpr size_t WS_KW = WS_D + 20 * MiB;
constexpr size_t WS_KCR = WS_D + 24 * MiB;
constexpr size_t WS_VCR = WS_D + 29 * MiB;
constexpr size_t WS_VST = WS_D + 34 * MiB;
constexpr size_t WS_VWT = WS_D + 38 * MiB;
constexpr size_t WS_RKVA = WS_D + 42 * MiB;
constexpr size_t WS_PRL = WS_D + 106 * MiB;
constexpr size_t WS_AGG = WS_D + 114 * MiB;
constexpr size_t WS_BONUS = WS_KCR;
constexpr size_t WS_END = 256 * MiB;
constexpr size_t WS_QM = WS_D;
constexpr size_t WS_OM = WS_D + 32 * MiB;
constexpr size_t WS_MK = WS_D + 64 * MiB;
constexpr size_t WS_MVT = WS_D + 65 * MiB;
static_assert(WS_GATES + (size_t)M_ * 24 * 4 <= WS_XN, "ws map");
static_assert(WS_AGG + 16 * MiB <= WS_END, "ws map");

struct Params {
    const float* in[41];
    float* out;
    unsigned char* ws;
};
enum { I_X = 0, I_MEM, I_F1_PRE, I_F1_WG, I_F1_WU, I_F1_WD, I_F1_POST, I_MIX_PRE, I_WIN, I_PE_K, I_W1_K, I_W2_K, I_PE_V, I_W1_V, I_W2_V,
       I_NSA_G, I_MU, I_W0, I_W2, I_A0, I_A2, I_G2, I_KK, I_KA, I_RK, I_GNG, I_GNB, I_WOUT, I_MIX_POST, I_MEM_PRE, I_MEM_KVG, I_WQ, I_WK, I_WV,
       I_WO, I_MEM_POST, I_F2_PRE, I_F2_WG, I_F2_WU, I_F2_WD, I_F2_POST };

struct MapPlain { const float* W; int N; int pad; __device__ const float* col(int p) const { return W + p; } };
struct MapGU {
    const float* Wg; const float* Wu; int N; int pad;
    __device__ const float* col(int p) const {
        const int pn = p >> 8, q = p & 255, n = (q >> 4) & 1;
        const int hid = 128 * pn + 64 * (q >> 7) + 16 * ((q >> 5) & 3) + (q & 15);
        return Wg + (size_t)n * (size_t)(Wu - Wg) + hid;
    }
};
__host__ __device__ inline int rope_perm(int x) { return 16 * ((x >> 5) & 1) + (x & 15) + 32 * ((x >> 4) & 1); }
struct MapWin {
    const float* W; int N; int pad;
    __device__ const float* col(int p) const {
        int l;
        if (p < 512) l = (p & ~63) + rope_perm(p & 63);
        else if (p < 640) l = 768 + ((p - 512) & ~63) + rope_perm(p & 63);
        else if (p < 768) l = 1024 + ((p - 640) & ~63) + rope_perm(p & 63);
        else if (p < 896) l = 512 + (p - 768);
        else if (p < 1024) l = 640 + (p - 896);
        else if (p < 1152) l = 896 + (p - 1024);
        else if (p < 1280) l = 1152 + (p - 1152);
        else if (p < 2304) { const int q = p - 1280; l = 1304 + (((q >> 4) & 1) ? 512 : 0) + 16 * (q >> 5) + (q & 15); }
        else if (p < 3072) l = 1304 + (p - 1280);
        else if (p < 3096) l = 1280 + (p - 3072);
        else return nullptr;
        return W + l;
    }
};

#define FOR_VB(vb, n) for (int vb = (int)blockIdx.x * 2 + (T512 >> 8); vb < (n); vb += (int)gridDim.x * 2)

template <class Map> __device__ __forceinline__ void d_convert(bf16* WT, int Np, int K, Map map) {
    const int T512 = tidx(), tid = T512 & 255, nbx = Np / 64, nb = nbx * (K / 64);
    FOR_VB(vb, nb) {
        const int p = (vb % nbx) * 64 + (tid & 63), k0 = (vb / nbx) * 64 + (tid >> 6) * 16;
        const float* src = map.col(p);
        float v[16];
#pragma unroll
        for (int i = 0; i < 16; ++i) v[i] = src ? src[(size_t)(k0 + i) * map.N] : 0.f;
        u32x4 a, b;
        a.x = pk2(v[0], v[1]); a.y = pk2(v[2], v[3]); a.z = pk2(v[4], v[5]); a.w = pk2(v[6], v[7]);
        b.x = pk2(v[8], v[9]); b.y = pk2(v[10], v[11]); b.z = pk2(v[12], v[13]); b.w = pk2(v[14], v[15]);
        u32x4* dst = (u32x4*)(WT + (size_t)p * K + k0);
        dst[0] = a; dst[1] = b;
    }
}
__device__ __forceinline__ void d_convert_lora(bf16* WT, const float* w2, const float* a2, const float* g2) {
    const int T512 = tidx(), tid = T512 & 255;
    FOR_VB(vb, NLORA * KLORA / 256) {
        const int idx = vb * 256 + tid, p = idx >> 8, k = idx & 255;
        float v = 0.f;
        if (p < 512) { if (k < 64) v = w2[k * 512 + p]; }
        else if (p < 1024) { if (k >= 64 && k < 128) v = a2[(k - 64) * 512 + (p - 512)]; }
        else { if (k >= 128) v = g2[(k - 128) * 512 + (p - 1024)]; }
        WT[idx] = (bf16)f2bf(v);
    }
}
__device__ __forceinline__ void d_rope_table(float* tab) {
    const int T512 = tidx(), tid = T512 & 255;
    FOR_VB(vb, T_ * 32 / 256) {
        const int idx = vb * 256 + tid, pos = idx >> 5, i = idx & 31;
        const float inv = (float)pow(10000.0, -(double)i / 32.0);
        const float ang = (float)pos * inv;
        tab[2 * idx] = (float)cos((double)ang); tab[2 * idx + 1] = (float)sin((double)ang);
    }
}
__device__ __forceinline__ void d_cmp_bias(const float* pe_k, const float* w1_k, const float* pe_v, const float* w1_v, float* bias, float* red  ) {
    for (int job = blockIdx.x; job < 8; job += gridDim.x) {
        const int kv = job >> 2; const float* pe = kv ? pe_v : pe_k; const float* w1 = kv ? w1_v : w1_k;
        const int T512 = tidx(), lane = T512 & 63, w = T512 >> 6, n = (job & 3) * 64 + lane;
        float s = 0.f;
        for (int j = w * 256; j < w * 256 + 256; ++j) s += pe[j] * w1[(size_t)j * 256 + n];
        red[w * 64 + lane] = s; __syncthreads();
        if (w == 0) { float t = 0.f; for (int i = 0; i < 8; ++i) t += red[i * 64 + lane]; bias[kv * 256 + n] = t; }
        __syncthreads();
    }
}
__device__ __forceinline__ void d_rownorm(const float* x, const float* g, bf16* xn, int rows) {
    const int T512 = tidx(), tid = T512 & 255, lane = tid & 63;
    FOR_VB(vb, rows / 4) {
        const int row = vb * 4 + (tid >> 6);
        const f32x4* xr = (const f32x4*)(x + (size_t)row * DM) + lane; f32x4 v[4]; float s = 0.f;
#pragma unroll
        for (int j = 0; j < 4; ++j) { v[j] = xr[64 * j]; s += v[j][0] * v[j][0] + v[j][1] * v[j][1] + v[j][2] * v[j][2] + v[j][3] * v[j][3]; }
        const float rstd = rsqrtf(wave_sum(s) * (1.f / DM) + NORM_EPS);
#pragma unroll
        for (int j = 0; j < 4; ++j) { const f32x4 gg = ((const f32x4*)g)[lane + 64 * j]; st_bf4(xn + (size_t)row * DM + 4 * (lane + 64 * j), v[j] * rstd * gg); }
    }
}
__device__ __forceinline__ void d_rowpass(const float* xin, const bf16* y, const float* gpost, float coef, const float* gpre, float* xout, bf16* xn) {
    const int T512 = tidx(), tid = T512 & 255, lane = tid & 63;
    FOR_VB(vb, M_ / 4) {
        const int row = vb * 4 + (tid >> 6);
        f32x4 yv[4], xv[4]; float s = 0.f;
#pragma unroll
        for (int j = 0; j < 4; ++j) {
            const u32x2 w = *(const u32x2*)(y + (size_t)row * DM + 4 * (lane + 64 * j));
            yv[j][0] = __builtin_bit_cast(float, w.x << 16); yv[j][1] = __builtin_bit_cast(float, w.x & 0xffff0000u);
            yv[j][2] = __builtin_bit_cast(float, w.y << 16); yv[j][3] = __builtin_bit_cast(float, w.y & 0xffff0000u);
            s += yv[j][0] * yv[j][0] + yv[j][1] * yv[j][1] + yv[j][2] * yv[j][2] + yv[j][3] * yv[j][3];
            xv[j] = ((const f32x4*)(xin + (size_t)row * DM))[lane + 64 * j];
        }
        const float rstd = rsqrtf(wave_sum(s) * (1.f / DM) + NORM_EPS) * coef; float s2 = 0.f;
#pragma unroll
        for (int j = 0; j < 4; ++j) { const f32x4 gg = ((const f32x4*)gpost)[lane + 64 * j]; xv[j] = xv[j] + yv[j] * rstd * gg;
            s2 += xv[j][0] * xv[j][0] + xv[j][1] * xv[j][1] + xv[j][2] * xv[j][2] + xv[j][3] * xv[j][3];
            ((f32x4*)(xout + (size_t)row * DM))[lane + 64 * j] = xv[j]; }
        if (gpre) {
            const float r2 = rsqrtf(wave_sum(s2) * (1.f / DM) + NORM_EPS);
#pragma unroll
            for (int j = 0; j < 4; ++j) { const f32x4 gg = ((const f32x4*)gpre)[lane + 64 * j]; st_bf4(xn + (size_t)row * DM + 4 * (lane + 64 * j), xv[j] * r2 * gg); }
        }
    }
}
__device__ __forceinline__ void d_nsa_outnorm(bf16* amix, const float* g) {
    const int T512 = tidx(), tid = T512 & 255, lane = tid & 63;
    FOR_VB(vb, M_ / 4) {
        const int row = vb * 4 + (tid >> 6);
        bf16* p = amix + (size_t)row * DM + 8 * lane;
        const u32x4 w = *(const u32x4*)p; float v[8]; float s = 0.f;
        v[0] = __builtin_bit_cast(float, w.x << 16); v[1] = __builtin_bit_cast(float, w.x & 0xffff0000u);
        v[2] = __builtin_bit_cast(float, w.y << 16); v[3] = __builtin_bit_cast(float, w.y & 0xffff0000u);
        v[4] = __builtin_bit_cast(float, w.z << 16); v[5] = __builtin_bit_cast(float, w.z & 0xffff0000u);
        v[6] = __builtin_bit_cast(float, w.w << 16); v[7] = __builtin_bit_cast(float, w.w & 0xffff0000u);
#pragma unroll
        for (int i = 0; i < 8; ++i) s += v[i] * v[i];
        const float rstd = rsqrtf(wave_sum(s) * (1.f / 512.f) + NORM_EPS);
        u32x4 o; const float* gg = g + 8 * lane;
        o.x = pk2(v[0] * rstd * gg[0], v[1] * rstd * gg[1]); o.y = pk2(v[2] * rstd * gg[2], v[3] * rstd * gg[3]);
        o.z = pk2(v[4] * rstd * gg[4], v[5] * rstd * gg[5]); o.w = pk2(v[6] * rstd * gg[6], v[7] * rstd * gg[7]);
        *(u32x4*)p = o;
    }
}

struct EpiStore { bf16* O; int ldc; float scale;
    static constexpr int NCAT = 1;
    __device__ __forceinline__ int cat(int) const { return 0; }
    template <int C> __device__ __forceinline__ void apply(int row, int p, f32x4 v0, f32x4 v1) const { bf16* o = O + (size_t)row * ldc + p; st_bf4(o, v0 * scale); st_bf4(o + 16, v1 * scale); } };
struct EpiSwiGLU { bf16* H;
    static constexpr int NCAT = 1;
    __device__ __forceinline__ int cat(int) const { return 0; }
    template <int C> __device__ __forceinline__ void apply(int row, int p, f32x4 g, f32x4 u) const {
        const int q = p & 255, hid = 128 * (p >> 8) + 64 * (q >> 7) + 16 * ((q >> 5) & 3) + (q & 15);
        f32x4 h;
#pragma unroll
        for (int e = 0; e < 4; ++e) h[e] = g[e] / (1.f + __expf(-g[e])) * u[e];
        st_bf4(H + (size_t)row * FF + hid, h); } };
struct EpiBiasSilu { bf16* O; const float* bias;
    static constexpr int NCAT = 1;
    __device__ __forceinline__ int cat(int) const { return 0; }
    template <int C> __device__ __forceinline__ void apply(int row, int p, f32x4 v0, f32x4 v1) const {
        f32x4 a, b; const f32x4 b0 = *(const f32x4*)(bias + p), b1 = *(const f32x4*)(bias + p + 16);
#pragma unroll
        for (int e = 0; e < 4; ++e) { const float x0 = v0[e] + b0[e], x1 = v1[e] + b1[e]; a[e] = x0 / (1.f + __expf(-x0)); b[e] = x1 / (1.f + __expf(-x1)); }
        bf16* o = O + (size_t)row * 256 + p; st_bf4(o, a); st_bf4(o + 16, b); } };
struct EpiLora { float* wdec; bf16* aga; bf16* agg; const float* w0; const float* a0;
    static constexpr int NCAT = 3;
    __device__ __forceinline__ int cat(int p0) const { return p0 < 512 ? 0 : (p0 < 1024 ? 1 : 2); }
    template <int C> __device__ __forceinline__ void one(int row, int p, f32x4 v) const {
        if (C == 0) { f32x4 o; const f32x4 ww = *(const f32x4*)(w0 + p);
#pragma unroll
            for (int e = 0; e < 4; ++e) o[e] = __expf(-0.6065306597126334f * sigmoidf_(ww[e] + v[e]));
            *(f32x4*)(wdec + (size_t)row * 512 + p) = o;
        } else if (C == 1) { f32x4 o; const f32x4 aa = *(const f32x4*)(a0 + p - 512);
#pragma unroll
            for (int e = 0; e < 4; ++e) o[e] = sigmoidf_(aa[e] + v[e]);
            st_bf4(aga + (size_t)row * 512 + (p - 512), o);
        } else st_bf4(agg + (size_t)row * 512 + (p - 1024), v);
    }
    template <int C> __device__ __forceinline__ void apply(int row, int p, f32x4 v0, f32x4 v1) const { one<C>(row, p, v0); one<C>(row, p + 16, v1); } };
struct EpiWin {
    bf16 *qb, *ks, *kw, *kcr, *vcr, *vst, *vwt; unsigned* rk; bf16 *vv, *prl; float* gates; const float* rope;
    static constexpr int NCAT = 8;
    __device__ __forceinline__ int cat(int p0) const { return p0 < 512 ? 0 : (p0 < 768 ? 1 : (p0 < 1024 ? 2 : (p0 < 1280 ? 3 : (p0 < 2304 ? 4 : (p0 < 2816 ? 7 : (p0 < 3072 ? 6 : 5)))))); }
    template <int C> __device__ __forceinline__ void apply(int row, int p, f32x4 v0, f32x4 v1) const {
        const int b = row / T_, t = row % T_;
        if (C == 0 || C == 1) {
            const int x = p & 63, d = 16 * ((x >> 5) & 1) + (x & 15);
            const f32x4* rp = (const f32x4*)(rope + ((size_t)t * 32 + d) * 2); const f32x4 r0 = rp[0], r1 = rp[1];
            const f32x4 cs = {r0[0], r0[2], r1[0], r1[2]}, sn = {r0[1], r0[3], r1[1], r1[3]};
            const f32x4 lo = v0 * cs - v1 * sn, hi = v0 * sn + v1 * cs;
            if (C == 0) { bf16* o = qb + (size_t)row * 512 + (p & ~63) + d; st_bf4(o, lo * QSCALE); st_bf4(o + 32, hi * QSCALE); }
            else { const int g = ((p - 512) >> 6) & 1; bf16* base = (p < 640) ? ks : kw; bf16* o = base + ((size_t)(b * 2 + g) * T_ + t) * 64 + d; st_bf4(o, lo); st_bf4(o + 32, hi); }
        } else if (C == 2) {
            const int c = (p - 768) & 127, g = c >> 6, d = c & 63; bf16* base = (p < 896) ? kcr : vcr;
            bf16* o = base + ((size_t)(b * 2 + g) * T_ + t) * 64 + d; st_bf4(o, v0); st_bf4(o + 16, v1);
        } else if (C == 3) {
            const int c = (p - 1024) & 127, g = c >> 6, d = c & 63; bf16* base = (p < 1152) ? vst : vwt;
            bf16* o = base + ((size_t)(b * 2 + g) * 64 + d) * T_ + t;
#pragma unroll
            for (int e = 0; e < 4; ++e) { o[(size_t)e * T_] = (bf16)f2bf(v0[e]); o[(size_t)(16 + e) * T_] = (bf16)f2bf(v1[e]); }
        } else if (C == 4) {
            const int q = p - 1280, ch = 16 * (q >> 5) + (q & 15);
            u32x4 w; w.x = pk2(v0[0], v1[0]); w.y = pk2(v0[1], v1[1]); w.z = pk2(v0[2], v1[2]); w.w = pk2(v0[3], v1[3]);
            *(u32x4*)(rk + (size_t)row * 512 + ch) = w;
        } else if (C == 7) {
            bf16* o = vv + (size_t)row * 512 + (p - 2304); st_bf4(o, v0); st_bf4(o + 16, v1);
        } else if (C == 6) {
            bf16* o = prl + (size_t)row * 256 + (p - 2816); st_bf4(o, v0); st_bf4(o + 16, v1);
        } else {
            const int c = p - 3072; float* o = gates + (size_t)row * 24 + c;
            if (c < 24) { f32x4 s = {sigmoidf_(v0[0]), sigmoidf_(v0[1]), sigmoidf_(v0[2]), sigmoidf_(v0[3])}; *(f32x4*)o = s; }
            if (c + 16 < 24) { f32x4 s = {sigmoidf_(v1[0]), sigmoidf_(v1[1]), sigmoidf_(v1[2]), sigmoidf_(v1[3])}; *(f32x4*)(o + 16) = s; }
        }
    }
};

namespace pg8 {
#define PG8_LAS __attribute__((address_space(3)))
typedef unsigned short bf16_t;
typedef short bf16x8 __attribute__((ext_vector_type(8)));
typedef float f32x4 __attribute__((ext_vector_type(4)));
typedef unsigned u32x4 __attribute__((ext_vector_type(4)));
constexpr int BM = 256, BK = 64, HALF = 128, HTB = HALF * BK * 2  , STAGE_BYTES = 8 * HTB, NXCD = 8, WGM = 8;

__host__ __device__ __forceinline__ int lds_byte(int r, int c) { const int st = (r >> 4) * 2 + (c >> 5), rr = r & 15, cc = c & 31, ob = rr * 64 + cc * 2; return st * 1024 + (ob ^ (((ob >> 9) & 1) << 5)); }
__host__ __device__ __forceinline__ void stage_rc(int b, int& R, int& C) { const int st = b / 1024, sb = b % 1024, swz = sb ^ (((sb >> 9) & 1) << 5); R = (st >> 1) * 16 + swz / 64; C = (st & 1) * 32 + (swz % 64) / 2; }
__host__ __device__ __forceinline__ int perm32(int rho) { const int n = rho >> 4, i = rho & 15; return 8 * (i >> 2) + 4 * n + (i & 3); }

struct Unit { int pm, pn; };
struct Gemm { const bf16_t* A; const bf16_t* Bt; int M, N, K, lda, ldb; };

struct StaticOrder {
    int nM, nN, nwg, G, c;
    __host__ __device__ void init(int M, int N, int G_, int c_) { nM = M / BM; nN = N / BM; nwg = nM * nN; G = G_; c = c_; }
    __host__ __device__ bool next(int i, Unit& u) const {
        const long L = (long)i * G + c; if (L >= nwg) return false;
        int wgid = (int)L; { const int q = nwg / NXCD, r = nwg % NXCD, xcd = wgid % NXCD, off = wgid / NXCD; wgid = (xcd < r ? xcd * (q + 1) : r * (q + 1) + (xcd - r) * q) + off; }
        const int nig = WGM * nN, gid = wgid / nig, fm = gid * WGM, gsz = (nM - fm) < WGM ? (nM - fm) : WGM;
        u.pm = fm + ((wgid % nig) % gsz); u.pn = (wgid % nig) / gsz; return true;
    }
    __device__ __forceinline__ void a_ready(const Unit&) const {}
    __device__ __forceinline__ void done(const Unit&) const {}
};

template <class Epi, class Sched, bool ALIGN_EPI = false, bool SP2 = false>
__device__ __forceinline__ void gemm_phase(PG8_LAS unsigned char* lds, const Gemm g, const Sched& S, const Epi& E) {
    const int tid = tidx(), wid = __builtin_amdgcn_readfirstlane(tid >> 6), lane = tid & 63, wr = wid >> 2, wc = wid & 3, fr = lane & 15, fq = lane >> 4;
    const int K = g.K, nt = K / BK;
    unsigned voffA[2], voffB[2];
#pragma unroll
    for (int i = 0; i < 2; ++i) { int R, C; stage_rc(tid * 16 + i * 8192, R, C); const int Rb = Epi::PERM ? ((R & ~31) + perm32(R & 31)) : R;
        voffA[i] = (unsigned)(R * g.lda + C) * 2u; voffB[i] = (unsigned)(Rb * g.ldb + C) * 2u; }
    const size_t kstep = (size_t)(BK * 2);
    const size_t hstepA = (size_t)HALF * g.lda * 2, hstepB = (size_t)HALF * g.ldb * 2;
    const size_t tstepA = 2 * hstepA, tstepB = 2 * hstepB;
    const unsigned ldsw = (unsigned)wid * 1024u;
    const int aoff = lds_byte(wr * 64 + fr, fq * 8), boff = lds_byte(wc * 32 + fr, fq * 8);
#define PG8_SA(b, h) (((b) * 2 + (h)) * HTB)
#define PG8_SB(b, h) ((4 + (b) * 2 + (h)) * HTB)
#define PG8_STAGE(bufoff, gbase, voff) do { _Pragma("unroll") for (int _i = 0; _i < 2; ++_i) \
        __builtin_amdgcn_global_load_lds((const unsigned*)((const char*)(gbase) + (voff)[_i]), (PG8_LAS unsigned*)(lds + (bufoff) + ldsw + _i * 8192), 16, 0, 0); } while (0)
#define PG8_LDA(dst, b, h) do { _Pragma("unroll") for (int m = 0; m < 4; ++m) _Pragma("unroll") for (int k = 0; k < 2; ++k) dst[m][k] = *(const PG8_LAS bf16x8*)(lds + PG8_SA(b, h) + aoff + m * 2048 + k * 1024); } while (0)
#define PG8_LDB(dst, b, h) do { _Pragma("unroll") for (int n = 0; n < 2; ++n) _Pragma("unroll") for (int k = 0; k < 2; ++k) dst[n][k] = *(const PG8_LAS bf16x8*)(lds + PG8_SB(b, h) + boff + n * 2048 + k * 1024); } while (0)
#define PG8_MMA(ai, bj, At, Bt) do { __builtin_amdgcn_s_setprio(1); _Pragma("unroll") for (int m = 0; m < 4; ++m) _Pragma("unroll") for (int n = 0; n < 2; ++n) _Pragma("unroll") for (int k = 0; k < 2; ++k) \
        acc[ai][bj][m][n] = __builtin_amdgcn_mfma_f32_16x16x32_bf16(Bt[n][k], At[m][k], acc[ai][bj][m][n], 0, 0, 0); __builtin_amdgcn_s_setprio(0); } while (0)
#define PG8_WAIT_V(n) asm volatile("s_waitcnt vmcnt(" #n ")" ::: "memory")
#define PG8_WAIT_L(n) asm volatile("s_waitcnt lgkmcnt(" #n ")" ::: "memory")
#define PG8_BAR __builtin_amdgcn_s_barrier()
#define PG8_SCHED __builtin_amdgcn_sched_barrier(0)
    Unit cur, nxt; int ui = 0;
    if (!S.next(0, cur)) return;
    f32x4 acc[2][2][4][2];
#pragma unroll
    for (int a = 0; a < 2; ++a)
#pragma unroll
        for (int b = 0; b < 2; ++b)
#pragma unroll
            for (int m = 0; m < 4; ++m)
#pragma unroll
                for (int n = 0; n < 2; ++n) acc[a][b][m][n] = (f32x4){0.f, 0.f, 0.f, 0.f};
    bf16x8 At[4][2], B0[2][2], B1[2][2];
    const char* cA = (const char*)g.A + (size_t)cur.pm * tstepA; const char* cB = (const char*)g.Bt + (size_t)cur.pn * tstepB;
    S.a_ready(cur);
    if constexpr (SP2) {
        PG8_STAGE(PG8_SB(0, 0), cB, voffB); PG8_STAGE(PG8_SB(0, 1), cB + hstepB, voffB); PG8_STAGE(PG8_SA(0, 0), cA, voffA); PG8_STAGE(PG8_SA(0, 1), cA + hstepA, voffA);
        if (wr == 1) PG8_BAR;
        PG8_WAIT_V(2); PG8_BAR;
        PG8_STAGE(PG8_SB(1, 0), cB + kstep, voffB); PG8_STAGE(PG8_SA(1, 0), cA + kstep, voffA); PG8_STAGE(PG8_SB(1, 1), cB + hstepB + kstep, voffB);
        PG8_WAIT_V(6); PG8_BAR;
    } else {
        PG8_STAGE(PG8_SB(0, 0), cB, voffB); PG8_STAGE(PG8_SA(0, 0), cA, voffA); PG8_STAGE(PG8_SB(0, 1), cB + hstepB, voffB); PG8_STAGE(PG8_SA(0, 1), cA + hstepA, voffA);
        if (wr == 1) PG8_BAR;
        PG8_WAIT_V(4); PG8_BAR;
        PG8_STAGE(PG8_SB(1, 0), cB + kstep, voffB); PG8_STAGE(PG8_SA(1, 0), cA + kstep, voffA); PG8_STAGE(PG8_SB(1, 1), cB + hstepB + kstep, voffB);
        PG8_WAIT_V(6); PG8_BAR;
    }
    for (;;) {
        const bool has_next = S.next(ui + 1, nxt);
        const char* nA = has_next ? (const char*)g.A + (size_t)nxt.pm * tstepA : cA; const char* nB = has_next ? (const char*)g.Bt + (size_t)nxt.pn * tstepB : cB;
        for (int t = 0; t < nt; t += 2) {
            const bool last = (t == nt - 2);
            const char* a1 = cA + (size_t)(t + 1) * kstep;
            const char* a2 = last ? nA : cA + (size_t)(t + 2) * kstep; const char* b2 = last ? nB : cB + (size_t)(t + 2) * kstep;
            const char* a3 = a2 + kstep; const char* b3 = b2 + kstep;
            if (last && has_next) S.a_ready(nxt);
            if constexpr (SP2) {
            PG8_LDB(B0, 0, 0); PG8_LDB(B1, 0, 1); PG8_SCHED; PG8_LDA(At, 0, 0); PG8_STAGE(PG8_SA(1, 1), a1 + hstepA, voffA);
            PG8_WAIT_V(8); PG8_WAIT_L(0); PG8_BAR; PG8_MMA(0, 0, At, B0); PG8_MMA(0, 1, At, B1); PG8_BAR; PG8_SCHED;
            PG8_LDA(At, 0, 1); PG8_STAGE(PG8_SB(0, 0), b2, voffB); PG8_STAGE(PG8_SB(0, 1), b2 + hstepB, voffB); PG8_STAGE(PG8_SA(0, 0), a2, voffA);
            PG8_WAIT_V(8); PG8_WAIT_L(0); PG8_BAR; PG8_MMA(1, 0, At, B0); PG8_MMA(1, 1, At, B1); PG8_BAR; PG8_SCHED;
            PG8_LDB(B0, 1, 0); PG8_LDB(B1, 1, 1); PG8_SCHED; PG8_LDA(At, 1, 0); PG8_STAGE(PG8_SA(0, 1), a2 + hstepA, voffA);
            PG8_WAIT_V(8); PG8_WAIT_L(0); PG8_BAR; PG8_MMA(0, 0, At, B0); PG8_MMA(0, 1, At, B1); PG8_BAR; PG8_SCHED;
            PG8_LDA(At, 1, 1); PG8_STAGE(PG8_SB(1, 0), b3, voffB); PG8_STAGE(PG8_SB(1, 1), b3 + hstepB, voffB); PG8_STAGE(PG8_SA(1, 0), a3, voffA);
            PG8_WAIT_V(8); PG8_WAIT_L(0); PG8_BAR; PG8_MMA(1, 0, At, B0); PG8_MMA(1, 1, At, B1); PG8_BAR; PG8_SCHED;
            } else {
            PG8_LDB(B0, 0, 0); PG8_SCHED; PG8_LDA(At, 0, 0); PG8_STAGE(PG8_SA(1, 1), a1 + hstepA, voffA);
            PG8_WAIT_L(8); PG8_BAR; PG8_WAIT_L(0); PG8_MMA(0, 0, At, B0); PG8_BAR; PG8_SCHED;
            PG8_LDB(B1, 0, 1); PG8_STAGE(PG8_SB(0, 0), b2, voffB);
            PG8_BAR; PG8_WAIT_L(0); PG8_MMA(0, 1, At, B1); PG8_BAR;
            PG8_LDA(At, 0, 1); PG8_STAGE(PG8_SA(0, 0), a2, voffA);
            PG8_BAR; PG8_WAIT_L(0); PG8_MMA(1, 0, At, B0); PG8_BAR; PG8_SCHED;
            PG8_STAGE(PG8_SB(0, 1), b2 + hstepB, voffB);
            PG8_WAIT_V(6); PG8_BAR; PG8_MMA(1, 1, At, B1); PG8_BAR;
            PG8_LDB(B0, 1, 0); PG8_SCHED; PG8_LDA(At, 1, 0); PG8_STAGE(PG8_SA(0, 1), a2 + hstepA, voffA);
            PG8_WAIT_L(8); PG8_BAR; PG8_WAIT_L(0); PG8_MMA(0, 0, At, B0); PG8_BAR; PG8_SCHED;
            PG8_LDB(B1, 1, 1); PG8_STAGE(PG8_SB(1, 0), b3, voffB);
            PG8_BAR; PG8_WAIT_L(0); PG8_MMA(0, 1, At, B1); PG8_BAR;
            PG8_LDA(At, 1, 1); PG8_STAGE(PG8_SA(1, 0), a3, voffA);
            PG8_BAR; PG8_WAIT_L(0); PG8_MMA(1, 0, At, B0); PG8_BAR; PG8_SCHED;
            PG8_STAGE(PG8_SB(1, 1), b3 + hstepB, voffB);
            PG8_WAIT_V(6); PG8_BAR; PG8_MMA(1, 1, At, B1); PG8_BAR;
            }
        }
        if constexpr (ALIGN_EPI) { if (wr == 0) PG8_BAR; }
        if constexpr (!Epi::AFTER_DRAIN) { E(acc, cur, wr, wc, fr, fq); S.done(cur); }
        if (!has_next) break;
#pragma unroll
        for (int a = 0; a < 2; ++a)
#pragma unroll
            for (int b = 0; b < 2; ++b)
#pragma unroll
                for (int m = 0; m < 4; ++m)
#pragma unroll
                    for (int n = 0; n < 2; ++n) acc[a][b][m][n] = (f32x4){0.f, 0.f, 0.f, 0.f};
        cur = nxt; cA = nA; cB = nB; ++ui;
        if constexpr (ALIGN_EPI) { if (wr == 1) PG8_BAR; }
    }
    PG8_WAIT_V(0);
    if constexpr (!ALIGN_EPI) { if (wr == 0) PG8_BAR; }
    PG8_BAR;
    if constexpr (Epi::AFTER_DRAIN) { E.fused(acc, cur, wr, wc, fr, fq, lds, wid, lane); S.done(cur); }
#undef PG8_SA
#undef PG8_SB
#undef PG8_STAGE
#undef PG8_LDA
#undef PG8_LDB
#undef PG8_MMA
#undef PG8_WAIT_V
#undef PG8_WAIT_L
#undef PG8_BAR
#undef PG8_SCHED
}
}

template <class F> struct EpiQuad {
    static constexpr bool PERM = false, AFTER_DRAIN = false;
    F f;
    template <int C, int BJ> __device__ __forceinline__ void half(const pg8::f32x4 (&acc)[2][2][4][2], int row0, int p) const {
#pragma unroll
        for (int ai = 0; ai < 2; ++ai)
#pragma unroll
            for (int m = 0; m < 4; ++m) { f.template apply<C>(row0 + ai * 128 + m * 16, p, acc[ai][BJ][m][0], acc[ai][BJ][m][1]); asm volatile("" ::: "memory"); }
    }
    template <int BJ> __device__ __forceinline__ void disp(const pg8::f32x4 (&acc)[2][2][4][2], int row0, int p0, int p) const {
        const int c = f.cat(p0);
        if (F::NCAT == 1 || c == 0) half<0, BJ>(acc, row0, p);
        else if (F::NCAT > 1 && c == 1) half<(F::NCAT > 1 ? 1 : 0), BJ>(acc, row0, p);
        else if (F::NCAT > 2 && c == 2) half<(F::NCAT > 2 ? 2 : 0), BJ>(acc, row0, p);
        else if (F::NCAT > 3 && c == 3) half<(F::NCAT > 3 ? 3 : 0), BJ>(acc, row0, p);
        else if (F::NCAT > 4 && c == 4) half<(F::NCAT > 4 ? 4 : 0), BJ>(acc, row0, p);
        else if (F::NCAT > 5 && c == 5) half<(F::NCAT > 5 ? 5 : 0), BJ>(acc, row0, p);
        else if (F::NCAT > 6 && c == 6) half<(F::NCAT > 6 ? 6 : 0), BJ>(acc, row0, p);
        else if (F::NCAT > 7) half<(F::NCAT > 7 ? 7 : 0), BJ>(acc, row0, p);
    }
    __device__ __forceinline__ void operator()(const pg8::f32x4 (&acc)[2][2][4][2], const pg8::Unit& u, int wr, int wc, int fr, int fq) const {
        const int row0 = u.pm * 256 + wr * 64 + fr, p0 = u.pn * 256;
        disp<0>(acc, row0, p0, p0 + wc * 32 + 4 * fq);
        disp<1>(acc, row0, p0 + 128, p0 + 128 + wc * 32 + 4 * fq);
    }
};
template <class F> __device__ __forceinline__ void gemm_pg8(unsigned char* lds, const bf16* A, int lda, const bf16* Bt, int ldb, int M, int N, int K, const F& f) {
    pg8::Gemm g{A, Bt, M, N, K, lda, ldb}; pg8::StaticOrder S; S.init(M, N, (int)gridDim.x, (int)blockIdx.x);
    EpiQuad<F> E{f};
    pg8::gemm_phase<EpiQuad<F>, pg8::StaticOrder, true, true>((PG8_LAS unsigned char*)lds, g, S, E);
}

namespace cg = cooperative_groups;
struct EpiNormRes {
    static constexpr bool PERM = false, AFTER_DRAIN = true;
    const float* xin; float* xout; bf16* xn; const float* gpost; const float* gpre; float coef; unsigned* part; unsigned* cnt;
    __device__ __forceinline__ void operator()(const pg8::f32x4 (&)[2][2][4][2], const pg8::Unit&, int, int, int, int) const {}
    __device__ __forceinline__ void rowstat(const pg8::f32x4 (&acc)[2][2][4][2], float* P, int wr, int wc, int fr, int fq) const {
#pragma unroll
        for (int ai = 0; ai < 2; ++ai)
#pragma unroll
            for (int m = 0; m < 4; ++m) { float sq = 0.f;
#pragma unroll
                for (int bj = 0; bj < 2; ++bj)
#pragma unroll
                    for (int n = 0; n < 2; ++n) { const pg8::f32x4 v = acc[ai][bj][m][n]; sq += (v[0] * v[0] + v[1] * v[1]) + (v[2] * v[2] + v[3] * v[3]); }
                sq += __shfl_xor(sq, 16); sq += __shfl_xor(sq, 32);
                if (fq == 0) P[(ai * 128 + wr * 64 + m * 16 + fr) * 4 + wc] = sq; }
    }
    __device__ __forceinline__ void exchange(float* P, float* S, unsigned* bank, unsigned* cnt, const pg8::Unit& u, int tid, float scale) const {
        __syncthreads();
        if (tid < 256) { const f32x4 p = *(const f32x4*)(P + tid * 4);
            __hip_atomic_store(bank + (size_t)(u.pm * 256 + tid) * 4 + u.pn, __builtin_bit_cast(unsigned, (p[0] + p[1]) + (p[2] + p[3])), __ATOMIC_RELAXED, __HIP_MEMORY_SCOPE_AGENT); }
        asm volatile("s_waitcnt vmcnt(0)" ::: "memory");
        __syncthreads();
        if (tid == 0) { unsigned* c = cnt + u.pm * 16; __hip_atomic_fetch_add(c, 1u, __ATOMIC_RELAXED, __HIP_MEMORY_SCOPE_AGENT);
            while (__hip_atomic_load(c, __ATOMIC_RELAXED, __HIP_MEMORY_SCOPE_AGENT) < 4u) __builtin_amdgcn_s_sleep(1); }
        __syncthreads();
        if (tid < 256) { const unsigned* b = bank + (size_t)(u.pm * 256 + tid) * 4; float q = 0.f;
#pragma unroll
            for (int j = 0; j < 4; ++j) q += __builtin_bit_cast(float, __hip_atomic_load(b + j, __ATOMIC_RELAXED, __HIP_MEMORY_SCOPE_AGENT));
            S[tid] = rsqrtf(q * (1.f / DM) + NORM_EPS) * scale; }
        __syncthreads();
    }
    __device__ __forceinline__ void fused(pg8::f32x4 (&acc)[2][2][4][2], const pg8::Unit& u, int wr, int wc, int fr, int fq, PG8_LAS unsigned char* lds, int wid, int lane) const {
        float* P = (float*)lds; float* S = P + 1024; const int tid = wid * 64 + lane;
        rowstat(acc, P, wr, wc, fr, fq);
        exchange(P, S, part, cnt, u, tid, coef);
        const int col0 = u.pn * 256 + wc * 32 + 4 * fq;
#pragma unroll
        for (int ai = 0; ai < 2; ++ai)
#pragma unroll
            for (int m = 0; m < 4; ++m) { const int r = ai * 128 + wr * 64 + m * 16 + fr; const float sr = S[r]; const size_t off = (size_t)(u.pm * 256 + r) * DM + col0;
#pragma unroll
                for (int bj = 0; bj < 2; ++bj)
#pragma unroll
                    for (int n = 0; n < 2; ++n) { const int o = bj * 128 + n * 16; const f32x4 g4 = *(const f32x4*)(gpost + col0 + o), x4 = *(const f32x4*)(xin + off + o);
                        const f32x4 y = x4 + acc[ai][bj][m][n] * sr * g4; acc[ai][bj][m][n] = y; *(f32x4*)(xout + off + o) = y; }
                asm volatile("" ::: "memory"); }
        if (!gpre) return;
        rowstat(acc, P, wr, wc, fr, fq);
        exchange(P, S, part + (size_t)M_ * 4, cnt + 64 * 16, u, tid, 1.f);
#pragma unroll
        for (int ai = 0; ai < 2; ++ai)
#pragma unroll
            for (int m = 0; m < 4; ++m) { const int r = ai * 128 + wr * 64 + m * 16 + fr; const float sr = S[r]; const size_t off = (size_t)(u.pm * 256 + r) * DM + col0;
#pragma unroll
                for (int bj = 0; bj < 2; ++bj)
#pragma unroll
                    for (int n = 0; n < 2; ++n) { const int o = bj * 128 + n * 16; const f32x4 g4 = *(const f32x4*)(gpre + col0 + o); st_bf4(xn + off + o, acc[ai][bj][m][n] * sr * g4); }
                asm volatile("" ::: "memory"); }
    }
};
__device__ __forceinline__ void gemm_norm_res(unsigned char* lds, const bf16* A, int lda, const bf16* Bt, int K, const float* xin, float* xout, bf16* xn, const float* gpost, const float* gpre,
                                              float coef, bf16* ybuf, unsigned* part, unsigned* cnt) {
    pg8::Gemm g{A, Bt, M_, DM, K, lda, K}; pg8::StaticOrder S; S.init(M_, DM, 256, (int)blockIdx.x);
    const EpiNormRes E{xin, xout, xn, gpost, gpre, coef, part, cnt};
    pg8::gemm_phase<EpiNormRes, pg8::StaticOrder, false, true>((PG8_LAS unsigned char*)lds, g, S, E);
}

__device__ __forceinline__ void d_cmp2(const bf16* hidk, const bf16* hidv, const float* w2k, const float* w2v, const float* rope, bf16* kc, bf16* vct) {
    const int T512 = tidx(), tid = T512 & 255;
    FOR_VB(vb, 2048 * 32 / 256) {
        const int idx = vb * 256 + tid; const int R = idx >> 5, i = idx & 31; const int bg = R >> 9, c = R & 511;
        float k0 = 0.f, k1 = 0.f, v0 = 0.f, v1 = 0.f;
        for (int n = 0; n < 256; ++n) { const float hk = bf2f(hidk[(size_t)R * 256 + n]), hv = bf2f(hidv[(size_t)R * 256 + n]);
            k0 += hk * w2k[n * 64 + i]; k1 += hk * w2k[n * 64 + i + 32]; v0 += hv * w2v[n * 64 + i]; v1 += hv * w2v[n * 64 + i + 32]; }
        const int pos = (16 * c + 31) & (T_ - 1);
        const float cs = rope[((size_t)pos * 32 + i) * 2], sn = rope[((size_t)pos * 32 + i) * 2 + 1];
        kc[(size_t)R * 64 + i] = (bf16)f2bf(k0 * cs - k1 * sn); kc[(size_t)R * 64 + i + 32] = (bf16)f2bf(k0 * sn + k1 * cs);
        vct[((size_t)bg * 64 + i) * NCP + c] = (bf16)f2bf(v0); vct[((size_t)bg * 64 + i + 32) * NCP + c] = (bf16)f2bf(v1);
    }
}

struct NsaArgs { const bf16 *qb, *kc, *vct, *ks, *vst, *kw, *vwt; const float* gates; bf16* amix; };
__device__ __forceinline__ float dot64(const float* q, const bf16* k) {
    float s = 0.f;
#pragma unroll
    for (int i = 0; i < 8; ++i) { const u32x4 w = ((const u32x4*)k)[i];
        s += q[8 * i + 0] * __builtin_bit_cast(float, w.x << 16) + q[8 * i + 1] * __builtin_bit_cast(float, w.x & 0xffff0000u)
           + q[8 * i + 2] * __builtin_bit_cast(float, w.y << 16) + q[8 * i + 3] * __builtin_bit_cast(float, w.y & 0xffff0000u)
           + q[8 * i + 4] * __builtin_bit_cast(float, w.z << 16) + q[8 * i + 5] * __builtin_bit_cast(float, w.z & 0xffff0000u)
           + q[8 * i + 6] * __builtin_bit_cast(float, w.w << 16) + q[8 * i + 7] * __builtin_bit_cast(float, w.w & 0xffff0000u); }
    return s;
}
__device__ __forceinline__ void softmax_row(float* s, int n, int lane) {
    float m = -INFINITY; for (int i = lane; i < n; i += 64) m = fmaxf(m, s[i]);
    m = wave_max(m); if (m == -INFINITY) m = 0.f;
    float l = 0.f; for (int i = lane; i < n; i += 64) { const float e = exp2f(s[i] - m); s[i] = e; l += e; }
    l = wave_sum(l); const float inv = 1.f / fmaxf(l, 1e-30f);
    for (int i = lane; i < n; i += 64) s[i] *= inv;
}
__device__ __forceinline__ void d_nsa_simple(const NsaArgs& a, int vb, int tid, unsigned char* smem) {
    float (*qs)[64] = (float (*)[64])smem; float (*sc)[1024] = (float (*)[1024])(smem + 1024); float* imp = (float*)(smem + 17408); float* score = imp + 128;
    int* list = (int*)(score + 128); int* nlist = list + 16;
    const int bg = vb / T_, t = vb % T_, b = bg >> 1, g = bg & 1;
    const int r = tid >> 6, d = tid & 63, lane = d;
    const size_t row = (size_t)b * T_ + t;
    qs[r][d] = bf2f(a.qb[row * 512 + g * 256 + r * 64 + d]);
    if (tid == 0) *nlist = 0;
    __syncthreads();
    const int nv = t < 31 ? 0 : (t - 31) / 16 + 1;
    for (int c = tid; c < nv; c += 256) { const bf16* k = a.kc + ((size_t)bg * NCP + c) * 64;
        _Pragma("unroll 1") for (int rr = 0; rr < 4; ++rr) sc[rr][c] = dot64(qs[rr], k); }
    __syncthreads();
    softmax_row(sc[r], nv, lane);
    __syncthreads();
    float oc = 0.f; { const bf16* v = a.vct + ((size_t)bg * 64 + d) * NCP; for (int c = 0; c < nv; ++c) oc += sc[r][c] * bf2f(v[c]); }
    if (tid < 128) { const int s = tid; float acc = 0.f;
        for (int c = 4 * s - 1; c <= 4 * s + 3; ++c) if (c >= 0 && c < nv) acc += sc[0][c] + sc[1][c] + sc[2][c] + sc[3][c];
        imp[s] = acc; }
    __syncthreads();
    const int cur = t >> 6;
    if (tid < 128) { const int s = tid; const bool forced = (s == 0) || (s == cur) || (s == cur - 1);
        score[s] = forced ? 1e4f : (s <= cur ? imp[s] : -1e4f); }
    __syncthreads();
    if (tid < 128) { const int s = tid; const float my = score[s]; int rank = 0;
        for (int j = 0; j < 128; ++j) { const float o = score[j]; rank += (o > my || (o == my && j < s)) ? 1 : 0; }
        if (rank < 16 && s <= cur) { const int slot = atomicAdd(nlist, 1); list[slot] = s; } }
    __syncthreads();
    const int ns = *nlist * 64;
    for (int i = tid; i < ns; i += 256) { const int pos = list[i >> 6] * 64 + (i & 63);
        if (pos <= t) { const bf16* k = a.ks + ((size_t)bg * T_ + pos) * 64; _Pragma("unroll 1") for (int rr = 0; rr < 4; ++rr) sc[rr][i] = dot64(qs[rr], k); }
        else { sc[0][i] = -INFINITY; sc[1][i] = -INFINITY; sc[2][i] = -INFINITY; sc[3][i] = -INFINITY; } }
    __syncthreads();
    softmax_row(sc[r], ns, lane);
    __syncthreads();
    float os = 0.f; { const bf16* v = a.vst + ((size_t)bg * 64 + d) * T_;
        for (int i = 0; i < ns; ++i) { const int pos = list[i >> 6] * 64 + (i & 63); if (pos <= t) os += sc[r][i] * bf2f(v[pos]); } }
    __syncthreads();
    const int lo = t - 511 > 0 ? t - 511 : 0, nw = t - lo + 1;
    for (int i = tid; i < nw; i += 256) { const bf16* k = a.kw + ((size_t)bg * T_ + lo + i) * 64;
        _Pragma("unroll 1") for (int rr = 0; rr < 4; ++rr) sc[rr][i] = dot64(qs[rr], k); }
    __syncthreads();
    softmax_row(sc[r], nw, lane);
    __syncthreads();
    float ow = 0.f; { const bf16* v = a.vwt + ((size_t)bg * 64 + d) * T_ + lo; for (int i = 0; i < nw; ++i) ow += sc[r][i] * bf2f(v[i]); }
    const float* gt = a.gates + row * 24 + g * 12 + r * 3;
    a.amix[row * DM + g * 256 + r * 64 + d] = (bf16)f2bf(gt[0] * oc + gt[1] * os + gt[2] * ow);
    __syncthreads();
}


namespace nsa {
typedef float f32x16 __attribute__((ext_vector_type(16)));
constexpr int KROW = 144, VROW = 136, KBUF = 64 * KROW, VBUF = 64 * VROW;
constexpr int OFF_K = 0, OFF_V = 2 * KBUF, OFF_IMP = OFF_V + 2 * VBUF, IMPW = 130, OFF_SEL = OFF_IMP + 64 * IMPW * 4, OFF_UM = OFF_SEL + 1024, OFF_WS = OFF_UM + 16, OFF_UNIT = OFF_WS + 1024, OFF_ACC = OFF_UNIT + 16, LDS_NEED = OFF_ACC + 8 * 8192;
static_assert(LDS_NEED <= 147456 - 64 && OFF_ACC % 16 == 0, "nsa lds");
static_assert(OFF_IMP % 16 == 0 && OFF_SEL % 16 == 0 && OFF_WS % 16 == 0, "nsa lds map");
__device__ __forceinline__ int crow(int r, int hi) { return (r & 3) + 8 * (r >> 2) + 4 * hi; }
__device__ __forceinline__ int next_bit(unsigned m0, unsigned m1, unsigned m2, unsigned m3, int from) {
#pragma unroll
    for (int wd = 0; wd < 4; ++wd) {
        unsigned x = wd == 0 ? m0 : (wd == 1 ? m1 : (wd == 2 ? m2 : m3)); const int base = wd * 32;
        if (from < base + 32) { if (from > base) x &= (~0u) << (from - base); if (x) return base + __builtin_ctz(x); }
    }
    return 128;
}
__device__ __forceinline__ bf16x8 pack8(const f32x16& p, int b0) {
    u32x4 w; w.x = pk2(p[b0 + 0], p[b0 + 1]); w.y = pk2(p[b0 + 2], p[b0 + 3]); w.z = pk2(p[b0 + 4], p[b0 + 5]); w.w = pk2(p[b0 + 6], p[b0 + 7]);
    return __builtin_bit_cast(bf16x8, w);
}
struct Branch { const bf16* k; const bf16* vt; int ldv; };

constexpr float THR = 8.f;
template <int MODE, bool SEL>
__device__ __forceinline__ void compute_tile(unsigned char* sm, int cb, int j, const bf16x8 (&qf)[4], int lo, int hi_b, int lo_max, int hi_min, unsigned s0, unsigned s1, unsigned s2, unsigned s3,
                                             float& m, float& l, float invl, bool& initd, f32x16& negm, f32x16 (&o)[2], float* imp_row, float* wsc, int i, int hi) {
        const unsigned char* kb = sm + OFF_K + cb * KBUF; const unsigned char* vb = sm + OFF_V + cb * VBUF;
        const int key0 = 64 * j;
        bool rowsel = true;
        if (SEL) { const unsigned wsel = j < 32 ? s0 : (j < 64 ? s1 : (j < 96 ? s2 : s3)); rowsel = (wsel >> (j & 31)) & 1u; }
        if (!SEL || __any(rowsel)) {
            f32x16 p0, p1;
            {
                f32x16 c0;
                if (SEL) {
#pragma unroll
                    for (int r = 0; r < 16; ++r) c0[r] = rowsel ? negm[r] : -INFINITY;
                } else c0 = negm;
                const bf16x8 a00 = *(const bf16x8*)(kb + i * KROW + (8 * hi) * 2), a10 = *(const bf16x8*)(kb + (32 + i) * KROW + (8 * hi) * 2);
                p0 = __builtin_amdgcn_mfma_f32_32x32x16_bf16(a00, qf[0], c0, 0, 0, 0);
                p1 = __builtin_amdgcn_mfma_f32_32x32x16_bf16(a10, qf[0], c0, 0, 0, 0);
#pragma unroll
                for (int d0 = 1; d0 < 4; ++d0) {
                    const bf16x8 a0 = *(const bf16x8*)(kb + i * KROW + (16 * d0 + 8 * hi) * 2);
                    const bf16x8 a1 = *(const bf16x8*)(kb + (32 + i) * KROW + (16 * d0 + 8 * hi) * 2);
                    p0 = __builtin_amdgcn_mfma_f32_32x32x16_bf16(a0, qf[d0], p0, 0, 0, 0);
                    p1 = __builtin_amdgcn_mfma_f32_32x32x16_bf16(a1, qf[d0], p1, 0, 0, 0);
                }
            }
            if (!(key0 >= lo_max && key0 + 63 <= hi_min)) {
#pragma unroll
                for (int r = 0; r < 16; ++r) { const int key = key0 + crow(r, hi);
                    if (key < lo || key > hi_b) p0[r] = -INFINITY;
                    if (key + 32 < lo || key + 32 > hi_b) p1[r] = -INFINITY; }
            }
            if (MODE == 1) {
#pragma unroll
                for (int r = 0; r < 16; ++r) { p0[r] = __builtin_amdgcn_exp2f(p0[r]) * invl; p1[r] = __builtin_amdgcn_exp2f(p1[r]) * invl; }
#pragma unroll
                for (int gq = 0; gq < 4; ++gq) {
                    float G0 = (p0[4 * gq] + p0[4 * gq + 1]) + (p0[4 * gq + 2] + p0[4 * gq + 3]), L0 = p0[4 * gq + 3];
                    float G1 = (p1[4 * gq] + p1[4 * gq + 1]) + (p1[4 * gq + 2] + p1[4 * gq + 3]), L1 = p1[4 * gq + 3];
                    G0 += __shfl_xor(G0, 1); L0 += __shfl_xor(L0, 1); G1 += __shfl_xor(G1, 1); L1 += __shfl_xor(L1, 1);
                    G0 += __shfl_xor(G0, 2); L0 += __shfl_xor(L0, 2); G1 += __shfl_xor(G1, 2); L1 += __shfl_xor(L1, 2);
                    if ((i & 3) == 0) { const int s = 16 * j + 2 * gq + hi;
                        atomicAdd(imp_row + s, G0); atomicAdd(imp_row + s + 1, L0); atomicAdd(imp_row + s + 8, G1); atomicAdd(imp_row + s + 9, L1); }
                }
            } else {
                float ta = fmaxf(fmaxf(p0[0], p0[1]), p1[0]), tb = fmaxf(fmaxf(p0[2], p0[3]), p1[1]);
                ta = fmaxf(fmaxf(ta, p1[2]), p1[3]);
#pragma unroll
                for (int r = 4; r < 16; r += 4) { ta = fmaxf(fmaxf(ta, p0[r]), p0[r + 1]); tb = fmaxf(fmaxf(tb, p0[r + 2]), p0[r + 3]); ta = fmaxf(fmaxf(ta, p1[r]), p1[r + 1]); tb = fmaxf(fmaxf(tb, p1[r + 2]), p1[r + 3]); }
                float tm = fmaxf(ta, tb);
                tm = fmaxf(tm, __shfl_xor(tm, 32));
                if (__any((!initd && tm > -INFINITY) || tm > THR)) {
                    const bool was = initd;
                    const float d = was ? fmaxf(tm, 0.f) : (tm > -INFINITY ? tm : 0.f);
                    initd = was || (tm > -INFINITY);
                    m += d; const float alpha = was ? __builtin_amdgcn_exp2f(-d) : 1.f; l *= alpha;
#pragma unroll
                    for (int r = 0; r < 16; ++r) { p0[r] -= d; p1[r] -= d; negm[r] = -m; }
                    if (MODE == 2) {
                        if (hi == 0) wsc[i] = alpha;
                        asm volatile("" ::: "memory");
#pragma unroll
                        for (int rg = 0; rg < 4; ++rg) { const f32x4 a4 = *(const f32x4*)(wsc + 8 * rg + 4 * hi);
#pragma unroll
                            for (int e = 0; e < 4; ++e) { o[0][4 * rg + e] *= a4[e]; o[1][4 * rg + e] *= a4[e]; } }
                        asm volatile("" ::: "memory");
                    }
                }
                float rs = 0.f;
#pragma unroll
                for (int r = 0; r < 16; ++r) { p0[r] = __builtin_amdgcn_exp2f(p0[r]); p1[r] = __builtin_amdgcn_exp2f(p1[r]); rs += p0[r] + p1[r]; }
                l += rs;
            }
            if (MODE != 0) {
                const bf16x8 pf0 = pack8(p0, 0), pf1 = pack8(p0, 8), pf2 = pack8(p1, 0), pf3 = pack8(p1, 8);
#pragma unroll
                for (int dt = 0; dt < 2; ++dt) {
                    const unsigned char* vp = vb + (32 * dt + i) * VROW + 8 * hi;
#pragma unroll
                    for (int ks = 0; ks < 4; ++ks) {
                        const u32x2 v_lo = *(const u32x2*)(vp + 32 * ks), v_hi = *(const u32x2*)(vp + 32 * ks + 16);
                        const bf16x8 vf = __builtin_bit_cast(bf16x8, (u32x4){v_lo.x, v_lo.y, v_hi.x, v_hi.y});
                        o[dt] = __builtin_amdgcn_mfma_f32_32x32x16_bf16(ks == 0 ? pf0 : (ks == 1 ? pf1 : (ks == 2 ? pf2 : pf3)), vf, o[dt], 0, 0, 0);
                    }
                }
            }
        }
}
template <int MODE, bool SEL>
__device__ __forceinline__ void run_branch(unsigned char* sm, const Branch br, unsigned m0, unsigned m1, unsigned m2, unsigned m3,
                                           const bf16x8 (&qf)[4], int lo, int hi_b, int lo_max, int hi_min, unsigned s0, unsigned s1, unsigned s2, unsigned s3,
                                           float& m, float& l, float invl, f32x16 (&o)[2], float* imp_row, float* wsc, int tid, int lane) {
    const int i = lane & 31, hi = lane >> 5;
    const bf16* kp = br.k + tid * 8; const bf16* vp_ = br.vt + (size_t)(tid >> 3) * br.ldv + (tid & 7) * 8;
    unsigned char* kst = sm + OFF_K + (tid >> 3) * KROW + (tid & 7) * 16; unsigned char* vst = sm + OFF_V + (tid >> 3) * VROW + (tid & 7) * 16;
#define NSA_LOAD(jj, KR, VR) do { KR = *(const u32x4*)(kp + (size_t)(jj) * 4096); if (MODE != 0) VR = *(const u32x4*)(vp_ + (jj) * 64); } while (0)
#define NSA_STORE(buf, KR, VR) do { *(u32x4*)(kst + (buf) * KBUF) = KR; if (MODE != 0) { *(u32x2*)(vst + (buf) * VBUF) = (u32x2){VR.x, VR.y}; *(u32x2*)(vst + (buf) * VBUF + 8) = (u32x2){VR.z, VR.w}; } } while (0)
    int j = next_bit(m0, m1, m2, m3, 0);
    int j1 = j < 128 ? next_bit(m0, m1, m2, m3, j + 1) : 128;
    u32x4 kA, vA, kB, vB;
    if (j < 128) { NSA_LOAD(j, kA, vA); if (j1 < 128) NSA_LOAD(j1, kB, vB); NSA_STORE(0, kA, vA); }
    __syncthreads();
    bool initd = (MODE == 1);
    f32x16 negm;
#pragma unroll
    for (int r = 0; r < 16; ++r) negm[r] = (MODE == 1) ? -m : 0.f;
    while (j < 128) {
        {
            const int j2 = j1 < 128 ? next_bit(m0, m1, m2, m3, j1 + 1) : 128;
            if (j2 < 128) NSA_LOAD(j2, kA, vA);
            compute_tile<MODE, SEL>(sm, 0, j, qf, lo, hi_b, lo_max, hi_min, s0, s1, s2, s3, m, l, invl, initd, negm, o, imp_row, wsc, i, hi);
            if (j1 < 128) NSA_STORE(1, kB, vB);
            __syncthreads();
            j = j1; j1 = j2;
        }
        if (j >= 128) break;
        {
            const int j2 = j1 < 128 ? next_bit(m0, m1, m2, m3, j1 + 1) : 128;
            if (j2 < 128) NSA_LOAD(j2, kB, vB);
            compute_tile<MODE, SEL>(sm, 1, j, qf, lo, hi_b, lo_max, hi_min, s0, s1, s2, s3, m, l, invl, initd, negm, o, imp_row, wsc, i, hi);
            if (j1 < 128) NSA_STORE(0, kA, vA);
            __syncthreads();
            j = j1; j1 = j2;
        }
    }
#undef NSA_LOAD
#undef NSA_STORE
}
template <bool FIRST> __device__ __forceinline__ void add_scaled(float* accw, const f32x16 (&o)[2], float f, float* wsc, int i, int hi, int lane) {
    if (hi == 0) wsc[i] = f;
    asm volatile("" ::: "memory");
#pragma unroll
    for (int rg = 0; rg < 4; ++rg) { const f32x4 a4 = *(const f32x4*)(wsc + 8 * rg + 4 * hi);
#pragma unroll
        for (int e = 0; e < 4; ++e)
#pragma unroll
            for (int dt = 0; dt < 2; ++dt) { float* p = accw + (dt * 16 + 4 * rg + e) * 64 + lane; const float v = a4[e] * o[dt][4 * rg + e]; *p = FIRST ? v : (*p + v); } }
    asm volatile("" ::: "memory");
}
__device__ __forceinline__ void unit(const NsaArgs& a, int u, unsigned char* sm) {
    const int tid = tidx(), lane = tid & 63, w = __builtin_amdgcn_readfirstlane(tid >> 6), i = lane & 31, hi = lane >> 5;
    const int cur = 127 - (u >> 2), bg = u & 3, b = bg >> 1, g = bg & 1, q0 = cur * 64;
    const int ql = 8 * w + (i >> 2), hd = i & 3, t = q0 + ql;
    const size_t grow = (size_t)b * T_ + t;
    bf16x8 qf[4];
    { const bf16* qp = a.qb + grow * 512 + g * 256 + hd * 64 + 8 * hi;
#pragma unroll
      for (int d0 = 0; d0 < 4; ++d0) qf[d0] = *(const bf16x8*)(qp + 16 * d0); }
    float* wsc = (float*)(sm + OFF_WS) + w * 32;
    float* imp = (float*)(sm + OFF_IMP);
    unsigned* selw = (unsigned*)(sm + OFF_SEL);
    unsigned* um = (unsigned*)(sm + OFF_UM);
    for (int k = tid; k < 64 * IMPW; k += 512) imp[k] = 0.f;
    if (tid < 4) um[tid] = 0u;
    const float* gt = a.gates + grow * 24 + g * 12 + hd * 3;
    const float gc = gt[0], gs = gt[1], gw = gt[2];
    f32x16 o[2];
    float* accw = (float*)(sm + OFF_ACC) + w * 2048;
    const int tw0 = q0 + 8 * w, tw1 = tw0 + 7;
    {
        const int nv = t < 31 ? 0 : (t - 31) / 16 + 1;
        const int nvw = tw0 < 31 ? 0 : (tw0 - 31) / 16 + 1;
        const int nvmax = (q0 + 63 - 31) / 16 + 1, ntc = (nvmax + 63) / 64;
        const unsigned cm0 = ntc >= 32 ? ~0u : ((1u << ntc) - 1u);
        const Branch br{a.kc + (size_t)bg * NCP * 64, a.vct + (size_t)bg * 64 * NCP, NCP};
        float m = 0.f, l = 0.f;
        run_branch<0, false>(sm, br, cm0, 0u, 0u, 0u, qf, 0, nv - 1, 0, nvw - 1, 0u, 0u, 0u, 0u, m, l, 0.f, o, nullptr, wsc, tid, lane);
        l += __shfl_xor(l, 32);
        const float invl = 1.f / fmaxf(l, 1e-30f);
#pragma unroll
        for (int r = 0; r < 16; ++r) { o[0][r] = 0.f; o[1][r] = 0.f; }
        run_branch<1, false>(sm, br, cm0, 0u, 0u, 0u, qf, 0, nv - 1, 0, nvw - 1, 0u, 0u, 0u, 0u, m, l, invl, o, imp + ql * IMPW, wsc, tid, lane);
        add_scaled<true>(accw, o, gc, wsc, i, hi, lane);
    }
    {
        unsigned u0 = 0u, u1 = 0u, u2 = 0u, u3 = 0u;
        const int ncand = cur - 2;
        unsigned k0[8], k1[8], k2[8], k3[8];
        if (ncand <= 13) {
#pragma unroll
            for (int wd = 0; wd < 4; ++wd) { const int nb = cur + 1 - 32 * wd; const unsigned x = nb >= 32 ? ~0u : (nb <= 0 ? 0u : ((1u << nb) - 1u));
#pragma unroll
                for (int qq = 0; qq < 8; ++qq) { if (wd == 0) k0[qq] = x; else if (wd == 1) k1[qq] = x; else if (wd == 2) k2[qq] = x; else k3[qq] = x; } }
        } else {
            float v0[8], v1[8];
#pragma unroll
            for (int qq = 0; qq < 8; ++qq) { const float* ir = imp + (8 * w + qq) * IMPW;
                v0[qq] = (lane >= 1 && lane <= cur - 2) ? ir[lane] : -1.f; v1[qq] = (lane + 64 <= cur - 2) ? ir[lane + 64] : -1.f;
                k0[qq] = 1u; k1[qq] = 0u; k2[qq] = 0u; k3[qq] = 0u; }
            for (int it = 0; it < 13; ++it) {
                float bv[8]; int bs[8];
#pragma unroll
                for (int qq = 0; qq < 8; ++qq) { bv[qq] = v0[qq]; bs[qq] = lane; if (v1[qq] > v0[qq]) { bv[qq] = v1[qq]; bs[qq] = lane + 64; } }
#pragma unroll
                for (int off = 1; off < 64; off <<= 1) {
#pragma unroll
                    for (int qq = 0; qq < 8; ++qq) { const float ov = __shfl_xor(bv[qq], off); const int os = __shfl_xor(bs[qq], off);
                        if (ov > bv[qq] || (ov == bv[qq] && os < bs[qq])) { bv[qq] = ov; bs[qq] = os; } } }
#pragma unroll
                for (int qq = 0; qq < 8; ++qq) { const int b_ = __builtin_amdgcn_readfirstlane(bs[qq]);
                    if (b_ == lane) v0[qq] = -1.f; if (b_ == lane + 64) v1[qq] = -1.f;
                    const unsigned bit = 1u << (b_ & 31);
                    if (b_ < 32) k0[qq] |= bit; else if (b_ < 64) k1[qq] |= bit; else if (b_ < 96) k2[qq] |= bit; else k3[qq] |= bit; }
            }
            { const int c1 = cur - 1; const unsigned b1 = 1u << (c1 & 31), b2 = 1u << (cur & 31);
#pragma unroll
              for (int qq = 0; qq < 8; ++qq) {
                if (c1 < 32) k0[qq] |= b1; else if (c1 < 64) k1[qq] |= b1; else if (c1 < 96) k2[qq] |= b1; else k3[qq] |= b1;
                if (cur < 32) k0[qq] |= b2; else if (cur < 64) k1[qq] |= b2; else if (cur < 96) k2[qq] |= b2; else k3[qq] |= b2; } }
        }
#pragma unroll
        for (int qq = 0; qq < 8; ++qq) {
            if (lane == 0) { unsigned* sp = selw + (8 * w + qq) * 4; sp[0] = k0[qq]; sp[1] = k1[qq]; sp[2] = k2[qq]; sp[3] = k3[qq]; }
            u0 |= k0[qq]; u1 |= k1[qq]; u2 |= k2[qq]; u3 |= k3[qq]; }
        if (lane == 0) { atomicOr(um + 0, u0); atomicOr(um + 1, u1); atomicOr(um + 2, u2); atomicOr(um + 3, u3); }
    }
    __syncthreads();
    {
        const unsigned U0 = um[0], U1 = um[1], U2 = um[2], U3 = um[3];
        const unsigned* sp = selw + ql * 4; const unsigned s0 = sp[0], s1 = sp[1], s2 = sp[2], s3 = sp[3];
        const Branch br{a.ks + (size_t)bg * T_ * 64, a.vst + (size_t)bg * 64 * T_, T_};
        float m = 0.f, l = 0.f;
#pragma unroll
        for (int r = 0; r < 16; ++r) { o[0][r] = 0.f; o[1][r] = 0.f; }
        run_branch<2, true>(sm, br, __builtin_amdgcn_readfirstlane(U0), __builtin_amdgcn_readfirstlane(U1), __builtin_amdgcn_readfirstlane(U2), __builtin_amdgcn_readfirstlane(U3),
                            qf, 0, t, 0, tw0, s0, s1, s2, s3, m, l, 0.f, o, nullptr, wsc, tid, lane);
        l += __shfl_xor(l, 32);
        add_scaled<false>(accw, o, gs / fmaxf(l, 1e-30f), wsc, i, hi, lane);
    }
    {
        const int j0 = cur - 8 > 0 ? cur - 8 : 0;
        unsigned wm0 = 0u, wm1 = 0u, wm2 = 0u, wm3 = 0u;
#pragma unroll
        for (int wd = 0; wd < 4; ++wd) { const int a0 = j0 - 32 * wd, a1 = cur + 1 - 32 * wd;
            const unsigned hi_m = a1 >= 32 ? ~0u : (a1 <= 0 ? 0u : ((1u << a1) - 1u)), lo_m = a0 >= 32 ? ~0u : (a0 <= 0 ? 0u : ((1u << a0) - 1u));
            const unsigned x = hi_m & ~lo_m; if (wd == 0) wm0 = x; else if (wd == 1) wm1 = x; else if (wd == 2) wm2 = x; else wm3 = x; }
        const Branch br{a.kw + (size_t)bg * T_ * 64, a.vwt + (size_t)bg * 64 * T_, T_};
        float m = 0.f, l = 0.f;
#pragma unroll
        for (int r = 0; r < 16; ++r) { o[0][r] = 0.f; o[1][r] = 0.f; }
        run_branch<2, false>(sm, br, wm0, wm1, wm2, wm3, qf, t - 511, t, tw1 - 511, tw0, 0u, 0u, 0u, 0u, m, l, 0.f, o, nullptr, wsc, tid, lane);
        l += __shfl_xor(l, 32);
        add_scaled<false>(accw, o, gw / fmaxf(l, 1e-30f), wsc, i, hi, lane);
    }
#pragma unroll
    for (int r = 0; r < 16; ++r) { const int rw = crow(r, hi), qq = 8 * w + (rw >> 2), hh = rw & 3;
        bf16* op = a.amix + ((size_t)b * T_ + q0 + qq) * DM + g * 256 + hh * 64 + i;
        op[0] = (bf16)f2bf(accw[r * 64 + lane]); op[32] = (bf16)f2bf(accw[(16 + r) * 64 + lane]); }
}
__device__ __forceinline__ void phase(const NsaArgs& a, unsigned* ctr, unsigned char* sm) {
    int* slot = (int*)(sm + OFF_UNIT);
    for (;;) {
        if (tidx() == 0) *slot = (int)atomicAdd(ctr, 1u);
        __syncthreads();
        const int u = *slot;
        __syncthreads();
        if (u >= 512) break;
        unit(a, u, sm);
    }
}
}

__device__ __forceinline__ void d_lora_prep(const bf16* pr, const float* mu, bf16* la) {
    const int T512 = tidx(), c = T512 & 255;
    const float m = mu[1536 + c];
    FOR_VB(vb, M_ / 4) {
        const int row0 = vb * 4;
        float x[5];
        x[0] = (row0 % T_) ? bf2f(pr[(size_t)(row0 - 1) * 256 + c]) : 0.f;
#pragma unroll
        for (int j = 0; j < 4; ++j) x[j + 1] = bf2f(pr[(size_t)(row0 + j) * 256 + c]);
#pragma unroll
        for (int j = 0; j < 4; ++j) { const float xs = x[j + 1] + (x[j] - x[j + 1]) * m;
            const float v = c < 64 ? tanhf(xs) : (c < 128 ? xs : sigmoidf_(xs));
            la[(size_t)(row0 + j) * KLORA + c] = (bf16)f2bf(v); }
    }
}

namespace rw7 {
using nsa::f32x16; using nsa::crow; using nsa::pack8;
constexpr int NHELP = 2, RG = 18;
constexpr int NPROD = 6, RING = 7, RA = 144, RB = 40, S_AT = 0, S_RT = 16 * RA, S_BT = 32 * RA, S_KT = S_BT + 64 * RB, S_VT = S_KT + 64 * RB, S_SM = S_VT + 64 * RB, SMM = 16 * RB, S_GC = S_SM + 4 * SMM, SLOT = S_GC + 256;
constexpr int OFF_SCR = RING * SLOT, SCR = 32 * RA, LDS_NEED = OFF_SCR;
static_assert(NPROD % NHELP == 0 && LDS_NEED <= 147456 - 64 && 6 * (SLOT + SCR) <= 147456 - 64 && (size_t)16 * NHELP * RG * SLOT <= (size_t)9 << 20 && SLOT % 16 == 0 && S_BT % 16 == 0 && 128 * RB >= 4096 && SCR >= 4096, "rw7 lds map");
struct Args { const unsigned* rkw; const bf16* vv; const bf16* aga; const float* wdec; const float *mu, *kk, *ka, *rk; float* yraw; float* bonus; unsigned char* ring; unsigned* flags; unsigned* cons; };
__device__ __forceinline__ void wg_bar() { asm volatile("s_waitcnt lgkmcnt(0)" ::: "memory"); __builtin_amdgcn_s_barrier(); asm volatile("" ::: "memory"); }
struct Chan { float mur, muk, muv, kkc, kac, rkc; };
struct Raw { unsigned rk[16]; unsigned short v[16], al[16]; float w[16]; unsigned prk; unsigned short pv; };
__device__ __forceinline__ void fetch(const Args& a, int b, int h, int c, int lane, Raw& q) {
    const size_t base = ((size_t)b * T_ + (size_t)c * 16) * 512 + h * 64 + lane;
#pragma unroll
    for (int t = 0; t < 16; ++t) { q.rk[t] = a.rkw[base + (size_t)t * 512]; q.v[t] = a.vv[base + (size_t)t * 512]; q.al[t] = a.aga[base + (size_t)t * 512]; q.w[t] = a.wdec[base + (size_t)t * 512]; }
    q.prk = 0u; q.pv = 0;
    if (c > 0) { q.prk = a.rkw[base - 512]; q.pv = a.vv[base - 512]; }
}
__device__ __forceinline__ void st_row40(unsigned char* p, const unsigned (&w)[8]) {
    *(u32x2*)p = (u32x2){w[0], w[1]}; *(u32x2*)(p + 8) = (u32x2){w[2], w[3]}; *(u32x2*)(p + 16) = (u32x2){w[4], w[5]}; *(u32x2*)(p + 24) = (u32x2){w[6], w[7]};
}
template <bool BAR> __device__ __forceinline__ void seg_end() { if (BAR) wg_bar(); else { asm volatile("s_waitcnt lgkmcnt(0)" ::: "memory"); __builtin_amdgcn_sched_barrier(0); } }
template <bool BAR> __device__ __forceinline__ void produce(const Args& a, const Chan& ch, int b, int h, int c, const Raw& q, unsigned char* slot, unsigned char* scr, int lane) {
    const int i = lane & 31, hi = lane >> 5;
    const size_t row0 = (size_t)b * T_ + (size_t)c * 16;
    float pr_r = __builtin_bit_cast(float, q.prk << 16), pr_k = __builtin_bit_cast(float, q.prk & 0xffff0000u), pr_v = bf2f(q.pv);
    float rr[16], kq[16], kt[16];
    float* RED1 = (float*)scr;
    float* RED2 = (float*)(slot + S_BT);
#pragma unroll
    for (int t4 = 0; t4 < 4; ++t4) { f32x4 e1, e2;
#pragma unroll
        for (int e = 0; e < 4; ++e) { const int t = 4 * t4 + e;
            const float r0 = __builtin_bit_cast(float, q.rk[t] << 16), k0 = __builtin_bit_cast(float, q.rk[t] & 0xffff0000u), al = bf2f(q.al[t]);
            const float r = r0 + (pr_r - r0) * ch.mur, k = k0 + (pr_k - k0) * ch.muk;
            pr_r = r0; pr_k = k0;
            rr[t] = r; kq[t] = k * ch.kkc; kt[t] = k * (1.f + (al - 1.f) * ch.kac);
            e1[e] = kq[t] * kq[t]; e2[e] = r * kt[t] * ch.rkc; }
        *(f32x4*)(RED1 + lane * 16 + 4 * t4) = e1; *(f32x4*)(RED2 + lane * 16 + 4 * t4) = e2; }
    seg_end<BAR>();
    { const int t = lane & 15, part = lane >> 4; float s1 = 0.f, s2 = 0.f;
#pragma unroll
      for (int j = 0; j < 16; ++j) { s1 += RED1[(part * 16 + j) * 16 + t]; s2 += RED2[(part * 16 + j) * 16 + t]; }
      s1 += __shfl_xor(s1, 16); s2 += __shfl_xor(s2, 16); s1 += __shfl_xor(s1, 32); s2 += __shfl_xor(s2, 32);
      asm volatile("s_waitcnt lgkmcnt(0)" ::: "memory");
      if (lane < 16) { ((float*)(slot + S_GC))[lane] = s1; a.bonus[(row0 + lane) * 8 + h] = s2; } }
    asm volatile("s_waitcnt lgkmcnt(0)" ::: "memory");
    f32x4 n2[4];
#pragma unroll
    for (int t4 = 0; t4 < 4; ++t4) n2[t4] = *(const f32x4*)(slot + S_GC + 16 * t4);
    asm volatile("s_waitcnt lgkmcnt(0)" ::: "memory");
    float gam = 1.f;
    unsigned btp[8], ktp[8], vtp[8];
    float b_ev = 0.f, k_ev = 0.f, v_ev = 0.f;
#pragma unroll
    for (int t = 0; t < 16; ++t) {
        if (t == 6) seg_end<BAR>();
        const float v0 = bf2f(q.v[t]), al = bf2f(q.al[t]);
        const float v = v0 + (pr_v - v0) * ch.muv; pr_v = v0;
        const float kkn = kq[t] * __builtin_amdgcn_rsqf(fmaxf(n2[t >> 2][t & 3], 1e-24f));
        const float gp = gam; gam *= q.w[t]; const float ig = __builtin_amdgcn_rcpf(gam);
        const float bt_ = kkn * al * ig, kt_ = kt[t] * ig;
        const unsigned ar = pk2(-kkn * gp, rr[t] * gam), bk = pk2(bt_, kt_);
        *(bf16*)(slot + S_AT + t * RA + lane * 2) = (bf16)(ar & 0xffffu); *(bf16*)(slot + S_RT + t * RA + lane * 2) = (bf16)(ar >> 16);
        *(bf16*)(scr + t * RA + lane * 2) = (bf16)(bk & 0xffffu); *(bf16*)(scr + (16 + t) * RA + lane * 2) = (bf16)(bk >> 16);
        if (t & 1) { btp[t >> 1] = pk2(b_ev, bt_); ktp[t >> 1] = pk2(k_ev, kt_); vtp[t >> 1] = pk2(v_ev, v); }
        else { b_ev = bt_; k_ev = kt_; v_ev = v; }
    }
    st_row40(slot + S_BT + lane * RB, btp); st_row40(slot + S_KT + lane * RB, ktp); st_row40(slot + S_VT + lane * RB, vtp);
    ((float*)(slot + S_GC))[lane] = gam;
    seg_end<BAR>();
    f32x16 C;
#pragma unroll
    for (int r = 0; r < 16; ++r) C[r] = 0.f;
#pragma unroll
    for (int ks = 0; ks < 4; ++ks) {
        const bf16x8 af = *(const bf16x8*)(slot + S_AT + i * RA + (16 * ks + 8 * hi) * 2);
        const bf16x8 bf = *(const bf16x8*)(scr + i * RA + (16 * ks + 8 * hi) * 2);
        C = __builtin_amdgcn_mfma_f32_32x32x16_bf16(af, bf, C, 0, 0, 0);
    }
    asm volatile("s_waitcnt lgkmcnt(0)" ::: "memory");
    float* AAB = (float*)scr;
    unsigned char* SM = slot + S_SM;
#pragma unroll
    for (int r = 0; r < 16; ++r) {
        const int rho = crow(r, hi); const float val = C[r];
        if (r < 8) {
            if (i < 16) AAB[rho * 16 + i] = (i < rho) ? val : 0.f;
            else *(bf16*)(SM + SMM + rho * RB + (i - 16) * 2) = (bf16)f2bf((i - 16 < rho) ? val : 0.f);
        } else {
            const int tt = rho - 16;
            if (i < 16) *(bf16*)(SM + 2 * SMM + tt * RB + i * 2) = (bf16)f2bf((i <= tt) ? val : 0.f);
            else *(bf16*)(SM + 3 * SMM + tt * RB + (i - 16) * 2) = (bf16)f2bf((i - 16 <= tt) ? val : 0.f);
        }
    }
    seg_end<BAR>();
    { const int j = lane & 15; float Tr[16];
#pragma unroll
      for (int t = 0; t < 16; ++t) { if (t == 11) seg_end<BAR>();
          float acc = (t == j) ? 1.f : 0.f;
#pragma unroll
          for (int s4 = 0; s4 < (t + 3) / 4; ++s4) { const f32x4 ar = *(const f32x4*)(AAB + t * 16 + 4 * s4);
#pragma unroll
              for (int e = 0; e < 4; ++e) if (4 * s4 + e < t) acc += ar[e] * Tr[4 * s4 + e]; }
          Tr[t] = acc;
          if (lane < 16) *(bf16*)(SM + t * RB + j * 2) = (bf16)f2bf(acc); } }
    seg_end<BAR>();
}

__device__ __forceinline__ bf16x8 rd_perm(const unsigned char* p, int hi) {
    const u32x2 a = *(const u32x2*)(p + 8 * hi), b = *(const u32x2*)(p + 16 + 8 * hi);
    return __builtin_bit_cast(bf16x8, (u32x4){a.x, a.y, b.x, b.y});
}
__device__ __forceinline__ bf16x8 rd_nat(const unsigned char* p, int hi) {
    const u32x2 a = *(const u32x2*)(p + 16 * hi), b = *(const u32x2*)(p + 16 * hi + 8);
    return __builtin_bit_cast(bf16x8, (u32x4){a.x, a.y, b.x, b.y});
}
__device__ __forceinline__ bf16x8 and8(bf16x8 f, unsigned m) { u32x4 w = __builtin_bit_cast(u32x4, f); w.x &= m; w.y &= m; w.z &= m; w.w &= m; return __builtin_bit_cast(bf16x8, w); }
__device__ __forceinline__ void consume(const unsigned char* slot, f32x16 (&z)[2], float* yout, int vt, int lane) {
    const int i = lane & 31, hi = lane >> 5, i16 = i & 15;
    const unsigned m16 = i < 16 ? 0xffffffffu : 0u;
    const unsigned char* at = slot + S_AT + i16 * RA; const unsigned char* rt = slot + S_RT + i16 * RA; const unsigned char* sm16 = slot + S_SM + i16 * RB;
    bf16x8 fa0 = rd_perm(at, hi), fa1 = rd_perm(at + 32, hi), fa2 = rd_perm(at + 64, hi), fa3 = rd_perm(at + 96, hi);
    bf16x8 fak = rd_nat(sm16 + SMM, hi), ft = rd_perm(sm16, hi);
    const bf16x8 vtf = rd_nat(slot + S_VT + (32 * vt + i) * RB, hi);
    bf16x8 fr0 = rd_perm(rt, hi), fr1 = rd_perm(rt + 32, hi), fr2 = rd_perm(rt + 64, hi), fr3 = rd_perm(rt + 96, hi);
    bf16x8 frb = rd_perm(sm16 + 2 * SMM, hi), frk = rd_nat(sm16 + 3 * SMM, hi);
    const bf16x8 fk0 = rd_nat(slot + S_KT + i * RB, hi), fk1 = rd_nat(slot + S_KT + (32 + i) * RB, hi);
    const bf16x8 fb0 = rd_perm(slot + S_BT + i * RB, hi), fb1 = rd_perm(slot + S_BT + (32 + i) * RB, hi);
    f32x4 g4[2][4];
#pragma unroll
    for (int kt = 0; kt < 2; ++kt)
#pragma unroll
        for (int rg = 0; rg < 4; ++rg) g4[kt][rg] = *(const f32x4*)(slot + S_GC + (32 * kt + 8 * rg + 4 * hi) * 4);
    const bf16x8 zb0 = pack8(z[0], 0), zb1 = pack8(z[0], 8), zb2 = pack8(z[1], 0), zb3 = pack8(z[1], 8);
    fa0 = and8(fa0, m16); fa1 = and8(fa1, m16); fa2 = and8(fa2, m16); fa3 = and8(fa3, m16); fak = and8(fak, m16); ft = and8(ft, m16);
    fr0 = and8(fr0, m16); fr1 = and8(fr1, m16); fr2 = and8(fr2, m16); fr3 = and8(fr3, m16); frb = and8(frb, m16); frk = and8(frk, m16);
    f32x16 X, U, Y;
#pragma unroll
    for (int r = 0; r < 16; ++r) { X[r] = 0.f; U[r] = 0.f; Y[r] = 0.f; }
    X = __builtin_amdgcn_mfma_f32_32x32x16_bf16(fa0, zb0, X, 0, 0, 0);
    X = __builtin_amdgcn_mfma_f32_32x32x16_bf16(fa1, zb1, X, 0, 0, 0);
    X = __builtin_amdgcn_mfma_f32_32x32x16_bf16(fa2, zb2, X, 0, 0, 0);
    X = __builtin_amdgcn_mfma_f32_32x32x16_bf16(fa3, zb3, X, 0, 0, 0);
    X = __builtin_amdgcn_mfma_f32_32x32x16_bf16(fak, vtf, X, 0, 0, 0);
    Y = __builtin_amdgcn_mfma_f32_32x32x16_bf16(fr0, zb0, Y, 0, 0, 0);
    Y = __builtin_amdgcn_mfma_f32_32x32x16_bf16(fr1, zb1, Y, 0, 0, 0);
    Y = __builtin_amdgcn_mfma_f32_32x32x16_bf16(fr2, zb2, Y, 0, 0, 0);
    Y = __builtin_amdgcn_mfma_f32_32x32x16_bf16(fr3, zb3, Y, 0, 0, 0);
    Y = __builtin_amdgcn_mfma_f32_32x32x16_bf16(frk, vtf, Y, 0, 0, 0);
    z[0] = __builtin_amdgcn_mfma_f32_32x32x16_bf16(fk0, vtf, z[0], 0, 0, 0);
    z[1] = __builtin_amdgcn_mfma_f32_32x32x16_bf16(fk1, vtf, z[1], 0, 0, 0);
    const bf16x8 xb = pack8(X, 0);
    U = __builtin_amdgcn_mfma_f32_32x32x16_bf16(ft, xb, U, 0, 0, 0);
    const bf16x8 ub = pack8(U, 0);
    z[0] = __builtin_amdgcn_mfma_f32_32x32x16_bf16(fb0, ub, z[0], 0, 0, 0);
    z[1] = __builtin_amdgcn_mfma_f32_32x32x16_bf16(fb1, ub, z[1], 0, 0, 0);
    Y = __builtin_amdgcn_mfma_f32_32x32x16_bf16(frb, ub, Y, 0, 0, 0);
#pragma unroll
    for (int kt = 0; kt < 2; ++kt)
#pragma unroll
        for (int rg = 0; rg < 4; ++rg)
#pragma unroll
            for (int e = 0; e < 4; ++e) z[kt][4 * rg + e] *= g4[kt][rg][e];
#pragma unroll
    for (int r = 0; r < 8; ++r) yout[(size_t)crow(r, hi) * 512] = Y[r];
}

__device__ __forceinline__ unsigned ld_relaxed(const unsigned* p) { return __hip_atomic_load(p, __ATOMIC_RELAXED, __HIP_MEMORY_SCOPE_AGENT); }
__device__ __forceinline__ void head(const Args& a, int bh, unsigned char* sm) {
    const int tid = tidx(), lane = tid & 63, w = __builtin_amdgcn_readfirstlane(tid >> 6);
    const int b = bh >> 3, h = bh & 7;
    constexpr int NCH = T_ / 16, NBAR = NCH + NPROD;
    if (w < 2) {
        f32x16 z[2];
#pragma unroll
        for (int r = 0; r < 16; ++r) { z[0][r] = 0.f; z[1][r] = 0.f; }
        for (int i = 0; i < NPROD; ++i) wg_bar();
        for (int c = 0; c < NCH; ++c) {
            consume(sm + (size_t)(c % RING) * SLOT, z, a.yraw + ((size_t)b * T_ + (size_t)c * 16) * 512 + h * 64 + 32 * w + (lane & 31), w, lane);
            if (w == 0 && (c & 7) == 7 && lane == 0) __hip_atomic_store(a.cons + bh * 64, (unsigned)(c + 1), __ATOMIC_RELAXED, __HIP_MEMORY_SCOPE_AGENT);
            wg_bar();
        }
    } else {
        const int pw = w - 2;
        int nb = pw;
        {
            u32x4 v[15];
            { const int c = pw; const int hl = c % NHELP, n = c / NHELP;
              const unsigned char* g = a.ring + ((size_t)(bh * NHELP + hl) * RG + (n % RG)) * SLOT;
              while (__builtin_amdgcn_readfirstlane(ld_relaxed(a.flags + bh * NCH + c)) == 0u) __builtin_amdgcn_s_sleep(2);
              __builtin_amdgcn_fence(__ATOMIC_ACQUIRE, "agent");
              asm volatile("s_waitcnt vmcnt(0)" ::: "memory");
#pragma unroll
              for (int i = 0; i < 15; ++i) { const int off = (i * 64 + lane) * 16; if (off < SLOT) v[i] = *(const u32x4*)(g + off); } }
            for (int i = 0; i < pw; ++i) wg_bar();
            for (int c = pw; c < NCH; c += NPROD) {
                unsigned char* slot = sm + (size_t)(c % RING) * SLOT;
#pragma unroll
                for (int i = 0; i < 15; ++i) { const int off = (i * 64 + lane) * 16; if (off < SLOT) *(u32x4*)(slot + off) = v[i]; }
                const int cn = c + NPROD; const bool more = cn < NCH;
                const unsigned* fp = a.flags + bh * NCH + (more ? cn : c);
                unsigned fl = ld_relaxed(fp);
                wg_bar(); wg_bar();
                if (more) {
                    while (__builtin_amdgcn_readfirstlane(fl) == 0u) { __builtin_amdgcn_s_sleep(2); fl = ld_relaxed(fp); }
                    __builtin_amdgcn_fence(__ATOMIC_ACQUIRE, "agent");
                    asm volatile("s_waitcnt vmcnt(0)" ::: "memory");
                    const int hl = cn % NHELP, n = cn / NHELP;
                    const unsigned char* g = a.ring + ((size_t)(bh * NHELP + hl) * RG + (n % RG)) * SLOT;
#pragma unroll
                    for (int i = 0; i < 15; ++i) { const int off = (i * 64 + lane) * 16; if (off < SLOT) v[i] = *(const u32x4*)(g + off); }
                }
                wg_bar(); wg_bar(); wg_bar(); wg_bar();
                nb += NPROD;
            }
        }
        for (; nb < NBAR; ++nb) wg_bar();
    }
}
__device__ __forceinline__ void helper(const Args& a, int bh, int hl, unsigned char* sm) {
    const int tid = tidx(), lane = tid & 63, w = __builtin_amdgcn_readfirstlane(tid >> 6);
    if (w >= 6) return;
    const int b = bh >> 3, h = bh & 7, col = h * 64 + lane;
    constexpr int NCH = T_ / 16;
    unsigned char* slot = sm + (size_t)w * SLOT; unsigned char* scr = sm + 6 * SLOT + w * SCR;
    const Chan ch{a.mu[col], a.mu[512 + col], a.mu[1024 + col], a.kk[col], a.ka[col], a.rk[col]};
    int n = w, c = NHELP * n + hl;
    if (c >= NCH) return;
    for (; c < NCH; n += 6, c += 6 * NHELP) {
        Raw q; fetch(a, b, h, c, lane, q);
        if (n >= RG) { const unsigned need = (unsigned)(c - RG * NHELP + 1);
            while (__builtin_amdgcn_readfirstlane(ld_relaxed(a.cons + bh * 64)) < need) __builtin_amdgcn_s_sleep(8); }
        produce<false>(a, ch, b, h, c, q, slot, scr, lane);
        asm volatile("s_waitcnt lgkmcnt(0)" ::: "memory");
        unsigned char* g = a.ring + ((size_t)(bh * NHELP + hl) * RG + (n % RG)) * SLOT;
#pragma unroll
        for (int i = 0; i < 15; ++i) { const int off = (i * 64 + lane) * 16;
            if (off < SLOT) { const u32x4 d = *(const u32x4*)(slot + off); unsigned char* gp = g + off; asm volatile("global_store_dwordx4 %0, %1, off sc1\n\ts_nop 1" :: "v"(gp), "v"(d) : "memory"); } }
        asm volatile("s_waitcnt vmcnt(0)" ::: "memory");
        if (lane == 0) __hip_atomic_store(a.flags + bh * NCH + c, 1u, __ATOMIC_RELAXED, __HIP_MEMORY_SCOPE_AGENT);
    }
}
__device__ __forceinline__ void finish(const float* yraw, const float* bonus, const bf16* vv, const bf16* agg, const float* mu, const float* gng, const float* gnb, bf16* amix) {
    const int T512 = tidx(), lane = T512 & 63;
    for (int it0 = (blockIdx.x * 8 + (T512 >> 6)) * 4; it0 < M_ * 8; it0 += gridDim.x * 8 * 4) {
        const int row = it0 >> 3, h0 = it0 & 7, t = row % T_;
        float y[4], v0[4], v1[4], gg[4], bo[4];
#pragma unroll
        for (int j = 0; j < 4; ++j) { const int col = (h0 + j) * 64 + lane;
            y[j] = yraw[(size_t)row * 512 + col]; v0[j] = bf2f(vv[(size_t)row * 512 + col]); v1[j] = t ? bf2f(vv[(size_t)(row - 1) * 512 + col]) : 0.f;
            gg[j] = bf2f(agg[(size_t)row * 512 + col]); bo[j] = bonus[(size_t)row * 8 + h0 + j]; }
        float mean[4], var[4];
#pragma unroll
        for (int j = 0; j < 4; ++j) mean[j] = y[j];
#pragma unroll
        for (int o = 1; o < 64; o <<= 1) {
#pragma unroll
            for (int j = 0; j < 4; ++j) mean[j] += __shfl_xor(mean[j], o); }
#pragma unroll
        for (int j = 0; j < 4; ++j) { mean[j] *= (1.f / 64.f); y[j] -= mean[j]; var[j] = y[j] * y[j]; }
#pragma unroll
        for (int o = 1; o < 64; o <<= 1) {
#pragma unroll
            for (int j = 0; j < 4; ++j) var[j] += __shfl_xor(var[j], o); }
#pragma unroll
        for (int j = 0; j < 4; ++j) { const int col = (h0 + j) * 64 + lane;
            const float yn = y[j] * rsqrtf(var[j] * (1.f / 64.f) + 64e-5f) * gng[col] + gnb[col];
            const float v = v0[j] + (v1[j] - v0[j]) * mu[1024 + col];
            amix[(size_t)row * DM + 512 + col] = (bf16)f2bf((yn + bo[j] * v) * gg[j]); }
    }
}
}

namespace mema {
using nsa::f32x16; using nsa::KROW; using nsa::VROW; using nsa::KBUF; using nsa::VBUF; using nsa::OFF_K; using nsa::OFF_V; using nsa::OFF_WS; using nsa::crow; using nsa::pack8;
__device__ __forceinline__ void unit(const bf16* qm, const bf16* mk, const bf16* mvt, bf16* om, int u, unsigned char* sm) {
    const int tid = tidx(), lane = tid & 63, w = __builtin_amdgcn_readfirstlane(tid >> 6), i = lane & 31, hi = lane >> 5;
    const int b = u >> 7, h = (u >> 5) & 3, rb = u & 31;
    const int row0 = b * T_ + rb * 256 + 32 * w;
    const bf16* qrow = qm + (size_t)(row0 + i) * DM + h * 256 + 8 * hi;
    const bf16* kbase = mk + (size_t)(b * 256 + (tid >> 3)) * DM + h * 256 + (tid & 7) * 8;
    const bf16* vbase = mvt + (size_t)(h * 256 + (tid >> 3)) * 512 + b * 256 + (tid & 7) * 8;
    unsigned char* kst = sm + OFF_K + (tid >> 3) * KROW + (tid & 7) * 16;
    unsigned char* vst = sm + OFF_V + (tid >> 3) * VROW + (tid & 7) * 16;
    float* wsc = (float*)(sm + OFF_WS) + w * 32;
    f32x16 p[4][2];
#pragma unroll
    for (int kt = 0; kt < 4; ++kt)
#pragma unroll
        for (int r = 0; r < 16; ++r) { p[kt][0][r] = 0.f; p[kt][1][r] = 0.f; }
    u32x4 tr = *(const u32x4*)kbase;
    *(u32x4*)kst = tr;
    __syncthreads();
    bf16x8 qf[4];
#pragma unroll
    for (int n = 0; n < 16; ++n) {
        const int dc = n >> 2, kt = n & 3, cb = n & 1;
        if (n + 1 < 16) tr = *(const u32x4*)(kbase + (size_t)(64 * ((n + 1) & 3)) * DM + 64 * ((n + 1) >> 2));
        else tr = *(const u32x4*)vbase;
        if (kt == 0) {
#pragma unroll
            for (int d0 = 0; d0 < 4; ++d0) qf[d0] = *(const bf16x8*)(qrow + 64 * dc + 16 * d0);
        }
        const unsigned char* kb = sm + OFF_K + cb * KBUF;
#pragma unroll
        for (int d0 = 0; d0 < 4; ++d0) {
            const bf16x8 a0 = *(const bf16x8*)(kb + i * KROW + (16 * d0 + 8 * hi) * 2);
            const bf16x8 a1 = *(const bf16x8*)(kb + (32 + i) * KROW + (16 * d0 + 8 * hi) * 2);
            p[kt][0] = __builtin_amdgcn_mfma_f32_32x32x16_bf16(a0, qf[d0], p[kt][0], 0, 0, 0);
            p[kt][1] = __builtin_amdgcn_mfma_f32_32x32x16_bf16(a1, qf[d0], p[kt][1], 0, 0, 0);
        }
        if (n + 1 < 16) *(u32x4*)(kst + (cb ^ 1) * KBUF) = tr;
        else { *(u32x2*)vst = (u32x2){tr.x, tr.y}; *(u32x2*)(vst + 8) = (u32x2){tr.z, tr.w}; }
        __syncthreads();
    }
    float mx = p[0][0][0];
#pragma unroll
    for (int kt = 0; kt < 4; ++kt)
#pragma unroll
        for (int r = 0; r < 16; ++r) mx = fmaxf(mx, fmaxf(p[kt][0][r], p[kt][1][r]));
    mx = fmaxf(mx, __shfl_xor(mx, 32));
    float l = 0.f;
#pragma unroll
    for (int kt = 0; kt < 4; ++kt)
#pragma unroll
        for (int r = 0; r < 16; ++r) { p[kt][0][r] = __builtin_amdgcn_exp2f(p[kt][0][r] - mx); p[kt][1][r] = __builtin_amdgcn_exp2f(p[kt][1][r] - mx); l += p[kt][0][r] + p[kt][1][r]; }
    l += __shfl_xor(l, 32);
    bf16x8 pf[4][4];
#pragma unroll
    for (int kt = 0; kt < 4; ++kt) { pf[kt][0] = pack8(p[kt][0], 0); pf[kt][1] = pack8(p[kt][0], 8); pf[kt][2] = pack8(p[kt][1], 0); pf[kt][3] = pack8(p[kt][1], 8); }
    if (hi == 0) wsc[i] = 1.f / l;
    asm volatile("" ::: "memory");
    f32x4 il[4];
#pragma unroll
    for (int rg = 0; rg < 4; ++rg) il[rg] = *(const f32x4*)(wsc + 8 * rg + 4 * hi);
    f32x16 o[2];
#pragma unroll
    for (int n = 0; n < 16; ++n) {
        const int dvt = n >> 2, kt = n & 3, cb = n & 1;
        if (n + 1 < 16) tr = *(const u32x4*)(vbase + (size_t)(64 * ((n + 1) >> 2)) * 512 + 64 * ((n + 1) & 3));
        if (kt == 0) {
#pragma unroll
            for (int r = 0; r < 16; ++r) { o[0][r] = 0.f; o[1][r] = 0.f; }
        }
        const unsigned char* vb = sm + OFF_V + cb * VBUF;
#pragma unroll
        for (int dt = 0; dt < 2; ++dt) {
            const unsigned char* vp = vb + (32 * dt + i) * VROW + 8 * hi;
#pragma unroll
            for (int ks = 0; ks < 4; ++ks) {
                const u32x2 v_lo = *(const u32x2*)(vp + 32 * ks), v_hi = *(const u32x2*)(vp + 32 * ks + 16);
                const bf16x8 vf = __builtin_bit_cast(bf16x8, (u32x4){v_lo.x, v_lo.y, v_hi.x, v_hi.y});
                o[dt] = __builtin_amdgcn_mfma_f32_32x32x16_bf16(pf[kt][ks], vf, o[dt], 0, 0, 0);
            }
        }
        if (kt == 3) {
#pragma unroll
            for (int r = 0; r < 16; ++r) { bf16* op = om + (size_t)(row0 + crow(r, hi)) * DM + h * 256 + 64 * dvt + i;
                op[0] = (bf16)f2bf(o[0][r] * il[r >> 2][r & 3]); op[32] = (bf16)f2bf(o[1][r] * il[r >> 2][r & 3]); }
        }
        if (n + 1 < 16) { unsigned char* vp2 = vst + (cb ^ 1) * VBUF; *(u32x2*)vp2 = (u32x2){tr.x, tr.y}; *(u32x2*)(vp2 + 8) = (u32x2){tr.z, tr.w}; }
        __syncthreads();
    }
}
}

#define LAS __attribute__((address_space(3)))
#define XB_TMO      128
#define XB_XCNT(j)  (256  + 64 * (j))
#define XB_XSUB(j)  (1280 + 64 * (j))
#define XB_XGEN(j)  (2304 + 64 * (j))
#define XB_TOP      3328
#define XB_TOPGEN   3392
#define XCD_BAR_WORDS 3456
#define XB_SPIN_CAP (1u << 18)

__device__ __forceinline__ unsigned xb_ld(unsigned* p)              { return __hip_atomic_load(p, __ATOMIC_RELAXED, __HIP_MEMORY_SCOPE_AGENT); }
__device__ __forceinline__ unsigned xb_add(unsigned* p, unsigned v) { return __hip_atomic_fetch_add(p, v, __ATOMIC_RELAXED, __HIP_MEMORY_SCOPE_AGENT); }
__device__ __forceinline__ unsigned xb_xcc_id() { return (unsigned)__builtin_amdgcn_s_getreg((3 << 11) | 20) & 0xFu; }
#define XB_SPIN(cond, bar) do { unsigned _sp = 0; while (cond) { __builtin_amdgcn_s_sleep(1); \
    if ((++_sp & 255u) == 0u) { if (xb_ld(&(bar)[XB_TMO])) break; if (_sp > XB_SPIN_CAP) { atomicAdd(&(bar)[XB_TMO], 1u); break; } } } } while (0)

struct XcdBarrier {
    unsigned* bar; unsigned x;
    volatile LAS unsigned* st;
};

__device__ __forceinline__ XcdBarrier xcd_barrier_post(unsigned* bar, volatile LAS unsigned* st) {
    XcdBarrier b; b.bar = bar; b.x = xb_xcc_id(); b.st = st;
    if (tidx() == 0) (void)xb_add(&bar[XB_XCNT(b.x)], 1u);
    return b;
}
__device__ __forceinline__ void xcd_barrier_complete(unsigned* bar, unsigned x, unsigned& nloc, unsigned& nx) {
    const unsigned G = gridDim.x * gridDim.y * gridDim.z;
    unsigned sum, cnt, mine, sp = 0u;
    for (;;) {
        sum = 0u; cnt = 0u; mine = 0u;
#pragma unroll
        for (unsigned j = 0; j < 16; ++j) { const unsigned c = xb_ld(&bar[XB_XCNT(j)]); sum += c; cnt += (c > 0u) ? 1u : 0u; mine = (j == x) ? c : mine; }
        if (sum == G) break;
        __builtin_amdgcn_s_sleep(1);
        if ((++sp & 255u) == 0u) { if (xb_ld(&bar[XB_TMO])) break; if (sp > XB_SPIN_CAP) { atomicAdd(&bar[XB_TMO], 1u); break; } }
    }
    nloc = mine > 0u ? mine : 1u; nx = cnt > 0u ? cnt : 1u;
}

__device__ __forceinline__ void xcd_barrier(const XcdBarrier& b) {
    asm volatile("s_waitcnt vmcnt(0)" ::: "memory");
    __syncthreads();
    if (tidx() == 0) {
        unsigned* bar = b.bar;
        __builtin_amdgcn_s_waitcnt(0);
        unsigned nloc = b.st[0], nx = b.st[1];
        if (nloc == 0u) { xcd_barrier_complete(bar, b.x, nloc, nx); b.st[0] = nloc; b.st[1] = nx; }
        const unsigned old = xb_add(&bar[XB_XSUB(b.x)], 1u);
        const unsigned gen = old / nloc;
        if (old + 1u == (gen + 1u) * nloc) {
            __builtin_amdgcn_fence(__ATOMIC_RELEASE, "agent");
            asm volatile("s_waitcnt vmcnt(0)" ::: "memory");
            const unsigned og = xb_add(&bar[XB_TOP], 1u);
            const unsigned tg = og / nx;
            if (og + 1u == (tg + 1u) * nx) xb_add(&bar[XB_TOPGEN], 1u);
            else XB_SPIN(xb_ld(&bar[XB_TOPGEN]) == tg, bar);
            __builtin_amdgcn_fence(__ATOMIC_ACQUIRE, "agent");
            xb_add(&bar[XB_XGEN(b.x)], 1u);
            asm volatile("s_waitcnt vmcnt(0)" ::: "memory");
        } else {
            XB_SPIN(xb_ld(&bar[XB_XGEN(b.x)]) == gen, bar);
            __builtin_amdgcn_fence(__ATOMIC_ACQUIRE, "agent");
            asm volatile("s_waitcnt vmcnt(0)" ::: "memory");
        }
    }
    __syncthreads();
}

constexpr int NTHREADS = 512, LDS_BYTES = 147456;
struct MegaArgs { const float* in[41]; float* out; unsigned char* ws; };
#define WSB(off) ((bf16*)(ws + (off)))
#define WSF(off) ((float*)(ws + (off)))

__global__ void __launch_bounds__(NTHREADS) mega_fwd(MegaArgs A) {
    extern __shared__ __attribute__((aligned(16))) unsigned char lds[];
    cg::grid_group grid = cg::this_grid();
    const float* const* in = A.in; unsigned char* ws = A.ws; float* out = A.out;
    if (tidx() < 2) ((volatile LAS unsigned*)(lds + LDS_BYTES - 64))[tidx()] = 0u;
    __syncthreads();
    const XcdBarrier xbar = xcd_barrier_post((unsigned*)(ws + WS_CTL) + 16384, (volatile LAS unsigned*)(lds + LDS_BYTES - 64));

    d_convert(WSB(WS_W1GU), NGU, DM, MapGU{in[I_F1_WG], in[I_F1_WU], FF});
    d_convert(WSB(WS_W1D), DM, FF, MapPlain{in[I_F1_WD], DM});
    d_convert(WSB(WS_W2GU), NGU, DM, MapGU{in[I_F2_WG], in[I_F2_WU], FF});
    d_convert(WSB(WS_W2D), DM, FF, MapPlain{in[I_F2_WD], DM});
    d_convert(WSB(WS_WIN), NWIN, DM, MapWin{in[I_WIN], IN_COLS});
    d_convert(WSB(WS_WOUT), DM, DM, MapPlain{in[I_WOUT], DM});
    d_convert(WSB(WS_WQ), DM, DM, MapPlain{in[I_WQ], DM});
    d_convert(WSB(WS_WK), DM, DM, MapPlain{in[I_WK], DM});
    d_convert(WSB(WS_WV), DM, DM, MapPlain{in[I_WV], DM});
    d_convert(WSB(WS_WO), DM, DM, MapPlain{in[I_WO], DM});
    d_convert(WSB(WS_CW1K), 256, 2048, MapPlain{in[I_W1_K], 256});
    d_convert(WSB(WS_CW1V), 256, 2048, MapPlain{in[I_W1_V], 256});
    d_convert_lora(WSB(WS_WLORA), in[I_W2], in[I_A2], in[I_G2]);
    d_rope_table(WSF(WS_ROPE));
    d_cmp_bias(in[I_PE_K], in[I_W1_K], in[I_PE_V], in[I_W1_V], WSF(WS_CBIAS), (float*)lds);
    d_rownorm(in[I_X], in[I_F1_PRE], WSB(WS_XN), M_);
    d_rownorm(in[I_MEM], in[I_MEM_KVG], WSB(WS_MEMN), 512);
    grid.sync();
    gemm_pg8(lds, WSB(WS_XN), DM, WSB(WS_W1GU), DM, M_, NGU, DM, EpiSwiGLU{WSB(WS_HB)});
    xcd_barrier(xbar);
    gemm_norm_res(lds, WSB(WS_HB), FF, WSB(WS_W1D), FF, in[I_X], out, WSB(WS_XN), in[I_F1_POST], in[I_MIX_PRE], 0.5f, WSB(WS_YB), (unsigned*)(ws + WS_GATES), (unsigned*)(ws + WS_CTL) + 1024 + 0 * 2048);
    xcd_barrier(xbar);
    gemm_pg8(lds, WSB(WS_XN), DM, WSB(WS_WIN), DM, M_, NWIN, DM,
             EpiWin{WSB(WS_QB), WSB(WS_KS), WSB(WS_KW), WSB(WS_KCR), WSB(WS_VCR), WSB(WS_VST), WSB(WS_VWT), (unsigned*)(ws + WS_RKVA), WSB(WS_RKVA + 32 * MiB), WSB(WS_PRL), WSF(WS_GATES), WSF(WS_ROPE)});
    xcd_barrier(xbar);
    gemm_pg8(lds, WSB(WS_KCR), 1024, WSB(WS_CW1K), 2048, 2048, 256, 2048, EpiBiasSilu{WSB(WS_HIDK), WSF(WS_CBIAS)});
    gemm_pg8(lds, WSB(WS_VCR), 1024, WSB(WS_CW1V), 2048, 2048, 256, 2048, EpiBiasSilu{WSB(WS_HIDV), WSF(WS_CBIAS) + 256});
    d_lora_prep(WSB(WS_PRL), in[I_MU], WSB(WS_XN));
    xcd_barrier(xbar);
    d_cmp2(WSB(WS_HIDK), WSB(WS_HIDV), in[I_W2_K], in[I_W2_V], WSF(WS_ROPE), WSB(WS_KC), WSB(WS_VCT));
    gemm_pg8(lds, WSB(WS_XN), KLORA, WSB(WS_WLORA), KLORA, M_, NLORA, KLORA, EpiLora{WSF(WS_YB), WSB(WS_RKVA + 48 * MiB), WSB(WS_AGG), in[I_W0], in[I_A0]});
    xcd_barrier(xbar);
    if (blockIdx.x < 16 * (1 + rw7::NHELP)) {
        const rw7::Args ra{(const unsigned*)(ws + WS_RKVA), WSB(WS_RKVA + 32 * MiB), WSB(WS_RKVA + 48 * MiB), WSF(WS_YB), in[I_MU], in[I_KK], in[I_KA], in[I_RK], WSF(WS_YB), WSF(WS_BONUS),
                           ws + WS_KCR + 1 * MiB, (unsigned*)(ws + WS_CTL) + 32768, (unsigned*)(ws + WS_CTL) + 24576};
        if (blockIdx.x < 16) rw7::head(ra, blockIdx.x, lds);
        else rw7::helper(ra, (blockIdx.x - 16) % 16, (blockIdx.x - 16) / 16, lds);
        __syncthreads();
    }
    {
        const NsaArgs na{WSB(WS_QB), WSB(WS_KC), WSB(WS_VCT), WSB(WS_KS), WSB(WS_VST), WSB(WS_KW), WSB(WS_VWT), WSF(WS_GATES), WSB(WS_XN)};
        nsa::phase(na, (unsigned*)(ws + WS_CTL), lds);
    }
    xcd_barrier(xbar);
    d_nsa_outnorm(WSB(WS_XN), in[I_NSA_G]);
    rw7::finish(WSF(WS_YB), WSF(WS_BONUS), WSB(WS_RKVA + 32 * MiB), WSB(WS_AGG), in[I_MU], in[I_GNG], in[I_GNB], WSB(WS_XN));
    xcd_barrier(xbar);
    gemm_norm_res(lds, WSB(WS_XN), DM, WSB(WS_WOUT), DM, out, out, WSB(WS_XN), in[I_MIX_POST], in[I_MEM_PRE], 1.0f, WSB(WS_YB), (unsigned*)(ws + WS_GATES), (unsigned*)(ws + WS_CTL) + 1024 + 1 * 2048);
    xcd_barrier(xbar);
    gemm_pg8(lds, WSB(WS_XN), DM, WSB(WS_WQ), DM, M_, DM, DM, EpiStore{WSB(WS_QM), DM, MSCALE});
    gemm_pg8(lds, WSB(WS_MEMN), DM, WSB(WS_WK), DM, 512, DM, DM, EpiStore{WSB(WS_MK), DM, 1.f});
    gemm_pg8(lds, WSB(WS_WV), DM, WSB(WS_MEMN), DM, DM, 512, DM, EpiStore{WSB(WS_MVT), 512, 1.f});
    xcd_barrier(xbar);
    for (int u = blockIdx.x; u < 256; u += gridDim.x) mema::unit(WSB(WS_QM), WSB(WS_MK), WSB(WS_MVT), WSB(WS_OM), u, lds);
    xcd_barrier(xbar);
    gemm_norm_res(lds, WSB(WS_OM), DM, WSB(WS_WO), DM, out, out, WSB(WS_XN), in[I_MEM_POST], in[I_F2_PRE], 1.0f, WSB(WS_YB), (unsigned*)(ws + WS_GATES), (unsigned*)(ws + WS_CTL) + 1024 + 2 * 2048);
    xcd_barrier(xbar);
    gemm_pg8(lds, WSB(WS_XN), DM, WSB(WS_W2GU), DM, M_, NGU, DM, EpiSwiGLU{WSB(WS_HB)});
    xcd_barrier(xbar);
    gemm_norm_res(lds, WSB(WS_HB), FF, WSB(WS_W2D), FF, out, out, (bf16*)nullptr, in[I_F2_POST], (const float*)nullptr, 0.5f, WSB(WS_YB), (unsigned*)(ws + WS_GATES), (unsigned*)(ws + WS_CTL) + 1024 + 3 * 2048);
}

extern "C" void kernel_launch(void* const* d_in, const int* in_sizes, int n_in, void* d_out, int out_size, void* d_ws, size_t ws_size, hipStream_t stream) {
    static int grid = 0;
    if (grid == 0) {
        if (n_in != 41 || ws_size < WS_END) { fprintf(stderr, "kernel_launch: unexpected n_in %d / ws %zu\n", n_in, ws_size); grid = -1; return; }
        int dev = 0, cus = 0, per_cu = 0;
        hipGetDevice(&dev); hipDeviceGetAttribute(&cus, hipDeviceAttributeMultiprocessorCount, dev);
        if (hipFuncSetAttribute((const void*)mega_fwd, hipFuncAttributeMaxDynamicSharedMemorySize, LDS_BYTES) != hipSuccess) { fprintf(stderr, "kernel_launch: hipFuncSetAttribute failed\n"); grid = -1; return; }
        if (hipOccupancyMaxActiveBlocksPerMultiprocessor(&per_cu, (const void*)mega_fwd, NTHREADS, LDS_BYTES) != hipSuccess || per_cu < 1) { fprintf(stderr, "kernel_launch: occupancy query says %d\n", per_cu); grid = -1; (void)hipGetLastError(); return; }
        grid = cus;
        if (grid != 256) { fprintf(stderr, "kernel_launch: built for 256 CUs (one 256x256 tile per workgroup in the fused norm epilogues), found %d\n", cus); grid = -1; return; }
    }
    if (grid < 0) return;
    MegaArgs a{};
    for (int i = 0; i < 41; ++i) a.in[i] = (const float*)d_in[i];
    a.out = (float*)d_out; a.ws = (unsigned char*)d_ws;
    hipMemsetAsync(d_ws, 0, 196608, stream);
    void* args[] = {&a};
    hipError_t e = hipLaunchCooperativeKernel((const void*)mega_fwd, dim3(grid), dim3(NTHREADS), args, LDS_BYTES, stream);
    if (e != hipSuccess) fprintf(stderr, "kernel_launch: cooperative launch failed: %s (grid %d)\n", hipGetErrorString(e), grid);
}
```

```cpp
#include <hip/hip_runtime.h>
#include <hip/hip_cooperative_groups.h>
#include <cstdint>
#include <cstdio>

constexpr int NB = 2, T_ = 8192, DM = 1024, M_ = NB * T_;
constexpr int FF = 2816, NGU = 2 * FF;
constexpr int IN_COLS = 3096, NWIN = 3328;
constexpr int NRW = 1792;
constexpr int NCP = 512;
constexpr int NLORA = 1536, KLORA = 256;
constexpr float NORM_EPS = 1e-6f;
constexpr float QSCALE = 0.125f * 1.4426950408889634f;
constexpr float MSCALE = 0.0625f * 1.4426950408889634f;

typedef unsigned short bf16;
typedef short bf16x8 __attribute__((ext_vector_type(8)));
typedef float f32x4 __attribute__((ext_vector_type(4)));
typedef unsigned u32x2 __attribute__((ext_vector_type(2)));
typedef unsigned u32x4 __attribute__((ext_vector_type(4)));

__device__ __forceinline__ unsigned f2bf(float f) { unsigned u = __builtin_bit_cast(unsigned, f); return (u + 0x7fffu + ((u >> 16) & 1u)) >> 16; }
__device__ __forceinline__ float bf2f(bf16 h) { return __builtin_bit_cast(float, (unsigned)h << 16); }
typedef float f32x2_t __attribute__((ext_vector_type(2))); typedef __bf16 bf16x2_t __attribute__((ext_vector_type(2)));
__device__ __forceinline__ unsigned pk2(float lo, float hi) { const f32x2_t v = {lo, hi}; return __builtin_bit_cast(unsigned, __builtin_convertvector(v, bf16x2_t)); }
__device__ __forceinline__ void st_bf4(bf16* p, f32x4 v) { u32x2 w; w.x = pk2(v[0], v[1]); w.y = pk2(v[2], v[3]); *(u32x2*)p = w; }
__device__ __forceinline__ float wave_sum(float v) {
#pragma unroll
    for (int o = 1; o < 64; o <<= 1) v += __shfl_xor(v, o);
    return v;
}
__device__ __forceinline__ float wave_max(float v) {
#pragma unroll
    for (int o = 1; o < 64; o <<= 1) v = fmaxf(v, __shfl_xor(v, o));
    return v;
}
__device__ __forceinline__ float sigmoidf_(float x) { return 1.f / (1.f + __expf(-x)); }
__device__ __forceinline__ int tidx() { int t = threadIdx.x; asm volatile("" : "+v"(t)); return t; }

constexpr size_t MiB = 1u << 20, KiB64 = 65536;
constexpr size_t WS_CTL = 0;
constexpr size_t WS_KC = 256 * 1024;
constexpr size_t WS_VCT = 512 * 1024;
constexpr size_t WS_CW2 = 768 * 1024;
constexpr size_t WS_W1GU = 1 * MiB;
constexpr size_t WS_W1D = 12 * MiB;
constexpr size_t WS_W2GU = WS_W1D + 88 * KiB64;
constexpr size_t WS_W2D = WS_W2GU + 11 * MiB;
constexpr size_t WS_WIN = WS_W2D + 88 * KiB64;
constexpr size_t WS_WOUT = WS_WIN + 104 * KiB64;
constexpr size_t WS_WQ = WS_WOUT + 2 * MiB, WS_WK = WS_WQ + 2 * MiB, WS_WV = WS_WK + 2 * MiB, WS_WO = WS_WV + 2 * MiB;
constexpr size_t WS_CW1K = WS_WO + 2 * MiB, WS_CW1V = WS_CW1K + 1 * MiB;
constexpr size_t WS_WLORA = WS_CW1V + 1 * MiB;
constexpr size_t WS_ROPE = WS_WLORA + 12 * KiB64;
constexpr size_t WS_CBIAS = WS_ROPE + 2 * MiB;
constexpr size_t WS_MEMN = WS_CBIAS + KiB64;
constexpr size_t WS_HIDK = WS_MEMN + 1 * MiB;
constexpr size_t WS_HIDV = WS_HIDK + 1 * MiB;
constexpr size_t WS_GATES = WS_HIDV + 1 * MiB;
constexpr size_t WS_XN = 60 * MiB;
constexpr size_t WS_YB = 92 * MiB;
constexpr size_t WS_D = 124 * MiB;
constexpr size_t WS_HB = WS_D;
constexpr size_t WS_QB = WS_D;
constexpr size_t WS_KS = WS_D + 16 * MiB;
constexpr size_t WS_KW = WS_D + 20 * MiB;
constexpr size_t WS_KCR = WS_D + 24 * MiB;
constexpr size_t WS_VCR = WS_D + 29 * MiB;
constexpr size_t WS_VST = WS_D + 34 * MiB;
constexpr size_t WS_VWT = WS_D + 38 * MiB;
constexpr size_t WS_RKVA = WS_D + 42 * MiB;
constexpr size_t WS_PRL = WS_D + 106 * MiB;
constexpr size_t WS_AGG = WS_D + 114 * MiB;
constexpr size_t WS_BONUS = WS_KCR;
constexpr size_t WS_END = 256 * MiB;
constexpr size_t WS_QM = WS_D;
constexpr size_t WS_OM = WS_D + 32 * MiB;
constexpr size_t WS_MK = WS_D + 64 * MiB;
constexpr size_t WS_MVT = WS_D + 65 * MiB;
static_assert(WS_GATES + (size_t)M_ * 24 * 4 <= WS_XN, "ws map");
static_assert(WS_AGG + 16 * MiB <= WS_END, "ws map");

struct Params {
    const float* in[41];
    float* out;
    unsigned char* ws;
};
enum { I_X = 0, I_MEM, I_F1_PRE, I_F1_WG, I_F1_WU, I_F1_WD, I_F1_POST, I_MIX_PRE, I_WIN, I_PE_K, I_W1_K, I_W2_K, I_PE_V, I_W1_V, I_W2_V,
       I_NSA_G, I_MU, I_W0, I_W2, I_A0, I_A2, I_G2, I_KK, I_KA, I_RK, I_GNG, I_GNB, I_WOUT, I_MIX_POST, I_MEM_PRE, I_MEM_KVG, I_WQ, I_WK, I_WV,
       I_WO, I_MEM_POST, I_F2_PRE, I_F2_WG, I_F2_WU, I_F2_WD, I_F2_POST };

struct MapPlain { const float* W; int N; int pad; __device__ const float* col(int p) const { return W + p; } };
struct MapGU {
    const float* Wg; const float* Wu; int N; int pad;
    __device__ const float* col(int p) const {
        const int pn = p >> 8, q = p & 255, n = (q >> 4) & 1;
        const int hid = 128 * pn + 64 * (q >> 7) + 16 * ((q >> 5) & 3) + (q & 15);
        return Wg + (size_t)n * (size_t)(Wu - Wg) + hid;
    }
};
__host__ __device__ inline int rope_perm(int x) { return 16 * ((x >> 5) & 1) + (x & 15) + 32 * ((x >> 4) & 1); }
struct MapWin {
    const float* W; int N; int pad;
    __device__ const float* col(int p) const {
        int l;
        if (p < 512) l = (p & ~63) + rope_perm(p & 63);
        else if (p < 640) l = 768 + ((p - 512) & ~63) + rope_perm(p & 63);
        else if (p < 768) l = 1024 + ((p - 640) & ~63) + rope_perm(p & 63);
        else if (p < 896) l = 512 + (p - 768);
        else if (p < 1024) l = 640 + (p - 896);
        else if (p < 1152) l = 896 + (p - 1024);
        else if (p < 1280) l = 1152 + (p - 1152);
        else if (p < 2304) { const int q = p - 1280; l = 1304 + (((q >> 4) & 1) ? 512 : 0) + 16 * (q >> 5) + (q & 15); }
        else if (p < 3072) l = 1304 + (p - 1280);
        else if (p < 3096) l = 1280 + (p - 3072);
        else return nullptr;
        return W + l;
    }
};

#define FOR_VB(vb, n) for (int vb = (int)blockIdx.x * 2 + (T512 >> 8); vb < (n); vb += (int)gridDim.x * 2)

template <class Map> __device__ __forceinline__ void d_convert(bf16* WT, int Np, int K, Map map) {
    const int T512 = tidx(), tid = T512 & 255, nbx = Np / 64, nb = nbx * (K / 64);
    FOR_VB(vb, nb) {
        const int p = (vb % nbx) * 64 + (tid & 63), k0 = (vb / nbx) * 64 + (tid >> 6) * 16;
        const float* src = map.col(p);
        float v[16];
#pragma unroll
        for (int i = 0; i < 16; ++i) v[i] = src ? src[(size_t)(k0 + i) * map.N] : 0.f;
        u32x4 a, b;
        a.x = pk2(v[0], v[1]); a.y = pk2(v[2], v[3]); a.z = pk2(v[4], v[5]); a.w = pk2(v[6], v[7]);
        b.x = pk2(v[8], v[9]); b.y = pk2(v[10], v[11]); b.z = pk2(v[12], v[13]); b.w = pk2(v[14], v[15]);
        u32x4* dst = (u32x4*)(WT + (size_t)p * K + k0);
        dst[0] = a; dst[1] = b;
    }
}
__device__ __forceinline__ void d_convert_lora(bf16* WT, const float* w2, const float* a2, const float* g2) {
    const int T512 = tidx(), tid = T512 & 255;
    FOR_VB(vb, NLORA * KLORA / 256) {
        const int idx = vb * 256 + tid, p = idx >> 8, k = idx & 255;
        float v = 0.f;
        if (p < 512) { if (k < 64) v = w2[k * 512 + p]; }
        else if (p < 1024) { if (k >= 64 && k < 128) v = a2[(k - 64) * 512 + (p - 512)]; }
        else { if (k >= 128) v = g2[(k - 128) * 512 + (p - 1024)]; }
        WT[idx] = (bf16)f2bf(v);
    }
}
__device__ __forceinline__ void d_rope_table(float* tab) {
    const int T512 = tidx(), tid = T512 & 255;
    FOR_VB(vb, T_ * 32 / 256) {
        const int idx = vb * 256 + tid, pos = idx >> 5, i = idx & 31;
        const float inv = (float)pow(10000.0, -(double)i / 32.0);
        const float ang = (float)pos * inv;
        tab[2 * idx] = (float)cos((double)ang); tab[2 * idx + 1] = (float)sin((double)ang);
    }
}
__device__ __forceinline__ void d_cmp_bias(const float* pe_k, const float* w1_k, const float* pe_v, const float* w1_v, float* bias, float* red  ) {
    for (int job = blockIdx.x; job < 8; job += gridDim.x) {
        const int kv = job >> 2; const float* pe = kv ? pe_v : pe_k; const float* w1 = kv ? w1_v : w1_k;
        const int T512 = tidx(), lane = T512 & 63, w = T512 >> 6, n = (job & 3) * 64 + lane;
        float s = 0.f;
        for (int j = w * 256; j < w * 256 + 256; ++j) s += pe[j] * w1[(size_t)j * 256 + n];
        red[w * 64 + lane] = s; __syncthreads();
        if (w == 0) { float t = 0.f; for (int i = 0; i < 8; ++i) t += red[i * 64 + lane]; bias[kv * 256 + n] = t; }
        __syncthreads();
    }
}
__device__ __forceinline__ void d_rownorm(const float* x, const float* g, bf16* xn, int rows) {
    const int T512 = tidx(), tid = T512 & 255, lane = tid & 63;
    FOR_VB(vb, rows / 4) {
        const int row = vb * 4 + (tid >> 6);
        const f32x4* xr = (const f32x4*)(x + (size_t)row * DM) + lane; f32x4 v[4]; float s = 0.f;
#pragma unroll
        for (int j = 0; j < 4; ++j) { v[j] = xr[64 * j]; s += v[j][0] * v[j][0] + v[j][1] * v[j][1] + v[j][2] * v[j][2] + v[j][3] * v[j][3]; }
        const float rstd = rsqrtf(wave_sum(s) * (1.f / DM) + NORM_EPS);
#pragma unroll
        for (int j = 0; j < 4; ++j) { const f32x4 gg = ((const f32x4*)g)[lane + 64 * j]; st_bf4(xn + (size_t)row * DM + 4 * (lane + 64 * j), v[j] * rstd * gg); }
    }
}
__device__ __forceinline__ void d_rowpass(const float* xin, const bf16* y, const float* gpost, float coef, const float* gpre, float* xout, bf16* xn) {
    const int T512 = tidx(), tid = T512 & 255, lane = tid & 63;
    FOR_VB(vb, M_ / 4) {
        const int row = vb * 4 + (tid >> 6);
        f32x4 yv[4], xv[4]; float s = 0.f;
#pragma unroll
        for (int j = 0; j < 4; ++j) {
            const u32x2 w = *(const u32x2*)(y + (size_t)row * DM + 4 * (lane + 64 * j));
            yv[j][0] = __builtin_bit_cast(float, w.x << 16); yv[j][1] = __builtin_bit_cast(float, w.x & 0xffff0000u);
            yv[j][2] = __builtin_bit_cast(float, w.y << 16); yv[j][3] = __builtin_bit_cast(float, w.y & 0xffff0000u);
            s += yv[j][0] * yv[j][0] + yv[j][1] * yv[j][1] + yv[j][2] * yv[j][2] + yv[j][3] * yv[j][3];
            xv[j] = ((const f32x4*)(xin + (size_t)row * DM))[lane + 64 * j];
        }
        const float rstd = rsqrtf(wave_sum(s) * (1.f / DM) + NORM_EPS) * coef; float s2 = 0.f;
#pragma unroll
        for (int j = 0; j < 4; ++j) { const f32x4 gg = ((const f32x4*)gpost)[lane + 64 * j]; xv[j] = xv[j] + yv[j] * rstd * gg;
            s2 += xv[j][0] * xv[j][0] + xv[j][1] * xv[j][1] + xv[j][2] * xv[j][2] + xv[j][3] * xv[j][3];
            ((f32x4*)(xout + (size_t)row * DM))[lane + 64 * j] = xv[j]; }
        if (gpre) {
            const float r2 = rsqrtf(wave_sum(s2) * (1.f / DM) + NORM_EPS);
#pragma unroll
            for (int j = 0; j < 4; ++j) { const f32x4 gg = ((const f32x4*)gpre)[lane + 64 * j]; st_bf4(xn + (size_t)row * DM + 4 * (lane + 64 * j), xv[j] * r2 * gg); }
        }
    }
}
__device__ __forceinline__ void d_nsa_outnorm(bf16* amix, const float* g) {
    const int T512 = tidx(), tid = T512 & 255, lane = tid & 63;
    FOR_VB(vb, M_ / 4) {
        const int row = vb * 4 + (tid >> 6);
        bf16* p = amix + (size_t)row * DM + 8 * lane;
        const u32x4 w = *(const u32x4*)p; float v[8]; float s = 0.f;
        v[0] = __builtin_bit_cast(float, w.x << 16); v[1] = __builtin_bit_cast(float, w.x & 0xffff0000u);
        v[2] = __builtin_bit_cast(float, w.y << 16); v[3] = __builtin_bit_cast(float, w.y & 0xffff0000u);
        v[4] = __builtin_bit_cast(float, w.z << 16); v[5] = __builtin_bit_cast(float, w.z & 0xffff0000u);
        v[6] = __builtin_bit_cast(float, w.w << 16); v[7] = __builtin_bit_cast(float, w.w & 0xffff0000u);
#pragma unroll
        for (int i = 0; i < 8; ++i) s += v[i] * v[i];
        const float rstd = rsqrtf(wave_sum(s) * (1.f / 512.f) + NORM_EPS);
        u32x4 o; const float* gg = g + 8 * lane;
        o.x = pk2(v[0] * rstd * gg[0], v[1] * rstd * gg[1]); o.y = pk2(v[2] * rstd * gg[2], v[3] * rstd * gg[3]);
        o.z = pk2(v[4] * rstd * gg[4], v[5] * rstd * gg[5]); o.w = pk2(v[6] * rstd * gg[6], v[7] * rstd * gg[7]);
        *(u32x4*)p = o;
    }
}

struct EpiStore { bf16* O; int ldc; float scale;
    static constexpr int NCAT = 1;
    __device__ __forceinline__ int cat(int) const { return 0; }
    template <int C> __device__ __forceinline__ void apply(int row, int p, f32x4 v0, f32x4 v1) const { bf16* o = O + (size_t)row * ldc + p; st_bf4(o, v0 * scale); st_bf4(o + 16, v1 * scale); } };
struct EpiSwiGLU { bf16* H;
    static constexpr int NCAT = 1;
    __device__ __forceinline__ int cat(int) const { return 0; }
    template <int C> __device__ __forceinline__ void apply(int row, int p, f32x4 g, f32x4 u) const {
        const int q = p & 255, hid = 128 * (p >> 8) + 64 * (q >> 7) + 16 * ((q >> 5) & 3) + (q & 15);
        f32x4 h;
#pragma unroll
        for (int e = 0; e < 4; ++e) h[e] = g[e] / (1.f + __expf(-g[e])) * u[e];
        st_bf4(H + (size_t)row * FF + hid, h); } };
struct EpiBiasSilu { bf16* O; const float* bias;
    static constexpr int NCAT = 1;
    __device__ __forceinline__ int cat(int) const { return 0; }
    template <int C> __device__ __forceinline__ void apply(int row, int p, f32x4 v0, f32x4 v1) const {
        f32x4 a, b; const f32x4 b0 = *(const f32x4*)(bias + p), b1 = *(const f32x4*)(bias + p + 16);
#pragma unroll
        for (int e = 0; e < 4; ++e) { const float x0 = v0[e] + b0[e], x1 = v1[e] + b1[e]; a[e] = x0 / (1.f + __expf(-x0)); b[e] = x1 / (1.f + __expf(-x1)); }
        bf16* o = O + (size_t)row * 256 + p; st_bf4(o, a); st_bf4(o + 16, b); } };
struct EpiLora { float* wdec; bf16* aga; bf16* agg; const float* w0; const float* a0;
    static constexpr int NCAT = 3;
    __device__ __forceinline__ int cat(int p0) const { return p0 < 512 ? 0 : (p0 < 1024 ? 1 : 2); }
    template <int C> __device__ __forceinline__ void one(int row, int p, f32x4 v) const {
        if (C == 0) { f32x4 o; const f32x4 ww = *(const f32x4*)(w0 + p);
#pragma unroll
            for (int e = 0; e < 4; ++e) o[e] = __expf(-0.6065306597126334f * sigmoidf_(ww[e] + v[e]));
            *(f32x4*)(wdec + (size_t)row * 512 + p) = o;
        } else if (C == 1) { f32x4 o; const f32x4 aa = *(const f32x4*)(a0 + p - 512);
#pragma unroll
            for (int e = 0; e < 4; ++e) o[e] = sigmoidf_(aa[e] + v[e]);
            st_bf4(aga + (size_t)row * 512 + (p - 512), o);
        } else st_bf4(agg + (size_t)row * 512 + (p - 1024), v);
    }
    template <int C> __device__ __forceinline__ void apply(int row, int p, f32x4 v0, f32x4 v1) const { one<C>(row, p, v0); one<C>(row, p + 16, v1); } };
struct EpiWin {
    bf16 *qb, *ks, *kw, *kcr, *vcr, *vst, *vwt; unsigned* rk; bf16 *vv, *prl; float* gates; const float* rope;
    static constexpr int NCAT = 8;
    __device__ __forceinline__ int cat(int p0) const { return p0 < 512 ? 0 : (p0 < 768 ? 1 : (p0 < 1024 ? 2 : (p0 < 1280 ? 3 : (p0 < 2304 ? 4 : (p0 < 2816 ? 7 : (p0 < 3072 ? 6 : 5)))))); }
    template <int C> __device__ __forceinline__ void apply(int row, int p, f32x4 v0, f32x4 v1) const {
        const int b = row / T_, t = row % T_;
        if (C == 0 || C == 1) {
            const int x = p & 63, d = 16 * ((x >> 5) & 1) + (x & 15);
            const f32x4* rp = (const f32x4*)(rope + ((size_t)t * 32 + d) * 2); const f32x4 r0 = rp[0], r1 = rp[1];
            const f32x4 cs = {r0[0], r0[2], r1[0], r1[2]}, sn = {r0[1], r0[3], r1[1], r1[3]};
            const f32x4 lo = v0 * cs - v1 * sn, hi = v0 * sn + v1 * cs;
            if (C == 0) { bf16* o = qb + (size_t)row * 512 + (p & ~63) + d; st_bf4(o, lo * QSCALE); st_bf4(o + 32, hi * QSCALE); }
            else { const int g = ((p - 512) >> 6) & 1; bf16* base = (p < 640) ? ks : kw; bf16* o = base + ((size_t)(b * 2 + g) * T_ + t) * 64 + d; st_bf4(o, lo); st_bf4(o + 32, hi); }
        } else if (C == 2) {
            const int c = (p - 768) & 127, g = c >> 6, d = c & 63; bf16* base = (p < 896) ? kcr : vcr;
            bf16* o = base + ((size_t)(b * 2 + g) * T_ + t) * 64 + d; st_bf4(o, v0); st_bf4(o + 16, v1);
        } else if (C == 3) {
            const int c = (p - 1024) & 127, g = c >> 6, d = c & 63; bf16* base = (p < 1152) ? vst : vwt;
            bf16* o = base + ((size_t)(b * 2 + g) * 64 + d) * T_ + t;
#pragma unroll
            for (int e = 0; e < 4; ++e) { o[(size_t)e * T_] = (bf16)f2bf(v0[e]); o[(size_t)(16 + e) * T_] = (bf16)f2bf(v1[e]); }
        } else if (C == 4) {
            const int q = p - 1280, ch = 16 * (q >> 5) + (q & 15);
            u32x4 w; w.x = pk2(v0[0], v1[0]); w.y = pk2(v0[1], v1[1]); w.z = pk2(v0[2], v1[2]); w.w = pk2(v0[3], v1[3]);
            *(u32x4*)(rk + (size_t)row * 512 + ch) = w;
        } else if (C == 7) {
            bf16* o = vv + (size_t)row * 512 + (p - 2304); st_bf4(o, v0); st_bf4(o + 16, v1);
        } else if (C == 6) {
            bf16* o = prl + (size_t)row * 256 + (p - 2816); st_bf4(o, v0); st_bf4(o + 16, v1);
        } else {
            const int c = p - 3072; float* o = gates + (size_t)row * 24 + c;
            if (c < 24) { f32x4 s = {sigmoidf_(v0[0]), sigmoidf_(v0[1]), sigmoidf_(v0[2]), sigmoidf_(v0[3])}; *(f32x4*)o = s; }
            if (c + 16 < 24) { f32x4 s = {sigmoidf_(v1[0]), sigmoidf_(v1[1]), sigmoidf_(v1[2]), sigmoidf_(v1[3])}; *(f32x4*)(o + 16) = s; }
        }
    }
};

namespace pg8 {
#define PG8_LAS __attribute__((address_space(3)))
typedef unsigned short bf16_t;
typedef short bf16x8 __attribute__((ext_vector_type(8)));
typedef float f32x4 __attribute__((ext_vector_type(4)));
typedef unsigned u32x4 __attribute__((ext_vector_type(4)));
constexpr int BM = 256, BK = 64, HALF = 128, HTB = HALF * BK * 2  , STAGE_BYTES = 8 * HTB, NXCD = 8, WGM = 8;

__host__ __device__ __forceinline__ int lds_byte(int r, int c) { const int st = (r >> 4) * 2 + (c >> 5), rr = r & 15, cc = c & 31, ob = rr * 64 + cc * 2; return st * 1024 + (ob ^ (((ob >> 9) & 1) << 5)); }
__host__ __device__ __forceinline__ void stage_rc(int b, int& R, int& C) { const int st = b / 1024, sb = b % 1024, swz = sb ^ (((sb >> 9) & 1) << 5); R = (st >> 1) * 16 + swz / 64; C = (st & 1) * 32 + (swz % 64) / 2; }
__host__ __device__ __forceinline__ int perm32(int rho) { const int n = rho >> 4, i = rho & 15; return 8 * (i >> 2) + 4 * n + (i & 3); }

struct Unit { int pm, pn; };
struct Gemm { const bf16_t* A; const bf16_t* Bt; int M, N, K, lda, ldb; };

struct StaticOrder {
    int nM, nN, nwg, G, c;
    __host__ __device__ void init(int M, int N, int G_, int c_) { nM = M / BM; nN = N / BM; nwg = nM * nN; G = G_; c = c_; }
    __host__ __device__ bool next(int i, Unit& u) const {
        const long L = (long)i * G + c; if (L >= nwg) return false;
        int wgid = (int)L; { const int q = nwg / NXCD, r = nwg % NXCD, xcd = wgid % NXCD, off = wgid / NXCD; wgid = (xcd < r ? xcd * (q + 1) : r * (q + 1) + (xcd - r) * q) + off; }
        const int nig = WGM * nN, gid = wgid / nig, fm = gid * WGM, gsz = (nM - fm) < WGM ? (nM - fm) : WGM;
        u.pm = fm + ((wgid % nig) % gsz); u.pn = (wgid % nig) / gsz; return true;
    }
    __device__ __forceinline__ void a_ready(const Unit&) const {}
    __device__ __forceinline__ void done(const Unit&) const {}
};

template <class Epi, class Sched, bool ALIGN_EPI = false, bool SP2 = false>
__device__ __forceinline__ void gemm_phase(PG8_LAS unsigned char* lds, const Gemm g, const Sched& S, const Epi& E) {
    const int tid = tidx(), wid = __builtin_amdgcn_readfirstlane(tid >> 6), lane = tid & 63, wr = wid >> 2, wc = wid & 3, fr = lane & 15, fq = lane >> 4;
    const int K = g.K, nt = K / BK;
    unsigned voffA[2], voffB[2];
#pragma unroll
    for (int i = 0; i < 2; ++i) { int R, C; stage_rc(tid * 16 + i * 8192, R, C); const int Rb = Epi::PERM ? ((R & ~31) + perm32(R & 31)) : R;
        voffA[i] = (unsigned)(R * g.lda + C) * 2u; voffB[i] = (unsigned)(Rb * g.ldb + C) * 2u; }
    const size_t kstep = (size_t)(BK * 2);
    const size_t hstepA = (size_t)HALF * g.lda * 2, hstepB = (size_t)HALF * g.ldb * 2;
    const size_t tstepA = 2 * hstepA, tstepB = 2 * hstepB;
    const unsigned ldsw = (unsigned)wid * 1024u;
    const int aoff = lds_byte(wr * 64 + fr, fq * 8), boff = lds_byte(wc * 32 + fr, fq * 8);
#define PG8_SA(b, h) (((b) * 2 + (h)) * HTB)
#define PG8_SB(b, h) ((4 + (b) * 2 + (h)) * HTB)
#define PG8_STAGE(bufoff, gbase, voff) do { _Pragma("unroll") for (int _i = 0; _i < 2; ++_i) \
        __builtin_amdgcn_global_load_lds((const unsigned*)((const char*)(gbase) + (voff)[_i]), (PG8_LAS unsigned*)(lds + (bufoff) + ldsw + _i * 8192), 16, 0, 0); } while (0)
#define PG8_LDA(dst, b, h) do { _Pragma("unroll") for (int m = 0; m < 4; ++m) _Pragma("unroll") for (int k = 0; k < 2; ++k) dst[m][k] = *(const PG8_LAS bf16x8*)(lds + PG8_SA(b, h) + aoff + m * 2048 + k * 1024); } while (0)
#define PG8_LDB(dst, b, h) do { _Pragma("unroll") for (int n = 0; n < 2; ++n) _Pragma("unroll") for (int k = 0; k < 2; ++k) dst[n][k] = *(const PG8_LAS bf16x8*)(lds + PG8_SB(b, h) + boff + n * 2048 + k * 1024); } while (0)
#define PG8_MMA(ai, bj, At, Bt) do { __builtin_amdgcn_s_setprio(1); _Pragma("unroll") for (int m = 0; m < 4; ++m) _Pragma("unroll") for (int n = 0; n < 2; ++n) _Pragma("unroll") for (int k = 0; k < 2; ++k) \
        acc[ai][bj][m][n] = __builtin_amdgcn_mfma_f32_16x16x32_bf16(Bt[n][k], At[m][k], acc[ai][bj][m][n], 0, 0, 0); __builtin_amdgcn_s_setprio(0); } while (0)
#define PG8_WAIT_V(n) asm volatile("s_waitcnt vmcnt(" #n ")" ::: "memory")
#define PG8_WAIT_L(n) asm volatile("s_waitcnt lgkmcnt(" #n ")" ::: "memory")
#define PG8_BAR __builtin_amdgcn_s_barrier()
#define PG8_SCHED __builtin_amdgcn_sched_barrier(0)
    Unit cur, nxt; int ui = 0;
    if (!S.next(0, cur)) return;
    f32x4 acc[2][2][4][2];
#pragma unroll
    for (int a = 0; a < 2; ++a)
#pragma unroll
        for (int b = 0; b < 2; ++b)
#pragma unroll
            for (int m = 0; m < 4; ++m)
#pragma unroll
                for (int n = 0; n < 2; ++n) acc[a][b][m][n] = (f32x4){0.f, 0.f, 0.f, 0.f};
    bf16x8 At[4][2], B0[2][2], B1[2][2];
    const char* cA = (const char*)g.A + (size_t)cur.pm * tstepA; const char* cB = (const char*)g.Bt + (size_t)cur.pn * tstepB;
    S.a_ready(cur);
    if constexpr (SP2) {
        PG8_STAGE(PG8_SB(0, 0), cB, voffB); PG8_STAGE(PG8_SB(0, 1), cB + hstepB, voffB); PG8_STAGE(PG8_SA(0, 0), cA, voffA); PG8_STAGE(PG8_SA(0, 1), cA + hstepA, voffA);
        if (wr == 1) PG8_BAR;
        PG8_WAIT_V(2); PG8_BAR;
        PG8_STAGE(PG8_SB(1, 0), cB + kstep, voffB); PG8_STAGE(PG8_SA(1, 0), cA + kstep, voffA); PG8_STAGE(PG8_SB(1, 1), cB + hstepB + kstep, voffB);
        PG8_WAIT_V(6); PG8_BAR;
    } else {
        PG8_STAGE(PG8_SB(0, 0), cB, voffB); PG8_STAGE(PG8_SA(0, 0), cA, voffA); PG8_STAGE(PG8_SB(0, 1), cB + hstepB, voffB); PG8_STAGE(PG8_SA(0, 1), cA + hstepA, voffA);
        if (wr == 1) PG8_BAR;
        PG8_WAIT_V(4); PG8_BAR;
        PG8_STAGE(PG8_SB(1, 0), cB + kstep, voffB); PG8_STAGE(PG8_SA(1, 0), cA + kstep, voffA); PG8_STAGE(PG8_SB(1, 1), cB + hstepB + kstep, voffB);
        PG8_WAIT_V(6); PG8_BAR;
    }
    for (;;) {
        const bool has_next = S.next(ui + 1, nxt);
        const char* nA = has_next ? (const char*)g.A + (size_t)nxt.pm * tstepA : cA; const char* nB = has_next ? (const char*)g.Bt + (size_t)nxt.pn * tstepB : cB;
        for (int t = 0; t < nt; t += 2) {
            const bool last = (t == nt - 2);
            const char* a1 = cA + (size_t)(t + 1) * kstep;
            const char* a2 = last ? nA : cA + (size_t)(t + 2) * kstep; const char* b2 = last ? nB : cB + (size_t)(t + 2) * kstep;
            const char* a3 = a2 + kstep; const char* b3 = b2 + kstep;
            if (last && has_next) S.a_ready(nxt);
            if constexpr (SP2) {
            PG8_LDB(B0, 0, 0); PG8_LDB(B1, 0, 1); PG8_SCHED; PG8_LDA(At, 0, 0); PG8_STAGE(PG8_SA(1, 1), a1 + hstepA, voffA);
            PG8_WAIT_V(8); PG8_WAIT_L(0); PG8_BAR; PG8_MMA(0, 0, At, B0); PG8_MMA(0, 1, At, B1); PG8_BAR; PG8_SCHED;
            PG8_LDA(At, 0, 1); PG8_STAGE(PG8_SB(0, 0), b2, voffB); PG8_STAGE(PG8_SB(0, 1), b2 + hstepB, voffB); PG8_STAGE(PG8_SA(0, 0), a2, voffA);
            PG8_WAIT_V(8); PG8_WAIT_L(0); PG8_BAR; PG8_MMA(1, 0, At, B0); PG8_MMA(1, 1, At, B1); PG8_BAR; PG8_SCHED;
            PG8_LDB(B0, 1, 0); PG8_LDB(B1, 1, 1); PG8_SCHED; PG8_LDA(At, 1, 0); PG8_STAGE(PG8_SA(0, 1), a2 + hstepA, voffA);
            PG8_WAIT_V(8); PG8_WAIT_L(0); PG8_BAR; PG8_MMA(0, 0, At, B0); PG8_MMA(0, 1, At, B1); PG8_BAR; PG8_SCHED;
            PG8_LDA(At, 1, 1); PG8_STAGE(PG8_SB(1, 0), b3, voffB); PG8_STAGE(PG8_SB(1, 1), b3 + hstepB, voffB); PG8_STAGE(PG8_SA(1, 0), a3, voffA);
            PG8_WAIT_V(8); PG8_WAIT_L(0); PG8_BAR; PG8_MMA(1, 0, At, B0); PG8_MMA(1, 1, At, B1); PG8_BAR; PG8_SCHED;
            } else {
            PG8_LDB(B0, 0, 0); PG8_SCHED; PG8_LDA(At, 0, 0); PG8_STAGE(PG8_SA(1, 1), a1 + hstepA, voffA);
            PG8_WAIT_L(8); PG8_BAR; PG8_WAIT_L(0); PG8_MMA(0, 0, At, B0); PG8_BAR; PG8_SCHED;
            PG8_LDB(B1, 0, 1); PG8_STAGE(PG8_SB(0, 0), b2, voffB);
            PG8_BAR; PG8_WAIT_L(0); PG8_MMA(0, 1, At, B1); PG8_BAR;
            PG8_LDA(At, 0, 1); PG8_STAGE(PG8_SA(0, 0), a2, voffA);
            PG8_BAR; PG8_WAIT_L(0); PG8_MMA(1, 0, At, B0); PG8_BAR; PG8_SCHED;
            PG8_STAGE(PG8_SB(0, 1), b2 + hstepB, voffB);
            PG8_WAIT_V(6); PG8_BAR; PG8_MMA(1, 1, At, B1); PG8_BAR;
            PG8_LDB(B0, 1, 0); PG8_SCHED; PG8_LDA(At, 1, 0); PG8_STAGE(PG8_SA(0, 1), a2 + hstepA, voffA);
            PG8_WAIT_L(8); PG8_BAR; PG8_WAIT_L(0); PG8_MMA(0, 0, At, B0); PG8_BAR; PG8_SCHED;
            PG8_LDB(B1, 1, 1); PG8_STAGE(PG8_SB(1, 0), b3, voffB);
            PG8_BAR; PG8_WAIT_L(0); PG8_MMA(0, 1, At, B1); PG8_BAR;
            PG8_LDA(At, 1, 1); PG8_STAGE(PG8_SA(1, 0), a3, voffA);
            PG8_BAR; PG8_WAIT_L(0); PG8_MMA(1, 0, At, B0); PG8_BAR; PG8_SCHED;
            PG8_STAGE(PG8_SB(1, 1), b3 + hstepB, voffB);
            PG8_WAIT_V(6); PG8_BAR; PG8_MMA(1, 1, At, B1); PG8_BAR;
            }
        }
        if constexpr (ALIGN_EPI) { if (wr == 0) PG8_BAR; }
        if constexpr (!Epi::AFTER_DRAIN) { E(acc, cur, wr, wc, fr, fq); S.done(cur); }
        if (!has_next) break;
#pragma unroll
        for (int a = 0; a < 2; ++a)
#pragma unroll
            for (int b = 0; b < 2; ++b)
#pragma unroll
                for (int m = 0; m < 4; ++m)
#pragma unroll
                    for (int n = 0; n < 2; ++n) acc[a][b][m][n] = (f32x4){0.f, 0.f, 0.f, 0.f};
        cur = nxt; cA = nA; cB = nB; ++ui;
        if constexpr (ALIGN_EPI) { if (wr == 1) PG8_BAR; }
    }
    PG8_WAIT_V(0);
    if constexpr (!ALIGN_EPI) { if (wr == 0) PG8_BAR; }
    PG8_BAR;
    if constexpr (Epi::AFTER_DRAIN) { E.fused(acc, cur, wr, wc, fr, fq, lds, wid, lane); S.done(cur); }
#undef PG8_SA
#undef PG8_SB
#undef PG8_STAGE
#undef PG8_LDA
#undef PG8_LDB
#undef PG8_MMA
#undef PG8_WAIT_V
#undef PG8_WAIT_L
#undef PG8_BAR
#undef PG8_SCHED
}
}

template <class F> struct EpiQuad {
    static constexpr bool PERM = false, AFTER_DRAIN = false;
    F f;
    template <int C, int BJ> __device__ __forceinline__ void half(const pg8::f32x4 (&acc)[2][2][4][2], int row0, int p) const {
#pragma unroll
        for (int ai = 0; ai < 2; ++ai)
#pragma unroll
            for (int m = 0; m < 4; ++m) { f.template apply<C>(row0 + ai * 128 + m * 16, p, acc[ai][BJ][m][0], acc[ai][BJ][m][1]); asm volatile("" ::: "memory"); }
    }
    template <int BJ> __device__ __forceinline__ void disp(const pg8::f32x4 (&acc)[2][2][4][2], int row0, int p0, int p) const {
        const int c = f.cat(p0);
        if (F::NCAT == 1 || c == 0) half<0, BJ>(acc, row0, p);
        else if (F::NCAT > 1 && c == 1) half<(F::NCAT > 1 ? 1 : 0), BJ>(acc, row0, p);
        else if (F::NCAT > 2 && c == 2) half<(F::NCAT > 2 ? 2 : 0), BJ>(acc, row0, p);
        else if (F::NCAT > 3 && c == 3) half<(F::NCAT > 3 ? 3 : 0), BJ>(acc, row0, p);
        else if (F::NCAT > 4 && c == 4) half<(F::NCAT > 4 ? 4 : 0), BJ>(acc, row0, p);
        else if (F::NCAT > 5 && c == 5) half<(F::NCAT > 5 ? 5 : 0), BJ>(acc, row0, p);
        else if (F::NCAT > 6 && c == 6) half<(F::NCAT > 6 ? 6 : 0), BJ>(acc, row0, p);
        else if (F::NCAT > 7) half<(F::NCAT > 7 ? 7 : 0), BJ>(acc, row0, p);
    }
    __device__ __forceinline__ void operator()(const pg8::f32x4 (&acc)[2][2][4][2], const pg8::Unit& u, int wr, int wc, int fr, int fq) const {
        const int row0 = u.pm * 256 + wr * 64 + fr, p0 = u.pn * 256;
        disp<0>(acc, row0, p0, p0 + wc * 32 + 4 * fq);
        disp<1>(acc, row0, p0 + 128, p0 + 128 + wc * 32 + 4 * fq);
    }
};
template <class F> __device__ __forceinline__ void gemm_pg8(unsigned char* lds, const bf16* A, int lda, const bf16* Bt, int ldb, int M, int N, int K, const F& f) {
    pg8::Gemm g{A, Bt, M, N, K, lda, ldb}; pg8::StaticOrder S; S.init(M, N, (int)gridDim.x, (int)blockIdx.x);
    EpiQuad<F> E{f};
    pg8::gemm_phase<EpiQuad<F>, pg8::StaticOrder, true, true>((PG8_LAS unsigned char*)lds, g, S, E);
}

namespace cg = cooperative_groups;
struct EpiNormRes {
    static constexpr bool PERM = false, AFTER_DRAIN = true;
    const float* xin; float* xout; bf16* xn; const float* gpost; const float* gpre; float coef; unsigned* part; unsigned* cnt;
    __device__ __forceinline__ void operator()(const pg8::f32x4 (&)[2][2][4][2], const pg8::Unit&, int, int, int, int) const {}
    __device__ __forceinline__ void rowstat(const pg8::f32x4 (&acc)[2][2][4][2], float* P, int wr, int wc, int fr, int fq) const {
#pragma unroll
        for (int ai = 0; ai < 2; ++ai)
#pragma unroll
            for (int m = 0; m < 4; ++m) { float sq = 0.f;
#pragma unroll
                for (int bj = 0; bj < 2; ++bj)
#pragma unroll
                    for (int n = 0; n < 2; ++n) { const pg8::f32x4 v = acc[ai][bj][m][n]; sq += (v[0] * v[0] + v[1] * v[1]) + (v[2] * v[2] + v[3] * v[3]); }
                sq += __shfl_xor(sq, 16); sq += __shfl_xor(sq, 32);
                if (fq == 0) P[(ai * 128 + wr * 64 + m * 16 + fr) * 4 + wc] = sq; }
    }
    __device__ __forceinline__ void exchange(float* P, float* S, unsigned* bank, unsigned* cnt, const pg8::Unit& u, int tid, float scale) const {
        __syncthreads();
        if (tid < 256) { const f32x4 p = *(const f32x4*)(P + tid * 4);
            __hip_atomic_store(bank + (size_t)(u.pm * 256 + tid) * 4 + u.pn, __builtin_bit_cast(unsigned, (p[0] + p[1]) + (p[2] + p[3])), __ATOMIC_RELAXED, __HIP_MEMORY_SCOPE_AGENT); }
        asm volatile("s_waitcnt vmcnt(0)" ::: "memory");
        __syncthreads();
        if (tid == 0) { unsigned* c = cnt + u.pm * 16; __hip_atomic_fetch_add(c, 1u, __ATOMIC_RELAXED, __HIP_MEMORY_SCOPE_AGENT);
            while (__hip_atomic_load(c, __ATOMIC_RELAXED, __HIP_MEMORY_SCOPE_AGENT) < 4u) __builtin_amdgcn_s_sleep(1); }
        __syncthreads();
        if (tid < 256) { const unsigned* b = bank + (size_t)(u.pm * 256 + tid) * 4; float q = 0.f;
#pragma unroll
            for (int j = 0; j < 4; ++j) q += __builtin_bit_cast(float, __hip_atomic_load(b + j, __ATOMIC_RELAXED, __HIP_MEMORY_SCOPE_AGENT));
            S[tid] = rsqrtf(q * (1.f / DM) + NORM_EPS) * scale; }
        __syncthreads();
    }
    __device__ __forceinline__ void fused(pg8::f32x4 (&acc)[2][2][4][2], const pg8::Unit& u, int wr, int wc, int fr, int fq, PG8_LAS unsigned char* lds, int wid, int lane) const {
        float* P = (float*)lds; float* S = P + 1024; const int tid = wid * 64 + lane;
        rowstat(acc, P, wr, wc, fr, fq);
        exchange(P, S, part, cnt, u, tid, coef);
        const int col0 = u.pn * 256 + wc * 32 + 4 * fq;
#pragma unroll
        for (int ai = 0; ai < 2; ++ai)
#pragma unroll
            for (int m = 0; m < 4; ++m) { const int r = ai * 128 + wr * 64 + m * 16 + fr; const float sr = S[r]; const size_t off = (size_t)(u.pm * 256 + r) * DM + col0;
#pragma unroll
                for (int bj = 0; bj < 2; ++bj)
#pragma unroll
                    for (int n = 0; n < 2; ++n) { const int o = bj * 128 + n * 16; const f32x4 g4 = *(const f32x4*)(gpost + col0 + o), x4 = *(const f32x4*)(xin + off + o);
                        const f32x4 y = x4 + acc[ai][bj][m][n] * sr * g4; acc[ai][bj][m][n] = y; *(f32x4*)(xout + off + o) = y; }
                asm volatile("" ::: "memory"); }
        if (!gpre) return;
        rowstat(acc, P, wr, wc, fr, fq);
        exchange(P, S, part + (size_t)M_ * 4, cnt + 64 * 16, u, tid, 1.f);
#pragma unroll
        for (int ai = 0; ai < 2; ++ai)
#pragma unroll
            for (int m = 0; m < 4; ++m) { const int r = ai * 128 + wr * 64 + m * 16 + fr; const float sr = S[r]; const size_t off = (size_t)(u.pm * 256 + r) * DM + col0;
#pragma unroll
                for (int bj = 0; bj < 2; ++bj)
#pragma unroll
                    for (int n = 0; n < 2; ++n) { const int o = bj * 128 + n * 16; const f32x4 g4 = *(const f32x4*)(gpre + col0 + o); st_bf4(xn + off + o, acc[ai][bj][m][n] * sr * g4); }
                asm volatile("" ::: "memory"); }
    }
};
__device__ __forceinline__ void gemm_norm_res(unsigned char* lds, const bf16* A, int lda, const bf16* Bt, int K, const float* xin, float* xout, bf16* xn, const float* gpost, const float* gpre,
                                              float coef, bf16* ybuf, unsigned* part, unsigned* cnt) {
    pg8::Gemm g{A, Bt, M_, DM, K, lda, K}; pg8::StaticOrder S; S.init(M_, DM, 256, (int)blockIdx.x);
    const EpiNormRes E{xin, xout, xn, gpost, gpre, coef, part, cnt};
    pg8::gemm_phase<EpiNormRes, pg8::StaticOrder, false, true>((PG8_LAS unsigned char*)lds, g, S, E);
}

__device__ __forceinline__ void d_cmp2(const bf16* hidk, const bf16* hidv, const bf16* w2t, const float* rope, bf16* kc, bf16* vct) {
    const int T512 = tidx(), lane = T512 & 63, fr = lane & 15, fq = lane >> 4;
    for (int task = blockIdx.x * 8 + (T512 >> 6); task < 256; task += gridDim.x * 8) {
        const int kv = task >> 7, R0 = (task & 127) * 16;
        const bf16* ap = (kv ? hidv : hidk) + (size_t)(R0 + fr) * 256 + 8 * fq;
        const bf16* bp = w2t + (size_t)kv * 64 * 256 + (size_t)fr * 256 + 8 * fq;
        f32x4 acc[4];
#pragma unroll
        for (int nt = 0; nt < 4; ++nt) acc[nt] = (f32x4){0.f, 0.f, 0.f, 0.f};
#pragma unroll
        for (int k0 = 0; k0 < 256; k0 += 32) {
            const bf16x8 a = *(const bf16x8*)(ap + k0);
#pragma unroll
            for (int nt = 0; nt < 4; ++nt) acc[nt] = __builtin_amdgcn_mfma_f32_16x16x32_bf16(*(const bf16x8*)(bp + (size_t)nt * 16 * 256 + k0), a, acc[nt], 0, 0, 0);
        }
        const int R = R0 + fr, bg = R >> 9, c = R & 511;
        if (kv == 0) {
            const int pos = (16 * c + 31) & (T_ - 1);
#pragma unroll
            for (int h2 = 0; h2 < 2; ++h2) {
                const int d = 16 * h2 + 4 * fq; const f32x4* rp = (const f32x4*)(rope + ((size_t)pos * 32 + d) * 2); const f32x4 r0 = rp[0], r1 = rp[1];
                const f32x4 cs = {r0[0], r0[2], r1[0], r1[2]}, sn = {r0[1], r0[3], r1[1], r1[3]};
                const f32x4 lo = acc[h2] * cs - acc[h2 + 2] * sn, hi = acc[h2] * sn + acc[h2 + 2] * cs;
                st_bf4(kc + (size_t)R * 64 + d, lo); st_bf4(kc + (size_t)R * 64 + d + 32, hi);
            }
        } else {
#pragma unroll
            for (int nt = 0; nt < 4; ++nt)
#pragma unroll
                for (int e = 0; e < 4; ++e) vct[((size_t)bg * 64 + 16 * nt + 4 * fq + e) * NCP + c] = (bf16)f2bf(acc[nt][e]);
        }
    }
}

struct NsaArgs { const bf16 *qb, *kc, *vct, *ks, *vst, *kw, *vwt; const float* gates; bf16* amix; };
__device__ __forceinline__ float dot64(const float* q, const bf16* k) {
    float s = 0.f;
#pragma unroll
    for (int i = 0; i < 8; ++i) { const u32x4 w = ((const u32x4*)k)[i];
        s += q[8 * i + 0] * __builtin_bit_cast(float, w.x << 16) + q[8 * i + 1] * __builtin_bit_cast(float, w.x & 0xffff0000u)
           + q[8 * i + 2] * __builtin_bit_cast(float, w.y << 16) + q[8 * i + 3] * __builtin_bit_cast(float, w.y & 0xffff0000u)
           + q[8 * i + 4] * __builtin_bit_cast(float, w.z << 16) + q[8 * i + 5] * __builtin_bit_cast(float, w.z & 0xffff0000u)
           + q[8 * i + 6] * __builtin_bit_cast(float, w.w << 16) + q[8 * i + 7] * __builtin_bit_cast(float, w.w & 0xffff0000u); }
    return s;
}
__device__ __forceinline__ void softmax_row(float* s, int n, int lane) {
    float m = -INFINITY; for (int i = lane; i < n; i += 64) m = fmaxf(m, s[i]);
    m = wave_max(m); if (m == -INFINITY) m = 0.f;
    float l = 0.f; for (int i = lane; i < n; i += 64) { const float e = exp2f(s[i] - m); s[i] = e; l += e; }
    l = wave_sum(l); const float inv = 1.f / fmaxf(l, 1e-30f);
    for (int i = lane; i < n; i += 64) s[i] *= inv;
}
__device__ __forceinline__ void d_nsa_simple(const NsaArgs& a, int vb, int tid, unsigned char* smem) {
    float (*qs)[64] = (float (*)[64])smem; float (*sc)[1024] = (float (*)[1024])(smem + 1024); float* imp = (float*)(smem + 17408); float* score = imp + 128;
    int* list = (int*)(score + 128); int* nlist = list + 16;
    const int bg = vb / T_, t = vb % T_, b = bg >> 1, g = bg & 1;
    const int r = tid >> 6, d = tid & 63, lane = d;
    const size_t row = (size_t)b * T_ + t;
    qs[r][d] = bf2f(a.qb[row * 512 + g * 256 + r * 64 + d]);
    if (tid == 0) *nlist = 0;
    __syncthreads();
    const int nv = t < 31 ? 0 : (t - 31) / 16 + 1;
    for (int c = tid; c < nv; c += 256) { const bf16* k = a.kc + ((size_t)bg * NCP + c) * 64;
        _Pragma("unroll 1") for (int rr = 0; rr < 4; ++rr) sc[rr][c] = dot64(qs[rr], k); }
    __syncthreads();
    softmax_row(sc[r], nv, lane);
    __syncthreads();
    float oc = 0.f; { const bf16* v = a.vct + ((size_t)bg * 64 + d) * NCP; for (int c = 0; c < nv; ++c) oc += sc[r][c] * bf2f(v[c]); }
    if (tid < 128) { const int s = tid; float acc = 0.f;
        for (int c = 4 * s - 1; c <= 4 * s + 3; ++c) if (c >= 0 && c < nv) acc += sc[0][c] + sc[1][c] + sc[2][c] + sc[3][c];
        imp[s] = acc; }
    __syncthreads();
    const int cur = t >> 6;
    if (tid < 128) { const int s = tid; const bool forced = (s == 0) || (s == cur) || (s == cur - 1);
        score[s] = forced ? 1e4f : (s <= cur ? imp[s] : -1e4f); }
    __syncthreads();
    if (tid < 128) { const int s = tid; const float my = score[s]; int rank = 0;
        for (int j = 0; j < 128; ++j) { const float o = score[j]; rank += (o > my || (o == my && j < s)) ? 1 : 0; }
        if (rank < 16 && s <= cur) { const int slot = atomicAdd(nlist, 1); list[slot] = s; } }
    __syncthreads();
    const int ns = *nlist * 64;
    for (int i = tid; i < ns; i += 256) { const int pos = list[i >> 6] * 64 + (i & 63);
        if (pos <= t) { const bf16* k = a.ks + ((size_t)bg * T_ + pos) * 64; _Pragma("unroll 1") for (int rr = 0; rr < 4; ++rr) sc[rr][i] = dot64(qs[rr], k); }
        else { sc[0][i] = -INFINITY; sc[1][i] = -INFINITY; sc[2][i] = -INFINITY; sc[3][i] = -INFINITY; } }
    __syncthreads();
    softmax_row(sc[r], ns, lane);
    __syncthreads();
    float os = 0.f; { const bf16* v = a.vst + ((size_t)bg * 64 + d) * T_;
        for (int i = 0; i < ns; ++i) { const int pos = list[i >> 6] * 64 + (i & 63); if (pos <= t) os += sc[r][i] * bf2f(v[pos]); } }
    __syncthreads();
    const int lo = t - 511 > 0 ? t - 511 : 0, nw = t - lo + 1;
    for (int i = tid; i < nw; i += 256) { const bf16* k = a.kw + ((size_t)bg * T_ + lo + i) * 64;
        _Pragma("unroll 1") for (int rr = 0; rr < 4; ++rr) sc[rr][i] = dot64(qs[rr], k); }
    __syncthreads();
    softmax_row(sc[r], nw, lane);
    __syncthreads();
    float ow = 0.f; { const bf16* v = a.vwt + ((size_t)bg * 64 + d) * T_ + lo; for (int i = 0; i < nw; ++i) ow += sc[r][i] * bf2f(v[i]); }
    const float* gt = a.gates + row * 24 + g * 12 + r * 3;
    a.amix[row * DM + g * 256 + r * 64 + d] = (bf16)f2bf(gt[0] * oc + gt[1] * os + gt[2] * ow);
    __syncthreads();
}


namespace nsa {
typedef float f32x16 __attribute__((ext_vector_type(16)));
constexpr int KROW = 144, VROW = 136, KBUF = 64 * KROW, VBUF = 64 * VROW;
constexpr int OFF_K = 0, OFF_V = 2 * KBUF, OFF_IMP = OFF_V + 2 * VBUF, IMPW = 130, OFF_SEL = OFF_IMP + 64 * IMPW * 4, OFF_UM = OFF_SEL + 1024, OFF_WS = OFF_UM + 16, OFF_UNIT = OFF_WS + 1024, OFF_ACC = OFF_UNIT + 16, LDS_NEED = OFF_ACC + 8 * 8192;
static_assert(LDS_NEED <= 147456 - 64 && OFF_ACC % 16 == 0, "nsa lds");
static_assert(OFF_IMP % 16 == 0 && OFF_SEL % 16 == 0 && OFF_WS % 16 == 0, "nsa lds map");
__device__ __forceinline__ int crow(int r, int hi) { return (r & 3) + 8 * (r >> 2) + 4 * hi; }
__device__ __forceinline__ int next_bit(unsigned m0, unsigned m1, unsigned m2, unsigned m3, int from) {
#pragma unroll
    for (int wd = 0; wd < 4; ++wd) {
        unsigned x = wd == 0 ? m0 : (wd == 1 ? m1 : (wd == 2 ? m2 : m3)); const int base = wd * 32;
        if (from < base + 32) { if (from > base) x &= (~0u) << (from - base); if (x) return base + __builtin_ctz(x); }
    }
    return 128;
}
__device__ __forceinline__ bf16x8 pack8(const f32x16& p, int b0) {
    u32x4 w; w.x = pk2(p[b0 + 0], p[b0 + 1]); w.y = pk2(p[b0 + 2], p[b0 + 3]); w.z = pk2(p[b0 + 4], p[b0 + 5]); w.w = pk2(p[b0 + 6], p[b0 + 7]);
    return __builtin_bit_cast(bf16x8, w);
}
struct Branch { const bf16* k; const bf16* vt; int ldv; };

constexpr float THR = 8.f;
template <int MODE, bool SEL>
__device__ __forceinline__ void compute_tile(unsigned char* sm, int cb, int j, const bf16x8 (&qf)[4], int lo, int hi_b, int lo_max, int hi_min, unsigned s0, unsigned s1, unsigned s2, unsigned s3,
                                             float& m, float& l, float invl, bool& initd, f32x16& negm, f32x16 (&o)[2], float* imp_row, float* wsc, int i, int hi) {
        const unsigned char* kb = sm + OFF_K + cb * KBUF; const unsigned char* vb = sm + OFF_V + cb * VBUF;
        const int key0 = 64 * j;
        bool rowsel = true;
        if (SEL) { const unsigned wsel = j < 32 ? s0 : (j < 64 ? s1 : (j < 96 ? s2 : s3)); rowsel = (wsel >> (j & 31)) & 1u; }
        if (!SEL || __any(rowsel)) {
            f32x16 p0, p1;
            {
                f32x16 c0;
                if (SEL) {
#pragma unroll
                    for (int r = 0; r < 16; ++r) c0[r] = rowsel ? negm[r] : -INFINITY;
                } else c0 = negm;
                const bf16x8 a00 = *(const bf16x8*)(kb + i * KROW + (8 * hi) * 2), a10 = *(const bf16x8*)(kb + (32 + i) * KROW + (8 * hi) * 2);
                p0 = __builtin_amdgcn_mfma_f32_32x32x16_bf16(a00, qf[0], c0, 0, 0, 0);
                p1 = __builtin_amdgcn_mfma_f32_32x32x16_bf16(a10, qf[0], c0, 0, 0, 0);
#pragma unroll
                for (int d0 = 1; d0 < 4; ++d0) {
                    const bf16x8 a0 = *(const bf16x8*)(kb + i * KROW + (16 * d0 + 8 * hi) * 2);
                    const bf16x8 a1 = *(const bf16x8*)(kb + (32 + i) * KROW + (16 * d0 + 8 * hi) * 2);
                    p0 = __builtin_amdgcn_mfma_f32_32x32x16_bf16(a0, qf[d0], p0, 0, 0, 0);
                    p1 = __builtin_amdgcn_mfma_f32_32x32x16_bf16(a1, qf[d0], p1, 0, 0, 0);
                }
            }
            if (!(key0 >= lo_max && key0 + 63 <= hi_min)) {
#pragma unroll
                for (int r = 0; r < 16; ++r) { const int key = key0 + crow(r, hi);
                    if (key < lo || key > hi_b) p0[r] = -INFINITY;
                    if (key + 32 < lo || key + 32 > hi_b) p1[r] = -INFINITY; }
            }
            if (MODE == 1) {
#pragma unroll
                for (int r = 0; r < 16; ++r) { p0[r] = __builtin_amdgcn_exp2f(p0[r]) * invl; p1[r] = __builtin_amdgcn_exp2f(p1[r]) * invl; }
#pragma unroll
                for (int gq = 0; gq < 4; ++gq) {
                    float G0 = (p0[4 * gq] + p0[4 * gq + 1]) + (p0[4 * gq + 2] + p0[4 * gq + 3]), L0 = p0[4 * gq + 3];
                    float G1 = (p1[4 * gq] + p1[4 * gq + 1]) + (p1[4 * gq + 2] + p1[4 * gq + 3]), L1 = p1[4 * gq + 3];
                    G0 += __shfl_xor(G0, 1); L0 += __shfl_xor(L0, 1); G1 += __shfl_xor(G1, 1); L1 += __shfl_xor(L1, 1);
                    G0 += __shfl_xor(G0, 2); L0 += __shfl_xor(L0, 2); G1 += __shfl_xor(G1, 2); L1 += __shfl_xor(L1, 2);
                    if ((i & 3) == 0) { const int s = 16 * j + 2 * gq + hi;
                        atomicAdd(imp_row + s, G0); atomicAdd(imp_row + s + 1, L0); atomicAdd(imp_row + s + 8, G1); atomicAdd(imp_row + s + 9, L1); }
                }
            } else {
                float ta = fmaxf(fmaxf(p0[0], p0[1]), p1[0]), tb = fmaxf(fmaxf(p0[2], p0[3]), p1[1]);
                ta = fmaxf(fmaxf(ta, p1[2]), p1[3]);
#pragma unroll
                for (int r = 4; r < 16; r += 4) { ta = fmaxf(fmaxf(ta, p0[r]), p0[r + 1]); tb = fmaxf(fmaxf(tb, p0[r + 2]), p0[r + 3]); ta = fmaxf(fmaxf(ta, p1[r]), p1[r + 1]); tb = fmaxf(fmaxf(tb, p1[r + 2]), p1[r + 3]); }
                float tm = fmaxf(ta, tb);
                tm = fmaxf(tm, __shfl_xor(tm, 32));
                if (__any((!initd && tm > -INFINITY) || tm > THR)) {
                    const bool was = initd;
                    const float d = was ? fmaxf(tm, 0.f) : (tm > -INFINITY ? tm : 0.f);
                    initd = was || (tm > -INFINITY);
                    m += d; const float alpha = was ? __builtin_amdgcn_exp2f(-d) : 1.f; l *= alpha;
#pragma unroll
                    for (int r = 0; r < 16; ++r) { p0[r] -= d; p1[r] -= d; negm[r] = -m; }
                    if (MODE == 2) {
                        if (hi == 0) wsc[i] = alpha;
                        asm volatile("" ::: "memory");
#pragma unroll
                        for (int rg = 0; rg < 4; ++rg) { const f32x4 a4 = *(const f32x4*)(wsc + 8 * rg + 4 * hi);
#pragma unroll
                            for (int e = 0; e < 4; ++e) { o[0][4 * rg + e] *= a4[e]; o[1][4 * rg + e] *= a4[e]; } }
                        asm volatile("" ::: "memory");
                    }
                }
                float rs = 0.f;
#pragma unroll
                for (int r = 0; r < 16; ++r) { p0[r] = __builtin_amdgcn_exp2f(p0[r]); p1[r] = __builtin_amdgcn_exp2f(p1[r]); rs += p0[r] + p1[r]; }
                l += rs;
            }
            if (MODE != 0) {
                const bf16x8 pf0 = pack8(p0, 0), pf1 = pack8(p0, 8), pf2 = pack8(p1, 0), pf3 = pack8(p1, 8);
#pragma unroll
                for (int dt = 0; dt < 2; ++dt) {
                    const unsigned char* vp = vb + (32 * dt + i) * VROW + 8 * hi;
#pragma unroll
                    for (int ks = 0; ks < 4; ++ks) {
                        const u32x2 v_lo = *(const u32x2*)(vp + 32 * ks), v_hi = *(const u32x2*)(vp + 32 * ks + 16);
                        const bf16x8 vf = __builtin_bit_cast(bf16x8, (u32x4){v_lo.x, v_lo.y, v_hi.x, v_hi.y});
                        o[dt] = __builtin_amdgcn_mfma_f32_32x32x16_bf16(ks == 0 ? pf0 : (ks == 1 ? pf1 : (ks == 2 ? pf2 : pf3)), vf, o[dt], 0, 0, 0);
                    }
                }
            }
        }
}
template <int MODE, bool SEL>
__device__ __forceinline__ void run_branch(unsigned char* sm, const Branch br, unsigned m0, unsigned m1, unsigned m2, unsigned m3,
                                           const bf16x8 (&qf)[4], int lo, int hi_b, int lo_max, int hi_min, unsigned s0, unsigned s1, unsigned s2, unsigned s3,
                                           float& m, float& l, float invl, f32x16 (&o)[2], float* imp_row, float* wsc, int tid, int lane) {
    const int i = lane & 31, hi = lane >> 5;
    const bf16* kp = br.k + tid * 8; const bf16* vp_ = br.vt + (size_t)(tid >> 3) * br.ldv + (tid & 7) * 8;
    unsigned char* kst = sm + OFF_K + (tid >> 3) * KROW + (tid & 7) * 16; unsigned char* vst = sm + OFF_V + (tid >> 3) * VROW + (tid & 7) * 16;
#define NSA_LOAD(jj, KR, VR) do { KR = *(const u32x4*)(kp + (size_t)(jj) * 4096); if (MODE != 0) VR = *(const u32x4*)(vp_ + (jj) * 64); } while (0)
#define NSA_STORE(buf, KR, VR) do { *(u32x4*)(kst + (buf) * KBUF) = KR; if (MODE != 0) { *(u32x2*)(vst + (buf) * VBUF) = (u32x2){VR.x, VR.y}; *(u32x2*)(vst + (buf) * VBUF + 8) = (u32x2){VR.z, VR.w}; } } while (0)
    int j = next_bit(m0, m1, m2, m3, 0);
    int j1 = j < 128 ? next_bit(m0, m1, m2, m3, j + 1) : 128;
    u32x4 kA, vA, kB, vB;
    if (j < 128) { NSA_LOAD(j, kA, vA); if (j1 < 128) NSA_LOAD(j1, kB, vB); NSA_STORE(0, kA, vA); }
    __syncthreads();
    bool initd = (MODE == 1);
    f32x16 negm;
#pragma unroll
    for (int r = 0; r < 16; ++r) negm[r] = (MODE == 1) ? -m : 0.f;
    while (j < 128) {
        {
            const int j2 = j1 < 128 ? next_bit(m0, m1, m2, m3, j1 + 1) : 128;
            if (j2 < 128) NSA_LOAD(j2, kA, vA);
            compute_tile<MODE, SEL>(sm, 0, j, qf, lo, hi_b, lo_max, hi_min, s0, s1, s2, s3, m, l, invl, initd, negm, o, imp_row, wsc, i, hi);
            if (j1 < 128) NSA_STORE(1, kB, vB);
            __syncthreads();
            j = j1; j1 = j2;
        }
        if (j >= 128) break;
        {
            const int j2 = j1 < 128 ? next_bit(m0, m1, m2, m3, j1 + 1) : 128;
            if (j2 < 128) NSA_LOAD(j2, kB, vB);
            compute_tile<MODE, SEL>(sm, 1, j, qf, lo, hi_b, lo_max, hi_min, s0, s1, s2, s3, m, l, invl, initd, negm, o, imp_row, wsc, i, hi);
            if (j1 < 128) NSA_STORE(0, kA, vA);
            __syncthreads();
            j = j1; j1 = j2;
        }
    }
#undef NSA_LOAD
#undef NSA_STORE
}
template <bool FIRST> __device__ __forceinline__ void add_scaled(float* accw, const f32x16 (&o)[2], float f, float* wsc, int i, int hi, int lane) {
    if (hi == 0) wsc[i] = f;
    asm volatile("" ::: "memory");
#pragma unroll
    for (int rg = 0; rg < 4; ++rg) { const f32x4 a4 = *(const f32x4*)(wsc + 8 * rg + 4 * hi);
#pragma unroll
        for (int e = 0; e < 4; ++e)
#pragma unroll
            for (int dt = 0; dt < 2; ++dt) { float* p = accw + (dt * 16 + 4 * rg + e) * 64 + lane; const float v = a4[e] * o[dt][4 * rg + e]; *p = FIRST ? v : (*p + v); } }
    asm volatile("" ::: "memory");
}
__device__ __forceinline__ void unit(const NsaArgs& a, int u, unsigned char* sm) {
    const int tid = tidx(), lane = tid & 63, w = __builtin_amdgcn_readfirstlane(tid >> 6), i = lane & 31, hi = lane >> 5;
    const int cur = 127 - (u >> 2), bg = u & 3, b = bg >> 1, g = bg & 1, q0 = cur * 64;
    const int ql = 8 * w + (i >> 2), hd = i & 3, t = q0 + ql;
    const size_t grow = (size_t)b * T_ + t;
    bf16x8 qf[4];
    { const bf16* qp = a.qb + grow * 512 + g * 256 + hd * 64 + 8 * hi;
#pragma unroll
      for (int d0 = 0; d0 < 4; ++d0) qf[d0] = *(const bf16x8*)(qp + 16 * d0); }
    float* wsc = (float*)(sm + OFF_WS) + w * 32;
    float* imp = (float*)(sm + OFF_IMP);
    unsigned* selw = (unsigned*)(sm + OFF_SEL);
    unsigned* um = (unsigned*)(sm + OFF_UM);
    for (int k = tid; k < 64 * IMPW; k += 512) imp[k] = 0.f;
    if (tid < 4) um[tid] = 0u;
    const float* gt = a.gates + grow * 24 + g * 12 + hd * 3;
    const float gc = gt[0], gs = gt[1], gw = gt[2];
    f32x16 o[2];
    float* accw = (float*)(sm + OFF_ACC) + w * 2048;
    const int tw0 = q0 + 8 * w, tw1 = tw0 + 7;
    {
        const int nv = t < 31 ? 0 : (t - 31) / 16 + 1;
        const int nvw = tw0 < 31 ? 0 : (tw0 - 31) / 16 + 1;
        const int nvmax = (q0 + 63 - 31) / 16 + 1, ntc = (nvmax + 63) / 64;
        const unsigned cm0 = ntc >= 32 ? ~0u : ((1u << ntc) - 1u);
        const Branch br{a.kc + (size_t)bg * NCP * 64, a.vct + (size_t)bg * 64 * NCP, NCP};
        float m = 0.f, l = 0.f;
        run_branch<0, false>(sm, br, cm0, 0u, 0u, 0u, qf, 0, nv - 1, 0, nvw - 1, 0u, 0u, 0u, 0u, m, l, 0.f, o, nullptr, wsc, tid, lane);
        l += __shfl_xor(l, 32);
        const float invl = 1.f / fmaxf(l, 1e-30f);
#pragma unroll
        for (int r = 0; r < 16; ++r) { o[0][r] = 0.f; o[1][r] = 0.f; }
        run_branch<1, false>(sm, br, cm0, 0u, 0u, 0u, qf, 0, nv - 1, 0, nvw - 1, 0u, 0u, 0u, 0u, m, l, invl, o, imp + ql * IMPW, wsc, tid, lane);
        add_scaled<true>(accw, o, gc, wsc, i, hi, lane);
    }
    {
        unsigned u0 = 0u, u1 = 0u, u2 = 0u, u3 = 0u;
        const int ncand = cur - 2;
        unsigned k0[8], k1[8], k2[8], k3[8];
        if (ncand <= 13) {
#pragma unroll
            for (int wd = 0; wd < 4; ++wd) { const int nb = cur + 1 - 32 * wd; const unsigned x = nb >= 32 ? ~0u : (nb <= 0 ? 0u : ((1u << nb) - 1u));
#pragma unroll
                for (int qq = 0; qq < 8; ++qq) { if (wd == 0) k0[qq] = x; else if (wd == 1) k1[qq] = x; else if (wd == 2) k2[qq] = x; else k3[qq] = x; } }
        } else {
            float v0[8], v1[8];
#pragma unroll
            for (int qq = 0; qq < 8; ++qq) { const float* ir = imp + (8 * w + qq) * IMPW;
                v0[qq] = (lane >= 1 && lane <= cur - 2) ? ir[lane] : -1.f; v1[qq] = (lane + 64 <= cur - 2) ? ir[lane + 64] : -1.f;
                k0[qq] = 1u; k1[qq] = 0u; k2[qq] = 0u; k3[qq] = 0u; }
            for (int it = 0; it < 13; ++it) {
                float bv[8]; int bs[8];
#pragma unroll
                for (int qq = 0; qq < 8; ++qq) { bv[qq] = v0[qq]; bs[qq] = lane; if (v1[qq] > v0[qq]) { bv[qq] = v1[qq]; bs[qq] = lane + 64; } }
#pragma unroll
                for (int off = 1; off < 64; off <<= 1) {
#pragma unroll
                    for (int qq = 0; qq < 8; ++qq) { const float ov = __shfl_xor(bv[qq], off); const int os = __shfl_xor(bs[qq], off);
                        if (ov > bv[qq] || (ov == bv[qq] && os < bs[qq])) { bv[qq] = ov; bs[qq] = os; } } }
#pragma unroll
                for (int qq = 0; qq < 8; ++qq) { const int b_ = __builtin_amdgcn_readfirstlane(bs[qq]);
                    if (b_ == lane) v0[qq] = -1.f; if (b_ == lane + 64) v1[qq] = -1.f;
                    const unsigned bit = 1u << (b_ & 31);
                    if (b_ < 32) k0[qq] |= bit; else if (b_ < 64) k1[qq] |= bit; else if (b_ < 96) k2[qq] |= bit; else k3[qq] |= bit; }
            }
            { const int c1 = cur - 1; const unsigned b1 = 1u << (c1 & 31), b2 = 1u << (cur & 31);
#pragma unroll
              for (int qq = 0; qq < 8; ++qq) {
                if (c1 < 32) k0[qq] |= b1; else if (c1 < 64) k1[qq] |= b1; else if (c1 < 96) k2[qq] |= b1; else k3[qq] |= b1;
                if (cur < 32) k0[qq] |= b2; else if (cur < 64) k1[qq] |= b2; else if (cur < 96) k2[qq] |= b2; else k3[qq] |= b2; } }
        }
#pragma unroll
        for (int qq = 0; qq < 8; ++qq) {
            if (lane == 0) { unsigned* sp = selw + (8 * w + qq) * 4; sp[0] = k0[qq]; sp[1] = k1[qq]; sp[2] = k2[qq]; sp[3] = k3[qq]; }
            u0 |= k0[qq]; u1 |= k1[qq]; u2 |= k2[qq]; u3 |= k3[qq]; }
        if (lane == 0) { atomicOr(um + 0, u0); atomicOr(um + 1, u1); atomicOr(um + 2, u2); atomicOr(um + 3, u3); }
    }
    __syncthreads();
    {
        const unsigned U0 = um[0], U1 = um[1], U2 = um[2], U3 = um[3];
        const unsigned* sp = selw + ql * 4; const unsigned s0 = sp[0], s1 = sp[1], s2 = sp[2], s3 = sp[3];
        const Branch br{a.ks + (size_t)bg * T_ * 64, a.vst + (size_t)bg * 64 * T_, T_};
        float m = 0.f, l = 0.f;
#pragma unroll
        for (int r = 0; r < 16; ++r) { o[0][r] = 0.f; o[1][r] = 0.f; }
        run_branch<2, true>(sm, br, __builtin_amdgcn_readfirstlane(U0), __builtin_amdgcn_readfirstlane(U1), __builtin_amdgcn_readfirstlane(U2), __builtin_amdgcn_readfirstlane(U3),
                            qf, 0, t, 0, tw0, s0, s1, s2, s3, m, l, 0.f, o, nullptr, wsc, tid, lane);
        l += __shfl_xor(l, 32);
        add_scaled<false>(accw, o, gs / fmaxf(l, 1e-30f), wsc, i, hi, lane);
    }
    {
        const int j0 = cur - 8 > 0 ? cur - 8 : 0;
        unsigned wm0 = 0u, wm1 = 0u, wm2 = 0u, wm3 = 0u;
#pragma unroll
        for (int wd = 0; wd < 4; ++wd) { const int a0 = j0 - 32 * wd, a1 = cur + 1 - 32 * wd;
            const unsigned hi_m = a1 >= 32 ? ~0u : (a1 <= 0 ? 0u : ((1u << a1) - 1u)), lo_m = a0 >= 32 ? ~0u : (a0 <= 0 ? 0u : ((1u << a0) - 1u));
            const unsigned x = hi_m & ~lo_m; if (wd == 0) wm0 = x; else if (wd == 1) wm1 = x; else if (wd == 2) wm2 = x; else wm3 = x; }
        const Branch br{a.kw + (size_t)bg * T_ * 64, a.vwt + (size_t)bg * 64 * T_, T_};
        float m = 0.f, l = 0.f;
#pragma unroll
        for (int r = 0; r < 16; ++r) { o[0][r] = 0.f; o[1][r] = 0.f; }
        run_branch<2, false>(sm, br, wm0, wm1, wm2, wm3, qf, t - 511, t, tw1 - 511, tw0, 0u, 0u, 0u, 0u, m, l, 0.f, o, nullptr, wsc, tid, lane);
        l += __shfl_xor(l, 32);
        add_scaled<false>(accw, o, gw / fmaxf(l, 1e-30f), wsc, i, hi, lane);
    }
#pragma unroll
    for (int r = 0; r < 16; ++r) { const int rw = crow(r, hi), qq = 8 * w + (rw >> 2), hh = rw & 3;
        bf16* op = a.amix + ((size_t)b * T_ + q0 + qq) * DM + g * 256 + hh * 64 + i;
        op[0] = (bf16)f2bf(accw[r * 64 + lane]); op[32] = (bf16)f2bf(accw[(16 + r) * 64 + lane]); }
}
__device__ __forceinline__ void phase(const NsaArgs& a, unsigned* ctr, unsigned char* sm) {
    int* slot = (int*)(sm + OFF_UNIT);
    for (;;) {
        if (tidx() == 0) *slot = (int)atomicAdd(ctr, 1u);
        __syncthreads();
        const int u = *slot;
        __syncthreads();
        if (u >= 512) break;
        unit(a, u, sm);
    }
}
}

__device__ __forceinline__ void d_lora_prep(const bf16* pr, const float* mu, bf16* la) {
    const int T512 = tidx(), c = T512 & 255;
    const float m = mu[1536 + c];
    FOR_VB(vb, M_ / 4) {
        const int row0 = vb * 4;
        float x[5];
        x[0] = (row0 % T_) ? bf2f(pr[(size_t)(row0 - 1) * 256 + c]) : 0.f;
#pragma unroll
        for (int j = 0; j < 4; ++j) x[j + 1] = bf2f(pr[(size_t)(row0 + j) * 256 + c]);
#pragma unroll
        for (int j = 0; j < 4; ++j) { const float xs = x[j + 1] + (x[j] - x[j + 1]) * m;
            const float v = c < 64 ? tanhf(xs) : (c < 128 ? xs : sigmoidf_(xs));
            la[(size_t)(row0 + j) * KLORA + c] = (bf16)f2bf(v); }
    }
}

namespace rw7 {
using nsa::f32x16; using nsa::crow; using nsa::pack8;
constexpr int NHELP = 2, RG = 18;
constexpr int NPROD = 6, RING = 7, RA = 144, RB = 40, S_AT = 0, S_RT = 16 * RA, S_BT = 32 * RA, S_KT = S_BT + 64 * RB, S_VT = S_KT + 64 * RB, S_SM = S_VT + 64 * RB, SMM = 16 * RB, S_GC = S_SM + 4 * SMM, SLOT = S_GC + 256;
constexpr int OFF_SCR = RING * SLOT, SCR = 32 * RA, LDS_NEED = OFF_SCR;
static_assert(NPROD % NHELP == 0 && LDS_NEED <= 147456 - 64 && 6 * (SLOT + SCR) <= 147456 - 64 && (size_t)16 * NHELP * RG * SLOT <= (size_t)9 << 20 && SLOT % 16 == 0 && S_BT % 16 == 0 && 128 * RB >= 4096 && SCR >= 4096, "rw7 lds map");
struct Args { const unsigned* rkw; const bf16* vv; const bf16* aga; const float* wdec; const float *mu, *kk, *ka, *rk; float* yraw; float* bonus; unsigned char* ring; unsigned* flags; unsigned* cons; };
__device__ __forceinline__ void wg_bar() { asm volatile("s_waitcnt lgkmcnt(0)" ::: "memory"); __builtin_amdgcn_s_barrier(); asm volatile("" ::: "memory"); }
struct Chan { float mur, muk, muv, kkc, kac, rkc; };
struct Raw { unsigned rk[16]; unsigned short v[16], al[16]; float w[16]; unsigned prk; unsigned short pv; };
__device__ __forceinline__ void fetch(const Args& a, int b, int h, int c, int lane, Raw& q) {
    const size_t base = ((size_t)b * T_ + (size_t)c * 16) * 512 + h * 64 + lane;
#pragma unroll
    for (int t = 0; t < 16; ++t) { q.rk[t] = a.rkw[base + (size_t)t * 512]; q.v[t] = a.vv[base + (size_t)t * 512]; q.al[t] = a.aga[base + (size_t)t * 512]; q.w[t] = a.wdec[base + (size_t)t * 512]; }
    q.prk = 0u; q.pv = 0;
    if (c > 0) { q.prk = a.rkw[base - 512]; q.pv = a.vv[base - 512]; }
}
__device__ __forceinline__ void st_row40(unsigned char* p, const unsigned (&w)[8]) {
    *(u32x2*)p = (u32x2){w[0], w[1]}; *(u32x2*)(p + 8) = (u32x2){w[2], w[3]}; *(u32x2*)(p + 16) = (u32x2){w[4], w[5]}; *(u32x2*)(p + 24) = (u32x2){w[6], w[7]};
}
template <bool BAR> __device__ __forceinline__ void seg_end() { if (BAR) wg_bar(); else { asm volatile("s_waitcnt lgkmcnt(0)" ::: "memory"); __builtin_amdgcn_sched_barrier(0); } }
template <bool BAR> __device__ __forceinline__ void produce(const Args& a, const Chan& ch, int b, int h, int c, const Raw& q, unsigned char* slot, unsigned char* scr, int lane) {
    const int i = lane & 31, hi = lane >> 5;
    const size_t row0 = (size_t)b * T_ + (size_t)c * 16;
    float pr_r = __builtin_bit_cast(float, q.prk << 16), pr_k = __builtin_bit_cast(float, q.prk & 0xffff0000u), pr_v = bf2f(q.pv);
    float rr[16], kq[16], kt[16];
    float* RED1 = (float*)scr;
    float* RED2 = (float*)(slot + S_BT);
#pragma unroll
    for (int t4 = 0; t4 < 4; ++t4) { f32x4 e1, e2;
#pragma unroll
        for (int e = 0; e < 4; ++e) { const int t = 4 * t4 + e;
            const float r0 = __builtin_bit_cast(float, q.rk[t] << 16), k0 = __builtin_bit_cast(float, q.rk[t] & 0xffff0000u), al = bf2f(q.al[t]);
            const float r = r0 + (pr_r - r0) * ch.mur, k = k0 + (pr_k - k0) * ch.muk;
            pr_r = r0; pr_k = k0;
            rr[t] = r; kq[t] = k * ch.kkc; kt[t] = k * (1.f + (al - 1.f) * ch.kac);
            e1[e] = kq[t] * kq[t]; e2[e] = r * kt[t] * ch.rkc; }
        *(f32x4*)(RED1 + lane * 16 + 4 * t4) = e1; *(f32x4*)(RED2 + lane * 16 + 4 * t4) = e2; }
    seg_end<BAR>();
    { const int t = lane & 15, part = lane >> 4; float s1 = 0.f, s2 = 0.f;
#pragma unroll
      for (int j = 0; j < 16; ++j) { s1 += RED1[(part * 16 + j) * 16 + t]; s2 += RED2[(part * 16 + j) * 16 + t]; }
      s1 += __shfl_xor(s1, 16); s2 += __shfl_xor(s2, 16); s1 += __shfl_xor(s1, 32); s2 += __shfl_xor(s2, 32);
      asm volatile("s_waitcnt lgkmcnt(0)" ::: "memory");
      if (lane < 16) { ((float*)(slot + S_GC))[lane] = s1; a.bonus[(row0 + lane) * 8 + h] = s2; } }
    asm volatile("s_waitcnt lgkmcnt(0)" ::: "memory");
    f32x4 n2[4];
#pragma unroll
    for (int t4 = 0; t4 < 4; ++t4) n2[t4] = *(const f32x4*)(slot + S_GC + 16 * t4);
    asm volatile("s_waitcnt lgkmcnt(0)" ::: "memory");
    float gam = 1.f;
    unsigned btp[8], ktp[8], vtp[8];
    float b_ev = 0.f, k_ev = 0.f, v_ev = 0.f;
#pragma unroll
    for (int t = 0; t < 16; ++t) {
        if (t == 6) seg_end<BAR>();
        const float v0 = bf2f(q.v[t]), al = bf2f(q.al[t]);
        const float v = v0 + (pr_v - v0) * ch.muv; pr_v = v0;
        const float kkn = kq[t] * __builtin_amdgcn_rsqf(fmaxf(n2[t >> 2][t & 3], 1e-24f));
        const float gp = gam; gam *= q.w[t]; const float ig = __builtin_amdgcn_rcpf(gam);
        const float bt_ = kkn * al * ig, kt_ = kt[t] * ig;
        const unsigned ar = pk2(-kkn * gp, rr[t] * gam), bk = pk2(bt_, kt_);
        *(bf16*)(slot + S_AT + t * RA + lane * 2) = (bf16)(ar & 0xffffu); *(bf16*)(slot + S_RT + t * RA + lane * 2) = (bf16)(ar >> 16);
        *(bf16*)(scr + t * RA + lane * 2) = (bf16)(bk & 0xffffu); *(bf16*)(scr + (16 + t) * RA + lane * 2) = (bf16)(bk >> 16);
        if (t & 1) { btp[t >> 1] = pk2(b_ev, bt_); ktp[t >> 1] = pk2(k_ev, kt_); vtp[t >> 1] = pk2(v_ev, v); }
        else { b_ev = bt_; k_ev = kt_; v_ev = v; }
    }
    st_row40(slot + S_BT + lane * RB, btp); st_row40(slot + S_KT + lane * RB, ktp); st_row40(slot + S_VT + lane * RB, vtp);
    ((float*)(slot + S_GC))[lane] = gam;
    seg_end<BAR>();
    f32x16 C;
#pragma unroll
    for (int r = 0; r < 16; ++r) C[r] = 0.f;
#pragma unroll
    for (int ks = 0; ks < 4; ++ks) {
        const bf16x8 af = *(const bf16x8*)(slot + S_AT + i * RA + (16 * ks + 8 * hi) * 2);
        const bf16x8 bf = *(const bf16x8*)(scr + i * RA + (16 * ks + 8 * hi) * 2);
        C = __builtin_amdgcn_mfma_f32_32x32x16_bf16(af, bf, C, 0, 0, 0);
    }
    asm volatile("s_waitcnt lgkmcnt(0)" ::: "memory");
    float* AAB = (float*)scr;
    unsigned char* SM = slot + S_SM;
#pragma unroll
    for (int r = 0; r < 16; ++r) {
        const int rho = crow(r, hi); const float val = C[r];
        if (r < 8) {
            if (i < 16) AAB[rho * 16 + i] = (i < rho) ? val : 0.f;
            else *(bf16*)(SM + SMM + rho * RB + (i - 16) * 2) = (bf16)f2bf((i - 16 < rho) ? val : 0.f);
        } else {
            const int tt = rho - 16;
            if (i < 16) *(bf16*)(SM + 2 * SMM + tt * RB + i * 2) = (bf16)f2bf((i <= tt) ? val : 0.f);
            else *(bf16*)(SM + 3 * SMM + tt * RB + (i - 16) * 2) = (bf16)f2bf((i - 16 <= tt) ? val : 0.f);
        }
    }
    seg_end<BAR>();
    { const int j = lane & 15; float Tr[16];
#pragma unroll
      for (int t = 0; t < 16; ++t) { if (t == 11) seg_end<BAR>();
          float acc = (t == j) ? 1.f : 0.f;
#pragma unroll
          for (int s4 = 0; s4 < (t + 3) / 4; ++s4) { const f32x4 ar = *(const f32x4*)(AAB + t * 16 + 4 * s4);
#pragma unroll
              for (int e = 0; e < 4; ++e) if (4 * s4 + e < t) acc += ar[e] * Tr[4 * s4 + e]; }
          Tr[t] = acc;
          if (lane < 16) *(bf16*)(SM + t * RB + j * 2) = (bf16)f2bf(acc); } }
    seg_end<BAR>();
}

__device__ __forceinline__ bf16x8 rd_perm(const unsigned char* p, int hi) {
    const u32x2 a = *(const u32x2*)(p + 8 * hi), b = *(const u32x2*)(p + 16 + 8 * hi);
    return __builtin_bit_cast(bf16x8, (u32x4){a.x, a.y, b.x, b.y});
}
__device__ __forceinline__ bf16x8 rd_nat(const unsigned char* p, int hi) {
    const u32x2 a = *(const u32x2*)(p + 16 * hi), b = *(const u32x2*)(p + 16 * hi + 8);
    return __builtin_bit_cast(bf16x8, (u32x4){a.x, a.y, b.x, b.y});
}
__device__ __forceinline__ bf16x8 and8(bf16x8 f, unsigned m) { u32x4 w = __builtin_bit_cast(u32x4, f); w.x &= m; w.y &= m; w.z &= m; w.w &= m; return __builtin_bit_cast(bf16x8, w); }
__device__ __forceinline__ void consume(const unsigned char* slot, f32x16 (&z)[2], float* yout, int vt, int lane) {
    const int i = lane & 31, hi = lane >> 5, i16 = i & 15;
    const unsigned m16 = i < 16 ? 0xffffffffu : 0u;
    const unsigned char* at = slot + S_AT + i16 * RA; const unsigned char* rt = slot + S_RT + i16 * RA; const unsigned char* sm16 = slot + S_SM + i16 * RB;
    bf16x8 fa0 = rd_perm(at, hi), fa1 = rd_perm(at + 32, hi), fa2 = rd_perm(at + 64, hi), fa3 = rd_perm(at + 96, hi);
    bf16x8 fak = rd_nat(sm16 + SMM, hi), ft = rd_perm(sm16, hi);
    const bf16x8 vtf = rd_nat(slot + S_VT + (32 * vt + i) * RB, hi);
    bf16x8 fr0 = rd_perm(rt, hi), fr1 = rd_perm(rt + 32, hi), fr2 = rd_perm(rt + 64, hi), fr3 = rd_perm(rt + 96, hi);
    bf16x8 frb = rd_perm(sm16 + 2 * SMM, hi), frk = rd_nat(sm16 + 3 * SMM, hi);
    const bf16x8 fk0 = rd_nat(slot + S_KT + i * RB, hi), fk1 = rd_nat(slot + S_KT + (32 + i) * RB, hi);
    const bf16x8 fb0 = rd_perm(slot + S_BT + i * RB, hi), fb1 = rd_perm(slot + S_BT + (32 + i) * RB, hi);
    f32x4 g4[2][4];
#pragma unroll
    for (int kt = 0; kt < 2; ++kt)
#pragma unroll
        for (int rg = 0; rg < 4; ++rg) g4[kt][rg] = *(const f32x4*)(slot + S_GC + (32 * kt + 8 * rg + 4 * hi) * 4);
    const bf16x8 zb0 = pack8(z[0], 0), zb1 = pack8(z[0], 8), zb2 = pack8(z[1], 0), zb3 = pack8(z[1], 8);
    fa0 = and8(fa0, m16); fa1 = and8(fa1, m16); fa2 = and8(fa2, m16); fa3 = and8(fa3, m16); fak = and8(fak, m16); ft = and8(ft, m16);
    fr0 = and8(fr0, m16); fr1 = and8(fr1, m16); fr2 = and8(fr2, m16); fr3 = and8(fr3, m16); frb = and8(frb, m16); frk = and8(frk, m16);
    f32x16 X, U, Y;
#pragma unroll
    for (int r = 0; r < 16; ++r) { X[r] = 0.f; U[r] = 0.f; Y[r] = 0.f; }
    X = __builtin_amdgcn_mfma_f32_32x32x16_bf16(fa0, zb0, X, 0, 0, 0);
    X = __builtin_amdgcn_mfma_f32_32x32x16_bf16(fa1, zb1, X, 0, 0, 0);
    X = __builtin_amdgcn_mfma_f32_32x32x16_bf16(fa2, zb2, X, 0, 0, 0);
    X = __builtin_amdgcn_mfma_f32_32x32x16_bf16(fa3, zb3, X, 0, 0, 0);
    X = __builtin_amdgcn_mfma_f32_32x32x16_bf16(fak, vtf, X, 0, 0, 0);
    Y = __builtin_amdgcn_mfma_f32_32x32x16_bf16(fr0, zb0, Y, 0, 0, 0);
    Y = __builtin_amdgcn_mfma_f32_32x32x16_bf16(fr1, zb1, Y, 0, 0, 0);
    Y = __builtin_amdgcn_mfma_f32_32x32x16_bf16(fr2, zb2, Y, 0, 0, 0);
    Y = __builtin_amdgcn_mfma_f32_32x32x16_bf16(fr3, zb3, Y, 0, 0, 0);
    Y = __builtin_amdgcn_mfma_f32_32x32x16_bf16(frk, vtf, Y, 0, 0, 0);
    z[0] = __builtin_amdgcn_mfma_f32_32x32x16_bf16(fk0, vtf, z[0], 0, 0, 0);
    z[1] = __builtin_amdgcn_mfma_f32_32x32x16_bf16(fk1, vtf, z[1], 0, 0, 0);
    const bf16x8 xb = pack8(X, 0);
    U = __builtin_amdgcn_mfma_f32_32x32x16_bf16(ft, xb, U, 0, 0, 0);
    const bf16x8 ub = pack8(U, 0);
    z[0] = __builtin_amdgcn_mfma_f32_32x32x16_bf16(fb0, ub, z[0], 0, 0, 0);
    z[1] = __builtin_amdgcn_mfma_f32_32x32x16_bf16(fb1, ub, z[1], 0, 0, 0);
    Y = __builtin_amdgcn_mfma_f32_32x32x16_bf16(frb, ub, Y, 0, 0, 0);
#pragma unroll
    for (int kt = 0; kt < 2; ++kt)
#pragma unroll
        for (int rg = 0; rg < 4; ++rg)
#pragma unroll
            for (int e = 0; e < 4; ++e) z[kt][4 * rg + e] *= g4[kt][rg][e];
#pragma unroll
    for (int r = 0; r < 8; ++r) yout[(size_t)crow(r, hi) * 512] = Y[r];
}

__device__ __forceinline__ unsigned ld_relaxed(const unsigned* p) { return __hip_atomic_load(p, __ATOMIC_RELAXED, __HIP_MEMORY_SCOPE_AGENT); }
__device__ __forceinline__ void head(const Args& a, int bh, unsigned char* sm) {
    const int tid = tidx(), lane = tid & 63, w = __builtin_amdgcn_readfirstlane(tid >> 6);
    const int b = bh >> 3, h = bh & 7;
    constexpr int NCH = T_ / 16, NBAR = NCH + NPROD;
    if (w < 2) {
        f32x16 z[2];
#pragma unroll
        for (int r = 0; r < 16; ++r) { z[0][r] = 0.f; z[1][r] = 0.f; }
        for (int i = 0; i < NPROD; ++i) wg_bar();
        for (int c = 0; c < NCH; ++c) {
            consume(sm + (size_t)(c % RING) * SLOT, z, a.yraw + ((size_t)b * T_ + (size_t)c * 16) * 512 + h * 64 + 32 * w + (lane & 31), w, lane);
            if (w == 0 && (c & 7) == 7 && lane == 0) __hip_atomic_store(a.cons + bh * 64, (unsigned)(c + 1), __ATOMIC_RELAXED, __HIP_MEMORY_SCOPE_AGENT);
            wg_bar();
        }
    } else {
        const int pw = w - 2;
        int nb = pw;
        {
            u32x4 v[15];
            { const int c = pw; const int hl = c % NHELP, n = c / NHELP;
              const unsigned char* g = a.ring + ((size_t)(bh * NHELP + hl) * RG + (n % RG)) * SLOT;
              while (__builtin_amdgcn_readfirstlane(ld_relaxed(a.flags + bh * NCH + c)) == 0u) __builtin_amdgcn_s_sleep(2);
              __builtin_amdgcn_fence(__ATOMIC_ACQUIRE, "agent");
              asm volatile("s_waitcnt vmcnt(0)" ::: "memory");
#pragma unroll
              for (int i = 0; i < 15; ++i) { const int off = (i * 64 + lane) * 16; if (off < SLOT) v[i] = *(const u32x4*)(g + off); } }
            for (int i = 0; i < pw; ++i) wg_bar();
            for (int c = pw; c < NCH; c += NPROD) {
                unsigned char* slot = sm + (size_t)(c % RING) * SLOT;
#pragma unroll
                for (int i = 0; i < 15; ++i) { const int off = (i * 64 + lane) * 16; if (off < SLOT) *(u32x4*)(slot + off) = v[i]; }
                const int cn = c + NPROD; const bool more = cn < NCH;
                const unsigned* fp = a.flags + bh * NCH + (more ? cn : c);
                unsigned fl = ld_relaxed(fp);
                wg_bar(); wg_bar();
                if (more) {
                    while (__builtin_amdgcn_readfirstlane(fl) == 0u) { __builtin_amdgcn_s_sleep(2); fl = ld_relaxed(fp); }
                    __builtin_amdgcn_fence(__ATOMIC_ACQUIRE, "agent");
                    asm volatile("s_waitcnt vmcnt(0)" ::: "memory");
                    const int hl = cn % NHELP, n = cn / NHELP;
                    const unsigned char* g = a.ring + ((size_t)(bh * NHELP + hl) * RG + (n % RG)) * SLOT;
#pragma unroll
                    for (int i = 0; i < 15; ++i) { const int off = (i * 64 + lane) * 16; if (off < SLOT) v[i] = *(const u32x4*)(g + off); }
                }
                wg_bar(); wg_bar(); wg_bar(); wg_bar();
                nb += NPROD;
            }
        }
        for (; nb < NBAR; ++nb) wg_bar();
    }
}
__device__ __forceinline__ void helper(const Args& a, int bh, int hl, unsigned char* sm) {
    const int tid = tidx(), lane = tid & 63, w = __builtin_amdgcn_readfirstlane(tid >> 6);
    if (w >= 6) return;
    const int b = bh >> 3, h = bh & 7, col = h * 64 + lane;
    constexpr int NCH = T_ / 16;
    unsigned char* slot = sm + (size_t)w * SLOT; unsigned char* scr = sm + 6 * SLOT + w * SCR;
    const Chan ch{a.mu[col], a.mu[512 + col], a.mu[1024 + col], a.kk[col], a.ka[col], a.rk[col]};
    int n = w, c = NHELP * n + hl;
    if (c >= NCH) return;
    for (; c < NCH; n += 6, c += 6 * NHELP) {
        Raw q; fetch(a, b, h, c, lane, q);
        if (n >= RG) { const unsigned need = (unsigned)(c - RG * NHELP + 1);
            while (__builtin_amdgcn_readfirstlane(ld_relaxed(a.cons + bh * 64)) < need) __builtin_amdgcn_s_sleep(8); }
        produce<false>(a, ch, b, h, c, q, slot, scr, lane);
        asm volatile("s_waitcnt lgkmcnt(0)" ::: "memory");
        unsigned char* g = a.ring + ((size_t)(bh * NHELP + hl) * RG + (n % RG)) * SLOT;
#pragma unroll
        for (int i = 0; i < 15; ++i) { const int off = (i * 64 + lane) * 16;
            if (off < SLOT) { const u32x4 d = *(const u32x4*)(slot + off); unsigned char* gp = g + off; asm volatile("global_store_dwordx4 %0, %1, off sc1\n\ts_nop 1" :: "v"(gp), "v"(d) : "memory"); } }
        asm volatile("s_waitcnt vmcnt(0)" ::: "memory");
        if (lane == 0) __hip_atomic_store(a.flags + bh * NCH + c, 1u, __ATOMIC_RELAXED, __HIP_MEMORY_SCOPE_AGENT);
    }
}
__device__ __forceinline__ void finish(const float* yraw, const float* bonus, const bf16* vv, const bf16* agg, const float* mu, const float* gng, const float* gnb, bf16* amix) {
    const int T512 = tidx(), lane = T512 & 63;
    for (int it0 = (blockIdx.x * 8 + (T512 >> 6)) * 4; it0 < M_ * 8; it0 += gridDim.x * 8 * 4) {
        const int row = it0 >> 3, h0 = it0 & 7, t = row % T_;
        float y[4], v0[4], v1[4], gg[4], bo[4];
#pragma unroll
        for (int j = 0; j < 4; ++j) { const int col = (h0 + j) * 64 + lane;
            y[j] = yraw[(size_t)row * 512 + col]; v0[j] = bf2f(vv[(size_t)row * 512 + col]); v1[j] = t ? bf2f(vv[(size_t)(row - 1) * 512 + col]) : 0.f;
            gg[j] = bf2f(agg[(size_t)row * 512 + col]); bo[j] = bonus[(size_t)row * 8 + h0 + j]; }
        float mean[4], var[4];
#pragma unroll
        for (int j = 0; j < 4; ++j) mean[j] = y[j];
#pragma unroll
        for (int o = 1; o < 64; o <<= 1) {
#pragma unroll
            for (int j = 0; j < 4; ++j) mean[j] += __shfl_xor(mean[j], o); }
#pragma unroll
        for (int j = 0; j < 4; ++j) { mean[j] *= (1.f / 64.f); y[j] -= mean[j]; var[j] = y[j] * y[j]; }
#pragma unroll
        for (int o = 1; o < 64; o <<= 1) {
#pragma unroll
            for (int j = 0; j < 4; ++j) var[j] += __shfl_xor(var[j], o); }
#pragma unroll
        for (int j = 0; j < 4; ++j) { const int col = (h0 + j) * 64 + lane;
            const float yn = y[j] * rsqrtf(var[j] * (1.f / 64.f) + 64e-5f) * gng[col] + gnb[col];
            const float v = v0[j] + (v1[j] - v0[j]) * mu[1024 + col];
            amix[(size_t)row * DM + 512 + col] = (bf16)f2bf((yn + bo[j] * v) * gg[j]); }
    }
}
}

namespace mema {
using nsa::f32x16; using nsa::KROW; using nsa::VROW; using nsa::KBUF; using nsa::VBUF; using nsa::OFF_K; using nsa::OFF_V; using nsa::OFF_WS; using nsa::crow; using nsa::pack8;
__device__ __forceinline__ void unit(const bf16* qm, const bf16* mk, const bf16* mvt, bf16* om, int u, unsigned char* sm) {
    const int tid = tidx(), lane = tid & 63, w = __builtin_amdgcn_readfirstlane(tid >> 6), i = lane & 31, hi = lane >> 5;
    const int b = u >> 7, h = (u >> 5) & 3, rb = u & 31;
    const int row0 = b * T_ + rb * 256 + 32 * w;
    const bf16* qrow = qm + (size_t)(row0 + i) * DM + h * 256 + 8 * hi;
    const bf16* kbase = mk + (size_t)(b * 256 + (tid >> 3)) * DM + h * 256 + (tid & 7) * 8;
    const bf16* vbase = mvt + (size_t)(h * 256 + (tid >> 3)) * 512 + b * 256 + (tid & 7) * 8;
    unsigned char* kst = sm + OFF_K + (tid >> 3) * KROW + (tid & 7) * 16;
    unsigned char* vst = sm + OFF_V + (tid >> 3) * VROW + (tid & 7) * 16;
    float* wsc = (float*)(sm + OFF_WS) + w * 32;
    f32x16 p[4][2];
#pragma unroll
    for (int kt = 0; kt < 4; ++kt)
#pragma unroll
        for (int r = 0; r < 16; ++r) { p[kt][0][r] = 0.f; p[kt][1][r] = 0.f; }
    u32x4 tr = *(const u32x4*)kbase;
    *(u32x4*)kst = tr;
    __syncthreads();
    bf16x8 qf[4];
#pragma unroll
    for (int n = 0; n < 16; ++n) {
        const int dc = n >> 2, kt = n & 3, cb = n & 1;
        if (n + 1 < 16) tr = *(const u32x4*)(kbase + (size_t)(64 * ((n + 1) & 3)) * DM + 64 * ((n + 1) >> 2));
        else tr = *(const u32x4*)vbase;
        if (kt == 0) {
#pragma unroll
            for (int d0 = 0; d0 < 4; ++d0) qf[d0] = *(const bf16x8*)(qrow + 64 * dc + 16 * d0);
        }
        const unsigned char* kb = sm + OFF_K + cb * KBUF;
#pragma unroll
        for (int d0 = 0; d0 < 4; ++d0) {
            const bf16x8 a0 = *(const bf16x8*)(kb + i * KROW + (16 * d0 + 8 * hi) * 2);
            const bf16x8 a1 = *(const bf16x8*)(kb + (32 + i) * KROW + (16 * d0 + 8 * hi) * 2);
            p[kt][0] = __builtin_amdgcn_mfma_f32_32x32x16_bf16(a0, qf[d0], p[kt][0], 0, 0, 0);
            p[kt][1] = __builtin_amdgcn_mfma_f32_32x32x16_bf16(a1, qf[d0], p[kt][1], 0, 0, 0);
        }
        if (n + 1 < 16) *(u32x4*)(kst + (cb ^ 1) * KBUF) = tr;
        else { *(u32x2*)vst = (u32x2){tr.x, tr.y}; *(u32x2*)(vst + 8) = (u32x2){tr.z, tr.w}; }
        __syncthreads();
    }
    float mx = p[0][0][0];
#pragma unroll
    for (int kt = 0; kt < 4; ++kt)
#pragma unroll
        for (int r = 0; r < 16; ++r) mx = fmaxf(mx, fmaxf(p[kt][0][r], p[kt][1][r]));
    mx = fmaxf(mx, __shfl_xor(mx, 32));
    float l = 0.f;
#pragma unroll
    for (int kt = 0; kt < 4; ++kt)
#pragma unroll
        for (int r = 0; r < 16; ++r) { p[kt][0][r] = __builtin_amdgcn_exp2f(p[kt][0][r] - mx); p[kt][1][r] = __builtin_amdgcn_exp2f(p[kt][1][r] - mx); l += p[kt][0][r] + p[kt][1][r]; }
    l += __shfl_xor(l, 32);
    bf16x8 pf[4][4];
#pragma unroll
    for (int kt = 0; kt < 4; ++kt) { pf[kt][0] = pack8(p[kt][0], 0); pf[kt][1] = pack8(p[kt][0], 8); pf[kt][2] = pack8(p[kt][1], 0); pf[kt][3] = pack8(p[kt][1], 8); }
    if (hi == 0) wsc[i] = 1.f / l;
    asm volatile("" ::: "memory");
    f32x4 il[4];
#pragma unroll
    for (int rg = 0; rg < 4; ++rg) il[rg] = *(const f32x4*)(wsc + 8 * rg + 4 * hi);
    f32x16 o[2];
#pragma unroll
    for (int n = 0; n < 16; ++n) {
        const int dvt = n >> 2, kt = n & 3, cb = n & 1;
        if (n + 1 < 16) tr = *(const u32x4*)(vbase + (size_t)(64 * ((n + 1) >> 2)) * 512 + 64 * ((n + 1) & 3));
        if (kt == 0) {
#pragma unroll
            for (int r = 0; r < 16; ++r) { o[0][r] = 0.f; o[1][r] = 0.f; }
        }
        const unsigned char* vb = sm + OFF_V + cb * VBUF;
#pragma unroll
        for (int dt = 0; dt < 2; ++dt) {
            const unsigned char* vp = vb + (32 * dt + i) * VROW + 8 * hi;
#pragma unroll
            for (int ks = 0; ks < 4; ++ks) {
                const u32x2 v_lo = *(const u32x2*)(vp + 32 * ks), v_hi = *(const u32x2*)(vp + 32 * ks + 16);
                const bf16x8 vf = __builtin_bit_cast(bf16x8, (u32x4){v_lo.x, v_lo.y, v_hi.x, v_hi.y});
                o[dt] = __builtin_amdgcn_mfma_f32_32x32x16_bf16(pf[kt][ks], vf, o[dt], 0, 0, 0);
            }
        }
        if (kt == 3) {
#pragma unroll
            for (int r = 0; r < 16; ++r) { bf16* op = om + (size_t)(row0 + crow(r, hi)) * DM + h * 256 + 64 * dvt + i;
                op[0] = (bf16)f2bf(o[0][r] * il[r >> 2][r & 3]); op[32] = (bf16)f2bf(o[1][r] * il[r >> 2][r & 3]); }
        }
        if (n + 1 < 16) { unsigned char* vp2 = vst + (cb ^ 1) * VBUF; *(u32x2*)vp2 = (u32x2){tr.x, tr.y}; *(u32x2*)(vp2 + 8) = (u32x2){tr.z, tr.w}; }
        __syncthreads();
    }
}
}

#define LAS __attribute__((address_space(3)))
#define XB_TMO      128
#define XB_XCNT(j)  (256  + 64 * (j))
#define XB_XSUB(j)  (1280 + 64 * (j))
#define XB_XGEN(j)  (2304 + 64 * (j))
#define XB_TOP      3328
#define XB_TOPGEN   3392
#define XCD_BAR_WORDS 3456
#define XB_SPIN_CAP (1u << 18)

__device__ __forceinline__ unsigned xb_ld(unsigned* p)              { return __hip_atomic_load(p, __ATOMIC_RELAXED, __HIP_MEMORY_SCOPE_AGENT); }
__device__ __forceinline__ unsigned xb_add(unsigned* p, unsigned v) { return __hip_atomic_fetch_add(p, v, __ATOMIC_RELAXED, __HIP_MEMORY_SCOPE_AGENT); }
__device__ __forceinline__ unsigned xb_xcc_id() { return (unsigned)__builtin_amdgcn_s_getreg((3 << 11) | 20) & 0xFu; }
#define XB_SPIN(cond, bar) do { unsigned _sp = 0; while (cond) { __builtin_amdgcn_s_sleep(1); \
    if ((++_sp & 255u) == 0u) { if (xb_ld(&(bar)[XB_TMO])) break; if (_sp > XB_SPIN_CAP) { atomicAdd(&(bar)[XB_TMO], 1u); break; } } } } while (0)

struct XcdBarrier {
    unsigned* bar; unsigned x;
    volatile LAS unsigned* st;
};

__device__ __forceinline__ XcdBarrier xcd_barrier_post(unsigned* bar, volatile LAS unsigned* st) {
    XcdBarrier b; b.bar = bar; b.x = xb_xcc_id(); b.st = st;
    if (tidx() == 0) (void)xb_add(&bar[XB_XCNT(b.x)], 1u);
    return b;
}
__device__ __forceinline__ void xcd_barrier_complete(unsigned* bar, unsigned x, unsigned& nloc, unsigned& nx) {
    const unsigned G = gridDim.x * gridDim.y * gridDim.z;
    unsigned sum, cnt, mine, sp = 0u;
    for (;;) {
        sum = 0u; cnt = 0u; mine = 0u;
#pragma unroll
        for (unsigned j = 0; j < 16; ++j) { const unsigned c = xb_ld(&bar[XB_XCNT(j)]); sum += c; cnt += (c > 0u) ? 1u : 0u; mine = (j == x) ? c : mine; }
        if (sum == G) break;
        __builtin_amdgcn_s_sleep(1);
        if ((++sp & 255u) == 0u) { if (xb_ld(&bar[XB_TMO])) break; if (sp > XB_SPIN_CAP) { atomicAdd(&bar[XB_TMO], 1u); break; } }
    }
    nloc = mine > 0u ? mine : 1u; nx = cnt > 0u ? cnt : 1u;
}

__device__ __forceinline__ void xcd_barrier(const XcdBarrier& b) {
    asm volatile("s_waitcnt vmcnt(0)" ::: "memory");
    __syncthreads();
    if (tidx() == 0) {
        unsigned* bar = b.bar;
        __builtin_amdgcn_s_waitcnt(0);
        unsigned nloc = b.st[0], nx = b.st[1];
        if (nloc == 0u) { xcd_barrier_complete(bar, b.x, nloc, nx); b.st[0] = nloc; b.st[1] = nx; }
        const unsigned old = xb_add(&bar[XB_XSUB(b.x)], 1u);
        const unsigned gen = old / nloc;
        if (old + 1u == (gen + 1u) * nloc) {
            __builtin_amdgcn_fence(__ATOMIC_RELEASE, "agent");
            asm volatile("s_waitcnt vmcnt(0)" ::: "memory");
            const unsigned og = xb_add(&bar[XB_TOP], 1u);
            const unsigned tg = og / nx;
            if (og + 1u == (tg + 1u) * nx) xb_add(&bar[XB_TOPGEN], 1u);
            else XB_SPIN(xb_ld(&bar[XB_TOPGEN]) == tg, bar);
            __builtin_amdgcn_fence(__ATOMIC_ACQUIRE, "agent");
            xb_add(&bar[XB_XGEN(b.x)], 1u);
            asm volatile("s_waitcnt vmcnt(0)" ::: "memory");
        } else {
            XB_SPIN(xb_ld(&bar[XB_XGEN(b.x)]) == gen, bar);
            __builtin_amdgcn_fence(__ATOMIC_ACQUIRE, "agent");
            asm volatile("s_waitcnt vmcnt(0)" ::: "memory");
        }
    }
    __syncthreads();
}

constexpr int NTHREADS = 512, LDS_BYTES = 147456;
struct MegaArgs { const float* in[41]; float* out; unsigned char* ws; };
#define WSB(off) ((bf16*)(ws + (off)))
#define WSF(off) ((float*)(ws + (off)))

__global__ void __launch_bounds__(NTHREADS) mega_fwd(MegaArgs A) {
    extern __shared__ __attribute__((aligned(16))) unsigned char lds[];
    cg::grid_group grid = cg::this_grid();
    const float* const* in = A.in; unsigned char* ws = A.ws; float* out = A.out;
    if (tidx() < 2) ((volatile LAS unsigned*)(lds + LDS_BYTES - 64))[tidx()] = 0u;
    __syncthreads();
    const XcdBarrier xbar = xcd_barrier_post((unsigned*)(ws + WS_CTL) + 16384, (volatile LAS unsigned*)(lds + LDS_BYTES - 64));

    d_convert(WSB(WS_W1GU), NGU, DM, MapGU{in[I_F1_WG], in[I_F1_WU], FF});
    d_convert(WSB(WS_W1D), DM, FF, MapPlain{in[I_F1_WD], DM});
    d_convert(WSB(WS_W2GU), NGU, DM, MapGU{in[I_F2_WG], in[I_F2_WU], FF});
    d_convert(WSB(WS_W2D), DM, FF, MapPlain{in[I_F2_WD], DM});
    d_convert(WSB(WS_WIN), NWIN, DM, MapWin{in[I_WIN], IN_COLS});
    d_convert(WSB(WS_WOUT), DM, DM, MapPlain{in[I_WOUT], DM});
    d_convert(WSB(WS_WQ), DM, DM, MapPlain{in[I_WQ], DM});
    d_convert(WSB(WS_WK), DM, DM, MapPlain{in[I_WK], DM});
    d_convert(WSB(WS_WV), DM, DM, MapPlain{in[I_WV], DM});
    d_convert(WSB(WS_WO), DM, DM, MapPlain{in[I_WO], DM});
    d_convert(WSB(WS_CW1K), 256, 2048, MapPlain{in[I_W1_K], 256});
    d_convert(WSB(WS_CW1V), 256, 2048, MapPlain{in[I_W1_V], 256});
    d_convert_lora(WSB(WS_WLORA), in[I_W2], in[I_A2], in[I_G2]);
    d_convert(WSB(WS_CW2), 64, 256, MapPlain{in[I_W2_K], 64});
    d_convert(WSB(WS_CW2) + 64 * 256, 64, 256, MapPlain{in[I_W2_V], 64});
    d_rope_table(WSF(WS_ROPE));
    d_cmp_bias(in[I_PE_K], in[I_W1_K], in[I_PE_V], in[I_W1_V], WSF(WS_CBIAS), (float*)lds);
    d_rownorm(in[I_X], in[I_F1_PRE], WSB(WS_XN), M_);
    d_rownorm(in[I_MEM], in[I_MEM_KVG], WSB(WS_MEMN), 512);
    grid.sync();
    gemm_pg8(lds, WSB(WS_XN), DM, WSB(WS_W1GU), DM, M_, NGU, DM, EpiSwiGLU{WSB(WS_HB)});
    xcd_barrier(xbar);
    gemm_norm_res(lds, WSB(WS_HB), FF, WSB(WS_W1D), FF, in[I_X], out, WSB(WS_XN), in[I_F1_POST], in[I_MIX_PRE], 0.5f, WSB(WS_YB), (unsigned*)(ws + WS_GATES), (unsigned*)(ws + WS_CTL) + 1024 + 0 * 2048);
    xcd_barrier(xbar);
    gemm_pg8(lds, WSB(WS_XN), DM, WSB(WS_WIN), DM, M_, NWIN, DM,
             EpiWin{WSB(WS_QB), WSB(WS_KS), WSB(WS_KW), WSB(WS_KCR), WSB(WS_VCR), WSB(WS_VST), WSB(WS_VWT), (unsigned*)(ws + WS_RKVA), WSB(WS_RKVA + 32 * MiB), WSB(WS_PRL), WSF(WS_GATES), WSF(WS_ROPE)});
    xcd_barrier(xbar);
    gemm_pg8(lds, WSB(WS_KCR), 1024, WSB(WS_CW1K), 2048, 2048, 256, 2048, EpiBiasSilu{WSB(WS_HIDK), WSF(WS_CBIAS)});
    gemm_pg8(lds, WSB(WS_VCR), 1024, WSB(WS_CW1V), 2048, 2048, 256, 2048, EpiBiasSilu{WSB(WS_HIDV), WSF(WS_CBIAS) + 256});
    d_lora_prep(WSB(WS_PRL), in[I_MU], WSB(WS_XN));
    xcd_barrier(xbar);
    d_cmp2(WSB(WS_HIDK), WSB(WS_HIDV), WSB(WS_CW2), WSF(WS_ROPE), WSB(WS_KC), WSB(WS_VCT));
    gemm_pg8(lds, WSB(WS_XN), KLORA, WSB(WS_WLORA), KLORA, M_, NLORA, KLORA, EpiLora{WSF(WS_YB), WSB(WS_RKVA + 48 * MiB), WSB(WS_AGG), in[I_W0], in[I_A0]});
    gemm_pg8(lds, WSB(WS_MEMN), DM, WSB(WS_WK), DM, 512, DM, DM, EpiStore{WSB(WS_CW1K), DM, 1.f});
    gemm_pg8(lds, WSB(WS_WV), DM, WSB(WS_MEMN), DM, DM, 512, DM, EpiStore{WSB(WS_CW1V), 512, 1.f});
    xcd_barrier(xbar);
    if (blockIdx.x < 16 * (1 + rw7::NHELP)) {
        const rw7::Args ra{(const unsigned*)(ws + WS_RKVA), WSB(WS_RKVA + 32 * MiB), WSB(WS_RKVA + 48 * MiB), WSF(WS_YB), in[I_MU], in[I_KK], in[I_KA], in[I_RK], WSF(WS_YB), WSF(WS_BONUS),
                           ws + WS_KCR + 1 * MiB, (unsigned*)(ws + WS_CTL) + 32768, (unsigned*)(ws + WS_CTL) + 24576};
        if (blockIdx.x < 16) rw7::head(ra, blockIdx.x, lds);
        else rw7::helper(ra, (blockIdx.x - 16) % 16, (blockIdx.x - 16) / 16, lds);
        __syncthreads();
    }
    {
        const NsaArgs na{WSB(WS_QB), WSB(WS_KC), WSB(WS_VCT), WSB(WS_KS), WSB(WS_VST), WSB(WS_KW), WSB(WS_VWT), WSF(WS_GATES), WSB(WS_XN)};
        nsa::phase(na, (unsigned*)(ws + WS_CTL), lds);
    }
    xcd_barrier(xbar);
    d_nsa_outnorm(WSB(WS_XN), in[I_NSA_G]);
    rw7::finish(WSF(WS_YB), WSF(WS_BONUS), WSB(WS_RKVA + 32 * MiB), WSB(WS_AGG), in[I_MU], in[I_GNG], in[I_GNB], WSB(WS_XN));
    xcd_barrier(xbar);
    gemm_norm_res(lds, WSB(WS_XN), DM, WSB(WS_WOUT), DM, out, out, WSB(WS_XN), in[I_MIX_POST], in[I_MEM_PRE], 1.0f, WSB(WS_YB), (unsigned*)(ws + WS_GATES), (unsigned*)(ws + WS_CTL) + 1024 + 1 * 2048);
    xcd_barrier(xbar);
    gemm_pg8(lds, WSB(WS_XN), DM, WSB(WS_WQ), DM, M_, DM, DM, EpiStore{WSB(WS_QM), DM, MSCALE});
    xcd_barrier(xbar);
    for (int u = blockIdx.x; u < 256; u += gridDim.x) mema::unit(WSB(WS_QM), WSB(WS_CW1K), WSB(WS_CW1V), WSB(WS_OM), u, lds);
    xcd_barrier(xbar);
    gemm_norm_res(lds, WSB(WS_OM), DM, WSB(WS_WO), DM, out, out, WSB(WS_XN), in[I_MEM_POST], in[I_F2_PRE], 1.0f, WSB(WS_YB), (unsigned*)(ws + WS_GATES), (unsigned*)(ws + WS_CTL) + 1024 + 2 * 2048);
    xcd_barrier(xbar);
    gemm_pg8(lds, WSB(WS_XN), DM, WSB(WS_W2GU), DM, M_, NGU, DM, EpiSwiGLU{WSB(WS_HB)});
    xcd_barrier(xbar);
    gemm_norm_res(lds, WSB(WS_HB), FF, WSB(WS_W2D), FF, out, out, (bf16*)nullptr, in[I_F2_POST], (const float*)nullptr, 0.5f, WSB(WS_YB), (unsigned*)(ws + WS_GATES), (unsigned*)(ws + WS_CTL) + 1024 + 3 * 2048);
}

extern "C" void kernel_launch(void* const* d_in, const int* in_sizes, int n_in, void* d_out, int out_size, void* d_ws, size_t ws_size, hipStream_t stream) {
    static int grid = 0;
    if (grid == 0) {
        if (n_in != 41 || ws_size < WS_END) { fprintf(stderr, "kernel_launch: unexpected n_in %d / ws %zu\n", n_in, ws_size); grid = -1; return; }
        int dev = 0, cus = 0, per_cu = 0;
        hipGetDevice(&dev); hipDeviceGetAttribute(&cus, hipDeviceAttributeMultiprocessorCount, dev);
        if (hipFuncSetAttribute((const void*)mega_fwd, hipFuncAttributeMaxDynamicSharedMemorySize, LDS_BYTES) != hipSuccess) { fprintf(stderr, "kernel_launch: hipFuncSetAttribute failed\n"); grid = -1; return; }
        if (hipOccupancyMaxActiveBlocksPerMultiprocessor(&per_cu, (const void*)mega_fwd, NTHREADS, LDS_BYTES) != hipSuccess || per_cu < 1) { fprintf(stderr, "kernel_launch: occupancy query says %d\n", per_cu); grid = -1; (void)hipGetLastError(); return; }
        grid = cus;
        if (grid != 256) { fprintf(stderr, "kernel_launch: built for 256 CUs (one 256x256 tile per workgroup in the fused norm epilogues), found %d\n", cus); grid = -1; return; }
    }
    if (grid < 0) return;
    MegaArgs a{};
    for (int i = 0; i < 41; ++i) a.in[i] = (const float*)d_in[i];
    a.out = (float*)d_out; a.ws = (unsigned char*)d_ws;
    hipMemsetAsync(d_ws, 0, 196608, stream);
    void* args[] = {&a};
    hipError_t e = hipLaunchCooperativeKernel((const void*)mega_fwd, dim3(grid), dim3(NTHREADS), args, LDS_BYTES, stream);
    if (e != hipSuccess) fprintf(stderr, "kernel_launch: cooperative launch failed: %s (grid %d)\n", hipGetErrorString(e), grid);
}
```

```cpp
#include <hip/hip_runtime.h>
#include <hip/hip_cooperative_groups.h>
#include <cstdint>
#include <cstdio>

constexpr int NB = 2, T_ = 8192, DM = 1024, M_ = NB * T_;
constexpr int FF = 2816, NGU = 2 * FF;
constexpr int IN_COLS = 3096, NWIN = 3328;
constexpr int NRW = 1792;
constexpr int NCP = 512;
constexpr int NLORA = 1536, KLORA = 256;
constexpr float NORM_EPS = 1e-6f;
constexpr float QSCALE = 0.125f * 1.4426950408889634f;
constexpr float MSCALE = 0.0625f * 1.4426950408889634f;

typedef unsigned short bf16;
typedef short bf16x8 __attribute__((ext_vector_type(8)));
typedef float f32x4 __attribute__((ext_vector_type(4)));
typedef unsigned u32x2 __attribute__((ext_vector_type(2)));
typedef unsigned u32x4 __attribute__((ext_vector_type(4)));

__device__ __forceinline__ unsigned f2bf(float f) { unsigned u = __builtin_bit_cast(unsigned, f); return (u + 0x7fffu + ((u >> 16) & 1u)) >> 16; }
__device__ __forceinline__ float bf2f(bf16 h) { return __builtin_bit_cast(float, (unsigned)h << 16); }
typedef float f32x2_t __attribute__((ext_vector_type(2))); typedef __bf16 bf16x2_t __attribute__((ext_vector_type(2)));
__device__ __forceinline__ unsigned pk2(float lo, float hi) { const f32x2_t v = {lo, hi}; return __builtin_bit_cast(unsigned, __builtin_convertvector(v, bf16x2_t)); }
__device__ __forceinline__ void st_bf4(bf16* p, f32x4 v) { u32x2 w; w.x = pk2(v[0], v[1]); w.y = pk2(v[2], v[3]); *(u32x2*)p = w; }
__device__ __forceinline__ float wave_sum(float v) {
#pragma unroll
    for (int o = 1; o < 64; o <<= 1) v += __shfl_xor(v, o);
    return v;
}
__device__ __forceinline__ float wave_max(float v) {
#pragma unroll
    for (int o = 1; o < 64; o <<= 1) v = fmaxf(v, __shfl_xor(v, o));
    return v;
}
__device__ __forceinline__ float sigmoidf_(float x) { return 1.f / (1.f + __expf(-x)); }
__device__ __forceinline__ int tidx() { int t = threadIdx.x; asm volatile("" : "+v"(t)); return t; }

constexpr size_t MiB = 1u << 20, KiB64 = 65536;
constexpr size_t WS_CTL = 0;
constexpr size_t WS_KC = 256 * 1024;
constexpr size_t WS_VCT = 512 * 1024;
constexpr size_t WS_CW2 = 768 * 1024;
constexpr size_t WS_W1GU = 1 * MiB;
constexpr size_t WS_W1D = 12 * MiB;
constexpr size_t WS_W2GU = WS_W1D + 88 * KiB64;
constexpr size_t WS_W2D = WS_W2GU + 11 * MiB;
constexpr size_t WS_WIN = WS_W2D + 88 * KiB64;
constexpr size_t WS_WOUT = WS_WIN + 104 * KiB64;
constexpr size_t WS_WQ = WS_WOUT + 2 * MiB, WS_WK = WS_WQ + 2 * MiB, WS_WV = WS_WK + 2 * MiB, WS_WO = WS_WV + 2 * MiB;
constexpr size_t WS_CW1K = WS_WO + 2 * MiB, WS_CW1V = WS_CW1K + 1 * MiB;
constexpr size_t WS_WLORA = WS_CW1V + 1 * MiB;
constexpr size_t WS_ROPE = WS_WLORA + 12 * KiB64;
constexpr size_t WS_CBIAS = WS_ROPE + 2 * MiB;
constexpr size_t WS_MEMN = WS_CBIAS + KiB64;
constexpr size_t WS_HIDK = WS_MEMN + 1 * MiB;
constexpr size_t WS_HIDV = WS_HIDK + 1 * MiB;
constexpr size_t WS_GATES = WS_HIDV + 1 * MiB;
constexpr size_t WS_XN = 60 * MiB;
constexpr size_t WS_YB = 92 * MiB;
constexpr size_t WS_D = 124 * MiB;
constexpr size_t WS_HB = WS_D;
constexpr size_t WS_QB = WS_D;
constexpr size_t WS_KS = WS_D + 16 * MiB;
constexpr size_t WS_KW = WS_D + 20 * MiB;
constexpr size_t WS_KCR = WS_D + 24 * MiB;
constexpr size_t WS_VCR = WS_D + 29 * MiB;
constexpr size_t WS_VST = WS_D + 34 * MiB;
constexpr size_t WS_VWT = WS_D + 38 * MiB;
constexpr size_t WS_RKVA = WS_D + 42 * MiB;
constexpr size_t WS_PRL = WS_D + 106 * MiB;
constexpr size_t WS_AGG = WS_D + 114 * MiB;
constexpr size_t WS_BONUS = WS_KCR;
constexpr size_t WS_END = 256 * MiB;
constexpr size_t WS_QM = WS_D;
constexpr size_t WS_OM = WS_D + 32 * MiB;
constexpr size_t WS_MK = WS_D + 64 * MiB;
constexpr size_t WS_MVT = WS_D + 65 * MiB;
static_assert(WS_GATES + (size_t)M_ * 24 * 4 <= WS_XN, "ws map");
static_assert(WS_AGG + 16 * MiB <= WS_END, "ws map");

struct Params {
    const float* in[41];
    float* out;
    unsigned char* ws;
};
enum { I_X = 0, I_MEM, I_F1_PRE, I_F1_WG, I_F1_WU, I_F1_WD, I_F1_POST, I_MIX_PRE, I_WIN, I_PE_K, I_W1_K, I_W2_K, I_PE_V, I_W1_V, I_W2_V,
       I_NSA_G, I_MU, I_W0, I_W2, I_A0, I_A2, I_G2, I_KK, I_KA, I_RK, I_GNG, I_GNB, I_WOUT, I_MIX_POST, I_MEM_PRE, I_MEM_KVG, I_WQ, I_WK, I_WV,
       I_WO, I_MEM_POST, I_F2_PRE, I_F2_WG, I_F2_WU, I_F2_WD, I_F2_POST };

struct MapPlain { const float* W; int N; int pad; __device__ const float* col(int p) const { return W + p; } };
struct MapGU {
    const float* Wg; const float* Wu; int N; int pad;
    __device__ const float* col(int p) const {
        const int pn = p >> 8, q = p & 255, n = (q >> 4) & 1;
        const int hid = 128 * pn + 64 * (q >> 7) + 16 * ((q >> 5) & 3) + (q & 15);
        return Wg + (size_t)n * (size_t)(Wu - Wg) + hid;
    }
};
__host__ __device__ inline int rope_perm(int x) { return 16 * ((x >> 5) & 1) + (x & 15) + 32 * ((x >> 4) & 1); }
struct MapWin {
    const float* W; int N; int pad;
    __device__ const float* col(int p) const {
        int l;
        if (p < 512) l = (p & ~63) + rope_perm(p & 63);
        else if (p < 640) l = 768 + ((p - 512) & ~63) + rope_perm(p & 63);
        else if (p < 768) l = 1024 + ((p - 640) & ~63) + rope_perm(p & 63);
        else if (p < 896) l = 512 + (p - 768);
        else if (p < 1024) l = 640 + (p - 896);
        else if (p < 1152) l = 896 + (p - 1024);
        else if (p < 1280) l = 1152 + (p - 1152);
        else if (p < 2304) { const int q = p - 1280; l = 1304 + (((q >> 4) & 1) ? 512 : 0) + 16 * (q >> 5) + (q & 15); }
        else if (p < 3072) l = 1304 + (p - 1280);
        else if (p < 3096) l = 1280 + (p - 3072);
        else return nullptr;
        return W + l;
    }
};

#define FOR_VB(vb, n) for (int vb = (int)blockIdx.x * 2 + (T512 >> 8); vb < (n); vb += (int)gridDim.x * 2)

template <class Map> __device__ __forceinline__ void d_convert(bf16* WT, int Np, int K, Map map) {
    const int T512 = tidx(), tid = T512 & 255, nbx = Np / 64, nb = nbx * (K / 64);
    FOR_VB(vb, nb) {
        const int p = (vb % nbx) * 64 + (tid & 63), k0 = (vb / nbx) * 64 + (tid >> 6) * 16;
        const float* src = map.col(p);
        float v[16];
#pragma unroll
        for (int i = 0; i < 16; ++i) v[i] = src ? src[(size_t)(k0 + i) * map.N] : 0.f;
        u32x4 a, b;
        a.x = pk2(v[0], v[1]); a.y = pk2(v[2], v[3]); a.z = pk2(v[4], v[5]); a.w = pk2(v[6], v[7]);
        b.x = pk2(v[8], v[9]); b.y = pk2(v[10], v[11]); b.z = pk2(v[12], v[13]); b.w = pk2(v[14], v[15]);
        u32x4* dst = (u32x4*)(WT + (size_t)p * K + k0);
        dst[0] = a; dst[1] = b;
    }
}
__device__ __forceinline__ void d_convert_lora(bf16* WT, const float* w2, const float* a2, const float* g2) {
    const int T512 = tidx(), tid = T512 & 255;
    FOR_VB(vb, NLORA * KLORA / 256) {
        const int idx = vb * 256 + tid, p = idx >> 8, k = idx & 255;
        float v = 0.f;
        if (p < 512) { if (k < 64) v = w2[k * 512 + p]; }
        else if (p < 1024) { if (k >= 64 && k < 128) v = a2[(k - 64) * 512 + (p - 512)]; }
        else { if (k >= 128) v = g2[(k - 128) * 512 + (p - 1024)]; }
        WT[idx] = (bf16)f2bf(v);
    }
}
__device__ __forceinline__ void d_rope_table(float* tab) {
    const int T512 = tidx(), tid = T512 & 255;
    FOR_VB(vb, T_ * 32 / 256) {
        const int idx = vb * 256 + tid, pos = idx >> 5, i = idx & 31;
        const float inv = (float)pow(10000.0, -(double)i / 32.0);
        const float ang = (float)pos * inv;
        tab[2 * idx] = (float)cos((double)ang); tab[2 * idx + 1] = (float)sin((double)ang);
    }
}
__device__ __forceinline__ void d_cmp_bias(const float* pe_k, const float* w1_k, const float* pe_v, const float* w1_v, float* bias, float* red  ) {
    for (int job = blockIdx.x; job < 8; job += gridDim.x) {
        const int kv = job >> 2; const float* pe = kv ? pe_v : pe_k; const float* w1 = kv ? w1_v : w1_k;
        const int T512 = tidx(), lane = T512 & 63, w = T512 >> 6, n = (job & 3) * 64 + lane;
        float s = 0.f;
        for (int j = w * 256; j < w * 256 + 256; ++j) s += pe[j] * w1[(size_t)j * 256 + n];
        red[w * 64 + lane] = s; __syncthreads();
        if (w == 0) { float t = 0.f; for (int i = 0; i < 8; ++i) t += red[i * 64 + lane]; bias[kv * 256 + n] = t; }
        __syncthreads();
    }
}
__device__ __forceinline__ void d_rownorm(const float* x, const float* g, bf16* xn, int rows) {
    const int T512 = tidx(), tid = T512 & 255, lane = tid & 63;
    FOR_VB(vb, rows / 4) {
        const int row = vb * 4 + (tid >> 6);
        const f32x4* xr = (const f32x4*)(x + (size_t)row * DM) + lane; f32x4 v[4]; float s = 0.f;
#pragma unroll
        for (int j = 0; j < 4; ++j) { v[j] = xr[64 * j]; s += v[j][0] * v[j][0] + v[j][1] * v[j][1] + v[j][2] * v[j][2] + v[j][3] * v[j][3]; }
        const float rstd = rsqrtf(wave_sum(s) * (1.f / DM) + NORM_EPS);
#pragma unroll
        for (int j = 0; j < 4; ++j) { const f32x4 gg = ((const f32x4*)g)[lane + 64 * j]; st_bf4(xn + (size_t)row * DM + 4 * (lane + 64 * j), v[j] * rstd * gg); }
    }
}
__device__ __forceinline__ void d_rowpass(const float* xin, const bf16* y, const float* gpost, float coef, const float* gpre, float* xout, bf16* xn) {
    const int T512 = tidx(), tid = T512 & 255, lane = tid & 63;
    FOR_VB(vb, M_ / 4) {
        const int row = vb * 4 + (tid >> 6);
        f32x4 yv[4], xv[4]; float s = 0.f;
#pragma unroll
        for (int j = 0; j < 4; ++j) {
            const u32x2 w = *(const u32x2*)(y + (size_t)row * DM + 4 * (lane + 64 * j));
            yv[j][0] = __builtin_bit_cast(float, w.x << 16); yv[j][1] = __builtin_bit_cast(float, w.x & 0xffff0000u);
            yv[j][2] = __builtin_bit_cast(float, w.y << 16); yv[j][3] = __builtin_bit_cast(float, w.y & 0xffff0000u);
            s += yv[j][0] * yv[j][0] + yv[j][1] * yv[j][1] + yv[j][2] * yv[j][2] + yv[j][3] * yv[j][3];
            xv[j] = ((const f32x4*)(xin + (size_t)row * DM))[lane + 64 * j];
        }
        const float rstd = rsqrtf(wave_sum(s) * (1.f / DM) + NORM_EPS) * coef; float s2 = 0.f;
#pragma unroll
        for (int j = 0; j < 4; ++j) { const f32x4 gg = ((const f32x4*)gpost)[lane + 64 * j]; xv[j] = xv[j] + yv[j] * rstd * gg;
            s2 += xv[j][0] * xv[j][0] + xv[j][1] * xv[j][1] + xv[j][2] * xv[j][2] + xv[j][3] * xv[j][3];
            ((f32x4*)(xout + (size_t)row * DM))[lane + 64 * j] = xv[j]; }
        if (gpre) {
            const float r2 = rsqrtf(wave_sum(s2) * (1.f / DM) + NORM_EPS);
#pragma unroll
            for (int j = 0; j < 4; ++j) { const f32x4 gg = ((const f32x4*)gpre)[lane + 64 * j]; st_bf4(xn + (size_t)row * DM + 4 * (lane + 64 * j), xv[j] * r2 * gg); }
        }
    }
}
__device__ __forceinline__ void d_nsa_outnorm(bf16* amix, const float* g) {
    const int T512 = tidx(), tid = T512 & 255, lane = tid & 63;
    FOR_VB(vb, M_ / 4) {
        const int row = vb * 4 + (tid >> 6);
        bf16* p = amix + (size_t)row * DM + 8 * lane;
        const u32x4 w = *(const u32x4*)p; float v[8]; float s = 0.f;
        v[0] = __builtin_bit_cast(float, w.x << 16); v[1] = __builtin_bit_cast(float, w.x & 0xffff0000u);
        v[2] = __builtin_bit_cast(float, w.y << 16); v[3] = __builtin_bit_cast(float, w.y & 0xffff0000u);
        v[4] = __builtin_bit_cast(float, w.z << 16); v[5] = __builtin_bit_cast(float, w.z & 0xffff0000u);
        v[6] = __builtin_bit_cast(float, w.w << 16); v[7] = __builtin_bit_cast(float, w.w & 0xffff0000u);
#pragma unroll
        for (int i = 0; i < 8; ++i) s += v[i] * v[i];
        const float rstd = rsqrtf(wave_sum(s) * (1.f / 512.f) + NORM_EPS);
        u32x4 o; const float* gg = g + 8 * lane;
        o.x = pk2(v[0] * rstd * gg[0], v[1] * rstd * gg[1]); o.y = pk2(v[2] * rstd * gg[2], v[3] * rstd * gg[3]);
        o.z = pk2(v[4] * rstd * gg[4], v[5] * rstd * gg[5]); o.w = pk2(v[6] * rstd * gg[6], v[7] * rstd * gg[7]);
        *(u32x4*)p = o;
    }
}

struct EpiStore { bf16* O; int ldc; float scale;
    static constexpr int NCAT = 1;
    __device__ __forceinline__ int cat(int) const { return 0; }
    template <int C> __device__ __forceinline__ void apply(int row, int p, f32x4 v0, f32x4 v1) const { bf16* o = O + (size_t)row * ldc + p; st_bf4(o, v0 * scale); st_bf4(o + 16, v1 * scale); } };
struct EpiSwiGLU { bf16* H;
    static constexpr int NCAT = 1;
    __device__ __forceinline__ int cat(int) const { return 0; }
    template <int C> __device__ __forceinline__ void apply(int row, int p, f32x4 g, f32x4 u) const {
        const int q = p & 255, hid = 128 * (p >> 8) + 64 * (q >> 7) + 16 * ((q >> 5) & 3) + (q & 15);
        f32x4 h;
#pragma unroll
        for (int e = 0; e < 4; ++e) h[e] = g[e] / (1.f + __expf(-g[e])) * u[e];
        st_bf4(H + (size_t)row * FF + hid, h); } };
struct EpiBiasSilu { bf16* O; const float* bias;
    static constexpr int NCAT = 1;
    __device__ __forceinline__ int cat(int) const { return 0; }
    template <int C> __device__ __forceinline__ void apply(int row, int p, f32x4 v0, f32x4 v1) const {
        f32x4 a, b; const f32x4 b0 = *(const f32x4*)(bias + p), b1 = *(const f32x4*)(bias + p + 16);
#pragma unroll
        for (int e = 0; e < 4; ++e) { const float x0 = v0[e] + b0[e], x1 = v1[e] + b1[e]; a[e] = x0 / (1.f + __expf(-x0)); b[e] = x1 / (1.f + __expf(-x1)); }
        bf16* o = O + (size_t)row * 256 + p; st_bf4(o, a); st_bf4(o + 16, b); } };
struct EpiLora { float* wdec; bf16* aga; bf16* agg; const float* w0; const float* a0;
    static constexpr int NCAT = 3;
    __device__ __forceinline__ int cat(int p0) const { return p0 < 512 ? 0 : (p0 < 1024 ? 1 : 2); }
    template <int C> __device__ __forceinline__ void one(int row, int p, f32x4 v) const {
        if (C == 0) { f32x4 o; const f32x4 ww = *(const f32x4*)(w0 + p);
#pragma unroll
            for (int e = 0; e < 4; ++e) o[e] = __expf(-0.6065306597126334f * sigmoidf_(ww[e] + v[e]));
            *(f32x4*)(wdec + (size_t)row * 512 + p) = o;
        } else if (C == 1) { f32x4 o; const f32x4 aa = *(const f32x4*)(a0 + p - 512);
#pragma unroll
            for (int e = 0; e < 4; ++e) o[e] = sigmoidf_(aa[e] + v[e]);
            st_bf4(aga + (size_t)row * 512 + (p - 512), o);
        } else st_bf4(agg + (size_t)row * 512 + (p - 1024), v);
    }
    template <int C> __device__ __forceinline__ void apply(int row, int p, f32x4 v0, f32x4 v1) const { one<C>(row, p, v0); one<C>(row, p + 16, v1); } };
struct EpiWin {
    bf16 *qb, *ks, *kw, *kcr, *vcr, *vst, *vwt; unsigned* rk; bf16 *vv, *prl; float* gates; const float* rope;
    static constexpr int NCAT = 8;
    __device__ __forceinline__ int cat(int p0) const { return p0 < 512 ? 0 : (p0 < 768 ? 1 : (p0 < 1024 ? 2 : (p0 < 1280 ? 3 : (p0 < 2304 ? 4 : (p0 < 2816 ? 7 : (p0 < 3072 ? 6 : 5)))))); }
    template <int C> __device__ __forceinline__ void apply(int row, int p, f32x4 v0, f32x4 v1) const {
        const int b = row / T_, t = row % T_;
        if (C == 0 || C == 1) {
            const int x = p & 63, d = 16 * ((x >> 5) & 1) + (x & 15);
            const f32x4* rp = (const f32x4*)(rope + ((size_t)t * 32 + d) * 2); const f32x4 r0 = rp[0], r1 = rp[1];
            const f32x4 cs = {r0[0], r0[2], r1[0], r1[2]}, sn = {r0[1], r0[3], r1[1], r1[3]};
            const f32x4 lo = v0 * cs - v1 * sn, hi = v0 * sn + v1 * cs;
            if (C == 0) { bf16* o = qb + (size_t)row * 512 + (p & ~63) + d; st_bf4(o, lo * QSCALE); st_bf4(o + 32, hi * QSCALE); }
            else { const int g = ((p - 512) >> 6) & 1; bf16* base = (p < 640) ? ks : kw; bf16* o = base + ((size_t)(b * 2 + g) * T_ + t) * 64 + d; st_bf4(o, lo); st_bf4(o + 32, hi); }
        } else if (C == 2) {
            const int c = (p - 768) & 127, g = c >> 6, d = c & 63; bf16* base = (p < 896) ? kcr : vcr;
            bf16* o = base + ((size_t)(b * 2 + g) * T_ + t) * 64 + d; st_bf4(o, v0); st_bf4(o + 16, v1);
        } else if (C == 3) {
            const int c = (p - 1024) & 127, g = c >> 6, d = c & 63; bf16* base = (p < 1152) ? vst : vwt;
            bf16* o = base + ((size_t)(b * 2 + g) * 64 + d) * T_ + t;
#pragma unroll
            for (int e = 0; e < 4; ++e) { o[(size_t)e * T_] = (bf16)f2bf(v0[e]); o[(size_t)(16 + e) * T_] = (bf16)f2bf(v1[e]); }
        } else if (C == 4) {
            const int q = p - 1280, ch = 16 * (q >> 5) + (q & 15);
            u32x4 w; w.x = pk2(v0[0], v1[0]); w.y = pk2(v0[1], v1[1]); w.z = pk2(v0[2], v1[2]); w.w = pk2(v0[3], v1[3]);
            *(u32x4*)(rk + (size_t)row * 512 + ch) = w;
        } else if (C == 7) {
            bf16* o = vv + (size_t)row * 512 + (p - 2304); st_bf4(o, v0); st_bf4(o + 16, v1);
        } else if (C == 6) {
            bf16* o = prl + (size_t)row * 256 + (p - 2816); st_bf4(o, v0); st_bf4(o + 16, v1);
        } else {
            const int c = p - 3072; float* o = gates + (size_t)row * 24 + c;
            if (c < 24) { f32x4 s = {sigmoidf_(v0[0]), sigmoidf_(v0[1]), sigmoidf_(v0[2]), sigmoidf_(v0[3])}; *(f32x4*)o = s; }
            if (c + 16 < 24) { f32x4 s = {sigmoidf_(v1[0]), sigmoidf_(v1[1]), sigmoidf_(v1[2]), sigmoidf_(v1[3])}; *(f32x4*)(o + 16) = s; }
        }
    }
};

namespace pg8 {
#define PG8_LAS __attribute__((address_space(3)))
typedef unsigned short bf16_t;
typedef short bf16x8 __attribute__((ext_vector_type(8)));
typedef float f32x4 __attribute__((ext_vector_type(4)));
typedef unsigned u32x4 __attribute__((ext_vector_type(4)));
constexpr int BM = 256, BK = 64, HALF = 128, HTB = HALF * BK * 2  , STAGE_BYTES = 8 * HTB, NXCD = 8, WGM = 8;

__host__ __device__ __forceinline__ int lds_byte(int r, int c) { const int st = (r >> 4) * 2 + (c >> 5), rr = r & 15, cc = c & 31, ob = rr * 64 + cc * 2; return st * 1024 + (ob ^ (((ob >> 9) & 1) << 5)); }
__host__ __device__ __forceinline__ void stage_rc(int b, int& R, int& C) { const int st = b / 1024, sb = b % 1024, swz = sb ^ (((sb >> 9) & 1) << 5); R = (st >> 1) * 16 + swz / 64; C = (st & 1) * 32 + (swz % 64) / 2; }
__host__ __device__ __forceinline__ int perm32(int rho) { const int n = rho >> 4, i = rho & 15; return 8 * (i >> 2) + 4 * n + (i & 3); }

struct Unit { int pm, pn; };
struct Gemm { const bf16_t* A; const bf16_t* Bt; int M, N, K, lda, ldb; };

struct StaticOrder {
    int nM, nN, nwg, G, c;
    __host__ __device__ void init(int M, int N, int G_, int c_) { nM = M / BM; nN = N / BM; nwg = nM * nN; G = G_; c = c_; }
    __host__ __device__ bool next(int i, Unit& u) const {
        const long L = (long)i * G + c; if (L >= nwg) return false;
        int wgid = (int)L; { const int q = nwg / NXCD, r = nwg % NXCD, xcd = wgid % NXCD, off = wgid / NXCD; wgid = (xcd < r ? xcd * (q + 1) : r * (q + 1) + (xcd - r) * q) + off; }
        const int nig = WGM * nN, gid = wgid / nig, fm = gid * WGM, gsz = (nM - fm) < WGM ? (nM - fm) : WGM;
        u.pm = fm + ((wgid % nig) % gsz); u.pn = (wgid % nig) / gsz; return true;
    }
    __device__ __forceinline__ void a_ready(const Unit&) const {}
    __device__ __forceinline__ void done(const Unit&) const {}
};

template <class Epi, class Sched, bool ALIGN_EPI = false, bool SP2 = false>
__device__ __forceinline__ void gemm_phase(PG8_LAS unsigned char* lds, const Gemm g, const Sched& S, const Epi& E) {
    const int tid = tidx(), wid = __builtin_amdgcn_readfirstlane(tid >> 6), lane = tid & 63, wr = wid >> 2, wc = wid & 3, fr = lane & 15, fq = lane >> 4;
    const int K = g.K, nt = K / BK;
    unsigned voffA[2], voffB[2];
#pragma unroll
    for (int i = 0; i < 2; ++i) { int R, C; stage_rc(tid * 16 + i * 8192, R, C); const int Rb = Epi::PERM ? ((R & ~31) + perm32(R & 31)) : R;
        voffA[i] = (unsigned)(R * g.lda + C) * 2u; voffB[i] = (unsigned)(Rb * g.ldb + C) * 2u; }
    const size_t kstep = (size_t)(BK * 2);
    const size_t hstepA = (size_t)HALF * g.lda * 2, hstepB = (size_t)HALF * g.ldb * 2;
    const size_t tstepA = 2 * hstepA, tstepB = 2 * hstepB;
    const unsigned ldsw = (unsigned)wid * 1024u;
    const int aoff = lds_byte(wr * 64 + fr, fq * 8), boff = lds_byte(wc * 32 + fr, fq * 8);
#define PG8_SA(b, h) (((b) * 2 + (h)) * HTB)
#define PG8_SB(b, h) ((4 + (b) * 2 + (h)) * HTB)
#define PG8_STAGE(bufoff, gbase, voff) do { _Pragma("unroll") for (int _i = 0; _i < 2; ++_i) \
        __builtin_amdgcn_global_load_lds((const unsigned*)((const char*)(gbase) + (voff)[_i]), (PG8_LAS unsigned*)(lds + (bufoff) + ldsw + _i * 8192), 16, 0, 0); } while (0)
#define PG8_LDA(dst, b, h) do { _Pragma("unroll") for (int m = 0; m < 4; ++m) _Pragma("unroll") for (int k = 0; k < 2; ++k) dst[m][k] = *(const PG8_LAS bf16x8*)(lds + PG8_SA(b, h) + aoff + m * 2048 + k * 1024); } while (0)
#define PG8_LDB(dst, b, h) do { _Pragma("unroll") for (int n = 0; n < 2; ++n) _Pragma("unroll") for (int k = 0; k < 2; ++k) dst[n][k] = *(const PG8_LAS bf16x8*)(lds + PG8_SB(b, h) + boff + n * 2048 + k * 1024); } while (0)
#define PG8_MMA(ai, bj, At, Bt) do { __builtin_amdgcn_s_setprio(1); _Pragma("unroll") for (int m = 0; m < 4; ++m) _Pragma("unroll") for (int n = 0; n < 2; ++n) _Pragma("unroll") for (int k = 0; k < 2; ++k) \
        acc[ai][bj][m][n] = __builtin_amdgcn_mfma_f32_16x16x32_bf16(Bt[n][k], At[m][k], acc[ai][bj][m][n], 0, 0, 0); __builtin_amdgcn_s_setprio(0); } while (0)
#define PG8_WAIT_V(n) asm volatile("s_waitcnt vmcnt(" #n ")" ::: "memory")
#define PG8_WAIT_L(n) asm volatile("s_waitcnt lgkmcnt(" #n ")" ::: "memory")
#define PG8_BAR __builtin_amdgcn_s_barrier()
#define PG8_SCHED __builtin_amdgcn_sched_barrier(0)
    Unit cur, nxt; int ui = 0;
    if (!S.next(0, cur)) return;
    f32x4 acc[2][2][4][2];
#pragma unroll
    for (int a = 0; a < 2; ++a)
#pragma unroll
        for (int b = 0; b < 2; ++b)
#pragma unroll
            for (int m = 0; m < 4; ++m)
#pragma unroll
                for (int n = 0; n < 2; ++n) acc[a][b][m][n] = (f32x4){0.f, 0.f, 0.f, 0.f};
    bf16x8 At[4][2], B0[2][2], B1[2][2];
    const char* cA = (const char*)g.A + (size_t)cur.pm * tstepA; const char* cB = (const char*)g.Bt + (size_t)cur.pn * tstepB;
    S.a_ready(cur);
    if constexpr (SP2) {
        PG8_STAGE(PG8_SB(0, 0), cB, voffB); PG8_STAGE(PG8_SB(0, 1), cB + hstepB, voffB); PG8_STAGE(PG8_SA(0, 0), cA, voffA); PG8_STAGE(PG8_SA(0, 1), cA + hstepA, voffA);
        if (wr == 1) PG8_BAR;
        PG8_WAIT_V(2); PG8_BAR;
        PG8_STAGE(PG8_SB(1, 0), cB + kstep, voffB); PG8_STAGE(PG8_SA(1, 0), cA + kstep, voffA); PG8_STAGE(PG8_SB(1, 1), cB + hstepB + kstep, voffB);
        PG8_WAIT_V(6); PG8_BAR;
    } else {
        PG8_STAGE(PG8_SB(0, 0), cB, voffB); PG8_STAGE(PG8_SA(0, 0), cA, voffA); PG8_STAGE(PG8_SB(0, 1), cB + hstepB, voffB); PG8_STAGE(PG8_SA(0, 1), cA + hstepA, voffA);
        if (wr == 1) PG8_BAR;
        PG8_WAIT_V(4); PG8_BAR;
        PG8_STAGE(PG8_SB(1, 0), cB + kstep, voffB); PG8_STAGE(PG8_SA(1, 0), cA + kstep, voffA); PG8_STAGE(PG8_SB(1, 1), cB + hstepB + kstep, voffB);
        PG8_WAIT_V(6); PG8_BAR;
    }
    for (;;) {
        const bool has_next = S.next(ui + 1, nxt);
        const char* nA = has_next ? (const char*)g.A + (size_t)nxt.pm * tstepA : cA; const char* nB = has_next ? (const char*)g.Bt + (size_t)nxt.pn * tstepB : cB;
        for (int t = 0; t < nt; t += 2) {
            const bool last = (t == nt - 2);
            const char* a1 = cA + (size_t)(t + 1) * kstep;
            const char* a2 = last ? nA : cA + (size_t)(t + 2) * kstep; const char* b2 = last ? nB : cB + (size_t)(t + 2) * kstep;
            const char* a3 = a2 + kstep; const char* b3 = b2 + kstep;
            if (last && has_next) S.a_ready(nxt);
            if constexpr (SP2) {
            PG8_LDB(B0, 0, 0); PG8_LDB(B1, 0, 1); PG8_SCHED; PG8_LDA(At, 0, 0); PG8_STAGE(PG8_SA(1, 1), a1 + hstepA, voffA);
            PG8_WAIT_V(8); PG8_WAIT_L(0); PG8_BAR; PG8_MMA(0, 0, At, B0); PG8_MMA(0, 1, At, B1); PG8_BAR; PG8_SCHED;
            PG8_LDA(At, 0, 1); PG8_STAGE(PG8_SB(0, 0), b2, voffB); PG8_STAGE(PG8_SB(0, 1), b2 + hstepB, voffB); PG8_STAGE(PG8_SA(0, 0), a2, voffA);
            PG8_WAIT_V(8); PG8_WAIT_L(0); PG8_BAR; PG8_MMA(1, 0, At, B0); PG8_MMA(1, 1, At, B1); PG8_BAR; PG8_SCHED;
            PG8_LDB(B0, 1, 0); PG8_LDB(B1, 1, 1); PG8_SCHED; PG8_LDA(At, 1, 0); PG8_STAGE(PG8_SA(0, 1), a2 + hstepA, voffA);
            PG8_WAIT_V(8); PG8_WAIT_L(0); PG8_BAR; PG8_MMA(0, 0, At, B0); PG8_MMA(0, 1, At, B1); PG8_BAR; PG8_SCHED;
            PG8_LDA(At, 1, 1); PG8_STAGE(PG8_SB(1, 0), b3, voffB); PG8_STAGE(PG8_SB(1, 1), b3 + hstepB, voffB); PG8_STAGE(PG8_SA(1, 0), a3, voffA);
            PG8_WAIT_V(8); PG8_WAIT_L(0); PG8_BAR; PG8_MMA(1, 0, At, B0); PG8_MMA(1, 1, At, B1); PG8_BAR; PG8_SCHED;
            } else {
            PG8_LDB(B0, 0, 0); PG8_SCHED; PG8_LDA(At, 0, 0); PG8_STAGE(PG8_SA(1, 1), a1 + hstepA, voffA);
            PG8_WAIT_L(8); PG8_BAR; PG8_WAIT_L(0); PG8_MMA(0, 0, At, B0); PG8_BAR; PG8_SCHED;
            PG8_LDB(B1, 0, 1); PG8_STAGE(PG8_SB(0, 0), b2, voffB);
            PG8_BAR; PG8_WAIT_L(0); PG8_MMA(0, 1, At, B1); PG8_BAR;
            PG8_LDA(At, 0, 1); PG8_STAGE(PG8_SA(0, 0), a2, voffA);
            PG8_BAR; PG8_WAIT_L(0); PG8_MMA(1, 0, At, B0); PG8_BAR; PG8_SCHED;
            PG8_STAGE(PG8_SB(0, 1), b2 + hstepB, voffB);
            PG8_WAIT_V(6); PG8_BAR; PG8_MMA(1, 1, At, B1); PG8_BAR;
            PG8_LDB(B0, 1, 0); PG8_SCHED; PG8_LDA(At, 1, 0); PG8_STAGE(PG8_SA(0, 1), a2 + hstepA, voffA);
            PG8_WAIT_L(8); PG8_BAR; PG8_WAIT_L(0); PG8_MMA(0, 0, At, B0); PG8_BAR; PG8_SCHED;
            PG8_LDB(B1, 1, 1); PG8_STAGE(PG8_SB(1, 0), b3, voffB);
            PG8_BAR; PG8_WAIT_L(0); PG8_MMA(0, 1, At, B1); PG8_BAR;
            PG8_LDA(At, 1, 1); PG8_STAGE(PG8_SA(1, 0), a3, voffA);
            PG8_BAR; PG8_WAIT_L(0); PG8_MMA(1, 0, At, B0); PG8_BAR; PG8_SCHED;
            PG8_STAGE(PG8_SB(1, 1), b3 + hstepB, voffB);
            PG8_WAIT_V(6); PG8_BAR; PG8_MMA(1, 1, At, B1); PG8_BAR;
            }
        }
        if constexpr (ALIGN_EPI) { if (wr == 0) PG8_BAR; }
        if constexpr (!Epi::AFTER_DRAIN) { E(acc, cur, wr, wc, fr, fq); S.done(cur); }
        if (!has_next) break;
#pragma unroll
        for (int a = 0; a < 2; ++a)
#pragma unroll
            for (int b = 0; b < 2; ++b)
#pragma unroll
                for (int m = 0; m < 4; ++m)
#pragma unroll
                    for (int n = 0; n < 2; ++n) acc[a][b][m][n] = (f32x4){0.f, 0.f, 0.f, 0.f};
        cur = nxt; cA = nA; cB = nB; ++ui;
        if constexpr (ALIGN_EPI) { if (wr == 1) PG8_BAR; }
    }
    PG8_WAIT_V(0);
    if constexpr (!ALIGN_EPI) { if (wr == 0) PG8_BAR; }
    PG8_BAR;
    if constexpr (Epi::AFTER_DRAIN) { E.fused(acc, cur, wr, wc, fr, fq, lds, wid, lane); S.done(cur); }
#undef PG8_SA
#undef PG8_SB
#undef PG8_STAGE
#undef PG8_LDA
#undef PG8_LDB
#undef PG8_MMA
#undef PG8_WAIT_V
#undef PG8_WAIT_L
#undef PG8_BAR
#undef PG8_SCHED
}
}

template <class F> struct EpiQuad {
    static constexpr bool PERM = false, AFTER_DRAIN = false;
    F f;
    template <int C, int BJ> __device__ __forceinline__ void half(const pg8::f32x4 (&acc)[2][2][4][2], int row0, int p) const {
#pragma unroll
        for (int ai = 0; ai < 2; ++ai)
#pragma unroll
            for (int m = 0; m < 4; ++m) { f.template apply<C>(row0 + ai * 128 + m * 16, p, acc[ai][BJ][m][0], acc[ai][BJ][m][1]); asm volatile("" ::: "memory"); }
    }
    template <int BJ> __device__ __forceinline__ void disp(const pg8::f32x4 (&acc)[2][2][4][2], int row0, int p0, int p) const {
        const int c = f.cat(p0);
        if (F::NCAT == 1 || c == 0) half<0, BJ>(acc, row0, p);
        else if (F::NCAT > 1 && c == 1) half<(F::NCAT > 1 ? 1 : 0), BJ>(acc, row0, p);
        else if (F::NCAT > 2 && c == 2) half<(F::NCAT > 2 ? 2 : 0), BJ>(acc, row0, p);
        else if (F::NCAT > 3 && c == 3) half<(F::NCAT > 3 ? 3 : 0), BJ>(acc, row0, p);
        else if (F::NCAT > 4 && c == 4) half<(F::NCAT > 4 ? 4 : 0), BJ>(acc, row0, p);
        else if (F::NCAT > 5 && c == 5) half<(F::NCAT > 5 ? 5 : 0), BJ>(acc, row0, p);
        else if (F::NCAT > 6 && c == 6) half<(F::NCAT > 6 ? 6 : 0), BJ>(acc, row0, p);
        else if (F::NCAT > 7) half<(F::NCAT > 7 ? 7 : 0), BJ>(acc, row0, p);
    }
    __device__ __forceinline__ void operator()(const pg8::f32x4 (&acc)[2][2][4][2], const pg8::Unit& u, int wr, int wc, int fr, int fq) const {
        const int row0 = u.pm * 256 + wr * 64 + fr, p0 = u.pn * 256;
        disp<0>(acc, row0, p0, p0 + wc * 32 + 4 * fq);
        disp<1>(acc, row0, p0 + 128, p0 + 128 + wc * 32 + 4 * fq);
    }
};
template <class F> __device__ __forceinline__ void gemm_pg8(unsigned char* lds, const bf16* A, int lda, const bf16* Bt, int ldb, int M, int N, int K, const F& f, int wg_off = 0) {
    if ((int)blockIdx.x < wg_off) return;
    pg8::Gemm g{A, Bt, M, N, K, lda, ldb}; pg8::StaticOrder S; S.init(M, N, (int)gridDim.x, (int)blockIdx.x - wg_off);
    EpiQuad<F> E{f};
    pg8::gemm_phase<EpiQuad<F>, pg8::StaticOrder, true, true>((PG8_LAS unsigned char*)lds, g, S, E);
}

namespace cg = cooperative_groups;
struct EpiNormRes {
    static constexpr bool PERM = false, AFTER_DRAIN = true;
    const float* xin; float* xout; bf16* xn; const float* gpost; const float* gpre; float coef; unsigned* part; unsigned* cnt;
    __device__ __forceinline__ void operator()(const pg8::f32x4 (&)[2][2][4][2], const pg8::Unit&, int, int, int, int) const {}
    __device__ __forceinline__ void rowstat(const pg8::f32x4 (&acc)[2][2][4][2], float* P, int wr, int wc, int fr, int fq) const {
#pragma unroll
        for (int ai = 0; ai < 2; ++ai)
#pragma unroll
            for (int m = 0; m < 4; ++m) { float sq = 0.f;
#pragma unroll
                for (int bj = 0; bj < 2; ++bj)
#pragma unroll
                    for (int n = 0; n < 2; ++n) { const pg8::f32x4 v = acc[ai][bj][m][n]; sq += (v[0] * v[0] + v[1] * v[1]) + (v[2] * v[2] + v[3] * v[3]); }
                sq += __shfl_xor(sq, 16); sq += __shfl_xor(sq, 32);
                if (fq == 0) P[(ai * 128 + wr * 64 + m * 16 + fr) * 4 + wc] = sq; }
    }
    __device__ __forceinline__ void exchange(float* P, float* S, unsigned* bank, unsigned* cnt, const pg8::Unit& u, int tid, float scale) const {
        __syncthreads();
        if (tid < 256) { const f32x4 p = *(const f32x4*)(P + tid * 4);
            __hip_atomic_store(bank + (size_t)(u.pm * 256 + tid) * 4 + u.pn, __builtin_bit_cast(unsigned, (p[0] + p[1]) + (p[2] + p[3])), __ATOMIC_RELAXED, __HIP_MEMORY_SCOPE_AGENT); }
        asm volatile("s_waitcnt vmcnt(0)" ::: "memory");
        __syncthreads();
        if (tid == 0) { unsigned* c = cnt + u.pm * 16; __hip_atomic_fetch_add(c, 1u, __ATOMIC_RELAXED, __HIP_MEMORY_SCOPE_AGENT);
            while (__hip_atomic_load(c, __ATOMIC_RELAXED, __HIP_MEMORY_SCOPE_AGENT) < 4u) __builtin_amdgcn_s_sleep(1); }
        __syncthreads();
        if (tid < 256) { const unsigned* b = bank + (size_t)(u.pm * 256 + tid) * 4; float q = 0.f;
#pragma unroll
            for (int j = 0; j < 4; ++j) q += __builtin_bit_cast(float, __hip_atomic_load(b + j, __ATOMIC_RELAXED, __HIP_MEMORY_SCOPE_AGENT));
            S[tid] = rsqrtf(q * (1.f / DM) + NORM_EPS) * scale; }
        __syncthreads();
    }
    __device__ __forceinline__ void fused(pg8::f32x4 (&acc)[2][2][4][2], const pg8::Unit& u, int wr, int wc, int fr, int fq, PG8_LAS unsigned char* lds, int wid, int lane) const {
        float* P = (float*)lds; float* S = P + 1024; const int tid = wid * 64 + lane;
        rowstat(acc, P, wr, wc, fr, fq);
        exchange(P, S, part, cnt, u, tid, coef);
        const int col0 = u.pn * 256 + wc * 32 + 4 * fq;
#pragma unroll
        for (int ai = 0; ai < 2; ++ai)
#pragma unroll
            for (int m = 0; m < 4; ++m) { const int r = ai * 128 + wr * 64 + m * 16 + fr; const float sr = S[r]; const size_t off = (size_t)(u.pm * 256 + r) * DM + col0;
#pragma unroll
                for (int bj = 0; bj < 2; ++bj)
#pragma unroll
                    for (int n = 0; n < 2; ++n) { const int o = bj * 128 + n * 16; const f32x4 g4 = *(const f32x4*)(gpost + col0 + o), x4 = *(const f32x4*)(xin + off + o);
                        const f32x4 y = x4 + acc[ai][bj][m][n] * sr * g4; acc[ai][bj][m][n] = y; *(f32x4*)(xout + off + o) = y; }
                asm volatile("" ::: "memory"); }
        if (!gpre) return;
        rowstat(acc, P, wr, wc, fr, fq);
        exchange(P, S, part + (size_t)M_ * 4, cnt + 64 * 16, u, tid, 1.f);
#pragma unroll
        for (int ai = 0; ai < 2; ++ai)
#pragma unroll
            for (int m = 0; m < 4; ++m) { const int r = ai * 128 + wr * 64 + m * 16 + fr; const float sr = S[r]; const size_t off = (size_t)(u.pm * 256 + r) * DM + col0;
#pragma unroll
                for (int bj = 0; bj < 2; ++bj)
#pragma unroll
                    for (int n = 0; n < 2; ++n) { const int o = bj * 128 + n * 16; const f32x4 g4 = *(const f32x4*)(gpre + col0 + o); st_bf4(xn + off + o, acc[ai][bj][m][n] * sr * g4); }
                asm volatile("" ::: "memory"); }
    }
};
__device__ __forceinline__ void gemm_norm_res(unsigned char* lds, const bf16* A, int lda, const bf16* Bt, int K, const float* xin, float* xout, bf16* xn, const float* gpost, const float* gpre,
                                              float coef, bf16* ybuf, unsigned* part, unsigned* cnt) {
    pg8::Gemm g{A, Bt, M_, DM, K, lda, K}; pg8::StaticOrder S; S.init(M_, DM, 256, (int)blockIdx.x);
    const EpiNormRes E{xin, xout, xn, gpost, gpre, coef, part, cnt};
    pg8::gemm_phase<EpiNormRes, pg8::StaticOrder, false, true>((PG8_LAS unsigned char*)lds, g, S, E);
}

__device__ __forceinline__ void d_gates(const bf16* xn, const bf16* wg  , float* gates) {
    const int T512 = tidx(), lane = T512 & 63, fr = lane & 15, fq = lane >> 4;
    for (int rt = blockIdx.x * 8 + (T512 >> 6); rt < M_ / 16; rt += gridDim.x * 8) {
        const bf16* ap = xn + (size_t)(rt * 16 + fr) * DM + 8 * fq; const bf16* bp = wg + (size_t)fr * DM + 8 * fq;
        f32x4 c0 = {0.f, 0.f, 0.f, 0.f}, c1 = {0.f, 0.f, 0.f, 0.f};
#pragma unroll 8
        for (int k0 = 0; k0 < DM; k0 += 32) { const bf16x8 a = *(const bf16x8*)(ap + k0);
            c0 = __builtin_amdgcn_mfma_f32_16x16x32_bf16(*(const bf16x8*)(bp + k0), a, c0, 0, 0, 0);
            c1 = __builtin_amdgcn_mfma_f32_16x16x32_bf16(*(const bf16x8*)(bp + (size_t)16 * DM + k0), a, c1, 0, 0, 0); }
        float* o = gates + (size_t)(rt * 16 + fr) * 24 + 4 * fq;
        *(f32x4*)o = (f32x4){sigmoidf_(c0[0]), sigmoidf_(c0[1]), sigmoidf_(c0[2]), sigmoidf_(c0[3])};
        if (fq < 2) *(f32x4*)(o + 16) = (f32x4){sigmoidf_(c1[0]), sigmoidf_(c1[1]), sigmoidf_(c1[2]), sigmoidf_(c1[3])};
    }
}

__device__ __forceinline__ void d_cmp2(const bf16* hidk, const bf16* hidv, const bf16* w2t, const float* rope, bf16* kc, bf16* vct) {
    const int T512 = tidx(), lane = T512 & 63, fr = lane & 15, fq = lane >> 4;
    for (int task = blockIdx.x * 8 + (T512 >> 6); task < 256; task += gridDim.x * 8) {
        const int kv = task >> 7, R0 = (task & 127) * 16;
        const bf16* ap = (kv ? hidv : hidk) + (size_t)(R0 + fr) * 256 + 8 * fq;
        const bf16* bp = w2t + (size_t)kv * 64 * 256 + (size_t)fr * 256 + 8 * fq;
        f32x4 acc[4];
#pragma unroll
        for (int nt = 0; nt < 4; ++nt) acc[nt] = (f32x4){0.f, 0.f, 0.f, 0.f};
#pragma unroll
        for (int k0 = 0; k0 < 256; k0 += 32) {
            const bf16x8 a = *(const bf16x8*)(ap + k0);
#pragma unroll
            for (int nt = 0; nt < 4; ++nt) acc[nt] = __builtin_amdgcn_mfma_f32_16x16x32_bf16(*(const bf16x8*)(bp + (size_t)nt * 16 * 256 + k0), a, acc[nt], 0, 0, 0);
        }
        const int R = R0 + fr, bg = R >> 9, c = R & 511;
        if (kv == 0) {
            const int pos = (16 * c + 31) & (T_ - 1);
#pragma unroll
            for (int h2 = 0; h2 < 2; ++h2) {
                const int d = 16 * h2 + 4 * fq; const f32x4* rp = (const f32x4*)(rope + ((size_t)pos * 32 + d) * 2); const f32x4 r0 = rp[0], r1 = rp[1];
                const f32x4 cs = {r0[0], r0[2], r1[0], r1[2]}, sn = {r0[1], r0[3], r1[1], r1[3]};
                const f32x4 lo = acc[h2] * cs - acc[h2 + 2] * sn, hi = acc[h2] * sn + acc[h2 + 2] * cs;
                st_bf4(kc + (size_t)R * 64 + d, lo); st_bf4(kc + (size_t)R * 64 + d + 32, hi);
            }
        } else {
#pragma unroll
            for (int nt = 0; nt < 4; ++nt)
#pragma unroll
                for (int e = 0; e < 4; ++e) vct[((size_t)bg * 64 + 16 * nt + 4 * fq + e) * NCP + c] = (bf16)f2bf(acc[nt][e]);
        }
    }
}

struct NsaArgs { const bf16 *qb, *kc, *vct, *ks, *vst, *kw, *vwt; const float* gates; bf16* amix; };
__device__ __forceinline__ float dot64(const float* q, const bf16* k) {
    float s = 0.f;
#pragma unroll
    for (int i = 0; i < 8; ++i) { const u32x4 w = ((const u32x4*)k)[i];
        s += q[8 * i + 0] * __builtin_bit_cast(float, w.x << 16) + q[8 * i + 1] * __builtin_bit_cast(float, w.x & 0xffff0000u)
           + q[8 * i + 2] * __builtin_bit_cast(float, w.y << 16) + q[8 * i + 3] * __builtin_bit_cast(float, w.y & 0xffff0000u)
           + q[8 * i + 4] * __builtin_bit_cast(float, w.z << 16) + q[8 * i + 5] * __builtin_bit_cast(float, w.z & 0xffff0000u)
           + q[8 * i + 6] * __builtin_bit_cast(float, w.w << 16) + q[8 * i + 7] * __builtin_bit_cast(float, w.w & 0xffff0000u); }
    return s;
}
__device__ __forceinline__ void softmax_row(float* s, int n, int lane) {
    float m = -INFINITY; for (int i = lane; i < n; i += 64) m = fmaxf(m, s[i]);
    m = wave_max(m); if (m == -INFINITY) m = 0.f;
    float l = 0.f; for (int i = lane; i < n; i += 64) { const float e = exp2f(s[i] - m); s[i] = e; l += e; }
    l = wave_sum(l); const float inv = 1.f / fmaxf(l, 1e-30f);
    for (int i = lane; i < n; i += 64) s[i] *= inv;
}
__device__ __forceinline__ void d_nsa_simple(const NsaArgs& a, int vb, int tid, unsigned char* smem) {
    float (*qs)[64] = (float (*)[64])smem; float (*sc)[1024] = (float (*)[1024])(smem + 1024); float* imp = (float*)(smem + 17408); float* score = imp + 128;
    int* list = (int*)(score + 128); int* nlist = list + 16;
    const int bg = vb / T_, t = vb % T_, b = bg >> 1, g = bg & 1;
    const int r = tid >> 6, d = tid & 63, lane = d;
    const size_t row = (size_t)b * T_ + t;
    qs[r][d] = bf2f(a.qb[row * 512 + g * 256 + r * 64 + d]);
    if (tid == 0) *nlist = 0;
    __syncthreads();
    const int nv = t < 31 ? 0 : (t - 31) / 16 + 1;
    for (int c = tid; c < nv; c += 256) { const bf16* k = a.kc + ((size_t)bg * NCP + c) * 64;
        _Pragma("unroll 1") for (int rr = 0; rr < 4; ++rr) sc[rr][c] = dot64(qs[rr], k); }
    __syncthreads();
    softmax_row(sc[r], nv, lane);
    __syncthreads();
    float oc = 0.f; { const bf16* v = a.vct + ((size_t)bg * 64 + d) * NCP; for (int c = 0; c < nv; ++c) oc += sc[r][c] * bf2f(v[c]); }
    if (tid < 128) { const int s = tid; float acc = 0.f;
        for (int c = 4 * s - 1; c <= 4 * s + 3; ++c) if (c >= 0 && c < nv) acc += sc[0][c] + sc[1][c] + sc[2][c] + sc[3][c];
        imp[s] = acc; }
    __syncthreads();
    const int cur = t >> 6;
    if (tid < 128) { const int s = tid; const bool forced = (s == 0) || (s == cur) || (s == cur - 1);
        score[s] = forced ? 1e4f : (s <= cur ? imp[s] : -1e4f); }
    __syncthreads();
    if (tid < 128) { const int s = tid; const float my = score[s]; int rank = 0;
        for (int j = 0; j < 128; ++j) { const float o = score[j]; rank += (o > my || (o == my && j < s)) ? 1 : 0; }
        if (rank < 16 && s <= cur) { const int slot = atomicAdd(nlist, 1); list[slot] = s; } }
    __syncthreads();
    const int ns = *nlist * 64;
    for (int i = tid; i < ns; i += 256) { const int pos = list[i >> 6] * 64 + (i & 63);
        if (pos <= t) { const bf16* k = a.ks + ((size_t)bg * T_ + pos) * 64; _Pragma("unroll 1") for (int rr = 0; rr < 4; ++rr) sc[rr][i] = dot64(qs[rr], k); }
        else { sc[0][i] = -INFINITY; sc[1][i] = -INFINITY; sc[2][i] = -INFINITY; sc[3][i] = -INFINITY; } }
    __syncthreads();
    softmax_row(sc[r], ns, lane);
    __syncthreads();
    float os = 0.f; { const bf16* v = a.vst + ((size_t)bg * 64 + d) * T_;
        for (int i = 0; i < ns; ++i) { const int pos = list[i >> 6] * 64 + (i & 63); if (pos <= t) os += sc[r][i] * bf2f(v[pos]); } }
    __syncthreads();
    const int lo = t - 511 > 0 ? t - 511 : 0, nw = t - lo + 1;
    for (int i = tid; i < nw; i += 256) { const bf16* k = a.kw + ((size_t)bg * T_ + lo + i) * 64;
        _Pragma("unroll 1") for (int rr = 0; rr < 4; ++rr) sc[rr][i] = dot64(qs[rr], k); }
    __syncthreads();
    softmax_row(sc[r], nw, lane);
    __syncthreads();
    float ow = 0.f; { const bf16* v = a.vwt + ((size_t)bg * 64 + d) * T_ + lo; for (int i = 0; i < nw; ++i) ow += sc[r][i] * bf2f(v[i]); }
    const float* gt = a.gates + row * 24 + g * 12 + r * 3;
    a.amix[row * DM + g * 256 + r * 64 + d] = (bf16)f2bf(gt[0] * oc + gt[1] * os + gt[2] * ow);
    __syncthreads();
}


namespace nsa {
typedef float f32x16 __attribute__((ext_vector_type(16)));
constexpr int KROW = 144, VROW = 136, KBUF = 64 * KROW, VBUF = 64 * VROW;
constexpr int OFF_K = 0, OFF_V = 2 * KBUF, OFF_IMP = OFF_V + 2 * VBUF, IMPW = 130, OFF_SEL = OFF_IMP + 64 * IMPW * 4, OFF_UM = OFF_SEL + 1024, OFF_WS = OFF_UM + 16, OFF_UNIT = OFF_WS + 1024, OFF_ACC = OFF_UNIT + 16, LDS_NEED = OFF_ACC + 8 * 8192;
static_assert(LDS_NEED <= 147456 - 64 && OFF_ACC % 16 == 0, "nsa lds");
static_assert(OFF_IMP % 16 == 0 && OFF_SEL % 16 == 0 && OFF_WS % 16 == 0, "nsa lds map");
__device__ __forceinline__ int crow(int r, int hi) { return (r & 3) + 8 * (r >> 2) + 4 * hi; }
__device__ __forceinline__ int next_bit(unsigned m0, unsigned m1, unsigned m2, unsigned m3, int from) {
#pragma unroll
    for (int wd = 0; wd < 4; ++wd) {
        unsigned x = wd == 0 ? m0 : (wd == 1 ? m1 : (wd == 2 ? m2 : m3)); const int base = wd * 32;
        if (from < base + 32) { if (from > base) x &= (~0u) << (from - base); if (x) return base + __builtin_ctz(x); }
    }
    return 128;
}
__device__ __forceinline__ bf16x8 pack8(const f32x16& p, int b0) {
    u32x4 w; w.x = pk2(p[b0 + 0], p[b0 + 1]); w.y = pk2(p[b0 + 2], p[b0 + 3]); w.z = pk2(p[b0 + 4], p[b0 + 5]); w.w = pk2(p[b0 + 6], p[b0 + 7]);
    return __builtin_bit_cast(bf16x8, w);
}
struct Branch { const bf16* k; const bf16* vt; int ldv; };

constexpr float THR = 8.f;
template <int MODE, bool SEL>
__device__ __forceinline__ void compute_tile(unsigned char* sm, int cb, int j, const bf16x8 (&qf)[4], int lo, int hi_b, int lo_max, int hi_min, unsigned s0, unsigned s1, unsigned s2, unsigned s3,
                                             float& m, float& l, float invl, bool& initd, f32x16& negm, f32x16 (&o)[2], float* imp_row, float* wsc, int i, int hi) {
        const unsigned char* kb = sm + OFF_K + cb * KBUF; const unsigned char* vb = sm + OFF_V + cb * VBUF;
        const int key0 = 64 * j;
        bool rowsel = true;
        if (SEL) { const unsigned wsel = j < 32 ? s0 : (j < 64 ? s1 : (j < 96 ? s2 : s3)); rowsel = (wsel >> (j & 31)) & 1u; }
        if (!SEL || __any(rowsel)) {
            f32x16 p0, p1;
            {
                f32x16 c0;
                if (SEL) {
#pragma unroll
                    for (int r = 0; r < 16; ++r) c0[r] = rowsel ? negm[r] : -INFINITY;
                } else c0 = negm;
                const bf16x8 a00 = *(const bf16x8*)(kb + i * KROW + (8 * hi) * 2), a10 = *(const bf16x8*)(kb + (32 + i) * KROW + (8 * hi) * 2);
                p0 = __builtin_amdgcn_mfma_f32_32x32x16_bf16(a00, qf[0], c0, 0, 0, 0);
                p1 = __builtin_amdgcn_mfma_f32_32x32x16_bf16(a10, qf[0], c0, 0, 0, 0);
#pragma unroll
                for (int d0 = 1; d0 < 4; ++d0) {
                    const bf16x8 a0 = *(const bf16x8*)(kb + i * KROW + (16 * d0 + 8 * hi) * 2);
                    const bf16x8 a1 = *(const bf16x8*)(kb + (32 + i) * KROW + (16 * d0 + 8 * hi) * 2);
                    p0 = __builtin_amdgcn_mfma_f32_32x32x16_bf16(a0, qf[d0], p0, 0, 0, 0);
                    p1 = __builtin_amdgcn_mfma_f32_32x32x16_bf16(a1, qf[d0], p1, 0, 0, 0);
                }
            }
            if (!(key0 >= lo_max && key0 + 63 <= hi_min)) {
#pragma unroll
                for (int r = 0; r < 16; ++r) { const int key = key0 + crow(r, hi);
                    if (key < lo || key > hi_b) p0[r] = -INFINITY;
                    if (key + 32 < lo || key + 32 > hi_b) p1[r] = -INFINITY; }
            }
            if (MODE == 1) {
#pragma unroll
                for (int r = 0; r < 16; ++r) { p0[r] = __builtin_amdgcn_exp2f(p0[r]) * invl; p1[r] = __builtin_amdgcn_exp2f(p1[r]) * invl; }
#pragma unroll
                for (int gq = 0; gq < 4; ++gq) {
                    float G0 = (p0[4 * gq] + p0[4 * gq + 1]) + (p0[4 * gq + 2] + p0[4 * gq + 3]), L0 = p0[4 * gq + 3];
                    float G1 = (p1[4 * gq] + p1[4 * gq + 1]) + (p1[4 * gq + 2] + p1[4 * gq + 3]), L1 = p1[4 * gq + 3];
                    G0 += __shfl_xor(G0, 1); L0 += __shfl_xor(L0, 1); G1 += __shfl_xor(G1, 1); L1 += __shfl_xor(L1, 1);
                    G0 += __shfl_xor(G0, 2); L0 += __shfl_xor(L0, 2); G1 += __shfl_xor(G1, 2); L1 += __shfl_xor(L1, 2);
                    if ((i & 3) == 0) { const int s = 16 * j + 2 * gq + hi;
                        atomicAdd(imp_row + s, G0); atomicAdd(imp_row + s + 1, L0); atomicAdd(imp_row + s + 8, G1); atomicAdd(imp_row + s + 9, L1); }
                }
            } else {
                float ta = fmaxf(fmaxf(p0[0], p0[1]), p1[0]), tb = fmaxf(fmaxf(p0[2], p0[3]), p1[1]);
                ta = fmaxf(fmaxf(ta, p1[2]), p1[3]);
#pragma unroll
                for (int r = 4; r < 16; r += 4) { ta = fmaxf(fmaxf(ta, p0[r]), p0[r + 1]); tb = fmaxf(fmaxf(tb, p0[r + 2]), p0[r + 3]); ta = fmaxf(fmaxf(ta, p1[r]), p1[r + 1]); tb = fmaxf(fmaxf(tb, p1[r + 2]), p1[r + 3]); }
                float tm = fmaxf(ta, tb);
                tm = fmaxf(tm, __shfl_xor(tm, 32));
                if (__any((!initd && tm > -INFINITY) || tm > THR)) {
                    const bool was = initd;
                    const float d = was ? fmaxf(tm, 0.f) : (tm > -INFINITY ? tm : 0.f);
                    initd = was || (tm > -INFINITY);
                    m += d; const float alpha = was ? __builtin_amdgcn_exp2f(-d) : 1.f; l *= alpha;
#pragma unroll
                    for (int r = 0; r < 16; ++r) { p0[r] -= d; p1[r] -= d; negm[r] = -m; }
                    if (MODE == 2) {
                        if (hi == 0) wsc[i] = alpha;
                        asm volatile("" ::: "memory");
#pragma unroll
                        for (int rg = 0; rg < 4; ++rg) { const f32x4 a4 = *(const f32x4*)(wsc + 8 * rg + 4 * hi);
#pragma unroll
                            for (int e = 0; e < 4; ++e) { o[0][4 * rg + e] *= a4[e]; o[1][4 * rg + e] *= a4[e]; } }
                        asm volatile("" ::: "memory");
                    }
                }
                float rs = 0.f;
#pragma unroll
                for (int r = 0; r < 16; ++r) { p0[r] = __builtin_amdgcn_exp2f(p0[r]); p1[r] = __builtin_amdgcn_exp2f(p1[r]); rs += p0[r] + p1[r]; }
                l += rs;
            }
            if (MODE != 0) {
                const bf16x8 pf0 = pack8(p0, 0), pf1 = pack8(p0, 8), pf2 = pack8(p1, 0), pf3 = pack8(p1, 8);
#pragma unroll
                for (int dt = 0; dt < 2; ++dt) {
                    const unsigned char* vp = vb + (32 * dt + i) * VROW + 8 * hi;
#pragma unroll
                    for (int ks = 0; ks < 4; ++ks) {
                        const u32x2 v_lo = *(const u32x2*)(vp + 32 * ks), v_hi = *(const u32x2*)(vp + 32 * ks + 16);
                        const bf16x8 vf = __builtin_bit_cast(bf16x8, (u32x4){v_lo.x, v_lo.y, v_hi.x, v_hi.y});
                        o[dt] = __builtin_amdgcn_mfma_f32_32x32x16_bf16(ks == 0 ? pf0 : (ks == 1 ? pf1 : (ks == 2 ? pf2 : pf3)), vf, o[dt], 0, 0, 0);
                    }
                }
            }
        }
}
template <int MODE, bool SEL>
__device__ __forceinline__ void run_branch(unsigned char* sm, const Branch br, unsigned m0, unsigned m1, unsigned m2, unsigned m3,
                                           const bf16x8 (&qf)[4], int lo, int hi_b, int lo_max, int hi_min, unsigned s0, unsigned s1, unsigned s2, unsigned s3,
                                           float& m, float& l, float invl, f32x16 (&o)[2], float* imp_row, float* wsc, int tid, int lane) {
    const int i = lane & 31, hi = lane >> 5;
    const bf16* kp = br.k + tid * 8; const bf16* vp_ = br.vt + (size_t)(tid >> 3) * br.ldv + (tid & 7) * 8;
    unsigned char* kst = sm + OFF_K + (tid >> 3) * KROW + (tid & 7) * 16; unsigned char* vst = sm + OFF_V + (tid >> 3) * VROW + (tid & 7) * 16;
#define NSA_LOAD(jj, KR, VR) do { KR = *(const u32x4*)(kp + (size_t)(jj) * 4096); if (MODE != 0) VR = *(const u32x4*)(vp_ + (jj) * 64); } while (0)
#define NSA_STORE(buf, KR, VR) do { *(u32x4*)(kst + (buf) * KBUF) = KR; if (MODE != 0) { *(u32x2*)(vst + (buf) * VBUF) = (u32x2){VR.x, VR.y}; *(u32x2*)(vst + (buf) * VBUF + 8) = (u32x2){VR.z, VR.w}; } } while (0)
    int j = next_bit(m0, m1, m2, m3, 0);
    int j1 = j < 128 ? next_bit(m0, m1, m2, m3, j + 1) : 128;
    u32x4 kA, vA, kB, vB;
    if (j < 128) { NSA_LOAD(j, kA, vA); if (j1 < 128) NSA_LOAD(j1, kB, vB); NSA_STORE(0, kA, vA); }
    __syncthreads();
    bool initd = (MODE == 1);
    f32x16 negm;
#pragma unroll
    for (int r = 0; r < 16; ++r) negm[r] = (MODE == 1) ? -m : 0.f;
    while (j < 128) {
        {
            const int j2 = j1 < 128 ? next_bit(m0, m1, m2, m3, j1 + 1) : 128;
            if (j2 < 128) NSA_LOAD(j2, kA, vA);
            compute_tile<MODE, SEL>(sm, 0, j, qf, lo, hi_b, lo_max, hi_min, s0, s1, s2, s3, m, l, invl, initd, negm, o, imp_row, wsc, i, hi);
            if (j1 < 128) NSA_STORE(1, kB, vB);
            __syncthreads();
            j = j1; j1 = j2;
        }
        if (j >= 128) break;
        {
            const int j2 = j1 < 128 ? next_bit(m0, m1, m2, m3, j1 + 1) : 128;
            if (j2 < 128) NSA_LOAD(j2, kB, vB);
            compute_tile<MODE, SEL>(sm, 1, j, qf, lo, hi_b, lo_max, hi_min, s0, s1, s2, s3, m, l, invl, initd, negm, o, imp_row, wsc, i, hi);
            if (j1 < 128) NSA_STORE(0, kA, vA);
            __syncthreads();
            j = j1; j1 = j2;
        }
    }
#undef NSA_LOAD
#undef NSA_STORE
}
template <bool FIRST> __device__ __forceinline__ void add_scaled(float* accw, const f32x16 (&o)[2], float f, float* wsc, int i, int hi, int lane) {
    if (hi == 0) wsc[i] = f;
    asm volatile("" ::: "memory");
#pragma unroll
    for (int rg = 0; rg < 4; ++rg) { const f32x4 a4 = *(const f32x4*)(wsc + 8 * rg + 4 * hi);
#pragma unroll
        for (int e = 0; e < 4; ++e)
#pragma unroll
            for (int dt = 0; dt < 2; ++dt) { float* p = accw + (dt * 16 + 4 * rg + e) * 64 + lane; const float v = a4[e] * o[dt][4 * rg + e]; *p = FIRST ? v : (*p + v); } }
    asm volatile("" ::: "memory");
}
__device__ __forceinline__ void unit(const NsaArgs& a, int u, unsigned char* sm) {
    const int tid = tidx(), lane = tid & 63, w = __builtin_amdgcn_readfirstlane(tid >> 6), i = lane & 31, hi = lane >> 5;
    const int cur = 127 - (u >> 2), bg = u & 3, b = bg >> 1, g = bg & 1, q0 = cur * 64;
    const int ql = 8 * w + (i >> 2), hd = i & 3, t = q0 + ql;
    const size_t grow = (size_t)b * T_ + t;
    bf16x8 qf[4];
    { const bf16* qp = a.qb + grow * 512 + g * 256 + hd * 64 + 8 * hi;
#pragma unroll
      for (int d0 = 0; d0 < 4; ++d0) qf[d0] = *(const bf16x8*)(qp + 16 * d0); }
    float* wsc = (float*)(sm + OFF_WS) + w * 32;
    float* imp = (float*)(sm + OFF_IMP);
    unsigned* selw = (unsigned*)(sm + OFF_SEL);
    unsigned* um = (unsigned*)(sm + OFF_UM);
    for (int k = tid; k < 64 * IMPW; k += 512) imp[k] = 0.f;
    if (tid < 4) um[tid] = 0u;
    const float* gt = a.gates + grow * 24 + g * 12 + hd * 3;
    const float gc = gt[0], gs = gt[1], gw = gt[2];
    f32x16 o[2];
    float* accw = (float*)(sm + OFF_ACC) + w * 2048;
    const int tw0 = q0 + 8 * w, tw1 = tw0 + 7;
    {
        const int nv = t < 31 ? 0 : (t - 31) / 16 + 1;
        const int nvw = tw0 < 31 ? 0 : (tw0 - 31) / 16 + 1;
        const int nvmax = (q0 + 63 - 31) / 16 + 1, ntc = (nvmax + 63) / 64;
        const unsigned cm0 = ntc >= 32 ? ~0u : ((1u << ntc) - 1u);
        const Branch br{a.kc + (size_t)bg * NCP * 64, a.vct + (size_t)bg * 64 * NCP, NCP};
        float m = 0.f, l = 0.f;
        run_branch<0, false>(sm, br, cm0, 0u, 0u, 0u, qf, 0, nv - 1, 0, nvw - 1, 0u, 0u, 0u, 0u, m, l, 0.f, o, nullptr, wsc, tid, lane);
        l += __shfl_xor(l, 32);
        const float invl = 1.f / fmaxf(l, 1e-30f);
#pragma unroll
        for (int r = 0; r < 16; ++r) { o[0][r] = 0.f; o[1][r] = 0.f; }
        run_branch<1, false>(sm, br, cm0, 0u, 0u, 0u, qf, 0, nv - 1, 0, nvw - 1, 0u, 0u, 0u, 0u, m, l, invl, o, imp + ql * IMPW, wsc, tid, lane);
        add_scaled<true>(accw, o, gc, wsc, i, hi, lane);
    }
    {
        unsigned u0 = 0u, u1 = 0u, u2 = 0u, u3 = 0u;
        const int ncand = cur - 2;
        unsigned k0[8], k1[8], k2[8], k3[8];
        if (ncand <= 13) {
#pragma unroll
            for (int wd = 0; wd < 4; ++wd) { const int nb = cur + 1 - 32 * wd; const unsigned x = nb >= 32 ? ~0u : (nb <= 0 ? 0u : ((1u << nb) - 1u));
#pragma unroll
                for (int qq = 0; qq < 8; ++qq) { if (wd == 0) k0[qq] = x; else if (wd == 1) k1[qq] = x; else if (wd == 2) k2[qq] = x; else k3[qq] = x; } }
        } else {
            float v0[8], v1[8];
#pragma unroll
            for (int qq = 0; qq < 8; ++qq) { const float* ir = imp + (8 * w + qq) * IMPW;
                v0[qq] = (lane >= 1 && lane <= cur - 2) ? ir[lane] : -1.f; v1[qq] = (lane + 64 <= cur - 2) ? ir[lane + 64] : -1.f;
                k0[qq] = 1u; k1[qq] = 0u; k2[qq] = 0u; k3[qq] = 0u; }
            for (int it = 0; it < 13; ++it) {
                float bv[8]; int bs[8];
#pragma unroll
                for (int qq = 0; qq < 8; ++qq) { bv[qq] = v0[qq]; bs[qq] = lane; if (v1[qq] > v0[qq]) { bv[qq] = v1[qq]; bs[qq] = lane + 64; } }
#pragma unroll
                for (int off = 1; off < 64; off <<= 1) {
#pragma unroll
                    for (int qq = 0; qq < 8; ++qq) { const float ov = __shfl_xor(bv[qq], off); const int os = __shfl_xor(bs[qq], off);
                        if (ov > bv[qq] || (ov == bv[qq] && os < bs[qq])) { bv[qq] = ov; bs[qq] = os; } } }
#pragma unroll
                for (int qq = 0; qq < 8; ++qq) { const int b_ = __builtin_amdgcn_readfirstlane(bs[qq]);
                    if (b_ == lane) v0[qq] = -1.f; if (b_ == lane + 64) v1[qq] = -1.f;
                    const unsigned bit = 1u << (b_ & 31);
                    if (b_ < 32) k0[qq] |= bit; else if (b_ < 64) k1[qq] |= bit; else if (b_ < 96) k2[qq] |= bit; else k3[qq] |= bit; }
            }
            { const int c1 = cur - 1; const unsigned b1 = 1u << (c1 & 31), b2 = 1u << (cur & 31);
#pragma unroll
              for (int qq = 0; qq < 8; ++qq) {
                if (c1 < 32) k0[qq] |= b1; else if (c1 < 64) k1[qq] |= b1; else if (c1 < 96) k2[qq] |= b1; else k3[qq] |= b1;
                if (cur < 32) k0[qq] |= b2; else if (cur < 64) k1[qq] |= b2; else if (cur < 96) k2[qq] |= b2; else k3[qq] |= b2; } }
        }
#pragma unroll
        for (int qq = 0; qq < 8; ++qq) {
            if (lane == 0) { unsigned* sp = selw + (8 * w + qq) * 4; sp[0] = k0[qq]; sp[1] = k1[qq]; sp[2] = k2[qq]; sp[3] = k3[qq]; }
            u0 |= k0[qq]; u1 |= k1[qq]; u2 |= k2[qq]; u3 |= k3[qq]; }
        if (lane == 0) { atomicOr(um + 0, u0); atomicOr(um + 1, u1); atomicOr(um + 2, u2); atomicOr(um + 3, u3); }
    }
    __syncthreads();
    {
        const unsigned U0 = um[0], U1 = um[1], U2 = um[2], U3 = um[3];
        const unsigned* sp = selw + ql * 4; const unsigned s0 = sp[0], s1 = sp[1], s2 = sp[2], s3 = sp[3];
        const Branch br{a.ks + (size_t)bg * T_ * 64, a.vst + (size_t)bg * 64 * T_, T_};
        float m = 0.f, l = 0.f;
#pragma unroll
        for (int r = 0; r < 16; ++r) { o[0][r] = 0.f; o[1][r] = 0.f; }
        run_branch<2, true>(sm, br, __builtin_amdgcn_readfirstlane(U0), __builtin_amdgcn_readfirstlane(U1), __builtin_amdgcn_readfirstlane(U2), __builtin_amdgcn_readfirstlane(U3),
                            qf, 0, t, 0, tw0, s0, s1, s2, s3, m, l, 0.f, o, nullptr, wsc, tid, lane);
        l += __shfl_xor(l, 32);
        add_scaled<false>(accw, o, gs / fmaxf(l, 1e-30f), wsc, i, hi, lane);
    }
    {
        const int j0 = cur - 8 > 0 ? cur - 8 : 0;
        unsigned wm0 = 0u, wm1 = 0u, wm2 = 0u, wm3 = 0u;
#pragma unroll
        for (int wd = 0; wd < 4; ++wd) { const int a0 = j0 - 32 * wd, a1 = cur + 1 - 32 * wd;
            const unsigned hi_m = a1 >= 32 ? ~0u : (a1 <= 0 ? 0u : ((1u << a1) - 1u)), lo_m = a0 >= 32 ? ~0u : (a0 <= 0 ? 0u : ((1u << a0) - 1u));
            const unsigned x = hi_m & ~lo_m; if (wd == 0) wm0 = x; else if (wd == 1) wm1 = x; else if (wd == 2) wm2 = x; else wm3 = x; }
        const Branch br{a.kw + (size_t)bg * T_ * 64, a.vwt + (size_t)bg * 64 * T_, T_};
        float m = 0.f, l = 0.f;
#pragma unroll
        for (int r = 0; r < 16; ++r) { o[0][r] = 0.f; o[1][r] = 0.f; }
        run_branch<2, false>(sm, br, wm0, wm1, wm2, wm3, qf, t - 511, t, tw1 - 511, tw0, 0u, 0u, 0u, 0u, m, l, 0.f, o, nullptr, wsc, tid, lane);
        l += __shfl_xor(l, 32);
        add_scaled<false>(accw, o, gw / fmaxf(l, 1e-30f), wsc, i, hi, lane);
    }
#pragma unroll
    for (int r = 0; r < 16; ++r) { const int rw = crow(r, hi), qq = 8 * w + (rw >> 2), hh = rw & 3;
        bf16* op = a.amix + ((size_t)b * T_ + q0 + qq) * DM + g * 256 + hh * 64 + i;
        op[0] = (bf16)f2bf(accw[r * 64 + lane]); op[32] = (bf16)f2bf(accw[(16 + r) * 64 + lane]); }
}
__device__ __forceinline__ void phase(const NsaArgs& a, unsigned* ctr, unsigned char* sm) {
    int* slot = (int*)(sm + OFF_UNIT);
    for (;;) {
        if (tidx() == 0) *slot = (int)atomicAdd(ctr, 1u);
        __syncthreads();
        const int u = *slot;
        __syncthreads();
        if (u >= 512) break;
        unit(a, u, sm);
    }
}
}

__device__ __forceinline__ void d_lora_prep(const bf16* pr, const float* mu, bf16* la) {
    const int T512 = tidx(), c = T512 & 255;
    const float m = mu[1536 + c];
    FOR_VB(vb, M_ / 4) {
        const int row0 = vb * 4;
        float x[5];
        x[0] = (row0 % T_) ? bf2f(pr[(size_t)(row0 - 1) * 256 + c]) : 0.f;
#pragma unroll
        for (int j = 0; j < 4; ++j) x[j + 1] = bf2f(pr[(size_t)(row0 + j) * 256 + c]);
#pragma unroll
        for (int j = 0; j < 4; ++j) { const float xs = x[j + 1] + (x[j] - x[j + 1]) * m;
            const float v = c < 64 ? tanhf(xs) : (c < 128 ? xs : sigmoidf_(xs));
            la[(size_t)(row0 + j) * KLORA + c] = (bf16)f2bf(v); }
    }
}

namespace rw7 {
using nsa::f32x16; using nsa::crow; using nsa::pack8;
constexpr int NHELP = 2, RG = 18;
constexpr int NPROD = 6, RING = 7, RA = 144, RB = 40, S_AT = 0, S_RT = 16 * RA, S_BT = 32 * RA, S_KT = S_BT + 64 * RB, S_VT = S_KT + 64 * RB, S_SM = S_VT + 64 * RB, SMM = 16 * RB, S_GC = S_SM + 4 * SMM, SLOT = S_GC + 256;
constexpr int OFF_SCR = RING * SLOT, SCR = 32 * RA, LDS_NEED = OFF_SCR;
static_assert(NPROD % NHELP == 0 && LDS_NEED <= 147456 - 64 && 6 * (SLOT + SCR) <= 147456 - 64 && (size_t)16 * NHELP * RG * SLOT <= (size_t)9 << 20 && SLOT % 16 == 0 && S_BT % 16 == 0 && 128 * RB >= 4096 && SCR >= 4096, "rw7 lds map");
struct Args { const unsigned* rkw; const bf16* vv; const bf16* aga; const float* wdec; const float *mu, *kk, *ka, *rk; float* yraw; float* bonus; unsigned char* ring; unsigned* flags; unsigned* cons; };
__device__ __forceinline__ void wg_bar() { asm volatile("s_waitcnt lgkmcnt(0)" ::: "memory"); __builtin_amdgcn_s_barrier(); asm volatile("" ::: "memory"); }
struct Chan { float mur, muk, muv, kkc, kac, rkc; };
struct Raw { unsigned rk[16]; unsigned short v[16], al[16]; float w[16]; unsigned prk; unsigned short pv; };
__device__ __forceinline__ void fetch(const Args& a, int b, int h, int c, int lane, Raw& q) {
    const size_t base = ((size_t)b * T_ + (size_t)c * 16) * 512 + h * 64 + lane;
#pragma unroll
    for (int t = 0; t < 16; ++t) { q.rk[t] = a.rkw[base + (size_t)t * 512]; q.v[t] = a.vv[base + (size_t)t * 512]; q.al[t] = a.aga[base + (size_t)t * 512]; q.w[t] = a.wdec[base + (size_t)t * 512]; }
    q.prk = 0u; q.pv = 0;
    if (c > 0) { q.prk = a.rkw[base - 512]; q.pv = a.vv[base - 512]; }
}
__device__ __forceinline__ void st_row40(unsigned char* p, const unsigned (&w)[8]) {
    *(u32x2*)p = (u32x2){w[0], w[1]}; *(u32x2*)(p + 8) = (u32x2){w[2], w[3]}; *(u32x2*)(p + 16) = (u32x2){w[4], w[5]}; *(u32x2*)(p + 24) = (u32x2){w[6], w[7]};
}
template <bool BAR> __device__ __forceinline__ void seg_end() { if (BAR) wg_bar(); else { asm volatile("s_waitcnt lgkmcnt(0)" ::: "memory"); __builtin_amdgcn_sched_barrier(0); } }
template <bool BAR> __device__ __forceinline__ void produce(const Args& a, const Chan& ch, int b, int h, int c, const Raw& q, unsigned char* slot, unsigned char* scr, int lane) {
    const int i = lane & 31, hi = lane >> 5;
    const size_t row0 = (size_t)b * T_ + (size_t)c * 16;
    float pr_r = __builtin_bit_cast(float, q.prk << 16), pr_k = __builtin_bit_cast(float, q.prk & 0xffff0000u), pr_v = bf2f(q.pv);
    float rr[16], kq[16], kt[16];
    float* RED1 = (float*)scr;
    float* RED2 = (float*)(slot + S_BT);
#pragma unroll
    for (int t4 = 0; t4 < 4; ++t4) { f32x4 e1, e2;
#pragma unroll
        for (int e = 0; e < 4; ++e) { const int t = 4 * t4 + e;
            const float r0 = __builtin_bit_cast(float, q.rk[t] << 16), k0 = __builtin_bit_cast(float, q.rk[t] & 0xffff0000u), al = bf2f(q.al[t]);
            const float r = r0 + (pr_r - r0) * ch.mur, k = k0 + (pr_k - k0) * ch.muk;
            pr_r = r0; pr_k = k0;
            rr[t] = r; kq[t] = k * ch.kkc; kt[t] = k * (1.f + (al - 1.f) * ch.kac);
            e1[e] = kq[t] * kq[t]; e2[e] = r * kt[t] * ch.rkc; }
        *(f32x4*)(RED1 + lane * 16 + 4 * t4) = e1; *(f32x4*)(RED2 + lane * 16 + 4 * t4) = e2; }
    seg_end<BAR>();
    { const int t = lane & 15, part = lane >> 4; float s1 = 0.f, s2 = 0.f;
#pragma unroll
      for (int j = 0; j < 16; ++j) { s1 += RED1[(part * 16 + j) * 16 + t]; s2 += RED2[(part * 16 + j) * 16 + t]; }
      s1 += __shfl_xor(s1, 16); s2 += __shfl_xor(s2, 16); s1 += __shfl_xor(s1, 32); s2 += __shfl_xor(s2, 32);
      asm volatile("s_waitcnt lgkmcnt(0)" ::: "memory");
      if (lane < 16) { ((float*)(slot + S_GC))[lane] = s1; a.bonus[(row0 + lane) * 8 + h] = s2; } }
    asm volatile("s_waitcnt lgkmcnt(0)" ::: "memory");
    f32x4 n2[4];
#pragma unroll
    for (int t4 = 0; t4 < 4; ++t4) n2[t4] = *(const f32x4*)(slot + S_GC + 16 * t4);
    asm volatile("s_waitcnt lgkmcnt(0)" ::: "memory");
    float gam = 1.f;
    unsigned btp[8], ktp[8], vtp[8];
    float b_ev = 0.f, k_ev = 0.f, v_ev = 0.f;
#pragma unroll
    for (int t = 0; t < 16; ++t) {
        if (t == 6) seg_end<BAR>();
        const float v0 = bf2f(q.v[t]), al = bf2f(q.al[t]);
        const float v = v0 + (pr_v - v0) * ch.muv; pr_v = v0;
        const float kkn = kq[t] * __builtin_amdgcn_rsqf(fmaxf(n2[t >> 2][t & 3], 1e-24f));
        const float gp = gam; gam *= q.w[t]; const float ig = __builtin_amdgcn_rcpf(gam);
        const float bt_ = kkn * al * ig, kt_ = kt[t] * ig;
        const unsigned ar = pk2(-kkn * gp, rr[t] * gam), bk = pk2(bt_, kt_);
        *(bf16*)(slot + S_AT + t * RA + lane * 2) = (bf16)(ar & 0xffffu); *(bf16*)(slot + S_RT + t * RA + lane * 2) = (bf16)(ar >> 16);
        *(bf16*)(scr + t * RA + lane * 2) = (bf16)(bk & 0xffffu); *(bf16*)(scr + (16 + t) * RA + lane * 2) = (bf16)(bk >> 16);
        if (t & 1) { btp[t >> 1] = pk2(b_ev, bt_); ktp[t >> 1] = pk2(k_ev, kt_); vtp[t >> 1] = pk2(v_ev, v); }
        else { b_ev = bt_; k_ev = kt_; v_ev = v; }
    }
    st_row40(slot + S_BT + lane * RB, btp); st_row40(slot + S_KT + lane * RB, ktp); st_row40(slot + S_VT + lane * RB, vtp);
    ((float*)(slot + S_GC))[lane] = gam;
    seg_end<BAR>();
    f32x16 C;
#pragma unroll
    for (int r = 0; r < 16; ++r) C[r] = 0.f;
#pragma unroll
    for (int ks = 0; ks < 4; ++ks) {
        const bf16x8 af = *(const bf16x8*)(slot + S_AT + i * RA + (16 * ks + 8 * hi) * 2);
        const bf16x8 bf = *(const bf16x8*)(scr + i * RA + (16 * ks + 8 * hi) * 2);
        C = __builtin_amdgcn_mfma_f32_32x32x16_bf16(af, bf, C, 0, 0, 0);
    }
    asm volatile("s_waitcnt lgkmcnt(0)" ::: "memory");
    float* AAB = (float*)scr;
    unsigned char* SM = slot + S_SM;
#pragma unroll
    for (int r = 0; r < 16; ++r) {
        const int rho = crow(r, hi); const float val = C[r];
        if (r < 8) {
            if (i < 16) AAB[rho * 16 + i] = (i < rho) ? val : 0.f;
            else *(bf16*)(SM + SMM + rho * RB + (i - 16) * 2) = (bf16)f2bf((i - 16 < rho) ? val : 0.f);
        } else {
            const int tt = rho - 16;
            if (i < 16) *(bf16*)(SM + 2 * SMM + tt * RB + i * 2) = (bf16)f2bf((i <= tt) ? val : 0.f);
            else *(bf16*)(SM + 3 * SMM + tt * RB + (i - 16) * 2) = (bf16)f2bf((i - 16 <= tt) ? val : 0.f);
        }
    }
    seg_end<BAR>();
    { const int j = lane & 15; float Tr[16];
#pragma unroll
      for (int t = 0; t < 16; ++t) { if (t == 11) seg_end<BAR>();
          float acc = (t == j) ? 1.f : 0.f;
#pragma unroll
          for (int s4 = 0; s4 < (t + 3) / 4; ++s4) { const f32x4 ar = *(const f32x4*)(AAB + t * 16 + 4 * s4);
#pragma unroll
              for (int e = 0; e < 4; ++e) if (4 * s4 + e < t) acc += ar[e] * Tr[4 * s4 + e]; }
          Tr[t] = acc;
          if (lane < 16) *(bf16*)(SM + t * RB + j * 2) = (bf16)f2bf(acc); } }
    seg_end<BAR>();
}

__device__ __forceinline__ bf16x8 rd_perm(const unsigned char* p, int hi) {
    const u32x2 a = *(const u32x2*)(p + 8 * hi), b = *(const u32x2*)(p + 16 + 8 * hi);
    return __builtin_bit_cast(bf16x8, (u32x4){a.x, a.y, b.x, b.y});
}
__device__ __forceinline__ bf16x8 rd_nat(const unsigned char* p, int hi) {
    const u32x2 a = *(const u32x2*)(p + 16 * hi), b = *(const u32x2*)(p + 16 * hi + 8);
    return __builtin_bit_cast(bf16x8, (u32x4){a.x, a.y, b.x, b.y});
}
__device__ __forceinline__ bf16x8 and8(bf16x8 f, unsigned m) { u32x4 w = __builtin_bit_cast(u32x4, f); w.x &= m; w.y &= m; w.z &= m; w.w &= m; return __builtin_bit_cast(bf16x8, w); }
__device__ __forceinline__ void consume(const unsigned char* slot, f32x16 (&z)[2], float* yout, int vt, int lane) {
    const int i = lane & 31, hi = lane >> 5, i16 = i & 15;
    const unsigned m16 = i < 16 ? 0xffffffffu : 0u;
    const unsigned char* at = slot + S_AT + i16 * RA; const unsigned char* rt = slot + S_RT + i16 * RA; const unsigned char* sm16 = slot + S_SM + i16 * RB;
    bf16x8 fa0 = rd_perm(at, hi), fa1 = rd_perm(at + 32, hi), fa2 = rd_perm(at + 64, hi), fa3 = rd_perm(at + 96, hi);
    bf16x8 fak = rd_nat(sm16 + SMM, hi), ft = rd_perm(sm16, hi);
    const bf16x8 vtf = rd_nat(slot + S_VT + (32 * vt + i) * RB, hi);
    bf16x8 fr0 = rd_perm(rt, hi), fr1 = rd_perm(rt + 32, hi), fr2 = rd_perm(rt + 64, hi), fr3 = rd_perm(rt + 96, hi);
    bf16x8 frb = rd_perm(sm16 + 2 * SMM, hi), frk = rd_nat(sm16 + 3 * SMM, hi);
    const bf16x8 fk0 = rd_nat(slot + S_KT + i * RB, hi), fk1 = rd_nat(slot + S_KT + (32 + i) * RB, hi);
    const bf16x8 fb0 = rd_perm(slot + S_BT + i * RB, hi), fb1 = rd_perm(slot + S_BT + (32 + i) * RB, hi);
    f32x4 g4[2][4];
#pragma unroll
    for (int kt = 0; kt < 2; ++kt)
#pragma unroll
        for (int rg = 0; rg < 4; ++rg) g4[kt][rg] = *(const f32x4*)(slot + S_GC + (32 * kt + 8 * rg + 4 * hi) * 4);
    const bf16x8 zb0 = pack8(z[0], 0), zb1 = pack8(z[0], 8), zb2 = pack8(z[1], 0), zb3 = pack8(z[1], 8);
    fa0 = and8(fa0, m16); fa1 = and8(fa1, m16); fa2 = and8(fa2, m16); fa3 = and8(fa3, m16); fak = and8(fak, m16); ft = and8(ft, m16);
    fr0 = and8(fr0, m16); fr1 = and8(fr1, m16); fr2 = and8(fr2, m16); fr3 = and8(fr3, m16); frb = and8(frb, m16); frk = and8(frk, m16);
    f32x16 X, U, Y;
#pragma unroll
    for (int r = 0; r < 16; ++r) { X[r] = 0.f; U[r] = 0.f; Y[r] = 0.f; }
    X = __builtin_amdgcn_mfma_f32_32x32x16_bf16(fa0, zb0, X, 0, 0, 0);
    X = __builtin_amdgcn_mfma_f32_32x32x16_bf16(fa1, zb1, X, 0, 0, 0);
    X = __builtin_amdgcn_mfma_f32_32x32x16_bf16(fa2, zb2, X, 0, 0, 0);
    X = __builtin_amdgcn_mfma_f32_32x32x16_bf16(fa3, zb3, X, 0, 0, 0);
    X = __builtin_amdgcn_mfma_f32_32x32x16_bf16(fak, vtf, X, 0, 0, 0);
    Y = __builtin_amdgcn_mfma_f32_32x32x16_bf16(fr0, zb0, Y, 0, 0, 0);
    Y = __builtin_amdgcn_mfma_f32_32x32x16_bf16(fr1, zb1, Y, 0, 0, 0);
    Y = __builtin_amdgcn_mfma_f32_32x32x16_bf16(fr2, zb2, Y, 0, 0, 0);
    Y = __builtin_amdgcn_mfma_f32_32x32x16_bf16(fr3, zb3, Y, 0, 0, 0);
    Y = __builtin_amdgcn_mfma_f32_32x32x16_bf16(frk, vtf, Y, 0, 0, 0);
    z[0] = __builtin_amdgcn_mfma_f32_32x32x16_bf16(fk0, vtf, z[0], 0, 0, 0);
    z[1] = __builtin_amdgcn_mfma_f32_32x32x16_bf16(fk1, vtf, z[1], 0, 0, 0);
    const bf16x8 xb = pack8(X, 0);
    U = __builtin_amdgcn_mfma_f32_32x32x16_bf16(ft, xb, U, 0, 0, 0);
    const bf16x8 ub = pack8(U, 0);
    z[0] = __builtin_amdgcn_mfma_f32_32x32x16_bf16(fb0, ub, z[0], 0, 0, 0);
    z[1] = __builtin_amdgcn_mfma_f32_32x32x16_bf16(fb1, ub, z[1], 0, 0, 0);
    Y = __builtin_amdgcn_mfma_f32_32x32x16_bf16(frb, ub, Y, 0, 0, 0);
#pragma unroll
    for (int kt = 0; kt < 2; ++kt)
#pragma unroll
        for (int rg = 0; rg < 4; ++rg)
#pragma unroll
            for (int e = 0; e < 4; ++e) z[kt][4 * rg + e] *= g4[kt][rg][e];
#pragma unroll
    for (int r = 0; r < 8; ++r) yout[(size_t)crow(r, hi) * 512] = Y[r];
}

__device__ __forceinline__ unsigned ld_relaxed(const unsigned* p) { return __hip_atomic_load(p, __ATOMIC_RELAXED, __HIP_MEMORY_SCOPE_AGENT); }
__device__ __forceinline__ void head(const Args& a, int bh, unsigned char* sm) {
    const int tid = tidx(), lane = tid & 63, w = __builtin_amdgcn_readfirstlane(tid >> 6);
    const int b = bh >> 3, h = bh & 7;
    constexpr int NCH = T_ / 16, NBAR = NCH + NPROD;
    if (w < 2) {
        f32x16 z[2];
#pragma unroll
        for (int r = 0; r < 16; ++r) { z[0][r] = 0.f; z[1][r] = 0.f; }
        for (int i = 0; i < NPROD; ++i) wg_bar();
        for (int c = 0; c < NCH; ++c) {
            consume(sm + (size_t)(c % RING) * SLOT, z, a.yraw + ((size_t)b * T_ + (size_t)c * 16) * 512 + h * 64 + 32 * w + (lane & 31), w, lane);
            if (w == 0 && (c & 7) == 7 && lane == 0) __hip_atomic_store(a.cons + bh * 64, (unsigned)(c + 1), __ATOMIC_RELAXED, __HIP_MEMORY_SCOPE_AGENT);
            wg_bar();
        }
    } else {
        const int pw = w - 2;
        int nb = pw;
        {
            u32x4 v[15];
            { const int c = pw; const int hl = c % NHELP, n = c / NHELP;
              const unsigned char* g = a.ring + ((size_t)(bh * NHELP + hl) * RG + (n % RG)) * SLOT;
              while (__builtin_amdgcn_readfirstlane(ld_relaxed(a.flags + bh * NCH + c)) == 0u) __builtin_amdgcn_s_sleep(2);
              __builtin_amdgcn_fence(__ATOMIC_ACQUIRE, "agent");
              asm volatile("s_waitcnt vmcnt(0)" ::: "memory");
#pragma unroll
              for (int i = 0; i < 15; ++i) { const int off = (i * 64 + lane) * 16; if (off < SLOT) v[i] = *(const u32x4*)(g + off); } }
            for (int i = 0; i < pw; ++i) wg_bar();
            for (int c = pw; c < NCH; c += NPROD) {
                unsigned char* slot = sm + (size_t)(c % RING) * SLOT;
#pragma unroll
                for (int i = 0; i < 15; ++i) { const int off = (i * 64 + lane) * 16; if (off < SLOT) *(u32x4*)(slot + off) = v[i]; }
                const int cn = c + NPROD; const bool more = cn < NCH;
                const unsigned* fp = a.flags + bh * NCH + (more ? cn : c);
                unsigned fl = ld_relaxed(fp);
                wg_bar(); wg_bar();
                if (more) {
                    while (__builtin_amdgcn_readfirstlane(fl) == 0u) { __builtin_amdgcn_s_sleep(2); fl = ld_relaxed(fp); }
                    __builtin_amdgcn_fence(__ATOMIC_ACQUIRE, "agent");
                    asm volatile("s_waitcnt vmcnt(0)" ::: "memory");
                    const int hl = cn % NHELP, n = cn / NHELP;
                    const unsigned char* g = a.ring + ((size_t)(bh * NHELP + hl) * RG + (n % RG)) * SLOT;
#pragma unroll
                    for (int i = 0; i < 15; ++i) { const int off = (i * 64 + lane) * 16; if (off < SLOT) v[i] = *(const u32x4*)(g + off); }
                }
                wg_bar(); wg_bar(); wg_bar(); wg_bar();
                nb += NPROD;
            }
        }
        for (; nb < NBAR; ++nb) wg_bar();
    }
}
__device__ __forceinline__ void helper(const Args& a, int bh, int hl, unsigned char* sm) {
    const int tid = tidx(), lane = tid & 63, w = __builtin_amdgcn_readfirstlane(tid >> 6);
    if (w >= 6) return;
    const int b = bh >> 3, h = bh & 7, col = h * 64 + lane;
    constexpr int NCH = T_ / 16;
    unsigned char* slot = sm + (size_t)w * SLOT; unsigned char* scr = sm + 6 * SLOT + w * SCR;
    const Chan ch{a.mu[col], a.mu[512 + col], a.mu[1024 + col], a.kk[col], a.ka[col], a.rk[col]};
    int n = w, c = NHELP * n + hl;
    if (c >= NCH) return;
    for (; c < NCH; n += 6, c += 6 * NHELP) {
        Raw q; fetch(a, b, h, c, lane, q);
        if (n >= RG) { const unsigned need = (unsigned)(c - RG * NHELP + 1);
            while (__builtin_amdgcn_readfirstlane(ld_relaxed(a.cons + bh * 64)) < need) __builtin_amdgcn_s_sleep(8); }
        produce<false>(a, ch, b, h, c, q, slot, scr, lane);
        asm volatile("s_waitcnt lgkmcnt(0)" ::: "memory");
        unsigned char* g = a.ring + ((size_t)(bh * NHELP + hl) * RG + (n % RG)) * SLOT;
#pragma unroll
        for (int i = 0; i < 15; ++i) { const int off = (i * 64 + lane) * 16;
            if (off < SLOT) { const u32x4 d = *(const u32x4*)(slot + off); unsigned char* gp = g + off; asm volatile("global_store_dwordx4 %0, %1, off sc1\n\ts_nop 1" :: "v"(gp), "v"(d) : "memory"); } }
        asm volatile("s_waitcnt vmcnt(0)" ::: "memory");
        if (lane == 0) __hip_atomic_store(a.flags + bh * NCH + c, 1u, __ATOMIC_RELAXED, __HIP_MEMORY_SCOPE_AGENT);
    }
}
__device__ __forceinline__ void finish(const float* yraw, const float* bonus, const bf16* vv, const bf16* agg, const float* mu, const float* gng, const float* gnb, bf16* amix) {
    const int T512 = tidx(), lane = T512 & 63;
    for (int it0 = (blockIdx.x * 8 + (T512 >> 6)) * 4; it0 < M_ * 8; it0 += gridDim.x * 8 * 4) {
        const int row = it0 >> 3, h0 = it0 & 7, t = row % T_;
        float y[4], v0[4], v1[4], gg[4], bo[4];
#pragma unroll
        for (int j = 0; j < 4; ++j) { const int col = (h0 + j) * 64 + lane;
            y[j] = yraw[(size_t)row * 512 + col]; v0[j] = bf2f(vv[(size_t)row * 512 + col]); v1[j] = t ? bf2f(vv[(size_t)(row - 1) * 512 + col]) : 0.f;
            gg[j] = bf2f(agg[(size_t)row * 512 + col]); bo[j] = bonus[(size_t)row * 8 + h0 + j]; }
        float mean[4], var[4];
#pragma unroll
        for (int j = 0; j < 4; ++j) mean[j] = y[j];
#pragma unroll
        for (int o = 1; o < 64; o <<= 1) {
#pragma unroll
            for (int j = 0; j < 4; ++j) mean[j] += __shfl_xor(mean[j], o); }
#pragma unroll
        for (int j = 0; j < 4; ++j) { mean[j] *= (1.f / 64.f); y[j] -= mean[j]; var[j] = y[j] * y[j]; }
#pragma unroll
        for (int o = 1; o < 64; o <<= 1) {
#pragma unroll
            for (int j = 0; j < 4; ++j) var[j] += __shfl_xor(var[j], o); }
#pragma unroll
        for (int j = 0; j < 4; ++j) { const int col = (h0 + j) * 64 + lane;
            const float yn = y[j] * rsqrtf(var[j] * (1.f / 64.f) + 64e-5f) * gng[col] + gnb[col];
            const float v = v0[j] + (v1[j] - v0[j]) * mu[1024 + col];
            amix[(size_t)row * DM + 512 + col] = (bf16)f2bf((yn + bo[j] * v) * gg[j]); }
    }
}
}

namespace mema {
using nsa::f32x16; using nsa::KROW; using nsa::VROW; using nsa::KBUF; using nsa::VBUF; using nsa::OFF_K; using nsa::OFF_V; using nsa::OFF_WS; using nsa::crow; using nsa::pack8;
__device__ __forceinline__ void unit(const bf16* qm, const bf16* mk, const bf16* mvt, bf16* om, int u, unsigned char* sm) {
    const int tid = tidx(), lane = tid & 63, w = __builtin_amdgcn_readfirstlane(tid >> 6), i = lane & 31, hi = lane >> 5;
    const int b = u >> 7, h = (u >> 5) & 3, rb = u & 31;
    const int row0 = b * T_ + rb * 256 + 32 * w;
    const bf16* qrow = qm + (size_t)(row0 + i) * DM + h * 256 + 8 * hi;
    const bf16* kbase = mk + (size_t)(b * 256 + (tid >> 3)) * DM + h * 256 + (tid & 7) * 8;
    const bf16* vbase = mvt + (size_t)(h * 256 + (tid >> 3)) * 512 + b * 256 + (tid & 7) * 8;
    unsigned char* kst = sm + OFF_K + (tid >> 3) * KROW + (tid & 7) * 16;
    unsigned char* vst = sm + OFF_V + (tid >> 3) * VROW + (tid & 7) * 16;
    float* wsc = (float*)(sm + OFF_WS) + w * 32;
    f32x16 p[4][2];
#pragma unroll
    for (int kt = 0; kt < 4; ++kt)
#pragma unroll
        for (int r = 0; r < 16; ++r) { p[kt][0][r] = 0.f; p[kt][1][r] = 0.f; }
    u32x4 tr[4];
#define MEMA_SRC(n) ((n) < 16 ? (const u32x4*)(kbase + (size_t)(64 * ((n) & 3)) * DM + 64 * ((n) >> 2)) : (const u32x4*)(vbase + (size_t)(64 * (((n) - 16) >> 2)) * 512 + 64 * ((n) & 3)))
#define MEMA_PUT(n) do { if ((n) < 16) *(u32x4*)(kst + ((n) & 1) * KBUF) = tr[(n) & 3]; else { unsigned char* vp2_ = vst + ((n) & 1) * VBUF; *(u32x2*)vp2_ = (u32x2){tr[(n) & 3].x, tr[(n) & 3].y}; *(u32x2*)(vp2_ + 8) = (u32x2){tr[(n) & 3].z, tr[(n) & 3].w}; } } while (0)
    tr[0] = *MEMA_SRC(0); tr[1] = *MEMA_SRC(1); tr[2] = *MEMA_SRC(2);
    MEMA_PUT(0);
    __syncthreads();
    bf16x8 qf[4];
#pragma unroll
    for (int n = 0; n < 16; ++n) {
        const int dc = n >> 2, kt = n & 3, cb = n & 1;
        tr[(n + 3) & 3] = *MEMA_SRC(n + 3);
        if (kt == 0) {
#pragma unroll
            for (int d0 = 0; d0 < 4; ++d0) qf[d0] = *(const bf16x8*)(qrow + 64 * dc + 16 * d0);
        }
        const unsigned char* kb = sm + OFF_K + cb * KBUF;
#pragma unroll
        for (int d0 = 0; d0 < 4; ++d0) {
            const bf16x8 a0 = *(const bf16x8*)(kb + i * KROW + (16 * d0 + 8 * hi) * 2);
            const bf16x8 a1 = *(const bf16x8*)(kb + (32 + i) * KROW + (16 * d0 + 8 * hi) * 2);
            p[kt][0] = __builtin_amdgcn_mfma_f32_32x32x16_bf16(a0, qf[d0], p[kt][0], 0, 0, 0);
            p[kt][1] = __builtin_amdgcn_mfma_f32_32x32x16_bf16(a1, qf[d0], p[kt][1], 0, 0, 0);
        }
        MEMA_PUT(n + 1);
        __syncthreads();
    }
    float mx = p[0][0][0];
#pragma unroll
    for (int kt = 0; kt < 4; ++kt)
#pragma unroll
        for (int r = 0; r < 16; ++r) mx = fmaxf(mx, fmaxf(p[kt][0][r], p[kt][1][r]));
    mx = fmaxf(mx, __shfl_xor(mx, 32));
    float l = 0.f;
#pragma unroll
    for (int kt = 0; kt < 4; ++kt)
#pragma unroll
        for (int r = 0; r < 16; ++r) { p[kt][0][r] = __builtin_amdgcn_exp2f(p[kt][0][r] - mx); p[kt][1][r] = __builtin_amdgcn_exp2f(p[kt][1][r] - mx); l += p[kt][0][r] + p[kt][1][r]; }
    l += __shfl_xor(l, 32);
    bf16x8 pf[4][4];
#pragma unroll
    for (int kt = 0; kt < 4; ++kt) { pf[kt][0] = pack8(p[kt][0], 0); pf[kt][1] = pack8(p[kt][0], 8); pf[kt][2] = pack8(p[kt][1], 0); pf[kt][3] = pack8(p[kt][1], 8); }
    if (hi == 0) wsc[i] = 1.f / l;
    asm volatile("" ::: "memory");
    f32x4 il[4];
#pragma unroll
    for (int rg = 0; rg < 4; ++rg) il[rg] = *(const f32x4*)(wsc + 8 * rg + 4 * hi);
    f32x16 o[2];
#pragma unroll
    for (int n = 16; n < 32; ++n) {
        const int dvt = (n - 16) >> 2, kt = n & 3, cb = n & 1;
        if (n + 3 < 32) tr[(n + 3) & 3] = *MEMA_SRC(n + 3);
        if (kt == 0) {
#pragma unroll
            for (int r = 0; r < 16; ++r) { o[0][r] = 0.f; o[1][r] = 0.f; }
        }
        const unsigned char* vb = sm + OFF_V + cb * VBUF;
#pragma unroll
        for (int dt = 0; dt < 2; ++dt) {
            const unsigned char* vp = vb + (32 * dt + i) * VROW + 8 * hi;
#pragma unroll
            for (int ks = 0; ks < 4; ++ks) {
                const u32x2 v_lo = *(const u32x2*)(vp + 32 * ks), v_hi = *(const u32x2*)(vp + 32 * ks + 16);
                const bf16x8 vf = __builtin_bit_cast(bf16x8, (u32x4){v_lo.x, v_lo.y, v_hi.x, v_hi.y});
                o[dt] = __builtin_amdgcn_mfma_f32_32x32x16_bf16(pf[kt][ks], vf, o[dt], 0, 0, 0);
            }
        }
        if (kt == 3) {
#pragma unroll
            for (int r = 0; r < 16; ++r) { bf16* op = om + (size_t)(row0 + crow(r, hi)) * DM + h * 256 + 64 * dvt + i;
                op[0] = (bf16)f2bf(o[0][r] * il[r >> 2][r & 3]); op[32] = (bf16)f2bf(o[1][r] * il[r >> 2][r & 3]); }
        }
        if (n + 1 < 32) MEMA_PUT(n + 1);
        __syncthreads();
    }
#undef MEMA_SRC
#undef MEMA_PUT
}
}

#define LAS __attribute__((address_space(3)))
#define XB_TMO      128
#define XB_XCNT(j)  (256  + 64 * (j))
#define XB_XSUB(j)  (1280 + 64 * (j))
#define XB_XGEN(j)  (2304 + 64 * (j))
#define XB_TOP      3328
#define XB_TOPGEN   3392
#define XCD_BAR_WORDS 3456
#define XB_SPIN_CAP (1u << 18)

__device__ __forceinline__ unsigned xb_ld(unsigned* p)              { return __hip_atomic_load(p, __ATOMIC_RELAXED, __HIP_MEMORY_SCOPE_AGENT); }
__device__ __forceinline__ unsigned xb_add(unsigned* p, unsigned v) { return __hip_atomic_fetch_add(p, v, __ATOMIC_RELAXED, __HIP_MEMORY_SCOPE_AGENT); }
__device__ __forceinline__ unsigned xb_xcc_id() { return (unsigned)__builtin_amdgcn_s_getreg((3 << 11) | 20) & 0xFu; }
#define XB_SPIN(cond, bar) do { unsigned _sp = 0; while (cond) { __builtin_amdgcn_s_sleep(1); \
    if ((++_sp & 255u) == 0u) { if (xb_ld(&(bar)[XB_TMO])) break; if (_sp > XB_SPIN_CAP) { atomicAdd(&(bar)[XB_TMO], 1u); break; } } } } while (0)

struct XcdBarrier {
    unsigned* bar; unsigned x;
    volatile LAS unsigned* st;
};

__device__ __forceinline__ XcdBarrier xcd_barrier_post(unsigned* bar, volatile LAS unsigned* st) {
    XcdBarrier b; b.bar = bar; b.x = xb_xcc_id(); b.st = st;
    if (tidx() == 0) (void)xb_add(&bar[XB_XCNT(b.x)], 1u);
    return b;
}
__device__ __forceinline__ void xcd_barrier_complete(unsigned* bar, unsigned x, unsigned& nloc, unsigned& nx) {
    const unsigned G = gridDim.x * gridDim.y * gridDim.z;
    unsigned sum, cnt, mine, sp = 0u;
    for (;;) {
        sum = 0u; cnt = 0u; mine = 0u;
#pragma unroll
        for (unsigned j = 0; j < 16; ++j) { const unsigned c = xb_ld(&bar[XB_XCNT(j)]); sum += c; cnt += (c > 0u) ? 1u : 0u; mine = (j == x) ? c : mine; }
        if (sum == G) break;
        __builtin_amdgcn_s_sleep(1);
        if ((++sp & 255u) == 0u) { if (xb_ld(&bar[XB_TMO])) break; if (sp > XB_SPIN_CAP) { atomicAdd(&bar[XB_TMO], 1u); break; } }
    }
    nloc = mine > 0u ? mine : 1u; nx = cnt > 0u ? cnt : 1u;
}

__device__ __forceinline__ void xcd_barrier(const XcdBarrier& b) {
    asm volatile("s_waitcnt vmcnt(0)" ::: "memory");
    __syncthreads();
    if (tidx() == 0) {
        unsigned* bar = b.bar;
        __builtin_amdgcn_s_waitcnt(0);
        unsigned nloc = b.st[0], nx = b.st[1];
        if (nloc == 0u) { xcd_barrier_complete(bar, b.x, nloc, nx); b.st[0] = nloc; b.st[1] = nx; }
        const unsigned old = xb_add(&bar[XB_XSUB(b.x)], 1u);
        const unsigned gen = old / nloc;
        if (old + 1u == (gen + 1u) * nloc) {
            __builtin_amdgcn_fence(__ATOMIC_RELEASE, "agent");
            asm volatile("s_waitcnt vmcnt(0)" ::: "memory");
            const unsigned og = xb_add(&bar[XB_TOP], 1u);
            const unsigned tg = og / nx;
            if (og + 1u == (tg + 1u) * nx) xb_add(&bar[XB_TOPGEN], 1u);
            else XB_SPIN(xb_ld(&bar[XB_TOPGEN]) == tg, bar);
            __builtin_amdgcn_fence(__ATOMIC_ACQUIRE, "agent");
            xb_add(&bar[XB_XGEN(b.x)], 1u);
            asm volatile("s_waitcnt vmcnt(0)" ::: "memory");
        } else {
            XB_SPIN(xb_ld(&bar[XB_XGEN(b.x)]) == gen, bar);
            __builtin_amdgcn_fence(__ATOMIC_ACQUIRE, "agent");
            asm volatile("s_waitcnt vmcnt(0)" ::: "memory");
        }
    }
    __syncthreads();
}

constexpr int NTHREADS = 512, LDS_BYTES = 147456;
struct MegaArgs { const float* in[41]; float* out; unsigned char* ws; };
#define WSB(off) ((bf16*)(ws + (off)))
#define WSF(off) ((float*)(ws + (off)))

__global__ void __launch_bounds__(NTHREADS) mega_fwd(MegaArgs A) {
    extern __shared__ __attribute__((aligned(16))) unsigned char lds[];
    cg::grid_group grid = cg::this_grid();
    const float* const* in = A.in; unsigned char* ws = A.ws; float* out = A.out;
    if (tidx() < 2) ((volatile LAS unsigned*)(lds + LDS_BYTES - 64))[tidx()] = 0u;
    __syncthreads();
    const XcdBarrier xbar = xcd_barrier_post((unsigned*)(ws + WS_CTL) + 16384, (volatile LAS unsigned*)(lds + LDS_BYTES - 64));

    d_convert(WSB(WS_W1GU), NGU, DM, MapGU{in[I_F1_WG], in[I_F1_WU], FF});
    d_convert(WSB(WS_W1D), DM, FF, MapPlain{in[I_F1_WD], DM});
    d_convert(WSB(WS_W2GU), NGU, DM, MapGU{in[I_F2_WG], in[I_F2_WU], FF});
    d_convert(WSB(WS_W2D), DM, FF, MapPlain{in[I_F2_WD], DM});
    d_convert(WSB(WS_WIN), NWIN, DM, MapWin{in[I_WIN], IN_COLS});
    d_convert(WSB(WS_WOUT), DM, DM, MapPlain{in[I_WOUT], DM});
    d_convert(WSB(WS_WQ), DM, DM, MapPlain{in[I_WQ], DM});
    d_convert(WSB(WS_WK), DM, DM, MapPlain{in[I_WK], DM});
    d_convert(WSB(WS_WV), DM, DM, MapPlain{in[I_WV], DM});
    d_convert(WSB(WS_WO), DM, DM, MapPlain{in[I_WO], DM});
    d_convert(WSB(WS_CW1K), 256, 2048, MapPlain{in[I_W1_K], 256});
    d_convert(WSB(WS_CW1V), 256, 2048, MapPlain{in[I_W1_V], 256});
    d_convert_lora(WSB(WS_WLORA), in[I_W2], in[I_A2], in[I_G2]);
    d_convert(WSB(WS_CW2), 64, 256, MapPlain{in[I_W2_K], 64});
    d_convert(WSB(WS_CW2) + 64 * 256, 64, 256, MapPlain{in[I_W2_V], 64});
    d_rope_table(WSF(WS_ROPE));
    d_cmp_bias(in[I_PE_K], in[I_W1_K], in[I_PE_V], in[I_W1_V], WSF(WS_CBIAS), (float*)lds);
    d_rownorm(in[I_X], in[I_F1_PRE], WSB(WS_XN), M_);
    d_rownorm(in[I_MEM], in[I_MEM_KVG], WSB(WS_MEMN), 512);
    grid.sync();
    gemm_pg8(lds, WSB(WS_XN), DM, WSB(WS_W1GU), DM, M_, NGU, DM, EpiSwiGLU{WSB(WS_HB)});
    xcd_barrier(xbar);
    gemm_norm_res(lds, WSB(WS_HB), FF, WSB(WS_W1D), FF, in[I_X], out, WSB(WS_XN), in[I_F1_POST], in[I_MIX_PRE], 0.5f, WSB(WS_YB), (unsigned*)(ws + WS_GATES), (unsigned*)(ws + WS_CTL) + 1024 + 0 * 2048);
    xcd_barrier(xbar);
    gemm_pg8(lds, WSB(WS_XN), DM, WSB(WS_WIN), DM, M_, 3072, DM,
             EpiWin{WSB(WS_QB), WSB(WS_KS), WSB(WS_KW), WSB(WS_KCR), WSB(WS_VCR), WSB(WS_VST), WSB(WS_VWT), (unsigned*)(ws + WS_RKVA), WSB(WS_RKVA + 32 * MiB), WSB(WS_PRL), WSF(WS_GATES), WSF(WS_ROPE)});
    d_gates(WSB(WS_XN), WSB(WS_WIN) + (size_t)3072 * DM, WSF(WS_GATES));
    xcd_barrier(xbar);
    gemm_pg8(lds, WSB(WS_KCR), 1024, WSB(WS_CW1K), 2048, 2048, 256, 2048, EpiBiasSilu{WSB(WS_HIDK), WSF(WS_CBIAS)});
    gemm_pg8(lds, WSB(WS_VCR), 1024, WSB(WS_CW1V), 2048, 2048, 256, 2048, EpiBiasSilu{WSB(WS_HIDV), WSF(WS_CBIAS) + 256}, 8);
    d_lora_prep(WSB(WS_PRL), in[I_MU], WSB(WS_XN));
    xcd_barrier(xbar);
    d_cmp2(WSB(WS_HIDK), WSB(WS_HIDV), WSB(WS_CW2), WSF(WS_ROPE), WSB(WS_KC), WSB(WS_VCT));
    gemm_pg8(lds, WSB(WS_XN), KLORA, WSB(WS_WLORA), KLORA, M_, NLORA, KLORA, EpiLora{WSF(WS_YB), WSB(WS_RKVA + 48 * MiB), WSB(WS_AGG), in[I_W0], in[I_A0]});
    gemm_pg8(lds, WSB(WS_MEMN), DM, WSB(WS_WK), DM, 512, DM, DM, EpiStore{WSB(WS_CW1K), DM, 1.f});
    gemm_pg8(lds, WSB(WS_WV), DM, WSB(WS_MEMN), DM, DM, 512, DM, EpiStore{WSB(WS_CW1V), 512, 1.f});
    xcd_barrier(xbar);
    if (blockIdx.x < 16 * (1 + rw7::NHELP)) {
        const rw7::Args ra{(const unsigned*)(ws + WS_RKVA), WSB(WS_RKVA + 32 * MiB), WSB(WS_RKVA + 48 * MiB), WSF(WS_YB), in[I_MU], in[I_KK], in[I_KA], in[I_RK], WSF(WS_YB), WSF(WS_BONUS),
                           ws + WS_KCR + 1 * MiB, (unsigned*)(ws + WS_CTL) + 32768, (unsigned*)(ws + WS_CTL) + 24576};
        if (blockIdx.x < 16) rw7::head(ra, blockIdx.x, lds);
        else rw7::helper(ra, (blockIdx.x - 16) % 16, (blockIdx.x - 16) / 16, lds);
        __syncthreads();
    }
    {
        const NsaArgs na{WSB(WS_QB), WSB(WS_KC), WSB(WS_VCT), WSB(WS_KS), WSB(WS_VST), WSB(WS_KW), WSB(WS_VWT), WSF(WS_GATES), WSB(WS_XN)};
        nsa::phase(na, (unsigned*)(ws + WS_CTL), lds);
    }
    xcd_barrier(xbar);
    d_nsa_outnorm(WSB(WS_XN), in[I_NSA_G]);
    rw7::finish(WSF(WS_YB), WSF(WS_BONUS), WSB(WS_RKVA + 32 * MiB), WSB(WS_AGG), in[I_MU], in[I_GNG], in[I_GNB], WSB(WS_XN));
    xcd_barrier(xbar);
    gemm_norm_res(lds, WSB(WS_XN), DM, WSB(WS_WOUT), DM, out, out, WSB(WS_XN), in[I_MIX_POST], in[I_MEM_PRE], 1.0f, WSB(WS_YB), (unsigned*)(ws + WS_GATES), (unsigned*)(ws + WS_CTL) + 1024 + 1 * 2048);
    xcd_barrier(xbar);
    gemm_pg8(lds, WSB(WS_XN), DM, WSB(WS_WQ), DM, M_, DM, DM, EpiStore{WSB(WS_QM), DM, MSCALE});
    xcd_barrier(xbar);
    for (int u = blockIdx.x; u < 256; u += gridDim.x) mema::unit(WSB(WS_QM), WSB(WS_CW1K), WSB(WS_CW1V), WSB(WS_OM), u, lds);
    xcd_barrier(xbar);
    gemm_norm_res(lds, WSB(WS_OM), DM, WSB(WS_WO), DM, out, out, WSB(WS_XN), in[I_MEM_POST], in[I_F2_PRE], 1.0f, WSB(WS_YB), (unsigned*)(ws + WS_GATES), (unsigned*)(ws + WS_CTL) + 1024 + 2 * 2048);
    xcd_barrier(xbar);
    gemm_pg8(lds, WSB(WS_XN), DM, WSB(WS_W2GU), DM, M_, NGU, DM, EpiSwiGLU{WSB(WS_HB)});
    xcd_barrier(xbar);
    gemm_norm_res(lds, WSB(WS_HB), FF, WSB(WS_W2D), FF, out, out, (bf16*)nullptr, in[I_F2_POST], (const float*)nullptr, 0.5f, WSB(WS_YB), (unsigned*)(ws + WS_GATES), (unsigned*)(ws + WS_CTL) + 1024 + 3 * 2048);
}

extern "C" void kernel_launch(void* const* d_in, const int* in_sizes, int n_in, void* d_out, int out_size, void* d_ws, size_t ws_size, hipStream_t stream) {
    static int grid = 0;
    if (grid == 0) {
        if (n_in != 41 || ws_size < WS_END) { fprintf(stderr, "kernel_launch: unexpected n_in %d / ws %zu\n", n_in, ws_size); grid = -1; return; }
        int dev = 0, cus = 0, per_cu = 0;
        hipGetDevice(&dev); hipDeviceGetAttribute(&cus, hipDeviceAttributeMultiprocessorCount, dev);
        if (hipFuncSetAttribute((const void*)mega_fwd, hipFuncAttributeMaxDynamicSharedMemorySize, LDS_BYTES) != hipSuccess) { fprintf(stderr, "kernel_launch: hipFuncSetAttribute failed\n"); grid = -1; return; }
        if (hipOccupancyMaxActiveBlocksPerMultiprocessor(&per_cu, (const void*)mega_fwd, NTHREADS, LDS_BYTES) != hipSuccess || per_cu < 1) { fprintf(stderr, "kernel_launch: occupancy query says %d\n", per_cu); grid = -1; (void)hipGetLastError(); return; }
        grid = cus;
        if (grid != 256) { fprintf(stderr, "kernel_launch: built for 256 CUs (one 256x256 tile per workgroup in the fused norm epilogues), found %d\n", cus); grid = -1; return; }
    }
    if (grid < 0) return;
    MegaArgs a{};
    for (int i = 0; i < 41; ++i) a.in[i] = (const float*)d_in[i];
    a.out = (float*)d_out; a.ws = (unsigned char*)d_ws;
    hipMemsetAsync(d_ws, 0, 196608, stream);
    void* args[] = {&a};
    hipError_t e = hipLaunchCooperativeKernel((const void*)mega_fwd, dim3(grid), dim3(NTHREADS), args, LDS_BYTES, stream);
    if (e != hipSuccess) fprintf(stderr, "kernel_launch: cooperative launch failed: %s (grid %d)\n", hipGetErrorString(e), grid);
}
```

```cpp
#include <hip/hip_runtime.h>
#include <hip/hip_cooperative_groups.h>
#include <cstdint>
#include <cstdio>

constexpr int NB = 2, T_ = 8192, DM = 1024, M_ = NB * T_;
constexpr int FF = 2816, NGU = 2 * FF;
constexpr int IN_COLS = 3096, NWIN = 3328;
constexpr int NRW = 1792;
constexpr int NCP = 512;
constexpr int NLORA = 1536, KLORA = 256;
constexpr float NORM_EPS = 1e-6f;
constexpr float QSCALE = 0.125f * 1.4426950408889634f;
constexpr float MSCALE = 0.0625f * 1.4426950408889634f;

typedef unsigned short bf16;
typedef short bf16x8 __attribute__((ext_vector_type(8)));
typedef float f32x4 __attribute__((ext_vector_type(4)));
typedef unsigned u32x2 __attribute__((ext_vector_type(2)));
typedef unsigned u32x4 __attribute__((ext_vector_type(4)));

__device__ __forceinline__ unsigned f2bf(float f) { unsigned u = __builtin_bit_cast(unsigned, f); return (u + 0x7fffu + ((u >> 16) & 1u)) >> 16; }
__device__ __forceinline__ float bf2f(bf16 h) { return __builtin_bit_cast(float, (unsigned)h << 16); }
typedef float f32x2_t __attribute__((ext_vector_type(2))); typedef __bf16 bf16x2_t __attribute__((ext_vector_type(2)));
__device__ __forceinline__ unsigned pk2(float lo, float hi) { const f32x2_t v = {lo, hi}; return __builtin_bit_cast(unsigned, __builtin_convertvector(v, bf16x2_t)); }
__device__ __forceinline__ void st_bf4(bf16* p, f32x4 v) { u32x2 w; w.x = pk2(v[0], v[1]); w.y = pk2(v[2], v[3]); *(u32x2*)p = w; }
__device__ __forceinline__ float wave_sum(float v) {
#pragma unroll
    for (int o = 1; o < 64; o <<= 1) v += __shfl_xor(v, o);
    return v;
}
__device__ __forceinline__ float wave_max(float v) {
#pragma unroll
    for (int o = 1; o < 64; o <<= 1) v = fmaxf(v, __shfl_xor(v, o));
    return v;
}
__device__ __forceinline__ float sigmoidf_(float x) { return 1.f / (1.f + __expf(-x)); }
__device__ __forceinline__ int tidx() { int t = threadIdx.x; asm volatile("" : "+v"(t)); return t; }

constexpr size_t MiB = 1u << 20, KiB64 = 65536;
constexpr size_t WS_CTL = 0;
constexpr size_t WS_KC = 256 * 1024;
constexpr size_t WS_VCT = 512 * 1024;
constexpr size_t WS_CW2 = 768 * 1024;
constexpr size_t WS_W1GU = 1 * MiB;
constexpr size_t WS_W1D = 12 * MiB;
constexpr size_t WS_W2GU = WS_W1D + 88 * KiB64;
constexpr size_t WS_W2D = WS_W2GU + 11 * MiB;
constexpr size_t WS_WIN = WS_W2D + 88 * KiB64;
constexpr size_t WS_WOUT = WS_WIN + 104 * KiB64;
constexpr size_t WS_WQ = WS_WOUT + 2 * MiB, WS_WK = WS_WQ + 2 * MiB, WS_WV = WS_WK + 2 * MiB, WS_WO = WS_WV + 2 * MiB;
constexpr size_t WS_CW1K = WS_WO + 2 * MiB, WS_CW1V = WS_CW1K + 1 * MiB;
constexpr size_t WS_WLORA = WS_CW1V + 1 * MiB;
constexpr size_t WS_ROPE = WS_WLORA + 12 * KiB64;
constexpr size_t WS_CBIAS = WS_ROPE + 2 * MiB;
constexpr size_t WS_MEMN = WS_CBIAS + KiB64;
constexpr size_t WS_HIDK = WS_MEMN + 1 * MiB;
constexpr size_t WS_HIDV = WS_HIDK + 1 * MiB;
constexpr size_t WS_GATES = WS_HIDV + 1 * MiB;
constexpr size_t WS_XN = 60 * MiB;
constexpr size_t WS_YB = 92 * MiB;
constexpr size_t WS_D = 124 * MiB;
constexpr size_t WS_HB = WS_D;
constexpr size_t WS_QB = WS_D;
constexpr size_t WS_KS = WS_D + 16 * MiB;
constexpr size_t WS_KW = WS_D + 20 * MiB;
constexpr size_t WS_KCR = WS_D + 24 * MiB;
constexpr size_t WS_VCR = WS_D + 29 * MiB;
constexpr size_t WS_VST = WS_D + 34 * MiB;
constexpr size_t WS_VWT = WS_D + 38 * MiB;
constexpr size_t WS_RKVA = WS_D + 42 * MiB;
constexpr size_t WS_PRL = WS_D + 106 * MiB;
constexpr size_t WS_AGG = WS_D + 114 * MiB;
constexpr size_t WS_BONUS = WS_KCR;
constexpr size_t WS_END = 256 * MiB;
constexpr size_t WS_QM = WS_D;
constexpr size_t WS_OM = WS_D + 32 * MiB;
constexpr size_t WS_MK = WS_D + 64 * MiB;
constexpr size_t WS_MVT = WS_D + 65 * MiB;
static_assert(WS_GATES + (size_t)M_ * 24 * 4 <= WS_XN, "ws map");
static_assert(WS_AGG + 16 * MiB <= WS_END, "ws map");

struct Params {
    const float* in[41];
    float* out;
    unsigned char* ws;
};
enum { I_X = 0, I_MEM, I_F1_PRE, I_F1_WG, I_F1_WU, I_F1_WD, I_F1_POST, I_MIX_PRE, I_WIN, I_PE_K, I_W1_K, I_W2_K, I_PE_V, I_W1_V, I_W2_V,
       I_NSA_G, I_MU, I_W0, I_W2, I_A0, I_A2, I_G2, I_KK, I_KA, I_RK, I_GNG, I_GNB, I_WOUT, I_MIX_POST, I_MEM_PRE, I_MEM_KVG, I_WQ, I_WK, I_WV,
       I_WO, I_MEM_POST, I_F2_PRE, I_F2_WG, I_F2_WU, I_F2_WD, I_F2_POST };

struct MapPlain { const float* W; int N; int pad; __device__ const float* col(int p) const { return W + p; } };
struct MapGU {
    const float* Wg; const float* Wu; int N; int pad;
    __device__ const float* col(int p) const {
        const int pn = p >> 8, q = p & 255, n = (q >> 4) & 1;
        const int hid = 128 * pn + 64 * (q >> 7) + 16 * ((q >> 5) & 3) + (q & 15);
        return Wg + (size_t)n * (size_t)(Wu - Wg) + hid;
    }
};
__host__ __device__ inline int rope_perm(int x) { return 16 * ((x >> 5) & 1) + (x & 15) + 32 * ((x >> 4) & 1); }
struct MapWin {
    const float* W; int N; int pad;
    __device__ const float* col(int p) const {
        int l;
        if (p < 512) l = (p & ~63) + rope_perm(p & 63);
        else if (p < 640) l = 768 + ((p - 512) & ~63) + rope_perm(p & 63);
        else if (p < 768) l = 1024 + ((p - 640) & ~63) + rope_perm(p & 63);
        else if (p < 896) l = 512 + (p - 768);
        else if (p < 1024) l = 640 + (p - 896);
        else if (p < 1152) l = 896 + (p - 1024);
        else if (p < 1280) l = 1152 + (p - 1152);
        else if (p < 2304) { const int q = p - 1280; l = 1304 + (((q >> 4) & 1) ? 512 : 0) + 16 * (q >> 5) + (q & 15); }
        else if (p < 3072) l = 1304 + (p - 1280);
        else if (p < 3096) l = 1280 + (p - 3072);
        else return nullptr;
        return W + l;
    }
};

#define FOR_VB(vb, n) for (int vb = (int)blockIdx.x * 2 + (T512 >> 8); vb < (n); vb += (int)gridDim.x * 2)

template <class Map> __device__ __forceinline__ void d_convert(bf16* WT, int Np, int K, Map map) {
    const int T512 = tidx(), tid = T512 & 255, nbx = Np / 64, nb = nbx * (K / 64);
    for (int vb0 = (int)blockIdx.x * 2 + (T512 >> 8); vb0 < nb; vb0 += (int)gridDim.x * 4) {
        const int vb1 = vb0 + (int)gridDim.x * 2; const bool two = vb1 < nb;
        const int p0 = (vb0 % nbx) * 64 + (tid & 63), k0 = (vb0 / nbx) * 64 + (tid >> 6) * 16;
        const int p1 = two ? (vb1 % nbx) * 64 + (tid & 63) : p0, k1 = two ? (vb1 / nbx) * 64 + (tid >> 6) * 16 : k0;
        const float* s0 = map.col(p0); const float* s1 = map.col(p1);
        float v[16], u[16];
#pragma unroll
        for (int i = 0; i < 16; ++i) { v[i] = s0 ? s0[(size_t)(k0 + i) * map.N] : 0.f; u[i] = s1 ? s1[(size_t)(k1 + i) * map.N] : 0.f; }
        u32x4 a, b;
        a.x = pk2(v[0], v[1]); a.y = pk2(v[2], v[3]); a.z = pk2(v[4], v[5]); a.w = pk2(v[6], v[7]);
        b.x = pk2(v[8], v[9]); b.y = pk2(v[10], v[11]); b.z = pk2(v[12], v[13]); b.w = pk2(v[14], v[15]);
        u32x4* d0 = (u32x4*)(WT + (size_t)p0 * K + k0); d0[0] = a; d0[1] = b;
        if (two) {
            a.x = pk2(u[0], u[1]); a.y = pk2(u[2], u[3]); a.z = pk2(u[4], u[5]); a.w = pk2(u[6], u[7]);
            b.x = pk2(u[8], u[9]); b.y = pk2(u[10], u[11]); b.z = pk2(u[12], u[13]); b.w = pk2(u[14], u[15]);
            u32x4* d1 = (u32x4*)(WT + (size_t)p1 * K + k1); d1[0] = a; d1[1] = b;
        }
    }
}
__device__ __forceinline__ void d_convert_lora(bf16* WT, const float* w2, const float* a2, const float* g2) {
    const int T512 = tidx(), tid = T512 & 255;
    FOR_VB(vb, NLORA * KLORA / 256) {
        const int idx = vb * 256 + tid, p = idx >> 8, k = idx & 255;
        float v = 0.f;
        if (p < 512) { if (k < 64) v = w2[k * 512 + p]; }
        else if (p < 1024) { if (k >= 64 && k < 128) v = a2[(k - 64) * 512 + (p - 512)]; }
        else { if (k >= 128) v = g2[(k - 128) * 512 + (p - 1024)]; }
        WT[idx] = (bf16)f2bf(v);
    }
}
__device__ __forceinline__ void d_rope_table(float* tab) {
    const int T512 = tidx(), tid = T512 & 255;
    FOR_VB(vb, T_ * 32 / 256) {
        const int idx = vb * 256 + tid, pos = idx >> 5, i = idx & 31;
        const float inv = (float)pow(10000.0, -(double)i / 32.0);
        const float ang = (float)pos * inv;
        tab[2 * idx] = (float)cos((double)ang); tab[2 * idx + 1] = (float)sin((double)ang);
    }
}
__device__ __forceinline__ void d_cmp_bias(const float* pe_k, const float* w1_k, const float* pe_v, const float* w1_v, float* part, float* red  ) {
    for (int job = blockIdx.x; job < 64; job += gridDim.x) {
        const int kv = job >> 5, cg_ = (job >> 3) & 3, jc = job & 7; const float* pe = kv ? pe_v : pe_k; const float* w1 = kv ? w1_v : w1_k;
        const int T512 = tidx(), lane = T512 & 63, w = T512 >> 6, n = cg_ * 64 + lane;
        float s = 0.f;
#pragma unroll 8
        for (int j = jc * 256 + w * 32; j < jc * 256 + w * 32 + 32; ++j) s += pe[j] * w1[(size_t)j * 256 + n];
        red[w * 64 + lane] = s; __syncthreads();
        if (w == 0) { float t = 0.f; for (int i = 0; i < 8; ++i) t += red[i * 64 + lane]; part[(jc * 2 + kv) * 256 + n] = t; }
        __syncthreads();
    }
}
__device__ __forceinline__ void d_rownorm(const float* x, const float* g, bf16* xn, int rows) {
    const int T512 = tidx(), tid = T512 & 255, lane = tid & 63;
    FOR_VB(vb, rows / 4) {
        const int row = vb * 4 + (tid >> 6);
        const f32x4* xr = (const f32x4*)(x + (size_t)row * DM) + lane; f32x4 v[4]; float s = 0.f;
#pragma unroll
        for (int j = 0; j < 4; ++j) { v[j] = xr[64 * j]; s += v[j][0] * v[j][0] + v[j][1] * v[j][1] + v[j][2] * v[j][2] + v[j][3] * v[j][3]; }
        const float rstd = rsqrtf(wave_sum(s) * (1.f / DM) + NORM_EPS);
#pragma unroll
        for (int j = 0; j < 4; ++j) { const f32x4 gg = ((const f32x4*)g)[lane + 64 * j]; st_bf4(xn + (size_t)row * DM + 4 * (lane + 64 * j), v[j] * rstd * gg); }
    }
}
__device__ __forceinline__ void d_rowpass(const float* xin, const bf16* y, const float* gpost, float coef, const float* gpre, float* xout, bf16* xn) {
    const int T512 = tidx(), tid = T512 & 255, lane = tid & 63;
    FOR_VB(vb, M_ / 4) {
        const int row = vb * 4 + (tid >> 6);
        f32x4 yv[4], xv[4]; float s = 0.f;
#pragma unroll
        for (int j = 0; j < 4; ++j) {
            const u32x2 w = *(const u32x2*)(y + (size_t)row * DM + 4 * (lane + 64 * j));
            yv[j][0] = __builtin_bit_cast(float, w.x << 16); yv[j][1] = __builtin_bit_cast(float, w.x & 0xffff0000u);
            yv[j][2] = __builtin_bit_cast(float, w.y << 16); yv[j][3] = __builtin_bit_cast(float, w.y & 0xffff0000u);
            s += yv[j][0] * yv[j][0] + yv[j][1] * yv[j][1] + yv[j][2] * yv[j][2] + yv[j][3] * yv[j][3];
            xv[j] = ((const f32x4*)(xin + (size_t)row * DM))[lane + 64 * j];
        }
        const float rstd = rsqrtf(wave_sum(s) * (1.f / DM) + NORM_EPS) * coef; float s2 = 0.f;
#pragma unroll
        for (int j = 0; j < 4; ++j) { const f32x4 gg = ((const f32x4*)gpost)[lane + 64 * j]; xv[j] = xv[j] + yv[j] * rstd * gg;
            s2 += xv[j][0] * xv[j][0] + xv[j][1] * xv[j][1] + xv[j][2] * xv[j][2] + xv[j][3] * xv[j][3];
            ((f32x4*)(xout + (size_t)row * DM))[lane + 64 * j] = xv[j]; }
        if (gpre) {
            const float r2 = rsqrtf(wave_sum(s2) * (1.f / DM) + NORM_EPS);
#pragma unroll
            for (int j = 0; j < 4; ++j) { const f32x4 gg = ((const f32x4*)gpre)[lane + 64 * j]; st_bf4(xn + (size_t)row * DM + 4 * (lane + 64 * j), xv[j] * r2 * gg); }
        }
    }
}
__device__ __forceinline__ void d_nsa_outnorm(bf16* amix, const float* g) {
    const int T512 = tidx(), tid = T512 & 255, lane = tid & 63;
    FOR_VB(vb, M_ / 4) {
        const int row = vb * 4 + (tid >> 6);
        bf16* p = amix + (size_t)row * DM + 8 * lane;
        const u32x4 w = *(const u32x4*)p; float v[8]; float s = 0.f;
        v[0] = __builtin_bit_cast(float, w.x << 16); v[1] = __builtin_bit_cast(float, w.x & 0xffff0000u);
        v[2] = __builtin_bit_cast(float, w.y << 16); v[3] = __builtin_bit_cast(float, w.y & 0xffff0000u);
        v[4] = __builtin_bit_cast(float, w.z << 16); v[5] = __builtin_bit_cast(float, w.z & 0xffff0000u);
        v[6] = __builtin_bit_cast(float, w.w << 16); v[7] = __builtin_bit_cast(float, w.w & 0xffff0000u);
#pragma unroll
        for (int i = 0; i < 8; ++i) s += v[i] * v[i];
        const float rstd = rsqrtf(wave_sum(s) * (1.f / 512.f) + NORM_EPS);
        u32x4 o; const float* gg = g + 8 * lane;
        o.x = pk2(v[0] * rstd * gg[0], v[1] * rstd * gg[1]); o.y = pk2(v[2] * rstd * gg[2], v[3] * rstd * gg[3]);
        o.z = pk2(v[4] * rstd * gg[4], v[5] * rstd * gg[5]); o.w = pk2(v[6] * rstd * gg[6], v[7] * rstd * gg[7]);
        *(u32x4*)p = o;
    }
}

struct EpiStore { bf16* O; int ldc; float scale;
    static constexpr int NCAT = 1;
    __device__ __forceinline__ int cat(int) const { return 0; }
    template <int C> __device__ __forceinline__ void apply(int row, int p, f32x4 v0, f32x4 v1) const { bf16* o = O + (size_t)row * ldc + p; st_bf4(o, v0 * scale); st_bf4(o + 16, v1 * scale); } };
struct EpiSwiGLU { bf16* H;
    static constexpr int NCAT = 1;
    __device__ __forceinline__ int cat(int) const { return 0; }
    template <int C> __device__ __forceinline__ void apply(int row, int p, f32x4 g, f32x4 u) const {
        const int q = p & 255, hid = 128 * (p >> 8) + 64 * (q >> 7) + 16 * ((q >> 5) & 3) + (q & 15);
        f32x4 h;
#pragma unroll
        for (int e = 0; e < 4; ++e) h[e] = g[e] / (1.f + __expf(-g[e])) * u[e];
        st_bf4(H + (size_t)row * FF + hid, h); } };
struct EpiBiasSilu { bf16* O; const float* bias;
    static constexpr int NCAT = 1;
    __device__ __forceinline__ int cat(int) const { return 0; }
    template <int C> __device__ __forceinline__ void apply(int row, int p, f32x4 v0, f32x4 v1) const {
        f32x4 a, b; f32x4 b0 = {0.f, 0.f, 0.f, 0.f}, b1 = {0.f, 0.f, 0.f, 0.f};
#pragma unroll
        for (int jc = 0; jc < 8; ++jc) { b0 += *(const f32x4*)(bias + jc * 512 + p); b1 += *(const f32x4*)(bias + jc * 512 + p + 16); }
#pragma unroll
        for (int e = 0; e < 4; ++e) { const float x0 = v0[e] + b0[e], x1 = v1[e] + b1[e]; a[e] = x0 / (1.f + __expf(-x0)); b[e] = x1 / (1.f + __expf(-x1)); }
        bf16* o = O + (size_t)row * 256 + p; st_bf4(o, a); st_bf4(o + 16, b); } };
struct EpiLora { float* wdec; bf16* aga; bf16* agg; const float* w0; const float* a0;
    static constexpr int NCAT = 3;
    __device__ __forceinline__ int cat(int p0) const { return p0 < 512 ? 0 : (p0 < 1024 ? 1 : 2); }
    template <int C> __device__ __forceinline__ void one(int row, int p, f32x4 v) const {
        if (C == 0) { f32x4 o; const f32x4 ww = *(const f32x4*)(w0 + p);
#pragma unroll
            for (int e = 0; e < 4; ++e) o[e] = __expf(-0.6065306597126334f * sigmoidf_(ww[e] + v[e]));
            *(f32x4*)(wdec + (size_t)row * 512 + p) = o;
        } else if (C == 1) { f32x4 o; const f32x4 aa = *(const f32x4*)(a0 + p - 512);
#pragma unroll
            for (int e = 0; e < 4; ++e) o[e] = sigmoidf_(aa[e] + v[e]);
            st_bf4(aga + (size_t)row * 512 + (p - 512), o);
        } else st_bf4(agg + (size_t)row * 512 + (p - 1024), v);
    }
    template <int C> __device__ __forceinline__ void apply(int row, int p, f32x4 v0, f32x4 v1) const { one<C>(row, p, v0); one<C>(row, p + 16, v1); } };
struct EpiWin {
    bf16 *qb, *ks, *kw, *kcr, *vcr, *vst, *vwt; unsigned* rk; bf16 *vv, *prl; float* gates; const float* rope;
    static constexpr int NCAT = 8;
    __device__ __forceinline__ int cat(int p0) const { return p0 < 512 ? 0 : (p0 < 768 ? 1 : (p0 < 1024 ? 2 : (p0 < 1280 ? 3 : (p0 < 2304 ? 4 : (p0 < 2816 ? 7 : (p0 < 3072 ? 6 : 5)))))); }
    template <int C> __device__ __forceinline__ void apply(int row, int p, f32x4 v0, f32x4 v1) const {
        const int b = row / T_, t = row % T_;
        if (C == 0 || C == 1) {
            const int x = p & 63, d = 16 * ((x >> 5) & 1) + (x & 15);
            const f32x4* rp = (const f32x4*)(rope + ((size_t)t * 32 + d) * 2); const f32x4 r0 = rp[0], r1 = rp[1];
            const f32x4 cs = {r0[0], r0[2], r1[0], r1[2]}, sn = {r0[1], r0[3], r1[1], r1[3]};
            const f32x4 lo = v0 * cs - v1 * sn, hi = v0 * sn + v1 * cs;
            if (C == 0) { bf16* o = qb + (size_t)row * 512 + (p & ~63) + d; st_bf4(o, lo * QSCALE); st_bf4(o + 32, hi * QSCALE); }
            else { const int g = ((p - 512) >> 6) & 1; bf16* base = (p < 640) ? ks : kw; bf16* o = base + ((size_t)(b * 2 + g) * T_ + t) * 64 + d; st_bf4(o, lo); st_bf4(o + 32, hi); }
        } else if (C == 2) {
            const int c = (p - 768) & 127, g = c >> 6, d = c & 63; bf16* base = (p < 896) ? kcr : vcr;
            bf16* o = base + ((size_t)(b * 2 + g) * T_ + t) * 64 + d; st_bf4(o, v0); st_bf4(o + 16, v1);
        } else if (C == 3) {
            const int c = (p - 1024) & 127, g = c >> 6, d = c & 63; bf16* base = (p < 1152) ? vst : vwt;
            bf16* o = base + ((size_t)(b * 2 + g) * 64 + d) * T_ + t;
#pragma unroll
            for (int e = 0; e < 4; ++e) { o[(size_t)e * T_] = (bf16)f2bf(v0[e]); o[(size_t)(16 + e) * T_] = (bf16)f2bf(v1[e]); }
        } else if (C == 4) {
            const int q = p - 1280, ch = 16 * (q >> 5) + (q & 15);
            u32x4 w; w.x = pk2(v0[0], v1[0]); w.y = pk2(v0[1], v1[1]); w.z = pk2(v0[2], v1[2]); w.w = pk2(v0[3], v1[3]);
            *(u32x4*)(rk + (size_t)row * 512 + ch) = w;
        } else if (C == 7) {
            bf16* o = vv + (size_t)row * 512 + (p - 2304); st_bf4(o, v0); st_bf4(o + 16, v1);
        } else if (C == 6) {
            bf16* o = prl + (size_t)row * 256 + (p - 2816); st_bf4(o, v0); st_bf4(o + 16, v1);
        } else {
            const int c = p - 3072; float* o = gates + (size_t)row * 24 + c;
            if (c < 24) { f32x4 s = {sigmoidf_(v0[0]), sigmoidf_(v0[1]), sigmoidf_(v0[2]), sigmoidf_(v0[3])}; *(f32x4*)o = s; }
            if (c + 16 < 24) { f32x4 s = {sigmoidf_(v1[0]), sigmoidf_(v1[1]), sigmoidf_(v1[2]), sigmoidf_(v1[3])}; *(f32x4*)(o + 16) = s; }
        }
    }
};

namespace pg8 {
#define PG8_LAS __attribute__((address_space(3)))
typedef unsigned short bf16_t;
typedef short bf16x8 __attribute__((ext_vector_type(8)));
typedef float f32x4 __attribute__((ext_vector_type(4)));
typedef unsigned u32x4 __attribute__((ext_vector_type(4)));
constexpr int BM = 256, BK = 64, HALF = 128, HTB = HALF * BK * 2  , STAGE_BYTES = 8 * HTB, NXCD = 8, WGM = 8;

__host__ __device__ __forceinline__ int lds_byte(int r, int c) { const int st = (r >> 4) * 2 + (c >> 5), rr = r & 15, cc = c & 31, ob = rr * 64 + cc * 2; return st * 1024 + (ob ^ (((ob >> 9) & 1) << 5)); }
__host__ __device__ __forceinline__ void stage_rc(int b, int& R, int& C) { const int st = b / 1024, sb = b % 1024, swz = sb ^ (((sb >> 9) & 1) << 5); R = (st >> 1) * 16 + swz / 64; C = (st & 1) * 32 + (swz % 64) / 2; }
__host__ __device__ __forceinline__ int perm32(int rho) { const int n = rho >> 4, i = rho & 15; return 8 * (i >> 2) + 4 * n + (i & 3); }

struct Unit { int pm, pn; };
struct Gemm { const bf16_t* A; const bf16_t* Bt; int M, N, K, lda, ldb; };

struct StaticOrder {
    int nM, nN, nwg, G, c;
    __host__ __device__ void init(int M, int N, int G_, int c_) { nM = M / BM; nN = N / BM; nwg = nM * nN; G = G_; c = c_; }
    __host__ __device__ bool next(int i, Unit& u) const {
        const long L = (long)i * G + c; if (L >= nwg) return false;
        int wgid = (int)L; { const int q = nwg / NXCD, r = nwg % NXCD, xcd = wgid % NXCD, off = wgid / NXCD; wgid = (xcd < r ? xcd * (q + 1) : r * (q + 1) + (xcd - r) * q) + off; }
        const int nig = WGM * nN, gid = wgid / nig, fm = gid * WGM, gsz = (nM - fm) < WGM ? (nM - fm) : WGM;
        u.pm = fm + ((wgid % nig) % gsz); u.pn = (wgid % nig) / gsz; return true;
    }
    __device__ __forceinline__ void a_ready(const Unit&) const {}
    __device__ __forceinline__ void done(const Unit&) const {}
};

template <class Epi, class Sched, bool ALIGN_EPI = false, bool SP2 = false>
__device__ __forceinline__ void gemm_phase(PG8_LAS unsigned char* lds, const Gemm g, const Sched& S, const Epi& E) {
    const int tid = tidx(), wid = __builtin_amdgcn_readfirstlane(tid >> 6), lane = tid & 63, wr = wid >> 2, wc = wid & 3, fr = lane & 15, fq = lane >> 4;
    const int K = g.K, nt = K / BK;
    unsigned voffA[2], voffB[2];
#pragma unroll
    for (int i = 0; i < 2; ++i) { int R, C; stage_rc(tid * 16 + i * 8192, R, C); const int Rb = Epi::PERM ? ((R & ~31) + perm32(R & 31)) : R;
        voffA[i] = (unsigned)(R * g.lda + C) * 2u; voffB[i] = (unsigned)(Rb * g.ldb + C) * 2u; }
    const size_t kstep = (size_t)(BK * 2);
    const size_t hstepA = (size_t)HALF * g.lda * 2, hstepB = (size_t)HALF * g.ldb * 2;
    const size_t tstepA = 2 * hstepA, tstepB = 2 * hstepB;
    const unsigned ldsw = (unsigned)wid * 1024u;
    const int aoff = lds_byte(wr * 64 + fr, fq * 8), boff = lds_byte(wc * 32 + fr, fq * 8);
#define PG8_SA(b, h) (((b) * 2 + (h)) * HTB)
#define PG8_SB(b, h) ((4 + (b) * 2 + (h)) * HTB)
#define PG8_STAGE(bufoff, gbase, voff) do { _Pragma("unroll") for (int _i = 0; _i < 2; ++_i) \
        __builtin_amdgcn_global_load_lds((const unsigned*)((const char*)(gbase) + (voff)[_i]), (PG8_LAS unsigned*)(lds + (bufoff) + ldsw + _i * 8192), 16, 0, 0); } while (0)
#define PG8_LDA(dst, b, h) do { _Pragma("unroll") for (int m = 0; m < 4; ++m) _Pragma("unroll") for (int k = 0; k < 2; ++k) dst[m][k] = *(const PG8_LAS bf16x8*)(lds + PG8_SA(b, h) + aoff + m * 2048 + k * 1024); } while (0)
#define PG8_LDB(dst, b, h) do { _Pragma("unroll") for (int n = 0; n < 2; ++n) _Pragma("unroll") for (int k = 0; k < 2; ++k) dst[n][k] = *(const PG8_LAS bf16x8*)(lds + PG8_SB(b, h) + boff + n * 2048 + k * 1024); } while (0)
#define PG8_MMA(ai, bj, At, Bt) do { __builtin_amdgcn_s_setprio(1); _Pragma("unroll") for (int m = 0; m < 4; ++m) _Pragma("unroll") for (int n = 0; n < 2; ++n) _Pragma("unroll") for (int k = 0; k < 2; ++k) \
        acc[ai][bj][m][n] = __builtin_amdgcn_mfma_f32_16x16x32_bf16(Bt[n][k], At[m][k], acc[ai][bj][m][n], 0, 0, 0); __builtin_amdgcn_s_setprio(0); } while (0)
#define PG8_WAIT_V(n) asm volatile("s_waitcnt vmcnt(" #n ")" ::: "memory")
#define PG8_WAIT_L(n) asm volatile("s_waitcnt lgkmcnt(" #n ")" ::: "memory")
#define PG8_BAR __builtin_amdgcn_s_barrier()
#define PG8_SCHED __builtin_amdgcn_sched_barrier(0)
    Unit cur, nxt; int ui = 0;
    if (!S.next(0, cur)) return;
    f32x4 acc[2][2][4][2];
#pragma unroll
    for (int a = 0; a < 2; ++a)
#pragma unroll
        for (int b = 0; b < 2; ++b)
#pragma unroll
            for (int m = 0; m < 4; ++m)
#pragma unroll
                for (int n = 0; n < 2; ++n) acc[a][b][m][n] = (f32x4){0.f, 0.f, 0.f, 0.f};
    bf16x8 At[4][2], B0[2][2], B1[2][2];
    const char* cA = (const char*)g.A + (size_t)cur.pm * tstepA; const char* cB = (const char*)g.Bt + (size_t)cur.pn * tstepB;
    S.a_ready(cur);
    if constexpr (SP2) {
        PG8_STAGE(PG8_SB(0, 0), cB, voffB); PG8_STAGE(PG8_SB(0, 1), cB + hstepB, voffB); PG8_STAGE(PG8_SA(0, 0), cA, voffA); PG8_STAGE(PG8_SA(0, 1), cA + hstepA, voffA);
        if (wr == 1) PG8_BAR;
        PG8_WAIT_V(2); PG8_BAR;
        PG8_STAGE(PG8_SB(1, 0), cB + kstep, voffB); PG8_STAGE(PG8_SA(1, 0), cA + kstep, voffA); PG8_STAGE(PG8_SB(1, 1), cB + hstepB + kstep, voffB);
        PG8_WAIT_V(6); PG8_BAR;
    } else {
        PG8_STAGE(PG8_SB(0, 0), cB, voffB); PG8_STAGE(PG8_SA(0, 0), cA, voffA); PG8_STAGE(PG8_SB(0, 1), cB + hstepB, voffB); PG8_STAGE(PG8_SA(0, 1), cA + hstepA, voffA);
        if (wr == 1) PG8_BAR;
        PG8_WAIT_V(4); PG8_BAR;
        PG8_STAGE(PG8_SB(1, 0), cB + kstep, voffB); PG8_STAGE(PG8_SA(1, 0), cA + kstep, voffA); PG8_STAGE(PG8_SB(1, 1), cB + hstepB + kstep, voffB);
        PG8_WAIT_V(6); PG8_BAR;
    }
    for (;;) {
        const bool has_next = S.next(ui + 1, nxt);
        const char* nA = has_next ? (const char*)g.A + (size_t)nxt.pm * tstepA : cA; const char* nB = has_next ? (const char*)g.Bt + (size_t)nxt.pn * tstepB : cB;
        for (int t = 0; t < nt; t += 2) {
            const bool last = (t == nt - 2);
            const char* a1 = cA + (size_t)(t + 1) * kstep;
            const char* a2 = last ? nA : cA + (size_t)(t + 2) * kstep; const char* b2 = last ? nB : cB + (size_t)(t + 2) * kstep;
            const char* a3 = a2 + kstep; const char* b3 = b2 + kstep;
            if (last && has_next) S.a_ready(nxt);
            if constexpr (SP2) {
            PG8_LDB(B0, 0, 0); PG8_LDB(B1, 0, 1); PG8_SCHED; PG8_LDA(At, 0, 0); PG8_STAGE(PG8_SA(1, 1), a1 + hstepA, voffA);
            PG8_WAIT_V(8); PG8_WAIT_L(0); PG8_BAR; PG8_MMA(0, 0, At, B0); PG8_MMA(0, 1, At, B1); PG8_BAR; PG8_SCHED;
            PG8_LDA(At, 0, 1); PG8_STAGE(PG8_SB(0, 0), b2, voffB); PG8_STAGE(PG8_SB(0, 1), b2 + hstepB, voffB); PG8_STAGE(PG8_SA(0, 0), a2, voffA);
            PG8_WAIT_V(8); PG8_WAIT_L(0); PG8_BAR; PG8_MMA(1, 0, At, B0); PG8_MMA(1, 1, At, B1); PG8_BAR; PG8_SCHED;
            PG8_LDB(B0, 1, 0); PG8_LDB(B1, 1, 1); PG8_SCHED; PG8_LDA(At, 1, 0); PG8_STAGE(PG8_SA(0, 1), a2 + hstepA, voffA);
            PG8_WAIT_V(8); PG8_WAIT_L(0); PG8_BAR; PG8_MMA(0, 0, At, B0); PG8_MMA(0, 1, At, B1); PG8_BAR; PG8_SCHED;
            PG8_LDA(At, 1, 1); PG8_STAGE(PG8_SB(1, 0), b3, voffB); PG8_STAGE(PG8_SB(1, 1), b3 + hstepB, voffB); PG8_STAGE(PG8_SA(1, 0), a3, voffA);
            PG8_WAIT_V(8); PG8_WAIT_L(0); PG8_BAR; PG8_MMA(1, 0, At, B0); PG8_MMA(1, 1, At, B1); PG8_BAR; PG8_SCHED;
            } else {
            PG8_LDB(B0, 0, 0); PG8_SCHED; PG8_LDA(At, 0, 0); PG8_STAGE(PG8_SA(1, 1), a1 + hstepA, voffA);
            PG8_WAIT_L(8); PG8_BAR; PG8_WAIT_L(0); PG8_MMA(0, 0, At, B0); PG8_BAR; PG8_SCHED;
            PG8_LDB(B1, 0, 1); PG8_STAGE(PG8_SB(0, 0), b2, voffB);
            PG8_BAR; PG8_WAIT_L(0); PG8_MMA(0, 1, At, B1); PG8_BAR;
            PG8_LDA(At, 0, 1); PG8_STAGE(PG8_SA(0, 0), a2, voffA);
            PG8_BAR; PG8_WAIT_L(0); PG8_MMA(1, 0, At, B0); PG8_BAR; PG8_SCHED;
            PG8_STAGE(PG8_SB(0, 1), b2 + hstepB, voffB);
            PG8_WAIT_V(6); PG8_BAR; PG8_MMA(1, 1, At, B1); PG8_BAR;
            PG8_LDB(B0, 1, 0); PG8_SCHED; PG8_LDA(At, 1, 0); PG8_STAGE(PG8_SA(0, 1), a2 + hstepA, voffA);
            PG8_WAIT_L(8); PG8_BAR; PG8_WAIT_L(0); PG8_MMA(0, 0, At, B0); PG8_BAR; PG8_SCHED;
            PG8_LDB(B1, 1, 1); PG8_STAGE(PG8_SB(1, 0), b3, voffB);
            PG8_BAR; PG8_WAIT_L(0); PG8_MMA(0, 1, At, B1); PG8_BAR;
            PG8_LDA(At, 1, 1); PG8_STAGE(PG8_SA(1, 0), a3, voffA);
            PG8_BAR; PG8_WAIT_L(0); PG8_MMA(1, 0, At, B0); PG8_BAR; PG8_SCHED;
            PG8_STAGE(PG8_SB(1, 1), b3 + hstepB, voffB);
            PG8_WAIT_V(6); PG8_BAR; PG8_MMA(1, 1, At, B1); PG8_BAR;
            }
        }
        if constexpr (ALIGN_EPI) { if (wr == 0) PG8_BAR; }
        if constexpr (!Epi::AFTER_DRAIN) { E(acc, cur, wr, wc, fr, fq); S.done(cur); }
        if (!has_next) break;
#pragma unroll
        for (int a = 0; a < 2; ++a)
#pragma unroll
            for (int b = 0; b < 2; ++b)
#pragma unroll
                for (int m = 0; m < 4; ++m)
#pragma unroll
                    for (int n = 0; n < 2; ++n) acc[a][b][m][n] = (f32x4){0.f, 0.f, 0.f, 0.f};
        cur = nxt; cA = nA; cB = nB; ++ui;
        if constexpr (ALIGN_EPI) { if (wr == 1) PG8_BAR; }
    }
    PG8_WAIT_V(0);
    if constexpr (!ALIGN_EPI) { if (wr == 0) PG8_BAR; }
    PG8_BAR;
    if constexpr (Epi::AFTER_DRAIN) { E.fused(acc, cur, wr, wc, fr, fq, lds, wid, lane); S.done(cur); }
#undef PG8_SA
#undef PG8_SB
#undef PG8_STAGE
#undef PG8_LDA
#undef PG8_LDB
#undef PG8_MMA
#undef PG8_WAIT_V
#undef PG8_WAIT_L
#undef PG8_BAR
#undef PG8_SCHED
}
}

template <class F> struct EpiQuad {
    static constexpr bool PERM = false, AFTER_DRAIN = false;
    F f;
    template <int C, int BJ> __device__ __forceinline__ void half(const pg8::f32x4 (&acc)[2][2][4][2], int row0, int p) const {
#pragma unroll
        for (int ai = 0; ai < 2; ++ai)
#pragma unroll
            for (int m = 0; m < 4; ++m) { f.template apply<C>(row0 + ai * 128 + m * 16, p, acc[ai][BJ][m][0], acc[ai][BJ][m][1]); asm volatile("" ::: "memory"); }
    }
    template <int BJ> __device__ __forceinline__ void disp(const pg8::f32x4 (&acc)[2][2][4][2], int row0, int p0, int p) const {
        const int c = f.cat(p0);
        if (F::NCAT == 1 || c == 0) half<0, BJ>(acc, row0, p);
        else if (F::NCAT > 1 && c == 1) half<(F::NCAT > 1 ? 1 : 0), BJ>(acc, row0, p);
        else if (F::NCAT > 2 && c == 2) half<(F::NCAT > 2 ? 2 : 0), BJ>(acc, row0, p);
        else if (F::NCAT > 3 && c == 3) half<(F::NCAT > 3 ? 3 : 0), BJ>(acc, row0, p);
        else if (F::NCAT > 4 && c == 4) half<(F::NCAT > 4 ? 4 : 0), BJ>(acc, row0, p);
        else if (F::NCAT > 5 && c == 5) half<(F::NCAT > 5 ? 5 : 0), BJ>(acc, row0, p);
        else if (F::NCAT > 6 && c == 6) half<(F::NCAT > 6 ? 6 : 0), BJ>(acc, row0, p);
        else if (F::NCAT > 7) half<(F::NCAT > 7 ? 7 : 0), BJ>(acc, row0, p);
    }
    __device__ __forceinline__ void operator()(const pg8::f32x4 (&acc)[2][2][4][2], const pg8::Unit& u, int wr, int wc, int fr, int fq) const {
        const int row0 = u.pm * 256 + wr * 64 + fr, p0 = u.pn * 256;
        disp<0>(acc, row0, p0, p0 + wc * 32 + 4 * fq);
        disp<1>(acc, row0, p0 + 128, p0 + 128 + wc * 32 + 4 * fq);
    }
};
template <class F> __device__ __forceinline__ void gemm_pg8(unsigned char* lds, const bf16* A, int lda, const bf16* Bt, int ldb, int M, int N, int K, const F& f, int wg_off = 0) {
    if ((int)blockIdx.x < wg_off) return;
    pg8::Gemm g{A, Bt, M, N, K, lda, ldb}; pg8::StaticOrder S; S.init(M, N, (int)gridDim.x, (int)blockIdx.x - wg_off);
    EpiQuad<F> E{f};
    pg8::gemm_phase<EpiQuad<F>, pg8::StaticOrder, true, true>((PG8_LAS unsigned char*)lds, g, S, E);
}

namespace cg = cooperative_groups;
struct EpiNormRes {
    static constexpr bool PERM = false, AFTER_DRAIN = true;
    const float* xin; float* xout; bf16* xn; const float* gpost; const float* gpre; float coef; unsigned* part; unsigned* cnt;
    __device__ __forceinline__ void operator()(const pg8::f32x4 (&)[2][2][4][2], const pg8::Unit&, int, int, int, int) const {}
    __device__ __forceinline__ void rowstat(const pg8::f32x4 (&acc)[2][2][4][2], float* P, int wr, int wc, int fr, int fq) const {
#pragma unroll
        for (int ai = 0; ai < 2; ++ai)
#pragma unroll
            for (int m = 0; m < 4; ++m) { float sq = 0.f;
#pragma unroll
                for (int bj = 0; bj < 2; ++bj)
#pragma unroll
                    for (int n = 0; n < 2; ++n) { const pg8::f32x4 v = acc[ai][bj][m][n]; sq += (v[0] * v[0] + v[1] * v[1]) + (v[2] * v[2] + v[3] * v[3]); }
                sq += __shfl_xor(sq, 16); sq += __shfl_xor(sq, 32);
                if (fq == 0) P[(ai * 128 + wr * 64 + m * 16 + fr) * 4 + wc] = sq; }
    }
    __device__ __forceinline__ void exchange(float* P, float* S, unsigned* bank, unsigned* cnt, const pg8::Unit& u, int tid, float scale) const {
        __syncthreads();
        if (tid < 256) { const f32x4 p = *(const f32x4*)(P + tid * 4);
            __hip_atomic_store(bank + (size_t)(u.pm * 256 + tid) * 4 + u.pn, __builtin_bit_cast(unsigned, (p[0] + p[1]) + (p[2] + p[3])), __ATOMIC_RELAXED, __HIP_MEMORY_SCOPE_AGENT); }
        asm volatile("s_waitcnt vmcnt(0)" ::: "memory");
        __syncthreads();
        if (tid == 0) { unsigned* c = cnt + u.pm * 16; __hip_atomic_fetch_add(c, 1u, __ATOMIC_RELAXED, __HIP_MEMORY_SCOPE_AGENT);
            while (__hip_atomic_load(c, __ATOMIC_RELAXED, __HIP_MEMORY_SCOPE_AGENT) < 4u) __builtin_amdgcn_s_sleep(1); }
        __syncthreads();
        if (tid < 256) { const unsigned* b = bank + (size_t)(u.pm * 256 + tid) * 4; float q = 0.f;
#pragma unroll
            for (int j = 0; j < 4; ++j) q += __builtin_bit_cast(float, __hip_atomic_load(b + j, __ATOMIC_RELAXED, __HIP_MEMORY_SCOPE_AGENT));
            S[tid] = rsqrtf(q * (1.f / DM) + NORM_EPS) * scale; }
        __syncthreads();
    }
    __device__ __forceinline__ void fused(pg8::f32x4 (&acc)[2][2][4][2], const pg8::Unit& u, int wr, int wc, int fr, int fq, PG8_LAS unsigned char* lds, int wid, int lane) const {
        float* P = (float*)lds; float* S = P + 1024; const int tid = wid * 64 + lane;
        rowstat(acc, P, wr, wc, fr, fq);
        exchange(P, S, part, cnt, u, tid, coef);
        const int col0 = u.pn * 256 + wc * 32 + 4 * fq;
#pragma unroll
        for (int ai = 0; ai < 2; ++ai)
#pragma unroll
            for (int m = 0; m < 4; ++m) { const int r = ai * 128 + wr * 64 + m * 16 + fr; const float sr = S[r]; const size_t off = (size_t)(u.pm * 256 + r) * DM + col0;
#pragma unroll
                for (int bj = 0; bj < 2; ++bj)
#pragma unroll
                    for (int n = 0; n < 2; ++n) { const int o = bj * 128 + n * 16; const f32x4 g4 = *(const f32x4*)(gpost + col0 + o), x4 = *(const f32x4*)(xin + off + o);
                        const f32x4 y = x4 + acc[ai][bj][m][n] * sr * g4; acc[ai][bj][m][n] = y; *(f32x4*)(xout + off + o) = y; }
                asm volatile("" ::: "memory"); }
        if (!gpre) return;
        rowstat(acc, P, wr, wc, fr, fq);
        exchange(P, S, part + (size_t)M_ * 4, cnt + 64 * 16, u, tid, 1.f);
#pragma unroll
        for (int ai = 0; ai < 2; ++ai)
#pragma unroll
            for (int m = 0; m < 4; ++m) { const int r = ai * 128 + wr * 64 + m * 16 + fr; const float sr = S[r]; const size_t off = (size_t)(u.pm * 256 + r) * DM + col0;
#pragma unroll
                for (int bj = 0; bj < 2; ++bj)
#pragma unroll
                    for (int n = 0; n < 2; ++n) { const int o = bj * 128 + n * 16; const f32x4 g4 = *(const f32x4*)(gpre + col0 + o); st_bf4(xn + off + o, acc[ai][bj][m][n] * sr * g4); }
                asm volatile("" ::: "memory"); }
    }
};
__device__ __forceinline__ void gemm_norm_res(unsigned char* lds, const bf16* A, int lda, const bf16* Bt, int K, const float* xin, float* xout, bf16* xn, const float* gpost, const float* gpre,
                                              float coef, bf16* ybuf, unsigned* part, unsigned* cnt) {
    pg8::Gemm g{A, Bt, M_, DM, K, lda, K}; pg8::StaticOrder S; S.init(M_, DM, 256, (int)blockIdx.x);
    const EpiNormRes E{xin, xout, xn, gpost, gpre, coef, part, cnt};
    pg8::gemm_phase<EpiNormRes, pg8::StaticOrder, false, true>((PG8_LAS unsigned char*)lds, g, S, E);
}

__device__ __forceinline__ void d_gates(const bf16* xn, const bf16* wg  , float* gates) {
    const int T512 = tidx(), lane = T512 & 63, fr = lane & 15, fq = lane >> 4;
    for (int rt = blockIdx.x * 8 + (T512 >> 6); rt < M_ / 16; rt += gridDim.x * 8) {
        const bf16* ap = xn + (size_t)(rt * 16 + fr) * DM + 8 * fq; const bf16* bp = wg + (size_t)fr * DM + 8 * fq;
        f32x4 c0 = {0.f, 0.f, 0.f, 0.f}, c1 = {0.f, 0.f, 0.f, 0.f};
#pragma unroll 8
        for (int k0 = 0; k0 < DM; k0 += 32) { const bf16x8 a = *(const bf16x8*)(ap + k0);
            c0 = __builtin_amdgcn_mfma_f32_16x16x32_bf16(*(const bf16x8*)(bp + k0), a, c0, 0, 0, 0);
            c1 = __builtin_amdgcn_mfma_f32_16x16x32_bf16(*(const bf16x8*)(bp + (size_t)16 * DM + k0), a, c1, 0, 0, 0); }
        float* o = gates + (size_t)(rt * 16 + fr) * 24 + 4 * fq;
        *(f32x4*)o = (f32x4){sigmoidf_(c0[0]), sigmoidf_(c0[1]), sigmoidf_(c0[2]), sigmoidf_(c0[3])};
        if (fq < 2) *(f32x4*)(o + 16) = (f32x4){sigmoidf_(c1[0]), sigmoidf_(c1[1]), sigmoidf_(c1[2]), sigmoidf_(c1[3])};
    }
}

__device__ __forceinline__ void d_cmp2(const bf16* hidk, const bf16* hidv, const bf16* w2t, const float* rope, bf16* kc, bf16* vct) {
    const int T512 = tidx(), lane = T512 & 63, fr = lane & 15, fq = lane >> 4;
    for (int task = blockIdx.x * 8 + (T512 >> 6); task < 256; task += gridDim.x * 8) {
        const int kv = task >> 7, R0 = (task & 127) * 16;
        const bf16* ap = (kv ? hidv : hidk) + (size_t)(R0 + fr) * 256 + 8 * fq;
        const bf16* bp = w2t + (size_t)kv * 64 * 256 + (size_t)fr * 256 + 8 * fq;
        f32x4 acc[4];
#pragma unroll
        for (int nt = 0; nt < 4; ++nt) acc[nt] = (f32x4){0.f, 0.f, 0.f, 0.f};
#pragma unroll
        for (int k0 = 0; k0 < 256; k0 += 32) {
            const bf16x8 a = *(const bf16x8*)(ap + k0);
#pragma unroll
            for (int nt = 0; nt < 4; ++nt) acc[nt] = __builtin_amdgcn_mfma_f32_16x16x32_bf16(*(const bf16x8*)(bp + (size_t)nt * 16 * 256 + k0), a, acc[nt], 0, 0, 0);
        }
        const int R = R0 + fr, bg = R >> 9, c = R & 511;
        if (kv == 0) {
            const int pos = (16 * c + 31) & (T_ - 1);
#pragma unroll
            for (int h2 = 0; h2 < 2; ++h2) {
                const int d = 16 * h2 + 4 * fq; const f32x4* rp = (const f32x4*)(rope + ((size_t)pos * 32 + d) * 2); const f32x4 r0 = rp[0], r1 = rp[1];
                const f32x4 cs = {r0[0], r0[2], r1[0], r1[2]}, sn = {r0[1], r0[3], r1[1], r1[3]};
                const f32x4 lo = acc[h2] * cs - acc[h2 + 2] * sn, hi = acc[h2] * sn + acc[h2 + 2] * cs;
                st_bf4(kc + (size_t)R * 64 + d, lo); st_bf4(kc + (size_t)R * 64 + d + 32, hi);
            }
        } else {
#pragma unroll
            for (int nt = 0; nt < 4; ++nt)
#pragma unroll
                for (int e = 0; e < 4; ++e) vct[((size_t)bg * 64 + 16 * nt + 4 * fq + e) * NCP + c] = (bf16)f2bf(acc[nt][e]);
        }
    }
}

struct NsaArgs { const bf16 *qb, *kc, *vct, *ks, *vst, *kw, *vwt; const float* gates; bf16* amix; };
__device__ __forceinline__ float dot64(const float* q, const bf16* k) {
    float s = 0.f;
#pragma unroll
    for (int i = 0; i < 8; ++i) { const u32x4 w = ((const u32x4*)k)[i];
        s += q[8 * i + 0] * __builtin_bit_cast(float, w.x << 16) + q[8 * i + 1] * __builtin_bit_cast(float, w.x & 0xffff0000u)
           + q[8 * i + 2] * __builtin_bit_cast(float, w.y << 16) + q[8 * i + 3] * __builtin_bit_cast(float, w.y & 0xffff0000u)
           + q[8 * i + 4] * __builtin_bit_cast(float, w.z << 16) + q[8 * i + 5] * __builtin_bit_cast(float, w.z & 0xffff0000u)
           + q[8 * i + 6] * __builtin_bit_cast(float, w.w << 16) + q[8 * i + 7] * __builtin_bit_cast(float, w.w & 0xffff0000u); }
    return s;
}
__device__ __forceinline__ void softmax_row(float* s, int n, int lane) {
    float m = -INFINITY; for (int i = lane; i < n; i += 64) m = fmaxf(m, s[i]);
    m = wave_max(m); if (m == -INFINITY) m = 0.f;
    float l = 0.f; for (int i = lane; i < n; i += 64) { const float e = exp2f(s[i] - m); s[i] = e; l += e; }
    l = wave_sum(l); const float inv = 1.f / fmaxf(l, 1e-30f);
    for (int i = lane; i < n; i += 64) s[i] *= inv;
}
__device__ __forceinline__ void d_nsa_simple(const NsaArgs& a, int vb, int tid, unsigned char* smem) {
    float (*qs)[64] = (float (*)[64])smem; float (*sc)[1024] = (float (*)[1024])(smem + 1024); float* imp = (float*)(smem + 17408); float* score = imp + 128;
    int* list = (int*)(score + 128); int* nlist = list + 16;
    const int bg = vb / T_, t = vb % T_, b = bg >> 1, g = bg & 1;
    const int r = tid >> 6, d = tid & 63, lane = d;
    const size_t row = (size_t)b * T_ + t;
    qs[r][d] = bf2f(a.qb[row * 512 + g * 256 + r * 64 + d]);
    if (tid == 0) *nlist = 0;
    __syncthreads();
    const int nv = t < 31 ? 0 : (t - 31) / 16 + 1;
    for (int c = tid; c < nv; c += 256) { const bf16* k = a.kc + ((size_t)bg * NCP + c) * 64;
        _Pragma("unroll 1") for (int rr = 0; rr < 4; ++rr) sc[rr][c] = dot64(qs[rr], k); }
    __syncthreads();
    softmax_row(sc[r], nv, lane);
    __syncthreads();
    float oc = 0.f; { const bf16* v = a.vct + ((size_t)bg * 64 + d) * NCP; for (int c = 0; c < nv; ++c) oc += sc[r][c] * bf2f(v[c]); }
    if (tid < 128) { const int s = tid; float acc = 0.f;
        for (int c = 4 * s - 1; c <= 4 * s + 3; ++c) if (c >= 0 && c < nv) acc += sc[0][c] + sc[1][c] + sc[2][c] + sc[3][c];
        imp[s] = acc; }
    __syncthreads();
    const int cur = t >> 6;
    if (tid < 128) { const int s = tid; const bool forced = (s == 0) || (s == cur) || (s == cur - 1);
        score[s] = forced ? 1e4f : (s <= cur ? imp[s] : -1e4f); }
    __syncthreads();
    if (tid < 128) { const int s = tid; const float my = score[s]; int rank = 0;
        for (int j = 0; j < 128; ++j) { const float o = score[j]; rank += (o > my || (o == my && j < s)) ? 1 : 0; }
        if (rank < 16 && s <= cur) { const int slot = atomicAdd(nlist, 1); list[slot] = s; } }
    __syncthreads();
    const int ns = *nlist * 64;
    for (int i = tid; i < ns; i += 256) { const int pos = list[i >> 6] * 64 + (i & 63);
        if (pos <= t) { const bf16* k = a.ks + ((size_t)bg * T_ + pos) * 64; _Pragma("unroll 1") for (int rr = 0; rr < 4; ++rr) sc[rr][i] = dot64(qs[rr], k); }
        else { sc[0][i] = -INFINITY; sc[1][i] = -INFINITY; sc[2][i] = -INFINITY; sc[3][i] = -INFINITY; } }
    __syncthreads();
    softmax_row(sc[r], ns, lane);
    __syncthreads();
    float os = 0.f; { const bf16* v = a.vst + ((size_t)bg * 64 + d) * T_;
        for (int i = 0; i < ns; ++i) { const int pos = list[i >> 6] * 64 + (i & 63); if (pos <= t) os += sc[r][i] * bf2f(v[pos]); } }
    __syncthreads();
    const int lo = t - 511 > 0 ? t - 511 : 0, nw = t - lo + 1;
    for (int i = tid; i < nw; i += 256) { const bf16* k = a.kw + ((size_t)bg * T_ + lo + i) * 64;
        _Pragma("unroll 1") for (int rr = 0; rr < 4; ++rr) sc[rr][i] = dot64(qs[rr], k); }
    __syncthreads();
    softmax_row(sc[r], nw, lane);
    __syncthreads();
    float ow = 0.f; { const bf16* v = a.vwt + ((size_t)bg * 64 + d) * T_ + lo; for (int i = 0; i < nw; ++i) ow += sc[r][i] * bf2f(v[i]); }
    const float* gt = a.gates + row * 24 + g * 12 + r * 3;
    a.amix[row * DM + g * 256 + r * 64 + d] = (bf16)f2bf(gt[0] * oc + gt[1] * os + gt[2] * ow);
    __syncthreads();
}


namespace nsa {
typedef float f32x16 __attribute__((ext_vector_type(16)));
constexpr int KROW = 144, VROW = 136, KBUF = 64 * KROW, VBUF = 64 * VROW;
constexpr int OFF_K = 0, OFF_V = 2 * KBUF, OFF_IMP = OFF_V + 2 * VBUF, IMPW = 130, OFF_SEL = OFF_IMP + 64 * IMPW * 4, OFF_UM = OFF_SEL + 1024, OFF_WS = OFF_UM + 16, OFF_UNIT = OFF_WS + 1024, OFF_ACC = OFF_UNIT + 16, LDS_NEED = OFF_ACC + 8 * 8192;
static_assert(LDS_NEED <= 147456 - 64 && OFF_ACC % 16 == 0, "nsa lds");
static_assert(OFF_IMP % 16 == 0 && OFF_SEL % 16 == 0 && OFF_WS % 16 == 0, "nsa lds map");
__device__ __forceinline__ int crow(int r, int hi) { return (r & 3) + 8 * (r >> 2) + 4 * hi; }
__device__ __forceinline__ int next_bit(unsigned m0, unsigned m1, unsigned m2, unsigned m3, int from) {
#pragma unroll
    for (int wd = 0; wd < 4; ++wd) {
        unsigned x = wd == 0 ? m0 : (wd == 1 ? m1 : (wd == 2 ? m2 : m3)); const int base = wd * 32;
        if (from < base + 32) { if (from > base) x &= (~0u) << (from - base); if (x) return base + __builtin_ctz(x); }
    }
    return 128;
}
__device__ __forceinline__ bf16x8 pack8(const f32x16& p, int b0) {
    u32x4 w; w.x = pk2(p[b0 + 0], p[b0 + 1]); w.y = pk2(p[b0 + 2], p[b0 + 3]); w.z = pk2(p[b0 + 4], p[b0 + 5]); w.w = pk2(p[b0 + 6], p[b0 + 7]);
    return __builtin_bit_cast(bf16x8, w);
}
struct Branch { const bf16* k; const bf16* vt; int ldv; };

constexpr float THR = 8.f;
template <int MODE, bool SEL>
__device__ __forceinline__ void compute_tile(unsigned char* sm, int cb, int j, const bf16x8 (&qf)[4], int lo, int hi_b, int lo_max, int hi_min, unsigned s0, unsigned s1, unsigned s2, unsigned s3,
                                             float& m, float& l, float invl, bool& initd, f32x16& negm, f32x16 (&o)[2], float* imp_row, float* wsc, int i, int hi) {
        const unsigned char* kb = sm + OFF_K + cb * KBUF; const unsigned char* vb = sm + OFF_V + cb * VBUF;
        const int key0 = 64 * j;
        bool rowsel = true;
        if (SEL) { const unsigned wsel = j < 32 ? s0 : (j < 64 ? s1 : (j < 96 ? s2 : s3)); rowsel = (wsel >> (j & 31)) & 1u; }
        if (!SEL || __any(rowsel)) {
            f32x16 p0, p1;
            {
                f32x16 c0;
                if (SEL) {
#pragma unroll
                    for (int r = 0; r < 16; ++r) c0[r] = rowsel ? negm[r] : -INFINITY;
                } else c0 = negm;
                const bf16x8 a00 = *(const bf16x8*)(kb + i * KROW + (8 * hi) * 2), a10 = *(const bf16x8*)(kb + (32 + i) * KROW + (8 * hi) * 2);
                p0 = __builtin_amdgcn_mfma_f32_32x32x16_bf16(a00, qf[0], c0, 0, 0, 0);
                p1 = __builtin_amdgcn_mfma_f32_32x32x16_bf16(a10, qf[0], c0, 0, 0, 0);
#pragma unroll
                for (int d0 = 1; d0 < 4; ++d0) {
                    const bf16x8 a0 = *(const bf16x8*)(kb + i * KROW + (16 * d0 + 8 * hi) * 2);
                    const bf16x8 a1 = *(const bf16x8*)(kb + (32 + i) * KROW + (16 * d0 + 8 * hi) * 2);
                    p0 = __builtin_amdgcn_mfma_f32_32x32x16_bf16(a0, qf[d0], p0, 0, 0, 0);
                    p1 = __builtin_amdgcn_mfma_f32_32x32x16_bf16(a1, qf[d0], p1, 0, 0, 0);
                }
            }
            if (!(key0 >= lo_max && key0 + 63 <= hi_min)) {
#pragma unroll
                for (int r = 0; r < 16; ++r) { const int key = key0 + crow(r, hi);
                    if (key < lo || key > hi_b) p0[r] = -INFINITY;
                    if (key + 32 < lo || key + 32 > hi_b) p1[r] = -INFINITY; }
            }
            if (MODE == 1) {
#pragma unroll
                for (int r = 0; r < 16; ++r) { p0[r] = __builtin_amdgcn_exp2f(p0[r]) * invl; p1[r] = __builtin_amdgcn_exp2f(p1[r]) * invl; }
#pragma unroll
                for (int gq = 0; gq < 4; ++gq) {
                    float G0 = (p0[4 * gq] + p0[4 * gq + 1]) + (p0[4 * gq + 2] + p0[4 * gq + 3]), L0 = p0[4 * gq + 3];
                    float G1 = (p1[4 * gq] + p1[4 * gq + 1]) + (p1[4 * gq + 2] + p1[4 * gq + 3]), L1 = p1[4 * gq + 3];
                    G0 += __shfl_xor(G0, 1); L0 += __shfl_xor(L0, 1); G1 += __shfl_xor(G1, 1); L1 += __shfl_xor(L1, 1);
                    G0 += __shfl_xor(G0, 2); L0 += __shfl_xor(L0, 2); G1 += __shfl_xor(G1, 2); L1 += __shfl_xor(L1, 2);
                    if ((i & 3) == 0) { const int s = 16 * j + 2 * gq + hi;
                        atomicAdd(imp_row + s, G0); atomicAdd(imp_row + s + 1, L0); atomicAdd(imp_row + s + 8, G1); atomicAdd(imp_row + s + 9, L1); }
                }
            } else {
                float ta = fmaxf(fmaxf(p0[0], p0[1]), p1[0]), tb = fmaxf(fmaxf(p0[2], p0[3]), p1[1]);
                ta = fmaxf(fmaxf(ta, p1[2]), p1[3]);
#pragma unroll
                for (int r = 4; r < 16; r += 4) { ta = fmaxf(fmaxf(ta, p0[r]), p0[r + 1]); tb = fmaxf(fmaxf(tb, p0[r + 2]), p0[r + 3]); ta = fmaxf(fmaxf(ta, p1[r]), p1[r + 1]); tb = fmaxf(fmaxf(tb, p1[r + 2]), p1[r + 3]); }
                float tm = fmaxf(ta, tb);
                tm = fmaxf(tm, __shfl_xor(tm, 32));
                if (__any((!initd && tm > -INFINITY) || tm > THR)) {
                    const bool was = initd;
                    const float d = was ? fmaxf(tm, 0.f) : (tm > -INFINITY ? tm : 0.f);
                    initd = was || (tm > -INFINITY);
                    m += d; const float alpha = was ? __builtin_amdgcn_exp2f(-d) : 1.f; l *= alpha;
#pragma unroll
                    for (int r = 0; r < 16; ++r) { p0[r] -= d; p1[r] -= d; negm[r] = -m; }
                    if (MODE == 2) {
                        if (hi == 0) wsc[i] = alpha;
                        asm volatile("" ::: "memory");
#pragma unroll
                        for (int rg = 0; rg < 4; ++rg) { const f32x4 a4 = *(const f32x4*)(wsc + 8 * rg + 4 * hi);
#pragma unroll
                            for (int e = 0; e < 4; ++e) { o[0][4 * rg + e] *= a4[e]; o[1][4 * rg + e] *= a4[e]; } }
                        asm volatile("" ::: "memory");
                    }
                }
                float rs = 0.f;
#pragma unroll
                for (int r = 0; r < 16; ++r) { p0[r] = __builtin_amdgcn_exp2f(p0[r]); p1[r] = __builtin_amdgcn_exp2f(p1[r]); rs += p0[r] + p1[r]; }
                l += rs;
            }
            if (MODE != 0) {
                const bf16x8 pf0 = pack8(p0, 0), pf1 = pack8(p0, 8), pf2 = pack8(p1, 0), pf3 = pack8(p1, 8);
#pragma unroll
                for (int dt = 0; dt < 2; ++dt) {
                    const unsigned char* vp = vb + (32 * dt + i) * VROW + 8 * hi;
#pragma unroll
                    for (int ks = 0; ks < 4; ++ks) {
                        const u32x2 v_lo = *(const u32x2*)(vp + 32 * ks), v_hi = *(const u32x2*)(vp + 32 * ks + 16);
                        const bf16x8 vf = __builtin_bit_cast(bf16x8, (u32x4){v_lo.x, v_lo.y, v_hi.x, v_hi.y});
                        o[dt] = __builtin_amdgcn_mfma_f32_32x32x16_bf16(ks == 0 ? pf0 : (ks == 1 ? pf1 : (ks == 2 ? pf2 : pf3)), vf, o[dt], 0, 0, 0);
                    }
                }
            }
        }
}
template <int MODE, bool SEL>
__device__ __forceinline__ void run_branch(unsigned char* sm, const Branch br, unsigned m0, unsigned m1, unsigned m2, unsigned m3,
                                           const bf16x8 (&qf)[4], int lo, int hi_b, int lo_max, int hi_min, unsigned s0, unsigned s1, unsigned s2, unsigned s3,
                                           float& m, float& l, float invl, f32x16 (&o)[2], float* imp_row, float* wsc, int tid, int lane) {
    const int i = lane & 31, hi = lane >> 5;
    const bf16* kp = br.k + tid * 8; const bf16* vp_ = br.vt + (size_t)(tid >> 3) * br.ldv + (tid & 7) * 8;
    unsigned char* kst = sm + OFF_K + (tid >> 3) * KROW + (tid & 7) * 16; unsigned char* vst = sm + OFF_V + (tid >> 3) * VROW + (tid & 7) * 16;
#define NSA_LOAD(jj, KR, VR) do { KR = *(const u32x4*)(kp + (size_t)(jj) * 4096); if (MODE != 0) VR = *(const u32x4*)(vp_ + (jj) * 64); } while (0)
#define NSA_STORE(buf, KR, VR) do { *(u32x4*)(kst + (buf) * KBUF) = KR; if (MODE != 0) { *(u32x2*)(vst + (buf) * VBUF) = (u32x2){VR.x, VR.y}; *(u32x2*)(vst + (buf) * VBUF + 8) = (u32x2){VR.z, VR.w}; } } while (0)
    int j = next_bit(m0, m1, m2, m3, 0);
    int j1 = j < 128 ? next_bit(m0, m1, m2, m3, j + 1) : 128;
    u32x4 kA, vA, kB, vB;
    if (j < 128) { NSA_LOAD(j, kA, vA); if (j1 < 128) NSA_LOAD(j1, kB, vB); NSA_STORE(0, kA, vA); }
    __syncthreads();
    bool initd = (MODE == 1);
    f32x16 negm;
#pragma unroll
    for (int r = 0; r < 16; ++r) negm[r] = (MODE == 1) ? -m : 0.f;
    while (j < 128) {
        {
            const int j2 = j1 < 128 ? next_bit(m0, m1, m2, m3, j1 + 1) : 128;
            if (j2 < 128) NSA_LOAD(j2, kA, vA);
            compute_tile<MODE, SEL>(sm, 0, j, qf, lo, hi_b, lo_max, hi_min, s0, s1, s2, s3, m, l, invl, initd, negm, o, imp_row, wsc, i, hi);
            if (j1 < 128) NSA_STORE(1, kB, vB);
            __syncthreads();
            j = j1; j1 = j2;
        }
        if (j >= 128) break;
        {
            const int j2 = j1 < 128 ? next_bit(m0, m1, m2, m3, j1 + 1) : 128;
            if (j2 < 128) NSA_LOAD(j2, kB, vB);
            compute_tile<MODE, SEL>(sm, 1, j, qf, lo, hi_b, lo_max, hi_min, s0, s1, s2, s3, m, l, invl, initd, negm, o, imp_row, wsc, i, hi);
            if (j1 < 128) NSA_STORE(0, kA, vA);
            __syncthreads();
            j = j1; j1 = j2;
        }
    }
#undef NSA_LOAD
#undef NSA_STORE
}
template <bool FIRST> __device__ __forceinline__ void add_scaled(float* accw, const f32x16 (&o)[2], float f, float* wsc, int i, int hi, int lane) {
    if (hi == 0) wsc[i] = f;
    asm volatile("" ::: "memory");
#pragma unroll
    for (int rg = 0; rg < 4; ++rg) { const f32x4 a4 = *(const f32x4*)(wsc + 8 * rg + 4 * hi);
#pragma unroll
        for (int e = 0; e < 4; ++e)
#pragma unroll
            for (int dt = 0; dt < 2; ++dt) { float* p = accw + (dt * 16 + 4 * rg + e) * 64 + lane; const float v = a4[e] * o[dt][4 * rg + e]; *p = FIRST ? v : (*p + v); } }
    asm volatile("" ::: "memory");
}
__device__ __forceinline__ void unit(const NsaArgs& a, int u, unsigned char* sm) {
    const int tid = tidx(), lane = tid & 63, w = __builtin_amdgcn_readfirstlane(tid >> 6), i = lane & 31, hi = lane >> 5;
    const int cur = 127 - (u >> 2), bg = u & 3, b = bg >> 1, g = bg & 1, q0 = cur * 64;
    const int ql = 8 * w + (i >> 2), hd = i & 3, t = q0 + ql;
    const size_t grow = (size_t)b * T_ + t;
    bf16x8 qf[4];
    { const bf16* qp = a.qb + grow * 512 + g * 256 + hd * 64 + 8 * hi;
#pragma unroll
      for (int d0 = 0; d0 < 4; ++d0) qf[d0] = *(const bf16x8*)(qp + 16 * d0); }
    float* wsc = (float*)(sm + OFF_WS) + w * 32;
    float* imp = (float*)(sm + OFF_IMP);
    unsigned* selw = (unsigned*)(sm + OFF_SEL);
    unsigned* um = (unsigned*)(sm + OFF_UM);
    for (int k = tid; k < 64 * IMPW; k += 512) imp[k] = 0.f;
    if (tid < 4) um[tid] = 0u;
    const float* gt = a.gates + grow * 24 + g * 12 + hd * 3;
    const float gc = gt[0], gs = gt[1], gw = gt[2];
    f32x16 o[2];
    float* accw = (float*)(sm + OFF_ACC) + w * 2048;
    const int tw0 = q0 + 8 * w, tw1 = tw0 + 7;
    {
        const int nv = t < 31 ? 0 : (t - 31) / 16 + 1;
        const int nvw = tw0 < 31 ? 0 : (tw0 - 31) / 16 + 1;
        const int nvmax = (q0 + 63 - 31) / 16 + 1, ntc = (nvmax + 63) / 64;
        const unsigned cm0 = ntc >= 32 ? ~0u : ((1u << ntc) - 1u);
        const Branch br{a.kc + (size_t)bg * NCP * 64, a.vct + (size_t)bg * 64 * NCP, NCP};
        float m = 0.f, l = 0.f;
        run_branch<0, false>(sm, br, cm0, 0u, 0u, 0u, qf, 0, nv - 1, 0, nvw - 1, 0u, 0u, 0u, 0u, m, l, 0.f, o, nullptr, wsc, tid, lane);
        l += __shfl_xor(l, 32);
        const float invl = 1.f / fmaxf(l, 1e-30f);
#pragma unroll
        for (int r = 0; r < 16; ++r) { o[0][r] = 0.f; o[1][r] = 0.f; }
        run_branch<1, false>(sm, br, cm0, 0u, 0u, 0u, qf, 0, nv - 1, 0, nvw - 1, 0u, 0u, 0u, 0u, m, l, invl, o, imp + ql * IMPW, wsc, tid, lane);
        add_scaled<true>(accw, o, gc, wsc, i, hi, lane);
    }
    {
        unsigned u0 = 0u, u1 = 0u, u2 = 0u, u3 = 0u;
        const int ncand = cur - 2;
        unsigned k0[8], k1[8], k2[8], k3[8];
        if (ncand <= 13) {
#pragma unroll
            for (int wd = 0; wd < 4; ++wd) { const int nb = cur + 1 - 32 * wd; const unsigned x = nb >= 32 ? ~0u : (nb <= 0 ? 0u : ((1u << nb) - 1u));
#pragma unroll
                for (int qq = 0; qq < 8; ++qq) { if (wd == 0) k0[qq] = x; else if (wd == 1) k1[qq] = x; else if (wd == 2) k2[qq] = x; else k3[qq] = x; } }
        } else {
            float v0[8], v1[8];
#pragma unroll
            for (int qq = 0; qq < 8; ++qq) { const float* ir = imp + (8 * w + qq) * IMPW;
                v0[qq] = (lane >= 1 && lane <= cur - 2) ? ir[lane] : -1.f; v1[qq] = (lane + 64 <= cur - 2) ? ir[lane + 64] : -1.f;
                k0[qq] = 1u; k1[qq] = 0u; k2[qq] = 0u; k3[qq] = 0u; }
            for (int it = 0; it < 13; ++it) {
                float bv[8]; int bs[8];
#pragma unroll
                for (int qq = 0; qq < 8; ++qq) { bv[qq] = v0[qq]; bs[qq] = lane; if (v1[qq] > v0[qq]) { bv[qq] = v1[qq]; bs[qq] = lane + 64; } }
#pragma unroll
                for (int off = 1; off < 64; off <<= 1) {
#pragma unroll
                    for (int qq = 0; qq < 8; ++qq) { const float ov = __shfl_xor(bv[qq], off); const int os = __shfl_xor(bs[qq], off);
                        if (ov > bv[qq] || (ov == bv[qq] && os < bs[qq])) { bv[qq] = ov; bs[qq] = os; } } }
#pragma unroll
                for (int qq = 0; qq < 8; ++qq) { const int b_ = __builtin_amdgcn_readfirstlane(bs[qq]);
                    if (b_ == lane) v0[qq] = -1.f; if (b_ == lane + 64) v1[qq] = -1.f;
                    const unsigned bit = 1u << (b_ & 31);
                    if (b_ < 32) k0[qq] |= bit; else if (b_ < 64) k1[qq] |= bit; else if (b_ < 96) k2[qq] |= bit; else k3[qq] |= bit; }
            }
            { const int c1 = cur - 1; const unsigned b1 = 1u << (c1 & 31), b2 = 1u << (cur & 31);
#pragma unroll
              for (int qq = 0; qq < 8; ++qq) {
                if (c1 < 32) k0[qq] |= b1; else if (c1 < 64) k1[qq] |= b1; else if (c1 < 96) k2[qq] |= b1; else k3[qq] |= b1;
                if (cur < 32) k0[qq] |= b2; else if (cur < 64) k1[qq] |= b2; else if (cur < 96) k2[qq] |= b2; else k3[qq] |= b2; } }
        }
#pragma unroll
        for (int qq = 0; qq < 8; ++qq) {
            if (lane == 0) { unsigned* sp = selw + (8 * w + qq) * 4; sp[0] = k0[qq]; sp[1] = k1[qq]; sp[2] = k2[qq]; sp[3] = k3[qq]; }
            u0 |= k0[qq]; u1 |= k1[qq]; u2 |= k2[qq]; u3 |= k3[qq]; }
        if (lane == 0) { atomicOr(um + 0, u0); atomicOr(um + 1, u1); atomicOr(um + 2, u2); atomicOr(um + 3, u3); }
    }
    __syncthreads();
    {
        const unsigned U0 = um[0], U1 = um[1], U2 = um[2], U3 = um[3];
        const unsigned* sp = selw + ql * 4; const unsigned s0 = sp[0], s1 = sp[1], s2 = sp[2], s3 = sp[3];
        const Branch br{a.ks + (size_t)bg * T_ * 64, a.vst + (size_t)bg * 64 * T_, T_};
        float m = 0.f, l = 0.f;
#pragma unroll
        for (int r = 0; r < 16; ++r) { o[0][r] = 0.f; o[1][r] = 0.f; }
        run_branch<2, true>(sm, br, __builtin_amdgcn_readfirstlane(U0), __builtin_amdgcn_readfirstlane(U1), __builtin_amdgcn_readfirstlane(U2), __builtin_amdgcn_readfirstlane(U3),
                            qf, 0, t, 0, tw0, s0, s1, s2, s3, m, l, 0.f, o, nullptr, wsc, tid, lane);
        l += __shfl_xor(l, 32);
        add_scaled<false>(accw, o, gs / fmaxf(l, 1e-30f), wsc, i, hi, lane);
    }
    {
        const int j0 = cur - 8 > 0 ? cur - 8 : 0;
        unsigned wm0 = 0u, wm1 = 0u, wm2 = 0u, wm3 = 0u;
#pragma unroll
        for (int wd = 0; wd < 4; ++wd) { const int a0 = j0 - 32 * wd, a1 = cur + 1 - 32 * wd;
            const unsigned hi_m = a1 >= 32 ? ~0u : (a1 <= 0 ? 0u : ((1u << a1) - 1u)), lo_m = a0 >= 32 ? ~0u : (a0 <= 0 ? 0u : ((1u << a0) - 1u));
            const unsigned x = hi_m & ~lo_m; if (wd == 0) wm0 = x; else if (wd == 1) wm1 = x; else if (wd == 2) wm2 = x; else wm3 = x; }
        const Branch br{a.kw + (size_t)bg * T_ * 64, a.vwt + (size_t)bg * 64 * T_, T_};
        float m = 0.f, l = 0.f;
#pragma unroll
        for (int r = 0; r < 16; ++r) { o[0][r] = 0.f; o[1][r] = 0.f; }
        run_branch<2, false>(sm, br, wm0, wm1, wm2, wm3, qf, t - 511, t, tw1 - 511, tw0, 0u, 0u, 0u, 0u, m, l, 0.f, o, nullptr, wsc, tid, lane);
        l += __shfl_xor(l, 32);
        add_scaled<false>(accw, o, gw / fmaxf(l, 1e-30f), wsc, i, hi, lane);
    }
#pragma unroll
    for (int r = 0; r < 16; ++r) { const int rw = crow(r, hi), qq = 8 * w + (rw >> 2), hh = rw & 3;
        bf16* op = a.amix + ((size_t)b * T_ + q0 + qq) * DM + g * 256 + hh * 64 + i;
        op[0] = (bf16)f2bf(accw[r * 64 + lane]); op[32] = (bf16)f2bf(accw[(16 + r) * 64 + lane]); }
}
__device__ __forceinline__ void phase(const NsaArgs& a, unsigned* ctr, unsigned char* sm) {
    int* slot = (int*)(sm + OFF_UNIT);
    for (;;) {
        if (tidx() == 0) *slot = (int)atomicAdd(ctr, 1u);
        __syncthreads();
        const int u = *slot;
        __syncthreads();
        if (u >= 512) break;
        unit(a, u, sm);
    }
}
}

__device__ __forceinline__ void d_lora_prep(const bf16* pr, const float* mu, bf16* la) {
    const int T512 = tidx(), c = T512 & 255;
    const float m = mu[1536 + c];
    FOR_VB(vb, M_ / 4) {
        const int row0 = vb * 4;
        float x[5];
        x[0] = (row0 % T_) ? bf2f(pr[(size_t)(row0 - 1) * 256 + c]) : 0.f;
#pragma unroll
        for (int j = 0; j < 4; ++j) x[j + 1] = bf2f(pr[(size_t)(row0 + j) * 256 + c]);
#pragma unroll
        for (int j = 0; j < 4; ++j) { const float xs = x[j + 1] + (x[j] - x[j + 1]) * m;
            const float v = c < 64 ? tanhf(xs) : (c < 128 ? xs : sigmoidf_(xs));
            la[(size_t)(row0 + j) * KLORA + c] = (bf16)f2bf(v); }
    }
}

namespace rw7 {
using nsa::f32x16; using nsa::crow; using nsa::pack8;
constexpr int NHELP = 2, RG = 18;
constexpr int NPROD = 6, RING = 7, RA = 144, RB = 40, S_AT = 0, S_RT = 16 * RA, S_BT = 32 * RA, S_KT = S_BT + 64 * RB, S_VT = S_KT + 64 * RB, S_SM = S_VT + 64 * RB, SMM = 16 * RB, S_GC = S_SM + 4 * SMM, SLOT = S_GC + 256;
constexpr int OFF_SCR = RING * SLOT, SCR = 32 * RA, LDS_NEED = OFF_SCR;
static_assert(NPROD % NHELP == 0 && LDS_NEED <= 147456 - 64 && 6 * (SLOT + SCR) <= 147456 - 64 && (size_t)16 * NHELP * RG * SLOT <= (size_t)9 << 20 && SLOT % 16 == 0 && S_BT % 16 == 0 && 128 * RB >= 4096 && SCR >= 4096, "rw7 lds map");
struct Args { const unsigned* rkw; const bf16* vv; const bf16* aga; const float* wdec; const float *mu, *kk, *ka, *rk; float* yraw; float* bonus; unsigned char* ring; unsigned* flags; unsigned* cons; };
__device__ __forceinline__ void wg_bar() { asm volatile("s_waitcnt lgkmcnt(0)" ::: "memory"); __builtin_amdgcn_s_barrier(); asm volatile("" ::: "memory"); }
struct Chan { float mur, muk, muv, kkc, kac, rkc; };
struct Raw { unsigned rk[16]; unsigned short v[16], al[16]; float w[16]; unsigned prk; unsigned short pv; };
__device__ __forceinline__ void fetch(const Args& a, int b, int h, int c, int lane, Raw& q) {
    const size_t base = ((size_t)b * T_ + (size_t)c * 16) * 512 + h * 64 + lane;
#pragma unroll
    for (int t = 0; t < 16; ++t) { q.rk[t] = a.rkw[base + (size_t)t * 512]; q.v[t] = a.vv[base + (size_t)t * 512]; q.al[t] = a.aga[base + (size_t)t * 512]; q.w[t] = a.wdec[base + (size_t)t * 512]; }
    q.prk = 0u; q.pv = 0;
    if (c > 0) { q.prk = a.rkw[base - 512]; q.pv = a.vv[base - 512]; }
}
__device__ __forceinline__ void st_row40(unsigned char* p, const unsigned (&w)[8]) {
    *(u32x2*)p = (u32x2){w[0], w[1]}; *(u32x2*)(p + 8) = (u32x2){w[2], w[3]}; *(u32x2*)(p + 16) = (u32x2){w[4], w[5]}; *(u32x2*)(p + 24) = (u32x2){w[6], w[7]};
}
template <bool BAR> __device__ __forceinline__ void seg_end() { if (BAR) wg_bar(); else { asm volatile("s_waitcnt lgkmcnt(0)" ::: "memory"); __builtin_amdgcn_sched_barrier(0); } }
template <bool BAR> __device__ __forceinline__ void produce(const Args& a, const Chan& ch, int b, int h, int c, const Raw& q, unsigned char* slot, unsigned char* scr, int lane) {
    const int i = lane & 31, hi = lane >> 5;
    const size_t row0 = (size_t)b * T_ + (size_t)c * 16;
    float pr_r = __builtin_bit_cast(float, q.prk << 16), pr_k = __builtin_bit_cast(float, q.prk & 0xffff0000u), pr_v = bf2f(q.pv);
    float rr[16], kq[16], kt[16];
    float* RED1 = (float*)scr;
    float* RED2 = (float*)(slot + S_BT);
#pragma unroll
    for (int t4 = 0; t4 < 4; ++t4) { f32x4 e1, e2;
#pragma unroll
        for (int e = 0; e < 4; ++e) { const int t = 4 * t4 + e;
            const float r0 = __builtin_bit_cast(float, q.rk[t] << 16), k0 = __builtin_bit_cast(float, q.rk[t] & 0xffff0000u), al = bf2f(q.al[t]);
            const float r = r0 + (pr_r - r0) * ch.mur, k = k0 + (pr_k - k0) * ch.muk;
            pr_r = r0; pr_k = k0;
            rr[t] = r; kq[t] = k * ch.kkc; kt[t] = k * (1.f + (al - 1.f) * ch.kac);
            e1[e] = kq[t] * kq[t]; e2[e] = r * kt[t] * ch.rkc; }
        *(f32x4*)(RED1 + lane * 16 + 4 * t4) = e1; *(f32x4*)(RED2 + lane * 16 + 4 * t4) = e2; }
    seg_end<BAR>();
    { const int t = lane & 15, part = lane >> 4; float s1 = 0.f, s2 = 0.f;
#pragma unroll
      for (int j = 0; j < 16; ++j) { s1 += RED1[(part * 16 + j) * 16 + t]; s2 += RED2[(part * 16 + j) * 16 + t]; }
      s1 += __shfl_xor(s1, 16); s2 += __shfl_xor(s2, 16); s1 += __shfl_xor(s1, 32); s2 += __shfl_xor(s2, 32);
      asm volatile("s_waitcnt lgkmcnt(0)" ::: "memory");
      if (lane < 16) { ((float*)(slot + S_GC))[lane] = s1; a.bonus[(row0 + lane) * 8 + h] = s2; } }
    asm volatile("s_waitcnt lgkmcnt(0)" ::: "memory");
    f32x4 n2[4];
#pragma unroll
    for (int t4 = 0; t4 < 4; ++t4) n2[t4] = *(const f32x4*)(slot + S_GC + 16 * t4);
    asm volatile("s_waitcnt lgkmcnt(0)" ::: "memory");
    float gam = 1.f;
    unsigned btp[8], ktp[8], vtp[8];
    float b_ev = 0.f, k_ev = 0.f, v_ev = 0.f;
#pragma unroll
    for (int t = 0; t < 16; ++t) {
        if (t == 6) seg_end<BAR>();
        const float v0 = bf2f(q.v[t]), al = bf2f(q.al[t]);
        const float v = v0 + (pr_v - v0) * ch.muv; pr_v = v0;
        const float kkn = kq[t] * __builtin_amdgcn_rsqf(fmaxf(n2[t >> 2][t & 3], 1e-24f));
        const float gp = gam; gam *= q.w[t]; const float ig = __builtin_amdgcn_rcpf(gam);
        const float bt_ = kkn * al * ig, kt_ = kt[t] * ig;
        const unsigned ar = pk2(-kkn * gp, rr[t] * gam), bk = pk2(bt_, kt_);
        *(bf16*)(slot + S_AT + t * RA + lane * 2) = (bf16)(ar & 0xffffu); *(bf16*)(slot + S_RT + t * RA + lane * 2) = (bf16)(ar >> 16);
        *(bf16*)(scr + t * RA + lane * 2) = (bf16)(bk & 0xffffu); *(bf16*)(scr + (16 + t) * RA + lane * 2) = (bf16)(bk >> 16);
        if (t & 1) { btp[t >> 1] = pk2(b_ev, bt_); ktp[t >> 1] = pk2(k_ev, kt_); vtp[t >> 1] = pk2(v_ev, v); }
        else { b_ev = bt_; k_ev = kt_; v_ev = v; }
    }
    st_row40(slot + S_BT + lane * RB, btp); st_row40(slot + S_KT + lane * RB, ktp); st_row40(slot + S_VT + lane * RB, vtp);
    ((float*)(slot + S_GC))[lane] = gam;
    seg_end<BAR>();
    f32x16 C;
#pragma unroll
    for (int r = 0; r < 16; ++r) C[r] = 0.f;
#pragma unroll
    for (int ks = 0; ks < 4; ++ks) {
        const bf16x8 af = *(const bf16x8*)(slot + S_AT + i * RA + (16 * ks + 8 * hi) * 2);
        const bf16x8 bf = *(const bf16x8*)(scr + i * RA + (16 * ks + 8 * hi) * 2);
        C = __builtin_amdgcn_mfma_f32_32x32x16_bf16(af, bf, C, 0, 0, 0);
    }
    asm volatile("s_waitcnt lgkmcnt(0)" ::: "memory");
    float* AAB = (float*)scr;
    unsigned char* SM = slot + S_SM;
#pragma unroll
    for (int r = 0; r < 16; ++r) {
        const int rho = crow(r, hi); const float val = C[r];
        if (r < 8) {
            if (i < 16) AAB[rho * 16 + i] = (i < rho) ? val : 0.f;
            else *(bf16*)(SM + SMM + rho * RB + (i - 16) * 2) = (bf16)f2bf((i - 16 < rho) ? val : 0.f);
        } else {
            const int tt = rho - 16;
            if (i < 16) *(bf16*)(SM + 2 * SMM + tt * RB + i * 2) = (bf16)f2bf((i <= tt) ? val : 0.f);
            else *(bf16*)(SM + 3 * SMM + tt * RB + (i - 16) * 2) = (bf16)f2bf((i - 16 <= tt) ? val : 0.f);
        }
    }
    seg_end<BAR>();
    { const int j = lane & 15; float Tr[16];
#pragma unroll
      for (int t = 0; t < 16; ++t) { if (t == 11) seg_end<BAR>();
          float acc = (t == j) ? 1.f : 0.f;
#pragma unroll
          for (int s4 = 0; s4 < (t + 3) / 4; ++s4) { const f32x4 ar = *(const f32x4*)(AAB + t * 16 + 4 * s4);
#pragma unroll
              for (int e = 0; e < 4; ++e) if (4 * s4 + e < t) acc += ar[e] * Tr[4 * s4 + e]; }
          Tr[t] = acc;
          if (lane < 16) *(bf16*)(SM + t * RB + j * 2) = (bf16)f2bf(acc); } }
    seg_end<BAR>();
}

__device__ __forceinline__ bf16x8 rd_perm(const unsigned char* p, int hi) {
    const u32x2 a = *(const u32x2*)(p + 8 * hi), b = *(const u32x2*)(p + 16 + 8 * hi);
    return __builtin_bit_cast(bf16x8, (u32x4){a.x, a.y, b.x, b.y});
}
__device__ __forceinline__ bf16x8 rd_nat(const unsigned char* p, int hi) {
    const u32x2 a = *(const u32x2*)(p + 16 * hi), b = *(const u32x2*)(p + 16 * hi + 8);
    return __builtin_bit_cast(bf16x8, (u32x4){a.x, a.y, b.x, b.y});
}
__device__ __forceinline__ bf16x8 and8(bf16x8 f, unsigned m) { u32x4 w = __builtin_bit_cast(u32x4, f); w.x &= m; w.y &= m; w.z &= m; w.w &= m; return __builtin_bit_cast(bf16x8, w); }
__device__ __forceinline__ void consume(const unsigned char* slot, f32x16 (&z)[2], float* yout, int vt, int lane) {
    const int i = lane & 31, hi = lane >> 5, i16 = i & 15;
    const unsigned m16 = i < 16 ? 0xffffffffu : 0u;
    const unsigned char* at = slot + S_AT + i16 * RA; const unsigned char* rt = slot + S_RT + i16 * RA; const unsigned char* sm16 = slot + S_SM + i16 * RB;
    bf16x8 fa0 = rd_perm(at, hi), fa1 = rd_perm(at + 32, hi), fa2 = rd_perm(at + 64, hi), fa3 = rd_perm(at + 96, hi);
    bf16x8 fak = rd_nat(sm16 + SMM, hi), ft = rd_perm(sm16, hi);
    const bf16x8 vtf = rd_nat(slot + S_VT + (32 * vt + i) * RB, hi);
    bf16x8 fr0 = rd_perm(rt, hi), fr1 = rd_perm(rt + 32, hi), fr2 = rd_perm(rt + 64, hi), fr3 = rd_perm(rt + 96, hi);
    bf16x8 frb = rd_perm(sm16 + 2 * SMM, hi), frk = rd_nat(sm16 + 3 * SMM, hi);
    const bf16x8 fk0 = rd_nat(slot + S_KT + i * RB, hi), fk1 = rd_nat(slot + S_KT + (32 + i) * RB, hi);
    const bf16x8 fb0 = rd_perm(slot + S_BT + i * RB, hi), fb1 = rd_perm(slot + S_BT + (32 + i) * RB, hi);
    f32x4 g4[2][4];
#pragma unroll
    for (int kt = 0; kt < 2; ++kt)
#pragma unroll
        for (int rg = 0; rg < 4; ++rg) g4[kt][rg] = *(const f32x4*)(slot + S_GC + (32 * kt + 8 * rg + 4 * hi) * 4);
    const bf16x8 zb0 = pack8(z[0], 0), zb1 = pack8(z[0], 8), zb2 = pack8(z[1], 0), zb3 = pack8(z[1], 8);
    fa0 = and8(fa0, m16); fa1 = and8(fa1, m16); fa2 = and8(fa2, m16); fa3 = and8(fa3, m16); fak = and8(fak, m16); ft = and8(ft, m16);
    fr0 = and8(fr0, m16); fr1 = and8(fr1, m16); fr2 = and8(fr2, m16); fr3 = and8(fr3, m16); frb = and8(frb, m16); frk = and8(frk, m16);
    f32x16 X, U, Y;
#pragma unroll
    for (int r = 0; r < 16; ++r) { X[r] = 0.f; U[r] = 0.f; Y[r] = 0.f; }
    X = __builtin_amdgcn_mfma_f32_32x32x16_bf16(fa0, zb0, X, 0, 0, 0);
    X = __builtin_amdgcn_mfma_f32_32x32x16_bf16(fa1, zb1, X, 0, 0, 0);
    X = __builtin_amdgcn_mfma_f32_32x32x16_bf16(fa2, zb2, X, 0, 0, 0);
    X = __builtin_amdgcn_mfma_f32_32x32x16_bf16(fa3, zb3, X, 0, 0, 0);
    X = __builtin_amdgcn_mfma_f32_32x32x16_bf16(fak, vtf, X, 0, 0, 0);
    Y = __builtin_amdgcn_mfma_f32_32x32x16_bf16(fr0, zb0, Y, 0, 0, 0);
    Y = __builtin_amdgcn_mfma_f32_32x32x16_bf16(fr1, zb1, Y, 0, 0, 0);
    Y = __builtin_amdgcn_mfma_f32_32x32x16_bf16(fr2, zb2, Y, 0, 0, 0);
    Y = __builtin_amdgcn_mfma_f32_32x32x16_bf16(fr3, zb3, Y, 0, 0, 0);
    Y = __builtin_amdgcn_mfma_f32_32x32x16_bf16(frk, vtf, Y, 0, 0, 0);
    z[0] = __builtin_amdgcn_mfma_f32_32x32x16_bf16(fk0, vtf, z[0], 0, 0, 0);
    z[1] = __builtin_amdgcn_mfma_f32_32x32x16_bf16(fk1, vtf, z[1], 0, 0, 0);
    const bf16x8 xb = pack8(X, 0);
    U = __builtin_amdgcn_mfma_f32_32x32x16_bf16(ft, xb, U, 0, 0, 0);
    const bf16x8 ub = pack8(U, 0);
    z[0] = __builtin_amdgcn_mfma_f32_32x32x16_bf16(fb0, ub, z[0], 0, 0, 0);
    z[1] = __builtin_amdgcn_mfma_f32_32x32x16_bf16(fb1, ub, z[1], 0, 0, 0);
    Y = __builtin_amdgcn_mfma_f32_32x32x16_bf16(frb, ub, Y, 0, 0, 0);
#pragma unroll
    for (int kt = 0; kt < 2; ++kt)
#pragma unroll
        for (int rg = 0; rg < 4; ++rg)
#pragma unroll
            for (int e = 0; e < 4; ++e) z[kt][4 * rg + e] *= g4[kt][rg][e];
#pragma unroll
    for (int r = 0; r < 8; ++r) yout[(size_t)crow(r, hi) * 512] = Y[r];
}

__device__ __forceinline__ unsigned ld_relaxed(const unsigned* p) { return __hip_atomic_load(p, __ATOMIC_RELAXED, __HIP_MEMORY_SCOPE_AGENT); }
__device__ __forceinline__ void head(const Args& a, int bh, unsigned char* sm) {
    const int tid = tidx(), lane = tid & 63, w = __builtin_amdgcn_readfirstlane(tid >> 6);
    const int b = bh >> 3, h = bh & 7;
    constexpr int NCH = T_ / 16, NBAR = NCH + NPROD;
    if (w < 2) {
        f32x16 z[2];
#pragma unroll
        for (int r = 0; r < 16; ++r) { z[0][r] = 0.f; z[1][r] = 0.f; }
        for (int i = 0; i < NPROD; ++i) wg_bar();
        for (int c = 0; c < NCH; ++c) {
            consume(sm + (size_t)(c % RING) * SLOT, z, a.yraw + ((size_t)b * T_ + (size_t)c * 16) * 512 + h * 64 + 32 * w + (lane & 31), w, lane);
            if (w == 0 && (c & 7) == 7 && lane == 0) __hip_atomic_store(a.cons + bh * 64, (unsigned)(c + 1), __ATOMIC_RELAXED, __HIP_MEMORY_SCOPE_AGENT);
            wg_bar();
        }
    } else {
        const int pw = w - 2;
        int nb = pw;
        {
            u32x4 v[15];
            { const int c = pw; const int hl = c % NHELP, n = c / NHELP;
              const unsigned char* g = a.ring + ((size_t)(bh * NHELP + hl) * RG + (n % RG)) * SLOT;
              while (__builtin_amdgcn_readfirstlane(ld_relaxed(a.flags + bh * NCH + c)) == 0u) __builtin_amdgcn_s_sleep(2);
              __builtin_amdgcn_fence(__ATOMIC_ACQUIRE, "agent");
              asm volatile("s_waitcnt vmcnt(0)" ::: "memory");
#pragma unroll
              for (int i = 0; i < 15; ++i) { const int off = (i * 64 + lane) * 16; if (off < SLOT) v[i] = *(const u32x4*)(g + off); } }
            for (int i = 0; i < pw; ++i) wg_bar();
            for (int c = pw; c < NCH; c += NPROD) {
                unsigned char* slot = sm + (size_t)(c % RING) * SLOT;
#pragma unroll
                for (int i = 0; i < 15; ++i) { const int off = (i * 64 + lane) * 16; if (off < SLOT) *(u32x4*)(slot + off) = v[i]; }
                const int cn = c + NPROD; const bool more = cn < NCH;
                const unsigned* fp = a.flags + bh * NCH + (more ? cn : c);
                unsigned fl = ld_relaxed(fp);
                wg_bar(); wg_bar();
                if (more) {
                    while (__builtin_amdgcn_readfirstlane(fl) == 0u) { __builtin_amdgcn_s_sleep(2); fl = ld_relaxed(fp); }
                    __builtin_amdgcn_fence(__ATOMIC_ACQUIRE, "agent");
                    asm volatile("s_waitcnt vmcnt(0)" ::: "memory");
                    const int hl = cn % NHELP, n = cn / NHELP;
                    const unsigned char* g = a.ring + ((size_t)(bh * NHELP + hl) * RG + (n % RG)) * SLOT;
#pragma unroll
                    for (int i = 0; i < 15; ++i) { const int off = (i * 64 + lane) * 16; if (off < SLOT) v[i] = *(const u32x4*)(g + off); }
                }
                wg_bar(); wg_bar(); wg_bar(); wg_bar();
                nb += NPROD;
            }
        }
        for (; nb < NBAR; ++nb) wg_bar();
    }
}
__device__ __forceinline__ void helper(const Args& a, int bh, int hl, unsigned char* sm) {
    const int tid = tidx(), lane = tid & 63, w = __builtin_amdgcn_readfirstlane(tid >> 6);
    if (w >= 6) return;
    const int b = bh >> 3, h = bh & 7, col = h * 64 + lane;
    constexpr int NCH = T_ / 16;
    unsigned char* slot = sm + (size_t)w * SLOT; unsigned char* scr = sm + 6 * SLOT + w * SCR;
    const Chan ch{a.mu[col], a.mu[512 + col], a.mu[1024 + col], a.kk[col], a.ka[col], a.rk[col]};
    int n = w, c = NHELP * n + hl;
    if (c >= NCH) return;
    for (; c < NCH; n += 6, c += 6 * NHELP) {
        Raw q; fetch(a, b, h, c, lane, q);
        if (n >= RG) { const unsigned need = (unsigned)(c - RG * NHELP + 1);
            while (__builtin_amdgcn_readfirstlane(ld_relaxed(a.cons + bh * 64)) < need) __builtin_amdgcn_s_sleep(8); }
        produce<false>(a, ch, b, h, c, q, slot, scr, lane);
        asm volatile("s_waitcnt lgkmcnt(0)" ::: "memory");
        unsigned char* g = a.ring + ((size_t)(bh * NHELP + hl) * RG + (n % RG)) * SLOT;
#pragma unroll
        for (int i = 0; i < 15; ++i) { const int off = (i * 64 + lane) * 16;
            if (off < SLOT) { const u32x4 d = *(const u32x4*)(slot + off); unsigned char* gp = g + off; asm volatile("global_store_dwordx4 %0, %1, off sc1\n\ts_nop 1" :: "v"(gp), "v"(d) : "memory"); } }
        asm volatile("s_waitcnt vmcnt(0)" ::: "memory");
        if (lane == 0) __hip_atomic_store(a.flags + bh * NCH + c, 1u, __ATOMIC_RELAXED, __HIP_MEMORY_SCOPE_AGENT);
    }
}
__device__ __forceinline__ void finish(const float* yraw, const float* bonus, const bf16* vv, const bf16* agg, const float* mu, const float* gng, const float* gnb, bf16* amix) {
    const int T512 = tidx(), lane = T512 & 63;
    for (int it0 = (blockIdx.x * 8 + (T512 >> 6)) * 4; it0 < M_ * 8; it0 += gridDim.x * 8 * 4) {
        const int row = it0 >> 3, h0 = it0 & 7, t = row % T_;
        float y[4], v0[4], v1[4], gg[4], bo[4];
#pragma unroll
        for (int j = 0; j < 4; ++j) { const int col = (h0 + j) * 64 + lane;
            y[j] = yraw[(size_t)row * 512 + col]; v0[j] = bf2f(vv[(size_t)row * 512 + col]); v1[j] = t ? bf2f(vv[(size_t)(row - 1) * 512 + col]) : 0.f;
            gg[j] = bf2f(agg[(size_t)row * 512 + col]); bo[j] = bonus[(size_t)row * 8 + h0 + j]; }
        float mean[4], var[4];
#pragma unroll
        for (int j = 0; j < 4; ++j) mean[j] = y[j];
#pragma unroll
        for (int o = 1; o < 64; o <<= 1) {
#pragma unroll
            for (int j = 0; j < 4; ++j) mean[j] += __shfl_xor(mean[j], o); }
#pragma unroll
        for (int j = 0; j < 4; ++j) { mean[j] *= (1.f / 64.f); y[j] -= mean[j]; var[j] = y[j] * y[j]; }
#pragma unroll
        for (int o = 1; o < 64; o <<= 1) {
#pragma unroll
            for (int j = 0; j < 4; ++j) var[j] += __shfl_xor(var[j], o); }
#pragma unroll
        for (int j = 0; j < 4; ++j) { const int col = (h0 + j) * 64 + lane;
            const float yn = y[j] * rsqrtf(var[j] * (1.f / 64.f) + 64e-5f) * gng[col] + gnb[col];
            const float v = v0[j] + (v1[j] - v0[j]) * mu[1024 + col];
            amix[(size_t)row * DM + 512 + col] = (bf16)f2bf((yn + bo[j] * v) * gg[j]); }
    }
}
}

namespace mema {
using nsa::f32x16; using nsa::KROW; using nsa::VROW; using nsa::KBUF; using nsa::VBUF; using nsa::OFF_K; using nsa::OFF_V; using nsa::OFF_WS; using nsa::crow; using nsa::pack8;
__device__ __forceinline__ void unit(const bf16* qm, const bf16* mk, const bf16* mvt, bf16* om, int u, unsigned char* sm) {
    const int tid = tidx(), lane = tid & 63, w = __builtin_amdgcn_readfirstlane(tid >> 6), i = lane & 31, hi = lane >> 5;
    const int b = u >> 7, h = (u >> 5) & 3, rb = u & 31;
    const int row0 = b * T_ + rb * 256 + 32 * w;
    const bf16* qrow = qm + (size_t)(row0 + i) * DM + h * 256 + 8 * hi;
    const bf16* kbase = mk + (size_t)(b * 256 + (tid >> 3)) * DM + h * 256 + (tid & 7) * 8;
    const bf16* vbase = mvt + (size_t)(h * 256 + (tid >> 3)) * 512 + b * 256 + (tid & 7) * 8;
    unsigned char* kst = sm + OFF_K + (tid >> 3) * KROW + (tid & 7) * 16;
    unsigned char* vst = sm + OFF_V + (tid >> 3) * VROW + (tid & 7) * 16;
    float* wsc = (float*)(sm + OFF_WS) + w * 32;
    f32x16 p[4][2];
#pragma unroll
    for (int kt = 0; kt < 4; ++kt)
#pragma unroll
        for (int r = 0; r < 16; ++r) { p[kt][0][r] = 0.f; p[kt][1][r] = 0.f; }
    u32x4 tr[4];
#define MEMA_SRC(n) ((n) < 16 ? (const u32x4*)(kbase + (size_t)(64 * ((n) & 3)) * DM + 64 * ((n) >> 2)) : (const u32x4*)(vbase + (size_t)(64 * (((n) - 16) >> 2)) * 512 + 64 * ((n) & 3)))
#define MEMA_PUT(n) do { if ((n) < 16) *(u32x4*)(kst + ((n) & 1) * KBUF) = tr[(n) & 3]; else { unsigned char* vp2_ = vst + ((n) & 1) * VBUF; *(u32x2*)vp2_ = (u32x2){tr[(n) & 3].x, tr[(n) & 3].y}; *(u32x2*)(vp2_ + 8) = (u32x2){tr[(n) & 3].z, tr[(n) & 3].w}; } } while (0)
    tr[0] = *MEMA_SRC(0); tr[1] = *MEMA_SRC(1); tr[2] = *MEMA_SRC(2);
    MEMA_PUT(0);
    __syncthreads();
    bf16x8 qf[4];
#pragma unroll
    for (int n = 0; n < 16; ++n) {
        const int dc = n >> 2, kt = n & 3, cb = n & 1;
        tr[(n + 3) & 3] = *MEMA_SRC(n + 3);
        if (kt == 0) {
#pragma unroll
            for (int d0 = 0; d0 < 4; ++d0) qf[d0] = *(const bf16x8*)(qrow + 64 * dc + 16 * d0);
        }
        const unsigned char* kb = sm + OFF_K + cb * KBUF;
#pragma unroll
        for (int d0 = 0; d0 < 4; ++d0) {
            const bf16x8 a0 = *(const bf16x8*)(kb + i * KROW + (16 * d0 + 8 * hi) * 2);
            const bf16x8 a1 = *(const bf16x8*)(kb + (32 + i) * KROW + (16 * d0 + 8 * hi) * 2);
            p[kt][0] = __builtin_amdgcn_mfma_f32_32x32x16_bf16(a0, qf[d0], p[kt][0], 0, 0, 0);
            p[kt][1] = __builtin_amdgcn_mfma_f32_32x32x16_bf16(a1, qf[d0], p[kt][1], 0, 0, 0);
        }
        MEMA_PUT(n + 1);
        __syncthreads();
    }
    float mx = p[0][0][0];
#pragma unroll
    for (int kt = 0; kt < 4; ++kt)
#pragma unroll
        for (int r = 0; r < 16; ++r) mx = fmaxf(mx, fmaxf(p[kt][0][r], p[kt][1][r]));
    mx = fmaxf(mx, __shfl_xor(mx, 32));
    float l = 0.f;
#pragma unroll
    for (int kt = 0; kt < 4; ++kt)
#pragma unroll
        for (int r = 0; r < 16; ++r) { p[kt][0][r] = __builtin_amdgcn_exp2f(p[kt][0][r] - mx); p[kt][1][r] = __builtin_amdgcn_exp2f(p[kt][1][r] - mx); l += p[kt][0][r] + p[kt][1][r]; }
    l += __shfl_xor(l, 32);
    bf16x8 pf[4][4];
#pragma unroll
    for (int kt = 0; kt < 4; ++kt) { pf[kt][0] = pack8(p[kt][0], 0); pf[kt][1] = pack8(p[kt][0], 8); pf[kt][2] = pack8(p[kt][1], 0); pf[kt][3] = pack8(p[kt][1], 8); }
    if (hi == 0) wsc[i] = 1.f / l;
    asm volatile("" ::: "memory");
    f32x4 il[4];
#pragma unroll
    for (int rg = 0; rg < 4; ++rg) il[rg] = *(const f32x4*)(wsc + 8 * rg + 4 * hi);
    f32x16 o[2];
#pragma unroll
    for (int n = 16; n < 32; ++n) {
        const int dvt = (n - 16) >> 2, kt = n & 3, cb = n & 1;
        if (n + 3 < 32) tr[(n + 3) & 3] = *MEMA_SRC(n + 3);
        if (kt == 0) {
#pragma unroll
            for (int r = 0; r < 16; ++r) { o[0][r] = 0.f; o[1][r] = 0.f; }
        }
        const unsigned char* vb = sm + OFF_V + cb * VBUF;
#pragma unroll
        for (int dt = 0; dt < 2; ++dt) {
            const unsigned char* vp = vb + (32 * dt + i) * VROW + 8 * hi;
#pragma unroll
            for (int ks = 0; ks < 4; ++ks) {
                const u32x2 v_lo = *(const u32x2*)(vp + 32 * ks), v_hi = *(const u32x2*)(vp + 32 * ks + 16);
                const bf16x8 vf = __builtin_bit_cast(bf16x8, (u32x4){v_lo.x, v_lo.y, v_hi.x, v_hi.y});
                o[dt] = __builtin_amdgcn_mfma_f32_32x32x16_bf16(pf[kt][ks], vf, o[dt], 0, 0, 0);
            }
        }
        if (kt == 3) {
#pragma unroll
            for (int r = 0; r < 16; ++r) { bf16* op = om + (size_t)(row0 + crow(r, hi)) * DM + h * 256 + 64 * dvt + i;
                op[0] = (bf16)f2bf(o[0][r] * il[r >> 2][r & 3]); op[32] = (bf16)f2bf(o[1][r] * il[r >> 2][r & 3]); }
        }
        if (n + 1 < 32) MEMA_PUT(n + 1);
        __syncthreads();
    }
#undef MEMA_SRC
#undef MEMA_PUT
}
}

#define LAS __attribute__((address_space(3)))
#define XB_TMO      128
#define XB_XCNT(j)  (256  + 64 * (j))
#define XB_XSUB(j)  (1280 + 64 * (j))
#define XB_XGEN(j)  (2304 + 64 * (j))
#define XB_TOP      3328
#define XB_TOPGEN   3392
#define XCD_BAR_WORDS 3456
#define XB_SPIN_CAP (1u << 18)

__device__ __forceinline__ unsigned xb_ld(unsigned* p)              { return __hip_atomic_load(p, __ATOMIC_RELAXED, __HIP_MEMORY_SCOPE_AGENT); }
__device__ __forceinline__ unsigned xb_add(unsigned* p, unsigned v) { return __hip_atomic_fetch_add(p, v, __ATOMIC_RELAXED, __HIP_MEMORY_SCOPE_AGENT); }
__device__ __forceinline__ unsigned xb_xcc_id() { return (unsigned)__builtin_amdgcn_s_getreg((3 << 11) | 20) & 0xFu; }
#define XB_SPIN(cond, bar) do { unsigned _sp = 0; while (cond) { __builtin_amdgcn_s_sleep(1); \
    if ((++_sp & 255u) == 0u) { if (xb_ld(&(bar)[XB_TMO])) break; if (_sp > XB_SPIN_CAP) { atomicAdd(&(bar)[XB_TMO], 1u); break; } } } } while (0)

struct XcdBarrier {
    unsigned* bar; unsigned x;
    volatile LAS unsigned* st;
};

__device__ __forceinline__ XcdBarrier xcd_barrier_post(unsigned* bar, volatile LAS unsigned* st) {
    XcdBarrier b; b.bar = bar; b.x = xb_xcc_id(); b.st = st;
    if (tidx() == 0) (void)xb_add(&bar[XB_XCNT(b.x)], 1u);
    return b;
}
__device__ __forceinline__ void xcd_barrier_complete(unsigned* bar, unsigned x, unsigned& nloc, unsigned& nx) {
    const unsigned G = gridDim.x * gridDim.y * gridDim.z;
    unsigned sum, cnt, mine, sp = 0u;
    for (;;) {
        sum = 0u; cnt = 0u; mine = 0u;
#pragma unroll
        for (unsigned j = 0; j < 16; ++j) { const unsigned c = xb_ld(&bar[XB_XCNT(j)]); sum += c; cnt += (c > 0u) ? 1u : 0u; mine = (j == x) ? c : mine; }
        if (sum == G) break;
        __builtin_amdgcn_s_sleep(1);
        if ((++sp & 255u) == 0u) { if (xb_ld(&bar[XB_TMO])) break; if (sp > XB_SPIN_CAP) { atomicAdd(&bar[XB_TMO], 1u); break; } }
    }
    nloc = mine > 0u ? mine : 1u; nx = cnt > 0u ? cnt : 1u;
}

__device__ __forceinline__ void xcd_barrier(const XcdBarrier& b) {
    asm volatile("s_waitcnt vmcnt(0)" ::: "memory");
    __syncthreads();
    if (tidx() == 0) {
        unsigned* bar = b.bar;
        __builtin_amdgcn_s_waitcnt(0);
        unsigned nloc = b.st[0], nx = b.st[1];
        if (nloc == 0u) { xcd_barrier_complete(bar, b.x, nloc, nx); b.st[0] = nloc; b.st[1] = nx; }
        const unsigned old = xb_add(&bar[XB_XSUB(b.x)], 1u);
        const unsigned gen = old / nloc;
        if (old + 1u == (gen + 1u) * nloc) {
            __builtin_amdgcn_fence(__ATOMIC_RELEASE, "agent");
            asm volatile("s_waitcnt vmcnt(0)" ::: "memory");
            const unsigned og = xb_add(&bar[XB_TOP], 1u);
            const unsigned tg = og / nx;
            if (og + 1u == (tg + 1u) * nx) xb_add(&bar[XB_TOPGEN], 1u);
            else XB_SPIN(xb_ld(&bar[XB_TOPGEN]) == tg, bar);
            __builtin_amdgcn_fence(__ATOMIC_ACQUIRE, "agent");
            xb_add(&bar[XB_XGEN(b.x)], 1u);
            asm volatile("s_waitcnt vmcnt(0)" ::: "memory");
        } else {
            XB_SPIN(xb_ld(&bar[XB_XGEN(b.x)]) == gen, bar);
            __builtin_amdgcn_fence(__ATOMIC_ACQUIRE, "agent");
            asm volatile("s_waitcnt vmcnt(0)" ::: "memory");
        }
    }
    __syncthreads();
}

constexpr int NTHREADS = 512, LDS_BYTES = 147456;
struct MegaArgs { const float* in[41]; float* out; unsigned char* ws; };
#define WSB(off) ((bf16*)(ws + (off)))
#define WSF(off) ((float*)(ws + (off)))

__global__ void __launch_bounds__(NTHREADS) mega_fwd(MegaArgs A) {
    extern __shared__ __attribute__((aligned(16))) unsigned char lds[];
    cg::grid_group grid = cg::this_grid();
    const float* const* in = A.in; unsigned char* ws = A.ws; float* out = A.out;
    if (tidx() < 2) ((volatile LAS unsigned*)(lds + LDS_BYTES - 64))[tidx()] = 0u;
    __syncthreads();
    const XcdBarrier xbar = xcd_barrier_post((unsigned*)(ws + WS_CTL) + 16384, (volatile LAS unsigned*)(lds + LDS_BYTES - 64));

    d_convert(WSB(WS_W1GU), NGU, DM, MapGU{in[I_F1_WG], in[I_F1_WU], FF});
    d_convert(WSB(WS_W1D), DM, FF, MapPlain{in[I_F1_WD], DM});
    d_convert(WSB(WS_W2GU), NGU, DM, MapGU{in[I_F2_WG], in[I_F2_WU], FF});
    d_convert(WSB(WS_W2D), DM, FF, MapPlain{in[I_F2_WD], DM});
    d_convert(WSB(WS_WIN), NWIN, DM, MapWin{in[I_WIN], IN_COLS});
    d_convert(WSB(WS_WOUT), DM, DM, MapPlain{in[I_WOUT], DM});
    d_convert(WSB(WS_WQ), DM, DM, MapPlain{in[I_WQ], DM});
    d_convert(WSB(WS_WK), DM, DM, MapPlain{in[I_WK], DM});
    d_convert(WSB(WS_WV), DM, DM, MapPlain{in[I_WV], DM});
    d_convert(WSB(WS_WO), DM, DM, MapPlain{in[I_WO], DM});
    d_convert(WSB(WS_CW1K), 256, 2048, MapPlain{in[I_W1_K], 256});
    d_convert(WSB(WS_CW1V), 256, 2048, MapPlain{in[I_W1_V], 256});
    d_convert_lora(WSB(WS_WLORA), in[I_W2], in[I_A2], in[I_G2]);
    d_convert(WSB(WS_CW2), 64, 256, MapPlain{in[I_W2_K], 64});
    d_convert(WSB(WS_CW2) + 64 * 256, 64, 256, MapPlain{in[I_W2_V], 64});
    d_rope_table(WSF(WS_ROPE));
    d_cmp_bias(in[I_PE_K], in[I_W1_K], in[I_PE_V], in[I_W1_V], WSF(WS_CBIAS), (float*)lds);
    d_rownorm(in[I_X], in[I_F1_PRE], WSB(WS_XN), M_);
    d_rownorm(in[I_MEM], in[I_MEM_KVG], WSB(WS_MEMN), 512);
    grid.sync();
    gemm_pg8(lds, WSB(WS_XN), DM, WSB(WS_W1GU), DM, M_, NGU, DM, EpiSwiGLU{WSB(WS_HB)});
    xcd_barrier(xbar);
    gemm_norm_res(lds, WSB(WS_HB), FF, WSB(WS_W1D), FF, in[I_X], out, WSB(WS_XN), in[I_F1_POST], in[I_MIX_PRE], 0.5f, WSB(WS_YB), (unsigned*)(ws + WS_GATES), (unsigned*)(ws + WS_CTL) + 1024 + 0 * 2048);
    xcd_barrier(xbar);
    gemm_pg8(lds, WSB(WS_XN), DM, WSB(WS_WIN), DM, M_, 3072, DM,
             EpiWin{WSB(WS_QB), WSB(WS_KS), WSB(WS_KW), WSB(WS_KCR), WSB(WS_VCR), WSB(WS_VST), WSB(WS_VWT), (unsigned*)(ws + WS_RKVA), WSB(WS_RKVA + 32 * MiB), WSB(WS_PRL), WSF(WS_GATES), WSF(WS_ROPE)});
    d_gates(WSB(WS_XN), WSB(WS_WIN) + (size_t)3072 * DM, WSF(WS_GATES));
    xcd_barrier(xbar);
    gemm_pg8(lds, WSB(WS_KCR), 1024, WSB(WS_CW1K), 2048, 2048, 256, 2048, EpiBiasSilu{WSB(WS_HIDK), WSF(WS_CBIAS)});
    gemm_pg8(lds, WSB(WS_VCR), 1024, WSB(WS_CW1V), 2048, 2048, 256, 2048, EpiBiasSilu{WSB(WS_HIDV), WSF(WS_CBIAS) + 256}, 8);
    d_lora_prep(WSB(WS_PRL), in[I_MU], WSB(WS_XN));
    xcd_barrier(xbar);
    d_cmp2(WSB(WS_HIDK), WSB(WS_HIDV), WSB(WS_CW2), WSF(WS_ROPE), WSB(WS_KC), WSB(WS_VCT));
    gemm_pg8(lds, WSB(WS_XN), KLORA, WSB(WS_WLORA), KLORA, M_, NLORA, KLORA, EpiLora{WSF(WS_YB), WSB(WS_RKVA + 48 * MiB), WSB(WS_AGG), in[I_W0], in[I_A0]});
    gemm_pg8(lds, WSB(WS_MEMN), DM, WSB(WS_WK), DM, 512, DM, DM, EpiStore{WSB(WS_CW1K), DM, 1.f});
    gemm_pg8(lds, WSB(WS_WV), DM, WSB(WS_MEMN), DM, DM, 512, DM, EpiStore{WSB(WS_CW1V), 512, 1.f});
    xcd_barrier(xbar);
    if (blockIdx.x < 16 * (1 + rw7::NHELP)) {
        const rw7::Args ra{(const unsigned*)(ws + WS_RKVA), WSB(WS_RKVA + 32 * MiB), WSB(WS_RKVA + 48 * MiB), WSF(WS_YB), in[I_MU], in[I_KK], in[I_KA], in[I_RK], WSF(WS_YB), WSF(WS_BONUS),
                           ws + WS_KCR + 1 * MiB, (unsigned*)(ws + WS_CTL) + 32768, (unsigned*)(ws + WS_CTL) + 24576};
        if (blockIdx.x < 16) rw7::head(ra, blockIdx.x, lds);
        else rw7::helper(ra, (blockIdx.x - 16) % 16, (blockIdx.x - 16) / 16, lds);
        __syncthreads();
    }
    {
        const NsaArgs na{WSB(WS_QB), WSB(WS_KC), WSB(WS_VCT), WSB(WS_KS), WSB(WS_VST), WSB(WS_KW), WSB(WS_VWT), WSF(WS_GATES), WSB(WS_XN)};
        nsa::phase(na, (unsigned*)(ws + WS_CTL), lds);
    }
    xcd_barrier(xbar);
    d_nsa_outnorm(WSB(WS_XN), in[I_NSA_G]);
    rw7::finish(WSF(WS_YB), WSF(WS_BONUS), WSB(WS_RKVA + 32 * MiB), WSB(WS_AGG), in[I_MU], in[I_GNG], in[I_GNB], WSB(WS_XN));
    xcd_barrier(xbar);
    gemm_norm_res(lds, WSB(WS_XN), DM, WSB(WS_WOUT), DM, out, out, WSB(WS_XN), in[I_MIX_POST], in[I_MEM_PRE], 1.0f, WSB(WS_YB), (unsigned*)(ws + WS_GATES), (unsigned*)(ws + WS_CTL) + 1024 + 1 * 2048);
    xcd_barrier(xbar);
    gemm_pg8(lds, WSB(WS_XN), DM, WSB(WS_WQ), DM, M_, DM, DM, EpiStore{WSB(WS_QM), DM, MSCALE});
    xcd_barrier(xbar);
    for (int u = blockIdx.x; u < 256; u += gridDim.x) mema::unit(WSB(WS_QM), WSB(WS_CW1K), WSB(WS_CW1V), WSB(WS_OM), u, lds);
    xcd_barrier(xbar);
    gemm_norm_res(lds, WSB(WS_OM), DM, WSB(WS_WO), DM, out, out, WSB(WS_XN), in[I_MEM_POST], in[I_F2_PRE], 1.0f, WSB(WS_YB), (unsigned*)(ws + WS_GATES), (unsigned*)(ws + WS_CTL) + 1024 + 2 * 2048);
    xcd_barrier(xbar);
    gemm_pg8(lds, WSB(WS_XN), DM, WSB(WS_W2GU), DM, M_, NGU, DM, EpiSwiGLU{WSB(WS_HB)});
    xcd_barrier(xbar);
    gemm_norm_res(lds, WSB(WS_HB), FF, WSB(WS_W2D), FF, out, out, (bf16*)nullptr, in[I_F2_POST], (const float*)nullptr, 0.5f, WSB(WS_YB), (unsigned*)(ws + WS_GATES), (unsigned*)(ws + WS_CTL) + 1024 + 3 * 2048);
}

extern "C" void kernel_launch(void* const* d_in, const int* in_sizes, int n_in, void* d_out, int out_size, void* d_ws, size_t ws_size, hipStream_t stream) {
    static int grid = 0;
    if (grid == 0) {
        if (n_in != 41 || ws_size < WS_END) { fprintf(stderr, "kernel_launch: unexpected n_in %d / ws %zu\n", n_in, ws_size); grid = -1; return; }
        int dev = 0, cus = 0, per_cu = 0;
        hipGetDevice(&dev); hipDeviceGetAttribute(&cus, hipDeviceAttributeMultiprocessorCount, dev);
        if (hipFuncSetAttribute((const void*)mega_fwd, hipFuncAttributeMaxDynamicSharedMemorySize, LDS_BYTES) != hipSuccess) { fprintf(stderr, "kernel_launch: hipFuncSetAttribute failed\n"); grid = -1; return; }
        if (hipOccupancyMaxActiveBlocksPerMultiprocessor(&per_cu, (const void*)mega_fwd, NTHREADS, LDS_BYTES) != hipSuccess || per_cu < 1) { fprintf(stderr, "kernel_launch: occupancy query says %d\n", per_cu); grid = -1; (void)hipGetLastError(); return; }
        grid = cus;
        if (grid != 256) { fprintf(stderr, "kernel_launch: built for 256 CUs (one 256x256 tile per workgroup in the fused norm epilogues), found %d\n", cus); grid = -1; return; }
    }
    if (grid < 0) return;
    MegaArgs a{};
    for (int i = 0; i < 41; ++i) a.in[i] = (const float*)d_in[i];
    a.out = (float*)d_out; a.ws = (unsigned char*)d_ws;
    hipMemsetAsync(d_ws, 0, 196608, stream);
    void* args[] = {&a};
    hipError_t e = hipLaunchCooperativeKernel((const void*)mega_fwd, dim3(grid), dim3(NTHREADS), args, LDS_BYTES, stream);
    if (e != hipSuccess) fprintf(stderr, "kernel_launch: cooperative launch failed: %s (grid %d)\n", hipGetErrorString(e), grid);
}
```

```cpp
#include <hip/hip_runtime.h>
#include <hip/hip_cooperative_groups.h>
#include <cstdint>
#include <cstdio>

constexpr int NB = 2, T_ = 8192, DM = 1024, M_ = NB * T_;
constexpr int FF = 2816, NGU = 2 * FF;
constexpr int IN_COLS = 3096, NWIN = 3328;
constexpr int NRW = 1792;
constexpr int NCP = 512;
constexpr int NLORA = 1536, KLORA = 256;
constexpr float NORM_EPS = 1e-6f;
constexpr float QSCALE = 0.125f * 1.4426950408889634f;
constexpr float MSCALE = 0.0625f * 1.4426950408889634f;

typedef unsigned short bf16;
typedef short bf16x8 __attribute__((ext_vector_type(8)));
typedef float f32x4 __attribute__((ext_vector_type(4)));
typedef unsigned u32x2 __attribute__((ext_vector_type(2)));
typedef unsigned u32x4 __attribute__((ext_vector_type(4)));

__device__ __forceinline__ unsigned f2bf(float f) { unsigned u = __builtin_bit_cast(unsigned, f); return (u + 0x7fffu + ((u >> 16) & 1u)) >> 16; }
__device__ __forceinline__ float bf2f(bf16 h) { return __builtin_bit_cast(float, (unsigned)h << 16); }
typedef float f32x2_t __attribute__((ext_vector_type(2))); typedef __bf16 bf16x2_t __attribute__((ext_vector_type(2)));
__device__ __forceinline__ unsigned pk2(float lo, float hi) { const f32x2_t v = {lo, hi}; return __builtin_bit_cast(unsigned, __builtin_convertvector(v, bf16x2_t)); }
__device__ __forceinline__ void st_bf4(bf16* p, f32x4 v) { u32x2 w; w.x = pk2(v[0], v[1]); w.y = pk2(v[2], v[3]); *(u32x2*)p = w; }
__device__ __forceinline__ float wave_sum(float v) {
#pragma unroll
    for (int o = 1; o < 64; o <<= 1) v += __shfl_xor(v, o);
    return v;
}
__device__ __forceinline__ float wave_max(float v) {
#pragma unroll
    for (int o = 1; o < 64; o <<= 1) v = fmaxf(v, __shfl_xor(v, o));
    return v;
}
__device__ __forceinline__ float sigmoidf_(float x) { return 1.f / (1.f + __expf(-x)); }
__device__ __forceinline__ int tidx() { int t = threadIdx.x; asm volatile("" : "+v"(t)); return t; }

constexpr size_t MiB = 1u << 20, KiB64 = 65536;
constexpr size_t WS_CTL = 0;
constexpr size_t WS_KC = 256 * 1024;
constexpr size_t WS_VCT = 512 * 1024;
constexpr size_t WS_CW2 = 768 * 1024;
constexpr size_t WS_W1GU = 1 * MiB;
constexpr size_t WS_W1D = 12 * MiB;
constexpr size_t WS_W2GU = WS_W1D + 88 * KiB64;
constexpr size_t WS_W2D = WS_W2GU + 11 * MiB;
constexpr size_t WS_WIN = WS_W2D + 88 * KiB64;
constexpr size_t WS_WOUT = WS_WIN + 104 * KiB64;
constexpr size_t WS_WQ = WS_WOUT + 2 * MiB, WS_WK = WS_WQ + 2 * MiB, WS_WV = WS_WK + 2 * MiB, WS_WO = WS_WV + 2 * MiB;
constexpr size_t WS_CW1K = WS_WO + 2 * MiB, WS_CW1V = WS_CW1K + 1 * MiB;
constexpr size_t WS_WLORA = WS_CW1V + 1 * MiB;
constexpr size_t WS_ROPE = WS_WLORA + 12 * KiB64;
constexpr size_t WS_CBIAS = WS_ROPE + 2 * MiB;
constexpr size_t WS_MEMN = WS_CBIAS + KiB64;
constexpr size_t WS_HIDK = WS_MEMN + 1 * MiB;
constexpr size_t WS_HIDV = WS_HIDK + 1 * MiB;
constexpr size_t WS_GATES = WS_HIDV + 1 * MiB;
constexpr size_t WS_XN = 60 * MiB;
constexpr size_t WS_YB = 92 * MiB;
constexpr size_t WS_D = 124 * MiB;
constexpr size_t WS_HB = WS_D;
constexpr size_t WS_QB = WS_D;
constexpr size_t WS_KS = WS_D + 16 * MiB;
constexpr size_t WS_KW = WS_D + 20 * MiB;
constexpr size_t WS_KCR = WS_D + 24 * MiB;
constexpr size_t WS_VCR = WS_D + 29 * MiB;
constexpr size_t WS_VST = WS_D + 34 * MiB;
constexpr size_t WS_VWT = WS_D + 38 * MiB;
constexpr size_t WS_RKVA = WS_D + 42 * MiB;
constexpr size_t WS_PRL = WS_D + 106 * MiB;
constexpr size_t WS_AGG = WS_D + 114 * MiB;
constexpr size_t WS_BONUS = WS_KCR;
constexpr size_t WS_END = 256 * MiB;
constexpr size_t WS_QM = WS_D;
constexpr size_t WS_OM = WS_D + 32 * MiB;
constexpr size_t WS_MK = WS_D + 64 * MiB;
constexpr size_t WS_MVT = WS_D + 65 * MiB;
static_assert(WS_GATES + (size_t)M_ * 24 * 4 <= WS_XN, "ws map");
static_assert(WS_AGG + 16 * MiB <= WS_END, "ws map");

struct Params {
    const float* in[41];
    float* out;
    unsigned char* ws;
};
enum { I_X = 0, I_MEM, I_F1_PRE, I_F1_WG, I_F1_WU, I_F1_WD, I_F1_POST, I_MIX_PRE, I_WIN, I_PE_K, I_W1_K, I_W2_K, I_PE_V, I_W1_V, I_W2_V,
       I_NSA_G, I_MU, I_W0, I_W2, I_A0, I_A2, I_G2, I_KK, I_KA, I_RK, I_GNG, I_GNB, I_WOUT, I_MIX_POST, I_MEM_PRE, I_MEM_KVG, I_WQ, I_WK, I_WV,
       I_WO, I_MEM_POST, I_F2_PRE, I_F2_WG, I_F2_WU, I_F2_WD, I_F2_POST };

struct MapPlain { const float* W; int N; int pad; __device__ const float* col(int p) const { return W + p; } };
struct MapGU {
    const float* Wg; const float* Wu; int N; int pad;
    __device__ const float* col(int p) const {
        const int pn = p >> 8, q = p & 255, n = (q >> 4) & 1;
        const int hid = 128 * pn + 64 * (q >> 7) + 16 * ((q >> 5) & 3) + (q & 15);
        return Wg + (size_t)n * (size_t)(Wu - Wg) + hid;
    }
};
__host__ __device__ inline int rope_perm(int x) { return 16 * ((x >> 5) & 1) + (x & 15) + 32 * ((x >> 4) & 1); }
struct MapWin {
    const float* W; int N; int pad;
    __device__ const float* col(int p) const {
        int l;
        if (p < 512) l = (p & ~63) + rope_perm(p & 63);
        else if (p < 640) l = 768 + ((p - 512) & ~63) + rope_perm(p & 63);
        else if (p < 768) l = 1024 + ((p - 640) & ~63) + rope_perm(p & 63);
        else if (p < 896) l = 512 + (p - 768);
        else if (p < 1024) l = 640 + (p - 896);
        else if (p < 1152) l = 896 + (p - 1024);
        else if (p < 1280) l = 1152 + (p - 1152);
        else if (p < 2304) { const int q = p - 1280; l = 1304 + (((q >> 4) & 1) ? 512 : 0) + 16 * (q >> 5) + (q & 15); }
        else if (p < 3072) l = 1304 + (p - 1280);
        else if (p < 3096) l = 1280 + (p - 3072);
        else return nullptr;
        return W + l;
    }
};

#define FOR_VB(vb, n) for (int vb = (int)blockIdx.x * 2 + (T512 >> 8); vb < (n); vb += (int)gridDim.x * 2)

template <class Map> __device__ __forceinline__ void d_convert(bf16* WT, int Np, int K, Map map, int wg0 = 0) {
    if ((int)blockIdx.x < wg0) return;
    const int T512 = tidx(), tid = T512 & 255, nbx = Np / 64, nb = nbx * (K / 64), G = (int)gridDim.x - wg0;
    for (int vb0 = ((int)blockIdx.x - wg0) * 2 + (T512 >> 8); vb0 < nb; vb0 += G * 4) {
        const int vb1 = vb0 + G * 2; const bool two = vb1 < nb;
        const int p0 = (vb0 % nbx) * 64 + (tid & 63), k0 = (vb0 / nbx) * 64 + (tid >> 6) * 16;
        const int p1 = two ? (vb1 % nbx) * 64 + (tid & 63) : p0, k1 = two ? (vb1 / nbx) * 64 + (tid >> 6) * 16 : k0;
        const float* s0 = map.col(p0); const float* s1 = map.col(p1);
        float v[16], u[16];
#pragma unroll
        for (int i = 0; i < 16; ++i) { v[i] = s0 ? s0[(size_t)(k0 + i) * map.N] : 0.f; u[i] = s1 ? s1[(size_t)(k1 + i) * map.N] : 0.f; }
        u32x4 a, b;
        a.x = pk2(v[0], v[1]); a.y = pk2(v[2], v[3]); a.z = pk2(v[4], v[5]); a.w = pk2(v[6], v[7]);
        b.x = pk2(v[8], v[9]); b.y = pk2(v[10], v[11]); b.z = pk2(v[12], v[13]); b.w = pk2(v[14], v[15]);
        u32x4* d0 = (u32x4*)(WT + (size_t)p0 * K + k0); d0[0] = a; d0[1] = b;
        if (two) {
            a.x = pk2(u[0], u[1]); a.y = pk2(u[2], u[3]); a.z = pk2(u[4], u[5]); a.w = pk2(u[6], u[7]);
            b.x = pk2(u[8], u[9]); b.y = pk2(u[10], u[11]); b.z = pk2(u[12], u[13]); b.w = pk2(u[14], u[15]);
            u32x4* d1 = (u32x4*)(WT + (size_t)p1 * K + k1); d1[0] = a; d1[1] = b;
        }
    }
}
__device__ __forceinline__ void d_convert_lora(bf16* WT, const float* w2, const float* a2, const float* g2) {
    const int T512 = tidx(), tid = T512 & 255;
    FOR_VB(vb, NLORA * KLORA / 256) {
        const int idx = vb * 256 + tid, p = idx >> 8, k = idx & 255;
        float v = 0.f;
        if (p < 512) { if (k < 64) v = w2[k * 512 + p]; }
        else if (p < 1024) { if (k >= 64 && k < 128) v = a2[(k - 64) * 512 + (p - 512)]; }
        else { if (k >= 128) v = g2[(k - 128) * 512 + (p - 1024)]; }
        WT[idx] = (bf16)f2bf(v);
    }
}
__device__ __forceinline__ void d_rope_table(float* tab) {
    const int T512 = tidx(), tid = T512 & 255;
    FOR_VB(vb, T_ * 32 / 256) {
        const int idx = vb * 256 + tid, pos = idx >> 5, i = idx & 31;
        const float inv = (float)pow(10000.0, -(double)i / 32.0);
        const float ang = (float)pos * inv;
        tab[2 * idx] = (float)cos((double)ang); tab[2 * idx + 1] = (float)sin((double)ang);
    }
}
__device__ __forceinline__ void d_cmp_bias(const float* pe_k, const float* w1_k, const float* pe_v, const float* w1_v, float* part, float* red  ) {
    for (int job = blockIdx.x; job < 64; job += gridDim.x) {
        const int kv = job >> 5, cg_ = (job >> 3) & 3, jc = job & 7; const float* pe = kv ? pe_v : pe_k; const float* w1 = kv ? w1_v : w1_k;
        const int T512 = tidx(), lane = T512 & 63, w = T512 >> 6, n = cg_ * 64 + lane;
        float s = 0.f;
#pragma unroll 8
        for (int j = jc * 256 + w * 32; j < jc * 256 + w * 32 + 32; ++j) s += pe[j] * w1[(size_t)j * 256 + n];
        red[w * 64 + lane] = s; __syncthreads();
        if (w == 0) { float t = 0.f; for (int i = 0; i < 8; ++i) t += red[i * 64 + lane]; part[(jc * 2 + kv) * 256 + n] = t; }
        __syncthreads();
    }
}
__device__ __forceinline__ void d_rownorm(const float* x, const float* g, bf16* xn, int rows) {
    const int T512 = tidx(), tid = T512 & 255, lane = tid & 63;
    FOR_VB(vb, rows / 4) {
        const int row = vb * 4 + (tid >> 6);
        const f32x4* xr = (const f32x4*)(x + (size_t)row * DM) + lane; f32x4 v[4]; float s = 0.f;
#pragma unroll
        for (int j = 0; j < 4; ++j) { v[j] = xr[64 * j]; s += v[j][0] * v[j][0] + v[j][1] * v[j][1] + v[j][2] * v[j][2] + v[j][3] * v[j][3]; }
        const float rstd = rsqrtf(wave_sum(s) * (1.f / DM) + NORM_EPS);
#pragma unroll
        for (int j = 0; j < 4; ++j) { const f32x4 gg = ((const f32x4*)g)[lane + 64 * j]; st_bf4(xn + (size_t)row * DM + 4 * (lane + 64 * j), v[j] * rstd * gg); }
    }
}
__device__ __forceinline__ void d_rowpass(const float* xin, const bf16* y, const float* gpost, float coef, const float* gpre, float* xout, bf16* xn) {
    const int T512 = tidx(), tid = T512 & 255, lane = tid & 63;
    FOR_VB(vb, M_ / 4) {
        const int row = vb * 4 + (tid >> 6);
        f32x4 yv[4], xv[4]; float s = 0.f;
#pragma unroll
        for (int j = 0; j < 4; ++j) {
            const u32x2 w = *(const u32x2*)(y + (size_t)row * DM + 4 * (lane + 64 * j));
            yv[j][0] = __builtin_bit_cast(float, w.x << 16); yv[j][1] = __builtin_bit_cast(float, w.x & 0xffff0000u);
            yv[j][2] = __builtin_bit_cast(float, w.y << 16); yv[j][3] = __builtin_bit_cast(float, w.y & 0xffff0000u);
            s += yv[j][0] * yv[j][0] + yv[j][1] * yv[j][1] + yv[j][2] * yv[j][2] + yv[j][3] * yv[j][3];
            xv[j] = ((const f32x4*)(xin + (size_t)row * DM))[lane + 64 * j];
        }
        const float rstd = rsqrtf(wave_sum(s) * (1.f / DM) + NORM_EPS) * coef; float s2 = 0.f;
#pragma unroll
        for (int j = 0; j < 4; ++j) { const f32x4 gg = ((const f32x4*)gpost)[lane + 64 * j]; xv[j] = xv[j] + yv[j] * rstd * gg;
            s2 += xv[j][0] * xv[j][0] + xv[j][1] * xv[j][1] + xv[j][2] * xv[j][2] + xv[j][3] * xv[j][3];
            ((f32x4*)(xout + (size_t)row * DM))[lane + 64 * j] = xv[j]; }
        if (gpre) {
            const float r2 = rsqrtf(wave_sum(s2) * (1.f / DM) + NORM_EPS);
#pragma unroll
            for (int j = 0; j < 4; ++j) { const f32x4 gg = ((const f32x4*)gpre)[lane + 64 * j]; st_bf4(xn + (size_t)row * DM + 4 * (lane + 64 * j), xv[j] * r2 * gg); }
        }
    }
}
__device__ __forceinline__ void d_nsa_outnorm(bf16* amix, const float* g) {
    const int T512 = tidx(), tid = T512 & 255, lane = tid & 63;
    FOR_VB(vb, M_ / 4) {
        const int row = vb * 4 + (tid >> 6);
        bf16* p = amix + (size_t)row * DM + 8 * lane;
        const u32x4 w = *(const u32x4*)p; float v[8]; float s = 0.f;
        v[0] = __builtin_bit_cast(float, w.x << 16); v[1] = __builtin_bit_cast(float, w.x & 0xffff0000u);
        v[2] = __builtin_bit_cast(float, w.y << 16); v[3] = __builtin_bit_cast(float, w.y & 0xffff0000u);
        v[4] = __builtin_bit_cast(float, w.z << 16); v[5] = __builtin_bit_cast(float, w.z & 0xffff0000u);
        v[6] = __builtin_bit_cast(float, w.w << 16); v[7] = __builtin_bit_cast(float, w.w & 0xffff0000u);
#pragma unroll
        for (int i = 0; i < 8; ++i) s += v[i] * v[i];
        const float rstd = rsqrtf(wave_sum(s) * (1.f / 512.f) + NORM_EPS);
        u32x4 o; const float* gg = g + 8 * lane;
        o.x = pk2(v[0] * rstd * gg[0], v[1] * rstd * gg[1]); o.y = pk2(v[2] * rstd * gg[2], v[3] * rstd * gg[3]);
        o.z = pk2(v[4] * rstd * gg[4], v[5] * rstd * gg[5]); o.w = pk2(v[6] * rstd * gg[6], v[7] * rstd * gg[7]);
        *(u32x4*)p = o;
    }
}

struct EpiStore { bf16* O; int ldc; float scale;
    static constexpr int NCAT = 1;
    __device__ __forceinline__ int cat(int) const { return 0; }
    template <int C> __device__ __forceinline__ void apply(int row, int p, f32x4 v0, f32x4 v1) const { bf16* o = O + (size_t)row * ldc + p; st_bf4(o, v0 * scale); st_bf4(o + 16, v1 * scale); } };
struct EpiSwiGLU { bf16* H;
    static constexpr int NCAT = 1;
    __device__ __forceinline__ int cat(int) const { return 0; }
    template <int C> __device__ __forceinline__ void apply(int row, int p, f32x4 g, f32x4 u) const {
        const int q = p & 255, hid = 128 * (p >> 8) + 64 * (q >> 7) + 16 * ((q >> 5) & 3) + (q & 15);
        f32x4 h;
#pragma unroll
        for (int e = 0; e < 4; ++e) h[e] = g[e] / (1.f + __expf(-g[e])) * u[e];
        st_bf4(H + (size_t)row * FF + hid, h); } };
struct EpiBiasSilu { bf16* O; const float* bias;
    static constexpr int NCAT = 1;
    __device__ __forceinline__ int cat(int) const { return 0; }
    template <int C> __device__ __forceinline__ void apply(int row, int p, f32x4 v0, f32x4 v1) const {
        f32x4 a, b; f32x4 b0 = {0.f, 0.f, 0.f, 0.f}, b1 = {0.f, 0.f, 0.f, 0.f};
#pragma unroll
        for (int jc = 0; jc < 8; ++jc) { b0 += *(const f32x4*)(bias + jc * 512 + p); b1 += *(const f32x4*)(bias + jc * 512 + p + 16); }
#pragma unroll
        for (int e = 0; e < 4; ++e) { const float x0 = v0[e] + b0[e], x1 = v1[e] + b1[e]; a[e] = x0 / (1.f + __expf(-x0)); b[e] = x1 / (1.f + __expf(-x1)); }
        bf16* o = O + (size_t)row * 256 + p; st_bf4(o, a); st_bf4(o + 16, b); } };
struct EpiLora { float* wdec; bf16* aga; bf16* agg; const float* w0; const float* a0;
    static constexpr int NCAT = 3;
    __device__ __forceinline__ int cat(int p0) const { return p0 < 512 ? 0 : (p0 < 1024 ? 1 : 2); }
    template <int C> __device__ __forceinline__ void one(int row, int p, f32x4 v) const {
        if (C == 0) { f32x4 o; const f32x4 ww = *(const f32x4*)(w0 + p);
#pragma unroll
            for (int e = 0; e < 4; ++e) o[e] = __expf(-0.6065306597126334f * sigmoidf_(ww[e] + v[e]));
            *(f32x4*)(wdec + (size_t)row * 512 + p) = o;
        } else if (C == 1) { f32x4 o; const f32x4 aa = *(const f32x4*)(a0 + p - 512);
#pragma unroll
            for (int e = 0; e < 4; ++e) o[e] = sigmoidf_(aa[e] + v[e]);
            st_bf4(aga + (size_t)row * 512 + (p - 512), o);
        } else st_bf4(agg + (size_t)row * 512 + (p - 1024), v);
    }
    template <int C> __device__ __forceinline__ void apply(int row, int p, f32x4 v0, f32x4 v1) const { one<C>(row, p, v0); one<C>(row, p + 16, v1); } };
struct EpiWin {
    bf16 *qb, *ks, *kw, *kcr, *vcr, *vst, *vwt; unsigned* rk; bf16 *vv, *prl; float* gates; const float* rope;
    static constexpr int NCAT = 8;
    __device__ __forceinline__ int cat(int p0) const { return p0 < 512 ? 0 : (p0 < 768 ? 1 : (p0 < 1024 ? 2 : (p0 < 1280 ? 3 : (p0 < 2304 ? 4 : (p0 < 2816 ? 7 : (p0 < 3072 ? 6 : 5)))))); }
    template <int C> __device__ __forceinline__ void apply(int row, int p, f32x4 v0, f32x4 v1) const {
        const int b = row / T_, t = row % T_;
        if (C == 0 || C == 1) {
            const int x = p & 63, d = 16 * ((x >> 5) & 1) + (x & 15);
            const f32x4* rp = (const f32x4*)(rope + ((size_t)t * 32 + d) * 2); const f32x4 r0 = rp[0], r1 = rp[1];
            const f32x4 cs = {r0[0], r0[2], r1[0], r1[2]}, sn = {r0[1], r0[3], r1[1], r1[3]};
            const f32x4 lo = v0 * cs - v1 * sn, hi = v0 * sn + v1 * cs;
            if (C == 0) { bf16* o = qb + (size_t)row * 512 + (p & ~63) + d; st_bf4(o, lo * QSCALE); st_bf4(o + 32, hi * QSCALE); }
            else { const int g = ((p - 512) >> 6) & 1; bf16* base = (p < 640) ? ks : kw; bf16* o = base + ((size_t)(b * 2 + g) * T_ + t) * 64 + d; st_bf4(o, lo); st_bf4(o + 32, hi); }
        } else if (C == 2) {
            const int c = (p - 768) & 127, g = c >> 6, d = c & 63; bf16* base = (p < 896) ? kcr : vcr;
            bf16* o = base + ((size_t)(b * 2 + g) * T_ + t) * 64 + d; st_bf4(o, v0); st_bf4(o + 16, v1);
        } else if (C == 3) {
            const int c = (p - 1024) & 127, g = c >> 6, d = c & 63; bf16* base = (p < 1152) ? vst : vwt;
            bf16* o = base + ((size_t)(b * 2 + g) * 64 + d) * T_ + t;
#pragma unroll
            for (int e = 0; e < 4; ++e) { o[(size_t)e * T_] = (bf16)f2bf(v0[e]); o[(size_t)(16 + e) * T_] = (bf16)f2bf(v1[e]); }
        } else if (C == 4) {
            const int q = p - 1280, ch = 16 * (q >> 5) + (q & 15);
            u32x4 w; w.x = pk2(v0[0], v1[0]); w.y = pk2(v0[1], v1[1]); w.z = pk2(v0[2], v1[2]); w.w = pk2(v0[3], v1[3]);
            *(u32x4*)(rk + (size_t)row * 512 + ch) = w;
        } else if (C == 7) {
            bf16* o = vv + (size_t)row * 512 + (p - 2304); st_bf4(o, v0); st_bf4(o + 16, v1);
        } else if (C == 6) {
            bf16* o = prl + (size_t)row * 256 + (p - 2816); st_bf4(o, v0); st_bf4(o + 16, v1);
        } else {
            const int c = p - 3072; float* o = gates + (size_t)row * 24 + c;
            if (c < 24) { f32x4 s = {sigmoidf_(v0[0]), sigmoidf_(v0[1]), sigmoidf_(v0[2]), sigmoidf_(v0[3])}; *(f32x4*)o = s; }
            if (c + 16 < 24) { f32x4 s = {sigmoidf_(v1[0]), sigmoidf_(v1[1]), sigmoidf_(v1[2]), sigmoidf_(v1[3])}; *(f32x4*)(o + 16) = s; }
        }
    }
};

namespace pg8 {
#define PG8_LAS __attribute__((address_space(3)))
typedef unsigned short bf16_t;
typedef short bf16x8 __attribute__((ext_vector_type(8)));
typedef float f32x4 __attribute__((ext_vector_type(4)));
typedef unsigned u32x4 __attribute__((ext_vector_type(4)));
constexpr int BM = 256, BK = 64, HALF = 128, HTB = HALF * BK * 2  , STAGE_BYTES = 8 * HTB, NXCD = 8, WGM = 8;

__host__ __device__ __forceinline__ int lds_byte(int r, int c) { const int st = (r >> 4) * 2 + (c >> 5), rr = r & 15, cc = c & 31, ob = rr * 64 + cc * 2; return st * 1024 + (ob ^ (((ob >> 9) & 1) << 5)); }
__host__ __device__ __forceinline__ void stage_rc(int b, int& R, int& C) { const int st = b / 1024, sb = b % 1024, swz = sb ^ (((sb >> 9) & 1) << 5); R = (st >> 1) * 16 + swz / 64; C = (st & 1) * 32 + (swz % 64) / 2; }
__host__ __device__ __forceinline__ int perm32(int rho) { const int n = rho >> 4, i = rho & 15; return 8 * (i >> 2) + 4 * n + (i & 3); }

struct Unit { int pm, pn; };
struct Gemm { const bf16_t* A; const bf16_t* Bt; int M, N, K, lda, ldb; };

struct StaticOrder {
    int nM, nN, nwg, G, c;
    __host__ __device__ void init(int M, int N, int G_, int c_) { nM = M / BM; nN = N / BM; nwg = nM * nN; G = G_; c = c_; }
    __host__ __device__ bool next(int i, Unit& u) const {
        const long L = (long)i * G + c; if (L >= nwg) return false;
        int wgid = (int)L; { const int q = nwg / NXCD, r = nwg % NXCD, xcd = wgid % NXCD, off = wgid / NXCD; wgid = (xcd < r ? xcd * (q + 1) : r * (q + 1) + (xcd - r) * q) + off; }
        const int nig = WGM * nN, gid = wgid / nig, fm = gid * WGM, gsz = (nM - fm) < WGM ? (nM - fm) : WGM;
        u.pm = fm + ((wgid % nig) % gsz); u.pn = (wgid % nig) / gsz; return true;
    }
    __device__ __forceinline__ void a_ready(const Unit&) const {}
    __device__ __forceinline__ void done(const Unit&) const {}
};

template <class Epi, class Sched, bool ALIGN_EPI = false, bool SP2 = false>
__device__ __forceinline__ void gemm_phase(PG8_LAS unsigned char* lds, const Gemm g, const Sched& S, const Epi& E) {
    const int tid = tidx(), wid = __builtin_amdgcn_readfirstlane(tid >> 6), lane = tid & 63, wr = wid >> 2, wc = wid & 3, fr = lane & 15, fq = lane >> 4;
    const int K = g.K, nt = K / BK;
    unsigned voffA[2], voffB[2];
#pragma unroll
    for (int i = 0; i < 2; ++i) { int R, C; stage_rc(tid * 16 + i * 8192, R, C); const int Rb = Epi::PERM ? ((R & ~31) + perm32(R & 31)) : R;
        voffA[i] = (unsigned)(R * g.lda + C) * 2u; voffB[i] = (unsigned)(Rb * g.ldb + C) * 2u; }
    const size_t kstep = (size_t)(BK * 2);
    const size_t hstepA = (size_t)HALF * g.lda * 2, hstepB = (size_t)HALF * g.ldb * 2;
    const size_t tstepA = 2 * hstepA, tstepB = 2 * hstepB;
    const unsigned ldsw = (unsigned)wid * 1024u;
    const int aoff = lds_byte(wr * 64 + fr, fq * 8), boff = lds_byte(wc * 32 + fr, fq * 8);
#define PG8_SA(b, h) (((b) * 2 + (h)) * HTB)
#define PG8_SB(b, h) ((4 + (b) * 2 + (h)) * HTB)
#define PG8_STAGE(bufoff, gbase, voff) do { _Pragma("unroll") for (int _i = 0; _i < 2; ++_i) \
        __builtin_amdgcn_global_load_lds((const unsigned*)((const char*)(gbase) + (voff)[_i]), (PG8_LAS unsigned*)(lds + (bufoff) + ldsw + _i * 8192), 16, 0, 0); } while (0)
#define PG8_LDA(dst, b, h) do { _Pragma("unroll") for (int m = 0; m < 4; ++m) _Pragma("unroll") for (int k = 0; k < 2; ++k) dst[m][k] = *(const PG8_LAS bf16x8*)(lds + PG8_SA(b, h) + aoff + m * 2048 + k * 1024); } while (0)
#define PG8_LDB(dst, b, h) do { _Pragma("unroll") for (int n = 0; n < 2; ++n) _Pragma("unroll") for (int k = 0; k < 2; ++k) dst[n][k] = *(const PG8_LAS bf16x8*)(lds + PG8_SB(b, h) + boff + n * 2048 + k * 1024); } while (0)
#define PG8_MMA(ai, bj, At, Bt) do { __builtin_amdgcn_s_setprio(1); _Pragma("unroll") for (int m = 0; m < 4; ++m) _Pragma("unroll") for (int n = 0; n < 2; ++n) _Pragma("unroll") for (int k = 0; k < 2; ++k) \
        acc[ai][bj][m][n] = __builtin_amdgcn_mfma_f32_16x16x32_bf16(Bt[n][k], At[m][k], acc[ai][bj][m][n], 0, 0, 0); __builtin_amdgcn_s_setprio(0); } while (0)
#define PG8_WAIT_V(n) asm volatile("s_waitcnt vmcnt(" #n ")" ::: "memory")
#define PG8_WAIT_L(n) asm volatile("s_waitcnt lgkmcnt(" #n ")" ::: "memory")
#define PG8_BAR __builtin_amdgcn_s_barrier()
#define PG8_SCHED __builtin_amdgcn_sched_barrier(0)
    Unit cur, nxt; int ui = 0;
    if (!S.next(0, cur)) return;
    f32x4 acc[2][2][4][2];
#pragma unroll
    for (int a = 0; a < 2; ++a)
#pragma unroll
        for (int b = 0; b < 2; ++b)
#pragma unroll
            for (int m = 0; m < 4; ++m)
#pragma unroll
                for (int n = 0; n < 2; ++n) acc[a][b][m][n] = (f32x4){0.f, 0.f, 0.f, 0.f};
    bf16x8 At[4][2], B0[2][2], B1[2][2];
    const char* cA = (const char*)g.A + (size_t)cur.pm * tstepA; const char* cB = (const char*)g.Bt + (size_t)cur.pn * tstepB;
    S.a_ready(cur);
    if constexpr (SP2) {
        PG8_STAGE(PG8_SB(0, 0), cB, voffB); PG8_STAGE(PG8_SB(0, 1), cB + hstepB, voffB); PG8_STAGE(PG8_SA(0, 0), cA, voffA); PG8_STAGE(PG8_SA(0, 1), cA + hstepA, voffA);
        if (wr == 1) PG8_BAR;
        PG8_WAIT_V(2); PG8_BAR;
        PG8_STAGE(PG8_SB(1, 0), cB + kstep, voffB); PG8_STAGE(PG8_SA(1, 0), cA + kstep, voffA); PG8_STAGE(PG8_SB(1, 1), cB + hstepB + kstep, voffB);
        PG8_WAIT_V(6); PG8_BAR;
    } else {
        PG8_STAGE(PG8_SB(0, 0), cB, voffB); PG8_STAGE(PG8_SA(0, 0), cA, voffA); PG8_STAGE(PG8_SB(0, 1), cB + hstepB, voffB); PG8_STAGE(PG8_SA(0, 1), cA + hstepA, voffA);
        if (wr == 1) PG8_BAR;
        PG8_WAIT_V(4); PG8_BAR;
        PG8_STAGE(PG8_SB(1, 0), cB + kstep, voffB); PG8_STAGE(PG8_SA(1, 0), cA + kstep, voffA); PG8_STAGE(PG8_SB(1, 1), cB + hstepB + kstep, voffB);
        PG8_WAIT_V(6); PG8_BAR;
    }
    for (;;) {
        const bool has_next = S.next(ui + 1, nxt);
        const char* nA = has_next ? (const char*)g.A + (size_t)nxt.pm * tstepA : cA; const char* nB = has_next ? (const char*)g.Bt + (size_t)nxt.pn * tstepB : cB;
        for (int t = 0; t < nt; t += 2) {
            const bool last = (t == nt - 2);
            const char* a1 = cA + (size_t)(t + 1) * kstep;
            const char* a2 = last ? nA : cA + (size_t)(t + 2) * kstep; const char* b2 = last ? nB : cB + (size_t)(t + 2) * kstep;
            const char* a3 = a2 + kstep; const char* b3 = b2 + kstep;
            if (last && has_next) S.a_ready(nxt);
            if constexpr (SP2) {
            PG8_LDB(B0, 0, 0); PG8_LDB(B1, 0, 1); PG8_SCHED; PG8_LDA(At, 0, 0); PG8_STAGE(PG8_SA(1, 1), a1 + hstepA, voffA);
            PG8_WAIT_V(8); PG8_WAIT_L(0); PG8_BAR; PG8_MMA(0, 0, At, B0); PG8_MMA(0, 1, At, B1); PG8_BAR; PG8_SCHED;
            PG8_LDA(At, 0, 1); PG8_STAGE(PG8_SB(0, 0), b2, voffB); PG8_STAGE(PG8_SB(0, 1), b2 + hstepB, voffB); PG8_STAGE(PG8_SA(0, 0), a2, voffA);
            PG8_WAIT_V(8); PG8_WAIT_L(0); PG8_BAR; PG8_MMA(1, 0, At, B0); PG8_MMA(1, 1, At, B1); PG8_BAR; PG8_SCHED;
            PG8_LDB(B0, 1, 0); PG8_LDB(B1, 1, 1); PG8_SCHED; PG8_LDA(At, 1, 0); PG8_STAGE(PG8_SA(0, 1), a2 + hstepA, voffA);
            PG8_WAIT_V(8); PG8_WAIT_L(0); PG8_BAR; PG8_MMA(0, 0, At, B0); PG8_MMA(0, 1, At, B1); PG8_BAR; PG8_SCHED;
            PG8_LDA(At, 1, 1); PG8_STAGE(PG8_SB(1, 0), b3, voffB); PG8_STAGE(PG8_SB(1, 1), b3 + hstepB, voffB); PG8_STAGE(PG8_SA(1, 0), a3, voffA);
            PG8_WAIT_V(8); PG8_WAIT_L(0); PG8_BAR; PG8_MMA(1, 0, At, B0); PG8_MMA(1, 1, At, B1); PG8_BAR; PG8_SCHED;
            } else {
            PG8_LDB(B0, 0, 0); PG8_SCHED; PG8_LDA(At, 0, 0); PG8_STAGE(PG8_SA(1, 1), a1 + hstepA, voffA);
            PG8_WAIT_L(8); PG8_BAR; PG8_WAIT_L(0); PG8_MMA(0, 0, At, B0); PG8_BAR; PG8_SCHED;
            PG8_LDB(B1, 0, 1); PG8_STAGE(PG8_SB(0, 0), b2, voffB);
            PG8_BAR; PG8_WAIT_L(0); PG8_MMA(0, 1, At, B1); PG8_BAR;
            PG8_LDA(At, 0, 1); PG8_STAGE(PG8_SA(0, 0), a2, voffA);
            PG8_BAR; PG8_WAIT_L(0); PG8_MMA(1, 0, At, B0); PG8_BAR; PG8_SCHED;
            PG8_STAGE(PG8_SB(0, 1), b2 + hstepB, voffB);
            PG8_WAIT_V(6); PG8_BAR; PG8_MMA(1, 1, At, B1); PG8_BAR;
            PG8_LDB(B0, 1, 0); PG8_SCHED; PG8_LDA(At, 1, 0); PG8_STAGE(PG8_SA(0, 1), a2 + hstepA, voffA);
            PG8_WAIT_L(8); PG8_BAR; PG8_WAIT_L(0); PG8_MMA(0, 0, At, B0); PG8_BAR; PG8_SCHED;
            PG8_LDB(B1, 1, 1); PG8_STAGE(PG8_SB(1, 0), b3, voffB);
            PG8_BAR; PG8_WAIT_L(0); PG8_MMA(0, 1, At, B1); PG8_BAR;
            PG8_LDA(At, 1, 1); PG8_STAGE(PG8_SA(1, 0), a3, voffA);
            PG8_BAR; PG8_WAIT_L(0); PG8_MMA(1, 0, At, B0); PG8_BAR; PG8_SCHED;
            PG8_STAGE(PG8_SB(1, 1), b3 + hstepB, voffB);
            PG8_WAIT_V(6); PG8_BAR; PG8_MMA(1, 1, At, B1); PG8_BAR;
            }
        }
        if constexpr (ALIGN_EPI) { if (wr == 0) PG8_BAR; }
        if constexpr (!Epi::AFTER_DRAIN) { E(acc, cur, wr, wc, fr, fq); S.done(cur); }
        if (!has_next) break;
#pragma unroll
        for (int a = 0; a < 2; ++a)
#pragma unroll
            for (int b = 0; b < 2; ++b)
#pragma unroll
                for (int m = 0; m < 4; ++m)
#pragma unroll
                    for (int n = 0; n < 2; ++n) acc[a][b][m][n] = (f32x4){0.f, 0.f, 0.f, 0.f};
        cur = nxt; cA = nA; cB = nB; ++ui;
        if constexpr (ALIGN_EPI) { if (wr == 1) PG8_BAR; }
    }
    PG8_WAIT_V(0);
    if constexpr (!ALIGN_EPI) { if (wr == 0) PG8_BAR; }
    PG8_BAR;
    if constexpr (Epi::AFTER_DRAIN) { E.fused(acc, cur, wr, wc, fr, fq, lds, wid, lane); S.done(cur); }
#undef PG8_SA
#undef PG8_SB
#undef PG8_STAGE
#undef PG8_LDA
#undef PG8_LDB
#undef PG8_MMA
#undef PG8_WAIT_V
#undef PG8_WAIT_L
#undef PG8_BAR
#undef PG8_SCHED
}
}

template <class F> struct EpiQuad {
    static constexpr bool PERM = false, AFTER_DRAIN = false;
    F f;
    template <int C, int BJ> __device__ __forceinline__ void half(const pg8::f32x4 (&acc)[2][2][4][2], int row0, int p) const {
#pragma unroll
        for (int ai = 0; ai < 2; ++ai)
#pragma unroll
            for (int m = 0; m < 4; ++m) { f.template apply<C>(row0 + ai * 128 + m * 16, p, acc[ai][BJ][m][0], acc[ai][BJ][m][1]); asm volatile("" ::: "memory"); }
    }
    template <int BJ> __device__ __forceinline__ void disp(const pg8::f32x4 (&acc)[2][2][4][2], int row0, int p0, int p) const {
        const int c = f.cat(p0);
        if (F::NCAT == 1 || c == 0) half<0, BJ>(acc, row0, p);
        else if (F::NCAT > 1 && c == 1) half<(F::NCAT > 1 ? 1 : 0), BJ>(acc, row0, p);
        else if (F::NCAT > 2 && c == 2) half<(F::NCAT > 2 ? 2 : 0), BJ>(acc, row0, p);
        else if (F::NCAT > 3 && c == 3) half<(F::NCAT > 3 ? 3 : 0), BJ>(acc, row0, p);
        else if (F::NCAT > 4 && c == 4) half<(F::NCAT > 4 ? 4 : 0), BJ>(acc, row0, p);
        else if (F::NCAT > 5 && c == 5) half<(F::NCAT > 5 ? 5 : 0), BJ>(acc, row0, p);
        else if (F::NCAT > 6 && c == 6) half<(F::NCAT > 6 ? 6 : 0), BJ>(acc, row0, p);
        else if (F::NCAT > 7) half<(F::NCAT > 7 ? 7 : 0), BJ>(acc, row0, p);
    }
    __device__ __forceinline__ void operator()(const pg8::f32x4 (&acc)[2][2][4][2], const pg8::Unit& u, int wr, int wc, int fr, int fq) const {
        const int row0 = u.pm * 256 + wr * 64 + fr, p0 = u.pn * 256;
        disp<0>(acc, row0, p0, p0 + wc * 32 + 4 * fq);
        disp<1>(acc, row0, p0 + 128, p0 + 128 + wc * 32 + 4 * fq);
    }
};
template <class F> __device__ __forceinline__ void gemm_pg8(unsigned char* lds, const bf16* A, int lda, const bf16* Bt, int ldb, int M, int N, int K, const F& f, int wg_off = 0) {
    if ((int)blockIdx.x < wg_off) return;
    pg8::Gemm g{A, Bt, M, N, K, lda, ldb}; pg8::StaticOrder S; S.init(M, N, (int)gridDim.x, (int)blockIdx.x - wg_off);
    EpiQuad<F> E{f};
    pg8::gemm_phase<EpiQuad<F>, pg8::StaticOrder, true, true>((PG8_LAS unsigned char*)lds, g, S, E);
}

namespace cg = cooperative_groups;
struct EpiNormRes {
    static constexpr bool PERM = false, AFTER_DRAIN = true;
    const float* xin; float* xout; bf16* xn; const float* gpost; const float* gpre; float coef; unsigned* part; unsigned* cnt;
    __device__ __forceinline__ void operator()(const pg8::f32x4 (&)[2][2][4][2], const pg8::Unit&, int, int, int, int) const {}
    __device__ __forceinline__ void rowstat(const pg8::f32x4 (&acc)[2][2][4][2], float* P, int wr, int wc, int fr, int fq) const {
#pragma unroll
        for (int ai = 0; ai < 2; ++ai)
#pragma unroll
            for (int m = 0; m < 4; ++m) { float sq = 0.f;
#pragma unroll
                for (int bj = 0; bj < 2; ++bj)
#pragma unroll
                    for (int n = 0; n < 2; ++n) { const pg8::f32x4 v = acc[ai][bj][m][n]; sq += (v[0] * v[0] + v[1] * v[1]) + (v[2] * v[2] + v[3] * v[3]); }
                sq += __shfl_xor(sq, 16); sq += __shfl_xor(sq, 32);
                if (fq == 0) P[(ai * 128 + wr * 64 + m * 16 + fr) * 4 + wc] = sq; }
    }
    __device__ __forceinline__ void exchange(float* P, float* S, unsigned* bank, unsigned* cnt, const pg8::Unit& u, int tid, float scale) const {
        __syncthreads();
        if (tid < 256) { const f32x4 p = *(const f32x4*)(P + tid * 4);
            __hip_atomic_store(bank + (size_t)(u.pm * 256 + tid) * 4 + u.pn, __builtin_bit_cast(unsigned, (p[0] + p[1]) + (p[2] + p[3])), __ATOMIC_RELAXED, __HIP_MEMORY_SCOPE_AGENT); }
        asm volatile("s_waitcnt vmcnt(0)" ::: "memory");
        __syncthreads();
        if (tid == 0) { unsigned* c = cnt + u.pm * 16; __hip_atomic_fetch_add(c, 1u, __ATOMIC_RELAXED, __HIP_MEMORY_SCOPE_AGENT);
            while (__hip_atomic_load(c, __ATOMIC_RELAXED, __HIP_MEMORY_SCOPE_AGENT) < 4u) __builtin_amdgcn_s_sleep(1); }
        __syncthreads();
        if (tid < 256) { const unsigned* b = bank + (size_t)(u.pm * 256 + tid) * 4; float q = 0.f;
#pragma unroll
            for (int j = 0; j < 4; ++j) q += __builtin_bit_cast(float, __hip_atomic_load(b + j, __ATOMIC_RELAXED, __HIP_MEMORY_SCOPE_AGENT));
            S[tid] = rsqrtf(q * (1.f / DM) + NORM_EPS) * scale; }
        __syncthreads();
    }
    __device__ __forceinline__ void fused(pg8::f32x4 (&acc)[2][2][4][2], const pg8::Unit& u, int wr, int wc, int fr, int fq, PG8_LAS unsigned char* lds, int wid, int lane) const {
        float* P = (float*)lds; float* S = P + 1024; const int tid = wid * 64 + lane;
        rowstat(acc, P, wr, wc, fr, fq);
        exchange(P, S, part, cnt, u, tid, coef);
        const int col0 = u.pn * 256 + wc * 32 + 4 * fq;
#pragma unroll
        for (int ai = 0; ai < 2; ++ai)
#pragma unroll
            for (int m = 0; m < 4; ++m) { const int r = ai * 128 + wr * 64 + m * 16 + fr; const float sr = S[r]; const size_t off = (size_t)(u.pm * 256 + r) * DM + col0;
#pragma unroll
                for (int bj = 0; bj < 2; ++bj)
#pragma unroll
                    for (int n = 0; n < 2; ++n) { const int o = bj * 128 + n * 16; const f32x4 g4 = *(const f32x4*)(gpost + col0 + o), x4 = *(const f32x4*)(xin + off + o);
                        const f32x4 y = x4 + acc[ai][bj][m][n] * sr * g4; acc[ai][bj][m][n] = y; *(f32x4*)(xout + off + o) = y; }
                asm volatile("" ::: "memory"); }
        if (!gpre) return;
        rowstat(acc, P, wr, wc, fr, fq);
        exchange(P, S, part + (size_t)M_ * 4, cnt + 64 * 16, u, tid, 1.f);
#pragma unroll
        for (int ai = 0; ai < 2; ++ai)
#pragma unroll
            for (int m = 0; m < 4; ++m) { const int r = ai * 128 + wr * 64 + m * 16 + fr; const float sr = S[r]; const size_t off = (size_t)(u.pm * 256 + r) * DM + col0;
#pragma unroll
                for (int bj = 0; bj < 2; ++bj)
#pragma unroll
                    for (int n = 0; n < 2; ++n) { const int o = bj * 128 + n * 16; const f32x4 g4 = *(const f32x4*)(gpre + col0 + o); st_bf4(xn + off + o, acc[ai][bj][m][n] * sr * g4); }
                asm volatile("" ::: "memory"); }
    }
};
__device__ __forceinline__ void gemm_norm_res(unsigned char* lds, const bf16* A, int lda, const bf16* Bt, int K, const float* xin, float* xout, bf16* xn, const float* gpost, const float* gpre,
                                              float coef, bf16* ybuf, unsigned* part, unsigned* cnt) {
    pg8::Gemm g{A, Bt, M_, DM, K, lda, K}; pg8::StaticOrder S; S.init(M_, DM, 256, (int)blockIdx.x);
    const EpiNormRes E{xin, xout, xn, gpost, gpre, coef, part, cnt};
    pg8::gemm_phase<EpiNormRes, pg8::StaticOrder, false, true>((PG8_LAS unsigned char*)lds, g, S, E);
}

__device__ __forceinline__ void d_gates(const bf16* xn, const bf16* wg  , float* gates) {
    const int T512 = tidx(), lane = T512 & 63, fr = lane & 15, fq = lane >> 4;
    for (int rt = blockIdx.x * 8 + (T512 >> 6); rt < M_ / 16; rt += gridDim.x * 8) {
        const bf16* ap = xn + (size_t)(rt * 16 + fr) * DM + 8 * fq; const bf16* bp = wg + (size_t)fr * DM + 8 * fq;
        f32x4 c0 = {0.f, 0.f, 0.f, 0.f}, c1 = {0.f, 0.f, 0.f, 0.f};
#pragma unroll 8
        for (int k0 = 0; k0 < DM; k0 += 32) { const bf16x8 a = *(const bf16x8*)(ap + k0);
            c0 = __builtin_amdgcn_mfma_f32_16x16x32_bf16(*(const bf16x8*)(bp + k0), a, c0, 0, 0, 0);
            c1 = __builtin_amdgcn_mfma_f32_16x16x32_bf16(*(const bf16x8*)(bp + (size_t)16 * DM + k0), a, c1, 0, 0, 0); }
        float* o = gates + (size_t)(rt * 16 + fr) * 24 + 4 * fq;
        *(f32x4*)o = (f32x4){sigmoidf_(c0[0]), sigmoidf_(c0[1]), sigmoidf_(c0[2]), sigmoidf_(c0[3])};
        if (fq < 2) *(f32x4*)(o + 16) = (f32x4){sigmoidf_(c1[0]), sigmoidf_(c1[1]), sigmoidf_(c1[2]), sigmoidf_(c1[3])};
    }
}

__device__ __forceinline__ void d_cmp2(const bf16* hidk, const bf16* hidv, const bf16* w2t, const float* rope, bf16* kc, bf16* vct) {
    const int T512 = tidx(), lane = T512 & 63, fr = lane & 15, fq = lane >> 4;
    for (int task = blockIdx.x * 8 + (T512 >> 6); task < 256; task += gridDim.x * 8) {
        const int kv = task >> 7, R0 = (task & 127) * 16;
        const bf16* ap = (kv ? hidv : hidk) + (size_t)(R0 + fr) * 256 + 8 * fq;
        const bf16* bp = w2t + (size_t)kv * 64 * 256 + (size_t)fr * 256 + 8 * fq;
        f32x4 acc[4];
#pragma unroll
        for (int nt = 0; nt < 4; ++nt) acc[nt] = (f32x4){0.f, 0.f, 0.f, 0.f};
#pragma unroll
        for (int k0 = 0; k0 < 256; k0 += 32) {
            const bf16x8 a = *(const bf16x8*)(ap + k0);
#pragma unroll
            for (int nt = 0; nt < 4; ++nt) acc[nt] = __builtin_amdgcn_mfma_f32_16x16x32_bf16(*(const bf16x8*)(bp + (size_t)nt * 16 * 256 + k0), a, acc[nt], 0, 0, 0);
        }
        const int R = R0 + fr, bg = R >> 9, c = R & 511;
        if (kv == 0) {
            const int pos = (16 * c + 31) & (T_ - 1);
#pragma unroll
            for (int h2 = 0; h2 < 2; ++h2) {
                const int d = 16 * h2 + 4 * fq; const f32x4* rp = (const f32x4*)(rope + ((size_t)pos * 32 + d) * 2); const f32x4 r0 = rp[0], r1 = rp[1];
                const f32x4 cs = {r0[0], r0[2], r1[0], r1[2]}, sn = {r0[1], r0[3], r1[1], r1[3]};
                const f32x4 lo = acc[h2] * cs - acc[h2 + 2] * sn, hi = acc[h2] * sn + acc[h2 + 2] * cs;
                st_bf4(kc + (size_t)R * 64 + d, lo); st_bf4(kc + (size_t)R * 64 + d + 32, hi);
            }
        } else {
#pragma unroll
            for (int nt = 0; nt < 4; ++nt)
#pragma unroll
                for (int e = 0; e < 4; ++e) vct[((size_t)bg * 64 + 16 * nt + 4 * fq + e) * NCP + c] = (bf16)f2bf(acc[nt][e]);
        }
    }
}

struct NsaArgs { const bf16 *qb, *kc, *vct, *ks, *vst, *kw, *vwt; const float* gates; bf16* amix; };
__device__ __forceinline__ float dot64(const float* q, const bf16* k) {
    float s = 0.f;
#pragma unroll
    for (int i = 0; i < 8; ++i) { const u32x4 w = ((const u32x4*)k)[i];
        s += q[8 * i + 0] * __builtin_bit_cast(float, w.x << 16) + q[8 * i + 1] * __builtin_bit_cast(float, w.x & 0xffff0000u)
           + q[8 * i + 2] * __builtin_bit_cast(float, w.y << 16) + q[8 * i + 3] * __builtin_bit_cast(float, w.y & 0xffff0000u)
           + q[8 * i + 4] * __builtin_bit_cast(float, w.z << 16) + q[8 * i + 5] * __builtin_bit_cast(float, w.z & 0xffff0000u)
           + q[8 * i + 6] * __builtin_bit_cast(float, w.w << 16) + q[8 * i + 7] * __builtin_bit_cast(float, w.w & 0xffff0000u); }
    return s;
}
__device__ __forceinline__ void softmax_row(float* s, int n, int lane) {
    float m = -INFINITY; for (int i = lane; i < n; i += 64) m = fmaxf(m, s[i]);
    m = wave_max(m); if (m == -INFINITY) m = 0.f;
    float l = 0.f; for (int i = lane; i < n; i += 64) { const float e = exp2f(s[i] - m); s[i] = e; l += e; }
    l = wave_sum(l); const float inv = 1.f / fmaxf(l, 1e-30f);
    for (int i = lane; i < n; i += 64) s[i] *= inv;
}
__device__ __forceinline__ void d_nsa_simple(const NsaArgs& a, int vb, int tid, unsigned char* smem) {
    float (*qs)[64] = (float (*)[64])smem; float (*sc)[1024] = (float (*)[1024])(smem + 1024); float* imp = (float*)(smem + 17408); float* score = imp + 128;
    int* list = (int*)(score + 128); int* nlist = list + 16;
    const int bg = vb / T_, t = vb % T_, b = bg >> 1, g = bg & 1;
    const int r = tid >> 6, d = tid & 63, lane = d;
    const size_t row = (size_t)b * T_ + t;
    qs[r][d] = bf2f(a.qb[row * 512 + g * 256 + r * 64 + d]);
    if (tid == 0) *nlist = 0;
    __syncthreads();
    const int nv = t < 31 ? 0 : (t - 31) / 16 + 1;
    for (int c = tid; c < nv; c += 256) { const bf16* k = a.kc + ((size_t)bg * NCP + c) * 64;
        _Pragma("unroll 1") for (int rr = 0; rr < 4; ++rr) sc[rr][c] = dot64(qs[rr], k); }
    __syncthreads();
    softmax_row(sc[r], nv, lane);
    __syncthreads();
    float oc = 0.f; { const bf16* v = a.vct + ((size_t)bg * 64 + d) * NCP; for (int c = 0; c < nv; ++c) oc += sc[r][c] * bf2f(v[c]); }
    if (tid < 128) { const int s = tid; float acc = 0.f;
        for (int c = 4 * s - 1; c <= 4 * s + 3; ++c) if (c >= 0 && c < nv) acc += sc[0][c] + sc[1][c] + sc[2][c] + sc[3][c];
        imp[s] = acc; }
    __syncthreads();
    const int cur = t >> 6;
    if (tid < 128) { const int s = tid; const bool forced = (s == 0) || (s == cur) || (s == cur - 1);
        score[s] = forced ? 1e4f : (s <= cur ? imp[s] : -1e4f); }
    __syncthreads();
    if (tid < 128) { const int s = tid; const float my = score[s]; int rank = 0;
        for (int j = 0; j < 128; ++j) { const float o = score[j]; rank += (o > my || (o == my && j < s)) ? 1 : 0; }
        if (rank < 16 && s <= cur) { const int slot = atomicAdd(nlist, 1); list[slot] = s; } }
    __syncthreads();
    const int ns = *nlist * 64;
    for (int i = tid; i < ns; i += 256) { const int pos = list[i >> 6] * 64 + (i & 63);
        if (pos <= t) { const bf16* k = a.ks + ((size_t)bg * T_ + pos) * 64; _Pragma("unroll 1") for (int rr = 0; rr < 4; ++rr) sc[rr][i] = dot64(qs[rr], k); }
        else { sc[0][i] = -INFINITY; sc[1][i] = -INFINITY; sc[2][i] = -INFINITY; sc[3][i] = -INFINITY; } }
    __syncthreads();
    softmax_row(sc[r], ns, lane);
    __syncthreads();
    float os = 0.f; { const bf16* v = a.vst + ((size_t)bg * 64 + d) * T_;
        for (int i = 0; i < ns; ++i) { const int pos = list[i >> 6] * 64 + (i & 63); if (pos <= t) os += sc[r][i] * bf2f(v[pos]); } }
    __syncthreads();
    const int lo = t - 511 > 0 ? t - 511 : 0, nw = t - lo + 1;
    for (int i = tid; i < nw; i += 256) { const bf16* k = a.kw + ((size_t)bg * T_ + lo + i) * 64;
        _Pragma("unroll 1") for (int rr = 0; rr < 4; ++rr) sc[rr][i] = dot64(qs[rr], k); }
    __syncthreads();
    softmax_row(sc[r], nw, lane);
    __syncthreads();
    float ow = 0.f; { const bf16* v = a.vwt + ((size_t)bg * 64 + d) * T_ + lo; for (int i = 0; i < nw; ++i) ow += sc[r][i] * bf2f(v[i]); }
    const float* gt = a.gates + row * 24 + g * 12 + r * 3;
    a.amix[row * DM + g * 256 + r * 64 + d] = (bf16)f2bf(gt[0] * oc + gt[1] * os + gt[2] * ow);
    __syncthreads();
}


namespace nsa {
typedef float f32x16 __attribute__((ext_vector_type(16)));
constexpr int KROW = 144, VROW = 136, KBUF = 64 * KROW, VBUF = 64 * VROW;
constexpr int OFF_K = 0, OFF_V = 2 * KBUF, OFF_IMP = OFF_V + 2 * VBUF, IMPW = 130, OFF_SEL = OFF_IMP + 64 * IMPW * 4, OFF_UM = OFF_SEL + 1024, OFF_WS = OFF_UM + 16, OFF_UNIT = OFF_WS + 1024, OFF_ACC = OFF_UNIT + 16, LDS_NEED = OFF_ACC + 8 * 8192;
static_assert(LDS_NEED <= 147456 - 64 && OFF_ACC % 16 == 0, "nsa lds");
static_assert(OFF_IMP % 16 == 0 && OFF_SEL % 16 == 0 && OFF_WS % 16 == 0, "nsa lds map");
__device__ __forceinline__ int crow(int r, int hi) { return (r & 3) + 8 * (r >> 2) + 4 * hi; }
__device__ __forceinline__ int next_bit(unsigned m0, unsigned m1, unsigned m2, unsigned m3, int from) {
#pragma unroll
    for (int wd = 0; wd < 4; ++wd) {
        unsigned x = wd == 0 ? m0 : (wd == 1 ? m1 : (wd == 2 ? m2 : m3)); const int base = wd * 32;
        if (from < base + 32) { if (from > base) x &= (~0u) << (from - base); if (x) return base + __builtin_ctz(x); }
    }
    return 128;
}
__device__ __forceinline__ bf16x8 pack8(const f32x16& p, int b0) {
    u32x4 w; w.x = pk2(p[b0 + 0], p[b0 + 1]); w.y = pk2(p[b0 + 2], p[b0 + 3]); w.z = pk2(p[b0 + 4], p[b0 + 5]); w.w = pk2(p[b0 + 6], p[b0 + 7]);
    return __builtin_bit_cast(bf16x8, w);
}
struct Branch { const bf16* k; const bf16* vt; int ldv; };

constexpr float THR = 8.f;
template <int MODE, bool SEL>
__device__ __forceinline__ void compute_tile(unsigned char* sm, int cb, int j, const bf16x8 (&qf)[4], int lo, int hi_b, int lo_max, int hi_min, unsigned s0, unsigned s1, unsigned s2, unsigned s3,
                                             float& m, float& l, float invl, bool& initd, f32x16& negm, f32x16 (&o)[2], float* imp_row, float* wsc, int i, int hi) {
        const unsigned char* kb = sm + OFF_K + cb * KBUF; const unsigned char* vb = sm + OFF_V + cb * VBUF;
        const int key0 = 64 * j;
        bool rowsel = true;
        if (SEL) { const unsigned wsel = j < 32 ? s0 : (j < 64 ? s1 : (j < 96 ? s2 : s3)); rowsel = (wsel >> (j & 31)) & 1u; }
        if (!SEL || __any(rowsel)) {
            f32x16 p0, p1;
            {
                f32x16 c0;
                if (SEL) {
#pragma unroll
                    for (int r = 0; r < 16; ++r) c0[r] = rowsel ? negm[r] : -INFINITY;
                } else c0 = negm;
                const bf16x8 a00 = *(const bf16x8*)(kb + i * KROW + (8 * hi) * 2), a10 = *(const bf16x8*)(kb + (32 + i) * KROW + (8 * hi) * 2);
                p0 = __builtin_amdgcn_mfma_f32_32x32x16_bf16(a00, qf[0], c0, 0, 0, 0);
                p1 = __builtin_amdgcn_mfma_f32_32x32x16_bf16(a10, qf[0], c0, 0, 0, 0);
#pragma unroll
                for (int d0 = 1; d0 < 4; ++d0) {
                    const bf16x8 a0 = *(const bf16x8*)(kb + i * KROW + (16 * d0 + 8 * hi) * 2);
                    const bf16x8 a1 = *(const bf16x8*)(kb + (32 + i) * KROW + (16 * d0 + 8 * hi) * 2);
                    p0 = __builtin_amdgcn_mfma_f32_32x32x16_bf16(a0, qf[d0], p0, 0, 0, 0);
                    p1 = __builtin_amdgcn_mfma_f32_32x32x16_bf16(a1, qf[d0], p1, 0, 0, 0);
                }
            }
            if (!(key0 >= lo_max && key0 + 63 <= hi_min)) {
#pragma unroll
                for (int r = 0; r < 16; ++r) { const int key = key0 + crow(r, hi);
                    if (key < lo || key > hi_b) p0[r] = -INFINITY;
                    if (key + 32 < lo || key + 32 > hi_b) p1[r] = -INFINITY; }
            }
            if (MODE == 1) {
#pragma unroll
                for (int r = 0; r < 16; ++r) { p0[r] = __builtin_amdgcn_exp2f(p0[r]) * invl; p1[r] = __builtin_amdgcn_exp2f(p1[r]) * invl; }
#pragma unroll
                for (int gq = 0; gq < 4; ++gq) {
                    float G0 = (p0[4 * gq] + p0[4 * gq + 1]) + (p0[4 * gq + 2] + p0[4 * gq + 3]), L0 = p0[4 * gq + 3];
                    float G1 = (p1[4 * gq] + p1[4 * gq + 1]) + (p1[4 * gq + 2] + p1[4 * gq + 3]), L1 = p1[4 * gq + 3];
                    G0 += __shfl_xor(G0, 1); L0 += __shfl_xor(L0, 1); G1 += __shfl_xor(G1, 1); L1 += __shfl_xor(L1, 1);
                    G0 += __shfl_xor(G0, 2); L0 += __shfl_xor(L0, 2); G1 += __shfl_xor(G1, 2); L1 += __shfl_xor(L1, 2);
                    if ((i & 3) == 0) { const int s = 16 * j + 2 * gq + hi;
                        atomicAdd(imp_row + s, G0); atomicAdd(imp_row + s + 1, L0); atomicAdd(imp_row + s + 8, G1); atomicAdd(imp_row + s + 9, L1); }
                }
            } else {
                float ta = fmaxf(fmaxf(p0[0], p0[1]), p1[0]), tb = fmaxf(fmaxf(p0[2], p0[3]), p1[1]);
                ta = fmaxf(fmaxf(ta, p1[2]), p1[3]);
#pragma unroll
                for (int r = 4; r < 16; r += 4) { ta = fmaxf(fmaxf(ta, p0[r]), p0[r + 1]); tb = fmaxf(fmaxf(tb, p0[r + 2]), p0[r + 3]); ta = fmaxf(fmaxf(ta, p1[r]), p1[r + 1]); tb = fmaxf(fmaxf(tb, p1[r + 2]), p1[r + 3]); }
                float tm = fmaxf(ta, tb);
                tm = fmaxf(tm, __shfl_xor(tm, 32));
                if (__any((!initd && tm > -INFINITY) || tm > THR)) {
                    const bool was = initd;
                    const float d = was ? fmaxf(tm, 0.f) : (tm > -INFINITY ? tm : 0.f);
                    initd = was || (tm > -INFINITY);
                    m += d; const float alpha = was ? __builtin_amdgcn_exp2f(-d) : 1.f; l *= alpha;
#pragma unroll
                    for (int r = 0; r < 16; ++r) { p0[r] -= d; p1[r] -= d; negm[r] = -m; }
                    if (MODE == 2) {
                        if (hi == 0) wsc[i] = alpha;
                        asm volatile("" ::: "memory");
#pragma unroll
                        for (int rg = 0; rg < 4; ++rg) { const f32x4 a4 = *(const f32x4*)(wsc + 8 * rg + 4 * hi);
#pragma unroll
                            for (int e = 0; e < 4; ++e) { o[0][4 * rg + e] *= a4[e]; o[1][4 * rg + e] *= a4[e]; } }
                        asm volatile("" ::: "memory");
                    }
                }
                float rs = 0.f;
#pragma unroll
                for (int r = 0; r < 16; ++r) { p0[r] = __builtin_amdgcn_exp2f(p0[r]); p1[r] = __builtin_amdgcn_exp2f(p1[r]); rs += p0[r] + p1[r]; }
                l += rs;
            }
            if (MODE != 0) {
                const bf16x8 pf0 = pack8(p0, 0), pf1 = pack8(p0, 8), pf2 = pack8(p1, 0), pf3 = pack8(p1, 8);
#pragma unroll
                for (int dt = 0; dt < 2; ++dt) {
                    const unsigned char* vp = vb + (32 * dt + i) * VROW + 8 * hi;
#pragma unroll
                    for (int ks = 0; ks < 4; ++ks) {
                        const u32x2 v_lo = *(const u32x2*)(vp + 32 * ks), v_hi = *(const u32x2*)(vp + 32 * ks + 16);
                        const bf16x8 vf = __builtin_bit_cast(bf16x8, (u32x4){v_lo.x, v_lo.y, v_hi.x, v_hi.y});
                        o[dt] = __builtin_amdgcn_mfma_f32_32x32x16_bf16(ks == 0 ? pf0 : (ks == 1 ? pf1 : (ks == 2 ? pf2 : pf3)), vf, o[dt], 0, 0, 0);
                    }
                }
            }
        }
}
template <int MODE, bool SEL>
__device__ __forceinline__ void run_branch(unsigned char* sm, const Branch br, unsigned m0, unsigned m1, unsigned m2, unsigned m3,
                                           const bf16x8 (&qf)[4], int lo, int hi_b, int lo_max, int hi_min, unsigned s0, unsigned s1, unsigned s2, unsigned s3,
                                           float& m, float& l, float invl, f32x16 (&o)[2], float* imp_row, float* wsc, int tid, int lane) {
    const int i = lane & 31, hi = lane >> 5;
    const bf16* kp = br.k + tid * 8; const bf16* vp_ = br.vt + (size_t)(tid >> 3) * br.ldv + (tid & 7) * 8;
    unsigned char* kst = sm + OFF_K + (tid >> 3) * KROW + (tid & 7) * 16; unsigned char* vst = sm + OFF_V + (tid >> 3) * VROW + (tid & 7) * 16;
#define NSA_LOAD(jj, KR, VR) do { KR = *(const u32x4*)(kp + (size_t)(jj) * 4096); if (MODE != 0) VR = *(const u32x4*)(vp_ + (jj) * 64); } while (0)
#define NSA_STORE(buf, KR, VR) do { *(u32x4*)(kst + (buf) * KBUF) = KR; if (MODE != 0) { *(u32x2*)(vst + (buf) * VBUF) = (u32x2){VR.x, VR.y}; *(u32x2*)(vst + (buf) * VBUF + 8) = (u32x2){VR.z, VR.w}; } } while (0)
    int j = next_bit(m0, m1, m2, m3, 0);
    int j1 = j < 128 ? next_bit(m0, m1, m2, m3, j + 1) : 128;
    u32x4 kA, vA, kB, vB;
    if (j < 128) { NSA_LOAD(j, kA, vA); if (j1 < 128) NSA_LOAD(j1, kB, vB); NSA_STORE(0, kA, vA); }
    __syncthreads();
    bool initd = (MODE == 1);
    f32x16 negm;
#pragma unroll
    for (int r = 0; r < 16; ++r) negm[r] = (MODE == 1) ? -m : 0.f;
    while (j < 128) {
        {
            const int j2 = j1 < 128 ? next_bit(m0, m1, m2, m3, j1 + 1) : 128;
            if (j2 < 128) NSA_LOAD(j2, kA, vA);
            compute_tile<MODE, SEL>(sm, 0, j, qf, lo, hi_b, lo_max, hi_min, s0, s1, s2, s3, m, l, invl, initd, negm, o, imp_row, wsc, i, hi);
            if (j1 < 128) NSA_STORE(1, kB, vB);
            __syncthreads();
            j = j1; j1 = j2;
        }
        if (j >= 128) break;
        {
            const int j2 = j1 < 128 ? next_bit(m0, m1, m2, m3, j1 + 1) : 128;
            if (j2 < 128) NSA_LOAD(j2, kB, vB);
            compute_tile<MODE, SEL>(sm, 1, j, qf, lo, hi_b, lo_max, hi_min, s0, s1, s2, s3, m, l, invl, initd, negm, o, imp_row, wsc, i, hi);
            if (j1 < 128) NSA_STORE(0, kA, vA);
            __syncthreads();
            j = j1; j1 = j2;
        }
    }
#undef NSA_LOAD
#undef NSA_STORE
}
template <bool FIRST> __device__ __forceinline__ void add_scaled(float* accw, const f32x16 (&o)[2], float f, float* wsc, int i, int hi, int lane) {
    if (hi == 0) wsc[i] = f;
    asm volatile("" ::: "memory");
#pragma unroll
    for (int rg = 0; rg < 4; ++rg) { const f32x4 a4 = *(const f32x4*)(wsc + 8 * rg + 4 * hi);
#pragma unroll
        for (int e = 0; e < 4; ++e)
#pragma unroll
            for (int dt = 0; dt < 2; ++dt) { float* p = accw + (dt * 16 + 4 * rg + e) * 64 + lane; const float v = a4[e] * o[dt][4 * rg + e]; *p = FIRST ? v : (*p + v); } }
    asm volatile("" ::: "memory");
}
__device__ __forceinline__ void unit(const NsaArgs& a, int u, unsigned char* sm) {
    const int tid = tidx(), lane = tid & 63, w = __builtin_amdgcn_readfirstlane(tid >> 6), i = lane & 31, hi = lane >> 5;
    const int cur = 127 - (u >> 2), bg = u & 3, b = bg >> 1, g = bg & 1, q0 = cur * 64;
    const int ql = 8 * w + (i >> 2), hd = i & 3, t = q0 + ql;
    const size_t grow = (size_t)b * T_ + t;
    bf16x8 qf[4];
    { const bf16* qp = a.qb + grow * 512 + g * 256 + hd * 64 + 8 * hi;
#pragma unroll
      for (int d0 = 0; d0 < 4; ++d0) qf[d0] = *(const bf16x8*)(qp + 16 * d0); }
    float* wsc = (float*)(sm + OFF_WS) + w * 32;
    float* imp = (float*)(sm + OFF_IMP);
    unsigned* selw = (unsigned*)(sm + OFF_SEL);
    unsigned* um = (unsigned*)(sm + OFF_UM);
    for (int k = tid; k < 64 * IMPW; k += 512) imp[k] = 0.f;
    if (tid < 4) um[tid] = 0u;
    const float* gt = a.gates + grow * 24 + g * 12 + hd * 3;
    const float gc = gt[0], gs = gt[1], gw = gt[2];
    f32x16 o[2];
    float* accw = (float*)(sm + OFF_ACC) + w * 2048;
    const int tw0 = q0 + 8 * w, tw1 = tw0 + 7;
    {
        const int nv = t < 31 ? 0 : (t - 31) / 16 + 1;
        const int nvw = tw0 < 31 ? 0 : (tw0 - 31) / 16 + 1;
        const int nvmax = (q0 + 63 - 31) / 16 + 1, ntc = (nvmax + 63) / 64;
        const unsigned cm0 = ntc >= 32 ? ~0u : ((1u << ntc) - 1u);
        const Branch br{a.kc + (size_t)bg * NCP * 64, a.vct + (size_t)bg * 64 * NCP, NCP};
        float m = 0.f, l = 0.f;
        run_branch<0, false>(sm, br, cm0, 0u, 0u, 0u, qf, 0, nv - 1, 0, nvw - 1, 0u, 0u, 0u, 0u, m, l, 0.f, o, nullptr, wsc, tid, lane);
        l += __shfl_xor(l, 32);
        const float invl = 1.f / fmaxf(l, 1e-30f);
#pragma unroll
        for (int r = 0; r < 16; ++r) { o[0][r] = 0.f; o[1][r] = 0.f; }
        run_branch<1, false>(sm, br, cm0, 0u, 0u, 0u, qf, 0, nv - 1, 0, nvw - 1, 0u, 0u, 0u, 0u, m, l, invl, o, imp + ql * IMPW, wsc, tid, lane);
        add_scaled<true>(accw, o, gc, wsc, i, hi, lane);
    }
    {
        unsigned u0 = 0u, u1 = 0u, u2 = 0u, u3 = 0u;
        const int ncand = cur - 2;
        unsigned k0[8], k1[8], k2[8], k3[8];
        if (ncand <= 13) {
#pragma unroll
            for (int wd = 0; wd < 4; ++wd) { const int nb = cur + 1 - 32 * wd; const unsigned x = nb >= 32 ? ~0u : (nb <= 0 ? 0u : ((1u << nb) - 1u));
#pragma unroll
                for (int qq = 0; qq < 8; ++qq) { if (wd == 0) k0[qq] = x; else if (wd == 1) k1[qq] = x; else if (wd == 2) k2[qq] = x; else k3[qq] = x; } }
        } else {
            float v0[8], v1[8];
#pragma unroll
            for (int qq = 0; qq < 8; ++qq) { const float* ir = imp + (8 * w + qq) * IMPW;
                v0[qq] = (lane >= 1 && lane <= cur - 2) ? ir[lane] : -1.f; v1[qq] = (lane + 64 <= cur - 2) ? ir[lane + 64] : -1.f;
                k0[qq] = 1u; k1[qq] = 0u; k2[qq] = 0u; k3[qq] = 0u; }
            for (int it = 0; it < 13; ++it) {
                float bv[8]; int bs[8];
#pragma unroll
                for (int qq = 0; qq < 8; ++qq) { bv[qq] = v0[qq]; bs[qq] = lane; if (v1[qq] > v0[qq]) { bv[qq] = v1[qq]; bs[qq] = lane + 64; } }
#pragma unroll
                for (int off = 1; off < 64; off <<= 1) {
#pragma unroll
                    for (int qq = 0; qq < 8; ++qq) { const float ov = __shfl_xor(bv[qq], off); const int os = __shfl_xor(bs[qq], off);
                        if (ov > bv[qq] || (ov == bv[qq] && os < bs[qq])) { bv[qq] = ov; bs[qq] = os; } } }
#pragma unroll
                for (int qq = 0; qq < 8; ++qq) { const int b_ = __builtin_amdgcn_readfirstlane(bs[qq]);
                    if (b_ == lane) v0[qq] = -1.f; if (b_ == lane + 64) v1[qq] = -1.f;
                    const unsigned bit = 1u << (b_ & 31);
                    if (b_ < 32) k0[qq] |= bit; else if (b_ < 64) k1[qq] |= bit; else if (b_ < 96) k2[qq] |= bit; else k3[qq] |= bit; }
            }
            { const int c1 = cur - 1; const unsigned b1 = 1u << (c1 & 31), b2 = 1u << (cur & 31);
#pragma unroll
              for (int qq = 0; qq < 8; ++qq) {
                if (c1 < 32) k0[qq] |= b1; else if (c1 < 64) k1[qq] |= b1; else if (c1 < 96) k2[qq] |= b1; else k3[qq] |= b1;
                if (cur < 32) k0[qq] |= b2; else if (cur < 64) k1[qq] |= b2; else if (cur < 96) k2[qq] |= b2; else k3[qq] |= b2; } }
        }
#pragma unroll
        for (int qq = 0; qq < 8; ++qq) {
            if (lane == 0) { unsigned* sp = selw + (8 * w + qq) * 4; sp[0] = k0[qq]; sp[1] = k1[qq]; sp[2] = k2[qq]; sp[3] = k3[qq]; }
            u0 |= k0[qq]; u1 |= k1[qq]; u2 |= k2[qq]; u3 |= k3[qq]; }
        if (lane == 0) { atomicOr(um + 0, u0); atomicOr(um + 1, u1); atomicOr(um + 2, u2); atomicOr(um + 3, u3); }
    }
    __syncthreads();
    {
        const unsigned U0 = um[0], U1 = um[1], U2 = um[2], U3 = um[3];
        const unsigned* sp = selw + ql * 4; const unsigned s0 = sp[0], s1 = sp[1], s2 = sp[2], s3 = sp[3];
        const Branch br{a.ks + (size_t)bg * T_ * 64, a.vst + (size_t)bg * 64 * T_, T_};
        float m = 0.f, l = 0.f;
#pragma unroll
        for (int r = 0; r < 16; ++r) { o[0][r] = 0.f; o[1][r] = 0.f; }
        run_branch<2, true>(sm, br, __builtin_amdgcn_readfirstlane(U0), __builtin_amdgcn_readfirstlane(U1), __builtin_amdgcn_readfirstlane(U2), __builtin_amdgcn_readfirstlane(U3),
                            qf, 0, t, 0, tw0, s0, s1, s2, s3, m, l, 0.f, o, nullptr, wsc, tid, lane);
        l += __shfl_xor(l, 32);
        add_scaled<false>(accw, o, gs / fmaxf(l, 1e-30f), wsc, i, hi, lane);
    }
    {
        const int j0 = cur - 8 > 0 ? cur - 8 : 0;
        unsigned wm0 = 0u, wm1 = 0u, wm2 = 0u, wm3 = 0u;
#pragma unroll
        for (int wd = 0; wd < 4; ++wd) { const int a0 = j0 - 32 * wd, a1 = cur + 1 - 32 * wd;
            const unsigned hi_m = a1 >= 32 ? ~0u : (a1 <= 0 ? 0u : ((1u << a1) - 1u)), lo_m = a0 >= 32 ? ~0u : (a0 <= 0 ? 0u : ((1u << a0) - 1u));
            const unsigned x = hi_m & ~lo_m; if (wd == 0) wm0 = x; else if (wd == 1) wm1 = x; else if (wd == 2) wm2 = x; else wm3 = x; }
        const Branch br{a.kw + (size_t)bg * T_ * 64, a.vwt + (size_t)bg * 64 * T_, T_};
        float m = 0.f, l = 0.f;
#pragma unroll
        for (int r = 0; r < 16; ++r) { o[0][r] = 0.f; o[1][r] = 0.f; }
        run_branch<2, false>(sm, br, wm0, wm1, wm2, wm3, qf, t - 511, t, tw1 - 511, tw0, 0u, 0u, 0u, 0u, m, l, 0.f, o, nullptr, wsc, tid, lane);
        l += __shfl_xor(l, 32);
        add_scaled<false>(accw, o, gw / fmaxf(l, 1e-30f), wsc, i, hi, lane);
    }
#pragma unroll
    for (int r = 0; r < 16; ++r) { const int rw = crow(r, hi), qq = 8 * w + (rw >> 2), hh = rw & 3;
        bf16* op = a.amix + ((size_t)b * T_ + q0 + qq) * DM + g * 256 + hh * 64 + i;
        op[0] = (bf16)f2bf(accw[r * 64 + lane]); op[32] = (bf16)f2bf(accw[(16 + r) * 64 + lane]); }
}
__device__ __forceinline__ void phase(const NsaArgs& a, unsigned* ctr, unsigned char* sm) {
    int* slot = (int*)(sm + OFF_UNIT);
    for (;;) {
        if (tidx() == 0) *slot = (int)atomicAdd(ctr, 1u);
        __syncthreads();
        const int u = *slot;
        __syncthreads();
        if (u >= 512) break;
        unit(a, u, sm);
    }
}
}

__device__ __forceinline__ void d_lora_prep(const bf16* pr, const float* mu, bf16* la, int wg0 = 0) {
    if ((int)blockIdx.x < wg0) return;
    const int T512 = tidx(), c = T512 & 255;
    const float m = mu[1536 + c];
    for (int vb = ((int)blockIdx.x - wg0) * 2 + (T512 >> 8); vb < M_ / 4; vb += ((int)gridDim.x - wg0) * 2) {
        const int row0 = vb * 4;
        float x[5];
        x[0] = (row0 % T_) ? bf2f(pr[(size_t)(row0 - 1) * 256 + c]) : 0.f;
#pragma unroll
        for (int j = 0; j < 4; ++j) x[j + 1] = bf2f(pr[(size_t)(row0 + j) * 256 + c]);
#pragma unroll
        for (int j = 0; j < 4; ++j) { const float xs = x[j + 1] + (x[j] - x[j + 1]) * m;
            const float v = c < 64 ? tanhf(xs) : (c < 128 ? xs : sigmoidf_(xs));
            la[(size_t)(row0 + j) * KLORA + c] = (bf16)f2bf(v); }
    }
}

namespace rw7 {
using nsa::f32x16; using nsa::crow; using nsa::pack8;
constexpr int NHELP = 2, RG = 18;
constexpr int NPROD = 6, RING = 7, RA = 144, RB = 40, S_AT = 0, S_RT = 16 * RA, S_BT = 32 * RA, S_KT = S_BT + 64 * RB, S_VT = S_KT + 64 * RB, S_SM = S_VT + 64 * RB, SMM = 16 * RB, S_GC = S_SM + 4 * SMM, SLOT = S_GC + 256;
constexpr int OFF_SCR = RING * SLOT, SCR = 32 * RA, LDS_NEED = OFF_SCR;
static_assert(NPROD % NHELP == 0 && LDS_NEED <= 147456 - 64 && 6 * (SLOT + SCR) <= 147456 - 64 && (size_t)16 * NHELP * RG * SLOT <= (size_t)9 << 20 && SLOT % 16 == 0 && S_BT % 16 == 0 && 128 * RB >= 4096 && SCR >= 4096, "rw7 lds map");
struct Args { const unsigned* rkw; const bf16* vv; const bf16* aga; const float* wdec; const float *mu, *kk, *ka, *rk; float* yraw; float* bonus; unsigned char* ring; unsigned* flags; unsigned* cons; };
__device__ __forceinline__ void wg_bar() { asm volatile("s_waitcnt lgkmcnt(0)" ::: "memory"); __builtin_amdgcn_s_barrier(); asm volatile("" ::: "memory"); }
struct Chan { float mur, muk, muv, kkc, kac, rkc; };
struct Raw { unsigned rk[16]; unsigned short v[16], al[16]; float w[16]; unsigned prk; unsigned short pv; };
__device__ __forceinline__ void fetch(const Args& a, int b, int h, int c, int lane, Raw& q) {
    const size_t base = ((size_t)b * T_ + (size_t)c * 16) * 512 + h * 64 + lane;
#pragma unroll
    for (int t = 0; t < 16; ++t) { q.rk[t] = a.rkw[base + (size_t)t * 512]; q.v[t] = a.vv[base + (size_t)t * 512]; q.al[t] = a.aga[base + (size_t)t * 512]; q.w[t] = a.wdec[base + (size_t)t * 512]; }
    q.prk = 0u; q.pv = 0;
    if (c > 0) { q.prk = a.rkw[base - 512]; q.pv = a.vv[base - 512]; }
}
__device__ __forceinline__ void st_row40(unsigned char* p, const unsigned (&w)[8]) {
    *(u32x2*)p = (u32x2){w[0], w[1]}; *(u32x2*)(p + 8) = (u32x2){w[2], w[3]}; *(u32x2*)(p + 16) = (u32x2){w[4], w[5]}; *(u32x2*)(p + 24) = (u32x2){w[6], w[7]};
}
template <bool BAR> __device__ __forceinline__ void seg_end() { if (BAR) wg_bar(); else { asm volatile("s_waitcnt lgkmcnt(0)" ::: "memory"); __builtin_amdgcn_sched_barrier(0); } }
template <bool BAR> __device__ __forceinline__ void produce(const Args& a, const Chan& ch, int b, int h, int c, const Raw& q, unsigned char* slot, unsigned char* scr, int lane) {
    const int i = lane & 31, hi = lane >> 5;
    const size_t row0 = (size_t)b * T_ + (size_t)c * 16;
    float pr_r = __builtin_bit_cast(float, q.prk << 16), pr_k = __builtin_bit_cast(float, q.prk & 0xffff0000u), pr_v = bf2f(q.pv);
    float rr[16], kq[16], kt[16];
    float* RED1 = (float*)scr;
    float* RED2 = (float*)(slot + S_BT);
#pragma unroll
    for (int t4 = 0; t4 < 4; ++t4) { f32x4 e1, e2;
#pragma unroll
        for (int e = 0; e < 4; ++e) { const int t = 4 * t4 + e;
            const float r0 = __builtin_bit_cast(float, q.rk[t] << 16), k0 = __builtin_bit_cast(float, q.rk[t] & 0xffff0000u), al = bf2f(q.al[t]);
            const float r = r0 + (pr_r - r0) * ch.mur, k = k0 + (pr_k - k0) * ch.muk;
            pr_r = r0; pr_k = k0;
            rr[t] = r; kq[t] = k * ch.kkc; kt[t] = k * (1.f + (al - 1.f) * ch.kac);
            e1[e] = kq[t] * kq[t]; e2[e] = r * kt[t] * ch.rkc; }
        *(f32x4*)(RED1 + lane * 16 + 4 * t4) = e1; *(f32x4*)(RED2 + lane * 16 + 4 * t4) = e2; }
    seg_end<BAR>();
    { const int t = lane & 15, part = lane >> 4; float s1 = 0.f, s2 = 0.f;
#pragma unroll
      for (int j = 0; j < 16; ++j) { s1 += RED1[(part * 16 + j) * 16 + t]; s2 += RED2[(part * 16 + j) * 16 + t]; }
      s1 += __shfl_xor(s1, 16); s2 += __shfl_xor(s2, 16); s1 += __shfl_xor(s1, 32); s2 += __shfl_xor(s2, 32);
      asm volatile("s_waitcnt lgkmcnt(0)" ::: "memory");
      if (lane < 16) { ((float*)(slot + S_GC))[lane] = s1; a.bonus[(row0 + lane) * 8 + h] = s2; } }
    asm volatile("s_waitcnt lgkmcnt(0)" ::: "memory");
    f32x4 n2[4];
#pragma unroll
    for (int t4 = 0; t4 < 4; ++t4) n2[t4] = *(const f32x4*)(slot + S_GC + 16 * t4);
    asm volatile("s_waitcnt lgkmcnt(0)" ::: "memory");
    float gam = 1.f;
    unsigned btp[8], ktp[8], vtp[8];
    float b_ev = 0.f, k_ev = 0.f, v_ev = 0.f;
#pragma unroll
    for (int t = 0; t < 16; ++t) {
        if (t == 6) seg_end<BAR>();
        const float v0 = bf2f(q.v[t]), al = bf2f(q.al[t]);
        const float v = v0 + (pr_v - v0) * ch.muv; pr_v = v0;
        const float kkn = kq[t] * __builtin_amdgcn_rsqf(fmaxf(n2[t >> 2][t & 3], 1e-24f));
        const float gp = gam; gam *= q.w[t]; const float ig = __builtin_amdgcn_rcpf(gam);
        const float bt_ = kkn * al * ig, kt_ = kt[t] * ig;
        const unsigned ar = pk2(-kkn * gp, rr[t] * gam), bk = pk2(bt_, kt_);
        *(bf16*)(slot + S_AT + t * RA + lane * 2) = (bf16)(ar & 0xffffu); *(bf16*)(slot + S_RT + t * RA + lane * 2) = (bf16)(ar >> 16);
        *(bf16*)(scr + t * RA + lane * 2) = (bf16)(bk & 0xffffu); *(bf16*)(scr + (16 + t) * RA + lane * 2) = (bf16)(bk >> 16);
        if (t & 1) { btp[t >> 1] = pk2(b_ev, bt_); ktp[t >> 1] = pk2(k_ev, kt_); vtp[t >> 1] = pk2(v_ev, v); }
        else { b_ev = bt_; k_ev = kt_; v_ev = v; }
    }
    st_row40(slot + S_BT + lane * RB, btp); st_row40(slot + S_KT + lane * RB, ktp); st_row40(slot + S_VT + lane * RB, vtp);
    ((float*)(slot + S_GC))[lane] = gam;
    seg_end<BAR>();
    f32x16 C;
#pragma unroll
    for (int r = 0; r < 16; ++r) C[r] = 0.f;
#pragma unroll
    for (int ks = 0; ks < 4; ++ks) {
        const bf16x8 af = *(const bf16x8*)(slot + S_AT + i * RA + (16 * ks + 8 * hi) * 2);
        const bf16x8 bf = *(const bf16x8*)(scr + i * RA + (16 * ks + 8 * hi) * 2);
        C = __builtin_amdgcn_mfma_f32_32x32x16_bf16(af, bf, C, 0, 0, 0);
    }
    asm volatile("s_waitcnt lgkmcnt(0)" ::: "memory");
    float* AAB = (float*)scr;
    unsigned char* SM = slot + S_SM;
#pragma unroll
    for (int r = 0; r < 16; ++r) {
        const int rho = crow(r, hi); const float val = C[r];
        if (r < 8) {
            if (i < 16) AAB[rho * 16 + i] = (i < rho) ? val : 0.f;
            else *(bf16*)(SM + SMM + rho * RB + (i - 16) * 2) = (bf16)f2bf((i - 16 < rho) ? val : 0.f);
        } else {
            const int tt = rho - 16;
            if (i < 16) *(bf16*)(SM + 2 * SMM + tt * RB + i * 2) = (bf16)f2bf((i <= tt) ? val : 0.f);
            else *(bf16*)(SM + 3 * SMM + tt * RB + (i - 16) * 2) = (bf16)f2bf((i - 16 <= tt) ? val : 0.f);
        }
    }
    seg_end<BAR>();
    { const int j = lane & 15; float Tr[16];
#pragma unroll
      for (int t = 0; t < 16; ++t) { if (t == 11) seg_end<BAR>();
          float acc = (t == j) ? 1.f : 0.f;
#pragma unroll
          for (int s4 = 0; s4 < (t + 3) / 4; ++s4) { const f32x4 ar = *(const f32x4*)(AAB + t * 16 + 4 * s4);
#pragma unroll
              for (int e = 0; e < 4; ++e) if (4 * s4 + e < t) acc += ar[e] * Tr[4 * s4 + e]; }
          Tr[t] = acc;
          if (lane < 16) *(bf16*)(SM + t * RB + j * 2) = (bf16)f2bf(acc); } }
    seg_end<BAR>();
}

__device__ __forceinline__ bf16x8 rd_perm(const unsigned char* p, int hi) {
    const u32x2 a = *(const u32x2*)(p + 8 * hi), b = *(const u32x2*)(p + 16 + 8 * hi);
    return __builtin_bit_cast(bf16x8, (u32x4){a.x, a.y, b.x, b.y});
}
__device__ __forceinline__ bf16x8 rd_nat(const unsigned char* p, int hi) {
    const u32x2 a = *(const u32x2*)(p + 16 * hi), b = *(const u32x2*)(p + 16 * hi + 8);
    return __builtin_bit_cast(bf16x8, (u32x4){a.x, a.y, b.x, b.y});
}
__device__ __forceinline__ bf16x8 and8(bf16x8 f, unsigned m) { u32x4 w = __builtin_bit_cast(u32x4, f); w.x &= m; w.y &= m; w.z &= m; w.w &= m; return __builtin_bit_cast(bf16x8, w); }
__device__ __forceinline__ void consume(const unsigned char* slot, f32x16 (&z)[2], float* yout, int vt, int lane) {
    const int i = lane & 31, hi = lane >> 5, i16 = i & 15;
    const unsigned m16 = i < 16 ? 0xffffffffu : 0u;
    const unsigned char* at = slot + S_AT + i16 * RA; const unsigned char* rt = slot + S_RT + i16 * RA; const unsigned char* sm16 = slot + S_SM + i16 * RB;
    bf16x8 fa0 = rd_perm(at, hi), fa1 = rd_perm(at + 32, hi), fa2 = rd_perm(at + 64, hi), fa3 = rd_perm(at + 96, hi);
    bf16x8 fak = rd_nat(sm16 + SMM, hi), ft = rd_perm(sm16, hi);
    const bf16x8 vtf = rd_nat(slot + S_VT + (32 * vt + i) * RB, hi);
    bf16x8 fr0 = rd_perm(rt, hi), fr1 = rd_perm(rt + 32, hi), fr2 = rd_perm(rt + 64, hi), fr3 = rd_perm(rt + 96, hi);
    bf16x8 frb = rd_perm(sm16 + 2 * SMM, hi), frk = rd_nat(sm16 + 3 * SMM, hi);
    const bf16x8 fk0 = rd_nat(slot + S_KT + i * RB, hi), fk1 = rd_nat(slot + S_KT + (32 + i) * RB, hi);
    const bf16x8 fb0 = rd_perm(slot + S_BT + i * RB, hi), fb1 = rd_perm(slot + S_BT + (32 + i) * RB, hi);
    f32x4 g4[2][4];
#pragma unroll
    for (int kt = 0; kt < 2; ++kt)
#pragma unroll
        for (int rg = 0; rg < 4; ++rg) g4[kt][rg] = *(const f32x4*)(slot + S_GC + (32 * kt + 8 * rg + 4 * hi) * 4);
    const bf16x8 zb0 = pack8(z[0], 0), zb1 = pack8(z[0], 8), zb2 = pack8(z[1], 0), zb3 = pack8(z[1], 8);
    fa0 = and8(fa0, m16); fa1 = and8(fa1, m16); fa2 = and8(fa2, m16); fa3 = and8(fa3, m16); fak = and8(fak, m16); ft = and8(ft, m16);
    fr0 = and8(fr0, m16); fr1 = and8(fr1, m16); fr2 = and8(fr2, m16); fr3 = and8(fr3, m16); frb = and8(frb, m16); frk = and8(frk, m16);
    f32x16 X, U, Y;
#pragma unroll
    for (int r = 0; r < 16; ++r) { X[r] = 0.f; U[r] = 0.f; Y[r] = 0.f; }
    X = __builtin_amdgcn_mfma_f32_32x32x16_bf16(fa0, zb0, X, 0, 0, 0);
    X = __builtin_amdgcn_mfma_f32_32x32x16_bf16(fa1, zb1, X, 0, 0, 0);
    X = __builtin_amdgcn_mfma_f32_32x32x16_bf16(fa2, zb2, X, 0, 0, 0);
    X = __builtin_amdgcn_mfma_f32_32x32x16_bf16(fa3, zb3, X, 0, 0, 0);
    X = __builtin_amdgcn_mfma_f32_32x32x16_bf16(fak, vtf, X, 0, 0, 0);
    Y = __builtin_amdgcn_mfma_f32_32x32x16_bf16(fr0, zb0, Y, 0, 0, 0);
    Y = __builtin_amdgcn_mfma_f32_32x32x16_bf16(fr1, zb1, Y, 0, 0, 0);
    Y = __builtin_amdgcn_mfma_f32_32x32x16_bf16(fr2, zb2, Y, 0, 0, 0);
    Y = __builtin_amdgcn_mfma_f32_32x32x16_bf16(fr3, zb3, Y, 0, 0, 0);
    Y = __builtin_amdgcn_mfma_f32_32x32x16_bf16(frk, vtf, Y, 0, 0, 0);
    z[0] = __builtin_amdgcn_mfma_f32_32x32x16_bf16(fk0, vtf, z[0], 0, 0, 0);
    z[1] = __builtin_amdgcn_mfma_f32_32x32x16_bf16(fk1, vtf, z[1], 0, 0, 0);
    const bf16x8 xb = pack8(X, 0);
    U = __builtin_amdgcn_mfma_f32_32x32x16_bf16(ft, xb, U, 0, 0, 0);
    const bf16x8 ub = pack8(U, 0);
    z[0] = __builtin_amdgcn_mfma_f32_32x32x16_bf16(fb0, ub, z[0], 0, 0, 0);
    z[1] = __builtin_amdgcn_mfma_f32_32x32x16_bf16(fb1, ub, z[1], 0, 0, 0);
    Y = __builtin_amdgcn_mfma_f32_32x32x16_bf16(frb, ub, Y, 0, 0, 0);
#pragma unroll
    for (int kt = 0; kt < 2; ++kt)
#pragma unroll
        for (int rg = 0; rg < 4; ++rg)
#pragma unroll
            for (int e = 0; e < 4; ++e) z[kt][4 * rg + e] *= g4[kt][rg][e];
#pragma unroll
    for (int r = 0; r < 8; ++r) yout[(size_t)crow(r, hi) * 512] = Y[r];
}

__device__ __forceinline__ unsigned ld_relaxed(const unsigned* p) { return __hip_atomic_load(p, __ATOMIC_RELAXED, __HIP_MEMORY_SCOPE_AGENT); }
__device__ __forceinline__ void head(const Args& a, int bh, unsigned char* sm) {
    const int tid = tidx(), lane = tid & 63, w = __builtin_amdgcn_readfirstlane(tid >> 6);
    const int b = bh >> 3, h = bh & 7;
    constexpr int NCH = T_ / 16, NBAR = NCH + NPROD;
    if (w < 2) {
        f32x16 z[2];
#pragma unroll
        for (int r = 0; r < 16; ++r) { z[0][r] = 0.f; z[1][r] = 0.f; }
        for (int i = 0; i < NPROD; ++i) wg_bar();
        for (int c = 0; c < NCH; ++c) {
            consume(sm + (size_t)(c % RING) * SLOT, z, a.yraw + ((size_t)b * T_ + (size_t)c * 16) * 512 + h * 64 + 32 * w + (lane & 31), w, lane);
            if (w == 0 && (c & 7) == 7 && lane == 0) __hip_atomic_store(a.cons + bh * 64, (unsigned)(c + 1), __ATOMIC_RELAXED, __HIP_MEMORY_SCOPE_AGENT);
            wg_bar();
        }
    } else {
        const int pw = w - 2;
        int nb = pw;
        {
            u32x4 v[15];
            { const int c = pw; const int hl = c % NHELP, n = c / NHELP;
              const unsigned char* g = a.ring + ((size_t)(bh * NHELP + hl) * RG + (n % RG)) * SLOT;
              while (__builtin_amdgcn_readfirstlane(ld_relaxed(a.flags + bh * NCH + c)) == 0u) __builtin_amdgcn_s_sleep(2);
              __builtin_amdgcn_fence(__ATOMIC_ACQUIRE, "agent");
              asm volatile("s_waitcnt vmcnt(0)" ::: "memory");
#pragma unroll
              for (int i = 0; i < 15; ++i) { const int off = (i * 64 + lane) * 16; if (off < SLOT) v[i] = *(const u32x4*)(g + off); } }
            for (int i = 0; i < pw; ++i) wg_bar();
            for (int c = pw; c < NCH; c += NPROD) {
                unsigned char* slot = sm + (size_t)(c % RING) * SLOT;
#pragma unroll
                for (int i = 0; i < 15; ++i) { const int off = (i * 64 + lane) * 16; if (off < SLOT) *(u32x4*)(slot + off) = v[i]; }
                const int cn = c + NPROD; const bool more = cn < NCH;
                const unsigned* fp = a.flags + bh * NCH + (more ? cn : c);
                unsigned fl = ld_relaxed(fp);
                wg_bar(); wg_bar();
                if (more) {
                    while (__builtin_amdgcn_readfirstlane(fl) == 0u) { __builtin_amdgcn_s_sleep(2); fl = ld_relaxed(fp); }
                    __builtin_amdgcn_fence(__ATOMIC_ACQUIRE, "agent");
                    asm volatile("s_waitcnt vmcnt(0)" ::: "memory");
                    const int hl = cn % NHELP, n = cn / NHELP;
                    const unsigned char* g = a.ring + ((size_t)(bh * NHELP + hl) * RG + (n % RG)) * SLOT;
#pragma unroll
                    for (int i = 0; i < 15; ++i) { const int off = (i * 64 + lane) * 16; if (off < SLOT) v[i] = *(const u32x4*)(g + off); }
                }
                wg_bar(); wg_bar(); wg_bar(); wg_bar();
                nb += NPROD;
            }
        }
        for (; nb < NBAR; ++nb) wg_bar();
    }
}
__device__ __forceinline__ void helper(const Args& a, int bh, int hl, unsigned char* sm) {
    const int tid = tidx(), lane = tid & 63, w = __builtin_amdgcn_readfirstlane(tid >> 6);
    if (w >= 6) return;
    const int b = bh >> 3, h = bh & 7, col = h * 64 + lane;
    constexpr int NCH = T_ / 16;
    unsigned char* slot = sm + (size_t)w * SLOT; unsigned char* scr = sm + 6 * SLOT + w * SCR;
    const Chan ch{a.mu[col], a.mu[512 + col], a.mu[1024 + col], a.kk[col], a.ka[col], a.rk[col]};
    int n = w, c = NHELP * n + hl;
    if (c >= NCH) return;
    for (; c < NCH; n += 6, c += 6 * NHELP) {
        Raw q; fetch(a, b, h, c, lane, q);
        if (n >= RG) { const unsigned need = (unsigned)(c - RG * NHELP + 1);
            while (__builtin_amdgcn_readfirstlane(ld_relaxed(a.cons + bh * 64)) < need) __builtin_amdgcn_s_sleep(8); }
        produce<false>(a, ch, b, h, c, q, slot, scr, lane);
        asm volatile("s_waitcnt lgkmcnt(0)" ::: "memory");
        unsigned char* g = a.ring + ((size_t)(bh * NHELP + hl) * RG + (n % RG)) * SLOT;
#pragma unroll
        for (int i = 0; i < 15; ++i) { const int off = (i * 64 + lane) * 16;
            if (off < SLOT) { const u32x4 d = *(const u32x4*)(slot + off); unsigned char* gp = g + off; asm volatile("global_store_dwordx4 %0, %1, off sc1\n\ts_nop 1" :: "v"(gp), "v"(d) : "memory"); } }
        asm volatile("s_waitcnt vmcnt(0)" ::: "memory");
        if (lane == 0) __hip_atomic_store(a.flags + bh * NCH + c, 1u, __ATOMIC_RELAXED, __HIP_MEMORY_SCOPE_AGENT);
    }
}
__device__ __forceinline__ void finish(const float* yraw, const float* bonus, const bf16* vv, const bf16* agg, const float* mu, const float* gng, const float* gnb, bf16* amix) {
    const int T512 = tidx(), lane = T512 & 63;
    for (int it0 = (blockIdx.x * 8 + (T512 >> 6)) * 4; it0 < M_ * 8; it0 += gridDim.x * 8 * 4) {
        const int row = it0 >> 3, h0 = it0 & 7, t = row % T_;
        float y[4], v0[4], v1[4], gg[4], bo[4];
#pragma unroll
        for (int j = 0; j < 4; ++j) { const int col = (h0 + j) * 64 + lane;
            y[j] = yraw[(size_t)row * 512 + col]; v0[j] = bf2f(vv[(size_t)row * 512 + col]); v1[j] = t ? bf2f(vv[(size_t)(row - 1) * 512 + col]) : 0.f;
            gg[j] = bf2f(agg[(size_t)row * 512 + col]); bo[j] = bonus[(size_t)row * 8 + h0 + j]; }
        float mean[4], var[4];
#pragma unroll
        for (int j = 0; j < 4; ++j) mean[j] = y[j];
#pragma unroll
        for (int o = 1; o < 64; o <<= 1) {
#pragma unroll
            for (int j = 0; j < 4; ++j) mean[j] += __shfl_xor(mean[j], o); }
#pragma unroll
        for (int j = 0; j < 4; ++j) { mean[j] *= (1.f / 64.f); y[j] -= mean[j]; var[j] = y[j] * y[j]; }
#pragma unroll
        for (int o = 1; o < 64; o <<= 1) {
#pragma unroll
            for (int j = 0; j < 4; ++j) var[j] += __shfl_xor(var[j], o); }
#pragma unroll
        for (int j = 0; j < 4; ++j) { const int col = (h0 + j) * 64 + lane;
            const float yn = y[j] * rsqrtf(var[j] * (1.f / 64.f) + 64e-5f) * gng[col] + gnb[col];
            const float v = v0[j] + (v1[j] - v0[j]) * mu[1024 + col];
            amix[(size_t)row * DM + 512 + col] = (bf16)f2bf((yn + bo[j] * v) * gg[j]); }
    }
}
}

namespace mema {
using nsa::f32x16; using nsa::KROW; using nsa::VROW; using nsa::KBUF; using nsa::VBUF; using nsa::OFF_K; using nsa::OFF_V; using nsa::OFF_WS; using nsa::crow; using nsa::pack8;
__device__ __forceinline__ void unit(const bf16* qm, const bf16* mk, const bf16* mvt, bf16* om, int u, unsigned char* sm) {
    const int tid = tidx(), lane = tid & 63, w = __builtin_amdgcn_readfirstlane(tid >> 6), i = lane & 31, hi = lane >> 5;
    const int b = u >> 7, h = (u >> 5) & 3, rb = u & 31;
    const int row0 = b * T_ + rb * 256 + 32 * w;
    const bf16* qrow = qm + (size_t)(row0 + i) * DM + h * 256 + 8 * hi;
    const bf16* kbase = mk + (size_t)(b * 256 + (tid >> 3)) * DM + h * 256 + (tid & 7) * 8;
    const bf16* vbase = mvt + (size_t)(h * 256 + (tid >> 3)) * 512 + b * 256 + (tid & 7) * 8;
    unsigned char* kst = sm + OFF_K + (tid >> 3) * KROW + (tid & 7) * 16;
    unsigned char* vst = sm + OFF_V + (tid >> 3) * VROW + (tid & 7) * 16;
    float* wsc = (float*)(sm + OFF_WS) + w * 32;
    f32x16 p[4][2];
#pragma unroll
    for (int kt = 0; kt < 4; ++kt)
#pragma unroll
        for (int r = 0; r < 16; ++r) { p[kt][0][r] = 0.f; p[kt][1][r] = 0.f; }
    u32x4 tr[4];
#define MEMA_SRC(n) ((n) < 16 ? (const u32x4*)(kbase + (size_t)(64 * ((n) & 3)) * DM + 64 * ((n) >> 2)) : (const u32x4*)(vbase + (size_t)(64 * (((n) - 16) >> 2)) * 512 + 64 * ((n) & 3)))
#define MEMA_PUT(n) do { if ((n) < 16) *(u32x4*)(kst + ((n) & 1) * KBUF) = tr[(n) & 3]; else { unsigned char* vp2_ = vst + ((n) & 1) * VBUF; *(u32x2*)vp2_ = (u32x2){tr[(n) & 3].x, tr[(n) & 3].y}; *(u32x2*)(vp2_ + 8) = (u32x2){tr[(n) & 3].z, tr[(n) & 3].w}; } } while (0)
    tr[0] = *MEMA_SRC(0); tr[1] = *MEMA_SRC(1); tr[2] = *MEMA_SRC(2);
    MEMA_PUT(0);
    __syncthreads();
    bf16x8 qf[4];
#pragma unroll
    for (int n = 0; n < 16; ++n) {
        const int dc = n >> 2, kt = n & 3, cb = n & 1;
        tr[(n + 3) & 3] = *MEMA_SRC(n + 3);
        if (kt == 0) {
#pragma unroll
            for (int d0 = 0; d0 < 4; ++d0) qf[d0] = *(const bf16x8*)(qrow + 64 * dc + 16 * d0);
        }
        const unsigned char* kb = sm + OFF_K + cb * KBUF;
#pragma unroll
        for (int d0 = 0; d0 < 4; ++d0) {
            const bf16x8 a0 = *(const bf16x8*)(kb + i * KROW + (16 * d0 + 8 * hi) * 2);
            const bf16x8 a1 = *(const bf16x8*)(kb + (32 + i) * KROW + (16 * d0 + 8 * hi) * 2);
            p[kt][0] = __builtin_amdgcn_mfma_f32_32x32x16_bf16(a0, qf[d0], p[kt][0], 0, 0, 0);
            p[kt][1] = __builtin_amdgcn_mfma_f32_32x32x16_bf16(a1, qf[d0], p[kt][1], 0, 0, 0);
        }
        MEMA_PUT(n + 1);
        __syncthreads();
    }
    float mx = p[0][0][0];
#pragma unroll
    for (int kt = 0; kt < 4; ++kt)
#pragma unroll
        for (int r = 0; r < 16; ++r) mx = fmaxf(mx, fmaxf(p[kt][0][r], p[kt][1][r]));
    mx = fmaxf(mx, __shfl_xor(mx, 32));
    float l = 0.f;
#pragma unroll
    for (int kt = 0; kt < 4; ++kt)
#pragma unroll
        for (int r = 0; r < 16; ++r) { p[kt][0][r] = __builtin_amdgcn_exp2f(p[kt][0][r] - mx); p[kt][1][r] = __builtin_amdgcn_exp2f(p[kt][1][r] - mx); l += p[kt][0][r] + p[kt][1][r]; }
    l += __shfl_xor(l, 32);
    bf16x8 pf[4][4];
#pragma unroll
    for (int kt = 0; kt < 4; ++kt) { pf[kt][0] = pack8(p[kt][0], 0); pf[kt][1] = pack8(p[kt][0], 8); pf[kt][2] = pack8(p[kt][1], 0); pf[kt][3] = pack8(p[kt][1], 8); }
    if (hi == 0) wsc[i] = 1.f / l;
    asm volatile("" ::: "memory");
    f32x4 il[4];
#pragma unroll
    for (int rg = 0; rg < 4; ++rg) il[rg] = *(const f32x4*)(wsc + 8 * rg + 4 * hi);
    f32x16 o[2];
#pragma unroll
    for (int n = 16; n < 32; ++n) {
        const int dvt = (n - 16) >> 2, kt = n & 3, cb = n & 1;
        if (n + 3 < 32) tr[(n + 3) & 3] = *MEMA_SRC(n + 3);
        if (kt == 0) {
#pragma unroll
            for (int r = 0; r < 16; ++r) { o[0][r] = 0.f; o[1][r] = 0.f; }
        }
        const unsigned char* vb = sm + OFF_V + cb * VBUF;
#pragma unroll
        for (int dt = 0; dt < 2; ++dt) {
            const unsigned char* vp = vb + (32 * dt + i) * VROW + 8 * hi;
#pragma unroll
            for (int ks = 0; ks < 4; ++ks) {
                const u32x2 v_lo = *(const u32x2*)(vp + 32 * ks), v_hi = *(const u32x2*)(vp + 32 * ks + 16);
                const bf16x8 vf = __builtin_bit_cast(bf16x8, (u32x4){v_lo.x, v_lo.y, v_hi.x, v_hi.y});
                o[dt] = __builtin_amdgcn_mfma_f32_32x32x16_bf16(pf[kt][ks], vf, o[dt], 0, 0, 0);
            }
        }
        if (kt == 3) {
#pragma unroll
            for (int r = 0; r < 16; ++r) { bf16* op = om + (size_t)(row0 + crow(r, hi)) * DM + h * 256 + 64 * dvt + i;
                op[0] = (bf16)f2bf(o[0][r] * il[r >> 2][r & 3]); op[32] = (bf16)f2bf(o[1][r] * il[r >> 2][r & 3]); }
        }
        if (n + 1 < 32) MEMA_PUT(n + 1);
        __syncthreads();
    }
#undef MEMA_SRC
#undef MEMA_PUT
}
}

#define LAS __attribute__((address_space(3)))
#define XB_TMO      128
#define XB_XCNT(j)  (256  + 64 * (j))
#define XB_XSUB(j)  (1280 + 64 * (j))
#define XB_XGEN(j)  (2304 + 64 * (j))
#define XB_TOP      3328
#define XB_TOPGEN   3392
#define XCD_BAR_WORDS 3456
#define XB_SPIN_CAP (1u << 18)

__device__ __forceinline__ unsigned xb_ld(unsigned* p)              { return __hip_atomic_load(p, __ATOMIC_RELAXED, __HIP_MEMORY_SCOPE_AGENT); }
__device__ __forceinline__ unsigned xb_add(unsigned* p, unsigned v) { return __hip_atomic_fetch_add(p, v, __ATOMIC_RELAXED, __HIP_MEMORY_SCOPE_AGENT); }
__device__ __forceinline__ unsigned xb_xcc_id() { return (unsigned)__builtin_amdgcn_s_getreg((3 << 11) | 20) & 0xFu; }
#define XB_SPIN(cond, bar) do { unsigned _sp = 0; while (cond) { __builtin_amdgcn_s_sleep(1); \
    if ((++_sp & 255u) == 0u) { if (xb_ld(&(bar)[XB_TMO])) break; if (_sp > XB_SPIN_CAP) { atomicAdd(&(bar)[XB_TMO], 1u); break; } } } } while (0)

struct XcdBarrier {
    unsigned* bar; unsigned x;
    volatile LAS unsigned* st;
};

__device__ __forceinline__ XcdBarrier xcd_barrier_post(unsigned* bar, volatile LAS unsigned* st) {
    XcdBarrier b; b.bar = bar; b.x = xb_xcc_id(); b.st = st;
    if (tidx() == 0) (void)xb_add(&bar[XB_XCNT(b.x)], 1u);
    return b;
}
__device__ __forceinline__ void xcd_barrier_complete(unsigned* bar, unsigned x, unsigned& nloc, unsigned& nx) {
    const unsigned G = gridDim.x * gridDim.y * gridDim.z;
    unsigned sum, cnt, mine, sp = 0u;
    for (;;) {
        sum = 0u; cnt = 0u; mine = 0u;
#pragma unroll
        for (unsigned j = 0; j < 16; ++j) { const unsigned c = xb_ld(&bar[XB_XCNT(j)]); sum += c; cnt += (c > 0u) ? 1u : 0u; mine = (j == x) ? c : mine; }
        if (sum == G) break;
        __builtin_amdgcn_s_sleep(1);
        if ((++sp & 255u) == 0u) { if (xb_ld(&bar[XB_TMO])) break; if (sp > XB_SPIN_CAP) { atomicAdd(&bar[XB_TMO], 1u); break; } }
    }
    nloc = mine > 0u ? mine : 1u; nx = cnt > 0u ? cnt : 1u;
}

__device__ __forceinline__ void xcd_barrier(const XcdBarrier& b) {
    asm volatile("s_waitcnt vmcnt(0)" ::: "memory");
    __syncthreads();
    if (tidx() == 0) {
        unsigned* bar = b.bar;
        __builtin_amdgcn_s_waitcnt(0);
        unsigned nloc = b.st[0], nx = b.st[1];
        if (nloc == 0u) { xcd_barrier_complete(bar, b.x, nloc, nx); b.st[0] = nloc; b.st[1] = nx; }
        const unsigned old = xb_add(&bar[XB_XSUB(b.x)], 1u);
        const unsigned gen = old / nloc;
        if (old + 1u == (gen + 1u) * nloc) {
            __builtin_amdgcn_fence(__ATOMIC_RELEASE, "agent");
            asm volatile("s_waitcnt vmcnt(0)" ::: "memory");
            const unsigned og = xb_add(&bar[XB_TOP], 1u);
            const unsigned tg = og / nx;
            if (og + 1u == (tg + 1u) * nx) xb_add(&bar[XB_TOPGEN], 1u);
            else XB_SPIN(xb_ld(&bar[XB_TOPGEN]) == tg, bar);
            __builtin_amdgcn_fence(__ATOMIC_ACQUIRE, "agent");
            xb_add(&bar[XB_XGEN(b.x)], 1u);
            asm volatile("s_waitcnt vmcnt(0)" ::: "memory");
        } else {
            XB_SPIN(xb_ld(&bar[XB_XGEN(b.x)]) == gen, bar);
            __builtin_amdgcn_fence(__ATOMIC_ACQUIRE, "agent");
            asm volatile("s_waitcnt vmcnt(0)" ::: "memory");
        }
    }
    __syncthreads();
}

constexpr int NTHREADS = 512, LDS_BYTES = 147456;
struct MegaArgs { const float* in[41]; float* out; unsigned char* ws; };
#define WSB(off) ((bf16*)(ws + (off)))
#define WSF(off) ((float*)(ws + (off)))

__global__ void __launch_bounds__(NTHREADS) mega_fwd(MegaArgs A) {
    extern __shared__ __attribute__((aligned(16))) unsigned char lds[];
    cg::grid_group grid = cg::this_grid();
    const float* const* in = A.in; unsigned char* ws = A.ws; float* out = A.out;
    if (tidx() < 2) ((volatile LAS unsigned*)(lds + LDS_BYTES - 64))[tidx()] = 0u;
    __syncthreads();
    const XcdBarrier xbar = xcd_barrier_post((unsigned*)(ws + WS_CTL) + 16384, (volatile LAS unsigned*)(lds + LDS_BYTES - 64));

    d_convert(WSB(WS_W1GU), NGU, DM, MapGU{in[I_F1_WG], in[I_F1_WU], FF});
    d_convert(WSB(WS_W1D), DM, FF, MapPlain{in[I_F1_WD], DM});
    d_convert(WSB(WS_WIN), NWIN, DM, MapWin{in[I_WIN], IN_COLS});
    d_convert(WSB(WS_CW1K), 256, 2048, MapPlain{in[I_W1_K], 256});
    d_convert(WSB(WS_CW1V), 256, 2048, MapPlain{in[I_W1_V], 256});
    d_convert_lora(WSB(WS_WLORA), in[I_W2], in[I_A2], in[I_G2]);
    d_convert(WSB(WS_CW2), 64, 256, MapPlain{in[I_W2_K], 64});
    d_convert(WSB(WS_CW2) + 64 * 256, 64, 256, MapPlain{in[I_W2_V], 64});
    d_rope_table(WSF(WS_ROPE));
    d_cmp_bias(in[I_PE_K], in[I_W1_K], in[I_PE_V], in[I_W1_V], WSF(WS_CBIAS), (float*)lds);
    d_rownorm(in[I_X], in[I_F1_PRE], WSB(WS_XN), M_);
    d_rownorm(in[I_MEM], in[I_MEM_KVG], WSB(WS_MEMN), 512);
    grid.sync();
    gemm_pg8(lds, WSB(WS_XN), DM, WSB(WS_W1GU), DM, M_, NGU, DM, EpiSwiGLU{WSB(WS_HB)});
    xcd_barrier(xbar);
    gemm_norm_res(lds, WSB(WS_HB), FF, WSB(WS_W1D), FF, in[I_X], out, WSB(WS_XN), in[I_F1_POST], in[I_MIX_PRE], 0.5f, WSB(WS_YB), (unsigned*)(ws + WS_GATES), (unsigned*)(ws + WS_CTL) + 1024 + 0 * 2048);
    xcd_barrier(xbar);
    gemm_pg8(lds, WSB(WS_XN), DM, WSB(WS_WIN), DM, M_, 3072, DM,
             EpiWin{WSB(WS_QB), WSB(WS_KS), WSB(WS_KW), WSB(WS_KCR), WSB(WS_VCR), WSB(WS_VST), WSB(WS_VWT), (unsigned*)(ws + WS_RKVA), WSB(WS_RKVA + 32 * MiB), WSB(WS_PRL), WSF(WS_GATES), WSF(WS_ROPE)});
    d_gates(WSB(WS_XN), WSB(WS_WIN) + (size_t)3072 * DM, WSF(WS_GATES));
    xcd_barrier(xbar);
    gemm_pg8(lds, WSB(WS_KCR), 1024, WSB(WS_CW1K), 2048, 2048, 256, 2048, EpiBiasSilu{WSB(WS_HIDK), WSF(WS_CBIAS)});
    gemm_pg8(lds, WSB(WS_VCR), 1024, WSB(WS_CW1V), 2048, 2048, 256, 2048, EpiBiasSilu{WSB(WS_HIDV), WSF(WS_CBIAS) + 256}, 8);
    d_lora_prep(WSB(WS_PRL), in[I_MU], WSB(WS_XN), 16);
    d_convert(WSB(WS_W2GU), NGU, DM, MapGU{in[I_F2_WG], in[I_F2_WU], FF}, 16);
    d_convert(WSB(WS_W2D), DM, FF, MapPlain{in[I_F2_WD], DM}, 16);
    d_convert(WSB(WS_WOUT), DM, DM, MapPlain{in[I_WOUT], DM}, 16);
    d_convert(WSB(WS_WQ), DM, DM, MapPlain{in[I_WQ], DM}, 16);
    d_convert(WSB(WS_WK), DM, DM, MapPlain{in[I_WK], DM}, 16);
    d_convert(WSB(WS_WV), DM, DM, MapPlain{in[I_WV], DM}, 16);
    d_convert(WSB(WS_WO), DM, DM, MapPlain{in[I_WO], DM}, 16);
    xcd_barrier(xbar);
    d_cmp2(WSB(WS_HIDK), WSB(WS_HIDV), WSB(WS_CW2), WSF(WS_ROPE), WSB(WS_KC), WSB(WS_VCT));
    gemm_pg8(lds, WSB(WS_XN), KLORA, WSB(WS_WLORA), KLORA, M_, NLORA, KLORA, EpiLora{WSF(WS_YB), WSB(WS_RKVA + 48 * MiB), WSB(WS_AGG), in[I_W0], in[I_A0]});
    gemm_pg8(lds, WSB(WS_MEMN), DM, WSB(WS_WK), DM, 512, DM, DM, EpiStore{WSB(WS_CW1K), DM, 1.f});
    gemm_pg8(lds, WSB(WS_WV), DM, WSB(WS_MEMN), DM, DM, 512, DM, EpiStore{WSB(WS_CW1V), 512, 1.f}, 8);
    xcd_barrier(xbar);
    if (blockIdx.x < 16 * (1 + rw7::NHELP)) {
        const rw7::Args ra{(const unsigned*)(ws + WS_RKVA), WSB(WS_RKVA + 32 * MiB), WSB(WS_RKVA + 48 * MiB), WSF(WS_YB), in[I_MU], in[I_KK], in[I_KA], in[I_RK], WSF(WS_YB), WSF(WS_BONUS),
                           ws + WS_KCR + 1 * MiB, (unsigned*)(ws + WS_CTL) + 32768, (unsigned*)(ws + WS_CTL) + 24576};
        if (blockIdx.x < 16) rw7::head(ra, blockIdx.x, lds);
        else rw7::helper(ra, (blockIdx.x - 16) % 16, (blockIdx.x - 16) / 16, lds);
        __syncthreads();
    }
    {
        const NsaArgs na{WSB(WS_QB), WSB(WS_KC), WSB(WS_VCT), WSB(WS_KS), WSB(WS_VST), WSB(WS_KW), WSB(WS_VWT), WSF(WS_GATES), WSB(WS_XN)};
        nsa::phase(na, (unsigned*)(ws + WS_CTL), lds);
    }
    xcd_barrier(xbar);
    d_nsa_outnorm(WSB(WS_XN), in[I_NSA_G]);
    rw7::finish(WSF(WS_YB), WSF(WS_BONUS), WSB(WS_RKVA + 32 * MiB), WSB(WS_AGG), in[I_MU], in[I_GNG], in[I_GNB], WSB(WS_XN));
    xcd_barrier(xbar);
    gemm_norm_res(lds, WSB(WS_XN), DM, WSB(WS_WOUT), DM, out, out, WSB(WS_XN), in[I_MIX_POST], in[I_MEM_PRE], 1.0f, WSB(WS_YB), (unsigned*)(ws + WS_GATES), (unsigned*)(ws + WS_CTL) + 1024 + 1 * 2048);
    xcd_barrier(xbar);
    gemm_pg8(lds, WSB(WS_XN), DM, WSB(WS_WQ), DM, M_, DM, DM, EpiStore{WSB(WS_QM), DM, MSCALE});
    xcd_barrier(xbar);
    for (int u = blockIdx.x; u < 256; u += gridDim.x) mema::unit(WSB(WS_QM), WSB(WS_CW1K), WSB(WS_CW1V), WSB(WS_OM), u, lds);
    xcd_barrier(xbar);
    gemm_norm_res(lds, WSB(WS_OM), DM, WSB(WS_WO), DM, out, out, WSB(WS_XN), in[I_MEM_POST], in[I_F2_PRE], 1.0f, WSB(WS_YB), (unsigned*)(ws + WS_GATES), (unsigned*)(ws + WS_CTL) + 1024 + 2 * 2048);
    xcd_barrier(xbar);
    gemm_pg8(lds, WSB(WS_XN), DM, WSB(WS_W2GU), DM, M_, NGU, DM, EpiSwiGLU{WSB(WS_HB)});
    xcd_barrier(xbar);
    gemm_norm_res(lds, WSB(WS_HB), FF, WSB(WS_W2D), FF, out, out, (bf16*)nullptr, in[I_F2_POST], (const float*)nullptr, 0.5f, WSB(WS_YB), (unsigned*)(ws + WS_GATES), (unsigned*)(ws + WS_CTL) + 1024 + 3 * 2048);
}

extern "C" void kernel_launch(void* const* d_in, const int* in_sizes, int n_in, void* d_out, int out_size, void* d_ws, size_t ws_size, hipStream_t stream) {
    static int grid = 0;
    if (grid == 0) {
        if (n_in != 41 || ws_size < WS_END) { fprintf(stderr, "kernel_launch: unexpected n_in %d / ws %zu\n", n_in, ws_size); grid = -1; return; }
        int dev = 0, cus = 0, per_cu = 0;
        hipGetDevice(&dev); hipDeviceGetAttribute(&cus, hipDeviceAttributeMultiprocessorCount, dev);
        if (hipFuncSetAttribute((const void*)mega_fwd, hipFuncAttributeMaxDynamicSharedMemorySize, LDS_BYTES) != hipSuccess) { fprintf(stderr, "kernel_launch: hipFuncSetAttribute failed\n"); grid = -1; return; }
        if (hipOccupancyMaxActiveBlocksPerMultiprocessor(&per_cu, (const void*)mega_fwd, NTHREADS, LDS_BYTES) != hipSuccess || per_cu < 1) { fprintf(stderr, "kernel_launch: occupancy query says %d\n", per_cu); grid = -1; (void)hipGetLastError(); return; }
        grid = cus;
        if (grid != 256) { fprintf(stderr, "kernel_launch: built for 256 CUs (one 256x256 tile per workgroup in the fused norm epilogues), found %d\n", cus); grid = -1; return; }
    }
    if (grid < 0) return;
    MegaArgs a{};
    for (int i = 0; i < 41; ++i) a.in[i] = (const float*)d_in[i];
    a.out = (float*)d_out; a.ws = (unsigned char*)d_ws;
    hipMemsetAsync(d_ws, 0, 196608, stream);
    void* args[] = {&a};
    hipError_t e = hipLaunchCooperativeKernel((const void*)mega_fwd, dim3(grid), dim3(NTHREADS), args, LDS_BYTES, stream);
    if (e != hipSuccess) fprintf(stderr, "kernel_launch: cooperative launch failed: %s (grid %d)\n", hipGetErrorString(e), grid);
}
```

```cpp
#include <hip/hip_runtime.h>
#include <hip/hip_cooperative_groups.h>
#include <cstdint>
#include <cstdio>

constexpr int NB = 2, T_ = 8192, DM = 1024, M_ = NB * T_;
constexpr int FF = 2816, NGU = 2 * FF;
constexpr int IN_COLS = 3096, NWIN = 3328;
constexpr int NRW = 1792;
constexpr int NCP = 512;
constexpr int NLORA = 1536, KLORA = 256;
constexpr float NORM_EPS = 1e-6f;
constexpr float QSCALE = 0.125f * 1.4426950408889634f;
constexpr float MSCALE = 0.0625f * 1.4426950408889634f;

typedef unsigned short bf16;
typedef short bf16x8 __attribute__((ext_vector_type(8)));
typedef float f32x4 __attribute__((ext_vector_type(4)));
typedef unsigned u32x2 __attribute__((ext_vector_type(2)));
typedef unsigned u32x4 __attribute__((ext_vector_type(4)));

__device__ __forceinline__ unsigned f2bf(float f) { unsigned u = __builtin_bit_cast(unsigned, f); return (u + 0x7fffu + ((u >> 16) & 1u)) >> 16; }
__device__ __forceinline__ float bf2f(bf16 h) { return __builtin_bit_cast(float, (unsigned)h << 16); }
typedef float f32x2_t __attribute__((ext_vector_type(2))); typedef __bf16 bf16x2_t __attribute__((ext_vector_type(2)));
__device__ __forceinline__ unsigned pk2(float lo, float hi) { const f32x2_t v = {lo, hi}; return __builtin_bit_cast(unsigned, __builtin_convertvector(v, bf16x2_t)); }
__device__ __forceinline__ void st_bf4(bf16* p, f32x4 v) { u32x2 w; w.x = pk2(v[0], v[1]); w.y = pk2(v[2], v[3]); *(u32x2*)p = w; }
__device__ __forceinline__ float wave_sum(float v) {
#pragma unroll
    for (int o = 1; o < 64; o <<= 1) v += __shfl_xor(v, o);
    return v;
}
__device__ __forceinline__ float wave_max(float v) {
#pragma unroll
    for (int o = 1; o < 64; o <<= 1) v = fmaxf(v, __shfl_xor(v, o));
    return v;
}
__device__ __forceinline__ float sigmoidf_(float x) { return 1.f / (1.f + __expf(-x)); }
__device__ __forceinline__ int tidx() { int t = threadIdx.x; asm volatile("" : "+v"(t)); return t; }

constexpr size_t MiB = 1u << 20, KiB64 = 65536;
constexpr size_t WS_CTL = 0;
constexpr size_t WS_KC = 256 * 1024;
constexpr size_t WS_VCT = 512 * 1024;
constexpr size_t WS_CW2 = 768 * 1024;
constexpr size_t WS_W1GU = 1 * MiB;
constexpr size_t WS_W1D = 12 * MiB;
constexpr size_t WS_W2GU = WS_W1D + 88 * KiB64;
constexpr size_t WS_W2D = WS_W2GU + 11 * MiB;
constexpr size_t WS_WIN = WS_W2D + 88 * KiB64;
constexpr size_t WS_WOUT = WS_WIN + 104 * KiB64;
constexpr size_t WS_WQ = WS_WOUT + 2 * MiB, WS_WK = WS_WQ + 2 * MiB, WS_WV = WS_WK + 2 * MiB, WS_WO = WS_WV + 2 * MiB;
constexpr size_t WS_CW1K = WS_WO + 2 * MiB, WS_CW1V = WS_CW1K + 1 * MiB;
constexpr size_t WS_WLORA = WS_CW1V + 1 * MiB;
constexpr size_t WS_ROPE = WS_WLORA + 12 * KiB64;
constexpr size_t WS_CBIAS = WS_ROPE + 2 * MiB;
constexpr size_t WS_MEMN = WS_CBIAS + KiB64;
constexpr size_t WS_HIDK = WS_MEMN + 1 * MiB;
constexpr size_t WS_HIDV = WS_HIDK + 1 * MiB;
constexpr size_t WS_GATES = WS_HIDV + 1 * MiB;
constexpr size_t WS_XN = 60 * MiB;
constexpr size_t WS_YB = 92 * MiB;
constexpr size_t WS_D = 124 * MiB;
constexpr size_t WS_HB = WS_D;
constexpr size_t WS_QB = WS_D;
constexpr size_t WS_KS = WS_D + 16 * MiB;
constexpr size_t WS_KW = WS_D + 20 * MiB;
constexpr size_t WS_KCR = WS_D + 24 * MiB;
constexpr size_t WS_VCR = WS_D + 29 * MiB;
constexpr size_t WS_VST = WS_D + 34 * MiB;
constexpr size_t WS_VWT = WS_D + 38 * MiB;
constexpr size_t WS_RKVA = WS_D + 42 * MiB;
constexpr size_t WS_PRL = WS_D + 106 * MiB;
constexpr size_t WS_AGG = WS_D + 114 * MiB;
constexpr size_t WS_BONUS = WS_KCR;
constexpr size_t WS_END = 256 * MiB;
constexpr size_t WS_QM = WS_D;
constexpr size_t WS_OM = WS_D + 32 * MiB;
constexpr size_t WS_MK = WS_D + 64 * MiB;
constexpr size_t WS_MVT = WS_D + 65 * MiB;
static_assert(WS_GATES + (size_t)M_ * 24 * 4 <= WS_XN, "ws map");
static_assert(WS_AGG + 16 * MiB <= WS_END, "ws map");

struct Params {
    const float* in[41];
    float* out;
    unsigned char* ws;
};
enum { I_X = 0, I_MEM, I_F1_PRE, I_F1_WG, I_F1_WU, I_F1_WD, I_F1_POST, I_MIX_PRE, I_WIN, I_PE_K, I_W1_K, I_W2_K, I_PE_V, I_W1_V, I_W2_V,
       I_NSA_G, I_MU, I_W0, I_W2, I_A0, I_A2, I_G2, I_KK, I_KA, I_RK, I_GNG, I_GNB, I_WOUT, I_MIX_POST, I_MEM_PRE, I_MEM_KVG, I_WQ, I_WK, I_WV,
       I_WO, I_MEM_POST, I_F2_PRE, I_F2_WG, I_F2_WU, I_F2_WD, I_F2_POST };

struct MapPlain { const float* W; int N; int pad; __device__ const float* col(int p) const { return W + p; } };
struct MapGU {
    const float* Wg; const float* Wu; int N; int pad;
    __device__ const float* col(int p) const {
        const int pn = p >> 8, q = p & 255, n = (q >> 4) & 1;
        const int hid = 128 * pn + 64 * (q >> 7) + 16 * ((q >> 5) & 3) + (q & 15);
        return Wg + (size_t)n * (size_t)(Wu - Wg) + hid;
    }
};
__host__ __device__ inline int rope_perm(int x) { return 16 * ((x >> 5) & 1) + (x & 15) + 32 * ((x >> 4) & 1); }
struct MapWin {
    const float* W; int N; int pad;
    __device__ const float* col(int p) const {
        int l;
        if (p < 512) l = (p & ~63) + rope_perm(p & 63);
        else if (p < 640) l = 768 + ((p - 512) & ~63) + rope_perm(p & 63);
        else if (p < 768) l = 1024 + ((p - 640) & ~63) + rope_perm(p & 63);
        else if (p < 896) l = 512 + (p - 768);
        else if (p < 1024) l = 640 + (p - 896);
        else if (p < 1152) l = 896 + (p - 1024);
        else if (p < 1280) l = 1152 + (p - 1152);
        else if (p < 2304) { const int q = p - 1280; l = 1304 + (((q >> 4) & 1) ? 512 : 0) + 16 * (q >> 5) + (q & 15); }
        else if (p < 3072) l = 1304 + (p - 1280);
        else if (p < 3096) l = 1280 + (p - 3072);
        else return nullptr;
        return W + l;
    }
};

#define FOR_VB(vb, n) for (int vb = (int)blockIdx.x * 2 + (T512 >> 8); vb < (n); vb += (int)gridDim.x * 2)

template <class Map> __device__ __forceinline__ void d_convert(bf16* WT, int Np, int K, Map map, int wg0 = 0) {
    if ((int)blockIdx.x < wg0) return;
    const int T512 = tidx(), tid = T512 & 255, nbx = Np / 64, nb = nbx * (K / 64), G = (int)gridDim.x - wg0;
    for (int vb0 = ((int)blockIdx.x - wg0) * 2 + (T512 >> 8); vb0 < nb; vb0 += G * 4) {
        const int vb1 = vb0 + G * 2; const bool two = vb1 < nb;
        const int p0 = (vb0 % nbx) * 64 + (tid & 63), k0 = (vb0 / nbx) * 64 + (tid >> 6) * 16;
        const int p1 = two ? (vb1 % nbx) * 64 + (tid & 63) : p0, k1 = two ? (vb1 / nbx) * 64 + (tid >> 6) * 16 : k0;
        const float* s0 = map.col(p0); const float* s1 = map.col(p1);
        float v[16], u[16];
#pragma unroll
        for (int i = 0; i < 16; ++i) { v[i] = s0 ? s0[(size_t)(k0 + i) * map.N] : 0.f; u[i] = s1 ? s1[(size_t)(k1 + i) * map.N] : 0.f; }
        u32x4 a, b;
        a.x = pk2(v[0], v[1]); a.y = pk2(v[2], v[3]); a.z = pk2(v[4], v[5]); a.w = pk2(v[6], v[7]);
        b.x = pk2(v[8], v[9]); b.y = pk2(v[10], v[11]); b.z = pk2(v[12], v[13]); b.w = pk2(v[14], v[15]);
        u32x4* d0 = (u32x4*)(WT + (size_t)p0 * K + k0); d0[0] = a; d0[1] = b;
        if (two) {
            a.x = pk2(u[0], u[1]); a.y = pk2(u[2], u[3]); a.z = pk2(u[4], u[5]); a.w = pk2(u[6], u[7]);
            b.x = pk2(u[8], u[9]); b.y = pk2(u[10], u[11]); b.z = pk2(u[12], u[13]); b.w = pk2(u[14], u[15]);
            u32x4* d1 = (u32x4*)(WT + (size_t)p1 * K + k1); d1[0] = a; d1[1] = b;
        }
    }
}
__device__ __forceinline__ void d_convert_lora(bf16* WT, const float* w2, const float* a2, const float* g2) {
    const int T512 = tidx(), tid = T512 & 255;
    FOR_VB(vb, NLORA * KLORA / 256) {
        const int idx = vb * 256 + tid, p = idx >> 8, k = idx & 255;
        float v = 0.f;
        if (p < 512) { if (k < 64) v = w2[k * 512 + p]; }
        else if (p < 1024) { if (k >= 64 && k < 128) v = a2[(k - 64) * 512 + (p - 512)]; }
        else { if (k >= 128) v = g2[(k - 128) * 512 + (p - 1024)]; }
        WT[idx] = (bf16)f2bf(v);
    }
}
__device__ __forceinline__ void d_rope_table(float* tab) {
    const int T512 = tidx(), tid = T512 & 255;
    FOR_VB(vb, T_ * 32 / 256) {
        const int idx = vb * 256 + tid, pos = idx >> 5, i = idx & 31;
        const float inv = (float)pow(10000.0, -(double)i / 32.0);
        const float ang = (float)pos * inv;
        tab[2 * idx] = (float)cos((double)ang); tab[2 * idx + 1] = (float)sin((double)ang);
    }
}
__device__ __forceinline__ void d_cmp_bias(const float* pe_k, const float* w1_k, const float* pe_v, const float* w1_v, float* part, float* red  ) {
    for (int job = blockIdx.x; job < 64; job += gridDim.x) {
        const int kv = job >> 5, cg_ = (job >> 3) & 3, jc = job & 7; const float* pe = kv ? pe_v : pe_k; const float* w1 = kv ? w1_v : w1_k;
        const int T512 = tidx(), lane = T512 & 63, w = T512 >> 6, n = cg_ * 64 + lane;
        float s = 0.f;
#pragma unroll 8
        for (int j = jc * 256 + w * 32; j < jc * 256 + w * 32 + 32; ++j) s += pe[j] * w1[(size_t)j * 256 + n];
        red[w * 64 + lane] = s; __syncthreads();
        if (w == 0) { float t = 0.f; for (int i = 0; i < 8; ++i) t += red[i * 64 + lane]; part[(jc * 2 + kv) * 256 + n] = t; }
        __syncthreads();
    }
}
__device__ __forceinline__ void d_rownorm(const float* x, const float* g, bf16* xn, int rows) {
    const int T512 = tidx(), tid = T512 & 255, lane = tid & 63;
    FOR_VB(vb, rows / 4) {
        const int row = vb * 4 + (tid >> 6);
        const f32x4* xr = (const f32x4*)(x + (size_t)row * DM) + lane; f32x4 v[4]; float s = 0.f;
#pragma unroll
        for (int j = 0; j < 4; ++j) { v[j] = xr[64 * j]; s += v[j][0] * v[j][0] + v[j][1] * v[j][1] + v[j][2] * v[j][2] + v[j][3] * v[j][3]; }
        const float rstd = rsqrtf(wave_sum(s) * (1.f / DM) + NORM_EPS);
#pragma unroll
        for (int j = 0; j < 4; ++j) { const f32x4 gg = ((const f32x4*)g)[lane + 64 * j]; st_bf4(xn + (size_t)row * DM + 4 * (lane + 64 * j), v[j] * rstd * gg); }
    }
}
__device__ __forceinline__ void d_rowpass(const float* xin, const bf16* y, const float* gpost, float coef, const float* gpre, float* xout, bf16* xn) {
    const int T512 = tidx(), tid = T512 & 255, lane = tid & 63;
    FOR_VB(vb, M_ / 4) {
        const int row = vb * 4 + (tid >> 6);
        f32x4 yv[4], xv[4]; float s = 0.f;
#pragma unroll
        for (int j = 0; j < 4; ++j) {
            const u32x2 w = *(const u32x2*)(y + (size_t)row * DM + 4 * (lane + 64 * j));
            yv[j][0] = __builtin_bit_cast(float, w.x << 16); yv[j][1] = __builtin_bit_cast(float, w.x & 0xffff0000u);
            yv[j][2] = __builtin_bit_cast(float, w.y << 16); yv[j][3] = __builtin_bit_cast(float, w.y & 0xffff0000u);
            s += yv[j][0] * yv[j][0] + yv[j][1] * yv[j][1] + yv[j][2] * yv[j][2] + yv[j][3] * yv[j][3];
            xv[j] = ((const f32x4*)(xin + (size_t)row * DM))[lane + 64 * j];
        }
        const float rstd = rsqrtf(wave_sum(s) * (1.f / DM) + NORM_EPS) * coef; float s2 = 0.f;
#pragma unroll
        for (int j = 0; j < 4; ++j) { const f32x4 gg = ((const f32x4*)gpost)[lane + 64 * j]; xv[j] = xv[j] + yv[j] * rstd * gg;
            s2 += xv[j][0] * xv[j][0] + xv[j][1] * xv[j][1] + xv[j][2] * xv[j][2] + xv[j][3] * xv[j][3];
            ((f32x4*)(xout + (size_t)row * DM))[lane + 64 * j] = xv[j]; }
        if (gpre) {
            const float r2 = rsqrtf(wave_sum(s2) * (1.f / DM) + NORM_EPS);
#pragma unroll
            for (int j = 0; j < 4; ++j) { const f32x4 gg = ((const f32x4*)gpre)[lane + 64 * j]; st_bf4(xn + (size_t)row * DM + 4 * (lane + 64 * j), xv[j] * r2 * gg); }
        }
    }
}
__device__ __forceinline__ void d_nsa_outnorm(bf16* amix, const float* g) {
    const int T512 = tidx(), tid = T512 & 255, lane = tid & 63;
    FOR_VB(vb, M_ / 4) {
        const int row = vb * 4 + (tid >> 6);
        bf16* p = amix + (size_t)row * DM + 8 * lane;
        const u32x4 w = *(const u32x4*)p; float v[8]; float s = 0.f;
        v[0] = __builtin_bit_cast(float, w.x << 16); v[1] = __builtin_bit_cast(float, w.x & 0xffff0000u);
        v[2] = __builtin_bit_cast(float, w.y << 16); v[3] = __builtin_bit_cast(float, w.y & 0xffff0000u);
        v[4] = __builtin_bit_cast(float, w.z << 16); v[5] = __builtin_bit_cast(float, w.z & 0xffff0000u);
        v[6] = __builtin_bit_cast(float, w.w << 16); v[7] = __builtin_bit_cast(float, w.w & 0xffff0000u);
#pragma unroll
        for (int i = 0; i < 8; ++i) s += v[i] * v[i];
        const float rstd = rsqrtf(wave_sum(s) * (1.f / 512.f) + NORM_EPS);
        u32x4 o; const float* gg = g + 8 * lane;
        o.x = pk2(v[0] * rstd * gg[0], v[1] * rstd * gg[1]); o.y = pk2(v[2] * rstd * gg[2], v[3] * rstd * gg[3]);
        o.z = pk2(v[4] * rstd * gg[4], v[5] * rstd * gg[5]); o.w = pk2(v[6] * rstd * gg[6], v[7] * rstd * gg[7]);
        *(u32x4*)p = o;
    }
}

struct EpiStore { bf16* O; int ldc; float scale;
    static constexpr int NCAT = 1;
    __device__ __forceinline__ int cat(int) const { return 0; }
    template <int C> __device__ __forceinline__ void apply(int row, int p, f32x4 v0, f32x4 v1) const { bf16* o = O + (size_t)row * ldc + p; st_bf4(o, v0 * scale); st_bf4(o + 16, v1 * scale); } };
struct EpiSwiGLU { bf16* H;
    static constexpr int NCAT = 1;
    __device__ __forceinline__ int cat(int) const { return 0; }
    template <int C> __device__ __forceinline__ void apply(int row, int p, f32x4 g, f32x4 u) const {
        const int q = p & 255, hid = 128 * (p >> 8) + 64 * (q >> 7) + 16 * ((q >> 5) & 3) + (q & 15);
        f32x4 h;
#pragma unroll
        for (int e = 0; e < 4; ++e) h[e] = g[e] / (1.f + __expf(-g[e])) * u[e];
        st_bf4(H + (size_t)row * FF + hid, h); } };
struct EpiBiasSilu { bf16* O; const float* bias;
    static constexpr int NCAT = 1;
    __device__ __forceinline__ int cat(int) const { return 0; }
    template <int C> __device__ __forceinline__ void apply(int row, int p, f32x4 v0, f32x4 v1) const {
        f32x4 a, b; f32x4 b0 = {0.f, 0.f, 0.f, 0.f}, b1 = {0.f, 0.f, 0.f, 0.f};
#pragma unroll
        for (int jc = 0; jc < 8; ++jc) { b0 += *(const f32x4*)(bias + jc * 512 + p); b1 += *(const f32x4*)(bias + jc * 512 + p + 16); }
#pragma unroll
        for (int e = 0; e < 4; ++e) { const float x0 = v0[e] + b0[e], x1 = v1[e] + b1[e]; a[e] = x0 / (1.f + __expf(-x0)); b[e] = x1 / (1.f + __expf(-x1)); }
        bf16* o = O + (size_t)row * 256 + p; st_bf4(o, a); st_bf4(o + 16, b); } };
struct EpiLora { float* wdec; bf16* aga; bf16* agg; const float* w0; const float* a0;
    static constexpr int NCAT = 3;
    __device__ __forceinline__ int cat(int p0) const { return p0 < 512 ? 0 : (p0 < 1024 ? 1 : 2); }
    template <int C> __device__ __forceinline__ void one(int row, int p, f32x4 v) const {
        if (C == 0) { f32x4 o; const f32x4 ww = *(const f32x4*)(w0 + p);
#pragma unroll
            for (int e = 0; e < 4; ++e) o[e] = __expf(-0.6065306597126334f * sigmoidf_(ww[e] + v[e]));
            *(f32x4*)(wdec + (size_t)row * 512 + p) = o;
        } else if (C == 1) { f32x4 o; const f32x4 aa = *(const f32x4*)(a0 + p - 512);
#pragma unroll
            for (int e = 0; e < 4; ++e) o[e] = sigmoidf_(aa[e] + v[e]);
            st_bf4(aga + (size_t)row * 512 + (p - 512), o);
        } else st_bf4(agg + (size_t)row * 512 + (p - 1024), v);
    }
    template <int C> __device__ __forceinline__ void apply(int row, int p, f32x4 v0, f32x4 v1) const { one<C>(row, p, v0); one<C>(row, p + 16, v1); } };
struct EpiWin {
    bf16 *qb, *ks, *kw, *kcr, *vcr, *vst, *vwt; unsigned* rk; bf16 *vv, *prl; float* gates; const float* rope;
    static constexpr int NCAT = 8;
    __device__ __forceinline__ int cat(int p0) const { return p0 < 512 ? 0 : (p0 < 768 ? 1 : (p0 < 1024 ? 2 : (p0 < 1280 ? 3 : (p0 < 2304 ? 4 : (p0 < 2816 ? 7 : (p0 < 3072 ? 6 : 5)))))); }
    template <int C> __device__ __forceinline__ void apply(int row, int p, f32x4 v0, f32x4 v1) const {
        const int b = row / T_, t = row % T_;
        if (C == 0 || C == 1) {
            const int x = p & 63, d = 16 * ((x >> 5) & 1) + (x & 15);
            const f32x4* rp = (const f32x4*)(rope + ((size_t)t * 32 + d) * 2); const f32x4 r0 = rp[0], r1 = rp[1];
            const f32x4 cs = {r0[0], r0[2], r1[0], r1[2]}, sn = {r0[1], r0[3], r1[1], r1[3]};
            const f32x4 lo = v0 * cs - v1 * sn, hi = v0 * sn + v1 * cs;
            if (C == 0) { bf16* o = qb + (size_t)row * 512 + (p & ~63) + d; st_bf4(o, lo * QSCALE); st_bf4(o + 32, hi * QSCALE); }
            else { const int g = ((p - 512) >> 6) & 1; bf16* base = (p < 640) ? ks : kw; bf16* o = base + ((size_t)(b * 2 + g) * T_ + t) * 64 + d; st_bf4(o, lo); st_bf4(o + 32, hi); }
        } else if (C == 2) {
            const int c = (p - 768) & 127, g = c >> 6, d = c & 63; bf16* base = (p < 896) ? kcr : vcr;
            bf16* o = base + ((size_t)(b * 2 + g) * T_ + t) * 64 + d; st_bf4(o, v0); st_bf4(o + 16, v1);
        } else if (C == 3) {
            const int c = (p - 1024) & 127, g = c >> 6, d = c & 63; bf16* base = (p < 1152) ? vst : vwt;
            bf16* o = base + ((size_t)(b * 2 + g) * 64 + d) * T_ + t;
#pragma unroll
            for (int e = 0; e < 4; ++e) { o[(size_t)e * T_] = (bf16)f2bf(v0[e]); o[(size_t)(16 + e) * T_] = (bf16)f2bf(v1[e]); }
        } else if (C == 4) {
            const int q = p - 1280, ch = 16 * (q >> 5) + (q & 15);
            u32x4 w; w.x = pk2(v0[0], v1[0]); w.y = pk2(v0[1], v1[1]); w.z = pk2(v0[2], v1[2]); w.w = pk2(v0[3], v1[3]);
            *(u32x4*)(rk + (size_t)row * 512 + ch) = w;
        } else if (C == 7) {
            bf16* o = vv + (size_t)row * 512 + (p - 2304); st_bf4(o, v0); st_bf4(o + 16, v1);
        } else if (C == 6) {
            bf16* o = prl + (size_t)row * 256 + (p - 2816); st_bf4(o, v0); st_bf4(o + 16, v1);
        } else {
            const int c = p - 3072; float* o = gates + (size_t)row * 24 + c;
            if (c < 24) { f32x4 s = {sigmoidf_(v0[0]), sigmoidf_(v0[1]), sigmoidf_(v0[2]), sigmoidf_(v0[3])}; *(f32x4*)o = s; }
            if (c + 16 < 24) { f32x4 s = {sigmoidf_(v1[0]), sigmoidf_(v1[1]), sigmoidf_(v1[2]), sigmoidf_(v1[3])}; *(f32x4*)(o + 16) = s; }
        }
    }
};

namespace pg8 {
#define PG8_LAS __attribute__((address_space(3)))
typedef unsigned short bf16_t;
typedef short bf16x8 __attribute__((ext_vector_type(8)));
typedef float f32x4 __attribute__((ext_vector_type(4)));
typedef unsigned u32x4 __attribute__((ext_vector_type(4)));
constexpr int BM = 256, BK = 64, HALF = 128, HTB = HALF * BK * 2  , STAGE_BYTES = 8 * HTB, NXCD = 8, WGM = 8;

__host__ __device__ __forceinline__ int lds_byte(int r, int c) { const int st = (r >> 4) * 2 + (c >> 5), rr = r & 15, cc = c & 31, ob = rr * 64 + cc * 2; return st * 1024 + (ob ^ (((ob >> 9) & 1) << 5)); }
__host__ __device__ __forceinline__ void stage_rc(int b, int& R, int& C) { const int st = b / 1024, sb = b % 1024, swz = sb ^ (((sb >> 9) & 1) << 5); R = (st >> 1) * 16 + swz / 64; C = (st & 1) * 32 + (swz % 64) / 2; }
__host__ __device__ __forceinline__ int perm32(int rho) { const int n = rho >> 4, i = rho & 15; return 8 * (i >> 2) + 4 * n + (i & 3); }

struct Unit { int pm, pn; };
struct Gemm { const bf16_t* A; const bf16_t* Bt; int M, N, K, lda, ldb; };

struct StaticOrder {
    int nM, nN, nwg, G, c;
    __host__ __device__ void init(int M, int N, int G_, int c_) { nM = M / BM; nN = N / BM; nwg = nM * nN; G = G_; c = c_; }
    __host__ __device__ bool next(int i, Unit& u) const {
        const long L = (long)i * G + c; if (L >= nwg) return false;
        int wgid = (int)L; { const int q = nwg / NXCD, r = nwg % NXCD, xcd = wgid % NXCD, off = wgid / NXCD; wgid = (xcd < r ? xcd * (q + 1) : r * (q + 1) + (xcd - r) * q) + off; }
        const int nig = WGM * nN, gid = wgid / nig, fm = gid * WGM, gsz = (nM - fm) < WGM ? (nM - fm) : WGM;
        u.pm = fm + ((wgid % nig) % gsz); u.pn = (wgid % nig) / gsz; return true;
    }
    __device__ __forceinline__ void a_ready(const Unit&) const {}
    __device__ __forceinline__ void done(const Unit&) const {}
};

template <class Epi, class Sched, bool ALIGN_EPI = false, bool SP2 = false>
__device__ __forceinline__ void gemm_phase(PG8_LAS unsigned char* lds, const Gemm g, const Sched& S, const Epi& E) {
    const int tid = tidx(), wid = __builtin_amdgcn_readfirstlane(tid >> 6), lane = tid & 63, wr = wid >> 2, wc = wid & 3, fr = lane & 15, fq = lane >> 4;
    const int K = g.K, nt = K / BK;
    unsigned voffA[2], voffB[2];
#pragma unroll
    for (int i = 0; i < 2; ++i) { int R, C; stage_rc(tid * 16 + i * 8192, R, C); const int Rb = Epi::PERM ? ((R & ~31) + perm32(R & 31)) : R;
        voffA[i] = (unsigned)(R * g.lda + C) * 2u; voffB[i] = (unsigned)(Rb * g.ldb + C) * 2u; }
    const size_t kstep = (size_t)(BK * 2);
    const size_t hstepA = (size_t)HALF * g.lda * 2, hstepB = (size_t)HALF * g.ldb * 2;
    const size_t tstepA = 2 * hstepA, tstepB = 2 * hstepB;
    const unsigned ldsw = (unsigned)wid * 1024u;
    const int aoff = lds_byte(wr * 64 + fr, fq * 8), boff = lds_byte(wc * 32 + fr, fq * 8);
#define PG8_SA(b, h) (((b) * 2 + (h)) * HTB)
#define PG8_SB(b, h) ((4 + (b) * 2 + (h)) * HTB)
#define PG8_STAGE(bufoff, gbase, voff) do { _Pragma("unroll") for (int _i = 0; _i < 2; ++_i) \
        __builtin_amdgcn_global_load_lds((const unsigned*)((const char*)(gbase) + (voff)[_i]), (PG8_LAS unsigned*)(lds + (bufoff) + ldsw + _i * 8192), 16, 0, 0); } while (0)
#define PG8_LDA(dst, b, h) do { _Pragma("unroll") for (int m = 0; m < 4; ++m) _Pragma("unroll") for (int k = 0; k < 2; ++k) dst[m][k] = *(const PG8_LAS bf16x8*)(lds + PG8_SA(b, h) + aoff + m * 2048 + k * 1024); } while (0)
#define PG8_LDB(dst, b, h) do { _Pragma("unroll") for (int n = 0; n < 2; ++n) _Pragma("unroll") for (int k = 0; k < 2; ++k) dst[n][k] = *(const PG8_LAS bf16x8*)(lds + PG8_SB(b, h) + boff + n * 2048 + k * 1024); } while (0)
#define PG8_MMA(ai, bj, At, Bt) do { __builtin_amdgcn_s_setprio(1); _Pragma("unroll") for (int m = 0; m < 4; ++m) _Pragma("unroll") for (int n = 0; n < 2; ++n) _Pragma("unroll") for (int k = 0; k < 2; ++k) \
        acc[ai][bj][m][n] = __builtin_amdgcn_mfma_f32_16x16x32_bf16(Bt[n][k], At[m][k], acc[ai][bj][m][n], 0, 0, 0); __builtin_amdgcn_s_setprio(0); } while (0)
#define PG8_WAIT_V(n) asm volatile("s_waitcnt vmcnt(" #n ")" ::: "memory")
#define PG8_WAIT_L(n) asm volatile("s_waitcnt lgkmcnt(" #n ")" ::: "memory")
#define PG8_BAR __builtin_amdgcn_s_barrier()
#define PG8_SCHED __builtin_amdgcn_sched_barrier(0)
    Unit cur, nxt; int ui = 0;
    if (!S.next(0, cur)) return;
    f32x4 acc[2][2][4][2];
#pragma unroll
    for (int a = 0; a < 2; ++a)
#pragma unroll
        for (int b = 0; b < 2; ++b)
#pragma unroll
            for (int m = 0; m < 4; ++m)
#pragma unroll
                for (int n = 0; n < 2; ++n) acc[a][b][m][n] = (f32x4){0.f, 0.f, 0.f, 0.f};
    bf16x8 At[4][2], B0[2][2], B1[2][2];
    const char* cA = (const char*)g.A + (size_t)cur.pm * tstepA; const char* cB = (const char*)g.Bt + (size_t)cur.pn * tstepB;
    S.a_ready(cur);
    if constexpr (SP2) {
        PG8_STAGE(PG8_SB(0, 0), cB, voffB); PG8_STAGE(PG8_SB(0, 1), cB + hstepB, voffB); PG8_STAGE(PG8_SA(0, 0), cA, voffA); PG8_STAGE(PG8_SA(0, 1), cA + hstepA, voffA);
        if (wr == 1) PG8_BAR;
        PG8_WAIT_V(2); PG8_BAR;
        PG8_STAGE(PG8_SB(1, 0), cB + kstep, voffB); PG8_STAGE(PG8_SA(1, 0), cA + kstep, voffA); PG8_STAGE(PG8_SB(1, 1), cB + hstepB + kstep, voffB);
        PG8_WAIT_V(6); PG8_BAR;
    } else {
        PG8_STAGE(PG8_SB(0, 0), cB, voffB); PG8_STAGE(PG8_SA(0, 0), cA, voffA); PG8_STAGE(PG8_SB(0, 1), cB + hstepB, voffB); PG8_STAGE(PG8_SA(0, 1), cA + hstepA, voffA);
        if (wr == 1) PG8_BAR;
        PG8_WAIT_V(4); PG8_BAR;
        PG8_STAGE(PG8_SB(1, 0), cB + kstep, voffB); PG8_STAGE(PG8_SA(1, 0), cA + kstep, voffA); PG8_STAGE(PG8_SB(1, 1), cB + hstepB + kstep, voffB);
        PG8_WAIT_V(6); PG8_BAR;
    }
    for (;;) {
        const bool has_next = S.next(ui + 1, nxt);
        const char* nA = has_next ? (const char*)g.A + (size_t)nxt.pm * tstepA : cA; const char* nB = has_next ? (const char*)g.Bt + (size_t)nxt.pn * tstepB : cB;
        for (int t = 0; t < nt; t += 2) {
            const bool last = (t == nt - 2);
            const char* a1 = cA + (size_t)(t + 1) * kstep;
            const char* a2 = last ? nA : cA + (size_t)(t + 2) * kstep; const char* b2 = last ? nB : cB + (size_t)(t + 2) * kstep;
            const char* a3 = a2 + kstep; const char* b3 = b2 + kstep;
            if (last && has_next) S.a_ready(nxt);
            if constexpr (SP2) {
            PG8_LDB(B0, 0, 0); PG8_LDB(B1, 0, 1); PG8_SCHED; PG8_LDA(At, 0, 0); PG8_STAGE(PG8_SA(1, 1), a1 + hstepA, voffA);
            PG8_WAIT_V(8); PG8_WAIT_L(0); PG8_BAR; PG8_MMA(0, 0, At, B0); PG8_MMA(0, 1, At, B1); PG8_BAR; PG8_SCHED;
            PG8_LDA(At, 0, 1); PG8_STAGE(PG8_SB(0, 0), b2, voffB); PG8_STAGE(PG8_SB(0, 1), b2 + hstepB, voffB); PG8_STAGE(PG8_SA(0, 0), a2, voffA);
            PG8_WAIT_V(8); PG8_WAIT_L(0); PG8_BAR; PG8_MMA(1, 0, At, B0); PG8_MMA(1, 1, At, B1); PG8_BAR; PG8_SCHED;
            PG8_LDB(B0, 1, 0); PG8_LDB(B1, 1, 1); PG8_SCHED; PG8_LDA(At, 1, 0); PG8_STAGE(PG8_SA(0, 1), a2 + hstepA, voffA);
            PG8_WAIT_V(8); PG8_WAIT_L(0); PG8_BAR; PG8_MMA(0, 0, At, B0); PG8_MMA(0, 1, At, B1); PG8_BAR; PG8_SCHED;
            PG8_LDA(At, 1, 1); PG8_STAGE(PG8_SB(1, 0), b3, voffB); PG8_STAGE(PG8_SB(1, 1), b3 + hstepB, voffB); PG8_STAGE(PG8_SA(1, 0), a3, voffA);
            PG8_WAIT_V(8); PG8_WAIT_L(0); PG8_BAR; PG8_MMA(1, 0, At, B0); PG8_MMA(1, 1, At, B1); PG8_BAR; PG8_SCHED;
            } else {
            PG8_LDB(B0, 0, 0); PG8_SCHED; PG8_LDA(At, 0, 0); PG8_STAGE(PG8_SA(1, 1), a1 + hstepA, voffA);
            PG8_WAIT_L(8); PG8_BAR; PG8_WAIT_L(0); PG8_MMA(0, 0, At, B0); PG8_BAR; PG8_SCHED;
            PG8_LDB(B1, 0, 1); PG8_STAGE(PG8_SB(0, 0), b2, voffB);
            PG8_BAR; PG8_WAIT_L(0); PG8_MMA(0, 1, At, B1); PG8_BAR;
            PG8_LDA(At, 0, 1); PG8_STAGE(PG8_SA(0, 0), a2, voffA);
            PG8_BAR; PG8_WAIT_L(0); PG8_MMA(1, 0, At, B0); PG8_BAR; PG8_SCHED;
            PG8_STAGE(PG8_SB(0, 1), b2 + hstepB, voffB);
            PG8_WAIT_V(6); PG8_BAR; PG8_MMA(1, 1, At, B1); PG8_BAR;
            PG8_LDB(B0, 1, 0); PG8_SCHED; PG8_LDA(At, 1, 0); PG8_STAGE(PG8_SA(0, 1), a2 + hstepA, voffA);
            PG8_WAIT_L(8); PG8_BAR; PG8_WAIT_L(0); PG8_MMA(0, 0, At, B0); PG8_BAR; PG8_SCHED;
            PG8_LDB(B1, 1, 1); PG8_STAGE(PG8_SB(1, 0), b3, voffB);
            PG8_BAR; PG8_WAIT_L(0); PG8_MMA(0, 1, At, B1); PG8_BAR;
            PG8_LDA(At, 1, 1); PG8_STAGE(PG8_SA(1, 0), a3, voffA);
            PG8_BAR; PG8_WAIT_L(0); PG8_MMA(1, 0, At, B0); PG8_BAR; PG8_SCHED;
            PG8_STAGE(PG8_SB(1, 1), b3 + hstepB, voffB);
            PG8_WAIT_V(6); PG8_BAR; PG8_MMA(1, 1, At, B1); PG8_BAR;
            }
        }
        if constexpr (ALIGN_EPI) { if (wr == 0) PG8_BAR; }
        if constexpr (!Epi::AFTER_DRAIN) { E(acc, cur, wr, wc, fr, fq); S.done(cur); }
        if (!has_next) break;
#pragma unroll
        for (int a = 0; a < 2; ++a)
#pragma unroll
            for (int b = 0; b < 2; ++b)
#pragma unroll
                for (int m = 0; m < 4; ++m)
#pragma unroll
                    for (int n = 0; n < 2; ++n) acc[a][b][m][n] = (f32x4){0.f, 0.f, 0.f, 0.f};
        cur = nxt; cA = nA; cB = nB; ++ui;
        if constexpr (ALIGN_EPI) { if (wr == 1) PG8_BAR; }
    }
    PG8_WAIT_V(0);
    if constexpr (!ALIGN_EPI) { if (wr == 0) PG8_BAR; }
    PG8_BAR;
    if constexpr (Epi::AFTER_DRAIN) { E.fused(acc, cur, wr, wc, fr, fq, lds, wid, lane); S.done(cur); }
#undef PG8_SA
#undef PG8_SB
#undef PG8_STAGE
#undef PG8_LDA
#undef PG8_LDB
#undef PG8_MMA
#undef PG8_WAIT_V
#undef PG8_WAIT_L
#undef PG8_BAR
#undef PG8_SCHED
}
}

template <class F> struct EpiQuad {
    static constexpr bool PERM = false, AFTER_DRAIN = false;
    F f;
    template <int C, int BJ> __device__ __forceinline__ void half(const pg8::f32x4 (&acc)[2][2][4][2], int row0, int p) const {
#pragma unroll
        for (int ai = 0; ai < 2; ++ai)
#pragma unroll
            for (int m = 0; m < 4; ++m) { f.template apply<C>(row0 + ai * 128 + m * 16, p, acc[ai][BJ][m][0], acc[ai][BJ][m][1]); asm volatile("" ::: "memory"); }
    }
    template <int BJ> __device__ __forceinline__ void disp(const pg8::f32x4 (&acc)[2][2][4][2], int row0, int p0, int p) const {
        const int c = f.cat(p0);
        if (F::NCAT == 1 || c == 0) half<0, BJ>(acc, row0, p);
        else if (F::NCAT > 1 && c == 1) half<(F::NCAT > 1 ? 1 : 0), BJ>(acc, row0, p);
        else if (F::NCAT > 2 && c == 2) half<(F::NCAT > 2 ? 2 : 0), BJ>(acc, row0, p);
        else if (F::NCAT > 3 && c == 3) half<(F::NCAT > 3 ? 3 : 0), BJ>(acc, row0, p);
        else if (F::NCAT > 4 && c == 4) half<(F::NCAT > 4 ? 4 : 0), BJ>(acc, row0, p);
        else if (F::NCAT > 5 && c == 5) half<(F::NCAT > 5 ? 5 : 0), BJ>(acc, row0, p);
        else if (F::NCAT > 6 && c == 6) half<(F::NCAT > 6 ? 6 : 0), BJ>(acc, row0, p);
        else if (F::NCAT > 7) half<(F::NCAT > 7 ? 7 : 0), BJ>(acc, row0, p);
    }
    __device__ __forceinline__ void operator()(const pg8::f32x4 (&acc)[2][2][4][2], const pg8::Unit& u, int wr, int wc, int fr, int fq) const {
        const int row0 = u.pm * 256 + wr * 64 + fr, p0 = u.pn * 256;
        disp<0>(acc, row0, p0, p0 + wc * 32 + 4 * fq);
        disp<1>(acc, row0, p0 + 128, p0 + 128 + wc * 32 + 4 * fq);
    }
};
template <class F> __device__ __forceinline__ void gemm_pg8(unsigned char* lds, const bf16* A, int lda, const bf16* Bt, int ldb, int M, int N, int K, const F& f, int wg_off = 0) {
    if ((int)blockIdx.x < wg_off) return;
    pg8::Gemm g{A, Bt, M, N, K, lda, ldb}; pg8::StaticOrder S; S.init(M, N, (int)gridDim.x, (int)blockIdx.x - wg_off);
    EpiQuad<F> E{f};
    pg8::gemm_phase<EpiQuad<F>, pg8::StaticOrder, true, true>((PG8_LAS unsigned char*)lds, g, S, E);
}

namespace cg = cooperative_groups;
struct EpiNormRes {
    static constexpr bool PERM = false, AFTER_DRAIN = true;
    const float* xin; float* xout; bf16* xn; const float* gpost; const float* gpre; float coef; unsigned* part; unsigned* cnt;
    __device__ __forceinline__ void operator()(const pg8::f32x4 (&)[2][2][4][2], const pg8::Unit&, int, int, int, int) const {}
    __device__ __forceinline__ void rowstat(const pg8::f32x4 (&acc)[2][2][4][2], float* P, int wr, int wc, int fr, int fq) const {
#pragma unroll
        for (int ai = 0; ai < 2; ++ai)
#pragma unroll
            for (int m = 0; m < 4; ++m) { float sq = 0.f;
#pragma unroll
                for (int bj = 0; bj < 2; ++bj)
#pragma unroll
                    for (int n = 0; n < 2; ++n) { const pg8::f32x4 v = acc[ai][bj][m][n]; sq += (v[0] * v[0] + v[1] * v[1]) + (v[2] * v[2] + v[3] * v[3]); }
                sq += __shfl_xor(sq, 16); sq += __shfl_xor(sq, 32);
                if (fq == 0) P[(ai * 128 + wr * 64 + m * 16 + fr) * 4 + wc] = sq; }
    }
    __device__ __forceinline__ void exchange(float* P, float* S, unsigned* bank, unsigned* cnt, const pg8::Unit& u, int tid, float scale) const {
        __syncthreads();
        if (tid < 256) { const f32x4 p = *(const f32x4*)(P + tid * 4);
            __hip_atomic_store(bank + (size_t)(u.pm * 256 + tid) * 4 + u.pn, __builtin_bit_cast(unsigned, (p[0] + p[1]) + (p[2] + p[3])), __ATOMIC_RELAXED, __HIP_MEMORY_SCOPE_AGENT); }
        asm volatile("s_waitcnt vmcnt(0)" ::: "memory");
        __syncthreads();
        if (tid == 0) { unsigned* c = cnt + u.pm * 16; __hip_atomic_fetch_add(c, 1u, __ATOMIC_RELAXED, __HIP_MEMORY_SCOPE_AGENT);
            while (__hip_atomic_load(c, __ATOMIC_RELAXED, __HIP_MEMORY_SCOPE_AGENT) < 4u) __builtin_amdgcn_s_sleep(1); }
        __syncthreads();
        if (tid < 256) { const unsigned* b = bank + (size_t)(u.pm * 256 + tid) * 4; float q = 0.f;
#pragma unroll
            for (int j = 0; j < 4; ++j) q += __builtin_bit_cast(float, __hip_atomic_load(b + j, __ATOMIC_RELAXED, __HIP_MEMORY_SCOPE_AGENT));
            S[tid] = rsqrtf(q * (1.f / DM) + NORM_EPS) * scale; }
        __syncthreads();
    }
    __device__ __forceinline__ void fused(pg8::f32x4 (&acc)[2][2][4][2], const pg8::Unit& u, int wr, int wc, int fr, int fq, PG8_LAS unsigned char* lds, int wid, int lane) const {
        float* P = (float*)lds; float* S = P + 1024; const int tid = wid * 64 + lane;
        rowstat(acc, P, wr, wc, fr, fq);
        exchange(P, S, part, cnt, u, tid, coef);
        const int col0 = u.pn * 256 + wc * 32 + 4 * fq;
#pragma unroll
        for (int ai = 0; ai < 2; ++ai)
#pragma unroll
            for (int m = 0; m < 4; ++m) { const int r = ai * 128 + wr * 64 + m * 16 + fr; const float sr = S[r]; const size_t off = (size_t)(u.pm * 256 + r) * DM + col0;
#pragma unroll
                for (int bj = 0; bj < 2; ++bj)
#pragma unroll
                    for (int n = 0; n < 2; ++n) { const int o = bj * 128 + n * 16; const f32x4 g4 = *(const f32x4*)(gpost + col0 + o), x4 = *(const f32x4*)(xin + off + o);
                        const f32x4 y = x4 + acc[ai][bj][m][n] * sr * g4; acc[ai][bj][m][n] = y; *(f32x4*)(xout + off + o) = y; }
                asm volatile("" ::: "memory"); }
        if (!gpre) return;
        rowstat(acc, P, wr, wc, fr, fq);
        exchange(P, S, part + (size_t)M_ * 4, cnt + 64 * 16, u, tid, 1.f);
#pragma unroll
        for (int ai = 0; ai < 2; ++ai)
#pragma unroll
            for (int m = 0; m < 4; ++m) { const int r = ai * 128 + wr * 64 + m * 16 + fr; const float sr = S[r]; const size_t off = (size_t)(u.pm * 256 + r) * DM + col0;
#pragma unroll
                for (int bj = 0; bj < 2; ++bj)
#pragma unroll
                    for (int n = 0; n < 2; ++n) { const int o = bj * 128 + n * 16; const f32x4 g4 = *(const f32x4*)(gpre + col0 + o); st_bf4(xn + off + o, acc[ai][bj][m][n] * sr * g4); }
                asm volatile("" ::: "memory"); }
    }
};
__device__ __forceinline__ void gemm_norm_res(unsigned char* lds, const bf16* A, int lda, const bf16* Bt, int K, const float* xin, float* xout, bf16* xn, const float* gpost, const float* gpre,
                                              float coef, bf16* ybuf, unsigned* part, unsigned* cnt) {
    pg8::Gemm g{A, Bt, M_, DM, K, lda, K}; pg8::StaticOrder S; S.init(M_, DM, 256, (int)blockIdx.x);
    const EpiNormRes E{xin, xout, xn, gpost, gpre, coef, part, cnt};
    pg8::gemm_phase<EpiNormRes, pg8::StaticOrder, false, true>((PG8_LAS unsigned char*)lds, g, S, E);
}

__device__ __forceinline__ void d_gates(const bf16* xn, const bf16* wg  , float* gates) {
    const int T512 = tidx(), lane = T512 & 63, fr = lane & 15, fq = lane >> 4;
    for (int rt = blockIdx.x * 8 + (T512 >> 6); rt < M_ / 16; rt += gridDim.x * 8) {
        const bf16* ap = xn + (size_t)(rt * 16 + fr) * DM + 8 * fq; const bf16* bp = wg + (size_t)fr * DM + 8 * fq;
        f32x4 c0 = {0.f, 0.f, 0.f, 0.f}, c1 = {0.f, 0.f, 0.f, 0.f};
#pragma unroll 8
        for (int k0 = 0; k0 < DM; k0 += 32) { const bf16x8 a = *(const bf16x8*)(ap + k0);
            c0 = __builtin_amdgcn_mfma_f32_16x16x32_bf16(*(const bf16x8*)(bp + k0), a, c0, 0, 0, 0);
            c1 = __builtin_amdgcn_mfma_f32_16x16x32_bf16(*(const bf16x8*)(bp + (size_t)16 * DM + k0), a, c1, 0, 0, 0); }
        float* o = gates + (size_t)(rt * 16 + fr) * 24 + 4 * fq;
        *(f32x4*)o = (f32x4){sigmoidf_(c0[0]), sigmoidf_(c0[1]), sigmoidf_(c0[2]), sigmoidf_(c0[3])};
        if (fq < 2) *(f32x4*)(o + 16) = (f32x4){sigmoidf_(c1[0]), sigmoidf_(c1[1]), sigmoidf_(c1[2]), sigmoidf_(c1[3])};
    }
}

__device__ __forceinline__ void d_cmp2(const bf16* hidk, const bf16* hidv, const bf16* w2t, const float* rope, bf16* kc, bf16* vct) {
    const int T512 = tidx(), lane = T512 & 63, fr = lane & 15, fq = lane >> 4;
    for (int task = blockIdx.x * 8 + (T512 >> 6); task < 256; task += gridDim.x * 8) {
        const int kv = task >> 7, R0 = (task & 127) * 16;
        const bf16* ap = (kv ? hidv : hidk) + (size_t)(R0 + fr) * 256 + 8 * fq;
        const bf16* bp = w2t + (size_t)kv * 64 * 256 + (size_t)fr * 256 + 8 * fq;
        f32x4 acc[4];
#pragma unroll
        for (int nt = 0; nt < 4; ++nt) acc[nt] = (f32x4){0.f, 0.f, 0.f, 0.f};
#pragma unroll
        for (int k0 = 0; k0 < 256; k0 += 32) {
            const bf16x8 a = *(const bf16x8*)(ap + k0);
#pragma unroll
            for (int nt = 0; nt < 4; ++nt) acc[nt] = __builtin_amdgcn_mfma_f32_16x16x32_bf16(*(const bf16x8*)(bp + (size_t)nt * 16 * 256 + k0), a, acc[nt], 0, 0, 0);
        }
        const int R = R0 + fr, bg = R >> 9, c = R & 511;
        if (kv == 0) {
            const int pos = (16 * c + 31) & (T_ - 1);
#pragma unroll
            for (int h2 = 0; h2 < 2; ++h2) {
                const int d = 16 * h2 + 4 * fq; const f32x4* rp = (const f32x4*)(rope + ((size_t)pos * 32 + d) * 2); const f32x4 r0 = rp[0], r1 = rp[1];
                const f32x4 cs = {r0[0], r0[2], r1[0], r1[2]}, sn = {r0[1], r0[3], r1[1], r1[3]};
                const f32x4 lo = acc[h2] * cs - acc[h2 + 2] * sn, hi = acc[h2] * sn + acc[h2 + 2] * cs;
                st_bf4(kc + (size_t)R * 64 + d, lo); st_bf4(kc + (size_t)R * 64 + d + 32, hi);
            }
        } else {
#pragma unroll
            for (int nt = 0; nt < 4; ++nt)
#pragma unroll
                for (int e = 0; e < 4; ++e) vct[((size_t)bg * 64 + 16 * nt + 4 * fq + e) * NCP + c] = (bf16)f2bf(acc[nt][e]);
        }
    }
}

struct NsaArgs { const bf16 *qb, *kc, *vct, *ks, *vst, *kw, *vwt; const float* gates; bf16* amix; };
__device__ __forceinline__ float dot64(const float* q, const bf16* k) {
    float s = 0.f;
#pragma unroll
    for (int i = 0; i < 8; ++i) { const u32x4 w = ((const u32x4*)k)[i];
        s += q[8 * i + 0] * __builtin_bit_cast(float, w.x << 16) + q[8 * i + 1] * __builtin_bit_cast(float, w.x & 0xffff0000u)
           + q[8 * i + 2] * __builtin_bit_cast(float, w.y << 16) + q[8 * i + 3] * __builtin_bit_cast(float, w.y & 0xffff0000u)
           + q[8 * i + 4] * __builtin_bit_cast(float, w.z << 16) + q[8 * i + 5] * __builtin_bit_cast(float, w.z & 0xffff0000u)
           + q[8 * i + 6] * __builtin_bit_cast(float, w.w << 16) + q[8 * i + 7] * __builtin_bit_cast(float, w.w & 0xffff0000u); }
    return s;
}
__device__ __forceinline__ void softmax_row(float* s, int n, int lane) {
    float m = -INFINITY; for (int i = lane; i < n; i += 64) m = fmaxf(m, s[i]);
    m = wave_max(m); if (m == -INFINITY) m = 0.f;
    float l = 0.f; for (int i = lane; i < n; i += 64) { const float e = exp2f(s[i] - m); s[i] = e; l += e; }
    l = wave_sum(l); const float inv = 1.f / fmaxf(l, 1e-30f);
    for (int i = lane; i < n; i += 64) s[i] *= inv;
}
__device__ __forceinline__ void d_nsa_simple(const NsaArgs& a, int vb, int tid, unsigned char* smem) {
    float (*qs)[64] = (float (*)[64])smem; float (*sc)[1024] = (float (*)[1024])(smem + 1024); float* imp = (float*)(smem + 17408); float* score = imp + 128;
    int* list = (int*)(score + 128); int* nlist = list + 16;
    const int bg = vb / T_, t = vb % T_, b = bg >> 1, g = bg & 1;
    const int r = tid >> 6, d = tid & 63, lane = d;
    const size_t row = (size_t)b * T_ + t;
    qs[r][d] = bf2f(a.qb[row * 512 + g * 256 + r * 64 + d]);
    if (tid == 0) *nlist = 0;
    __syncthreads();
    const int nv = t < 31 ? 0 : (t - 31) / 16 + 1;
    for (int c = tid; c < nv; c += 256) { const bf16* k = a.kc + ((size_t)bg * NCP + c) * 64;
        _Pragma("unroll 1") for (int rr = 0; rr < 4; ++rr) sc[rr][c] = dot64(qs[rr], k); }
    __syncthreads();
    softmax_row(sc[r], nv, lane);
    __syncthreads();
    float oc = 0.f; { const bf16* v = a.vct + ((size_t)bg * 64 + d) * NCP; for (int c = 0; c < nv; ++c) oc += sc[r][c] * bf2f(v[c]); }
    if (tid < 128) { const int s = tid; float acc = 0.f;
        for (int c = 4 * s - 1; c <= 4 * s + 3; ++c) if (c >= 0 && c < nv) acc += sc[0][c] + sc[1][c] + sc[2][c] + sc[3][c];
        imp[s] = acc; }
    __syncthreads();
    const int cur = t >> 6;
    if (tid < 128) { const int s = tid; const bool forced = (s == 0) || (s == cur) || (s == cur - 1);
        score[s] = forced ? 1e4f : (s <= cur ? imp[s] : -1e4f); }
    __syncthreads();
    if (tid < 128) { const int s = tid; const float my = score[s]; int rank = 0;
        for (int j = 0; j < 128; ++j) { const float o = score[j]; rank += (o > my || (o == my && j < s)) ? 1 : 0; }
        if (rank < 16 && s <= cur) { const int slot = atomicAdd(nlist, 1); list[slot] = s; } }
    __syncthreads();
    const int ns = *nlist * 64;
    for (int i = tid; i < ns; i += 256) { const int pos = list[i >> 6] * 64 + (i & 63);
        if (pos <= t) { const bf16* k = a.ks + ((size_t)bg * T_ + pos) * 64; _Pragma("unroll 1") for (int rr = 0; rr < 4; ++rr) sc[rr][i] = dot64(qs[rr], k); }
        else { sc[0][i] = -INFINITY; sc[1][i] = -INFINITY; sc[2][i] = -INFINITY; sc[3][i] = -INFINITY; } }
    __syncthreads();
    softmax_row(sc[r], ns, lane);
    __syncthreads();
    float os = 0.f; { const bf16* v = a.vst + ((size_t)bg * 64 + d) * T_;
        for (int i = 0; i < ns; ++i) { const int pos = list[i >> 6] * 64 + (i & 63); if (pos <= t) os += sc[r][i] * bf2f(v[pos]); } }
    __syncthreads();
    const int lo = t - 511 > 0 ? t - 511 : 0, nw = t - lo + 1;
    for (int i = tid; i < nw; i += 256) { const bf16* k = a.kw + ((size_t)bg * T_ + lo + i) * 64;
        _Pragma("unroll 1") for (int rr = 0; rr < 4; ++rr) sc[rr][i] = dot64(qs[rr], k); }
    __syncthreads();
    softmax_row(sc[r], nw, lane);
    __syncthreads();
    float ow = 0.f; { const bf16* v = a.vwt + ((size_t)bg * 64 + d) * T_ + lo; for (int i = 0; i < nw; ++i) ow += sc[r][i] * bf2f(v[i]); }
    const float* gt = a.gates + row * 24 + g * 12 + r * 3;
    a.amix[row * DM + g * 256 + r * 64 + d] = (bf16)f2bf(gt[0] * oc + gt[1] * os + gt[2] * ow);
    __syncthreads();
}


namespace nsa {
typedef float f32x16 __attribute__((ext_vector_type(16)));
constexpr int KROW = 144, VROW = 136, KBUF = 64 * KROW, VBUF = 64 * VROW;
constexpr int OFF_K = 0, OFF_V = 2 * KBUF, OFF_IMP = OFF_V + 2 * VBUF, IMPW = 130, OFF_SEL = OFF_IMP + 64 * IMPW * 4, OFF_UM = OFF_SEL + 1024, OFF_WS = OFF_UM + 16, OFF_UNIT = OFF_WS + 1024, OFF_ACC = OFF_UNIT + 16, LDS_NEED = OFF_ACC + 8 * 8192;
static_assert(LDS_NEED <= 147456 - 64 && OFF_ACC % 16 == 0, "nsa lds");
static_assert(OFF_IMP % 16 == 0 && OFF_SEL % 16 == 0 && OFF_WS % 16 == 0, "nsa lds map");
__device__ __forceinline__ int crow(int r, int hi) { return (r & 3) + 8 * (r >> 2) + 4 * hi; }
__device__ __forceinline__ int next_bit(unsigned m0, unsigned m1, unsigned m2, unsigned m3, int from) {
#pragma unroll
    for (int wd = 0; wd < 4; ++wd) {
        unsigned x = wd == 0 ? m0 : (wd == 1 ? m1 : (wd == 2 ? m2 : m3)); const int base = wd * 32;
        if (from < base + 32) { if (from > base) x &= (~0u) << (from - base); if (x) return base + __builtin_ctz(x); }
    }
    return 128;
}
__device__ __forceinline__ bf16x8 pack8(const f32x16& p, int b0) {
    u32x4 w; w.x = pk2(p[b0 + 0], p[b0 + 1]); w.y = pk2(p[b0 + 2], p[b0 + 3]); w.z = pk2(p[b0 + 4], p[b0 + 5]); w.w = pk2(p[b0 + 6], p[b0 + 7]);
    return __builtin_bit_cast(bf16x8, w);
}
struct Branch { const bf16* k; const bf16* vt; int ldv; };

constexpr float THR = 8.f;
template <int MODE, bool SEL>
__device__ __forceinline__ void compute_tile(unsigned char* sm, int cb, int j, const bf16x8 (&qf)[4], int lo, int hi_b, int lo_max, int hi_min, unsigned s0, unsigned s1, unsigned s2, unsigned s3,
                                             float& m, float& l, float invl, bool& initd, f32x16& negm, f32x16 (&o)[2], float* imp_row, float* wsc, int i, int hi) {
        const unsigned char* kb = sm + OFF_K + cb * KBUF; const unsigned char* vb = sm + OFF_V + cb * VBUF;
        const int key0 = 64 * j;
        bool rowsel = true;
        if (SEL) { const unsigned wsel = j < 32 ? s0 : (j < 64 ? s1 : (j < 96 ? s2 : s3)); rowsel = (wsel >> (j & 31)) & 1u; }
        if (!SEL || __any(rowsel)) {
            f32x16 p0, p1;
            {
                f32x16 c0;
                if (SEL) {
#pragma unroll
                    for (int r = 0; r < 16; ++r) c0[r] = rowsel ? negm[r] : -INFINITY;
                } else c0 = negm;
                const bf16x8 a00 = *(const bf16x8*)(kb + i * KROW + (8 * hi) * 2), a10 = *(const bf16x8*)(kb + (32 + i) * KROW + (8 * hi) * 2);
                p0 = __builtin_amdgcn_mfma_f32_32x32x16_bf16(a00, qf[0], c0, 0, 0, 0);
                p1 = __builtin_amdgcn_mfma_f32_32x32x16_bf16(a10, qf[0], c0, 0, 0, 0);
#pragma unroll
                for (int d0 = 1; d0 < 4; ++d0) {
                    const bf16x8 a0 = *(const bf16x8*)(kb + i * KROW + (16 * d0 + 8 * hi) * 2);
                    const bf16x8 a1 = *(const bf16x8*)(kb + (32 + i) * KROW + (16 * d0 + 8 * hi) * 2);
                    p0 = __builtin_amdgcn_mfma_f32_32x32x16_bf16(a0, qf[d0], p0, 0, 0, 0);
                    p1 = __builtin_amdgcn_mfma_f32_32x32x16_bf16(a1, qf[d0], p1, 0, 0, 0);
                }
            }
            if (!(key0 >= lo_max && key0 + 63 <= hi_min)) {
#pragma unroll
                for (int r = 0; r < 16; ++r) { const int key = key0 + crow(r, hi);
                    if (key < lo || key > hi_b) p0[r] = -INFINITY;
                    if (key + 32 < lo || key + 32 > hi_b) p1[r] = -INFINITY; }
            }
            if (MODE == 1) {
#pragma unroll
                for (int r = 0; r < 16; ++r) { p0[r] = __builtin_amdgcn_exp2f(p0[r]) * invl; p1[r] = __builtin_amdgcn_exp2f(p1[r]) * invl; }
#pragma unroll
                for (int gq = 0; gq < 4; ++gq) {
                    float G0 = (p0[4 * gq] + p0[4 * gq + 1]) + (p0[4 * gq + 2] + p0[4 * gq + 3]), L0 = p0[4 * gq + 3];
                    float G1 = (p1[4 * gq] + p1[4 * gq + 1]) + (p1[4 * gq + 2] + p1[4 * gq + 3]), L1 = p1[4 * gq + 3];
                    G0 += __shfl_xor(G0, 1); L0 += __shfl_xor(L0, 1); G1 += __shfl_xor(G1, 1); L1 += __shfl_xor(L1, 1);
                    G0 += __shfl_xor(G0, 2); L0 += __shfl_xor(L0, 2); G1 += __shfl_xor(G1, 2); L1 += __shfl_xor(L1, 2);
                    if ((i & 3) == 0) { const int s = 16 * j + 2 * gq + hi;
                        atomicAdd(imp_row + s, G0); atomicAdd(imp_row + s + 1, L0); atomicAdd(imp_row + s + 8, G1); atomicAdd(imp_row + s + 9, L1); }
                }
            } else {
                float ta = fmaxf(fmaxf(p0[0], p0[1]), p1[0]), tb = fmaxf(fmaxf(p0[2], p0[3]), p1[1]);
                ta = fmaxf(fmaxf(ta, p1[2]), p1[3]);
#pragma unroll
                for (int r = 4; r < 16; r += 4) { ta = fmaxf(fmaxf(ta, p0[r]), p0[r + 1]); tb = fmaxf(fmaxf(tb, p0[r + 2]), p0[r + 3]); ta = fmaxf(fmaxf(ta, p1[r]), p1[r + 1]); tb = fmaxf(fmaxf(tb, p1[r + 2]), p1[r + 3]); }
                float tm = fmaxf(ta, tb);
                tm = fmaxf(tm, __shfl_xor(tm, 32));
                if (__any((!initd && tm > -INFINITY) || tm > THR)) {
                    const bool was = initd;
                    const float d = was ? fmaxf(tm, 0.f) : (tm > -INFINITY ? tm : 0.f);
                    initd = was || (tm > -INFINITY);
                    m += d; const float alpha = was ? __builtin_amdgcn_exp2f(-d) : 1.f; l *= alpha;
#pragma unroll
                    for (int r = 0; r < 16; ++r) { p0[r] -= d; p1[r] -= d; negm[r] = -m; }
                    if (MODE == 2) {
                        if (hi == 0) wsc[i] = alpha;
                        asm volatile("" ::: "memory");
#pragma unroll
                        for (int rg = 0; rg < 4; ++rg) { const f32x4 a4 = *(const f32x4*)(wsc + 8 * rg + 4 * hi);
#pragma unroll
                            for (int e = 0; e < 4; ++e) { o[0][4 * rg + e] *= a4[e]; o[1][4 * rg + e] *= a4[e]; } }
                        asm volatile("" ::: "memory");
                    }
                }
                float rs = 0.f;
#pragma unroll
                for (int r = 0; r < 16; ++r) { p0[r] = __builtin_amdgcn_exp2f(p0[r]); p1[r] = __builtin_amdgcn_exp2f(p1[r]); rs += p0[r] + p1[r]; }
                l += rs;
            }
            if (MODE != 0) {
                const bf16x8 pf0 = pack8(p0, 0), pf1 = pack8(p0, 8), pf2 = pack8(p1, 0), pf3 = pack8(p1, 8);
#pragma unroll
                for (int dt = 0; dt < 2; ++dt) {
                    const unsigned char* vp = vb + (32 * dt + i) * VROW + 8 * hi;
#pragma unroll
                    for (int ks = 0; ks < 4; ++ks) {
                        const u32x2 v_lo = *(const u32x2*)(vp + 32 * ks), v_hi = *(const u32x2*)(vp + 32 * ks + 16);
                        const bf16x8 vf = __builtin_bit_cast(bf16x8, (u32x4){v_lo.x, v_lo.y, v_hi.x, v_hi.y});
                        o[dt] = __builtin_amdgcn_mfma_f32_32x32x16_bf16(ks == 0 ? pf0 : (ks == 1 ? pf1 : (ks == 2 ? pf2 : pf3)), vf, o[dt], 0, 0, 0);
                    }
                }
            }
        }
}
template <int MODE, bool SEL>
__device__ __forceinline__ void run_branch(unsigned char* sm, const Branch br, unsigned m0, unsigned m1, unsigned m2, unsigned m3,
                                           const bf16x8 (&qf)[4], int lo, int hi_b, int lo_max, int hi_min, unsigned s0, unsigned s1, unsigned s2, unsigned s3,
                                           float& m, float& l, float invl, f32x16 (&o)[2], float* imp_row, float* wsc, int tid, int lane) {
    const int i = lane & 31, hi = lane >> 5;
    const bf16* kp = br.k + tid * 8; const bf16* vp_ = br.vt + (size_t)(tid >> 3) * br.ldv + (tid & 7) * 8;
    unsigned char* kst = sm + OFF_K + (tid >> 3) * KROW + (tid & 7) * 16; unsigned char* vst = sm + OFF_V + (tid >> 3) * VROW + (tid & 7) * 16;
#define NSA_LOAD(jj, KR, VR) do { KR = *(const u32x4*)(kp + (size_t)(jj) * 4096); if (MODE != 0) VR = *(const u32x4*)(vp_ + (jj) * 64); } while (0)
#define NSA_STORE(buf, KR, VR) do { *(u32x4*)(kst + (buf) * KBUF) = KR; if (MODE != 0) { *(u32x2*)(vst + (buf) * VBUF) = (u32x2){VR.x, VR.y}; *(u32x2*)(vst + (buf) * VBUF + 8) = (u32x2){VR.z, VR.w}; } } while (0)
    int j = next_bit(m0, m1, m2, m3, 0);
    int j1 = j < 128 ? next_bit(m0, m1, m2, m3, j + 1) : 128;
    u32x4 kA, vA, kB, vB;
    if (j < 128) { NSA_LOAD(j, kA, vA); if (j1 < 128) NSA_LOAD(j1, kB, vB); NSA_STORE(0, kA, vA); }
    __syncthreads();
    bool initd = (MODE == 1);
    f32x16 negm;
#pragma unroll
    for (int r = 0; r < 16; ++r) negm[r] = (MODE == 1) ? -m : 0.f;
    while (j < 128) {
        {
            const int j2 = j1 < 128 ? next_bit(m0, m1, m2, m3, j1 + 1) : 128;
            if (j2 < 128) NSA_LOAD(j2, kA, vA);
            compute_tile<MODE, SEL>(sm, 0, j, qf, lo, hi_b, lo_max, hi_min, s0, s1, s2, s3, m, l, invl, initd, negm, o, imp_row, wsc, i, hi);
            if (j1 < 128) NSA_STORE(1, kB, vB);
            __syncthreads();
            j = j1; j1 = j2;
        }
        if (j >= 128) break;
        {
            const int j2 = j1 < 128 ? next_bit(m0, m1, m2, m3, j1 + 1) : 128;
            if (j2 < 128) NSA_LOAD(j2, kB, vB);
            compute_tile<MODE, SEL>(sm, 1, j, qf, lo, hi_b, lo_max, hi_min, s0, s1, s2, s3, m, l, invl, initd, negm, o, imp_row, wsc, i, hi);
            if (j1 < 128) NSA_STORE(0, kA, vA);
            __syncthreads();
            j = j1; j1 = j2;
        }
    }
#undef NSA_LOAD
#undef NSA_STORE
}
template <bool FIRST> __device__ __forceinline__ void add_scaled(float* accw, const f32x16 (&o)[2], float f, float* wsc, int i, int hi, int lane) {
    if (hi == 0) wsc[i] = f;
    asm volatile("" ::: "memory");
#pragma unroll
    for (int rg = 0; rg < 4; ++rg) { const f32x4 a4 = *(const f32x4*)(wsc + 8 * rg + 4 * hi);
#pragma unroll
        for (int e = 0; e < 4; ++e)
#pragma unroll
            for (int dt = 0; dt < 2; ++dt) { float* p = accw + (dt * 16 + 4 * rg + e) * 64 + lane; const float v = a4[e] * o[dt][4 * rg + e]; *p = FIRST ? v : (*p + v); } }
    asm volatile("" ::: "memory");
}
__device__ __forceinline__ void unit(const NsaArgs& a, int u, unsigned char* sm) {
    const int tid = tidx(), lane = tid & 63, w = __builtin_amdgcn_readfirstlane(tid >> 6), i = lane & 31, hi = lane >> 5;
    const int cur = 127 - (u >> 2), bg = u & 3, b = bg >> 1, g = bg & 1, q0 = cur * 64;
    const int ql = 8 * w + (i >> 2), hd = i & 3, t = q0 + ql;
    const size_t grow = (size_t)b * T_ + t;
    bf16x8 qf[4];
    { const bf16* qp = a.qb + grow * 512 + g * 256 + hd * 64 + 8 * hi;
#pragma unroll
      for (int d0 = 0; d0 < 4; ++d0) qf[d0] = *(const bf16x8*)(qp + 16 * d0); }
    float* wsc = (float*)(sm + OFF_WS) + w * 32;
    float* imp = (float*)(sm + OFF_IMP);
    unsigned* selw = (unsigned*)(sm + OFF_SEL);
    unsigned* um = (unsigned*)(sm + OFF_UM);
    for (int k = tid; k < 64 * IMPW; k += 512) imp[k] = 0.f;
    if (tid < 4) um[tid] = 0u;
    const float* gt = a.gates + grow * 24 + g * 12 + hd * 3;
    const float gc = gt[0], gs = gt[1], gw = gt[2];
    f32x16 o[2];
    float* accw = (float*)(sm + OFF_ACC) + w * 2048;
    const int tw0 = q0 + 8 * w, tw1 = tw0 + 7;
    {
        const int nv = t < 31 ? 0 : (t - 31) / 16 + 1;
        const int nvw = tw0 < 31 ? 0 : (tw0 - 31) / 16 + 1;
        const int nvmax = (q0 + 63 - 31) / 16 + 1, ntc = (nvmax + 63) / 64;
        const unsigned cm0 = ntc >= 32 ? ~0u : ((1u << ntc) - 1u);
        const Branch br{a.kc + (size_t)bg * NCP * 64, a.vct + (size_t)bg * 64 * NCP, NCP};
        float m = 0.f, l = 0.f;
        run_branch<0, false>(sm, br, cm0, 0u, 0u, 0u, qf, 0, nv - 1, 0, nvw - 1, 0u, 0u, 0u, 0u, m, l, 0.f, o, nullptr, wsc, tid, lane);
        l += __shfl_xor(l, 32);
        const float invl = 1.f / fmaxf(l, 1e-30f);
#pragma unroll
        for (int r = 0; r < 16; ++r) { o[0][r] = 0.f; o[1][r] = 0.f; }
        run_branch<1, false>(sm, br, cm0, 0u, 0u, 0u, qf, 0, nv - 1, 0, nvw - 1, 0u, 0u, 0u, 0u, m, l, invl, o, imp + ql * IMPW, wsc, tid, lane);
        add_scaled<true>(accw, o, gc, wsc, i, hi, lane);
    }
    {
        unsigned u0 = 0u, u1 = 0u, u2 = 0u, u3 = 0u;
        const int ncand = cur - 2;
        unsigned k0[8], k1[8], k2[8], k3[8];
        if (ncand <= 13) {
#pragma unroll
            for (int wd = 0; wd < 4; ++wd) { const int nb = cur + 1 - 32 * wd; const unsigned x = nb >= 32 ? ~0u : (nb <= 0 ? 0u : ((1u << nb) - 1u));
#pragma unroll
                for (int qq = 0; qq < 8; ++qq) { if (wd == 0) k0[qq] = x; else if (wd == 1) k1[qq] = x; else if (wd == 2) k2[qq] = x; else k3[qq] = x; } }
        } else {
            float v0[8], v1[8];
#pragma unroll
            for (int qq = 0; qq < 8; ++qq) { const float* ir = imp + (8 * w + qq) * IMPW;
                v0[qq] = (lane >= 1 && lane <= cur - 2) ? ir[lane] : -1.f; v1[qq] = (lane + 64 <= cur - 2) ? ir[lane + 64] : -1.f;
                k0[qq] = 1u; k1[qq] = 0u; k2[qq] = 0u; k3[qq] = 0u; }
            for (int it = 0; it < 13; ++it) {
                float bv[8]; int bs[8];
#pragma unroll
                for (int qq = 0; qq < 8; ++qq) { bv[qq] = v0[qq]; bs[qq] = lane; if (v1[qq] > v0[qq]) { bv[qq] = v1[qq]; bs[qq] = lane + 64; } }
#pragma unroll
                for (int off = 1; off < 64; off <<= 1) {
#pragma unroll
                    for (int qq = 0; qq < 8; ++qq) { const float ov = __shfl_xor(bv[qq], off); const int os = __shfl_xor(bs[qq], off);
                        if (ov > bv[qq] || (ov == bv[qq] && os < bs[qq])) { bv[qq] = ov; bs[qq] = os; } } }
#pragma unroll
                for (int qq = 0; qq < 8; ++qq) { const int b_ = __builtin_amdgcn_readfirstlane(bs[qq]);
                    if (b_ == lane) v0[qq] = -1.f; if (b_ == lane + 64) v1[qq] = -1.f;
                    const unsigned bit = 1u << (b_ & 31);
                    if (b_ < 32) k0[qq] |= bit; else if (b_ < 64) k1[qq] |= bit; else if (b_ < 96) k2[qq] |= bit; else k3[qq] |= bit; }
            }
            { const int c1 = cur - 1; const unsigned b1 = 1u << (c1 & 31), b2 = 1u << (cur & 31);
#pragma unroll
              for (int qq = 0; qq < 8; ++qq) {
                if (c1 < 32) k0[qq] |= b1; else if (c1 < 64) k1[qq] |= b1; else if (c1 < 96) k2[qq] |= b1; else k3[qq] |= b1;
                if (cur < 32) k0[qq] |= b2; else if (cur < 64) k1[qq] |= b2; else if (cur < 96) k2[qq] |= b2; else k3[qq] |= b2; } }
        }
#pragma unroll
        for (int qq = 0; qq < 8; ++qq) {
            if (lane == 0) { unsigned* sp = selw + (8 * w + qq) * 4; sp[0] = k0[qq]; sp[1] = k1[qq]; sp[2] = k2[qq]; sp[3] = k3[qq]; }
            u0 |= k0[qq]; u1 |= k1[qq]; u2 |= k2[qq]; u3 |= k3[qq]; }
        if (lane == 0) { atomicOr(um + 0, u0); atomicOr(um + 1, u1); atomicOr(um + 2, u2); atomicOr(um + 3, u3); }
    }
    __syncthreads();
    {
        const unsigned U0 = um[0], U1 = um[1], U2 = um[2], U3 = um[3];
        const unsigned* sp = selw + ql * 4; const unsigned s0 = sp[0], s1 = sp[1], s2 = sp[2], s3 = sp[3];
        const Branch br{a.ks + (size_t)bg * T_ * 64, a.vst + (size_t)bg * 64 * T_, T_};
        float m = 0.f, l = 0.f;
#pragma unroll
        for (int r = 0; r < 16; ++r) { o[0][r] = 0.f; o[1][r] = 0.f; }
        run_branch<2, true>(sm, br, __builtin_amdgcn_readfirstlane(U0), __builtin_amdgcn_readfirstlane(U1), __builtin_amdgcn_readfirstlane(U2), __builtin_amdgcn_readfirstlane(U3),
                            qf, 0, t, 0, tw0, s0, s1, s2, s3, m, l, 0.f, o, nullptr, wsc, tid, lane);
        l += __shfl_xor(l, 32);
        add_scaled<false>(accw, o, gs / fmaxf(l, 1e-30f), wsc, i, hi, lane);
    }
    {
        const int j0 = cur - 8 > 0 ? cur - 8 : 0;
        unsigned wm0 = 0u, wm1 = 0u, wm2 = 0u, wm3 = 0u;
#pragma unroll
        for (int wd = 0; wd < 4; ++wd) { const int a0 = j0 - 32 * wd, a1 = cur + 1 - 32 * wd;
            const unsigned hi_m = a1 >= 32 ? ~0u : (a1 <= 0 ? 0u : ((1u << a1) - 1u)), lo_m = a0 >= 32 ? ~0u : (a0 <= 0 ? 0u : ((1u << a0) - 1u));
            const unsigned x = hi_m & ~lo_m; if (wd == 0) wm0 = x; else if (wd == 1) wm1 = x; else if (wd == 2) wm2 = x; else wm3 = x; }
        const Branch br{a.kw + (size_t)bg * T_ * 64, a.vwt + (size_t)bg * 64 * T_, T_};
        float m = 0.f, l = 0.f;
#pragma unroll
        for (int r = 0; r < 16; ++r) { o[0][r] = 0.f; o[1][r] = 0.f; }
        run_branch<2, false>(sm, br, wm0, wm1, wm2, wm3, qf, t - 511, t, tw1 - 511, tw0, 0u, 0u, 0u, 0u, m, l, 0.f, o, nullptr, wsc, tid, lane);
        l += __shfl_xor(l, 32);
        add_scaled<false>(accw, o, gw / fmaxf(l, 1e-30f), wsc, i, hi, lane);
    }
#pragma unroll
    for (int r = 0; r < 16; ++r) { const int rw = crow(r, hi), qq = 8 * w + (rw >> 2), hh = rw & 3;
        bf16* op = a.amix + ((size_t)b * T_ + q0 + qq) * DM + g * 256 + hh * 64 + i;
        op[0] = (bf16)f2bf(accw[r * 64 + lane]); op[32] = (bf16)f2bf(accw[(16 + r) * 64 + lane]); }
}
__device__ __forceinline__ void phase(const NsaArgs& a, unsigned* ctr, unsigned char* sm) {
    int* slot = (int*)(sm + OFF_UNIT);
    for (;;) {
        if (tidx() == 0) *slot = (int)atomicAdd(ctr, 1u);
        __syncthreads();
        const int u = *slot;
        __syncthreads();
        if (u >= 512) break;
        unit(a, u, sm);
    }
}
}

__device__ __forceinline__ void d_lora_prep(const bf16* pr, const float* mu, bf16* la, int wg0 = 0) {
    if ((int)blockIdx.x < wg0) return;
    const int T512 = tidx(), c = T512 & 255;
    const float m = mu[1536 + c];
    for (int vb = ((int)blockIdx.x - wg0) * 2 + (T512 >> 8); vb < M_ / 4; vb += ((int)gridDim.x - wg0) * 2) {
        const int row0 = vb * 4;
        float x[5];
        x[0] = (row0 % T_) ? bf2f(pr[(size_t)(row0 - 1) * 256 + c]) : 0.f;
#pragma unroll
        for (int j = 0; j < 4; ++j) x[j + 1] = bf2f(pr[(size_t)(row0 + j) * 256 + c]);
#pragma unroll
        for (int j = 0; j < 4; ++j) { const float xs = x[j + 1] + (x[j] - x[j + 1]) * m;
            const float v = c < 64 ? tanhf(xs) : (c < 128 ? xs : sigmoidf_(xs));
            la[(size_t)(row0 + j) * KLORA + c] = (bf16)f2bf(v); }
    }
}

namespace rw7 {
using nsa::f32x16; using nsa::crow; using nsa::pack8;
constexpr int NHELP = 2, RG = 18;
constexpr int NPROD = 6, RING = 7, RA = 144, RB = 40, S_AT = 0, S_RT = 16 * RA, S_BT = 32 * RA, S_KT = S_BT + 64 * RB, S_VT = S_KT + 64 * RB, S_SM = S_VT + 64 * RB, SMM = 16 * RB, S_GC = S_SM + 4 * SMM, SLOT = S_GC + 256;
constexpr int OFF_SCR = RING * SLOT, SCR = 32 * RA, LDS_NEED = OFF_SCR;
static_assert(NPROD % NHELP == 0 && LDS_NEED <= 147456 - 64 && 7 * (SLOT + SCR) <= 147456 - 64 && (size_t)16 * NHELP * RG * SLOT <= (size_t)9 << 20 && SLOT % 16 == 0 && S_BT % 16 == 0 && 128 * RB >= 4096 && SCR >= 4096, "rw7 lds map");
struct Args { const unsigned* rkw; const bf16* vv; const bf16* aga; const float* wdec; const float *mu, *kk, *ka, *rk; float* yraw; float* bonus; unsigned char* ring; unsigned* flags; unsigned* cons; };
__device__ __forceinline__ void wg_bar() { asm volatile("s_waitcnt lgkmcnt(0)" ::: "memory"); __builtin_amdgcn_s_barrier(); asm volatile("" ::: "memory"); }
struct Chan { float mur, muk, muv, kkc, kac, rkc; };
struct Raw { unsigned rk[16]; unsigned short v[16], al[16]; float w[16]; unsigned prk; unsigned short pv; };
__device__ __forceinline__ void fetch(const Args& a, int b, int h, int c, int lane, Raw& q) {
    const size_t base = ((size_t)b * T_ + (size_t)c * 16) * 512 + h * 64 + lane;
#pragma unroll
    for (int t = 0; t < 16; ++t) { q.rk[t] = a.rkw[base + (size_t)t * 512]; q.v[t] = a.vv[base + (size_t)t * 512]; q.al[t] = a.aga[base + (size_t)t * 512]; q.w[t] = a.wdec[base + (size_t)t * 512]; }
    q.prk = 0u; q.pv = 0;
    if (c > 0) { q.prk = a.rkw[base - 512]; q.pv = a.vv[base - 512]; }
}
__device__ __forceinline__ void st_row40(unsigned char* p, const unsigned (&w)[8]) {
    *(u32x2*)p = (u32x2){w[0], w[1]}; *(u32x2*)(p + 8) = (u32x2){w[2], w[3]}; *(u32x2*)(p + 16) = (u32x2){w[4], w[5]}; *(u32x2*)(p + 24) = (u32x2){w[6], w[7]};
}
template <bool BAR> __device__ __forceinline__ void seg_end() { if (BAR) wg_bar(); else { asm volatile("s_waitcnt lgkmcnt(0)" ::: "memory"); __builtin_amdgcn_sched_barrier(0); } }
template <bool BAR> __device__ __forceinline__ void produce(const Args& a, const Chan& ch, int b, int h, int c, const Raw& q, unsigned char* slot, unsigned char* scr, int lane) {
    const int i = lane & 31, hi = lane >> 5;
    const size_t row0 = (size_t)b * T_ + (size_t)c * 16;
    float pr_r = __builtin_bit_cast(float, q.prk << 16), pr_k = __builtin_bit_cast(float, q.prk & 0xffff0000u), pr_v = bf2f(q.pv);
    float rr[16], kq[16], kt[16];
    float* RED1 = (float*)scr;
    float* RED2 = (float*)(slot + S_BT);
#pragma unroll
    for (int t4 = 0; t4 < 4; ++t4) { f32x4 e1, e2;
#pragma unroll
        for (int e = 0; e < 4; ++e) { const int t = 4 * t4 + e;
            const float r0 = __builtin_bit_cast(float, q.rk[t] << 16), k0 = __builtin_bit_cast(float, q.rk[t] & 0xffff0000u), al = bf2f(q.al[t]);
            const float r = r0 + (pr_r - r0) * ch.mur, k = k0 + (pr_k - k0) * ch.muk;
            pr_r = r0; pr_k = k0;
            rr[t] = r; kq[t] = k * ch.kkc; kt[t] = k * (1.f + (al - 1.f) * ch.kac);
            e1[e] = kq[t] * kq[t]; e2[e] = r * kt[t] * ch.rkc; }
        *(f32x4*)(RED1 + lane * 16 + 4 * t4) = e1; *(f32x4*)(RED2 + lane * 16 + 4 * t4) = e2; }
    seg_end<BAR>();
    { const int t = lane & 15, part = lane >> 4; float s1 = 0.f, s2 = 0.f;
#pragma unroll
      for (int j = 0; j < 16; ++j) { s1 += RED1[(part * 16 + j) * 16 + t]; s2 += RED2[(part * 16 + j) * 16 + t]; }
      s1 += __shfl_xor(s1, 16); s2 += __shfl_xor(s2, 16); s1 += __shfl_xor(s1, 32); s2 += __shfl_xor(s2, 32);
      asm volatile("s_waitcnt lgkmcnt(0)" ::: "memory");
      if (lane < 16) { ((float*)(slot + S_GC))[lane] = s1; a.bonus[(row0 + lane) * 8 + h] = s2; } }
    asm volatile("s_waitcnt lgkmcnt(0)" ::: "memory");
    f32x4 n2[4];
#pragma unroll
    for (int t4 = 0; t4 < 4; ++t4) n2[t4] = *(const f32x4*)(slot + S_GC + 16 * t4);
    asm volatile("s_waitcnt lgkmcnt(0)" ::: "memory");
    float gam = 1.f;
    unsigned btp[8], ktp[8], vtp[8];
    float b_ev = 0.f, k_ev = 0.f, v_ev = 0.f;
#pragma unroll
    for (int t = 0; t < 16; ++t) {
        if (t == 6) seg_end<BAR>();
        const float v0 = bf2f(q.v[t]), al = bf2f(q.al[t]);
        const float v = v0 + (pr_v - v0) * ch.muv; pr_v = v0;
        const float kkn = kq[t] * __builtin_amdgcn_rsqf(fmaxf(n2[t >> 2][t & 3], 1e-24f));
        const float gp = gam; gam *= q.w[t]; const float ig = __builtin_amdgcn_rcpf(gam);
        const float bt_ = kkn * al * ig, kt_ = kt[t] * ig;
        const unsigned ar = pk2(-kkn * gp, rr[t] * gam), bk = pk2(bt_, kt_);
        *(bf16*)(slot + S_AT + t * RA + lane * 2) = (bf16)(ar & 0xffffu); *(bf16*)(slot + S_RT + t * RA + lane * 2) = (bf16)(ar >> 16);
        *(bf16*)(scr + t * RA + lane * 2) = (bf16)(bk & 0xffffu); *(bf16*)(scr + (16 + t) * RA + lane * 2) = (bf16)(bk >> 16);
        if (t & 1) { btp[t >> 1] = pk2(b_ev, bt_); ktp[t >> 1] = pk2(k_ev, kt_); vtp[t >> 1] = pk2(v_ev, v); }
        else { b_ev = bt_; k_ev = kt_; v_ev = v; }
    }
    st_row40(slot + S_BT + lane * RB, btp); st_row40(slot + S_KT + lane * RB, ktp); st_row40(slot + S_VT + lane * RB, vtp);
    ((float*)(slot + S_GC))[lane] = gam;
    seg_end<BAR>();
    f32x16 C;
#pragma unroll
    for (int r = 0; r < 16; ++r) C[r] = 0.f;
#pragma unroll
    for (int ks = 0; ks < 4; ++ks) {
        const bf16x8 af = *(const bf16x8*)(slot + S_AT + i * RA + (16 * ks + 8 * hi) * 2);
        const bf16x8 bf = *(const bf16x8*)(scr + i * RA + (16 * ks + 8 * hi) * 2);
        C = __builtin_amdgcn_mfma_f32_32x32x16_bf16(af, bf, C, 0, 0, 0);
    }
    asm volatile("s_waitcnt lgkmcnt(0)" ::: "memory");
    float* AAB = (float*)scr;
    unsigned char* SM = slot + S_SM;
#pragma unroll
    for (int r = 0; r < 16; ++r) {
        const int rho = crow(r, hi); const float val = C[r];
        if (r < 8) {
            if (i < 16) AAB[rho * 16 + i] = (i < rho) ? val : 0.f;
            else *(bf16*)(SM + SMM + rho * RB + (i - 16) * 2) = (bf16)f2bf((i - 16 < rho) ? val : 0.f);
        } else {
            const int tt = rho - 16;
            if (i < 16) *(bf16*)(SM + 2 * SMM + tt * RB + i * 2) = (bf16)f2bf((i <= tt) ? val : 0.f);
            else *(bf16*)(SM + 3 * SMM + tt * RB + (i - 16) * 2) = (bf16)f2bf((i - 16 <= tt) ? val : 0.f);
        }
    }
    seg_end<BAR>();
    { const int j = lane & 15; float Tr[16];
#pragma unroll
      for (int t = 0; t < 16; ++t) { if (t == 11) seg_end<BAR>();
          float acc = (t == j) ? 1.f : 0.f;
#pragma unroll
          for (int s4 = 0; s4 < (t + 3) / 4; ++s4) { const f32x4 ar = *(const f32x4*)(AAB + t * 16 + 4 * s4);
#pragma unroll
              for (int e = 0; e < 4; ++e) if (4 * s4 + e < t) acc += ar[e] * Tr[4 * s4 + e]; }
          Tr[t] = acc;
          if (lane < 16) *(bf16*)(SM + t * RB + j * 2) = (bf16)f2bf(acc); } }
    seg_end<BAR>();
}

__device__ __forceinline__ bf16x8 rd_perm(const unsigned char* p, int hi) {
    const u32x2 a = *(const u32x2*)(p + 8 * hi), b = *(const u32x2*)(p + 16 + 8 * hi);
    return __builtin_bit_cast(bf16x8, (u32x4){a.x, a.y, b.x, b.y});
}
__device__ __forceinline__ bf16x8 rd_nat(const unsigned char* p, int hi) {
    const u32x2 a = *(const u32x2*)(p + 16 * hi), b = *(const u32x2*)(p + 16 * hi + 8);
    return __builtin_bit_cast(bf16x8, (u32x4){a.x, a.y, b.x, b.y});
}
__device__ __forceinline__ bf16x8 and8(bf16x8 f, unsigned m) { u32x4 w = __builtin_bit_cast(u32x4, f); w.x &= m; w.y &= m; w.z &= m; w.w &= m; return __builtin_bit_cast(bf16x8, w); }
__device__ __forceinline__ void consume(const unsigned char* slot, f32x16 (&z)[2], float* yout, int vt, int lane) {
    const int i = lane & 31, hi = lane >> 5, i16 = i & 15;
    const unsigned m16 = i < 16 ? 0xffffffffu : 0u;
    const unsigned char* at = slot + S_AT + i16 * RA; const unsigned char* rt = slot + S_RT + i16 * RA; const unsigned char* sm16 = slot + S_SM + i16 * RB;
    bf16x8 fa0 = rd_perm(at, hi), fa1 = rd_perm(at + 32, hi), fa2 = rd_perm(at + 64, hi), fa3 = rd_perm(at + 96, hi);
    bf16x8 fak = rd_nat(sm16 + SMM, hi), ft = rd_perm(sm16, hi);
    const bf16x8 vtf = rd_nat(slot + S_VT + (32 * vt + i) * RB, hi);
    bf16x8 fr0 = rd_perm(rt, hi), fr1 = rd_perm(rt + 32, hi), fr2 = rd_perm(rt + 64, hi), fr3 = rd_perm(rt + 96, hi);
    bf16x8 frb = rd_perm(sm16 + 2 * SMM, hi), frk = rd_nat(sm16 + 3 * SMM, hi);
    const bf16x8 fk0 = rd_nat(slot + S_KT + i * RB, hi), fk1 = rd_nat(slot + S_KT + (32 + i) * RB, hi);
    const bf16x8 fb0 = rd_perm(slot + S_BT + i * RB, hi), fb1 = rd_perm(slot + S_BT + (32 + i) * RB, hi);
    f32x4 g4[2][4];
#pragma unroll
    for (int kt = 0; kt < 2; ++kt)
#pragma unroll
        for (int rg = 0; rg < 4; ++rg) g4[kt][rg] = *(const f32x4*)(slot + S_GC + (32 * kt + 8 * rg + 4 * hi) * 4);
    const bf16x8 zb0 = pack8(z[0], 0), zb1 = pack8(z[0], 8), zb2 = pack8(z[1], 0), zb3 = pack8(z[1], 8);
    fa0 = and8(fa0, m16); fa1 = and8(fa1, m16); fa2 = and8(fa2, m16); fa3 = and8(fa3, m16); fak = and8(fak, m16); ft = and8(ft, m16);
    fr0 = and8(fr0, m16); fr1 = and8(fr1, m16); fr2 = and8(fr2, m16); fr3 = and8(fr3, m16); frb = and8(frb, m16); frk = and8(frk, m16);
    f32x16 X, U, Y;
#pragma unroll
    for (int r = 0; r < 16; ++r) { X[r] = 0.f; U[r] = 0.f; Y[r] = 0.f; }
    X = __builtin_amdgcn_mfma_f32_32x32x16_bf16(fa0, zb0, X, 0, 0, 0);
    X = __builtin_amdgcn_mfma_f32_32x32x16_bf16(fa1, zb1, X, 0, 0, 0);
    X = __builtin_amdgcn_mfma_f32_32x32x16_bf16(fa2, zb2, X, 0, 0, 0);
    X = __builtin_amdgcn_mfma_f32_32x32x16_bf16(fa3, zb3, X, 0, 0, 0);
    X = __builtin_amdgcn_mfma_f32_32x32x16_bf16(fak, vtf, X, 0, 0, 0);
    Y = __builtin_amdgcn_mfma_f32_32x32x16_bf16(fr0, zb0, Y, 0, 0, 0);
    Y = __builtin_amdgcn_mfma_f32_32x32x16_bf16(fr1, zb1, Y, 0, 0, 0);
    Y = __builtin_amdgcn_mfma_f32_32x32x16_bf16(fr2, zb2, Y, 0, 0, 0);
    Y = __builtin_amdgcn_mfma_f32_32x32x16_bf16(fr3, zb3, Y, 0, 0, 0);
    Y = __builtin_amdgcn_mfma_f32_32x32x16_bf16(frk, vtf, Y, 0, 0, 0);
    z[0] = __builtin_amdgcn_mfma_f32_32x32x16_bf16(fk0, vtf, z[0], 0, 0, 0);
    z[1] = __builtin_amdgcn_mfma_f32_32x32x16_bf16(fk1, vtf, z[1], 0, 0, 0);
    const bf16x8 xb = pack8(X, 0);
    U = __builtin_amdgcn_mfma_f32_32x32x16_bf16(ft, xb, U, 0, 0, 0);
    const bf16x8 ub = pack8(U, 0);
    z[0] = __builtin_amdgcn_mfma_f32_32x32x16_bf16(fb0, ub, z[0], 0, 0, 0);
    z[1] = __builtin_amdgcn_mfma_f32_32x32x16_bf16(fb1, ub, z[1], 0, 0, 0);
    Y = __builtin_amdgcn_mfma_f32_32x32x16_bf16(frb, ub, Y, 0, 0, 0);
#pragma unroll
    for (int kt = 0; kt < 2; ++kt)
#pragma unroll
        for (int rg = 0; rg < 4; ++rg)
#pragma unroll
            for (int e = 0; e < 4; ++e) z[kt][4 * rg + e] *= g4[kt][rg][e];
#pragma unroll
    for (int r = 0; r < 8; ++r) yout[(size_t)crow(r, hi) * 512] = Y[r];
}

__device__ __forceinline__ unsigned ld_relaxed(const unsigned* p) { return __hip_atomic_load(p, __ATOMIC_RELAXED, __HIP_MEMORY_SCOPE_AGENT); }
__device__ __forceinline__ void head(const Args& a, int bh, unsigned char* sm) {
    const int tid = tidx(), lane = tid & 63, w = __builtin_amdgcn_readfirstlane(tid >> 6);
    const int b = bh >> 3, h = bh & 7;
    constexpr int NCH = T_ / 16, NBAR = NCH + NPROD;
    if (w < 2) {
        f32x16 z[2];
#pragma unroll
        for (int r = 0; r < 16; ++r) { z[0][r] = 0.f; z[1][r] = 0.f; }
        for (int i = 0; i < NPROD; ++i) wg_bar();
        for (int c = 0; c < NCH; ++c) {
            consume(sm + (size_t)(c % RING) * SLOT, z, a.yraw + ((size_t)b * T_ + (size_t)c * 16) * 512 + h * 64 + 32 * w + (lane & 31), w, lane);
            if (w == 0 && (c & 7) == 7 && lane == 0) __hip_atomic_store(a.cons + bh * 64, (unsigned)(c + 1), __ATOMIC_RELAXED, __HIP_MEMORY_SCOPE_AGENT);
            wg_bar();
        }
    } else {
        const int pw = w - 2;
        int nb = pw;
        {
            u32x4 v[15];
            { const int c = pw; const int hl = c % NHELP, n = c / NHELP;
              const unsigned char* g = a.ring + ((size_t)(bh * NHELP + hl) * RG + (n % RG)) * SLOT;
              while (__builtin_amdgcn_readfirstlane(ld_relaxed(a.flags + bh * NCH + c)) == 0u) __builtin_amdgcn_s_sleep(2);
              __builtin_amdgcn_fence(__ATOMIC_ACQUIRE, "agent");
              asm volatile("s_waitcnt vmcnt(0)" ::: "memory");
#pragma unroll
              for (int i = 0; i < 15; ++i) { const int off = (i * 64 + lane) * 16; if (off < SLOT) v[i] = *(const u32x4*)(g + off); } }
            for (int i = 0; i < pw; ++i) wg_bar();
            for (int c = pw; c < NCH; c += NPROD) {
                unsigned char* slot = sm + (size_t)(c % RING) * SLOT;
#pragma unroll
                for (int i = 0; i < 15; ++i) { const int off = (i * 64 + lane) * 16; if (off < SLOT) *(u32x4*)(slot + off) = v[i]; }
                const int cn = c + NPROD; const bool more = cn < NCH;
                const unsigned* fp = a.flags + bh * NCH + (more ? cn : c);
                unsigned fl = ld_relaxed(fp);
                wg_bar(); wg_bar();
                if (more) {
                    while (__builtin_amdgcn_readfirstlane(fl) == 0u) { __builtin_amdgcn_s_sleep(2); fl = ld_relaxed(fp); }
                    __builtin_amdgcn_fence(__ATOMIC_ACQUIRE, "agent");
                    asm volatile("s_waitcnt vmcnt(0)" ::: "memory");
                    const int hl = cn % NHELP, n = cn / NHELP;
                    const unsigned char* g = a.ring + ((size_t)(bh * NHELP + hl) * RG + (n % RG)) * SLOT;
#pragma unroll
                    for (int i = 0; i < 15; ++i) { const int off = (i * 64 + lane) * 16; if (off < SLOT) v[i] = *(const u32x4*)(g + off); }
                }
                wg_bar(); wg_bar(); wg_bar(); wg_bar();
                nb += NPROD;
            }
        }
        for (; nb < NBAR; ++nb) wg_bar();
    }
}
constexpr int NHW = 7;
__device__ __forceinline__ void helper(const Args& a, int bh, int hl, unsigned char* sm) {
    const int tid = tidx(), lane = tid & 63, w = __builtin_amdgcn_readfirstlane(tid >> 6);
    if (w >= NHW) return;
    const int b = bh >> 3, h = bh & 7, col = h * 64 + lane;
    constexpr int NCH = T_ / 16;
    unsigned char* slot = sm + (size_t)w * SLOT; unsigned char* scr = sm + NHW * SLOT + w * SCR;
    const Chan ch{a.mu[col], a.mu[512 + col], a.mu[1024 + col], a.kk[col], a.ka[col], a.rk[col]};
    int n = w, c = NHELP * n + hl;
    if (c >= NCH) return;
    for (; c < NCH; n += NHW, c += NHW * NHELP) {
        Raw q; fetch(a, b, h, c, lane, q);
        if (n >= RG) { const unsigned need = (unsigned)(c - RG * NHELP + 1);
            while (__builtin_amdgcn_readfirstlane(ld_relaxed(a.cons + bh * 64)) < need) __builtin_amdgcn_s_sleep(8); }
        produce<false>(a, ch, b, h, c, q, slot, scr, lane);
        asm volatile("s_waitcnt lgkmcnt(0)" ::: "memory");
        unsigned char* g = a.ring + ((size_t)(bh * NHELP + hl) * RG + (n % RG)) * SLOT;
#pragma unroll
        for (int i = 0; i < 15; ++i) { const int off = (i * 64 + lane) * 16;
            if (off < SLOT) { const u32x4 d = *(const u32x4*)(slot + off); unsigned char* gp = g + off; asm volatile("global_store_dwordx4 %0, %1, off sc1\n\ts_nop 1" :: "v"(gp), "v"(d) : "memory"); } }
        asm volatile("s_waitcnt vmcnt(0)" ::: "memory");
        if (lane == 0) __hip_atomic_store(a.flags + bh * NCH + c, 1u, __ATOMIC_RELAXED, __HIP_MEMORY_SCOPE_AGENT);
    }
}
__device__ __forceinline__ void finish(const float* yraw, const float* bonus, const bf16* vv, const bf16* agg, const float* mu, const float* gng, const float* gnb, bf16* amix) {
    const int T512 = tidx(), lane = T512 & 63;
    for (int it0 = (blockIdx.x * 8 + (T512 >> 6)) * 4; it0 < M_ * 8; it0 += gridDim.x * 8 * 4) {
        const int row = it0 >> 3, h0 = it0 & 7, t = row % T_;
        float y[4], v0[4], v1[4], gg[4], bo[4];
#pragma unroll
        for (int j = 0; j < 4; ++j) { const int col = (h0 + j) * 64 + lane;
            y[j] = yraw[(size_t)row * 512 + col]; v0[j] = bf2f(vv[(size_t)row * 512 + col]); v1[j] = t ? bf2f(vv[(size_t)(row - 1) * 512 + col]) : 0.f;
            gg[j] = bf2f(agg[(size_t)row * 512 + col]); bo[j] = bonus[(size_t)row * 8 + h0 + j]; }
        float mean[4], var[4];
#pragma unroll
        for (int j = 0; j < 4; ++j) mean[j] = y[j];
#pragma unroll
        for (int o = 1; o < 64; o <<= 1) {
#pragma unroll
            for (int j = 0; j < 4; ++j) mean[j] += __shfl_xor(mean[j], o); }
#pragma unroll
        for (int j = 0; j < 4; ++j) { mean[j] *= (1.f / 64.f); y[j] -= mean[j]; var[j] = y[j] * y[j]; }
#pragma unroll
        for (int o = 1; o < 64; o <<= 1) {
#pragma unroll
            for (int j = 0; j < 4; ++j) var[j] += __shfl_xor(var[j], o); }
#pragma unroll
        for (int j = 0; j < 4; ++j) { const int col = (h0 + j) * 64 + lane;
            const float yn = y[j] * rsqrtf(var[j] * (1.f / 64.f) + 64e-5f) * gng[col] + gnb[col];
            const float v = v0[j] + (v1[j] - v0[j]) * mu[1024 + col];
            amix[(size_t)row * DM + 512 + col] = (bf16)f2bf((yn + bo[j] * v) * gg[j]); }
    }
}
}

namespace mema {
using nsa::f32x16; using nsa::KROW; using nsa::VROW; using nsa::KBUF; using nsa::VBUF; using nsa::OFF_K; using nsa::OFF_V; using nsa::OFF_WS; using nsa::crow; using nsa::pack8;
__device__ __forceinline__ void unit(const bf16* qm, const bf16* mk, const bf16* mvt, bf16* om, int u, unsigned char* sm) {
    const int tid = tidx(), lane = tid & 63, w = __builtin_amdgcn_readfirstlane(tid >> 6), i = lane & 31, hi = lane >> 5;
    const int b = u >> 7, h = (u >> 5) & 3, rb = u & 31;
    const int row0 = b * T_ + rb * 256 + 32 * w;
    const bf16* qrow = qm + (size_t)(row0 + i) * DM + h * 256 + 8 * hi;
    const bf16* kbase = mk + (size_t)(b * 256 + (tid >> 3)) * DM + h * 256 + (tid & 7) * 8;
    const bf16* vbase = mvt + (size_t)(h * 256 + (tid >> 3)) * 512 + b * 256 + (tid & 7) * 8;
    unsigned char* kst = sm + OFF_K + (tid >> 3) * KROW + (tid & 7) * 16;
    unsigned char* vst = sm + OFF_V + (tid >> 3) * VROW + (tid & 7) * 16;
    float* wsc = (float*)(sm + OFF_WS) + w * 32;
    f32x16 p[4][2];
#pragma unroll
    for (int kt = 0; kt < 4; ++kt)
#pragma unroll
        for (int r = 0; r < 16; ++r) { p[kt][0][r] = 0.f; p[kt][1][r] = 0.f; }
    u32x4 tr[4];
#define MEMA_SRC(n) ((n) < 16 ? (const u32x4*)(kbase + (size_t)(64 * ((n) & 3)) * DM + 64 * ((n) >> 2)) : (const u32x4*)(vbase + (size_t)(64 * (((n) - 16) >> 2)) * 512 + 64 * ((n) & 3)))
#define MEMA_PUT(n) do { if ((n) < 16) *(u32x4*)(kst + ((n) & 1) * KBUF) = tr[(n) & 3]; else { unsigned char* vp2_ = vst + ((n) & 1) * VBUF; *(u32x2*)vp2_ = (u32x2){tr[(n) & 3].x, tr[(n) & 3].y}; *(u32x2*)(vp2_ + 8) = (u32x2){tr[(n) & 3].z, tr[(n) & 3].w}; } } while (0)
    tr[0] = *MEMA_SRC(0); tr[1] = *MEMA_SRC(1); tr[2] = *MEMA_SRC(2);
    MEMA_PUT(0);
    __syncthreads();
    bf16x8 qf[4];
#pragma unroll
    for (int n = 0; n < 16; ++n) {
        const int dc = n >> 2, kt = n & 3, cb = n & 1;
        tr[(n + 3) & 3] = *MEMA_SRC(n + 3);
        if (kt == 0) {
#pragma unroll
            for (int d0 = 0; d0 < 4; ++d0) qf[d0] = *(const bf16x8*)(qrow + 64 * dc + 16 * d0);
        }
        const unsigned char* kb = sm + OFF_K + cb * KBUF;
#pragma unroll
        for (int d0 = 0; d0 < 4; ++d0) {
            const bf16x8 a0 = *(const bf16x8*)(kb + i * KROW + (16 * d0 + 8 * hi) * 2);
            const bf16x8 a1 = *(const bf16x8*)(kb + (32 + i) * KROW + (16 * d0 + 8 * hi) * 2);
            p[kt][0] = __builtin_amdgcn_mfma_f32_32x32x16_bf16(a0, qf[d0], p[kt][0], 0, 0, 0);
            p[kt][1] = __builtin_amdgcn_mfma_f32_32x32x16_bf16(a1, qf[d0], p[kt][1], 0, 0, 0);
        }
        MEMA_PUT(n + 1);
        __syncthreads();
    }
    float mx = p[0][0][0];
#pragma unroll
    for (int kt = 0; kt < 4; ++kt)
#pragma unroll
        for (int r = 0; r < 16; ++r) mx = fmaxf(mx, fmaxf(p[kt][0][r], p[kt][1][r]));
    mx = fmaxf(mx, __shfl_xor(mx, 32));
    float l = 0.f;
#pragma unroll
    for (int kt = 0; kt < 4; ++kt)
#pragma unroll
        for (int r = 0; r < 16; ++r) { p[kt][0][r] = __builtin_amdgcn_exp2f(p[kt][0][r] - mx); p[kt][1][r] = __builtin_amdgcn_exp2f(p[kt][1][r] - mx); l += p[kt][0][r] + p[kt][1][r]; }
    l += __shfl_xor(l, 32);
    bf16x8 pf[4][4];
#pragma unroll
    for (int kt = 0; kt < 4; ++kt) { pf[kt][0] = pack8(p[kt][0], 0); pf[kt][1] = pack8(p[kt][0], 8); pf[kt][2] = pack8(p[kt][1], 0); pf[kt][3] = pack8(p[kt][1], 8); }
    if (hi == 0) wsc[i] = 1.f / l;
    asm volatile("" ::: "memory");
    f32x4 il[4];
#pragma unroll
    for (int rg = 0; rg < 4; ++rg) il[rg] = *(const f32x4*)(wsc + 8 * rg + 4 * hi);
    f32x16 o[2];
#pragma unroll
    for (int n = 16; n < 32; ++n) {
        const int dvt = (n - 16) >> 2, kt = n & 3, cb = n & 1;
        if (n + 3 < 32) tr[(n + 3) & 3] = *MEMA_SRC(n + 3);
        if (kt == 0) {
#pragma unroll
            for (int r = 0; r < 16; ++r) { o[0][r] = 0.f; o[1][r] = 0.f; }
        }
        const unsigned char* vb = sm + OFF_V + cb * VBUF;
#pragma unroll
        for (int dt = 0; dt < 2; ++dt) {
            const unsigned char* vp = vb + (32 * dt + i) * VROW + 8 * hi;
#pragma unroll
            for (int ks = 0; ks < 4; ++ks) {
                const u32x2 v_lo = *(const u32x2*)(vp + 32 * ks), v_hi = *(const u32x2*)(vp + 32 * ks + 16);
                const bf16x8 vf = __builtin_bit_cast(bf16x8, (u32x4){v_lo.x, v_lo.y, v_hi.x, v_hi.y});
                o[dt] = __builtin_amdgcn_mfma_f32_32x32x16_bf16(pf[kt][ks], vf, o[dt], 0, 0, 0);
            }
        }
        if (kt == 3) {
#pragma unroll
            for (int r = 0; r < 16; ++r) { bf16* op = om + (size_t)(row0 + crow(r, hi)) * DM + h * 256 + 64 * dvt + i;
                op[0] = (bf16)f2bf(o[0][r] * il[r >> 2][r & 3]); op[32] = (bf16)f2bf(o[1][r] * il[r >> 2][r & 3]); }
        }
        if (n + 1 < 32) MEMA_PUT(n + 1);
        __syncthreads();
    }
#undef MEMA_SRC
#undef MEMA_PUT
}
}

#define LAS __attribute__((address_space(3)))
#define XB_TMO      128
#define XB_XCNT(j)  (256  + 64 * (j))
#define XB_XSUB(j)  (1280 + 64 * (j))
#define XB_XGEN(j)  (2304 + 64 * (j))
#define XB_TOP      3328
#define XB_TOPGEN   3392
#define XCD_BAR_WORDS 3456
#define XB_SPIN_CAP (1u << 18)

__device__ __forceinline__ unsigned xb_ld(unsigned* p)              { return __hip_atomic_load(p, __ATOMIC_RELAXED, __HIP_MEMORY_SCOPE_AGENT); }
__device__ __forceinline__ unsigned xb_add(unsigned* p, unsigned v) { return __hip_atomic_fetch_add(p, v, __ATOMIC_RELAXED, __HIP_MEMORY_SCOPE_AGENT); }
__device__ __forceinline__ unsigned xb_xcc_id() { return (unsigned)__builtin_amdgcn_s_getreg((3 << 11) | 20) & 0xFu; }
#define XB_SPIN(cond, bar) do { unsigned _sp = 0; while (cond) { __builtin_amdgcn_s_sleep(1); \
    if ((++_sp & 255u) == 0u) { if (xb_ld(&(bar)[XB_TMO])) break; if (_sp > XB_SPIN_CAP) { atomicAdd(&(bar)[XB_TMO], 1u); break; } } } } while (0)

struct XcdBarrier {
    unsigned* bar; unsigned x;
    volatile LAS unsigned* st;
};

__device__ __forceinline__ XcdBarrier xcd_barrier_post(unsigned* bar, volatile LAS unsigned* st) {
    XcdBarrier b; b.bar = bar; b.x = xb_xcc_id(); b.st = st;
    if (tidx() == 0) (void)xb_add(&bar[XB_XCNT(b.x)], 1u);
    return b;
}
__device__ __forceinline__ void xcd_barrier_complete(unsigned* bar, unsigned x, unsigned& nloc, unsigned& nx) {
    const unsigned G = gridDim.x * gridDim.y * gridDim.z;
    unsigned sum, cnt, mine, sp = 0u;
    for (;;) {
        sum = 0u; cnt = 0u; mine = 0u;
#pragma unroll
        for (unsigned j = 0; j < 16; ++j) { const unsigned c = xb_ld(&bar[XB_XCNT(j)]); sum += c; cnt += (c > 0u) ? 1u : 0u; mine = (j == x) ? c : mine; }
        if (sum == G) break;
        __builtin_amdgcn_s_sleep(1);
        if ((++sp & 255u) == 0u) { if (xb_ld(&bar[XB_TMO])) break; if (sp > XB_SPIN_CAP) { atomicAdd(&bar[XB_TMO], 1u); break; } }
    }
    nloc = mine > 0u ? mine : 1u; nx = cnt > 0u ? cnt : 1u;
}

__device__ __forceinline__ void xcd_barrier(const XcdBarrier& b) {
    asm volatile("s_waitcnt vmcnt(0)" ::: "memory");
    __syncthreads();
    if (tidx() == 0) {
        unsigned* bar = b.bar;
        __builtin_amdgcn_s_waitcnt(0);
        unsigned nloc = b.st[0], nx = b.st[1];
        if (nloc == 0u) { xcd_barrier_complete(bar, b.x, nloc, nx); b.st[0] = nloc; b.st[1] = nx; }
        const unsigned old = xb_add(&bar[XB_XSUB(b.x)], 1u);
        const unsigned gen = old / nloc;
        if (old + 1u == (gen + 1u) * nloc) {
            __builtin_amdgcn_fence(__ATOMIC_RELEASE, "agent");
            asm volatile("s_waitcnt vmcnt(0)" ::: "memory");
            const unsigned og = xb_add(&bar[XB_TOP], 1u);
            const unsigned tg = og / nx;
            if (og + 1u == (tg + 1u) * nx) xb_add(&bar[XB_TOPGEN], 1u);
            else XB_SPIN(xb_ld(&bar[XB_TOPGEN]) == tg, bar);
            __builtin_amdgcn_fence(__ATOMIC_ACQUIRE, "agent");
            xb_add(&bar[XB_XGEN(b.x)], 1u);
            asm volatile("s_waitcnt vmcnt(0)" ::: "memory");
        } else {
            XB_SPIN(xb_ld(&bar[XB_XGEN(b.x)]) == gen, bar);
            __builtin_amdgcn_fence(__ATOMIC_ACQUIRE, "agent");
            asm volatile("s_waitcnt vmcnt(0)" ::: "memory");
        }
    }
    __syncthreads();
}

constexpr int NTHREADS = 512, LDS_BYTES = 147456;
struct MegaArgs { const float* in[41]; float* out; unsigned char* ws; };
#define WSB(off) ((bf16*)(ws + (off)))
#define WSF(off) ((float*)(ws + (off)))

__global__ void __launch_bounds__(NTHREADS) mega_fwd(MegaArgs A) {
    extern __shared__ __attribute__((aligned(16))) unsigned char lds[];
    cg::grid_group grid = cg::this_grid();
    const float* const* in = A.in; unsigned char* ws = A.ws; float* out = A.out;
    if (tidx() < 2) ((volatile LAS unsigned*)(lds + LDS_BYTES - 64))[tidx()] = 0u;
    __syncthreads();
    const XcdBarrier xbar = xcd_barrier_post((unsigned*)(ws + WS_CTL) + 16384, (volatile LAS unsigned*)(lds + LDS_BYTES - 64));

    d_convert(WSB(WS_W1GU), NGU, DM, MapGU{in[I_F1_WG], in[I_F1_WU], FF});
    d_convert(WSB(WS_W1D), DM, FF, MapPlain{in[I_F1_WD], DM});
    d_convert(WSB(WS_WIN), NWIN, DM, MapWin{in[I_WIN], IN_COLS});
    d_convert(WSB(WS_CW1K), 256, 2048, MapPlain{in[I_W1_K], 256});
    d_convert(WSB(WS_CW1V), 256, 2048, MapPlain{in[I_W1_V], 256});
    d_convert_lora(WSB(WS_WLORA), in[I_W2], in[I_A2], in[I_G2]);
    d_convert(WSB(WS_CW2), 64, 256, MapPlain{in[I_W2_K], 64});
    d_convert(WSB(WS_CW2) + 64 * 256, 64, 256, MapPlain{in[I_W2_V], 64});
    d_rope_table(WSF(WS_ROPE));
    d_cmp_bias(in[I_PE_K], in[I_W1_K], in[I_PE_V], in[I_W1_V], WSF(WS_CBIAS), (float*)lds);
    d_rownorm(in[I_X], in[I_F1_PRE], WSB(WS_XN), M_);
    d_rownorm(in[I_MEM], in[I_MEM_KVG], WSB(WS_MEMN), 512);
    grid.sync();
    gemm_pg8(lds, WSB(WS_XN), DM, WSB(WS_W1GU), DM, M_, NGU, DM, EpiSwiGLU{WSB(WS_HB)});
    xcd_barrier(xbar);
    gemm_norm_res(lds, WSB(WS_HB), FF, WSB(WS_W1D), FF, in[I_X], out, WSB(WS_XN), in[I_F1_POST], in[I_MIX_PRE], 0.5f, WSB(WS_YB), (unsigned*)(ws + WS_GATES), (unsigned*)(ws + WS_CTL) + 1024 + 0 * 2048);
    xcd_barrier(xbar);
    gemm_pg8(lds, WSB(WS_XN), DM, WSB(WS_WIN), DM, M_, 3072, DM,
             EpiWin{WSB(WS_QB), WSB(WS_KS), WSB(WS_KW), WSB(WS_KCR), WSB(WS_VCR), WSB(WS_VST), WSB(WS_VWT), (unsigned*)(ws + WS_RKVA), WSB(WS_RKVA + 32 * MiB), WSB(WS_PRL), WSF(WS_GATES), WSF(WS_ROPE)});
    d_gates(WSB(WS_XN), WSB(WS_WIN) + (size_t)3072 * DM, WSF(WS_GATES));
    xcd_barrier(xbar);
    gemm_pg8(lds, WSB(WS_KCR), 1024, WSB(WS_CW1K), 2048, 2048, 256, 2048, EpiBiasSilu{WSB(WS_HIDK), WSF(WS_CBIAS)});
    gemm_pg8(lds, WSB(WS_VCR), 1024, WSB(WS_CW1V), 2048, 2048, 256, 2048, EpiBiasSilu{WSB(WS_HIDV), WSF(WS_CBIAS) + 256}, 8);
    d_lora_prep(WSB(WS_PRL), in[I_MU], WSB(WS_XN), 16);
    d_convert(WSB(WS_W2GU), NGU, DM, MapGU{in[I_F2_WG], in[I_F2_WU], FF}, 16);
    d_convert(WSB(WS_W2D), DM, FF, MapPlain{in[I_F2_WD], DM}, 16);
    d_convert(WSB(WS_WOUT), DM, DM, MapPlain{in[I_WOUT], DM}, 16);
    d_convert(WSB(WS_WQ), DM, DM, MapPlain{in[I_WQ], DM}, 16);
    d_convert(WSB(WS_WK), DM, DM, MapPlain{in[I_WK], DM}, 16);
    d_convert(WSB(WS_WV), DM, DM, MapPlain{in[I_WV], DM}, 16);
    d_convert(WSB(WS_WO), DM, DM, MapPlain{in[I_WO], DM}, 16);
    xcd_barrier(xbar);
    d_cmp2(WSB(WS_HIDK), WSB(WS_HIDV), WSB(WS_CW2), WSF(WS_ROPE), WSB(WS_KC), WSB(WS_VCT));
    gemm_pg8(lds, WSB(WS_XN), KLORA, WSB(WS_WLORA), KLORA, M_, NLORA, KLORA, EpiLora{WSF(WS_YB), WSB(WS_RKVA + 48 * MiB), WSB(WS_AGG), in[I_W0], in[I_A0]});
    gemm_pg8(lds, WSB(WS_MEMN), DM, WSB(WS_WK), DM, 512, DM, DM, EpiStore{WSB(WS_CW1K), DM, 1.f});
    gemm_pg8(lds, WSB(WS_WV), DM, WSB(WS_MEMN), DM, DM, 512, DM, EpiStore{WSB(WS_CW1V), 512, 1.f}, 8);
    xcd_barrier(xbar);
    if (blockIdx.x < 16 * (1 + rw7::NHELP)) {
        const rw7::Args ra{(const unsigned*)(ws + WS_RKVA), WSB(WS_RKVA + 32 * MiB), WSB(WS_RKVA + 48 * MiB), WSF(WS_YB), in[I_MU], in[I_KK], in[I_KA], in[I_RK], WSF(WS_YB), WSF(WS_BONUS),
                           ws + WS_KCR + 1 * MiB, (unsigned*)(ws + WS_CTL) + 32768, (unsigned*)(ws + WS_CTL) + 24576};
        if (blockIdx.x < 16) rw7::head(ra, blockIdx.x, lds);
        else rw7::helper(ra, (blockIdx.x - 16) % 16, (blockIdx.x - 16) / 16, lds);
        __syncthreads();
    }
    {
        const NsaArgs na{WSB(WS_QB), WSB(WS_KC), WSB(WS_VCT), WSB(WS_KS), WSB(WS_VST), WSB(WS_KW), WSB(WS_VWT), WSF(WS_GATES), WSB(WS_XN)};
        nsa::phase(na, (unsigned*)(ws + WS_CTL), lds);
    }
    xcd_barrier(xbar);
    d_nsa_outnorm(WSB(WS_XN), in[I_NSA_G]);
    rw7::finish(WSF(WS_YB), WSF(WS_BONUS), WSB(WS_RKVA + 32 * MiB), WSB(WS_AGG), in[I_MU], in[I_GNG], in[I_GNB], WSB(WS_XN));
    xcd_barrier(xbar);
    gemm_norm_res(lds, WSB(WS_XN), DM, WSB(WS_WOUT), DM, out, out, WSB(WS_XN), in[I_MIX_POST], in[I_MEM_PRE], 1.0f, WSB(WS_YB), (unsigned*)(ws + WS_GATES), (unsigned*)(ws + WS_CTL) + 1024 + 1 * 2048);
    xcd_barrier(xbar);
    gemm_pg8(lds, WSB(WS_XN), DM, WSB(WS_WQ), DM, M_, DM, DM, EpiStore{WSB(WS_QM), DM, MSCALE});
    xcd_barrier(xbar);
    for (int u = blockIdx.x; u < 256; u += gridDim.x) mema::unit(WSB(WS_QM), WSB(WS_CW1K), WSB(WS_CW1V), WSB(WS_OM), u, lds);
    xcd_barrier(xbar);
    gemm_norm_res(lds, WSB(WS_OM), DM, WSB(WS_WO), DM, out, out, WSB(WS_XN), in[I_MEM_POST], in[I_F2_PRE], 1.0f, WSB(WS_YB), (unsigned*)(ws + WS_GATES), (unsigned*)(ws + WS_CTL) + 1024 + 2 * 2048);
    xcd_barrier(xbar);
    gemm_pg8(lds, WSB(WS_XN), DM, WSB(WS_W2GU), DM, M_, NGU, DM, EpiSwiGLU{WSB(WS_HB)});
    xcd_barrier(xbar);
    gemm_norm_res(lds, WSB(WS_HB), FF, WSB(WS_W2D), FF, out, out, (bf16*)nullptr, in[I_F2_POST], (const float*)nullptr, 0.5f, WSB(WS_YB), (unsigned*)(ws + WS_GATES), (unsigned*)(ws + WS_CTL) + 1024 + 3 * 2048);
}

extern "C" void kernel_launch(void* const* d_in, const int* in_sizes, int n_in, void* d_out, int out_size, void* d_ws, size_t ws_size, hipStream_t stream) {
    static int grid = 0;
    if (grid == 0) {
        if (n_in != 41 || ws_size < WS_END) { fprintf(stderr, "kernel_launch: unexpected n_in %d / ws %zu\n", n_in, ws_size); grid = -1; return; }
        int dev = 0, cus = 0, per_cu = 0;
        hipGetDevice(&dev); hipDeviceGetAttribute(&cus, hipDeviceAttributeMultiprocessorCount, dev);
        if (hipFuncSetAttribute((const void*)mega_fwd, hipFuncAttributeMaxDynamicSharedMemorySize, LDS_BYTES) != hipSuccess) { fprintf(stderr, "kernel_launch: hipFuncSetAttribute failed\n"); grid = -1; return; }
        if (hipOccupancyMaxActiveBlocksPerMultiprocessor(&per_cu, (const void*)mega_fwd, NTHREADS, LDS_BYTES) != hipSuccess || per_cu < 1) { fprintf(stderr, "kernel_launch: occupancy query says %d\n", per_cu); grid = -1; (void)hipGetLastError(); return; }
        grid = cus;
        if (grid != 256) { fprintf(stderr, "kernel_launch: built for 256 CUs (one 256x256 tile per workgroup in the fused norm epilogues), found %d\n", cus); grid = -1; return; }
    }
    if (grid < 0) return;
    MegaArgs a{};
    for (int i = 0; i < 41; ++i) a.in[i] = (const float*)d_in[i];
    a.out = (float*)d_out; a.ws = (unsigned char*)d_ws;
    hipMemsetAsync(d_ws, 0, 196608, stream);
    void* args[] = {&a};
    hipError_t e = hipLaunchCooperativeKernel((const void*)mega_fwd, dim3(grid), dim3(NTHREADS), args, LDS_BYTES, stream);
    if (e != hipSuccess) fprintf(stderr, "kernel_launch: cooperative launch failed: %s (grid %d)\n", hipGetErrorString(e), grid);
}
```

```cpp
#include <hip/hip_runtime.h>
#include <hip/hip_cooperative_groups.h>
#include <cstdint>
#include <cstdio>

constexpr int NB = 2, T_ = 8192, DM = 1024, M_ = NB * T_;
constexpr int FF = 2816, NGU = 2 * FF;
constexpr int IN_COLS = 3096, NWIN = 3328;
constexpr int NRW = 1792;
constexpr int NCP = 512;
constexpr int NLORA = 1536, KLORA = 256;
constexpr float NORM_EPS = 1e-6f;
constexpr float QSCALE = 0.125f * 1.4426950408889634f;
constexpr float MSCALE = 0.0625f * 1.4426950408889634f;

typedef unsigned short bf16;
typedef short bf16x8 __attribute__((ext_vector_type(8)));
typedef float f32x4 __attribute__((ext_vector_type(4)));
typedef unsigned u32x2 __attribute__((ext_vector_type(2)));
typedef unsigned u32x4 __attribute__((ext_vector_type(4)));

__device__ __forceinline__ unsigned f2bf(float f) { unsigned u = __builtin_bit_cast(unsigned, f); return (u + 0x7fffu + ((u >> 16) & 1u)) >> 16; }
__device__ __forceinline__ float bf2f(bf16 h) { return __builtin_bit_cast(float, (unsigned)h << 16); }
typedef float f32x2_t __attribute__((ext_vector_type(2))); typedef __bf16 bf16x2_t __attribute__((ext_vector_type(2)));
__device__ __forceinline__ unsigned pk2(float lo, float hi) { const f32x2_t v = {lo, hi}; return __builtin_bit_cast(unsigned, __builtin_convertvector(v, bf16x2_t)); }
__device__ __forceinline__ void st_bf4(bf16* p, f32x4 v) { u32x2 w; w.x = pk2(v[0], v[1]); w.y = pk2(v[2], v[3]); *(u32x2*)p = w; }
__device__ __forceinline__ float wave_sum(float v) {
#pragma unroll
    for (int o = 1; o < 64; o <<= 1) v += __shfl_xor(v, o);
    return v;
}
__device__ __forceinline__ float wave_max(float v) {
#pragma unroll
    for (int o = 1; o < 64; o <<= 1) v = fmaxf(v, __shfl_xor(v, o));
    return v;
}
__device__ __forceinline__ float sigmoidf_(float x) { return 1.f / (1.f + __expf(-x)); }
__device__ __forceinline__ int tidx() { int t = threadIdx.x; asm volatile("" : "+v"(t)); return t; }

constexpr size_t MiB = 1u << 20, KiB64 = 65536;
constexpr size_t WS_CTL = 0;
constexpr size_t WS_KC = 256 * 1024;
constexpr size_t WS_VCT = 512 * 1024;
constexpr size_t WS_CW2 = 768 * 1024;
constexpr size_t WS_W1GU = 1 * MiB;
constexpr size_t WS_W1D = 12 * MiB;
constexpr size_t WS_W2GU = WS_W1D + 88 * KiB64;
constexpr size_t WS_W2D = WS_W2GU + 11 * MiB;
constexpr size_t WS_WIN = WS_W2D + 88 * KiB64;
constexpr size_t WS_WOUT = WS_WIN + 104 * KiB64;
constexpr size_t WS_WQ = WS_WOUT + 2 * MiB, WS_WK = WS_WQ + 2 * MiB, WS_WV = WS_WK + 2 * MiB, WS_WO = WS_WV + 2 * MiB;
constexpr size_t WS_CW1K = WS_WO + 2 * MiB, WS_CW1V = WS_CW1K + 1 * MiB;
constexpr size_t WS_WLORA = WS_CW1V + 1 * MiB;
constexpr size_t WS_ROPE = WS_WLORA + 12 * KiB64;
constexpr size_t WS_CBIAS = WS_ROPE + 2 * MiB;
constexpr size_t WS_MEMN = WS_CBIAS + KiB64;
constexpr size_t WS_HIDK = WS_MEMN + 1 * MiB;
constexpr size_t WS_HIDV = WS_HIDK + 1 * MiB;
constexpr size_t WS_GATES = WS_HIDV + 1 * MiB;
constexpr size_t WS_XN = 60 * MiB;
constexpr size_t WS_YB = 92 * MiB;
constexpr size_t WS_D = 124 * MiB;
constexpr size_t WS_HB = WS_D;
constexpr size_t WS_QB = WS_D;
constexpr size_t WS_KS = WS_D + 16 * MiB;
constexpr size_t WS_KW = WS_D + 20 * MiB;
constexpr size_t WS_KCR = WS_D + 24 * MiB;
constexpr size_t WS_VCR = WS_D + 29 * MiB;
constexpr size_t WS_VST = WS_D + 34 * MiB;
constexpr size_t WS_VWT = WS_D + 38 * MiB;
constexpr size_t WS_RKVA = WS_D + 42 * MiB;
constexpr size_t WS_PRL = WS_D + 106 * MiB;
constexpr size_t WS_AGG = WS_D + 114 * MiB;
constexpr size_t WS_BONUS = WS_KCR;
constexpr size_t WS_END = 256 * MiB;
constexpr size_t WS_QM = WS_D;
constexpr size_t WS_OM = WS_D + 32 * MiB;
constexpr size_t WS_MK = WS_D + 64 * MiB;
constexpr size_t WS_MVT = WS_D + 65 * MiB;
static_assert(WS_GATES + (size_t)M_ * 24 * 4 <= WS_XN, "ws map");
static_assert(WS_AGG + 16 * MiB <= WS_END, "ws map");

struct Params {
    const float* in[41];
    float* out;
    unsigned char* ws;
};
enum { I_X = 0, I_MEM, I_F1_PRE, I_F1_WG, I_F1_WU, I_F1_WD, I_F1_POST, I_MIX_PRE, I_WIN, I_PE_K, I_W1_K, I_W2_K, I_PE_V, I_W1_V, I_W2_V,
       I_NSA_G, I_MU, I_W0, I_W2, I_A0, I_A2, I_G2, I_KK, I_KA, I_RK, I_GNG, I_GNB, I_WOUT, I_MIX_POST, I_MEM_PRE, I_MEM_KVG, I_WQ, I_WK, I_WV,
       I_WO, I_MEM_POST, I_F2_PRE, I_F2_WG, I_F2_WU, I_F2_WD, I_F2_POST };

struct MapPlain { const float* W; int N; int pad; __device__ const float* col(int p) const { return W + p; } };
struct MapGU {
    const float* Wg; const float* Wu; int N; int pad;
    __device__ const float* col(int p) const {
        const int pn = p >> 8, q = p & 255, n = (q >> 4) & 1;
        const int hid = 128 * pn + 64 * (q >> 7) + 16 * ((q >> 5) & 3) + (q & 15);
        return Wg + (size_t)n * (size_t)(Wu - Wg) + hid;
    }
};
__host__ __device__ inline int rope_perm(int x) { return 16 * ((x >> 5) & 1) + (x & 15) + 32 * ((x >> 4) & 1); }
struct MapWin {
    const float* W; int N; int pad;
    __device__ const float* col(int p) const {
        int l;
        if (p < 512) l = (p & ~63) + rope_perm(p & 63);
        else if (p < 640) l = 768 + ((p - 512) & ~63) + rope_perm(p & 63);
        else if (p < 768) l = 1024 + ((p - 640) & ~63) + rope_perm(p & 63);
        else if (p < 896) l = 512 + (p - 768);
        else if (p < 1024) l = 640 + (p - 896);
        else if (p < 1152) l = 896 + (p - 1024);
        else if (p < 1280) l = 1152 + (p - 1152);
        else if (p < 2304) { const int q = p - 1280; l = 1304 + (((q >> 4) & 1) ? 512 : 0) + 16 * (q >> 5) + (q & 15); }
        else if (p < 3072) l = 1304 + (p - 1280);
        else if (p < 3096) l = 1280 + (p - 3072);
        else return nullptr;
        return W + l;
    }
};

#define FOR_VB(vb, n) for (int vb = (int)blockIdx.x * 2 + (T512 >> 8); vb < (n); vb += (int)gridDim.x * 2)

template <class Map> __device__ __forceinline__ void d_convert(bf16* WT, int Np, int K, Map map, int wg0 = 0) {
    if ((int)blockIdx.x < wg0) return;
    const int T512 = tidx(), tid = T512 & 255, nbx = Np / 64, nb = nbx * (K / 64), G = (int)gridDim.x - wg0;
    for (int vb0 = ((int)blockIdx.x - wg0) * 2 + (T512 >> 8); vb0 < nb; vb0 += G * 4) {
        const int vb1 = vb0 + G * 2; const bool two = vb1 < nb;
        const int p0 = (vb0 % nbx) * 64 + (tid & 63), k0 = (vb0 / nbx) * 64 + (tid >> 6) * 16;
        const int p1 = two ? (vb1 % nbx) * 64 + (tid & 63) : p0, k1 = two ? (vb1 / nbx) * 64 + (tid >> 6) * 16 : k0;
        const float* s0 = map.col(p0); const float* s1 = map.col(p1);
        float v[16], u[16];
#pragma unroll
        for (int i = 0; i < 16; ++i) { v[i] = s0 ? s0[(size_t)(k0 + i) * map.N] : 0.f; u[i] = s1 ? s1[(size_t)(k1 + i) * map.N] : 0.f; }
        u32x4 a, b;
        a.x = pk2(v[0], v[1]); a.y = pk2(v[2], v[3]); a.z = pk2(v[4], v[5]); a.w = pk2(v[6], v[7]);
        b.x = pk2(v[8], v[9]); b.y = pk2(v[10], v[11]); b.z = pk2(v[12], v[13]); b.w = pk2(v[14], v[15]);
        u32x4* d0 = (u32x4*)(WT + (size_t)p0 * K + k0); d0[0] = a; d0[1] = b;
        if (two) {
            a.x = pk2(u[0], u[1]); a.y = pk2(u[2], u[3]); a.z = pk2(u[4], u[5]); a.w = pk2(u[6], u[7]);
            b.x = pk2(u[8], u[9]); b.y = pk2(u[10], u[11]); b.z = pk2(u[12], u[13]); b.w = pk2(u[14], u[15]);
            u32x4* d1 = (u32x4*)(WT + (size_t)p1 * K + k1); d1[0] = a; d1[1] = b;
        }
    }
}
__device__ __forceinline__ void d_convert_lora(bf16* WT, const float* w2, const float* a2, const float* g2) {
    const int T512 = tidx(), tid = T512 & 255;
    FOR_VB(vb, NLORA * KLORA / 256) {
        const int idx = vb * 256 + tid, p = idx >> 8, k = idx & 255;
        float v = 0.f;
        if (p < 512) { if (k < 64) v = w2[k * 512 + p]; }
        else if (p < 1024) { if (k >= 64 && k < 128) v = a2[(k - 64) * 512 + (p - 512)]; }
        else { if (k >= 128) v = g2[(k - 128) * 512 + (p - 1024)]; }
        WT[idx] = (bf16)f2bf(v);
    }
}
__device__ __forceinline__ void d_rope_table(float* tab) {
    const int T512 = tidx(), tid = T512 & 255;
    FOR_VB(vb, T_ * 32 / 256) {
        const int idx = vb * 256 + tid, pos = idx >> 5, i = idx & 31;
        const float inv = (float)pow(10000.0, -(double)i / 32.0);
        const float ang = (float)pos * inv;
        tab[2 * idx] = (float)cos((double)ang); tab[2 * idx + 1] = (float)sin((double)ang);
    }
}
__device__ __forceinline__ void d_cmp_bias(const float* pe_k, const float* w1_k, const float* pe_v, const float* w1_v, float* part, float* red  ) {
    for (int job = blockIdx.x; job < 64; job += gridDim.x) {
        const int kv = job >> 5, cg_ = (job >> 3) & 3, jc = job & 7; const float* pe = kv ? pe_v : pe_k; const float* w1 = kv ? w1_v : w1_k;
        const int T512 = tidx(), lane = T512 & 63, w = T512 >> 6, n = cg_ * 64 + lane;
        float s = 0.f;
#pragma unroll 8
        for (int j = jc * 256 + w * 32; j < jc * 256 + w * 32 + 32; ++j) s += pe[j] * w1[(size_t)j * 256 + n];
        red[w * 64 + lane] = s; __syncthreads();
        if (w == 0) { float t = 0.f; for (int i = 0; i < 8; ++i) t += red[i * 64 + lane]; part[(jc * 2 + kv) * 256 + n] = t; }
        __syncthreads();
    }
}
__device__ __forceinline__ void d_rownorm(const float* x, const float* g, bf16* xn, int rows) {
    const int T512 = tidx(), tid = T512 & 255, lane = tid & 63;
    FOR_VB(vb, rows / 4) {
        const int row = vb * 4 + (tid >> 6);
        const f32x4* xr = (const f32x4*)(x + (size_t)row * DM) + lane; f32x4 v[4]; float s = 0.f;
#pragma unroll
        for (int j = 0; j < 4; ++j) { v[j] = xr[64 * j]; s += v[j][0] * v[j][0] + v[j][1] * v[j][1] + v[j][2] * v[j][2] + v[j][3] * v[j][3]; }
        const float rstd = rsqrtf(wave_sum(s) * (1.f / DM) + NORM_EPS);
#pragma unroll
        for (int j = 0; j < 4; ++j) { const f32x4 gg = ((const f32x4*)g)[lane + 64 * j]; st_bf4(xn + (size_t)row * DM + 4 * (lane + 64 * j), v[j] * rstd * gg); }
    }
}
__device__ __forceinline__ void d_rowpass(const float* xin, const bf16* y, const float* gpost, float coef, const float* gpre, float* xout, bf16* xn) {
    const int T512 = tidx(), tid = T512 & 255, lane = tid & 63;
    FOR_VB(vb, M_ / 4) {
        const int row = vb * 4 + (tid >> 6);
        f32x4 yv[4], xv[4]; float s = 0.f;
#pragma unroll
        for (int j = 0; j < 4; ++j) {
            const u32x2 w = *(const u32x2*)(y + (size_t)row * DM + 4 * (lane + 64 * j));
            yv[j][0] = __builtin_bit_cast(float, w.x << 16); yv[j][1] = __builtin_bit_cast(float, w.x & 0xffff0000u);
            yv[j][2] = __builtin_bit_cast(float, w.y << 16); yv[j][3] = __builtin_bit_cast(float, w.y & 0xffff0000u);
            s += yv[j][0] * yv[j][0] + yv[j][1] * yv[j][1] + yv[j][2] * yv[j][2] + yv[j][3] * yv[j][3];
            xv[j] = ((const f32x4*)(xin + (size_t)row * DM))[lane + 64 * j];
        }
        const float rstd = rsqrtf(wave_sum(s) * (1.f / DM) + NORM_EPS) * coef; float s2 = 0.f;
#pragma unroll
        for (int j = 0; j < 4; ++j) { const f32x4 gg = ((const f32x4*)gpost)[lane + 64 * j]; xv[j] = xv[j] + yv[j] * rstd * gg;
            s2 += xv[j][0] * xv[j][0] + xv[j][1] * xv[j][1] + xv[j][2] * xv[j][2] + xv[j][3] * xv[j][3];
            ((f32x4*)(xout + (size_t)row * DM))[lane + 64 * j] = xv[j]; }
        if (gpre) {
            const float r2 = rsqrtf(wave_sum(s2) * (1.f / DM) + NORM_EPS);
#pragma unroll
            for (int j = 0; j < 4; ++j) { const f32x4 gg = ((const f32x4*)gpre)[lane + 64 * j]; st_bf4(xn + (size_t)row * DM + 4 * (lane + 64 * j), xv[j] * r2 * gg); }
        }
    }
}
__device__ __forceinline__ void d_nsa_outnorm(bf16* amix, const float* g) {
    const int T512 = tidx(), tid = T512 & 255, lane = tid & 63;
    FOR_VB(vb, M_ / 4) {
        const int row = vb * 4 + (tid >> 6);
        bf16* p = amix + (size_t)row * DM + 8 * lane;
        const u32x4 w = *(const u32x4*)p; float v[8]; float s = 0.f;
        v[0] = __builtin_bit_cast(float, w.x << 16); v[1] = __builtin_bit_cast(float, w.x & 0xffff0000u);
        v[2] = __builtin_bit_cast(float, w.y << 16); v[3] = __builtin_bit_cast(float, w.y & 0xffff0000u);
        v[4] = __builtin_bit_cast(float, w.z << 16); v[5] = __builtin_bit_cast(float, w.z & 0xffff0000u);
        v[6] = __builtin_bit_cast(float, w.w << 16); v[7] = __builtin_bit_cast(float, w.w & 0xffff0000u);
#pragma unroll
        for (int i = 0; i < 8; ++i) s += v[i] * v[i];
        const float rstd = rsqrtf(wave_sum(s) * (1.f / 512.f) + NORM_EPS);
        u32x4 o; const float* gg = g + 8 * lane;
        o.x = pk2(v[0] * rstd * gg[0], v[1] * rstd * gg[1]); o.y = pk2(v[2] * rstd * gg[2], v[3] * rstd * gg[3]);
        o.z = pk2(v[4] * rstd * gg[4], v[5] * rstd * gg[5]); o.w = pk2(v[6] * rstd * gg[6], v[7] * rstd * gg[7]);
        *(u32x4*)p = o;
    }
}

struct EpiStore { bf16* O; int ldc; float scale;
    static constexpr int NCAT = 1;
    __device__ __forceinline__ int cat(int) const { return 0; }
    template <int C> __device__ __forceinline__ void apply(int row, int p, f32x4 v0, f32x4 v1) const { bf16* o = O + (size_t)row * ldc + p; st_bf4(o, v0 * scale); st_bf4(o + 16, v1 * scale); } };
struct EpiStoreF32 { float* O; int ldc;
    static constexpr int NCAT = 1;
    __device__ __forceinline__ int cat(int) const { return 0; }
    template <int C> __device__ __forceinline__ void apply(int row, int p, f32x4 v0, f32x4 v1) const { float* o = O + (size_t)row * ldc + p; *(f32x4*)o = v0; *(f32x4*)(o + 16) = v1; } };
struct EpiSwiGLU { bf16* H;
    static constexpr int NCAT = 1;
    __device__ __forceinline__ int cat(int) const { return 0; }
    template <int C> __device__ __forceinline__ void apply(int row, int p, f32x4 g, f32x4 u) const {
        const int q = p & 255, hid = 128 * (p >> 8) + 64 * (q >> 7) + 16 * ((q >> 5) & 3) + (q & 15);
        f32x4 h;
#pragma unroll
        for (int e = 0; e < 4; ++e) h[e] = g[e] / (1.f + __expf(-g[e])) * u[e];
        st_bf4(H + (size_t)row * FF + hid, h); } };
struct EpiBiasSilu { bf16* O; const float* bias;
    static constexpr int NCAT = 1;
    __device__ __forceinline__ int cat(int) const { return 0; }
    template <int C> __device__ __forceinline__ void apply(int row, int p, f32x4 v0, f32x4 v1) const {
        f32x4 a, b; f32x4 b0 = {0.f, 0.f, 0.f, 0.f}, b1 = {0.f, 0.f, 0.f, 0.f};
#pragma unroll
        for (int jc = 0; jc < 8; ++jc) { b0 += *(const f32x4*)(bias + jc * 512 + p); b1 += *(const f32x4*)(bias + jc * 512 + p + 16); }
#pragma unroll
        for (int e = 0; e < 4; ++e) { const float x0 = v0[e] + b0[e], x1 = v1[e] + b1[e]; a[e] = x0 / (1.f + __expf(-x0)); b[e] = x1 / (1.f + __expf(-x1)); }
        bf16* o = O + (size_t)row * 256 + p; st_bf4(o, a); st_bf4(o + 16, b); } };
struct EpiLora { float* wdec; bf16* aga; bf16* agg; const float* w0; const float* a0;
    static constexpr int NCAT = 3;
    __device__ __forceinline__ int cat(int p0) const { return p0 < 512 ? 0 : (p0 < 1024 ? 1 : 2); }
    template <int C> __device__ __forceinline__ void one(int row, int p, f32x4 v) const {
        if (C == 0) { f32x4 o; const f32x4 ww = *(const f32x4*)(w0 + p);
#pragma unroll
            for (int e = 0; e < 4; ++e) o[e] = __expf(-0.6065306597126334f * sigmoidf_(ww[e] + v[e]));
            *(f32x4*)(wdec + (size_t)row * 512 + p) = o;
        } else if (C == 1) { f32x4 o; const f32x4 aa = *(const f32x4*)(a0 + p - 512);
#pragma unroll
            for (int e = 0; e < 4; ++e) o[e] = sigmoidf_(aa[e] + v[e]);
            st_bf4(aga + (size_t)row * 512 + (p - 512), o);
        } else st_bf4(agg + (size_t)row * 512 + (p - 1024), v);
    }
    template <int C> __device__ __forceinline__ void apply(int row, int p, f32x4 v0, f32x4 v1) const { one<C>(row, p, v0); one<C>(row, p + 16, v1); } };
struct EpiWin {
    bf16 *qb, *ks, *kw, *kcr, *vcr, *vst, *vwt; unsigned* rk; bf16 *vv, *prl; float* gates; const float* rope;
    static constexpr int NCAT = 8;
    __device__ __forceinline__ int cat(int p0) const { return p0 < 512 ? 0 : (p0 < 768 ? 1 : (p0 < 1024 ? 2 : (p0 < 1280 ? 3 : (p0 < 2304 ? 4 : (p0 < 2816 ? 7 : (p0 < 3072 ? 6 : 5)))))); }
    template <int C> __device__ __forceinline__ void apply(int row, int p, f32x4 v0, f32x4 v1) const {
        const int b = row / T_, t = row % T_;
        if (C == 0 || C == 1) {
            const int x = p & 63, d = 16 * ((x >> 5) & 1) + (x & 15);
            const f32x4* rp = (const f32x4*)(rope + ((size_t)t * 32 + d) * 2); const f32x4 r0 = rp[0], r1 = rp[1];
            const f32x4 cs = {r0[0], r0[2], r1[0], r1[2]}, sn = {r0[1], r0[3], r1[1], r1[3]};
            const f32x4 lo = v0 * cs - v1 * sn, hi = v0 * sn + v1 * cs;
            if (C == 0) { bf16* o = qb + (size_t)row * 512 + (p & ~63) + d; st_bf4(o, lo * QSCALE); st_bf4(o + 32, hi * QSCALE); }
            else { const int g = ((p - 512) >> 6) & 1; bf16* base = (p < 640) ? ks : kw; bf16* o = base + ((size_t)(b * 2 + g) * T_ + t) * 64 + d; st_bf4(o, lo); st_bf4(o + 32, hi); }
        } else if (C == 2) {
            const int c = (p - 768) & 127, g = c >> 6, d = c & 63; bf16* base = (p < 896) ? kcr : vcr;
            bf16* o = base + ((size_t)(b * 2 + g) * T_ + t) * 64 + d; st_bf4(o, v0); st_bf4(o + 16, v1);
        } else if (C == 3) {
            const int c = (p - 1024) & 127, g = c >> 6, d = c & 63; bf16* base = (p < 1152) ? vst : vwt;
            bf16* o = base + ((size_t)(b * 2 + g) * 64 + d) * T_ + t;
#pragma unroll
            for (int e = 0; e < 4; ++e) { o[(size_t)e * T_] = (bf16)f2bf(v0[e]); o[(size_t)(16 + e) * T_] = (bf16)f2bf(v1[e]); }
        } else if (C == 4) {
            const int q = p - 1280, ch = 16 * (q >> 5) + (q & 15);
            u32x4 w; w.x = pk2(v0[0], v1[0]); w.y = pk2(v0[1], v1[1]); w.z = pk2(v0[2], v1[2]); w.w = pk2(v0[3], v1[3]);
            *(u32x4*)(rk + (size_t)row * 512 + ch) = w;
        } else if (C == 7) {
            bf16* o = vv + (size_t)row * 512 + (p - 2304); st_bf4(o, v0); st_bf4(o + 16, v1);
        } else if (C == 6) {
            bf16* o = prl + (size_t)row * 256 + (p - 2816); st_bf4(o, v0); st_bf4(o + 16, v1);
        } else {
            const int c = p - 3072; float* o = gates + (size_t)row * 24 + c;
            if (c < 24) { f32x4 s = {sigmoidf_(v0[0]), sigmoidf_(v0[1]), sigmoidf_(v0[2]), sigmoidf_(v0[3])}; *(f32x4*)o = s; }
            if (c + 16 < 24) { f32x4 s = {sigmoidf_(v1[0]), sigmoidf_(v1[1]), sigmoidf_(v1[2]), sigmoidf_(v1[3])}; *(f32x4*)(o + 16) = s; }
        }
    }
};

namespace pg8 {
#define PG8_LAS __attribute__((address_space(3)))
typedef unsigned short bf16_t;
typedef short bf16x8 __attribute__((ext_vector_type(8)));
typedef float f32x4 __attribute__((ext_vector_type(4)));
typedef unsigned u32x4 __attribute__((ext_vector_type(4)));
constexpr int BM = 256, BK = 64, HALF = 128, HTB = HALF * BK * 2  , STAGE_BYTES = 8 * HTB, NXCD = 8, WGM = 8;

__host__ __device__ __forceinline__ int lds_byte(int r, int c) { const int st = (r >> 4) * 2 + (c >> 5), rr = r & 15, cc = c & 31, ob = rr * 64 + cc * 2; return st * 1024 + (ob ^ (((ob >> 9) & 1) << 5)); }
__host__ __device__ __forceinline__ void stage_rc(int b, int& R, int& C) { const int st = b / 1024, sb = b % 1024, swz = sb ^ (((sb >> 9) & 1) << 5); R = (st >> 1) * 16 + swz / 64; C = (st & 1) * 32 + (swz % 64) / 2; }
__host__ __device__ __forceinline__ int perm32(int rho) { const int n = rho >> 4, i = rho & 15; return 8 * (i >> 2) + 4 * n + (i & 3); }

struct Unit { int pm, pn; };
struct Gemm { const bf16_t* A; const bf16_t* Bt; int M, N, K, lda, ldb; };

struct StaticOrder {
    int nM, nN, nwg, G, c;
    __host__ __device__ void init(int M, int N, int G_, int c_) { nM = M / BM; nN = N / BM; nwg = nM * nN; G = G_; c = c_; }
    __host__ __device__ bool next(int i, Unit& u) const {
        const long L = (long)i * G + c; if (L >= nwg) return false;
        int wgid = (int)L; { const int q = nwg / NXCD, r = nwg % NXCD, xcd = wgid % NXCD, off = wgid / NXCD; wgid = (xcd < r ? xcd * (q + 1) : r * (q + 1) + (xcd - r) * q) + off; }
        const int nig = WGM * nN, gid = wgid / nig, fm = gid * WGM, gsz = (nM - fm) < WGM ? (nM - fm) : WGM;
        u.pm = fm + ((wgid % nig) % gsz); u.pn = (wgid % nig) / gsz; return true;
    }
    __device__ __forceinline__ void a_ready(const Unit&) const {}
    __device__ __forceinline__ void done(const Unit&) const {}
};

template <class Epi, class Sched, bool ALIGN_EPI = false, bool SP2 = false>
__device__ __forceinline__ void gemm_phase(PG8_LAS unsigned char* lds, const Gemm g, const Sched& S, const Epi& E) {
    const int tid = tidx(), wid = __builtin_amdgcn_readfirstlane(tid >> 6), lane = tid & 63, wr = wid >> 2, wc = wid & 3, fr = lane & 15, fq = lane >> 4;
    const int K = g.K, nt = K / BK;
    unsigned voffA[2], voffB[2];
#pragma unroll
    for (int i = 0; i < 2; ++i) { int R, C; stage_rc(tid * 16 + i * 8192, R, C); const int Rb = Epi::PERM ? ((R & ~31) + perm32(R & 31)) : R;
        voffA[i] = (unsigned)(R * g.lda + C) * 2u; voffB[i] = (unsigned)(Rb * g.ldb + C) * 2u; }
    const size_t kstep = (size_t)(BK * 2);
    const size_t hstepA = (size_t)HALF * g.lda * 2, hstepB = (size_t)HALF * g.ldb * 2;
    const size_t tstepA = 2 * hstepA, tstepB = 2 * hstepB;
    const unsigned ldsw = (unsigned)wid * 1024u;
    const int aoff = lds_byte(wr * 64 + fr, fq * 8), boff = lds_byte(wc * 32 + fr, fq * 8);
#define PG8_SA(b, h) (((b) * 2 + (h)) * HTB)
#define PG8_SB(b, h) ((4 + (b) * 2 + (h)) * HTB)
#define PG8_STAGE(bufoff, gbase, voff) do { _Pragma("unroll") for (int _i = 0; _i < 2; ++_i) \
        __builtin_amdgcn_global_load_lds((const unsigned*)((const char*)(gbase) + (voff)[_i]), (PG8_LAS unsigned*)(lds + (bufoff) + ldsw + _i * 8192), 16, 0, 0); } while (0)
#define PG8_LDA(dst, b, h) do { _Pragma("unroll") for (int m = 0; m < 4; ++m) _Pragma("unroll") for (int k = 0; k < 2; ++k) dst[m][k] = *(const PG8_LAS bf16x8*)(lds + PG8_SA(b, h) + aoff + m * 2048 + k * 1024); } while (0)
#define PG8_LDB(dst, b, h) do { _Pragma("unroll") for (int n = 0; n < 2; ++n) _Pragma("unroll") for (int k = 0; k < 2; ++k) dst[n][k] = *(const PG8_LAS bf16x8*)(lds + PG8_SB(b, h) + boff + n * 2048 + k * 1024); } while (0)
#define PG8_MMA(ai, bj, At, Bt) do { __builtin_amdgcn_s_setprio(1); _Pragma("unroll") for (int m = 0; m < 4; ++m) _Pragma("unroll") for (int n = 0; n < 2; ++n) _Pragma("unroll") for (int k = 0; k < 2; ++k) \
        acc[ai][bj][m][n] = __builtin_amdgcn_mfma_f32_16x16x32_bf16(Bt[n][k], At[m][k], acc[ai][bj][m][n], 0, 0, 0); __builtin_amdgcn_s_setprio(0); } while (0)
#define PG8_WAIT_V(n) asm volatile("s_waitcnt vmcnt(" #n ")" ::: "memory")
#define PG8_WAIT_L(n) asm volatile("s_waitcnt lgkmcnt(" #n ")" ::: "memory")
#define PG8_BAR __builtin_amdgcn_s_barrier()
#define PG8_SCHED __builtin_amdgcn_sched_barrier(0)
    Unit cur, nxt; int ui = 0;
    if (!S.next(0, cur)) return;
    f32x4 acc[2][2][4][2];
#pragma unroll
    for (int a = 0; a < 2; ++a)
#pragma unroll
        for (int b = 0; b < 2; ++b)
#pragma unroll
            for (int m = 0; m < 4; ++m)
#pragma unroll
                for (int n = 0; n < 2; ++n) acc[a][b][m][n] = (f32x4){0.f, 0.f, 0.f, 0.f};
    bf16x8 At[4][2], B0[2][2], B1[2][2];
    const char* cA = (const char*)g.A + (size_t)cur.pm * tstepA; const char* cB = (const char*)g.Bt + (size_t)cur.pn * tstepB;
    S.a_ready(cur);
    if constexpr (SP2) {
        PG8_STAGE(PG8_SB(0, 0), cB, voffB); PG8_STAGE(PG8_SB(0, 1), cB + hstepB, voffB); PG8_STAGE(PG8_SA(0, 0), cA, voffA); PG8_STAGE(PG8_SA(0, 1), cA + hstepA, voffA);
        if (wr == 1) PG8_BAR;
        PG8_WAIT_V(2); PG8_BAR;
        PG8_STAGE(PG8_SB(1, 0), cB + kstep, voffB); PG8_STAGE(PG8_SA(1, 0), cA + kstep, voffA); PG8_STAGE(PG8_SB(1, 1), cB + hstepB + kstep, voffB);
        PG8_WAIT_V(6); PG8_BAR;
    } else {
        PG8_STAGE(PG8_SB(0, 0), cB, voffB); PG8_STAGE(PG8_SA(0, 0), cA, voffA); PG8_STAGE(PG8_SB(0, 1), cB + hstepB, voffB); PG8_STAGE(PG8_SA(0, 1), cA + hstepA, voffA);
        if (wr == 1) PG8_BAR;
        PG8_WAIT_V(4); PG8_BAR;
        PG8_STAGE(PG8_SB(1, 0), cB + kstep, voffB); PG8_STAGE(PG8_SA(1, 0), cA + kstep, voffA); PG8_STAGE(PG8_SB(1, 1), cB + hstepB + kstep, voffB);
        PG8_WAIT_V(6); PG8_BAR;
    }
    for (;;) {
        const bool has_next = S.next(ui + 1, nxt);
        const char* nA = has_next ? (const char*)g.A + (size_t)nxt.pm * tstepA : cA; const char* nB = has_next ? (const char*)g.Bt + (size_t)nxt.pn * tstepB : cB;
        for (int t = 0; t < nt; t += 2) {
            const bool last = (t == nt - 2);
            const char* a1 = cA + (size_t)(t + 1) * kstep;
            const char* a2 = last ? nA : cA + (size_t)(t + 2) * kstep; const char* b2 = last ? nB : cB + (size_t)(t + 2) * kstep;
            const char* a3 = a2 + kstep; const char* b3 = b2 + kstep;
            if (last && has_next) S.a_ready(nxt);
            if constexpr (SP2) {
            PG8_LDB(B0, 0, 0); PG8_LDB(B1, 0, 1); PG8_SCHED; PG8_LDA(At, 0, 0); PG8_STAGE(PG8_SA(1, 1), a1 + hstepA, voffA);
            PG8_WAIT_V(8); PG8_WAIT_L(0); PG8_BAR; PG8_MMA(0, 0, At, B0); PG8_MMA(0, 1, At, B1); PG8_BAR; PG8_SCHED;
            PG8_LDA(At, 0, 1); PG8_STAGE(PG8_SB(0, 0), b2, voffB); PG8_STAGE(PG8_SB(0, 1), b2 + hstepB, voffB); PG8_STAGE(PG8_SA(0, 0), a2, voffA);
            PG8_WAIT_V(8); PG8_WAIT_L(0); PG8_BAR; PG8_MMA(1, 0, At, B0); PG8_MMA(1, 1, At, B1); PG8_BAR; PG8_SCHED;
            PG8_LDB(B0, 1, 0); PG8_LDB(B1, 1, 1); PG8_SCHED; PG8_LDA(At, 1, 0); PG8_STAGE(PG8_SA(0, 1), a2 + hstepA, voffA);
            PG8_WAIT_V(8); PG8_WAIT_L(0); PG8_BAR; PG8_MMA(0, 0, At, B0); PG8_MMA(0, 1, At, B1); PG8_BAR; PG8_SCHED;
            PG8_LDA(At, 1, 1); PG8_STAGE(PG8_SB(1, 0), b3, voffB); PG8_STAGE(PG8_SB(1, 1), b3 + hstepB, voffB); PG8_STAGE(PG8_SA(1, 0), a3, voffA);
            PG8_WAIT_V(8); PG8_WAIT_L(0); PG8_BAR; PG8_MMA(1, 0, At, B0); PG8_MMA(1, 1, At, B1); PG8_BAR; PG8_SCHED;
            } else {
            PG8_LDB(B0, 0, 0); PG8_SCHED; PG8_LDA(At, 0, 0); PG8_STAGE(PG8_SA(1, 1), a1 + hstepA, voffA);
            PG8_WAIT_L(8); PG8_BAR; PG8_WAIT_L(0); PG8_MMA(0, 0, At, B0); PG8_BAR; PG8_SCHED;
            PG8_LDB(B1, 0, 1); PG8_STAGE(PG8_SB(0, 0), b2, voffB);
            PG8_BAR; PG8_WAIT_L(0); PG8_MMA(0, 1, At, B1); PG8_BAR;
            PG8_LDA(At, 0, 1); PG8_STAGE(PG8_SA(0, 0), a2, voffA);
            PG8_BAR; PG8_WAIT_L(0); PG8_MMA(1, 0, At, B0); PG8_BAR; PG8_SCHED;
            PG8_STAGE(PG8_SB(0, 1), b2 + hstepB, voffB);
            PG8_WAIT_V(6); PG8_BAR; PG8_MMA(1, 1, At, B1); PG8_BAR;
            PG8_LDB(B0, 1, 0); PG8_SCHED; PG8_LDA(At, 1, 0); PG8_STAGE(PG8_SA(0, 1), a2 + hstepA, voffA);
            PG8_WAIT_L(8); PG8_BAR; PG8_WAIT_L(0); PG8_MMA(0, 0, At, B0); PG8_BAR; PG8_SCHED;
            PG8_LDB(B1, 1, 1); PG8_STAGE(PG8_SB(1, 0), b3, voffB);
            PG8_BAR; PG8_WAIT_L(0); PG8_MMA(0, 1, At, B1); PG8_BAR;
            PG8_LDA(At, 1, 1); PG8_STAGE(PG8_SA(1, 0), a3, voffA);
            PG8_BAR; PG8_WAIT_L(0); PG8_MMA(1, 0, At, B0); PG8_BAR; PG8_SCHED;
            PG8_STAGE(PG8_SB(1, 1), b3 + hstepB, voffB);
            PG8_WAIT_V(6); PG8_BAR; PG8_MMA(1, 1, At, B1); PG8_BAR;
            }
        }
        if constexpr (ALIGN_EPI) { if (wr == 0) PG8_BAR; }
        if constexpr (!Epi::AFTER_DRAIN) { E(acc, cur, wr, wc, fr, fq); S.done(cur); }
        if (!has_next) break;
#pragma unroll
        for (int a = 0; a < 2; ++a)
#pragma unroll
            for (int b = 0; b < 2; ++b)
#pragma unroll
                for (int m = 0; m < 4; ++m)
#pragma unroll
                    for (int n = 0; n < 2; ++n) acc[a][b][m][n] = (f32x4){0.f, 0.f, 0.f, 0.f};
        cur = nxt; cA = nA; cB = nB; ++ui;
        if constexpr (ALIGN_EPI) { if (wr == 1) PG8_BAR; }
    }
    PG8_WAIT_V(0);
    if constexpr (!ALIGN_EPI) { if (wr == 0) PG8_BAR; }
    PG8_BAR;
    if constexpr (Epi::AFTER_DRAIN) { E.fused(acc, cur, wr, wc, fr, fq, lds, wid, lane); S.done(cur); }
#undef PG8_SA
#undef PG8_SB
#undef PG8_STAGE
#undef PG8_LDA
#undef PG8_LDB
#undef PG8_MMA
#undef PG8_WAIT_V
#undef PG8_WAIT_L
#undef PG8_BAR
#undef PG8_SCHED
}
}

template <class F> struct EpiQuad {
    static constexpr bool PERM = false, AFTER_DRAIN = false;
    F f;
    template <int C, int BJ> __device__ __forceinline__ void half(const pg8::f32x4 (&acc)[2][2][4][2], int row0, int p) const {
#pragma unroll
        for (int ai = 0; ai < 2; ++ai)
#pragma unroll
            for (int m = 0; m < 4; ++m) { f.template apply<C>(row0 + ai * 128 + m * 16, p, acc[ai][BJ][m][0], acc[ai][BJ][m][1]); asm volatile("" ::: "memory"); }
    }
    template <int BJ> __device__ __forceinline__ void disp(const pg8::f32x4 (&acc)[2][2][4][2], int row0, int p0, int p) const {
        const int c = f.cat(p0);
        if (F::NCAT == 1 || c == 0) half<0, BJ>(acc, row0, p);
        else if (F::NCAT > 1 && c == 1) half<(F::NCAT > 1 ? 1 : 0), BJ>(acc, row0, p);
        else if (F::NCAT > 2 && c == 2) half<(F::NCAT > 2 ? 2 : 0), BJ>(acc, row0, p);
        else if (F::NCAT > 3 && c == 3) half<(F::NCAT > 3 ? 3 : 0), BJ>(acc, row0, p);
        else if (F::NCAT > 4 && c == 4) half<(F::NCAT > 4 ? 4 : 0), BJ>(acc, row0, p);
        else if (F::NCAT > 5 && c == 5) half<(F::NCAT > 5 ? 5 : 0), BJ>(acc, row0, p);
        else if (F::NCAT > 6 && c == 6) half<(F::NCAT > 6 ? 6 : 0), BJ>(acc, row0, p);
        else if (F::NCAT > 7) half<(F::NCAT > 7 ? 7 : 0), BJ>(acc, row0, p);
    }
    __device__ __forceinline__ void operator()(const pg8::f32x4 (&acc)[2][2][4][2], const pg8::Unit& u, int wr, int wc, int fr, int fq) const {
        const int row0 = u.pm * 256 + wr * 64 + fr, p0 = u.pn * 256;
        disp<0>(acc, row0, p0, p0 + wc * 32 + 4 * fq);
        disp<1>(acc, row0, p0 + 128, p0 + 128 + wc * 32 + 4 * fq);
    }
};
template <class F> __device__ __forceinline__ void gemm_pg8(unsigned char* lds, const bf16* A, int lda, const bf16* Bt, int ldb, int M, int N, int K, const F& f, int wg_off = 0) {
    if ((int)blockIdx.x < wg_off) return;
    pg8::Gemm g{A, Bt, M, N, K, lda, ldb}; pg8::StaticOrder S; S.init(M, N, (int)gridDim.x, (int)blockIdx.x - wg_off);
    EpiQuad<F> E{f};
    pg8::gemm_phase<EpiQuad<F>, pg8::StaticOrder, true, true>((PG8_LAS unsigned char*)lds, g, S, E);
}

namespace cg = cooperative_groups;
template <bool XIN16, bool XOUT16> struct EpiNormRes {
    static constexpr bool PERM = false, AFTER_DRAIN = true;
    const void* xin; void* xout; bf16* xn; const float* gpost; const float* gpre; float coef; unsigned* part; unsigned* cnt;
    __device__ __forceinline__ void operator()(const pg8::f32x4 (&)[2][2][4][2], const pg8::Unit&, int, int, int, int) const {}
    __device__ __forceinline__ void rowstat(const pg8::f32x4 (&acc)[2][2][4][2], float* P, int wr, int wc, int fr, int fq) const {
#pragma unroll
        for (int ai = 0; ai < 2; ++ai)
#pragma unroll
            for (int m = 0; m < 4; ++m) { float sq = 0.f;
#pragma unroll
                for (int bj = 0; bj < 2; ++bj)
#pragma unroll
                    for (int n = 0; n < 2; ++n) { const pg8::f32x4 v = acc[ai][bj][m][n]; sq += (v[0] * v[0] + v[1] * v[1]) + (v[2] * v[2] + v[3] * v[3]); }
                sq += __shfl_xor(sq, 16); sq += __shfl_xor(sq, 32);
                if (fq == 0) P[(ai * 128 + wr * 64 + m * 16 + fr) * 4 + wc] = sq; }
    }
    __device__ __forceinline__ void exchange(float* P, float* S, unsigned* bank, unsigned* cnt_, const pg8::Unit& u, int tid, float scale) const {
        __syncthreads();
        if (tid < 256) { const f32x4 p = *(const f32x4*)(P + tid * 4);
            __hip_atomic_store(bank + (size_t)(u.pm * 256 + tid) * 4 + u.pn, __builtin_bit_cast(unsigned, (p[0] + p[1]) + (p[2] + p[3])), __ATOMIC_RELAXED, __HIP_MEMORY_SCOPE_AGENT); }
        asm volatile("s_waitcnt vmcnt(0)" ::: "memory");
        __syncthreads();
        if (tid == 0) { unsigned* c = cnt_ + u.pm * 16; __hip_atomic_fetch_add(c, 1u, __ATOMIC_RELAXED, __HIP_MEMORY_SCOPE_AGENT);
            while (__hip_atomic_load(c, __ATOMIC_RELAXED, __HIP_MEMORY_SCOPE_AGENT) < 4u) __builtin_amdgcn_s_sleep(1); }
        __syncthreads();
        if (tid < 256) { const unsigned* b = bank + (size_t)(u.pm * 256 + tid) * 4; float q = 0.f;
#pragma unroll
            for (int j = 0; j < 4; ++j) q += __builtin_bit_cast(float, __hip_atomic_load(b + j, __ATOMIC_RELAXED, __HIP_MEMORY_SCOPE_AGENT));
            S[tid] = rsqrtf(q * (1.f / DM) + NORM_EPS) * scale; }
        __syncthreads();
    }
    __device__ __forceinline__ void fused(pg8::f32x4 (&acc)[2][2][4][2], const pg8::Unit& u, int wr, int wc, int fr, int fq, PG8_LAS unsigned char* lds, int wid, int lane) const {
        float* P = (float*)lds; float* S = P + 1024; const int tid = wid * 64 + lane;
        rowstat(acc, P, wr, wc, fr, fq);
        exchange(P, S, part, cnt, u, tid, coef);
        const int col0 = u.pn * 256 + wc * 32 + 4 * fq;
#pragma unroll
        for (int ai = 0; ai < 2; ++ai)
#pragma unroll
            for (int m = 0; m < 4; ++m) { const int r = ai * 128 + wr * 64 + m * 16 + fr; const float sr = S[r]; const size_t off = (size_t)(u.pm * 256 + r) * DM + col0;
#pragma unroll
                for (int bj = 0; bj < 2; ++bj)
#pragma unroll
                    for (int n = 0; n < 2; ++n) { const int o = bj * 128 + n * 16; const f32x4 g4 = *(const f32x4*)(gpost + col0 + o);
                        f32x4 x4;
                        if (XIN16) { const u32x2 w = *(const u32x2*)((const bf16*)xin + off + o);
                            x4 = (f32x4){__builtin_bit_cast(float, w.x << 16), __builtin_bit_cast(float, w.x & 0xffff0000u), __builtin_bit_cast(float, w.y << 16), __builtin_bit_cast(float, w.y & 0xffff0000u)}; }
                        else x4 = *(const f32x4*)((const float*)xin + off + o);
                        const f32x4 y = x4 + acc[ai][bj][m][n] * sr * g4; acc[ai][bj][m][n] = y;
                        if (XOUT16) st_bf4((bf16*)xout + off + o, y); else *(f32x4*)((float*)xout + off + o) = y; }
                asm volatile("" ::: "memory"); }
        if (!gpre) return;
        rowstat(acc, P, wr, wc, fr, fq);
        exchange(P, S, part + (size_t)M_ * 4, cnt + 64 * 16, u, tid, 1.f);
#pragma unroll
        for (int ai = 0; ai < 2; ++ai)
#pragma unroll
            for (int m = 0; m < 4; ++m) { const int r = ai * 128 + wr * 64 + m * 16 + fr; const float sr = S[r]; const size_t off = (size_t)(u.pm * 256 + r) * DM + col0;
#pragma unroll
                for (int bj = 0; bj < 2; ++bj)
#pragma unroll
                    for (int n = 0; n < 2; ++n) { const int o = bj * 128 + n * 16; const f32x4 g4 = *(const f32x4*)(gpre + col0 + o); st_bf4(xn + off + o, acc[ai][bj][m][n] * sr * g4); }
                asm volatile("" ::: "memory"); }
    }
};
template <bool XIN16, bool XOUT16>
__device__ __forceinline__ void gemm_norm_res(unsigned char* lds, const bf16* A, int lda, const bf16* Bt, int K, const void* xin, void* xout, bf16* xn, const float* gpost, const float* gpre,
                                              float coef, unsigned* part, unsigned* cnt) {
    pg8::Gemm g{A, Bt, M_, DM, K, lda, K}; pg8::StaticOrder S; S.init(M_, DM, 256, (int)blockIdx.x);
    const EpiNormRes<XIN16, XOUT16> E{xin, xout, xn, gpost, gpre, coef, part, cnt};
    pg8::gemm_phase<EpiNormRes<XIN16, XOUT16>, pg8::StaticOrder, false, true>((PG8_LAS unsigned char*)lds, g, S, E);
}

__device__ __forceinline__ void d_gates(const bf16* xn, const bf16* wg  , float* gates, float* red  ) {
    const int T512 = tidx(), lane = T512 & 63, fr = lane & 15, fq = lane >> 4, w = T512 >> 6, kh = w & 1;
    for (int rt0 = blockIdx.x * 4; rt0 < M_ / 16; rt0 += gridDim.x * 4) {
        const int rt = rt0 + (w >> 1);
        const bf16* ap = xn + (size_t)(rt * 16 + fr) * DM + 8 * fq + kh * 512; const bf16* bp = wg + (size_t)fr * DM + 8 * fq + kh * 512;
        f32x4 c0 = {0.f, 0.f, 0.f, 0.f}, c1 = {0.f, 0.f, 0.f, 0.f};
#pragma unroll 8
        for (int k0 = 0; k0 < 512; k0 += 32) { const bf16x8 a = *(const bf16x8*)(ap + k0);
            c0 = __builtin_amdgcn_mfma_f32_16x16x32_bf16(*(const bf16x8*)(bp + k0), a, c0, 0, 0, 0);
            c1 = __builtin_amdgcn_mfma_f32_16x16x32_bf16(*(const bf16x8*)(bp + (size_t)16 * DM + k0), a, c1, 0, 0, 0); }
        float* r = red + ((w >> 1) * 64 + lane) * 8;
        if (kh) { *(f32x4*)r = c0; *(f32x4*)(r + 4) = c1; }
        __syncthreads();
        if (!kh) { c0 += *(const f32x4*)r; c1 += *(const f32x4*)(r + 4);
            float* o = gates + (size_t)(rt * 16 + fr) * 24 + 4 * fq;
            *(f32x4*)o = (f32x4){sigmoidf_(c0[0]), sigmoidf_(c0[1]), sigmoidf_(c0[2]), sigmoidf_(c0[3])};
            if (fq < 2) *(f32x4*)(o + 16) = (f32x4){sigmoidf_(c1[0]), sigmoidf_(c1[1]), sigmoidf_(c1[2]), sigmoidf_(c1[3])}; }
        __syncthreads();
    }
}

__device__ __forceinline__ void d_cmp2(const float* part  , const float* bias  , const bf16* w2t, const float* rope, bf16* kc, bf16* vct) {
    const int T512 = tidx(), lane = T512 & 63, fr = lane & 15, fq = lane >> 4;
    for (int task = blockIdx.x * 8 + (T512 >> 6); task < 256; task += gridDim.x * 8) {
        const int kv = task >> 7, R0 = (task & 127) * 16;
        const float* p0 = part + ((size_t)(kv * 2) * 2048 + R0 + fr) * 256 + 8 * fq; const float* p1 = p0 + (size_t)2048 * 256;
        const float* bb = bias + kv * 256 + 8 * fq;
        const bf16* bp = w2t + (size_t)kv * 64 * 256 + (size_t)fr * 256 + 8 * fq;
        f32x4 acc[4];
#pragma unroll
        for (int nt = 0; nt < 4; ++nt) acc[nt] = (f32x4){0.f, 0.f, 0.f, 0.f};
#pragma unroll
        for (int k0 = 0; k0 < 256; k0 += 32) {
            f32x4 xa = *(const f32x4*)(p0 + k0) + *(const f32x4*)(p1 + k0) + *(const f32x4*)(bb + k0);
            f32x4 xb = *(const f32x4*)(p0 + k0 + 4) + *(const f32x4*)(p1 + k0 + 4) + *(const f32x4*)(bb + k0 + 4);
#pragma unroll
            for (int e = 0; e < 4; ++e) { xa[e] = xa[e] / (1.f + __expf(-xa[e])); xb[e] = xb[e] / (1.f + __expf(-xb[e])); }
            const bf16x8 a = __builtin_bit_cast(bf16x8, (u32x4){pk2(xa[0], xa[1]), pk2(xa[2], xa[3]), pk2(xb[0], xb[1]), pk2(xb[2], xb[3])});
#pragma unroll
            for (int nt = 0; nt < 4; ++nt) acc[nt] = __builtin_amdgcn_mfma_f32_16x16x32_bf16(*(const bf16x8*)(bp + (size_t)nt * 16 * 256 + k0), a, acc[nt], 0, 0, 0);
        }
        const int R = R0 + fr, bg = R >> 9, c = R & 511;
        if (kv == 0) {
            const int pos = (16 * c + 31) & (T_ - 1);
#pragma unroll
            for (int h2 = 0; h2 < 2; ++h2) {
                const int d = 16 * h2 + 4 * fq; const f32x4* rp = (const f32x4*)(rope + ((size_t)pos * 32 + d) * 2); const f32x4 r0 = rp[0], r1 = rp[1];
                const f32x4 cs = {r0[0], r0[2], r1[0], r1[2]}, sn = {r0[1], r0[3], r1[1], r1[3]};
                const f32x4 lo = acc[h2] * cs - acc[h2 + 2] * sn, hi = acc[h2] * sn + acc[h2 + 2] * cs;
                st_bf4(kc + (size_t)R * 64 + d, lo); st_bf4(kc + (size_t)R * 64 + d + 32, hi);
            }
        } else {
#pragma unroll
            for (int nt = 0; nt < 4; ++nt)
#pragma unroll
                for (int e = 0; e < 4; ++e) vct[((size_t)bg * 64 + 16 * nt + 4 * fq + e) * NCP + c] = (bf16)f2bf(acc[nt][e]);
        }
    }
}

struct NsaArgs { const bf16 *qb, *kc, *vct, *ks, *vst, *kw, *vwt; const float* gates; bf16* amix; };
__device__ __forceinline__ float dot64(const float* q, const bf16* k) {
    float s = 0.f;
#pragma unroll
    for (int i = 0; i < 8; ++i) { const u32x4 w = ((const u32x4*)k)[i];
        s += q[8 * i + 0] * __builtin_bit_cast(float, w.x << 16) + q[8 * i + 1] * __builtin_bit_cast(float, w.x & 0xffff0000u)
           + q[8 * i + 2] * __builtin_bit_cast(float, w.y << 16) + q[8 * i + 3] * __builtin_bit_cast(float, w.y & 0xffff0000u)
           + q[8 * i + 4] * __builtin_bit_cast(float, w.z << 16) + q[8 * i + 5] * __builtin_bit_cast(float, w.z & 0xffff0000u)
           + q[8 * i + 6] * __builtin_bit_cast(float, w.w << 16) + q[8 * i + 7] * __builtin_bit_cast(float, w.w & 0xffff0000u); }
    return s;
}
__device__ __forceinline__ void softmax_row(float* s, int n, int lane) {
    float m = -INFINITY; for (int i = lane; i < n; i += 64) m = fmaxf(m, s[i]);
    m = wave_max(m); if (m == -INFINITY) m = 0.f;
    float l = 0.f; for (int i = lane; i < n; i += 64) { const float e = exp2f(s[i] - m); s[i] = e; l += e; }
    l = wave_sum(l); const float inv = 1.f / fmaxf(l, 1e-30f);
    for (int i = lane; i < n; i += 64) s[i] *= inv;
}
__device__ __forceinline__ void d_nsa_simple(const NsaArgs& a, int vb, int tid, unsigned char* smem) {
    float (*qs)[64] = (float (*)[64])smem; float (*sc)[1024] = (float (*)[1024])(smem + 1024); float* imp = (float*)(smem + 17408); float* score = imp + 128;
    int* list = (int*)(score + 128); int* nlist = list + 16;
    const int bg = vb / T_, t = vb % T_, b = bg >> 1, g = bg & 1;
    const int r = tid >> 6, d = tid & 63, lane = d;
    const size_t row = (size_t)b * T_ + t;
    qs[r][d] = bf2f(a.qb[row * 512 + g * 256 + r * 64 + d]);
    if (tid == 0) *nlist = 0;
    __syncthreads();
    const int nv = t < 31 ? 0 : (t - 31) / 16 + 1;
    for (int c = tid; c < nv; c += 256) { const bf16* k = a.kc + ((size_t)bg * NCP + c) * 64;
        _Pragma("unroll 1") for (int rr = 0; rr < 4; ++rr) sc[rr][c] = dot64(qs[rr], k); }
    __syncthreads();
    softmax_row(sc[r], nv, lane);
    __syncthreads();
    float oc = 0.f; { const bf16* v = a.vct + ((size_t)bg * 64 + d) * NCP; for (int c = 0; c < nv; ++c) oc += sc[r][c] * bf2f(v[c]); }
    if (tid < 128) { const int s = tid; float acc = 0.f;
        for (int c = 4 * s - 1; c <= 4 * s + 3; ++c) if (c >= 0 && c < nv) acc += sc[0][c] + sc[1][c] + sc[2][c] + sc[3][c];
        imp[s] = acc; }
    __syncthreads();
    const int cur = t >> 6;
    if (tid < 128) { const int s = tid; const bool forced = (s == 0) || (s == cur) || (s == cur - 1);
        score[s] = forced ? 1e4f : (s <= cur ? imp[s] : -1e4f); }
    __syncthreads();
    if (tid < 128) { const int s = tid; const float my = score[s]; int rank = 0;
        for (int j = 0; j < 128; ++j) { const float o = score[j]; rank += (o > my || (o == my && j < s)) ? 1 : 0; }
        if (rank < 16 && s <= cur) { const int slot = atomicAdd(nlist, 1); list[slot] = s; } }
    __syncthreads();
    const int ns = *nlist * 64;
    for (int i = tid; i < ns; i += 256) { const int pos = list[i >> 6] * 64 + (i & 63);
        if (pos <= t) { const bf16* k = a.ks + ((size_t)bg * T_ + pos) * 64; _Pragma("unroll 1") for (int rr = 0; rr < 4; ++rr) sc[rr][i] = dot64(qs[rr], k); }
        else { sc[0][i] = -INFINITY; sc[1][i] = -INFINITY; sc[2][i] = -INFINITY; sc[3][i] = -INFINITY; } }
    __syncthreads();
    softmax_row(sc[r], ns, lane);
    __syncthreads();
    float os = 0.f; { const bf16* v = a.vst + ((size_t)bg * 64 + d) * T_;
        for (int i = 0; i < ns; ++i) { const int pos = list[i >> 6] * 64 + (i & 63); if (pos <= t) os += sc[r][i] * bf2f(v[pos]); } }
    __syncthreads();
    const int lo = t - 511 > 0 ? t - 511 : 0, nw = t - lo + 1;
    for (int i = tid; i < nw; i += 256) { const bf16* k = a.kw + ((size_t)bg * T_ + lo + i) * 64;
        _Pragma("unroll 1") for (int rr = 0; rr < 4; ++rr) sc[rr][i] = dot64(qs[rr], k); }
    __syncthreads();
    softmax_row(sc[r], nw, lane);
    __syncthreads();
    float ow = 0.f; { const bf16* v = a.vwt + ((size_t)bg * 64 + d) * T_ + lo; for (int i = 0; i < nw; ++i) ow += sc[r][i] * bf2f(v[i]); }
    const float* gt = a.gates + row * 24 + g * 12 + r * 3;
    a.amix[row * DM + g * 256 + r * 64 + d] = (bf16)f2bf(gt[0] * oc + gt[1] * os + gt[2] * ow);
    __syncthreads();
}


namespace nsa {
typedef float f32x16 __attribute__((ext_vector_type(16)));
constexpr int KROW = 144, VROW = 136, KBUF = 64 * KROW, VBUF = 64 * VROW;
constexpr int OFF_K = 0, OFF_V = 2 * KBUF, OFF_IMP = OFF_V + 2 * VBUF, IMPW = 130, OFF_SEL = OFF_IMP + 64 * IMPW * 4, OFF_UM = OFF_SEL + 1024, OFF_WS = OFF_UM + 16, OFF_UNIT = OFF_WS + 1024, OFF_ACC = OFF_UNIT + 16, LDS_NEED = OFF_ACC + 8 * 8192;
static_assert(LDS_NEED <= 147456 - 64 && OFF_ACC % 16 == 0, "nsa lds");
static_assert(OFF_IMP % 16 == 0 && OFF_SEL % 16 == 0 && OFF_WS % 16 == 0, "nsa lds map");
__device__ __forceinline__ int crow(int r, int hi) { return (r & 3) + 8 * (r >> 2) + 4 * hi; }
__device__ __forceinline__ int next_bit(unsigned m0, unsigned m1, unsigned m2, unsigned m3, int from) {
#pragma unroll
    for (int wd = 0; wd < 4; ++wd) {
        unsigned x = wd == 0 ? m0 : (wd == 1 ? m1 : (wd == 2 ? m2 : m3)); const int base = wd * 32;
        if (from < base + 32) { if (from > base) x &= (~0u) << (from - base); if (x) return base + __builtin_ctz(x); }
    }
    return 128;
}
__device__ __forceinline__ bf16x8 pack8(const f32x16& p, int b0) {
    u32x4 w; w.x = pk2(p[b0 + 0], p[b0 + 1]); w.y = pk2(p[b0 + 2], p[b0 + 3]); w.z = pk2(p[b0 + 4], p[b0 + 5]); w.w = pk2(p[b0 + 6], p[b0 + 7]);
    return __builtin_bit_cast(bf16x8, w);
}
struct Branch { const bf16* k; const bf16* vt; int ldv; };

constexpr float THR = 8.f;
template <int MODE, bool SEL>
__device__ __forceinline__ void compute_tile(unsigned char* sm, int cb, int j, const bf16x8 (&qf)[4], int lo, int hi_b, int lo_max, int hi_min, unsigned s0, unsigned s1, unsigned s2, unsigned s3,
                                             float& m, float& l, float invl, bool& initd, f32x16& negm, f32x16 (&o)[2], float* imp_row, float* wsc, int i, int hi) {
        const unsigned char* kb = sm + OFF_K + cb * KBUF; const unsigned char* vb = sm + OFF_V + cb * VBUF;
        const int key0 = 64 * j;
        bool rowsel = true;
        if (SEL) { const unsigned wsel = j < 32 ? s0 : (j < 64 ? s1 : (j < 96 ? s2 : s3)); rowsel = (wsel >> (j & 31)) & 1u; }
        if (!SEL || __any(rowsel)) {
            f32x16 p0, p1;
            {
                f32x16 c0;
                if (SEL) {
#pragma unroll
                    for (int r = 0; r < 16; ++r) c0[r] = rowsel ? negm[r] : -INFINITY;
                } else c0 = negm;
                const bf16x8 a00 = *(const bf16x8*)(kb + i * KROW + (8 * hi) * 2), a10 = *(const bf16x8*)(kb + (32 + i) * KROW + (8 * hi) * 2);
                p0 = __builtin_amdgcn_mfma_f32_32x32x16_bf16(a00, qf[0], c0, 0, 0, 0);
                p1 = __builtin_amdgcn_mfma_f32_32x32x16_bf16(a10, qf[0], c0, 0, 0, 0);
#pragma unroll
                for (int d0 = 1; d0 < 4; ++d0) {
                    const bf16x8 a0 = *(const bf16x8*)(kb + i * KROW + (16 * d0 + 8 * hi) * 2);
                    const bf16x8 a1 = *(const bf16x8*)(kb + (32 + i) * KROW + (16 * d0 + 8 * hi) * 2);
                    p0 = __builtin_amdgcn_mfma_f32_32x32x16_bf16(a0, qf[d0], p0, 0, 0, 0);
                    p1 = __builtin_amdgcn_mfma_f32_32x32x16_bf16(a1, qf[d0], p1, 0, 0, 0);
                }
            }
            if (!(key0 >= lo_max && key0 + 63 <= hi_min)) {
#pragma unroll
                for (int r = 0; r < 16; ++r) { const int key = key0 + crow(r, hi);
                    if (key < lo || key > hi_b) p0[r] = -INFINITY;
                    if (key + 32 < lo || key + 32 > hi_b) p1[r] = -INFINITY; }
            }
            if (MODE == 1) {
#pragma unroll
                for (int r = 0; r < 16; ++r) { p0[r] = __builtin_amdgcn_exp2f(p0[r]) * invl; p1[r] = __builtin_amdgcn_exp2f(p1[r]) * invl; }
#pragma unroll
                for (int gq = 0; gq < 4; ++gq) {
                    float G0 = (p0[4 * gq] + p0[4 * gq + 1]) + (p0[4 * gq + 2] + p0[4 * gq + 3]), L0 = p0[4 * gq + 3];
                    float G1 = (p1[4 * gq] + p1[4 * gq + 1]) + (p1[4 * gq + 2] + p1[4 * gq + 3]), L1 = p1[4 * gq + 3];
                    G0 += __shfl_xor(G0, 1); L0 += __shfl_xor(L0, 1); G1 += __shfl_xor(G1, 1); L1 += __shfl_xor(L1, 1);
                    G0 += __shfl_xor(G0, 2); L0 += __shfl_xor(L0, 2); G1 += __shfl_xor(G1, 2); L1 += __shfl_xor(L1, 2);
                    if ((i & 3) == 0) { const int s = 16 * j + 2 * gq + hi;
                        atomicAdd(imp_row + s, G0); atomicAdd(imp_row + s + 1, L0); atomicAdd(imp_row + s + 8, G1); atomicAdd(imp_row + s + 9, L1); }
                }
            } else {
                float ta = fmaxf(fmaxf(p0[0], p0[1]), p1[0]), tb = fmaxf(fmaxf(p0[2], p0[3]), p1[1]);
                ta = fmaxf(fmaxf(ta, p1[2]), p1[3]);
#pragma unroll
                for (int r = 4; r < 16; r += 4) { ta = fmaxf(fmaxf(ta, p0[r]), p0[r + 1]); tb = fmaxf(fmaxf(tb, p0[r + 2]), p0[r + 3]); ta = fmaxf(fmaxf(ta, p1[r]), p1[r + 1]); tb = fmaxf(fmaxf(tb, p1[r + 2]), p1[r + 3]); }
                float tm = fmaxf(ta, tb);
                tm = fmaxf(tm, __shfl_xor(tm, 32));
                if (__any((!initd && tm > -INFINITY) || tm > THR)) {
                    const bool was = initd;
                    const float d = was ? fmaxf(tm, 0.f) : (tm > -INFINITY ? tm : 0.f);
                    initd = was || (tm > -INFINITY);
                    m += d; const float alpha = was ? __builtin_amdgcn_exp2f(-d) : 1.f; l *= alpha;
#pragma unroll
                    for (int r = 0; r < 16; ++r) { p0[r] -= d; p1[r] -= d; negm[r] = -m; }
                    if (MODE == 2) {
                        if (hi == 0) wsc[i] = alpha;
                        asm volatile("" ::: "memory");
#pragma unroll
                        for (int rg = 0; rg < 4; ++rg) { const f32x4 a4 = *(const f32x4*)(wsc + 8 * rg + 4 * hi);
#pragma unroll
                            for (int e = 0; e < 4; ++e) { o[0][4 * rg + e] *= a4[e]; o[1][4 * rg + e] *= a4[e]; } }
                        asm volatile("" ::: "memory");
                    }
                }
                float rs = 0.f;
#pragma unroll
                for (int r = 0; r < 16; ++r) { p0[r] = __builtin_amdgcn_exp2f(p0[r]); p1[r] = __builtin_amdgcn_exp2f(p1[r]); rs += p0[r] + p1[r]; }
                l += rs;
            }
            if (MODE != 0) {
                const bf16x8 pf0 = pack8(p0, 0), pf1 = pack8(p0, 8), pf2 = pack8(p1, 0), pf3 = pack8(p1, 8);
#pragma unroll
                for (int dt = 0; dt < 2; ++dt) {
                    const unsigned char* vp = vb + (32 * dt + i) * VROW + 8 * hi;
#pragma unroll
                    for (int ks = 0; ks < 4; ++ks) {
                        const u32x2 v_lo = *(const u32x2*)(vp + 32 * ks), v_hi = *(const u32x2*)(vp + 32 * ks + 16);
                        const bf16x8 vf = __builtin_bit_cast(bf16x8, (u32x4){v_lo.x, v_lo.y, v_hi.x, v_hi.y});
                        o[dt] = __builtin_amdgcn_mfma_f32_32x32x16_bf16(ks == 0 ? pf0 : (ks == 1 ? pf1 : (ks == 2 ? pf2 : pf3)), vf, o[dt], 0, 0, 0);
                    }
                }
            }
        }
}
template <int MODE, bool SEL>
__device__ __forceinline__ void run_branch(unsigned char* sm, const Branch br, unsigned m0, unsigned m1, unsigned m2, unsigned m3,
                                           const bf16x8 (&qf)[4], int lo, int hi_b, int lo_max, int hi_min, unsigned s0, unsigned s1, unsigned s2, unsigned s3,
                                           float& m, float& l, float invl, f32x16 (&o)[2], float* imp_row, float* wsc, int tid, int lane) {
    const int i = lane & 31, hi = lane >> 5;
    const bf16* kp = br.k + tid * 8; const bf16* vp_ = br.vt + (size_t)(tid >> 3) * br.ldv + (tid & 7) * 8;
    unsigned char* kst = sm + OFF_K + (tid >> 3) * KROW + (tid & 7) * 16; unsigned char* vst = sm + OFF_V + (tid >> 3) * VROW + (tid & 7) * 16;
#define NSA_LOAD(jj, KR, VR) do { KR = *(const u32x4*)(kp + (size_t)(jj) * 4096); if (MODE != 0) VR = *(const u32x4*)(vp_ + (jj) * 64); } while (0)
#define NSA_STORE(buf, KR, VR) do { *(u32x4*)(kst + (buf) * KBUF) = KR; if (MODE != 0) { *(u32x2*)(vst + (buf) * VBUF) = (u32x2){VR.x, VR.y}; *(u32x2*)(vst + (buf) * VBUF + 8) = (u32x2){VR.z, VR.w}; } } while (0)
    int j = next_bit(m0, m1, m2, m3, 0);
    int j1 = j < 128 ? next_bit(m0, m1, m2, m3, j + 1) : 128;
    u32x4 kA, vA, kB, vB;
    if (j < 128) { NSA_LOAD(j, kA, vA); if (j1 < 128) NSA_LOAD(j1, kB, vB); NSA_STORE(0, kA, vA); }
    __syncthreads();
    bool initd = (MODE == 1);
    f32x16 negm;
#pragma unroll
    for (int r = 0; r < 16; ++r) negm[r] = (MODE == 1) ? -m : 0.f;
    while (j < 128) {
        {
            const int j2 = j1 < 128 ? next_bit(m0, m1, m2, m3, j1 + 1) : 128;
            if (j2 < 128) NSA_LOAD(j2, kA, vA);
            compute_tile<MODE, SEL>(sm, 0, j, qf, lo, hi_b, lo_max, hi_min, s0, s1, s2, s3, m, l, invl, initd, negm, o, imp_row, wsc, i, hi);
            if (j1 < 128) NSA_STORE(1, kB, vB);
            __syncthreads();
            j = j1; j1 = j2;
        }
        if (j >= 128) break;
        {
            const int j2 = j1 < 128 ? next_bit(m0, m1, m2, m3, j1 + 1) : 128;
            if (j2 < 128) NSA_LOAD(j2, kB, vB);
            compute_tile<MODE, SEL>(sm, 1, j, qf, lo, hi_b, lo_max, hi_min, s0, s1, s2, s3, m, l, invl, initd, negm, o, imp_row, wsc, i, hi);
            if (j1 < 128) NSA_STORE(0, kA, vA);
            __syncthreads();
            j = j1; j1 = j2;
        }
    }
#undef NSA_LOAD
#undef NSA_STORE
}
template <bool FIRST> __device__ __forceinline__ void add_scaled(float* accw, const f32x16 (&o)[2], float f, float* wsc, int i, int hi, int lane) {
    if (hi == 0) wsc[i] = f;
    asm volatile("" ::: "memory");
#pragma unroll
    for (int rg = 0; rg < 4; ++rg) { const f32x4 a4 = *(const f32x4*)(wsc + 8 * rg + 4 * hi);
#pragma unroll
        for (int e = 0; e < 4; ++e)
#pragma unroll
            for (int dt = 0; dt < 2; ++dt) { float* p = accw + (dt * 16 + 4 * rg + e) * 64 + lane; const float v = a4[e] * o[dt][4 * rg + e]; *p = FIRST ? v : (*p + v); } }
    asm volatile("" ::: "memory");
}
__device__ __forceinline__ void unit(const NsaArgs& a, int u, unsigned char* sm) {
    const int tid = tidx(), lane = tid & 63, w = __builtin_amdgcn_readfirstlane(tid >> 6), i = lane & 31, hi = lane >> 5;
    const int cur = 127 - (u >> 2), bg = u & 3, b = bg >> 1, g = bg & 1, q0 = cur * 64;
    const int ql = 8 * w + (i >> 2), hd = i & 3, t = q0 + ql;
    const size_t grow = (size_t)b * T_ + t;
    bf16x8 qf[4];
    { const bf16* qp = a.qb + grow * 512 + g * 256 + hd * 64 + 8 * hi;
#pragma unroll
      for (int d0 = 0; d0 < 4; ++d0) qf[d0] = *(const bf16x8*)(qp + 16 * d0); }
    float* wsc = (float*)(sm + OFF_WS) + w * 32;
    float* imp = (float*)(sm + OFF_IMP);
    unsigned* selw = (unsigned*)(sm + OFF_SEL);
    unsigned* um = (unsigned*)(sm + OFF_UM);
    for (int k = tid; k < 64 * IMPW; k += 512) imp[k] = 0.f;
    if (tid < 4) um[tid] = 0u;
    const float* gt = a.gates + grow * 24 + g * 12 + hd * 3;
    const float gc = gt[0], gs = gt[1], gw = gt[2];
    f32x16 o[2];
    float* accw = (float*)(sm + OFF_ACC) + w * 2048;
    const int tw0 = q0 + 8 * w, tw1 = tw0 + 7;
    {
        const int nv = t < 31 ? 0 : (t - 31) / 16 + 1;
        const int nvw = tw0 < 31 ? 0 : (tw0 - 31) / 16 + 1;
        const int nvmax = (q0 + 63 - 31) / 16 + 1, ntc = (nvmax + 63) / 64;
        const unsigned cm0 = ntc >= 32 ? ~0u : ((1u << ntc) - 1u);
        const Branch br{a.kc + (size_t)bg * NCP * 64, a.vct + (size_t)bg * 64 * NCP, NCP};
        float m = 0.f, l = 0.f;
        run_branch<0, false>(sm, br, cm0, 0u, 0u, 0u, qf, 0, nv - 1, 0, nvw - 1, 0u, 0u, 0u, 0u, m, l, 0.f, o, nullptr, wsc, tid, lane);
        l += __shfl_xor(l, 32);
        const float invl = 1.f / fmaxf(l, 1e-30f);
#pragma unroll
        for (int r = 0; r < 16; ++r) { o[0][r] = 0.f; o[1][r] = 0.f; }
        run_branch<1, false>(sm, br, cm0, 0u, 0u, 0u, qf, 0, nv - 1, 0, nvw - 1, 0u, 0u, 0u, 0u, m, l, invl, o, imp + ql * IMPW, wsc, tid, lane);
        add_scaled<true>(accw, o, gc, wsc, i, hi, lane);
    }
    {
        unsigned u0 = 0u, u1 = 0u, u2 = 0u, u3 = 0u;
        const int ncand = cur - 2;
        unsigned k0[8], k1[8], k2[8], k3[8];
        if (ncand <= 13) {
#pragma unroll
            for (int wd = 0; wd < 4; ++wd) { const int nb = cur + 1 - 32 * wd; const unsigned x = nb >= 32 ? ~0u : (nb <= 0 ? 0u : ((1u << nb) - 1u));
#pragma unroll
                for (int qq = 0; qq < 8; ++qq) { if (wd == 0) k0[qq] = x; else if (wd == 1) k1[qq] = x; else if (wd == 2) k2[qq] = x; else k3[qq] = x; } }
        } else {
            float v0[8], v1[8];
#pragma unroll
            for (int qq = 0; qq < 8; ++qq) { const float* ir = imp + (8 * w + qq) * IMPW;
                v0[qq] = (lane >= 1 && lane <= cur - 2) ? ir[lane] : -1.f; v1[qq] = (lane + 64 <= cur - 2) ? ir[lane + 64] : -1.f;
                k0[qq] = 1u; k1[qq] = 0u; k2[qq] = 0u; k3[qq] = 0u; }
            for (int it = 0; it < 13; ++it) {
                float bv[8]; int bs[8];
#pragma unroll
                for (int qq = 0; qq < 8; ++qq) { bv[qq] = v0[qq]; bs[qq] = lane; if (v1[qq] > v0[qq]) { bv[qq] = v1[qq]; bs[qq] = lane + 64; } }
#pragma unroll
                for (int off = 1; off < 64; off <<= 1) {
#pragma unroll
                    for (int qq = 0; qq < 8; ++qq) { const float ov = __shfl_xor(bv[qq], off); const int os = __shfl_xor(bs[qq], off);
                        if (ov > bv[qq] || (ov == bv[qq] && os < bs[qq])) { bv[qq] = ov; bs[qq] = os; } } }
#pragma unroll
                for (int qq = 0; qq < 8; ++qq) { const int b_ = __builtin_amdgcn_readfirstlane(bs[qq]);
                    if (b_ == lane) v0[qq] = -1.f; if (b_ == lane + 64) v1[qq] = -1.f;
                    const unsigned bit = 1u << (b_ & 31);
                    if (b_ < 32) k0[qq] |= bit; else if (b_ < 64) k1[qq] |= bit; else if (b_ < 96) k2[qq] |= bit; else k3[qq] |= bit; }
            }
            { const int c1 = cur - 1; const unsigned b1 = 1u << (c1 & 31), b2 = 1u << (cur & 31);
#pragma unroll
              for (int qq = 0; qq < 8; ++qq) {
                if (c1 < 32) k0[qq] |= b1; else if (c1 < 64) k1[qq] |= b1; else if (c1 < 96) k2[qq] |= b1; else k3[qq] |= b1;
                if (cur < 32) k0[qq] |= b2; else if (cur < 64) k1[qq] |= b2; else if (cur < 96) k2[qq] |= b2; else k3[qq] |= b2; } }
        }
#pragma unroll
        for (int qq = 0; qq < 8; ++qq) {
            if (lane == 0) { unsigned* sp = selw + (8 * w + qq) * 4; sp[0] = k0[qq]; sp[1] = k1[qq]; sp[2] = k2[qq]; sp[3] = k3[qq]; }
            u0 |= k0[qq]; u1 |= k1[qq]; u2 |= k2[qq]; u3 |= k3[qq]; }
        if (lane == 0) { atomicOr(um + 0, u0); atomicOr(um + 1, u1); atomicOr(um + 2, u2); atomicOr(um + 3, u3); }
    }
    __syncthreads();
    {
        const unsigned U0 = um[0], U1 = um[1], U2 = um[2], U3 = um[3];
        const unsigned* sp = selw + ql * 4; const unsigned s0 = sp[0], s1 = sp[1], s2 = sp[2], s3 = sp[3];
        const Branch br{a.ks + (size_t)bg * T_ * 64, a.vst + (size_t)bg * 64 * T_, T_};
        float m = 0.f, l = 0.f;
#pragma unroll
        for (int r = 0; r < 16; ++r) { o[0][r] = 0.f; o[1][r] = 0.f; }
        run_branch<2, true>(sm, br, __builtin_amdgcn_readfirstlane(U0), __builtin_amdgcn_readfirstlane(U1), __builtin_amdgcn_readfirstlane(U2), __builtin_amdgcn_readfirstlane(U3),
                            qf, 0, t, 0, tw0, s0, s1, s2, s3, m, l, 0.f, o, nullptr, wsc, tid, lane);
        l += __shfl_xor(l, 32);
        add_scaled<false>(accw, o, gs / fmaxf(l, 1e-30f), wsc, i, hi, lane);
    }
    {
        const int j0 = cur - 8 > 0 ? cur - 8 : 0;
        unsigned wm0 = 0u, wm1 = 0u, wm2 = 0u, wm3 = 0u;
#pragma unroll
        for (int wd = 0; wd < 4; ++wd) { const int a0 = j0 - 32 * wd, a1 = cur + 1 - 32 * wd;
            const unsigned hi_m = a1 >= 32 ? ~0u : (a1 <= 0 ? 0u : ((1u << a1) - 1u)), lo_m = a0 >= 32 ? ~0u : (a0 <= 0 ? 0u : ((1u << a0) - 1u));
            const unsigned x = hi_m & ~lo_m; if (wd == 0) wm0 = x; else if (wd == 1) wm1 = x; else if (wd == 2) wm2 = x; else wm3 = x; }
        const Branch br{a.kw + (size_t)bg * T_ * 64, a.vwt + (size_t)bg * 64 * T_, T_};
        float m = 0.f, l = 0.f;
#pragma unroll
        for (int r = 0; r < 16; ++r) { o[0][r] = 0.f; o[1][r] = 0.f; }
        run_branch<2, false>(sm, br, wm0, wm1, wm2, wm3, qf, t - 511, t, tw1 - 511, tw0, 0u, 0u, 0u, 0u, m, l, 0.f, o, nullptr, wsc, tid, lane);
        l += __shfl_xor(l, 32);
        add_scaled<false>(accw, o, gw / fmaxf(l, 1e-30f), wsc, i, hi, lane);
    }
#pragma unroll
    for (int r = 0; r < 16; ++r) { const int rw = crow(r, hi), qq = 8 * w + (rw >> 2), hh = rw & 3;
        bf16* op = a.amix + ((size_t)b * T_ + q0 + qq) * DM + g * 256 + hh * 64 + i;
        op[0] = (bf16)f2bf(accw[r * 64 + lane]); op[32] = (bf16)f2bf(accw[(16 + r) * 64 + lane]); }
}
__device__ __forceinline__ void phase(const NsaArgs& a, unsigned* ctr, unsigned char* sm) {
    int* slot = (int*)(sm + OFF_UNIT);
    for (;;) {
        if (tidx() == 0) *slot = (int)atomicAdd(ctr, 1u);
        __syncthreads();
        const int u = *slot;
        __syncthreads();
        if (u >= 512) break;
        unit(a, u, sm);
    }
}
}

__device__ __forceinline__ void d_lora_prep(const bf16* pr, const float* mu, bf16* la, int wg0 = 0) {
    if ((int)blockIdx.x < wg0) return;
    const int T512 = tidx(), c = T512 & 255;
    const float m = mu[1536 + c];
    for (int vb = ((int)blockIdx.x - wg0) * 2 + (T512 >> 8); vb < M_ / 4; vb += ((int)gridDim.x - wg0) * 2) {
        const int row0 = vb * 4;
        float x[5];
        x[0] = (row0 % T_) ? bf2f(pr[(size_t)(row0 - 1) * 256 + c]) : 0.f;
#pragma unroll
        for (int j = 0; j < 4; ++j) x[j + 1] = bf2f(pr[(size_t)(row0 + j) * 256 + c]);
#pragma unroll
        for (int j = 0; j < 4; ++j) { const float xs = x[j + 1] + (x[j] - x[j + 1]) * m;
            const float v = c < 64 ? tanhf(xs) : (c < 128 ? xs : sigmoidf_(xs));
            la[(size_t)(row0 + j) * KLORA + c] = (bf16)f2bf(v); }
    }
}

namespace rw7 {
using nsa::f32x16; using nsa::crow; using nsa::pack8;
constexpr int NHELP = 2, RG = 18;
constexpr int NPROD = 6, RING = 7, RA = 144, RB = 40, S_AT = 0, S_RT = 16 * RA, S_BT = 32 * RA, S_KT = S_BT + 64 * RB, S_VT = S_KT + 64 * RB, S_SM = S_VT + 64 * RB, SMM = 16 * RB, S_GC = S_SM + 4 * SMM, SLOT = S_GC + 256;
constexpr int OFF_SCR = RING * SLOT, SCR = 32 * RA, LDS_NEED = OFF_SCR;
static_assert(NPROD % NHELP == 0 && LDS_NEED <= 147456 - 64 && 7 * (SLOT + SCR) <= 147456 - 64 && (size_t)16 * NHELP * RG * SLOT <= (size_t)9 << 20 && SLOT % 16 == 0 && S_BT % 16 == 0 && 128 * RB >= 4096 && SCR >= 4096, "rw7 lds map");
struct Args { const unsigned* rkw; const bf16* vv; const bf16* aga; const float* wdec; const float *mu, *kk, *ka, *rk; float* yraw; float* bonus; unsigned char* ring; unsigned* flags; unsigned* cons; };
__device__ __forceinline__ void wg_bar() { asm volatile("s_waitcnt lgkmcnt(0)" ::: "memory"); __builtin_amdgcn_s_barrier(); asm volatile("" ::: "memory"); }
struct Chan { float mur, muk, muv, kkc, kac, rkc; };
struct Raw { unsigned rk[16]; unsigned short v[16], al[16]; float w[16]; unsigned prk; unsigned short pv; };
__device__ __forceinline__ void fetch(const Args& a, int b, int h, int c, int lane, Raw& q) {
    const size_t base = ((size_t)b * T_ + (size_t)c * 16) * 512 + h * 64 + lane;
#pragma unroll
    for (int t = 0; t < 16; ++t) { q.rk[t] = a.rkw[base + (size_t)t * 512]; q.v[t] = a.vv[base + (size_t)t * 512]; q.al[t] = a.aga[base + (size_t)t * 512]; q.w[t] = a.wdec[base + (size_t)t * 512]; }
    q.prk = 0u; q.pv = 0;
    if (c > 0) { q.prk = a.rkw[base - 512]; q.pv = a.vv[base - 512]; }
}
__device__ __forceinline__ void st_row40(unsigned char* p, const unsigned (&w)[8]) {
    *(u32x2*)p = (u32x2){w[0], w[1]}; *(u32x2*)(p + 8) = (u32x2){w[2], w[3]}; *(u32x2*)(p + 16) = (u32x2){w[4], w[5]}; *(u32x2*)(p + 24) = (u32x2){w[6], w[7]};
}
template <bool BAR> __device__ __forceinline__ void seg_end() { if (BAR) wg_bar(); else { asm volatile("s_waitcnt lgkmcnt(0)" ::: "memory"); __builtin_amdgcn_sched_barrier(0); } }
template <bool BAR> __device__ __forceinline__ void produce(const Args& a, const Chan& ch, int b, int h, int c, const Raw& q, unsigned char* slot, unsigned char* scr, int lane) {
    const int i = lane & 31, hi = lane >> 5;
    const size_t row0 = (size_t)b * T_ + (size_t)c * 16;
    float pr_r = __builtin_bit_cast(float, q.prk << 16), pr_k = __builtin_bit_cast(float, q.prk & 0xffff0000u), pr_v = bf2f(q.pv);
    float rr[16], kq[16], kt[16];
    float* RED1 = (float*)scr;
    float* RED2 = (float*)(slot + S_BT);
#pragma unroll
    for (int t4 = 0; t4 < 4; ++t4) { f32x4 e1, e2;
#pragma unroll
        for (int e = 0; e < 4; ++e) { const int t = 4 * t4 + e;
            const float r0 = __builtin_bit_cast(float, q.rk[t] << 16), k0 = __builtin_bit_cast(float, q.rk[t] & 0xffff0000u), al = bf2f(q.al[t]);
            const float r = r0 + (pr_r - r0) * ch.mur, k = k0 + (pr_k - k0) * ch.muk;
            pr_r = r0; pr_k = k0;
            rr[t] = r; kq[t] = k * ch.kkc; kt[t] = k * (1.f + (al - 1.f) * ch.kac);
            e1[e] = kq[t] * kq[t]; e2[e] = r * kt[t] * ch.rkc; }
        *(f32x4*)(RED1 + lane * 16 + 4 * t4) = e1; *(f32x4*)(RED2 + lane * 16 + 4 * t4) = e2; }
    seg_end<BAR>();
    { const int t = lane & 15, part = lane >> 4; float s1 = 0.f, s2 = 0.f;
#pragma unroll
      for (int j = 0; j < 16; ++j) { s1 += RED1[(part * 16 + j) * 16 + t]; s2 += RED2[(part * 16 + j) * 16 + t]; }
      s1 += __shfl_xor(s1, 16); s2 += __shfl_xor(s2, 16); s1 += __shfl_xor(s1, 32); s2 += __shfl_xor(s2, 32);
      asm volatile("s_waitcnt lgkmcnt(0)" ::: "memory");
      if (lane < 16) { ((float*)(slot + S_GC))[lane] = s1; a.bonus[(row0 + lane) * 8 + h] = s2; } }
    asm volatile("s_waitcnt lgkmcnt(0)" ::: "memory");
    f32x4 n2[4];
#pragma unroll
    for (int t4 = 0; t4 < 4; ++t4) n2[t4] = *(const f32x4*)(slot + S_GC + 16 * t4);
    asm volatile("s_waitcnt lgkmcnt(0)" ::: "memory");
    float gam = 1.f;
    unsigned btp[8], ktp[8], vtp[8];
    float b_ev = 0.f, k_ev = 0.f, v_ev = 0.f;
#pragma unroll
    for (int t = 0; t < 16; ++t) {
        if (t == 6) seg_end<BAR>();
        const float v0 = bf2f(q.v[t]), al = bf2f(q.al[t]);
        const float v = v0 + (pr_v - v0) * ch.muv; pr_v = v0;
        const float kkn = kq[t] * __builtin_amdgcn_rsqf(fmaxf(n2[t >> 2][t & 3], 1e-24f));
        const float gp = gam; gam *= q.w[t]; const float ig = __builtin_amdgcn_rcpf(gam);
        const float bt_ = kkn * al * ig, kt_ = kt[t] * ig;
        const unsigned ar = pk2(-kkn * gp, rr[t] * gam), bk = pk2(bt_, kt_);
        *(bf16*)(slot + S_AT + t * RA + lane * 2) = (bf16)(ar & 0xffffu); *(bf16*)(slot + S_RT + t * RA + lane * 2) = (bf16)(ar >> 16);
        *(bf16*)(scr + t * RA + lane * 2) = (bf16)(bk & 0xffffu); *(bf16*)(scr + (16 + t) * RA + lane * 2) = (bf16)(bk >> 16);
        if (t & 1) { btp[t >> 1] = pk2(b_ev, bt_); ktp[t >> 1] = pk2(k_ev, kt_); vtp[t >> 1] = pk2(v_ev, v); }
        else { b_ev = bt_; k_ev = kt_; v_ev = v; }
    }
    st_row40(slot + S_BT + lane * RB, btp); st_row40(slot + S_KT + lane * RB, ktp); st_row40(slot + S_VT + lane * RB, vtp);
    ((float*)(slot + S_GC))[lane] = gam;
    seg_end<BAR>();
    f32x16 C;
#pragma unroll
    for (int r = 0; r < 16; ++r) C[r] = 0.f;
#pragma unroll
    for (int ks = 0; ks < 4; ++ks) {
        const bf16x8 af = *(const bf16x8*)(slot + S_AT + i * RA + (16 * ks + 8 * hi) * 2);
        const bf16x8 bf = *(const bf16x8*)(scr + i * RA + (16 * ks + 8 * hi) * 2);
        C = __builtin_amdgcn_mfma_f32_32x32x16_bf16(af, bf, C, 0, 0, 0);
    }
    asm volatile("s_waitcnt lgkmcnt(0)" ::: "memory");
    float* AAB = (float*)scr;
    unsigned char* SM = slot + S_SM;
#pragma unroll
    for (int r = 0; r < 16; ++r) {
        const int rho = crow(r, hi); const float val = C[r];
        if (r < 8) {
            if (i < 16) AAB[rho * 16 + i] = (i < rho) ? val : 0.f;
            else *(bf16*)(SM + SMM + rho * RB + (i - 16) * 2) = (bf16)f2bf((i - 16 < rho) ? val : 0.f);
        } else {
            const int tt = rho - 16;
            if (i < 16) *(bf16*)(SM + 2 * SMM + tt * RB + i * 2) = (bf16)f2bf((i <= tt) ? val : 0.f);
            else *(bf16*)(SM + 3 * SMM + tt * RB + (i - 16) * 2) = (bf16)f2bf((i - 16 <= tt) ? val : 0.f);
        }
    }
    seg_end<BAR>();
    { const int j = lane & 15; float Tr[16];
#pragma unroll
      for (int t = 0; t < 16; ++t) { if (t == 11) seg_end<BAR>();
          float acc = (t == j) ? 1.f : 0.f;
#pragma unroll
          for (int s4 = 0; s4 < (t + 3) / 4; ++s4) { const f32x4 ar = *(const f32x4*)(AAB + t * 16 + 4 * s4);
#pragma unroll
              for (int e = 0; e < 4; ++e) if (4 * s4 + e < t) acc += ar[e] * Tr[4 * s4 + e]; }
          Tr[t] = acc;
          if (lane < 16) *(bf16*)(SM + t * RB + j * 2) = (bf16)f2bf(acc); } }
    seg_end<BAR>();
}

__device__ __forceinline__ bf16x8 rd_perm(const unsigned char* p, int hi) {
    const u32x2 a = *(const u32x2*)(p + 8 * hi), b = *(const u32x2*)(p + 16 + 8 * hi);
    return __builtin_bit_cast(bf16x8, (u32x4){a.x, a.y, b.x, b.y});
}
__device__ __forceinline__ bf16x8 rd_nat(const unsigned char* p, int hi) {
    const u32x2 a = *(const u32x2*)(p + 16 * hi), b = *(const u32x2*)(p + 16 * hi + 8);
    return __builtin_bit_cast(bf16x8, (u32x4){a.x, a.y, b.x, b.y});
}
__device__ __forceinline__ bf16x8 and8(bf16x8 f, unsigned m) { u32x4 w = __builtin_bit_cast(u32x4, f); w.x &= m; w.y &= m; w.z &= m; w.w &= m; return __builtin_bit_cast(bf16x8, w); }
__device__ __forceinline__ void consume(const unsigned char* slot, f32x16 (&z)[2], float* yout, int vt, int lane) {
    const int i = lane & 31, hi = lane >> 5, i16 = i & 15;
    const unsigned m16 = i < 16 ? 0xffffffffu : 0u;
    const unsigned char* at = slot + S_AT + i16 * RA; const unsigned char* rt = slot + S_RT + i16 * RA; const unsigned char* sm16 = slot + S_SM + i16 * RB;
    bf16x8 fa0 = rd_perm(at, hi), fa1 = rd_perm(at + 32, hi), fa2 = rd_perm(at + 64, hi), fa3 = rd_perm(at + 96, hi);
    bf16x8 fak = rd_nat(sm16 + SMM, hi), ft = rd_perm(sm16, hi);
    const bf16x8 vtf = rd_nat(slot + S_VT + (32 * vt + i) * RB, hi);
    bf16x8 fr0 = rd_perm(rt, hi), fr1 = rd_perm(rt + 32, hi), fr2 = rd_perm(rt + 64, hi), fr3 = rd_perm(rt + 96, hi);
    bf16x8 frb = rd_perm(sm16 + 2 * SMM, hi), frk = rd_nat(sm16 + 3 * SMM, hi);
    const bf16x8 fk0 = rd_nat(slot + S_KT + i * RB, hi), fk1 = rd_nat(slot + S_KT + (32 + i) * RB, hi);
    const bf16x8 fb0 = rd_perm(slot + S_BT + i * RB, hi), fb1 = rd_perm(slot + S_BT + (32 + i) * RB, hi);
    f32x4 g4[2][4];
#pragma unroll
    for (int kt = 0; kt < 2; ++kt)
#pragma unroll
        for (int rg = 0; rg < 4; ++rg) g4[kt][rg] = *(const f32x4*)(slot + S_GC + (32 * kt + 8 * rg + 4 * hi) * 4);
    const bf16x8 zb0 = pack8(z[0], 0), zb1 = pack8(z[0], 8), zb2 = pack8(z[1], 0), zb3 = pack8(z[1], 8);
    fa0 = and8(fa0, m16); fa1 = and8(fa1, m16); fa2 = and8(fa2, m16); fa3 = and8(fa3, m16); fak = and8(fak, m16); ft = and8(ft, m16);
    fr0 = and8(fr0, m16); fr1 = and8(fr1, m16); fr2 = and8(fr2, m16); fr3 = and8(fr3, m16); frb = and8(frb, m16); frk = and8(frk, m16);
    f32x16 X, U, Y;
#pragma unroll
    for (int r = 0; r < 16; ++r) { X[r] = 0.f; U[r] = 0.f; Y[r] = 0.f; }
    X = __builtin_amdgcn_mfma_f32_32x32x16_bf16(fa0, zb0, X, 0, 0, 0);
    X = __builtin_amdgcn_mfma_f32_32x32x16_bf16(fa1, zb1, X, 0, 0, 0);
    X = __builtin_amdgcn_mfma_f32_32x32x16_bf16(fa2, zb2, X, 0, 0, 0);
    X = __builtin_amdgcn_mfma_f32_32x32x16_bf16(fa3, zb3, X, 0, 0, 0);
    X = __builtin_amdgcn_mfma_f32_32x32x16_bf16(fak, vtf, X, 0, 0, 0);
    Y = __builtin_amdgcn_mfma_f32_32x32x16_bf16(fr0, zb0, Y, 0, 0, 0);
    Y = __builtin_amdgcn_mfma_f32_32x32x16_bf16(fr1, zb1, Y, 0, 0, 0);
    Y = __builtin_amdgcn_mfma_f32_32x32x16_bf16(fr2, zb2, Y, 0, 0, 0);
    Y = __builtin_amdgcn_mfma_f32_32x32x16_bf16(fr3, zb3, Y, 0, 0, 0);
    Y = __builtin_amdgcn_mfma_f32_32x32x16_bf16(frk, vtf, Y, 0, 0, 0);
    z[0] = __builtin_amdgcn_mfma_f32_32x32x16_bf16(fk0, vtf, z[0], 0, 0, 0);
    z[1] = __builtin_amdgcn_mfma_f32_32x32x16_bf16(fk1, vtf, z[1], 0, 0, 0);
    const bf16x8 xb = pack8(X, 0);
    U = __builtin_amdgcn_mfma_f32_32x32x16_bf16(ft, xb, U, 0, 0, 0);
    const bf16x8 ub = pack8(U, 0);
    z[0] = __builtin_amdgcn_mfma_f32_32x32x16_bf16(fb0, ub, z[0], 0, 0, 0);
    z[1] = __builtin_amdgcn_mfma_f32_32x32x16_bf16(fb1, ub, z[1], 0, 0, 0);
    Y = __builtin_amdgcn_mfma_f32_32x32x16_bf16(frb, ub, Y, 0, 0, 0);
#pragma unroll
    for (int kt = 0; kt < 2; ++kt)
#pragma unroll
        for (int rg = 0; rg < 4; ++rg)
#pragma unroll
            for (int e = 0; e < 4; ++e) z[kt][4 * rg + e] *= g4[kt][rg][e];
#pragma unroll
    for (int r = 0; r < 8; ++r) yout[(size_t)crow(r, hi) * 512] = Y[r];
}

__device__ __forceinline__ unsigned ld_relaxed(const unsigned* p) { return __hip_atomic_load(p, __ATOMIC_RELAXED, __HIP_MEMORY_SCOPE_AGENT); }
__device__ __forceinline__ void head(const Args& a, int bh, unsigned char* sm) {
    const int tid = tidx(), lane = tid & 63, w = __builtin_amdgcn_readfirstlane(tid >> 6);
    const int b = bh >> 3, h = bh & 7;
    constexpr int NCH = T_ / 16, NBAR = NCH + NPROD;
    if (w < 2) {
        f32x16 z[2];
#pragma unroll
        for (int r = 0; r < 16; ++r) { z[0][r] = 0.f; z[1][r] = 0.f; }
        for (int i = 0; i < NPROD; ++i) wg_bar();
        for (int c = 0; c < NCH; ++c) {
            consume(sm + (size_t)(c % RING) * SLOT, z, a.yraw + ((size_t)b * T_ + (size_t)c * 16) * 512 + h * 64 + 32 * w + (lane & 31), w, lane);
            if (w == 0 && (c & 7) == 7 && lane == 0) __hip_atomic_store(a.cons + bh * 64, (unsigned)(c + 1), __ATOMIC_RELAXED, __HIP_MEMORY_SCOPE_AGENT);
            wg_bar();
        }
    } else {
        const int pw = w - 2;
        int nb = pw;
        {
            u32x4 v[15];
            { const int c = pw; const int hl = c % NHELP, n = c / NHELP;
              const unsigned char* g = a.ring + ((size_t)(bh * NHELP + hl) * RG + (n % RG)) * SLOT;
              while (__builtin_amdgcn_readfirstlane(ld_relaxed(a.flags + bh * NCH + c)) == 0u) __builtin_amdgcn_s_sleep(2);
              __builtin_amdgcn_fence(__ATOMIC_ACQUIRE, "agent");
              asm volatile("s_waitcnt vmcnt(0)" ::: "memory");
#pragma unroll
              for (int i = 0; i < 15; ++i) { const int off = (i * 64 + lane) * 16; if (off < SLOT) v[i] = *(const u32x4*)(g + off); } }
            for (int i = 0; i < pw; ++i) wg_bar();
            for (int c = pw; c < NCH; c += NPROD) {
                unsigned char* slot = sm + (size_t)(c % RING) * SLOT;
#pragma unroll
                for (int i = 0; i < 15; ++i) { const int off = (i * 64 + lane) * 16; if (off < SLOT) *(u32x4*)(slot + off) = v[i]; }
                const int cn = c + NPROD; const bool more = cn < NCH;
                const unsigned* fp = a.flags + bh * NCH + (more ? cn : c);
                unsigned fl = ld_relaxed(fp);
                wg_bar(); wg_bar();
                if (more) {
                    while (__builtin_amdgcn_readfirstlane(fl) == 0u) { __builtin_amdgcn_s_sleep(2); fl = ld_relaxed(fp); }
                    __builtin_amdgcn_fence(__ATOMIC_ACQUIRE, "agent");
                    asm volatile("s_waitcnt vmcnt(0)" ::: "memory");
                    const int hl = cn % NHELP, n = cn / NHELP;
                    const unsigned char* g = a.ring + ((size_t)(bh * NHELP + hl) * RG + (n % RG)) * SLOT;
#pragma unroll
                    for (int i = 0; i < 15; ++i) { const int off = (i * 64 + lane) * 16; if (off < SLOT) v[i] = *(const u32x4*)(g + off); }
                }
                wg_bar(); wg_bar(); wg_bar(); wg_bar();
                nb += NPROD;
            }
        }
        for (; nb < NBAR; ++nb) wg_bar();
    }
}
constexpr int NHW = 7;
__device__ __forceinline__ void helper(const Args& a, int bh, int hl, unsigned char* sm) {
    const int tid = tidx(), lane = tid & 63, w = __builtin_amdgcn_readfirstlane(tid >> 6);
    if (w >= NHW) return;
    const int b = bh >> 3, h = bh & 7, col = h * 64 + lane;
    constexpr int NCH = T_ / 16;
    unsigned char* slot = sm + (size_t)w * SLOT; unsigned char* scr = sm + NHW * SLOT + w * SCR;
    const Chan ch{a.mu[col], a.mu[512 + col], a.mu[1024 + col], a.kk[col], a.ka[col], a.rk[col]};
    int n = w, c = NHELP * n + hl;
    if (c >= NCH) return;
    for (; c < NCH; n += NHW, c += NHW * NHELP) {
        Raw q; fetch(a, b, h, c, lane, q);
        if (n >= RG) { const unsigned need = (unsigned)(c - RG * NHELP + 1);
            while (__builtin_amdgcn_readfirstlane(ld_relaxed(a.cons + bh * 64)) < need) __builtin_amdgcn_s_sleep(8); }
        produce<false>(a, ch, b, h, c, q, slot, scr, lane);
        asm volatile("s_waitcnt lgkmcnt(0)" ::: "memory");
        unsigned char* g = a.ring + ((size_t)(bh * NHELP + hl) * RG + (n % RG)) * SLOT;
#pragma unroll
        for (int i = 0; i < 15; ++i) { const int off = (i * 64 + lane) * 16;
            if (off < SLOT) { const u32x4 d = *(const u32x4*)(slot + off); unsigned char* gp = g + off; asm volatile("global_store_dwordx4 %0, %1, off sc1\n\ts_nop 1" :: "v"(gp), "v"(d) : "memory"); } }
        asm volatile("s_waitcnt vmcnt(0)" ::: "memory");
        if (lane == 0) __hip_atomic_store(a.flags + bh * NCH + c, 1u, __ATOMIC_RELAXED, __HIP_MEMORY_SCOPE_AGENT);
    }
}
__device__ __forceinline__ void finish(const float* yraw, const float* bonus, const bf16* vv, const bf16* agg, const float* mu, const float* gng, const float* gnb, bf16* amix) {
    const int T512 = tidx(), lane = T512 & 63;
    for (int row = blockIdx.x * 8 + (T512 >> 6); row < M_; row += gridDim.x * 8) {
        const int t = row % T_;
        float y[8], v0[8], v1[8], gg[8], bo[8];
#pragma unroll
        for (int j = 0; j < 8; ++j) { const int col = j * 64 + lane;
            y[j] = yraw[(size_t)row * 512 + col]; v0[j] = bf2f(vv[(size_t)row * 512 + col]); v1[j] = t ? bf2f(vv[(size_t)(row - 1) * 512 + col]) : 0.f;
            gg[j] = bf2f(agg[(size_t)row * 512 + col]); bo[j] = bonus[(size_t)row * 8 + j]; }
        float mean[8], var[8];
#pragma unroll
        for (int j = 0; j < 8; ++j) mean[j] = y[j];
#pragma unroll
        for (int o = 1; o < 64; o <<= 1) {
#pragma unroll
            for (int j = 0; j < 8; ++j) mean[j] += __shfl_xor(mean[j], o); }
#pragma unroll
        for (int j = 0; j < 8; ++j) { mean[j] *= (1.f / 64.f); y[j] -= mean[j]; var[j] = y[j] * y[j]; }
#pragma unroll
        for (int o = 1; o < 64; o <<= 1) {
#pragma unroll
            for (int j = 0; j < 8; ++j) var[j] += __shfl_xor(var[j], o); }
#pragma unroll
        for (int j = 0; j < 8; ++j) { const int col = j * 64 + lane;
            const float yn = y[j] * rsqrtf(var[j] * (1.f / 64.f) + 64e-5f) * gng[col] + gnb[col];
            const float v = v0[j] + (v1[j] - v0[j]) * mu[1024 + col];
            amix[(size_t)row * DM + 512 + col] = (bf16)f2bf((yn + bo[j] * v) * gg[j]); }
    }
}
}

namespace mema {
using nsa::f32x16; using nsa::KROW; using nsa::VROW; using nsa::KBUF; using nsa::VBUF; using nsa::OFF_K; using nsa::OFF_V; using nsa::OFF_WS; using nsa::crow; using nsa::pack8;
__device__ __forceinline__ void unit(const bf16* qm, const bf16* mk, const bf16* mvt, bf16* om, int u, unsigned char* sm) {
    const int tid = tidx(), lane = tid & 63, w = __builtin_amdgcn_readfirstlane(tid >> 6), i = lane & 31, hi = lane >> 5;
    const int b = u >> 7, h = (u >> 5) & 3, rb = u & 31;
    const int row0 = b * T_ + rb * 256 + 32 * w;
    const bf16* qrow = qm + (size_t)(row0 + i) * DM + h * 256 + 8 * hi;
    const bf16* kbase = mk + (size_t)(b * 256 + (tid >> 3)) * DM + h * 256 + (tid & 7) * 8;
    const bf16* vbase = mvt + (size_t)(h * 256 + (tid >> 3)) * 512 + b * 256 + (tid & 7) * 8;
    unsigned char* kst = sm + OFF_K + (tid >> 3) * KROW + (tid & 7) * 16;
    unsigned char* vst = sm + OFF_V + (tid >> 3) * VROW + (tid & 7) * 16;
    float* wsc = (float*)(sm + OFF_WS) + w * 32;
    f32x16 p[4][2];
#pragma unroll
    for (int kt = 0; kt < 4; ++kt)
#pragma unroll
        for (int r = 0; r < 16; ++r) { p[kt][0][r] = 0.f; p[kt][1][r] = 0.f; }
    u32x4 tr[4];
#define MEMA_SRC(n) ((n) < 16 ? (const u32x4*)(kbase + (size_t)(64 * ((n) & 3)) * DM + 64 * ((n) >> 2)) : (const u32x4*)(vbase + (size_t)(64 * (((n) - 16) >> 2)) * 512 + 64 * ((n) & 3)))
#define MEMA_PUT(n) do { if ((n) < 16) *(u32x4*)(kst + ((n) & 1) * KBUF) = tr[(n) & 3]; else { unsigned char* vp2_ = vst + ((n) & 1) * VBUF; *(u32x2*)vp2_ = (u32x2){tr[(n) & 3].x, tr[(n) & 3].y}; *(u32x2*)(vp2_ + 8) = (u32x2){tr[(n) & 3].z, tr[(n) & 3].w}; } } while (0)
    tr[0] = *MEMA_SRC(0); tr[1] = *MEMA_SRC(1); tr[2] = *MEMA_SRC(2);
    MEMA_PUT(0);
    __syncthreads();
    bf16x8 qf[4];
#pragma unroll
    for (int n = 0; n < 16; ++n) {
        const int dc = n >> 2, kt = n & 3, cb = n & 1;
        tr[(n + 3) & 3] = *MEMA_SRC(n + 3);
        if (kt == 0) {
#pragma unroll
            for (int d0 = 0; d0 < 4; ++d0) qf[d0] = *(const bf16x8*)(qrow + 64 * dc + 16 * d0);
        }
        const unsigned char* kb = sm + OFF_K + cb * KBUF;
#pragma unroll
        for (int d0 = 0; d0 < 4; ++d0) {
            const bf16x8 a0 = *(const bf16x8*)(kb + i * KROW + (16 * d0 + 8 * hi) * 2);
            const bf16x8 a1 = *(const bf16x8*)(kb + (32 + i) * KROW + (16 * d0 + 8 * hi) * 2);
            p[kt][0] = __builtin_amdgcn_mfma_f32_32x32x16_bf16(a0, qf[d0], p[kt][0], 0, 0, 0);
            p[kt][1] = __builtin_amdgcn_mfma_f32_32x32x16_bf16(a1, qf[d0], p[kt][1], 0, 0, 0);
        }
        MEMA_PUT(n + 1);
        __syncthreads();
    }
    float mx = p[0][0][0];
#pragma unroll
    for (int kt = 0; kt < 4; ++kt)
#pragma unroll
        for (int r = 0; r < 16; ++r) mx = fmaxf(mx, fmaxf(p[kt][0][r], p[kt][1][r]));
    mx = fmaxf(mx, __shfl_xor(mx, 32));
    float l = 0.f;
#pragma unroll
    for (int kt = 0; kt < 4; ++kt)
#pragma unroll
        for (int r = 0; r < 16; ++r) { p[kt][0][r] = __builtin_amdgcn_exp2f(p[kt][0][r] - mx); p[kt][1][r] = __builtin_amdgcn_exp2f(p[kt][1][r] - mx); l += p[kt][0][r] + p[kt][1][r]; }
    l += __shfl_xor(l, 32);
    bf16x8 pf[4][4];
#pragma unroll
    for (int kt = 0; kt < 4; ++kt) { pf[kt][0] = pack8(p[kt][0], 0); pf[kt][1] = pack8(p[kt][0], 8); pf[kt][2] = pack8(p[kt][1], 0); pf[kt][3] = pack8(p[kt][1], 8); }
    if (hi == 0) wsc[i] = 1.f / l;
    asm volatile("" ::: "memory");
    f32x4 il[4];
#pragma unroll
    for (int rg = 0; rg < 4; ++rg) il[rg] = *(const f32x4*)(wsc + 8 * rg + 4 * hi);
    f32x16 o[2];
#pragma unroll
    for (int n = 16; n < 32; ++n) {
        const int dvt = (n - 16) >> 2, kt = n & 3, cb = n & 1;
        if (n + 3 < 32) tr[(n + 3) & 3] = *MEMA_SRC(n + 3);
        if (kt == 0) {
#pragma unroll
            for (int r = 0; r < 16; ++r) { o[0][r] = 0.f; o[1][r] = 0.f; }
        }
        const unsigned char* vb = sm + OFF_V + cb * VBUF;
#pragma unroll
        for (int dt = 0; dt < 2; ++dt) {
            const unsigned char* vp = vb + (32 * dt + i) * VROW + 8 * hi;
#pragma unroll
            for (int ks = 0; ks < 4; ++ks) {
                const u32x2 v_lo = *(const u32x2*)(vp + 32 * ks), v_hi = *(const u32x2*)(vp + 32 * ks + 16);
                const bf16x8 vf = __builtin_bit_cast(bf16x8, (u32x4){v_lo.x, v_lo.y, v_hi.x, v_hi.y});
                o[dt] = __builtin_amdgcn_mfma_f32_32x32x16_bf16(pf[kt][ks], vf, o[dt], 0, 0, 0);
            }
        }
        if (kt == 3) {
#pragma unroll
            for (int r = 0; r < 16; ++r) { bf16* op = om + (size_t)(row0 + crow(r, hi)) * DM + h * 256 + 64 * dvt + i;
                op[0] = (bf16)f2bf(o[0][r] * il[r >> 2][r & 3]); op[32] = (bf16)f2bf(o[1][r] * il[r >> 2][r & 3]); }
        }
        if (n + 1 < 32) MEMA_PUT(n + 1);
        __syncthreads();
    }
#undef MEMA_SRC
#undef MEMA_PUT
}
}

#define LAS __attribute__((address_space(3)))
#define XB_TMO      128
#define XB_XCNT(j)  (256  + 64 * (j))
#define XB_XSUB(j)  (1280 + 64 * (j))
#define XB_XGEN(j)  (2304 + 64 * (j))
#define XB_TOP      3328
#define XB_TOPGEN   3392
#define XCD_BAR_WORDS 3456
#define XB_SPIN_CAP (1u << 18)

__device__ __forceinline__ unsigned xb_ld(unsigned* p)              { return __hip_atomic_load(p, __ATOMIC_RELAXED, __HIP_MEMORY_SCOPE_AGENT); }
__device__ __forceinline__ unsigned xb_add(unsigned* p, unsigned v) { return __hip_atomic_fetch_add(p, v, __ATOMIC_RELAXED, __HIP_MEMORY_SCOPE_AGENT); }
__device__ __forceinline__ unsigned xb_xcc_id() { return (unsigned)__builtin_amdgcn_s_getreg((3 << 11) | 20) & 0xFu; }
#define XB_SPIN(cond, bar) do { unsigned _sp = 0; while (cond) { __builtin_amdgcn_s_sleep(1); \
    if ((++_sp & 255u) == 0u) { if (xb_ld(&(bar)[XB_TMO])) break; if (_sp > XB_SPIN_CAP) { atomicAdd(&(bar)[XB_TMO], 1u); break; } } } } while (0)

struct XcdBarrier {
    unsigned* bar; unsigned x;
    volatile LAS unsigned* st;
};

__device__ __forceinline__ XcdBarrier xcd_barrier_post(unsigned* bar, volatile LAS unsigned* st) {
    XcdBarrier b; b.bar = bar; b.x = xb_xcc_id(); b.st = st;
    if (tidx() == 0) (void)xb_add(&bar[XB_XCNT(b.x)], 1u);
    return b;
}
__device__ __forceinline__ void xcd_barrier_complete(unsigned* bar, unsigned x, unsigned& nloc, unsigned& nx) {
    const unsigned G = gridDim.x * gridDim.y * gridDim.z;
    unsigned sum, cnt, mine, sp = 0u;
    for (;;) {
        sum = 0u; cnt = 0u; mine = 0u;
#pragma unroll
        for (unsigned j = 0; j < 16; ++j) { const unsigned c = xb_ld(&bar[XB_XCNT(j)]); sum += c; cnt += (c > 0u) ? 1u : 0u; mine = (j == x) ? c : mine; }
        if (sum == G) break;
        __builtin_amdgcn_s_sleep(1);
        if ((++sp & 255u) == 0u) { if (xb_ld(&bar[XB_TMO])) break; if (sp > XB_SPIN_CAP) { atomicAdd(&bar[XB_TMO], 1u); break; } }
    }
    nloc = mine > 0u ? mine : 1u; nx = cnt > 0u ? cnt : 1u;
}

__device__ __forceinline__ void xcd_barrier(const XcdBarrier& b) {
    asm volatile("s_waitcnt vmcnt(0)" ::: "memory");
    __syncthreads();
    if (tidx() == 0) {
        unsigned* bar = b.bar;
        __builtin_amdgcn_s_waitcnt(0);
        unsigned nloc = b.st[0], nx = b.st[1];
        if (nloc == 0u) { xcd_barrier_complete(bar, b.x, nloc, nx); b.st[0] = nloc; b.st[1] = nx; }
        const unsigned old = xb_add(&bar[XB_XSUB(b.x)], 1u);
        const unsigned gen = old / nloc;
        if (old + 1u == (gen + 1u) * nloc) {
            __builtin_amdgcn_fence(__ATOMIC_RELEASE, "agent");
            asm volatile("s_waitcnt vmcnt(0)" ::: "memory");
            const unsigned og = xb_add(&bar[XB_TOP], 1u);
            const unsigned tg = og / nx;
            if (og + 1u == (tg + 1u) * nx) xb_add(&bar[XB_TOPGEN], 1u);
            else XB_SPIN(xb_ld(&bar[XB_TOPGEN]) == tg, bar);
            __builtin_amdgcn_fence(__ATOMIC_ACQUIRE, "agent");
            xb_add(&bar[XB_XGEN(b.x)], 1u);
            asm volatile("s_waitcnt vmcnt(0)" ::: "memory");
        } else {
            XB_SPIN(xb_ld(&bar[XB_XGEN(b.x)]) == gen, bar);
            __builtin_amdgcn_fence(__ATOMIC_ACQUIRE, "agent");
            asm volatile("s_waitcnt vmcnt(0)" ::: "memory");
        }
    }
    __syncthreads();
}

constexpr int NTHREADS = 512, LDS_BYTES = 147456;
struct MegaArgs { const float* in[41]; float* out; unsigned char* ws; };
#define WSB(off) ((bf16*)(ws + (off)))
#define WSF(off) ((float*)(ws + (off)))

__global__ void __launch_bounds__(NTHREADS) mega_fwd(MegaArgs A) {
    extern __shared__ __attribute__((aligned(16))) unsigned char lds[];
    cg::grid_group grid = cg::this_grid();
    const float* const* in = A.in; unsigned char* ws = A.ws; float* out = A.out;
    if (tidx() < 2) ((volatile LAS unsigned*)(lds + LDS_BYTES - 64))[tidx()] = 0u;
    __syncthreads();
    const XcdBarrier xbar = xcd_barrier_post((unsigned*)(ws + WS_CTL) + 16384, (volatile LAS unsigned*)(lds + LDS_BYTES - 64));

    d_convert(WSB(WS_W1GU), NGU, DM, MapGU{in[I_F1_WG], in[I_F1_WU], FF});
    d_convert(WSB(WS_WIN), NWIN, DM, MapWin{in[I_WIN], IN_COLS});
    d_convert(WSB(WS_CW1K), 256, 2048, MapPlain{in[I_W1_K], 256});
    d_convert(WSB(WS_CW1V), 256, 2048, MapPlain{in[I_W1_V], 256});
    d_convert_lora(WSB(WS_WLORA), in[I_W2], in[I_A2], in[I_G2]);
    d_convert(WSB(WS_WK), DM, DM, MapPlain{in[I_WK], DM});
    d_convert(WSB(WS_WV), DM, DM, MapPlain{in[I_WV], DM});
    d_convert(WSB(WS_CW2), 64, 256, MapPlain{in[I_W2_K], 64});
    d_convert(WSB(WS_CW2) + 64 * 256, 64, 256, MapPlain{in[I_W2_V], 64});
    d_rope_table(WSF(WS_ROPE));
    d_cmp_bias(in[I_PE_K], in[I_W1_K], in[I_PE_V], in[I_W1_V], WSF(WS_CBIAS), (float*)lds);
    d_rownorm(in[I_X], in[I_F1_PRE], WSB(WS_XN), M_);
    d_rownorm(in[I_MEM], in[I_MEM_KVG], WSB(WS_MEMN), 512);
    grid.sync();
    gemm_pg8(lds, WSB(WS_XN), DM, WSB(WS_W1GU), DM, M_, NGU, DM, EpiSwiGLU{WSB(WS_HB)});
    d_convert(WSB(WS_W1D), DM, FF, MapPlain{in[I_F1_WD], DM}, 128);
    xcd_barrier(xbar);
    gemm_norm_res<false, true>(lds, WSB(WS_HB), FF, WSB(WS_W1D), FF, in[I_X], out, WSB(WS_XN), in[I_F1_POST], in[I_MIX_PRE], 0.5f, (unsigned*)(ws + WS_GATES), (unsigned*)(ws + WS_CTL) + 1024 + 0 * 2048);
    xcd_barrier(xbar);
    gemm_pg8(lds, WSB(WS_XN), DM, WSB(WS_WIN), DM, M_, 3072, DM,
             EpiWin{WSB(WS_QB), WSB(WS_KS), WSB(WS_KW), WSB(WS_KCR), WSB(WS_VCR), WSB(WS_VST), WSB(WS_VWT), (unsigned*)(ws + WS_RKVA), WSB(WS_RKVA + 32 * MiB), WSB(WS_PRL), WSF(WS_GATES), WSF(WS_ROPE)});
    d_gates(WSB(WS_XN), WSB(WS_WIN) + (size_t)3072 * DM, WSF(WS_GATES), (float*)lds);
    if (blockIdx.x == 0) { const int t_ = tidx(); float b_ = 0.f; for (int jc = 0; jc < 8; ++jc) b_ += WSF(WS_CBIAS)[jc * 512 + t_]; WSF(WS_CBIAS)[4096 + t_] = b_; }
    xcd_barrier(xbar);
    { float* part = (float*)(ws + WS_XN + 8 * MiB);
      gemm_pg8(lds, WSB(WS_KCR), 1024, WSB(WS_CW1K), 2048, 2048, 256, 1024, EpiStoreF32{part, 256}, 0);
      gemm_pg8(lds, WSB(WS_KCR) + 1024, 1024, WSB(WS_CW1K) + 1024, 2048, 2048, 256, 1024, EpiStoreF32{part + (size_t)2048 * 256, 256}, 8);
      gemm_pg8(lds, WSB(WS_VCR), 1024, WSB(WS_CW1V), 2048, 2048, 256, 1024, EpiStoreF32{part + (size_t)2 * 2048 * 256, 256}, 48);
      gemm_pg8(lds, WSB(WS_VCR) + 1024, 1024, WSB(WS_CW1V) + 1024, 2048, 2048, 256, 1024, EpiStoreF32{part + (size_t)3 * 2048 * 256, 256}, 24); }
    gemm_pg8(lds, WSB(WS_MEMN), DM, WSB(WS_WK), DM, 512, DM, DM, EpiStore{WSB(WS_HIDK), DM, 1.f}, 32);
    gemm_pg8(lds, WSB(WS_WV), DM, WSB(WS_MEMN), DM, DM, 512, DM, EpiStore{WSB(WS_HIDV), 512, 1.f}, 40);
    d_lora_prep(WSB(WS_PRL), in[I_MU], WSB(WS_XN), 48);
    d_convert(WSB(WS_W2GU), NGU, DM, MapGU{in[I_F2_WG], in[I_F2_WU], FF}, 48);
    d_convert(WSB(WS_W2D), DM, FF, MapPlain{in[I_F2_WD], DM}, 48);
    d_convert(WSB(WS_WOUT), DM, DM, MapPlain{in[I_WOUT], DM}, 48);
    d_convert(WSB(WS_WQ), DM, DM, MapPlain{in[I_WQ], DM}, 48);
    d_convert(WSB(WS_WO), DM, DM, MapPlain{in[I_WO], DM}, 48);
    xcd_barrier(xbar);
    d_cmp2((const float*)(ws + WS_XN + 8 * MiB), WSF(WS_CBIAS) + 4096, WSB(WS_CW2), WSF(WS_ROPE), WSB(WS_KC), WSB(WS_VCT));
    gemm_pg8(lds, WSB(WS_XN), KLORA, WSB(WS_WLORA), KLORA, M_, NLORA, KLORA, EpiLora{WSF(WS_YB), WSB(WS_RKVA + 48 * MiB), WSB(WS_AGG), in[I_W0], in[I_A0]});
    xcd_barrier(xbar);
    if (blockIdx.x < 16 * (1 + rw7::NHELP)) {
        const rw7::Args ra{(const unsigned*)(ws + WS_RKVA), WSB(WS_RKVA + 32 * MiB), WSB(WS_RKVA + 48 * MiB), WSF(WS_YB), in[I_MU], in[I_KK], in[I_KA], in[I_RK], WSF(WS_YB), WSF(WS_BONUS),
                           ws + WS_KCR + 1 * MiB, (unsigned*)(ws + WS_CTL) + 32768, (unsigned*)(ws + WS_CTL) + 24576};
        if (blockIdx.x < 16) rw7::head(ra, blockIdx.x, lds);
        else rw7::helper(ra, (blockIdx.x - 16) % 16, (blockIdx.x - 16) / 16, lds);
        __syncthreads();
    }
    {
        const NsaArgs na{WSB(WS_QB), WSB(WS_KC), WSB(WS_VCT), WSB(WS_KS), WSB(WS_VST), WSB(WS_KW), WSB(WS_VWT), WSF(WS_GATES), WSB(WS_XN)};
        nsa::phase(na, (unsigned*)(ws + WS_CTL), lds);
    }
    xcd_barrier(xbar);
    d_nsa_outnorm(WSB(WS_XN), in[I_NSA_G]);
    rw7::finish(WSF(WS_YB), WSF(WS_BONUS), WSB(WS_RKVA + 32 * MiB), WSB(WS_AGG), in[I_MU], in[I_GNG], in[I_GNB], WSB(WS_XN));
    xcd_barrier(xbar);
    gemm_norm_res<true, true>(lds, WSB(WS_XN), DM, WSB(WS_WOUT), DM, out, WSB(WS_YB), WSB(WS_XN), in[I_MIX_POST], in[I_MEM_PRE], 1.0f, (unsigned*)(ws + WS_GATES), (unsigned*)(ws + WS_CTL) + 1024 + 1 * 2048);
    xcd_barrier(xbar);
    gemm_pg8(lds, WSB(WS_XN), DM, WSB(WS_WQ), DM, M_, DM, DM, EpiStore{WSB(WS_QM), DM, MSCALE});
    xcd_barrier(xbar);
    for (int u = blockIdx.x; u < 256; u += gridDim.x) mema::unit(WSB(WS_QM), WSB(WS_HIDK), WSB(WS_HIDV), WSB(WS_OM), u, lds);
    xcd_barrier(xbar);
    gemm_norm_res<true, true>(lds, WSB(WS_OM), DM, WSB(WS_WO), DM, WSB(WS_YB), WSB(WS_YB), WSB(WS_XN), in[I_MEM_POST], in[I_F2_PRE], 1.0f, (unsigned*)(ws + WS_GATES), (unsigned*)(ws + WS_CTL) + 1024 + 2 * 2048);
    xcd_barrier(xbar);
    gemm_pg8(lds, WSB(WS_XN), DM, WSB(WS_W2GU), DM, M_, NGU, DM, EpiSwiGLU{WSB(WS_HB)});
    xcd_barrier(xbar);
    gemm_norm_res<true, false>(lds, WSB(WS_HB), FF, WSB(WS_W2D), FF, WSB(WS_YB), out, (bf16*)nullptr, in[I_F2_POST], (const float*)nullptr, 0.5f, (unsigned*)(ws + WS_GATES), (unsigned*)(ws + WS_CTL) + 1024 + 3 * 2048);
}

extern "C" void kernel_launch(void* const* d_in, const int* in_sizes, int n_in, void* d_out, int out_size, void* d_ws, size_t ws_size, hipStream_t stream) {
    static int grid = 0;
    if (grid == 0) {
        if (n_in != 41 || ws_size < WS_END) { fprintf(stderr, "kernel_launch: unexpected n_in %d / ws %zu\n", n_in, ws_size); grid = -1; return; }
        int dev = 0, cus = 0, per_cu = 0;
        hipGetDevice(&dev); hipDeviceGetAttribute(&cus, hipDeviceAttributeMultiprocessorCount, dev);
        if (hipFuncSetAttribute((const void*)mega_fwd, hipFuncAttributeMaxDynamicSharedMemorySize, LDS_BYTES) != hipSuccess) { fprintf(stderr, "kernel_launch: hipFuncSetAttribute failed\n"); grid = -1; return; }
        if (hipOccupancyMaxActiveBlocksPerMultiprocessor(&per_cu, (const void*)mega_fwd, NTHREADS, LDS_BYTES) != hipSuccess || per_cu < 1) { fprintf(stderr, "kernel_launch: occupancy query says %d\n", per_cu); grid = -1; (void)hipGetLastError(); return; }
        grid = cus;
        if (grid != 256) { fprintf(stderr, "kernel_launch: built for 256 CUs (one 256x256 tile per workgroup in the fused norm epilogues), found %d\n", cus); grid = -1; return; }
    }
    if (grid < 0) return;
    MegaArgs a{};
    for (int i = 0; i < 41; ++i) a.in[i] = (const float*)d_in[i];
    a.out = (float*)d_out; a.ws = (unsigned char*)d_ws;
    hipMemsetAsync(d_ws, 0, 196608, stream);
    void* args[] = {&a};
    hipError_t e = hipLaunchCooperativeKernel((const void*)mega_fwd, dim3(grid), dim3(NTHREADS), args, LDS_BYTES, stream);
    if (e != hipSuccess) fprintf(stderr, "kernel_launch: cooperative launch failed: %s (grid %d)\n", hipGetErrorString(e), grid);
}
```

```cpp
#include <hip/hip_runtime.h>
#include <hip/hip_cooperative_groups.h>
#include <cstdint>
#include <cstdio>

constexpr int NB = 2, T_ = 8192, DM = 1024, M_ = NB * T_;
constexpr int FF = 2816, NGU = 2 * FF;
constexpr int IN_COLS = 3096, NWIN = 3328;
constexpr int NRW = 1792;
constexpr int NCP = 512;
constexpr int NLORA = 1536, KLORA = 256;
constexpr float NORM_EPS = 1e-6f;
constexpr float QSCALE = 0.125f * 1.4426950408889634f;
constexpr float MSCALE = 0.0625f * 1.4426950408889634f;

typedef unsigned short bf16;
typedef short bf16x8 __attribute__((ext_vector_type(8)));
typedef float f32x4 __attribute__((ext_vector_type(4)));
typedef unsigned u32x2 __attribute__((ext_vector_type(2)));
typedef unsigned u32x4 __attribute__((ext_vector_type(4)));

__device__ __forceinline__ unsigned f2bf(float f) { unsigned u = __builtin_bit_cast(unsigned, f); return (u + 0x7fffu + ((u >> 16) & 1u)) >> 16; }
__device__ __forceinline__ float bf2f(bf16 h) { return __builtin_bit_cast(float, (unsigned)h << 16); }
typedef float f32x2_t __attribute__((ext_vector_type(2))); typedef __bf16 bf16x2_t __attribute__((ext_vector_type(2)));
__device__ __forceinline__ unsigned pk2(float lo, float hi) { const f32x2_t v = {lo, hi}; return __builtin_bit_cast(unsigned, __builtin_convertvector(v, bf16x2_t)); }
__device__ __forceinline__ void st_bf4(bf16* p, f32x4 v) { u32x2 w; w.x = pk2(v[0], v[1]); w.y = pk2(v[2], v[3]); *(u32x2*)p = w; }
__device__ __forceinline__ float wave_sum(float v) {
#pragma unroll
    for (int o = 1; o < 64; o <<= 1) v += __shfl_xor(v, o);
    return v;
}
__device__ __forceinline__ float wave_max(float v) {
#pragma unroll
    for (int o = 1; o < 64; o <<= 1) v = fmaxf(v, __shfl_xor(v, o));
    return v;
}
__device__ __forceinline__ float sigmoidf_(float x) { return 1.f / (1.f + __expf(-x)); }
__device__ __forceinline__ int tidx() { int t = threadIdx.x; asm volatile("" : "+v"(t)); return t; }

constexpr size_t MiB = 1u << 20, KiB64 = 65536;
constexpr size_t WS_CTL = 0;
constexpr size_t WS_KC = 256 * 1024;
constexpr size_t WS_VCT = 512 * 1024;
constexpr size_t WS_CW2 = 768 * 1024;
constexpr size_t WS_W1GU = 1 * MiB;
constexpr size_t WS_W1D = 12 * MiB;
constexpr size_t WS_W2GU = WS_W1D + 88 * KiB64;
constexpr size_t WS_W2D = WS_W2GU + 11 * MiB;
constexpr size_t WS_WIN = WS_W2D + 88 * KiB64;
constexpr size_t WS_WOUT = WS_WIN + 104 * KiB64;
constexpr size_t WS_WQ = WS_WOUT + 2 * MiB, WS_WK = WS_WQ + 2 * MiB, WS_WV = WS_WK + 2 * MiB, WS_WO = WS_WV + 2 * MiB;
constexpr size_t WS_CW1K = WS_WO + 2 * MiB, WS_CW1V = WS_CW1K + 1 * MiB;
constexpr size_t WS_WLORA = WS_CW1V + 1 * MiB;
constexpr size_t WS_ROPE = WS_WLORA + 12 * KiB64;
constexpr size_t WS_CBIAS = WS_ROPE + 2 * MiB;
constexpr size_t WS_MEMN = WS_CBIAS + KiB64;
constexpr size_t WS_HIDK = WS_MEMN + 1 * MiB;
constexpr size_t WS_HIDV = WS_HIDK + 1 * MiB;
constexpr size_t WS_GATES = WS_HIDV + 1 * MiB;
constexpr size_t WS_XN = 60 * MiB;
constexpr size_t WS_YB = 92 * MiB;
constexpr size_t WS_D = 124 * MiB;
constexpr size_t WS_HB = WS_D;
constexpr size_t WS_QB = WS_D;
constexpr size_t WS_KS = WS_D + 16 * MiB;
constexpr size_t WS_KW = WS_D + 20 * MiB;
constexpr size_t WS_KCR = WS_D + 24 * MiB;
constexpr size_t WS_VCR = WS_D + 29 * MiB;
constexpr size_t WS_VST = WS_D + 34 * MiB;
constexpr size_t WS_VWT = WS_D + 38 * MiB;
constexpr size_t WS_RKVA = WS_D + 42 * MiB;
constexpr size_t WS_PRL = WS_D + 106 * MiB;
constexpr size_t WS_AGG = WS_D + 114 * MiB;
constexpr size_t WS_BONUS = WS_KCR;
constexpr size_t WS_END = 256 * MiB;
constexpr size_t WS_QM = WS_D;
constexpr size_t WS_OM = WS_D + 32 * MiB;
constexpr size_t WS_MK = WS_D + 64 * MiB;
constexpr size_t WS_MVT = WS_D + 65 * MiB;
static_assert(WS_GATES + (size_t)M_ * 24 * 4 <= WS_XN, "ws map");
static_assert(WS_AGG + 16 * MiB <= WS_END, "ws map");

struct Params {
    const float* in[41];
    float* out;
    unsigned char* ws;
};
enum { I_X = 0, I_MEM, I_F1_PRE, I_F1_WG, I_F1_WU, I_F1_WD, I_F1_POST, I_MIX_PRE, I_WIN, I_PE_K, I_W1_K, I_W2_K, I_PE_V, I_W1_V, I_W2_V,
       I_NSA_G, I_MU, I_W0, I_W2, I_A0, I_A2, I_G2, I_KK, I_KA, I_RK, I_GNG, I_GNB, I_WOUT, I_MIX_POST, I_MEM_PRE, I_MEM_KVG, I_WQ, I_WK, I_WV,
       I_WO, I_MEM_POST, I_F2_PRE, I_F2_WG, I_F2_WU, I_F2_WD, I_F2_POST };

struct MapPlain { const float* W; int N; int pad; __device__ const float* col(int p) const { return W + p; } };
struct MapGU {
    const float* Wg; const float* Wu; int N; int pad;
    __device__ const float* col(int p) const {
        const int pn = p >> 8, q = p & 255, n = (q >> 4) & 1;
        const int hid = 128 * pn + 64 * (q >> 7) + 16 * ((q >> 5) & 3) + (q & 15);
        return Wg + (size_t)n * (size_t)(Wu - Wg) + hid;
    }
};
__host__ __device__ inline int rope_perm(int x) { return 16 * ((x >> 5) & 1) + (x & 15) + 32 * ((x >> 4) & 1); }
struct MapWin {
    const float* W; int N; int pad;
    __device__ const float* col(int p) const {
        int l;
        if (p < 512) l = (p & ~63) + rope_perm(p & 63);
        else if (p < 640) l = 768 + ((p - 512) & ~63) + rope_perm(p & 63);
        else if (p < 768) l = 1024 + ((p - 640) & ~63) + rope_perm(p & 63);
        else if (p < 896) l = 512 + (p - 768);
        else if (p < 1024) l = 640 + (p - 896);
        else if (p < 1152) l = 896 + (p - 1024);
        else if (p < 1280) l = 1152 + (p - 1152);
        else if (p < 2304) { const int q = p - 1280; l = 1304 + (((q >> 4) & 1) ? 512 : 0) + 16 * (q >> 5) + (q & 15); }
        else if (p < 3072) l = 1304 + (p - 1280);
        else if (p < 3096) l = 1280 + (p - 3072);
        else return nullptr;
        return W + l;
    }
};

#define FOR_VB(vb, n) for (int vb = (int)blockIdx.x * 2 + (T512 >> 8); vb < (n); vb += (int)gridDim.x * 2)

template <class Map> __device__ __forceinline__ void d_convert(bf16* WT, int Np, int K, Map map, int wg0 = 0) {
    if ((int)blockIdx.x < wg0) return;
    const int T512 = tidx(), tid = T512 & 255, nbx = Np / 64, nb = nbx * (K / 64), G = (int)gridDim.x - wg0;
    for (int vb0 = ((int)blockIdx.x - wg0) * 2 + (T512 >> 8); vb0 < nb; vb0 += G * 4) {
        const int vb1 = vb0 + G * 2; const bool two = vb1 < nb;
        const int p0 = (vb0 % nbx) * 64 + (tid & 63), k0 = (vb0 / nbx) * 64 + (tid >> 6) * 16;
        const int p1 = two ? (vb1 % nbx) * 64 + (tid & 63) : p0, k1 = two ? (vb1 / nbx) * 64 + (tid >> 6) * 16 : k0;
        const float* s0 = map.col(p0); const float* s1 = map.col(p1);
        float v[16], u[16];
#pragma unroll
        for (int i = 0; i < 16; ++i) { v[i] = s0 ? s0[(size_t)(k0 + i) * map.N] : 0.f; u[i] = s1 ? s1[(size_t)(k1 + i) * map.N] : 0.f; }
        u32x4 a, b;
        a.x = pk2(v[0], v[1]); a.y = pk2(v[2], v[3]); a.z = pk2(v[4], v[5]); a.w = pk2(v[6], v[7]);
        b.x = pk2(v[8], v[9]); b.y = pk2(v[10], v[11]); b.z = pk2(v[12], v[13]); b.w = pk2(v[14], v[15]);
        u32x4* d0 = (u32x4*)(WT + (size_t)p0 * K + k0); d0[0] = a; d0[1] = b;
        if (two) {
            a.x = pk2(u[0], u[1]); a.y = pk2(u[2], u[3]); a.z = pk2(u[4], u[5]); a.w = pk2(u[6], u[7]);
            b.x = pk2(u[8], u[9]); b.y = pk2(u[10], u[11]); b.z = pk2(u[12], u[13]); b.w = pk2(u[14], u[15]);
            u32x4* d1 = (u32x4*)(WT + (size_t)p1 * K + k1); d1[0] = a; d1[1] = b;
        }
    }
}
__device__ __forceinline__ void d_convert_lora(bf16* WT, const float* w2, const float* a2, const float* g2) {
    const int T512 = tidx(), tid = T512 & 255;
    FOR_VB(vb, NLORA * KLORA / 256) {
        const int idx = vb * 256 + tid, p = idx >> 8, k = idx & 255;
        float v = 0.f;
        if (p < 512) { if (k < 64) v = w2[k * 512 + p]; }
        else if (p < 1024) { if (k >= 64 && k < 128) v = a2[(k - 64) * 512 + (p - 512)]; }
        else { if (k >= 128) v = g2[(k - 128) * 512 + (p - 1024)]; }
        WT[idx] = (bf16)f2bf(v);
    }
}
__device__ __forceinline__ void d_rope_table(float* tab) {
    const int T512 = tidx(), tid = T512 & 255;
    FOR_VB(vb, T_ * 32 / 256) {
        const int idx = vb * 256 + tid, pos = idx >> 5, i = idx & 31;
        const float inv = (float)pow(10000.0, -(double)i / 32.0);
        const float ang = (float)pos * inv;
        tab[2 * idx] = (float)cos((double)ang); tab[2 * idx + 1] = (float)sin((double)ang);
    }
}
__device__ __forceinline__ void d_cmp_bias(const float* pe_k, const float* w1_k, const float* pe_v, const float* w1_v, float* part, float* red  ) {
    for (int job = blockIdx.x; job < 64; job += gridDim.x) {
        const int kv = job >> 5, cg_ = (job >> 3) & 3, jc = job & 7; const float* pe = kv ? pe_v : pe_k; const float* w1 = kv ? w1_v : w1_k;
        const int T512 = tidx(), lane = T512 & 63, w = T512 >> 6, n = cg_ * 64 + lane;
        float s = 0.f;
#pragma unroll 8
        for (int j = jc * 256 + w * 32; j < jc * 256 + w * 32 + 32; ++j) s += pe[j] * w1[(size_t)j * 256 + n];
        red[w * 64 + lane] = s; __syncthreads();
        if (w == 0) { float t = 0.f; for (int i = 0; i < 8; ++i) t += red[i * 64 + lane]; part[(jc * 2 + kv) * 256 + n] = t; }
        __syncthreads();
    }
}
__device__ __forceinline__ void d_rownorm(const float* x, const float* g, bf16* xn, int rows) {
    const int T512 = tidx(), tid = T512 & 255, lane = tid & 63;
    FOR_VB(vb, rows / 4) {
        const int row = vb * 4 + (tid >> 6);
        const f32x4* xr = (const f32x4*)(x + (size_t)row * DM) + lane; f32x4 v[4]; float s = 0.f;
#pragma unroll
        for (int j = 0; j < 4; ++j) { v[j] = xr[64 * j]; s += v[j][0] * v[j][0] + v[j][1] * v[j][1] + v[j][2] * v[j][2] + v[j][3] * v[j][3]; }
        const float rstd = rsqrtf(wave_sum(s) * (1.f / DM) + NORM_EPS);
#pragma unroll
        for (int j = 0; j < 4; ++j) { const f32x4 gg = ((const f32x4*)g)[lane + 64 * j]; st_bf4(xn + (size_t)row * DM + 4 * (lane + 64 * j), v[j] * rstd * gg); }
    }
}
__device__ __forceinline__ void d_rowpass(const float* xin, const bf16* y, const float* gpost, float coef, const float* gpre, float* xout, bf16* xn) {
    const int T512 = tidx(), tid = T512 & 255, lane = tid & 63;
    FOR_VB(vb, M_ / 4) {
        const int row = vb * 4 + (tid >> 6);
        f32x4 yv[4], xv[4]; float s = 0.f;
#pragma unroll
        for (int j = 0; j < 4; ++j) {
            const u32x2 w = *(const u32x2*)(y + (size_t)row * DM + 4 * (lane + 64 * j));
            yv[j][0] = __builtin_bit_cast(float, w.x << 16); yv[j][1] = __builtin_bit_cast(float, w.x & 0xffff0000u);
            yv[j][2] = __builtin_bit_cast(float, w.y << 16); yv[j][3] = __builtin_bit_cast(float, w.y & 0xffff0000u);
            s += yv[j][0] * yv[j][0] + yv[j][1] * yv[j][1] + yv[j][2] * yv[j][2] + yv[j][3] * yv[j][3];
            xv[j] = ((const f32x4*)(xin + (size_t)row * DM))[lane + 64 * j];
        }
        const float rstd = rsqrtf(wave_sum(s) * (1.f / DM) + NORM_EPS) * coef; float s2 = 0.f;
#pragma unroll
        for (int j = 0; j < 4; ++j) { const f32x4 gg = ((const f32x4*)gpost)[lane + 64 * j]; xv[j] = xv[j] + yv[j] * rstd * gg;
            s2 += xv[j][0] * xv[j][0] + xv[j][1] * xv[j][1] + xv[j][2] * xv[j][2] + xv[j][3] * xv[j][3];
            ((f32x4*)(xout + (size_t)row * DM))[lane + 64 * j] = xv[j]; }
        if (gpre) {
            const float r2 = rsqrtf(wave_sum(s2) * (1.f / DM) + NORM_EPS);
#pragma unroll
            for (int j = 0; j < 4; ++j) { const f32x4 gg = ((const f32x4*)gpre)[lane + 64 * j]; st_bf4(xn + (size_t)row * DM + 4 * (lane + 64 * j), xv[j] * r2 * gg); }
        }
    }
}
__device__ __forceinline__ void d_nsa_outnorm(bf16* amix, const float* g) {
    const int T512 = tidx(), tid = T512 & 255, lane = tid & 63;
    FOR_VB(vb, M_ / 4) {
        const int row = vb * 4 + (tid >> 6);
        bf16* p = amix + (size_t)row * DM + 8 * lane;
        const u32x4 w = *(const u32x4*)p; float v[8]; float s = 0.f;
        v[0] = __builtin_bit_cast(float, w.x << 16); v[1] = __builtin_bit_cast(float, w.x & 0xffff0000u);
        v[2] = __builtin_bit_cast(float, w.y << 16); v[3] = __builtin_bit_cast(float, w.y & 0xffff0000u);
        v[4] = __builtin_bit_cast(float, w.z << 16); v[5] = __builtin_bit_cast(float, w.z & 0xffff0000u);
        v[6] = __builtin_bit_cast(float, w.w << 16); v[7] = __builtin_bit_cast(float, w.w & 0xffff0000u);
#pragma unroll
        for (int i = 0; i < 8; ++i) s += v[i] * v[i];
        const float rstd = rsqrtf(wave_sum(s) * (1.f / 512.f) + NORM_EPS);
        u32x4 o; const float* gg = g + 8 * lane;
        o.x = pk2(v[0] * rstd * gg[0], v[1] * rstd * gg[1]); o.y = pk2(v[2] * rstd * gg[2], v[3] * rstd * gg[3]);
        o.z = pk2(v[4] * rstd * gg[4], v[5] * rstd * gg[5]); o.w = pk2(v[6] * rstd * gg[6], v[7] * rstd * gg[7]);
        *(u32x4*)p = o;
    }
}

struct EpiStore { bf16* O; int ldc; float scale;
    static constexpr int NCAT = 1;
    __device__ __forceinline__ int cat(int) const { return 0; }
    template <int C> __device__ __forceinline__ void apply(int row, int p, f32x4 v0, f32x4 v1) const { bf16* o = O + (size_t)row * ldc + p; st_bf4(o, v0 * scale); st_bf4(o + 16, v1 * scale); } };
struct EpiStoreF32 { float* O; int ldc;
    static constexpr int NCAT = 1;
    __device__ __forceinline__ int cat(int) const { return 0; }
    template <int C> __device__ __forceinline__ void apply(int row, int p, f32x4 v0, f32x4 v1) const { float* o = O + (size_t)row * ldc + p; *(f32x4*)o = v0; *(f32x4*)(o + 16) = v1; } };
struct EpiSwiGLU { bf16* H;
    static constexpr int NCAT = 1;
    __device__ __forceinline__ int cat(int) const { return 0; }
    template <int C> __device__ __forceinline__ void apply(int row, int p, f32x4 g, f32x4 u) const {
        const int q = p & 255, hid = 128 * (p >> 8) + 64 * (q >> 7) + 16 * ((q >> 5) & 3) + (q & 15);
        f32x4 h;
#pragma unroll
        for (int e = 0; e < 4; ++e) h[e] = g[e] / (1.f + __expf(-g[e])) * u[e];
        st_bf4(H + (size_t)row * FF + hid, h); } };
struct EpiBiasSilu { bf16* O; const float* bias;
    static constexpr int NCAT = 1;
    __device__ __forceinline__ int cat(int) const { return 0; }
    template <int C> __device__ __forceinline__ void apply(int row, int p, f32x4 v0, f32x4 v1) const {
        f32x4 a, b; f32x4 b0 = {0.f, 0.f, 0.f, 0.f}, b1 = {0.f, 0.f, 0.f, 0.f};
#pragma unroll
        for (int jc = 0; jc < 8; ++jc) { b0 += *(const f32x4*)(bias + jc * 512 + p); b1 += *(const f32x4*)(bias + jc * 512 + p + 16); }
#pragma unroll
        for (int e = 0; e < 4; ++e) { const float x0 = v0[e] + b0[e], x1 = v1[e] + b1[e]; a[e] = x0 / (1.f + __expf(-x0)); b[e] = x1 / (1.f + __expf(-x1)); }
        bf16* o = O + (size_t)row * 256 + p; st_bf4(o, a); st_bf4(o + 16, b); } };
struct EpiLora { float* wdec; bf16* aga; bf16* agg; const float* w0; const float* a0;
    static constexpr int NCAT = 3;
    __device__ __forceinline__ int cat(int p0) const { return p0 < 512 ? 0 : (p0 < 1024 ? 1 : 2); }
    template <int C> __device__ __forceinline__ void one(int row, int p, f32x4 v) const {
        if (C == 0) { f32x4 o; const f32x4 ww = *(const f32x4*)(w0 + p);
#pragma unroll
            for (int e = 0; e < 4; ++e) o[e] = __expf(-0.6065306597126334f * sigmoidf_(ww[e] + v[e]));
            *(f32x4*)(wdec + (size_t)row * 512 + p) = o;
        } else if (C == 1) { f32x4 o; const f32x4 aa = *(const f32x4*)(a0 + p - 512);
#pragma unroll
            for (int e = 0; e < 4; ++e) o[e] = sigmoidf_(aa[e] + v[e]);
            st_bf4(aga + (size_t)row * 512 + (p - 512), o);
        } else st_bf4(agg + (size_t)row * 512 + (p - 1024), v);
    }
    template <int C> __device__ __forceinline__ void apply(int row, int p, f32x4 v0, f32x4 v1) const { one<C>(row, p, v0); one<C>(row, p + 16, v1); } };
struct EpiWin {
    bf16 *qb, *ks, *kw, *kcr, *vcr, *vst, *vwt; unsigned* rk; bf16 *vv, *prl; float* gates; const float* rope;
    static constexpr int NCAT = 8;
    __device__ __forceinline__ int cat(int p0) const { return p0 < 512 ? 0 : (p0 < 768 ? 1 : (p0 < 1024 ? 2 : (p0 < 1280 ? 3 : (p0 < 2304 ? 4 : (p0 < 2816 ? 7 : (p0 < 3072 ? 6 : 5)))))); }
    template <int C> __device__ __forceinline__ void apply(int row, int p, f32x4 v0, f32x4 v1) const {
        const int b = row / T_, t = row % T_;
        if (C == 0 || C == 1) {
            const int x = p & 63, d = 16 * ((x >> 5) & 1) + (x & 15);
            const f32x4* rp = (const f32x4*)(rope + ((size_t)t * 32 + d) * 2); const f32x4 r0 = rp[0], r1 = rp[1];
            const f32x4 cs = {r0[0], r0[2], r1[0], r1[2]}, sn = {r0[1], r0[3], r1[1], r1[3]};
            const f32x4 lo = v0 * cs - v1 * sn, hi = v0 * sn + v1 * cs;
            if (C == 0) { bf16* o = qb + (size_t)row * 512 + (p & ~63) + d; st_bf4(o, lo * QSCALE); st_bf4(o + 32, hi * QSCALE); }
            else { const int g = ((p - 512) >> 6) & 1; bf16* base = (p < 640) ? ks : kw; bf16* o = base + ((size_t)(b * 2 + g) * T_ + t) * 64 + d; st_bf4(o, lo); st_bf4(o + 32, hi); }
        } else if (C == 2) {
            const int c = (p - 768) & 127, g = c >> 6, d = c & 63; bf16* base = (p < 896) ? kcr : vcr;
            bf16* o = base + ((size_t)(b * 2 + g) * T_ + t) * 64 + d; st_bf4(o, v0); st_bf4(o + 16, v1);
        } else if (C == 3) {
            const int c = (p - 1024) & 127, g = c >> 6, d = c & 63; bf16* base = (p < 1152) ? vst : vwt;
            bf16* o = base + ((size_t)(b * 2 + g) * 64 + d) * T_ + t;
#pragma unroll
            for (int e = 0; e < 4; ++e) { o[(size_t)e * T_] = (bf16)f2bf(v0[e]); o[(size_t)(16 + e) * T_] = (bf16)f2bf(v1[e]); }
        } else if (C == 4) {
            const int q = p - 1280, ch = 16 * (q >> 5) + (q & 15);
            u32x4 w; w.x = pk2(v0[0], v1[0]); w.y = pk2(v0[1], v1[1]); w.z = pk2(v0[2], v1[2]); w.w = pk2(v0[3], v1[3]);
            *(u32x4*)(rk + (size_t)row * 512 + ch) = w;
        } else if (C == 7) {
            bf16* o = vv + (size_t)row * 512 + (p - 2304); st_bf4(o, v0); st_bf4(o + 16, v1);
        } else if (C == 6) {
            bf16* o = prl + (size_t)row * 256 + (p - 2816); st_bf4(o, v0); st_bf4(o + 16, v1);
        } else {
            const int c = p - 3072; float* o = gates + (size_t)row * 24 + c;
            if (c < 24) { f32x4 s = {sigmoidf_(v0[0]), sigmoidf_(v0[1]), sigmoidf_(v0[2]), sigmoidf_(v0[3])}; *(f32x4*)o = s; }
            if (c + 16 < 24) { f32x4 s = {sigmoidf_(v1[0]), sigmoidf_(v1[1]), sigmoidf_(v1[2]), sigmoidf_(v1[3])}; *(f32x4*)(o + 16) = s; }
        }
    }
};

namespace pg8 {
#define PG8_LAS __attribute__((address_space(3)))
typedef unsigned short bf16_t;
typedef short bf16x8 __attribute__((ext_vector_type(8)));
typedef float f32x4 __attribute__((ext_vector_type(4)));
typedef unsigned u32x4 __attribute__((ext_vector_type(4)));
constexpr int BM = 256, BK = 64, HALF = 128, HTB = HALF * BK * 2  , STAGE_BYTES = 8 * HTB, NXCD = 8, WGM = 8;

__host__ __device__ __forceinline__ int lds_byte(int r, int c) { const int st = (r >> 4) * 2 + (c >> 5), rr = r & 15, cc = c & 31, ob = rr * 64 + cc * 2; return st * 1024 + (ob ^ (((ob >> 9) & 1) << 5)); }
__host__ __device__ __forceinline__ void stage_rc(int b, int& R, int& C) { const int st = b / 1024, sb = b % 1024, swz = sb ^ (((sb >> 9) & 1) << 5); R = (st >> 1) * 16 + swz / 64; C = (st & 1) * 32 + (swz % 64) / 2; }
__host__ __device__ __forceinline__ int perm32(int rho) { const int n = rho >> 4, i = rho & 15; return 8 * (i >> 2) + 4 * n + (i & 3); }

struct Unit { int pm, pn; };
struct Gemm { const bf16_t* A; const bf16_t* Bt; int M, N, K, lda, ldb; };

struct StaticOrder {
    int nM, nN, nwg, G, c;
    __host__ __device__ void init(int M, int N, int G_, int c_) { nM = M / BM; nN = N / BM; nwg = nM * nN; G = G_; c = c_; }
    __host__ __device__ bool next(int i, Unit& u) const {
        const long L = (long)i * G + c; if (L >= nwg) return false;
        int wgid = (int)L; { const int q = nwg / NXCD, r = nwg % NXCD, xcd = wgid % NXCD, off = wgid / NXCD; wgid = (xcd < r ? xcd * (q + 1) : r * (q + 1) + (xcd - r) * q) + off; }
        const int nig = WGM * nN, gid = wgid / nig, fm = gid * WGM, gsz = (nM - fm) < WGM ? (nM - fm) : WGM;
        u.pm = fm + ((wgid % nig) % gsz); u.pn = (wgid % nig) / gsz; return true;
    }
    __device__ __forceinline__ void a_ready(const Unit&) const {}
    __device__ __forceinline__ void done(const Unit&) const {}
};

template <class Epi, class Sched, bool ALIGN_EPI = false, bool SP2 = false>
__device__ __forceinline__ void gemm_phase(PG8_LAS unsigned char* lds, const Gemm g, const Sched& S, const Epi& E) {
    const int tid = tidx(), wid = __builtin_amdgcn_readfirstlane(tid >> 6), lane = tid & 63, wr = wid >> 2, wc = wid & 3, fr = lane & 15, fq = lane >> 4;
    const int K = g.K, nt = K / BK;
    unsigned voffA[2], voffB[2];
#pragma unroll
    for (int i = 0; i < 2; ++i) { int R, C; stage_rc(tid * 16 + i * 8192, R, C); const int Rb = Epi::PERM ? ((R & ~31) + perm32(R & 31)) : R;
        voffA[i] = (unsigned)(R * g.lda + C) * 2u; voffB[i] = (unsigned)(Rb * g.ldb + C) * 2u; }
    const size_t kstep = (size_t)(BK * 2);
    const size_t hstepA = (size_t)HALF * g.lda * 2, hstepB = (size_t)HALF * g.ldb * 2;
    const size_t tstepA = 2 * hstepA, tstepB = 2 * hstepB;
    const unsigned ldsw = (unsigned)wid * 1024u;
    const int aoff = lds_byte(wr * 64 + fr, fq * 8), boff = lds_byte(wc * 32 + fr, fq * 8);
#define PG8_SA(b, h) (((b) * 2 + (h)) * HTB)
#define PG8_SB(b, h) ((4 + (b) * 2 + (h)) * HTB)
#define PG8_STAGE(bufoff, gbase, voff) do { _Pragma("unroll") for (int _i = 0; _i < 2; ++_i) \
        __builtin_amdgcn_global_load_lds((const unsigned*)((const char*)(gbase) + (voff)[_i]), (PG8_LAS unsigned*)(lds + (bufoff) + ldsw + _i * 8192), 16, 0, 0); } while (0)
#define PG8_LDA(dst, b, h) do { _Pragma("unroll") for (int m = 0; m < 4; ++m) _Pragma("unroll") for (int k = 0; k < 2; ++k) dst[m][k] = *(const PG8_LAS bf16x8*)(lds + PG8_SA(b, h) + aoff + m * 2048 + k * 1024); } while (0)
#define PG8_LDB(dst, b, h) do { _Pragma("unroll") for (int n = 0; n < 2; ++n) _Pragma("unroll") for (int k = 0; k < 2; ++k) dst[n][k] = *(const PG8_LAS bf16x8*)(lds + PG8_SB(b, h) + boff + n * 2048 + k * 1024); } while (0)
#define PG8_MMA(ai, bj, At, Bt) do { __builtin_amdgcn_s_setprio(1); _Pragma("unroll") for (int m = 0; m < 4; ++m) _Pragma("unroll") for (int n = 0; n < 2; ++n) _Pragma("unroll") for (int k = 0; k < 2; ++k) \
        acc[ai][bj][m][n] = __builtin_amdgcn_mfma_f32_16x16x32_bf16(Bt[n][k], At[m][k], acc[ai][bj][m][n], 0, 0, 0); __builtin_amdgcn_s_setprio(0); } while (0)
#define PG8_WAIT_V(n) asm volatile("s_waitcnt vmcnt(" #n ")" ::: "memory")
#define PG8_WAIT_L(n) asm volatile("s_waitcnt lgkmcnt(" #n ")" ::: "memory")
#define PG8_BAR __builtin_amdgcn_s_barrier()
#define PG8_SCHED __builtin_amdgcn_sched_barrier(0)
    Unit cur, nxt; int ui = 0;
    if (!S.next(0, cur)) return;
    f32x4 acc[2][2][4][2];
#pragma unroll
    for (int a = 0; a < 2; ++a)
#pragma unroll
        for (int b = 0; b < 2; ++b)
#pragma unroll
            for (int m = 0; m < 4; ++m)
#pragma unroll
                for (int n = 0; n < 2; ++n) acc[a][b][m][n] = (f32x4){0.f, 0.f, 0.f, 0.f};
    bf16x8 At[4][2], B0[2][2], B1[2][2];
    const char* cA = (const char*)g.A + (size_t)cur.pm * tstepA; const char* cB = (const char*)g.Bt + (size_t)cur.pn * tstepB;
    S.a_ready(cur);
    if constexpr (SP2) {
        PG8_STAGE(PG8_SB(0, 0), cB, voffB); PG8_STAGE(PG8_SB(0, 1), cB + hstepB, voffB); PG8_STAGE(PG8_SA(0, 0), cA, voffA); PG8_STAGE(PG8_SA(0, 1), cA + hstepA, voffA);
        if (wr == 1) PG8_BAR;
        PG8_WAIT_V(2); PG8_BAR;
        PG8_STAGE(PG8_SB(1, 0), cB + kstep, voffB); PG8_STAGE(PG8_SA(1, 0), cA + kstep, voffA); PG8_STAGE(PG8_SB(1, 1), cB + hstepB + kstep, voffB);
        PG8_WAIT_V(6); PG8_BAR;
    } else {
        PG8_STAGE(PG8_SB(0, 0), cB, voffB); PG8_STAGE(PG8_SA(0, 0), cA, voffA); PG8_STAGE(PG8_SB(0, 1), cB + hstepB, voffB); PG8_STAGE(PG8_SA(0, 1), cA + hstepA, voffA);
        if (wr == 1) PG8_BAR;
        PG8_WAIT_V(4); PG8_BAR;
        PG8_STAGE(PG8_SB(1, 0), cB + kstep, voffB); PG8_STAGE(PG8_SA(1, 0), cA + kstep, voffA); PG8_STAGE(PG8_SB(1, 1), cB + hstepB + kstep, voffB);
        PG8_WAIT_V(6); PG8_BAR;
    }
    for (;;) {
        const bool has_next = S.next(ui + 1, nxt);
        const char* nA = has_next ? (const char*)g.A + (size_t)nxt.pm * tstepA : cA; const char* nB = has_next ? (const char*)g.Bt + (size_t)nxt.pn * tstepB : cB;
        for (int t = 0; t < nt; t += 2) {
            const bool last = (t == nt - 2);
            const char* a1 = cA + (size_t)(t + 1) * kstep;
            const char* a2 = last ? nA : cA + (size_t)(t + 2) * kstep; const char* b2 = last ? nB : cB + (size_t)(t + 2) * kstep;
            const char* a3 = a2 + kstep; const char* b3 = b2 + kstep;
            if (last && has_next) S.a_ready(nxt);
            if constexpr (SP2) {
            PG8_LDB(B0, 0, 0); PG8_LDB(B1, 0, 1); PG8_SCHED; PG8_LDA(At, 0, 0); PG8_STAGE(PG8_SA(1, 1), a1 + hstepA, voffA);
            PG8_WAIT_V(8); PG8_WAIT_L(0); PG8_BAR; PG8_MMA(0, 0, At, B0); PG8_MMA(0, 1, At, B1); PG8_BAR; PG8_SCHED;
            PG8_LDA(At, 0, 1); PG8_STAGE(PG8_SB(0, 0), b2, voffB); PG8_STAGE(PG8_SB(0, 1), b2 + hstepB, voffB); PG8_STAGE(PG8_SA(0, 0), a2, voffA);
            PG8_WAIT_V(8); PG8_WAIT_L(0); PG8_BAR; PG8_MMA(1, 0, At, B0); PG8_MMA(1, 1, At, B1); PG8_BAR; PG8_SCHED;
            PG8_LDB(B0, 1, 0); PG8_LDB(B1, 1, 1); PG8_SCHED; PG8_LDA(At, 1, 0); PG8_STAGE(PG8_SA(0, 1), a2 + hstepA, voffA);
            PG8_WAIT_V(8); PG8_WAIT_L(0); PG8_BAR; PG8_MMA(0, 0, At, B0); PG8_MMA(0, 1, At, B1); PG8_BAR; PG8_SCHED;
            PG8_LDA(At, 1, 1); PG8_STAGE(PG8_SB(1, 0), b3, voffB); PG8_STAGE(PG8_SB(1, 1), b3 + hstepB, voffB); PG8_STAGE(PG8_SA(1, 0), a3, voffA);
            PG8_WAIT_V(8); PG8_WAIT_L(0); PG8_BAR; PG8_MMA(1, 0, At, B0); PG8_MMA(1, 1, At, B1); PG8_BAR; PG8_SCHED;
            } else {
            PG8_LDB(B0, 0, 0); PG8_SCHED; PG8_LDA(At, 0, 0); PG8_STAGE(PG8_SA(1, 1), a1 + hstepA, voffA);
            PG8_WAIT_L(8); PG8_BAR; PG8_WAIT_L(0); PG8_MMA(0, 0, At, B0); PG8_BAR; PG8_SCHED;
            PG8_LDB(B1, 0, 1); PG8_STAGE(PG8_SB(0, 0), b2, voffB);
            PG8_BAR; PG8_WAIT_L(0); PG8_MMA(0, 1, At, B1); PG8_BAR;
            PG8_LDA(At, 0, 1); PG8_STAGE(PG8_SA(0, 0), a2, voffA);
            PG8_BAR; PG8_WAIT_L(0); PG8_MMA(1, 0, At, B0); PG8_BAR; PG8_SCHED;
            PG8_STAGE(PG8_SB(0, 1), b2 + hstepB, voffB);
            PG8_WAIT_V(6); PG8_BAR; PG8_MMA(1, 1, At, B1); PG8_BAR;
            PG8_LDB(B0, 1, 0); PG8_SCHED; PG8_LDA(At, 1, 0); PG8_STAGE(PG8_SA(0, 1), a2 + hstepA, voffA);
            PG8_WAIT_L(8); PG8_BAR; PG8_WAIT_L(0); PG8_MMA(0, 0, At, B0); PG8_BAR; PG8_SCHED;
            PG8_LDB(B1, 1, 1); PG8_STAGE(PG8_SB(1, 0), b3, voffB);
            PG8_BAR; PG8_WAIT_L(0); PG8_MMA(0, 1, At, B1); PG8_BAR;
            PG8_LDA(At, 1, 1); PG8_STAGE(PG8_SA(1, 0), a3, voffA);
            PG8_BAR; PG8_WAIT_L(0); PG8_MMA(1, 0, At, B0); PG8_BAR; PG8_SCHED;
            PG8_STAGE(PG8_SB(1, 1), b3 + hstepB, voffB);
            PG8_WAIT_V(6); PG8_BAR; PG8_MMA(1, 1, At, B1); PG8_BAR;
            }
        }
        if constexpr (ALIGN_EPI) { if (wr == 0) PG8_BAR; }
        if constexpr (!Epi::AFTER_DRAIN) { E(acc, cur, wr, wc, fr, fq); S.done(cur); }
        if (!has_next) break;
#pragma unroll
        for (int a = 0; a < 2; ++a)
#pragma unroll
            for (int b = 0; b < 2; ++b)
#pragma unroll
                for (int m = 0; m < 4; ++m)
#pragma unroll
                    for (int n = 0; n < 2; ++n) acc[a][b][m][n] = (f32x4){0.f, 0.f, 0.f, 0.f};
        cur = nxt; cA = nA; cB = nB; ++ui;
        if constexpr (ALIGN_EPI) { if (wr == 1) PG8_BAR; }
    }
    PG8_WAIT_V(0);
    if constexpr (!ALIGN_EPI) { if (wr == 0) PG8_BAR; }
    PG8_BAR;
    if constexpr (Epi::AFTER_DRAIN) { E.fused(acc, cur, wr, wc, fr, fq, lds, wid, lane); S.done(cur); }
#undef PG8_SA
#undef PG8_SB
#undef PG8_STAGE
#undef PG8_LDA
#undef PG8_LDB
#undef PG8_MMA
#undef PG8_WAIT_V
#undef PG8_WAIT_L
#undef PG8_BAR
#undef PG8_SCHED
}
}

template <class F> struct EpiQuad {
    static constexpr bool PERM = false, AFTER_DRAIN = false;
    F f;
    template <int C, int BJ> __device__ __forceinline__ void half(const pg8::f32x4 (&acc)[2][2][4][2], int row0, int p) const {
#pragma unroll
        for (int ai = 0; ai < 2; ++ai)
#pragma unroll
            for (int m = 0; m < 4; ++m) { f.template apply<C>(row0 + ai * 128 + m * 16, p, acc[ai][BJ][m][0], acc[ai][BJ][m][1]); asm volatile("" ::: "memory"); }
    }
    template <int BJ> __device__ __forceinline__ void disp(const pg8::f32x4 (&acc)[2][2][4][2], int row0, int p0, int p) const {
        const int c = f.cat(p0);
        if (F::NCAT == 1 || c == 0) half<0, BJ>(acc, row0, p);
        else if (F::NCAT > 1 && c == 1) half<(F::NCAT > 1 ? 1 : 0), BJ>(acc, row0, p);
        else if (F::NCAT > 2 && c == 2) half<(F::NCAT > 2 ? 2 : 0), BJ>(acc, row0, p);
        else if (F::NCAT > 3 && c == 3) half<(F::NCAT > 3 ? 3 : 0), BJ>(acc, row0, p);
        else if (F::NCAT > 4 && c == 4) half<(F::NCAT > 4 ? 4 : 0), BJ>(acc, row0, p);
        else if (F::NCAT > 5 && c == 5) half<(F::NCAT > 5 ? 5 : 0), BJ>(acc, row0, p);
        else if (F::NCAT > 6 && c == 6) half<(F::NCAT > 6 ? 6 : 0), BJ>(acc, row0, p);
        else if (F::NCAT > 7) half<(F::NCAT > 7 ? 7 : 0), BJ>(acc, row0, p);
    }
    __device__ __forceinline__ void operator()(const pg8::f32x4 (&acc)[2][2][4][2], const pg8::Unit& u, int wr, int wc, int fr, int fq) const {
        const int row0 = u.pm * 256 + wr * 64 + fr, p0 = u.pn * 256;
        disp<0>(acc, row0, p0, p0 + wc * 32 + 4 * fq);
        disp<1>(acc, row0, p0 + 128, p0 + 128 + wc * 32 + 4 * fq);
    }
};
template <class F> __device__ __forceinline__ void gemm_pg8(unsigned char* lds, const bf16* A, int lda, const bf16* Bt, int ldb, int M, int N, int K, const F& f, int wg_off = 0) {
    if ((int)blockIdx.x < wg_off) return;
    pg8::Gemm g{A, Bt, M, N, K, lda, ldb}; pg8::StaticOrder S; S.init(M, N, (int)gridDim.x, (int)blockIdx.x - wg_off);
    EpiQuad<F> E{f};
    pg8::gemm_phase<EpiQuad<F>, pg8::StaticOrder, true, true>((PG8_LAS unsigned char*)lds, g, S, E);
}

namespace cg = cooperative_groups;
template <bool XIN16, bool XOUT16> struct EpiNormRes {
    static constexpr bool PERM = false, AFTER_DRAIN = true;
    const void* xin; void* xout; bf16* xn; const float* gpost; const float* gpre; float coef; unsigned* part; unsigned* cnt;
    __device__ __forceinline__ void operator()(const pg8::f32x4 (&)[2][2][4][2], const pg8::Unit&, int, int, int, int) const {}
    __device__ __forceinline__ void rowstat(const pg8::f32x4 (&acc)[2][2][4][2], float* P, int wr, int wc, int fr, int fq) const {
#pragma unroll
        for (int ai = 0; ai < 2; ++ai)
#pragma unroll
            for (int m = 0; m < 4; ++m) { float sq = 0.f;
#pragma unroll
                for (int bj = 0; bj < 2; ++bj)
#pragma unroll
                    for (int n = 0; n < 2; ++n) { const pg8::f32x4 v = acc[ai][bj][m][n]; sq += (v[0] * v[0] + v[1] * v[1]) + (v[2] * v[2] + v[3] * v[3]); }
                sq += __shfl_xor(sq, 16); sq += __shfl_xor(sq, 32);
                if (fq == 0) P[(ai * 128 + wr * 64 + m * 16 + fr) * 4 + wc] = sq; }
    }
    __device__ __forceinline__ void exchange(float* P, float* S, unsigned* bank, unsigned* cnt_, const pg8::Unit& u, int tid, float scale) const {
        __syncthreads();
        if (tid < 256) { const f32x4 p = *(const f32x4*)(P + tid * 4);
            __hip_atomic_store(bank + (size_t)(u.pm * 256 + tid) * 4 + u.pn, __builtin_bit_cast(unsigned, (p[0] + p[1]) + (p[2] + p[3])), __ATOMIC_RELAXED, __HIP_MEMORY_SCOPE_AGENT); }
        asm volatile("s_waitcnt vmcnt(0)" ::: "memory");
        __syncthreads();
        if (tid == 0) { unsigned* c = cnt_ + u.pm * 16; __hip_atomic_fetch_add(c, 1u, __ATOMIC_RELAXED, __HIP_MEMORY_SCOPE_AGENT);
            while (__hip_atomic_load(c, __ATOMIC_RELAXED, __HIP_MEMORY_SCOPE_AGENT) < 4u) __builtin_amdgcn_s_sleep(1); }
        __syncthreads();
        if (tid < 256) { const unsigned* b = bank + (size_t)(u.pm * 256 + tid) * 4; float q = 0.f;
#pragma unroll
            for (int j = 0; j < 4; ++j) q += __builtin_bit_cast(float, __hip_atomic_load(b + j, __ATOMIC_RELAXED, __HIP_MEMORY_SCOPE_AGENT));
            S[tid] = rsqrtf(q * (1.f / DM) + NORM_EPS) * scale; }
        __syncthreads();
    }
    __device__ __forceinline__ void fused(pg8::f32x4 (&acc)[2][2][4][2], const pg8::Unit& u, int wr, int wc, int fr, int fq, PG8_LAS unsigned char* lds, int wid, int lane) const {
        float* P = (float*)lds; float* S = P + 1024; const int tid = wid * 64 + lane;
        rowstat(acc, P, wr, wc, fr, fq);
        exchange(P, S, part, cnt, u, tid, coef);
        const int col0 = u.pn * 256 + wc * 32 + 4 * fq;
#pragma unroll
        for (int ai = 0; ai < 2; ++ai)
#pragma unroll
            for (int m = 0; m < 4; ++m) { const int r = ai * 128 + wr * 64 + m * 16 + fr; const float sr = S[r]; const size_t off = (size_t)(u.pm * 256 + r) * DM + col0;
#pragma unroll
                for (int bj = 0; bj < 2; ++bj)
#pragma unroll
                    for (int n = 0; n < 2; ++n) { const int o = bj * 128 + n * 16; const f32x4 g4 = *(const f32x4*)(gpost + col0 + o);
                        f32x4 x4;
                        if (XIN16) { const u32x2 w = *(const u32x2*)((const bf16*)xin + off + o);
                            x4 = (f32x4){__builtin_bit_cast(float, w.x << 16), __builtin_bit_cast(float, w.x & 0xffff0000u), __builtin_bit_cast(float, w.y << 16), __builtin_bit_cast(float, w.y & 0xffff0000u)}; }
                        else x4 = *(const f32x4*)((const float*)xin + off + o);
                        const f32x4 y = x4 + acc[ai][bj][m][n] * sr * g4; acc[ai][bj][m][n] = y;
                        if (XOUT16) st_bf4((bf16*)xout + off + o, y); else *(f32x4*)((float*)xout + off + o) = y; }
                asm volatile("" ::: "memory"); }
        if (!gpre) return;
        rowstat(acc, P, wr, wc, fr, fq);
        exchange(P, S, part + (size_t)M_ * 4, cnt + 64 * 16, u, tid, 1.f);
#pragma unroll
        for (int ai = 0; ai < 2; ++ai)
#pragma unroll
            for (int m = 0; m < 4; ++m) { const int r = ai * 128 + wr * 64 + m * 16 + fr; const float sr = S[r]; const size_t off = (size_t)(u.pm * 256 + r) * DM + col0;
#pragma unroll
                for (int bj = 0; bj < 2; ++bj)
#pragma unroll
                    for (int n = 0; n < 2; ++n) { const int o = bj * 128 + n * 16; const f32x4 g4 = *(const f32x4*)(gpre + col0 + o); st_bf4(xn + off + o, acc[ai][bj][m][n] * sr * g4); }
                asm volatile("" ::: "memory"); }
    }
};
template <bool XIN16, bool XOUT16>
__device__ __forceinline__ void gemm_norm_res(unsigned char* lds, const bf16* A, int lda, const bf16* Bt, int K, const void* xin, void* xout, bf16* xn, const float* gpost, const float* gpre,
                                              float coef, unsigned* part, unsigned* cnt) {
    pg8::Gemm g{A, Bt, M_, DM, K, lda, K}; pg8::StaticOrder S; S.init(M_, DM, 256, (int)blockIdx.x);
    const EpiNormRes<XIN16, XOUT16> E{xin, xout, xn, gpost, gpre, coef, part, cnt};
    pg8::gemm_phase<EpiNormRes<XIN16, XOUT16>, pg8::StaticOrder, false, true>((PG8_LAS unsigned char*)lds, g, S, E);
}

__device__ __forceinline__ void d_gates(const bf16* xn, const bf16* wg  , float* gates, float* red  ) {
    const int T512 = tidx(), lane = T512 & 63, fr = lane & 15, fq = lane >> 4, w = T512 >> 6, kh = w & 1;
    for (int rt0 = blockIdx.x * 4; rt0 < M_ / 16; rt0 += gridDim.x * 4) {
        const int rt = rt0 + (w >> 1);
        const bf16* ap = xn + (size_t)(rt * 16 + fr) * DM + 8 * fq + kh * 512; const bf16* bp = wg + (size_t)fr * DM + 8 * fq + kh * 512;
        f32x4 c0 = {0.f, 0.f, 0.f, 0.f}, c1 = {0.f, 0.f, 0.f, 0.f};
#pragma unroll 8
        for (int k0 = 0; k0 < 512; k0 += 32) { const bf16x8 a = *(const bf16x8*)(ap + k0);
            c0 = __builtin_amdgcn_mfma_f32_16x16x32_bf16(*(const bf16x8*)(bp + k0), a, c0, 0, 0, 0);
            c1 = __builtin_amdgcn_mfma_f32_16x16x32_bf16(*(const bf16x8*)(bp + (size_t)16 * DM + k0), a, c1, 0, 0, 0); }
        float* r = red + ((w >> 1) * 64 + lane) * 8;
        if (kh) { *(f32x4*)r = c0; *(f32x4*)(r + 4) = c1; }
        __syncthreads();
        if (!kh) { c0 += *(const f32x4*)r; c1 += *(const f32x4*)(r + 4);
            float* o = gates + (size_t)(rt * 16 + fr) * 24 + 4 * fq;
            *(f32x4*)o = (f32x4){sigmoidf_(c0[0]), sigmoidf_(c0[1]), sigmoidf_(c0[2]), sigmoidf_(c0[3])};
            if (fq < 2) *(f32x4*)(o + 16) = (f32x4){sigmoidf_(c1[0]), sigmoidf_(c1[1]), sigmoidf_(c1[2]), sigmoidf_(c1[3])}; }
        __syncthreads();
    }
}

__device__ __forceinline__ void d_cmp2(const float* part  , const float* bias  , const bf16* w2t, const float* rope, bf16* kc, bf16* vct) {
    const int T512 = tidx(), lane = T512 & 63, fr = lane & 15, fq = lane >> 4;
    for (int task = blockIdx.x * 8 + (T512 >> 6); task < 256; task += gridDim.x * 8) {
        const int kv = task >> 7, R0 = (task & 127) * 16;
        const float* p0 = part + ((size_t)(kv * 2) * 2048 + R0 + fr) * 256 + 8 * fq; const float* p1 = p0 + (size_t)2048 * 256;
        const float* bb = bias + kv * 256 + 8 * fq;
        const bf16* bp = w2t + (size_t)kv * 64 * 256 + (size_t)fr * 256 + 8 * fq;
        f32x4 acc[4];
#pragma unroll
        for (int nt = 0; nt < 4; ++nt) acc[nt] = (f32x4){0.f, 0.f, 0.f, 0.f};
#pragma unroll
        for (int k0 = 0; k0 < 256; k0 += 32) {
            f32x4 xa = *(const f32x4*)(p0 + k0) + *(const f32x4*)(p1 + k0) + *(const f32x4*)(bb + k0);
            f32x4 xb = *(const f32x4*)(p0 + k0 + 4) + *(const f32x4*)(p1 + k0 + 4) + *(const f32x4*)(bb + k0 + 4);
#pragma unroll
            for (int e = 0; e < 4; ++e) { xa[e] = xa[e] / (1.f + __expf(-xa[e])); xb[e] = xb[e] / (1.f + __expf(-xb[e])); }
            const bf16x8 a = __builtin_bit_cast(bf16x8, (u32x4){pk2(xa[0], xa[1]), pk2(xa[2], xa[3]), pk2(xb[0], xb[1]), pk2(xb[2], xb[3])});
#pragma unroll
            for (int nt = 0; nt < 4; ++nt) acc[nt] = __builtin_amdgcn_mfma_f32_16x16x32_bf16(*(const bf16x8*)(bp + (size_t)nt * 16 * 256 + k0), a, acc[nt], 0, 0, 0);
        }
        const int R = R0 + fr, bg = R >> 9, c = R & 511;
        if (kv == 0) {
            const int pos = (16 * c + 31) & (T_ - 1);
#pragma unroll
            for (int h2 = 0; h2 < 2; ++h2) {
                const int d = 16 * h2 + 4 * fq; const f32x4* rp = (const f32x4*)(rope + ((size_t)pos * 32 + d) * 2); const f32x4 r0 = rp[0], r1 = rp[1];
                const f32x4 cs = {r0[0], r0[2], r1[0], r1[2]}, sn = {r0[1], r0[3], r1[1], r1[3]};
                const f32x4 lo = acc[h2] * cs - acc[h2 + 2] * sn, hi = acc[h2] * sn + acc[h2 + 2] * cs;
                st_bf4(kc + (size_t)R * 64 + d, lo); st_bf4(kc + (size_t)R * 64 + d + 32, hi);
            }
        } else {
#pragma unroll
            for (int nt = 0; nt < 4; ++nt)
#pragma unroll
                for (int e = 0; e < 4; ++e) vct[((size_t)bg * 64 + 16 * nt + 4 * fq + e) * NCP + c] = (bf16)f2bf(acc[nt][e]);
        }
    }
}

struct NsaArgs { const bf16 *qb, *kc, *vct, *ks, *vst, *kw, *vwt; const float* gates; bf16* amix; };
__device__ __forceinline__ float dot64(const float* q, const bf16* k) {
    float s = 0.f;
#pragma unroll
    for (int i = 0; i < 8; ++i) { const u32x4 w = ((const u32x4*)k)[i];
        s += q[8 * i + 0] * __builtin_bit_cast(float, w.x << 16) + q[8 * i + 1] * __builtin_bit_cast(float, w.x & 0xffff0000u)
           + q[8 * i + 2] * __builtin_bit_cast(float, w.y << 16) + q[8 * i + 3] * __builtin_bit_cast(float, w.y & 0xffff0000u)
           + q[8 * i + 4] * __builtin_bit_cast(float, w.z << 16) + q[8 * i + 5] * __builtin_bit_cast(float, w.z & 0xffff0000u)
           + q[8 * i + 6] * __builtin_bit_cast(float, w.w << 16) + q[8 * i + 7] * __builtin_bit_cast(float, w.w & 0xffff0000u); }
    return s;
}
__device__ __forceinline__ void softmax_row(float* s, int n, int lane) {
    float m = -INFINITY; for (int i = lane; i < n; i += 64) m = fmaxf(m, s[i]);
    m = wave_max(m); if (m == -INFINITY) m = 0.f;
    float l = 0.f; for (int i = lane; i < n; i += 64) { const float e = exp2f(s[i] - m); s[i] = e; l += e; }
    l = wave_sum(l); const float inv = 1.f / fmaxf(l, 1e-30f);
    for (int i = lane; i < n; i += 64) s[i] *= inv;
}
__device__ __forceinline__ void d_nsa_simple(const NsaArgs& a, int vb, int tid, unsigned char* smem) {
    float (*qs)[64] = (float (*)[64])smem; float (*sc)[1024] = (float (*)[1024])(smem + 1024); float* imp = (float*)(smem + 17408); float* score = imp + 128;
    int* list = (int*)(score + 128); int* nlist = list + 16;
    const int bg = vb / T_, t = vb % T_, b = bg >> 1, g = bg & 1;
    const int r = tid >> 6, d = tid & 63, lane = d;
    const size_t row = (size_t)b * T_ + t;
    qs[r][d] = bf2f(a.qb[row * 512 + g * 256 + r * 64 + d]);
    if (tid == 0) *nlist = 0;
    __syncthreads();
    const int nv = t < 31 ? 0 : (t - 31) / 16 + 1;
    for (int c = tid; c < nv; c += 256) { const bf16* k = a.kc + ((size_t)bg * NCP + c) * 64;
        _Pragma("unroll 1") for (int rr = 0; rr < 4; ++rr) sc[rr][c] = dot64(qs[rr], k); }
    __syncthreads();
    softmax_row(sc[r], nv, lane);
    __syncthreads();
    float oc = 0.f; { const bf16* v = a.vct + ((size_t)bg * 64 + d) * NCP; for (int c = 0; c < nv; ++c) oc += sc[r][c] * bf2f(v[c]); }
    if (tid < 128) { const int s = tid; float acc = 0.f;
        for (int c = 4 * s - 1; c <= 4 * s + 3; ++c) if (c >= 0 && c < nv) acc += sc[0][c] + sc[1][c] + sc[2][c] + sc[3][c];
        imp[s] = acc; }
    __syncthreads();
    const int cur = t >> 6;
    if (tid < 128) { const int s = tid; const bool forced = (s == 0) || (s == cur) || (s == cur - 1);
        score[s] = forced ? 1e4f : (s <= cur ? imp[s] : -1e4f); }
    __syncthreads();
    if (tid < 128) { const int s = tid; const float my = score[s]; int rank = 0;
        for (int j = 0; j < 128; ++j) { const float o = score[j]; rank += (o > my || (o == my && j < s)) ? 1 : 0; }
        if (rank < 16 && s <= cur) { const int slot = atomicAdd(nlist, 1); list[slot] = s; } }
    __syncthreads();
    const int ns = *nlist * 64;
    for (int i = tid; i < ns; i += 256) { const int pos = list[i >> 6] * 64 + (i & 63);
        if (pos <= t) { const bf16* k = a.ks + ((size_t)bg * T_ + pos) * 64; _Pragma("unroll 1") for (int rr = 0; rr < 4; ++rr) sc[rr][i] = dot64(qs[rr], k); }
        else { sc[0][i] = -INFINITY; sc[1][i] = -INFINITY; sc[2][i] = -INFINITY; sc[3][i] = -INFINITY; } }
    __syncthreads();
    softmax_row(sc[r], ns, lane);
    __syncthreads();
    float os = 0.f; { const bf16* v = a.vst + ((size_t)bg * 64 + d) * T_;
        for (int i = 0; i < ns; ++i) { const int pos = list[i >> 6] * 64 + (i & 63); if (pos <= t) os += sc[r][i] * bf2f(v[pos]); } }
    __syncthreads();
    const int lo = t - 511 > 0 ? t - 511 : 0, nw = t - lo + 1;
    for (int i = tid; i < nw; i += 256) { const bf16* k = a.kw + ((size_t)bg * T_ + lo + i) * 64;
        _Pragma("unroll 1") for (int rr = 0; rr < 4; ++rr) sc[rr][i] = dot64(qs[rr], k); }
    __syncthreads();
    softmax_row(sc[r], nw, lane);
    __syncthreads();
    float ow = 0.f; { const bf16* v = a.vwt + ((size_t)bg * 64 + d) * T_ + lo; for (int i = 0; i < nw; ++i) ow += sc[r][i] * bf2f(v[i]); }
    const float* gt = a.gates + row * 24 + g * 12 + r * 3;
    a.amix[row * DM + g * 256 + r * 64 + d] = (bf16)f2bf(gt[0] * oc + gt[1] * os + gt[2] * ow);
    __syncthreads();
}


namespace nsa {
typedef float f32x16 __attribute__((ext_vector_type(16)));
constexpr int KROW = 144, VROW = 136, KBUF = 64 * KROW, VBUF = 64 * VROW;
constexpr int OFF_K = 0, OFF_V = 2 * KBUF, OFF_IMP = OFF_V + 2 * VBUF, IMPW = 130, OFF_SEL = OFF_IMP + 64 * IMPW * 4, OFF_UM = OFF_SEL + 1024, OFF_WS = OFF_UM + 16, OFF_UNIT = OFF_WS + 1024, OFF_ACC = OFF_UNIT + 16, LDS_NEED = OFF_ACC + 8 * 8192;
static_assert(LDS_NEED <= 147456 - 64 && OFF_ACC % 16 == 0, "nsa lds");
static_assert(OFF_IMP % 16 == 0 && OFF_SEL % 16 == 0 && OFF_WS % 16 == 0, "nsa lds map");
__device__ __forceinline__ int crow(int r, int hi) { return (r & 3) + 8 * (r >> 2) + 4 * hi; }
__device__ __forceinline__ int next_bit(unsigned m0, unsigned m1, unsigned m2, unsigned m3, int from) {
#pragma unroll
    for (int wd = 0; wd < 4; ++wd) {
        unsigned x = wd == 0 ? m0 : (wd == 1 ? m1 : (wd == 2 ? m2 : m3)); const int base = wd * 32;
        if (from < base + 32) { if (from > base) x &= (~0u) << (from - base); if (x) return base + __builtin_ctz(x); }
    }
    return 128;
}
__device__ __forceinline__ bf16x8 pack8(const f32x16& p, int b0) {
    u32x4 w; w.x = pk2(p[b0 + 0], p[b0 + 1]); w.y = pk2(p[b0 + 2], p[b0 + 3]); w.z = pk2(p[b0 + 4], p[b0 + 5]); w.w = pk2(p[b0 + 6], p[b0 + 7]);
    return __builtin_bit_cast(bf16x8, w);
}
struct Branch { const bf16* k; const bf16* vt; int ldv; };

constexpr float THR = 8.f;
template <int MODE, bool SEL>
__device__ __forceinline__ void compute_tile(unsigned char* sm, int cb, int j, const bf16x8 (&qf)[4], int lo, int hi_b, int lo_max, int hi_min, unsigned s0, unsigned s1, unsigned s2, unsigned s3,
                                             float& m, float& l, float invl, bool& initd, f32x16& negm, f32x16 (&o)[2], float* imp_row, float* wsc, int i, int hi) {
        const unsigned char* kb = sm + OFF_K + cb * KBUF; const unsigned char* vb = sm + OFF_V + cb * VBUF;
        const int key0 = 64 * j;
        bool rowsel = true;
        if (SEL) { const unsigned wsel = j < 32 ? s0 : (j < 64 ? s1 : (j < 96 ? s2 : s3)); rowsel = (wsel >> (j & 31)) & 1u; }
        if (!SEL || __any(rowsel)) {
            f32x16 p0, p1;
            {
                f32x16 c0;
                if (SEL) {
#pragma unroll
                    for (int r = 0; r < 16; ++r) c0[r] = rowsel ? negm[r] : -INFINITY;
                } else c0 = negm;
                bf16x8 ka[8];
#pragma unroll
                for (int d0 = 0; d0 < 4; ++d0) { ka[2 * d0] = *(const bf16x8*)(kb + i * KROW + (16 * d0 + 8 * hi) * 2); ka[2 * d0 + 1] = *(const bf16x8*)(kb + (32 + i) * KROW + (16 * d0 + 8 * hi) * 2); }
                __builtin_amdgcn_sched_barrier(0);
                p0 = __builtin_amdgcn_mfma_f32_32x32x16_bf16(ka[0], qf[0], c0, 0, 0, 0);
                p1 = __builtin_amdgcn_mfma_f32_32x32x16_bf16(ka[1], qf[0], c0, 0, 0, 0);
#pragma unroll
                for (int d0 = 1; d0 < 4; ++d0) {
                    p0 = __builtin_amdgcn_mfma_f32_32x32x16_bf16(ka[2 * d0], qf[d0], p0, 0, 0, 0);
                    p1 = __builtin_amdgcn_mfma_f32_32x32x16_bf16(ka[2 * d0 + 1], qf[d0], p1, 0, 0, 0);
                }
            }
            bf16x8 vfr[8];
            if (MODE != 0) {
#pragma unroll
                for (int dt = 0; dt < 2; ++dt) { const unsigned char* vp = vb + (32 * dt + i) * VROW + 8 * hi;
#pragma unroll
                    for (int ks = 0; ks < 4; ++ks) { const u32x2 v_lo = *(const u32x2*)(vp + 32 * ks), v_hi = *(const u32x2*)(vp + 32 * ks + 16);
                        vfr[dt * 4 + ks] = __builtin_bit_cast(bf16x8, (u32x4){v_lo.x, v_lo.y, v_hi.x, v_hi.y}); } }
                __builtin_amdgcn_sched_barrier(0);
            }
            if (!(key0 >= lo_max && key0 + 63 <= hi_min)) {
#pragma unroll
                for (int r = 0; r < 16; ++r) { const int key = key0 + crow(r, hi);
                    if (key < lo || key > hi_b) p0[r] = -INFINITY;
                    if (key + 32 < lo || key + 32 > hi_b) p1[r] = -INFINITY; }
            }
            if (MODE == 1) {
#pragma unroll
                for (int r = 0; r < 16; ++r) { p0[r] = __builtin_amdgcn_exp2f(p0[r]) * invl; p1[r] = __builtin_amdgcn_exp2f(p1[r]) * invl; }
#pragma unroll
                for (int gq = 0; gq < 4; ++gq) {
                    float G0 = (p0[4 * gq] + p0[4 * gq + 1]) + (p0[4 * gq + 2] + p0[4 * gq + 3]), L0 = p0[4 * gq + 3];
                    float G1 = (p1[4 * gq] + p1[4 * gq + 1]) + (p1[4 * gq + 2] + p1[4 * gq + 3]), L1 = p1[4 * gq + 3];
                    G0 += __shfl_xor(G0, 1); L0 += __shfl_xor(L0, 1); G1 += __shfl_xor(G1, 1); L1 += __shfl_xor(L1, 1);
                    G0 += __shfl_xor(G0, 2); L0 += __shfl_xor(L0, 2); G1 += __shfl_xor(G1, 2); L1 += __shfl_xor(L1, 2);
                    if ((i & 3) == 0) { const int s = 16 * j + 2 * gq + hi;
                        atomicAdd(imp_row + s, G0); atomicAdd(imp_row + s + 1, L0); atomicAdd(imp_row + s + 8, G1); atomicAdd(imp_row + s + 9, L1); }
                }
            } else {
                float ta = fmaxf(fmaxf(p0[0], p0[1]), p1[0]), tb = fmaxf(fmaxf(p0[2], p0[3]), p1[1]);
                ta = fmaxf(fmaxf(ta, p1[2]), p1[3]);
#pragma unroll
                for (int r = 4; r < 16; r += 4) { ta = fmaxf(fmaxf(ta, p0[r]), p0[r + 1]); tb = fmaxf(fmaxf(tb, p0[r + 2]), p0[r + 3]); ta = fmaxf(fmaxf(ta, p1[r]), p1[r + 1]); tb = fmaxf(fmaxf(tb, p1[r + 2]), p1[r + 3]); }
                float tm = fmaxf(ta, tb);
                tm = fmaxf(tm, __shfl_xor(tm, 32));
                if (__any((!initd && tm > -INFINITY) || tm > THR)) {
                    const bool was = initd;
                    const float d = was ? fmaxf(tm, 0.f) : (tm > -INFINITY ? tm : 0.f);
                    initd = was || (tm > -INFINITY);
                    m += d; const float alpha = was ? __builtin_amdgcn_exp2f(-d) : 1.f; l *= alpha;
#pragma unroll
                    for (int r = 0; r < 16; ++r) { p0[r] -= d; p1[r] -= d; negm[r] = -m; }
                    if (MODE == 2) {
                        if (hi == 0) wsc[i] = alpha;
                        asm volatile("" ::: "memory");
#pragma unroll
                        for (int rg = 0; rg < 4; ++rg) { const f32x4 a4 = *(const f32x4*)(wsc + 8 * rg + 4 * hi);
#pragma unroll
                            for (int e = 0; e < 4; ++e) { o[0][4 * rg + e] *= a4[e]; o[1][4 * rg + e] *= a4[e]; } }
                        asm volatile("" ::: "memory");
                    }
                }
                float rs = 0.f;
#pragma unroll
                for (int r = 0; r < 16; ++r) { p0[r] = __builtin_amdgcn_exp2f(p0[r]); p1[r] = __builtin_amdgcn_exp2f(p1[r]); rs += p0[r] + p1[r]; }
                l += rs;
            }
            if (MODE != 0) {
                const bf16x8 pf0 = pack8(p0, 0), pf1 = pack8(p0, 8), pf2 = pack8(p1, 0), pf3 = pack8(p1, 8);
#pragma unroll
                for (int dt = 0; dt < 2; ++dt)
#pragma unroll
                    for (int ks = 0; ks < 4; ++ks)
                        o[dt] = __builtin_amdgcn_mfma_f32_32x32x16_bf16(ks == 0 ? pf0 : (ks == 1 ? pf1 : (ks == 2 ? pf2 : pf3)), vfr[dt * 4 + ks], o[dt], 0, 0, 0);
            }
        }
}
template <int MODE, bool SEL>
__device__ __forceinline__ void run_branch(unsigned char* sm, const Branch br, unsigned m0, unsigned m1, unsigned m2, unsigned m3,
                                           const bf16x8 (&qf)[4], int lo, int hi_b, int lo_max, int hi_min, unsigned s0, unsigned s1, unsigned s2, unsigned s3,
                                           float& m, float& l, float invl, f32x16 (&o)[2], float* imp_row, float* wsc, int tid, int lane) {
    const int i = lane & 31, hi = lane >> 5;
    const bf16* kp = br.k + tid * 8; const bf16* vp_ = br.vt + (size_t)(tid >> 3) * br.ldv + (tid & 7) * 8;
    unsigned char* kst = sm + OFF_K + (tid >> 3) * KROW + (tid & 7) * 16; unsigned char* vst = sm + OFF_V + (tid >> 3) * VROW + (tid & 7) * 16;
#define NSA_LOAD(jj, KR, VR) do { KR = *(const u32x4*)(kp + (size_t)(jj) * 4096); if (MODE != 0) VR = *(const u32x4*)(vp_ + (jj) * 64); } while (0)
#define NSA_STORE(buf, KR, VR) do { *(u32x4*)(kst + (buf) * KBUF) = KR; if (MODE != 0) { *(u32x2*)(vst + (buf) * VBUF) = (u32x2){VR.x, VR.y}; *(u32x2*)(vst + (buf) * VBUF + 8) = (u32x2){VR.z, VR.w}; } } while (0)
    int j = next_bit(m0, m1, m2, m3, 0);
    int j1 = j < 128 ? next_bit(m0, m1, m2, m3, j + 1) : 128;
    u32x4 kA, vA, kB, vB;
    if (j < 128) { NSA_LOAD(j, kA, vA); if (j1 < 128) NSA_LOAD(j1, kB, vB); NSA_STORE(0, kA, vA); }
    __syncthreads();
    bool initd = (MODE == 1);
    f32x16 negm;
#pragma unroll
    for (int r = 0; r < 16; ++r) negm[r] = (MODE == 1) ? -m : 0.f;
    while (j < 128) {
        {
            const int j2 = j1 < 128 ? next_bit(m0, m1, m2, m3, j1 + 1) : 128;
            if (j2 < 128) NSA_LOAD(j2, kA, vA);
            compute_tile<MODE, SEL>(sm, 0, j, qf, lo, hi_b, lo_max, hi_min, s0, s1, s2, s3, m, l, invl, initd, negm, o, imp_row, wsc, i, hi);
            if (j1 < 128) NSA_STORE(1, kB, vB);
            __syncthreads();
            j = j1; j1 = j2;
        }
        if (j >= 128) break;
        {
            const int j2 = j1 < 128 ? next_bit(m0, m1, m2, m3, j1 + 1) : 128;
            if (j2 < 128) NSA_LOAD(j2, kB, vB);
            compute_tile<MODE, SEL>(sm, 1, j, qf, lo, hi_b, lo_max, hi_min, s0, s1, s2, s3, m, l, invl, initd, negm, o, imp_row, wsc, i, hi);
            if (j1 < 128) NSA_STORE(0, kA, vA);
            __syncthreads();
            j = j1; j1 = j2;
        }
    }
#undef NSA_LOAD
#undef NSA_STORE
}
template <bool FIRST> __device__ __forceinline__ void add_scaled(float* accw, const f32x16 (&o)[2], float f, float* wsc, int i, int hi, int lane) {
    if (hi == 0) wsc[i] = f;
    asm volatile("" ::: "memory");
#pragma unroll
    for (int rg = 0; rg < 4; ++rg) { const f32x4 a4 = *(const f32x4*)(wsc + 8 * rg + 4 * hi);
#pragma unroll
        for (int e = 0; e < 4; ++e)
#pragma unroll
            for (int dt = 0; dt < 2; ++dt) { float* p = accw + (dt * 16 + 4 * rg + e) * 64 + lane; const float v = a4[e] * o[dt][4 * rg + e]; *p = FIRST ? v : (*p + v); } }
    asm volatile("" ::: "memory");
}
__device__ __forceinline__ void unit(const NsaArgs& a, int u, unsigned char* sm) {
    const int tid = tidx(), lane = tid & 63, w = __builtin_amdgcn_readfirstlane(tid >> 6), i = lane & 31, hi = lane >> 5;
    const int cur = 127 - (u >> 2), bg = u & 3, b = bg >> 1, g = bg & 1, q0 = cur * 64;
    const int ql = 8 * w + (i >> 2), hd = i & 3, t = q0 + ql;
    const size_t grow = (size_t)b * T_ + t;
    bf16x8 qf[4];
    { const bf16* qp = a.qb + grow * 512 + g * 256 + hd * 64 + 8 * hi;
#pragma unroll
      for (int d0 = 0; d0 < 4; ++d0) qf[d0] = *(const bf16x8*)(qp + 16 * d0); }
    float* wsc = (float*)(sm + OFF_WS) + w * 32;
    float* imp = (float*)(sm + OFF_IMP);
    unsigned* selw = (unsigned*)(sm + OFF_SEL);
    unsigned* um = (unsigned*)(sm + OFF_UM);
    for (int k = tid; k < 64 * IMPW; k += 512) imp[k] = 0.f;
    if (tid < 4) um[tid] = 0u;
    const float* gt = a.gates + grow * 24 + g * 12 + hd * 3;
    const float gc = gt[0], gs = gt[1], gw = gt[2];
    f32x16 o[2];
    float* accw = (float*)(sm + OFF_ACC) + w * 2048;
    const int tw0 = q0 + 8 * w, tw1 = tw0 + 7;
    {
        const int nv = t < 31 ? 0 : (t - 31) / 16 + 1;
        const int nvw = tw0 < 31 ? 0 : (tw0 - 31) / 16 + 1;
        const int nvmax = (q0 + 63 - 31) / 16 + 1, ntc = (nvmax + 63) / 64;
        const unsigned cm0 = ntc >= 32 ? ~0u : ((1u << ntc) - 1u);
        const Branch br{a.kc + (size_t)bg * NCP * 64, a.vct + (size_t)bg * 64 * NCP, NCP};
        float m = 0.f, l = 0.f;
        run_branch<0, false>(sm, br, cm0, 0u, 0u, 0u, qf, 0, nv - 1, 0, nvw - 1, 0u, 0u, 0u, 0u, m, l, 0.f, o, nullptr, wsc, tid, lane);
        l += __shfl_xor(l, 32);
        const float invl = 1.f / fmaxf(l, 1e-30f);
#pragma unroll
        for (int r = 0; r < 16; ++r) { o[0][r] = 0.f; o[1][r] = 0.f; }
        run_branch<1, false>(sm, br, cm0, 0u, 0u, 0u, qf, 0, nv - 1, 0, nvw - 1, 0u, 0u, 0u, 0u, m, l, invl, o, imp + ql * IMPW, wsc, tid, lane);
        add_scaled<true>(accw, o, gc, wsc, i, hi, lane);
    }
    {
        unsigned u0 = 0u, u1 = 0u, u2 = 0u, u3 = 0u;
        const int ncand = cur - 2;
        unsigned k0[8], k1[8], k2[8], k3[8];
        if (ncand <= 13) {
#pragma unroll
            for (int wd = 0; wd < 4; ++wd) { const int nb = cur + 1 - 32 * wd; const unsigned x = nb >= 32 ? ~0u : (nb <= 0 ? 0u : ((1u << nb) - 1u));
#pragma unroll
                for (int qq = 0; qq < 8; ++qq) { if (wd == 0) k0[qq] = x; else if (wd == 1) k1[qq] = x; else if (wd == 2) k2[qq] = x; else k3[qq] = x; } }
        } else {
            float v0[8], v1[8];
#pragma unroll
            for (int qq = 0; qq < 8; ++qq) { const float* ir = imp + (8 * w + qq) * IMPW;
                v0[qq] = (lane >= 1 && lane <= cur - 2) ? ir[lane] : -1.f; v1[qq] = (lane + 64 <= cur - 2) ? ir[lane + 64] : -1.f;
                k0[qq] = 1u; k1[qq] = 0u; k2[qq] = 0u; k3[qq] = 0u; }
            for (int it = 0; it < 13; ++it) {
                float bv[8]; int bs[8];
#pragma unroll
                for (int qq = 0; qq < 8; ++qq) { bv[qq] = v0[qq]; bs[qq] = lane; if (v1[qq] > v0[qq]) { bv[qq] = v1[qq]; bs[qq] = lane + 64; } }
#pragma unroll
                for (int off = 1; off < 64; off <<= 1) {
#pragma unroll
                    for (int qq = 0; qq < 8; ++qq) { const float ov = __shfl_xor(bv[qq], off); const int os = __shfl_xor(bs[qq], off);
                        if (ov > bv[qq] || (ov == bv[qq] && os < bs[qq])) { bv[qq] = ov; bs[qq] = os; } } }
#pragma unroll
                for (int qq = 0; qq < 8; ++qq) { const int b_ = __builtin_amdgcn_readfirstlane(bs[qq]);
                    if (b_ == lane) v0[qq] = -1.f; if (b_ == lane + 64) v1[qq] = -1.f;
                    const unsigned bit = 1u << (b_ & 31);
                    if (b_ < 32) k0[qq] |= bit; else if (b_ < 64) k1[qq] |= bit; else if (b_ < 96) k2[qq] |= bit; else k3[qq] |= bit; }
            }
            { const int c1 = cur - 1; const unsigned b1 = 1u << (c1 & 31), b2 = 1u << (cur & 31);
#pragma unroll
              for (int qq = 0; qq < 8; ++qq) {
                if (c1 < 32) k0[qq] |= b1; else if (c1 < 64) k1[qq] |= b1; else if (c1 < 96) k2[qq] |= b1; else k3[qq] |= b1;
                if (cur < 32) k0[qq] |= b2; else if (cur < 64) k1[qq] |= b2; else if (cur < 96) k2[qq] |= b2; else k3[qq] |= b2; } }
        }
#pragma unroll
        for (int qq = 0; qq < 8; ++qq) {
            if (lane == 0) { unsigned* sp = selw + (8 * w + qq) * 4; sp[0] = k0[qq]; sp[1] = k1[qq]; sp[2] = k2[qq]; sp[3] = k3[qq]; }
            u0 |= k0[qq]; u1 |= k1[qq]; u2 |= k2[qq]; u3 |= k3[qq]; }
        if (lane == 0) { atomicOr(um + 0, u0); atomicOr(um + 1, u1); atomicOr(um + 2, u2); atomicOr(um + 3, u3); }
    }
    __syncthreads();
    {
        const unsigned U0 = um[0], U1 = um[1], U2 = um[2], U3 = um[3];
        const unsigned* sp = selw + ql * 4; const unsigned s0 = sp[0], s1 = sp[1], s2 = sp[2], s3 = sp[3];
        const Branch br{a.ks + (size_t)bg * T_ * 64, a.vst + (size_t)bg * 64 * T_, T_};
        float m = 0.f, l = 0.f;
#pragma unroll
        for (int r = 0; r < 16; ++r) { o[0][r] = 0.f; o[1][r] = 0.f; }
        run_branch<2, true>(sm, br, __builtin_amdgcn_readfirstlane(U0), __builtin_amdgcn_readfirstlane(U1), __builtin_amdgcn_readfirstlane(U2), __builtin_amdgcn_readfirstlane(U3),
                            qf, 0, t, 0, tw0, s0, s1, s2, s3, m, l, 0.f, o, nullptr, wsc, tid, lane);
        l += __shfl_xor(l, 32);
        add_scaled<false>(accw, o, gs / fmaxf(l, 1e-30f), wsc, i, hi, lane);
    }
    {
        const int j0 = cur - 8 > 0 ? cur - 8 : 0;
        unsigned wm0 = 0u, wm1 = 0u, wm2 = 0u, wm3 = 0u;
#pragma unroll
        for (int wd = 0; wd < 4; ++wd) { const int a0 = j0 - 32 * wd, a1 = cur + 1 - 32 * wd;
            const unsigned hi_m = a1 >= 32 ? ~0u : (a1 <= 0 ? 0u : ((1u << a1) - 1u)), lo_m = a0 >= 32 ? ~0u : (a0 <= 0 ? 0u : ((1u << a0) - 1u));
            const unsigned x = hi_m & ~lo_m; if (wd == 0) wm0 = x; else if (wd == 1) wm1 = x; else if (wd == 2) wm2 = x; else wm3 = x; }
        const Branch br{a.kw + (size_t)bg * T_ * 64, a.vwt + (size_t)bg * 64 * T_, T_};
        float m = 0.f, l = 0.f;
#pragma unroll
        for (int r = 0; r < 16; ++r) { o[0][r] = 0.f; o[1][r] = 0.f; }
        run_branch<2, false>(sm, br, wm0, wm1, wm2, wm3, qf, t - 511, t, tw1 - 511, tw0, 0u, 0u, 0u, 0u, m, l, 0.f, o, nullptr, wsc, tid, lane);
        l += __shfl_xor(l, 32);
        add_scaled<false>(accw, o, gw / fmaxf(l, 1e-30f), wsc, i, hi, lane);
    }
#pragma unroll
    for (int r = 0; r < 16; ++r) { const int rw = crow(r, hi), qq = 8 * w + (rw >> 2), hh = rw & 3;
        bf16* op = a.amix + ((size_t)b * T_ + q0 + qq) * DM + g * 256 + hh * 64 + i;
        op[0] = (bf16)f2bf(accw[r * 64 + lane]); op[32] = (bf16)f2bf(accw[(16 + r) * 64 + lane]); }
}
__device__ __forceinline__ void phase(const NsaArgs& a, unsigned* ctr, unsigned char* sm) {
    int* slot = (int*)(sm + OFF_UNIT);
    for (;;) {
        if (tidx() == 0) *slot = (int)atomicAdd(ctr, 1u);
        __syncthreads();
        const int u = *slot;
        __syncthreads();
        if (u >= 512) break;
        unit(a, u, sm);
    }
}
}

__device__ __forceinline__ void d_lora_prep(const bf16* pr, const float* mu, bf16* la, int wg0 = 0) {
    if ((int)blockIdx.x < wg0) return;
    const int T512 = tidx(), c = T512 & 255;
    const float m = mu[1536 + c];
    for (int vb = ((int)blockIdx.x - wg0) * 2 + (T512 >> 8); vb < M_ / 4; vb += ((int)gridDim.x - wg0) * 2) {
        const int row0 = vb * 4;
        float x[5];
        x[0] = (row0 % T_) ? bf2f(pr[(size_t)(row0 - 1) * 256 + c]) : 0.f;
#pragma unroll
        for (int j = 0; j < 4; ++j) x[j + 1] = bf2f(pr[(size_t)(row0 + j) * 256 + c]);
#pragma unroll
        for (int j = 0; j < 4; ++j) { const float xs = x[j + 1] + (x[j] - x[j + 1]) * m;
            const float v = c < 64 ? tanhf(xs) : (c < 128 ? xs : sigmoidf_(xs));
            la[(size_t)(row0 + j) * KLORA + c] = (bf16)f2bf(v); }
    }
}

namespace rw7 {
using nsa::f32x16; using nsa::crow; using nsa::pack8;
constexpr int NHELP = 2, RG = 18;
constexpr int NPROD = 6, RING = 7, RA = 144, RB = 40, S_AT = 0, S_RT = 16 * RA, S_BT = 32 * RA, S_KT = S_BT + 64 * RB, S_VT = S_KT + 64 * RB, S_SM = S_VT + 64 * RB, SMM = 16 * RB, S_GC = S_SM + 4 * SMM, SLOT = S_GC + 256;
constexpr int OFF_SCR = RING * SLOT, SCR = 32 * RA, LDS_NEED = OFF_SCR;
static_assert(NPROD % NHELP == 0 && LDS_NEED <= 147456 - 64 && 7 * (SLOT + SCR) <= 147456 - 64 && (size_t)16 * NHELP * RG * SLOT <= (size_t)9 << 20 && SLOT % 16 == 0 && S_BT % 16 == 0 && 128 * RB >= 4096 && SCR >= 4096, "rw7 lds map");
struct Args { const unsigned* rkw; const bf16* vv; const bf16* aga; const float* wdec; const float *mu, *kk, *ka, *rk; float* yraw; float* bonus; unsigned char* ring; unsigned* flags; unsigned* cons; };
__device__ __forceinline__ void wg_bar() { asm volatile("s_waitcnt lgkmcnt(0)" ::: "memory"); __builtin_amdgcn_s_barrier(); asm volatile("" ::: "memory"); }
struct Chan { float mur, muk, muv, kkc, kac, rkc; };
struct Raw { unsigned rk[16]; unsigned short v[16], al[16]; float w[16]; unsigned prk; unsigned short pv; };
__device__ __forceinline__ void fetch(const Args& a, int b, int h, int c, int lane, Raw& q) {
    const size_t base = ((size_t)b * T_ + (size_t)c * 16) * 512 + h * 64 + lane;
#pragma unroll
    for (int t = 0; t < 16; ++t) { q.rk[t] = a.rkw[base + (size_t)t * 512]; q.v[t] = a.vv[base + (size_t)t * 512]; q.al[t] = a.aga[base + (size_t)t * 512]; q.w[t] = a.wdec[base + (size_t)t * 512]; }
    q.prk = 0u; q.pv = 0;
    if (c > 0) { q.prk = a.rkw[base - 512]; q.pv = a.vv[base - 512]; }
}
__device__ __forceinline__ void st_row40(unsigned char* p, const unsigned (&w)[8]) {
    *(u32x2*)p = (u32x2){w[0], w[1]}; *(u32x2*)(p + 8) = (u32x2){w[2], w[3]}; *(u32x2*)(p + 16) = (u32x2){w[4], w[5]}; *(u32x2*)(p + 24) = (u32x2){w[6], w[7]};
}
template <bool BAR> __device__ __forceinline__ void seg_end() { if (BAR) wg_bar(); else { asm volatile("s_waitcnt lgkmcnt(0)" ::: "memory"); __builtin_amdgcn_sched_barrier(0); } }
template <bool BAR> __device__ __forceinline__ void produce(const Args& a, const Chan& ch, int b, int h, int c, const Raw& q, unsigned char* slot, unsigned char* scr, int lane) {
    const int i = lane & 31, hi = lane >> 5;
    const size_t row0 = (size_t)b * T_ + (size_t)c * 16;
    float pr_r = __builtin_bit_cast(float, q.prk << 16), pr_k = __builtin_bit_cast(float, q.prk & 0xffff0000u), pr_v = bf2f(q.pv);
    float rr[16], kq[16], kt[16];
    float* RED1 = (float*)scr;
    float* RED2 = (float*)(slot + S_BT);
#pragma unroll
    for (int t4 = 0; t4 < 4; ++t4) { f32x4 e1, e2;
#pragma unroll
        for (int e = 0; e < 4; ++e) { const int t = 4 * t4 + e;
            const float r0 = __builtin_bit_cast(float, q.rk[t] << 16), k0 = __builtin_bit_cast(float, q.rk[t] & 0xffff0000u), al = bf2f(q.al[t]);
            const float r = r0 + (pr_r - r0) * ch.mur, k = k0 + (pr_k - k0) * ch.muk;
            pr_r = r0; pr_k = k0;
            rr[t] = r; kq[t] = k * ch.kkc; kt[t] = k * (1.f + (al - 1.f) * ch.kac);
            e1[e] = kq[t] * kq[t]; e2[e] = r * kt[t] * ch.rkc; }
        *(f32x4*)(RED1 + lane * 16 + 4 * t4) = e1; *(f32x4*)(RED2 + lane * 16 + 4 * t4) = e2; }
    seg_end<BAR>();
    { const int t = lane & 15, part = lane >> 4; float s1 = 0.f, s2 = 0.f;
#pragma unroll
      for (int j = 0; j < 16; ++j) { s1 += RED1[(part * 16 + j) * 16 + t]; s2 += RED2[(part * 16 + j) * 16 + t]; }
      s1 += __shfl_xor(s1, 16); s2 += __shfl_xor(s2, 16); s1 += __shfl_xor(s1, 32); s2 += __shfl_xor(s2, 32);
      asm volatile("s_waitcnt lgkmcnt(0)" ::: "memory");
      if (lane < 16) { ((float*)(slot + S_GC))[lane] = s1; a.bonus[(row0 + lane) * 8 + h] = s2; } }
    asm volatile("s_waitcnt lgkmcnt(0)" ::: "memory");
    f32x4 n2[4];
#pragma unroll
    for (int t4 = 0; t4 < 4; ++t4) n2[t4] = *(const f32x4*)(slot + S_GC + 16 * t4);
    asm volatile("s_waitcnt lgkmcnt(0)" ::: "memory");
    float gam = 1.f;
    unsigned btp[8], ktp[8], vtp[8];
    float b_ev = 0.f, k_ev = 0.f, v_ev = 0.f;
#pragma unroll
    for (int t = 0; t < 16; ++t) {
        if (t == 6) seg_end<BAR>();
        const float v0 = bf2f(q.v[t]), al = bf2f(q.al[t]);
        const float v = v0 + (pr_v - v0) * ch.muv; pr_v = v0;
        const float kkn = kq[t] * __builtin_amdgcn_rsqf(fmaxf(n2[t >> 2][t & 3], 1e-24f));
        const float gp = gam; gam *= q.w[t]; const float ig = __builtin_amdgcn_rcpf(gam);
        const float bt_ = kkn * al * ig, kt_ = kt[t] * ig;
        const unsigned ar = pk2(-kkn * gp, rr[t] * gam), bk = pk2(bt_, kt_);
        *(bf16*)(slot + S_AT + t * RA + lane * 2) = (bf16)(ar & 0xffffu); *(bf16*)(slot + S_RT + t * RA + lane * 2) = (bf16)(ar >> 16);
        *(bf16*)(scr + t * RA + lane * 2) = (bf16)(bk & 0xffffu); *(bf16*)(scr + (16 + t) * RA + lane * 2) = (bf16)(bk >> 16);
        if (t & 1) { btp[t >> 1] = pk2(b_ev, bt_); ktp[t >> 1] = pk2(k_ev, kt_); vtp[t >> 1] = pk2(v_ev, v); }
        else { b_ev = bt_; k_ev = kt_; v_ev = v; }
    }
    st_row40(slot + S_BT + lane * RB, btp); st_row40(slot + S_KT + lane * RB, ktp); st_row40(slot + S_VT + lane * RB, vtp);
    ((float*)(slot + S_GC))[lane] = gam;
    seg_end<BAR>();
    f32x16 C;
#pragma unroll
    for (int r = 0; r < 16; ++r) C[r] = 0.f;
#pragma unroll
    for (int ks = 0; ks < 4; ++ks) {
        const bf16x8 af = *(const bf16x8*)(slot + S_AT + i * RA + (16 * ks + 8 * hi) * 2);
        const bf16x8 bf = *(const bf16x8*)(scr + i * RA + (16 * ks + 8 * hi) * 2);
        C = __builtin_amdgcn_mfma_f32_32x32x16_bf16(af, bf, C, 0, 0, 0);
    }
    asm volatile("s_waitcnt lgkmcnt(0)" ::: "memory");
    float* AAB = (float*)scr;
    unsigned char* SM = slot + S_SM;
#pragma unroll
    for (int r = 0; r < 16; ++r) {
        const int rho = crow(r, hi); const float val = C[r];
        if (r < 8) {
            if (i < 16) AAB[rho * 16 + i] = (i < rho) ? val : 0.f;
            else *(bf16*)(SM + SMM + rho * RB + (i - 16) * 2) = (bf16)f2bf((i - 16 < rho) ? val : 0.f);
        } else {
            const int tt = rho - 16;
            if (i < 16) *(bf16*)(SM + 2 * SMM + tt * RB + i * 2) = (bf16)f2bf((i <= tt) ? val : 0.f);
            else *(bf16*)(SM + 3 * SMM + tt * RB + (i - 16) * 2) = (bf16)f2bf((i - 16 <= tt) ? val : 0.f);
        }
    }
    seg_end<BAR>();
    { const int j = lane & 15; float Tr[16];
#pragma unroll
      for (int t = 0; t < 16; ++t) { if (t == 11) seg_end<BAR>();
          float acc = (t == j) ? 1.f : 0.f;
#pragma unroll
          for (int s4 = 0; s4 < (t + 3) / 4; ++s4) { const f32x4 ar = *(const f32x4*)(AAB + t * 16 + 4 * s4);
#pragma unroll
              for (int e = 0; e < 4; ++e) if (4 * s4 + e < t) acc += ar[e] * Tr[4 * s4 + e]; }
          Tr[t] = acc;
          if (lane < 16) *(bf16*)(SM + t * RB + j * 2) = (bf16)f2bf(acc); } }
    seg_end<BAR>();
}

__device__ __forceinline__ bf16x8 rd_perm(const unsigned char* p, int hi) {
    const u32x2 a = *(const u32x2*)(p + 8 * hi), b = *(const u32x2*)(p + 16 + 8 * hi);
    return __builtin_bit_cast(bf16x8, (u32x4){a.x, a.y, b.x, b.y});
}
__device__ __forceinline__ bf16x8 rd_nat(const unsigned char* p, int hi) {
    const u32x2 a = *(const u32x2*)(p + 16 * hi), b = *(const u32x2*)(p + 16 * hi + 8);
    return __builtin_bit_cast(bf16x8, (u32x4){a.x, a.y, b.x, b.y});
}
__device__ __forceinline__ bf16x8 and8(bf16x8 f, unsigned m) { u32x4 w = __builtin_bit_cast(u32x4, f); w.x &= m; w.y &= m; w.z &= m; w.w &= m; return __builtin_bit_cast(bf16x8, w); }
__device__ __forceinline__ void consume(const unsigned char* slot, f32x16 (&z)[2], float* yout, int vt, int lane) {
    const int i = lane & 31, hi = lane >> 5, i16 = i & 15;
    const unsigned m16 = i < 16 ? 0xffffffffu : 0u;
    const unsigned char* at = slot + S_AT + i16 * RA; const unsigned char* rt = slot + S_RT + i16 * RA; const unsigned char* sm16 = slot + S_SM + i16 * RB;
    bf16x8 fa0 = rd_perm(at, hi), fa1 = rd_perm(at + 32, hi), fa2 = rd_perm(at + 64, hi), fa3 = rd_perm(at + 96, hi);
    bf16x8 fak = rd_nat(sm16 + SMM, hi), ft = rd_perm(sm16, hi);
    const bf16x8 vtf = rd_nat(slot + S_VT + (32 * vt + i) * RB, hi);
    bf16x8 fr0 = rd_perm(rt, hi), fr1 = rd_perm(rt + 32, hi), fr2 = rd_perm(rt + 64, hi), fr3 = rd_perm(rt + 96, hi);
    bf16x8 frb = rd_perm(sm16 + 2 * SMM, hi), frk = rd_nat(sm16 + 3 * SMM, hi);
    const bf16x8 fk0 = rd_nat(slot + S_KT + i * RB, hi), fk1 = rd_nat(slot + S_KT + (32 + i) * RB, hi);
    const bf16x8 fb0 = rd_perm(slot + S_BT + i * RB, hi), fb1 = rd_perm(slot + S_BT + (32 + i) * RB, hi);
    f32x4 g4[2][4];
#pragma unroll
    for (int kt = 0; kt < 2; ++kt)
#pragma unroll
        for (int rg = 0; rg < 4; ++rg) g4[kt][rg] = *(const f32x4*)(slot + S_GC + (32 * kt + 8 * rg + 4 * hi) * 4);
    const bf16x8 zb0 = pack8(z[0], 0), zb1 = pack8(z[0], 8), zb2 = pack8(z[1], 0), zb3 = pack8(z[1], 8);
    fa0 = and8(fa0, m16); fa1 = and8(fa1, m16); fa2 = and8(fa2, m16); fa3 = and8(fa3, m16); fak = and8(fak, m16); ft = and8(ft, m16);
    fr0 = and8(fr0, m16); fr1 = and8(fr1, m16); fr2 = and8(fr2, m16); fr3 = and8(fr3, m16); frb = and8(frb, m16); frk = and8(frk, m16);
    f32x16 X, U, Y;
#pragma unroll
    for (int r = 0; r < 16; ++r) { X[r] = 0.f; U[r] = 0.f; Y[r] = 0.f; }
    X = __builtin_amdgcn_mfma_f32_32x32x16_bf16(fa0, zb0, X, 0, 0, 0);
    X = __builtin_amdgcn_mfma_f32_32x32x16_bf16(fa1, zb1, X, 0, 0, 0);
    X = __builtin_amdgcn_mfma_f32_32x32x16_bf16(fa2, zb2, X, 0, 0, 0);
    X = __builtin_amdgcn_mfma_f32_32x32x16_bf16(fa3, zb3, X, 0, 0, 0);
    X = __builtin_amdgcn_mfma_f32_32x32x16_bf16(fak, vtf, X, 0, 0, 0);
    Y = __builtin_amdgcn_mfma_f32_32x32x16_bf16(fr0, zb0, Y, 0, 0, 0);
    Y = __builtin_amdgcn_mfma_f32_32x32x16_bf16(fr1, zb1, Y, 0, 0, 0);
    Y = __builtin_amdgcn_mfma_f32_32x32x16_bf16(fr2, zb2, Y, 0, 0, 0);
    Y = __builtin_amdgcn_mfma_f32_32x32x16_bf16(fr3, zb3, Y, 0, 0, 0);
    Y = __builtin_amdgcn_mfma_f32_32x32x16_bf16(frk, vtf, Y, 0, 0, 0);
    z[0] = __builtin_amdgcn_mfma_f32_32x32x16_bf16(fk0, vtf, z[0], 0, 0, 0);
    z[1] = __builtin_amdgcn_mfma_f32_32x32x16_bf16(fk1, vtf, z[1], 0, 0, 0);
    const bf16x8 xb = pack8(X, 0);
    U = __builtin_amdgcn_mfma_f32_32x32x16_bf16(ft, xb, U, 0, 0, 0);
    const bf16x8 ub = pack8(U, 0);
    z[0] = __builtin_amdgcn_mfma_f32_32x32x16_bf16(fb0, ub, z[0], 0, 0, 0);
    z[1] = __builtin_amdgcn_mfma_f32_32x32x16_bf16(fb1, ub, z[1], 0, 0, 0);
    Y = __builtin_amdgcn_mfma_f32_32x32x16_bf16(frb, ub, Y, 0, 0, 0);
#pragma unroll
    for (int kt = 0; kt < 2; ++kt)
#pragma unroll
        for (int rg = 0; rg < 4; ++rg)
#pragma unroll
            for (int e = 0; e < 4; ++e) z[kt][4 * rg + e] *= g4[kt][rg][e];
#pragma unroll
    for (int r = 0; r < 8; ++r) yout[(size_t)crow(r, hi) * 512] = Y[r];
}

__device__ __forceinline__ unsigned ld_relaxed(const unsigned* p) { return __hip_atomic_load(p, __ATOMIC_RELAXED, __HIP_MEMORY_SCOPE_AGENT); }
__device__ __forceinline__ void head(const Args& a, int bh, unsigned char* sm) {
    const int tid = tidx(), lane = tid & 63, w = __builtin_amdgcn_readfirstlane(tid >> 6);
    const int b = bh >> 3, h = bh & 7;
    constexpr int NCH = T_ / 16, NBAR = NCH + NPROD;
    if (w < 2) {
        f32x16 z[2];
#pragma unroll
        for (int r = 0; r < 16; ++r) { z[0][r] = 0.f; z[1][r] = 0.f; }
        for (int i = 0; i < NPROD; ++i) wg_bar();
        for (int c = 0; c < NCH; ++c) {
            consume(sm + (size_t)(c % RING) * SLOT, z, a.yraw + ((size_t)b * T_ + (size_t)c * 16) * 512 + h * 64 + 32 * w + (lane & 31), w, lane);
            if (w == 0 && (c & 7) == 7 && lane == 0) __hip_atomic_store(a.cons + bh * 64, (unsigned)(c + 1), __ATOMIC_RELAXED, __HIP_MEMORY_SCOPE_AGENT);
            wg_bar();
        }
    } else {
        const int pw = w - 2;
        int nb = pw;
        {
            u32x4 v[15];
            { const int c = pw; const int hl = c % NHELP, n = c / NHELP;
              const unsigned char* g = a.ring + ((size_t)(bh * NHELP + hl) * RG + (n % RG)) * SLOT;
              while (__builtin_amdgcn_readfirstlane(ld_relaxed(a.flags + bh * NCH + c)) == 0u) __builtin_amdgcn_s_sleep(2);
              __builtin_amdgcn_fence(__ATOMIC_ACQUIRE, "agent");
              asm volatile("s_waitcnt vmcnt(0)" ::: "memory");
#pragma unroll
              for (int i = 0; i < 15; ++i) { const int off = (i * 64 + lane) * 16; if (off < SLOT) v[i] = *(const u32x4*)(g + off); } }
            for (int i = 0; i < pw; ++i) wg_bar();
            for (int c = pw; c < NCH; c += NPROD) {
                unsigned char* slot = sm + (size_t)(c % RING) * SLOT;
#pragma unroll
                for (int i = 0; i < 15; ++i) { const int off = (i * 64 + lane) * 16; if (off < SLOT) *(u32x4*)(slot + off) = v[i]; }
                const int cn = c + NPROD; const bool more = cn < NCH;
                const unsigned* fp = a.flags + bh * NCH + (more ? cn : c);
                unsigned fl = ld_relaxed(fp);
                wg_bar(); wg_bar();
                if (more) {
                    while (__builtin_amdgcn_readfirstlane(fl) == 0u) { __builtin_amdgcn_s_sleep(2); fl = ld_relaxed(fp); }
                    __builtin_amdgcn_fence(__ATOMIC_ACQUIRE, "agent");
                    asm volatile("s_waitcnt vmcnt(0)" ::: "memory");
                    const int hl = cn % NHELP, n = cn / NHELP;
                    const unsigned char* g = a.ring + ((size_t)(bh * NHELP + hl) * RG + (n % RG)) * SLOT;
#pragma unroll
                    for (int i = 0; i < 15; ++i) { const int off = (i * 64 + lane) * 16; if (off < SLOT) v[i] = *(const u32x4*)(g + off); }
                }
                wg_bar(); wg_bar(); wg_bar(); wg_bar();
                nb += NPROD;
            }
        }
        for (; nb < NBAR; ++nb) wg_bar();
    }
}
constexpr int NHW = 7;
__device__ __forceinline__ void helper(const Args& a, int bh, int hl, unsigned char* sm) {
    const int tid = tidx(), lane = tid & 63, w = __builtin_amdgcn_readfirstlane(tid >> 6);
    if (w >= NHW) return;
    const int b = bh >> 3, h = bh & 7, col = h * 64 + lane;
    constexpr int NCH = T_ / 16;
    unsigned char* slot = sm + (size_t)w * SLOT; unsigned char* scr = sm + NHW * SLOT + w * SCR;
    const Chan ch{a.mu[col], a.mu[512 + col], a.mu[1024 + col], a.kk[col], a.ka[col], a.rk[col]};
    int n = w, c = NHELP * n + hl;
    if (c >= NCH) return;
    for (; c < NCH; n += NHW, c += NHW * NHELP) {
        Raw q; fetch(a, b, h, c, lane, q);
        if (n >= RG) { const unsigned need = (unsigned)(c - RG * NHELP + 1);
            while (__builtin_amdgcn_readfirstlane(ld_relaxed(a.cons + bh * 64)) < need) __builtin_amdgcn_s_sleep(8); }
        produce<false>(a, ch, b, h, c, q, slot, scr, lane);
        asm volatile("s_waitcnt lgkmcnt(0)" ::: "memory");
        unsigned char* g = a.ring + ((size_t)(bh * NHELP + hl) * RG + (n % RG)) * SLOT;
#pragma unroll
        for (int i = 0; i < 15; ++i) { const int off = (i * 64 + lane) * 16;
            if (off < SLOT) { const u32x4 d = *(const u32x4*)(slot + off); unsigned char* gp = g + off; asm volatile("global_store_dwordx4 %0, %1, off sc1\n\ts_nop 1" :: "v"(gp), "v"(d) : "memory"); } }
        asm volatile("s_waitcnt vmcnt(0)" ::: "memory");
        if (lane == 0) __hip_atomic_store(a.flags + bh * NCH + c, 1u, __ATOMIC_RELAXED, __HIP_MEMORY_SCOPE_AGENT);
    }
}
__device__ __forceinline__ void finish(const float* yraw, const float* bonus, const bf16* vv, const bf16* agg, const float* mu, const float* gng, const float* gnb, bf16* amix) {
    const int T512 = tidx(), lane = T512 & 63;
    for (int row = blockIdx.x * 8 + (T512 >> 6); row < M_; row += gridDim.x * 8) {
        const int t = row % T_;
        float y[8], v0[8], v1[8], gg[8], bo[8];
#pragma unroll
        for (int j = 0; j < 8; ++j) { const int col = j * 64 + lane;
            y[j] = yraw[(size_t)row * 512 + col]; v0[j] = bf2f(vv[(size_t)row * 512 + col]); v1[j] = t ? bf2f(vv[(size_t)(row - 1) * 512 + col]) : 0.f;
            gg[j] = bf2f(agg[(size_t)row * 512 + col]); bo[j] = bonus[(size_t)row * 8 + j]; }
        float mean[8], var[8];
#pragma unroll
        for (int j = 0; j < 8; ++j) mean[j] = y[j];
#pragma unroll
        for (int o = 1; o < 64; o <<= 1) {
#pragma unroll
            for (int j = 0; j < 8; ++j) mean[j] += __shfl_xor(mean[j], o); }
#pragma unroll
        for (int j = 0; j < 8; ++j) { mean[j] *= (1.f / 64.f); y[j] -= mean[j]; var[j] = y[j] * y[j]; }
#pragma unroll
        for (int o = 1; o < 64; o <<= 1) {
#pragma unroll
            for (int j = 0; j < 8; ++j) var[j] += __shfl_xor(var[j], o); }
#pragma unroll
        for (int j = 0; j < 8; ++j) { const int col = j * 64 + lane;
            const float yn = y[j] * rsqrtf(var[j] * (1.f / 64.f) + 64e-5f) * gng[col] + gnb[col];
            const float v = v0[j] + (v1[j] - v0[j]) * mu[1024 + col];
            amix[(size_t)row * DM + 512 + col] = (bf16)f2bf((yn + bo[j] * v) * gg[j]); }
    }
}
}

namespace mema {
using nsa::f32x16; using nsa::KROW; using nsa::VROW; using nsa::KBUF; using nsa::VBUF; using nsa::OFF_K; using nsa::OFF_V; using nsa::OFF_WS; using nsa::crow; using nsa::pack8;
__device__ __forceinline__ void unit(const bf16* qm, const bf16* mk, const bf16* mvt, bf16* om, int u, unsigned char* sm) {
    const int tid = tidx(), lane = tid & 63, w = __builtin_amdgcn_readfirstlane(tid >> 6), i = lane & 31, hi = lane >> 5;
    const int b = u >> 7, h = (u >> 5) & 3, rb = u & 31;
    const int row0 = b * T_ + rb * 256 + 32 * w;
    const bf16* qrow = qm + (size_t)(row0 + i) * DM + h * 256 + 8 * hi;
    const bf16* kbase = mk + (size_t)(b * 256 + (tid >> 3)) * DM + h * 256 + (tid & 7) * 8;
    const bf16* vbase = mvt + (size_t)(h * 256 + (tid >> 3)) * 512 + b * 256 + (tid & 7) * 8;
    unsigned char* kst = sm + OFF_K + (tid >> 3) * KROW + (tid & 7) * 16;
    unsigned char* vst = sm + OFF_V + (tid >> 3) * VROW + (tid & 7) * 16;
    float* wsc = (float*)(sm + OFF_WS) + w * 32;
    f32x16 p[4][2];
#pragma unroll
    for (int kt = 0; kt < 4; ++kt)
#pragma unroll
        for (int r = 0; r < 16; ++r) { p[kt][0][r] = 0.f; p[kt][1][r] = 0.f; }
    u32x4 tr[4];
#define MEMA_SRC(n) ((n) < 16 ? (const u32x4*)(kbase + (size_t)(64 * ((n) & 3)) * DM + 64 * ((n) >> 2)) : (const u32x4*)(vbase + (size_t)(64 * (((n) - 16) >> 2)) * 512 + 64 * ((n) & 3)))
#define MEMA_PUT(n) do { if ((n) < 16) *(u32x4*)(kst + ((n) & 1) * KBUF) = tr[(n) & 3]; else { unsigned char* vp2_ = vst + ((n) & 1) * VBUF; *(u32x2*)vp2_ = (u32x2){tr[(n) & 3].x, tr[(n) & 3].y}; *(u32x2*)(vp2_ + 8) = (u32x2){tr[(n) & 3].z, tr[(n) & 3].w}; } } while (0)
    tr[0] = *MEMA_SRC(0); tr[1] = *MEMA_SRC(1); tr[2] = *MEMA_SRC(2);
    MEMA_PUT(0);
    __syncthreads();
    bf16x8 qf[4];
#pragma unroll
    for (int n = 0; n < 16; ++n) {
        const int dc = n >> 2, kt = n & 3, cb = n & 1;
        tr[(n + 3) & 3] = *MEMA_SRC(n + 3);
        if (kt == 0) {
#pragma unroll
            for (int d0 = 0; d0 < 4; ++d0) qf[d0] = *(const bf16x8*)(qrow + 64 * dc + 16 * d0);
        }
        const unsigned char* kb = sm + OFF_K + cb * KBUF;
#pragma unroll
        for (int d0 = 0; d0 < 4; ++d0) {
            const bf16x8 a0 = *(const bf16x8*)(kb + i * KROW + (16 * d0 + 8 * hi) * 2);
            const bf16x8 a1 = *(const bf16x8*)(kb + (32 + i) * KROW + (16 * d0 + 8 * hi) * 2);
            p[kt][0] = __builtin_amdgcn_mfma_f32_32x32x16_bf16(a0, qf[d0], p[kt][0], 0, 0, 0);
            p[kt][1] = __builtin_amdgcn_mfma_f32_32x32x16_bf16(a1, qf[d0], p[kt][1], 0, 0, 0);
        }
        MEMA_PUT(n + 1);
        __syncthreads();
    }
    float mx = p[0][0][0];
#pragma unroll
    for (int kt = 0; kt < 4; ++kt)
#pragma unroll
        for (int r = 0; r < 16; ++r) mx = fmaxf(mx, fmaxf(p[kt][0][r], p[kt][1][r]));
    mx = fmaxf(mx, __shfl_xor(mx, 32));
    float l = 0.f;
#pragma unroll
    for (int kt = 0; kt < 4; ++kt)
#pragma unroll
        for (int r = 0; r < 16; ++r) { p[kt][0][r] = __builtin_amdgcn_exp2f(p[kt][0][r] - mx); p[kt][1][r] = __builtin_amdgcn_exp2f(p[kt][1][r] - mx); l += p[kt][0][r] + p[kt][1][r]; }
    l += __shfl_xor(l, 32);
    bf16x8 pf[4][4];
#pragma unroll
    for (int kt = 0; kt < 4; ++kt) { pf[kt][0] = pack8(p[kt][0], 0); pf[kt][1] = pack8(p[kt][0], 8); pf[kt][2] = pack8(p[kt][1], 0); pf[kt][3] = pack8(p[kt][1], 8); }
    if (hi == 0) wsc[i] = 1.f / l;
    asm volatile("" ::: "memory");
    f32x4 il[4];
#pragma unroll
    for (int rg = 0; rg < 4; ++rg) il[rg] = *(const f32x4*)(wsc + 8 * rg + 4 * hi);
    f32x16 o[2];
#pragma unroll
    for (int n = 16; n < 32; ++n) {
        const int dvt = (n - 16) >> 2, kt = n & 3, cb = n & 1;
        if (n + 3 < 32) tr[(n + 3) & 3] = *MEMA_SRC(n + 3);
        if (kt == 0) {
#pragma unroll
            for (int r = 0; r < 16; ++r) { o[0][r] = 0.f; o[1][r] = 0.f; }
        }
        const unsigned char* vb = sm + OFF_V + cb * VBUF;
#pragma unroll
        for (int dt = 0; dt < 2; ++dt) {
            const unsigned char* vp = vb + (32 * dt + i) * VROW + 8 * hi;
#pragma unroll
            for (int ks = 0; ks < 4; ++ks) {
                const u32x2 v_lo = *(const u32x2*)(vp + 32 * ks), v_hi = *(const u32x2*)(vp + 32 * ks + 16);
                const bf16x8 vf = __builtin_bit_cast(bf16x8, (u32x4){v_lo.x, v_lo.y, v_hi.x, v_hi.y});
                o[dt] = __builtin_amdgcn_mfma_f32_32x32x16_bf16(pf[kt][ks], vf, o[dt], 0, 0, 0);
            }
        }
        if (kt == 3) {
#pragma unroll
            for (int r = 0; r < 16; ++r) { bf16* op = om + (size_t)(row0 + crow(r, hi)) * DM + h * 256 + 64 * dvt + i;
                op[0] = (bf16)f2bf(o[0][r] * il[r >> 2][r & 3]); op[32] = (bf16)f2bf(o[1][r] * il[r >> 2][r & 3]); }
        }
        if (n + 1 < 32) MEMA_PUT(n + 1);
        __syncthreads();
    }
#undef MEMA_SRC
#undef MEMA_PUT
}
}

#define LAS __attribute__((address_space(3)))
#define XB_TMO      128
#define XB_XCNT(j)  (256  + 64 * (j))
#define XB_XSUB(j)  (1280 + 64 * (j))
#define XB_XGEN(j)  (2304 + 64 * (j))
#define XB_TOP      3328
#define XB_TOPGEN   3392
#define XCD_BAR_WORDS 3456
#define XB_SPIN_CAP (1u << 18)

__device__ __forceinline__ unsigned xb_ld(unsigned* p)              { return __hip_atomic_load(p, __ATOMIC_RELAXED, __HIP_MEMORY_SCOPE_AGENT); }
__device__ __forceinline__ unsigned xb_add(unsigned* p, unsigned v) { return __hip_atomic_fetch_add(p, v, __ATOMIC_RELAXED, __HIP_MEMORY_SCOPE_AGENT); }
__device__ __forceinline__ unsigned xb_xcc_id() { return (unsigned)__builtin_amdgcn_s_getreg((3 << 11) | 20) & 0xFu; }
#define XB_SPIN(cond, bar) do { unsigned _sp = 0; while (cond) { __builtin_amdgcn_s_sleep(1); \
    if ((++_sp & 255u) == 0u) { if (xb_ld(&(bar)[XB_TMO])) break; if (_sp > XB_SPIN_CAP) { atomicAdd(&(bar)[XB_TMO], 1u); break; } } } } while (0)

struct XcdBarrier {
    unsigned* bar; unsigned x;
    volatile LAS unsigned* st;
};

__device__ __forceinline__ XcdBarrier xcd_barrier_post(unsigned* bar, volatile LAS unsigned* st) {
    XcdBarrier b; b.bar = bar; b.x = xb_xcc_id(); b.st = st;
    if (tidx() == 0) (void)xb_add(&bar[XB_XCNT(b.x)], 1u);
    return b;
}
__device__ __forceinline__ void xcd_barrier_complete(unsigned* bar, unsigned x, unsigned& nloc, unsigned& nx) {
    const unsigned G = gridDim.x * gridDim.y * gridDim.z;
    unsigned sum, cnt, mine, sp = 0u;
    for (;;) {
        sum = 0u; cnt = 0u; mine = 0u;
#pragma unroll
        for (unsigned j = 0; j < 16; ++j) { const unsigned c = xb_ld(&bar[XB_XCNT(j)]); sum += c; cnt += (c > 0u) ? 1u : 0u; mine = (j == x) ? c : mine; }
        if (sum == G) break;
        __builtin_amdgcn_s_sleep(1);
        if ((++sp & 255u) == 0u) { if (xb_ld(&bar[XB_TMO])) break; if (sp > XB_SPIN_CAP) { atomicAdd(&bar[XB_TMO], 1u); break; } }
    }
    nloc = mine > 0u ? mine : 1u; nx = cnt > 0u ? cnt : 1u;
}

__device__ __forceinline__ void xcd_barrier(const XcdBarrier& b) {
    asm volatile("s_waitcnt vmcnt(0)" ::: "memory");
    __syncthreads();
    if (tidx() == 0) {
        unsigned* bar = b.bar;
        __builtin_amdgcn_s_waitcnt(0);
        unsigned nloc = b.st[0], nx = b.st[1];
        if (nloc == 0u) { xcd_barrier_complete(bar, b.x, nloc, nx); b.st[0] = nloc; b.st[1] = nx; }
        const unsigned old = xb_add(&bar[XB_XSUB(b.x)], 1u);
        const unsigned gen = old / nloc;
        if (old + 1u == (gen + 1u) * nloc) {
            __builtin_amdgcn_fence(__ATOMIC_RELEASE, "agent");
            asm volatile("s_waitcnt vmcnt(0)" ::: "memory");
            const unsigned og = xb_add(&bar[XB_TOP], 1u);
            const unsigned tg = og / nx;
            if (og + 1u == (tg + 1u) * nx) xb_add(&bar[XB_TOPGEN], 1u);
            else XB_SPIN(xb_ld(&bar[XB_TOPGEN]) == tg, bar);
            __builtin_amdgcn_fence(__ATOMIC_ACQUIRE, "agent");
            xb_add(&bar[XB_XGEN(b.x)], 1u);
            asm volatile("s_waitcnt vmcnt(0)" ::: "memory");
        } else {
            XB_SPIN(xb_ld(&bar[XB_XGEN(b.x)]) == gen, bar);
            __builtin_amdgcn_fence(__ATOMIC_ACQUIRE, "agent");
            asm volatile("s_waitcnt vmcnt(0)" ::: "memory");
        }
    }
    __syncthreads();
}

constexpr int NTHREADS = 512, LDS_BYTES = 147456;
struct MegaArgs { const float* in[41]; float* out; unsigned char* ws; };
#define WSB(off) ((bf16*)(ws + (off)))
#define WSF(off) ((float*)(ws + (off)))

__global__ void __launch_bounds__(NTHREADS) mega_fwd(MegaArgs A) {
    extern __shared__ __attribute__((aligned(16))) unsigned char lds[];
    cg::grid_group grid = cg::this_grid();
    const float* const* in = A.in; unsigned char* ws = A.ws; float* out = A.out;
    if (tidx() < 2) ((volatile LAS unsigned*)(lds + LDS_BYTES - 64))[tidx()] = 0u;
    __syncthreads();
    const XcdBarrier xbar = xcd_barrier_post((unsigned*)(ws + WS_CTL) + 16384, (volatile LAS unsigned*)(lds + LDS_BYTES - 64));

    d_convert(WSB(WS_W1GU), NGU, DM, MapGU{in[I_F1_WG], in[I_F1_WU], FF});
    d_convert(WSB(WS_WIN), NWIN, DM, MapWin{in[I_WIN], IN_COLS});
    d_convert(WSB(WS_CW1K), 256, 2048, MapPlain{in[I_W1_K], 256});
    d_convert(WSB(WS_CW1V), 256, 2048, MapPlain{in[I_W1_V], 256});
    d_convert_lora(WSB(WS_WLORA), in[I_W2], in[I_A2], in[I_G2]);
    d_convert(WSB(WS_WK), DM, DM, MapPlain{in[I_WK], DM});
    d_convert(WSB(WS_WV), DM, DM, MapPlain{in[I_WV], DM});
    d_convert(WSB(WS_CW2), 64, 256, MapPlain{in[I_W2_K], 64});
    d_convert(WSB(WS_CW2) + 64 * 256, 64, 256, MapPlain{in[I_W2_V], 64});
    d_rope_table(WSF(WS_ROPE));
    d_cmp_bias(in[I_PE_K], in[I_W1_K], in[I_PE_V], in[I_W1_V], WSF(WS_CBIAS), (float*)lds);
    d_rownorm(in[I_X], in[I_F1_PRE], WSB(WS_XN), M_);
    d_rownorm(in[I_MEM], in[I_MEM_KVG], WSB(WS_MEMN), 512);
    grid.sync();
    gemm_pg8(lds, WSB(WS_XN), DM, WSB(WS_W1GU), DM, M_, NGU, DM, EpiSwiGLU{WSB(WS_HB)});
    d_convert(WSB(WS_W1D), DM, FF, MapPlain{in[I_F1_WD], DM}, 128);
    xcd_barrier(xbar);
    gemm_norm_res<false, true>(lds, WSB(WS_HB), FF, WSB(WS_W1D), FF, in[I_X], out, WSB(WS_XN), in[I_F1_POST], in[I_MIX_PRE], 0.5f, (unsigned*)(ws + WS_GATES), (unsigned*)(ws + WS_CTL) + 1024 + 0 * 2048);
    xcd_barrier(xbar);
    gemm_pg8(lds, WSB(WS_XN), DM, WSB(WS_WIN), DM, M_, 3072, DM,
             EpiWin{WSB(WS_QB), WSB(WS_KS), WSB(WS_KW), WSB(WS_KCR), WSB(WS_VCR), WSB(WS_VST), WSB(WS_VWT), (unsigned*)(ws + WS_RKVA), WSB(WS_RKVA + 32 * MiB), WSB(WS_PRL), WSF(WS_GATES), WSF(WS_ROPE)});
    d_gates(WSB(WS_XN), WSB(WS_WIN) + (size_t)3072 * DM, WSF(WS_GATES), (float*)lds);
    if (blockIdx.x == 0) { const int t_ = tidx(); float b_ = 0.f; for (int jc = 0; jc < 8; ++jc) b_ += WSF(WS_CBIAS)[jc * 512 + t_]; WSF(WS_CBIAS)[4096 + t_] = b_; }
    xcd_barrier(xbar);
    { float* part = (float*)(ws + WS_XN + 8 * MiB);
      gemm_pg8(lds, WSB(WS_KCR), 1024, WSB(WS_CW1K), 2048, 2048, 256, 1024, EpiStoreF32{part, 256}, 0);
      gemm_pg8(lds, WSB(WS_KCR) + 1024, 1024, WSB(WS_CW1K) + 1024, 2048, 2048, 256, 1024, EpiStoreF32{part + (size_t)2048 * 256, 256}, 8);
      gemm_pg8(lds, WSB(WS_VCR), 1024, WSB(WS_CW1V), 2048, 2048, 256, 1024, EpiStoreF32{part + (size_t)2 * 2048 * 256, 256}, 48);
      gemm_pg8(lds, WSB(WS_VCR) + 1024, 1024, WSB(WS_CW1V) + 1024, 2048, 2048, 256, 1024, EpiStoreF32{part + (size_t)3 * 2048 * 256, 256}, 24); }
    gemm_pg8(lds, WSB(WS_MEMN), DM, WSB(WS_WK), DM, 512, DM, DM, EpiStore{WSB(WS_HIDK), DM, 1.f}, 32);
    gemm_pg8(lds, WSB(WS_WV), DM, WSB(WS_MEMN), DM, DM, 512, DM, EpiStore{WSB(WS_HIDV), 512, 1.f}, 40);
    d_lora_prep(WSB(WS_PRL), in[I_MU], WSB(WS_XN), 48);
    d_convert(WSB(WS_W2GU), NGU, DM, MapGU{in[I_F2_WG], in[I_F2_WU], FF}, 48);
    d_convert(WSB(WS_W2D), DM, FF, MapPlain{in[I_F2_WD], DM}, 48);
    d_convert(WSB(WS_WOUT), DM, DM, MapPlain{in[I_WOUT], DM}, 48);
    d_convert(WSB(WS_WQ), DM, DM, MapPlain{in[I_WQ], DM}, 48);
    d_convert(WSB(WS_WO), DM, DM, MapPlain{in[I_WO], DM}, 48);
    xcd_barrier(xbar);
    d_cmp2((const float*)(ws + WS_XN + 8 * MiB), WSF(WS_CBIAS) + 4096, WSB(WS_CW2), WSF(WS_ROPE), WSB(WS_KC), WSB(WS_VCT));
    gemm_pg8(lds, WSB(WS_XN), KLORA, WSB(WS_WLORA), KLORA, M_, NLORA, KLORA, EpiLora{WSF(WS_YB), WSB(WS_RKVA + 48 * MiB), WSB(WS_AGG), in[I_W0], in[I_A0]});
    xcd_barrier(xbar);
    if (blockIdx.x < 16 * (1 + rw7::NHELP)) {
        const rw7::Args ra{(const unsigned*)(ws + WS_RKVA), WSB(WS_RKVA + 32 * MiB), WSB(WS_RKVA + 48 * MiB), WSF(WS_YB), in[I_MU], in[I_KK], in[I_KA], in[I_RK], WSF(WS_YB), WSF(WS_BONUS),
                           ws + WS_KCR + 1 * MiB, (unsigned*)(ws + WS_CTL) + 32768, (unsigned*)(ws + WS_CTL) + 24576};
        if (blockIdx.x < 16) rw7::head(ra, blockIdx.x, lds);
        else rw7::helper(ra, (blockIdx.x - 16) % 16, (blockIdx.x - 16) / 16, lds);
        __syncthreads();
    }
    {
        const NsaArgs na{WSB(WS_QB), WSB(WS_KC), WSB(WS_VCT), WSB(WS_KS), WSB(WS_VST), WSB(WS_KW), WSB(WS_VWT), WSF(WS_GATES), WSB(WS_XN)};
        nsa::phase(na, (unsigned*)(ws + WS_CTL), lds);
    }
    xcd_barrier(xbar);
    d_nsa_outnorm(WSB(WS_XN), in[I_NSA_G]);
    rw7::finish(WSF(WS_YB), WSF(WS_BONUS), WSB(WS_RKVA + 32 * MiB), WSB(WS_AGG), in[I_MU], in[I_GNG], in[I_GNB], WSB(WS_XN));
    xcd_barrier(xbar);
    gemm_norm_res<true, true>(lds, WSB(WS_XN), DM, WSB(WS_WOUT), DM, out, WSB(WS_YB), WSB(WS_XN), in[I_MIX_POST], in[I_MEM_PRE], 1.0f, (unsigned*)(ws + WS_GATES), (unsigned*)(ws + WS_CTL) + 1024 + 1 * 2048);
    xcd_barrier(xbar);
    gemm_pg8(lds, WSB(WS_XN), DM, WSB(WS_WQ), DM, M_, DM, DM, EpiStore{WSB(WS_QM), DM, MSCALE});
    xcd_barrier(xbar);
    if (blockIdx.x < 256) mema::unit(WSB(WS_QM), WSB(WS_HIDK), WSB(WS_HIDV), WSB(WS_OM), (int)blockIdx.x, lds);
    xcd_barrier(xbar);
    gemm_norm_res<true, true>(lds, WSB(WS_OM), DM, WSB(WS_WO), DM, WSB(WS_YB), WSB(WS_YB), WSB(WS_XN), in[I_MEM_POST], in[I_F2_PRE], 1.0f, (unsigned*)(ws + WS_GATES), (unsigned*)(ws + WS_CTL) + 1024 + 2 * 2048);
    xcd_barrier(xbar);
    gemm_pg8(lds, WSB(WS_XN), DM, WSB(WS_W2GU), DM, M_, NGU, DM, EpiSwiGLU{WSB(WS_HB)});
    xcd_barrier(xbar);
    gemm_norm_res<true, false>(lds, WSB(WS_HB), FF, WSB(WS_W2D), FF, WSB(WS_YB), out, (bf16*)nullptr, in[I_F2_POST], (const float*)nullptr, 0.5f, (unsigned*)(ws + WS_GATES), (unsigned*)(ws + WS_CTL) + 1024 + 3 * 2048);
}

extern "C" void kernel_launch(void* const* d_in, const int* in_sizes, int n_in, void* d_out, int out_size, void* d_ws, size_t ws_size, hipStream_t stream) {
    static int grid = 0;
    if (grid == 0) {
        if (n_in != 41 || ws_size < WS_END) { fprintf(stderr, "kernel_launch: unexpected n_in %d / ws %zu\n", n_in, ws_size); grid = -1; return; }
        int dev = 0, cus = 0, per_cu = 0;
        hipGetDevice(&dev); hipDeviceGetAttribute(&cus, hipDeviceAttributeMultiprocessorCount, dev);
        if (hipFuncSetAttribute((const void*)mega_fwd, hipFuncAttributeMaxDynamicSharedMemorySize, LDS_BYTES) != hipSuccess) { fprintf(stderr, "kernel_launch: hipFuncSetAttribute failed\n"); grid = -1; return; }
        if (hipOccupancyMaxActiveBlocksPerMultiprocessor(&per_cu, (const void*)mega_fwd, NTHREADS, LDS_BYTES) != hipSuccess || per_cu < 1) { fprintf(stderr, "kernel_launch: occupancy query says %d\n", per_cu); grid = -1; (void)hipGetLastError(); return; }
        grid = cus;
        if (grid != 256) { fprintf(stderr, "kernel_launch: built for 256 CUs (one 256x256 tile per workgroup in the fused norm epilogues), found %d\n", cus); grid = -1; return; }
    }
    if (grid < 0) return;
    MegaArgs a{};
    for (int i = 0; i < 41; ++i) a.in[i] = (const float*)d_in[i];
    a.out = (float*)d_out; a.ws = (unsigned char*)d_ws;
    hipMemsetAsync(d_ws, 0, 196608, stream);
    void* args[] = {&a};
    hipError_t e = hipLaunchCooperativeKernel((const void*)mega_fwd, dim3(grid), dim3(NTHREADS), args, LDS_BYTES, stream);
    if (e != hipSuccess) fprintf(stderr, "kernel_launch: cooperative launch failed: %s (grid %d)\n", hipGetErrorString(e), grid);
}
```

```cpp
#include <hip/hip_runtime.h>
#include <hip/hip_cooperative_groups.h>
#include <cstdint>
#include <cstdio>

constexpr int NB = 2, T_ = 8192, DM = 1024, M_ = NB * T_;
constexpr int FF = 2816, NGU = 2 * FF;
constexpr int IN_COLS = 3096, NWIN = 3328;
constexpr int NRW = 1792;
constexpr int NCP = 512;
constexpr int NLORA = 1536, KLORA = 256;
constexpr float NORM_EPS = 1e-6f;
constexpr float QSCALE = 0.125f * 1.4426950408889634f;
constexpr float MSCALE = 0.0625f * 1.4426950408889634f;

typedef unsigned short bf16;
typedef short bf16x8 __attribute__((ext_vector_type(8)));
typedef float f32x4 __attribute__((ext_vector_type(4)));
typedef unsigned u32x2 __attribute__((ext_vector_type(2)));
typedef unsigned u32x4 __attribute__((ext_vector_type(4)));

__device__ __forceinline__ unsigned f2bf(float f) { unsigned u = __builtin_bit_cast(unsigned, f); return (u + 0x7fffu + ((u >> 16) & 1u)) >> 16; }
__device__ __forceinline__ float bf2f(bf16 h) { return __builtin_bit_cast(float, (unsigned)h << 16); }
typedef float f32x2_t __attribute__((ext_vector_type(2))); typedef __bf16 bf16x2_t __attribute__((ext_vector_type(2)));
__device__ __forceinline__ unsigned pk2(float lo, float hi) { const f32x2_t v = {lo, hi}; return __builtin_bit_cast(unsigned, __builtin_convertvector(v, bf16x2_t)); }
__device__ __forceinline__ void st_bf4(bf16* p, f32x4 v) { u32x2 w; w.x = pk2(v[0], v[1]); w.y = pk2(v[2], v[3]); *(u32x2*)p = w; }
__device__ __forceinline__ float wave_sum(float v) {
#pragma unroll
    for (int o = 1; o < 64; o <<= 1) v += __shfl_xor(v, o);
    return v;
}
__device__ __forceinline__ float wave_max(float v) {
#pragma unroll
    for (int o = 1; o < 64; o <<= 1) v = fmaxf(v, __shfl_xor(v, o));
    return v;
}
__device__ __forceinline__ float sigmoidf_(float x) { return 1.f / (1.f + __expf(-x)); }
__device__ __forceinline__ int tidx() { int t = threadIdx.x; asm volatile("" : "+v"(t)); return t; }

constexpr size_t MiB = 1u << 20, KiB64 = 65536;
constexpr size_t WS_CTL = 0;
constexpr size_t WS_KC = 256 * 1024;
constexpr size_t WS_VCT = 512 * 1024;
constexpr size_t WS_CW2 = 768 * 1024;
constexpr size_t WS_W1GU = 1 * MiB;
constexpr size_t WS_W1D = 12 * MiB;
constexpr size_t WS_W2GU = WS_W1D + 88 * KiB64;
constexpr size_t WS_W2D = WS_W2GU + 11 * MiB;
constexpr size_t WS_WIN = WS_W2D + 88 * KiB64;
constexpr size_t WS_WOUT = WS_WIN + 104 * KiB64;
constexpr size_t WS_WQ = WS_WOUT + 2 * MiB, WS_WK = WS_WQ + 2 * MiB, WS_WV = WS_WK + 2 * MiB, WS_WO = WS_WV + 2 * MiB;
constexpr size_t WS_CW1K = WS_WO + 2 * MiB, WS_CW1V = WS_CW1K + 1 * MiB;
constexpr size_t WS_WLORA = WS_CW1V + 1 * MiB;
constexpr size_t WS_ROPE = WS_WLORA + 12 * KiB64;
constexpr size_t WS_CBIAS = WS_ROPE + 2 * MiB;
constexpr size_t WS_MEMN = WS_CBIAS + KiB64;
constexpr size_t WS_HIDK = WS_MEMN + 1 * MiB;
constexpr size_t WS_HIDV = WS_HIDK + 1 * MiB;
constexpr size_t WS_GATES = WS_HIDV + 1 * MiB;
constexpr size_t WS_XN = 60 * MiB;
constexpr size_t WS_YB = 92 * MiB;
constexpr size_t WS_D = 124 * MiB;
constexpr size_t WS_HB = WS_D;
constexpr size_t WS_QB = WS_D;
constexpr size_t WS_KS = WS_D + 16 * MiB;
constexpr size_t WS_KW = WS_D + 20 * MiB;
constexpr size_t WS_KCR = WS_D + 24 * MiB;
constexpr size_t WS_VCR = WS_D + 29 * MiB;
constexpr size_t WS_VST = WS_D + 34 * MiB;
constexpr size_t WS_VWT = WS_D + 38 * MiB;
constexpr size_t WS_RKVA = WS_D + 42 * MiB;
constexpr size_t WS_PRL = WS_D + 106 * MiB;
constexpr size_t WS_AGG = WS_D + 114 * MiB;
constexpr size_t WS_BONUS = WS_KCR;
constexpr size_t WS_END = 256 * MiB;
constexpr size_t WS_QM = WS_D;
constexpr size_t WS_OM = WS_D + 32 * MiB;
constexpr size_t WS_MK = WS_D + 64 * MiB;
constexpr size_t WS_MVT = WS_D + 65 * MiB;
static_assert(WS_GATES + (size_t)M_ * 24 * 4 <= WS_XN, "ws map");
static_assert(WS_AGG + 16 * MiB <= WS_END, "ws map");

struct Params {
    const float* in[41];
    float* out;
    unsigned char* ws;
};
enum { I_X = 0, I_MEM, I_F1_PRE, I_F1_WG, I_F1_WU, I_F1_WD, I_F1_POST, I_MIX_PRE, I_WIN, I_PE_K, I_W1_K, I_W2_K, I_PE_V, I_W1_V, I_W2_V,
       I_NSA_G, I_MU, I_W0, I_W2, I_A0, I_A2, I_G2, I_KK, I_KA, I_RK, I_GNG, I_GNB, I_WOUT, I_MIX_POST, I_MEM_PRE, I_MEM_KVG, I_WQ, I_WK, I_WV,
       I_WO, I_MEM_POST, I_F2_PRE, I_F2_WG, I_F2_WU, I_F2_WD, I_F2_POST };

struct MapPlain { const float* W; int N; int pad; __device__ const float* col(int p) const { return W + p; } };
struct MapGU {
    const float* Wg; const float* Wu; int N; int pad;
    __device__ const float* col(int p) const {
        const int pn = p >> 8, q = p & 255, n = (q >> 4) & 1;
        const int hid = 128 * pn + 64 * (q >> 7) + 16 * ((q >> 5) & 3) + (q & 15);
        return Wg + (size_t)n * (size_t)(Wu - Wg) + hid;
    }
};
__host__ __device__ inline int rope_perm(int x) { return 16 * ((x >> 5) & 1) + (x & 15) + 32 * ((x >> 4) & 1); }
struct MapWin {
    const float* W; int N; int pad;
    __device__ const float* col(int p) const {
        int l;
        if (p < 512) l = (p & ~63) + rope_perm(p & 63);
        else if (p < 640) l = 768 + ((p - 512) & ~63) + rope_perm(p & 63);
        else if (p < 768) l = 1024 + ((p - 640) & ~63) + rope_perm(p & 63);
        else if (p < 896) l = 512 + (p - 768);
        else if (p < 1024) l = 640 + (p - 896);
        else if (p < 1152) l = 896 + (p - 1024);
        else if (p < 1280) l = 1152 + (p - 1152);
        else if (p < 2304) { const int q = p - 1280; l = 1304 + (((q >> 4) & 1) ? 512 : 0) + 16 * (q >> 5) + (q & 15); }
        else if (p < 3072) l = 1304 + (p - 1280);
        else if (p < 3096) l = 1280 + (p - 3072);
        else return nullptr;
        return W + l;
    }
};

#define FOR_VB(vb, n) for (int vb = (int)blockIdx.x * 2 + (T512 >> 8); vb < (n); vb += (int)gridDim.x * 2)

template <class Map> __device__ __forceinline__ void d_convert(bf16* WT, int Np, int K, Map map, int wg0 = 0) {
    if ((int)blockIdx.x < wg0) return;
    const int T512 = tidx(), tid = T512 & 255, nbx = Np / 64, nb = nbx * (K / 64), G = (int)gridDim.x - wg0;
    for (int vb0 = ((int)blockIdx.x - wg0) * 2 + (T512 >> 8); vb0 < nb; vb0 += G * 4) {
        const int vb1 = vb0 + G * 2; const bool two = vb1 < nb;
        const int p0 = (vb0 % nbx) * 64 + (tid & 63), k0 = (vb0 / nbx) * 64 + (tid >> 6) * 16;
        const int p1 = two ? (vb1 % nbx) * 64 + (tid & 63) : p0, k1 = two ? (vb1 / nbx) * 64 + (tid >> 6) * 16 : k0;
        const float* s0 = map.col(p0); const float* s1 = map.col(p1);
        float v[16], u[16];
#pragma unroll
        for (int i = 0; i < 16; ++i) { v[i] = s0 ? s0[(size_t)(k0 + i) * map.N] : 0.f; u[i] = s1 ? s1[(size_t)(k1 + i) * map.N] : 0.f; }
        u32x4 a, b;
        a.x = pk2(v[0], v[1]); a.y = pk2(v[2], v[3]); a.z = pk2(v[4], v[5]); a.w = pk2(v[6], v[7]);
        b.x = pk2(v[8], v[9]); b.y = pk2(v[10], v[11]); b.z = pk2(v[12], v[13]); b.w = pk2(v[14], v[15]);
        u32x4* d0 = (u32x4*)(WT + (size_t)p0 * K + k0); d0[0] = a; d0[1] = b;
        if (two) {
            a.x = pk2(u[0], u[1]); a.y = pk2(u[2], u[3]); a.z = pk2(u[4], u[5]); a.w = pk2(u[6], u[7]);
            b.x = pk2(u[8], u[9]); b.y = pk2(u[10], u[11]); b.z = pk2(u[12], u[13]); b.w = pk2(u[14], u[15]);
            u32x4* d1 = (u32x4*)(WT + (size_t)p1 * K + k1); d1[0] = a; d1[1] = b;
        }
    }
}
__device__ __forceinline__ void d_convert_lora(bf16* WT, const float* w2, const float* a2, const float* g2) {
    const int T512 = tidx(), tid = T512 & 255;
    FOR_VB(vb, NLORA * KLORA / 256) {
        const int idx = vb * 256 + tid, p = idx >> 8, k = idx & 255;
        float v = 0.f;
        if (p < 512) { if (k < 64) v = w2[k * 512 + p]; }
        else if (p < 1024) { if (k >= 64 && k < 128) v = a2[(k - 64) * 512 + (p - 512)]; }
        else { if (k >= 128) v = g2[(k - 128) * 512 + (p - 1024)]; }
        WT[idx] = (bf16)f2bf(v);
    }
}
__device__ __forceinline__ void d_rope_table(float* tab) {
    const int T512 = tidx(), tid = T512 & 255;
    FOR_VB(vb, T_ * 32 / 256) {
        const int idx = vb * 256 + tid, pos = idx >> 5, i = idx & 31;
        const float inv = (float)pow(10000.0, -(double)i / 32.0);
        const float ang = (float)pos * inv;
        tab[2 * idx] = (float)cos((double)ang); tab[2 * idx + 1] = (float)sin((double)ang);
    }
}
__device__ __forceinline__ void d_cmp_bias(const float* pe_k, const float* w1_k, const float* pe_v, const float* w1_v, float* part, float* red  ) {
    for (int job = blockIdx.x; job < 64; job += gridDim.x) {
        const int kv = job >> 5, cg_ = (job >> 3) & 3, jc = job & 7; const float* pe = kv ? pe_v : pe_k; const float* w1 = kv ? w1_v : w1_k;
        const int T512 = tidx(), lane = T512 & 63, w = T512 >> 6, n = cg_ * 64 + lane;
        float s = 0.f;
#pragma unroll 8
        for (int j = jc * 256 + w * 32; j < jc * 256 + w * 32 + 32; ++j) s += pe[j] * w1[(size_t)j * 256 + n];
        red[w * 64 + lane] = s; __syncthreads();
        if (w == 0) { float t = 0.f; for (int i = 0; i < 8; ++i) t += red[i * 64 + lane]; part[(jc * 2 + kv) * 256 + n] = t; }
        __syncthreads();
    }
}
__device__ __forceinline__ void d_rownorm(const float* x, const float* g, bf16* xn, int rows) {
    const int T512 = tidx(), tid = T512 & 255, lane = tid & 63;
    FOR_VB(vb, rows / 4) {
        const int row = vb * 4 + (tid >> 6);
        const f32x4* xr = (const f32x4*)(x + (size_t)row * DM) + lane; f32x4 v[4]; float s = 0.f;
#pragma unroll
        for (int j = 0; j < 4; ++j) { v[j] = xr[64 * j]; s += v[j][0] * v[j][0] + v[j][1] * v[j][1] + v[j][2] * v[j][2] + v[j][3] * v[j][3]; }
        const float rstd = rsqrtf(wave_sum(s) * (1.f / DM) + NORM_EPS);
#pragma unroll
        for (int j = 0; j < 4; ++j) { const f32x4 gg = ((const f32x4*)g)[lane + 64 * j]; st_bf4(xn + (size_t)row * DM + 4 * (lane + 64 * j), v[j] * rstd * gg); }
    }
}
__device__ __forceinline__ void d_rowpass(const float* xin, const bf16* y, const float* gpost, float coef, const float* gpre, float* xout, bf16* xn) {
    const int T512 = tidx(), tid = T512 & 255, lane = tid & 63;
    FOR_VB(vb, M_ / 4) {
        const int row = vb * 4 + (tid >> 6);
        f32x4 yv[4], xv[4]; float s = 0.f;
#pragma unroll
        for (int j = 0; j < 4; ++j) {
            const u32x2 w = *(const u32x2*)(y + (size_t)row * DM + 4 * (lane + 64 * j));
            yv[j][0] = __builtin_bit_cast(float, w.x << 16); yv[j][1] = __builtin_bit_cast(float, w.x & 0xffff0000u);
            yv[j][2] = __builtin_bit_cast(float, w.y << 16); yv[j][3] = __builtin_bit_cast(float, w.y & 0xffff0000u);
            s += yv[j][0] * yv[j][0] + yv[j][1] * yv[j][1] + yv[j][2] * yv[j][2] + yv[j][3] * yv[j][3];
            xv[j] = ((const f32x4*)(xin + (size_t)row * DM))[lane + 64 * j];
        }
        const float rstd = rsqrtf(wave_sum(s) * (1.f / DM) + NORM_EPS) * coef; float s2 = 0.f;
#pragma unroll
        for (int j = 0; j < 4; ++j) { const f32x4 gg = ((const f32x4*)gpost)[lane + 64 * j]; xv[j] = xv[j] + yv[j] * rstd * gg;
            s2 += xv[j][0] * xv[j][0] + xv[j][1] * xv[j][1] + xv[j][2] * xv[j][2] + xv[j][3] * xv[j][3];
            ((f32x4*)(xout + (size_t)row * DM))[lane + 64 * j] = xv[j]; }
        if (gpre) {
            const float r2 = rsqrtf(wave_sum(s2) * (1.f / DM) + NORM_EPS);
#pragma unroll
            for (int j = 0; j < 4; ++j) { const f32x4 gg = ((const f32x4*)gpre)[lane + 64 * j]; st_bf4(xn + (size_t)row * DM + 4 * (lane + 64 * j), xv[j] * r2 * gg); }
        }
    }
}
__device__ __forceinline__ void d_nsa_outnorm(bf16* amix, const float* g) {
    const int T512 = tidx(), tid = T512 & 255, lane = tid & 63;
    FOR_VB(vb, M_ / 4) {
        const int row = vb * 4 + (tid >> 6);
        bf16* p = amix + (size_t)row * DM + 8 * lane;
        const u32x4 w = *(const u32x4*)p; float v[8]; float s = 0.f;
        v[0] = __builtin_bit_cast(float, w.x << 16); v[1] = __builtin_bit_cast(float, w.x & 0xffff0000u);
        v[2] = __builtin_bit_cast(float, w.y << 16); v[3] = __builtin_bit_cast(float, w.y & 0xffff0000u);
        v[4] = __builtin_bit_cast(float, w.z << 16); v[5] = __builtin_bit_cast(float, w.z & 0xffff0000u);
        v[6] = __builtin_bit_cast(float, w.w << 16); v[7] = __builtin_bit_cast(float, w.w & 0xffff0000u);
#pragma unroll
        for (int i = 0; i < 8; ++i) s += v[i] * v[i];
        const float rstd = rsqrtf(wave_sum(s) * (1.f / 512.f) + NORM_EPS);
        u32x4 o; const float* gg = g + 8 * lane;
        o.x = pk2(v[0] * rstd * gg[0], v[1] * rstd * gg[1]); o.y = pk2(v[2] * rstd * gg[2], v[3] * rstd * gg[3]);
        o.z = pk2(v[4] * rstd * gg[4], v[5] * rstd * gg[5]); o.w = pk2(v[6] * rstd * gg[6], v[7] * rstd * gg[7]);
        *(u32x4*)p = o;
    }
}

struct EpiStore { bf16* O; int ldc; float scale;
    static constexpr int NCAT = 1;
    __device__ __forceinline__ int cat(int) const { return 0; }
    template <int C> __device__ __forceinline__ void apply(int row, int p, f32x4 v0, f32x4 v1) const { bf16* o = O + (size_t)row * ldc + p; st_bf4(o, v0 * scale); st_bf4(o + 16, v1 * scale); } };
struct EpiStoreF32 { float* O; int ldc;
    static constexpr int NCAT = 1;
    __device__ __forceinline__ int cat(int) const { return 0; }
    template <int C> __device__ __forceinline__ void apply(int row, int p, f32x4 v0, f32x4 v1) const { float* o = O + (size_t)row * ldc + p; *(f32x4*)o = v0; *(f32x4*)(o + 16) = v1; } };
struct EpiSwiGLU { bf16* H;
    static constexpr int NCAT = 1;
    __device__ __forceinline__ int cat(int) const { return 0; }
    template <int C> __device__ __forceinline__ void apply(int row, int p, f32x4 g, f32x4 u) const {
        const int q = p & 255, hid = 128 * (p >> 8) + 64 * (q >> 7) + 16 * ((q >> 5) & 3) + (q & 15);
        f32x4 h;
#pragma unroll
        for (int e = 0; e < 4; ++e) h[e] = g[e] / (1.f + __expf(-g[e])) * u[e];
        st_bf4(H + (size_t)row * FF + hid, h); } };
struct EpiBiasSilu { bf16* O; const float* bias;
    static constexpr int NCAT = 1;
    __device__ __forceinline__ int cat(int) const { return 0; }
    template <int C> __device__ __forceinline__ void apply(int row, int p, f32x4 v0, f32x4 v1) const {
        f32x4 a, b; f32x4 b0 = {0.f, 0.f, 0.f, 0.f}, b1 = {0.f, 0.f, 0.f, 0.f};
#pragma unroll
        for (int jc = 0; jc < 8; ++jc) { b0 += *(const f32x4*)(bias + jc * 512 + p); b1 += *(const f32x4*)(bias + jc * 512 + p + 16); }
#pragma unroll
        for (int e = 0; e < 4; ++e) { const float x0 = v0[e] + b0[e], x1 = v1[e] + b1[e]; a[e] = x0 / (1.f + __expf(-x0)); b[e] = x1 / (1.f + __expf(-x1)); }
        bf16* o = O + (size_t)row * 256 + p; st_bf4(o, a); st_bf4(o + 16, b); } };
struct EpiLora { float* wdec; bf16* aga; bf16* agg; const float* w0; const float* a0;
    static constexpr int NCAT = 3;
    __device__ __forceinline__ int cat(int p0) const { return p0 < 512 ? 0 : (p0 < 1024 ? 1 : 2); }
    template <int C> __device__ __forceinline__ void one(int row, int p, f32x4 v) const {
        if (C == 0) { f32x4 o; const f32x4 ww = *(const f32x4*)(w0 + p);
#pragma unroll
            for (int e = 0; e < 4; ++e) o[e] = __expf(-0.6065306597126334f * sigmoidf_(ww[e] + v[e]));
            *(f32x4*)(wdec + (size_t)row * 512 + p) = o;
        } else if (C == 1) { f32x4 o; const f32x4 aa = *(const f32x4*)(a0 + p - 512);
#pragma unroll
            for (int e = 0; e < 4; ++e) o[e] = sigmoidf_(aa[e] + v[e]);
            st_bf4(aga + (size_t)row * 512 + (p - 512), o);
        } else st_bf4(agg + (size_t)row * 512 + (p - 1024), v);
    }
    template <int C> __device__ __forceinline__ void apply(int row, int p, f32x4 v0, f32x4 v1) const { one<C>(row, p, v0); one<C>(row, p + 16, v1); } };
struct EpiWin {
    bf16 *qb, *ks, *kw, *kcr, *vcr, *vst, *vwt; unsigned* rk; bf16 *vv, *prl; float* gates; const float* rope;
    static constexpr int NCAT = 8;
    __device__ __forceinline__ int cat(int p0) const { return p0 < 512 ? 0 : (p0 < 768 ? 1 : (p0 < 1024 ? 2 : (p0 < 1280 ? 3 : (p0 < 2304 ? 4 : (p0 < 2816 ? 7 : (p0 < 3072 ? 6 : 5)))))); }
    template <int C> __device__ __forceinline__ void apply(int row, int p, f32x4 v0, f32x4 v1) const {
        const int b = row / T_, t = row % T_;
        if (C == 0 || C == 1) {
            const int x = p & 63, d = 16 * ((x >> 5) & 1) + (x & 15);
            const f32x4* rp = (const f32x4*)(rope + ((size_t)t * 32 + d) * 2); const f32x4 r0 = rp[0], r1 = rp[1];
            const f32x4 cs = {r0[0], r0[2], r1[0], r1[2]}, sn = {r0[1], r0[3], r1[1], r1[3]};
            const f32x4 lo = v0 * cs - v1 * sn, hi = v0 * sn + v1 * cs;
            if (C == 0) { bf16* o = qb + (size_t)row * 512 + (p & ~63) + d; st_bf4(o, lo * QSCALE); st_bf4(o + 32, hi * QSCALE); }
            else { const int g = ((p - 512) >> 6) & 1; bf16* base = (p < 640) ? ks : kw; bf16* o = base + ((size_t)(b * 2 + g) * T_ + t) * 64 + d; st_bf4(o, lo); st_bf4(o + 32, hi); }
        } else if (C == 2) {
            const int c = (p - 768) & 127, g = c >> 6, d = c & 63; bf16* base = (p < 896) ? kcr : vcr;
            bf16* o = base + ((size_t)(b * 2 + g) * T_ + t) * 64 + d; st_bf4(o, v0); st_bf4(o + 16, v1);
        } else if (C == 3) {
            const int c = (p - 1024) & 127, g = c >> 6, d = c & 63; bf16* base = (p < 1152) ? vst : vwt;
            bf16* o = base + ((size_t)(b * 2 + g) * 64 + d) * T_ + t;
#pragma unroll
            for (int e = 0; e < 4; ++e) { o[(size_t)e * T_] = (bf16)f2bf(v0[e]); o[(size_t)(16 + e) * T_] = (bf16)f2bf(v1[e]); }
        } else if (C == 4) {
            const int q = p - 1280, ch = 16 * (q >> 5) + (q & 15);
            u32x4 w; w.x = pk2(v0[0], v1[0]); w.y = pk2(v0[1], v1[1]); w.z = pk2(v0[2], v1[2]); w.w = pk2(v0[3], v1[3]);
            *(u32x4*)(rk + (size_t)row * 512 + ch) = w;
        } else if (C == 7) {
            bf16* o = vv + (size_t)row * 512 + (p - 2304); st_bf4(o, v0); st_bf4(o + 16, v1);
        } else if (C == 6) {
            bf16* o = prl + (size_t)row * 256 + (p - 2816); st_bf4(o, v0); st_bf4(o + 16, v1);
        } else {
            const int c = p - 3072; float* o = gates + (size_t)row * 24 + c;
            if (c < 24) { f32x4 s = {sigmoidf_(v0[0]), sigmoidf_(v0[1]), sigmoidf_(v0[2]), sigmoidf_(v0[3])}; *(f32x4*)o = s; }
            if (c + 16 < 24) { f32x4 s = {sigmoidf_(v1[0]), sigmoidf_(v1[1]), sigmoidf_(v1[2]), sigmoidf_(v1[3])}; *(f32x4*)(o + 16) = s; }
        }
    }
};

namespace pg8 {
#define PG8_LAS __attribute__((address_space(3)))
typedef unsigned short bf16_t;
typedef short bf16x8 __attribute__((ext_vector_type(8)));
typedef float f32x4 __attribute__((ext_vector_type(4)));
typedef unsigned u32x4 __attribute__((ext_vector_type(4)));
constexpr int BM = 256, BK = 64, HALF = 128, HTB = HALF * BK * 2  , STAGE_BYTES = 8 * HTB, NXCD = 8, WGM = 8;

__host__ __device__ __forceinline__ int lds_byte(int r, int c) { const int st = (r >> 4) * 2 + (c >> 5), rr = r & 15, cc = c & 31, ob = rr * 64 + cc * 2; return st * 1024 + (ob ^ (((ob >> 9) & 1) << 5)); }
__host__ __device__ __forceinline__ void stage_rc(int b, int& R, int& C) { const int st = b / 1024, sb = b % 1024, swz = sb ^ (((sb >> 9) & 1) << 5); R = (st >> 1) * 16 + swz / 64; C = (st & 1) * 32 + (swz % 64) / 2; }
__host__ __device__ __forceinline__ int perm32(int rho) { const int n = rho >> 4, i = rho & 15; return 8 * (i >> 2) + 4 * n + (i & 3); }

struct Unit { int pm, pn; };
struct Gemm { const bf16_t* A; const bf16_t* Bt; int M, N, K, lda, ldb; };

struct StaticOrder {
    int nM, nN, nwg, G, c;
    __host__ __device__ void init(int M, int N, int G_, int c_) { nM = M / BM; nN = N / BM; nwg = nM * nN; G = G_; c = c_; }
    __host__ __device__ bool next(int i, Unit& u) const {
        const long L = (long)i * G + c; if (L >= nwg) return false;
        int wgid = (int)L; { const int q = nwg / NXCD, r = nwg % NXCD, xcd = wgid % NXCD, off = wgid / NXCD; wgid = (xcd < r ? xcd * (q + 1) : r * (q + 1) + (xcd - r) * q) + off; }
        const int nig = WGM * nN, gid = wgid / nig, fm = gid * WGM, gsz = (nM - fm) < WGM ? (nM - fm) : WGM;
        u.pm = fm + ((wgid % nig) % gsz); u.pn = (wgid % nig) / gsz; return true;
    }
    __device__ __forceinline__ void a_ready(const Unit&) const {}
    __device__ __forceinline__ void done(const Unit&) const {}
};

template <class Epi, class Sched, bool ALIGN_EPI = false, bool SP2 = false>
__device__ __forceinline__ void gemm_phase(PG8_LAS unsigned char* lds, const Gemm g, const Sched& S, const Epi& E) {
    const int tid = tidx(), wid = __builtin_amdgcn_readfirstlane(tid >> 6), lane = tid & 63, wr = wid >> 2, wc = wid & 3, fr = lane & 15, fq = lane >> 4;
    const int K = g.K, nt = K / BK;
    unsigned voffA[2], voffB[2];
#pragma unroll
    for (int i = 0; i < 2; ++i) { int R, C; stage_rc(tid * 16 + i * 8192, R, C); const int Rb = Epi::PERM ? ((R & ~31) + perm32(R & 31)) : R;
        voffA[i] = (unsigned)(R * g.lda + C) * 2u; voffB[i] = (unsigned)(Rb * g.ldb + C) * 2u; }
    const size_t kstep = (size_t)(BK * 2);
    const size_t hstepA = (size_t)HALF * g.lda * 2, hstepB = (size_t)HALF * g.ldb * 2;
    const size_t tstepA = 2 * hstepA, tstepB = 2 * hstepB;
    const unsigned ldsw = (unsigned)wid * 1024u;
    const int aoff = lds_byte(wr * 64 + fr, fq * 8), boff = lds_byte(wc * 32 + fr, fq * 8);
#define PG8_SA(b, h) (((b) * 2 + (h)) * HTB)
#define PG8_SB(b, h) ((4 + (b) * 2 + (h)) * HTB)
#define PG8_STAGE(bufoff, gbase, voff) do { _Pragma("unroll") for (int _i = 0; _i < 2; ++_i) \
        __builtin_amdgcn_global_load_lds((const unsigned*)((const char*)(gbase) + (voff)[_i]), (PG8_LAS unsigned*)(lds + (bufoff) + ldsw + _i * 8192), 16, 0, 0); } while (0)
#define PG8_LDA(dst, b, h) do { _Pragma("unroll") for (int m = 0; m < 4; ++m) _Pragma("unroll") for (int k = 0; k < 2; ++k) dst[m][k] = *(const PG8_LAS bf16x8*)(lds + PG8_SA(b, h) + aoff + m * 2048 + k * 1024); } while (0)
#define PG8_LDB(dst, b, h) do { _Pragma("unroll") for (int n = 0; n < 2; ++n) _Pragma("unroll") for (int k = 0; k < 2; ++k) dst[n][k] = *(const PG8_LAS bf16x8*)(lds + PG8_SB(b, h) + boff + n * 2048 + k * 1024); } while (0)
#define PG8_MMA(ai, bj, At, Bt) do { __builtin_amdgcn_s_setprio(1); _Pragma("unroll") for (int m = 0; m < 4; ++m) _Pragma("unroll") for (int n = 0; n < 2; ++n) _Pragma("unroll") for (int k = 0; k < 2; ++k) \
        acc[ai][bj][m][n] = __builtin_amdgcn_mfma_f32_16x16x32_bf16(Bt[n][k], At[m][k], acc[ai][bj][m][n], 0, 0, 0); __builtin_amdgcn_s_setprio(0); } while (0)
#define PG8_WAIT_V(n) asm volatile("s_waitcnt vmcnt(" #n ")" ::: "memory")
#define PG8_WAIT_L(n) asm volatile("s_waitcnt lgkmcnt(" #n ")" ::: "memory")
#define PG8_BAR __builtin_amdgcn_s_barrier()
#define PG8_SCHED __builtin_amdgcn_sched_barrier(0)
    Unit cur, nxt; int ui = 0;
    if (!S.next(0, cur)) return;
    f32x4 acc[2][2][4][2];
#pragma unroll
    for (int a = 0; a < 2; ++a)
#pragma unroll
        for (int b = 0; b < 2; ++b)
#pragma unroll
            for (int m = 0; m < 4; ++m)
#pragma unroll
                for (int n = 0; n < 2; ++n) acc[a][b][m][n] = (f32x4){0.f, 0.f, 0.f, 0.f};
    bf16x8 At[4][2], B0[2][2], B1[2][2];
    const char* cA = (const char*)g.A + (size_t)cur.pm * tstepA; const char* cB = (const char*)g.Bt + (size_t)cur.pn * tstepB;
    S.a_ready(cur);
    if constexpr (SP2) {
        PG8_STAGE(PG8_SB(0, 0), cB, voffB); PG8_STAGE(PG8_SB(0, 1), cB + hstepB, voffB); PG8_STAGE(PG8_SA(0, 0), cA, voffA); PG8_STAGE(PG8_SA(0, 1), cA + hstepA, voffA);
        if (wr == 1) PG8_BAR;
        PG8_WAIT_V(2); PG8_BAR;
        PG8_STAGE(PG8_SB(1, 0), cB + kstep, voffB); PG8_STAGE(PG8_SA(1, 0), cA + kstep, voffA); PG8_STAGE(PG8_SB(1, 1), cB + hstepB + kstep, voffB);
        PG8_WAIT_V(6); PG8_BAR;
    } else {
        PG8_STAGE(PG8_SB(0, 0), cB, voffB); PG8_STAGE(PG8_SA(0, 0), cA, voffA); PG8_STAGE(PG8_SB(0, 1), cB + hstepB, voffB); PG8_STAGE(PG8_SA(0, 1), cA + hstepA, voffA);
        if (wr == 1) PG8_BAR;
        PG8_WAIT_V(4); PG8_BAR;
        PG8_STAGE(PG8_SB(1, 0), cB + kstep, voffB); PG8_STAGE(PG8_SA(1, 0), cA + kstep, voffA); PG8_STAGE(PG8_SB(1, 1), cB + hstepB + kstep, voffB);
        PG8_WAIT_V(6); PG8_BAR;
    }
    for (;;) {
        const bool has_next = S.next(ui + 1, nxt);
        const char* nA = has_next ? (const char*)g.A + (size_t)nxt.pm * tstepA : cA; const char* nB = has_next ? (const char*)g.Bt + (size_t)nxt.pn * tstepB : cB;
        for (int t = 0; t < nt; t += 2) {
            const bool last = (t == nt - 2);
            const char* a1 = cA + (size_t)(t + 1) * kstep;
            const char* a2 = last ? nA : cA + (size_t)(t + 2) * kstep; const char* b2 = last ? nB : cB + (size_t)(t + 2) * kstep;
            const char* a3 = a2 + kstep; const char* b3 = b2 + kstep;
            if (last && has_next) S.a_ready(nxt);
            if constexpr (SP2) {
            PG8_LDB(B0, 0, 0); PG8_LDB(B1, 0, 1); PG8_SCHED; PG8_LDA(At, 0, 0); PG8_STAGE(PG8_SA(1, 1), a1 + hstepA, voffA);
            PG8_WAIT_V(8); PG8_WAIT_L(0); PG8_BAR; PG8_MMA(0, 0, At, B0); PG8_MMA(0, 1, At, B1); PG8_BAR; PG8_SCHED;
            PG8_LDA(At, 0, 1); PG8_STAGE(PG8_SB(0, 0), b2, voffB); PG8_STAGE(PG8_SB(0, 1), b2 + hstepB, voffB); PG8_STAGE(PG8_SA(0, 0), a2, voffA);
            PG8_WAIT_V(8); PG8_WAIT_L(0); PG8_BAR; PG8_MMA(1, 0, At, B0); PG8_MMA(1, 1, At, B1); PG8_BAR; PG8_SCHED;
            PG8_LDB(B0, 1, 0); PG8_LDB(B1, 1, 1); PG8_SCHED; PG8_LDA(At, 1, 0); PG8_STAGE(PG8_SA(0, 1), a2 + hstepA, voffA);
            PG8_WAIT_V(8); PG8_WAIT_L(0); PG8_BAR; PG8_MMA(0, 0, At, B0); PG8_MMA(0, 1, At, B1); PG8_BAR; PG8_SCHED;
            PG8_LDA(At, 1, 1); PG8_STAGE(PG8_SB(1, 0), b3, voffB); PG8_STAGE(PG8_SB(1, 1), b3 + hstepB, voffB); PG8_STAGE(PG8_SA(1, 0), a3, voffA);
            PG8_WAIT_V(8); PG8_WAIT_L(0); PG8_BAR; PG8_MMA(1, 0, At, B0); PG8_MMA(1, 1, At, B1); PG8_BAR; PG8_SCHED;
            } else {
            PG8_LDB(B0, 0, 0); PG8_SCHED; PG8_LDA(At, 0, 0); PG8_STAGE(PG8_SA(1, 1), a1 + hstepA, voffA);
            PG8_WAIT_L(8); PG8_BAR; PG8_WAIT_L(0); PG8_MMA(0, 0, At, B0); PG8_BAR; PG8_SCHED;
            PG8_LDB(B1, 0, 1); PG8_STAGE(PG8_SB(0, 0), b2, voffB);
            PG8_BAR; PG8_WAIT_L(0); PG8_MMA(0, 1, At, B1); PG8_BAR;
            PG8_LDA(At, 0, 1); PG8_STAGE(PG8_SA(0, 0), a2, voffA);
            PG8_BAR; PG8_WAIT_L(0); PG8_MMA(1, 0, At, B0); PG8_BAR; PG8_SCHED;
            PG8_STAGE(PG8_SB(0, 1), b2 + hstepB, voffB);
            PG8_WAIT_V(6); PG8_BAR; PG8_MMA(1, 1, At, B1); PG8_BAR;
            PG8_LDB(B0, 1, 0); PG8_SCHED; PG8_LDA(At, 1, 0); PG8_STAGE(PG8_SA(0, 1), a2 + hstepA, voffA);
            PG8_WAIT_L(8); PG8_BAR; PG8_WAIT_L(0); PG8_MMA(0, 0, At, B0); PG8_BAR; PG8_SCHED;
            PG8_LDB(B1, 1, 1); PG8_STAGE(PG8_SB(1, 0), b3, voffB);
            PG8_BAR; PG8_WAIT_L(0); PG8_MMA(0, 1, At, B1); PG8_BAR;
            PG8_LDA(At, 1, 1); PG8_STAGE(PG8_SA(1, 0), a3, voffA);
            PG8_BAR; PG8_WAIT_L(0); PG8_MMA(1, 0, At, B0); PG8_BAR; PG8_SCHED;
            PG8_STAGE(PG8_SB(1, 1), b3 + hstepB, voffB);
            PG8_WAIT_V(6); PG8_BAR; PG8_MMA(1, 1, At, B1); PG8_BAR;
            }
        }
        if constexpr (ALIGN_EPI) { if (wr == 0) PG8_BAR; }
        if constexpr (!Epi::AFTER_DRAIN) { E(acc, cur, wr, wc, fr, fq); S.done(cur); }
        if (!has_next) break;
#pragma unroll
        for (int a = 0; a < 2; ++a)
#pragma unroll
            for (int b = 0; b < 2; ++b)
#pragma unroll
                for (int m = 0; m < 4; ++m)
#pragma unroll
                    for (int n = 0; n < 2; ++n) acc[a][b][m][n] = (f32x4){0.f, 0.f, 0.f, 0.f};
        cur = nxt; cA = nA; cB = nB; ++ui;
        if constexpr (ALIGN_EPI) { if (wr == 1) PG8_BAR; }
    }
    PG8_WAIT_V(0);
    if constexpr (!ALIGN_EPI) { if (wr == 0) PG8_BAR; }
    PG8_BAR;
    if constexpr (Epi::AFTER_DRAIN) { E.fused(acc, cur, wr, wc, fr, fq, lds, wid, lane); S.done(cur); }
#undef PG8_SA
#undef PG8_SB
#undef PG8_STAGE
#undef PG8_LDA
#undef PG8_LDB
#undef PG8_MMA
#undef PG8_WAIT_V
#undef PG8_WAIT_L
#undef PG8_BAR
#undef PG8_SCHED
}
}

template <class F> struct EpiQuad {
    static constexpr bool PERM = false, AFTER_DRAIN = false;
    F f;
    template <int C, int BJ> __device__ __forceinline__ void half(const pg8::f32x4 (&acc)[2][2][4][2], int row0, int p) const {
#pragma unroll
        for (int ai = 0; ai < 2; ++ai)
#pragma unroll
            for (int m = 0; m < 4; ++m) { f.template apply<C>(row0 + ai * 128 + m * 16, p, acc[ai][BJ][m][0], acc[ai][BJ][m][1]); asm volatile("" ::: "memory"); }
    }
    template <int BJ> __device__ __forceinline__ void disp(const pg8::f32x4 (&acc)[2][2][4][2], int row0, int p0, int p) const {
        const int c = f.cat(p0);
        if (F::NCAT == 1 || c == 0) half<0, BJ>(acc, row0, p);
        else if (F::NCAT > 1 && c == 1) half<(F::NCAT > 1 ? 1 : 0), BJ>(acc, row0, p);
        else if (F::NCAT > 2 && c == 2) half<(F::NCAT > 2 ? 2 : 0), BJ>(acc, row0, p);
        else if (F::NCAT > 3 && c == 3) half<(F::NCAT > 3 ? 3 : 0), BJ>(acc, row0, p);
        else if (F::NCAT > 4 && c == 4) half<(F::NCAT > 4 ? 4 : 0), BJ>(acc, row0, p);
        else if (F::NCAT > 5 && c == 5) half<(F::NCAT > 5 ? 5 : 0), BJ>(acc, row0, p);
        else if (F::NCAT > 6 && c == 6) half<(F::NCAT > 6 ? 6 : 0), BJ>(acc, row0, p);
        else if (F::NCAT > 7) half<(F::NCAT > 7 ? 7 : 0), BJ>(acc, row0, p);
    }
    __device__ __forceinline__ void operator()(const pg8::f32x4 (&acc)[2][2][4][2], const pg8::Unit& u, int wr, int wc, int fr, int fq) const {
        const int row0 = u.pm * 256 + wr * 64 + fr, p0 = u.pn * 256;
        disp<0>(acc, row0, p0, p0 + wc * 32 + 4 * fq);
        disp<1>(acc, row0, p0 + 128, p0 + 128 + wc * 32 + 4 * fq);
    }
};
template <class F> __device__ __forceinline__ void gemm_pg8(unsigned char* lds, const bf16* A, int lda, const bf16* Bt, int ldb, int M, int N, int K, const F& f, int wg_off = 0) {
    if ((int)blockIdx.x < wg_off) return;
    pg8::Gemm g{A, Bt, M, N, K, lda, ldb}; pg8::StaticOrder S; S.init(M, N, (int)gridDim.x, (int)blockIdx.x - wg_off);
    EpiQuad<F> E{f};
    pg8::gemm_phase<EpiQuad<F>, pg8::StaticOrder, true, true>((PG8_LAS unsigned char*)lds, g, S, E);
}

namespace cg = cooperative_groups;
template <bool XIN16, bool XOUT16> struct EpiNormRes {
    static constexpr bool PERM = false, AFTER_DRAIN = true;
    const void* xin; void* xout; bf16* xn; const float* gpost; const float* gpre; float coef; unsigned* part; unsigned* cnt;
    __device__ __forceinline__ void operator()(const pg8::f32x4 (&)[2][2][4][2], const pg8::Unit&, int, int, int, int) const {}
    __device__ __forceinline__ void rowstat(const pg8::f32x4 (&acc)[2][2][4][2], float* P, int wr, int wc, int fr, int fq) const {
#pragma unroll
        for (int ai = 0; ai < 2; ++ai)
#pragma unroll
            for (int m = 0; m < 4; ++m) { float sq = 0.f;
#pragma unroll
                for (int bj = 0; bj < 2; ++bj)
#pragma unroll
                    for (int n = 0; n < 2; ++n) { const pg8::f32x4 v = acc[ai][bj][m][n]; sq += (v[0] * v[0] + v[1] * v[1]) + (v[2] * v[2] + v[3] * v[3]); }
                sq += __shfl_xor(sq, 16); sq += __shfl_xor(sq, 32);
                if (fq == 0) P[(ai * 128 + wr * 64 + m * 16 + fr) * 4 + wc] = sq; }
    }
    __device__ __forceinline__ void exchange(float* P, float* S, unsigned* bank, unsigned* cnt_, const pg8::Unit& u, int tid, float scale) const {
        __syncthreads();
        if (tid < 256) { const f32x4 p = *(const f32x4*)(P + tid * 4);
            __hip_atomic_store(bank + (size_t)(u.pm * 256 + tid) * 4 + u.pn, __builtin_bit_cast(unsigned, (p[0] + p[1]) + (p[2] + p[3])), __ATOMIC_RELAXED, __HIP_MEMORY_SCOPE_AGENT); }
        asm volatile("s_waitcnt vmcnt(0)" ::: "memory");
        __syncthreads();
        if (tid == 0) { unsigned* c = cnt_ + u.pm * 16; __hip_atomic_fetch_add(c, 1u, __ATOMIC_RELAXED, __HIP_MEMORY_SCOPE_AGENT);
            while (__hip_atomic_load(c, __ATOMIC_RELAXED, __HIP_MEMORY_SCOPE_AGENT) < 4u) __builtin_amdgcn_s_sleep(1); }
        __syncthreads();
        if (tid < 256) { const unsigned* b = bank + (size_t)(u.pm * 256 + tid) * 4; float q = 0.f;
#pragma unroll
            for (int j = 0; j < 4; ++j) q += __builtin_bit_cast(float, __hip_atomic_load(b + j, __ATOMIC_RELAXED, __HIP_MEMORY_SCOPE_AGENT));
            S[tid] = rsqrtf(q * (1.f / DM) + NORM_EPS) * scale; }
        __syncthreads();
    }
    __device__ __forceinline__ void fused(pg8::f32x4 (&acc)[2][2][4][2], const pg8::Unit& u, int wr, int wc, int fr, int fq, PG8_LAS unsigned char* lds, int wid, int lane) const {
        float* P = (float*)lds; float* S = P + 1024; const int tid = wid * 64 + lane;
        rowstat(acc, P, wr, wc, fr, fq);
        exchange(P, S, part, cnt, u, tid, coef);
        const int col0 = u.pn * 256 + wc * 32 + 4 * fq;
#pragma unroll
        for (int ai = 0; ai < 2; ++ai)
#pragma unroll
            for (int m = 0; m < 4; ++m) { const int r = ai * 128 + wr * 64 + m * 16 + fr; const float sr = S[r]; const size_t off = (size_t)(u.pm * 256 + r) * DM + col0;
#pragma unroll
                for (int bj = 0; bj < 2; ++bj)
#pragma unroll
                    for (int n = 0; n < 2; ++n) { const int o = bj * 128 + n * 16; const f32x4 g4 = *(const f32x4*)(gpost + col0 + o);
                        f32x4 x4;
                        if (XIN16) { const u32x2 w = *(const u32x2*)((const bf16*)xin + off + o);
                            x4 = (f32x4){__builtin_bit_cast(float, w.x << 16), __builtin_bit_cast(float, w.x & 0xffff0000u), __builtin_bit_cast(float, w.y << 16), __builtin_bit_cast(float, w.y & 0xffff0000u)}; }
                        else x4 = *(const f32x4*)((const float*)xin + off + o);
                        const f32x4 y = x4 + acc[ai][bj][m][n] * sr * g4; acc[ai][bj][m][n] = y;
                        if (XOUT16) st_bf4((bf16*)xout + off + o, y); else *(f32x4*)((float*)xout + off + o) = y; }
                asm volatile("" ::: "memory"); }
        if (!gpre) return;
        rowstat(acc, P, wr, wc, fr, fq);
        exchange(P, S, part + (size_t)M_ * 4, cnt + 64 * 16, u, tid, 1.f);
#pragma unroll
        for (int ai = 0; ai < 2; ++ai)
#pragma unroll
            for (int m = 0; m < 4; ++m) { const int r = ai * 128 + wr * 64 + m * 16 + fr; const float sr = S[r]; const size_t off = (size_t)(u.pm * 256 + r) * DM + col0;
#pragma unroll
                for (int bj = 0; bj < 2; ++bj)
#pragma unroll
                    for (int n = 0; n < 2; ++n) { const int o = bj * 128 + n * 16; const f32x4 g4 = *(const f32x4*)(gpre + col0 + o); st_bf4(xn + off + o, acc[ai][bj][m][n] * sr * g4); }
                asm volatile("" ::: "memory"); }
    }
};
template <bool XIN16, bool XOUT16>
__device__ __forceinline__ void gemm_norm_res(unsigned char* lds, const bf16* A, int lda, const bf16* Bt, int K, const void* xin, void* xout, bf16* xn, const float* gpost, const float* gpre,
                                              float coef, unsigned* part, unsigned* cnt) {
    pg8::Gemm g{A, Bt, M_, DM, K, lda, K}; pg8::StaticOrder S; S.init(M_, DM, 256, (int)blockIdx.x);
    const EpiNormRes<XIN16, XOUT16> E{xin, xout, xn, gpost, gpre, coef, part, cnt};
    pg8::gemm_phase<EpiNormRes<XIN16, XOUT16>, pg8::StaticOrder, false, true>((PG8_LAS unsigned char*)lds, g, S, E);
}

__device__ __forceinline__ void d_gates(const bf16* xn, const bf16* wg  , float* gates, float* red  ) {
    const int T512 = tidx(), lane = T512 & 63, fr = lane & 15, fq = lane >> 4, w = T512 >> 6, kh = w & 1;
    for (int rt0 = blockIdx.x * 4; rt0 < M_ / 16; rt0 += gridDim.x * 4) {
        const int rt = rt0 + (w >> 1);
        const bf16* ap = xn + (size_t)(rt * 16 + fr) * DM + 8 * fq + kh * 512; const bf16* bp = wg + (size_t)fr * DM + 8 * fq + kh * 512;
        f32x4 c0 = {0.f, 0.f, 0.f, 0.f}, c1 = {0.f, 0.f, 0.f, 0.f};
#pragma unroll 8
        for (int k0 = 0; k0 < 512; k0 += 32) { const bf16x8 a = *(const bf16x8*)(ap + k0);
            c0 = __builtin_amdgcn_mfma_f32_16x16x32_bf16(*(const bf16x8*)(bp + k0), a, c0, 0, 0, 0);
            c1 = __builtin_amdgcn_mfma_f32_16x16x32_bf16(*(const bf16x8*)(bp + (size_t)16 * DM + k0), a, c1, 0, 0, 0); }
        float* r = red + ((w >> 1) * 64 + lane) * 8;
        if (kh) { *(f32x4*)r = c0; *(f32x4*)(r + 4) = c1; }
        __syncthreads();
        if (!kh) { c0 += *(const f32x4*)r; c1 += *(const f32x4*)(r + 4);
            float* o = gates + (size_t)(rt * 16 + fr) * 24 + 4 * fq;
            *(f32x4*)o = (f32x4){sigmoidf_(c0[0]), sigmoidf_(c0[1]), sigmoidf_(c0[2]), sigmoidf_(c0[3])};
            if (fq < 2) *(f32x4*)(o + 16) = (f32x4){sigmoidf_(c1[0]), sigmoidf_(c1[1]), sigmoidf_(c1[2]), sigmoidf_(c1[3])}; }
        __syncthreads();
    }
}

__device__ __forceinline__ void d_cmp2(const float* part  , const float* bias  , const bf16* w2t, const float* rope, bf16* kc, bf16* vct) {
    const int T512 = tidx(), lane = T512 & 63, fr = lane & 15, fq = lane >> 4;
    for (int task = blockIdx.x * 8 + (T512 >> 6); task < 256; task += gridDim.x * 8) {
        const int kv = task >> 7, R0 = (task & 127) * 16;
        const float* p0 = part + ((size_t)(kv * 2) * 2048 + R0 + fr) * 256 + 8 * fq; const float* p1 = p0 + (size_t)2048 * 256;
        const float* bb = bias + kv * 256 + 8 * fq;
        const bf16* bp = w2t + (size_t)kv * 64 * 256 + (size_t)fr * 256 + 8 * fq;
        f32x4 acc[4];
#pragma unroll
        for (int nt = 0; nt < 4; ++nt) acc[nt] = (f32x4){0.f, 0.f, 0.f, 0.f};
#pragma unroll
        for (int k0 = 0; k0 < 256; k0 += 32) {
            f32x4 xa = *(const f32x4*)(p0 + k0) + *(const f32x4*)(p1 + k0) + *(const f32x4*)(bb + k0);
            f32x4 xb = *(const f32x4*)(p0 + k0 + 4) + *(const f32x4*)(p1 + k0 + 4) + *(const f32x4*)(bb + k0 + 4);
#pragma unroll
            for (int e = 0; e < 4; ++e) { xa[e] = xa[e] / (1.f + __expf(-xa[e])); xb[e] = xb[e] / (1.f + __expf(-xb[e])); }
            const bf16x8 a = __builtin_bit_cast(bf16x8, (u32x4){pk2(xa[0], xa[1]), pk2(xa[2], xa[3]), pk2(xb[0], xb[1]), pk2(xb[2], xb[3])});
#pragma unroll
            for (int nt = 0; nt < 4; ++nt) acc[nt] = __builtin_amdgcn_mfma_f32_16x16x32_bf16(*(const bf16x8*)(bp + (size_t)nt * 16 * 256 + k0), a, acc[nt], 0, 0, 0);
        }
        const int R = R0 + fr, bg = R >> 9, c = R & 511;
        if (kv == 0) {
            const int pos = (16 * c + 31) & (T_ - 1);
#pragma unroll
            for (int h2 = 0; h2 < 2; ++h2) {
                const int d = 16 * h2 + 4 * fq; const f32x4* rp = (const f32x4*)(rope + ((size_t)pos * 32 + d) * 2); const f32x4 r0 = rp[0], r1 = rp[1];
                const f32x4 cs = {r0[0], r0[2], r1[0], r1[2]}, sn = {r0[1], r0[3], r1[1], r1[3]};
                const f32x4 lo = acc[h2] * cs - acc[h2 + 2] * sn, hi = acc[h2] * sn + acc[h2 + 2] * cs;
                st_bf4(kc + (size_t)R * 64 + d, lo); st_bf4(kc + (size_t)R * 64 + d + 32, hi);
            }
        } else {
#pragma unroll
            for (int nt = 0; nt < 4; ++nt)
#pragma unroll
                for (int e = 0; e < 4; ++e) vct[((size_t)bg * 64 + 16 * nt + 4 * fq + e) * NCP + c] = (bf16)f2bf(acc[nt][e]);
        }
    }
}

struct NsaArgs { const bf16 *qb, *kc, *vct, *ks, *vst, *kw, *vwt; const float* gates; bf16* amix; };
__device__ __forceinline__ float dot64(const float* q, const bf16* k) {
    float s = 0.f;
#pragma unroll
    for (int i = 0; i < 8; ++i) { const u32x4 w = ((const u32x4*)k)[i];
        s += q[8 * i + 0] * __builtin_bit_cast(float, w.x << 16) + q[8 * i + 1] * __builtin_bit_cast(float, w.x & 0xffff0000u)
           + q[8 * i + 2] * __builtin_bit_cast(float, w.y << 16) + q[8 * i + 3] * __builtin_bit_cast(float, w.y & 0xffff0000u)
           + q[8 * i + 4] * __builtin_bit_cast(float, w.z << 16) + q[8 * i + 5] * __builtin_bit_cast(float, w.z & 0xffff0000u)
           + q[8 * i + 6] * __builtin_bit_cast(float, w.w << 16) + q[8 * i + 7] * __builtin_bit_cast(float, w.w & 0xffff0000u); }
    return s;
}
__device__ __forceinline__ void softmax_row(float* s, int n, int lane) {
    float m = -INFINITY; for (int i = lane; i < n; i += 64) m = fmaxf(m, s[i]);
    m = wave_max(m); if (m == -INFINITY) m = 0.f;
    float l = 0.f; for (int i = lane; i < n; i += 64) { const float e = exp2f(s[i] - m); s[i] = e; l += e; }
    l = wave_sum(l); const float inv = 1.f / fmaxf(l, 1e-30f);
    for (int i = lane; i < n; i += 64) s[i] *= inv;
}
__device__ __forceinline__ void d_nsa_simple(const NsaArgs& a, int vb, int tid, unsigned char* smem) {
    float (*qs)[64] = (float (*)[64])smem; float (*sc)[1024] = (float (*)[1024])(smem + 1024); float* imp = (float*)(smem + 17408); float* score = imp + 128;
    int* list = (int*)(score + 128); int* nlist = list + 16;
    const int bg = vb / T_, t = vb % T_, b = bg >> 1, g = bg & 1;
    const int r = tid >> 6, d = tid & 63, lane = d;
    const size_t row = (size_t)b * T_ + t;
    qs[r][d] = bf2f(a.qb[row * 512 + g * 256 + r * 64 + d]);
    if (tid == 0) *nlist = 0;
    __syncthreads();
    const int nv = t < 31 ? 0 : (t - 31) / 16 + 1;
    for (int c = tid; c < nv; c += 256) { const bf16* k = a.kc + ((size_t)bg * NCP + c) * 64;
        _Pragma("unroll 1") for (int rr = 0; rr < 4; ++rr) sc[rr][c] = dot64(qs[rr], k); }
    __syncthreads();
    softmax_row(sc[r], nv, lane);
    __syncthreads();
    float oc = 0.f; { const bf16* v = a.vct + ((size_t)bg * 64 + d) * NCP; for (int c = 0; c < nv; ++c) oc += sc[r][c] * bf2f(v[c]); }
    if (tid < 128) { const int s = tid; float acc = 0.f;
        for (int c = 4 * s - 1; c <= 4 * s + 3; ++c) if (c >= 0 && c < nv) acc += sc[0][c] + sc[1][c] + sc[2][c] + sc[3][c];
        imp[s] = acc; }
    __syncthreads();
    const int cur = t >> 6;
    if (tid < 128) { const int s = tid; const bool forced = (s == 0) || (s == cur) || (s == cur - 1);
        score[s] = forced ? 1e4f : (s <= cur ? imp[s] : -1e4f); }
    __syncthreads();
    if (tid < 128) { const int s = tid; const float my = score[s]; int rank = 0;
        for (int j = 0; j < 128; ++j) { const float o = score[j]; rank += (o > my || (o == my && j < s)) ? 1 : 0; }
        if (rank < 16 && s <= cur) { const int slot = atomicAdd(nlist, 1); list[slot] = s; } }
    __syncthreads();
    const int ns = *nlist * 64;
    for (int i = tid; i < ns; i += 256) { const int pos = list[i >> 6] * 64 + (i & 63);
        if (pos <= t) { const bf16* k = a.ks + ((size_t)bg * T_ + pos) * 64; _Pragma("unroll 1") for (int rr = 0; rr < 4; ++rr) sc[rr][i] = dot64(qs[rr], k); }
        else { sc[0][i] = -INFINITY; sc[1][i] = -INFINITY; sc[2][i] = -INFINITY; sc[3][i] = -INFINITY; } }
    __syncthreads();
    softmax_row(sc[r], ns, lane);
    __syncthreads();
    float os = 0.f; { const bf16* v = a.vst + ((size_t)bg * 64 + d) * T_;
        for (int i = 0; i < ns; ++i) { const int pos = list[i >> 6] * 64 + (i & 63); if (pos <= t) os += sc[r][i] * bf2f(v[pos]); } }
    __syncthreads();
    const int lo = t - 511 > 0 ? t - 511 : 0, nw = t - lo + 1;
    for (int i = tid; i < nw; i += 256) { const bf16* k = a.kw + ((size_t)bg * T_ + lo + i) * 64;
        _Pragma("unroll 1") for (int rr = 0; rr < 4; ++rr) sc[rr][i] = dot64(qs[rr], k); }
    __syncthreads();
    softmax_row(sc[r], nw, lane);
    __syncthreads();
    float ow = 0.f; { const bf16* v = a.vwt + ((size_t)bg * 64 + d) * T_ + lo; for (int i = 0; i < nw; ++i) ow += sc[r][i] * bf2f(v[i]); }
    const float* gt = a.gates + row * 24 + g * 12 + r * 3;
    a.amix[row * DM + g * 256 + r * 64 + d] = (bf16)f2bf(gt[0] * oc + gt[1] * os + gt[2] * ow);
    __syncthreads();
}


namespace nsa {
typedef float f32x16 __attribute__((ext_vector_type(16)));
constexpr int KROW = 144, VROW = 136, KBUF = 64 * KROW, VBUF = 64 * VROW;
constexpr int OFF_K = 0, OFF_V = 2 * KBUF, OFF_IMP = OFF_V + 2 * VBUF, IMPW = 130, OFF_SEL = OFF_IMP + 64 * IMPW * 4, OFF_UM = OFF_SEL + 1024, OFF_WS = OFF_UM + 16, OFF_UNIT = OFF_WS + 1024, OFF_ACC = OFF_UNIT + 16, LDS_NEED = OFF_ACC + 8 * 8192;
static_assert(LDS_NEED <= 147456 - 64 && OFF_ACC % 16 == 0, "nsa lds");
static_assert(OFF_IMP % 16 == 0 && OFF_SEL % 16 == 0 && OFF_WS % 16 == 0, "nsa lds map");
__device__ __forceinline__ int crow(int r, int hi) { return (r & 3) + 8 * (r >> 2) + 4 * hi; }
__device__ __forceinline__ int next_bit(unsigned m0, unsigned m1, unsigned m2, unsigned m3, int from) {
#pragma unroll
    for (int wd = 0; wd < 4; ++wd) {
        unsigned x = wd == 0 ? m0 : (wd == 1 ? m1 : (wd == 2 ? m2 : m3)); const int base = wd * 32;
        if (from < base + 32) { if (from > base) x &= (~0u) << (from - base); if (x) return base + __builtin_ctz(x); }
    }
    return 128;
}
__device__ __forceinline__ bf16x8 pack8(const f32x16& p, int b0) {
    u32x4 w; w.x = pk2(p[b0 + 0], p[b0 + 1]); w.y = pk2(p[b0 + 2], p[b0 + 3]); w.z = pk2(p[b0 + 4], p[b0 + 5]); w.w = pk2(p[b0 + 6], p[b0 + 7]);
    return __builtin_bit_cast(bf16x8, w);
}
struct Branch { const bf16* k; const bf16* vt; int ldv; };

constexpr float THR = 8.f;
template <int MODE, bool SEL>
__device__ __forceinline__ void compute_tile(unsigned char* sm, int cb, int j, const bf16x8 (&qf)[4], int lo, int hi_b, int lo_max, int hi_min, unsigned s0, unsigned s1, unsigned s2, unsigned s3,
                                             float& m, float& l, float invl, bool& initd, f32x16& negm, f32x16 (&o)[2], float* imp_row, float* wsc, int i, int hi) {
        const unsigned char* kb = sm + OFF_K + cb * KBUF; const unsigned char* vb = sm + OFF_V + cb * VBUF;
        const int key0 = 64 * j;
        bool rowsel = true;
        if (SEL) { const unsigned wsel = j < 32 ? s0 : (j < 64 ? s1 : (j < 96 ? s2 : s3)); rowsel = (wsel >> (j & 31)) & 1u; }
        if (!SEL || __any(rowsel)) {
            f32x16 p0, p1;
            {
                f32x16 c0;
                if (SEL) {
#pragma unroll
                    for (int r = 0; r < 16; ++r) c0[r] = rowsel ? negm[r] : -INFINITY;
                } else c0 = negm;
                bf16x8 ka[8];
#pragma unroll
                for (int d0 = 0; d0 < 4; ++d0) { ka[2 * d0] = *(const bf16x8*)(kb + i * KROW + (16 * d0 + 8 * hi) * 2); ka[2 * d0 + 1] = *(const bf16x8*)(kb + (32 + i) * KROW + (16 * d0 + 8 * hi) * 2); }
                __builtin_amdgcn_sched_barrier(0);
                p0 = __builtin_amdgcn_mfma_f32_32x32x16_bf16(ka[0], qf[0], c0, 0, 0, 0);
                p1 = __builtin_amdgcn_mfma_f32_32x32x16_bf16(ka[1], qf[0], c0, 0, 0, 0);
#pragma unroll
                for (int d0 = 1; d0 < 4; ++d0) {
                    p0 = __builtin_amdgcn_mfma_f32_32x32x16_bf16(ka[2 * d0], qf[d0], p0, 0, 0, 0);
                    p1 = __builtin_amdgcn_mfma_f32_32x32x16_bf16(ka[2 * d0 + 1], qf[d0], p1, 0, 0, 0);
                }
            }
            bf16x8 vfr[8];
            if (MODE != 0) {
#pragma unroll
                for (int dt = 0; dt < 2; ++dt) { const unsigned char* vp = vb + (32 * dt + i) * VROW + 8 * hi;
#pragma unroll
                    for (int ks = 0; ks < 4; ++ks) { const u32x2 v_lo = *(const u32x2*)(vp + 32 * ks), v_hi = *(const u32x2*)(vp + 32 * ks + 16);
                        vfr[dt * 4 + ks] = __builtin_bit_cast(bf16x8, (u32x4){v_lo.x, v_lo.y, v_hi.x, v_hi.y}); } }
                __builtin_amdgcn_sched_barrier(0);
            }
            if (!(key0 >= lo_max && key0 + 63 <= hi_min)) {
#pragma unroll
                for (int r = 0; r < 16; ++r) { const int key = key0 + crow(r, hi);
                    if (key < lo || key > hi_b) p0[r] = -INFINITY;
                    if (key + 32 < lo || key + 32 > hi_b) p1[r] = -INFINITY; }
            }
            if (MODE == 1) {
#pragma unroll
                for (int r = 0; r < 16; ++r) { p0[r] = __builtin_amdgcn_exp2f(p0[r]) * invl; p1[r] = __builtin_amdgcn_exp2f(p1[r]) * invl; }
#pragma unroll
                for (int gq = 0; gq < 4; ++gq) {
                    float G0 = (p0[4 * gq] + p0[4 * gq + 1]) + (p0[4 * gq + 2] + p0[4 * gq + 3]), L0 = p0[4 * gq + 3];
                    float G1 = (p1[4 * gq] + p1[4 * gq + 1]) + (p1[4 * gq + 2] + p1[4 * gq + 3]), L1 = p1[4 * gq + 3];
                    G0 += __shfl_xor(G0, 1); L0 += __shfl_xor(L0, 1); G1 += __shfl_xor(G1, 1); L1 += __shfl_xor(L1, 1);
                    G0 += __shfl_xor(G0, 2); L0 += __shfl_xor(L0, 2); G1 += __shfl_xor(G1, 2); L1 += __shfl_xor(L1, 2);
                    if ((i & 3) == 0) { const int s = 16 * j + 2 * gq + hi;
                        atomicAdd(imp_row + s, G0); atomicAdd(imp_row + s + 1, L0); atomicAdd(imp_row + s + 8, G1); atomicAdd(imp_row + s + 9, L1); }
                }
            } else {
                float ta = fmaxf(fmaxf(p0[0], p0[1]), p1[0]), tb = fmaxf(fmaxf(p0[2], p0[3]), p1[1]);
                ta = fmaxf(fmaxf(ta, p1[2]), p1[3]);
#pragma unroll
                for (int r = 4; r < 16; r += 4) { ta = fmaxf(fmaxf(ta, p0[r]), p0[r + 1]); tb = fmaxf(fmaxf(tb, p0[r + 2]), p0[r + 3]); ta = fmaxf(fmaxf(ta, p1[r]), p1[r + 1]); tb = fmaxf(fmaxf(tb, p1[r + 2]), p1[r + 3]); }
                float tm = fmaxf(ta, tb);
                tm = fmaxf(tm, __shfl_xor(tm, 32));
                if (__any((!initd && tm > -INFINITY) || tm > THR)) {
                    const bool was = initd;
                    const float d = was ? fmaxf(tm, 0.f) : (tm > -INFINITY ? tm : 0.f);
                    initd = was || (tm > -INFINITY);
                    m += d; const float alpha = was ? __builtin_amdgcn_exp2f(-d) : 1.f; l *= alpha;
#pragma unroll
                    for (int r = 0; r < 16; ++r) { p0[r] -= d; p1[r] -= d; negm[r] = -m; }
                    if (MODE == 2) {
                        if (hi == 0) wsc[i] = alpha;
                        asm volatile("" ::: "memory");
#pragma unroll
                        for (int rg = 0; rg < 4; ++rg) { const f32x4 a4 = *(const f32x4*)(wsc + 8 * rg + 4 * hi);
#pragma unroll
                            for (int e = 0; e < 4; ++e) { o[0][4 * rg + e] *= a4[e]; o[1][4 * rg + e] *= a4[e]; } }
                        asm volatile("" ::: "memory");
                    }
                }
                float rs = 0.f;
#pragma unroll
                for (int r = 0; r < 16; ++r) { p0[r] = __builtin_amdgcn_exp2f(p0[r]); p1[r] = __builtin_amdgcn_exp2f(p1[r]); rs += p0[r] + p1[r]; }
                l += rs;
            }
            if (MODE != 0) {
                const bf16x8 pf0 = pack8(p0, 0), pf1 = pack8(p0, 8), pf2 = pack8(p1, 0), pf3 = pack8(p1, 8);
#pragma unroll
                for (int dt = 0; dt < 2; ++dt)
#pragma unroll
                    for (int ks = 0; ks < 4; ++ks)
                        o[dt] = __builtin_amdgcn_mfma_f32_32x32x16_bf16(ks == 0 ? pf0 : (ks == 1 ? pf1 : (ks == 2 ? pf2 : pf3)), vfr[dt * 4 + ks], o[dt], 0, 0, 0);
            }
        }
}
template <int MODE, bool SEL>
__device__ __forceinline__ void run_branch(unsigned char* sm, const Branch br, unsigned m0, unsigned m1, unsigned m2, unsigned m3,
                                           const bf16x8 (&qf)[4], int lo, int hi_b, int lo_max, int hi_min, unsigned s0, unsigned s1, unsigned s2, unsigned s3,
                                           float& m, float& l, float invl, f32x16 (&o)[2], float* imp_row, float* wsc, int tid, int lane) {
    const int i = lane & 31, hi = lane >> 5;
    const bf16* kp = br.k + tid * 8; const bf16* vp_ = br.vt + (size_t)(tid >> 3) * br.ldv + (tid & 7) * 8;
    unsigned char* kst = sm + OFF_K + (tid >> 3) * KROW + (tid & 7) * 16; unsigned char* vst = sm + OFF_V + (tid >> 3) * VROW + (tid & 7) * 16;
#define NSA_LOAD(jj, KR, VR) do { KR = *(const u32x4*)(kp + (size_t)(jj) * 4096); if (MODE != 0) VR = *(const u32x4*)(vp_ + (jj) * 64); } while (0)
#define NSA_STORE(buf, KR, VR) do { *(u32x4*)(kst + (buf) * KBUF) = KR; if (MODE != 0) { *(u32x2*)(vst + (buf) * VBUF) = (u32x2){VR.x, VR.y}; *(u32x2*)(vst + (buf) * VBUF + 8) = (u32x2){VR.z, VR.w}; } } while (0)
    int j = next_bit(m0, m1, m2, m3, 0);
    int j1 = j < 128 ? next_bit(m0, m1, m2, m3, j + 1) : 128;
    u32x4 kA, vA, kB, vB;
    if (j < 128) { NSA_LOAD(j, kA, vA); if (j1 < 128) NSA_LOAD(j1, kB, vB); NSA_STORE(0, kA, vA); }
    __syncthreads();
    bool initd = (MODE == 1);
    f32x16 negm;
#pragma unroll
    for (int r = 0; r < 16; ++r) negm[r] = (MODE == 1) ? -m : 0.f;
    while (j < 128) {
        {
            const int j2 = j1 < 128 ? next_bit(m0, m1, m2, m3, j1 + 1) : 128;
            if (j2 < 128) NSA_LOAD(j2, kA, vA);
            compute_tile<MODE, SEL>(sm, 0, j, qf, lo, hi_b, lo_max, hi_min, s0, s1, s2, s3, m, l, invl, initd, negm, o, imp_row, wsc, i, hi);
            if (j1 < 128) NSA_STORE(1, kB, vB);
            __syncthreads();
            j = j1; j1 = j2;
        }
        if (j >= 128) break;
        {
            const int j2 = j1 < 128 ? next_bit(m0, m1, m2, m3, j1 + 1) : 128;
            if (j2 < 128) NSA_LOAD(j2, kB, vB);
            compute_tile<MODE, SEL>(sm, 1, j, qf, lo, hi_b, lo_max, hi_min, s0, s1, s2, s3, m, l, invl, initd, negm, o, imp_row, wsc, i, hi);
            if (j1 < 128) NSA_STORE(0, kA, vA);
            __syncthreads();
            j = j1; j1 = j2;
        }
    }
#undef NSA_LOAD
#undef NSA_STORE
}
template <bool FIRST> __device__ __forceinline__ void add_scaled(float* accw, const f32x16 (&o)[2], float f, float* wsc, int i, int hi, int lane) {
    if (hi == 0) wsc[i] = f;
    asm volatile("" ::: "memory");
#pragma unroll
    for (int rg = 0; rg < 4; ++rg) { const f32x4 a4 = *(const f32x4*)(wsc + 8 * rg + 4 * hi);
#pragma unroll
        for (int e = 0; e < 4; ++e)
#pragma unroll
            for (int dt = 0; dt < 2; ++dt) { float* p = accw + (dt * 16 + 4 * rg + e) * 64 + lane; const float v = a4[e] * o[dt][4 * rg + e]; *p = FIRST ? v : (*p + v); } }
    asm volatile("" ::: "memory");
}
__device__ __forceinline__ void unit(const NsaArgs& a, int u, unsigned char* sm) {
    const int tid = tidx(), lane = tid & 63, w = __builtin_amdgcn_readfirstlane(tid >> 6), i = lane & 31, hi = lane >> 5;
    const int cur = 127 - (u >> 2), bg = u & 3, b = bg >> 1, g = bg & 1, q0 = cur * 64;
    const int ql = 8 * w + (i >> 2), hd = i & 3, t = q0 + ql;
    const size_t grow = (size_t)b * T_ + t;
    bf16x8 qf[4];
    { const bf16* qp = a.qb + grow * 512 + g * 256 + hd * 64 + 8 * hi;
#pragma unroll
      for (int d0 = 0; d0 < 4; ++d0) qf[d0] = *(const bf16x8*)(qp + 16 * d0); }
    float* wsc = (float*)(sm + OFF_WS) + w * 32;
    float* imp = (float*)(sm + OFF_IMP);
    unsigned* selw = (unsigned*)(sm + OFF_SEL);
    unsigned* um = (unsigned*)(sm + OFF_UM);
    for (int k = tid; k < 64 * IMPW; k += 512) imp[k] = 0.f;
    if (tid < 4) um[tid] = 0u;
    const float* gt = a.gates + grow * 24 + g * 12 + hd * 3;
    const float gc = gt[0], gs = gt[1], gw = gt[2];
    f32x16 o[2];
    float* accw = (float*)(sm + OFF_ACC) + w * 2048;
    const int tw0 = q0 + 8 * w, tw1 = tw0 + 7;
    {
        const int nv = t < 31 ? 0 : (t - 31) / 16 + 1;
        const int nvw = tw0 < 31 ? 0 : (tw0 - 31) / 16 + 1;
        const int nvmax = (q0 + 63 - 31) / 16 + 1, ntc = (nvmax + 63) / 64;
        const unsigned cm0 = ntc >= 32 ? ~0u : ((1u << ntc) - 1u);
        const Branch br{a.kc + (size_t)bg * NCP * 64, a.vct + (size_t)bg * 64 * NCP, NCP};
        float m = 0.f, l = 0.f;
        run_branch<0, false>(sm, br, cm0, 0u, 0u, 0u, qf, 0, nv - 1, 0, nvw - 1, 0u, 0u, 0u, 0u, m, l, 0.f, o, nullptr, wsc, tid, lane);
        l += __shfl_xor(l, 32);
        const float invl = 1.f / fmaxf(l, 1e-30f);
#pragma unroll
        for (int r = 0; r < 16; ++r) { o[0][r] = 0.f; o[1][r] = 0.f; }
        run_branch<1, false>(sm, br, cm0, 0u, 0u, 0u, qf, 0, nv - 1, 0, nvw - 1, 0u, 0u, 0u, 0u, m, l, invl, o, imp + ql * IMPW, wsc, tid, lane);
        add_scaled<true>(accw, o, gc, wsc, i, hi, lane);
    }
    {
        unsigned u0 = 0u, u1 = 0u, u2 = 0u, u3 = 0u;
        const int ncand = cur - 2;
        unsigned k0[8], k1[8], k2[8], k3[8];
        if (ncand <= 13) {
#pragma unroll
            for (int wd = 0; wd < 4; ++wd) { const int nb = cur + 1 - 32 * wd; const unsigned x = nb >= 32 ? ~0u : (nb <= 0 ? 0u : ((1u << nb) - 1u));
#pragma unroll
                for (int qq = 0; qq < 8; ++qq) { if (wd == 0) k0[qq] = x; else if (wd == 1) k1[qq] = x; else if (wd == 2) k2[qq] = x; else k3[qq] = x; } }
        } else {
            unsigned q0[8], q1[8];
#pragma unroll
            for (int qq = 0; qq < 8; ++qq) { const float* ir = imp + (8 * w + qq) * IMPW;
                q0[qq] = (lane >= 1 && lane <= cur - 2) ? ((__builtin_bit_cast(unsigned, ir[lane]) & 0xFFFFFF80u) | (unsigned)(127 - lane)) : 0u;
                q1[qq] = (lane + 64 <= cur - 2) ? ((__builtin_bit_cast(unsigned, ir[lane + 64]) & 0xFFFFFF80u) | (unsigned)(63 - lane)) : 0u;
                k0[qq] = 1u; k1[qq] = 0u; k2[qq] = 0u; k3[qq] = 0u; }
            for (int it = 0; it < 13; ++it) {
#pragma unroll
                for (int qq = 0; qq < 8; ++qq) {
                    unsigned mx = q0[qq] > q1[qq] ? q0[qq] : q1[qq];
                    { const unsigned o_ = (unsigned)__builtin_amdgcn_update_dpp(0, (int)mx, 0xB1, 0xF, 0xF, true); mx = o_ > mx ? o_ : mx; }
                    { const unsigned o_ = (unsigned)__builtin_amdgcn_update_dpp(0, (int)mx, 0x4E, 0xF, 0xF, true); mx = o_ > mx ? o_ : mx; }
                    { const unsigned o_ = (unsigned)__builtin_amdgcn_update_dpp(0, (int)mx, 0x141, 0xF, 0xF, true); mx = o_ > mx ? o_ : mx; }
                    { const unsigned o_ = (unsigned)__builtin_amdgcn_update_dpp(0, (int)mx, 0x140, 0xF, 0xF, true); mx = o_ > mx ? o_ : mx; }
                    const unsigned r0 = (unsigned)__builtin_amdgcn_readlane((int)mx, 0), r1 = (unsigned)__builtin_amdgcn_readlane((int)mx, 16), r2 = (unsigned)__builtin_amdgcn_readlane((int)mx, 32), r3 = (unsigned)__builtin_amdgcn_readlane((int)mx, 48);
                    const unsigned ra = r0 > r1 ? r0 : r1, rb = r2 > r3 ? r2 : r3, best = ra > rb ? ra : rb;
                    if (q0[qq] == best) q0[qq] = 0u; if (q1[qq] == best) q1[qq] = 0u;
                    const int b_ = 127 - (int)(best & 127u);
                    const unsigned bit = 1u << (b_ & 31);
                    if (b_ < 32) k0[qq] |= bit; else if (b_ < 64) k1[qq] |= bit; else if (b_ < 96) k2[qq] |= bit; else k3[qq] |= bit; }
            }
            { const int c1 = cur - 1; const unsigned b1 = 1u << (c1 & 31), b2 = 1u << (cur & 31);
#pragma unroll
              for (int qq = 0; qq < 8; ++qq) {
                if (c1 < 32) k0[qq] |= b1; else if (c1 < 64) k1[qq] |= b1; else if (c1 < 96) k2[qq] |= b1; else k3[qq] |= b1;
                if (cur < 32) k0[qq] |= b2; else if (cur < 64) k1[qq] |= b2; else if (cur < 96) k2[qq] |= b2; else k3[qq] |= b2; } }
        }
#pragma unroll
        for (int qq = 0; qq < 8; ++qq) {
            if (lane == 0) { unsigned* sp = selw + (8 * w + qq) * 4; sp[0] = k0[qq]; sp[1] = k1[qq]; sp[2] = k2[qq]; sp[3] = k3[qq]; }
            u0 |= k0[qq]; u1 |= k1[qq]; u2 |= k2[qq]; u3 |= k3[qq]; }
        if (lane == 0) { atomicOr(um + 0, u0); atomicOr(um + 1, u1); atomicOr(um + 2, u2); atomicOr(um + 3, u3); }
    }
    __syncthreads();
    {
        const unsigned U0 = um[0], U1 = um[1], U2 = um[2], U3 = um[3];
        const unsigned* sp = selw + ql * 4; const unsigned s0 = sp[0], s1 = sp[1], s2 = sp[2], s3 = sp[3];
        const Branch br{a.ks + (size_t)bg * T_ * 64, a.vst + (size_t)bg * 64 * T_, T_};
        float m = 0.f, l = 0.f;
#pragma unroll
        for (int r = 0; r < 16; ++r) { o[0][r] = 0.f; o[1][r] = 0.f; }
        run_branch<2, true>(sm, br, __builtin_amdgcn_readfirstlane(U0), __builtin_amdgcn_readfirstlane(U1), __builtin_amdgcn_readfirstlane(U2), __builtin_amdgcn_readfirstlane(U3),
                            qf, 0, t, 0, tw0, s0, s1, s2, s3, m, l, 0.f, o, nullptr, wsc, tid, lane);
        l += __shfl_xor(l, 32);
        add_scaled<false>(accw, o, gs / fmaxf(l, 1e-30f), wsc, i, hi, lane);
    }
    {
        const int j0 = cur - 8 > 0 ? cur - 8 : 0;
        unsigned wm0 = 0u, wm1 = 0u, wm2 = 0u, wm3 = 0u;
#pragma unroll
        for (int wd = 0; wd < 4; ++wd) { const int a0 = j0 - 32 * wd, a1 = cur + 1 - 32 * wd;
            const unsigned hi_m = a1 >= 32 ? ~0u : (a1 <= 0 ? 0u : ((1u << a1) - 1u)), lo_m = a0 >= 32 ? ~0u : (a0 <= 0 ? 0u : ((1u << a0) - 1u));
            const unsigned x = hi_m & ~lo_m; if (wd == 0) wm0 = x; else if (wd == 1) wm1 = x; else if (wd == 2) wm2 = x; else wm3 = x; }
        const Branch br{a.kw + (size_t)bg * T_ * 64, a.vwt + (size_t)bg * 64 * T_, T_};
        float m = 0.f, l = 0.f;
#pragma unroll
        for (int r = 0; r < 16; ++r) { o[0][r] = 0.f; o[1][r] = 0.f; }
        run_branch<2, false>(sm, br, wm0, wm1, wm2, wm3, qf, t - 511, t, tw1 - 511, tw0, 0u, 0u, 0u, 0u, m, l, 0.f, o, nullptr, wsc, tid, lane);
        l += __shfl_xor(l, 32);
        add_scaled<false>(accw, o, gw / fmaxf(l, 1e-30f), wsc, i, hi, lane);
    }
#pragma unroll
    for (int r = 0; r < 16; ++r) { const int rw = crow(r, hi), qq = 8 * w + (rw >> 2), hh = rw & 3;
        bf16* op = a.amix + ((size_t)b * T_ + q0 + qq) * DM + g * 256 + hh * 64 + i;
        op[0] = (bf16)f2bf(accw[r * 64 + lane]); op[32] = (bf16)f2bf(accw[(16 + r) * 64 + lane]); }
}
__device__ __forceinline__ void phase(const NsaArgs& a, unsigned* ctr, unsigned char* sm) {
    int* slot = (int*)(sm + OFF_UNIT);
    for (;;) {
        if (tidx() == 0) *slot = (int)atomicAdd(ctr, 1u);
        __syncthreads();
        const int u = *slot;
        __syncthreads();
        if (u >= 512) break;
        unit(a, u, sm);
    }
}
}

__device__ __forceinline__ void d_lora_prep(const bf16* pr, const float* mu, bf16* la, int wg0 = 0) {
    if ((int)blockIdx.x < wg0) return;
    const int T512 = tidx(), c = T512 & 255;
    const float m = mu[1536 + c];
    for (int vb = ((int)blockIdx.x - wg0) * 2 + (T512 >> 8); vb < M_ / 4; vb += ((int)gridDim.x - wg0) * 2) {
        const int row0 = vb * 4;
        float x[5];
        x[0] = (row0 % T_) ? bf2f(pr[(size_t)(row0 - 1) * 256 + c]) : 0.f;
#pragma unroll
        for (int j = 0; j < 4; ++j) x[j + 1] = bf2f(pr[(size_t)(row0 + j) * 256 + c]);
#pragma unroll
        for (int j = 0; j < 4; ++j) { const float xs = x[j + 1] + (x[j] - x[j + 1]) * m;
            const float v = c < 64 ? tanhf(xs) : (c < 128 ? xs : sigmoidf_(xs));
            la[(size_t)(row0 + j) * KLORA + c] = (bf16)f2bf(v); }
    }
}

namespace rw7 {
using nsa::f32x16; using nsa::crow; using nsa::pack8;
constexpr int NHELP = 2, RG = 18;
constexpr int NPROD = 6, RING = 7, RA = 144, RB = 40, S_AT = 0, S_RT = 16 * RA, S_BT = 32 * RA, S_KT = S_BT + 64 * RB, S_VT = S_KT + 64 * RB, S_SM = S_VT + 64 * RB, SMM = 16 * RB, S_GC = S_SM + 4 * SMM, SLOT = S_GC + 256;
constexpr int OFF_SCR = RING * SLOT, SCR = 32 * RA, LDS_NEED = OFF_SCR;
static_assert(NPROD % NHELP == 0 && LDS_NEED <= 147456 - 64 && 7 * (SLOT + SCR) <= 147456 - 64 && (size_t)16 * NHELP * RG * SLOT <= (size_t)9 << 20 && SLOT % 16 == 0 && S_BT % 16 == 0 && 128 * RB >= 4096 && SCR >= 4096, "rw7 lds map");
struct Args { const unsigned* rkw; const bf16* vv; const bf16* aga; const float* wdec; const float *mu, *kk, *ka, *rk; float* yraw; float* bonus; unsigned char* ring; unsigned* flags; unsigned* cons; };
__device__ __forceinline__ void wg_bar() { asm volatile("s_waitcnt lgkmcnt(0)" ::: "memory"); __builtin_amdgcn_s_barrier(); asm volatile("" ::: "memory"); }
struct Chan { float mur, muk, muv, kkc, kac, rkc; };
struct Raw { unsigned rk[16]; unsigned short v[16], al[16]; float w[16]; unsigned prk; unsigned short pv; };
__device__ __forceinline__ void fetch(const Args& a, int b, int h, int c, int lane, Raw& q) {
    const size_t base = ((size_t)b * T_ + (size_t)c * 16) * 512 + h * 64 + lane;
#pragma unroll
    for (int t = 0; t < 16; ++t) { q.rk[t] = a.rkw[base + (size_t)t * 512]; q.v[t] = a.vv[base + (size_t)t * 512]; q.al[t] = a.aga[base + (size_t)t * 512]; q.w[t] = a.wdec[base + (size_t)t * 512]; }
    q.prk = 0u; q.pv = 0;
    if (c > 0) { q.prk = a.rkw[base - 512]; q.pv = a.vv[base - 512]; }
}
__device__ __forceinline__ void st_row40(unsigned char* p, const unsigned (&w)[8]) {
    *(u32x2*)p = (u32x2){w[0], w[1]}; *(u32x2*)(p + 8) = (u32x2){w[2], w[3]}; *(u32x2*)(p + 16) = (u32x2){w[4], w[5]}; *(u32x2*)(p + 24) = (u32x2){w[6], w[7]};
}
template <bool BAR> __device__ __forceinline__ void seg_end() { if (BAR) wg_bar(); else { asm volatile("s_waitcnt lgkmcnt(0)" ::: "memory"); __builtin_amdgcn_sched_barrier(0); } }
template <bool BAR> __device__ __forceinline__ void produce(const Args& a, const Chan& ch, int b, int h, int c, const Raw& q, unsigned char* slot, unsigned char* scr, int lane) {
    const int i = lane & 31, hi = lane >> 5;
    const size_t row0 = (size_t)b * T_ + (size_t)c * 16;
    float pr_r = __builtin_bit_cast(float, q.prk << 16), pr_k = __builtin_bit_cast(float, q.prk & 0xffff0000u), pr_v = bf2f(q.pv);
    float rr[16], kq[16], kt[16];
    float* RED1 = (float*)scr;
    float* RED2 = (float*)(slot + S_BT);
#pragma unroll
    for (int t4 = 0; t4 < 4; ++t4) { f32x4 e1, e2;
#pragma unroll
        for (int e = 0; e < 4; ++e) { const int t = 4 * t4 + e;
            const float r0 = __builtin_bit_cast(float, q.rk[t] << 16), k0 = __builtin_bit_cast(float, q.rk[t] & 0xffff0000u), al = bf2f(q.al[t]);
            const float r = r0 + (pr_r - r0) * ch.mur, k = k0 + (pr_k - k0) * ch.muk;
            pr_r = r0; pr_k = k0;
            rr[t] = r; kq[t] = k * ch.kkc; kt[t] = k * (1.f + (al - 1.f) * ch.kac);
            e1[e] = kq[t] * kq[t]; e2[e] = r * kt[t] * ch.rkc; }
        *(f32x4*)(RED1 + lane * 16 + 4 * t4) = e1; *(f32x4*)(RED2 + lane * 16 + 4 * t4) = e2; }
    seg_end<BAR>();
    { const int t = lane & 15, part = lane >> 4; float s1 = 0.f, s2 = 0.f;
#pragma unroll
      for (int j = 0; j < 16; ++j) { s1 += RED1[(part * 16 + j) * 16 + t]; s2 += RED2[(part * 16 + j) * 16 + t]; }
      s1 += __shfl_xor(s1, 16); s2 += __shfl_xor(s2, 16); s1 += __shfl_xor(s1, 32); s2 += __shfl_xor(s2, 32);
      asm volatile("s_waitcnt lgkmcnt(0)" ::: "memory");
      if (lane < 16) { ((float*)(slot + S_GC))[lane] = s1; a.bonus[(row0 + lane) * 8 + h] = s2; } }
    asm volatile("s_waitcnt lgkmcnt(0)" ::: "memory");
    f32x4 n2[4];
#pragma unroll
    for (int t4 = 0; t4 < 4; ++t4) n2[t4] = *(const f32x4*)(slot + S_GC + 16 * t4);
    asm volatile("s_waitcnt lgkmcnt(0)" ::: "memory");
    float gam = 1.f;
    unsigned btp[8], ktp[8], vtp[8];
    float b_ev = 0.f, k_ev = 0.f, v_ev = 0.f;
#pragma unroll
    for (int t = 0; t < 16; ++t) {
        if (t == 6) seg_end<BAR>();
        const float v0 = bf2f(q.v[t]), al = bf2f(q.al[t]);
        const float v = v0 + (pr_v - v0) * ch.muv; pr_v = v0;
        const float kkn = kq[t] * __builtin_amdgcn_rsqf(fmaxf(n2[t >> 2][t & 3], 1e-24f));
        const float gp = gam; gam *= q.w[t]; const float ig = __builtin_amdgcn_rcpf(gam);
        const float bt_ = kkn * al * ig, kt_ = kt[t] * ig;
        const unsigned ar = pk2(-kkn * gp, rr[t] * gam), bk = pk2(bt_, kt_);
        *(bf16*)(slot + S_AT + t * RA + lane * 2) = (bf16)(ar & 0xffffu); *(bf16*)(slot + S_RT + t * RA + lane * 2) = (bf16)(ar >> 16);
        *(bf16*)(scr + t * RA + lane * 2) = (bf16)(bk & 0xffffu); *(bf16*)(scr + (16 + t) * RA + lane * 2) = (bf16)(bk >> 16);
        if (t & 1) { btp[t >> 1] = pk2(b_ev, bt_); ktp[t >> 1] = pk2(k_ev, kt_); vtp[t >> 1] = pk2(v_ev, v); }
        else { b_ev = bt_; k_ev = kt_; v_ev = v; }
    }
    st_row40(slot + S_BT + lane * RB, btp); st_row40(slot + S_KT + lane * RB, ktp); st_row40(slot + S_VT + lane * RB, vtp);
    ((float*)(slot + S_GC))[lane] = gam;
    seg_end<BAR>();
    f32x16 C;
#pragma unroll
    for (int r = 0; r < 16; ++r) C[r] = 0.f;
#pragma unroll
    for (int ks = 0; ks < 4; ++ks) {
        const bf16x8 af = *(const bf16x8*)(slot + S_AT + i * RA + (16 * ks + 8 * hi) * 2);
        const bf16x8 bf = *(const bf16x8*)(scr + i * RA + (16 * ks + 8 * hi) * 2);
        C = __builtin_amdgcn_mfma_f32_32x32x16_bf16(af, bf, C, 0, 0, 0);
    }
    asm volatile("s_waitcnt lgkmcnt(0)" ::: "memory");
    float* AAB = (float*)scr;
    unsigned char* SM = slot + S_SM;
#pragma unroll
    for (int r = 0; r < 16; ++r) {
        const int rho = crow(r, hi); const float val = C[r];
        if (r < 8) {
            if (i < 16) AAB[rho * 16 + i] = (i < rho) ? val : 0.f;
            else *(bf16*)(SM + SMM + rho * RB + (i - 16) * 2) = (bf16)f2bf((i - 16 < rho) ? val : 0.f);
        } else {
            const int tt = rho - 16;
            if (i < 16) *(bf16*)(SM + 2 * SMM + tt * RB + i * 2) = (bf16)f2bf((i <= tt) ? val : 0.f);
            else *(bf16*)(SM + 3 * SMM + tt * RB + (i - 16) * 2) = (bf16)f2bf((i - 16 <= tt) ? val : 0.f);
        }
    }
    seg_end<BAR>();
    { const int j = lane & 15; float Tr[16];
#pragma unroll
      for (int t = 0; t < 16; ++t) { if (t == 11) seg_end<BAR>();
          float acc = (t == j) ? 1.f : 0.f;
#pragma unroll
          for (int s4 = 0; s4 < (t + 3) / 4; ++s4) { const f32x4 ar = *(const f32x4*)(AAB + t * 16 + 4 * s4);
#pragma unroll
              for (int e = 0; e < 4; ++e) if (4 * s4 + e < t) acc += ar[e] * Tr[4 * s4 + e]; }
          Tr[t] = acc;
          if (lane < 16) *(bf16*)(SM + t * RB + j * 2) = (bf16)f2bf(acc); } }
    seg_end<BAR>();
}

__device__ __forceinline__ bf16x8 rd_perm(const unsigned char* p, int hi) {
    const u32x2 a = *(const u32x2*)(p + 8 * hi), b = *(const u32x2*)(p + 16 + 8 * hi);
    return __builtin_bit_cast(bf16x8, (u32x4){a.x, a.y, b.x, b.y});
}
__device__ __forceinline__ bf16x8 rd_nat(const unsigned char* p, int hi) {
    const u32x2 a = *(const u32x2*)(p + 16 * hi), b = *(const u32x2*)(p + 16 * hi + 8);
    return __builtin_bit_cast(bf16x8, (u32x4){a.x, a.y, b.x, b.y});
}
__device__ __forceinline__ bf16x8 and8(bf16x8 f, unsigned m) { u32x4 w = __builtin_bit_cast(u32x4, f); w.x &= m; w.y &= m; w.z &= m; w.w &= m; return __builtin_bit_cast(bf16x8, w); }
__device__ __forceinline__ void consume(const unsigned char* slot, f32x16 (&z)[2], float* yout, int vt, int lane) {
    const int i = lane & 31, hi = lane >> 5, i16 = i & 15;
    const unsigned m16 = i < 16 ? 0xffffffffu : 0u;
    const unsigned char* at = slot + S_AT + i16 * RA; const unsigned char* rt = slot + S_RT + i16 * RA; const unsigned char* sm16 = slot + S_SM + i16 * RB;
    bf16x8 fa0 = rd_perm(at, hi), fa1 = rd_perm(at + 32, hi), fa2 = rd_perm(at + 64, hi), fa3 = rd_perm(at + 96, hi);
    bf16x8 fak = rd_nat(sm16 + SMM, hi), ft = rd_perm(sm16, hi);
    const bf16x8 vtf = rd_nat(slot + S_VT + (32 * vt + i) * RB, hi);
    bf16x8 fr0 = rd_perm(rt, hi), fr1 = rd_perm(rt + 32, hi), fr2 = rd_perm(rt + 64, hi), fr3 = rd_perm(rt + 96, hi);
    bf16x8 frb = rd_perm(sm16 + 2 * SMM, hi), frk = rd_nat(sm16 + 3 * SMM, hi);
    const bf16x8 fk0 = rd_nat(slot + S_KT + i * RB, hi), fk1 = rd_nat(slot + S_KT + (32 + i) * RB, hi);
    const bf16x8 fb0 = rd_perm(slot + S_BT + i * RB, hi), fb1 = rd_perm(slot + S_BT + (32 + i) * RB, hi);
    f32x4 g4[2][4];
#pragma unroll
    for (int kt = 0; kt < 2; ++kt)
#pragma unroll
        for (int rg = 0; rg < 4; ++rg) g4[kt][rg] = *(const f32x4*)(slot + S_GC + (32 * kt + 8 * rg + 4 * hi) * 4);
    const bf16x8 zb0 = pack8(z[0], 0), zb1 = pack8(z[0], 8), zb2 = pack8(z[1], 0), zb3 = pack8(z[1], 8);
    fa0 = and8(fa0, m16); fa1 = and8(fa1, m16); fa2 = and8(fa2, m16); fa3 = and8(fa3, m16); fak = and8(fak, m16); ft = and8(ft, m16);
    fr0 = and8(fr0, m16); fr1 = and8(fr1, m16); fr2 = and8(fr2, m16); fr3 = and8(fr3, m16); frb = and8(frb, m16); frk = and8(frk, m16);
    f32x16 X, U, Y;
#pragma unroll
    for (int r = 0; r < 16; ++r) { X[r] = 0.f; U[r] = 0.f; Y[r] = 0.f; }
    X = __builtin_amdgcn_mfma_f32_32x32x16_bf16(fa0, zb0, X, 0, 0, 0);
    X = __builtin_amdgcn_mfma_f32_32x32x16_bf16(fa1, zb1, X, 0, 0, 0);
    X = __builtin_amdgcn_mfma_f32_32x32x16_bf16(fa2, zb2, X, 0, 0, 0);
    X = __builtin_amdgcn_mfma_f32_32x32x16_bf16(fa3, zb3, X, 0, 0, 0);
    X = __builtin_amdgcn_mfma_f32_32x32x16_bf16(fak, vtf, X, 0, 0, 0);
    Y = __builtin_amdgcn_mfma_f32_32x32x16_bf16(fr0, zb0, Y, 0, 0, 0);
    Y = __builtin_amdgcn_mfma_f32_32x32x16_bf16(fr1, zb1, Y, 0, 0, 0);
    Y = __builtin_amdgcn_mfma_f32_32x32x16_bf16(fr2, zb2, Y, 0, 0, 0);
    Y = __builtin_amdgcn_mfma_f32_32x32x16_bf16(fr3, zb3, Y, 0, 0, 0);
    Y = __builtin_amdgcn_mfma_f32_32x32x16_bf16(frk, vtf, Y, 0, 0, 0);
    z[0] = __builtin_amdgcn_mfma_f32_32x32x16_bf16(fk0, vtf, z[0], 0, 0, 0);
    z[1] = __builtin_amdgcn_mfma_f32_32x32x16_bf16(fk1, vtf, z[1], 0, 0, 0);
    const bf16x8 xb = pack8(X, 0);
    U = __builtin_amdgcn_mfma_f32_32x32x16_bf16(ft, xb, U, 0, 0, 0);
    const bf16x8 ub = pack8(U, 0);
    z[0] = __builtin_amdgcn_mfma_f32_32x32x16_bf16(fb0, ub, z[0], 0, 0, 0);
    z[1] = __builtin_amdgcn_mfma_f32_32x32x16_bf16(fb1, ub, z[1], 0, 0, 0);
    Y = __builtin_amdgcn_mfma_f32_32x32x16_bf16(frb, ub, Y, 0, 0, 0);
#pragma unroll
    for (int kt = 0; kt < 2; ++kt)
#pragma unroll
        for (int rg = 0; rg < 4; ++rg)
#pragma unroll
            for (int e = 0; e < 4; ++e) z[kt][4 * rg + e] *= g4[kt][rg][e];
#pragma unroll
    for (int r = 0; r < 8; ++r) yout[(size_t)crow(r, hi) * 512] = Y[r];
}

__device__ __forceinline__ unsigned ld_relaxed(const unsigned* p) { return __hip_atomic_load(p, __ATOMIC_RELAXED, __HIP_MEMORY_SCOPE_AGENT); }
__device__ __forceinline__ void head(const Args& a, int bh, unsigned char* sm) {
    const int tid = tidx(), lane = tid & 63, w = __builtin_amdgcn_readfirstlane(tid >> 6);
    const int b = bh >> 3, h = bh & 7;
    constexpr int NCH = T_ / 16, NBAR = NCH + NPROD;
    if (w < 2) {
        f32x16 z[2];
#pragma unroll
        for (int r = 0; r < 16; ++r) { z[0][r] = 0.f; z[1][r] = 0.f; }
        for (int i = 0; i < NPROD; ++i) wg_bar();
        for (int c = 0; c < NCH; ++c) {
            consume(sm + (size_t)(c % RING) * SLOT, z, a.yraw + ((size_t)b * T_ + (size_t)c * 16) * 512 + h * 64 + 32 * w + (lane & 31), w, lane);
            if (w == 0 && (c & 7) == 7 && lane == 0) __hip_atomic_store(a.cons + bh * 64, (unsigned)(c + 1), __ATOMIC_RELAXED, __HIP_MEMORY_SCOPE_AGENT);
            wg_bar();
        }
    } else {
        const int pw = w - 2;
        int nb = pw;
        {
            u32x4 v[15];
            { const int c = pw; const int hl = c % NHELP, n = c / NHELP;
              const unsigned char* g = a.ring + ((size_t)(bh * NHELP + hl) * RG + (n % RG)) * SLOT;
              while (__builtin_amdgcn_readfirstlane(ld_relaxed(a.flags + bh * NCH + c)) == 0u) __builtin_amdgcn_s_sleep(2);
              __builtin_amdgcn_fence(__ATOMIC_ACQUIRE, "agent");
              asm volatile("s_waitcnt vmcnt(0)" ::: "memory");
#pragma unroll
              for (int i = 0; i < 15; ++i) { const int off = (i * 64 + lane) * 16; if (off < SLOT) v[i] = *(const u32x4*)(g + off); } }
            for (int i = 0; i < pw; ++i) wg_bar();
            for (int c = pw; c < NCH; c += NPROD) {
                unsigned char* slot = sm + (size_t)(c % RING) * SLOT;
#pragma unroll
                for (int i = 0; i < 15; ++i) { const int off = (i * 64 + lane) * 16; if (off < SLOT) *(u32x4*)(slot + off) = v[i]; }
                const int cn = c + NPROD; const bool more = cn < NCH;
                const unsigned* fp = a.flags + bh * NCH + (more ? cn : c);
                unsigned fl = ld_relaxed(fp);
                wg_bar(); wg_bar();
                if (more) {
                    while (__builtin_amdgcn_readfirstlane(fl) == 0u) { __builtin_amdgcn_s_sleep(2); fl = ld_relaxed(fp); }
                    __builtin_amdgcn_fence(__ATOMIC_ACQUIRE, "agent");
                    asm volatile("s_waitcnt vmcnt(0)" ::: "memory");
                    const int hl = cn % NHELP, n = cn / NHELP;
                    const unsigned char* g = a.ring + ((size_t)(bh * NHELP + hl) * RG + (n % RG)) * SLOT;
#pragma unroll
                    for (int i = 0; i < 15; ++i) { const int off = (i * 64 + lane) * 16; if (off < SLOT) v[i] = *(const u32x4*)(g + off); }
                }
                wg_bar(); wg_bar(); wg_bar(); wg_bar();
                nb += NPROD;
            }
        }
        for (; nb < NBAR; ++nb) wg_bar();
    }
}
constexpr int NHW = 7;
__device__ __forceinline__ void helper(const Args& a, int bh, int hl, unsigned char* sm) {
    const int tid = tidx(), lane = tid & 63, w = __builtin_amdgcn_readfirstlane(tid >> 6);
    if (w >= NHW) return;
    const int b = bh >> 3, h = bh & 7, col = h * 64 + lane;
    constexpr int NCH = T_ / 16;
    unsigned char* slot = sm + (size_t)w * SLOT; unsigned char* scr = sm + NHW * SLOT + w * SCR;
    const Chan ch{a.mu[col], a.mu[512 + col], a.mu[1024 + col], a.kk[col], a.ka[col], a.rk[col]};
    int n = w, c = NHELP * n + hl;
    if (c >= NCH) return;
    for (; c < NCH; n += NHW, c += NHW * NHELP) {
        Raw q; fetch(a, b, h, c, lane, q);
        if (n >= RG) { const unsigned need = (unsigned)(c - RG * NHELP + 1);
            while (__builtin_amdgcn_readfirstlane(ld_relaxed(a.cons + bh * 64)) < need) __builtin_amdgcn_s_sleep(8); }
        produce<false>(a, ch, b, h, c, q, slot, scr, lane);
        asm volatile("s_waitcnt lgkmcnt(0)" ::: "memory");
        unsigned char* g = a.ring + ((size_t)(bh * NHELP + hl) * RG + (n % RG)) * SLOT;
#pragma unroll
        for (int i = 0; i < 15; ++i) { const int off = (i * 64 + lane) * 16;
            if (off < SLOT) { const u32x4 d = *(const u32x4*)(slot + off); unsigned char* gp = g + off; asm volatile("global_store_dwordx4 %0, %1, off sc1\n\ts_nop 1" :: "v"(gp), "v"(d) : "memory"); } }
        asm volatile("s_waitcnt vmcnt(0)" ::: "memory");
        if (lane == 0) __hip_atomic_store(a.flags + bh * NCH + c, 1u, __ATOMIC_RELAXED, __HIP_MEMORY_SCOPE_AGENT);
    }
}
__device__ __forceinline__ void finish(const float* yraw, const float* bonus, const bf16* vv, const bf16* agg, const float* mu, const float* gng, const float* gnb, bf16* amix) {
    const int T512 = tidx(), lane = T512 & 63;
    for (int row = blockIdx.x * 8 + (T512 >> 6); row < M_; row += gridDim.x * 8) {
        const int t = row % T_;
        float y[8], v0[8], v1[8], gg[8], bo[8];
#pragma unroll
        for (int j = 0; j < 8; ++j) { const int col = j * 64 + lane;
            y[j] = yraw[(size_t)row * 512 + col]; v0[j] = bf2f(vv[(size_t)row * 512 + col]); v1[j] = t ? bf2f(vv[(size_t)(row - 1) * 512 + col]) : 0.f;
            gg[j] = bf2f(agg[(size_t)row * 512 + col]); bo[j] = bonus[(size_t)row * 8 + j]; }
        float mean[8], var[8];
#pragma unroll
        for (int j = 0; j < 8; ++j) mean[j] = y[j];
#pragma unroll
        for (int o = 1; o < 64; o <<= 1) {
#pragma unroll
            for (int j = 0; j < 8; ++j) mean[j] += __shfl_xor(mean[j], o); }
#pragma unroll
        for (int j = 0; j < 8; ++j) { mean[j] *= (1.f / 64.f); y[j] -= mean[j]; var[j] = y[j] * y[j]; }
#pragma unroll
        for (int o = 1; o < 64; o <<= 1) {
#pragma unroll
            for (int j = 0; j < 8; ++j) var[j] += __shfl_xor(var[j], o); }
#pragma unroll
        for (int j = 0; j < 8; ++j) { const int col = j * 64 + lane;
            const float yn = y[j] * rsqrtf(var[j] * (1.f / 64.f) + 64e-5f) * gng[col] + gnb[col];
            const float v = v0[j] + (v1[j] - v0[j]) * mu[1024 + col];
            amix[(size_t)row * DM + 512 + col] = (bf16)f2bf((yn + bo[j] * v) * gg[j]); }
    }
}
}

namespace mema {
using nsa::f32x16; using nsa::KROW; using nsa::VROW; using nsa::KBUF; using nsa::VBUF; using nsa::OFF_K; using nsa::OFF_V; using nsa::OFF_WS; using nsa::crow; using nsa::pack8;
__device__ __forceinline__ void unit(const bf16* qm, const bf16* mk, const bf16* mvt, bf16* om, int u, unsigned char* sm) {
    const int tid = tidx(), lane = tid & 63, w = __builtin_amdgcn_readfirstlane(tid >> 6), i = lane & 31, hi = lane >> 5;
    const int b = u >> 7, h = (u >> 5) & 3, rb = u & 31;
    const int row0 = b * T_ + rb * 256 + 32 * w;
    const bf16* qrow = qm + (size_t)(row0 + i) * DM + h * 256 + 8 * hi;
    const bf16* kbase = mk + (size_t)(b * 256 + (tid >> 3)) * DM + h * 256 + (tid & 7) * 8;
    const bf16* vbase = mvt + (size_t)(h * 256 + (tid >> 3)) * 512 + b * 256 + (tid & 7) * 8;
    unsigned char* kst = sm + OFF_K + (tid >> 3) * KROW + (tid & 7) * 16;
    unsigned char* vst = sm + OFF_V + (tid >> 3) * VROW + (tid & 7) * 16;
    float* wsc = (float*)(sm + OFF_WS) + w * 32;
    f32x16 p[4][2];
#pragma unroll
    for (int kt = 0; kt < 4; ++kt)
#pragma unroll
        for (int r = 0; r < 16; ++r) { p[kt][0][r] = 0.f; p[kt][1][r] = 0.f; }
    u32x4 tr[4];
#define MEMA_SRC(n) ((n) < 16 ? (const u32x4*)(kbase + (size_t)(64 * ((n) & 3)) * DM + 64 * ((n) >> 2)) : (const u32x4*)(vbase + (size_t)(64 * (((n) - 16) >> 2)) * 512 + 64 * ((n) & 3)))
#define MEMA_PUT(n) do { if ((n) < 16) *(u32x4*)(kst + ((n) & 1) * KBUF) = tr[(n) & 3]; else { unsigned char* vp2_ = vst + ((n) & 1) * VBUF; *(u32x2*)vp2_ = (u32x2){tr[(n) & 3].x, tr[(n) & 3].y}; *(u32x2*)(vp2_ + 8) = (u32x2){tr[(n) & 3].z, tr[(n) & 3].w}; } } while (0)
    tr[0] = *MEMA_SRC(0); tr[1] = *MEMA_SRC(1); tr[2] = *MEMA_SRC(2);
    MEMA_PUT(0);
    __syncthreads();
    bf16x8 qf[4];
#pragma unroll
    for (int n = 0; n < 16; ++n) {
        const int dc = n >> 2, kt = n & 3, cb = n & 1;
        tr[(n + 3) & 3] = *MEMA_SRC(n + 3);
        if (kt == 0) {
#pragma unroll
            for (int d0 = 0; d0 < 4; ++d0) qf[d0] = *(const bf16x8*)(qrow + 64 * dc + 16 * d0);
        }
        const unsigned char* kb = sm + OFF_K + cb * KBUF;
#pragma unroll
        for (int d0 = 0; d0 < 4; ++d0) {
            const bf16x8 a0 = *(const bf16x8*)(kb + i * KROW + (16 * d0 + 8 * hi) * 2);
            const bf16x8 a1 = *(const bf16x8*)(kb + (32 + i) * KROW + (16 * d0 + 8 * hi) * 2);
            p[kt][0] = __builtin_amdgcn_mfma_f32_32x32x16_bf16(a0, qf[d0], p[kt][0], 0, 0, 0);
            p[kt][1] = __builtin_amdgcn_mfma_f32_32x32x16_bf16(a1, qf[d0], p[kt][1], 0, 0, 0);
        }
        MEMA_PUT(n + 1);
        __syncthreads();
    }
    float mx = p[0][0][0];
#pragma unroll
    for (int kt = 0; kt < 4; ++kt)
#pragma unroll
        for (int r = 0; r < 16; ++r) mx = fmaxf(mx, fmaxf(p[kt][0][r], p[kt][1][r]));
    mx = fmaxf(mx, __shfl_xor(mx, 32));
    float l = 0.f;
#pragma unroll
    for (int kt = 0; kt < 4; ++kt)
#pragma unroll
        for (int r = 0; r < 16; ++r) { p[kt][0][r] = __builtin_amdgcn_exp2f(p[kt][0][r] - mx); p[kt][1][r] = __builtin_amdgcn_exp2f(p[kt][1][r] - mx); l += p[kt][0][r] + p[kt][1][r]; }
    l += __shfl_xor(l, 32);
    bf16x8 pf[4][4];
#pragma unroll
    for (int kt = 0; kt < 4; ++kt) { pf[kt][0] = pack8(p[kt][0], 0); pf[kt][1] = pack8(p[kt][0], 8); pf[kt][2] = pack8(p[kt][1], 0); pf[kt][3] = pack8(p[kt][1], 8); }
    if (hi == 0) wsc[i] = 1.f / l;
    asm volatile("" ::: "memory");
    f32x4 il[4];
#pragma unroll
    for (int rg = 0; rg < 4; ++rg) il[rg] = *(const f32x4*)(wsc + 8 * rg + 4 * hi);
    f32x16 o[2];
#pragma unroll
    for (int n = 16; n < 32; ++n) {
        const int dvt = (n - 16) >> 2, kt = n & 3, cb = n & 1;
        if (n + 3 < 32) tr[(n + 3) & 3] = *MEMA_SRC(n + 3);
        if (kt == 0) {
#pragma unroll
            for (int r = 0; r < 16; ++r) { o[0][r] = 0.f; o[1][r] = 0.f; }
        }
        const unsigned char* vb = sm + OFF_V + cb * VBUF;
#pragma unroll
        for (int dt = 0; dt < 2; ++dt) {
            const unsigned char* vp = vb + (32 * dt + i) * VROW + 8 * hi;
#pragma unroll
            for (int ks = 0; ks < 4; ++ks) {
                const u32x2 v_lo = *(const u32x2*)(vp + 32 * ks), v_hi = *(const u32x2*)(vp + 32 * ks + 16);
                const bf16x8 vf = __builtin_bit_cast(bf16x8, (u32x4){v_lo.x, v_lo.y, v_hi.x, v_hi.y});
                o[dt] = __builtin_amdgcn_mfma_f32_32x32x16_bf16(pf[kt][ks], vf, o[dt], 0, 0, 0);
            }
        }
        if (kt == 3) {
#pragma unroll
            for (int r = 0; r < 16; ++r) { bf16* op = om + (size_t)(row0 + crow(r, hi)) * DM + h * 256 + 64 * dvt + i;
                op[0] = (bf16)f2bf(o[0][r] * il[r >> 2][r & 3]); op[32] = (bf16)f2bf(o[1][r] * il[r >> 2][r & 3]); }
        }
        if (n + 1 < 32) MEMA_PUT(n + 1);
        __syncthreads();
    }
#undef MEMA_SRC
#undef MEMA_PUT
}
}

#define LAS __attribute__((address_space(3)))
#define XB_TMO      128
#define XB_XCNT(j)  (256  + 64 * (j))
#define XB_XSUB(j)  (1280 + 64 * (j))
#define XB_XGEN(j)  (2304 + 64 * (j))
#define XB_TOP      3328
#define XB_TOPGEN   3392
#define XCD_BAR_WORDS 3456
#define XB_SPIN_CAP (1u << 18)

__device__ __forceinline__ unsigned xb_ld(unsigned* p)              { return __hip_atomic_load(p, __ATOMIC_RELAXED, __HIP_MEMORY_SCOPE_AGENT); }
__device__ __forceinline__ unsigned xb_add(unsigned* p, unsigned v) { return __hip_atomic_fetch_add(p, v, __ATOMIC_RELAXED, __HIP_MEMORY_SCOPE_AGENT); }
__device__ __forceinline__ unsigned xb_xcc_id() { return (unsigned)__builtin_amdgcn_s_getreg((3 << 11) | 20) & 0xFu; }
#define XB_SPIN(cond, bar) do { unsigned _sp = 0; while (cond) { __builtin_amdgcn_s_sleep(1); \
    if ((++_sp & 255u) == 0u) { if (xb_ld(&(bar)[XB_TMO])) break; if (_sp > XB_SPIN_CAP) { atomicAdd(&(bar)[XB_TMO], 1u); break; } } } } while (0)

struct XcdBarrier {
    unsigned* bar; unsigned x;
    volatile LAS unsigned* st;
};

__device__ __forceinline__ XcdBarrier xcd_barrier_post(unsigned* bar, volatile LAS unsigned* st) {
    XcdBarrier b; b.bar = bar; b.x = xb_xcc_id(); b.st = st;
    if (tidx() == 0) (void)xb_add(&bar[XB_XCNT(b.x)], 1u);
    return b;
}
__device__ __forceinline__ void xcd_barrier_complete(unsigned* bar, unsigned x, unsigned& nloc, unsigned& nx) {
    const unsigned G = gridDim.x * gridDim.y * gridDim.z;
    unsigned sum, cnt, mine, sp = 0u;
    for (;;) {
        sum = 0u; cnt = 0u; mine = 0u;
#pragma unroll
        for (unsigned j = 0; j < 16; ++j) { const unsigned c = xb_ld(&bar[XB_XCNT(j)]); sum += c; cnt += (c > 0u) ? 1u : 0u; mine = (j == x) ? c : mine; }
        if (sum == G) break;
        __builtin_amdgcn_s_sleep(1);
        if ((++sp & 255u) == 0u) { if (xb_ld(&bar[XB_TMO])) break; if (sp > XB_SPIN_CAP) { atomicAdd(&bar[XB_TMO], 1u); break; } }
    }
    nloc = mine > 0u ? mine : 1u; nx = cnt > 0u ? cnt : 1u;
}

__device__ __forceinline__ void xcd_barrier(const XcdBarrier& b) {
    asm volatile("s_waitcnt vmcnt(0)" ::: "memory");
    __syncthreads();
    if (tidx() == 0) {
        unsigned* bar = b.bar;
        __builtin_amdgcn_s_waitcnt(0);
        unsigned nloc = b.st[0], nx = b.st[1];
        if (nloc == 0u) { xcd_barrier_complete(bar, b.x, nloc, nx); b.st[0] = nloc; b.st[1] = nx; }
        const unsigned old = xb_add(&bar[XB_XSUB(b.x)], 1u);
        const unsigned gen = old / nloc;
        if (old + 1u == (gen + 1u) * nloc) {
            __builtin_amdgcn_fence(__ATOMIC_RELEASE, "agent");
            asm volatile("s_waitcnt vmcnt(0)" ::: "memory");
            const unsigned og = xb_add(&bar[XB_TOP], 1u);
            const unsigned tg = og / nx;
            if (og + 1u == (tg + 1u) * nx) xb_add(&bar[XB_TOPGEN], 1u);
            else XB_SPIN(xb_ld(&bar[XB_TOPGEN]) == tg, bar);
            __builtin_amdgcn_fence(__ATOMIC_ACQUIRE, "agent");
            xb_add(&bar[XB_XGEN(b.x)], 1u);
            asm volatile("s_waitcnt vmcnt(0)" ::: "memory");
        } else {
            XB_SPIN(xb_ld(&bar[XB_XGEN(b.x)]) == gen, bar);
            __builtin_amdgcn_fence(__ATOMIC_ACQUIRE, "agent");
            asm volatile("s_waitcnt vmcnt(0)" ::: "memory");
        }
    }
    __syncthreads();
}

constexpr int NTHREADS = 512, LDS_BYTES = 147456;
struct MegaArgs { const float* in[41]; float* out; unsigned char* ws; };
#define WSB(off) ((bf16*)(ws + (off)))
#define WSF(off) ((float*)(ws + (off)))

__global__ void __launch_bounds__(NTHREADS) mega_fwd(MegaArgs A) {
    extern __shared__ __attribute__((aligned(16))) unsigned char lds[];
    cg::grid_group grid = cg::this_grid();
    const float* const* in = A.in; unsigned char* ws = A.ws; float* out = A.out;
    if (tidx() < 2) ((volatile LAS unsigned*)(lds + LDS_BYTES - 64))[tidx()] = 0u;
    __syncthreads();
    const XcdBarrier xbar = xcd_barrier_post((unsigned*)(ws + WS_CTL) + 16384, (volatile LAS unsigned*)(lds + LDS_BYTES - 64));

    d_convert(WSB(WS_W1GU), NGU, DM, MapGU{in[I_F1_WG], in[I_F1_WU], FF});
    d_convert(WSB(WS_WIN), NWIN, DM, MapWin{in[I_WIN], IN_COLS});
    d_convert(WSB(WS_CW1K), 256, 2048, MapPlain{in[I_W1_K], 256});
    d_convert(WSB(WS_CW1V), 256, 2048, MapPlain{in[I_W1_V], 256});
    d_convert_lora(WSB(WS_WLORA), in[I_W2], in[I_A2], in[I_G2]);
    d_convert(WSB(WS_WK), DM, DM, MapPlain{in[I_WK], DM});
    d_convert(WSB(WS_WV), DM, DM, MapPlain{in[I_WV], DM});
    d_convert(WSB(WS_CW2), 64, 256, MapPlain{in[I_W2_K], 64});
    d_convert(WSB(WS_CW2) + 64 * 256, 64, 256, MapPlain{in[I_W2_V], 64});
    d_rope_table(WSF(WS_ROPE));
    d_cmp_bias(in[I_PE_K], in[I_W1_K], in[I_PE_V], in[I_W1_V], WSF(WS_CBIAS), (float*)lds);
    d_rownorm(in[I_X], in[I_F1_PRE], WSB(WS_XN), M_);
    d_rownorm(in[I_MEM], in[I_MEM_KVG], WSB(WS_MEMN), 512);
    grid.sync();
    gemm_pg8(lds, WSB(WS_XN), DM, WSB(WS_W1GU), DM, M_, NGU, DM, EpiSwiGLU{WSB(WS_HB)});
    d_convert(WSB(WS_W1D), DM, FF, MapPlain{in[I_F1_WD], DM}, 128);
    xcd_barrier(xbar);
    gemm_norm_res<false, true>(lds, WSB(WS_HB), FF, WSB(WS_W1D), FF, in[I_X], out, WSB(WS_XN), in[I_F1_POST], in[I_MIX_PRE], 0.5f, (unsigned*)(ws + WS_GATES), (unsigned*)(ws + WS_CTL) + 1024 + 0 * 2048);
    xcd_barrier(xbar);
    gemm_pg8(lds, WSB(WS_XN), DM, WSB(WS_WIN), DM, M_, 3072, DM,
             EpiWin{WSB(WS_QB), WSB(WS_KS), WSB(WS_KW), WSB(WS_KCR), WSB(WS_VCR), WSB(WS_VST), WSB(WS_VWT), (unsigned*)(ws + WS_RKVA), WSB(WS_RKVA + 32 * MiB), WSB(WS_PRL), WSF(WS_GATES), WSF(WS_ROPE)});
    d_gates(WSB(WS_XN), WSB(WS_WIN) + (size_t)3072 * DM, WSF(WS_GATES), (float*)lds);
    if (blockIdx.x == 0) { const int t_ = tidx(); float b_ = 0.f; for (int jc = 0; jc < 8; ++jc) b_ += WSF(WS_CBIAS)[jc * 512 + t_]; WSF(WS_CBIAS)[4096 + t_] = b_; }
    xcd_barrier(xbar);
    { float* part = (float*)(ws + WS_XN + 8 * MiB);
      gemm_pg8(lds, WSB(WS_KCR), 1024, WSB(WS_CW1K), 2048, 2048, 256, 1024, EpiStoreF32{part, 256}, 0);
      gemm_pg8(lds, WSB(WS_KCR) + 1024, 1024, WSB(WS_CW1K) + 1024, 2048, 2048, 256, 1024, EpiStoreF32{part + (size_t)2048 * 256, 256}, 8);
      gemm_pg8(lds, WSB(WS_VCR), 1024, WSB(WS_CW1V), 2048, 2048, 256, 1024, EpiStoreF32{part + (size_t)2 * 2048 * 256, 256}, 48);
      gemm_pg8(lds, WSB(WS_VCR) + 1024, 1024, WSB(WS_CW1V) + 1024, 2048, 2048, 256, 1024, EpiStoreF32{part + (size_t)3 * 2048 * 256, 256}, 24); }
    gemm_pg8(lds, WSB(WS_MEMN), DM, WSB(WS_WK), DM, 512, DM, DM, EpiStore{WSB(WS_HIDK), DM, 1.f}, 32);
    gemm_pg8(lds, WSB(WS_WV), DM, WSB(WS_MEMN), DM, DM, 512, DM, EpiStore{WSB(WS_HIDV), 512, 1.f}, 40);
    d_lora_prep(WSB(WS_PRL), in[I_MU], WSB(WS_XN), 48);
    d_convert(WSB(WS_W2GU), NGU, DM, MapGU{in[I_F2_WG], in[I_F2_WU], FF}, 48);
    d_convert(WSB(WS_W2D), DM, FF, MapPlain{in[I_F2_WD], DM}, 48);
    d_convert(WSB(WS_WOUT), DM, DM, MapPlain{in[I_WOUT], DM}, 48);
    d_convert(WSB(WS_WQ), DM, DM, MapPlain{in[I_WQ], DM}, 48);
    d_convert(WSB(WS_WO), DM, DM, MapPlain{in[I_WO], DM}, 48);
    xcd_barrier(xbar);
    d_cmp2((const float*)(ws + WS_XN + 8 * MiB), WSF(WS_CBIAS) + 4096, WSB(WS_CW2), WSF(WS_ROPE), WSB(WS_KC), WSB(WS_VCT));
    gemm_pg8(lds, WSB(WS_XN), KLORA, WSB(WS_WLORA), KLORA, M_, NLORA, KLORA, EpiLora{WSF(WS_YB), WSB(WS_RKVA + 48 * MiB), WSB(WS_AGG), in[I_W0], in[I_A0]});
    xcd_barrier(xbar);
    if (blockIdx.x < 16 * (1 + rw7::NHELP)) {
        const rw7::Args ra{(const unsigned*)(ws + WS_RKVA), WSB(WS_RKVA + 32 * MiB), WSB(WS_RKVA + 48 * MiB), WSF(WS_YB), in[I_MU], in[I_KK], in[I_KA], in[I_RK], WSF(WS_YB), WSF(WS_BONUS),
                           ws + WS_KCR + 1 * MiB, (unsigned*)(ws + WS_CTL) + 32768, (unsigned*)(ws + WS_CTL) + 24576};
        if (blockIdx.x < 16) rw7::head(ra, blockIdx.x, lds);
        else rw7::helper(ra, (blockIdx.x - 16) % 16, (blockIdx.x - 16) / 16, lds);
        __syncthreads();
    }
    {
        const NsaArgs na{WSB(WS_QB), WSB(WS_KC), WSB(WS_VCT), WSB(WS_KS), WSB(WS_VST), WSB(WS_KW), WSB(WS_VWT), WSF(WS_GATES), WSB(WS_XN)};
        nsa::phase(na, (unsigned*)(ws + WS_CTL), lds);
    }
    xcd_barrier(xbar);
    d_nsa_outnorm(WSB(WS_XN), in[I_NSA_G]);
    rw7::finish(WSF(WS_YB), WSF(WS_BONUS), WSB(WS_RKVA + 32 * MiB), WSB(WS_AGG), in[I_MU], in[I_GNG], in[I_GNB], WSB(WS_XN));
    xcd_barrier(xbar);
    gemm_norm_res<true, true>(lds, WSB(WS_XN), DM, WSB(WS_WOUT), DM, out, WSB(WS_YB), WSB(WS_XN), in[I_MIX_POST], in[I_MEM_PRE], 1.0f, (unsigned*)(ws + WS_GATES), (unsigned*)(ws + WS_CTL) + 1024 + 1 * 2048);
    xcd_barrier(xbar);
    gemm_pg8(lds, WSB(WS_XN), DM, WSB(WS_WQ), DM, M_, DM, DM, EpiStore{WSB(WS_QM), DM, MSCALE});
    xcd_barrier(xbar);
    if (blockIdx.x < 256) mema::unit(WSB(WS_QM), WSB(WS_HIDK), WSB(WS_HIDV), WSB(WS_OM), (int)blockIdx.x, lds);
    xcd_barrier(xbar);
    gemm_norm_res<true, true>(lds, WSB(WS_OM), DM, WSB(WS_WO), DM, WSB(WS_YB), WSB(WS_YB), WSB(WS_XN), in[I_MEM_POST], in[I_F2_PRE], 1.0f, (unsigned*)(ws + WS_GATES), (unsigned*)(ws + WS_CTL) + 1024 + 2 * 2048);
    xcd_barrier(xbar);
    gemm_pg8(lds, WSB(WS_XN), DM, WSB(WS_W2GU), DM, M_, NGU, DM, EpiSwiGLU{WSB(WS_HB)});
    xcd_barrier(xbar);
    gemm_norm_res<true, false>(lds, WSB(WS_HB), FF, WSB(WS_W2D), FF, WSB(WS_YB), out, (bf16*)nullptr, in[I_F2_POST], (const float*)nullptr, 0.5f, (unsigned*)(ws + WS_GATES), (unsigned*)(ws + WS_CTL) + 1024 + 3 * 2048);
}

extern "C" void kernel_launch(void* const* d_in, const int* in_sizes, int n_in, void* d_out, int out_size, void* d_ws, size_t ws_size, hipStream_t stream) {
    static int grid = 0;
    if (grid == 0) {
        if (n_in != 41 || ws_size < WS_END) { fprintf(stderr, "kernel_launch: unexpected n_in %d / ws %zu\n", n_in, ws_size); grid = -1; return; }
        int dev = 0, cus = 0, per_cu = 0;
        hipGetDevice(&dev); hipDeviceGetAttribute(&cus, hipDeviceAttributeMultiprocessorCount, dev);
        if (hipFuncSetAttribute((const void*)mega_fwd, hipFuncAttributeMaxDynamicSharedMemorySize, LDS_BYTES) != hipSuccess) { fprintf(stderr, "kernel_launch: hipFuncSetAttribute failed\n"); grid = -1; return; }
        if (hipOccupancyMaxActiveBlocksPerMultiprocessor(&per_cu, (const void*)mega_fwd, NTHREADS, LDS_BYTES) != hipSuccess || per_cu < 1) { fprintf(stderr, "kernel_launch: occupancy query says %d\n", per_cu); grid = -1; (void)hipGetLastError(); return; }
        grid = cus;
        if (grid != 256) { fprintf(stderr, "kernel_launch: built for 256 CUs (one 256x256 tile per workgroup in the fused norm epilogues), found %d\n", cus); grid = -1; return; }
    }
    if (grid < 0) return;
    MegaArgs a{};
    for (int i = 0; i < 41; ++i) a.in[i] = (const float*)d_in[i];
    a.out = (float*)d_out; a.ws = (unsigned char*)d_ws;
    hipMemsetAsync(d_ws, 0, 196608, stream);
    void* args[] = {&a};
    hipError_t e = hipLaunchCooperativeKernel((const void*)mega_fwd, dim3(grid), dim3(NTHREADS), args, LDS_BYTES, stream);
    if (e != hipSuccess) fprintf(stderr, "kernel_launch: cooperative launch failed: %s (grid %d)\n", hipGetErrorString(e), grid);
}
```

```cpp
#include <hip/hip_runtime.h>
#include <hip/hip_cooperative_groups.h>
#include <cstdint>
#include <cstdio>

constexpr int NB = 2, T_ = 8192, DM = 1024, M_ = NB * T_;
constexpr int FF = 2816, NGU = 2 * FF;
constexpr int IN_COLS = 3096, NWIN = 3328;
constexpr int NRW = 1792;
constexpr int NCP = 512;
constexpr int NLORA = 1536, KLORA = 256;
constexpr float NORM_EPS = 1e-6f;
constexpr float QSCALE = 0.125f * 1.4426950408889634f;
constexpr float MSCALE = 0.0625f * 1.4426950408889634f;

typedef unsigned short bf16;
typedef short bf16x8 __attribute__((ext_vector_type(8)));
typedef float f32x4 __attribute__((ext_vector_type(4)));
typedef unsigned u32x2 __attribute__((ext_vector_type(2)));
typedef unsigned u32x4 __attribute__((ext_vector_type(4)));

__device__ __forceinline__ unsigned f2bf(float f) { unsigned u = __builtin_bit_cast(unsigned, f); return (u + 0x7fffu + ((u >> 16) & 1u)) >> 16; }
__device__ __forceinline__ float bf2f(bf16 h) { return __builtin_bit_cast(float, (unsigned)h << 16); }
typedef float f32x2_t __attribute__((ext_vector_type(2))); typedef __bf16 bf16x2_t __attribute__((ext_vector_type(2)));
__device__ __forceinline__ unsigned pk2(float lo, float hi) { const f32x2_t v = {lo, hi}; return __builtin_bit_cast(unsigned, __builtin_convertvector(v, bf16x2_t)); }
__device__ __forceinline__ void st_bf4(bf16* p, f32x4 v) { u32x2 w; w.x = pk2(v[0], v[1]); w.y = pk2(v[2], v[3]); *(u32x2*)p = w; }
__device__ __forceinline__ float wave_sum(float v) {
#pragma unroll
    for (int o = 1; o < 64; o <<= 1) v += __shfl_xor(v, o);
    return v;
}
__device__ __forceinline__ float wave_max(float v) {
#pragma unroll
    for (int o = 1; o < 64; o <<= 1) v = fmaxf(v, __shfl_xor(v, o));
    return v;
}
__device__ __forceinline__ float sigmoidf_(float x) { return 1.f / (1.f + __expf(-x)); }
__device__ __forceinline__ int tidx() { int t = threadIdx.x; asm volatile("" : "+v"(t)); return t; }

constexpr size_t MiB = 1u << 20, KiB64 = 65536;
constexpr size_t WS_CTL = 0;
constexpr size_t WS_KC = 256 * 1024;
constexpr size_t WS_VCT = 512 * 1024;
constexpr size_t WS_CW2 = 768 * 1024;
constexpr size_t WS_W1GU = 1 * MiB;
constexpr size_t WS_W1D = 12 * MiB;
constexpr size_t WS_W2GU = WS_W1D + 88 * KiB64;
constexpr size_t WS_W2D = WS_W2GU + 11 * MiB;
constexpr size_t WS_WIN = WS_W2D + 88 * KiB64;
constexpr size_t WS_WOUT = WS_WIN + 104 * KiB64;
constexpr size_t WS_WQ = WS_WOUT + 2 * MiB, WS_WK = WS_WQ + 2 * MiB, WS_WV = WS_WK + 2 * MiB, WS_WO = WS_WV + 2 * MiB;
constexpr size_t WS_CW1K = WS_WO + 2 * MiB, WS_CW1V = WS_CW1K + 1 * MiB;
constexpr size_t WS_WLORA = WS_CW1V + 1 * MiB;
constexpr size_t WS_ROPE = WS_WLORA + 12 * KiB64;
constexpr size_t WS_CBIAS = WS_ROPE + 2 * MiB;
constexpr size_t WS_MEMN = WS_CBIAS + KiB64;
constexpr size_t WS_HIDK = WS_MEMN + 1 * MiB;
constexpr size_t WS_HIDV = WS_HIDK + 1 * MiB;
constexpr size_t WS_GATES = WS_HIDV + 1 * MiB;
constexpr size_t WS_XN = 60 * MiB;
constexpr size_t WS_YB = 92 * MiB;
constexpr size_t WS_D = 124 * MiB;
constexpr size_t WS_HB = WS_D;
constexpr size_t WS_QB = WS_D;
constexpr size_t WS_KS = WS_D + 16 * MiB;
constexpr size_t WS_KW = WS_D + 20 * MiB;
constexpr size_t WS_KCR = WS_D + 24 * MiB;
constexpr size_t WS_VCR = WS_D + 29 * MiB;
constexpr size_t WS_VST = WS_D + 34 * MiB;
constexpr size_t WS_VWT = WS_D + 38 * MiB;
constexpr size_t WS_RKVA = WS_D + 42 * MiB;
constexpr size_t WS_PRL = WS_D + 106 * MiB;
constexpr size_t WS_AGG = WS_D + 114 * MiB;
constexpr size_t WS_BONUS = WS_W1GU;
constexpr size_t WS_END = 256 * MiB;
constexpr size_t WS_QM = WS_D;
constexpr size_t WS_OM = WS_D + 32 * MiB;
constexpr size_t WS_MK = WS_D + 64 * MiB;
constexpr size_t WS_MVT = WS_D + 65 * MiB;
static_assert(WS_GATES + (size_t)M_ * 24 * 4 <= WS_XN, "ws map");
static_assert(WS_AGG + 16 * MiB <= WS_END, "ws map");

struct Params {
    const float* in[41];
    float* out;
    unsigned char* ws;
};
enum { I_X = 0, I_MEM, I_F1_PRE, I_F1_WG, I_F1_WU, I_F1_WD, I_F1_POST, I_MIX_PRE, I_WIN, I_PE_K, I_W1_K, I_W2_K, I_PE_V, I_W1_V, I_W2_V,
       I_NSA_G, I_MU, I_W0, I_W2, I_A0, I_A2, I_G2, I_KK, I_KA, I_RK, I_GNG, I_GNB, I_WOUT, I_MIX_POST, I_MEM_PRE, I_MEM_KVG, I_WQ, I_WK, I_WV,
       I_WO, I_MEM_POST, I_F2_PRE, I_F2_WG, I_F2_WU, I_F2_WD, I_F2_POST };

struct MapPlain { const float* W; int N; int pad; __device__ const float* col(int p) const { return W + p; } };
struct MapGU {
    const float* Wg; const float* Wu; int N; int pad;
    __device__ const float* col(int p) const {
        const int pn = p >> 8, q = p & 255, n = (q >> 4) & 1;
        const int hid = 128 * pn + 64 * (q >> 7) + 16 * ((q >> 5) & 3) + (q & 15);
        return Wg + (size_t)n * (size_t)(Wu - Wg) + hid;
    }
};
__host__ __device__ inline int rope_perm(int x) { return 16 * ((x >> 5) & 1) + (x & 15) + 32 * ((x >> 4) & 1); }
struct MapWin {
    const float* W; int N; int pad;
    __device__ const float* col(int p) const {
        int l;
        if (p < 512) l = (p & ~63) + rope_perm(p & 63);
        else if (p < 640) l = 768 + ((p - 512) & ~63) + rope_perm(p & 63);
        else if (p < 768) l = 1024 + ((p - 640) & ~63) + rope_perm(p & 63);
        else if (p < 896) l = 512 + (p - 768);
        else if (p < 1024) l = 640 + (p - 896);
        else if (p < 1152) l = 896 + (p - 1024);
        else if (p < 1280) l = 1152 + (p - 1152);
        else if (p < 2304) { const int q = p - 1280; l = 1304 + (((q >> 4) & 1) ? 512 : 0) + 16 * (q >> 5) + (q & 15); }
        else if (p < 3072) l = 1304 + (p - 1280);
        else if (p < 3096) l = 1280 + (p - 3072);
        else return nullptr;
        return W + l;
    }
};

#define FOR_VB(vb, n) for (int vb = (int)blockIdx.x * 2 + (T512 >> 8); vb < (n); vb += (int)gridDim.x * 2)

template <class Map> __device__ __forceinline__ void d_convert(bf16* WT, int Np, int K, Map map, int wg0 = 0) {
    if ((int)blockIdx.x < wg0) return;
    const int T512 = tidx(), tid = T512 & 255, nbx = Np / 64, nb = nbx * (K / 64), G = (int)gridDim.x - wg0;
    for (int vb0 = ((int)blockIdx.x - wg0) * 2 + (T512 >> 8); vb0 < nb; vb0 += G * 4) {
        const int vb1 = vb0 + G * 2; const bool two = vb1 < nb;
        const int p0 = (vb0 % nbx) * 64 + (tid & 63), k0 = (vb0 / nbx) * 64 + (tid >> 6) * 16;
        const int p1 = two ? (vb1 % nbx) * 64 + (tid & 63) : p0, k1 = two ? (vb1 / nbx) * 64 + (tid >> 6) * 16 : k0;
        const float* s0 = map.col(p0); const float* s1 = map.col(p1);
        float v[16], u[16];
#pragma unroll
        for (int i = 0; i < 16; ++i) { v[i] = s0 ? s0[(size_t)(k0 + i) * map.N] : 0.f; u[i] = s1 ? s1[(size_t)(k1 + i) * map.N] : 0.f; }
        u32x4 a, b;
        a.x = pk2(v[0], v[1]); a.y = pk2(v[2], v[3]); a.z = pk2(v[4], v[5]); a.w = pk2(v[6], v[7]);
        b.x = pk2(v[8], v[9]); b.y = pk2(v[10], v[11]); b.z = pk2(v[12], v[13]); b.w = pk2(v[14], v[15]);
        u32x4* d0 = (u32x4*)(WT + (size_t)p0 * K + k0); d0[0] = a; d0[1] = b;
        if (two) {
            a.x = pk2(u[0], u[1]); a.y = pk2(u[2], u[3]); a.z = pk2(u[4], u[5]); a.w = pk2(u[6], u[7]);
            b.x = pk2(u[8], u[9]); b.y = pk2(u[10], u[11]); b.z = pk2(u[12], u[13]); b.w = pk2(u[14], u[15]);
            u32x4* d1 = (u32x4*)(WT + (size_t)p1 * K + k1); d1[0] = a; d1[1] = b;
        }
    }
}
__device__ __forceinline__ void d_convert_lora(bf16* WT, const float* w2, const float* a2, const float* g2) {
    const int T512 = tidx(), tid = T512 & 255;
    FOR_VB(vb, NLORA * KLORA / 256) {
        const int idx = vb * 256 + tid, p = idx >> 8, k = idx & 255;
        float v = 0.f;
        if (p < 512) { if (k < 64) v = w2[k * 512 + p]; }
        else if (p < 1024) { if (k >= 64 && k < 128) v = a2[(k - 64) * 512 + (p - 512)]; }
        else { if (k >= 128) v = g2[(k - 128) * 512 + (p - 1024)]; }
        WT[idx] = (bf16)f2bf(v);
    }
}
__device__ __forceinline__ void d_rope_table(float* tab) {
    const int T512 = tidx(), tid = T512 & 255;
    FOR_VB(vb, T_ * 32 / 256) {
        const int idx = vb * 256 + tid, pos = idx >> 5, i = idx & 31;
        const float inv = (float)pow(10000.0, -(double)i / 32.0);
        const float ang = (float)pos * inv;
        tab[2 * idx] = (float)cos((double)ang); tab[2 * idx + 1] = (float)sin((double)ang);
    }
}
__device__ __forceinline__ void d_cmp_bias(const float* pe_k, const float* w1_k, const float* pe_v, const float* w1_v, float* part, float* red  ) {
    for (int job = blockIdx.x; job < 64; job += gridDim.x) {
        const int kv = job >> 5, cg_ = (job >> 3) & 3, jc = job & 7; const float* pe = kv ? pe_v : pe_k; const float* w1 = kv ? w1_v : w1_k;
        const int T512 = tidx(), lane = T512 & 63, w = T512 >> 6, n = cg_ * 64 + lane;
        float s = 0.f;
#pragma unroll 8
        for (int j = jc * 256 + w * 32; j < jc * 256 + w * 32 + 32; ++j) s += pe[j] * w1[(size_t)j * 256 + n];
        red[w * 64 + lane] = s; __syncthreads();
        if (w == 0) { float t = 0.f; for (int i = 0; i < 8; ++i) t += red[i * 64 + lane]; part[(jc * 2 + kv) * 256 + n] = t; }
        __syncthreads();
    }
}
__device__ __forceinline__ void d_rownorm(const float* x, const float* g, bf16* xn, int rows) {
    const int T512 = tidx(), tid = T512 & 255, lane = tid & 63;
    FOR_VB(vb, rows / 4) {
        const int row = vb * 4 + (tid >> 6);
        const f32x4* xr = (const f32x4*)(x + (size_t)row * DM) + lane; f32x4 v[4]; float s = 0.f;
#pragma unroll
        for (int j = 0; j < 4; ++j) { v[j] = xr[64 * j]; s += v[j][0] * v[j][0] + v[j][1] * v[j][1] + v[j][2] * v[j][2] + v[j][3] * v[j][3]; }
        const float rstd = rsqrtf(wave_sum(s) * (1.f / DM) + NORM_EPS);
#pragma unroll
        for (int j = 0; j < 4; ++j) { const f32x4 gg = ((const f32x4*)g)[lane + 64 * j]; st_bf4(xn + (size_t)row * DM + 4 * (lane + 64 * j), v[j] * rstd * gg); }
    }
}
__device__ __forceinline__ void d_rowpass(const float* xin, const bf16* y, const float* gpost, float coef, const float* gpre, float* xout, bf16* xn) {
    const int T512 = tidx(), tid = T512 & 255, lane = tid & 63;
    FOR_VB(vb, M_ / 4) {
        const int row = vb * 4 + (tid >> 6);
        f32x4 yv[4], xv[4]; float s = 0.f;
#pragma unroll
        for (int j = 0; j < 4; ++j) {
            const u32x2 w = *(const u32x2*)(y + (size_t)row * DM + 4 * (lane + 64 * j));
            yv[j][0] = __builtin_bit_cast(float, w.x << 16); yv[j][1] = __builtin_bit_cast(float, w.x & 0xffff0000u);
            yv[j][2] = __builtin_bit_cast(float, w.y << 16); yv[j][3] = __builtin_bit_cast(float, w.y & 0xffff0000u);
            s += yv[j][0] * yv[j][0] + yv[j][1] * yv[j][1] + yv[j][2] * yv[j][2] + yv[j][3] * yv[j][3];
            xv[j] = ((const f32x4*)(xin + (size_t)row * DM))[lane + 64 * j];
        }
        const float rstd = rsqrtf(wave_sum(s) * (1.f / DM) + NORM_EPS) * coef; float s2 = 0.f;
#pragma unroll
        for (int j = 0; j < 4; ++j) { const f32x4 gg = ((const f32x4*)gpost)[lane + 64 * j]; xv[j] = xv[j] + yv[j] * rstd * gg;
            s2 += xv[j][0] * xv[j][0] + xv[j][1] * xv[j][1] + xv[j][2] * xv[j][2] + xv[j][3] * xv[j][3];
            ((f32x4*)(xout + (size_t)row * DM))[lane + 64 * j] = xv[j]; }
        if (gpre) {
            const float r2 = rsqrtf(wave_sum(s2) * (1.f / DM) + NORM_EPS);
#pragma unroll
            for (int j = 0; j < 4; ++j) { const f32x4 gg = ((const f32x4*)gpre)[lane + 64 * j]; st_bf4(xn + (size_t)row * DM + 4 * (lane + 64 * j), xv[j] * r2 * gg); }
        }
    }
}
__device__ __forceinline__ void d_nsa_outnorm(bf16* amix, const float* g) {
    const int T512 = tidx(), tid = T512 & 255, lane = tid & 63;
    FOR_VB(vb, M_ / 4) {
        const int row = vb * 4 + (tid >> 6);
        bf16* p = amix + (size_t)row * DM + 8 * lane;
        const u32x4 w = *(const u32x4*)p; float v[8]; float s = 0.f;
        v[0] = __builtin_bit_cast(float, w.x << 16); v[1] = __builtin_bit_cast(float, w.x & 0xffff0000u);
        v[2] = __builtin_bit_cast(float, w.y << 16); v[3] = __builtin_bit_cast(float, w.y & 0xffff0000u);
        v[4] = __builtin_bit_cast(float, w.z << 16); v[5] = __builtin_bit_cast(float, w.z & 0xffff0000u);
        v[6] = __builtin_bit_cast(float, w.w << 16); v[7] = __builtin_bit_cast(float, w.w & 0xffff0000u);
#pragma unroll
        for (int i = 0; i < 8; ++i) s += v[i] * v[i];
        const float rstd = rsqrtf(wave_sum(s) * (1.f / 512.f) + NORM_EPS);
        u32x4 o; const float* gg = g + 8 * lane;
        o.x = pk2(v[0] * rstd * gg[0], v[1] * rstd * gg[1]); o.y = pk2(v[2] * rstd * gg[2], v[3] * rstd * gg[3]);
        o.z = pk2(v[4] * rstd * gg[4], v[5] * rstd * gg[5]); o.w = pk2(v[6] * rstd * gg[6], v[7] * rstd * gg[7]);
        *(u32x4*)p = o;
    }
}

struct EpiStore { bf16* O; int ldc; float scale;
    static constexpr int NCAT = 1;
    __device__ __forceinline__ int cat(int) const { return 0; }
    template <int C> __device__ __forceinline__ void apply(int row, int p, f32x4 v0, f32x4 v1) const { bf16* o = O + (size_t)row * ldc + p; st_bf4(o, v0 * scale); st_bf4(o + 16, v1 * scale); } };
struct EpiStoreF32 { float* O; int ldc;
    static constexpr int NCAT = 1;
    __device__ __forceinline__ int cat(int) const { return 0; }
    template <int C> __device__ __forceinline__ void apply(int row, int p, f32x4 v0, f32x4 v1) const { float* o = O + (size_t)row * ldc + p; *(f32x4*)o = v0; *(f32x4*)(o + 16) = v1; } };
struct EpiSwiGLU { bf16* H;
    static constexpr int NCAT = 1;
    __device__ __forceinline__ int cat(int) const { return 0; }
    template <int C> __device__ __forceinline__ void apply(int row, int p, f32x4 g, f32x4 u) const {
        const int q = p & 255, hid = 128 * (p >> 8) + 64 * (q >> 7) + 16 * ((q >> 5) & 3) + (q & 15);
        f32x4 h;
#pragma unroll
        for (int e = 0; e < 4; ++e) h[e] = g[e] / (1.f + __expf(-g[e])) * u[e];
        st_bf4(H + (size_t)row * FF + hid, h); } };
struct EpiBiasSilu { bf16* O; const float* bias;
    static constexpr int NCAT = 1;
    __device__ __forceinline__ int cat(int) const { return 0; }
    template <int C> __device__ __forceinline__ void apply(int row, int p, f32x4 v0, f32x4 v1) const {
        f32x4 a, b; f32x4 b0 = {0.f, 0.f, 0.f, 0.f}, b1 = {0.f, 0.f, 0.f, 0.f};
#pragma unroll
        for (int jc = 0; jc < 8; ++jc) { b0 += *(const f32x4*)(bias + jc * 512 + p); b1 += *(const f32x4*)(bias + jc * 512 + p + 16); }
#pragma unroll
        for (int e = 0; e < 4; ++e) { const float x0 = v0[e] + b0[e], x1 = v1[e] + b1[e]; a[e] = x0 / (1.f + __expf(-x0)); b[e] = x1 / (1.f + __expf(-x1)); }
        bf16* o = O + (size_t)row * 256 + p; st_bf4(o, a); st_bf4(o + 16, b); } };
struct EpiLora { float* wdec; bf16* aga; bf16* agg; const float* w0; const float* a0;
    static constexpr int NCAT = 3;
    __device__ __forceinline__ int cat(int p0) const { return p0 < 512 ? 0 : (p0 < 1024 ? 1 : 2); }
    template <int C> __device__ __forceinline__ void one(int row, int p, f32x4 v) const {
        if (C == 0) { f32x4 o; const f32x4 ww = *(const f32x4*)(w0 + p);
#pragma unroll
            for (int e = 0; e < 4; ++e) o[e] = __expf(-0.6065306597126334f * sigmoidf_(ww[e] + v[e]));
            *(f32x4*)(wdec + (size_t)row * 512 + p) = o;
        } else if (C == 1) { f32x4 o; const f32x4 aa = *(const f32x4*)(a0 + p - 512);
#pragma unroll
            for (int e = 0; e < 4; ++e) o[e] = sigmoidf_(aa[e] + v[e]);
            st_bf4(aga + (size_t)row * 512 + (p - 512), o);
        } else st_bf4(agg + (size_t)row * 512 + (p - 1024), v);
    }
    template <int C> __device__ __forceinline__ void apply(int row, int p, f32x4 v0, f32x4 v1) const { one<C>(row, p, v0); one<C>(row, p + 16, v1); } };
struct EpiWin {
    bf16 *qb, *ks, *kw, *kcr, *vcr, *vst, *vwt; unsigned* rk; bf16 *vv, *prl; float* gates; const float* rope;
    static constexpr int NCAT = 8;
    __device__ __forceinline__ int cat(int p0) const { return p0 < 512 ? 0 : (p0 < 768 ? 1 : (p0 < 1024 ? 2 : (p0 < 1280 ? 3 : (p0 < 2304 ? 4 : (p0 < 2816 ? 7 : (p0 < 3072 ? 6 : 5)))))); }
    template <int C> __device__ __forceinline__ void apply(int row, int p, f32x4 v0, f32x4 v1) const {
        const int b = row / T_, t = row % T_;
        if (C == 0 || C == 1) {
            const int x = p & 63, d = 16 * ((x >> 5) & 1) + (x & 15);
            const f32x4* rp = (const f32x4*)(rope + ((size_t)t * 32 + d) * 2); const f32x4 r0 = rp[0], r1 = rp[1];
            const f32x4 cs = {r0[0], r0[2], r1[0], r1[2]}, sn = {r0[1], r0[3], r1[1], r1[3]};
            const f32x4 lo = v0 * cs - v1 * sn, hi = v0 * sn + v1 * cs;
            if (C == 0) { bf16* o = qb + (size_t)row * 512 + (p & ~63) + d; st_bf4(o, lo * QSCALE); st_bf4(o + 32, hi * QSCALE); }
            else { const int g = ((p - 512) >> 6) & 1; bf16* base = (p < 640) ? ks : kw; bf16* o = base + ((size_t)(b * 2 + g) * T_ + t) * 64 + d; st_bf4(o, lo); st_bf4(o + 32, hi); }
        } else if (C == 2) {
            const int c = (p - 768) & 127, g = c >> 6, d = c & 63; bf16* base = (p < 896) ? kcr : vcr;
            bf16* o = base + ((size_t)(b * 2 + g) * T_ + t) * 64 + d; st_bf4(o, v0); st_bf4(o + 16, v1);
        } else if (C == 3) {
            const int c = (p - 1024) & 127, g = c >> 6, d = c & 63; bf16* base = (p < 1152) ? vst : vwt;
            bf16* o = base + ((size_t)(b * 2 + g) * 64 + d) * T_ + t;
#pragma unroll
            for (int e = 0; e < 4; ++e) { o[(size_t)e * T_] = (bf16)f2bf(v0[e]); o[(size_t)(16 + e) * T_] = (bf16)f2bf(v1[e]); }
        } else if (C == 4) {
            const int q = p - 1280, ch = 16 * (q >> 5) + (q & 15);
            u32x4 w; w.x = pk2(v0[0], v1[0]); w.y = pk2(v0[1], v1[1]); w.z = pk2(v0[2], v1[2]); w.w = pk2(v0[3], v1[3]);
            *(u32x4*)(rk + (size_t)row * 512 + ch) = w;
        } else if (C == 7) {
            bf16* o = vv + (size_t)row * 512 + (p - 2304); st_bf4(o, v0); st_bf4(o + 16, v1);
        } else if (C == 6) {
            bf16* o = prl + (size_t)row * 256 + (p - 2816); st_bf4(o, v0); st_bf4(o + 16, v1);
        } else {
            const int c = p - 3072; float* o = gates + (size_t)row * 24 + c;
            if (c < 24) { f32x4 s = {sigmoidf_(v0[0]), sigmoidf_(v0[1]), sigmoidf_(v0[2]), sigmoidf_(v0[3])}; *(f32x4*)o = s; }
            if (c + 16 < 24) { f32x4 s = {sigmoidf_(v1[0]), sigmoidf_(v1[1]), sigmoidf_(v1[2]), sigmoidf_(v1[3])}; *(f32x4*)(o + 16) = s; }
        }
    }
};

namespace pg8 {
#define PG8_LAS __attribute__((address_space(3)))
typedef unsigned short bf16_t;
typedef short bf16x8 __attribute__((ext_vector_type(8)));
typedef float f32x4 __attribute__((ext_vector_type(4)));
typedef unsigned u32x4 __attribute__((ext_vector_type(4)));
constexpr int BM = 256, BK = 64, HALF = 128, HTB = HALF * BK * 2  , STAGE_BYTES = 8 * HTB, NXCD = 8, WGM = 8;

__host__ __device__ __forceinline__ int lds_byte(int r, int c) { const int st = (r >> 4) * 2 + (c >> 5), rr = r & 15, cc = c & 31, ob = rr * 64 + cc * 2; return st * 1024 + (ob ^ (((ob >> 9) & 1) << 5)); }
__host__ __device__ __forceinline__ void stage_rc(int b, int& R, int& C) { const int st = b / 1024, sb = b % 1024, swz = sb ^ (((sb >> 9) & 1) << 5); R = (st >> 1) * 16 + swz / 64; C = (st & 1) * 32 + (swz % 64) / 2; }
__host__ __device__ __forceinline__ int perm32(int rho) { const int n = rho >> 4, i = rho & 15; return 8 * (i >> 2) + 4 * n + (i & 3); }

struct Unit { int pm, pn; };
struct Gemm { const bf16_t* A; const bf16_t* Bt; int M, N, K, lda, ldb; };

struct StaticOrder {
    int nM, nN, nwg, G, c;
    __host__ __device__ void init(int M, int N, int G_, int c_) { nM = M / BM; nN = N / BM; nwg = nM * nN; G = G_; c = c_; }
    __host__ __device__ bool next(int i, Unit& u) const {
        const long L = (long)i * G + c; if (L >= nwg) return false;
        int wgid = (int)L; { const int q = nwg / NXCD, r = nwg % NXCD, xcd = wgid % NXCD, off = wgid / NXCD; wgid = (xcd < r ? xcd * (q + 1) : r * (q + 1) + (xcd - r) * q) + off; }
        const int nig = WGM * nN, gid = wgid / nig, fm = gid * WGM, gsz = (nM - fm) < WGM ? (nM - fm) : WGM;
        u.pm = fm + ((wgid % nig) % gsz); u.pn = (wgid % nig) / gsz; return true;
    }
    __device__ __forceinline__ void a_ready(const Unit&) const {}
    __device__ __forceinline__ void done(const Unit&) const {}
};

template <class Epi, class Sched, bool ALIGN_EPI = false, bool SP2 = false>
__device__ __forceinline__ void gemm_phase(PG8_LAS unsigned char* lds, const Gemm g, const Sched& S, const Epi& E) {
    const int tid = tidx(), wid = __builtin_amdgcn_readfirstlane(tid >> 6), lane = tid & 63, wr = wid >> 2, wc = wid & 3, fr = lane & 15, fq = lane >> 4;
    const int K = g.K, nt = K / BK;
    unsigned voffA[2], voffB[2];
#pragma unroll
    for (int i = 0; i < 2; ++i) { int R, C; stage_rc(tid * 16 + i * 8192, R, C); const int Rb = Epi::PERM ? ((R & ~31) + perm32(R & 31)) : R;
        voffA[i] = (unsigned)(R * g.lda + C) * 2u; voffB[i] = (unsigned)(Rb * g.ldb + C) * 2u; }
    const size_t kstep = (size_t)(BK * 2);
    const size_t hstepA = (size_t)HALF * g.lda * 2, hstepB = (size_t)HALF * g.ldb * 2;
    const size_t tstepA = 2 * hstepA, tstepB = 2 * hstepB;
    const unsigned ldsw = (unsigned)wid * 1024u;
    const int aoff = lds_byte(wr * 64 + fr, fq * 8), boff = lds_byte(wc * 32 + fr, fq * 8);
#define PG8_SA(b, h) (((b) * 2 + (h)) * HTB)
#define PG8_SB(b, h) ((4 + (b) * 2 + (h)) * HTB)
#define PG8_STAGE(bufoff, gbase, voff) do { _Pragma("unroll") for (int _i = 0; _i < 2; ++_i) \
        __builtin_amdgcn_global_load_lds((const unsigned*)((const char*)(gbase) + (voff)[_i]), (PG8_LAS unsigned*)(lds + (bufoff) + ldsw + _i * 8192), 16, 0, 0); } while (0)
#define PG8_LDA(dst, b, h) do { _Pragma("unroll") for (int m = 0; m < 4; ++m) _Pragma("unroll") for (int k = 0; k < 2; ++k) dst[m][k] = *(const PG8_LAS bf16x8*)(lds + PG8_SA(b, h) + aoff + m * 2048 + k * 1024); } while (0)
#define PG8_LDB(dst, b, h) do { _Pragma("unroll") for (int n = 0; n < 2; ++n) _Pragma("unroll") for (int k = 0; k < 2; ++k) dst[n][k] = *(const PG8_LAS bf16x8*)(lds + PG8_SB(b, h) + boff + n * 2048 + k * 1024); } while (0)
#define PG8_MMA(ai, bj, At, Bt) do { __builtin_amdgcn_s_setprio(1); _Pragma("unroll") for (int m = 0; m < 4; ++m) _Pragma("unroll") for (int n = 0; n < 2; ++n) _Pragma("unroll") for (int k = 0; k < 2; ++k) \
        acc[ai][bj][m][n] = __builtin_amdgcn_mfma_f32_16x16x32_bf16(Bt[n][k], At[m][k], acc[ai][bj][m][n], 0, 0, 0); __builtin_amdgcn_s_setprio(0); } while (0)
#define PG8_WAIT_V(n) asm volatile("s_waitcnt vmcnt(" #n ")" ::: "memory")
#define PG8_WAIT_L(n) asm volatile("s_waitcnt lgkmcnt(" #n ")" ::: "memory")
#define PG8_BAR __builtin_amdgcn_s_barrier()
#define PG8_SCHED __builtin_amdgcn_sched_barrier(0)
    Unit cur, nxt; int ui = 0;
    if (!S.next(0, cur)) return;
    f32x4 acc[2][2][4][2];
#pragma unroll
    for (int a = 0; a < 2; ++a)
#pragma unroll
        for (int b = 0; b < 2; ++b)
#pragma unroll
            for (int m = 0; m < 4; ++m)
#pragma unroll
                for (int n = 0; n < 2; ++n) acc[a][b][m][n] = (f32x4){0.f, 0.f, 0.f, 0.f};
    bf16x8 At[4][2], B0[2][2], B1[2][2];
    const char* cA = (const char*)g.A + (size_t)cur.pm * tstepA; const char* cB = (const char*)g.Bt + (size_t)cur.pn * tstepB;
    S.a_ready(cur);
    if constexpr (SP2) {
        PG8_STAGE(PG8_SB(0, 0), cB, voffB); PG8_STAGE(PG8_SB(0, 1), cB + hstepB, voffB); PG8_STAGE(PG8_SA(0, 0), cA, voffA); PG8_STAGE(PG8_SA(0, 1), cA + hstepA, voffA);
        if (wr == 1) PG8_BAR;
        PG8_WAIT_V(2); PG8_BAR;
        PG8_STAGE(PG8_SB(1, 0), cB + kstep, voffB); PG8_STAGE(PG8_SA(1, 0), cA + kstep, voffA); PG8_STAGE(PG8_SB(1, 1), cB + hstepB + kstep, voffB);
        PG8_WAIT_V(6); PG8_BAR;
    } else {
        PG8_STAGE(PG8_SB(0, 0), cB, voffB); PG8_STAGE(PG8_SA(0, 0), cA, voffA); PG8_STAGE(PG8_SB(0, 1), cB + hstepB, voffB); PG8_STAGE(PG8_SA(0, 1), cA + hstepA, voffA);
        if (wr == 1) PG8_BAR;
        PG8_WAIT_V(4); PG8_BAR;
        PG8_STAGE(PG8_SB(1, 0), cB + kstep, voffB); PG8_STAGE(PG8_SA(1, 0), cA + kstep, voffA); PG8_STAGE(PG8_SB(1, 1), cB + hstepB + kstep, voffB);
        PG8_WAIT_V(6); PG8_BAR;
    }
    for (;;) {
        const bool has_next = S.next(ui + 1, nxt);
        const char* nA = has_next ? (const char*)g.A + (size_t)nxt.pm * tstepA : cA; const char* nB = has_next ? (const char*)g.Bt + (size_t)nxt.pn * tstepB : cB;
        for (int t = 0; t < nt; t += 2) {
            const bool last = (t == nt - 2);
            const char* a1 = cA + (size_t)(t + 1) * kstep;
            const char* a2 = last ? nA : cA + (size_t)(t + 2) * kstep; const char* b2 = last ? nB : cB + (size_t)(t + 2) * kstep;
            const char* a3 = a2 + kstep; const char* b3 = b2 + kstep;
            if (last && has_next) S.a_ready(nxt);
            if constexpr (SP2) {
            PG8_LDB(B0, 0, 0); PG8_LDB(B1, 0, 1); PG8_SCHED; PG8_LDA(At, 0, 0); PG8_STAGE(PG8_SA(1, 1), a1 + hstepA, voffA);
            PG8_WAIT_V(8); PG8_WAIT_L(0); PG8_BAR; PG8_MMA(0, 0, At, B0); PG8_MMA(0, 1, At, B1); PG8_BAR; PG8_SCHED;
            PG8_LDA(At, 0, 1); PG8_STAGE(PG8_SB(0, 0), b2, voffB); PG8_STAGE(PG8_SB(0, 1), b2 + hstepB, voffB); PG8_STAGE(PG8_SA(0, 0), a2, voffA);
            PG8_WAIT_V(8); PG8_WAIT_L(0); PG8_BAR; PG8_MMA(1, 0, At, B0); PG8_MMA(1, 1, At, B1); PG8_BAR; PG8_SCHED;
            PG8_LDB(B0, 1, 0); PG8_LDB(B1, 1, 1); PG8_SCHED; PG8_LDA(At, 1, 0); PG8_STAGE(PG8_SA(0, 1), a2 + hstepA, voffA);
            PG8_WAIT_V(8); PG8_WAIT_L(0); PG8_BAR; PG8_MMA(0, 0, At, B0); PG8_MMA(0, 1, At, B1); PG8_BAR; PG8_SCHED;
            PG8_LDA(At, 1, 1); PG8_STAGE(PG8_SB(1, 0), b3, voffB); PG8_STAGE(PG8_SB(1, 1), b3 + hstepB, voffB); PG8_STAGE(PG8_SA(1, 0), a3, voffA);
            PG8_WAIT_V(8); PG8_WAIT_L(0); PG8_BAR; PG8_MMA(1, 0, At, B0); PG8_MMA(1, 1, At, B1); PG8_BAR; PG8_SCHED;
            } else {
            PG8_LDB(B0, 0, 0); PG8_SCHED; PG8_LDA(At, 0, 0); PG8_STAGE(PG8_SA(1, 1), a1 + hstepA, voffA);
            PG8_WAIT_L(8); PG8_BAR; PG8_WAIT_L(0); PG8_MMA(0, 0, At, B0); PG8_BAR; PG8_SCHED;
            PG8_LDB(B1, 0, 1); PG8_STAGE(PG8_SB(0, 0), b2, voffB);
            PG8_BAR; PG8_WAIT_L(0); PG8_MMA(0, 1, At, B1); PG8_BAR;
            PG8_LDA(At, 0, 1); PG8_STAGE(PG8_SA(0, 0), a2, voffA);
            PG8_BAR; PG8_WAIT_L(0); PG8_MMA(1, 0, At, B0); PG8_BAR; PG8_SCHED;
            PG8_STAGE(PG8_SB(0, 1), b2 + hstepB, voffB);
            PG8_WAIT_V(6); PG8_BAR; PG8_MMA(1, 1, At, B1); PG8_BAR;
            PG8_LDB(B0, 1, 0); PG8_SCHED; PG8_LDA(At, 1, 0); PG8_STAGE(PG8_SA(0, 1), a2 + hstepA, voffA);
            PG8_WAIT_L(8); PG8_BAR; PG8_WAIT_L(0); PG8_MMA(0, 0, At, B0); PG8_BAR; PG8_SCHED;
            PG8_LDB(B1, 1, 1); PG8_STAGE(PG8_SB(1, 0), b3, voffB);
            PG8_BAR; PG8_WAIT_L(0); PG8_MMA(0, 1, At, B1); PG8_BAR;
            PG8_LDA(At, 1, 1); PG8_STAGE(PG8_SA(1, 0), a3, voffA);
            PG8_BAR; PG8_WAIT_L(0); PG8_MMA(1, 0, At, B0); PG8_BAR; PG8_SCHED;
            PG8_STAGE(PG8_SB(1, 1), b3 + hstepB, voffB);
            PG8_WAIT_V(6); PG8_BAR; PG8_MMA(1, 1, At, B1); PG8_BAR;
            }
        }
        if constexpr (ALIGN_EPI) { if (wr == 0) PG8_BAR; }
        if constexpr (!Epi::AFTER_DRAIN) { E(acc, cur, wr, wc, fr, fq); S.done(cur); }
        if (!has_next) break;
#pragma unroll
        for (int a = 0; a < 2; ++a)
#pragma unroll
            for (int b = 0; b < 2; ++b)
#pragma unroll
                for (int m = 0; m < 4; ++m)
#pragma unroll
                    for (int n = 0; n < 2; ++n) acc[a][b][m][n] = (f32x4){0.f, 0.f, 0.f, 0.f};
        cur = nxt; cA = nA; cB = nB; ++ui;
        if constexpr (ALIGN_EPI) { if (wr == 1) PG8_BAR; }
    }
    PG8_WAIT_V(0);
    if constexpr (!ALIGN_EPI) { if (wr == 0) PG8_BAR; }
    PG8_BAR;
    if constexpr (Epi::AFTER_DRAIN) { E.fused(acc, cur, wr, wc, fr, fq, lds, wid, lane); S.done(cur); }
#undef PG8_SA
#undef PG8_SB
#undef PG8_STAGE
#undef PG8_LDA
#undef PG8_LDB
#undef PG8_MMA
#undef PG8_WAIT_V
#undef PG8_WAIT_L
#undef PG8_BAR
#undef PG8_SCHED
}
}

template <class F> struct EpiQuad {
    static constexpr bool PERM = false, AFTER_DRAIN = false;
    F f;
    template <int C, int BJ> __device__ __forceinline__ void half(const pg8::f32x4 (&acc)[2][2][4][2], int row0, int p) const {
#pragma unroll
        for (int ai = 0; ai < 2; ++ai)
#pragma unroll
            for (int m = 0; m < 4; ++m) { f.template apply<C>(row0 + ai * 128 + m * 16, p, acc[ai][BJ][m][0], acc[ai][BJ][m][1]); asm volatile("" ::: "memory"); }
    }
    template <int BJ> __device__ __forceinline__ void disp(const pg8::f32x4 (&acc)[2][2][4][2], int row0, int p0, int p) const {
        const int c = f.cat(p0);
        if (F::NCAT == 1 || c == 0) half<0, BJ>(acc, row0, p);
        else if (F::NCAT > 1 && c == 1) half<(F::NCAT > 1 ? 1 : 0), BJ>(acc, row0, p);
        else if (F::NCAT > 2 && c == 2) half<(F::NCAT > 2 ? 2 : 0), BJ>(acc, row0, p);
        else if (F::NCAT > 3 && c == 3) half<(F::NCAT > 3 ? 3 : 0), BJ>(acc, row0, p);
        else if (F::NCAT > 4 && c == 4) half<(F::NCAT > 4 ? 4 : 0), BJ>(acc, row0, p);
        else if (F::NCAT > 5 && c == 5) half<(F::NCAT > 5 ? 5 : 0), BJ>(acc, row0, p);
        else if (F::NCAT > 6 && c == 6) half<(F::NCAT > 6 ? 6 : 0), BJ>(acc, row0, p);
        else if (F::NCAT > 7) half<(F::NCAT > 7 ? 7 : 0), BJ>(acc, row0, p);
    }
    __device__ __forceinline__ void operator()(const pg8::f32x4 (&acc)[2][2][4][2], const pg8::Unit& u, int wr, int wc, int fr, int fq) const {
        const int row0 = u.pm * 256 + wr * 64 + fr, p0 = u.pn * 256;
        disp<0>(acc, row0, p0, p0 + wc * 32 + 4 * fq);
        disp<1>(acc, row0, p0 + 128, p0 + 128 + wc * 32 + 4 * fq);
    }
};
template <class F> __device__ __forceinline__ void gemm_pg8(unsigned char* lds, const bf16* A, int lda, const bf16* Bt, int ldb, int M, int N, int K, const F& f, int wg_off = 0) {
    if ((int)blockIdx.x < wg_off) return;
    pg8::Gemm g{A, Bt, M, N, K, lda, ldb}; pg8::StaticOrder S; S.init(M, N, (int)gridDim.x, (int)blockIdx.x - wg_off);
    EpiQuad<F> E{f};
    pg8::gemm_phase<EpiQuad<F>, pg8::StaticOrder, true, true>((PG8_LAS unsigned char*)lds, g, S, E);
}

namespace cg = cooperative_groups;
template <bool XIN16, bool XOUT16> struct EpiNormRes {
    static constexpr bool PERM = false, AFTER_DRAIN = true;
    const void* xin; void* xout; bf16* xn; const float* gpost; const float* gpre; float coef; unsigned* part; unsigned* cnt;
    __device__ __forceinline__ void operator()(const pg8::f32x4 (&)[2][2][4][2], const pg8::Unit&, int, int, int, int) const {}
    __device__ __forceinline__ void rowstat(const pg8::f32x4 (&acc)[2][2][4][2], float* P, int wr, int wc, int fr, int fq) const {
#pragma unroll
        for (int ai = 0; ai < 2; ++ai)
#pragma unroll
            for (int m = 0; m < 4; ++m) { float sq = 0.f;
#pragma unroll
                for (int bj = 0; bj < 2; ++bj)
#pragma unroll
                    for (int n = 0; n < 2; ++n) { const pg8::f32x4 v = acc[ai][bj][m][n]; sq += (v[0] * v[0] + v[1] * v[1]) + (v[2] * v[2] + v[3] * v[3]); }
                sq += __shfl_xor(sq, 16); sq += __shfl_xor(sq, 32);
                if (fq == 0) P[(ai * 128 + wr * 64 + m * 16 + fr) * 4 + wc] = sq; }
    }
    __device__ __forceinline__ void exchange(float* P, float* S, unsigned* bank, unsigned* cnt_, const pg8::Unit& u, int tid, float scale) const {
        __syncthreads();
        if (tid < 256) { const f32x4 p = *(const f32x4*)(P + tid * 4);
            __hip_atomic_store(bank + (size_t)(u.pm * 256 + tid) * 4 + u.pn, __builtin_bit_cast(unsigned, (p[0] + p[1]) + (p[2] + p[3])), __ATOMIC_RELAXED, __HIP_MEMORY_SCOPE_AGENT); }
        asm volatile("s_waitcnt vmcnt(0)" ::: "memory");
        __syncthreads();
        if (tid == 0) { unsigned* c = cnt_ + u.pm * 16; __hip_atomic_fetch_add(c, 1u, __ATOMIC_RELAXED, __HIP_MEMORY_SCOPE_AGENT);
            while (__hip_atomic_load(c, __ATOMIC_RELAXED, __HIP_MEMORY_SCOPE_AGENT) < 4u) __builtin_amdgcn_s_sleep(1); }
        __syncthreads();
        if (tid < 256) { const unsigned* b = bank + (size_t)(u.pm * 256 + tid) * 4; float q = 0.f;
#pragma unroll
            for (int j = 0; j < 4; ++j) q += __builtin_bit_cast(float, __hip_atomic_load(b + j, __ATOMIC_RELAXED, __HIP_MEMORY_SCOPE_AGENT));
            S[tid] = rsqrtf(q * (1.f / DM) + NORM_EPS) * scale; }
        __syncthreads();
    }
    __device__ __forceinline__ void fused(pg8::f32x4 (&acc)[2][2][4][2], const pg8::Unit& u, int wr, int wc, int fr, int fq, PG8_LAS unsigned char* lds, int wid, int lane) const {
        float* P = (float*)lds; float* S = P + 1024; const int tid = wid * 64 + lane;
        rowstat(acc, P, wr, wc, fr, fq);
        exchange(P, S, part, cnt, u, tid, coef);
        const int col0 = u.pn * 256 + wc * 32 + 4 * fq;
#pragma unroll
        for (int ai = 0; ai < 2; ++ai)
#pragma unroll
            for (int m = 0; m < 4; ++m) { const int r = ai * 128 + wr * 64 + m * 16 + fr; const float sr = S[r]; const size_t off = (size_t)(u.pm * 256 + r) * DM + col0;
#pragma unroll
                for (int bj = 0; bj < 2; ++bj)
#pragma unroll
                    for (int n = 0; n < 2; ++n) { const int o = bj * 128 + n * 16; const f32x4 g4 = *(const f32x4*)(gpost + col0 + o);
                        f32x4 x4;
                        if (XIN16) { const u32x2 w = *(const u32x2*)((const bf16*)xin + off + o);
                            x4 = (f32x4){__builtin_bit_cast(float, w.x << 16), __builtin_bit_cast(float, w.x & 0xffff0000u), __builtin_bit_cast(float, w.y << 16), __builtin_bit_cast(float, w.y & 0xffff0000u)}; }
                        else x4 = *(const f32x4*)((const float*)xin + off + o);
                        const f32x4 y = x4 + acc[ai][bj][m][n] * sr * g4; acc[ai][bj][m][n] = y;
                        if (XOUT16) st_bf4((bf16*)xout + off + o, y); else *(f32x4*)((float*)xout + off + o) = y; }
                asm volatile("" ::: "memory"); }
        if (!gpre) return;
        rowstat(acc, P, wr, wc, fr, fq);
        exchange(P, S, part + (size_t)M_ * 4, cnt + 64 * 16, u, tid, 1.f);
#pragma unroll
        for (int ai = 0; ai < 2; ++ai)
#pragma unroll
            for (int m = 0; m < 4; ++m) { const int r = ai * 128 + wr * 64 + m * 16 + fr; const float sr = S[r]; const size_t off = (size_t)(u.pm * 256 + r) * DM + col0;
#pragma unroll
                for (int bj = 0; bj < 2; ++bj)
#pragma unroll
                    for (int n = 0; n < 2; ++n) { const int o = bj * 128 + n * 16; const f32x4 g4 = *(const f32x4*)(gpre + col0 + o); st_bf4(xn + off + o, acc[ai][bj][m][n] * sr * g4); }
                asm volatile("" ::: "memory"); }
    }
};
template <bool XIN16, bool XOUT16>
__device__ __forceinline__ void gemm_norm_res(unsigned char* lds, const bf16* A, int lda, const bf16* Bt, int K, const void* xin, void* xout, bf16* xn, const float* gpost, const float* gpre,
                                              float coef, unsigned* part, unsigned* cnt) {
    pg8::Gemm g{A, Bt, M_, DM, K, lda, K}; pg8::StaticOrder S; S.init(M_, DM, 256, (int)blockIdx.x);
    const EpiNormRes<XIN16, XOUT16> E{xin, xout, xn, gpost, gpre, coef, part, cnt};
    pg8::gemm_phase<EpiNormRes<XIN16, XOUT16>, pg8::StaticOrder, false, true>((PG8_LAS unsigned char*)lds, g, S, E);
}

__device__ __forceinline__ void d_gates(const bf16* xn, const bf16* wg  , float* gates, float* red  ) {
    const int T512 = tidx(), lane = T512 & 63, fr = lane & 15, fq = lane >> 4, w = T512 >> 6, kh = w & 1;
    for (int rt0 = blockIdx.x * 4; rt0 < M_ / 16; rt0 += gridDim.x * 4) {
        const int rt = rt0 + (w >> 1);
        const bf16* ap = xn + (size_t)(rt * 16 + fr) * DM + 8 * fq + kh * 512; const bf16* bp = wg + (size_t)fr * DM + 8 * fq + kh * 512;
        f32x4 c0 = {0.f, 0.f, 0.f, 0.f}, c1 = {0.f, 0.f, 0.f, 0.f};
#pragma unroll 8
        for (int k0 = 0; k0 < 512; k0 += 32) { const bf16x8 a = *(const bf16x8*)(ap + k0);
            c0 = __builtin_amdgcn_mfma_f32_16x16x32_bf16(*(const bf16x8*)(bp + k0), a, c0, 0, 0, 0);
            c1 = __builtin_amdgcn_mfma_f32_16x16x32_bf16(*(const bf16x8*)(bp + (size_t)16 * DM + k0), a, c1, 0, 0, 0); }
        float* r = red + ((w >> 1) * 64 + lane) * 8;
        if (kh) { *(f32x4*)r = c0; *(f32x4*)(r + 4) = c1; }
        __syncthreads();
        if (!kh) { c0 += *(const f32x4*)r; c1 += *(const f32x4*)(r + 4);
            float* o = gates + (size_t)(rt * 16 + fr) * 24 + 4 * fq;
            *(f32x4*)o = (f32x4){sigmoidf_(c0[0]), sigmoidf_(c0[1]), sigmoidf_(c0[2]), sigmoidf_(c0[3])};
            if (fq < 2) *(f32x4*)(o + 16) = (f32x4){sigmoidf_(c1[0]), sigmoidf_(c1[1]), sigmoidf_(c1[2]), sigmoidf_(c1[3])}; }
        __syncthreads();
    }
}

__device__ __forceinline__ void d_cmp2(const float* part  , const float* bias  , const bf16* w2t, const float* rope, bf16* kc, bf16* vct, int wg0 = 0) {
    if ((int)blockIdx.x < wg0) return;
    const int T512 = tidx(), lane = T512 & 63, fr = lane & 15, fq = lane >> 4;
    for (int task = ((int)blockIdx.x - wg0) * 8 + (T512 >> 6); task < 256; task += ((int)gridDim.x - wg0) * 8) {
        const int kv = task >> 7, R0 = (task & 127) * 16;
        const float* p0 = part + ((size_t)(kv * 2) * 2048 + R0 + fr) * 256 + 8 * fq; const float* p1 = p0 + (size_t)2048 * 256;
        const float* bb = bias + kv * 256 + 8 * fq;
        const bf16* bp = w2t + (size_t)kv * 64 * 256 + (size_t)fr * 256 + 8 * fq;
        f32x4 acc[4];
#pragma unroll
        for (int nt = 0; nt < 4; ++nt) acc[nt] = (f32x4){0.f, 0.f, 0.f, 0.f};
#pragma unroll
        for (int k0 = 0; k0 < 256; k0 += 32) {
            f32x4 xa = *(const f32x4*)(p0 + k0) + *(const f32x4*)(p1 + k0) + *(const f32x4*)(bb + k0);
            f32x4 xb = *(const f32x4*)(p0 + k0 + 4) + *(const f32x4*)(p1 + k0 + 4) + *(const f32x4*)(bb + k0 + 4);
#pragma unroll
            for (int e = 0; e < 4; ++e) { xa[e] = xa[e] / (1.f + __expf(-xa[e])); xb[e] = xb[e] / (1.f + __expf(-xb[e])); }
            const bf16x8 a = __builtin_bit_cast(bf16x8, (u32x4){pk2(xa[0], xa[1]), pk2(xa[2], xa[3]), pk2(xb[0], xb[1]), pk2(xb[2], xb[3])});
#pragma unroll
            for (int nt = 0; nt < 4; ++nt) acc[nt] = __builtin_amdgcn_mfma_f32_16x16x32_bf16(*(const bf16x8*)(bp + (size_t)nt * 16 * 256 + k0), a, acc[nt], 0, 0, 0);
        }
        const int R = R0 + fr, bg = R >> 9, c = R & 511;
        if (kv == 0) {
            const int pos = (16 * c + 31) & (T_ - 1);
#pragma unroll
            for (int h2 = 0; h2 < 2; ++h2) {
                const int d = 16 * h2 + 4 * fq; const f32x4* rp = (const f32x4*)(rope + ((size_t)pos * 32 + d) * 2); const f32x4 r0 = rp[0], r1 = rp[1];
                const f32x4 cs = {r0[0], r0[2], r1[0], r1[2]}, sn = {r0[1], r0[3], r1[1], r1[3]};
                const f32x4 lo = acc[h2] * cs - acc[h2 + 2] * sn, hi = acc[h2] * sn + acc[h2 + 2] * cs;
                st_bf4(kc + (size_t)R * 64 + d, lo); st_bf4(kc + (size_t)R * 64 + d + 32, hi);
            }
        } else {
#pragma unroll
            for (int nt = 0; nt < 4; ++nt)
#pragma unroll
                for (int e = 0; e < 4; ++e) vct[((size_t)bg * 64 + 16 * nt + 4 * fq + e) * NCP + c] = (bf16)f2bf(acc[nt][e]);
        }
    }
}

struct NsaArgs { const bf16 *qb, *kc, *vct, *ks, *vst, *kw, *vwt; const float* gates; bf16* amix; };
__device__ __forceinline__ float dot64(const float* q, const bf16* k) {
    float s = 0.f;
#pragma unroll
    for (int i = 0; i < 8; ++i) { const u32x4 w = ((const u32x4*)k)[i];
        s += q[8 * i + 0] * __builtin_bit_cast(float, w.x << 16) + q[8 * i + 1] * __builtin_bit_cast(float, w.x & 0xffff0000u)
           + q[8 * i + 2] * __builtin_bit_cast(float, w.y << 16) + q[8 * i + 3] * __builtin_bit_cast(float, w.y & 0xffff0000u)
           + q[8 * i + 4] * __builtin_bit_cast(float, w.z << 16) + q[8 * i + 5] * __builtin_bit_cast(float, w.z & 0xffff0000u)
           + q[8 * i + 6] * __builtin_bit_cast(float, w.w << 16) + q[8 * i + 7] * __builtin_bit_cast(float, w.w & 0xffff0000u); }
    return s;
}
__device__ __forceinline__ void softmax_row(float* s, int n, int lane) {
    float m = -INFINITY; for (int i = lane; i < n; i += 64) m = fmaxf(m, s[i]);
    m = wave_max(m); if (m == -INFINITY) m = 0.f;
    float l = 0.f; for (int i = lane; i < n; i += 64) { const float e = exp2f(s[i] - m); s[i] = e; l += e; }
    l = wave_sum(l); const float inv = 1.f / fmaxf(l, 1e-30f);
    for (int i = lane; i < n; i += 64) s[i] *= inv;
}
__device__ __forceinline__ void d_nsa_simple(const NsaArgs& a, int vb, int tid, unsigned char* smem) {
    float (*qs)[64] = (float (*)[64])smem; float (*sc)[1024] = (float (*)[1024])(smem + 1024); float* imp = (float*)(smem + 17408); float* score = imp + 128;
    int* list = (int*)(score + 128); int* nlist = list + 16;
    const int bg = vb / T_, t = vb % T_, b = bg >> 1, g = bg & 1;
    const int r = tid >> 6, d = tid & 63, lane = d;
    const size_t row = (size_t)b * T_ + t;
    qs[r][d] = bf2f(a.qb[row * 512 + g * 256 + r * 64 + d]);
    if (tid == 0) *nlist = 0;
    __syncthreads();
    const int nv = t < 31 ? 0 : (t - 31) / 16 + 1;
    for (int c = tid; c < nv; c += 256) { const bf16* k = a.kc + ((size_t)bg * NCP + c) * 64;
        _Pragma("unroll 1") for (int rr = 0; rr < 4; ++rr) sc[rr][c] = dot64(qs[rr], k); }
    __syncthreads();
    softmax_row(sc[r], nv, lane);
    __syncthreads();
    float oc = 0.f; { const bf16* v = a.vct + ((size_t)bg * 64 + d) * NCP; for (int c = 0; c < nv; ++c) oc += sc[r][c] * bf2f(v[c]); }
    if (tid < 128) { const int s = tid; float acc = 0.f;
        for (int c = 4 * s - 1; c <= 4 * s + 3; ++c) if (c >= 0 && c < nv) acc += sc[0][c] + sc[1][c] + sc[2][c] + sc[3][c];
        imp[s] = acc; }
    __syncthreads();
    const int cur = t >> 6;
    if (tid < 128) { const int s = tid; const bool forced = (s == 0) || (s == cur) || (s == cur - 1);
        score[s] = forced ? 1e4f : (s <= cur ? imp[s] : -1e4f); }
    __syncthreads();
    if (tid < 128) { const int s = tid; const float my = score[s]; int rank = 0;
        for (int j = 0; j < 128; ++j) { const float o = score[j]; rank += (o > my || (o == my && j < s)) ? 1 : 0; }
        if (rank < 16 && s <= cur) { const int slot = atomicAdd(nlist, 1); list[slot] = s; } }
    __syncthreads();
    const int ns = *nlist * 64;
    for (int i = tid; i < ns; i += 256) { const int pos = list[i >> 6] * 64 + (i & 63);
        if (pos <= t) { const bf16* k = a.ks + ((size_t)bg * T_ + pos) * 64; _Pragma("unroll 1") for (int rr = 0; rr < 4; ++rr) sc[rr][i] = dot64(qs[rr], k); }
        else { sc[0][i] = -INFINITY; sc[1][i] = -INFINITY; sc[2][i] = -INFINITY; sc[3][i] = -INFINITY; } }
    __syncthreads();
    softmax_row(sc[r], ns, lane);
    __syncthreads();
    float os = 0.f; { const bf16* v = a.vst + ((size_t)bg * 64 + d) * T_;
        for (int i = 0; i < ns; ++i) { const int pos = list[i >> 6] * 64 + (i & 63); if (pos <= t) os += sc[r][i] * bf2f(v[pos]); } }
    __syncthreads();
    const int lo = t - 511 > 0 ? t - 511 : 0, nw = t - lo + 1;
    for (int i = tid; i < nw; i += 256) { const bf16* k = a.kw + ((size_t)bg * T_ + lo + i) * 64;
        _Pragma("unroll 1") for (int rr = 0; rr < 4; ++rr) sc[rr][i] = dot64(qs[rr], k); }
    __syncthreads();
    softmax_row(sc[r], nw, lane);
    __syncthreads();
    float ow = 0.f; { const bf16* v = a.vwt + ((size_t)bg * 64 + d) * T_ + lo; for (int i = 0; i < nw; ++i) ow += sc[r][i] * bf2f(v[i]); }
    const float* gt = a.gates + row * 24 + g * 12 + r * 3;
    a.amix[row * DM + g * 256 + r * 64 + d] = (bf16)f2bf(gt[0] * oc + gt[1] * os + gt[2] * ow);
    __syncthreads();
}


namespace nsa {
typedef float f32x16 __attribute__((ext_vector_type(16)));
constexpr int KROW = 144, VROW = 136, KBUF = 64 * KROW, VBUF = 64 * VROW;
constexpr int OFF_K = 0, OFF_V = 2 * KBUF, OFF_IMP = OFF_V + 2 * VBUF, IMPW = 130, OFF_SEL = OFF_IMP + 64 * IMPW * 4, OFF_UM = OFF_SEL + 1024, OFF_WS = OFF_UM + 16, OFF_UNIT = OFF_WS + 1024, OFF_ACC = OFF_UNIT + 16, LDS_NEED = OFF_ACC + 8 * 8192;
static_assert(LDS_NEED <= 147456 - 64 && OFF_ACC % 16 == 0, "nsa lds");
static_assert(OFF_IMP % 16 == 0 && OFF_SEL % 16 == 0 && OFF_WS % 16 == 0, "nsa lds map");
__device__ __forceinline__ int crow(int r, int hi) { return (r & 3) + 8 * (r >> 2) + 4 * hi; }
__device__ __forceinline__ int next_bit(unsigned m0, unsigned m1, unsigned m2, unsigned m3, int from) {
#pragma unroll
    for (int wd = 0; wd < 4; ++wd) {
        unsigned x = wd == 0 ? m0 : (wd == 1 ? m1 : (wd == 2 ? m2 : m3)); const int base = wd * 32;
        if (from < base + 32) { if (from > base) x &= (~0u) << (from - base); if (x) return base + __builtin_ctz(x); }
    }
    return 128;
}
__device__ __forceinline__ bf16x8 pack8(const f32x16& p, int b0) {
    u32x4 w; w.x = pk2(p[b0 + 0], p[b0 + 1]); w.y = pk2(p[b0 + 2], p[b0 + 3]); w.z = pk2(p[b0 + 4], p[b0 + 5]); w.w = pk2(p[b0 + 6], p[b0 + 7]);
    return __builtin_bit_cast(bf16x8, w);
}
struct Branch { const bf16* k; const bf16* vt; int ldv; };

constexpr float THR = 8.f;
template <int MODE, bool SEL>
__device__ __forceinline__ void compute_tile(unsigned char* sm, int cb, int j, const bf16x8 (&qf)[4], int lo, int hi_b, int lo_max, int hi_min, unsigned s0, unsigned s1, unsigned s2, unsigned s3,
                                             float& m, float& l, float invl, bool& initd, f32x16& negm, f32x16 (&o)[2], float* imp_row, float* wsc, int i, int hi) {
        const unsigned char* kb = sm + OFF_K + cb * KBUF; const unsigned char* vb = sm + OFF_V + cb * VBUF;
        const int key0 = 64 * j;
        bool rowsel = true;
        if (SEL) { const unsigned wsel = j < 32 ? s0 : (j < 64 ? s1 : (j < 96 ? s2 : s3)); rowsel = (wsel >> (j & 31)) & 1u; }
        if (!SEL || __any(rowsel)) {
            f32x16 p0, p1;
            {
                f32x16 c0;
                if (SEL) {
#pragma unroll
                    for (int r = 0; r < 16; ++r) c0[r] = rowsel ? negm[r] : -INFINITY;
                } else c0 = negm;
                bf16x8 ka[8];
#pragma unroll
                for (int d0 = 0; d0 < 4; ++d0) { ka[2 * d0] = *(const bf16x8*)(kb + i * KROW + (16 * d0 + 8 * hi) * 2); ka[2 * d0 + 1] = *(const bf16x8*)(kb + (32 + i) * KROW + (16 * d0 + 8 * hi) * 2); }
                __builtin_amdgcn_sched_barrier(0);
                p0 = __builtin_amdgcn_mfma_f32_32x32x16_bf16(ka[0], qf[0], c0, 0, 0, 0);
                p1 = __builtin_amdgcn_mfma_f32_32x32x16_bf16(ka[1], qf[0], c0, 0, 0, 0);
#pragma unroll
                for (int d0 = 1; d0 < 4; ++d0) {
                    p0 = __builtin_amdgcn_mfma_f32_32x32x16_bf16(ka[2 * d0], qf[d0], p0, 0, 0, 0);
                    p1 = __builtin_amdgcn_mfma_f32_32x32x16_bf16(ka[2 * d0 + 1], qf[d0], p1, 0, 0, 0);
                }
            }
            bf16x8 vfr[8];
            if (MODE != 0) {
#pragma unroll
                for (int dt = 0; dt < 2; ++dt) { const unsigned char* vp = vb + (32 * dt + i) * VROW + 8 * hi;
#pragma unroll
                    for (int ks = 0; ks < 4; ++ks) { const u32x2 v_lo = *(const u32x2*)(vp + 32 * ks), v_hi = *(const u32x2*)(vp + 32 * ks + 16);
                        vfr[dt * 4 + ks] = __builtin_bit_cast(bf16x8, (u32x4){v_lo.x, v_lo.y, v_hi.x, v_hi.y}); } }
                __builtin_amdgcn_sched_barrier(0);
            }
            if (!(key0 >= lo_max && key0 + 63 <= hi_min)) {
#pragma unroll
                for (int r = 0; r < 16; ++r) { const int key = key0 + crow(r, hi);
                    if (key < lo || key > hi_b) p0[r] = -INFINITY;
                    if (key + 32 < lo || key + 32 > hi_b) p1[r] = -INFINITY; }
            }
            if (MODE == 1) {
#pragma unroll
                for (int r = 0; r < 16; ++r) { p0[r] = __builtin_amdgcn_exp2f(p0[r]) * invl; p1[r] = __builtin_amdgcn_exp2f(p1[r]) * invl; }
#pragma unroll
                for (int gq = 0; gq < 4; ++gq) {
                    float G0 = (p0[4 * gq] + p0[4 * gq + 1]) + (p0[4 * gq + 2] + p0[4 * gq + 3]), L0 = p0[4 * gq + 3];
                    float G1 = (p1[4 * gq] + p1[4 * gq + 1]) + (p1[4 * gq + 2] + p1[4 * gq + 3]), L1 = p1[4 * gq + 3];
                    G0 += __shfl_xor(G0, 1); L0 += __shfl_xor(L0, 1); G1 += __shfl_xor(G1, 1); L1 += __shfl_xor(L1, 1);
                    G0 += __shfl_xor(G0, 2); L0 += __shfl_xor(L0, 2); G1 += __shfl_xor(G1, 2); L1 += __shfl_xor(L1, 2);
                    if ((i & 3) == 0) { const int s = 16 * j + 2 * gq + hi;
                        atomicAdd(imp_row + s, G0); atomicAdd(imp_row + s + 1, L0); atomicAdd(imp_row + s + 8, G1); atomicAdd(imp_row + s + 9, L1); }
                }
            } else {
                float ta = fmaxf(fmaxf(p0[0], p0[1]), p1[0]), tb = fmaxf(fmaxf(p0[2], p0[3]), p1[1]);
                ta = fmaxf(fmaxf(ta, p1[2]), p1[3]);
#pragma unroll
                for (int r = 4; r < 16; r += 4) { ta = fmaxf(fmaxf(ta, p0[r]), p0[r + 1]); tb = fmaxf(fmaxf(tb, p0[r + 2]), p0[r + 3]); ta = fmaxf(fmaxf(ta, p1[r]), p1[r + 1]); tb = fmaxf(fmaxf(tb, p1[r + 2]), p1[r + 3]); }
                float tm = fmaxf(ta, tb);
                tm = fmaxf(tm, __shfl_xor(tm, 32));
                if (__any((!initd && tm > -INFINITY) || tm > THR)) {
                    const bool was = initd;
                    const float d = was ? fmaxf(tm, 0.f) : (tm > -INFINITY ? tm : 0.f);
                    initd = was || (tm > -INFINITY);
                    m += d; const float alpha = was ? __builtin_amdgcn_exp2f(-d) : 1.f; l *= alpha;
#pragma unroll
                    for (int r = 0; r < 16; ++r) { p0[r] -= d; p1[r] -= d; negm[r] = -m; }
                    if (MODE == 2) {
                        if (hi == 0) wsc[i] = alpha;
                        asm volatile("" ::: "memory");
#pragma unroll
                        for (int rg = 0; rg < 4; ++rg) { const f32x4 a4 = *(const f32x4*)(wsc + 8 * rg + 4 * hi);
#pragma unroll
                            for (int e = 0; e < 4; ++e) { o[0][4 * rg + e] *= a4[e]; o[1][4 * rg + e] *= a4[e]; } }
                        asm volatile("" ::: "memory");
                    }
                }
                float rs = 0.f;
#pragma unroll
                for (int r = 0; r < 16; ++r) { p0[r] = __builtin_amdgcn_exp2f(p0[r]); p1[r] = __builtin_amdgcn_exp2f(p1[r]); rs += p0[r] + p1[r]; }
                l += rs;
            }
            if (MODE != 0) {
                const bf16x8 pf0 = pack8(p0, 0), pf1 = pack8(p0, 8), pf2 = pack8(p1, 0), pf3 = pack8(p1, 8);
#pragma unroll
                for (int dt = 0; dt < 2; ++dt)
#pragma unroll
                    for (int ks = 0; ks < 4; ++ks)
                        o[dt] = __builtin_amdgcn_mfma_f32_32x32x16_bf16(ks == 0 ? pf0 : (ks == 1 ? pf1 : (ks == 2 ? pf2 : pf3)), vfr[dt * 4 + ks], o[dt], 0, 0, 0);
            }
        }
}
template <int MODE, bool SEL>
__device__ __forceinline__ void run_branch(unsigned char* sm, const Branch br, unsigned m0, unsigned m1, unsigned m2, unsigned m3,
                                           const bf16x8 (&qf)[4], int lo, int hi_b, int lo_max, int hi_min, unsigned s0, unsigned s1, unsigned s2, unsigned s3,
                                           float& m, float& l, float invl, f32x16 (&o)[2], float* imp_row, float* wsc, int tid, int lane) {
    const int i = lane & 31, hi = lane >> 5;
    const bf16* kp = br.k + tid * 8; const bf16* vp_ = br.vt + (size_t)(tid >> 3) * br.ldv + (tid & 7) * 8;
    unsigned char* kst = sm + OFF_K + (tid >> 3) * KROW + (tid & 7) * 16; unsigned char* vst = sm + OFF_V + (tid >> 3) * VROW + (tid & 7) * 16;
#define NSA_LOAD(jj, KR, VR) do { KR = *(const u32x4*)(kp + (size_t)(jj) * 4096); if (MODE != 0) VR = *(const u32x4*)(vp_ + (jj) * 64); } while (0)
#define NSA_STORE(buf, KR, VR) do { *(u32x4*)(kst + (buf) * KBUF) = KR; if (MODE != 0) { *(u32x2*)(vst + (buf) * VBUF) = (u32x2){VR.x, VR.y}; *(u32x2*)(vst + (buf) * VBUF + 8) = (u32x2){VR.z, VR.w}; } } while (0)
    int j = next_bit(m0, m1, m2, m3, 0);
    int j1 = j < 128 ? next_bit(m0, m1, m2, m3, j + 1) : 128;
    u32x4 kA, vA, kB, vB;
    if (j < 128) { NSA_LOAD(j, kA, vA); if (j1 < 128) NSA_LOAD(j1, kB, vB); NSA_STORE(0, kA, vA); }
    __syncthreads();
    bool initd = (MODE == 1);
    f32x16 negm;
#pragma unroll
    for (int r = 0; r < 16; ++r) negm[r] = (MODE == 1) ? -m : 0.f;
    while (j < 128) {
        {
            const int j2 = j1 < 128 ? next_bit(m0, m1, m2, m3, j1 + 1) : 128;
            NSA_LOAD(j2 < 128 ? j2 : j, kA, vA);
            compute_tile<MODE, SEL>(sm, 0, j, qf, lo, hi_b, lo_max, hi_min, s0, s1, s2, s3, m, l, invl, initd, negm, o, imp_row, wsc, i, hi);
            if (j1 < 128) NSA_STORE(1, kB, vB);
            __syncthreads();
            j = j1; j1 = j2;
        }
        if (j >= 128) break;
        {
            const int j2 = j1 < 128 ? next_bit(m0, m1, m2, m3, j1 + 1) : 128;
            NSA_LOAD(j2 < 128 ? j2 : j, kB, vB);
            compute_tile<MODE, SEL>(sm, 1, j, qf, lo, hi_b, lo_max, hi_min, s0, s1, s2, s3, m, l, invl, initd, negm, o, imp_row, wsc, i, hi);
            if (j1 < 128) NSA_STORE(0, kA, vA);
            __syncthreads();
            j = j1; j1 = j2;
        }
    }
#undef NSA_LOAD
#undef NSA_STORE
}
template <bool FIRST> __device__ __forceinline__ void add_scaled(float* accw, const f32x16 (&o)[2], float f, float* wsc, int i, int hi, int lane) {
    if (hi == 0) wsc[i] = f;
    asm volatile("" ::: "memory");
#pragma unroll
    for (int rg = 0; rg < 4; ++rg) { const f32x4 a4 = *(const f32x4*)(wsc + 8 * rg + 4 * hi);
#pragma unroll
        for (int e = 0; e < 4; ++e)
#pragma unroll
            for (int dt = 0; dt < 2; ++dt) { float* p = accw + (dt * 16 + 4 * rg + e) * 64 + lane; const float v = a4[e] * o[dt][4 * rg + e]; *p = FIRST ? v : (*p + v); } }
    asm volatile("" ::: "memory");
}
__device__ __forceinline__ void unit(const NsaArgs& a, int u, unsigned char* sm) {
    const int tid = tidx(), lane = tid & 63, w = __builtin_amdgcn_readfirstlane(tid >> 6), i = lane & 31, hi = lane >> 5;
    const int cur = 127 - (u >> 2), bg = u & 3, b = bg >> 1, g = bg & 1, q0 = cur * 64;
    const int ql = 8 * w + (i >> 2), hd = i & 3, t = q0 + ql;
    const size_t grow = (size_t)b * T_ + t;
    bf16x8 qf[4];
    { const bf16* qp = a.qb + grow * 512 + g * 256 + hd * 64 + 8 * hi;
#pragma unroll
      for (int d0 = 0; d0 < 4; ++d0) qf[d0] = *(const bf16x8*)(qp + 16 * d0); }
    float* wsc = (float*)(sm + OFF_WS) + w * 32;
    float* imp = (float*)(sm + OFF_IMP);
    unsigned* selw = (unsigned*)(sm + OFF_SEL);
    unsigned* um = (unsigned*)(sm + OFF_UM);
    for (int k = tid; k < 64 * IMPW; k += 512) imp[k] = 0.f;
    if (tid < 4) um[tid] = 0u;
    const float* gt = a.gates + grow * 24 + g * 12 + hd * 3;
    const float gc = gt[0], gs = gt[1], gw = gt[2];
    f32x16 o[2];
    float* accw = (float*)(sm + OFF_ACC) + w * 2048;
    const int tw0 = q0 + 8 * w, tw1 = tw0 + 7;
    {
        const int nv = t < 31 ? 0 : (t - 31) / 16 + 1;
        const int nvw = tw0 < 31 ? 0 : (tw0 - 31) / 16 + 1;
        const int nvmax = (q0 + 63 - 31) / 16 + 1, ntc = (nvmax + 63) / 64;
        const unsigned cm0 = ntc >= 32 ? ~0u : ((1u << ntc) - 1u);
        const Branch br{a.kc + (size_t)bg * NCP * 64, a.vct + (size_t)bg * 64 * NCP, NCP};
        float m = 0.f, l = 0.f;
        run_branch<0, false>(sm, br, cm0, 0u, 0u, 0u, qf, 0, nv - 1, 0, nvw - 1, 0u, 0u, 0u, 0u, m, l, 0.f, o, nullptr, wsc, tid, lane);
        l += __shfl_xor(l, 32);
        const float invl = 1.f / fmaxf(l, 1e-30f);
#pragma unroll
        for (int r = 0; r < 16; ++r) { o[0][r] = 0.f; o[1][r] = 0.f; }
        run_branch<1, false>(sm, br, cm0, 0u, 0u, 0u, qf, 0, nv - 1, 0, nvw - 1, 0u, 0u, 0u, 0u, m, l, invl, o, imp + ql * IMPW, wsc, tid, lane);
        add_scaled<true>(accw, o, gc, wsc, i, hi, lane);
    }
    {
        unsigned u0 = 0u, u1 = 0u, u2 = 0u, u3 = 0u;
        const int ncand = cur - 2;
        unsigned k0[8], k1[8], k2[8], k3[8];
        if (ncand <= 13) {
#pragma unroll
            for (int wd = 0; wd < 4; ++wd) { const int nb = cur + 1 - 32 * wd; const unsigned x = nb >= 32 ? ~0u : (nb <= 0 ? 0u : ((1u << nb) - 1u));
#pragma unroll
                for (int qq = 0; qq < 8; ++qq) { if (wd == 0) k0[qq] = x; else if (wd == 1) k1[qq] = x; else if (wd == 2) k2[qq] = x; else k3[qq] = x; } }
        } else {
            unsigned q0[8], q1[8];
#pragma unroll
            for (int qq = 0; qq < 8; ++qq) { const float* ir = imp + (8 * w + qq) * IMPW;
                q0[qq] = (lane >= 1 && lane <= cur - 2) ? ((__builtin_bit_cast(unsigned, ir[lane]) & 0xFFFFFF80u) | (unsigned)(127 - lane)) : 0u;
                q1[qq] = (lane + 64 <= cur - 2) ? ((__builtin_bit_cast(unsigned, ir[lane + 64]) & 0xFFFFFF80u) | (unsigned)(63 - lane)) : 0u;
                k0[qq] = 1u; k1[qq] = 0u; k2[qq] = 0u; k3[qq] = 0u; }
            for (int it = 0; it < 13; ++it) {
#pragma unroll
                for (int qq = 0; qq < 8; ++qq) {
                    unsigned mx = q0[qq] > q1[qq] ? q0[qq] : q1[qq];
                    { const unsigned o_ = (unsigned)__builtin_amdgcn_update_dpp(0, (int)mx, 0xB1, 0xF, 0xF, true); mx = o_ > mx ? o_ : mx; }
                    { const unsigned o_ = (unsigned)__builtin_amdgcn_update_dpp(0, (int)mx, 0x4E, 0xF, 0xF, true); mx = o_ > mx ? o_ : mx; }
                    { const unsigned o_ = (unsigned)__builtin_amdgcn_update_dpp(0, (int)mx, 0x141, 0xF, 0xF, true); mx = o_ > mx ? o_ : mx; }
                    { const unsigned o_ = (unsigned)__builtin_amdgcn_update_dpp(0, (int)mx, 0x140, 0xF, 0xF, true); mx = o_ > mx ? o_ : mx; }
                    const unsigned r0 = (unsigned)__builtin_amdgcn_readlane((int)mx, 0), r1 = (unsigned)__builtin_amdgcn_readlane((int)mx, 16), r2 = (unsigned)__builtin_amdgcn_readlane((int)mx, 32), r3 = (unsigned)__builtin_amdgcn_readlane((int)mx, 48);
                    const unsigned ra = r0 > r1 ? r0 : r1, rb = r2 > r3 ? r2 : r3, best = ra > rb ? ra : rb;
                    if (q0[qq] == best) q0[qq] = 0u; if (q1[qq] == best) q1[qq] = 0u;
                    const int b_ = 127 - (int)(best & 127u);
                    const unsigned bit = 1u << (b_ & 31);
                    if (b_ < 32) k0[qq] |= bit; else if (b_ < 64) k1[qq] |= bit; else if (b_ < 96) k2[qq] |= bit; else k3[qq] |= bit; }
            }
            { const int c1 = cur - 1; const unsigned b1 = 1u << (c1 & 31), b2 = 1u << (cur & 31);
#pragma unroll
              for (int qq = 0; qq < 8; ++qq) {
                if (c1 < 32) k0[qq] |= b1; else if (c1 < 64) k1[qq] |= b1; else if (c1 < 96) k2[qq] |= b1; else k3[qq] |= b1;
                if (cur < 32) k0[qq] |= b2; else if (cur < 64) k1[qq] |= b2; else if (cur < 96) k2[qq] |= b2; else k3[qq] |= b2; } }
        }
#pragma unroll
        for (int qq = 0; qq < 8; ++qq) {
            if (lane == 0) { unsigned* sp = selw + (8 * w + qq) * 4; sp[0] = k0[qq]; sp[1] = k1[qq]; sp[2] = k2[qq]; sp[3] = k3[qq]; }
            u0 |= k0[qq]; u1 |= k1[qq]; u2 |= k2[qq]; u3 |= k3[qq]; }
        if (lane == 0) { atomicOr(um + 0, u0); atomicOr(um + 1, u1); atomicOr(um + 2, u2); atomicOr(um + 3, u3); }
    }
    __syncthreads();
    {
        const unsigned U0 = um[0], U1 = um[1], U2 = um[2], U3 = um[3];
        const unsigned* sp = selw + ql * 4; const unsigned s0 = sp[0], s1 = sp[1], s2 = sp[2], s3 = sp[3];
        const Branch br{a.ks + (size_t)bg * T_ * 64, a.vst + (size_t)bg * 64 * T_, T_};
        float m = 0.f, l = 0.f;
#pragma unroll
        for (int r = 0; r < 16; ++r) { o[0][r] = 0.f; o[1][r] = 0.f; }
        run_branch<2, true>(sm, br, __builtin_amdgcn_readfirstlane(U0), __builtin_amdgcn_readfirstlane(U1), __builtin_amdgcn_readfirstlane(U2), __builtin_amdgcn_readfirstlane(U3),
                            qf, 0, t, 0, tw0, s0, s1, s2, s3, m, l, 0.f, o, nullptr, wsc, tid, lane);
        l += __shfl_xor(l, 32);
        add_scaled<false>(accw, o, gs / fmaxf(l, 1e-30f), wsc, i, hi, lane);
    }
    {
        const int j0 = cur - 8 > 0 ? cur - 8 : 0;
        unsigned wm0 = 0u, wm1 = 0u, wm2 = 0u, wm3 = 0u;
#pragma unroll
        for (int wd = 0; wd < 4; ++wd) { const int a0 = j0 - 32 * wd, a1 = cur + 1 - 32 * wd;
            const unsigned hi_m = a1 >= 32 ? ~0u : (a1 <= 0 ? 0u : ((1u << a1) - 1u)), lo_m = a0 >= 32 ? ~0u : (a0 <= 0 ? 0u : ((1u << a0) - 1u));
            const unsigned x = hi_m & ~lo_m; if (wd == 0) wm0 = x; else if (wd == 1) wm1 = x; else if (wd == 2) wm2 = x; else wm3 = x; }
        const Branch br{a.kw + (size_t)bg * T_ * 64, a.vwt + (size_t)bg * 64 * T_, T_};
        float m = 0.f, l = 0.f;
#pragma unroll
        for (int r = 0; r < 16; ++r) { o[0][r] = 0.f; o[1][r] = 0.f; }
        run_branch<2, false>(sm, br, wm0, wm1, wm2, wm3, qf, t - 511, t, tw1 - 511, tw0, 0u, 0u, 0u, 0u, m, l, 0.f, o, nullptr, wsc, tid, lane);
        l += __shfl_xor(l, 32);
        add_scaled<false>(accw, o, gw / fmaxf(l, 1e-30f), wsc, i, hi, lane);
    }
#pragma unroll
    for (int r = 0; r < 16; ++r) { const int rw = crow(r, hi), qq = 8 * w + (rw >> 2), hh = rw & 3;
        bf16* op = a.amix + ((size_t)b * T_ + q0 + qq) * DM + g * 256 + hh * 64 + i;
        op[0] = (bf16)f2bf(accw[r * 64 + lane]); op[32] = (bf16)f2bf(accw[(16 + r) * 64 + lane]); }
}
__device__ __forceinline__ void phase(const NsaArgs& a, unsigned* ctr, unsigned char* sm) {
    int* slot = (int*)(sm + OFF_UNIT);
    for (;;) {
        if (tidx() == 0) *slot = (int)atomicAdd(ctr, 1u);
        __syncthreads();
        const int u = *slot;
        __syncthreads();
        if (u >= 512) break;
        unit(a, u, sm);
    }
}
}

__device__ __forceinline__ void d_lora_prep(const bf16* pr, const float* mu, bf16* la, int wg0 = 0) {
    if ((int)blockIdx.x < wg0) return;
    const int T512 = tidx(), c = T512 & 255;
    const float m = mu[1536 + c];
    for (int vb = ((int)blockIdx.x - wg0) * 2 + (T512 >> 8); vb < M_ / 4; vb += ((int)gridDim.x - wg0) * 2) {
        const int row0 = vb * 4;
        float x[5];
        x[0] = (row0 % T_) ? bf2f(pr[(size_t)(row0 - 1) * 256 + c]) : 0.f;
#pragma unroll
        for (int j = 0; j < 4; ++j) x[j + 1] = bf2f(pr[(size_t)(row0 + j) * 256 + c]);
#pragma unroll
        for (int j = 0; j < 4; ++j) { const float xs = x[j + 1] + (x[j] - x[j + 1]) * m;
            const float v = c < 64 ? tanhf(xs) : (c < 128 ? xs : sigmoidf_(xs));
            la[(size_t)(row0 + j) * KLORA + c] = (bf16)f2bf(v); }
    }
}

namespace rw7 {
using nsa::f32x16; using nsa::crow; using nsa::pack8;
constexpr int NHELP = 2, RG = 18;
constexpr int NPROD = 6, RING = 7, RA = 144, RB = 40, S_AT = 0, S_RT = 16 * RA, S_BT = 32 * RA, S_KT = S_BT + 64 * RB, S_VT = S_KT + 64 * RB, S_SM = S_VT + 64 * RB, SMM = 16 * RB, S_GC = S_SM + 4 * SMM, SLOT = S_GC + 256;
constexpr int OFF_SCR = RING * SLOT, SCR = 32 * RA, LDS_NEED = OFF_SCR;
static_assert(NPROD % NHELP == 0 && LDS_NEED <= 147456 - 64 && 7 * (SLOT + SCR) <= 147456 - 64 && (size_t)16 * NHELP * RG * SLOT <= (size_t)9 << 20 && SLOT % 16 == 0 && S_BT % 16 == 0 && 128 * RB >= 4096 && SCR >= 4096, "rw7 lds map");
struct Args { const unsigned* rkw; const bf16* vv; const bf16* aga; const float* wdec; const float *mu, *kk, *ka, *rk; float* yraw; float* bonus; unsigned char* ring; unsigned* flags; unsigned* cons; };
__device__ __forceinline__ void wg_bar() { asm volatile("s_waitcnt lgkmcnt(0)" ::: "memory"); __builtin_amdgcn_s_barrier(); asm volatile("" ::: "memory"); }
struct Chan { float mur, muk, muv, kkc, kac, rkc; };
struct Raw { unsigned rk[16]; unsigned short v[16], al[16]; float w[16]; unsigned prk; unsigned short pv; };
__device__ __forceinline__ void fetch(const Args& a, int b, int h, int c, int lane, Raw& q) {
    const size_t base = ((size_t)b * T_ + (size_t)c * 16) * 512 + h * 64 + lane;
#pragma unroll
    for (int t = 0; t < 16; ++t) { q.rk[t] = a.rkw[base + (size_t)t * 512]; q.v[t] = a.vv[base + (size_t)t * 512]; q.al[t] = a.aga[base + (size_t)t * 512]; q.w[t] = a.wdec[base + (size_t)t * 512]; }
    q.prk = 0u; q.pv = 0;
    if (c > 0) { q.prk = a.rkw[base - 512]; q.pv = a.vv[base - 512]; }
}
__device__ __forceinline__ void st_row40(unsigned char* p, const unsigned (&w)[8]) {
    *(u32x2*)p = (u32x2){w[0], w[1]}; *(u32x2*)(p + 8) = (u32x2){w[2], w[3]}; *(u32x2*)(p + 16) = (u32x2){w[4], w[5]}; *(u32x2*)(p + 24) = (u32x2){w[6], w[7]};
}
template <bool BAR> __device__ __forceinline__ void seg_end() { if (BAR) wg_bar(); else { asm volatile("s_waitcnt lgkmcnt(0)" ::: "memory"); __builtin_amdgcn_sched_barrier(0); } }
template <bool BAR> __device__ __forceinline__ void produce(const Args& a, const Chan& ch, int b, int h, int c, const Raw& q, unsigned char* slot, unsigned char* scr, int lane) {
    const int i = lane & 31, hi = lane >> 5;
    const size_t row0 = (size_t)b * T_ + (size_t)c * 16;
    float pr_r = __builtin_bit_cast(float, q.prk << 16), pr_k = __builtin_bit_cast(float, q.prk & 0xffff0000u), pr_v = bf2f(q.pv);
    float rr[16], kq[16], kt[16];
    float* RED1 = (float*)scr;
    float* RED2 = (float*)(slot + S_BT);
#pragma unroll
    for (int t4 = 0; t4 < 4; ++t4) { f32x4 e1, e2;
#pragma unroll
        for (int e = 0; e < 4; ++e) { const int t = 4 * t4 + e;
            const float r0 = __builtin_bit_cast(float, q.rk[t] << 16), k0 = __builtin_bit_cast(float, q.rk[t] & 0xffff0000u), al = bf2f(q.al[t]);
            const float r = r0 + (pr_r - r0) * ch.mur, k = k0 + (pr_k - k0) * ch.muk;
            pr_r = r0; pr_k = k0;
            rr[t] = r; kq[t] = k * ch.kkc; kt[t] = k * (1.f + (al - 1.f) * ch.kac);
            e1[e] = kq[t] * kq[t]; e2[e] = r * kt[t] * ch.rkc; }
        *(f32x4*)(RED1 + lane * 16 + 4 * t4) = e1; *(f32x4*)(RED2 + lane * 16 + 4 * t4) = e2; }
    seg_end<BAR>();
    { const int t = lane & 15, part = lane >> 4; float s1 = 0.f, s2 = 0.f;
#pragma unroll
      for (int j = 0; j < 16; ++j) { s1 += RED1[(part * 16 + j) * 16 + t]; s2 += RED2[(part * 16 + j) * 16 + t]; }
      s1 += __shfl_xor(s1, 16); s2 += __shfl_xor(s2, 16); s1 += __shfl_xor(s1, 32); s2 += __shfl_xor(s2, 32);
      asm volatile("s_waitcnt lgkmcnt(0)" ::: "memory");
      if (lane < 16) { ((float*)(slot + S_GC))[lane] = s1; a.bonus[(row0 + lane) * 8 + h] = s2; } }
    asm volatile("s_waitcnt lgkmcnt(0)" ::: "memory");
    f32x4 n2[4];
#pragma unroll
    for (int t4 = 0; t4 < 4; ++t4) n2[t4] = *(const f32x4*)(slot + S_GC + 16 * t4);
    asm volatile("s_waitcnt lgkmcnt(0)" ::: "memory");
    float gam = 1.f;
    unsigned btp[8], ktp[8], vtp[8];
    float b_ev = 0.f, k_ev = 0.f, v_ev = 0.f;
#pragma unroll
    for (int t = 0; t < 16; ++t) {
        if (t == 6) seg_end<BAR>();
        const float v0 = bf2f(q.v[t]), al = bf2f(q.al[t]);
        const float v = v0 + (pr_v - v0) * ch.muv; pr_v = v0;
        const float kkn = kq[t] * __builtin_amdgcn_rsqf(fmaxf(n2[t >> 2][t & 3], 1e-24f));
        const float gp = gam; gam *= q.w[t]; const float ig = __builtin_amdgcn_rcpf(gam);
        const float bt_ = kkn * al * ig, kt_ = kt[t] * ig;
        const unsigned ar = pk2(-kkn * gp, rr[t] * gam), bk = pk2(bt_, kt_);
        *(bf16*)(slot + S_AT + t * RA + lane * 2) = (bf16)(ar & 0xffffu); *(bf16*)(slot + S_RT + t * RA + lane * 2) = (bf16)(ar >> 16);
        *(bf16*)(scr + t * RA + lane * 2) = (bf16)(bk & 0xffffu); *(bf16*)(scr + (16 + t) * RA + lane * 2) = (bf16)(bk >> 16);
        if (t & 1) { btp[t >> 1] = pk2(b_ev, bt_); ktp[t >> 1] = pk2(k_ev, kt_); vtp[t >> 1] = pk2(v_ev, v); }
        else { b_ev = bt_; k_ev = kt_; v_ev = v; }
    }
    st_row40(slot + S_BT + lane * RB, btp); st_row40(slot + S_KT + lane * RB, ktp); st_row40(slot + S_VT + lane * RB, vtp);
    ((float*)(slot + S_GC))[lane] = gam;
    seg_end<BAR>();
    f32x16 C;
#pragma unroll
    for (int r = 0; r < 16; ++r) C[r] = 0.f;
#pragma unroll
    for (int ks = 0; ks < 4; ++ks) {
        const bf16x8 af = *(const bf16x8*)(slot + S_AT + i * RA + (16 * ks + 8 * hi) * 2);
        const bf16x8 bf = *(const bf16x8*)(scr + i * RA + (16 * ks + 8 * hi) * 2);
        C = __builtin_amdgcn_mfma_f32_32x32x16_bf16(af, bf, C, 0, 0, 0);
    }
    asm volatile("s_waitcnt lgkmcnt(0)" ::: "memory");
    float* AAB = (float*)scr;
    unsigned char* SM = slot + S_SM;
#pragma unroll
    for (int r = 0; r < 16; ++r) {
        const int rho = crow(r, hi); const float val = C[r];
        if (r < 8) {
            if (i < 16) AAB[rho * 16 + i] = (i < rho) ? val : 0.f;
            else *(bf16*)(SM + SMM + rho * RB + (i - 16) * 2) = (bf16)f2bf((i - 16 < rho) ? val : 0.f);
        } else {
            const int tt = rho - 16;
            if (i < 16) *(bf16*)(SM + 2 * SMM + tt * RB + i * 2) = (bf16)f2bf((i <= tt) ? val : 0.f);
            else *(bf16*)(SM + 3 * SMM + tt * RB + (i - 16) * 2) = (bf16)f2bf((i - 16 <= tt) ? val : 0.f);
        }
    }
    seg_end<BAR>();
    { const int j = lane & 15; float Tr[16];
#pragma unroll
      for (int t = 0; t < 16; ++t) { if (t == 11) seg_end<BAR>();
          float acc = (t == j) ? 1.f : 0.f;
#pragma unroll
          for (int s4 = 0; s4 < (t + 3) / 4; ++s4) { const f32x4 ar = *(const f32x4*)(AAB + t * 16 + 4 * s4);
#pragma unroll
              for (int e = 0; e < 4; ++e) if (4 * s4 + e < t) acc += ar[e] * Tr[4 * s4 + e]; }
          Tr[t] = acc;
          if (lane < 16) *(bf16*)(SM + t * RB + j * 2) = (bf16)f2bf(acc); } }
    seg_end<BAR>();
}

__device__ __forceinline__ bf16x8 rd_perm(const unsigned char* p, int hi) {
    const u32x2 a = *(const u32x2*)(p + 8 * hi), b = *(const u32x2*)(p + 16 + 8 * hi);
    return __builtin_bit_cast(bf16x8, (u32x4){a.x, a.y, b.x, b.y});
}
__device__ __forceinline__ bf16x8 rd_nat(const unsigned char* p, int hi) {
    const u32x2 a = *(const u32x2*)(p + 16 * hi), b = *(const u32x2*)(p + 16 * hi + 8);
    return __builtin_bit_cast(bf16x8, (u32x4){a.x, a.y, b.x, b.y});
}
__device__ __forceinline__ bf16x8 and8(bf16x8 f, unsigned m) { u32x4 w = __builtin_bit_cast(u32x4, f); w.x &= m; w.y &= m; w.z &= m; w.w &= m; return __builtin_bit_cast(bf16x8, w); }
__device__ __forceinline__ void consume(const unsigned char* slot, f32x16 (&z)[2], float* yout, int vt, int lane) {
    const int i = lane & 31, hi = lane >> 5, i16 = i & 15;
    const unsigned m16 = i < 16 ? 0xffffffffu : 0u;
    const unsigned char* at = slot + S_AT + i16 * RA; const unsigned char* rt = slot + S_RT + i16 * RA; const unsigned char* sm16 = slot + S_SM + i16 * RB;
    bf16x8 fa0 = rd_perm(at, hi), fa1 = rd_perm(at + 32, hi), fa2 = rd_perm(at + 64, hi), fa3 = rd_perm(at + 96, hi);
    bf16x8 fak = rd_nat(sm16 + SMM, hi), ft = rd_perm(sm16, hi);
    const bf16x8 vtf = rd_nat(slot + S_VT + (32 * vt + i) * RB, hi);
    bf16x8 fr0 = rd_perm(rt, hi), fr1 = rd_perm(rt + 32, hi), fr2 = rd_perm(rt + 64, hi), fr3 = rd_perm(rt + 96, hi);
    bf16x8 frb = rd_perm(sm16 + 2 * SMM, hi), frk = rd_nat(sm16 + 3 * SMM, hi);
    const bf16x8 fk0 = rd_nat(slot + S_KT + i * RB, hi), fk1 = rd_nat(slot + S_KT + (32 + i) * RB, hi);
    const bf16x8 fb0 = rd_perm(slot + S_BT + i * RB, hi), fb1 = rd_perm(slot + S_BT + (32 + i) * RB, hi);
    f32x4 g4[2][4];
#pragma unroll
    for (int kt = 0; kt < 2; ++kt)
#pragma unroll
        for (int rg = 0; rg < 4; ++rg) g4[kt][rg] = *(const f32x4*)(slot + S_GC + (32 * kt + 8 * rg + 4 * hi) * 4);
    const bf16x8 zb0 = pack8(z[0], 0), zb1 = pack8(z[0], 8), zb2 = pack8(z[1], 0), zb3 = pack8(z[1], 8);
    fa0 = and8(fa0, m16); fa1 = and8(fa1, m16); fa2 = and8(fa2, m16); fa3 = and8(fa3, m16); fak = and8(fak, m16); ft = and8(ft, m16);
    fr0 = and8(fr0, m16); fr1 = and8(fr1, m16); fr2 = and8(fr2, m16); fr3 = and8(fr3, m16); frb = and8(frb, m16); frk = and8(frk, m16);
    f32x16 X, U, Y;
#pragma unroll
    for (int r = 0; r < 16; ++r) { X[r] = 0.f; U[r] = 0.f; Y[r] = 0.f; }
    X = __builtin_amdgcn_mfma_f32_32x32x16_bf16(fa0, zb0, X, 0, 0, 0);
    X = __builtin_amdgcn_mfma_f32_32x32x16_bf16(fa1, zb1, X, 0, 0, 0);
    X = __builtin_amdgcn_mfma_f32_32x32x16_bf16(fa2, zb2, X, 0, 0, 0);
    X = __builtin_amdgcn_mfma_f32_32x32x16_bf16(fa3, zb3, X, 0, 0, 0);
    X = __builtin_amdgcn_mfma_f32_32x32x16_bf16(fak, vtf, X, 0, 0, 0);
    Y = __builtin_amdgcn_mfma_f32_32x32x16_bf16(fr0, zb0, Y, 0, 0, 0);
    Y = __builtin_amdgcn_mfma_f32_32x32x16_bf16(fr1, zb1, Y, 0, 0, 0);
    Y = __builtin_amdgcn_mfma_f32_32x32x16_bf16(fr2, zb2, Y, 0, 0, 0);
    Y = __builtin_amdgcn_mfma_f32_32x32x16_bf16(fr3, zb3, Y, 0, 0, 0);
    Y = __builtin_amdgcn_mfma_f32_32x32x16_bf16(frk, vtf, Y, 0, 0, 0);
    z[0] = __builtin_amdgcn_mfma_f32_32x32x16_bf16(fk0, vtf, z[0], 0, 0, 0);
    z[1] = __builtin_amdgcn_mfma_f32_32x32x16_bf16(fk1, vtf, z[1], 0, 0, 0);
    const bf16x8 xb = pack8(X, 0);
    U = __builtin_amdgcn_mfma_f32_32x32x16_bf16(ft, xb, U, 0, 0, 0);
    const bf16x8 ub = pack8(U, 0);
    z[0] = __builtin_amdgcn_mfma_f32_32x32x16_bf16(fb0, ub, z[0], 0, 0, 0);
    z[1] = __builtin_amdgcn_mfma_f32_32x32x16_bf16(fb1, ub, z[1], 0, 0, 0);
    Y = __builtin_amdgcn_mfma_f32_32x32x16_bf16(frb, ub, Y, 0, 0, 0);
#pragma unroll
    for (int kt = 0; kt < 2; ++kt)
#pragma unroll
        for (int rg = 0; rg < 4; ++rg)
#pragma unroll
            for (int e = 0; e < 4; ++e) z[kt][4 * rg + e] *= g4[kt][rg][e];
#pragma unroll
    for (int r = 0; r < 8; ++r) yout[(size_t)crow(r, hi) * 512] = Y[r];
}

__device__ __forceinline__ unsigned ld_relaxed(const unsigned* p) { return __hip_atomic_load(p, __ATOMIC_RELAXED, __HIP_MEMORY_SCOPE_AGENT); }
__device__ __forceinline__ void head(const Args& a, int bh, unsigned char* sm) {
    const int tid = tidx(), lane = tid & 63, w = __builtin_amdgcn_readfirstlane(tid >> 6);
    const int b = bh >> 3, h = bh & 7;
    constexpr int NCH = T_ / 16, NBAR = NCH + NPROD;
    if (w < 2) {
        f32x16 z[2];
#pragma unroll
        for (int r = 0; r < 16; ++r) { z[0][r] = 0.f; z[1][r] = 0.f; }
        for (int i = 0; i < NPROD; ++i) wg_bar();
        for (int c = 0; c < NCH; ++c) {
            consume(sm + (size_t)(c % RING) * SLOT, z, a.yraw + ((size_t)b * T_ + (size_t)c * 16) * 512 + h * 64 + 32 * w + (lane & 31), w, lane);
            if (w == 0 && (c & 7) == 7 && lane == 0) __hip_atomic_store(a.cons + bh * 64, (unsigned)(c + 1), __ATOMIC_RELAXED, __HIP_MEMORY_SCOPE_AGENT);
            wg_bar();
        }
    } else {
        const int pw = w - 2;
        int nb = pw;
        {
            u32x4 v[15];
            { const int c = pw; const int hl = c % NHELP, n = c / NHELP;
              const unsigned char* g = a.ring + ((size_t)(bh * NHELP + hl) * RG + (n % RG)) * SLOT;
              while (__builtin_amdgcn_readfirstlane(ld_relaxed(a.flags + bh * NCH + c)) == 0u) __builtin_amdgcn_s_sleep(2);
              __builtin_amdgcn_fence(__ATOMIC_ACQUIRE, "agent");
              asm volatile("s_waitcnt vmcnt(0)" ::: "memory");
#pragma unroll
              for (int i = 0; i < 15; ++i) { const int off = (i * 64 + lane) * 16; if (off < SLOT) v[i] = *(const u32x4*)(g + off); } }
            for (int i = 0; i < pw; ++i) wg_bar();
            for (int c = pw; c < NCH; c += NPROD) {
                unsigned char* slot = sm + (size_t)(c % RING) * SLOT;
#pragma unroll
                for (int i = 0; i < 15; ++i) { const int off = (i * 64 + lane) * 16; if (off < SLOT) *(u32x4*)(slot + off) = v[i]; }
                const int cn = c + NPROD; const bool more = cn < NCH;
                const unsigned* fp = a.flags + bh * NCH + (more ? cn : c);
                unsigned fl = ld_relaxed(fp);
                wg_bar(); wg_bar();
                if (more) {
                    while (__builtin_amdgcn_readfirstlane(fl) == 0u) { __builtin_amdgcn_s_sleep(2); fl = ld_relaxed(fp); }
                    __builtin_amdgcn_fence(__ATOMIC_ACQUIRE, "agent");
                    asm volatile("s_waitcnt vmcnt(0)" ::: "memory");
                    const int hl = cn % NHELP, n = cn / NHELP;
                    const unsigned char* g = a.ring + ((size_t)(bh * NHELP + hl) * RG + (n % RG)) * SLOT;
#pragma unroll
                    for (int i = 0; i < 15; ++i) { const int off = (i * 64 + lane) * 16; if (off < SLOT) v[i] = *(const u32x4*)(g + off); }
                }
                wg_bar(); wg_bar(); wg_bar(); wg_bar();
                nb += NPROD;
            }
        }
        for (; nb < NBAR; ++nb) wg_bar();
    }
}
constexpr int NHW = 7;
__device__ __forceinline__ void helper(const Args& a, int bh, int hl, unsigned char* sm) {
    const int tid = tidx(), lane = tid & 63, w = __builtin_amdgcn_readfirstlane(tid >> 6);
    if (w >= NHW) return;
    const int b = bh >> 3, h = bh & 7, col = h * 64 + lane;
    constexpr int NCH = T_ / 16;
    unsigned char* slot = sm + (size_t)w * SLOT; unsigned char* scr = sm + NHW * SLOT + w * SCR;
    const Chan ch{a.mu[col], a.mu[512 + col], a.mu[1024 + col], a.kk[col], a.ka[col], a.rk[col]};
    int n = w, c = NHELP * n + hl;
    if (c >= NCH) return;
    for (; c < NCH; n += NHW, c += NHW * NHELP) {
        Raw q; fetch(a, b, h, c, lane, q);
        if (n >= RG) { const unsigned need = (unsigned)(c - RG * NHELP + 1);
            while (__builtin_amdgcn_readfirstlane(ld_relaxed(a.cons + bh * 64)) < need) __builtin_amdgcn_s_sleep(8); }
        produce<false>(a, ch, b, h, c, q, slot, scr, lane);
        asm volatile("s_waitcnt lgkmcnt(0)" ::: "memory");
        unsigned char* g = a.ring + ((size_t)(bh * NHELP + hl) * RG + (n % RG)) * SLOT;
#pragma unroll
        for (int i = 0; i < 15; ++i) { const int off = (i * 64 + lane) * 16;
            if (off < SLOT) { const u32x4 d = *(const u32x4*)(slot + off); unsigned char* gp = g + off; asm volatile("global_store_dwordx4 %0, %1, off sc1\n\ts_nop 1" :: "v"(gp), "v"(d) : "memory"); } }
        asm volatile("s_waitcnt vmcnt(0)" ::: "memory");
        if (lane == 0) __hip_atomic_store(a.flags + bh * NCH + c, 1u, __ATOMIC_RELAXED, __HIP_MEMORY_SCOPE_AGENT);
    }
}
__device__ __forceinline__ void finish(const float* yraw, const float* bonus, const bf16* vv, const bf16* agg, const float* mu, const float* gng, const float* gnb, bf16* amix) {
    const int T512 = tidx(), lane = T512 & 63;
    for (int row = blockIdx.x * 8 + (T512 >> 6); row < M_; row += gridDim.x * 8) {
        const int t = row % T_;
        float y[8], v0[8], v1[8], gg[8], bo[8];
#pragma unroll
        for (int j = 0; j < 8; ++j) { const int col = j * 64 + lane;
            y[j] = yraw[(size_t)row * 512 + col]; v0[j] = bf2f(vv[(size_t)row * 512 + col]); v1[j] = t ? bf2f(vv[(size_t)(row - 1) * 512 + col]) : 0.f;
            gg[j] = bf2f(agg[(size_t)row * 512 + col]); bo[j] = bonus[(size_t)row * 8 + j]; }
        float mean[8], var[8];
#pragma unroll
        for (int j = 0; j < 8; ++j) mean[j] = y[j];
#pragma unroll
        for (int o = 1; o < 64; o <<= 1) {
#pragma unroll
            for (int j = 0; j < 8; ++j) mean[j] += __shfl_xor(mean[j], o); }
#pragma unroll
        for (int j = 0; j < 8; ++j) { mean[j] *= (1.f / 64.f); y[j] -= mean[j]; var[j] = y[j] * y[j]; }
#pragma unroll
        for (int o = 1; o < 64; o <<= 1) {
#pragma unroll
            for (int j = 0; j < 8; ++j) var[j] += __shfl_xor(var[j], o); }
#pragma unroll
        for (int j = 0; j < 8; ++j) { const int col = j * 64 + lane;
            const float yn = y[j] * rsqrtf(var[j] * (1.f / 64.f) + 64e-5f) * gng[col] + gnb[col];
            const float v = v0[j] + (v1[j] - v0[j]) * mu[1024 + col];
            amix[(size_t)row * DM + 512 + col] = (bf16)f2bf((yn + bo[j] * v) * gg[j]); }
    }
}
}

namespace mema {
using nsa::f32x16; using nsa::KROW; using nsa::VROW; using nsa::KBUF; using nsa::VBUF; using nsa::OFF_K; using nsa::OFF_V; using nsa::OFF_WS; using nsa::crow; using nsa::pack8;
__device__ __forceinline__ void unit(const bf16* qm, const bf16* mk, const bf16* mvt, bf16* om, int u, unsigned char* sm) {
    const int tid = tidx(), lane = tid & 63, w = __builtin_amdgcn_readfirstlane(tid >> 6), i = lane & 31, hi = lane >> 5;
    const int b = u >> 7, h = (u >> 5) & 3, rb = u & 31;
    const int row0 = b * T_ + rb * 256 + 32 * w;
    const bf16* qrow = qm + (size_t)(row0 + i) * DM + h * 256 + 8 * hi;
    const bf16* kbase = mk + (size_t)(b * 256 + (tid >> 3)) * DM + h * 256 + (tid & 7) * 8;
    const bf16* vbase = mvt + (size_t)(h * 256 + (tid >> 3)) * 512 + b * 256 + (tid & 7) * 8;
    unsigned char* kst = sm + OFF_K + (tid >> 3) * KROW + (tid & 7) * 16;
    unsigned char* vst = sm + OFF_V + (tid >> 3) * VROW + (tid & 7) * 16;
    float* wsc = (float*)(sm + OFF_WS) + w * 32;
    f32x16 p[4][2];
#pragma unroll
    for (int kt = 0; kt < 4; ++kt)
#pragma unroll
        for (int r = 0; r < 16; ++r) { p[kt][0][r] = 0.f; p[kt][1][r] = 0.f; }
    u32x4 tr[4];
#define MEMA_SRC(n) ((n) < 16 ? (const u32x4*)(kbase + (size_t)(64 * ((n) & 3)) * DM + 64 * ((n) >> 2)) : (const u32x4*)(vbase + (size_t)(64 * (((n) - 16) >> 2)) * 512 + 64 * ((n) & 3)))
#define MEMA_PUT(n) do { if ((n) < 16) *(u32x4*)(kst + ((n) & 1) * KBUF) = tr[(n) & 3]; else { unsigned char* vp2_ = vst + ((n) & 1) * VBUF; *(u32x2*)vp2_ = (u32x2){tr[(n) & 3].x, tr[(n) & 3].y}; *(u32x2*)(vp2_ + 8) = (u32x2){tr[(n) & 3].z, tr[(n) & 3].w}; } } while (0)
    tr[0] = *MEMA_SRC(0); tr[1] = *MEMA_SRC(1); tr[2] = *MEMA_SRC(2);
    MEMA_PUT(0);
    __syncthreads();
    bf16x8 qf[4];
#pragma unroll
    for (int n = 0; n < 16; ++n) {
        const int dc = n >> 2, kt = n & 3, cb = n & 1;
        tr[(n + 3) & 3] = *MEMA_SRC(n + 3);
        if (kt == 0) {
#pragma unroll
            for (int d0 = 0; d0 < 4; ++d0) qf[d0] = *(const bf16x8*)(qrow + 64 * dc + 16 * d0);
        }
        const unsigned char* kb = sm + OFF_K + cb * KBUF;
#pragma unroll
        for (int d0 = 0; d0 < 4; ++d0) {
            const bf16x8 a0 = *(const bf16x8*)(kb + i * KROW + (16 * d0 + 8 * hi) * 2);
            const bf16x8 a1 = *(const bf16x8*)(kb + (32 + i) * KROW + (16 * d0 + 8 * hi) * 2);
            p[kt][0] = __builtin_amdgcn_mfma_f32_32x32x16_bf16(a0, qf[d0], p[kt][0], 0, 0, 0);
            p[kt][1] = __builtin_amdgcn_mfma_f32_32x32x16_bf16(a1, qf[d0], p[kt][1], 0, 0, 0);
        }
        MEMA_PUT(n + 1);
        __syncthreads();
    }
    float mx = p[0][0][0];
#pragma unroll
    for (int kt = 0; kt < 4; ++kt)
#pragma unroll
        for (int r = 0; r < 16; ++r) mx = fmaxf(mx, fmaxf(p[kt][0][r], p[kt][1][r]));
    mx = fmaxf(mx, __shfl_xor(mx, 32));
    float l = 0.f;
#pragma unroll
    for (int kt = 0; kt < 4; ++kt)
#pragma unroll
        for (int r = 0; r < 16; ++r) { p[kt][0][r] = __builtin_amdgcn_exp2f(p[kt][0][r] - mx); p[kt][1][r] = __builtin_amdgcn_exp2f(p[kt][1][r] - mx); l += p[kt][0][r] + p[kt][1][r]; }
    l += __shfl_xor(l, 32);
    bf16x8 pf[4][4];
#pragma unroll
    for (int kt = 0; kt < 4; ++kt) { pf[kt][0] = pack8(p[kt][0], 0); pf[kt][1] = pack8(p[kt][0], 8); pf[kt][2] = pack8(p[kt][1], 0); pf[kt][3] = pack8(p[kt][1], 8); }
    if (hi == 0) wsc[i] = 1.f / l;
    asm volatile("" ::: "memory");
    f32x4 il[4];
#pragma unroll
    for (int rg = 0; rg < 4; ++rg) il[rg] = *(const f32x4*)(wsc + 8 * rg + 4 * hi);
    f32x16 o[2];
#pragma unroll
    for (int n = 16; n < 32; ++n) {
        const int dvt = (n - 16) >> 2, kt = n & 3, cb = n & 1;
        if (n + 3 < 32) tr[(n + 3) & 3] = *MEMA_SRC(n + 3);
        if (kt == 0) {
#pragma unroll
            for (int r = 0; r < 16; ++r) { o[0][r] = 0.f; o[1][r] = 0.f; }
        }
        const unsigned char* vb = sm + OFF_V + cb * VBUF;
#pragma unroll
        for (int dt = 0; dt < 2; ++dt) {
            const unsigned char* vp = vb + (32 * dt + i) * VROW + 8 * hi;
#pragma unroll
            for (int ks = 0; ks < 4; ++ks) {
                const u32x2 v_lo = *(const u32x2*)(vp + 32 * ks), v_hi = *(const u32x2*)(vp + 32 * ks + 16);
                const bf16x8 vf = __builtin_bit_cast(bf16x8, (u32x4){v_lo.x, v_lo.y, v_hi.x, v_hi.y});
                o[dt] = __builtin_amdgcn_mfma_f32_32x32x16_bf16(pf[kt][ks], vf, o[dt], 0, 0, 0);
            }
        }
        if (kt == 3) {
#pragma unroll
            for (int r = 0; r < 16; ++r) { bf16* op = om + (size_t)(row0 + crow(r, hi)) * DM + h * 256 + 64 * dvt + i;
                op[0] = (bf16)f2bf(o[0][r] * il[r >> 2][r & 3]); op[32] = (bf16)f2bf(o[1][r] * il[r >> 2][r & 3]); }
        }
        if (n + 1 < 32) MEMA_PUT(n + 1);
        __syncthreads();
    }
#undef MEMA_SRC
#undef MEMA_PUT
}
}

#define LAS __attribute__((address_space(3)))
#define XB_TMO      128
#define XB_XCNT(j)  (256  + 64 * (j))
#define XB_XSUB(j)  (1280 + 64 * (j))
#define XB_XGEN(j)  (2304 + 64 * (j))
#define XB_TOP      3328
#define XB_TOPGEN   3392
#define XCD_BAR_WORDS 3456
#define XB_SPIN_CAP (1u << 18)

__device__ __forceinline__ unsigned xb_ld(unsigned* p)              { return __hip_atomic_load(p, __ATOMIC_RELAXED, __HIP_MEMORY_SCOPE_AGENT); }
__device__ __forceinline__ unsigned xb_add(unsigned* p, unsigned v) { return __hip_atomic_fetch_add(p, v, __ATOMIC_RELAXED, __HIP_MEMORY_SCOPE_AGENT); }
__device__ __forceinline__ unsigned xb_xcc_id() { return (unsigned)__builtin_amdgcn_s_getreg((3 << 11) | 20) & 0xFu; }
#define XB_SPIN(cond, bar) do { unsigned _sp = 0; while (cond) { __builtin_amdgcn_s_sleep(1); \
    if ((++_sp & 255u) == 0u) { if (xb_ld(&(bar)[XB_TMO])) break; if (_sp > XB_SPIN_CAP) { atomicAdd(&(bar)[XB_TMO], 1u); break; } } } } while (0)

struct XcdBarrier {
    unsigned* bar; unsigned x;
    volatile LAS unsigned* st;
};

__device__ __forceinline__ XcdBarrier xcd_barrier_post(unsigned* bar, volatile LAS unsigned* st) {
    XcdBarrier b; b.bar = bar; b.x = xb_xcc_id(); b.st = st;
    if (tidx() == 0) (void)xb_add(&bar[XB_XCNT(b.x)], 1u);
    return b;
}
__device__ __forceinline__ void xcd_barrier_complete(unsigned* bar, unsigned x, unsigned& nloc, unsigned& nx, unsigned gsize) {
    const unsigned G = gsize ? gsize : gridDim.x * gridDim.y * gridDim.z;
    unsigned sum, cnt, mine, sp = 0u;
    for (;;) {
        sum = 0u; cnt = 0u; mine = 0u;
#pragma unroll
        for (unsigned j = 0; j < 16; ++j) { const unsigned c = xb_ld(&bar[XB_XCNT(j)]); sum += c; cnt += (c > 0u) ? 1u : 0u; mine = (j == x) ? c : mine; }
        if (sum == G) break;
        __builtin_amdgcn_s_sleep(1);
        if ((++sp & 255u) == 0u) { if (xb_ld(&bar[XB_TMO])) break; if (sp > XB_SPIN_CAP) { atomicAdd(&bar[XB_TMO], 1u); break; } }
    }
    nloc = mine > 0u ? mine : 1u; nx = cnt > 0u ? cnt : 1u;
}

__device__ __forceinline__ void xcd_barrier(const XcdBarrier& b, unsigned gsize = 0u) {
    asm volatile("s_waitcnt vmcnt(0)" ::: "memory");
    __syncthreads();
    if (tidx() == 0) {
        unsigned* bar = b.bar;
        __builtin_amdgcn_s_waitcnt(0);
        unsigned nloc = b.st[0], nx = b.st[1];
        if (nloc == 0u) { xcd_barrier_complete(bar, b.x, nloc, nx, gsize); b.st[0] = nloc; b.st[1] = nx; }
        const unsigned old = xb_add(&bar[XB_XSUB(b.x)], 1u);
        const unsigned gen = old / nloc;
        if (old + 1u == (gen + 1u) * nloc) {
            __builtin_amdgcn_fence(__ATOMIC_RELEASE, "agent");
            asm volatile("s_waitcnt vmcnt(0)" ::: "memory");
            const unsigned og = xb_add(&bar[XB_TOP], 1u);
            const unsigned tg = og / nx;
            if (og + 1u == (tg + 1u) * nx) xb_add(&bar[XB_TOPGEN], 1u);
            else XB_SPIN(xb_ld(&bar[XB_TOPGEN]) == tg, bar);
            __builtin_amdgcn_fence(__ATOMIC_ACQUIRE, "agent");
            xb_add(&bar[XB_XGEN(b.x)], 1u);
            asm volatile("s_waitcnt vmcnt(0)" ::: "memory");
        } else {
            XB_SPIN(xb_ld(&bar[XB_XGEN(b.x)]) == gen, bar);
            __builtin_amdgcn_fence(__ATOMIC_ACQUIRE, "agent");
            asm volatile("s_waitcnt vmcnt(0)" ::: "memory");
        }
    }
    __syncthreads();
}

constexpr int NTHREADS = 512, LDS_BYTES = 147456;
struct MegaArgs { const float* in[41]; float* out; unsigned char* ws; };
#define WSB(off) ((bf16*)(ws + (off)))
#define WSF(off) ((float*)(ws + (off)))

__global__ void __launch_bounds__(NTHREADS) mega_fwd(MegaArgs A) {
    extern __shared__ __attribute__((aligned(16))) unsigned char lds[];
    cg::grid_group grid = cg::this_grid();
    const float* const* in = A.in; unsigned char* ws = A.ws; float* out = A.out;
    if (tidx() < 4) ((volatile LAS unsigned*)(lds + LDS_BYTES - 64))[tidx()] = 0u;
    __syncthreads();
    const XcdBarrier xbar = xcd_barrier_post((unsigned*)(ws + WS_CTL) + 16384, (volatile LAS unsigned*)(lds + LDS_BYTES - 64));
    constexpr int NRW = 16 * (1 + rw7::NHELP);
    if ((int)blockIdx.x >= NRW && tidx() == 0) (void)xb_add(&((unsigned*)(ws + WS_CTL) + 20480)[XB_XCNT(xb_xcc_id())], 1u);

    d_convert(WSB(WS_W1GU), NGU, DM, MapGU{in[I_F1_WG], in[I_F1_WU], FF});
    d_convert(WSB(WS_WIN), NWIN, DM, MapWin{in[I_WIN], IN_COLS});
    d_convert(WSB(WS_CW1K), 256, 2048, MapPlain{in[I_W1_K], 256});
    d_convert(WSB(WS_CW1V), 256, 2048, MapPlain{in[I_W1_V], 256});
    d_convert_lora(WSB(WS_WLORA), in[I_W2], in[I_A2], in[I_G2]);
    d_convert(WSB(WS_WK), DM, DM, MapPlain{in[I_WK], DM});
    d_convert(WSB(WS_WV), DM, DM, MapPlain{in[I_WV], DM});
    d_convert(WSB(WS_CW2), 64, 256, MapPlain{in[I_W2_K], 64});
    d_convert(WSB(WS_CW2) + 64 * 256, 64, 256, MapPlain{in[I_W2_V], 64});
    d_rope_table(WSF(WS_ROPE));
    d_cmp_bias(in[I_PE_K], in[I_W1_K], in[I_PE_V], in[I_W1_V], WSF(WS_CBIAS), (float*)lds);
    d_rownorm(in[I_X], in[I_F1_PRE], WSB(WS_XN), M_);
    d_rownorm(in[I_MEM], in[I_MEM_KVG], WSB(WS_MEMN), 512);
    grid.sync();
    gemm_pg8(lds, WSB(WS_XN), DM, WSB(WS_W1GU), DM, M_, NGU, DM, EpiSwiGLU{WSB(WS_HB)});
    d_convert(WSB(WS_W1D), DM, FF, MapPlain{in[I_F1_WD], DM}, 128);
    xcd_barrier(xbar);
    gemm_norm_res<false, true>(lds, WSB(WS_HB), FF, WSB(WS_W1D), FF, in[I_X], out, WSB(WS_XN), in[I_F1_POST], in[I_MIX_PRE], 0.5f, (unsigned*)(ws + WS_GATES), (unsigned*)(ws + WS_CTL) + 1024 + 0 * 2048);
    xcd_barrier(xbar);
    gemm_pg8(lds, WSB(WS_XN), DM, WSB(WS_WIN), DM, M_, 3072, DM,
             EpiWin{WSB(WS_QB), WSB(WS_KS), WSB(WS_KW), WSB(WS_KCR), WSB(WS_VCR), WSB(WS_VST), WSB(WS_VWT), (unsigned*)(ws + WS_RKVA), WSB(WS_RKVA + 32 * MiB), WSB(WS_PRL), WSF(WS_GATES), WSF(WS_ROPE)});
    d_gates(WSB(WS_XN), WSB(WS_WIN) + (size_t)3072 * DM, WSF(WS_GATES), (float*)lds);
    if (blockIdx.x == 0) { const int t_ = tidx(); float b_ = 0.f; for (int jc = 0; jc < 8; ++jc) b_ += WSF(WS_CBIAS)[jc * 512 + t_]; WSF(WS_CBIAS)[4096 + t_] = b_; }
    xcd_barrier(xbar);
    d_lora_prep(WSB(WS_PRL), in[I_MU], WSB(WS_XN));
    xcd_barrier(xbar);
    gemm_pg8(lds, WSB(WS_XN), KLORA, WSB(WS_WLORA), KLORA, M_, NLORA, KLORA, EpiLora{WSF(WS_YB), WSB(WS_RKVA + 48 * MiB), WSB(WS_AGG), in[I_W0], in[I_A0]});
    xcd_barrier(xbar);
    if ((int)blockIdx.x < NRW) {
        const rw7::Args ra{(const unsigned*)(ws + WS_RKVA), WSB(WS_RKVA + 32 * MiB), WSB(WS_RKVA + 48 * MiB), WSF(WS_YB), in[I_MU], in[I_KK], in[I_KA], in[I_RK], WSF(WS_YB), WSF(WS_BONUS),
                           ws + WS_BONUS + 1 * MiB, (unsigned*)(ws + WS_CTL) + 32768, (unsigned*)(ws + WS_CTL) + 24576};
        if (blockIdx.x < 16) rw7::head(ra, blockIdx.x, lds);
        else rw7::helper(ra, (blockIdx.x - 16) % 16, (blockIdx.x - 16) / 16, lds);
        __syncthreads();
        if (tidx() == 0) { unsigned* f = (unsigned*)(ws + WS_CTL) + 64; unsigned sp = 0u; while (xb_ld(f) == 0u && ++sp < (1u << 22)) __builtin_amdgcn_s_sleep(2); }
        __builtin_amdgcn_fence(__ATOMIC_ACQUIRE, "agent");
        asm volatile("s_waitcnt vmcnt(0)" ::: "memory");
        __syncthreads();
    } else {
        XcdBarrier sb; sb.bar = (unsigned*)(ws + WS_CTL) + 20480; sb.x = xb_xcc_id(); sb.st = (volatile LAS unsigned*)(lds + LDS_BYTES - 56);
        { float* part = (float*)(ws + WS_XN + 8 * MiB);
          gemm_pg8(lds, WSB(WS_KCR), 1024, WSB(WS_CW1K), 2048, 2048, 256, 1024, EpiStoreF32{part, 256}, NRW);
          gemm_pg8(lds, WSB(WS_KCR) + 1024, 1024, WSB(WS_CW1K) + 1024, 2048, 2048, 256, 1024, EpiStoreF32{part + (size_t)2048 * 256, 256}, NRW + 8);
          gemm_pg8(lds, WSB(WS_VCR), 1024, WSB(WS_CW1V), 2048, 2048, 256, 1024, EpiStoreF32{part + (size_t)2 * 2048 * 256, 256}, NRW + 16);
          gemm_pg8(lds, WSB(WS_VCR) + 1024, 1024, WSB(WS_CW1V) + 1024, 2048, 2048, 256, 1024, EpiStoreF32{part + (size_t)3 * 2048 * 256, 256}, NRW + 24); }
        gemm_pg8(lds, WSB(WS_MEMN), DM, WSB(WS_WK), DM, 512, DM, DM, EpiStore{WSB(WS_HIDK), DM, 1.f}, NRW + 32);
        gemm_pg8(lds, WSB(WS_WV), DM, WSB(WS_MEMN), DM, DM, 512, DM, EpiStore{WSB(WS_HIDV), 512, 1.f}, NRW + 40);
        d_convert(WSB(WS_W2GU), NGU, DM, MapGU{in[I_F2_WG], in[I_F2_WU], FF}, NRW + 48);
        d_convert(WSB(WS_W2D), DM, FF, MapPlain{in[I_F2_WD], DM}, NRW + 48);
        d_convert(WSB(WS_WOUT), DM, DM, MapPlain{in[I_WOUT], DM}, NRW + 48);
        d_convert(WSB(WS_WQ), DM, DM, MapPlain{in[I_WQ], DM}, NRW + 48);
        d_convert(WSB(WS_WO), DM, DM, MapPlain{in[I_WO], DM}, NRW + 48);
        xcd_barrier(sb, 256u - NRW);
        d_cmp2((const float*)(ws + WS_XN + 8 * MiB), WSF(WS_CBIAS) + 4096, WSB(WS_CW2), WSF(WS_ROPE), WSB(WS_KC), WSB(WS_VCT), NRW);
        xcd_barrier(sb, 256u - NRW);
        if ((int)blockIdx.x == NRW && tidx() == 0) __hip_atomic_store((unsigned*)(ws + WS_CTL) + 64, 1u, __ATOMIC_RELAXED, __HIP_MEMORY_SCOPE_AGENT);
    }
    {
        const NsaArgs na{WSB(WS_QB), WSB(WS_KC), WSB(WS_VCT), WSB(WS_KS), WSB(WS_VST), WSB(WS_KW), WSB(WS_VWT), WSF(WS_GATES), WSB(WS_XN)};
        nsa::phase(na, (unsigned*)(ws + WS_CTL), lds);
    }
    xcd_barrier(xbar);
    d_nsa_outnorm(WSB(WS_XN), in[I_NSA_G]);
    rw7::finish(WSF(WS_YB), WSF(WS_BONUS), WSB(WS_RKVA + 32 * MiB), WSB(WS_AGG), in[I_MU], in[I_GNG], in[I_GNB], WSB(WS_XN));
    xcd_barrier(xbar);
    gemm_norm_res<true, true>(lds, WSB(WS_XN), DM, WSB(WS_WOUT), DM, out, WSB(WS_YB), WSB(WS_XN), in[I_MIX_POST], in[I_MEM_PRE], 1.0f, (unsigned*)(ws + WS_GATES), (unsigned*)(ws + WS_CTL) + 1024 + 1 * 2048);
    xcd_barrier(xbar);
    gemm_pg8(lds, WSB(WS_XN), DM, WSB(WS_WQ), DM, M_, DM, DM, EpiStore{WSB(WS_QM), DM, MSCALE});
    xcd_barrier(xbar);
    if (blockIdx.x < 256) mema::unit(WSB(WS_QM), WSB(WS_HIDK), WSB(WS_HIDV), WSB(WS_OM), (int)blockIdx.x, lds);
    xcd_barrier(xbar);
    gemm_norm_res<true, true>(lds, WSB(WS_OM), DM, WSB(WS_WO), DM, WSB(WS_YB), WSB(WS_YB), WSB(WS_XN), in[I_MEM_POST], in[I_F2_PRE], 1.0f, (unsigned*)(ws + WS_GATES), (unsigned*)(ws + WS_CTL) + 1024 + 2 * 2048);
    xcd_barrier(xbar);
    gemm_pg8(lds, WSB(WS_XN), DM, WSB(WS_W2GU), DM, M_, NGU, DM, EpiSwiGLU{WSB(WS_HB)});
    xcd_barrier(xbar);
    gemm_norm_res<true, false>(lds, WSB(WS_HB), FF, WSB(WS_W2D), FF, WSB(WS_YB), out, (bf16*)nullptr, in[I_F2_POST], (const float*)nullptr, 0.5f, (unsigned*)(ws + WS_GATES), (unsigned*)(ws + WS_CTL) + 1024 + 3 * 2048);
}

extern "C" void kernel_launch(void* const* d_in, const int* in_sizes, int n_in, void* d_out, int out_size, void* d_ws, size_t ws_size, hipStream_t stream) {
    static int grid = 0;
    if (grid == 0) {
        if (n_in != 41 || ws_size < WS_END) { fprintf(stderr, "kernel_launch: unexpected n_in %d / ws %zu\n", n_in, ws_size); grid = -1; return; }
        int dev = 0, cus = 0, per_cu = 0;
        hipGetDevice(&dev); hipDeviceGetAttribute(&cus, hipDeviceAttributeMultiprocessorCount, dev);
        if (hipFuncSetAttribute((const void*)mega_fwd, hipFuncAttributeMaxDynamicSharedMemorySize, LDS_BYTES) != hipSuccess) { fprintf(stderr, "kernel_launch: hipFuncSetAttribute failed\n"); grid = -1; return; }
        if (hipOccupancyMaxActiveBlocksPerMultiprocessor(&per_cu, (const void*)mega_fwd, NTHREADS, LDS_BYTES) != hipSuccess || per_cu < 1) { fprintf(stderr, "kernel_launch: occupancy query says %d\n", per_cu); grid = -1; (void)hipGetLastError(); return; }
        grid = cus;
        if (grid != 256) { fprintf(stderr, "kernel_launch: built for 256 CUs (one 256x256 tile per workgroup in the fused norm epilogues), found %d\n", cus); grid = -1; return; }
    }
    if (grid < 0) return;
    MegaArgs a{};
    for (int i = 0; i < 41; ++i) a.in[i] = (const float*)d_in[i];
    a.out = (float*)d_out; a.ws = (unsigned char*)d_ws;
    hipMemsetAsync(d_ws, 0, 196608, stream);
    void* args[] = {&a};
    hipError_t e = hipLaunchCooperativeKernel((const void*)mega_fwd, dim3(grid), dim3(NTHREADS), args, LDS_BYTES, stream);
    if (e != hipSuccess) fprintf(stderr, "kernel_launch: cooperative launch failed: %s (grid %d)\n", hipGetErrorString(e), grid);
}
```

```cpp
#include <hip/hip_runtime.h>
#include <hip/hip_cooperative_groups.h>
#include <cstdint>
#include <cstdio>

constexpr int NB = 2, T_ = 8192, DM = 1024, M_ = NB * T_;
constexpr int FF = 2816, NGU = 2 * FF;
constexpr int IN_COLS = 3096, NWIN = 3328;
constexpr int NRW = 1792;
constexpr int NCP = 512;
constexpr int NLORA = 1536, KLORA = 256;
constexpr float NORM_EPS = 1e-6f;
constexpr float QSCALE = 0.125f * 1.4426950408889634f;
constexpr float MSCALE = 0.0625f * 1.4426950408889634f;

typedef unsigned short bf16;
typedef short bf16x8 __attribute__((ext_vector_type(8)));
typedef float f32x4 __attribute__((ext_vector_type(4)));
typedef unsigned u32x2 __attribute__((ext_vector_type(2)));
typedef unsigned u32x4 __attribute__((ext_vector_type(4)));

__device__ __forceinline__ unsigned f2bf(float f) { unsigned u = __builtin_bit_cast(unsigned, f); return (u + 0x7fffu + ((u >> 16) & 1u)) >> 16; }
__device__ __forceinline__ float bf2f(bf16 h) { return __builtin_bit_cast(float, (unsigned)h << 16); }
typedef float f32x2_t __attribute__((ext_vector_type(2))); typedef __bf16 bf16x2_t __attribute__((ext_vector_type(2)));
__device__ __forceinline__ unsigned pk2(float lo, float hi) { const f32x2_t v = {lo, hi}; return __builtin_bit_cast(unsigned, __builtin_convertvector(v, bf16x2_t)); }
__device__ __forceinline__ void st_bf4(bf16* p, f32x4 v) { u32x2 w; w.x = pk2(v[0], v[1]); w.y = pk2(v[2], v[3]); *(u32x2*)p = w; }
__device__ __forceinline__ float wave_sum(float v) {
#pragma unroll
    for (int o = 1; o < 64; o <<= 1) v += __shfl_xor(v, o);
    return v;
}
__device__ __forceinline__ float wave_max(float v) {
#pragma unroll
    for (int o = 1; o < 64; o <<= 1) v = fmaxf(v, __shfl_xor(v, o));
    return v;
}
__device__ __forceinline__ float sigmoidf_(float x) { return 1.f / (1.f + __expf(-x)); }
__device__ __forceinline__ int tidx() { int t = threadIdx.x; asm volatile("" : "+v"(t)); return t; }

constexpr size_t MiB = 1u << 20, KiB64 = 65536;
constexpr size_t WS_CTL = 0;
constexpr size_t WS_KC = 256 * 1024;
constexpr size_t WS_VCT = 512 * 1024;
constexpr size_t WS_CW2 = 768 * 1024;
constexpr size_t WS_W1GU = 1 * MiB;
constexpr size_t WS_W1D = 12 * MiB;
constexpr size_t WS_W2GU = WS_W1D + 88 * KiB64;
constexpr size_t WS_W2D = WS_W2GU + 11 * MiB;
constexpr size_t WS_WIN = WS_W2D + 88 * KiB64;
constexpr size_t WS_WOUT = WS_WIN + 104 * KiB64;
constexpr size_t WS_WQ = WS_WOUT + 2 * MiB, WS_WK = WS_WQ + 2 * MiB, WS_WV = WS_WK + 2 * MiB, WS_WO = WS_WV + 2 * MiB;
constexpr size_t WS_CW1K = WS_WO + 2 * MiB, WS_CW1V = WS_CW1K + 1 * MiB;
constexpr size_t WS_WLORA = WS_CW1V + 1 * MiB;
constexpr size_t WS_ROPE = WS_WLORA + 12 * KiB64;
constexpr size_t WS_CBIAS = WS_ROPE + 2 * MiB;
constexpr size_t WS_MEMN = WS_CBIAS + KiB64;
constexpr size_t WS_HIDK = WS_MEMN + 1 * MiB;
constexpr size_t WS_HIDV = WS_HIDK + 1 * MiB;
constexpr size_t WS_GATES = WS_HIDV + 1 * MiB;
constexpr size_t WS_XN = 60 * MiB;
constexpr size_t WS_YB = 92 * MiB;
constexpr size_t WS_D = 124 * MiB;
constexpr size_t WS_HB = WS_D;
constexpr size_t WS_QB = WS_D;
constexpr size_t WS_KS = WS_D + 16 * MiB;
constexpr size_t WS_KW = WS_D + 20 * MiB;
constexpr size_t WS_KCR = WS_D + 24 * MiB;
constexpr size_t WS_VCR = WS_D + 29 * MiB;
constexpr size_t WS_VST = WS_D + 34 * MiB;
constexpr size_t WS_VWT = WS_D + 38 * MiB;
constexpr size_t WS_RKVA = WS_D + 42 * MiB;
constexpr size_t WS_PRL = WS_D + 106 * MiB;
constexpr size_t WS_AGG = WS_D + 114 * MiB;
constexpr size_t WS_BONUS = WS_W1GU;
constexpr size_t WS_END = 256 * MiB;
constexpr size_t WS_QM = WS_D;
constexpr size_t WS_OM = WS_D + 32 * MiB;
constexpr size_t WS_MK = WS_D + 64 * MiB;
constexpr size_t WS_MVT = WS_D + 65 * MiB;
static_assert(WS_GATES + (size_t)M_ * 24 * 4 <= WS_XN, "ws map");
static_assert(WS_AGG + 16 * MiB <= WS_END, "ws map");

struct Params {
    const float* in[41];
    float* out;
    unsigned char* ws;
};
enum { I_X = 0, I_MEM, I_F1_PRE, I_F1_WG, I_F1_WU, I_F1_WD, I_F1_POST, I_MIX_PRE, I_WIN, I_PE_K, I_W1_K, I_W2_K, I_PE_V, I_W1_V, I_W2_V,
       I_NSA_G, I_MU, I_W0, I_W2, I_A0, I_A2, I_G2, I_KK, I_KA, I_RK, I_GNG, I_GNB, I_WOUT, I_MIX_POST, I_MEM_PRE, I_MEM_KVG, I_WQ, I_WK, I_WV,
       I_WO, I_MEM_POST, I_F2_PRE, I_F2_WG, I_F2_WU, I_F2_WD, I_F2_POST };

struct MapPlain { const float* W; int N; int pad; __device__ const float* col(int p) const { return W + p; } };
struct MapGU {
    const float* Wg; const float* Wu; int N; int pad;
    __device__ const float* col(int p) const {
        const int pn = p >> 8, q = p & 255, n = (q >> 4) & 1;
        const int hid = 128 * pn + 64 * (q >> 7) + 16 * ((q >> 5) & 3) + (q & 15);
        return Wg + (size_t)n * (size_t)(Wu - Wg) + hid;
    }
};
__host__ __device__ inline int rope_perm(int x) { return 16 * ((x >> 5) & 1) + (x & 15) + 32 * ((x >> 4) & 1); }
struct MapWin {
    const float* W; int N; int pad;
    __device__ const float* col(int p) const {
        int l;
        if (p < 512) l = (p & ~63) + rope_perm(p & 63);
        else if (p < 640) l = 768 + ((p - 512) & ~63) + rope_perm(p & 63);
        else if (p < 768) l = 1024 + ((p - 640) & ~63) + rope_perm(p & 63);
        else if (p < 896) l = 512 + (p - 768);
        else if (p < 1024) l = 640 + (p - 896);
        else if (p < 1152) l = 896 + (p - 1024);
        else if (p < 1280) l = 1152 + (p - 1152);
        else if (p < 2304) { const int q = p - 1280; l = 1304 + (((q >> 4) & 1) ? 512 : 0) + 16 * (q >> 5) + (q & 15); }
        else if (p < 3072) l = 1304 + (p - 1280);
        else if (p < 3096) l = 1280 + (p - 3072);
        else return nullptr;
        return W + l;
    }
};

#define FOR_VB(vb, n) for (int vb = (int)blockIdx.x * 2 + (T512 >> 8); vb < (n); vb += (int)gridDim.x * 2)

template <class Map> __device__ __forceinline__ void d_convert(bf16* WT, int Np, int K, Map map, int wg0 = 0) {
    if ((int)blockIdx.x < wg0) return;
    const int T512 = tidx(), tid = T512 & 255, nbx = Np / 64, nb = nbx * (K / 64), G = (int)gridDim.x - wg0;
    for (int vb0 = ((int)blockIdx.x - wg0) * 2 + (T512 >> 8); vb0 < nb; vb0 += G * 4) {
        const int vb1 = vb0 + G * 2; const bool two = vb1 < nb;
        const int p0 = (vb0 % nbx) * 64 + (tid & 63), k0 = (vb0 / nbx) * 64 + (tid >> 6) * 16;
        const int p1 = two ? (vb1 % nbx) * 64 + (tid & 63) : p0, k1 = two ? (vb1 / nbx) * 64 + (tid >> 6) * 16 : k0;
        const float* s0 = map.col(p0); const float* s1 = map.col(p1);
        float v[16], u[16];
#pragma unroll
        for (int i = 0; i < 16; ++i) { v[i] = s0 ? s0[(size_t)(k0 + i) * map.N] : 0.f; u[i] = s1 ? s1[(size_t)(k1 + i) * map.N] : 0.f; }
        u32x4 a, b;
        a.x = pk2(v[0], v[1]); a.y = pk2(v[2], v[3]); a.z = pk2(v[4], v[5]); a.w = pk2(v[6], v[7]);
        b.x = pk2(v[8], v[9]); b.y = pk2(v[10], v[11]); b.z = pk2(v[12], v[13]); b.w = pk2(v[14], v[15]);
        u32x4* d0 = (u32x4*)(WT + (size_t)p0 * K + k0); d0[0] = a; d0[1] = b;
        if (two) {
            a.x = pk2(u[0], u[1]); a.y = pk2(u[2], u[3]); a.z = pk2(u[4], u[5]); a.w = pk2(u[6], u[7]);
            b.x = pk2(u[8], u[9]); b.y = pk2(u[10], u[11]); b.z = pk2(u[12], u[13]); b.w = pk2(u[14], u[15]);
            u32x4* d1 = (u32x4*)(WT + (size_t)p1 * K + k1); d1[0] = a; d1[1] = b;
        }
    }
}
__device__ __forceinline__ void d_convert_lora(bf16* WT, const float* w2, const float* a2, const float* g2) {
    const int T512 = tidx(), tid = T512 & 255;
    FOR_VB(vb, NLORA * KLORA / 256) {
        const int idx = vb * 256 + tid, p = idx >> 8, k = idx & 255;
        float v = 0.f;
        if (p < 512) { if (k < 64) v = w2[k * 512 + p]; }
        else if (p < 1024) { if (k >= 64 && k < 128) v = a2[(k - 64) * 512 + (p - 512)]; }
        else { if (k >= 128) v = g2[(k - 128) * 512 + (p - 1024)]; }
        WT[idx] = (bf16)f2bf(v);
    }
}
__device__ __forceinline__ void d_rope_table(float* tab) {
    const int T512 = tidx(), tid = T512 & 255;
    FOR_VB(vb, T_ * 32 / 256) {
        const int idx = vb * 256 + tid, pos = idx >> 5, i = idx & 31;
        const float inv = (float)pow(10000.0, -(double)i / 32.0);
        const float ang = (float)pos * inv;
        tab[2 * idx] = (float)cos((double)ang); tab[2 * idx + 1] = (float)sin((double)ang);
    }
}
__device__ __forceinline__ void d_cmp_bias(const float* pe_k, const float* w1_k, const float* pe_v, const float* w1_v, float* part, float* red  ) {
    for (int job = blockIdx.x; job < 64; job += gridDim.x) {
        const int kv = job >> 5, cg_ = (job >> 3) & 3, jc = job & 7; const float* pe = kv ? pe_v : pe_k; const float* w1 = kv ? w1_v : w1_k;
        const int T512 = tidx(), lane = T512 & 63, w = T512 >> 6, n = cg_ * 64 + lane;
        float s = 0.f;
#pragma unroll 8
        for (int j = jc * 256 + w * 32; j < jc * 256 + w * 32 + 32; ++j) s += pe[j] * w1[(size_t)j * 256 + n];
        red[w * 64 + lane] = s; __syncthreads();
        if (w == 0) { float t = 0.f; for (int i = 0; i < 8; ++i) t += red[i * 64 + lane]; part[(jc * 2 + kv) * 256 + n] = t; }
        __syncthreads();
    }
}
__device__ __forceinline__ void d_rownorm(const float* x, const float* g, bf16* xn, int rows) {
    const int T512 = tidx(), tid = T512 & 255, lane = tid & 63;
    FOR_VB(vb, rows / 4) {
        const int row = vb * 4 + (tid >> 6);
        const f32x4* xr = (const f32x4*)(x + (size_t)row * DM) + lane; f32x4 v[4]; float s = 0.f;
#pragma unroll
        for (int j = 0; j < 4; ++j) { v[j] = xr[64 * j]; s += v[j][0] * v[j][0] + v[j][1] * v[j][1] + v[j][2] * v[j][2] + v[j][3] * v[j][3]; }
        const float rstd = rsqrtf(wave_sum(s) * (1.f / DM) + NORM_EPS);
#pragma unroll
        for (int j = 0; j < 4; ++j) { const f32x4 gg = ((const f32x4*)g)[lane + 64 * j]; st_bf4(xn + (size_t)row * DM + 4 * (lane + 64 * j), v[j] * rstd * gg); }
    }
}
__device__ __forceinline__ void d_rowpass(const float* xin, const bf16* y, const float* gpost, float coef, const float* gpre, float* xout, bf16* xn) {
    const int T512 = tidx(), tid = T512 & 255, lane = tid & 63;
    FOR_VB(vb, M_ / 4) {
        const int row = vb * 4 + (tid >> 6);
        f32x4 yv[4], xv[4]; float s = 0.f;
#pragma unroll
        for (int j = 0; j < 4; ++j) {
            const u32x2 w = *(const u32x2*)(y + (size_t)row * DM + 4 * (lane + 64 * j));
            yv[j][0] = __builtin_bit_cast(float, w.x << 16); yv[j][1] = __builtin_bit_cast(float, w.x & 0xffff0000u);
            yv[j][2] = __builtin_bit_cast(float, w.y << 16); yv[j][3] = __builtin_bit_cast(float, w.y & 0xffff0000u);
            s += yv[j][0] * yv[j][0] + yv[j][1] * yv[j][1] + yv[j][2] * yv[j][2] + yv[j][3] * yv[j][3];
            xv[j] = ((const f32x4*)(xin + (size_t)row * DM))[lane + 64 * j];
        }
        const float rstd = rsqrtf(wave_sum(s) * (1.f / DM) + NORM_EPS) * coef; float s2 = 0.f;
#pragma unroll
        for (int j = 0; j < 4; ++j) { const f32x4 gg = ((const f32x4*)gpost)[lane + 64 * j]; xv[j] = xv[j] + yv[j] * rstd * gg;
            s2 += xv[j][0] * xv[j][0] + xv[j][1] * xv[j][1] + xv[j][2] * xv[j][2] + xv[j][3] * xv[j][3];
            ((f32x4*)(xout + (size_t)row * DM))[lane + 64 * j] = xv[j]; }
        if (gpre) {
            const float r2 = rsqrtf(wave_sum(s2) * (1.f / DM) + NORM_EPS);
#pragma unroll
            for (int j = 0; j < 4; ++j) { const f32x4 gg = ((const f32x4*)gpre)[lane + 64 * j]; st_bf4(xn + (size_t)row * DM + 4 * (lane + 64 * j), xv[j] * r2 * gg); }
        }
    }
}
__device__ __forceinline__ void d_nsa_outnorm(bf16* amix, const float* g) {
    const int T512 = tidx(), tid = T512 & 255, lane = tid & 63;
    FOR_VB(vb, M_ / 4) {
        const int row = vb * 4 + (tid >> 6);
        bf16* p = amix + (size_t)row * DM + 8 * lane;
        const u32x4 w = *(const u32x4*)p; float v[8]; float s = 0.f;
        v[0] = __builtin_bit_cast(float, w.x << 16); v[1] = __builtin_bit_cast(float, w.x & 0xffff0000u);
        v[2] = __builtin_bit_cast(float, w.y << 16); v[3] = __builtin_bit_cast(float, w.y & 0xffff0000u);
        v[4] = __builtin_bit_cast(float, w.z << 16); v[5] = __builtin_bit_cast(float, w.z & 0xffff0000u);
        v[6] = __builtin_bit_cast(float, w.w << 16); v[7] = __builtin_bit_cast(float, w.w & 0xffff0000u);
#pragma unroll
        for (int i = 0; i < 8; ++i) s += v[i] * v[i];
        const float rstd = rsqrtf(wave_sum(s) * (1.f / 512.f) + NORM_EPS);
        u32x4 o; const float* gg = g + 8 * lane;
        o.x = pk2(v[0] * rstd * gg[0], v[1] * rstd * gg[1]); o.y = pk2(v[2] * rstd * gg[2], v[3] * rstd * gg[3]);
        o.z = pk2(v[4] * rstd * gg[4], v[5] * rstd * gg[5]); o.w = pk2(v[6] * rstd * gg[6], v[7] * rstd * gg[7]);
        *(u32x4*)p = o;
    }
}

struct EpiStore { bf16* O; int ldc; float scale;
    static constexpr int NCAT = 1;
    __device__ __forceinline__ int cat(int) const { return 0; }
    template <int C> __device__ __forceinline__ void apply(int row, int p, f32x4 v0, f32x4 v1) const { bf16* o = O + (size_t)row * ldc + p; st_bf4(o, v0 * scale); st_bf4(o + 16, v1 * scale); } };
struct EpiStoreF32 { float* O; int ldc;
    static constexpr int NCAT = 1;
    __device__ __forceinline__ int cat(int) const { return 0; }
    template <int C> __device__ __forceinline__ void apply(int row, int p, f32x4 v0, f32x4 v1) const { float* o = O + (size_t)row * ldc + p; *(f32x4*)o = v0; *(f32x4*)(o + 16) = v1; } };
struct EpiSwiGLU { bf16* H;
    static constexpr int NCAT = 1;
    __device__ __forceinline__ int cat(int) const { return 0; }
    template <int C> __device__ __forceinline__ void apply(int row, int p, f32x4 g, f32x4 u) const {
        const int q = p & 255, hid = 128 * (p >> 8) + 64 * (q >> 7) + 16 * ((q >> 5) & 3) + (q & 15);
        f32x4 h;
#pragma unroll
        for (int e = 0; e < 4; ++e) h[e] = g[e] / (1.f + __expf(-g[e])) * u[e];
        st_bf4(H + (size_t)row * FF + hid, h); } };
struct EpiBiasSilu { bf16* O; const float* bias;
    static constexpr int NCAT = 1;
    __device__ __forceinline__ int cat(int) const { return 0; }
    template <int C> __device__ __forceinline__ void apply(int row, int p, f32x4 v0, f32x4 v1) const {
        f32x4 a, b; f32x4 b0 = {0.f, 0.f, 0.f, 0.f}, b1 = {0.f, 0.f, 0.f, 0.f};
#pragma unroll
        for (int jc = 0; jc < 8; ++jc) { b0 += *(const f32x4*)(bias + jc * 512 + p); b1 += *(const f32x4*)(bias + jc * 512 + p + 16); }
#pragma unroll
        for (int e = 0; e < 4; ++e) { const float x0 = v0[e] + b0[e], x1 = v1[e] + b1[e]; a[e] = x0 / (1.f + __expf(-x0)); b[e] = x1 / (1.f + __expf(-x1)); }
        bf16* o = O + (size_t)row * 256 + p; st_bf4(o, a); st_bf4(o + 16, b); } };
struct EpiLora { float* wdec; bf16* aga; bf16* agg; const float* w0; const float* a0;
    static constexpr int NCAT = 3;
    __device__ __forceinline__ int cat(int p0) const { return p0 < 512 ? 0 : (p0 < 1024 ? 1 : 2); }
    template <int C> __device__ __forceinline__ void one(int row, int p, f32x4 v) const {
        if (C == 0) { f32x4 o; const f32x4 ww = *(const f32x4*)(w0 + p);
#pragma unroll
            for (int e = 0; e < 4; ++e) o[e] = __expf(-0.6065306597126334f * sigmoidf_(ww[e] + v[e]));
            *(f32x4*)(wdec + (size_t)row * 512 + p) = o;
        } else if (C == 1) { f32x4 o; const f32x4 aa = *(const f32x4*)(a0 + p - 512);
#pragma unroll
            for (int e = 0; e < 4; ++e) o[e] = sigmoidf_(aa[e] + v[e]);
            st_bf4(aga + (size_t)row * 512 + (p - 512), o);
        } else st_bf4(agg + (size_t)row * 512 + (p - 1024), v);
    }
    template <int C> __device__ __forceinline__ void apply(int row, int p, f32x4 v0, f32x4 v1) const { one<C>(row, p, v0); one<C>(row, p + 16, v1); } };
struct EpiWin {
    bf16 *qb, *ks, *kw, *kcr, *vcr, *vst, *vwt; unsigned* rk; bf16 *vv, *prl; float* gates; const float* rope;
    static constexpr int NCAT = 8;
    __device__ __forceinline__ int cat(int p0) const { return p0 < 512 ? 0 : (p0 < 768 ? 1 : (p0 < 1024 ? 2 : (p0 < 1280 ? 3 : (p0 < 2304 ? 4 : (p0 < 2816 ? 7 : (p0 < 3072 ? 6 : 5)))))); }
    template <int C> __device__ __forceinline__ void apply(int row, int p, f32x4 v0, f32x4 v1) const {
        const int b = row / T_, t = row % T_;
        if (C == 0 || C == 1) {
            const int x = p & 63, d = 16 * ((x >> 5) & 1) + (x & 15);
            const f32x4* rp = (const f32x4*)(rope + ((size_t)t * 32 + d) * 2); const f32x4 r0 = rp[0], r1 = rp[1];
            const f32x4 cs = {r0[0], r0[2], r1[0], r1[2]}, sn = {r0[1], r0[3], r1[1], r1[3]};
            const f32x4 lo = v0 * cs - v1 * sn, hi = v0 * sn + v1 * cs;
            if (C == 0) { bf16* o = qb + (size_t)row * 512 + (p & ~63) + d; st_bf4(o, lo * QSCALE); st_bf4(o + 32, hi * QSCALE); }
            else { const int g = ((p - 512) >> 6) & 1; bf16* base = (p < 640) ? ks : kw; bf16* o = base + ((size_t)(b * 2 + g) * T_ + t) * 64 + d; st_bf4(o, lo); st_bf4(o + 32, hi); }
        } else if (C == 2) {
            const int c = (p - 768) & 127, g = c >> 6, d = c & 63; bf16* base = (p < 896) ? kcr : vcr;
            bf16* o = base + ((size_t)(b * 2 + g) * T_ + t) * 64 + d; st_bf4(o, v0); st_bf4(o + 16, v1);
        } else if (C == 3) {
            const int c = (p - 1024) & 127, g = c >> 6, d = c & 63; bf16* base = (p < 1152) ? vst : vwt;
            bf16* o = base + ((size_t)(b * 2 + g) * 64 + d) * T_ + t;
#pragma unroll
            for (int e = 0; e < 4; ++e) { o[(size_t)e * T_] = (bf16)f2bf(v0[e]); o[(size_t)(16 + e) * T_] = (bf16)f2bf(v1[e]); }
        } else if (C == 4) {
            const int q = p - 1280, ch = 16 * (q >> 5) + (q & 15);
            u32x4 w; w.x = pk2(v0[0], v1[0]); w.y = pk2(v0[1], v1[1]); w.z = pk2(v0[2], v1[2]); w.w = pk2(v0[3], v1[3]);
            *(u32x4*)(rk + (size_t)row * 512 + ch) = w;
        } else if (C == 7) {
            bf16* o = vv + (size_t)row * 512 + (p - 2304); st_bf4(o, v0); st_bf4(o + 16, v1);
        } else if (C == 6) {
            bf16* o = prl + (size_t)row * 256 + (p - 2816); st_bf4(o, v0); st_bf4(o + 16, v1);
        } else {
            const int c = p - 3072; float* o = gates + (size_t)row * 24 + c;
            if (c < 24) { f32x4 s = {sigmoidf_(v0[0]), sigmoidf_(v0[1]), sigmoidf_(v0[2]), sigmoidf_(v0[3])}; *(f32x4*)o = s; }
            if (c + 16 < 24) { f32x4 s = {sigmoidf_(v1[0]), sigmoidf_(v1[1]), sigmoidf_(v1[2]), sigmoidf_(v1[3])}; *(f32x4*)(o + 16) = s; }
        }
    }
};

namespace pg8 {
#define PG8_LAS __attribute__((address_space(3)))
typedef unsigned short bf16_t;
typedef short bf16x8 __attribute__((ext_vector_type(8)));
typedef float f32x4 __attribute__((ext_vector_type(4)));
typedef unsigned u32x4 __attribute__((ext_vector_type(4)));
constexpr int BM = 256, BK = 64, HALF = 128, HTB = HALF * BK * 2  , STAGE_BYTES = 8 * HTB, NXCD = 8, WGM = 8;

__host__ __device__ __forceinline__ int lds_byte(int r, int c) { const int st = (r >> 4) * 2 + (c >> 5), rr = r & 15, cc = c & 31, ob = rr * 64 + cc * 2; return st * 1024 + (ob ^ (((ob >> 9) & 1) << 5)); }
__host__ __device__ __forceinline__ void stage_rc(int b, int& R, int& C) { const int st = b / 1024, sb = b % 1024, swz = sb ^ (((sb >> 9) & 1) << 5); R = (st >> 1) * 16 + swz / 64; C = (st & 1) * 32 + (swz % 64) / 2; }
__host__ __device__ __forceinline__ int perm32(int rho) { const int n = rho >> 4, i = rho & 15; return 8 * (i >> 2) + 4 * n + (i & 3); }

struct Unit { int pm, pn; };
struct Gemm { const bf16_t* A; const bf16_t* Bt; int M, N, K, lda, ldb; };

struct StaticOrder {
    int nM, nN, nwg, G, c;
    __host__ __device__ void init(int M, int N, int G_, int c_) { nM = M / BM; nN = N / BM; nwg = nM * nN; G = G_; c = c_; }
    __host__ __device__ bool next(int i, Unit& u) const {
        const long L = (long)i * G + c; if (L >= nwg) return false;
        int wgid = (int)L; { const int q = nwg / NXCD, r = nwg % NXCD, xcd = wgid % NXCD, off = wgid / NXCD; wgid = (xcd < r ? xcd * (q + 1) : r * (q + 1) + (xcd - r) * q) + off; }
        const int nig = WGM * nN, gid = wgid / nig, fm = gid * WGM, gsz = (nM - fm) < WGM ? (nM - fm) : WGM;
        u.pm = fm + ((wgid % nig) % gsz); u.pn = (wgid % nig) / gsz; return true;
    }
    __device__ __forceinline__ void a_ready(const Unit&) const {}
    __device__ __forceinline__ void done(const Unit&) const {}
};

template <class Epi, class Sched, bool ALIGN_EPI = false, bool SP2 = false>
__device__ __forceinline__ void gemm_phase(PG8_LAS unsigned char* lds, const Gemm g, const Sched& S, const Epi& E) {
    const int tid = tidx(), wid = __builtin_amdgcn_readfirstlane(tid >> 6), lane = tid & 63, wr = wid >> 2, wc = wid & 3, fr = lane & 15, fq = lane >> 4;
    const int K = g.K, nt = K / BK;
    unsigned voffA[2], voffB[2];
#pragma unroll
    for (int i = 0; i < 2; ++i) { int R, C; stage_rc(tid * 16 + i * 8192, R, C); const int Rb = Epi::PERM ? ((R & ~31) + perm32(R & 31)) : R;
        voffA[i] = (unsigned)(R * g.lda + C) * 2u; voffB[i] = (unsigned)(Rb * g.ldb + C) * 2u; }
    const size_t kstep = (size_t)(BK * 2);
    const size_t hstepA = (size_t)HALF * g.lda * 2, hstepB = (size_t)HALF * g.ldb * 2;
    const size_t tstepA = 2 * hstepA, tstepB = 2 * hstepB;
    const unsigned ldsw = (unsigned)wid * 1024u;
    const int aoff = lds_byte(wr * 64 + fr, fq * 8), boff = lds_byte(wc * 32 + fr, fq * 8);
#define PG8_SA(b, h) (((b) * 2 + (h)) * HTB)
#define PG8_SB(b, h) ((4 + (b) * 2 + (h)) * HTB)
#define PG8_STAGE(bufoff, gbase, voff) do { _Pragma("unroll") for (int _i = 0; _i < 2; ++_i) \
        __builtin_amdgcn_global_load_lds((const unsigned*)((const char*)(gbase) + (voff)[_i]), (PG8_LAS unsigned*)(lds + (bufoff) + ldsw + _i * 8192), 16, 0, 0); } while (0)
#define PG8_LDA(dst, b, h) do { _Pragma("unroll") for (int m = 0; m < 4; ++m) _Pragma("unroll") for (int k = 0; k < 2; ++k) dst[m][k] = *(const PG8_LAS bf16x8*)(lds + PG8_SA(b, h) + aoff + m * 2048 + k * 1024); } while (0)
#define PG8_LDB(dst, b, h) do { _Pragma("unroll") for (int n = 0; n < 2; ++n) _Pragma("unroll") for (int k = 0; k < 2; ++k) dst[n][k] = *(const PG8_LAS bf16x8*)(lds + PG8_SB(b, h) + boff + n * 2048 + k * 1024); } while (0)
#define PG8_MMA(ai, bj, At, Bt) do { __builtin_amdgcn_s_setprio(1); _Pragma("unroll") for (int m = 0; m < 4; ++m) _Pragma("unroll") for (int n = 0; n < 2; ++n) _Pragma("unroll") for (int k = 0; k < 2; ++k) \
        acc[ai][bj][m][n] = __builtin_amdgcn_mfma_f32_16x16x32_bf16(Bt[n][k], At[m][k], acc[ai][bj][m][n], 0, 0, 0); __builtin_amdgcn_s_setprio(0); } while (0)
#define PG8_WAIT_V(n) asm volatile("s_waitcnt vmcnt(" #n ")" ::: "memory")
#define PG8_WAIT_L(n) asm volatile("s_waitcnt lgkmcnt(" #n ")" ::: "memory")
#define PG8_BAR __builtin_amdgcn_s_barrier()
#define PG8_SCHED __builtin_amdgcn_sched_barrier(0)
    Unit cur, nxt; int ui = 0;
    if (!S.next(0, cur)) return;
    f32x4 acc[2][2][4][2];
#pragma unroll
    for (int a = 0; a < 2; ++a)
#pragma unroll
        for (int b = 0; b < 2; ++b)
#pragma unroll
            for (int m = 0; m < 4; ++m)
#pragma unroll
                for (int n = 0; n < 2; ++n) acc[a][b][m][n] = (f32x4){0.f, 0.f, 0.f, 0.f};
    bf16x8 At[4][2], B0[2][2], B1[2][2];
    const char* cA = (const char*)g.A + (size_t)cur.pm * tstepA; const char* cB = (const char*)g.Bt + (size_t)cur.pn * tstepB;
    S.a_ready(cur);
    if constexpr (SP2) {
        PG8_STAGE(PG8_SB(0, 0), cB, voffB); PG8_STAGE(PG8_SB(0, 1), cB + hstepB, voffB); PG8_STAGE(PG8_SA(0, 0), cA, voffA); PG8_STAGE(PG8_SA(0, 1), cA + hstepA, voffA);
        if (wr == 1) PG8_BAR;
        PG8_WAIT_V(2); PG8_BAR;
        PG8_STAGE(PG8_SB(1, 0), cB + kstep, voffB); PG8_STAGE(PG8_SA(1, 0), cA + kstep, voffA); PG8_STAGE(PG8_SB(1, 1), cB + hstepB + kstep, voffB);
        PG8_WAIT_V(6); PG8_BAR;
    } else {
        PG8_STAGE(PG8_SB(0, 0), cB, voffB); PG8_STAGE(PG8_SA(0, 0), cA, voffA); PG8_STAGE(PG8_SB(0, 1), cB + hstepB, voffB); PG8_STAGE(PG8_SA(0, 1), cA + hstepA, voffA);
        if (wr == 1) PG8_BAR;
        PG8_WAIT_V(4); PG8_BAR;
        PG8_STAGE(PG8_SB(1, 0), cB + kstep, voffB); PG8_STAGE(PG8_SA(1, 0), cA + kstep, voffA); PG8_STAGE(PG8_SB(1, 1), cB + hstepB + kstep, voffB);
        PG8_WAIT_V(6); PG8_BAR;
    }
    for (;;) {
        const bool has_next = S.next(ui + 1, nxt);
        const char* nA = has_next ? (const char*)g.A + (size_t)nxt.pm * tstepA : cA; const char* nB = has_next ? (const char*)g.Bt + (size_t)nxt.pn * tstepB : cB;
        for (int t = 0; t < nt; t += 2) {
            const bool last = (t == nt - 2);
            const char* a1 = cA + (size_t)(t + 1) * kstep;
            const char* a2 = last ? nA : cA + (size_t)(t + 2) * kstep; const char* b2 = last ? nB : cB + (size_t)(t + 2) * kstep;
            const char* a3 = a2 + kstep; const char* b3 = b2 + kstep;
            if (last && has_next) S.a_ready(nxt);
            if constexpr (SP2) {
            PG8_LDB(B0, 0, 0); PG8_LDB(B1, 0, 1); PG8_SCHED; PG8_LDA(At, 0, 0); PG8_STAGE(PG8_SA(1, 1), a1 + hstepA, voffA);
            PG8_WAIT_V(8); PG8_WAIT_L(0); PG8_BAR; PG8_MMA(0, 0, At, B0); PG8_MMA(0, 1, At, B1); PG8_BAR; PG8_SCHED;
            PG8_LDA(At, 0, 1); PG8_STAGE(PG8_SB(0, 0), b2, voffB); PG8_STAGE(PG8_SB(0, 1), b2 + hstepB, voffB); PG8_STAGE(PG8_SA(0, 0), a2, voffA);
            PG8_WAIT_V(8); PG8_WAIT_L(0); PG8_BAR; PG8_MMA(1, 0, At, B0); PG8_MMA(1, 1, At, B1); PG8_BAR; PG8_SCHED;
            PG8_LDB(B0, 1, 0); PG8_LDB(B1, 1, 1); PG8_SCHED; PG8_LDA(At, 1, 0); PG8_STAGE(PG8_SA(0, 1), a2 + hstepA, voffA);
            PG8_WAIT_V(8); PG8_WAIT_L(0); PG8_BAR; PG8_MMA(0, 0, At, B0); PG8_MMA(0, 1, At, B1); PG8_BAR; PG8_SCHED;
            PG8_LDA(At, 1, 1); PG8_STAGE(PG8_SB(1, 0), b3, voffB); PG8_STAGE(PG8_SB(1, 1), b3 + hstepB, voffB); PG8_STAGE(PG8_SA(1, 0), a3, voffA);
            PG8_WAIT_V(8); PG8_WAIT_L(0); PG8_BAR; PG8_MMA(1, 0, At, B0); PG8_MMA(1, 1, At, B1); PG8_BAR; PG8_SCHED;
            } else {
            PG8_LDB(B0, 0, 0); PG8_SCHED; PG8_LDA(At, 0, 0); PG8_STAGE(PG8_SA(1, 1), a1 + hstepA, voffA);
            PG8_WAIT_L(8); PG8_BAR; PG8_WAIT_L(0); PG8_MMA(0, 0, At, B0); PG8_BAR; PG8_SCHED;
            PG8_LDB(B1, 0, 1); PG8_STAGE(PG8_SB(0, 0), b2, voffB);
            PG8_BAR; PG8_WAIT_L(0); PG8_MMA(0, 1, At, B1); PG8_BAR;
            PG8_LDA(At, 0, 1); PG8_STAGE(PG8_SA(0, 0), a2, voffA);
            PG8_BAR; PG8_WAIT_L(0); PG8_MMA(1, 0, At, B0); PG8_BAR; PG8_SCHED;
            PG8_STAGE(PG8_SB(0, 1), b2 + hstepB, voffB);
            PG8_WAIT_V(6); PG8_BAR; PG8_MMA(1, 1, At, B1); PG8_BAR;
            PG8_LDB(B0, 1, 0); PG8_SCHED; PG8_LDA(At, 1, 0); PG8_STAGE(PG8_SA(0, 1), a2 + hstepA, voffA);
            PG8_WAIT_L(8); PG8_BAR; PG8_WAIT_L(0); PG8_MMA(0, 0, At, B0); PG8_BAR; PG8_SCHED;
            PG8_LDB(B1, 1, 1); PG8_STAGE(PG8_SB(1, 0), b3, voffB);
            PG8_BAR; PG8_WAIT_L(0); PG8_MMA(0, 1, At, B1); PG8_BAR;
            PG8_LDA(At, 1, 1); PG8_STAGE(PG8_SA(1, 0), a3, voffA);
            PG8_BAR; PG8_WAIT_L(0); PG8_MMA(1, 0, At, B0); PG8_BAR; PG8_SCHED;
            PG8_STAGE(PG8_SB(1, 1), b3 + hstepB, voffB);
            PG8_WAIT_V(6); PG8_BAR; PG8_MMA(1, 1, At, B1); PG8_BAR;
            }
        }
        if constexpr (ALIGN_EPI) { if (wr == 0) PG8_BAR; }
        if constexpr (!Epi::AFTER_DRAIN) { E(acc, cur, wr, wc, fr, fq); S.done(cur); }
        if (!has_next) break;
#pragma unroll
        for (int a = 0; a < 2; ++a)
#pragma unroll
            for (int b = 0; b < 2; ++b)
#pragma unroll
                for (int m = 0; m < 4; ++m)
#pragma unroll
                    for (int n = 0; n < 2; ++n) acc[a][b][m][n] = (f32x4){0.f, 0.f, 0.f, 0.f};
        cur = nxt; cA = nA; cB = nB; ++ui;
        if constexpr (ALIGN_EPI) { if (wr == 1) PG8_BAR; }
    }
    PG8_WAIT_V(0);
    if constexpr (!ALIGN_EPI) { if (wr == 0) PG8_BAR; }
    PG8_BAR;
    if constexpr (Epi::AFTER_DRAIN) { E.fused(acc, cur, wr, wc, fr, fq, lds, wid, lane); S.done(cur); }
#undef PG8_SA
#undef PG8_SB
#undef PG8_STAGE
#undef PG8_LDA
#undef PG8_LDB
#undef PG8_MMA
#undef PG8_WAIT_V
#undef PG8_WAIT_L
#undef PG8_BAR
#undef PG8_SCHED
}
}

template <class F> struct EpiQuad {
    static constexpr bool PERM = false, AFTER_DRAIN = false;
    F f;
    template <int C, int BJ> __device__ __forceinline__ void half(const pg8::f32x4 (&acc)[2][2][4][2], int row0, int p) const {
#pragma unroll
        for (int ai = 0; ai < 2; ++ai)
#pragma unroll
            for (int m = 0; m < 4; ++m) { f.template apply<C>(row0 + ai * 128 + m * 16, p, acc[ai][BJ][m][0], acc[ai][BJ][m][1]); asm volatile("" ::: "memory"); }
    }
    template <int BJ> __device__ __forceinline__ void disp(const pg8::f32x4 (&acc)[2][2][4][2], int row0, int p0, int p) const {
        const int c = f.cat(p0);
        if (F::NCAT == 1 || c == 0) half<0, BJ>(acc, row0, p);
        else if (F::NCAT > 1 && c == 1) half<(F::NCAT > 1 ? 1 : 0), BJ>(acc, row0, p);
        else if (F::NCAT > 2 && c == 2) half<(F::NCAT > 2 ? 2 : 0), BJ>(acc, row0, p);
        else if (F::NCAT > 3 && c == 3) half<(F::NCAT > 3 ? 3 : 0), BJ>(acc, row0, p);
        else if (F::NCAT > 4 && c == 4) half<(F::NCAT > 4 ? 4 : 0), BJ>(acc, row0, p);
        else if (F::NCAT > 5 && c == 5) half<(F::NCAT > 5 ? 5 : 0), BJ>(acc, row0, p);
        else if (F::NCAT > 6 && c == 6) half<(F::NCAT > 6 ? 6 : 0), BJ>(acc, row0, p);
        else if (F::NCAT > 7) half<(F::NCAT > 7 ? 7 : 0), BJ>(acc, row0, p);
    }
    __device__ __forceinline__ void operator()(const pg8::f32x4 (&acc)[2][2][4][2], const pg8::Unit& u, int wr, int wc, int fr, int fq) const {
        const int row0 = u.pm * 256 + wr * 64 + fr, p0 = u.pn * 256;
        disp<0>(acc, row0, p0, p0 + wc * 32 + 4 * fq);
        disp<1>(acc, row0, p0 + 128, p0 + 128 + wc * 32 + 4 * fq);
    }
};
template <class F> __device__ __forceinline__ void gemm_pg8(unsigned char* lds, const bf16* A, int lda, const bf16* Bt, int ldb, int M, int N, int K, const F& f, int wg_off = 0) {
    if ((int)blockIdx.x < wg_off) return;
    pg8::Gemm g{A, Bt, M, N, K, lda, ldb}; pg8::StaticOrder S; S.init(M, N, (int)gridDim.x, (int)blockIdx.x - wg_off);
    EpiQuad<F> E{f};
    pg8::gemm_phase<EpiQuad<F>, pg8::StaticOrder, true, true>((PG8_LAS unsigned char*)lds, g, S, E);
}

namespace cg = cooperative_groups;
template <bool XIN16, bool XOUT16> struct EpiNormRes {
    static constexpr bool PERM = false, AFTER_DRAIN = true;
    const void* xin; void* xout; bf16* xn; const float* gpost; const float* gpre; float coef; unsigned* part; unsigned* cnt;
    __device__ __forceinline__ void operator()(const pg8::f32x4 (&)[2][2][4][2], const pg8::Unit&, int, int, int, int) const {}
    __device__ __forceinline__ void rowstat(const pg8::f32x4 (&acc)[2][2][4][2], float* P, int wr, int wc, int fr, int fq) const {
#pragma unroll
        for (int ai = 0; ai < 2; ++ai)
#pragma unroll
            for (int m = 0; m < 4; ++m) { float sq = 0.f;
#pragma unroll
                for (int bj = 0; bj < 2; ++bj)
#pragma unroll
                    for (int n = 0; n < 2; ++n) { const pg8::f32x4 v = acc[ai][bj][m][n]; sq += (v[0] * v[0] + v[1] * v[1]) + (v[2] * v[2] + v[3] * v[3]); }
                sq += __shfl_xor(sq, 16); sq += __shfl_xor(sq, 32);
                if (fq == 0) P[(ai * 128 + wr * 64 + m * 16 + fr) * 4 + wc] = sq; }
    }
    __device__ __forceinline__ void exchange(float* P, float* S, unsigned* bank, unsigned* cnt_, const pg8::Unit& u, int tid, float scale) const {
        __syncthreads();
        if (tid < 256) { const f32x4 p = *(const f32x4*)(P + tid * 4);
            __hip_atomic_store(bank + (size_t)(u.pm * 256 + tid) * 4 + u.pn, __builtin_bit_cast(unsigned, (p[0] + p[1]) + (p[2] + p[3])), __ATOMIC_RELAXED, __HIP_MEMORY_SCOPE_AGENT); }
        asm volatile("s_waitcnt vmcnt(0)" ::: "memory");
        __syncthreads();
        if (tid == 0) { unsigned* c = cnt_ + u.pm * 16; __hip_atomic_fetch_add(c, 1u, __ATOMIC_RELAXED, __HIP_MEMORY_SCOPE_AGENT);
            while (__hip_atomic_load(c, __ATOMIC_RELAXED, __HIP_MEMORY_SCOPE_AGENT) < 4u) __builtin_amdgcn_s_sleep(1); }
        __syncthreads();
        if (tid < 256) { const unsigned* b = bank + (size_t)(u.pm * 256 + tid) * 4; float q = 0.f;
#pragma unroll
            for (int j = 0; j < 4; ++j) q += __builtin_bit_cast(float, __hip_atomic_load(b + j, __ATOMIC_RELAXED, __HIP_MEMORY_SCOPE_AGENT));
            S[tid] = rsqrtf(q * (1.f / DM) + NORM_EPS) * scale; }
        __syncthreads();
    }
    __device__ __forceinline__ void fused(pg8::f32x4 (&acc)[2][2][4][2], const pg8::Unit& u, int wr, int wc, int fr, int fq, PG8_LAS unsigned char* lds, int wid, int lane) const {
        float* P = (float*)lds; float* S = P + 1024; const int tid = wid * 64 + lane;
        rowstat(acc, P, wr, wc, fr, fq);
        exchange(P, S, part, cnt, u, tid, coef);
        const int col0 = u.pn * 256 + wc * 32 + 4 * fq;
#pragma unroll
        for (int ai = 0; ai < 2; ++ai)
#pragma unroll
            for (int m = 0; m < 4; ++m) { const int r = ai * 128 + wr * 64 + m * 16 + fr; const float sr = S[r]; const size_t off = (size_t)(u.pm * 256 + r) * DM + col0;
#pragma unroll
                for (int bj = 0; bj < 2; ++bj)
#pragma unroll
                    for (int n = 0; n < 2; ++n) { const int o = bj * 128 + n * 16; const f32x4 g4 = *(const f32x4*)(gpost + col0 + o);
                        f32x4 x4;
                        if (XIN16) { const u32x2 w = *(const u32x2*)((const bf16*)xin + off + o);
                            x4 = (f32x4){__builtin_bit_cast(float, w.x << 16), __builtin_bit_cast(float, w.x & 0xffff0000u), __builtin_bit_cast(float, w.y << 16), __builtin_bit_cast(float, w.y & 0xffff0000u)}; }
                        else x4 = *(const f32x4*)((const float*)xin + off + o);
                        const f32x4 y = x4 + acc[ai][bj][m][n] * sr * g4; acc[ai][bj][m][n] = y;
                        if (XOUT16) st_bf4((bf16*)xout + off + o, y); else *(f32x4*)((float*)xout + off + o) = y; }
                asm volatile("" ::: "memory"); }
        if (!gpre) return;
        rowstat(acc, P, wr, wc, fr, fq);
        exchange(P, S, part + (size_t)M_ * 4, cnt + 64 * 16, u, tid, 1.f);
#pragma unroll
        for (int ai = 0; ai < 2; ++ai)
#pragma unroll
            for (int m = 0; m < 4; ++m) { const int r = ai * 128 + wr * 64 + m * 16 + fr; const float sr = S[r]; const size_t off = (size_t)(u.pm * 256 + r) * DM + col0;
#pragma unroll
                for (int bj = 0; bj < 2; ++bj)
#pragma unroll
                    for (int n = 0; n < 2; ++n) { const int o = bj * 128 + n * 16; const f32x4 g4 = *(const f32x4*)(gpre + col0 + o); st_bf4(xn + off + o, acc[ai][bj][m][n] * sr * g4); }
                asm volatile("" ::: "memory"); }
    }
};
template <bool XIN16, bool XOUT16>
__device__ __forceinline__ void gemm_norm_res(unsigned char* lds, const bf16* A, int lda, const bf16* Bt, int K, const void* xin, void* xout, bf16* xn, const float* gpost, const float* gpre,
                                              float coef, unsigned* part, unsigned* cnt) {
    pg8::Gemm g{A, Bt, M_, DM, K, lda, K}; pg8::StaticOrder S; S.init(M_, DM, 256, (int)blockIdx.x);
    const EpiNormRes<XIN16, XOUT16> E{xin, xout, xn, gpost, gpre, coef, part, cnt};
    pg8::gemm_phase<EpiNormRes<XIN16, XOUT16>, pg8::StaticOrder, false, true>((PG8_LAS unsigned char*)lds, g, S, E);
}

__device__ __forceinline__ void d_gates(const bf16* xn, const bf16* wg  , float* gates, float* red  ) {
    const int T512 = tidx(), lane = T512 & 63, fr = lane & 15, fq = lane >> 4, w = T512 >> 6, kh = w & 1;
    for (int rt0 = blockIdx.x * 4; rt0 < M_ / 16; rt0 += gridDim.x * 4) {
        const int rt = rt0 + (w >> 1);
        const bf16* ap = xn + (size_t)(rt * 16 + fr) * DM + 8 * fq + kh * 512; const bf16* bp = wg + (size_t)fr * DM + 8 * fq + kh * 512;
        f32x4 c0 = {0.f, 0.f, 0.f, 0.f}, c1 = {0.f, 0.f, 0.f, 0.f};
#pragma unroll 8
        for (int k0 = 0; k0 < 512; k0 += 32) { const bf16x8 a = *(const bf16x8*)(ap + k0);
            c0 = __builtin_amdgcn_mfma_f32_16x16x32_bf16(*(const bf16x8*)(bp + k0), a, c0, 0, 0, 0);
            c1 = __builtin_amdgcn_mfma_f32_16x16x32_bf16(*(const bf16x8*)(bp + (size_t)16 * DM + k0), a, c1, 0, 0, 0); }
        float* r = red + ((w >> 1) * 64 + lane) * 8;
        if (kh) { *(f32x4*)r = c0; *(f32x4*)(r + 4) = c1; }
        __syncthreads();
        if (!kh) { c0 += *(const f32x4*)r; c1 += *(const f32x4*)(r + 4);
            float* o = gates + (size_t)(rt * 16 + fr) * 24 + 4 * fq;
            *(f32x4*)o = (f32x4){sigmoidf_(c0[0]), sigmoidf_(c0[1]), sigmoidf_(c0[2]), sigmoidf_(c0[3])};
            if (fq < 2) *(f32x4*)(o + 16) = (f32x4){sigmoidf_(c1[0]), sigmoidf_(c1[1]), sigmoidf_(c1[2]), sigmoidf_(c1[3])}; }
        __syncthreads();
    }
}

__device__ __forceinline__ void d_cmp2(const float* part  , const float* bias  , const bf16* w2t, const float* rope, bf16* kc, bf16* vct, int wg0 = 0) {
    if ((int)blockIdx.x < wg0) return;
    const int T512 = tidx(), lane = T512 & 63, fr = lane & 15, fq = lane >> 4;
    for (int task = ((int)blockIdx.x - wg0) * 8 + (T512 >> 6); task < 256; task += ((int)gridDim.x - wg0) * 8) {
        const int kv = task >> 7, R0 = (task & 127) * 16;
        const float* p0 = part + ((size_t)(kv * 2) * 2048 + R0 + fr) * 256 + 8 * fq; const float* p1 = p0 + (size_t)2048 * 256;
        const float* bb = bias + kv * 256 + 8 * fq;
        const bf16* bp = w2t + (size_t)kv * 64 * 256 + (size_t)fr * 256 + 8 * fq;
        f32x4 acc[4];
#pragma unroll
        for (int nt = 0; nt < 4; ++nt) acc[nt] = (f32x4){0.f, 0.f, 0.f, 0.f};
#pragma unroll
        for (int k0 = 0; k0 < 256; k0 += 32) {
            f32x4 xa = *(const f32x4*)(p0 + k0) + *(const f32x4*)(p1 + k0) + *(const f32x4*)(bb + k0);
            f32x4 xb = *(const f32x4*)(p0 + k0 + 4) + *(const f32x4*)(p1 + k0 + 4) + *(const f32x4*)(bb + k0 + 4);
#pragma unroll
            for (int e = 0; e < 4; ++e) { xa[e] = xa[e] / (1.f + __expf(-xa[e])); xb[e] = xb[e] / (1.f + __expf(-xb[e])); }
            const bf16x8 a = __builtin_bit_cast(bf16x8, (u32x4){pk2(xa[0], xa[1]), pk2(xa[2], xa[3]), pk2(xb[0], xb[1]), pk2(xb[2], xb[3])});
#pragma unroll
            for (int nt = 0; nt < 4; ++nt) acc[nt] = __builtin_amdgcn_mfma_f32_16x16x32_bf16(*(const bf16x8*)(bp + (size_t)nt * 16 * 256 + k0), a, acc[nt], 0, 0, 0);
        }
        const int R = R0 + fr, bg = R >> 9, c = R & 511;
        if (kv == 0) {
            const int pos = (16 * c + 31) & (T_ - 1);
#pragma unroll
            for (int h2 = 0; h2 < 2; ++h2) {
                const int d = 16 * h2 + 4 * fq; const f32x4* rp = (const f32x4*)(rope + ((size_t)pos * 32 + d) * 2); const f32x4 r0 = rp[0], r1 = rp[1];
                const f32x4 cs = {r0[0], r0[2], r1[0], r1[2]}, sn = {r0[1], r0[3], r1[1], r1[3]};
                const f32x4 lo = acc[h2] * cs - acc[h2 + 2] * sn, hi = acc[h2] * sn + acc[h2 + 2] * cs;
                st_bf4(kc + (size_t)R * 64 + d, lo); st_bf4(kc + (size_t)R * 64 + d + 32, hi);
            }
        } else {
#pragma unroll
            for (int nt = 0; nt < 4; ++nt)
#pragma unroll
                for (int e = 0; e < 4; ++e) vct[((size_t)bg * 64 + 16 * nt + 4 * fq + e) * NCP + c] = (bf16)f2bf(acc[nt][e]);
        }
    }
}

struct NsaArgs { const bf16 *qb, *kc, *vct, *ks, *vst, *kw, *vwt; const float* gates; bf16* amix; };
__device__ __forceinline__ float dot64(const float* q, const bf16* k) {
    float s = 0.f;
#pragma unroll
    for (int i = 0; i < 8; ++i) { const u32x4 w = ((const u32x4*)k)[i];
        s += q[8 * i + 0] * __builtin_bit_cast(float, w.x << 16) + q[8 * i + 1] * __builtin_bit_cast(float, w.x & 0xffff0000u)
           + q[8 * i + 2] * __builtin_bit_cast(float, w.y << 16) + q[8 * i + 3] * __builtin_bit_cast(float, w.y & 0xffff0000u)
           + q[8 * i + 4] * __builtin_bit_cast(float, w.z << 16) + q[8 * i + 5] * __builtin_bit_cast(float, w.z & 0xffff0000u)
           + q[8 * i + 6] * __builtin_bit_cast(float, w.w << 16) + q[8 * i + 7] * __builtin_bit_cast(float, w.w & 0xffff0000u); }
    return s;
}
__device__ __forceinline__ void softmax_row(float* s, int n, int lane) {
    float m = -INFINITY; for (int i = lane; i < n; i += 64) m = fmaxf(m, s[i]);
    m = wave_max(m); if (m == -INFINITY) m = 0.f;
    float l = 0.f; for (int i = lane; i < n; i += 64) { const float e = exp2f(s[i] - m); s[i] = e; l += e; }
    l = wave_sum(l); const float inv = 1.f / fmaxf(l, 1e-30f);
    for (int i = lane; i < n; i += 64) s[i] *= inv;
}
__device__ __forceinline__ void d_nsa_simple(const NsaArgs& a, int vb, int tid, unsigned char* smem) {
    float (*qs)[64] = (float (*)[64])smem; float (*sc)[1024] = (float (*)[1024])(smem + 1024); float* imp = (float*)(smem + 17408); float* score = imp + 128;
    int* list = (int*)(score + 128); int* nlist = list + 16;
    const int bg = vb / T_, t = vb % T_, b = bg >> 1, g = bg & 1;
    const int r = tid >> 6, d = tid & 63, lane = d;
    const size_t row = (size_t)b * T_ + t;
    qs[r][d] = bf2f(a.qb[row * 512 + g * 256 + r * 64 + d]);
    if (tid == 0) *nlist = 0;
    __syncthreads();
    const int nv = t < 31 ? 0 : (t - 31) / 16 + 1;
    for (int c = tid; c < nv; c += 256) { const bf16* k = a.kc + ((size_t)bg * NCP + c) * 64;
        _Pragma("unroll 1") for (int rr = 0; rr < 4; ++rr) sc[rr][c] = dot64(qs[rr], k); }
    __syncthreads();
    softmax_row(sc[r], nv, lane);
    __syncthreads();
    float oc = 0.f; { const bf16* v = a.vct + ((size_t)bg * 64 + d) * NCP; for (int c = 0; c < nv; ++c) oc += sc[r][c] * bf2f(v[c]); }
    if (tid < 128) { const int s = tid; float acc = 0.f;
        for (int c = 4 * s - 1; c <= 4 * s + 3; ++c) if (c >= 0 && c < nv) acc += sc[0][c] + sc[1][c] + sc[2][c] + sc[3][c];
        imp[s] = acc; }
    __syncthreads();
    const int cur = t >> 6;
    if (tid < 128) { const int s = tid; const bool forced = (s == 0) || (s == cur) || (s == cur - 1);
        score[s] = forced ? 1e4f : (s <= cur ? imp[s] : -1e4f); }
    __syncthreads();
    if (tid < 128) { const int s = tid; const float my = score[s]; int rank = 0;
        for (int j = 0; j < 128; ++j) { const float o = score[j]; rank += (o > my || (o == my && j < s)) ? 1 : 0; }
        if (rank < 16 && s <= cur) { const int slot = atomicAdd(nlist, 1); list[slot] = s; } }
    __syncthreads();
    const int ns = *nlist * 64;
    for (int i = tid; i < ns; i += 256) { const int pos = list[i >> 6] * 64 + (i & 63);
        if (pos <= t) { const bf16* k = a.ks + ((size_t)bg * T_ + pos) * 64; _Pragma("unroll 1") for (int rr = 0; rr < 4; ++rr) sc[rr][i] = dot64(qs[rr], k); }
        else { sc[0][i] = -INFINITY; sc[1][i] = -INFINITY; sc[2][i] = -INFINITY; sc[3][i] = -INFINITY; } }
    __syncthreads();
    softmax_row(sc[r], ns, lane);
    __syncthreads();
    float os = 0.f; { const bf16* v = a.vst + ((size_t)bg * 64 + d) * T_;
        for (int i = 0; i < ns; ++i) { const int pos = list[i >> 6] * 64 + (i & 63); if (pos <= t) os += sc[r][i] * bf2f(v[pos]); } }
    __syncthreads();
    const int lo = t - 511 > 0 ? t - 511 : 0, nw = t - lo + 1;
    for (int i = tid; i < nw; i += 256) { const bf16* k = a.kw + ((size_t)bg * T_ + lo + i) * 64;
        _Pragma("unroll 1") for (int rr = 0; rr < 4; ++rr) sc[rr][i] = dot64(qs[rr], k); }
    __syncthreads();
    softmax_row(sc[r], nw, lane);
    __syncthreads();
    float ow = 0.f; { const bf16* v = a.vwt + ((size_t)bg * 64 + d) * T_ + lo; for (int i = 0; i < nw; ++i) ow += sc[r][i] * bf2f(v[i]); }
    const float* gt = a.gates + row * 24 + g * 12 + r * 3;
    a.amix[row * DM + g * 256 + r * 64 + d] = (bf16)f2bf(gt[0] * oc + gt[1] * os + gt[2] * ow);
    __syncthreads();
}


namespace nsa {
typedef float f32x16 __attribute__((ext_vector_type(16)));
constexpr int KROW = 144, VROW = 136, KBUF = 64 * KROW, VBUF = 64 * VROW;
constexpr int OFF_K = 0, OFF_V = 2 * KBUF, OFF_IMP = OFF_V + 2 * VBUF, IMPW = 130, OFF_SEL = OFF_IMP + 64 * IMPW * 4, OFF_UM = OFF_SEL + 1024, OFF_WS = OFF_UM + 16, OFF_UNIT = OFF_WS + 1024, OFF_ACC = OFF_UNIT + 16, LDS_NEED = OFF_ACC + 8 * 8192;
static_assert(LDS_NEED <= 147456 - 64 && OFF_ACC % 16 == 0, "nsa lds");
static_assert(OFF_IMP % 16 == 0 && OFF_SEL % 16 == 0 && OFF_WS % 16 == 0, "nsa lds map");
__device__ __forceinline__ int crow(int r, int hi) { return (r & 3) + 8 * (r >> 2) + 4 * hi; }
__device__ __forceinline__ int next_bit(unsigned m0, unsigned m1, unsigned m2, unsigned m3, int from) {
#pragma unroll
    for (int wd = 0; wd < 4; ++wd) {
        unsigned x = wd == 0 ? m0 : (wd == 1 ? m1 : (wd == 2 ? m2 : m3)); const int base = wd * 32;
        if (from < base + 32) { if (from > base) x &= (~0u) << (from - base); if (x) return base + __builtin_ctz(x); }
    }
    return 128;
}
__device__ __forceinline__ bf16x8 pack8(const f32x16& p, int b0) {
    u32x4 w; w.x = pk2(p[b0 + 0], p[b0 + 1]); w.y = pk2(p[b0 + 2], p[b0 + 3]); w.z = pk2(p[b0 + 4], p[b0 + 5]); w.w = pk2(p[b0 + 6], p[b0 + 7]);
    return __builtin_bit_cast(bf16x8, w);
}
struct Branch { const bf16* k; const bf16* vt; int ldv; };

constexpr float THR = 8.f;
template <int MODE, bool SEL>
__device__ __forceinline__ void compute_tile(unsigned char* sm, int cb, int j, const bf16x8 (&qf)[4], int lo, int hi_b, int lo_max, int hi_min, unsigned s0, unsigned s1, unsigned s2, unsigned s3,
                                             float& m, float& l, float invl, bool& initd, f32x16& negm, f32x16 (&o)[2], float* imp_row, float* wsc, int i, int hi) {
        const unsigned char* kb = sm + OFF_K + cb * KBUF; const unsigned char* vb = sm + OFF_V + cb * VBUF;
        const int key0 = 64 * j;
        bool rowsel = true;
        if (SEL) { const unsigned wsel = j < 32 ? s0 : (j < 64 ? s1 : (j < 96 ? s2 : s3)); rowsel = (wsel >> (j & 31)) & 1u; }
        if (!SEL || __any(rowsel)) {
            f32x16 p0, p1;
            {
                f32x16 c0;
                if (SEL) {
#pragma unroll
                    for (int r = 0; r < 16; ++r) c0[r] = rowsel ? negm[r] : -INFINITY;
                } else c0 = negm;
                bf16x8 ka[8];
#pragma unroll
                for (int d0 = 0; d0 < 4; ++d0) { ka[2 * d0] = *(const bf16x8*)(kb + i * KROW + (16 * d0 + 8 * hi) * 2); ka[2 * d0 + 1] = *(const bf16x8*)(kb + (32 + i) * KROW + (16 * d0 + 8 * hi) * 2); }
                __builtin_amdgcn_sched_barrier(0);
                p0 = __builtin_amdgcn_mfma_f32_32x32x16_bf16(ka[0], qf[0], c0, 0, 0, 0);
                p1 = __builtin_amdgcn_mfma_f32_32x32x16_bf16(ka[1], qf[0], c0, 0, 0, 0);
#pragma unroll
                for (int d0 = 1; d0 < 4; ++d0) {
                    p0 = __builtin_amdgcn_mfma_f32_32x32x16_bf16(ka[2 * d0], qf[d0], p0, 0, 0, 0);
                    p1 = __builtin_amdgcn_mfma_f32_32x32x16_bf16(ka[2 * d0 + 1], qf[d0], p1, 0, 0, 0);
                }
            }
            bf16x8 vfr[8];
            if (MODE != 0) {
#pragma unroll
                for (int dt = 0; dt < 2; ++dt) { const unsigned char* vp = vb + (32 * dt + i) * VROW + 8 * hi;
#pragma unroll
                    for (int ks = 0; ks < 4; ++ks) { const u32x2 v_lo = *(const u32x2*)(vp + 32 * ks), v_hi = *(const u32x2*)(vp + 32 * ks + 16);
                        vfr[dt * 4 + ks] = __builtin_bit_cast(bf16x8, (u32x4){v_lo.x, v_lo.y, v_hi.x, v_hi.y}); } }
                __builtin_amdgcn_sched_barrier(0);
            }
            if (!(key0 >= lo_max && key0 + 63 <= hi_min)) {
#pragma unroll
                for (int r = 0; r < 16; ++r) { const int key = key0 + crow(r, hi);
                    if (key < lo || key > hi_b) p0[r] = -INFINITY;
                    if (key + 32 < lo || key + 32 > hi_b) p1[r] = -INFINITY; }
            }
            if (MODE == 1) {
#pragma unroll
                for (int r = 0; r < 16; ++r) { p0[r] = __builtin_amdgcn_exp2f(p0[r]) * invl; p1[r] = __builtin_amdgcn_exp2f(p1[r]) * invl; }
#pragma unroll
                for (int gq = 0; gq < 4; ++gq) {
                    float G0 = (p0[4 * gq] + p0[4 * gq + 1]) + (p0[4 * gq + 2] + p0[4 * gq + 3]), L0 = p0[4 * gq + 3];
                    float G1 = (p1[4 * gq] + p1[4 * gq + 1]) + (p1[4 * gq + 2] + p1[4 * gq + 3]), L1 = p1[4 * gq + 3];
                    G0 += __shfl_xor(G0, 1); L0 += __shfl_xor(L0, 1); G1 += __shfl_xor(G1, 1); L1 += __shfl_xor(L1, 1);
                    G0 += __shfl_xor(G0, 2); L0 += __shfl_xor(L0, 2); G1 += __shfl_xor(G1, 2); L1 += __shfl_xor(L1, 2);
                    if ((i & 3) == 0) { const int s = 16 * j + 2 * gq + hi;
                        atomicAdd(imp_row + s, G0); atomicAdd(imp_row + s + 1, L0); atomicAdd(imp_row + s + 8, G1); atomicAdd(imp_row + s + 9, L1); }
                }
            } else {
                float ta = fmaxf(fmaxf(p0[0], p0[1]), p1[0]), tb = fmaxf(fmaxf(p0[2], p0[3]), p1[1]);
                ta = fmaxf(fmaxf(ta, p1[2]), p1[3]);
#pragma unroll
                for (int r = 4; r < 16; r += 4) { ta = fmaxf(fmaxf(ta, p0[r]), p0[r + 1]); tb = fmaxf(fmaxf(tb, p0[r + 2]), p0[r + 3]); ta = fmaxf(fmaxf(ta, p1[r]), p1[r + 1]); tb = fmaxf(fmaxf(tb, p1[r + 2]), p1[r + 3]); }
                float tm = fmaxf(ta, tb);
                tm = fmaxf(tm, __shfl_xor(tm, 32));
                if (__any((!initd && tm > -INFINITY) || tm > THR)) {
                    const bool was = initd;
                    const float d = was ? fmaxf(tm, 0.f) : (tm > -INFINITY ? tm : 0.f);
                    initd = was || (tm > -INFINITY);
                    m += d; const float alpha = was ? __builtin_amdgcn_exp2f(-d) : 1.f; l *= alpha;
#pragma unroll
                    for (int r = 0; r < 16; ++r) { p0[r] -= d; p1[r] -= d; negm[r] = -m; }
                    if (MODE == 2) {
                        if (hi == 0) wsc[i] = alpha;
                        asm volatile("" ::: "memory");
#pragma unroll
                        for (int rg = 0; rg < 4; ++rg) { const f32x4 a4 = *(const f32x4*)(wsc + 8 * rg + 4 * hi);
#pragma unroll
                            for (int e = 0; e < 4; ++e) { o[0][4 * rg + e] *= a4[e]; o[1][4 * rg + e] *= a4[e]; } }
                        asm volatile("" ::: "memory");
                    }
                }
                float rs = 0.f;
#pragma unroll
                for (int r = 0; r < 16; ++r) { p0[r] = __builtin_amdgcn_exp2f(p0[r]); p1[r] = __builtin_amdgcn_exp2f(p1[r]); rs += p0[r] + p1[r]; }
                l += rs;
            }
            if (MODE != 0) {
                const bf16x8 pf0 = pack8(p0, 0), pf1 = pack8(p0, 8), pf2 = pack8(p1, 0), pf3 = pack8(p1, 8);
#pragma unroll
                for (int dt = 0; dt < 2; ++dt)
#pragma unroll
                    for (int ks = 0; ks < 4; ++ks)
                        o[dt] = __builtin_amdgcn_mfma_f32_32x32x16_bf16(ks == 0 ? pf0 : (ks == 1 ? pf1 : (ks == 2 ? pf2 : pf3)), vfr[dt * 4 + ks], o[dt], 0, 0, 0);
            }
        }
}
template <int MODE, bool SEL>
__device__ __forceinline__ void run_branch(unsigned char* sm, const Branch br, unsigned m0, unsigned m1, unsigned m2, unsigned m3,
                                           const bf16x8 (&qf)[4], int lo, int hi_b, int lo_max, int hi_min, unsigned s0, unsigned s1, unsigned s2, unsigned s3,
                                           float& m, float& l, float invl, f32x16 (&o)[2], float* imp_row, float* wsc, int tid, int lane) {
    const int i = lane & 31, hi = lane >> 5;
    const bf16* kp = br.k + tid * 8; const bf16* vp_ = br.vt + (size_t)(tid >> 3) * br.ldv + (tid & 7) * 8;
    unsigned char* kst = sm + OFF_K + (tid >> 3) * KROW + (tid & 7) * 16; unsigned char* vst = sm + OFF_V + (tid >> 3) * VROW + (tid & 7) * 16;
#define NSA_LOAD(jj, KR, VR) do { KR = *(const u32x4*)(kp + (size_t)(jj) * 4096); if (MODE != 0) VR = *(const u32x4*)(vp_ + (jj) * 64); } while (0)
#define NSA_STORE(buf, KR, VR) do { *(u32x4*)(kst + (buf) * KBUF) = KR; if (MODE != 0) { *(u32x2*)(vst + (buf) * VBUF) = (u32x2){VR.x, VR.y}; *(u32x2*)(vst + (buf) * VBUF + 8) = (u32x2){VR.z, VR.w}; } } while (0)
    int j = next_bit(m0, m1, m2, m3, 0);
    int j1 = j < 128 ? next_bit(m0, m1, m2, m3, j + 1) : 128;
    u32x4 kA, vA, kB, vB;
    if (j < 128) { NSA_LOAD(j, kA, vA); if (j1 < 128) NSA_LOAD(j1, kB, vB); NSA_STORE(0, kA, vA); }
    __syncthreads();
    bool initd = (MODE == 1);
    f32x16 negm;
#pragma unroll
    for (int r = 0; r < 16; ++r) negm[r] = (MODE == 1) ? -m : 0.f;
    while (j < 128) {
        {
            const int j2 = j1 < 128 ? next_bit(m0, m1, m2, m3, j1 + 1) : 128;
            NSA_LOAD(j2 < 128 ? j2 : j, kA, vA);
            if (j1 < 128) NSA_STORE(1, kB, vB);
            compute_tile<MODE, SEL>(sm, 0, j, qf, lo, hi_b, lo_max, hi_min, s0, s1, s2, s3, m, l, invl, initd, negm, o, imp_row, wsc, i, hi);
            __syncthreads();
            j = j1; j1 = j2;
        }
        if (j >= 128) break;
        {
            const int j2 = j1 < 128 ? next_bit(m0, m1, m2, m3, j1 + 1) : 128;
            NSA_LOAD(j2 < 128 ? j2 : j, kB, vB);
            if (j1 < 128) NSA_STORE(0, kA, vA);
            compute_tile<MODE, SEL>(sm, 1, j, qf, lo, hi_b, lo_max, hi_min, s0, s1, s2, s3, m, l, invl, initd, negm, o, imp_row, wsc, i, hi);
            __syncthreads();
            j = j1; j1 = j2;
        }
    }
#undef NSA_LOAD
#undef NSA_STORE
}
template <bool FIRST> __device__ __forceinline__ void add_scaled(float* accw, const f32x16 (&o)[2], float f, float* wsc, int i, int hi, int lane) {
    if (hi == 0) wsc[i] = f;
    asm volatile("" ::: "memory");
#pragma unroll
    for (int rg = 0; rg < 4; ++rg) { const f32x4 a4 = *(const f32x4*)(wsc + 8 * rg + 4 * hi);
#pragma unroll
        for (int e = 0; e < 4; ++e)
#pragma unroll
            for (int dt = 0; dt < 2; ++dt) { float* p = accw + (dt * 16 + 4 * rg + e) * 64 + lane; const float v = a4[e] * o[dt][4 * rg + e]; *p = FIRST ? v : (*p + v); } }
    asm volatile("" ::: "memory");
}
__device__ __forceinline__ void unit(const NsaArgs& a, int u, unsigned char* sm) {
    const int tid = tidx(), lane = tid & 63, w = __builtin_amdgcn_readfirstlane(tid >> 6), i = lane & 31, hi = lane >> 5;
    const int cur = 127 - (u >> 2), bg = u & 3, b = bg >> 1, g = bg & 1, q0 = cur * 64;
    const int ql = 8 * w + (i >> 2), hd = i & 3, t = q0 + ql;
    const size_t grow = (size_t)b * T_ + t;
    bf16x8 qf[4];
    { const bf16* qp = a.qb + grow * 512 + g * 256 + hd * 64 + 8 * hi;
#pragma unroll
      for (int d0 = 0; d0 < 4; ++d0) qf[d0] = *(const bf16x8*)(qp + 16 * d0); }
    float* wsc = (float*)(sm + OFF_WS) + w * 32;
    float* imp = (float*)(sm + OFF_IMP);
    unsigned* selw = (unsigned*)(sm + OFF_SEL);
    unsigned* um = (unsigned*)(sm + OFF_UM);
    for (int k = tid; k < 64 * IMPW; k += 512) imp[k] = 0.f;
    if (tid < 4) um[tid] = 0u;
    const float* gt = a.gates + grow * 24 + g * 12 + hd * 3;
    const float gc = gt[0], gs = gt[1], gw = gt[2];
    f32x16 o[2];
    float* accw = (float*)(sm + OFF_ACC) + w * 2048;
    const int tw0 = q0 + 8 * w, tw1 = tw0 + 7;
    {
        const int nv = t < 31 ? 0 : (t - 31) / 16 + 1;
        const int nvw = tw0 < 31 ? 0 : (tw0 - 31) / 16 + 1;
        const int nvmax = (q0 + 63 - 31) / 16 + 1, ntc = (nvmax + 63) / 64;
        const unsigned cm0 = ntc >= 32 ? ~0u : ((1u << ntc) - 1u);
        const Branch br{a.kc + (size_t)bg * NCP * 64, a.vct + (size_t)bg * 64 * NCP, NCP};
        float m = 0.f, l = 0.f;
        run_branch<0, false>(sm, br, cm0, 0u, 0u, 0u, qf, 0, nv - 1, 0, nvw - 1, 0u, 0u, 0u, 0u, m, l, 0.f, o, nullptr, wsc, tid, lane);
        l += __shfl_xor(l, 32);
        const float invl = 1.f / fmaxf(l, 1e-30f);
#pragma unroll
        for (int r = 0; r < 16; ++r) { o[0][r] = 0.f; o[1][r] = 0.f; }
        run_branch<1, false>(sm, br, cm0, 0u, 0u, 0u, qf, 0, nv - 1, 0, nvw - 1, 0u, 0u, 0u, 0u, m, l, invl, o, imp + ql * IMPW, wsc, tid, lane);
        add_scaled<true>(accw, o, gc, wsc, i, hi, lane);
    }
    {
        unsigned u0 = 0u, u1 = 0u, u2 = 0u, u3 = 0u;
        const int ncand = cur - 2;
        unsigned k0[8], k1[8], k2[8], k3[8];
        if (ncand <= 13) {
#pragma unroll
            for (int wd = 0; wd < 4; ++wd) { const int nb = cur + 1 - 32 * wd; const unsigned x = nb >= 32 ? ~0u : (nb <= 0 ? 0u : ((1u << nb) - 1u));
#pragma unroll
                for (int qq = 0; qq < 8; ++qq) { if (wd == 0) k0[qq] = x; else if (wd == 1) k1[qq] = x; else if (wd == 2) k2[qq] = x; else k3[qq] = x; } }
        } else {
            unsigned q0[8], q1[8];
#pragma unroll
            for (int qq = 0; qq < 8; ++qq) { const float* ir = imp + (8 * w + qq) * IMPW;
                q0[qq] = (lane >= 1 && lane <= cur - 2) ? ((__builtin_bit_cast(unsigned, ir[lane]) & 0xFFFFFF80u) | (unsigned)(127 - lane)) : 0u;
                q1[qq] = (lane + 64 <= cur - 2) ? ((__builtin_bit_cast(unsigned, ir[lane + 64]) & 0xFFFFFF80u) | (unsigned)(63 - lane)) : 0u;
                k0[qq] = 1u; k1[qq] = 0u; k2[qq] = 0u; k3[qq] = 0u; }
            for (int it = 0; it < 13; ++it) {
#pragma unroll
                for (int qq = 0; qq < 8; ++qq) {
                    unsigned mx = q0[qq] > q1[qq] ? q0[qq] : q1[qq];
                    { const unsigned o_ = (unsigned)__builtin_amdgcn_update_dpp(0, (int)mx, 0xB1, 0xF, 0xF, true); mx = o_ > mx ? o_ : mx; }
                    { const unsigned o_ = (unsigned)__builtin_amdgcn_update_dpp(0, (int)mx, 0x4E, 0xF, 0xF, true); mx = o_ > mx ? o_ : mx; }
                    { const unsigned o_ = (unsigned)__builtin_amdgcn_update_dpp(0, (int)mx, 0x141, 0xF, 0xF, true); mx = o_ > mx ? o_ : mx; }
                    { const unsigned o_ = (unsigned)__builtin_amdgcn_update_dpp(0, (int)mx, 0x140, 0xF, 0xF, true); mx = o_ > mx ? o_ : mx; }
                    const unsigned r0 = (unsigned)__builtin_amdgcn_readlane((int)mx, 0), r1 = (unsigned)__builtin_amdgcn_readlane((int)mx, 16), r2 = (unsigned)__builtin_amdgcn_readlane((int)mx, 32), r3 = (unsigned)__builtin_amdgcn_readlane((int)mx, 48);
                    const unsigned ra = r0 > r1 ? r0 : r1, rb = r2 > r3 ? r2 : r3, best = ra > rb ? ra : rb;
                    if (q0[qq] == best) q0[qq] = 0u; if (q1[qq] == best) q1[qq] = 0u;
                    const int b_ = 127 - (int)(best & 127u);
                    const unsigned bit = 1u << (b_ & 31);
                    if (b_ < 32) k0[qq] |= bit; else if (b_ < 64) k1[qq] |= bit; else if (b_ < 96) k2[qq] |= bit; else k3[qq] |= bit; }
            }
            { const int c1 = cur - 1; const unsigned b1 = 1u << (c1 & 31), b2 = 1u << (cur & 31);
#pragma unroll
              for (int qq = 0; qq < 8; ++qq) {
                if (c1 < 32) k0[qq] |= b1; else if (c1 < 64) k1[qq] |= b1; else if (c1 < 96) k2[qq] |= b1; else k3[qq] |= b1;
                if (cur < 32) k0[qq] |= b2; else if (cur < 64) k1[qq] |= b2; else if (cur < 96) k2[qq] |= b2; else k3[qq] |= b2; } }
        }
#pragma unroll
        for (int qq = 0; qq < 8; ++qq) {
            if (lane == 0) { unsigned* sp = selw + (8 * w + qq) * 4; sp[0] = k0[qq]; sp[1] = k1[qq]; sp[2] = k2[qq]; sp[3] = k3[qq]; }
            u0 |= k0[qq]; u1 |= k1[qq]; u2 |= k2[qq]; u3 |= k3[qq]; }
        if (lane == 0) { atomicOr(um + 0, u0); atomicOr(um + 1, u1); atomicOr(um + 2, u2); atomicOr(um + 3, u3); }
    }
    __syncthreads();
    {
        const unsigned U0 = um[0], U1 = um[1], U2 = um[2], U3 = um[3];
        const unsigned* sp = selw + ql * 4; const unsigned s0 = sp[0], s1 = sp[1], s2 = sp[2], s3 = sp[3];
        const Branch br{a.ks + (size_t)bg * T_ * 64, a.vst + (size_t)bg * 64 * T_, T_};
        float m = 0.f, l = 0.f;
#pragma unroll
        for (int r = 0; r < 16; ++r) { o[0][r] = 0.f; o[1][r] = 0.f; }
        run_branch<2, true>(sm, br, __builtin_amdgcn_readfirstlane(U0), __builtin_amdgcn_readfirstlane(U1), __builtin_amdgcn_readfirstlane(U2), __builtin_amdgcn_readfirstlane(U3),
                            qf, 0, t, 0, tw0, s0, s1, s2, s3, m, l, 0.f, o, nullptr, wsc, tid, lane);
        l += __shfl_xor(l, 32);
        add_scaled<false>(accw, o, gs / fmaxf(l, 1e-30f), wsc, i, hi, lane);
    }
    {
        const int j0 = cur - 8 > 0 ? cur - 8 : 0;
        unsigned wm0 = 0u, wm1 = 0u, wm2 = 0u, wm3 = 0u;
#pragma unroll
        for (int wd = 0; wd < 4; ++wd) { const int a0 = j0 - 32 * wd, a1 = cur + 1 - 32 * wd;
            const unsigned hi_m = a1 >= 32 ? ~0u : (a1 <= 0 ? 0u : ((1u << a1) - 1u)), lo_m = a0 >= 32 ? ~0u : (a0 <= 0 ? 0u : ((1u << a0) - 1u));
            const unsigned x = hi_m & ~lo_m; if (wd == 0) wm0 = x; else if (wd == 1) wm1 = x; else if (wd == 2) wm2 = x; else wm3 = x; }
        const Branch br{a.kw + (size_t)bg * T_ * 64, a.vwt + (size_t)bg * 64 * T_, T_};
        float m = 0.f, l = 0.f;
#pragma unroll
        for (int r = 0; r < 16; ++r) { o[0][r] = 0.f; o[1][r] = 0.f; }
        run_branch<2, false>(sm, br, wm0, wm1, wm2, wm3, qf, t - 511, t, tw1 - 511, tw0, 0u, 0u, 0u, 0u, m, l, 0.f, o, nullptr, wsc, tid, lane);
        l += __shfl_xor(l, 32);
        add_scaled<false>(accw, o, gw / fmaxf(l, 1e-30f), wsc, i, hi, lane);
    }
#pragma unroll
    for (int r = 0; r < 16; ++r) { const int rw = crow(r, hi), qq = 8 * w + (rw >> 2), hh = rw & 3;
        bf16* op = a.amix + ((size_t)b * T_ + q0 + qq) * DM + g * 256 + hh * 64 + i;
        op[0] = (bf16)f2bf(accw[r * 64 + lane]); op[32] = (bf16)f2bf(accw[(16 + r) * 64 + lane]); }
}
__device__ __forceinline__ void phase(const NsaArgs& a, unsigned* ctr, unsigned char* sm) {
    int* slot = (int*)(sm + OFF_UNIT);
    for (;;) {
        if (tidx() == 0) *slot = (int)atomicAdd(ctr, 1u);
        __syncthreads();
        const int u = *slot;
        __syncthreads();
        if (u >= 512) break;
        unit(a, u, sm);
    }
}
}

__device__ __forceinline__ void d_lora_prep(const bf16* pr, const float* mu, bf16* la, int wg0 = 0) {
    if ((int)blockIdx.x < wg0) return;
    const int T512 = tidx(), c = T512 & 255;
    const float m = mu[1536 + c];
    for (int vb = ((int)blockIdx.x - wg0) * 2 + (T512 >> 8); vb < M_ / 4; vb += ((int)gridDim.x - wg0) * 2) {
        const int row0 = vb * 4;
        float x[5];
        x[0] = (row0 % T_) ? bf2f(pr[(size_t)(row0 - 1) * 256 + c]) : 0.f;
#pragma unroll
        for (int j = 0; j < 4; ++j) x[j + 1] = bf2f(pr[(size_t)(row0 + j) * 256 + c]);
#pragma unroll
        for (int j = 0; j < 4; ++j) { const float xs = x[j + 1] + (x[j] - x[j + 1]) * m;
            const float v = c < 64 ? tanhf(xs) : (c < 128 ? xs : sigmoidf_(xs));
            la[(size_t)(row0 + j) * KLORA + c] = (bf16)f2bf(v); }
    }
}

namespace rw7 {
using nsa::f32x16; using nsa::crow; using nsa::pack8;
constexpr int NHELP = 2, RG = 18;
constexpr int NPROD = 6, RING = 7, RA = 144, RB = 40, S_AT = 0, S_RT = 16 * RA, S_BT = 32 * RA, S_KT = S_BT + 64 * RB, S_VT = S_KT + 64 * RB, S_SM = S_VT + 64 * RB, SMM = 16 * RB, S_GC = S_SM + 4 * SMM, SLOT = S_GC + 256;
constexpr int OFF_SCR = RING * SLOT, SCR = 32 * RA, LDS_NEED = OFF_SCR;
static_assert(NPROD % NHELP == 0 && LDS_NEED <= 147456 - 64 && 7 * (SLOT + SCR) <= 147456 - 64 && (size_t)16 * NHELP * RG * SLOT <= (size_t)9 << 20 && SLOT % 16 == 0 && S_BT % 16 == 0 && 128 * RB >= 4096 && SCR >= 4096, "rw7 lds map");
struct Args { const unsigned* rkw; const bf16* vv; const bf16* aga; const float* wdec; const float *mu, *kk, *ka, *rk; float* yraw; float* bonus; unsigned char* ring; unsigned* flags; unsigned* cons; };
__device__ __forceinline__ void wg_bar() { asm volatile("s_waitcnt lgkmcnt(0)" ::: "memory"); __builtin_amdgcn_s_barrier(); asm volatile("" ::: "memory"); }
struct Chan { float mur, muk, muv, kkc, kac, rkc; };
struct Raw { unsigned rk[16]; unsigned short v[16], al[16]; float w[16]; unsigned prk; unsigned short pv; };
__device__ __forceinline__ void fetch(const Args& a, int b, int h, int c, int lane, Raw& q) {
    const size_t base = ((size_t)b * T_ + (size_t)c * 16) * 512 + h * 64 + lane;
#pragma unroll
    for (int t = 0; t < 16; ++t) { q.rk[t] = a.rkw[base + (size_t)t * 512]; q.v[t] = a.vv[base + (size_t)t * 512]; q.al[t] = a.aga[base + (size_t)t * 512]; q.w[t] = a.wdec[base + (size_t)t * 512]; }
    q.prk = 0u; q.pv = 0;
    if (c > 0) { q.prk = a.rkw[base - 512]; q.pv = a.vv[base - 512]; }
}
__device__ __forceinline__ void st_row40(unsigned char* p, const unsigned (&w)[8]) {
    *(u32x2*)p = (u32x2){w[0], w[1]}; *(u32x2*)(p + 8) = (u32x2){w[2], w[3]}; *(u32x2*)(p + 16) = (u32x2){w[4], w[5]}; *(u32x2*)(p + 24) = (u32x2){w[6], w[7]};
}
template <bool BAR> __device__ __forceinline__ void seg_end() { if (BAR) wg_bar(); else { asm volatile("s_waitcnt lgkmcnt(0)" ::: "memory"); __builtin_amdgcn_sched_barrier(0); } }
template <bool BAR> __device__ __forceinline__ void produce(const Args& a, const Chan& ch, int b, int h, int c, const Raw& q, unsigned char* slot, unsigned char* scr, int lane) {
    const int i = lane & 31, hi = lane >> 5;
    const size_t row0 = (size_t)b * T_ + (size_t)c * 16;
    float pr_r = __builtin_bit_cast(float, q.prk << 16), pr_k = __builtin_bit_cast(float, q.prk & 0xffff0000u), pr_v = bf2f(q.pv);
    float rr[16], kq[16], kt[16];
    float* RED1 = (float*)scr;
    float* RED2 = (float*)(slot + S_BT);
#pragma unroll
    for (int t4 = 0; t4 < 4; ++t4) { f32x4 e1, e2;
#pragma unroll
        for (int e = 0; e < 4; ++e) { const int t = 4 * t4 + e;
            const float r0 = __builtin_bit_cast(float, q.rk[t] << 16), k0 = __builtin_bit_cast(float, q.rk[t] & 0xffff0000u), al = bf2f(q.al[t]);
            const float r = r0 + (pr_r - r0) * ch.mur, k = k0 + (pr_k - k0) * ch.muk;
            pr_r = r0; pr_k = k0;
            rr[t] = r; kq[t] = k * ch.kkc; kt[t] = k * (1.f + (al - 1.f) * ch.kac);
            e1[e] = kq[t] * kq[t]; e2[e] = r * kt[t] * ch.rkc; }
        *(f32x4*)(RED1 + lane * 16 + 4 * t4) = e1; *(f32x4*)(RED2 + lane * 16 + 4 * t4) = e2; }
    seg_end<BAR>();
    { const int t = lane & 15, part = lane >> 4; float s1 = 0.f, s2 = 0.f;
#pragma unroll
      for (int j = 0; j < 16; ++j) { s1 += RED1[(part * 16 + j) * 16 + t]; s2 += RED2[(part * 16 + j) * 16 + t]; }
      s1 += __shfl_xor(s1, 16); s2 += __shfl_xor(s2, 16); s1 += __shfl_xor(s1, 32); s2 += __shfl_xor(s2, 32);
      asm volatile("s_waitcnt lgkmcnt(0)" ::: "memory");
      if (lane < 16) { ((float*)(slot + S_GC))[lane] = s1; a.bonus[(row0 + lane) * 8 + h] = s2; } }
    asm volatile("s_waitcnt lgkmcnt(0)" ::: "memory");
    f32x4 n2[4];
#pragma unroll
    for (int t4 = 0; t4 < 4; ++t4) n2[t4] = *(const f32x4*)(slot + S_GC + 16 * t4);
    asm volatile("s_waitcnt lgkmcnt(0)" ::: "memory");
    float gam = 1.f;
    unsigned btp[8], ktp[8], vtp[8];
    float b_ev = 0.f, k_ev = 0.f, v_ev = 0.f;
#pragma unroll
    for (int t = 0; t < 16; ++t) {
        if (t == 6) seg_end<BAR>();
        const float v0 = bf2f(q.v[t]), al = bf2f(q.al[t]);
        const float v = v0 + (pr_v - v0) * ch.muv; pr_v = v0;
        const float kkn = kq[t] * __builtin_amdgcn_rsqf(fmaxf(n2[t >> 2][t & 3], 1e-24f));
        const float gp = gam; gam *= q.w[t]; const float ig = __builtin_amdgcn_rcpf(gam);
        const float bt_ = kkn * al * ig, kt_ = kt[t] * ig;
        const unsigned ar = pk2(-kkn * gp, rr[t] * gam), bk = pk2(bt_, kt_);
        *(bf16*)(slot + S_AT + t * RA + lane * 2) = (bf16)(ar & 0xffffu); *(bf16*)(slot + S_RT + t * RA + lane * 2) = (bf16)(ar >> 16);
        *(bf16*)(scr + t * RA + lane * 2) = (bf16)(bk & 0xffffu); *(bf16*)(scr + (16 + t) * RA + lane * 2) = (bf16)(bk >> 16);
        if (t & 1) { btp[t >> 1] = pk2(b_ev, bt_); ktp[t >> 1] = pk2(k_ev, kt_); vtp[t >> 1] = pk2(v_ev, v); }
        else { b_ev = bt_; k_ev = kt_; v_ev = v; }
    }
    st_row40(slot + S_BT + lane * RB, btp); st_row40(slot + S_KT + lane * RB, ktp); st_row40(slot + S_VT + lane * RB, vtp);
    ((float*)(slot + S_GC))[lane] = gam;
    seg_end<BAR>();
    f32x16 C;
#pragma unroll
    for (int r = 0; r < 16; ++r) C[r] = 0.f;
#pragma unroll
    for (int ks = 0; ks < 4; ++ks) {
        const bf16x8 af = *(const bf16x8*)(slot + S_AT + i * RA + (16 * ks + 8 * hi) * 2);
        const bf16x8 bf = *(const bf16x8*)(scr + i * RA + (16 * ks + 8 * hi) * 2);
        C = __builtin_amdgcn_mfma_f32_32x32x16_bf16(af, bf, C, 0, 0, 0);
    }
    asm volatile("s_waitcnt lgkmcnt(0)" ::: "memory");
    float* AAB = (float*)scr;
    unsigned char* SM = slot + S_SM;
#pragma unroll
    for (int r = 0; r < 16; ++r) {
        const int rho = crow(r, hi); const float val = C[r];
        if (r < 8) {
            if (i < 16) AAB[rho * 16 + i] = (i < rho) ? val : 0.f;
            else *(bf16*)(SM + SMM + rho * RB + (i - 16) * 2) = (bf16)f2bf((i - 16 < rho) ? val : 0.f);
        } else {
            const int tt = rho - 16;
            if (i < 16) *(bf16*)(SM + 2 * SMM + tt * RB + i * 2) = (bf16)f2bf((i <= tt) ? val : 0.f);
            else *(bf16*)(SM + 3 * SMM + tt * RB + (i - 16) * 2) = (bf16)f2bf((i - 16 <= tt) ? val : 0.f);
        }
    }
    seg_end<BAR>();
    { const int j = lane & 15; float Tr[16];
#pragma unroll
      for (int t = 0; t < 16; ++t) { if (t == 11) seg_end<BAR>();
          float acc = (t == j) ? 1.f : 0.f;
#pragma unroll
          for (int s4 = 0; s4 < (t + 3) / 4; ++s4) { const f32x4 ar = *(const f32x4*)(AAB + t * 16 + 4 * s4);
#pragma unroll
              for (int e = 0; e < 4; ++e) if (4 * s4 + e < t) acc += ar[e] * Tr[4 * s4 + e]; }
          Tr[t] = acc;
          if (lane < 16) *(bf16*)(SM + t * RB + j * 2) = (bf16)f2bf(acc); } }
    seg_end<BAR>();
}

__device__ __forceinline__ bf16x8 rd_perm(const unsigned char* p, int hi) {
    const u32x2 a = *(const u32x2*)(p + 8 * hi), b = *(const u32x2*)(p + 16 + 8 * hi);
    return __builtin_bit_cast(bf16x8, (u32x4){a.x, a.y, b.x, b.y});
}
__device__ __forceinline__ bf16x8 rd_nat(const unsigned char* p, int hi) {
    const u32x2 a = *(const u32x2*)(p + 16 * hi), b = *(const u32x2*)(p + 16 * hi + 8);
    return __builtin_bit_cast(bf16x8, (u32x4){a.x, a.y, b.x, b.y});
}
__device__ __forceinline__ bf16x8 and8(bf16x8 f, unsigned m) { u32x4 w = __builtin_bit_cast(u32x4, f); w.x &= m; w.y &= m; w.z &= m; w.w &= m; return __builtin_bit_cast(bf16x8, w); }
__device__ __forceinline__ void consume(const unsigned char* slot, f32x16 (&z)[2], float* yout, int vt, int lane) {
    const int i = lane & 31, hi = lane >> 5, i16 = i & 15;
    const unsigned m16 = i < 16 ? 0xffffffffu : 0u;
    const unsigned char* at = slot + S_AT + i16 * RA; const unsigned char* rt = slot + S_RT + i16 * RA; const unsigned char* sm16 = slot + S_SM + i16 * RB;
    bf16x8 fa0 = rd_perm(at, hi), fa1 = rd_perm(at + 32, hi), fa2 = rd_perm(at + 64, hi), fa3 = rd_perm(at + 96, hi);
    bf16x8 fak = rd_nat(sm16 + SMM, hi), ft = rd_perm(sm16, hi);
    const bf16x8 vtf = rd_nat(slot + S_VT + (32 * vt + i) * RB, hi);
    bf16x8 fr0 = rd_perm(rt, hi), fr1 = rd_perm(rt + 32, hi), fr2 = rd_perm(rt + 64, hi), fr3 = rd_perm(rt + 96, hi);
    bf16x8 frb = rd_perm(sm16 + 2 * SMM, hi), frk = rd_nat(sm16 + 3 * SMM, hi);
    const bf16x8 fk0 = rd_nat(slot + S_KT + i * RB, hi), fk1 = rd_nat(slot + S_KT + (32 + i) * RB, hi);
    const bf16x8 fb0 = rd_perm(slot + S_BT + i * RB, hi), fb1 = rd_perm(slot + S_BT + (32 + i) * RB, hi);
    f32x4 g4[2][4];
#pragma unroll
    for (int kt = 0; kt < 2; ++kt)
#pragma unroll
        for (int rg = 0; rg < 4; ++rg) g4[kt][rg] = *(const f32x4*)(slot + S_GC + (32 * kt + 8 * rg + 4 * hi) * 4);
    const bf16x8 zb0 = pack8(z[0], 0), zb1 = pack8(z[0], 8), zb2 = pack8(z[1], 0), zb3 = pack8(z[1], 8);
    fa0 = and8(fa0, m16); fa1 = and8(fa1, m16); fa2 = and8(fa2, m16); fa3 = and8(fa3, m16); fak = and8(fak, m16); ft = and8(ft, m16);
    fr0 = and8(fr0, m16); fr1 = and8(fr1, m16); fr2 = and8(fr2, m16); fr3 = and8(fr3, m16); frb = and8(frb, m16); frk = and8(frk, m16);
    f32x16 X, U, Y;
#pragma unroll
    for (int r = 0; r < 16; ++r) { X[r] = 0.f; U[r] = 0.f; Y[r] = 0.f; }
    X = __builtin_amdgcn_mfma_f32_32x32x16_bf16(fa0, zb0, X, 0, 0, 0);
    X = __builtin_amdgcn_mfma_f32_32x32x16_bf16(fa1, zb1, X, 0, 0, 0);
    X = __builtin_amdgcn_mfma_f32_32x32x16_bf16(fa2, zb2, X, 0, 0, 0);
    X = __builtin_amdgcn_mfma_f32_32x32x16_bf16(fa3, zb3, X, 0, 0, 0);
    X = __builtin_amdgcn_mfma_f32_32x32x16_bf16(fak, vtf, X, 0, 0, 0);
    Y = __builtin_amdgcn_mfma_f32_32x32x16_bf16(fr0, zb0, Y, 0, 0, 0);
    Y = __builtin_amdgcn_mfma_f32_32x32x16_bf16(fr1, zb1, Y, 0, 0, 0);
    Y = __builtin_amdgcn_mfma_f32_32x32x16_bf16(fr2, zb2, Y, 0, 0, 0);
    Y = __builtin_amdgcn_mfma_f32_32x32x16_bf16(fr3, zb3, Y, 0, 0, 0);
    Y = __builtin_amdgcn_mfma_f32_32x32x16_bf16(frk, vtf, Y, 0, 0, 0);
    z[0] = __builtin_amdgcn_mfma_f32_32x32x16_bf16(fk0, vtf, z[0], 0, 0, 0);
    z[1] = __builtin_amdgcn_mfma_f32_32x32x16_bf16(fk1, vtf, z[1], 0, 0, 0);
    const bf16x8 xb = pack8(X, 0);
    U = __builtin_amdgcn_mfma_f32_32x32x16_bf16(ft, xb, U, 0, 0, 0);
    const bf16x8 ub = pack8(U, 0);
    z[0] = __builtin_amdgcn_mfma_f32_32x32x16_bf16(fb0, ub, z[0], 0, 0, 0);
    z[1] = __builtin_amdgcn_mfma_f32_32x32x16_bf16(fb1, ub, z[1], 0, 0, 0);
    Y = __builtin_amdgcn_mfma_f32_32x32x16_bf16(frb, ub, Y, 0, 0, 0);
#pragma unroll
    for (int kt = 0; kt < 2; ++kt)
#pragma unroll
        for (int rg = 0; rg < 4; ++rg)
#pragma unroll
            for (int e = 0; e < 4; ++e) z[kt][4 * rg + e] *= g4[kt][rg][e];
#pragma unroll
    for (int r = 0; r < 8; ++r) yout[(size_t)crow(r, hi) * 512] = Y[r];
}

__device__ __forceinline__ unsigned ld_relaxed(const unsigned* p) { return __hip_atomic_load(p, __ATOMIC_RELAXED, __HIP_MEMORY_SCOPE_AGENT); }
__device__ __forceinline__ void head(const Args& a, int bh, unsigned char* sm) {
    const int tid = tidx(), lane = tid & 63, w = __builtin_amdgcn_readfirstlane(tid >> 6);
    const int b = bh >> 3, h = bh & 7;
    constexpr int NCH = T_ / 16, NBAR = NCH + NPROD;
    if (w < 2) {
        f32x16 z[2];
#pragma unroll
        for (int r = 0; r < 16; ++r) { z[0][r] = 0.f; z[1][r] = 0.f; }
        for (int i = 0; i < NPROD; ++i) wg_bar();
        for (int c = 0; c < NCH; ++c) {
            consume(sm + (size_t)(c % RING) * SLOT, z, a.yraw + ((size_t)b * T_ + (size_t)c * 16) * 512 + h * 64 + 32 * w + (lane & 31), w, lane);
            if (w == 0 && (c & 7) == 7 && lane == 0) __hip_atomic_store(a.cons + bh * 64, (unsigned)(c + 1), __ATOMIC_RELAXED, __HIP_MEMORY_SCOPE_AGENT);
            wg_bar();
        }
    } else {
        const int pw = w - 2;
        int nb = pw;
        {
            u32x4 v[15];
            { const int c = pw; const int hl = c % NHELP, n = c / NHELP;
              const unsigned char* g = a.ring + ((size_t)(bh * NHELP + hl) * RG + (n % RG)) * SLOT;
              while (__builtin_amdgcn_readfirstlane(ld_relaxed(a.flags + bh * NCH + c)) == 0u) __builtin_amdgcn_s_sleep(2);
              __builtin_amdgcn_fence(__ATOMIC_ACQUIRE, "agent");
              asm volatile("s_waitcnt vmcnt(0)" ::: "memory");
#pragma unroll
              for (int i = 0; i < 15; ++i) { const int off = (i * 64 + lane) * 16; if (off < SLOT) v[i] = *(const u32x4*)(g + off); } }
            for (int i = 0; i < pw; ++i) wg_bar();
            for (int c = pw; c < NCH; c += NPROD) {
                unsigned char* slot = sm + (size_t)(c % RING) * SLOT;
#pragma unroll
                for (int i = 0; i < 15; ++i) { const int off = (i * 64 + lane) * 16; if (off < SLOT) *(u32x4*)(slot + off) = v[i]; }
                const int cn = c + NPROD; const bool more = cn < NCH;
                const unsigned* fp = a.flags + bh * NCH + (more ? cn : c);
                unsigned fl = ld_relaxed(fp);
                wg_bar(); wg_bar();
                if (more) {
                    while (__builtin_amdgcn_readfirstlane(fl) == 0u) { __builtin_amdgcn_s_sleep(2); fl = ld_relaxed(fp); }
                    __builtin_amdgcn_fence(__ATOMIC_ACQUIRE, "agent");
                    asm volatile("s_waitcnt vmcnt(0)" ::: "memory");
                    const int hl = cn % NHELP, n = cn / NHELP;
                    const unsigned char* g = a.ring + ((size_t)(bh * NHELP + hl) * RG + (n % RG)) * SLOT;
#pragma unroll
                    for (int i = 0; i < 15; ++i) { const int off = (i * 64 + lane) * 16; if (off < SLOT) v[i] = *(const u32x4*)(g + off); }
                }
                wg_bar(); wg_bar(); wg_bar(); wg_bar();
                nb += NPROD;
            }
        }
        for (; nb < NBAR; ++nb) wg_bar();
    }
}
constexpr int NHW = 7;
__device__ __forceinline__ void helper(const Args& a, int bh, int hl, unsigned char* sm) {
    const int tid = tidx(), lane = tid & 63, w = __builtin_amdgcn_readfirstlane(tid >> 6);
    if (w >= NHW) return;
    const int b = bh >> 3, h = bh & 7, col = h * 64 + lane;
    constexpr int NCH = T_ / 16;
    unsigned char* slot = sm + (size_t)w * SLOT; unsigned char* scr = sm + NHW * SLOT + w * SCR;
    const Chan ch{a.mu[col], a.mu[512 + col], a.mu[1024 + col], a.kk[col], a.ka[col], a.rk[col]};
    int n = w, c = NHELP * n + hl;
    if (c >= NCH) return;
    for (; c < NCH; n += NHW, c += NHW * NHELP) {
        Raw q; fetch(a, b, h, c, lane, q);
        if (n >= RG) { const unsigned need = (unsigned)(c - RG * NHELP + 1);
            while (__builtin_amdgcn_readfirstlane(ld_relaxed(a.cons + bh * 64)) < need) __builtin_amdgcn_s_sleep(8); }
        produce<false>(a, ch, b, h, c, q, slot, scr, lane);
        asm volatile("s_waitcnt lgkmcnt(0)" ::: "memory");
        unsigned char* g = a.ring + ((size_t)(bh * NHELP + hl) * RG + (n % RG)) * SLOT;
#pragma unroll
        for (int i = 0; i < 15; ++i) { const int off = (i * 64 + lane) * 16;
            if (off < SLOT) { const u32x4 d = *(const u32x4*)(slot + off); unsigned char* gp = g + off; asm volatile("global_store_dwordx4 %0, %1, off sc1\n\ts_nop 1" :: "v"(gp), "v"(d) : "memory"); } }
        asm volatile("s_waitcnt vmcnt(0)" ::: "memory");
        if (lane == 0) __hip_atomic_store(a.flags + bh * NCH + c, 1u, __ATOMIC_RELAXED, __HIP_MEMORY_SCOPE_AGENT);
    }
}
__device__ __forceinline__ void finish(const float* yraw, const float* bonus, const bf16* vv, const bf16* agg, const float* mu, const float* gng, const float* gnb, bf16* amix) {
    const int T512 = tidx(), lane = T512 & 63;
    for (int row = blockIdx.x * 8 + (T512 >> 6); row < M_; row += gridDim.x * 8) {
        const int t = row % T_;
        float y[8], v0[8], v1[8], gg[8], bo[8];
#pragma unroll
        for (int j = 0; j < 8; ++j) { const int col = j * 64 + lane;
            y[j] = yraw[(size_t)row * 512 + col]; v0[j] = bf2f(vv[(size_t)row * 512 + col]); v1[j] = t ? bf2f(vv[(size_t)(row - 1) * 512 + col]) : 0.f;
            gg[j] = bf2f(agg[(size_t)row * 512 + col]); bo[j] = bonus[(size_t)row * 8 + j]; }
        float mean[8], var[8];
#pragma unroll
        for (int j = 0; j < 8; ++j) mean[j] = y[j];
#pragma unroll
        for (int o = 1; o < 64; o <<= 1) {
#pragma unroll
            for (int j = 0; j < 8; ++j) mean[j] += __shfl_xor(mean[j], o); }
#pragma unroll
        for (int j = 0; j < 8; ++j) { mean[j] *= (1.f / 64.f); y[j] -= mean[j]; var[j] = y[j] * y[j]; }
#pragma unroll
        for (int o = 1; o < 64; o <<= 1) {
#pragma unroll
            for (int j = 0; j < 8; ++j) var[j] += __shfl_xor(var[j], o); }
#pragma unroll
        for (int j = 0; j < 8; ++j) { const int col = j * 64 + lane;
            const float yn = y[j] * rsqrtf(var[j] * (1.f / 64.f) + 64e-5f) * gng[col] + gnb[col];
            const float v = v0[j] + (v1[j] - v0[j]) * mu[1024 + col];
            amix[(size_t)row * DM + 512 + col] = (bf16)f2bf((yn + bo[j] * v) * gg[j]); }
    }
}
}

namespace mema {
using nsa::f32x16; using nsa::KROW; using nsa::VROW; using nsa::KBUF; using nsa::VBUF; using nsa::OFF_K; using nsa::OFF_V; using nsa::OFF_WS; using nsa::crow; using nsa::pack8;
__device__ __forceinline__ void unit(const bf16* qm, const bf16* mk, const bf16* mvt, bf16* om, int u, unsigned char* sm) {
    const int tid = tidx(), lane = tid & 63, w = __builtin_amdgcn_readfirstlane(tid >> 6), i = lane & 31, hi = lane >> 5;
    const int b = u >> 7, h = (u >> 5) & 3, rb = u & 31;
    const int row0 = b * T_ + rb * 256 + 32 * w;
    const bf16* qrow = qm + (size_t)(row0 + i) * DM + h * 256 + 8 * hi;
    const bf16* kbase = mk + (size_t)(b * 256 + (tid >> 3)) * DM + h * 256 + (tid & 7) * 8;
    const bf16* vbase = mvt + (size_t)(h * 256 + (tid >> 3)) * 512 + b * 256 + (tid & 7) * 8;
    unsigned char* kst = sm + OFF_K + (tid >> 3) * KROW + (tid & 7) * 16;
    unsigned char* vst = sm + OFF_V + (tid >> 3) * VROW + (tid & 7) * 16;
    float* wsc = (float*)(sm + OFF_WS) + w * 32;
    f32x16 p[4][2];
#pragma unroll
    for (int kt = 0; kt < 4; ++kt)
#pragma unroll
        for (int r = 0; r < 16; ++r) { p[kt][0][r] = 0.f; p[kt][1][r] = 0.f; }
    u32x4 tr[4];
#define MEMA_SRC(n) ((n) < 16 ? (const u32x4*)(kbase + (size_t)(64 * ((n) & 3)) * DM + 64 * ((n) >> 2)) : (const u32x4*)(vbase + (size_t)(64 * (((n) - 16) >> 2)) * 512 + 64 * ((n) & 3)))
#define MEMA_PUT(n) do { if ((n) < 16) *(u32x4*)(kst + ((n) & 1) * KBUF) = tr[(n) & 3]; else { unsigned char* vp2_ = vst + ((n) & 1) * VBUF; *(u32x2*)vp2_ = (u32x2){tr[(n) & 3].x, tr[(n) & 3].y}; *(u32x2*)(vp2_ + 8) = (u32x2){tr[(n) & 3].z, tr[(n) & 3].w}; } } while (0)
    tr[0] = *MEMA_SRC(0); tr[1] = *MEMA_SRC(1); tr[2] = *MEMA_SRC(2);
    MEMA_PUT(0);
    __syncthreads();
    bf16x8 qf[4];
#pragma unroll
    for (int n = 0; n < 16; ++n) {
        const int dc = n >> 2, kt = n & 3, cb = n & 1;
        tr[(n + 3) & 3] = *MEMA_SRC(n + 3);
        if (kt == 0) {
#pragma unroll
            for (int d0 = 0; d0 < 4; ++d0) qf[d0] = *(const bf16x8*)(qrow + 64 * dc + 16 * d0);
        }
        const unsigned char* kb = sm + OFF_K + cb * KBUF;
#pragma unroll
        for (int d0 = 0; d0 < 4; ++d0) {
            const bf16x8 a0 = *(const bf16x8*)(kb + i * KROW + (16 * d0 + 8 * hi) * 2);
            const bf16x8 a1 = *(const bf16x8*)(kb + (32 + i) * KROW + (16 * d0 + 8 * hi) * 2);
            p[kt][0] = __builtin_amdgcn_mfma_f32_32x32x16_bf16(a0, qf[d0], p[kt][0], 0, 0, 0);
            p[kt][1] = __builtin_amdgcn_mfma_f32_32x32x16_bf16(a1, qf[d0], p[kt][1], 0, 0, 0);
        }
        MEMA_PUT(n + 1);
        __syncthreads();
    }
    float mx = p[0][0][0];
#pragma unroll
    for (int kt = 0; kt < 4; ++kt)
#pragma unroll
        for (int r = 0; r < 16; ++r) mx = fmaxf(mx, fmaxf(p[kt][0][r], p[kt][1][r]));
    mx = fmaxf(mx, __shfl_xor(mx, 32));
    float l = 0.f;
#pragma unroll
    for (int kt = 0; kt < 4; ++kt)
#pragma unroll
        for (int r = 0; r < 16; ++r) { p[kt][0][r] = __builtin_amdgcn_exp2f(p[kt][0][r] - mx); p[kt][1][r] = __builtin_amdgcn_exp2f(p[kt][1][r] - mx); l += p[kt][0][r] + p[kt][1][r]; }
    l += __shfl_xor(l, 32);
    bf16x8 pf[4][4];
#pragma unroll
    for (int kt = 0; kt < 4; ++kt) { pf[kt][0] = pack8(p[kt][0], 0); pf[kt][1] = pack8(p[kt][0], 8); pf[kt][2] = pack8(p[kt][1], 0); pf[kt][3] = pack8(p[kt][1], 8); }
    if (hi == 0) wsc[i] = 1.f / l;
    asm volatile("" ::: "memory");
    f32x4 il[4];
#pragma unroll
    for (int rg = 0; rg < 4; ++rg) il[rg] = *(const f32x4*)(wsc + 8 * rg + 4 * hi);
    f32x16 o[2];
#pragma unroll
    for (int n = 16; n < 32; ++n) {
        const int dvt = (n - 16) >> 2, kt = n & 3, cb = n & 1;
        if (n + 3 < 32) tr[(n + 3) & 3] = *MEMA_SRC(n + 3);
        if (kt == 0) {
#pragma unroll
            for (int r = 0; r < 16; ++r) { o[0][r] = 0.f; o[1][r] = 0.f; }
        }
        const unsigned char* vb = sm + OFF_V + cb * VBUF;
#pragma unroll
        for (int dt = 0; dt < 2; ++dt) {
            const unsigned char* vp = vb + (32 * dt + i) * VROW + 8 * hi;
#pragma unroll
            for (int ks = 0; ks < 4; ++ks) {
                const u32x2 v_lo = *(const u32x2*)(vp + 32 * ks), v_hi = *(const u32x2*)(vp + 32 * ks + 16);
                const bf16x8 vf = __builtin_bit_cast(bf16x8, (u32x4){v_lo.x, v_lo.y, v_hi.x, v_hi.y});
                o[dt] = __builtin_amdgcn_mfma_f32_32x32x16_bf16(pf[kt][ks], vf, o[dt], 0, 0, 0);
            }
        }
        if (kt == 3) {
#pragma unroll
            for (int r = 0; r < 16; ++r) { bf16* op = om + (size_t)(row0 + crow(r, hi)) * DM + h * 256 + 64 * dvt + i;
                op[0] = (bf16)f2bf(o[0][r] * il[r >> 2][r & 3]); op[32] = (bf16)f2bf(o[1][r] * il[r >> 2][r & 3]); }
        }
        if (n + 1 < 32) MEMA_PUT(n + 1);
        __syncthreads();
    }
#undef MEMA_SRC
#undef MEMA_PUT
}
}

#define LAS __attribute__((address_space(3)))
#define XB_TMO      128
#define XB_XCNT(j)  (256  + 64 * (j))
#define XB_XSUB(j)  (1280 + 64 * (j))
#define XB_XGEN(j)  (2304 + 64 * (j))
#define XB_TOP      3328
#define XB_TOPGEN   3392
#define XCD_BAR_WORDS 3456
#define XB_SPIN_CAP (1u << 18)

__device__ __forceinline__ unsigned xb_ld(unsigned* p)              { return __hip_atomic_load(p, __ATOMIC_RELAXED, __HIP_MEMORY_SCOPE_AGENT); }
__device__ __forceinline__ unsigned xb_add(unsigned* p, unsigned v) { return __hip_atomic_fetch_add(p, v, __ATOMIC_RELAXED, __HIP_MEMORY_SCOPE_AGENT); }
__device__ __forceinline__ unsigned xb_xcc_id() { return (unsigned)__builtin_amdgcn_s_getreg((3 << 11) | 20) & 0xFu; }
#define XB_SPIN(cond, bar) do { unsigned _sp = 0; while (cond) { __builtin_amdgcn_s_sleep(1); \
    if ((++_sp & 255u) == 0u) { if (xb_ld(&(bar)[XB_TMO])) break; if (_sp > XB_SPIN_CAP) { atomicAdd(&(bar)[XB_TMO], 1u); break; } } } } while (0)

struct XcdBarrier {
    unsigned* bar; unsigned x;
    volatile LAS unsigned* st;
};

__device__ __forceinline__ XcdBarrier xcd_barrier_post(unsigned* bar, volatile LAS unsigned* st) {
    XcdBarrier b; b.bar = bar; b.x = xb_xcc_id(); b.st = st;
    if (tidx() == 0) (void)xb_add(&bar[XB_XCNT(b.x)], 1u);
    return b;
}
__device__ __forceinline__ void xcd_barrier_complete(unsigned* bar, unsigned x, unsigned& nloc, unsigned& nx, unsigned gsize) {
    const unsigned G = gsize ? gsize : gridDim.x * gridDim.y * gridDim.z;
    unsigned sum, cnt, mine, sp = 0u;
    for (;;) {
        sum = 0u; cnt = 0u; mine = 0u;
#pragma unroll
        for (unsigned j = 0; j < 16; ++j) { const unsigned c = xb_ld(&bar[XB_XCNT(j)]); sum += c; cnt += (c > 0u) ? 1u : 0u; mine = (j == x) ? c : mine; }
        if (sum == G) break;
        __builtin_amdgcn_s_sleep(1);
        if ((++sp & 255u) == 0u) { if (xb_ld(&bar[XB_TMO])) break; if (sp > XB_SPIN_CAP) { atomicAdd(&bar[XB_TMO], 1u); break; } }
    }
    nloc = mine > 0u ? mine : 1u; nx = cnt > 0u ? cnt : 1u;
}

__device__ __forceinline__ void xcd_barrier(const XcdBarrier& b, unsigned gsize = 0u) {
    asm volatile("s_waitcnt vmcnt(0)" ::: "memory");
    __syncthreads();
    if (tidx() == 0) {
        unsigned* bar = b.bar;
        __builtin_amdgcn_s_waitcnt(0);
        unsigned nloc = b.st[0], nx = b.st[1];
        if (nloc == 0u) { xcd_barrier_complete(bar, b.x, nloc, nx, gsize); b.st[0] = nloc; b.st[1] = nx; }
        const unsigned old = xb_add(&bar[XB_XSUB(b.x)], 1u);
        const unsigned gen = old / nloc;
        if (old + 1u == (gen + 1u) * nloc) {
            __builtin_amdgcn_fence(__ATOMIC_RELEASE, "agent");
            asm volatile("s_waitcnt vmcnt(0)" ::: "memory");
            const unsigned og = xb_add(&bar[XB_TOP], 1u);
            const unsigned tg = og / nx;
            if (og + 1u == (tg + 1u) * nx) xb_add(&bar[XB_TOPGEN], 1u);
            else XB_SPIN(xb_ld(&bar[XB_TOPGEN]) == tg, bar);
            __builtin_amdgcn_fence(__ATOMIC_ACQUIRE, "agent");
            xb_add(&bar[XB_XGEN(b.x)], 1u);
            asm volatile("s_waitcnt vmcnt(0)" ::: "memory");
        } else {
            XB_SPIN(xb_ld(&bar[XB_XGEN(b.x)]) == gen, bar);
            __builtin_amdgcn_fence(__ATOMIC_ACQUIRE, "agent");
            asm volatile("s_waitcnt vmcnt(0)" ::: "memory");
        }
    }
    __syncthreads();
}

constexpr int NTHREADS = 512, LDS_BYTES = 147456;
struct MegaArgs { const float* in[41]; float* out; unsigned char* ws; };
#define WSB(off) ((bf16*)(ws + (off)))
#define WSF(off) ((float*)(ws + (off)))

__global__ void __launch_bounds__(NTHREADS) mega_fwd(MegaArgs A) {
    extern __shared__ __attribute__((aligned(16))) unsigned char lds[];
    cg::grid_group grid = cg::this_grid();
    const float* const* in = A.in; unsigned char* ws = A.ws; float* out = A.out;
    if (tidx() < 4) ((volatile LAS unsigned*)(lds + LDS_BYTES - 64))[tidx()] = 0u;
    __syncthreads();
    const XcdBarrier xbar = xcd_barrier_post((unsigned*)(ws + WS_CTL) + 16384, (volatile LAS unsigned*)(lds + LDS_BYTES - 64));
    constexpr int NRW = 16 * (1 + rw7::NHELP);
    if ((int)blockIdx.x >= NRW && tidx() == 0) (void)xb_add(&((unsigned*)(ws + WS_CTL) + 20480)[XB_XCNT(xb_xcc_id())], 1u);

    d_convert(WSB(WS_W1GU), NGU, DM, MapGU{in[I_F1_WG], in[I_F1_WU], FF});
    d_convert(WSB(WS_WIN), NWIN, DM, MapWin{in[I_WIN], IN_COLS});
    d_convert(WSB(WS_CW1K), 256, 2048, MapPlain{in[I_W1_K], 256});
    d_convert(WSB(WS_CW1V), 256, 2048, MapPlain{in[I_W1_V], 256});
    d_convert_lora(WSB(WS_WLORA), in[I_W2], in[I_A2], in[I_G2]);
    d_convert(WSB(WS_WK), DM, DM, MapPlain{in[I_WK], DM});
    d_convert(WSB(WS_WV), DM, DM, MapPlain{in[I_WV], DM});
    d_convert(WSB(WS_CW2), 64, 256, MapPlain{in[I_W2_K], 64});
    d_convert(WSB(WS_CW2) + 64 * 256, 64, 256, MapPlain{in[I_W2_V], 64});
    d_rope_table(WSF(WS_ROPE));
    d_cmp_bias(in[I_PE_K], in[I_W1_K], in[I_PE_V], in[I_W1_V], WSF(WS_CBIAS), (float*)lds);
    d_rownorm(in[I_X], in[I_F1_PRE], WSB(WS_XN), M_);
    d_rownorm(in[I_MEM], in[I_MEM_KVG], WSB(WS_MEMN), 512);
    grid.sync();
    gemm_pg8(lds, WSB(WS_XN), DM, WSB(WS_W1GU), DM, M_, NGU, DM, EpiSwiGLU{WSB(WS_HB)});
    d_convert(WSB(WS_W1D), DM, FF, MapPlain{in[I_F1_WD], DM}, 128);
    xcd_barrier(xbar);
    gemm_norm_res<false, true>(lds, WSB(WS_HB), FF, WSB(WS_W1D), FF, in[I_X], out, WSB(WS_XN), in[I_F1_POST], in[I_MIX_PRE], 0.5f, (unsigned*)(ws + WS_GATES), (unsigned*)(ws + WS_CTL) + 1024 + 0 * 2048);
    xcd_barrier(xbar);
    gemm_pg8(lds, WSB(WS_XN), DM, WSB(WS_WIN), DM, M_, 3072, DM,
             EpiWin{WSB(WS_QB), WSB(WS_KS), WSB(WS_KW), WSB(WS_KCR), WSB(WS_VCR), WSB(WS_VST), WSB(WS_VWT), (unsigned*)(ws + WS_RKVA), WSB(WS_RKVA + 32 * MiB), WSB(WS_PRL), WSF(WS_GATES), WSF(WS_ROPE)});
    d_gates(WSB(WS_XN), WSB(WS_WIN) + (size_t)3072 * DM, WSF(WS_GATES), (float*)lds);
    if (blockIdx.x == 0) { const int t_ = tidx(); float b_ = 0.f; for (int jc = 0; jc < 8; ++jc) b_ += WSF(WS_CBIAS)[jc * 512 + t_]; WSF(WS_CBIAS)[4096 + t_] = b_; }
    xcd_barrier(xbar);
    d_lora_prep(WSB(WS_PRL), in[I_MU], WSB(WS_XN));
    xcd_barrier(xbar);
    gemm_pg8(lds, WSB(WS_XN), KLORA, WSB(WS_WLORA), KLORA, M_, NLORA, KLORA, EpiLora{WSF(WS_YB), WSB(WS_RKVA + 48 * MiB), WSB(WS_AGG), in[I_W0], in[I_A0]});
    xcd_barrier(xbar);
    if ((int)blockIdx.x < NRW) {
        const rw7::Args ra{(const unsigned*)(ws + WS_RKVA), WSB(WS_RKVA + 32 * MiB), WSB(WS_RKVA + 48 * MiB), WSF(WS_YB), in[I_MU], in[I_KK], in[I_KA], in[I_RK], WSF(WS_YB), WSF(WS_BONUS),
                           ws + WS_BONUS + 1 * MiB, (unsigned*)(ws + WS_CTL) + 32768, (unsigned*)(ws + WS_CTL) + 24576};
        if (blockIdx.x < 16) rw7::head(ra, blockIdx.x, lds);
        else rw7::helper(ra, (blockIdx.x - 16) % 16, (blockIdx.x - 16) / 16, lds);
        __syncthreads();
        if (tidx() == 0) { unsigned* f = (unsigned*)(ws + WS_CTL) + 64; unsigned sp = 0u; while (xb_ld(f) == 0u && ++sp < (1u << 22)) __builtin_amdgcn_s_sleep(2); }
        __builtin_amdgcn_fence(__ATOMIC_ACQUIRE, "agent");
        asm volatile("s_waitcnt vmcnt(0)" ::: "memory");
        __syncthreads();
    } else {
        XcdBarrier sb; sb.bar = (unsigned*)(ws + WS_CTL) + 20480; sb.x = xb_xcc_id(); sb.st = (volatile LAS unsigned*)(lds + LDS_BYTES - 56);
        { float* part = (float*)(ws + WS_XN + 8 * MiB);
          gemm_pg8(lds, WSB(WS_KCR), 1024, WSB(WS_CW1K), 2048, 2048, 256, 1024, EpiStoreF32{part, 256}, NRW);
          gemm_pg8(lds, WSB(WS_KCR) + 1024, 1024, WSB(WS_CW1K) + 1024, 2048, 2048, 256, 1024, EpiStoreF32{part + (size_t)2048 * 256, 256}, NRW + 8);
          gemm_pg8(lds, WSB(WS_VCR), 1024, WSB(WS_CW1V), 2048, 2048, 256, 1024, EpiStoreF32{part + (size_t)2 * 2048 * 256, 256}, NRW + 16);
          gemm_pg8(lds, WSB(WS_VCR) + 1024, 1024, WSB(WS_CW1V) + 1024, 2048, 2048, 256, 1024, EpiStoreF32{part + (size_t)3 * 2048 * 256, 256}, NRW + 24); }
        gemm_pg8(lds, WSB(WS_MEMN), DM, WSB(WS_WK), DM, 512, DM, DM, EpiStore{WSB(WS_HIDK), DM, 1.f}, NRW + 32);
        gemm_pg8(lds, WSB(WS_WV), DM, WSB(WS_MEMN), DM, DM, 512, DM, EpiStore{WSB(WS_HIDV), 512, 1.f}, NRW + 40);
        d_convert(WSB(WS_W2GU), NGU, DM, MapGU{in[I_F2_WG], in[I_F2_WU], FF}, NRW + 48);
        d_convert(WSB(WS_W2D), DM, FF, MapPlain{in[I_F2_WD], DM}, NRW + 48);
        d_convert(WSB(WS_WOUT), DM, DM, MapPlain{in[I_WOUT], DM}, NRW + 48);
        d_convert(WSB(WS_WQ), DM, DM, MapPlain{in[I_WQ], DM}, NRW + 48);
        d_convert(WSB(WS_WO), DM, DM, MapPlain{in[I_WO], DM}, NRW + 48);
        xcd_barrier(sb, 256u - NRW);
        d_cmp2((const float*)(ws + WS_XN + 8 * MiB), WSF(WS_CBIAS) + 4096, WSB(WS_CW2), WSF(WS_ROPE), WSB(WS_KC), WSB(WS_VCT), NRW);
        xcd_barrier(sb, 256u - NRW);
        if ((int)blockIdx.x == NRW && tidx() == 0) __hip_atomic_store((unsigned*)(ws + WS_CTL) + 64, 1u, __ATOMIC_RELAXED, __HIP_MEMORY_SCOPE_AGENT);
    }
    {
        const NsaArgs na{WSB(WS_QB), WSB(WS_KC), WSB(WS_VCT), WSB(WS_KS), WSB(WS_VST), WSB(WS_KW), WSB(WS_VWT), WSF(WS_GATES), WSB(WS_XN)};
        nsa::phase(na, (unsigned*)(ws + WS_CTL), lds);
    }
    xcd_barrier(xbar);
    d_nsa_outnorm(WSB(WS_XN), in[I_NSA_G]);
    rw7::finish(WSF(WS_YB), WSF(WS_BONUS), WSB(WS_RKVA + 32 * MiB), WSB(WS_AGG), in[I_MU], in[I_GNG], in[I_GNB], WSB(WS_XN));
    xcd_barrier(xbar);
    gemm_norm_res<true, true>(lds, WSB(WS_XN), DM, WSB(WS_WOUT), DM, out, WSB(WS_YB), WSB(WS_XN), in[I_MIX_POST], in[I_MEM_PRE], 1.0f, (unsigned*)(ws + WS_GATES), (unsigned*)(ws + WS_CTL) + 1024 + 1 * 2048);
    xcd_barrier(xbar);
    gemm_pg8(lds, WSB(WS_XN), DM, WSB(WS_WQ), DM, M_, DM, DM, EpiStore{WSB(WS_QM), DM, MSCALE});
    xcd_barrier(xbar);
    if (blockIdx.x < 256) mema::unit(WSB(WS_QM), WSB(WS_HIDK), WSB(WS_HIDV), WSB(WS_OM), (int)blockIdx.x, lds);
    xcd_barrier(xbar);
    gemm_norm_res<true, true>(lds, WSB(WS_OM), DM, WSB(WS_WO), DM, WSB(WS_YB), WSB(WS_YB), WSB(WS_XN), in[I_MEM_POST], in[I_F2_PRE], 1.0f, (unsigned*)(ws + WS_GATES), (unsigned*)(ws + WS_CTL) + 1024 + 2 * 2048);
    xcd_barrier(xbar);
    gemm_pg8(lds, WSB(WS_XN), DM, WSB(WS_W2GU), DM, M_, NGU, DM, EpiSwiGLU{WSB(WS_HB)});
    xcd_barrier(xbar);
    gemm_norm_res<true, false>(lds, WSB(WS_HB), FF, WSB(WS_W2D), FF, WSB(WS_YB), out, (bf16*)nullptr, in[I_F2_POST], (const float*)nullptr, 0.5f, (unsigned*)(ws + WS_GATES), (unsigned*)(ws + WS_CTL) + 1024 + 3 * 2048);
}

extern "C" void kernel_launch(void* const* d_in, const int* in_sizes, int n_in, void* d_out, int out_size, void* d_ws, size_t ws_size, hipStream_t stream) {
    static int grid = 0;
    if (grid == 0) {
        if (n_in != 41 || ws_size < WS_END) { fprintf(stderr, "kernel_launch: unexpected n_in %d / ws %zu\n", n_in, ws_size); grid = -1; return; }
        int dev = 0, cus = 0, per_cu = 0;
        hipGetDevice(&dev); hipDeviceGetAttribute(&cus, hipDeviceAttributeMultiprocessorCount, dev);
        if (hipFuncSetAttribute((const void*)mega_fwd, hipFuncAttributeMaxDynamicSharedMemorySize, LDS_BYTES) != hipSuccess) { fprintf(stderr, "kernel_launch: hipFuncSetAttribute failed\n"); grid = -1; return; }
        if (hipOccupancyMaxActiveBlocksPerMultiprocessor(&per_cu, (const void*)mega_fwd, NTHREADS, LDS_BYTES) != hipSuccess || per_cu < 1) { fprintf(stderr, "kernel_launch: occupancy query says %d\n", per_cu); grid = -1; (void)hipGetLastError(); return; }
        grid = cus;
        if (grid != 256) { fprintf(stderr, "kernel_launch: built for 256 CUs (one 256x256 tile per workgroup in the fused norm epilogues), found %d\n", cus); grid = -1; return; }
    }
    if (grid < 0) return;
    MegaArgs a{};
    for (int i = 0; i < 41; ++i) a.in[i] = (const float*)d_in[i];
    a.out = (float*)d_out; a.ws = (unsigned char*)d_ws;
    hipMemsetAsync(d_ws, 0, 196608, stream);
    void* args[] = {&a};
    hipError_t e = hipLaunchCooperativeKernel((const void*)mega_fwd, dim3(grid), dim3(NTHREADS), args, LDS_BYTES, stream);
    if (e != hipSuccess) fprintf(stderr, "kernel_launch: cooperative launch failed: %s (grid %d)\n", hipGetErrorString(e), grid);
}
```

```cpp
#include <hip/hip_runtime.h>
#include <hip/hip_cooperative_groups.h>
#include <cstdint>
#include <cstdio>

constexpr int NB = 2, T_ = 8192, DM = 1024, M_ = NB * T_;
constexpr int FF = 2816, NGU = 2 * FF;
constexpr int IN_COLS = 3096, NWIN = 3328;
constexpr int NRW = 1792;
constexpr int NCP = 512;
constexpr int NLORA = 1536, KLORA = 256;
constexpr float NORM_EPS = 1e-6f;
constexpr float QSCALE = 0.125f * 1.4426950408889634f;
constexpr float MSCALE = 0.0625f * 1.4426950408889634f;

typedef unsigned short bf16;
typedef short bf16x8 __attribute__((ext_vector_type(8)));
typedef float f32x4 __attribute__((ext_vector_type(4)));
typedef unsigned u32x2 __attribute__((ext_vector_type(2)));
typedef unsigned u32x4 __attribute__((ext_vector_type(4)));

__device__ __forceinline__ unsigned f2bf(float f) { unsigned u = __builtin_bit_cast(unsigned, f); return (u + 0x7fffu + ((u >> 16) & 1u)) >> 16; }
__device__ __forceinline__ float bf2f(bf16 h) { return __builtin_bit_cast(float, (unsigned)h << 16); }
typedef float f32x2_t __attribute__((ext_vector_type(2))); typedef __bf16 bf16x2_t __attribute__((ext_vector_type(2)));
__device__ __forceinline__ unsigned pk2(float lo, float hi) { const f32x2_t v = {lo, hi}; return __builtin_bit_cast(unsigned, __builtin_convertvector(v, bf16x2_t)); }
__device__ __forceinline__ void st_bf4(bf16* p, f32x4 v) { u32x2 w; w.x = pk2(v[0], v[1]); w.y = pk2(v[2], v[3]); *(u32x2*)p = w; }
__device__ __forceinline__ float wave_sum(float v) {
#pragma unroll
    for (int o = 1; o < 64; o <<= 1) v += __shfl_xor(v, o);
    return v;
}
__device__ __forceinline__ float wave_max(float v) {
#pragma unroll
    for (int o = 1; o < 64; o <<= 1) v = fmaxf(v, __shfl_xor(v, o));
    return v;
}
__device__ __forceinline__ float sigmoidf_(float x) { return 1.f / (1.f + __expf(-x)); }
__device__ __forceinline__ int tidx() { int t = threadIdx.x; asm volatile("" : "+v"(t)); return t; }

constexpr size_t MiB = 1u << 20, KiB64 = 65536;
constexpr size_t WS_CTL = 0;
constexpr size_t WS_KC = 256 * 1024;
constexpr size_t WS_VCT = 512 * 1024;
constexpr size_t WS_CW2 = 768 * 1024;
constexpr size_t WS_W1GU = 1 * MiB;
constexpr size_t WS_W1D = 12 * MiB;
constexpr size_t WS_W2GU = WS_W1D + 88 * KiB64;
constexpr size_t WS_W2D = WS_W2GU + 11 * MiB;
constexpr size_t WS_WIN = WS_W2D + 88 * KiB64;
constexpr size_t WS_WOUT = WS_WIN + 104 * KiB64;
constexpr size_t WS_WQ = WS_WOUT + 2 * MiB, WS_WK = WS_WQ + 2 * MiB, WS_WV = WS_WK + 2 * MiB, WS_WO = WS_WV + 2 * MiB;
constexpr size_t WS_CW1K = WS_WO + 2 * MiB, WS_CW1V = WS_CW1K + 1 * MiB;
constexpr size_t WS_WLORA = WS_CW1V + 1 * MiB;
constexpr size_t WS_ROPE = WS_WLORA + 12 * KiB64;
constexpr size_t WS_CBIAS = WS_ROPE + 2 * MiB;
constexpr size_t WS_MEMN = WS_CBIAS + KiB64;
constexpr size_t WS_HIDK = WS_MEMN + 1 * MiB;
constexpr size_t WS_HIDV = WS_HIDK + 1 * MiB;
constexpr size_t WS_GATES = WS_HIDV + 1 * MiB;
constexpr size_t WS_XN = 60 * MiB;
constexpr size_t WS_YB = 92 * MiB;
constexpr size_t WS_D = 124 * MiB;
constexpr size_t WS_HB = WS_D;
constexpr size_t WS_QB = WS_D;
constexpr size_t WS_KS = WS_D + 16 * MiB;
constexpr size_t WS_KW = WS_D + 20 * MiB;
constexpr size_t WS_KCR = WS_D + 24 * MiB;
constexpr size_t WS_VCR = WS_D + 29 * MiB;
constexpr size_t WS_VST = WS_D + 34 * MiB;
constexpr size_t WS_VWT = WS_D + 38 * MiB;
constexpr size_t WS_RKVA = WS_D + 42 * MiB;
constexpr size_t WS_PRL = WS_D + 106 * MiB;
constexpr size_t WS_AGG = WS_D + 114 * MiB;
constexpr size_t WS_BONUS = WS_W1GU;
constexpr size_t WS_END = 256 * MiB;
constexpr size_t WS_QM = WS_D;
constexpr size_t WS_OM = WS_D + 32 * MiB;
constexpr size_t WS_MK = WS_D + 64 * MiB;
constexpr size_t WS_MVT = WS_D + 65 * MiB;
static_assert(WS_GATES + (size_t)M_ * 24 * 4 <= WS_XN, "ws map");
static_assert(WS_AGG + 16 * MiB <= WS_END, "ws map");

struct Params {
    const float* in[41];
    float* out;
    unsigned char* ws;
};
enum { I_X = 0, I_MEM, I_F1_PRE, I_F1_WG, I_F1_WU, I_F1_WD, I_F1_POST, I_MIX_PRE, I_WIN, I_PE_K, I_W1_K, I_W2_K, I_PE_V, I_W1_V, I_W2_V,
       I_NSA_G, I_MU, I_W0, I_W2, I_A0, I_A2, I_G2, I_KK, I_KA, I_RK, I_GNG, I_GNB, I_WOUT, I_MIX_POST, I_MEM_PRE, I_MEM_KVG, I_WQ, I_WK, I_WV,
       I_WO, I_MEM_POST, I_F2_PRE, I_F2_WG, I_F2_WU, I_F2_WD, I_F2_POST };

struct MapPlain { const float* W; int N; int pad; __device__ const float* col(int p) const { return W + p; } };
struct MapGU {
    const float* Wg; const float* Wu; int N; int pad;
    __device__ const float* col(int p) const {
        const int pn = p >> 8, q = p & 255, n = (q >> 4) & 1;
        const int hid = 128 * pn + 64 * (q >> 7) + 16 * ((q >> 5) & 3) + (q & 15);
        return Wg + (size_t)n * (size_t)(Wu - Wg) + hid;
    }
};
__host__ __device__ inline int rope_perm(int x) { return 16 * ((x >> 5) & 1) + (x & 15) + 32 * ((x >> 4) & 1); }
struct MapWin {
    const float* W; int N; int pad;
    __device__ const float* col(int p) const {
        int l;
        if (p < 512) l = (p & ~63) + rope_perm(p & 63);
        else if (p < 640) l = 768 + ((p - 512) & ~63) + rope_perm(p & 63);
        else if (p < 768) l = 1024 + ((p - 640) & ~63) + rope_perm(p & 63);
        else if (p < 896) l = 512 + (p - 768);
        else if (p < 1024) l = 640 + (p - 896);
        else if (p < 1152) l = 896 + (p - 1024);
        else if (p < 1280) l = 1152 + (p - 1152);
        else if (p < 2304) { const int q = p - 1280; l = 1304 + (((q >> 4) & 1) ? 512 : 0) + 16 * (q >> 5) + (q & 15); }
        else if (p < 3072) l = 1304 + (p - 1280);
        else if (p < 3096) l = 1280 + (p - 3072);
        else return nullptr;
        return W + l;
    }
};

#define FOR_VB(vb, n) for (int vb = (int)blockIdx.x * 2 + (T512 >> 8); vb < (n); vb += (int)gridDim.x * 2)

template <class Map> __device__ __forceinline__ void d_convert(bf16* WT, int Np, int K, Map map, int wg0 = 0) {
    if ((int)blockIdx.x < wg0) return;
    const int T512 = tidx(), tid = T512 & 255, nbx = Np / 64, nb = nbx * (K / 64), G = (int)gridDim.x - wg0;
    for (int vb0 = ((int)blockIdx.x - wg0) * 2 + (T512 >> 8); vb0 < nb; vb0 += G * 4) {
        const int vb1 = vb0 + G * 2; const bool two = vb1 < nb;
        const int p0 = (vb0 % nbx) * 64 + (tid & 63), k0 = (vb0 / nbx) * 64 + (tid >> 6) * 16;
        const int p1 = two ? (vb1 % nbx) * 64 + (tid & 63) : p0, k1 = two ? (vb1 / nbx) * 64 + (tid >> 6) * 16 : k0;
        const float* s0 = map.col(p0); const float* s1 = map.col(p1);
        float v[16], u[16];
#pragma unroll
        for (int i = 0; i < 16; ++i) { v[i] = s0 ? s0[(size_t)(k0 + i) * map.N] : 0.f; u[i] = s1 ? s1[(size_t)(k1 + i) * map.N] : 0.f; }
        u32x4 a, b;
        a.x = pk2(v[0], v[1]); a.y = pk2(v[2], v[3]); a.z = pk2(v[4], v[5]); a.w = pk2(v[6], v[7]);
        b.x = pk2(v[8], v[9]); b.y = pk2(v[10], v[11]); b.z = pk2(v[12], v[13]); b.w = pk2(v[14], v[15]);
        u32x4* d0 = (u32x4*)(WT + (size_t)p0 * K + k0); d0[0] = a; d0[1] = b;
        if (two) {
            a.x = pk2(u[0], u[1]); a.y = pk2(u[2], u[3]); a.z = pk2(u[4], u[5]); a.w = pk2(u[6], u[7]);
            b.x = pk2(u[8], u[9]); b.y = pk2(u[10], u[11]); b.z = pk2(u[12], u[13]); b.w = pk2(u[14], u[15]);
            u32x4* d1 = (u32x4*)(WT + (size_t)p1 * K + k1); d1[0] = a; d1[1] = b;
        }
    }
}
__device__ __forceinline__ void d_convert_lora(bf16* WT, const float* w2, const float* a2, const float* g2) {
    const int T512 = tidx(), tid = T512 & 255;
    FOR_VB(vb, NLORA * KLORA / 256) {
        const int idx = vb * 256 + tid, p = idx >> 8, k = idx & 255;
        float v = 0.f;
        if (p < 512) { if (k < 64) v = w2[k * 512 + p]; }
        else if (p < 1024) { if (k >= 64 && k < 128) v = a2[(k - 64) * 512 + (p - 512)]; }
        else { if (k >= 128) v = g2[(k - 128) * 512 + (p - 1024)]; }
        WT[idx] = (bf16)f2bf(v);
    }
}
__device__ __forceinline__ void d_rope_table(float* tab) {
    const int T512 = tidx(), tid = T512 & 255;
    FOR_VB(vb, T_ * 32 / 256) {
        const int idx = vb * 256 + tid, pos = idx >> 5, i = idx & 31;
        const float inv = (float)pow(10000.0, -(double)i / 32.0);
        const float ang = (float)pos * inv;
        tab[2 * idx] = (float)cos((double)ang); tab[2 * idx + 1] = (float)sin((double)ang);
    }
}
__device__ __forceinline__ void d_cmp_bias(const float* pe_k, const float* w1_k, const float* pe_v, const float* w1_v, float* part, float* red  ) {
    for (int job = blockIdx.x; job < 64; job += gridDim.x) {
        const int kv = job >> 5, cg_ = (job >> 3) & 3, jc = job & 7; const float* pe = kv ? pe_v : pe_k; const float* w1 = kv ? w1_v : w1_k;
        const int T512 = tidx(), lane = T512 & 63, w = T512 >> 6, n = cg_ * 64 + lane;
        float s = 0.f;
#pragma unroll 8
        for (int j = jc * 256 + w * 32; j < jc * 256 + w * 32 + 32; ++j) s += pe[j] * w1[(size_t)j * 256 + n];
        red[w * 64 + lane] = s; __syncthreads();
        if (w == 0) { float t = 0.f; for (int i = 0; i < 8; ++i) t += red[i * 64 + lane]; part[(jc * 2 + kv) * 256 + n] = t; }
        __syncthreads();
    }
}
__device__ __forceinline__ void d_rownorm(const float* x, const float* g, bf16* xn, int rows) {
    const int T512 = tidx(), tid = T512 & 255, lane = tid & 63;
    FOR_VB(vb, rows / 4) {
        const int row = vb * 4 + (tid >> 6);
        const f32x4* xr = (const f32x4*)(x + (size_t)row * DM) + lane; f32x4 v[4]; float s = 0.f;
#pragma unroll
        for (int j = 0; j < 4; ++j) { v[j] = xr[64 * j]; s += v[j][0] * v[j][0] + v[j][1] * v[j][1] + v[j][2] * v[j][2] + v[j][3] * v[j][3]; }
        const float rstd = rsqrtf(wave_sum(s) * (1.f / DM) + NORM_EPS);
#pragma unroll
        for (int j = 0; j < 4; ++j) { const f32x4 gg = ((const f32x4*)g)[lane + 64 * j]; st_bf4(xn + (size_t)row * DM + 4 * (lane + 64 * j), v[j] * rstd * gg); }
    }
}
__device__ __forceinline__ void d_rowpass(const float* xin, const bf16* y, const float* gpost, float coef, const float* gpre, float* xout, bf16* xn) {
    const int T512 = tidx(), tid = T512 & 255, lane = tid & 63;
    FOR_VB(vb, M_ / 4) {
        const int row = vb * 4 + (tid >> 6);
        f32x4 yv[4], xv[4]; float s = 0.f;
#pragma unroll
        for (int j = 0; j < 4; ++j) {
            const u32x2 w = *(const u32x2*)(y + (size_t)row * DM + 4 * (lane + 64 * j));
            yv[j][0] = __builtin_bit_cast(float, w.x << 16); yv[j][1] = __builtin_bit_cast(float, w.x & 0xffff0000u);
            yv[j][2] = __builtin_bit_cast(float, w.y << 16); yv[j][3] = __builtin_bit_cast(float, w.y & 0xffff0000u);
            s += yv[j][0] * yv[j][0] + yv[j][1] * yv[j][1] + yv[j][2] * yv[j][2] + yv[j][3] * yv[j][3];
            xv[j] = ((const f32x4*)(xin + (size_t)row * DM))[lane + 64 * j];
        }
        const float rstd = rsqrtf(wave_sum(s) * (1.f / DM) + NORM_EPS) * coef; float s2 = 0.f;
#pragma unroll
        for (int j = 0; j < 4; ++j) { const f32x4 gg = ((const f32x4*)gpost)[lane + 64 * j]; xv[j] = xv[j] + yv[j] * rstd * gg;
            s2 += xv[j][0] * xv[j][0] + xv[j][1] * xv[j][1] + xv[j][2] * xv[j][2] + xv[j][3] * xv[j][3];
            ((f32x4*)(xout + (size_t)row * DM))[lane + 64 * j] = xv[j]; }
        if (gpre) {
            const float r2 = rsqrtf(wave_sum(s2) * (1.f / DM) + NORM_EPS);
#pragma unroll
            for (int j = 0; j < 4; ++j) { const f32x4 gg = ((const f32x4*)gpre)[lane + 64 * j]; st_bf4(xn + (size_t)row * DM + 4 * (lane + 64 * j), xv[j] * r2 * gg); }
        }
    }
}
__device__ __forceinline__ void d_nsa_outnorm(bf16* amix, const float* g) {
    const int T512 = tidx(), tid = T512 & 255, lane = tid & 63;
    FOR_VB(vb, M_ / 4) {
        const int row = vb * 4 + (tid >> 6);
        bf16* p = amix + (size_t)row * DM + 8 * lane;
        const u32x4 w = *(const u32x4*)p; float v[8]; float s = 0.f;
        v[0] = __builtin_bit_cast(float, w.x << 16); v[1] = __builtin_bit_cast(float, w.x & 0xffff0000u);
        v[2] = __builtin_bit_cast(float, w.y << 16); v[3] = __builtin_bit_cast(float, w.y & 0xffff0000u);
        v[4] = __builtin_bit_cast(float, w.z << 16); v[5] = __builtin_bit_cast(float, w.z & 0xffff0000u);
        v[6] = __builtin_bit_cast(float, w.w << 16); v[7] = __builtin_bit_cast(float, w.w & 0xffff0000u);
#pragma unroll
        for (int i = 0; i < 8; ++i) s += v[i] * v[i];
        const float rstd = rsqrtf(wave_sum(s) * (1.f / 512.f) + NORM_EPS);
        u32x4 o; const float* gg = g + 8 * lane;
        o.x = pk2(v[0] * rstd * gg[0], v[1] * rstd * gg[1]); o.y = pk2(v[2] * rstd * gg[2], v[3] * rstd * gg[3]);
        o.z = pk2(v[4] * rstd * gg[4], v[5] * rstd * gg[5]); o.w = pk2(v[6] * rstd * gg[6], v[7] * rstd * gg[7]);
        *(u32x4*)p = o;
    }
}

struct EpiStore { bf16* O; int ldc; float scale;
    static constexpr int NCAT = 1;
    __device__ __forceinline__ int cat(int) const { return 0; }
    template <int C> __device__ __forceinline__ void apply(int row, int p, f32x4 v0, f32x4 v1) const { bf16* o = O + (size_t)row * ldc + p; st_bf4(o, v0 * scale); st_bf4(o + 16, v1 * scale); } };
struct EpiStoreF32 { float* O; int ldc;
    static constexpr int NCAT = 1;
    __device__ __forceinline__ int cat(int) const { return 0; }
    template <int C> __device__ __forceinline__ void apply(int row, int p, f32x4 v0, f32x4 v1) const { float* o = O + (size_t)row * ldc + p; *(f32x4*)o = v0; *(f32x4*)(o + 16) = v1; } };
struct EpiSwiGLU { bf16* H;
    static constexpr int NCAT = 1;
    __device__ __forceinline__ int cat(int) const { return 0; }
    template <int C> __device__ __forceinline__ void apply(int row, int p, f32x4 g, f32x4 u) const {
        const int q = p & 255, hid = 128 * (p >> 8) + 64 * (q >> 7) + 16 * ((q >> 5) & 3) + (q & 15);
        f32x4 h;
#pragma unroll
        for (int e = 0; e < 4; ++e) h[e] = g[e] / (1.f + __expf(-g[e])) * u[e];
        st_bf4(H + (size_t)row * FF + hid, h); } };
struct EpiBiasSilu { bf16* O; const float* bias;
    static constexpr int NCAT = 1;
    __device__ __forceinline__ int cat(int) const { return 0; }
    template <int C> __device__ __forceinline__ void apply(int row, int p, f32x4 v0, f32x4 v1) const {
        f32x4 a, b; f32x4 b0 = {0.f, 0.f, 0.f, 0.f}, b1 = {0.f, 0.f, 0.f, 0.f};
#pragma unroll
        for (int jc = 0; jc < 8; ++jc) { b0 += *(const f32x4*)(bias + jc * 512 + p); b1 += *(const f32x4*)(bias + jc * 512 + p + 16); }
#pragma unroll
        for (int e = 0; e < 4; ++e) { const float x0 = v0[e] + b0[e], x1 = v1[e] + b1[e]; a[e] = x0 / (1.f + __expf(-x0)); b[e] = x1 / (1.f + __expf(-x1)); }
        bf16* o = O + (size_t)row * 256 + p; st_bf4(o, a); st_bf4(o + 16, b); } };
struct EpiLora { float* wdec; bf16* aga; bf16* agg; const float* w0; const float* a0;
    static constexpr int NCAT = 3;
    __device__ __forceinline__ int cat(int p0) const { return p0 < 512 ? 0 : (p0 < 1024 ? 1 : 2); }
    template <int C> __device__ __forceinline__ void one(int row, int p, f32x4 v) const {
        if (C == 0) { f32x4 o; const f32x4 ww = *(const f32x4*)(w0 + p);
#pragma unroll
            for (int e = 0; e < 4; ++e) o[e] = __expf(-0.6065306597126334f * sigmoidf_(ww[e] + v[e]));
            *(f32x4*)(wdec + (size_t)row * 512 + p) = o;
        } else if (C == 1) { f32x4 o; const f32x4 aa = *(const f32x4*)(a0 + p - 512);
#pragma unroll
            for (int e = 0; e < 4; ++e) o[e] = sigmoidf_(aa[e] + v[e]);
            st_bf4(aga + (size_t)row * 512 + (p - 512), o);
        } else st_bf4(agg + (size_t)row * 512 + (p - 1024), v);
    }
    template <int C> __device__ __forceinline__ void apply(int row, int p, f32x4 v0, f32x4 v1) const { one<C>(row, p, v0); one<C>(row, p + 16, v1); } };
struct EpiWin {
    bf16 *qb, *ks, *kw, *kcr, *vcr, *vst, *vwt; unsigned* rk; bf16 *vv, *prl; float* gates; const float* rope;
    static constexpr int NCAT = 8;
    __device__ __forceinline__ int cat(int p0) const { return p0 < 512 ? 0 : (p0 < 768 ? 1 : (p0 < 1024 ? 2 : (p0 < 1280 ? 3 : (p0 < 2304 ? 4 : (p0 < 2816 ? 7 : (p0 < 3072 ? 6 : 5)))))); }
    template <int C> __device__ __forceinline__ void apply(int row, int p, f32x4 v0, f32x4 v1) const {
        const int b = row / T_, t = row % T_;
        if (C == 0 || C == 1) {
            const int x = p & 63, d = 16 * ((x >> 5) & 1) + (x & 15);
            const f32x4* rp = (const f32x4*)(rope + ((size_t)t * 32 + d) * 2); const f32x4 r0 = rp[0], r1 = rp[1];
            const f32x4 cs = {r0[0], r0[2], r1[0], r1[2]}, sn = {r0[1], r0[3], r1[1], r1[3]};
            const f32x4 lo = v0 * cs - v1 * sn, hi = v0 * sn + v1 * cs;
            if (C == 0) { bf16* o = qb + (size_t)row * 512 + (p & ~63) + d; st_bf4(o, lo * QSCALE); st_bf4(o + 32, hi * QSCALE); }
            else { const int g = ((p - 512) >> 6) & 1; bf16* base = (p < 640) ? ks : kw; bf16* o = base + ((size_t)(b * 2 + g) * T_ + t) * 64 + d; st_bf4(o, lo); st_bf4(o + 32, hi); }
        } else if (C == 2) {
            const int c = (p - 768) & 127, g = c >> 6, d = c & 63; bf16* base = (p < 896) ? kcr : vcr;
            bf16* o = base + ((size_t)(b * 2 + g) * T_ + t) * 64 + d; st_bf4(o, v0); st_bf4(o + 16, v1);
        } else if (C == 3) {
            const int c = (p - 1024) & 127, g = c >> 6, d = c & 63; bf16* base = (p < 1152) ? vst : vwt;
            bf16* o = base + ((size_t)(b * 2 + g) * 64 + d) * T_ + t;
#pragma unroll
            for (int e = 0; e < 4; ++e) { o[(size_t)e * T_] = (bf16)f2bf(v0[e]); o[(size_t)(16 + e) * T_] = (bf16)f2bf(v1[e]); }
        } else if (C == 4) {
            const int q = p - 1280, ch = 16 * (q >> 5) + (q & 15);
            u32x4 w; w.x = pk2(v0[0], v1[0]); w.y = pk2(v0[1], v1[1]); w.z = pk2(v0[2], v1[2]); w.w = pk2(v0[3], v1[3]);
            *(u32x4*)(rk + (size_t)row * 512 + ch) = w;
        } else if (C == 7) {
            bf16* o = vv + (size_t)row * 512 + (p - 2304); st_bf4(o, v0); st_bf4(o + 16, v1);
        } else if (C == 6) {
            bf16* o = prl + (size_t)row * 256 + (p - 2816); st_bf4(o, v0); st_bf4(o + 16, v1);
        } else {
            const int c = p - 3072; float* o = gates + (size_t)row * 24 + c;
            if (c < 24) { f32x4 s = {sigmoidf_(v0[0]), sigmoidf_(v0[1]), sigmoidf_(v0[2]), sigmoidf_(v0[3])}; *(f32x4*)o = s; }
            if (c + 16 < 24) { f32x4 s = {sigmoidf_(v1[0]), sigmoidf_(v1[1]), sigmoidf_(v1[2]), sigmoidf_(v1[3])}; *(f32x4*)(o + 16) = s; }
        }
    }
};

namespace pg8 {
#define PG8_LAS __attribute__((address_space(3)))
typedef unsigned short bf16_t;
typedef short bf16x8 __attribute__((ext_vector_type(8)));
typedef float f32x4 __attribute__((ext_vector_type(4)));
typedef unsigned u32x4 __attribute__((ext_vector_type(4)));
constexpr int BM = 256, BK = 64, HALF = 128, HTB = HALF * BK * 2  , STAGE_BYTES = 8 * HTB, NXCD = 8, WGM = 8;

__host__ __device__ __forceinline__ int lds_byte(int r, int c) { const int st = (r >> 4) * 2 + (c >> 5), rr = r & 15, cc = c & 31, ob = rr * 64 + cc * 2; return st * 1024 + (ob ^ (((ob >> 9) & 1) << 5)); }
__host__ __device__ __forceinline__ void stage_rc(int b, int& R, int& C) { const int st = b / 1024, sb = b % 1024, swz = sb ^ (((sb >> 9) & 1) << 5); R = (st >> 1) * 16 + swz / 64; C = (st & 1) * 32 + (swz % 64) / 2; }
__host__ __device__ __forceinline__ int perm32(int rho) { const int n = rho >> 4, i = rho & 15; return 8 * (i >> 2) + 4 * n + (i & 3); }

struct Unit { int pm, pn; };
struct Gemm { const bf16_t* A; const bf16_t* Bt; int M, N, K, lda, ldb; };

struct StaticOrder {
    int nM, nN, nwg, G, c;
    __host__ __device__ void init(int M, int N, int G_, int c_) { nM = M / BM; nN = N / BM; nwg = nM * nN; G = G_; c = c_; }
    __host__ __device__ bool next(int i, Unit& u) const {
        const long L = (long)i * G + c; if (L >= nwg) return false;
        int wgid = (int)L; { const int q = nwg / NXCD, r = nwg % NXCD, xcd = wgid % NXCD, off = wgid / NXCD; wgid = (xcd < r ? xcd * (q + 1) : r * (q + 1) + (xcd - r) * q) + off; }
        const int nig = WGM * nN, gid = wgid / nig, fm = gid * WGM, gsz = (nM - fm) < WGM ? (nM - fm) : WGM;
        u.pm = fm + ((wgid % nig) % gsz); u.pn = (wgid % nig) / gsz; return true;
    }
    __device__ __forceinline__ void a_ready(const Unit&) const {}
    __device__ __forceinline__ void done(const Unit&) const {}
};

template <class Epi, class Sched, bool ALIGN_EPI = false, bool SP2 = false>
__device__ __forceinline__ void gemm_phase(PG8_LAS unsigned char* lds, const Gemm g, const Sched& S, const Epi& E) {
    const int tid = tidx(), wid = __builtin_amdgcn_readfirstlane(tid >> 6), lane = tid & 63, wr = wid >> 2, wc = wid & 3, fr = lane & 15, fq = lane >> 4;
    const int K = g.K, nt = K / BK;
    unsigned voffA[2], voffB[2];
#pragma unroll
    for (int i = 0; i < 2; ++i) { int R, C; stage_rc(tid * 16 + i * 8192, R, C); const int Rb = Epi::PERM ? ((R & ~31) + perm32(R & 31)) : R;
        voffA[i] = (unsigned)(R * g.lda + C) * 2u; voffB[i] = (unsigned)(Rb * g.ldb + C) * 2u; }
    const size_t kstep = (size_t)(BK * 2);
    const size_t hstepA = (size_t)HALF * g.lda * 2, hstepB = (size_t)HALF * g.ldb * 2;
    const size_t tstepA = 2 * hstepA, tstepB = 2 * hstepB;
    const unsigned ldsw = (unsigned)wid * 1024u;
    const int aoff = lds_byte(wr * 64 + fr, fq * 8), boff = lds_byte(wc * 32 + fr, fq * 8);
#define PG8_SA(b, h) (((b) * 2 + (h)) * HTB)
#define PG8_SB(b, h) ((4 + (b) * 2 + (h)) * HTB)
#define PG8_STAGE(bufoff, gbase, voff) do { _Pragma("unroll") for (int _i = 0; _i < 2; ++_i) \
        __builtin_amdgcn_global_load_lds((const unsigned*)((const char*)(gbase) + (voff)[_i]), (PG8_LAS unsigned*)(lds + (bufoff) + ldsw + _i * 8192), 16, 0, 0); } while (0)
#define PG8_LDA(dst, b, h) do { _Pragma("unroll") for (int m = 0; m < 4; ++m) _Pragma("unroll") for (int k = 0; k < 2; ++k) dst[m][k] = *(const PG8_LAS bf16x8*)(lds + PG8_SA(b, h) + aoff + m * 2048 + k * 1024); } while (0)
#define PG8_LDB(dst, b, h) do { _Pragma("unroll") for (int n = 0; n < 2; ++n) _Pragma("unroll") for (int k = 0; k < 2; ++k) dst[n][k] = *(const PG8_LAS bf16x8*)(lds + PG8_SB(b, h) + boff + n * 2048 + k * 1024); } while (0)
#define PG8_MMA(ai, bj, At, Bt) do { __builtin_amdgcn_s_setprio(1); _Pragma("unroll") for (int m = 0; m < 4; ++m) _Pragma("unroll") for (int n = 0; n < 2; ++n) _Pragma("unroll") for (int k = 0; k < 2; ++k) \
        acc[ai][bj][m][n] = __builtin_amdgcn_mfma_f32_16x16x32_bf16(Bt[n][k], At[m][k], acc[ai][bj][m][n], 0, 0, 0); __builtin_amdgcn_s_setprio(0); } while (0)
#define PG8_WAIT_V(n) asm volatile("s_waitcnt vmcnt(" #n ")" ::: "memory")
#define PG8_WAIT_L(n) asm volatile("s_waitcnt lgkmcnt(" #n ")" ::: "memory")
#define PG8_BAR __builtin_amdgcn_s_barrier()
#define PG8_SCHED __builtin_amdgcn_sched_barrier(0)
    Unit cur, nxt; int ui = 0;
    if (!S.next(0, cur)) return;
    f32x4 acc[2][2][4][2];
#pragma unroll
    for (int a = 0; a < 2; ++a)
#pragma unroll
        for (int b = 0; b < 2; ++b)
#pragma unroll
            for (int m = 0; m < 4; ++m)
#pragma unroll
                for (int n = 0; n < 2; ++n) acc[a][b][m][n] = (f32x4){0.f, 0.f, 0.f, 0.f};
    bf16x8 At[4][2], B0[2][2], B1[2][2];
    const char* cA = (const char*)g.A + (size_t)cur.pm * tstepA; const char* cB = (const char*)g.Bt + (size_t)cur.pn * tstepB;
    S.a_ready(cur);
    if constexpr (SP2) {
        PG8_STAGE(PG8_SB(0, 0), cB, voffB); PG8_STAGE(PG8_SB(0, 1), cB + hstepB, voffB); PG8_STAGE(PG8_SA(0, 0), cA, voffA); PG8_STAGE(PG8_SA(0, 1), cA + hstepA, voffA);
        if (wr == 1) PG8_BAR;
        PG8_WAIT_V(2); PG8_BAR;
        PG8_STAGE(PG8_SB(1, 0), cB + kstep, voffB); PG8_STAGE(PG8_SA(1, 0), cA + kstep, voffA); PG8_STAGE(PG8_SB(1, 1), cB + hstepB + kstep, voffB);
        PG8_WAIT_V(6); PG8_BAR;
    } else {
        PG8_STAGE(PG8_SB(0, 0), cB, voffB); PG8_STAGE(PG8_SA(0, 0), cA, voffA); PG8_STAGE(PG8_SB(0, 1), cB + hstepB, voffB); PG8_STAGE(PG8_SA(0, 1), cA + hstepA, voffA);
        if (wr == 1) PG8_BAR;
        PG8_WAIT_V(4); PG8_BAR;
        PG8_STAGE(PG8_SB(1, 0), cB + kstep, voffB); PG8_STAGE(PG8_SA(1, 0), cA + kstep, voffA); PG8_STAGE(PG8_SB(1, 1), cB + hstepB + kstep, voffB);
        PG8_WAIT_V(6); PG8_BAR;
    }
    for (;;) {
        const bool has_next = S.next(ui + 1, nxt);
        const char* nA = has_next ? (const char*)g.A + (size_t)nxt.pm * tstepA : cA; const char* nB = has_next ? (const char*)g.Bt + (size_t)nxt.pn * tstepB : cB;
        for (int t = 0; t < nt; t += 2) {
            const bool last = (t == nt - 2);
            const char* a1 = cA + (size_t)(t + 1) * kstep;
            const char* a2 = last ? nA : cA + (size_t)(t + 2) * kstep; const char* b2 = last ? nB : cB + (size_t)(t + 2) * kstep;
            const char* a3 = a2 + kstep; const char* b3 = b2 + kstep;
            if (last && has_next) S.a_ready(nxt);
            if constexpr (SP2) {
            PG8_LDB(B0, 0, 0); PG8_LDB(B1, 0, 1); PG8_SCHED; PG8_LDA(At, 0, 0); PG8_STAGE(PG8_SA(1, 1), a1 + hstepA, voffA);
            PG8_WAIT_V(8); PG8_WAIT_L(0); PG8_BAR; PG8_MMA(0, 0, At, B0); PG8_MMA(0, 1, At, B1); PG8_BAR; PG8_SCHED;
            PG8_LDA(At, 0, 1); PG8_STAGE(PG8_SB(0, 0), b2, voffB); PG8_STAGE(PG8_SB(0, 1), b2 + hstepB, voffB); PG8_STAGE(PG8_SA(0, 0), a2, voffA);
            PG8_WAIT_V(8); PG8_WAIT_L(0); PG8_BAR; PG8_MMA(1, 0, At, B0); PG8_MMA(1, 1, At, B1); PG8_BAR; PG8_SCHED;
            PG8_LDB(B0, 1, 0); PG8_LDB(B1, 1, 1); PG8_SCHED; PG8_LDA(At, 1, 0); PG8_STAGE(PG8_SA(0, 1), a2 + hstepA, voffA);
            PG8_WAIT_V(8); PG8_WAIT_L(0); PG8_BAR; PG8_MMA(0, 0, At, B0); PG8_MMA(0, 1, At, B1); PG8_BAR; PG8_SCHED;
            PG8_LDA(At, 1, 1); PG8_STAGE(PG8_SB(1, 0), b3, voffB); PG8_STAGE(PG8_SB(1, 1), b3 + hstepB, voffB); PG8_STAGE(PG8_SA(1, 0), a3, voffA);
            PG8_WAIT_V(8); PG8_WAIT_L(0); PG8_BAR; PG8_MMA(1, 0, At, B0); PG8_MMA(1, 1, At, B1); PG8_BAR; PG8_SCHED;
            } else {
            PG8_LDB(B0, 0, 0); PG8_SCHED; PG8_LDA(At, 0, 0); PG8_STAGE(PG8_SA(1, 1), a1 + hstepA, voffA);
            PG8_WAIT_L(8); PG8_BAR; PG8_WAIT_L(0); PG8_MMA(0, 0, At, B0); PG8_BAR; PG8_SCHED;
            PG8_LDB(B1, 0, 1); PG8_STAGE(PG8_SB(0, 0), b2, voffB);
            PG8_BAR; PG8_WAIT_L(0); PG8_MMA(0, 1, At, B1); PG8_BAR;
            PG8_LDA(At, 0, 1); PG8_STAGE(PG8_SA(0, 0), a2, voffA);
            PG8_BAR; PG8_WAIT_L(0); PG8_MMA(1, 0, At, B0); PG8_BAR; PG8_SCHED;
            PG8_STAGE(PG8_SB(0, 1), b2 + hstepB, voffB);
            PG8_WAIT_V(6); PG8_BAR; PG8_MMA(1, 1, At, B1); PG8_BAR;
            PG8_LDB(B0, 1, 0); PG8_SCHED; PG8_LDA(At, 1, 0); PG8_STAGE(PG8_SA(0, 1), a2 + hstepA, voffA);
            PG8_WAIT_L(8); PG8_BAR; PG8_WAIT_L(0); PG8_MMA(0, 0, At, B0); PG8_BAR; PG8_SCHED;
            PG8_LDB(B1, 1, 1); PG8_STAGE(PG8_SB(1, 0), b3, voffB);
            PG8_BAR; PG8_WAIT_L(0); PG8_MMA(0, 1, At, B1); PG8_BAR;
            PG8_LDA(At, 1, 1); PG8_STAGE(PG8_SA(1, 0), a3, voffA);
            PG8_BAR; PG8_WAIT_L(0); PG8_MMA(1, 0, At, B0); PG8_BAR; PG8_SCHED;
            PG8_STAGE(PG8_SB(1, 1), b3 + hstepB, voffB);
            PG8_WAIT_V(6); PG8_BAR; PG8_MMA(1, 1, At, B1); PG8_BAR;
            }
        }
        if constexpr (ALIGN_EPI) { if (wr == 0) PG8_BAR; }
        if constexpr (!Epi::AFTER_DRAIN) { E(acc, cur, wr, wc, fr, fq); S.done(cur); }
        if (!has_next) break;
#pragma unroll
        for (int a = 0; a < 2; ++a)
#pragma unroll
            for (int b = 0; b < 2; ++b)
#pragma unroll
                for (int m = 0; m < 4; ++m)
#pragma unroll
                    for (int n = 0; n < 2; ++n) acc[a][b][m][n] = (f32x4){0.f, 0.f, 0.f, 0.f};
        cur = nxt; cA = nA; cB = nB; ++ui;
        if constexpr (ALIGN_EPI) { if (wr == 1) PG8_BAR; }
    }
    PG8_WAIT_V(0);
    if constexpr (!ALIGN_EPI) { if (wr == 0) PG8_BAR; }
    PG8_BAR;
    if constexpr (Epi::AFTER_DRAIN) { E.fused(acc, cur, wr, wc, fr, fq, lds, wid, lane); S.done(cur); }
#undef PG8_SA
#undef PG8_SB
#undef PG8_STAGE
#undef PG8_LDA
#undef PG8_LDB
#undef PG8_MMA
#undef PG8_WAIT_V
#undef PG8_WAIT_L
#undef PG8_BAR
#undef PG8_SCHED
}
}

template <class F> struct EpiQuad {
    static constexpr bool PERM = false, AFTER_DRAIN = false;
    F f;
    template <int C, int BJ> __device__ __forceinline__ void half(const pg8::f32x4 (&acc)[2][2][4][2], int row0, int p) const {
#pragma unroll
        for (int ai = 0; ai < 2; ++ai)
#pragma unroll
            for (int m = 0; m < 4; ++m) { f.template apply<C>(row0 + ai * 128 + m * 16, p, acc[ai][BJ][m][0], acc[ai][BJ][m][1]); asm volatile("" ::: "memory"); }
    }
    template <int BJ> __device__ __forceinline__ void disp(const pg8::f32x4 (&acc)[2][2][4][2], int row0, int p0, int p) const {
        const int c = f.cat(p0);
        if (F::NCAT == 1 || c == 0) half<0, BJ>(acc, row0, p);
        else if (F::NCAT > 1 && c == 1) half<(F::NCAT > 1 ? 1 : 0), BJ>(acc, row0, p);
        else if (F::NCAT > 2 && c == 2) half<(F::NCAT > 2 ? 2 : 0), BJ>(acc, row0, p);
        else if (F::NCAT > 3 && c == 3) half<(F::NCAT > 3 ? 3 : 0), BJ>(acc, row0, p);
        else if (F::NCAT > 4 && c == 4) half<(F::NCAT > 4 ? 4 : 0), BJ>(acc, row0, p);
        else if (F::NCAT > 5 && c == 5) half<(F::NCAT > 5 ? 5 : 0), BJ>(acc, row0, p);
        else if (F::NCAT > 6 && c == 6) half<(F::NCAT > 6 ? 6 : 0), BJ>(acc, row0, p);
        else if (F::NCAT > 7) half<(F::NCAT > 7 ? 7 : 0), BJ>(acc, row0, p);
    }
    __device__ __forceinline__ void operator()(const pg8::f32x4 (&acc)[2][2][4][2], const pg8::Unit& u, int wr, int wc, int fr, int fq) const {
        const int row0 = u.pm * 256 + wr * 64 + fr, p0 = u.pn * 256;
        disp<0>(acc, row0, p0, p0 + wc * 32 + 4 * fq);
        disp<1>(acc, row0, p0 + 128, p0 + 128 + wc * 32 + 4 * fq);
    }
};
template <class F> __device__ __forceinline__ void gemm_pg8(unsigned char* lds, const bf16* A, int lda, const bf16* Bt, int ldb, int M, int N, int K, const F& f, int wg_off = 0) {
    if ((int)blockIdx.x < wg_off) return;
    pg8::Gemm g{A, Bt, M, N, K, lda, ldb}; pg8::StaticOrder S; S.init(M, N, (int)gridDim.x, (int)blockIdx.x - wg_off);
    EpiQuad<F> E{f};
    pg8::gemm_phase<EpiQuad<F>, pg8::StaticOrder, true, true>((PG8_LAS unsigned char*)lds, g, S, E);
}

namespace cg = cooperative_groups;
template <bool XIN16, bool XOUT16> struct EpiNormRes {
    static constexpr bool PERM = false, AFTER_DRAIN = true;
    const void* xin; void* xout; bf16* xn; const float* gpost; const float* gpre; float coef; unsigned* part; unsigned* cnt;
    __device__ __forceinline__ void operator()(const pg8::f32x4 (&)[2][2][4][2], const pg8::Unit&, int, int, int, int) const {}
    __device__ __forceinline__ void rowstat(const pg8::f32x4 (&acc)[2][2][4][2], float* P, int wr, int wc, int fr, int fq) const {
#pragma unroll
        for (int ai = 0; ai < 2; ++ai)
#pragma unroll
            for (int m = 0; m < 4; ++m) { float sq = 0.f;
#pragma unroll
                for (int bj = 0; bj < 2; ++bj)
#pragma unroll
                    for (int n = 0; n < 2; ++n) { const pg8::f32x4 v = acc[ai][bj][m][n]; sq += (v[0] * v[0] + v[1] * v[1]) + (v[2] * v[2] + v[3] * v[3]); }
                sq += __shfl_xor(sq, 16); sq += __shfl_xor(sq, 32);
                if (fq == 0) P[(ai * 128 + wr * 64 + m * 16 + fr) * 4 + wc] = sq; }
    }
    __device__ __forceinline__ void exchange(float* P, float* S, unsigned* bank, unsigned* cnt_, const pg8::Unit& u, int tid, float scale) const {
        __syncthreads();
        if (tid < 256) { const f32x4 p = *(const f32x4*)(P + tid * 4);
            __hip_atomic_store(bank + (size_t)(u.pm * 256 + tid) * 4 + u.pn, __builtin_bit_cast(unsigned, (p[0] + p[1]) + (p[2] + p[3])), __ATOMIC_RELAXED, __HIP_MEMORY_SCOPE_AGENT); }
        asm volatile("s_waitcnt vmcnt(0)" ::: "memory");
        __syncthreads();
        if (tid == 0) { unsigned* c = cnt_ + u.pm * 16; __hip_atomic_fetch_add(c, 1u, __ATOMIC_RELAXED, __HIP_MEMORY_SCOPE_AGENT);
            while (__hip_atomic_load(c, __ATOMIC_RELAXED, __HIP_MEMORY_SCOPE_AGENT) < 4u) __builtin_amdgcn_s_sleep(1); }
        __syncthreads();
        if (tid < 256) { const unsigned* b = bank + (size_t)(u.pm * 256 + tid) * 4; float q = 0.f;
#pragma unroll
            for (int j = 0; j < 4; ++j) q += __builtin_bit_cast(float, __hip_atomic_load(b + j, __ATOMIC_RELAXED, __HIP_MEMORY_SCOPE_AGENT));
            S[tid] = rsqrtf(q * (1.f / DM) + NORM_EPS) * scale; }
        __syncthreads();
    }
    __device__ __forceinline__ void fused(pg8::f32x4 (&acc)[2][2][4][2], const pg8::Unit& u, int wr, int wc, int fr, int fq, PG8_LAS unsigned char* lds, int wid, int lane) const {
        float* P = (float*)lds; float* S = P + 1024; const int tid = wid * 64 + lane;
        rowstat(acc, P, wr, wc, fr, fq);
        exchange(P, S, part, cnt, u, tid, coef);
        const int col0 = u.pn * 256 + wc * 32 + 4 * fq;
#pragma unroll
        for (int ai = 0; ai < 2; ++ai)
#pragma unroll
            for (int m = 0; m < 4; ++m) { const int r = ai * 128 + wr * 64 + m * 16 + fr; const float sr = S[r]; const size_t off = (size_t)(u.pm * 256 + r) * DM + col0;
#pragma unroll
                for (int bj = 0; bj < 2; ++bj)
#pragma unroll
                    for (int n = 0; n < 2; ++n) { const int o = bj * 128 + n * 16; const f32x4 g4 = *(const f32x4*)(gpost + col0 + o);
                        f32x4 x4;
                        if (XIN16) { const u32x2 w = *(const u32x2*)((const bf16*)xin + off + o);
                            x4 = (f32x4){__builtin_bit_cast(float, w.x << 16), __builtin_bit_cast(float, w.x & 0xffff0000u), __builtin_bit_cast(float, w.y << 16), __builtin_bit_cast(float, w.y & 0xffff0000u)}; }
                        else x4 = *(const f32x4*)((const float*)xin + off + o);
                        const f32x4 y = x4 + acc[ai][bj][m][n] * sr * g4; acc[ai][bj][m][n] = y;
                        if (XOUT16) st_bf4((bf16*)xout + off + o, y); else *(f32x4*)((float*)xout + off + o) = y; }
                asm volatile("" ::: "memory"); }
        if (!gpre) return;
        rowstat(acc, P, wr, wc, fr, fq);
        exchange(P, S, part + (size_t)M_ * 4, cnt + 64 * 16, u, tid, 1.f);
#pragma unroll
        for (int ai = 0; ai < 2; ++ai)
#pragma unroll
            for (int m = 0; m < 4; ++m) { const int r = ai * 128 + wr * 64 + m * 16 + fr; const float sr = S[r]; const size_t off = (size_t)(u.pm * 256 + r) * DM + col0;
#pragma unroll
                for (int bj = 0; bj < 2; ++bj)
#pragma unroll
                    for (int n = 0; n < 2; ++n) { const int o = bj * 128 + n * 16; const f32x4 g4 = *(const f32x4*)(gpre + col0 + o); st_bf4(xn + off + o, acc[ai][bj][m][n] * sr * g4); }
                asm volatile("" ::: "memory"); }
    }
};
template <bool XIN16, bool XOUT16>
__device__ __forceinline__ void gemm_norm_res(unsigned char* lds, const bf16* A, int lda, const bf16* Bt, int K, const void* xin, void* xout, bf16* xn, const float* gpost, const float* gpre,
                                              float coef, unsigned* part, unsigned* cnt) {
    pg8::Gemm g{A, Bt, M_, DM, K, lda, K}; pg8::StaticOrder S; S.init(M_, DM, 256, (int)blockIdx.x);
    const EpiNormRes<XIN16, XOUT16> E{xin, xout, xn, gpost, gpre, coef, part, cnt};
    pg8::gemm_phase<EpiNormRes<XIN16, XOUT16>, pg8::StaticOrder, false, true>((PG8_LAS unsigned char*)lds, g, S, E);
}

__device__ __forceinline__ void d_gates(const bf16* xn, const bf16* wg  , float* gates, float* red  ) {
    const int T512 = tidx(), lane = T512 & 63, fr = lane & 15, fq = lane >> 4, w = T512 >> 6, kh = w & 1;
    for (int rt0 = blockIdx.x * 4; rt0 < M_ / 16; rt0 += gridDim.x * 4) {
        const int rt = rt0 + (w >> 1);
        const bf16* ap = xn + (size_t)(rt * 16 + fr) * DM + 8 * fq + kh * 512; const bf16* bp = wg + (size_t)fr * DM + 8 * fq + kh * 512;
        f32x4 c0 = {0.f, 0.f, 0.f, 0.f}, c1 = {0.f, 0.f, 0.f, 0.f};
#pragma unroll 8
        for (int k0 = 0; k0 < 512; k0 += 32) { const bf16x8 a = *(const bf16x8*)(ap + k0);
            c0 = __builtin_amdgcn_mfma_f32_16x16x32_bf16(*(const bf16x8*)(bp + k0), a, c0, 0, 0, 0);
            c1 = __builtin_amdgcn_mfma_f32_16x16x32_bf16(*(const bf16x8*)(bp + (size_t)16 * DM + k0), a, c1, 0, 0, 0); }
        float* r = red + ((w >> 1) * 64 + lane) * 8;
        if (kh) { *(f32x4*)r = c0; *(f32x4*)(r + 4) = c1; }
        __syncthreads();
        if (!kh) { c0 += *(const f32x4*)r; c1 += *(const f32x4*)(r + 4);
            float* o = gates + (size_t)(rt * 16 + fr) * 24 + 4 * fq;
            *(f32x4*)o = (f32x4){sigmoidf_(c0[0]), sigmoidf_(c0[1]), sigmoidf_(c0[2]), sigmoidf_(c0[3])};
            if (fq < 2) *(f32x4*)(o + 16) = (f32x4){sigmoidf_(c1[0]), sigmoidf_(c1[1]), sigmoidf_(c1[2]), sigmoidf_(c1[3])}; }
        __syncthreads();
    }
}

__device__ __forceinline__ void d_cmp2(const float* part  , const float* bias  , const bf16* w2t, const float* rope, bf16* kc, bf16* vct, int wg0 = 0) {
    if ((int)blockIdx.x < wg0) return;
    const int T512 = tidx(), lane = T512 & 63, fr = lane & 15, fq = lane >> 4;
    for (int task = ((int)blockIdx.x - wg0) * 8 + (T512 >> 6); task < 256; task += ((int)gridDim.x - wg0) * 8) {
        const int kv = task >> 7, R0 = (task & 127) * 16;
        const float* p0 = part + ((size_t)(kv * 2) * 2048 + R0 + fr) * 256 + 8 * fq; const float* p1 = p0 + (size_t)2048 * 256;
        const float* bb = bias + kv * 256 + 8 * fq;
        const bf16* bp = w2t + (size_t)kv * 64 * 256 + (size_t)fr * 256 + 8 * fq;
        f32x4 acc[4];
#pragma unroll
        for (int nt = 0; nt < 4; ++nt) acc[nt] = (f32x4){0.f, 0.f, 0.f, 0.f};
#pragma unroll
        for (int k0 = 0; k0 < 256; k0 += 32) {
            f32x4 xa = *(const f32x4*)(p0 + k0) + *(const f32x4*)(p1 + k0) + *(const f32x4*)(bb + k0);
            f32x4 xb = *(const f32x4*)(p0 + k0 + 4) + *(const f32x4*)(p1 + k0 + 4) + *(const f32x4*)(bb + k0 + 4);
#pragma unroll
            for (int e = 0; e < 4; ++e) { xa[e] = xa[e] / (1.f + __expf(-xa[e])); xb[e] = xb[e] / (1.f + __expf(-xb[e])); }
            const bf16x8 a = __builtin_bit_cast(bf16x8, (u32x4){pk2(xa[0], xa[1]), pk2(xa[2], xa[3]), pk2(xb[0], xb[1]), pk2(xb[2], xb[3])});
#pragma unroll
            for (int nt = 0; nt < 4; ++nt) acc[nt] = __builtin_amdgcn_mfma_f32_16x16x32_bf16(*(const bf16x8*)(bp + (size_t)nt * 16 * 256 + k0), a, acc[nt], 0, 0, 0);
        }
        const int R = R0 + fr, bg = R >> 9, c = R & 511;
        if (kv == 0) {
            const int pos = (16 * c + 31) & (T_ - 1);
#pragma unroll
            for (int h2 = 0; h2 < 2; ++h2) {
                const int d = 16 * h2 + 4 * fq; const f32x4* rp = (const f32x4*)(rope + ((size_t)pos * 32 + d) * 2); const f32x4 r0 = rp[0], r1 = rp[1];
                const f32x4 cs = {r0[0], r0[2], r1[0], r1[2]}, sn = {r0[1], r0[3], r1[1], r1[3]};
                const f32x4 lo = acc[h2] * cs - acc[h2 + 2] * sn, hi = acc[h2] * sn + acc[h2 + 2] * cs;
                st_bf4(kc + (size_t)R * 64 + d, lo); st_bf4(kc + (size_t)R * 64 + d + 32, hi);
            }
        } else {
#pragma unroll
            for (int nt = 0; nt < 4; ++nt)
#pragma unroll
                for (int e = 0; e < 4; ++e) vct[((size_t)bg * 64 + 16 * nt + 4 * fq + e) * NCP + c] = (bf16)f2bf(acc[nt][e]);
        }
    }
}

struct NsaArgs { const bf16 *qb, *kc, *vct, *ks, *vst, *kw, *vwt; const float* gates; bf16* amix; };
__device__ __forceinline__ float dot64(const float* q, const bf16* k) {
    float s = 0.f;
#pragma unroll
    for (int i = 0; i < 8; ++i) { const u32x4 w = ((const u32x4*)k)[i];
        s += q[8 * i + 0] * __builtin_bit_cast(float, w.x << 16) + q[8 * i + 1] * __builtin_bit_cast(float, w.x & 0xffff0000u)
           + q[8 * i + 2] * __builtin_bit_cast(float, w.y << 16) + q[8 * i + 3] * __builtin_bit_cast(float, w.y & 0xffff0000u)
           + q[8 * i + 4] * __builtin_bit_cast(float, w.z << 16) + q[8 * i + 5] * __builtin_bit_cast(float, w.z & 0xffff0000u)
           + q[8 * i + 6] * __builtin_bit_cast(float, w.w << 16) + q[8 * i + 7] * __builtin_bit_cast(float, w.w & 0xffff0000u); }
    return s;
}
__device__ __forceinline__ void softmax_row(float* s, int n, int lane) {
    float m = -INFINITY; for (int i = lane; i < n; i += 64) m = fmaxf(m, s[i]);
    m = wave_max(m); if (m == -INFINITY) m = 0.f;
    float l = 0.f; for (int i = lane; i < n; i += 64) { const float e = exp2f(s[i] - m); s[i] = e; l += e; }
    l = wave_sum(l); const float inv = 1.f / fmaxf(l, 1e-30f);
    for (int i = lane; i < n; i += 64) s[i] *= inv;
}
__device__ __forceinline__ void d_nsa_simple(const NsaArgs& a, int vb, int tid, unsigned char* smem) {
    float (*qs)[64] = (float (*)[64])smem; float (*sc)[1024] = (float (*)[1024])(smem + 1024); float* imp = (float*)(smem + 17408); float* score = imp + 128;
    int* list = (int*)(score + 128); int* nlist = list + 16;
    const int bg = vb / T_, t = vb % T_, b = bg >> 1, g = bg & 1;
    const int r = tid >> 6, d = tid & 63, lane = d;
    const size_t row = (size_t)b * T_ + t;
    qs[r][d] = bf2f(a.qb[row * 512 + g * 256 + r * 64 + d]);
    if (tid == 0) *nlist = 0;
    __syncthreads();
    const int nv = t < 31 ? 0 : (t - 31) / 16 + 1;
    for (int c = tid; c < nv; c += 256) { const bf16* k = a.kc + ((size_t)bg * NCP + c) * 64;
        _Pragma("unroll 1") for (int rr = 0; rr < 4; ++rr) sc[rr][c] = dot64(qs[rr], k); }
    __syncthreads();
    softmax_row(sc[r], nv, lane);
    __syncthreads();
    float oc = 0.f; { const bf16* v = a.vct + ((size_t)bg * 64 + d) * NCP; for (int c = 0; c < nv; ++c) oc += sc[r][c] * bf2f(v[c]); }
    if (tid < 128) { const int s = tid; float acc = 0.f;
        for (int c = 4 * s - 1; c <= 4 * s + 3; ++c) if (c >= 0 && c < nv) acc += sc[0][c] + sc[1][c] + sc[2][c] + sc[3][c];
        imp[s] = acc; }
    __syncthreads();
    const int cur = t >> 6;
    if (tid < 128) { const int s = tid; const bool forced = (s == 0) || (s == cur) || (s == cur - 1);
        score[s] = forced ? 1e4f : (s <= cur ? imp[s] : -1e4f); }
    __syncthreads();
    if (tid < 128) { const int s = tid; const float my = score[s]; int rank = 0;
        for (int j = 0; j < 128; ++j) { const float o = score[j]; rank += (o > my || (o == my && j < s)) ? 1 : 0; }
        if (rank < 16 && s <= cur) { const int slot = atomicAdd(nlist, 1); list[slot] = s; } }
    __syncthreads();
    const int ns = *nlist * 64;
    for (int i = tid; i < ns; i += 256) { const int pos = list[i >> 6] * 64 + (i & 63);
        if (pos <= t) { const bf16* k = a.ks + ((size_t)bg * T_ + pos) * 64; _Pragma("unroll 1") for (int rr = 0; rr < 4; ++rr) sc[rr][i] = dot64(qs[rr], k); }
        else { sc[0][i] = -INFINITY; sc[1][i] = -INFINITY; sc[2][i] = -INFINITY; sc[3][i] = -INFINITY; } }
    __syncthreads();
    softmax_row(sc[r], ns, lane);
    __syncthreads();
    float os = 0.f; { const bf16* v = a.vst + ((size_t)bg * 64 + d) * T_;
        for (int i = 0; i < ns; ++i) { const int pos = list[i >> 6] * 64 + (i & 63); if (pos <= t) os += sc[r][i] * bf2f(v[pos]); } }
    __syncthreads();
    const int lo = t - 511 > 0 ? t - 511 : 0, nw = t - lo + 1;
    for (int i = tid; i < nw; i += 256) { const bf16* k = a.kw + ((size_t)bg * T_ + lo + i) * 64;
        _Pragma("unroll 1") for (int rr = 0; rr < 4; ++rr) sc[rr][i] = dot64(qs[rr], k); }
    __syncthreads();
    softmax_row(sc[r], nw, lane);
    __syncthreads();
    float ow = 0.f; { const bf16* v = a.vwt + ((size_t)bg * 64 + d) * T_ + lo; for (int i = 0; i < nw; ++i) ow += sc[r][i] * bf2f(v[i]); }
    const float* gt = a.gates + row * 24 + g * 12 + r * 3;
    a.amix[row * DM + g * 256 + r * 64 + d] = (bf16)f2bf(gt[0] * oc + gt[1] * os + gt[2] * ow);
    __syncthreads();
}


namespace nsa {
typedef float f32x16 __attribute__((ext_vector_type(16)));
constexpr int KROW = 144, VROW = 136, KBUF = 64 * KROW, VBUF = 64 * VROW;
constexpr int GRP = 2 * KBUF + 2 * VBUF;
constexpr int OFF_K = 0, OFF_V = 2 * KBUF, OFF_IMP = OFF_V + 2 * VBUF, IMPW = 130, OFF_SEL = OFF_IMP + GRP, OFF_UM = OFF_SEL + 1024, OFF_WS = OFF_UM + 16, OFF_UNIT = OFF_WS + 1024, OFF_ACC = OFF_UNIT + 16, LDS_NEED = OFF_ACC + 8 * 8192;
static_assert(LDS_NEED <= 147456 - 64 && OFF_ACC % 16 == 0, "nsa lds");
static_assert(OFF_IMP % 16 == 0 && OFF_SEL % 16 == 0 && OFF_WS % 16 == 0 && OFF_IMP == GRP && 64 * IMPW * 4 <= GRP, "nsa lds map");
__device__ __forceinline__ int crow(int r, int hi) { return (r & 3) + 8 * (r >> 2) + 4 * hi; }
__device__ __forceinline__ int next_bit(unsigned m0, unsigned m1, unsigned m2, unsigned m3, int from) {
#pragma unroll
    for (int wd = 0; wd < 4; ++wd) {
        unsigned x = wd == 0 ? m0 : (wd == 1 ? m1 : (wd == 2 ? m2 : m3)); const int base = wd * 32;
        if (from < base + 32) { if (from > base) x &= (~0u) << (from - base); if (x) return base + __builtin_ctz(x); }
    }
    return 128;
}
__device__ __forceinline__ bf16x8 pack8(const f32x16& p, int b0) {
    u32x4 w; w.x = pk2(p[b0 + 0], p[b0 + 1]); w.y = pk2(p[b0 + 2], p[b0 + 3]); w.z = pk2(p[b0 + 4], p[b0 + 5]); w.w = pk2(p[b0 + 6], p[b0 + 7]);
    return __builtin_bit_cast(bf16x8, w);
}
struct Branch { const bf16* k; const bf16* vt; int ldv; };

constexpr float THR = 8.f;
template <int MODE, bool SEL>
__device__ __forceinline__ void compute_tile(unsigned char* sm, int pg, int cb, int j, const bf16x8 (&qf)[4], int lo, int hi_b, int lo_max, int hi_min, unsigned s0, unsigned s1, unsigned s2, unsigned s3,
                                             float& m, float& l, float invl, bool& initd, f32x16& negm, f32x16 (&o)[2], float* imp_row, float* wsc, int i, int hi) {
        const unsigned char* kb = sm + OFF_K + pg + cb * KBUF; const unsigned char* vb = sm + OFF_V + pg + cb * VBUF;
        const int key0 = 64 * j;
        bool rowsel = true;
        if (SEL) { const unsigned wsel = j < 32 ? s0 : (j < 64 ? s1 : (j < 96 ? s2 : s3)); rowsel = (wsel >> (j & 31)) & 1u; }
        if (!SEL || __any(rowsel)) {
            f32x16 p0, p1;
            {
                f32x16 c0;
                if (SEL) {
#pragma unroll
                    for (int r = 0; r < 16; ++r) c0[r] = rowsel ? negm[r] : -INFINITY;
                } else c0 = negm;
                bf16x8 ka[8];
#pragma unroll
                for (int d0 = 0; d0 < 4; ++d0) { ka[2 * d0] = *(const bf16x8*)(kb + i * KROW + (16 * d0 + 8 * hi) * 2); ka[2 * d0 + 1] = *(const bf16x8*)(kb + (32 + i) * KROW + (16 * d0 + 8 * hi) * 2); }
                __builtin_amdgcn_sched_barrier(0);
                p0 = __builtin_amdgcn_mfma_f32_32x32x16_bf16(ka[0], qf[0], c0, 0, 0, 0);
                p1 = __builtin_amdgcn_mfma_f32_32x32x16_bf16(ka[1], qf[0], c0, 0, 0, 0);
#pragma unroll
                for (int d0 = 1; d0 < 4; ++d0) {
                    p0 = __builtin_amdgcn_mfma_f32_32x32x16_bf16(ka[2 * d0], qf[d0], p0, 0, 0, 0);
                    p1 = __builtin_amdgcn_mfma_f32_32x32x16_bf16(ka[2 * d0 + 1], qf[d0], p1, 0, 0, 0);
                }
            }
            bf16x8 vfr[8];
            if (MODE != 0) {
#pragma unroll
                for (int dt = 0; dt < 2; ++dt) { const unsigned char* vp = vb + (32 * dt + i) * VROW + 8 * hi;
#pragma unroll
                    for (int ks = 0; ks < 4; ++ks) { const u32x2 v_lo = *(const u32x2*)(vp + 32 * ks), v_hi = *(const u32x2*)(vp + 32 * ks + 16);
                        vfr[dt * 4 + ks] = __builtin_bit_cast(bf16x8, (u32x4){v_lo.x, v_lo.y, v_hi.x, v_hi.y}); } }
                __builtin_amdgcn_sched_barrier(0);
            }
            if (!(key0 >= lo_max && key0 + 63 <= hi_min)) {
#pragma unroll
                for (int r = 0; r < 16; ++r) { const int key = key0 + crow(r, hi);
                    if (key < lo || key > hi_b) p0[r] = -INFINITY;
                    if (key + 32 < lo || key + 32 > hi_b) p1[r] = -INFINITY; }
            }
            if (MODE == 1) {
#pragma unroll
                for (int r = 0; r < 16; ++r) { p0[r] = __builtin_amdgcn_exp2f(p0[r]) * invl; p1[r] = __builtin_amdgcn_exp2f(p1[r]) * invl; }
#pragma unroll
                for (int gq = 0; gq < 4; ++gq) {
                    float G0 = (p0[4 * gq] + p0[4 * gq + 1]) + (p0[4 * gq + 2] + p0[4 * gq + 3]), L0 = p0[4 * gq + 3];
                    float G1 = (p1[4 * gq] + p1[4 * gq + 1]) + (p1[4 * gq + 2] + p1[4 * gq + 3]), L1 = p1[4 * gq + 3];
                    G0 += __shfl_xor(G0, 1); L0 += __shfl_xor(L0, 1); G1 += __shfl_xor(G1, 1); L1 += __shfl_xor(L1, 1);
                    G0 += __shfl_xor(G0, 2); L0 += __shfl_xor(L0, 2); G1 += __shfl_xor(G1, 2); L1 += __shfl_xor(L1, 2);
                    if ((i & 3) == 0) { const int s = 16 * j + 2 * gq + hi;
                        atomicAdd(imp_row + s, G0); atomicAdd(imp_row + s + 1, L0); atomicAdd(imp_row + s + 8, G1); atomicAdd(imp_row + s + 9, L1); }
                }
            } else {
                float ta = fmaxf(fmaxf(p0[0], p0[1]), p1[0]), tb = fmaxf(fmaxf(p0[2], p0[3]), p1[1]);
                ta = fmaxf(fmaxf(ta, p1[2]), p1[3]);
#pragma unroll
                for (int r = 4; r < 16; r += 4) { ta = fmaxf(fmaxf(ta, p0[r]), p0[r + 1]); tb = fmaxf(fmaxf(tb, p0[r + 2]), p0[r + 3]); ta = fmaxf(fmaxf(ta, p1[r]), p1[r + 1]); tb = fmaxf(fmaxf(tb, p1[r + 2]), p1[r + 3]); }
                float tm = fmaxf(ta, tb);
                tm = fmaxf(tm, __shfl_xor(tm, 32));
                if (__any((!initd && tm > -INFINITY) || tm > THR)) {
                    const bool was = initd;
                    const float d = was ? fmaxf(tm, 0.f) : (tm > -INFINITY ? tm : 0.f);
                    initd = was || (tm > -INFINITY);
                    m += d; const float alpha = was ? __builtin_amdgcn_exp2f(-d) : 1.f; l *= alpha;
#pragma unroll
                    for (int r = 0; r < 16; ++r) { p0[r] -= d; p1[r] -= d; negm[r] = -m; }
                    if (MODE == 2) {
                        if (hi == 0) wsc[i] = alpha;
                        asm volatile("" ::: "memory");
#pragma unroll
                        for (int rg = 0; rg < 4; ++rg) { const f32x4 a4 = *(const f32x4*)(wsc + 8 * rg + 4 * hi);
#pragma unroll
                            for (int e = 0; e < 4; ++e) { o[0][4 * rg + e] *= a4[e]; o[1][4 * rg + e] *= a4[e]; } }
                        asm volatile("" ::: "memory");
                    }
                }
                float rs = 0.f;
#pragma unroll
                for (int r = 0; r < 16; ++r) { p0[r] = __builtin_amdgcn_exp2f(p0[r]); p1[r] = __builtin_amdgcn_exp2f(p1[r]); rs += p0[r] + p1[r]; }
                l += rs;
            }
            if (MODE != 0) {
                const bf16x8 pf0 = pack8(p0, 0), pf1 = pack8(p0, 8), pf2 = pack8(p1, 0), pf3 = pack8(p1, 8);
#pragma unroll
                for (int dt = 0; dt < 2; ++dt)
#pragma unroll
                    for (int ks = 0; ks < 4; ++ks)
                        o[dt] = __builtin_amdgcn_mfma_f32_32x32x16_bf16(ks == 0 ? pf0 : (ks == 1 ? pf1 : (ks == 2 ? pf2 : pf3)), vfr[dt * 4 + ks], o[dt], 0, 0, 0);
            }
        }
}
template <int MODE, bool SEL>
__device__ __forceinline__ void run_branch(unsigned char* sm, const Branch br, unsigned m0, unsigned m1, unsigned m2, unsigned m3,
                                           const bf16x8 (&qf)[4], int lo, int hi_b, int lo_max, int hi_min, unsigned s0, unsigned s1, unsigned s2, unsigned s3,
                                           float& m, float& l, float invl, f32x16 (&o)[2], float* imp_row, float* wsc, int tid, int lane) {
    const int i = lane & 31, hi = lane >> 5;
    const bf16* kp = br.k + tid * 8; const bf16* vp_ = br.vt + (size_t)(tid >> 3) * br.ldv + (tid & 7) * 8;
    unsigned char* kst = sm + OFF_K + (tid >> 3) * KROW + (tid & 7) * 16; unsigned char* vst = sm + OFF_V + (tid >> 3) * VROW + (tid & 7) * 16;
#define NSA_LOAD(jj, KR, VR) do { KR = *(const u32x4*)(kp + (size_t)(jj) * 4096); if (MODE != 0) VR = *(const u32x4*)(vp_ + (jj) * 64); } while (0)
#define NSA_STORE(buf, KR, VR) do { *(u32x4*)(kst + (buf) * KBUF) = KR; if (MODE != 0) { *(u32x2*)(vst + (buf) * VBUF) = (u32x2){VR.x, VR.y}; *(u32x2*)(vst + (buf) * VBUF + 8) = (u32x2){VR.z, VR.w}; } } while (0)
    int j = next_bit(m0, m1, m2, m3, 0);
    int j1 = j < 128 ? next_bit(m0, m1, m2, m3, j + 1) : 128;
    u32x4 kA, vA, kB, vB;
    if (j < 128) { NSA_LOAD(j, kA, vA); if (j1 < 128) NSA_LOAD(j1, kB, vB); NSA_STORE(0, kA, vA); }
    __syncthreads();
    bool initd = (MODE == 1);
    f32x16 negm;
#pragma unroll
    for (int r = 0; r < 16; ++r) negm[r] = (MODE == 1) ? -m : 0.f;
    while (j < 128) {
        {
            const int j2 = j1 < 128 ? next_bit(m0, m1, m2, m3, j1 + 1) : 128;
            NSA_LOAD(j2 < 128 ? j2 : j, kA, vA);
            if (j1 < 128) NSA_STORE(1, kB, vB);
            compute_tile<MODE, SEL>(sm, 0, 0, j, qf, lo, hi_b, lo_max, hi_min, s0, s1, s2, s3, m, l, invl, initd, negm, o, imp_row, wsc, i, hi);
            __syncthreads();
            j = j1; j1 = j2;
        }
        if (j >= 128) break;
        {
            const int j2 = j1 < 128 ? next_bit(m0, m1, m2, m3, j1 + 1) : 128;
            NSA_LOAD(j2 < 128 ? j2 : j, kB, vB);
            if (j1 < 128) NSA_STORE(0, kA, vA);
            compute_tile<MODE, SEL>(sm, 0, 1, j, qf, lo, hi_b, lo_max, hi_min, s0, s1, s2, s3, m, l, invl, initd, negm, o, imp_row, wsc, i, hi);
            __syncthreads();
            j = j1; j1 = j2;
        }
    }
#undef NSA_LOAD
#undef NSA_STORE
}
template <bool SEL>
__device__ __forceinline__ void run_branch2(unsigned char* sm, const Branch br, unsigned m0, unsigned m1, unsigned m2, unsigned m3,
                                            const bf16x8 (&qf)[4], int lo, int hi_b, int lo_max, int hi_min, unsigned s0, unsigned s1, unsigned s2, unsigned s3,
                                            float& m, float& l, f32x16 (&o)[2], float* wsc, int tid, int lane) {
    const int i = lane & 31, hi = lane >> 5;
    const bf16* kp = br.k + tid * 8; const bf16* vp_ = br.vt + (size_t)(tid >> 3) * br.ldv + (tid & 7) * 8;
    unsigned char* kst = sm + OFF_K + (tid >> 3) * KROW + (tid & 7) * 16; unsigned char* vst = sm + OFF_V + (tid >> 3) * VROW + (tid & 7) * 16;
#define NSA_LOAD2(jj, KR, VR) do { KR = *(const u32x4*)(kp + (size_t)(jj) * 4096); VR = *(const u32x4*)(vp_ + (jj) * 64); } while (0)
#define NSA_STORE2(pg_, t_, KR, VR) do { *(u32x4*)(kst + (pg_) + (t_) * KBUF) = KR; unsigned char* v2_ = vst + (pg_) + (t_) * VBUF; *(u32x2*)v2_ = (u32x2){VR.x, VR.y}; *(u32x2*)(v2_ + 8) = (u32x2){VR.z, VR.w}; } while (0)
    int ja = next_bit(m0, m1, m2, m3, 0);
    int jb = ja < 128 ? next_bit(m0, m1, m2, m3, ja + 1) : 128;
    u32x4 kA, vA, kB, vB;
    if (ja < 128) { NSA_LOAD2(ja, kA, vA); NSA_LOAD2(jb < 128 ? jb : ja, kB, vB); NSA_STORE2(0, 0, kA, vA); NSA_STORE2(0, 1, kB, vB); }
    __syncthreads();
    bool initd = false;
    f32x16 negm;
#pragma unroll
    for (int r = 0; r < 16; ++r) negm[r] = 0.f;
    int pg = 0;
    while (ja < 128) {
        const int jc = jb < 128 ? next_bit(m0, m1, m2, m3, jb + 1) : 128;
        const int jd = jc < 128 ? next_bit(m0, m1, m2, m3, jc + 1) : 128;
        NSA_LOAD2(jc < 128 ? jc : ja, kA, vA); NSA_LOAD2(jd < 128 ? jd : ja, kB, vB);
        compute_tile<2, SEL>(sm, pg, 0, ja, qf, lo, hi_b, lo_max, hi_min, s0, s1, s2, s3, m, l, 0.f, initd, negm, o, nullptr, wsc, i, hi);
        if (jc < 128) { NSA_STORE2(pg ^ GRP, 0, kA, vA); if (jd < 128) NSA_STORE2(pg ^ GRP, 1, kB, vB); }
        if (jb < 128) compute_tile<2, SEL>(sm, pg, 1, jb, qf, lo, hi_b, lo_max, hi_min, s0, s1, s2, s3, m, l, 0.f, initd, negm, o, nullptr, wsc, i, hi);
        __syncthreads();
        ja = jc; jb = jd; pg ^= GRP;
    }
#undef NSA_LOAD2
#undef NSA_STORE2
}
template <bool FIRST> __device__ __forceinline__ void add_scaled(float* accw, const f32x16 (&o)[2], float f, float* wsc, int i, int hi, int lane) {
    if (hi == 0) wsc[i] = f;
    asm volatile("" ::: "memory");
#pragma unroll
    for (int rg = 0; rg < 4; ++rg) { const f32x4 a4 = *(const f32x4*)(wsc + 8 * rg + 4 * hi);
#pragma unroll
        for (int e = 0; e < 4; ++e)
#pragma unroll
            for (int dt = 0; dt < 2; ++dt) { float* p = accw + (dt * 16 + 4 * rg + e) * 64 + lane; const float v = a4[e] * o[dt][4 * rg + e]; *p = FIRST ? v : (*p + v); } }
    asm volatile("" ::: "memory");
}
__device__ __forceinline__ void unit(const NsaArgs& a, int u, unsigned char* sm) {
    const int tid = tidx(), lane = tid & 63, w = __builtin_amdgcn_readfirstlane(tid >> 6), i = lane & 31, hi = lane >> 5;
    const int cur = 127 - (u >> 2), bg = u & 3, b = bg >> 1, g = bg & 1, q0 = cur * 64;
    const int ql = 8 * w + (i >> 2), hd = i & 3, t = q0 + ql;
    const size_t grow = (size_t)b * T_ + t;
    bf16x8 qf[4];
    { const bf16* qp = a.qb + grow * 512 + g * 256 + hd * 64 + 8 * hi;
#pragma unroll
      for (int d0 = 0; d0 < 4; ++d0) qf[d0] = *(const bf16x8*)(qp + 16 * d0); }
    float* wsc = (float*)(sm + OFF_WS) + w * 32;
    float* imp = (float*)(sm + OFF_IMP);
    unsigned* selw = (unsigned*)(sm + OFF_SEL);
    unsigned* um = (unsigned*)(sm + OFF_UM);
    for (int k = tid; k < 64 * IMPW; k += 512) imp[k] = 0.f;
    if (tid < 4) um[tid] = 0u;
    const float* gt = a.gates + grow * 24 + g * 12 + hd * 3;
    const float gc = gt[0], gs = gt[1], gw = gt[2];
    f32x16 o[2];
    float* accw = (float*)(sm + OFF_ACC) + w * 2048;
    const int tw0 = q0 + 8 * w, tw1 = tw0 + 7;
    {
        const int nv = t < 31 ? 0 : (t - 31) / 16 + 1;
        const int nvw = tw0 < 31 ? 0 : (tw0 - 31) / 16 + 1;
        const int nvmax = (q0 + 63 - 31) / 16 + 1, ntc = (nvmax + 63) / 64;
        const unsigned cm0 = ntc >= 32 ? ~0u : ((1u << ntc) - 1u);
        const Branch br{a.kc + (size_t)bg * NCP * 64, a.vct + (size_t)bg * 64 * NCP, NCP};
        float m = 0.f, l = 0.f;
        run_branch<0, false>(sm, br, cm0, 0u, 0u, 0u, qf, 0, nv - 1, 0, nvw - 1, 0u, 0u, 0u, 0u, m, l, 0.f, o, nullptr, wsc, tid, lane);
        l += __shfl_xor(l, 32);
        const float invl = 1.f / fmaxf(l, 1e-30f);
#pragma unroll
        for (int r = 0; r < 16; ++r) { o[0][r] = 0.f; o[1][r] = 0.f; }
        run_branch<1, false>(sm, br, cm0, 0u, 0u, 0u, qf, 0, nv - 1, 0, nvw - 1, 0u, 0u, 0u, 0u, m, l, invl, o, imp + ql * IMPW, wsc, tid, lane);
        add_scaled<true>(accw, o, gc, wsc, i, hi, lane);
    }
    {
        unsigned u0 = 0u, u1 = 0u, u2 = 0u, u3 = 0u;
        const int ncand = cur - 2;
        unsigned k0[8], k1[8], k2[8], k3[8];
        if (ncand <= 13) {
#pragma unroll
            for (int wd = 0; wd < 4; ++wd) { const int nb = cur + 1 - 32 * wd; const unsigned x = nb >= 32 ? ~0u : (nb <= 0 ? 0u : ((1u << nb) - 1u));
#pragma unroll
                for (int qq = 0; qq < 8; ++qq) { if (wd == 0) k0[qq] = x; else if (wd == 1) k1[qq] = x; else if (wd == 2) k2[qq] = x; else k3[qq] = x; } }
        } else {
            unsigned q0[8], q1[8];
#pragma unroll
            for (int qq = 0; qq < 8; ++qq) { const float* ir = imp + (8 * w + qq) * IMPW;
                q0[qq] = (lane >= 1 && lane <= cur - 2) ? ((__builtin_bit_cast(unsigned, ir[lane]) & 0xFFFFFF80u) | (unsigned)(127 - lane)) : 0u;
                q1[qq] = (lane + 64 <= cur - 2) ? ((__builtin_bit_cast(unsigned, ir[lane + 64]) & 0xFFFFFF80u) | (unsigned)(63 - lane)) : 0u;
                k0[qq] = 1u; k1[qq] = 0u; k2[qq] = 0u; k3[qq] = 0u; }
            for (int it = 0; it < 13; ++it) {
#pragma unroll
                for (int qq = 0; qq < 8; ++qq) {
                    unsigned mx = q0[qq] > q1[qq] ? q0[qq] : q1[qq];
                    { const unsigned o_ = (unsigned)__builtin_amdgcn_update_dpp(0, (int)mx, 0xB1, 0xF, 0xF, true); mx = o_ > mx ? o_ : mx; }
                    { const unsigned o_ = (unsigned)__builtin_amdgcn_update_dpp(0, (int)mx, 0x4E, 0xF, 0xF, true); mx = o_ > mx ? o_ : mx; }
                    { const unsigned o_ = (unsigned)__builtin_amdgcn_update_dpp(0, (int)mx, 0x141, 0xF, 0xF, true); mx = o_ > mx ? o_ : mx; }
                    { const unsigned o_ = (unsigned)__builtin_amdgcn_update_dpp(0, (int)mx, 0x140, 0xF, 0xF, true); mx = o_ > mx ? o_ : mx; }
                    const unsigned r0 = (unsigned)__builtin_amdgcn_readlane((int)mx, 0), r1 = (unsigned)__builtin_amdgcn_readlane((int)mx, 16), r2 = (unsigned)__builtin_amdgcn_readlane((int)mx, 32), r3 = (unsigned)__builtin_amdgcn_readlane((int)mx, 48);
                    const unsigned ra = r0 > r1 ? r0 : r1, rb = r2 > r3 ? r2 : r3, best = ra > rb ? ra : rb;
                    if (q0[qq] == best) q0[qq] = 0u; if (q1[qq] == best) q1[qq] = 0u;
                    const int b_ = 127 - (int)(best & 127u);
                    const unsigned bit = 1u << (b_ & 31);
                    if (b_ < 32) k0[qq] |= bit; else if (b_ < 64) k1[qq] |= bit; else if (b_ < 96) k2[qq] |= bit; else k3[qq] |= bit; }
            }
            { const int c1 = cur - 1; const unsigned b1 = 1u << (c1 & 31), b2 = 1u << (cur & 31);
#pragma unroll
              for (int qq = 0; qq < 8; ++qq) {
                if (c1 < 32) k0[qq] |= b1; else if (c1 < 64) k1[qq] |= b1; else if (c1 < 96) k2[qq] |= b1; else k3[qq] |= b1;
                if (cur < 32) k0[qq] |= b2; else if (cur < 64) k1[qq] |= b2; else if (cur < 96) k2[qq] |= b2; else k3[qq] |= b2; } }
        }
#pragma unroll
        for (int qq = 0; qq < 8; ++qq) {
            if (lane == 0) { unsigned* sp = selw + (8 * w + qq) * 4; sp[0] = k0[qq]; sp[1] = k1[qq]; sp[2] = k2[qq]; sp[3] = k3[qq]; }
            u0 |= k0[qq]; u1 |= k1[qq]; u2 |= k2[qq]; u3 |= k3[qq]; }
        if (lane == 0) { atomicOr(um + 0, u0); atomicOr(um + 1, u1); atomicOr(um + 2, u2); atomicOr(um + 3, u3); }
    }
    __syncthreads();
    {
        const unsigned U0 = um[0], U1 = um[1], U2 = um[2], U3 = um[3];
        const unsigned* sp = selw + ql * 4; const unsigned s0 = sp[0], s1 = sp[1], s2 = sp[2], s3 = sp[3];
        const Branch br{a.ks + (size_t)bg * T_ * 64, a.vst + (size_t)bg * 64 * T_, T_};
        float m = 0.f, l = 0.f;
#pragma unroll
        for (int r = 0; r < 16; ++r) { o[0][r] = 0.f; o[1][r] = 0.f; }
        run_branch2<true>(sm, br, __builtin_amdgcn_readfirstlane(U0), __builtin_amdgcn_readfirstlane(U1), __builtin_amdgcn_readfirstlane(U2), __builtin_amdgcn_readfirstlane(U3),
                          qf, 0, t, 0, tw0, s0, s1, s2, s3, m, l, o, wsc, tid, lane);
        l += __shfl_xor(l, 32);
        add_scaled<false>(accw, o, gs / fmaxf(l, 1e-30f), wsc, i, hi, lane);
    }
    {
        const int j0 = cur - 8 > 0 ? cur - 8 : 0;
        unsigned wm0 = 0u, wm1 = 0u, wm2 = 0u, wm3 = 0u;
#pragma unroll
        for (int wd = 0; wd < 4; ++wd) { const int a0 = j0 - 32 * wd, a1 = cur + 1 - 32 * wd;
            const unsigned hi_m = a1 >= 32 ? ~0u : (a1 <= 0 ? 0u : ((1u << a1) - 1u)), lo_m = a0 >= 32 ? ~0u : (a0 <= 0 ? 0u : ((1u << a0) - 1u));
            const unsigned x = hi_m & ~lo_m; if (wd == 0) wm0 = x; else if (wd == 1) wm1 = x; else if (wd == 2) wm2 = x; else wm3 = x; }
        const Branch br{a.kw + (size_t)bg * T_ * 64, a.vwt + (size_t)bg * 64 * T_, T_};
        float m = 0.f, l = 0.f;
#pragma unroll
        for (int r = 0; r < 16; ++r) { o[0][r] = 0.f; o[1][r] = 0.f; }
        run_branch2<false>(sm, br, wm0, wm1, wm2, wm3, qf, t - 511, t, tw1 - 511, tw0, 0u, 0u, 0u, 0u, m, l, o, wsc, tid, lane);
        l += __shfl_xor(l, 32);
        add_scaled<false>(accw, o, gw / fmaxf(l, 1e-30f), wsc, i, hi, lane);
    }
#pragma unroll
    for (int r = 0; r < 16; ++r) { const int rw = crow(r, hi), qq = 8 * w + (rw >> 2), hh = rw & 3;
        bf16* op = a.amix + ((size_t)b * T_ + q0 + qq) * DM + g * 256 + hh * 64 + i;
        op[0] = (bf16)f2bf(accw[r * 64 + lane]); op[32] = (bf16)f2bf(accw[(16 + r) * 64 + lane]); }
}
__device__ __forceinline__ void phase(const NsaArgs& a, unsigned* ctr, unsigned char* sm) {
    int* slot = (int*)(sm + OFF_UNIT);
    for (;;) {
        if (tidx() == 0) *slot = (int)atomicAdd(ctr, 1u);
        __syncthreads();
        const int u = *slot;
        __syncthreads();
        if (u >= 512) break;
        unit(a, u, sm);
    }
}
}

__device__ __forceinline__ void d_lora_prep(const bf16* pr, const float* mu, bf16* la, int wg0 = 0) {
    if ((int)blockIdx.x < wg0) return;
    const int T512 = tidx(), c = T512 & 255;
    const float m = mu[1536 + c];
    for (int vb = ((int)blockIdx.x - wg0) * 2 + (T512 >> 8); vb < M_ / 4; vb += ((int)gridDim.x - wg0) * 2) {
        const int row0 = vb * 4;
        float x[5];
        x[0] = (row0 % T_) ? bf2f(pr[(size_t)(row0 - 1) * 256 + c]) : 0.f;
#pragma unroll
        for (int j = 0; j < 4; ++j) x[j + 1] = bf2f(pr[(size_t)(row0 + j) * 256 + c]);
#pragma unroll
        for (int j = 0; j < 4; ++j) { const float xs = x[j + 1] + (x[j] - x[j + 1]) * m;
            const float v = c < 64 ? tanhf(xs) : (c < 128 ? xs : sigmoidf_(xs));
            la[(size_t)(row0 + j) * KLORA + c] = (bf16)f2bf(v); }
    }
}

namespace rw7 {
using nsa::f32x16; using nsa::crow; using nsa::pack8;
constexpr int NHELP = 2, RG = 18;
constexpr int NPROD = 6, RING = 7, RA = 144, RB = 40, S_AT = 0, S_RT = 16 * RA, S_BT = 32 * RA, S_KT = S_BT + 64 * RB, S_VT = S_KT + 64 * RB, S_SM = S_VT + 64 * RB, SMM = 16 * RB, S_GC = S_SM + 4 * SMM, SLOT = S_GC + 256;
constexpr int OFF_SCR = RING * SLOT, SCR = 32 * RA, LDS_NEED = OFF_SCR;
static_assert(NPROD % NHELP == 0 && LDS_NEED <= 147456 - 64 && 7 * (SLOT + SCR) <= 147456 - 64 && RING * SLOT + 4 * 16 * RB + 128 <= 147456 - 64 && (size_t)16 * NHELP * RG * SLOT <= (size_t)9 << 20 && SLOT % 16 == 0 && S_BT % 16 == 0 && 128 * RB >= 4096 && SCR >= 4096, "rw7 lds map");
struct Args { const unsigned* rkw; const bf16* vv; const bf16* aga; const float* wdec; const float *mu, *kk, *ka, *rk; float* yraw; float* bonus; unsigned char* ring; unsigned* flags; unsigned* cons; };
__device__ __forceinline__ void wg_bar() { asm volatile("s_waitcnt lgkmcnt(0)" ::: "memory"); __builtin_amdgcn_s_barrier(); asm volatile("" ::: "memory"); }
struct Chan { float mur, muk, muv, kkc, kac, rkc; };
struct Raw { unsigned rk[16]; unsigned short v[16], al[16]; float w[16]; unsigned prk; unsigned short pv; };
__device__ __forceinline__ void fetch(const Args& a, int b, int h, int c, int lane, Raw& q) {
    const size_t base = ((size_t)b * T_ + (size_t)c * 16) * 512 + h * 64 + lane;
#pragma unroll
    for (int t = 0; t < 16; ++t) { q.rk[t] = a.rkw[base + (size_t)t * 512]; q.v[t] = a.vv[base + (size_t)t * 512]; q.al[t] = a.aga[base + (size_t)t * 512]; q.w[t] = a.wdec[base + (size_t)t * 512]; }
    q.prk = 0u; q.pv = 0;
    if (c > 0) { q.prk = a.rkw[base - 512]; q.pv = a.vv[base - 512]; }
}
__device__ __forceinline__ void st_row40(unsigned char* p, const unsigned (&w)[8]) {
    *(u32x2*)p = (u32x2){w[0], w[1]}; *(u32x2*)(p + 8) = (u32x2){w[2], w[3]}; *(u32x2*)(p + 16) = (u32x2){w[4], w[5]}; *(u32x2*)(p + 24) = (u32x2){w[6], w[7]};
}
template <bool BAR> __device__ __forceinline__ void seg_end() { if (BAR) wg_bar(); else { asm volatile("s_waitcnt lgkmcnt(0)" ::: "memory"); __builtin_amdgcn_sched_barrier(0); } }
template <bool BAR> __device__ __forceinline__ void produce(const Args& a, const Chan& ch, int b, int h, int c, const Raw& q, unsigned char* slot, unsigned char* scr, int lane) {
    const int i = lane & 31, hi = lane >> 5;
    const size_t row0 = (size_t)b * T_ + (size_t)c * 16;
    float pr_r = __builtin_bit_cast(float, q.prk << 16), pr_k = __builtin_bit_cast(float, q.prk & 0xffff0000u), pr_v = bf2f(q.pv);
    float rr[16], kq[16], kt[16];
    float* RED1 = (float*)scr;
    float* RED2 = (float*)(slot + S_BT);
#pragma unroll
    for (int t4 = 0; t4 < 4; ++t4) { f32x4 e1, e2;
#pragma unroll
        for (int e = 0; e < 4; ++e) { const int t = 4 * t4 + e;
            const float r0 = __builtin_bit_cast(float, q.rk[t] << 16), k0 = __builtin_bit_cast(float, q.rk[t] & 0xffff0000u), al = bf2f(q.al[t]);
            const float r = r0 + (pr_r - r0) * ch.mur, k = k0 + (pr_k - k0) * ch.muk;
            pr_r = r0; pr_k = k0;
            rr[t] = r; kq[t] = k * ch.kkc; kt[t] = k * (1.f + (al - 1.f) * ch.kac);
            e1[e] = kq[t] * kq[t]; e2[e] = r * kt[t] * ch.rkc; }
        *(f32x4*)(RED1 + lane * 16 + 4 * t4) = e1; *(f32x4*)(RED2 + lane * 16 + 4 * t4) = e2; }
    seg_end<BAR>();
    { const int t = lane & 15, part = lane >> 4; float s1 = 0.f, s2 = 0.f;
#pragma unroll
      for (int j = 0; j < 16; ++j) { s1 += RED1[(part * 16 + j) * 16 + t]; s2 += RED2[(part * 16 + j) * 16 + t]; }
      s1 += __shfl_xor(s1, 16); s2 += __shfl_xor(s2, 16); s1 += __shfl_xor(s1, 32); s2 += __shfl_xor(s2, 32);
      asm volatile("s_waitcnt lgkmcnt(0)" ::: "memory");
      if (lane < 16) { ((float*)(slot + S_GC))[lane] = s1; a.bonus[(row0 + lane) * 8 + h] = s2; } }
    asm volatile("s_waitcnt lgkmcnt(0)" ::: "memory");
    f32x4 n2[4];
#pragma unroll
    for (int t4 = 0; t4 < 4; ++t4) n2[t4] = *(const f32x4*)(slot + S_GC + 16 * t4);
    asm volatile("s_waitcnt lgkmcnt(0)" ::: "memory");
    float gam = 1.f;
    unsigned btp[8], ktp[8], vtp[8];
    float b_ev = 0.f, k_ev = 0.f, v_ev = 0.f;
#pragma unroll
    for (int t = 0; t < 16; ++t) {
        if (t == 6) seg_end<BAR>();
        const float v0 = bf2f(q.v[t]), al = bf2f(q.al[t]);
        const float v = v0 + (pr_v - v0) * ch.muv; pr_v = v0;
        const float kkn = kq[t] * __builtin_amdgcn_rsqf(fmaxf(n2[t >> 2][t & 3], 1e-24f));
        const float gp = gam; gam *= q.w[t]; const float ig = __builtin_amdgcn_rcpf(gam);
        const float bt_ = kkn * al * ig, kt_ = kt[t] * ig;
        const unsigned ar = pk2(-kkn * gp, rr[t] * gam), bk = pk2(bt_, kt_);
        *(bf16*)(slot + S_AT + t * RA + lane * 2) = (bf16)(ar & 0xffffu); *(bf16*)(slot + S_RT + t * RA + lane * 2) = (bf16)(ar >> 16);
        *(bf16*)(scr + t * RA + lane * 2) = (bf16)(bk & 0xffffu); *(bf16*)(scr + (16 + t) * RA + lane * 2) = (bf16)(bk >> 16);
        if (t & 1) { btp[t >> 1] = pk2(b_ev, bt_); ktp[t >> 1] = pk2(k_ev, kt_); vtp[t >> 1] = pk2(v_ev, v); }
        else { b_ev = bt_; k_ev = kt_; v_ev = v; }
    }
    st_row40(slot + S_BT + lane * RB, btp); st_row40(slot + S_KT + lane * RB, ktp); st_row40(slot + S_VT + lane * RB, vtp);
    ((float*)(slot + S_GC))[lane] = gam;
    seg_end<BAR>();
    f32x16 C;
#pragma unroll
    for (int r = 0; r < 16; ++r) C[r] = 0.f;
#pragma unroll
    for (int ks = 0; ks < 4; ++ks) {
        const bf16x8 af = *(const bf16x8*)(slot + S_AT + i * RA + (16 * ks + 8 * hi) * 2);
        const bf16x8 bf = *(const bf16x8*)(scr + i * RA + (16 * ks + 8 * hi) * 2);
        C = __builtin_amdgcn_mfma_f32_32x32x16_bf16(af, bf, C, 0, 0, 0);
    }
    asm volatile("s_waitcnt lgkmcnt(0)" ::: "memory");
    float* AAB = (float*)scr;
    unsigned char* SM = slot + S_SM;
#pragma unroll
    for (int r = 0; r < 16; ++r) {
        const int rho = crow(r, hi); const float val = C[r];
        if (r < 8) {
            if (i < 16) AAB[rho * 16 + i] = (i < rho) ? val : 0.f;
            else *(bf16*)(SM + SMM + rho * RB + (i - 16) * 2) = (bf16)f2bf((i - 16 < rho) ? val : 0.f);
        } else {
            const int tt = rho - 16;
            if (i < 16) *(bf16*)(SM + 2 * SMM + tt * RB + i * 2) = (bf16)f2bf((i <= tt) ? val : 0.f);
            else *(bf16*)(SM + 3 * SMM + tt * RB + (i - 16) * 2) = (bf16)f2bf((i - 16 <= tt) ? val : 0.f);
        }
    }
    seg_end<BAR>();
    { const int j = lane & 15; float Tr[16];
#pragma unroll
      for (int t = 0; t < 16; ++t) { if (t == 11) seg_end<BAR>();
          float acc = (t == j) ? 1.f : 0.f;
#pragma unroll
          for (int s4 = 0; s4 < (t + 3) / 4; ++s4) { const f32x4 ar = *(const f32x4*)(AAB + t * 16 + 4 * s4);
#pragma unroll
              for (int e = 0; e < 4; ++e) if (4 * s4 + e < t) acc += ar[e] * Tr[4 * s4 + e]; }
          Tr[t] = acc;
          if (lane < 16) *(bf16*)(SM + t * RB + j * 2) = (bf16)f2bf(acc); } }
    seg_end<BAR>();
}

__device__ __forceinline__ bf16x8 rd_perm(const unsigned char* p, int hi) {
    const u32x2 a = *(const u32x2*)(p + 8 * hi), b = *(const u32x2*)(p + 16 + 8 * hi);
    return __builtin_bit_cast(bf16x8, (u32x4){a.x, a.y, b.x, b.y});
}
__device__ __forceinline__ bf16x8 rd_nat(const unsigned char* p, int hi) {
    const u32x2 a = *(const u32x2*)(p + 16 * hi), b = *(const u32x2*)(p + 16 * hi + 8);
    return __builtin_bit_cast(bf16x8, (u32x4){a.x, a.y, b.x, b.y});
}
constexpr int ZOFF = RING * SLOT, ZBYTES = 4 * SMM + 128;
struct Pre { bf16x8 fa0, fa1, fa2, fa3, fak, vtf; };
__device__ __forceinline__ void load_pre(Pre& p, const unsigned char* slot, const unsigned char* zero, int vt, int lane) {
    const int i = lane & 31, hi = lane >> 5, i16 = i & 15;
    const unsigned char* at = i < 16 ? slot + S_AT + i16 * RA : zero; const unsigned char* sm16 = i < 16 ? slot + S_SM + i16 * RB : zero;
    p.fa0 = rd_perm(at, hi); p.fa1 = rd_perm(at + 32, hi); p.fa2 = rd_perm(at + 64, hi); p.fa3 = rd_perm(at + 96, hi);
    p.fak = rd_nat(sm16 + SMM, hi);
    p.vtf = rd_nat(slot + S_VT + (32 * vt + i) * RB, hi);
}
__device__ __forceinline__ void consume(const unsigned char* slot, const unsigned char* nslot, const unsigned char* zero, Pre& pre, f32x16 (&z)[2], f32x4 (&gp)[2][4], float* yout, int vt, int lane) {
    const int i = lane & 31, hi = lane >> 5, i16 = i & 15;
    const unsigned char* rt = i < 16 ? slot + S_RT + i16 * RA : zero; const unsigned char* sm16 = i < 16 ? slot + S_SM + i16 * RB : zero;
    const bf16x8 ft = rd_perm(sm16, hi);
    const bf16x8 fr0 = rd_perm(rt, hi), fr1 = rd_perm(rt + 32, hi), fr2 = rd_perm(rt + 64, hi), fr3 = rd_perm(rt + 96, hi);
    const bf16x8 frk = rd_nat(sm16 + 3 * SMM, hi);
    const bf16x8 fk0 = rd_nat(slot + S_KT + i * RB, hi), fk1 = rd_nat(slot + S_KT + (32 + i) * RB, hi);
    const bf16x8 fb0 = rd_perm(slot + S_BT + i * RB, hi), fb1 = rd_perm(slot + S_BT + (32 + i) * RB, hi);
    const bf16x8 frb = rd_perm(sm16 + 2 * SMM, hi);
    __builtin_amdgcn_sched_barrier(0);
    f32x16 zs[2];
#pragma unroll
    for (int kt = 0; kt < 2; ++kt)
#pragma unroll
        for (int rg = 0; rg < 4; ++rg)
#pragma unroll
            for (int e = 0; e < 4; ++e) zs[kt][4 * rg + e] = z[kt][4 * rg + e] * gp[kt][rg][e];
    const bf16x8 zb0 = pack8(zs[0], 0), zb1 = pack8(zs[0], 8), zb2 = pack8(zs[1], 0), zb3 = pack8(zs[1], 8);
    f32x16 X, U, Y;
#pragma unroll
    for (int r = 0; r < 16; ++r) { X[r] = 0.f; U[r] = 0.f; Y[r] = 0.f; }
    X = __builtin_amdgcn_mfma_f32_32x32x16_bf16(pre.fa0, zb0, X, 0, 0, 0);
    X = __builtin_amdgcn_mfma_f32_32x32x16_bf16(pre.fa1, zb1, X, 0, 0, 0);
    X = __builtin_amdgcn_mfma_f32_32x32x16_bf16(pre.fa2, zb2, X, 0, 0, 0);
    X = __builtin_amdgcn_mfma_f32_32x32x16_bf16(pre.fa3, zb3, X, 0, 0, 0);
    X = __builtin_amdgcn_mfma_f32_32x32x16_bf16(pre.fak, pre.vtf, X, 0, 0, 0);
    Y = __builtin_amdgcn_mfma_f32_32x32x16_bf16(fr0, zb0, Y, 0, 0, 0);
    Y = __builtin_amdgcn_mfma_f32_32x32x16_bf16(fr1, zb1, Y, 0, 0, 0);
    Y = __builtin_amdgcn_mfma_f32_32x32x16_bf16(fr2, zb2, Y, 0, 0, 0);
    Y = __builtin_amdgcn_mfma_f32_32x32x16_bf16(fr3, zb3, Y, 0, 0, 0);
    Y = __builtin_amdgcn_mfma_f32_32x32x16_bf16(frk, pre.vtf, Y, 0, 0, 0);
    z[0] = __builtin_amdgcn_mfma_f32_32x32x16_bf16(fk0, pre.vtf, zs[0], 0, 0, 0);
    z[1] = __builtin_amdgcn_mfma_f32_32x32x16_bf16(fk1, pre.vtf, zs[1], 0, 0, 0);
    __builtin_amdgcn_sched_barrier(0);
    load_pre(pre, nslot, zero, vt, lane);
#pragma unroll
    for (int kt = 0; kt < 2; ++kt)
#pragma unroll
        for (int rg = 0; rg < 4; ++rg) gp[kt][rg] = *(const f32x4*)(slot + S_GC + (32 * kt + 8 * rg + 4 * hi) * 4);
    __builtin_amdgcn_sched_barrier(0);
    const bf16x8 xb = pack8(X, 0);
    U = __builtin_amdgcn_mfma_f32_32x32x16_bf16(ft, xb, U, 0, 0, 0);
    const bf16x8 ub = pack8(U, 0);
    z[0] = __builtin_amdgcn_mfma_f32_32x32x16_bf16(fb0, ub, z[0], 0, 0, 0);
    z[1] = __builtin_amdgcn_mfma_f32_32x32x16_bf16(fb1, ub, z[1], 0, 0, 0);
    Y = __builtin_amdgcn_mfma_f32_32x32x16_bf16(frb, ub, Y, 0, 0, 0);
#pragma unroll
    for (int r = 0; r < 8; ++r) yout[(size_t)crow(r, hi) * 512] = Y[r];
}

__device__ __forceinline__ unsigned ld_relaxed(const unsigned* p) { return __hip_atomic_load(p, __ATOMIC_RELAXED, __HIP_MEMORY_SCOPE_AGENT); }
__device__ __forceinline__ void head(const Args& a, int bh, unsigned char* sm) {
    const int tid = tidx(), lane = tid & 63, w = __builtin_amdgcn_readfirstlane(tid >> 6);
    const int b = bh >> 3, h = bh & 7;
    constexpr int NCH = T_ / 16, NBAR = NCH + NPROD;
    if (w < 2) {
        f32x16 z[2];
#pragma unroll
        for (int r = 0; r < 16; ++r) { z[0][r] = 0.f; z[1][r] = 0.f; }
        for (int k = lane * 4 + w * 256; k < ZBYTES; k += 512) *(unsigned*)(sm + ZOFF + k) = 0u;
        for (int i = 0; i < NPROD; ++i) wg_bar();
        Pre pre; load_pre(pre, sm, sm + ZOFF, w, lane);
        f32x4 gp[2][4];
#pragma unroll
        for (int kt = 0; kt < 2; ++kt)
#pragma unroll
            for (int rg = 0; rg < 4; ++rg) gp[kt][rg] = (f32x4){1.f, 1.f, 1.f, 1.f};
        for (int c = 0; c < NCH; ++c) {
            consume(sm + (size_t)(c % RING) * SLOT, sm + (size_t)((c + 1) % RING) * SLOT, sm + ZOFF, pre, z, gp, a.yraw + ((size_t)b * T_ + (size_t)c * 16) * 512 + h * 64 + 32 * w + (lane & 31), w, lane);
            if (w == 0 && (c & 7) == 7 && lane == 0) __hip_atomic_store(a.cons + bh * 64, (unsigned)(c + 1), __ATOMIC_RELAXED, __HIP_MEMORY_SCOPE_AGENT);
            wg_bar();
        }
    } else {
        const int pw = w - 2;
        int nb = pw;
        {
            u32x4 v[15];
            { const int c = pw; const int hl = c % NHELP, n = c / NHELP;
              const unsigned char* g = a.ring + ((size_t)(bh * NHELP + hl) * RG + (n % RG)) * SLOT;
              while (__builtin_amdgcn_readfirstlane(ld_relaxed(a.flags + bh * NCH + c)) == 0u) __builtin_amdgcn_s_sleep(2);
              __builtin_amdgcn_fence(__ATOMIC_ACQUIRE, "agent");
              asm volatile("s_waitcnt vmcnt(0)" ::: "memory");
#pragma unroll
              for (int i = 0; i < 15; ++i) { const int off = (i * 64 + lane) * 16; if (off < SLOT) v[i] = *(const u32x4*)(g + off); } }
            for (int i = 0; i < pw; ++i) wg_bar();
            for (int c = pw; c < NCH; c += NPROD) {
                unsigned char* slot = sm + (size_t)(c % RING) * SLOT;
#pragma unroll
                for (int i = 0; i < 15; ++i) { const int off = (i * 64 + lane) * 16; if (off < SLOT) *(u32x4*)(slot + off) = v[i]; }
                const int cn = c + NPROD; const bool more = cn < NCH;
                const unsigned* fp = a.flags + bh * NCH + (more ? cn : c);
                unsigned fl = ld_relaxed(fp);
                wg_bar(); wg_bar();
                if (more) {
                    while (__builtin_amdgcn_readfirstlane(fl) == 0u) { __builtin_amdgcn_s_sleep(2); fl = ld_relaxed(fp); }
                    __builtin_amdgcn_fence(__ATOMIC_ACQUIRE, "agent");
                    asm volatile("s_waitcnt vmcnt(0)" ::: "memory");
                    const int hl = cn % NHELP, n = cn / NHELP;
                    const unsigned char* g = a.ring + ((size_t)(bh * NHELP + hl) * RG + (n % RG)) * SLOT;
#pragma unroll
                    for (int i = 0; i < 15; ++i) { const int off = (i * 64 + lane) * 16; if (off < SLOT) v[i] = *(const u32x4*)(g + off); }
                }
                wg_bar(); wg_bar(); wg_bar(); wg_bar();
                nb += NPROD;
            }
        }
        for (; nb < NBAR; ++nb) wg_bar();
    }
}
constexpr int NHW = 7;
__device__ __forceinline__ void helper(const Args& a, int bh, int hl, unsigned char* sm) {
    const int tid = tidx(), lane = tid & 63, w = __builtin_amdgcn_readfirstlane(tid >> 6);
    if (w >= NHW) return;
    const int b = bh >> 3, h = bh & 7, col = h * 64 + lane;
    constexpr int NCH = T_ / 16;
    unsigned char* slot = sm + (size_t)w * SLOT; unsigned char* scr = sm + NHW * SLOT + w * SCR;
    const Chan ch{a.mu[col], a.mu[512 + col], a.mu[1024 + col], a.kk[col], a.ka[col], a.rk[col]};
    int n = w, c = NHELP * n + hl;
    if (c >= NCH) return;
    for (; c < NCH; n += NHW, c += NHW * NHELP) {
        Raw q; fetch(a, b, h, c, lane, q);
        if (n >= RG) { const unsigned need = (unsigned)(c - RG * NHELP + 1);
            while (__builtin_amdgcn_readfirstlane(ld_relaxed(a.cons + bh * 64)) < need) __builtin_amdgcn_s_sleep(8); }
        produce<false>(a, ch, b, h, c, q, slot, scr, lane);
        asm volatile("s_waitcnt lgkmcnt(0)" ::: "memory");
        unsigned char* g = a.ring + ((size_t)(bh * NHELP + hl) * RG + (n % RG)) * SLOT;
#pragma unroll
        for (int i = 0; i < 15; ++i) { const int off = (i * 64 + lane) * 16;
            if (off < SLOT) { const u32x4 d = *(const u32x4*)(slot + off); unsigned char* gp = g + off; asm volatile("global_store_dwordx4 %0, %1, off sc1\n\ts_nop 1" :: "v"(gp), "v"(d) : "memory"); } }
        asm volatile("s_waitcnt vmcnt(0)" ::: "memory");
        if (lane == 0) __hip_atomic_store(a.flags + bh * NCH + c, 1u, __ATOMIC_RELAXED, __HIP_MEMORY_SCOPE_AGENT);
    }
}
__device__ __forceinline__ void finish(const float* yraw, const float* bonus, const bf16* vv, const bf16* agg, const float* mu, const float* gng, const float* gnb, bf16* amix) {
    const int T512 = tidx(), lane = T512 & 63;
    for (int row = blockIdx.x * 8 + (T512 >> 6); row < M_; row += gridDim.x * 8) {
        const int t = row % T_;
        float y[8], v0[8], v1[8], gg[8], bo[8];
#pragma unroll
        for (int j = 0; j < 8; ++j) { const int col = j * 64 + lane;
            y[j] = yraw[(size_t)row * 512 + col]; v0[j] = bf2f(vv[(size_t)row * 512 + col]); v1[j] = t ? bf2f(vv[(size_t)(row - 1) * 512 + col]) : 0.f;
            gg[j] = bf2f(agg[(size_t)row * 512 + col]); bo[j] = bonus[(size_t)row * 8 + j]; }
        float mean[8], var[8];
#pragma unroll
        for (int j = 0; j < 8; ++j) mean[j] = y[j];
#pragma unroll
        for (int o = 1; o < 64; o <<= 1) {
#pragma unroll
            for (int j = 0; j < 8; ++j) mean[j] += __shfl_xor(mean[j], o); }
#pragma unroll
        for (int j = 0; j < 8; ++j) { mean[j] *= (1.f / 64.f); y[j] -= mean[j]; var[j] = y[j] * y[j]; }
#pragma unroll
        for (int o = 1; o < 64; o <<= 1) {
#pragma unroll
            for (int j = 0; j < 8; ++j) var[j] += __shfl_xor(var[j], o); }
#pragma unroll
        for (int j = 0; j < 8; ++j) { const int col = j * 64 + lane;
            const float yn = y[j] * rsqrtf(var[j] * (1.f / 64.f) + 64e-5f) * gng[col] + gnb[col];
            const float v = v0[j] + (v1[j] - v0[j]) * mu[1024 + col];
            amix[(size_t)row * DM + 512 + col] = (bf16)f2bf((yn + bo[j] * v) * gg[j]); }
    }
}
}

namespace mema {
using nsa::f32x16; using nsa::KROW; using nsa::VROW; using nsa::KBUF; using nsa::VBUF; using nsa::OFF_K; using nsa::OFF_V; using nsa::OFF_WS; using nsa::crow; using nsa::pack8;
__device__ __forceinline__ void unit(const bf16* qm, const bf16* mk, const bf16* mvt, bf16* om, int u, unsigned char* sm) {
    const int tid = tidx(), lane = tid & 63, w = __builtin_amdgcn_readfirstlane(tid >> 6), i = lane & 31, hi = lane >> 5;
    const int b = u >> 7, h = (u >> 5) & 3, rb = u & 31;
    const int row0 = b * T_ + rb * 256 + 32 * w;
    const bf16* qrow = qm + (size_t)(row0 + i) * DM + h * 256 + 8 * hi;
    const bf16* kbase = mk + (size_t)(b * 256 + (tid >> 3)) * DM + h * 256 + (tid & 7) * 8;
    const bf16* vbase = mvt + (size_t)(h * 256 + (tid >> 3)) * 512 + b * 256 + (tid & 7) * 8;
    unsigned char* kst = sm + OFF_K + (tid >> 3) * KROW + (tid & 7) * 16;
    unsigned char* vst = sm + OFF_V + (tid >> 3) * VROW + (tid & 7) * 16;
    float* wsc = (float*)(sm + OFF_WS) + w * 32;
    f32x16 p[4][2];
#pragma unroll
    for (int kt = 0; kt < 4; ++kt)
#pragma unroll
        for (int r = 0; r < 16; ++r) { p[kt][0][r] = 0.f; p[kt][1][r] = 0.f; }
    u32x4 tr[4];
#define MEMA_SRC(n) ((n) < 16 ? (const u32x4*)(kbase + (size_t)(64 * ((n) & 3)) * DM + 64 * ((n) >> 2)) : (const u32x4*)(vbase + (size_t)(64 * (((n) - 16) >> 2)) * 512 + 64 * ((n) & 3)))
#define MEMA_PUT(n) do { if ((n) < 16) *(u32x4*)(kst + ((n) & 1) * KBUF) = tr[(n) & 3]; else { unsigned char* vp2_ = vst + ((n) & 1) * VBUF; *(u32x2*)vp2_ = (u32x2){tr[(n) & 3].x, tr[(n) & 3].y}; *(u32x2*)(vp2_ + 8) = (u32x2){tr[(n) & 3].z, tr[(n) & 3].w}; } } while (0)
    tr[0] = *MEMA_SRC(0); tr[1] = *MEMA_SRC(1); tr[2] = *MEMA_SRC(2);
    MEMA_PUT(0);
    __syncthreads();
    bf16x8 qf[4];
#pragma unroll
    for (int n = 0; n < 16; ++n) {
        const int dc = n >> 2, kt = n & 3, cb = n & 1;
        tr[(n + 3) & 3] = *MEMA_SRC(n + 3);
        if (kt == 0) {
#pragma unroll
            for (int d0 = 0; d0 < 4; ++d0) qf[d0] = *(const bf16x8*)(qrow + 64 * dc + 16 * d0);
        }
        const unsigned char* kb = sm + OFF_K + cb * KBUF;
#pragma unroll
        for (int d0 = 0; d0 < 4; ++d0) {
            const bf16x8 a0 = *(const bf16x8*)(kb + i * KROW + (16 * d0 + 8 * hi) * 2);
            const bf16x8 a1 = *(const bf16x8*)(kb + (32 + i) * KROW + (16 * d0 + 8 * hi) * 2);
            p[kt][0] = __builtin_amdgcn_mfma_f32_32x32x16_bf16(a0, qf[d0], p[kt][0], 0, 0, 0);
            p[kt][1] = __builtin_amdgcn_mfma_f32_32x32x16_bf16(a1, qf[d0], p[kt][1], 0, 0, 0);
        }
        MEMA_PUT(n + 1);
        __syncthreads();
    }
    float mx = p[0][0][0];
#pragma unroll
    for (int kt = 0; kt < 4; ++kt)
#pragma unroll
        for (int r = 0; r < 16; ++r) mx = fmaxf(mx, fmaxf(p[kt][0][r], p[kt][1][r]));
    mx = fmaxf(mx, __shfl_xor(mx, 32));
    float l = 0.f;
#pragma unroll
    for (int kt = 0; kt < 4; ++kt)
#pragma unroll
        for (int r = 0; r < 16; ++r) { p[kt][0][r] = __builtin_amdgcn_exp2f(p[kt][0][r] - mx); p[kt][1][r] = __builtin_amdgcn_exp2f(p[kt][1][r] - mx); l += p[kt][0][r] + p[kt][1][r]; }
    l += __shfl_xor(l, 32);
    bf16x8 pf[4][4];
#pragma unroll
    for (int kt = 0; kt < 4; ++kt) { pf[kt][0] = pack8(p[kt][0], 0); pf[kt][1] = pack8(p[kt][0], 8); pf[kt][2] = pack8(p[kt][1], 0); pf[kt][3] = pack8(p[kt][1], 8); }
    if (hi == 0) wsc[i] = 1.f / l;
    asm volatile("" ::: "memory");
    f32x4 il[4];
#pragma unroll
    for (int rg = 0; rg < 4; ++rg) il[rg] = *(const f32x4*)(wsc + 8 * rg + 4 * hi);
    f32x16 o[2];
#pragma unroll
    for (int n = 16; n < 32; ++n) {
        const int dvt = (n - 16) >> 2, kt = n & 3, cb = n & 1;
        if (n + 3 < 32) tr[(n + 3) & 3] = *MEMA_SRC(n + 3);
        if (kt == 0) {
#pragma unroll
            for (int r = 0; r < 16; ++r) { o[0][r] = 0.f; o[1][r] = 0.f; }
        }
        const unsigned char* vb = sm + OFF_V + cb * VBUF;
#pragma unroll
        for (int dt = 0; dt < 2; ++dt) {
            const unsigned char* vp = vb + (32 * dt + i) * VROW + 8 * hi;
#pragma unroll
            for (int ks = 0; ks < 4; ++ks) {
                const u32x2 v_lo = *(const u32x2*)(vp + 32 * ks), v_hi = *(const u32x2*)(vp + 32 * ks + 16);
                const bf16x8 vf = __builtin_bit_cast(bf16x8, (u32x4){v_lo.x, v_lo.y, v_hi.x, v_hi.y});
                o[dt] = __builtin_amdgcn_mfma_f32_32x32x16_bf16(pf[kt][ks], vf, o[dt], 0, 0, 0);
            }
        }
        if (kt == 3) {
#pragma unroll
            for (int r = 0; r < 16; ++r) { bf16* op = om + (size_t)(row0 + crow(r, hi)) * DM + h * 256 + 64 * dvt + i;
                op[0] = (bf16)f2bf(o[0][r] * il[r >> 2][r & 3]); op[32] = (bf16)f2bf(o[1][r] * il[r >> 2][r & 3]); }
        }
        if (n + 1 < 32) MEMA_PUT(n + 1);
        __syncthreads();
    }
#undef MEMA_SRC
#undef MEMA_PUT
}
}

#define LAS __attribute__((address_space(3)))
#define XB_TMO      128
#define XB_XCNT(j)  (256  + 64 * (j))
#define XB_XSUB(j)  (1280 + 64 * (j))
#define XB_XGEN(j)  (2304 + 64 * (j))
#define XB_TOP      3328
#define XB_TOPGEN   3392
#define XCD_BAR_WORDS 3456
#define XB_SPIN_CAP (1u << 18)

__device__ __forceinline__ unsigned xb_ld(unsigned* p)              { return __hip_atomic_load(p, __ATOMIC_RELAXED, __HIP_MEMORY_SCOPE_AGENT); }
__device__ __forceinline__ unsigned xb_add(unsigned* p, unsigned v) { return __hip_atomic_fetch_add(p, v, __ATOMIC_RELAXED, __HIP_MEMORY_SCOPE_AGENT); }
__device__ __forceinline__ unsigned xb_xcc_id() { return (unsigned)__builtin_amdgcn_s_getreg((3 << 11) | 20) & 0xFu; }
#define XB_SPIN(cond, bar) do { unsigned _sp = 0; while (cond) { __builtin_amdgcn_s_sleep(1); \
    if ((++_sp & 255u) == 0u) { if (xb_ld(&(bar)[XB_TMO])) break; if (_sp > XB_SPIN_CAP) { atomicAdd(&(bar)[XB_TMO], 1u); break; } } } } while (0)

struct XcdBarrier {
    unsigned* bar; unsigned x;
    volatile LAS unsigned* st;
};

__device__ __forceinline__ XcdBarrier xcd_barrier_post(unsigned* bar, volatile LAS unsigned* st) {
    XcdBarrier b; b.bar = bar; b.x = xb_xcc_id(); b.st = st;
    if (tidx() == 0) (void)xb_add(&bar[XB_XCNT(b.x)], 1u);
    return b;
}
__device__ __forceinline__ void xcd_barrier_complete(unsigned* bar, unsigned x, unsigned& nloc, unsigned& nx, unsigned gsize) {
    const unsigned G = gsize ? gsize : gridDim.x * gridDim.y * gridDim.z;
    unsigned sum, cnt, mine, sp = 0u;
    for (;;) {
        sum = 0u; cnt = 0u; mine = 0u;
#pragma unroll
        for (unsigned j = 0; j < 16; ++j) { const unsigned c = xb_ld(&bar[XB_XCNT(j)]); sum += c; cnt += (c > 0u) ? 1u : 0u; mine = (j == x) ? c : mine; }
        if (sum == G) break;
        __builtin_amdgcn_s_sleep(1);
        if ((++sp & 255u) == 0u) { if (xb_ld(&bar[XB_TMO])) break; if (sp > XB_SPIN_CAP) { atomicAdd(&bar[XB_TMO], 1u); break; } }
    }
    nloc = mine > 0u ? mine : 1u; nx = cnt > 0u ? cnt : 1u;
}

__device__ __forceinline__ void xcd_barrier(const XcdBarrier& b, unsigned gsize = 0u) {
    asm volatile("s_waitcnt vmcnt(0)" ::: "memory");
    __syncthreads();
    if (tidx() == 0) {
        unsigned* bar = b.bar;
        __builtin_amdgcn_s_waitcnt(0);
        unsigned nloc = b.st[0], nx = b.st[1];
        if (nloc == 0u) { xcd_barrier_complete(bar, b.x, nloc, nx, gsize); b.st[0] = nloc; b.st[1] = nx; }
        const unsigned old = xb_add(&bar[XB_XSUB(b.x)], 1u);
        const unsigned gen = old / nloc;
        if (old + 1u == (gen + 1u) * nloc) {
            __builtin_amdgcn_fence(__ATOMIC_RELEASE, "agent");
            asm volatile("s_waitcnt vmcnt(0)" ::: "memory");
            const unsigned og = xb_add(&bar[XB_TOP], 1u);
            const unsigned tg = og / nx;
            if (og + 1u == (tg + 1u) * nx) xb_add(&bar[XB_TOPGEN], 1u);
            else XB_SPIN(xb_ld(&bar[XB_TOPGEN]) == tg, bar);
            __builtin_amdgcn_fence(__ATOMIC_ACQUIRE, "agent");
            xb_add(&bar[XB_XGEN(b.x)], 1u);
            asm volatile("s_waitcnt vmcnt(0)" ::: "memory");
        } else {
            XB_SPIN(xb_ld(&bar[XB_XGEN(b.x)]) == gen, bar);
            __builtin_amdgcn_fence(__ATOMIC_ACQUIRE, "agent");
            asm volatile("s_waitcnt vmcnt(0)" ::: "memory");
        }
    }
    __syncthreads();
}

__device__ __forceinline__ void wg_signal(unsigned* cnt) {
    asm volatile("s_waitcnt vmcnt(0)" ::: "memory");
    __syncthreads();
    if (tidx() == 0) { __builtin_amdgcn_fence(__ATOMIC_RELEASE, "agent"); asm volatile("s_waitcnt vmcnt(0)" ::: "memory"); (void)xb_add(cnt, 1u); }
}
__device__ __forceinline__ void wg_wait(unsigned* cnt, unsigned need) {
    if (tidx() == 0) { unsigned sp = 0u; while (xb_ld(cnt) < need && ++sp < (1u << 22)) __builtin_amdgcn_s_sleep(2);
        __builtin_amdgcn_fence(__ATOMIC_ACQUIRE, "agent"); asm volatile("s_waitcnt vmcnt(0)" ::: "memory"); }
    __syncthreads();
}

constexpr int NTHREADS = 512, LDS_BYTES = 147456;
struct MegaArgs { const float* in[41]; float* out; unsigned char* ws; };
#define WSB(off) ((bf16*)(ws + (off)))
#define WSF(off) ((float*)(ws + (off)))

__global__ void __launch_bounds__(NTHREADS) mega_fwd(MegaArgs A) {
    extern __shared__ __attribute__((aligned(16))) unsigned char lds[];
    cg::grid_group grid = cg::this_grid();
    const float* const* in = A.in; unsigned char* ws = A.ws; float* out = A.out;
    if (tidx() < 4) ((volatile LAS unsigned*)(lds + LDS_BYTES - 64))[tidx()] = 0u;
    __syncthreads();
    const XcdBarrier xbar = xcd_barrier_post((unsigned*)(ws + WS_CTL) + 16384, (volatile LAS unsigned*)(lds + LDS_BYTES - 64));
    constexpr int NRW = 16 * (1 + rw7::NHELP);

    d_convert(WSB(WS_W1GU), NGU, DM, MapGU{in[I_F1_WG], in[I_F1_WU], FF});
    d_convert(WSB(WS_WIN), NWIN, DM, MapWin{in[I_WIN], IN_COLS});
    d_convert(WSB(WS_CW1K), 256, 2048, MapPlain{in[I_W1_K], 256});
    d_convert(WSB(WS_CW1V), 256, 2048, MapPlain{in[I_W1_V], 256});
    d_convert_lora(WSB(WS_WLORA), in[I_W2], in[I_A2], in[I_G2]);
    d_convert(WSB(WS_WK), DM, DM, MapPlain{in[I_WK], DM});
    d_convert(WSB(WS_WV), DM, DM, MapPlain{in[I_WV], DM});
    d_convert(WSB(WS_CW2), 64, 256, MapPlain{in[I_W2_K], 64});
    d_convert(WSB(WS_CW2) + 64 * 256, 64, 256, MapPlain{in[I_W2_V], 64});
    d_rope_table(WSF(WS_ROPE));
    d_cmp_bias(in[I_PE_K], in[I_W1_K], in[I_PE_V], in[I_W1_V], WSF(WS_CBIAS), (float*)lds);
    d_rownorm(in[I_X], in[I_F1_PRE], WSB(WS_XN), M_);
    d_rownorm(in[I_MEM], in[I_MEM_KVG], WSB(WS_MEMN), 512);
    grid.sync();
    gemm_pg8(lds, WSB(WS_XN), DM, WSB(WS_W1GU), DM, M_, NGU, DM, EpiSwiGLU{WSB(WS_HB)});
    d_convert(WSB(WS_W1D), DM, FF, MapPlain{in[I_F1_WD], DM}, 128);
    xcd_barrier(xbar);
    gemm_norm_res<false, true>(lds, WSB(WS_HB), FF, WSB(WS_W1D), FF, in[I_X], out, WSB(WS_XN), in[I_F1_POST], in[I_MIX_PRE], 0.5f, (unsigned*)(ws + WS_GATES), (unsigned*)(ws + WS_CTL) + 1024 + 0 * 2048);
    xcd_barrier(xbar);
    gemm_pg8(lds, WSB(WS_XN), DM, WSB(WS_WIN), DM, M_, 3072, DM,
             EpiWin{WSB(WS_QB), WSB(WS_KS), WSB(WS_KW), WSB(WS_KCR), WSB(WS_VCR), WSB(WS_VST), WSB(WS_VWT), (unsigned*)(ws + WS_RKVA), WSB(WS_RKVA + 32 * MiB), WSB(WS_PRL), WSF(WS_GATES), WSF(WS_ROPE)});
    d_gates(WSB(WS_XN), WSB(WS_WIN) + (size_t)3072 * DM, WSF(WS_GATES), (float*)lds);
    if (blockIdx.x == 0) { const int t_ = tidx(); float b_ = 0.f; for (int jc = 0; jc < 8; ++jc) b_ += WSF(WS_CBIAS)[jc * 512 + t_]; WSF(WS_CBIAS)[4096 + t_] = b_; }
    xcd_barrier(xbar);
    d_lora_prep(WSB(WS_PRL), in[I_MU], WSB(WS_XN));
    xcd_barrier(xbar);
    gemm_pg8(lds, WSB(WS_XN), KLORA, WSB(WS_WLORA), KLORA, M_, NLORA, KLORA, EpiLora{WSF(WS_YB), WSB(WS_RKVA + 48 * MiB), WSB(WS_AGG), in[I_W0], in[I_A0]});
    xcd_barrier(xbar);
    unsigned* cready = (unsigned*)(ws + WS_CTL) + 128;
    if ((int)blockIdx.x < NRW) {
        const rw7::Args ra{(const unsigned*)(ws + WS_RKVA), WSB(WS_RKVA + 32 * MiB), WSB(WS_RKVA + 48 * MiB), WSF(WS_YB), in[I_MU], in[I_KK], in[I_KA], in[I_RK], WSF(WS_YB), WSF(WS_BONUS),
                           ws + WS_BONUS + 1 * MiB, (unsigned*)(ws + WS_CTL) + 32768, (unsigned*)(ws + WS_CTL) + 24576};
        if (blockIdx.x < 16) rw7::head(ra, blockIdx.x, lds);
        else rw7::helper(ra, (blockIdx.x - 16) % 16, (blockIdx.x - 16) / 16, lds);
        __syncthreads();
    } else {
        unsigned* c1 = (unsigned*)(ws + WS_CTL) + 64;
        const int wl = (int)blockIdx.x - NRW;
        if (wl < 32) {
            float* part = (float*)(ws + WS_XN + 8 * MiB);
            gemm_pg8(lds, WSB(WS_KCR), 1024, WSB(WS_CW1K), 2048, 2048, 256, 1024, EpiStoreF32{part, 256}, NRW);
            gemm_pg8(lds, WSB(WS_KCR) + 1024, 1024, WSB(WS_CW1K) + 1024, 2048, 2048, 256, 1024, EpiStoreF32{part + (size_t)2048 * 256, 256}, NRW + 8);
            gemm_pg8(lds, WSB(WS_VCR), 1024, WSB(WS_CW1V), 2048, 2048, 256, 1024, EpiStoreF32{part + (size_t)2 * 2048 * 256, 256}, NRW + 16);
            gemm_pg8(lds, WSB(WS_VCR) + 1024, 1024, WSB(WS_CW1V) + 1024, 2048, 2048, 256, 1024, EpiStoreF32{part + (size_t)3 * 2048 * 256, 256}, NRW + 24);
            wg_signal(c1);
            wg_wait(c1, 32u);
            d_cmp2((const float*)(ws + WS_XN + 8 * MiB), WSF(WS_CBIAS) + 4096, WSB(WS_CW2), WSF(WS_ROPE), WSB(WS_KC), WSB(WS_VCT), NRW);
            wg_signal(cready);
        } else {
            gemm_pg8(lds, WSB(WS_MEMN), DM, WSB(WS_WK), DM, 512, DM, DM, EpiStore{WSB(WS_HIDK), DM, 1.f}, NRW + 32);
            gemm_pg8(lds, WSB(WS_WV), DM, WSB(WS_MEMN), DM, DM, 512, DM, EpiStore{WSB(WS_HIDV), 512, 1.f}, NRW + 40);
            d_convert(WSB(WS_W2GU), NGU, DM, MapGU{in[I_F2_WG], in[I_F2_WU], FF}, NRW + 48);
            d_convert(WSB(WS_WOUT), DM, DM, MapPlain{in[I_WOUT], DM}, NRW + 48);
            d_convert(WSB(WS_WQ), DM, DM, MapPlain{in[I_WQ], DM}, NRW + 48);
            d_convert(WSB(WS_WO), DM, DM, MapPlain{in[I_WO], DM}, NRW + 48);
        }
    }
    wg_wait(cready, 32u);
    {
        const NsaArgs na{WSB(WS_QB), WSB(WS_KC), WSB(WS_VCT), WSB(WS_KS), WSB(WS_VST), WSB(WS_KW), WSB(WS_VWT), WSF(WS_GATES), WSB(WS_XN)};
        nsa::phase(na, (unsigned*)(ws + WS_CTL), lds);
    }
    xcd_barrier(xbar);
    d_nsa_outnorm(WSB(WS_XN), in[I_NSA_G]);
    rw7::finish(WSF(WS_YB), WSF(WS_BONUS), WSB(WS_RKVA + 32 * MiB), WSB(WS_AGG), in[I_MU], in[I_GNG], in[I_GNB], WSB(WS_XN));
    xcd_barrier(xbar);
    gemm_norm_res<true, true>(lds, WSB(WS_XN), DM, WSB(WS_WOUT), DM, out, WSB(WS_YB), WSB(WS_XN), in[I_MIX_POST], in[I_MEM_PRE], 1.0f, (unsigned*)(ws + WS_GATES), (unsigned*)(ws + WS_CTL) + 1024 + 1 * 2048);
    xcd_barrier(xbar);
    gemm_pg8(lds, WSB(WS_XN), DM, WSB(WS_WQ), DM, M_, DM, DM, EpiStore{WSB(WS_QM), DM, MSCALE});
    xcd_barrier(xbar);
    if (blockIdx.x < 256) mema::unit(WSB(WS_QM), WSB(WS_HIDK), WSB(WS_HIDV), WSB(WS_OM), (int)blockIdx.x, lds);
    xcd_barrier(xbar);
    gemm_norm_res<true, true>(lds, WSB(WS_OM), DM, WSB(WS_WO), DM, WSB(WS_YB), WSB(WS_YB), WSB(WS_XN), in[I_MEM_POST], in[I_F2_PRE], 1.0f, (unsigned*)(ws + WS_GATES), (unsigned*)(ws + WS_CTL) + 1024 + 2 * 2048);
    xcd_barrier(xbar);
    gemm_pg8(lds, WSB(WS_XN), DM, WSB(WS_W2GU), DM, M_, NGU, DM, EpiSwiGLU{WSB(WS_HB)});
    d_convert(WSB(WS_W2D), DM, FF, MapPlain{in[I_F2_WD], DM}, 128);
    xcd_barrier(xbar);
    gemm_norm_res<true, false>(lds, WSB(WS_HB), FF, WSB(WS_W2D), FF, WSB(WS_YB), out, (bf16*)nullptr, in[I_F2_POST], (const float*)nullptr, 0.5f, (unsigned*)(ws + WS_GATES), (unsigned*)(ws + WS_CTL) + 1024 + 3 * 2048);
}

extern "C" void kernel_launch(void* const* d_in, const int* in_sizes, int n_in, void* d_out, int out_size, void* d_ws, size_t ws_size, hipStream_t stream) {
    static int grid = 0;
    if (grid == 0) {
        if (n_in != 41 || ws_size < WS_END) { fprintf(stderr, "kernel_launch: unexpected n_in %d / ws %zu\n", n_in, ws_size); grid = -1; return; }
        int dev = 0, cus = 0, per_cu = 0;
        hipGetDevice(&dev); hipDeviceGetAttribute(&cus, hipDeviceAttributeMultiprocessorCount, dev);
        if (hipFuncSetAttribute((const void*)mega_fwd, hipFuncAttributeMaxDynamicSharedMemorySize, LDS_BYTES) != hipSuccess) { fprintf(stderr, "kernel_launch: hipFuncSetAttribute failed\n"); grid = -1; return; }
        if (hipOccupancyMaxActiveBlocksPerMultiprocessor(&per_cu, (const void*)mega_fwd, NTHREADS, LDS_BYTES) != hipSuccess || per_cu < 1) { fprintf(stderr, "kernel_launch: occupancy query says %d\n", per_cu); grid = -1; (void)hipGetLastError(); return; }
        grid = cus;
        if (grid != 256) { fprintf(stderr, "kernel_launch: built for 256 CUs (one 256x256 tile per workgroup in the fused norm epilogues), found %d\n", cus); grid = -1; return; }
    }
    if (grid < 0) return;
    MegaArgs a{};
    for (int i = 0; i < 41; ++i) a.in[i] = (const float*)d_in[i];
    a.out = (float*)d_out; a.ws = (unsigned char*)d_ws;
    hipMemsetAsync(d_ws, 0, 196608, stream);
    void* args[] = {&a};
    hipError_t e = hipLaunchCooperativeKernel((const void*)mega_fwd, dim3(grid), dim3(NTHREADS), args, LDS_BYTES, stream);
    if (e != hipSuccess) fprintf(stderr, "kernel_launch: cooperative launch failed: %s (grid %d)\n", hipGetErrorString(e), grid);
}
```
